# Optimizing an MI355X kernel written in HIP

```python
import jax, jax.numpy as jnp
from jax import lax
import numpy as np

D_MODEL = 1024
BATCH = 4
SEQ = 8192
DEPTH = 1

HEAD_DIM = 64
N_ATT_HEADS = (D_MODEL // 2) // HEAD_DIM
N_RWKV_HEADS = (D_MODEL // 2) // HEAD_DIM
ATT_W = N_ATT_HEADS * HEAD_DIM
RWKV_W = N_RWKV_HEADS * HEAD_DIM
MIX_W = ATT_W + RWKV_W
GRID_W = 64
WIN_H = 8
WIN_W = 16
ROWS_PER_BLOCK = 2
D_DECAY_LORA = 64
D_AAA_LORA = 64
D_GATE_LORA = 128
N_DIR = 2
SHIFT_W = 3 * RWKV_W + N_DIR * D_DECAY_LORA + N_DIR * D_AAA_LORA + D_GATE_LORA
IN_PROJ_W = 3 * ATT_W + SHIFT_W
N_EXPERTS = 32
TOP_K = 4
D_EXPERT = D_MODEL
SWIGLU_ALPHA = 1.702
SWIGLU_LIMIT = 7.0
EXPERT_BLOCK = 128
RMS_EPS = 1e-5
GN_EPS = 64e-5

kernel_name = "hybrid_na2d_birwkv7_moe_block"


def rmsnorm(x, w):
    xf = x.astype(jnp.float32)
    y = xf * lax.rsqrt(jnp.mean(xf * xf, axis=-1, keepdims=True) + RMS_EPS)
    return (y * w.astype(jnp.float32)).astype(x.dtype)


def neighbourhood_attention(q, k, v, rpb):
    B, T, H, dh = q.shape
    rows = T // GRID_W
    kh = min(WIN_H, rows)
    kw = WIN_W
    qg = q.reshape(B, rows, GRID_W, H, dh)
    kg = k.reshape(B, rows, GRID_W, H, dh)
    vg = v.reshape(B, rows, GRID_W, H, dh)
    cols = np.arange(GRID_W)
    col_start = np.clip(cols - kw // 2, 0, GRID_W - kw)
    col_idx = col_start[:, None] + np.arange(kw)[None, :]
    dc = col_idx - cols[:, None] + (WIN_W - 1)
    n_blocks = rows // ROWS_PER_BLOCK
    scale = dh ** -0.5

    def block(bi):
        r = bi * ROWS_PER_BLOCK + jnp.arange(ROWS_PER_BLOCK)
        r_start = jnp.clip(r - kh // 2, 0, rows - kh)
        row_idx = r_start[:, None] + jnp.arange(kh)[None, :]
        q_blk = lax.dynamic_slice_in_dim(qg, bi * ROWS_PER_BLOCK, ROWS_PER_BLOCK, axis=1)
        k_win = kg[:, row_idx][:, :, :, col_idx]
        v_win = vg[:, row_idx][:, :, :, col_idx]
        s = jnp.einsum('brchd,bricjhd->bhrcij', q_blk, k_win).astype(jnp.float32) * scale
        dr = row_idx - r[:, None] + (WIN_H - 1)
        bias = rpb[:, dr[:, None, :, None], dc[None, :, None, :]]
        s = s + bias.astype(jnp.float32)[None]
        p = jax.nn.softmax(s.reshape(s.shape[:4] + (kh * kw,)), axis=-1).reshape(s.shape)
        return jnp.einsum('bhrcij,bricjhd->brchd', p.astype(v.dtype), v_win)

    out = lax.map(block, jnp.arange(n_blocks))
    return jnp.moveaxis(out, 0, 1).reshape(B, T, H, dh)


def rwkv7_bidir(p, mu_prev, mu_next, w0, w2, a0, a2, g2, k_k, k_a, r_k, ln_w, ln_b):
    B, T, _ = p.shape
    H, N, C = N_RWKV_HEADS, HEAD_DIM, RWKV_W
    p_prev = jnp.pad(p, ((0, 0), (1, 0), (0, 0)))[:, :-1]
    p_next = jnp.pad(p, ((0, 0), (0, 1), (0, 0)))[:, 1:]
    p = p + mu_prev * (p_prev - p) + mu_next * (p_next - p)
    split_at = list(np.cumsum([C, C, C, N_DIR * D_DECAY_LORA, N_DIR * D_AAA_LORA]))
    r, k, v, dw, da, dg = jnp.split(p, split_at, axis=-1)
    dw = dw.reshape(B, T, N_DIR, D_DECAY_LORA)
    da = da.reshape(B, T, N_DIR, D_AAA_LORA)
    w_log = -jax.nn.softplus(-(w0[:, None, None, :] + jnp.einsum('btzr,zrc->zbtc', jnp.tanh(dw), w2))) - 0.5
    decay = jnp.exp(-jnp.exp(w_log.astype(jnp.float32)))
    a = jax.nn.sigmoid(a0[:, None, None, :] + jnp.einsum('btzr,zrc->zbtc', da, a2))
    g = jax.nn.sigmoid(dg) @ g2
    heads = lambda u: u.reshape(u.shape[:-1] + (H, N))
    kk = heads((k * k_k).astype(jnp.float32))
    kk = kk / jnp.maximum(jnp.sqrt(jnp.sum(kk * kk, axis=-1, keepdims=True)), 1e-12)
    kk_c = kk.reshape(B, T, C)
    k_dir = k[None] * (1.0 + (a - 1.0) * k_a)
    a_kk = a.astype(jnp.float32) * kk_c[None]
    both = lambda u: jnp.broadcast_to(u[None], (N_DIR,) + u.shape)

    def orient(u):
        return jnp.stack([u[0], jnp.flip(u[1], axis=1)])

    to_scan = lambda u: jnp.moveaxis(orient(heads(u.astype(jnp.float32))), 2, 0)
    xs = (to_scan(both(r)), to_scan(decay), to_scan(k_dir), to_scan(both(v)),
          to_scan(both(kk_c)), to_scan(a_kk))

    def step(S, inp):
        r_t, w_t, k_t, v_t, kk_t, akk_t = inp
        sa = jnp.einsum('zbhij,zbhj->zbhi', S, kk_t)
        S = S * w_t[..., None, :] - sa[..., :, None] * akk_t[..., None, :] + v_t[..., :, None] * k_t[..., None, :]
        return S, jnp.einsum('zbhij,zbhj->zbhi', S, r_t)

    S0 = jnp.zeros((N_DIR, B, H, N, N), jnp.float32)
    _, ys = lax.scan(step, S0, xs)
    y = orient(jnp.moveaxis(ys, 0, 2)).sum(axis=0)
    mean = jnp.mean(y, axis=-1, keepdims=True)
    var = jnp.mean((y - mean) ** 2, axis=-1, keepdims=True)
    yn = ((y - mean) * lax.rsqrt(var + GN_EPS)).reshape(B, T, C) * ln_w.astype(jnp.float32) + ln_b.astype(jnp.float32)
    coef = jnp.einsum('bthn,zbthn,hn->bth', heads(r.astype(jnp.float32)), heads(k_dir.astype(jnp.float32)),
                      r_k.astype(jnp.float32))
    bonus = (coef[..., None] * heads(v.astype(jnp.float32))).reshape(B, T, C)
    return ((yn + bonus) * g.astype(jnp.float32)).astype(p.dtype)


def clamped_swiglu(hcat):
    gate, lin = hcat[:, :D_EXPERT], hcat[:, D_EXPERT:]
    gate = jnp.minimum(gate, SWIGLU_LIMIT)
    lin = jnp.clip(lin, -SWIGLU_LIMIT, SWIGLU_LIMIT)
    return (lin + 1.0) * (gate * jax.nn.sigmoid(SWIGLU_ALPHA * gate))


def moe(x2d, router_w, router_b, w_up, b_up, w_down, b_down):
    M, D = x2d.shape
    logits = (x2d @ router_w + router_b).astype(jnp.float32)
    top_val, top_idx = lax.top_k(logits, TOP_K)
    gates = jax.nn.softmax(top_val, axis=-1)
    A = M * TOP_K
    e_flat = top_idx.reshape(A)
    tok_flat = jnp.arange(A, dtype=jnp.int32) // TOP_K
    g_flat = gates.reshape(A)
    order = jnp.argsort(e_flat)
    e_s, tok_s, g_s = e_flat[order], tok_flat[order], g_flat[order]
    counts = jnp.bincount(e_flat, length=N_EXPERTS)
    padded = (counts + EXPERT_BLOCK - 1) // EXPERT_BLOCK * EXPERT_BLOCK
    start = jnp.cumsum(counts) - counts
    pend = jnp.cumsum(padded)
    pstart = pend - padded
    dest = pstart[e_s] + (jnp.arange(A) - start[e_s])
    P = -(-(A + N_EXPERTS * EXPERT_BLOCK) // EXPERT_BLOCK) * EXPERT_BLOCK
    n_blk = P // EXPERT_BLOCK
    row_tok = jnp.zeros((P,), jnp.int32).at[dest].set(tok_s)
    x_buf = x2d[row_tok].reshape(n_blk, EXPERT_BLOCK, D)
    blk_expert = jnp.searchsorted(pend, jnp.arange(n_blk) * EXPERT_BLOCK, side='right')
    blk_expert = jnp.minimum(blk_expert, N_EXPERTS - 1)

    def expert_block(args):
        xb, e = args
        hcat = xb @ w_up[e] + b_up[e]
        return clamped_swiglu(hcat) @ w_down[e] + b_down[e]

    y_buf = lax.map(expert_block, (x_buf, blk_expert)).reshape(P, D)
    contrib = g_s[:, None].astype(x2d.dtype) * y_buf[dest]
    return jax.ops.segment_sum(contrib, tok_s, num_segments=M)


def setup_inputs(seed: int = 0) -> dict:
    key = jax.random.key(seed)
    ks = jax.random.split(key, 32)
    L, D, C = DEPTH, D_MODEL, RWKV_W
    nrm = lambda k, s, sc: jax.random.normal(k, s, jnp.float32) * sc
    return {
        "x": nrm(ks[0], (BATCH, SEQ, D), 1.0),
        "norm1_w": 1.0 + nrm(ks[1], (L, D), 0.05),
        "w_in": nrm(ks[2], (L, D, IN_PROJ_W), D ** -0.5),
        "attn_rpb": nrm(ks[3], (L, N_ATT_HEADS, 2 * WIN_H - 1, 2 * WIN_W - 1), 0.1),
        "attn_norm_w": 1.0 + nrm(ks[4], (L, ATT_W), 0.05),
        "rwkv_mu_prev": jax.random.uniform(ks[5], (L, SHIFT_W), jnp.float32, 0.0, 0.5),
        "rwkv_mu_next": jax.random.uniform(ks[6], (L, SHIFT_W), jnp.float32, 0.0, 0.5),
        "rwkv_w0": nrm(ks[7], (L, N_DIR, C), 0.5),
        "rwkv_w2": nrm(ks[8], (L, N_DIR, D_DECAY_LORA, C), 0.1),
        "rwkv_a0": nrm(ks[9], (L, N_DIR, C), 0.5),
        "rwkv_a2": nrm(ks[10], (L, N_DIR, D_AAA_LORA, C), 0.1),
        "rwkv_g2": nrm(ks[11], (L, D_GATE_LORA, C), D_GATE_LORA ** -0.5),
        "rwkv_k_k": 0.85 + nrm(ks[12], (L, C), 0.05),
        "rwkv_k_a": 1.0 + nrm(ks[13], (L, C), 0.05),
        "rwkv_r_k": nrm(ks[14], (L, N_RWKV_HEADS, HEAD_DIM), 0.1),
        "rwkv_ln_w": 1.0 + nrm(ks[15], (L, C), 0.05),
        "rwkv_ln_b": nrm(ks[16], (L, C), 0.01),
        "w_o": nrm(ks[17], (L, MIX_W, D), MIX_W ** -0.5),
        "norm2_w": 1.0 + nrm(ks[18], (L, D), 0.05),
        "router_w": nrm(ks[19], (L, D, N_EXPERTS), D ** -0.5),
        "router_b": nrm(ks[20], (L, N_EXPERTS), 0.01),
        "expert_w_up": nrm(ks[21], (L, N_EXPERTS, D, 2 * D_EXPERT), D ** -0.5),
        "expert_b_up": nrm(ks[22], (L, N_EXPERTS, 2 * D_EXPERT), 0.01),
        "expert_w_down": nrm(ks[23], (L, N_EXPERTS, D_EXPERT, D), D_EXPERT ** -0.5),
        "expert_b_down": nrm(ks[24], (L, N_EXPERTS, D), 0.01),
        "final_norm_w": 1.0 + nrm(ks[25], (D,), 0.05),
    }


def reference(x, norm1_w, w_in, attn_rpb, attn_norm_w, rwkv_mu_prev, rwkv_mu_next, rwkv_w0, rwkv_w2,
              rwkv_a0, rwkv_a2, rwkv_g2, rwkv_k_k, rwkv_k_a, rwkv_r_k, rwkv_ln_w, rwkv_ln_b, w_o,
              norm2_w, router_w, router_b, expert_w_up, expert_b_up, expert_w_down, expert_b_down,
              final_norm_w):
    B, T, D = x.shape
    h = x
    for l in range(DEPTH):
        hn = rmsnorm(h, norm1_w[l])
        proj = hn @ w_in[l]
        q = proj[..., :ATT_W].reshape(B, T, N_ATT_HEADS, HEAD_DIM)
        k = proj[..., ATT_W:2 * ATT_W].reshape(B, T, N_ATT_HEADS, HEAD_DIM)
        v = proj[..., 2 * ATT_W:3 * ATT_W].reshape(B, T, N_ATT_HEADS, HEAD_DIM)
        att = neighbourhood_attention(q, k, v, attn_rpb[l]).reshape(B, T, ATT_W)
        att = rmsnorm(att, attn_norm_w[l])
        rk = rwkv7_bidir(proj[..., 3 * ATT_W:], rwkv_mu_prev[l], rwkv_mu_next[l], rwkv_w0[l], rwkv_w2[l],
                         rwkv_a0[l], rwkv_a2[l], rwkv_g2[l], rwkv_k_k[l], rwkv_k_a[l], rwkv_r_k[l],
                         rwkv_ln_w[l], rwkv_ln_b[l])
        h = h + jnp.concatenate([att, rk], axis=-1) @ w_o[l]
        hn = rmsnorm(h, norm2_w[l])
        h = h + moe(hn.reshape(B * T, D), router_w[l], router_b[l], expert_w_up[l], expert_b_up[l],
                    expert_w_down[l], expert_b_down[l]).reshape(B, T, D)
    return rmsnorm(h, final_norm_w)
```

```cpp
#include <hip/hip_runtime.h>
#include <hip/hip_cooperative_groups.h>
#include <cstdio>
#include <cstdint>
namespace cg = cooperative_groups;

#ifndef MK_SPLIT
#define MK_SPLIT 0
#endif

#define LAS __attribute__((address_space(3)))
typedef unsigned short bf16;
typedef float f32x4 __attribute__((ext_vector_type(4)));
typedef float f32x2 __attribute__((ext_vector_type(2)));
typedef unsigned u32x4 __attribute__((ext_vector_type(4)));
typedef unsigned u32x2 __attribute__((ext_vector_type(2)));
typedef short bf16x8 __attribute__((ext_vector_type(8)));

constexpr int BATCH = 4, T = 8192, D = 1024, M = BATCH * T;
constexpr int NH = 8, HD = 64, CW = 512;
constexpr int SHIFT_W = 1920, NPROJ = 3456, NPROJ_PAD = 3584, PW = 2048;
constexpr int NE = 32, TOPK = 4, DE = 1024;
constexpr int GRIDW = 64, GROWS = 128;
constexpr int P_TILES_MAX = 544, P_ROWS = P_TILES_MAX * 256;
constexpr float RMS_EPS = 1e-5f, GN_EPS = 64e-5f;
constexpr int NPHASE = 11;

constexpr size_t MiB = 1u << 20;
constexpr size_t WS_CTL = 0;
constexpr size_t WS_W2T = 1 * MiB, WS_A2T = WS_W2T + 131072, WS_G2T = WS_A2T + 131072;
constexpr size_t WS_WINT = 2 * MiB, WS_WOT = 9 * MiB, WS_WUPT = 12 * MiB, WS_WDNT = 140 * MiB;
constexpr size_t WS_EIDX = 204 * MiB, WS_GATE = WS_EIDX + 524288, WS_RANK = WS_GATE + 524288, WS_DEST = WS_RANK + 524288;
constexpr size_t WS_R = 208 * MiB, WS_V = 240 * MiB, WS_KK = 272 * MiB, WS_DECAY = 304 * MiB, WS_KDIR = 368 * MiB, WS_AKK = 432 * MiB,
                 WS_G = 496 * MiB, WS_ATT = 528 * MiB;
constexpr size_t WS_Q = 560 * MiB, WS_K = 592 * MiB, WS_VT = 624 * MiB, WS_P = 656 * MiB, WS_HN = 784 * MiB, WS_Y = 848 * MiB;
constexpr size_t WS_MIX = 560 * MiB, WS_H = 752 * MiB, WS_HN2 = 880 * MiB, WS_XBUF = 208 * MiB, WS_ACT = 480 * MiB, WS_YBUF = 208 * MiB;
constexpr size_t WS_END = 976 * MiB;
constexpr int CW_NT = 0, CW_TEXP = 64, CW_CNT = 1024;

constexpr int LDS_BYTES = 159744;

__device__ __forceinline__ unsigned cvt_pk_bf16(float lo, float hi) { unsigned r; asm volatile("v_cvt_pk_bf16_f32 %0, %1, %2" : "=v"(r) : "v"(lo), "v"(hi)); return r; }
__device__ __forceinline__ float bflo(unsigned u) { return __uint_as_float(u << 16); }
__device__ __forceinline__ float bfhi(unsigned u) { return __uint_as_float(u & 0xffff0000u); }
__device__ __forceinline__ float bf1(bf16 v) { return __uint_as_float(((unsigned)v) << 16); }
__device__ __forceinline__ void unpack8(const u32x4 u, float* f) { f[0] = bflo(u.x); f[1] = bfhi(u.x); f[2] = bflo(u.y); f[3] = bfhi(u.y); f[4] = bflo(u.z); f[5] = bfhi(u.z); f[6] = bflo(u.w); f[7] = bfhi(u.w); }
__device__ __forceinline__ u32x4 pack8(const float* f) { u32x4 o; o.x = cvt_pk_bf16(f[0], f[1]); o.y = cvt_pk_bf16(f[2], f[3]); o.z = cvt_pk_bf16(f[4], f[5]); o.w = cvt_pk_bf16(f[6], f[7]); return o; }
__device__ __forceinline__ float wave_sum(float v) {
#pragma unroll
    for (int o = 1; o < 64; o <<= 1) v += __shfl_xor(v, o);
    return v;
}
__device__ __forceinline__ float sigmoidf_(float x) { return 1.0f / (1.0f + __expf(-x)); }
__device__ __forceinline__ unsigned ld_u32_agent(const unsigned* p) { return __hip_atomic_load(p, __ATOMIC_RELAXED, __HIP_MEMORY_SCOPE_AGENT); }

namespace pg8 {
constexpr int BM = 256, BK = 64, HALF = 128, HTB = HALF * BK * 2, STAGE_BYTES = 8 * HTB, NXCD = 8, WGM = 8;
__host__ __device__ __forceinline__ int lds_byte(int r, int c) { const int st = (r >> 4) * 2 + (c >> 5), rr = r & 15, cc = c & 31, ob = rr * 64 + cc * 2; return st * 1024 + (ob ^ (((ob >> 9) & 1) << 5)); }
__host__ __device__ __forceinline__ void stage_rc(int b, int& R, int& C) { const int st = b / 1024, sb = b % 1024, swz = sb ^ (((sb >> 9) & 1) << 5); R = (st >> 1) * 16 + swz / 64; C = (st & 1) * 32 + (swz % 64) / 2; }
__host__ __device__ __forceinline__ int perm32(int rho) { const int n = rho >> 4, i = rho & 15; return 8 * (i >> 2) + 4 * n + (i & 3); }

struct Unit { int pm, pn, e; };
struct Gemm { const bf16* A; const bf16* Bt; int K; const unsigned* texp; size_t bstride; };

struct StaticOrder {
    int nM, nN, nwg, G, c;
    __device__ void init(int nM_, int nN_, int G_, int c_) { nM = nM_; nN = nN_; nwg = nM * nN; G = G_; c = c_; }
    __device__ bool next(int i, Unit& u) const {
        const long L = (long)i * G + c; if (L >= nwg) return false;
        int wgid = (int)L; { const int q = nwg / NXCD, r = nwg % NXCD, xcd = wgid % NXCD, off = wgid / NXCD; wgid = (xcd < r ? xcd * (q + 1) : r * (q + 1) + (xcd - r) * q) + off; }
        const int nig = WGM * nN, gid = wgid / nig, fm = gid * WGM, gsz = (nM - fm) < WGM ? (nM - fm) : WGM;
        u.pm = fm + ((wgid % nig) % gsz); u.pn = (wgid % nig) / gsz; u.e = 0; return true;
    }
};

template <class Epi, bool ALIGN_EPI, bool SP2>
__device__ __forceinline__ void gemm_phase(LAS unsigned char* lds, const Gemm g, const StaticOrder& S, const Epi& E) {
    const int tid = threadIdx.x, wid = __builtin_amdgcn_readfirstlane(tid >> 6), lane = tid & 63, wr = wid >> 2, wc = wid & 3, fr = lane & 15, fq = lane >> 4;
    const int K = g.K, nt = K / BK;
    unsigned voffA[2], voffB[2];
#pragma unroll
    for (int i = 0; i < 2; ++i) { int R, C; stage_rc(tid * 16 + i * 8192, R, C); const int Rb = Epi::PERM ? ((R & ~31) + perm32(R & 31)) : R;
        voffA[i] = (unsigned)(R * K + C) * 2u; voffB[i] = (unsigned)(Rb * K + C) * 2u; }
    const size_t kstep = (size_t)(BK * 2);
    const size_t hstep = (size_t)HALF * K * 2;
    const size_t tstep = 2 * hstep;
    const unsigned ldsw = (unsigned)wid * 1024u;
    const int aoff = lds_byte(wr * 64 + fr, fq * 8), boff = lds_byte(wc * 32 + fr, fq * 8);
#define PG8_SA(b, h) (((b) * 2 + (h)) * HTB)
#define PG8_SB(b, h) ((4 + (b) * 2 + (h)) * HTB)
#define PG8_STAGE(bufoff, gbase, voff) do { _Pragma("unroll") for (int _i = 0; _i < 2; ++_i) \
        __builtin_amdgcn_global_load_lds((const unsigned*)((const char*)(gbase) + (voff)[_i]), (LAS unsigned*)(lds + (bufoff) + ldsw + _i * 8192), 16, 0, 0); } while (0)
#define PG8_LDA(dst, b, h) do { _Pragma("unroll") for (int m = 0; m < 4; ++m) _Pragma("unroll") for (int k = 0; k < 2; ++k) dst[m][k] = *(const LAS bf16x8*)(lds + PG8_SA(b, h) + aoff + m * 2048 + k * 1024); } while (0)
#define PG8_LDB(dst, b, h) do { _Pragma("unroll") for (int n = 0; n < 2; ++n) _Pragma("unroll") for (int k = 0; k < 2; ++k) dst[n][k] = *(const LAS bf16x8*)(lds + PG8_SB(b, h) + boff + n * 2048 + k * 1024); } while (0)
#define PG8_MMA(ai, bj, At, Bt) do { __builtin_amdgcn_s_setprio(1); _Pragma("unroll") for (int m = 0; m < 4; ++m) _Pragma("unroll") for (int n = 0; n < 2; ++n) _Pragma("unroll") for (int k = 0; k < 2; ++k) \
        acc[ai][bj][m][n] = __builtin_amdgcn_mfma_f32_16x16x32_bf16(Bt[n][k], At[m][k], acc[ai][bj][m][n], 0, 0, 0); __builtin_amdgcn_s_setprio(0); } while (0)
#define PG8_WAIT_V(n) asm volatile("s_waitcnt vmcnt(" #n ")" ::: "memory")
#define PG8_WAIT_L(n) asm volatile("s_waitcnt lgkmcnt(" #n ")" ::: "memory")
#define PG8_BAR __builtin_amdgcn_s_barrier()
#define PG8_SCHED __builtin_amdgcn_sched_barrier(0)
#define PG8_UPTR(u, pa, pb) do { unsigned _e = g.texp ? ld_u32_agent(g.texp + (u).pm) : 0u; _e = (unsigned)__builtin_amdgcn_readfirstlane((int)_e); (u).e = (int)_e; \
        pa = (const char*)g.A + (size_t)(u).pm * tstep; pb = (const char*)g.Bt + (size_t)_e * g.bstride + (size_t)(u).pn * tstep; } while (0)
    Unit cur, nxt; int ui = 0;
    if (!S.next(0, cur)) return;
    f32x4 acc[2][2][4][2];
#pragma unroll
    for (int a = 0; a < 2; ++a)
#pragma unroll
        for (int b = 0; b < 2; ++b)
#pragma unroll
            for (int m = 0; m < 4; ++m)
#pragma unroll
                for (int n = 0; n < 2; ++n) acc[a][b][m][n] = (f32x4){0.f, 0.f, 0.f, 0.f};
    bf16x8 At[4][2], B0[2][2], B1[2][2];
    const char* cA; const char* cB;
    PG8_UPTR(cur, cA, cB);
    if constexpr (SP2) {
        PG8_STAGE(PG8_SB(0, 0), cB, voffB); PG8_STAGE(PG8_SB(0, 1), cB + hstep, voffB); PG8_STAGE(PG8_SA(0, 0), cA, voffA); PG8_STAGE(PG8_SA(0, 1), cA + hstep, voffA);
        if (wr == 1) PG8_BAR;
        PG8_WAIT_V(2); PG8_BAR;
        PG8_STAGE(PG8_SB(1, 0), cB + kstep, voffB); PG8_STAGE(PG8_SA(1, 0), cA + kstep, voffA); PG8_STAGE(PG8_SB(1, 1), cB + hstep + kstep, voffB);
        PG8_WAIT_V(6); PG8_BAR;
    } else {
        PG8_STAGE(PG8_SB(0, 0), cB, voffB); PG8_STAGE(PG8_SA(0, 0), cA, voffA); PG8_STAGE(PG8_SB(0, 1), cB + hstep, voffB); PG8_STAGE(PG8_SA(0, 1), cA + hstep, voffA);
        if (wr == 1) PG8_BAR;
        PG8_WAIT_V(4); PG8_BAR;
        PG8_STAGE(PG8_SB(1, 0), cB + kstep, voffB); PG8_STAGE(PG8_SA(1, 0), cA + kstep, voffA); PG8_STAGE(PG8_SB(1, 1), cB + hstep + kstep, voffB);
        PG8_WAIT_V(6); PG8_BAR;
    }
    for (;;) {
        const bool has_next = S.next(ui + 1, nxt);
        const char* nA = cA; const char* nB = cB;
        if (has_next) PG8_UPTR(nxt, nA, nB);
        for (int t = 0; t < nt; t += 2) {
            const bool last = (t == nt - 2);
            const char* a1 = cA + (size_t)(t + 1) * kstep;
            const char* a2 = last ? nA : cA + (size_t)(t + 2) * kstep; const char* b2 = last ? nB : cB + (size_t)(t + 2) * kstep;
            const char* a3 = a2 + kstep; const char* b3 = b2 + kstep;
            if constexpr (SP2) {
            PG8_LDB(B0, 0, 0); PG8_LDB(B1, 0, 1); PG8_SCHED; PG8_LDA(At, 0, 0); PG8_STAGE(PG8_SA(1, 1), a1 + hstep, voffA);
            PG8_WAIT_V(8); PG8_WAIT_L(0); PG8_BAR; PG8_MMA(0, 0, At, B0); PG8_MMA(0, 1, At, B1); PG8_BAR; PG8_SCHED;
            PG8_LDA(At, 0, 1); PG8_STAGE(PG8_SB(0, 0), b2, voffB); PG8_STAGE(PG8_SB(0, 1), b2 + hstep, voffB); PG8_STAGE(PG8_SA(0, 0), a2, voffA);
            PG8_WAIT_V(8); PG8_WAIT_L(0); PG8_BAR; PG8_MMA(1, 0, At, B0); PG8_MMA(1, 1, At, B1); PG8_BAR; PG8_SCHED;
            PG8_LDB(B0, 1, 0); PG8_LDB(B1, 1, 1); PG8_SCHED; PG8_LDA(At, 1, 0); PG8_STAGE(PG8_SA(0, 1), a2 + hstep, voffA);
            PG8_WAIT_V(8); PG8_WAIT_L(0); PG8_BAR; PG8_MMA(0, 0, At, B0); PG8_MMA(0, 1, At, B1); PG8_BAR; PG8_SCHED;
            PG8_LDA(At, 1, 1); PG8_STAGE(PG8_SB(1, 0), b3, voffB); PG8_STAGE(PG8_SB(1, 1), b3 + hstep, voffB); PG8_STAGE(PG8_SA(1, 0), a3, voffA);
            PG8_WAIT_V(8); PG8_WAIT_L(0); PG8_BAR; PG8_MMA(1, 0, At, B0); PG8_MMA(1, 1, At, B1); PG8_BAR; PG8_SCHED;
            } else {
            PG8_LDB(B0, 0, 0); PG8_SCHED; PG8_LDA(At, 0, 0); PG8_STAGE(PG8_SA(1, 1), a1 + hstep, voffA);
            PG8_WAIT_L(8); PG8_BAR; PG8_WAIT_L(0); PG8_MMA(0, 0, At, B0); PG8_BAR; PG8_SCHED;
            PG8_LDB(B1, 0, 1); PG8_STAGE(PG8_SB(0, 0), b2, voffB);
            PG8_BAR; PG8_WAIT_L(0); PG8_MMA(0, 1, At, B1); PG8_BAR;
            PG8_LDA(At, 0, 1); PG8_STAGE(PG8_SA(0, 0), a2, voffA);
            PG8_BAR; PG8_WAIT_L(0); PG8_MMA(1, 0, At, B0); PG8_BAR; PG8_SCHED;
            PG8_STAGE(PG8_SB(0, 1), b2 + hstep, voffB);
            PG8_WAIT_V(6); PG8_BAR; PG8_MMA(1, 1, At, B1); PG8_BAR;
            PG8_LDB(B0, 1, 0); PG8_SCHED; PG8_LDA(At, 1, 0); PG8_STAGE(PG8_SA(0, 1), a2 + hstep, voffA);
            PG8_WAIT_L(8); PG8_BAR; PG8_WAIT_L(0); PG8_MMA(0, 0, At, B0); PG8_BAR; PG8_SCHED;
            PG8_LDB(B1, 1, 1); PG8_STAGE(PG8_SB(1, 0), b3, voffB);
            PG8_BAR; PG8_WAIT_L(0); PG8_MMA(0, 1, At, B1); PG8_BAR;
            PG8_LDA(At, 1, 1); PG8_STAGE(PG8_SA(1, 0), a3, voffA);
            PG8_BAR; PG8_WAIT_L(0); PG8_MMA(1, 0, At, B0); PG8_BAR; PG8_SCHED;
            PG8_STAGE(PG8_SB(1, 1), b3 + hstep, voffB);
            PG8_WAIT_V(6); PG8_BAR; PG8_MMA(1, 1, At, B1); PG8_BAR;
            }
        }
        if constexpr (ALIGN_EPI) { if (wr == 0) PG8_BAR; }
        E(acc, cur, wr, wc, fr, fq);
        if (!has_next) break;
#pragma unroll
        for (int a = 0; a < 2; ++a)
#pragma unroll
            for (int b = 0; b < 2; ++b)
#pragma unroll
                for (int m = 0; m < 4; ++m)
#pragma unroll
                    for (int n = 0; n < 2; ++n) acc[a][b][m][n] = (f32x4){0.f, 0.f, 0.f, 0.f};
        cur = nxt; cA = nA; cB = nB; ++ui;
        if constexpr (ALIGN_EPI) { if (wr == 1) PG8_BAR; }
    }
    PG8_WAIT_V(0);
    if constexpr (!ALIGN_EPI) { if (wr == 0) PG8_BAR; }
    PG8_BAR;
#undef PG8_SA
#undef PG8_SB
#undef PG8_STAGE
#undef PG8_LDA
#undef PG8_LDB
#undef PG8_MMA
#undef PG8_WAIT_V
#undef PG8_WAIT_L
#undef PG8_BAR
#undef PG8_SCHED
#undef PG8_UPTR
}

struct EpiProj {
    static constexpr bool PERM = true;
    bf16 *q, *k, *vT, *p;
    __device__ __forceinline__ void operator()(const f32x4 (&acc)[2][2][4][2], const Unit& u, int wr, int wc, int fr, int fq) const {
        const int row0 = u.pm * BM + wr * 64 + fr;
        const int pn = u.pn;
#pragma unroll
        for (int ai = 0; ai < 2; ++ai)
#pragma unroll
            for (int m = 0; m < 4; ++m) {
                const int row = row0 + ai * HALF + m * 16;
#pragma unroll
                for (int bj = 0; bj < 2; ++bj) {
                    f32x4 v0 = acc[ai][bj][m][0], v1 = acc[ai][bj][m][1];
                    const int col = pn * BM + bj * HALF + wc * 32 + 8 * fq;
                    if (pn >= 4 && pn < 6) {
                        const int cv = col - 1024, hh = cv >> 6, dim = cv & 63, b = row / T, t = row % T;
                        bf16* dst = vT + ((size_t)((b * NH + hh) * HD + dim)) * T + t;
                        const unsigned w0 = cvt_pk_bf16(v0[0], v0[1]), w1 = cvt_pk_bf16(v0[2], v0[3]), w2 = cvt_pk_bf16(v1[0], v1[1]), w3 = cvt_pk_bf16(v1[2], v1[3]);
                        dst[0 * (size_t)T] = (bf16)(w0 & 0xffff); dst[1 * (size_t)T] = (bf16)(w0 >> 16); dst[2 * (size_t)T] = (bf16)(w1 & 0xffff); dst[3 * (size_t)T] = (bf16)(w1 >> 16);
                        dst[4 * (size_t)T] = (bf16)(w2 & 0xffff); dst[5 * (size_t)T] = (bf16)(w2 >> 16); dst[6 * (size_t)T] = (bf16)(w3 & 0xffff); dst[7 * (size_t)T] = (bf16)(w3 >> 16);
                    } else {
                        bf16* dst;
                        if (pn < 2) { v0 = v0 * 0.125f; v1 = v1 * 0.125f; dst = q + (size_t)row * CW + col; }
                        else if (pn < 4) dst = k + (size_t)row * CW + (col - 512);
                        else dst = p + (size_t)row * PW + (col - 1536);
                        u32x4 w; w.x = cvt_pk_bf16(v0[0], v0[1]); w.y = cvt_pk_bf16(v0[2], v0[3]); w.z = cvt_pk_bf16(v1[0], v1[1]); w.w = cvt_pk_bf16(v1[2], v1[3]);
                        *(u32x4*)dst = w;
                    }
                }
            }
    }
};
struct EpiWo {
    static constexpr bool PERM = false;
    const float* x; float* h;
    __device__ __forceinline__ void operator()(const f32x4 (&acc)[2][2][4][2], const Unit& u, int wr, int wc, int fr, int fq) const {
        const int row0 = u.pm * BM + wr * 64 + fr, col0 = u.pn * BM + wc * 32 + 4 * fq;
#pragma unroll
        for (int ai = 0; ai < 2; ++ai)
#pragma unroll
            for (int m = 0; m < 4; ++m) { const size_t off = (size_t)(row0 + ai * HALF + m * 16) * D + col0;
#pragma unroll
                for (int bj = 0; bj < 2; ++bj)
#pragma unroll
                    for (int n = 0; n < 2; ++n) { const f32x4 xv = *(const f32x4*)(x + off + bj * HALF + n * 16); *(f32x4*)(h + off + bj * HALF + n * 16) = acc[ai][bj][m][n] + xv; } }
    }
};
struct EpiUp {
    static constexpr bool PERM = true;
    const float* b_up; bf16* act;
    __device__ __forceinline__ void operator()(const f32x4 (&acc)[2][2][4][2], const Unit& u, int wr, int wc, int fr, int fq) const {
        const int row0 = u.pm * BM + wr * 64 + fr, ch = u.pn * 128 + wc * 32 + 8 * fq;
        const float* bg = b_up + (size_t)u.e * 2048 + ch; const float* bl = bg + 1024;
        const f32x4 bg0 = *(const f32x4*)bg, bg1 = *(const f32x4*)(bg + 4), bl0 = *(const f32x4*)bl, bl1 = *(const f32x4*)(bl + 4);
#pragma unroll
        for (int ai = 0; ai < 2; ++ai)
#pragma unroll
            for (int m = 0; m < 4; ++m) {
                float o[8];
#pragma unroll
                for (int n = 0; n < 2; ++n) { const f32x4 gv = acc[ai][0][m][n] + (n ? bg1 : bg0), lv = acc[ai][1][m][n] + (n ? bl1 : bl0);
#pragma unroll
                    for (int j = 0; j < 4; ++j) { const float gt = fminf(gv[j], 7.0f), li = fminf(fmaxf(lv[j], -7.0f), 7.0f); o[n * 4 + j] = (li + 1.0f) * gt * sigmoidf_(1.702f * gt); } }
                *(u32x4*)(act + (size_t)(row0 + ai * HALF + m * 16) * DE + ch) = pack8(o);
            }
    }
};
struct EpiDown {
    static constexpr bool PERM = true;
    const float* b_dn; bf16* y;
    __device__ __forceinline__ void operator()(const f32x4 (&acc)[2][2][4][2], const Unit& u, int wr, int wc, int fr, int fq) const {
        const int row0 = u.pm * BM + wr * 64 + fr, col0 = u.pn * BM + wc * 32 + 8 * fq;
        const float* bb = b_dn + (size_t)u.e * D + col0;
        f32x4 bv[2][2];
#pragma unroll
        for (int bj = 0; bj < 2; ++bj)
#pragma unroll
            for (int n = 0; n < 2; ++n) bv[bj][n] = *(const f32x4*)(bb + bj * HALF + 4 * n);
#pragma unroll
        for (int ai = 0; ai < 2; ++ai)
#pragma unroll
            for (int m = 0; m < 4; ++m) { bf16* rowp = y + (size_t)(row0 + ai * HALF + m * 16) * D + col0;
#pragma unroll
                for (int bj = 0; bj < 2; ++bj) { const f32x4 v0 = acc[ai][bj][m][0] + bv[bj][0], v1 = acc[ai][bj][m][1] + bv[bj][1];
                    u32x4 w; w.x = cvt_pk_bf16(v0[0], v0[1]); w.y = cvt_pk_bf16(v0[2], v0[3]); w.z = cvt_pk_bf16(v1[0], v1[1]); w.w = cvt_pk_bf16(v1[2], v1[3]);
                    *(u32x4*)(rowp + bj * HALF) = w; } }
    }
};
}

struct Args { const float* in[26]; float* out; unsigned char* ws; int ph_lo, ph_hi; };

struct Frame { LAS unsigned char* lds; int tid, lane, wave, G, vcu; };

__device__ __forceinline__ void transpose_item(const float* W, int K, int N, bf16* WT, int k0, int n0, int orow0, LAS float* scr, int lane) {
#pragma unroll 8
    for (int i = 0; i < 32; ++i) { const int kk = 2 * i + (lane >> 5); scr[kk * 33 + (lane & 31)] = W[(size_t)(k0 + kk) * N + n0 + (lane & 31)]; }
    asm volatile("s_waitcnt lgkmcnt(0)" ::: "memory");
    const int c = lane & 7;
#pragma unroll
    for (int j = 0; j < 4; ++j) { const int n = (lane >> 3) + 8 * j; const LAS float* s = scr + (8 * c) * 33 + n;
        u32x4 o; o.x = cvt_pk_bf16(s[0 * 33], s[1 * 33]); o.y = cvt_pk_bf16(s[2 * 33], s[3 * 33]); o.z = cvt_pk_bf16(s[4 * 33], s[5 * 33]); o.w = cvt_pk_bf16(s[6 * 33], s[7 * 33]);
        *(u32x4*)(WT + (size_t)(orow0 + n) * K + k0 + 8 * c) = o; }
    asm volatile("s_waitcnt lgkmcnt(0)" ::: "memory");
}

__device__ __forceinline__ void p0_prologue(const Frame& F, const Args& a) {
    unsigned char* ws = a.ws;
    LAS float* scr = (LAS float*)(F.lds + F.wave * 8448);
    const int gw = F.vcu * 8 + F.wave, NGW = F.G * 8;
    constexpr int I_IN = 16 * 108, I_O = 16 * 32, I_UP = 32 * 16 * 64, I_DN = 32 * 16 * 32, I_L = 16, I_G = 32;
    constexpr int NITEMS = I_IN + I_O + I_UP + I_DN + 2 * I_L + 2 * I_L + I_G;
    for (int it = gw; it < NITEMS; it += NGW) {
        int r = it;
        if (r < I_UP) {
            const int e = r / 1024, q = r % 1024, kb = q / 64, nb = q % 64, n0 = nb * 32;
            const int orow0 = n0 < 1024 ? 256 * (n0 >> 7) + (n0 & 127) : 256 * ((n0 - 1024) >> 7) + 128 + ((n0 - 1024) & 127);
            transpose_item(a.in[21] + (size_t)e * 1024 * 2048, 1024, 2048, (bf16*)(ws + WS_WUPT) + (size_t)e * 2048 * 1024, kb * 64, n0, orow0, scr, F.lane); continue; }
        r -= I_UP;
        if (r < I_DN) { const int e = r / 512, q = r % 512, kb = q / 32, nb = q % 32;
            transpose_item(a.in[23] + (size_t)e * 1024 * 1024, 1024, 1024, (bf16*)(ws + WS_WDNT) + (size_t)e * 1024 * 1024, kb * 64, nb * 32, nb * 32, scr, F.lane); continue; }
        r -= I_DN;
        if (r < I_IN) { const int kb = r / 108, nb = r % 108; transpose_item(a.in[2], 1024, NPROJ, (bf16*)(ws + WS_WINT), kb * 64, nb * 32, nb * 32, scr, F.lane); continue; }
        r -= I_IN;
        if (r < I_O) { const int kb = r / 32, nb = r % 32; transpose_item(a.in[17], 1024, 1024, (bf16*)(ws + WS_WOT), kb * 64, nb * 32, nb * 32, scr, F.lane); continue; }
        r -= I_O;
        if (r < 2 * I_L) { const int z = r / 16, nb = r % 16; transpose_item(a.in[8] + (size_t)z * 64 * 512, 64, 512, (bf16*)(ws + WS_W2T) + (size_t)z * 512 * 64, 0, nb * 32, nb * 32, scr, F.lane); continue; }
        r -= 2 * I_L;
        if (r < 2 * I_L) { const int z = r / 16, nb = r % 16; transpose_item(a.in[10] + (size_t)z * 64 * 512, 64, 512, (bf16*)(ws + WS_A2T) + (size_t)z * 512 * 64, 0, nb * 32, nb * 32, scr, F.lane); continue; }
        r -= 2 * I_L;
        { const int kb = r / 16, nb = r % 16; transpose_item(a.in[11], 128, 512, (bf16*)(ws + WS_G2T), kb * 64, nb * 32, nb * 32, scr, F.lane); }
    }
    { u32x4* z = (u32x4*)(ws + WS_WINT + (size_t)NPROJ * 1024 * 2); const u32x4 zero = {0u, 0u, 0u, 0u};
      for (int i = F.vcu * 512 + F.tid; i < 16384; i += F.G * 512) z[i] = zero; }
    const float* x = a.in[0]; const float* nw = a.in[1]; bf16* hn = (bf16*)(ws + WS_HN);
    f32x4 wv[4];
#pragma unroll
    for (int j = 0; j < 4; ++j) wv[j] = *((const f32x4*)nw + F.lane + 64 * j);
    for (int m = gw; m < M; m += NGW) {
        const f32x4* xr = (const f32x4*)(x + (size_t)m * D) + F.lane;
        f32x4 v[4]; float s = 0.f;
#pragma unroll
        for (int j = 0; j < 4; ++j) { v[j] = xr[64 * j]; s += (v[j].x * v[j].x + v[j].y * v[j].y) + (v[j].z * v[j].z + v[j].w * v[j].w); }
        const float rs = rsqrtf(wave_sum(s) * (1.f / D) + RMS_EPS);
        u32x2* o8 = (u32x2*)(hn + (size_t)m * D) + F.lane;
#pragma unroll
        for (int j = 0; j < 4; ++j) { u32x2 o; o.x = cvt_pk_bf16(v[j].x * rs * wv[j].x, v[j].y * rs * wv[j].y); o.y = cvt_pk_bf16(v[j].z * rs * wv[j].z, v[j].w * rs * wv[j].w); o8[64 * j] = o; }
    }
}

constexpr int PREP_KBUF = 0, PREP_INV = 65536, PREP_AW = 67584, PREP_AA = PREP_AW + 17408, PREP_AG = PREP_AA + 17408, PREP_LD = 136;
__device__ __forceinline__ void prep_phase(const Frame& F, const Args& a) {
    unsigned char* ws = a.ws;
    const bf16* p = (const bf16*)(ws + WS_P);
    bf16* r_out = (bf16*)(ws + WS_R); bf16* v_out = (bf16*)(ws + WS_V); bf16* kk_out = (bf16*)(ws + WS_KK);
    bf16* decay_out = (bf16*)(ws + WS_DECAY); bf16* kdir_out = (bf16*)(ws + WS_KDIR); bf16* akk_out = (bf16*)(ws + WS_AKK); bf16* g_out = (bf16*)(ws + WS_G);
    const bf16* w2T = (const bf16*)(ws + WS_W2T); const bf16* a2T = (const bf16*)(ws + WS_A2T); const bf16* g2T = (const bf16*)(ws + WS_G2T);
    const float* mu_p = a.in[5]; const float* mu_n = a.in[6]; const float* w0 = a.in[7]; const float* a0 = a.in[9];
    const float* k_k = a.in[12]; const float* k_a = a.in[13];
    LAS bf16* kbuf = (LAS bf16*)(F.lds + PREP_KBUF); LAS float* invb = (LAS float*)(F.lds + PREP_INV);
    LAS bf16* Aw = (LAS bf16*)(F.lds + PREP_AW); LAS bf16* Aa = (LAS bf16*)(F.lds + PREP_AA); LAS bf16* Ag = (LAS bf16*)(F.lds + PREP_AG);
    const int lane = F.lane, wave = F.wave, fr = lane & 15, fg = lane >> 4;
    for (int tile = F.vcu; tile < M / 64; tile += F.G) {
        const int m0 = tile * 64;
#pragma unroll 1
        for (int jj = 0; jj < 4; ++jj) {
            const int q = lane + 64 * jj; const bool valid = q < 240; const int c0 = 8 * q;
            float mp[8], mn[8];
#pragma unroll
            for (int i = 0; i < 8; ++i) { mp[i] = valid ? mu_p[c0 + i] : 0.f; mn[i] = valid ? mu_n[c0 + i] : 0.f; }
            const int mfirst = m0 + wave * 8;
            const u32x4 zero = {0u, 0u, 0u, 0u};
            u32x4 prev = (valid && (mfirst % T) != 0) ? *(const u32x4*)(p + (size_t)(mfirst - 1) * PW + c0) : zero;
            u32x4 cur = valid ? *(const u32x4*)(p + (size_t)mfirst * PW + c0) : zero;
#pragma unroll 1
            for (int i = 0; i < 8; ++i) {
                const int m = mfirst + i, it = wave * 8 + i;
                const u32x4 nxt = (valid && (m % T) != T - 1) ? *(const u32x4*)(p + (size_t)(m + 1) * PW + c0) : zero;
                float fp[8], fc[8], fn[8], s[8];
                unpack8(prev, fp); unpack8(cur, fc); unpack8(nxt, fn);
#pragma unroll
                for (int e = 0; e < 8; ++e) s[e] = fc[e] + mp[e] * (fp[e] - fc[e]) + mn[e] * (fn[e] - fc[e]);
                if (jj == 0) { *(u32x4*)(r_out + (size_t)m * CW + c0) = pack8(s); }
                else if (jj == 1) {
                    const int c = c0 - 512;
                    *(LAS u32x4*)(kbuf + it * 512 + c) = pack8(s);
                    float kr[8]; float ss = 0.f;
#pragma unroll
                    for (int e = 0; e < 8; ++e) { kr[e] = s[e] * k_k[c + e]; ss += kr[e] * kr[e]; }
                    ss += __shfl_xor(ss, 1); ss += __shfl_xor(ss, 2); ss += __shfl_xor(ss, 4);
                    const float inv = 1.0f / fmaxf(sqrtf(ss), 1e-12f);
#pragma unroll
                    for (int e = 0; e < 8; ++e) kr[e] *= inv;
                    *(u32x4*)(kk_out + (size_t)m * CW + c) = pack8(kr);
                    if ((lane & 7) == 0) invb[it * 8 + (lane >> 3)] = inv;
                }
                else if (jj == 2) { *(u32x4*)(v_out + (size_t)m * CW + (c0 - 1024)) = pack8(s); }
                else if (valid) {
                    const int seg = lane >> 4, cw = 8 * (lane & 15);
                    if (seg == 0) {
#pragma unroll
                        for (int e = 0; e < 8; ++e) s[e] = 1.0f - 2.0f / (__expf(2.0f * s[e]) + 1.0f);
                        *(LAS u32x4*)(Aw + it * PREP_LD + cw) = pack8(s);
                    } else if (seg == 1) { *(LAS u32x4*)(Aa + it * PREP_LD + cw) = pack8(s); }
                    else {
#pragma unroll
                        for (int e = 0; e < 8; ++e) s[e] = sigmoidf_(s[e]);
                        *(LAS u32x4*)(Ag + it * PREP_LD + cw) = pack8(s);
                    }
                }
                prev = cur; cur = nxt;
            }
        }
        __syncthreads();
        const int nb = 64 * wave;
#pragma unroll 1
        for (int job = 0; job < 5; ++job) {
            const int z = job & 1;
            const bf16* WT = job < 2 ? w2T + (size_t)z * 512 * 64 : (job < 4 ? a2T + (size_t)z * 512 * 64 : g2T);
            const LAS bf16* Ax = job < 2 ? Aw + z * 64 : (job < 4 ? Aa + z * 64 : Ag);
            const int kw = job < 4 ? 64 : 128, nks = kw / 32;
            f32x4 acc[4][4];
#pragma unroll
            for (int mt = 0; mt < 4; ++mt)
#pragma unroll
                for (int nt = 0; nt < 4; ++nt) acc[mt][nt] = (f32x4){0.f, 0.f, 0.f, 0.f};
#pragma unroll 1
            for (int ks = 0; ks < nks; ++ks) {
                bf16x8 af[4], wf[4];
#pragma unroll
                for (int mt = 0; mt < 4; ++mt) af[mt] = *(const LAS bf16x8*)(Ax + (16 * mt + fr) * PREP_LD + 32 * ks + 8 * fg);
#pragma unroll
                for (int nt = 0; nt < 4; ++nt) wf[nt] = *(const bf16x8*)(WT + (size_t)(nb + 16 * nt + fr) * kw + 32 * ks + 8 * fg);
#pragma unroll
                for (int mt = 0; mt < 4; ++mt)
#pragma unroll
                    for (int nt = 0; nt < 4; ++nt) acc[mt][nt] = __builtin_amdgcn_mfma_f32_16x16x32_bf16(wf[nt], af[mt], acc[mt][nt], 0, 0, 0);
            }
#pragma unroll
            for (int mt = 0; mt < 4; ++mt) {
                const int it = 16 * mt + fr; const size_t m = (size_t)(m0 + it);
#pragma unroll
                for (int nt = 0; nt < 4; ++nt) {
                    const int n = nb + 16 * nt + 4 * fg;
                    const f32x4 v = acc[mt][nt];
                    if (job < 2) {
                        const f32x4 b = *(const f32x4*)(w0 + z * 512 + n);
                        float o[4];
#pragma unroll
                        for (int i = 0; i < 4; ++i) o[i] = __expf(-0.60653066f * sigmoidf_(v[i] + b[i]));
                        u32x2 w; w.x = cvt_pk_bf16(o[0], o[1]); w.y = cvt_pk_bf16(o[2], o[3]);
                        *(u32x2*)(decay_out + ((size_t)z * M + m) * CW + n) = w;
                    } else if (job < 4) {
                        const f32x4 b = *(const f32x4*)(a0 + z * 512 + n), kkc = *(const f32x4*)(k_k + n), kac = *(const f32x4*)(k_a + n);
                        const u32x2 kb = *(const LAS u32x2*)(kbuf + it * 512 + n);
                        const float kv[4] = {bflo(kb.x), bfhi(kb.x), bflo(kb.y), bfhi(kb.y)};
                        const float inv = invb[it * 8 + wave];
                        float kd[4], ak[4];
#pragma unroll
                        for (int i = 0; i < 4; ++i) { const float av = sigmoidf_(v[i] + b[i]); kd[i] = kv[i] * (1.0f + (av - 1.0f) * kac[i]); ak[i] = av * (kv[i] * kkc[i] * inv); }
                        u32x2 w; w.x = cvt_pk_bf16(kd[0], kd[1]); w.y = cvt_pk_bf16(kd[2], kd[3]);
                        *(u32x2*)(kdir_out + ((size_t)z * M + m) * CW + n) = w;
                        w.x = cvt_pk_bf16(ak[0], ak[1]); w.y = cvt_pk_bf16(ak[2], ak[3]);
                        *(u32x2*)(akk_out + ((size_t)z * M + m) * CW + n) = w;
                    } else {
                        u32x2 w; w.x = cvt_pk_bf16(v[0], v[1]); w.y = cvt_pk_bf16(v[2], v[3]);
                        *(u32x2*)(g_out + m * CW + n) = w;
                    }
                }
            }
        }
        __syncthreads();
    }
}

__device__ __forceinline__ void attn_phase(const Frame& F, const Args& a) {
    unsigned char* ws = a.ws;
    const bf16* q = (const bf16*)(ws + WS_Q); const bf16* k = (const bf16*)(ws + WS_K); const bf16* vT = (const bf16*)(ws + WS_VT);
    bf16* att = (bf16*)(ws + WS_ATT);
    LAS float* bias = (LAS float*)F.lds;
    for (int i = F.tid; i < 8 * 15 * 31; i += 512) bias[i] = a.in[3][i];
    __syncthreads();
    const int lane = F.lane, fr = lane & 15, fg = lane >> 4;
    const int NGW = F.G * 8, gw = F.vcu * 8 + F.wave;
    const int per = (16384 + NGW - 1) / NGW;
    for (int task = gw * per; task < (gw + 1) * per && task < 16384; ++task) {
        const int cgp = task & 3, r = (task >> 2) & 127, h = (task >> 9) & 7, b = task >> 12;
        const int c0 = 16 * cgp, wsc = min(max(c0 - 8, 0), 32), rs = min(max(r - 4, 0), GROWS - 8);
        const int c = c0 + fr, cs = min(max(c - 8, 0), 48);
        const size_t tq = (size_t)b * T + r * 64 + c;
        bf16x8 qf[2];
#pragma unroll
        for (int ks = 0; ks < 2; ++ks) qf[ks] = *(const bf16x8*)(q + tq * CW + h * 64 + 32 * ks + 8 * fg);
        f32x4 sc[16];
        const int kcol_a = wsc + 8 * (fr >> 2) + (fr & 3);
#pragma unroll
        for (int u = 0; u < 8; ++u)
#pragma unroll
            for (int par = 0; par < 2; ++par) {
                const size_t tk = (size_t)b * T + (rs + u) * 64 + kcol_a + 4 * par;
                const bf16x8 k0 = *(const bf16x8*)(k + tk * CW + h * 64 + 8 * fg), k1 = *(const bf16x8*)(k + tk * CW + h * 64 + 32 + 8 * fg);
                f32x4 s = {0.f, 0.f, 0.f, 0.f};
                s = __builtin_amdgcn_mfma_f32_16x16x32_bf16(k0, qf[0], s, 0, 0, 0);
                s = __builtin_amdgcn_mfma_f32_16x16x32_bf16(k1, qf[1], s, 0, 0, 0);
                sc[2 * u + par] = s;
            }
        float mx = -1e30f;
#pragma unroll
        for (int u = 0; u < 8; ++u) {
            const int dr = rs + u - r + 7;
#pragma unroll
            for (int par = 0; par < 2; ++par)
#pragma unroll
                for (int i = 0; i < 4; ++i) {
                    const int kc = wsc + 8 * fg + 4 * par + i; const bool ok = (kc >= cs) && (kc < cs + 16);
                    const int dc = min(max(kc - c + 15, 0), 30);
                    const float s = ok ? sc[2 * u + par][i] + bias[(h * 15 + dr) * 31 + dc] : -1e30f;
                    sc[2 * u + par][i] = s; mx = fmaxf(mx, s);
                }
        }
        mx = fmaxf(mx, __shfl_xor(mx, 16)); mx = fmaxf(mx, __shfl_xor(mx, 32));
        float sum = 0.f;
#pragma unroll
        for (int t = 0; t < 16; ++t)
#pragma unroll
            for (int i = 0; i < 4; ++i) { const float pv = sc[t][i] > -1e29f ? __expf(sc[t][i] - mx) : 0.f; sc[t][i] = pv; sum += pv; }
        sum += __shfl_xor(sum, 16); sum += __shfl_xor(sum, 32);
        const float inv = 1.0f / sum;
        f32x4 o[4];
#pragma unroll
        for (int nt = 0; nt < 4; ++nt) o[nt] = (f32x4){0.f, 0.f, 0.f, 0.f};
#pragma unroll
        for (int u = 0; u < 8; ++u) {
            union { u32x4 w; bf16x8 h8; } pf;
            pf.w.x = cvt_pk_bf16(sc[2 * u][0], sc[2 * u][1]); pf.w.y = cvt_pk_bf16(sc[2 * u][2], sc[2 * u][3]);
            pf.w.z = cvt_pk_bf16(sc[2 * u + 1][0], sc[2 * u + 1][1]); pf.w.w = cvt_pk_bf16(sc[2 * u + 1][2], sc[2 * u + 1][3]);
            const size_t tv = (size_t)(rs + u) * 64 + wsc + 8 * fg;
#pragma unroll
            for (int nt = 0; nt < 4; ++nt) {
                const bf16x8 vf = *(const bf16x8*)(vT + ((size_t)((b * NH + h) * HD + 16 * nt + fr)) * T + tv);
                o[nt] = __builtin_amdgcn_mfma_f32_16x16x32_bf16(vf, pf.h8, o[nt], 0, 0, 0);
            }
        }
#pragma unroll
        for (int nt = 0; nt < 4; ++nt) { u32x2 w; w.x = cvt_pk_bf16(o[nt][0] * inv, o[nt][1] * inv); w.y = cvt_pk_bf16(o[nt][2] * inv, o[nt][3] * inv);
            *(u32x2*)(att + tq * CW + h * 64 + 16 * nt + 4 * fg) = w; }
    }
    __syncthreads();
}

constexpr int SC_TC = 32, SC_REC = 1344, SC_STAGE = SC_TC * SC_REC  , SC_YB = SC_TC * 1024, SC_YOFF = 2 * SC_STAGE  ;
__device__ __forceinline__ float row16_sum(float v) {
    v += __builtin_bit_cast(float, __builtin_amdgcn_update_dpp(0, __builtin_bit_cast(int, v), 0xB1, 0xF, 0xF, true));
    v += __builtin_bit_cast(float, __builtin_amdgcn_update_dpp(0, __builtin_bit_cast(int, v), 0x4E, 0xF, 0xF, true));
    v += __builtin_bit_cast(float, __builtin_amdgcn_update_dpp(0, __builtin_bit_cast(int, v), 0x141, 0xF, 0xF, true));
    v += __builtin_bit_cast(float, __builtin_amdgcn_update_dpp(0, __builtin_bit_cast(int, v), 0x140, 0xF, 0xF, true));
    return v;
}
__device__ __forceinline__ void scan_phase(const Frame& F, const Args& a) {
    unsigned char* ws = a.ws;
    const int seq = F.vcu >> 2, rg = F.vcu & 3;
    if (seq >= 64) return;
    const int z = seq >> 5, b = (seq >> 3) & 3, h = seq & 7;
    const bf16* vsrc = (const bf16*)(ws + WS_V);
    float* yout = (float*)(ws + WS_Y) + (size_t)z * M * CW;
    const size_t mb = (size_t)b * T;
    const int lane = F.lane, wave = F.wave;
    constexpr int NCH = T / SC_TC;
    if (wave >= 4) {
        const int u = F.tid - 256;
        const bf16* gp[5]; int ldo[5];
        const long tstep = z ? -(long)CW : (long)CW;
#pragma unroll
        for (int j = 0; j < 5; ++j) { const int piece = u + 256 * j, tau = piece / 40, w = piece % 40, arr = w >> 3, part = w & 7;
            const bf16* base = arr == 0 ? (const bf16*)(ws + WS_KK) : arr == 1 ? (const bf16*)(ws + WS_DECAY) + (size_t)z * M * CW : arr == 2 ? (const bf16*)(ws + WS_AKK) + (size_t)z * M * CW
                             : arr == 3 ? (const bf16*)(ws + WS_KDIR) + (size_t)z * M * CW : (const bf16*)(ws + WS_R);
            const int t0 = z ? (T - 1 - tau) : tau;
            gp[j] = base + (mb + t0) * CW + h * 64 + part * 8; ldo[j] = tau * SC_REC + w * 32; }
        const int vtau = (u & 63) >> 1, vpart = u & 1;
        const bf16* gv = vsrc + (mb + (z ? (T - 1 - vtau) : vtau)) * CW + h * 64 + rg * 16 + vpart * 8;
        const int ldv = vtau * SC_REC + 1280 + vpart * 32;
        u32x4 reg0, reg1, reg2, reg3, reg4, regv = {0u, 0u, 0u, 0u};
#define SC_LOAD(c) do { const long adv = (long)(c) * SC_TC * tstep; reg0 = *(const u32x4*)(gp[0] + adv); reg1 = *(const u32x4*)(gp[1] + adv); reg2 = *(const u32x4*)(gp[2] + adv); \
            reg3 = *(const u32x4*)(gp[3] + adv); reg4 = *(const u32x4*)(gp[4] + adv); if (u < 64) regv = *(const u32x4*)(gv + adv); } while (0)
#define SC_W1(rg_, off_) do { float f_[8]; unpack8(rg_, f_); LAS f32x4* d_ = (LAS f32x4*)(st_ + (off_)); d_[0] = (f32x4){f_[0], f_[1], f_[2], f_[3]}; d_[1] = (f32x4){f_[4], f_[5], f_[6], f_[7]}; } while (0)
#define SC_WRITE(buf) do { LAS unsigned char* st_ = F.lds + (buf) * SC_STAGE; SC_W1(reg0, ldo[0]); SC_W1(reg1, ldo[1]); SC_W1(reg2, ldo[2]); SC_W1(reg3, ldo[3]); SC_W1(reg4, ldo[4]); \
            if (u < 64) SC_W1(regv, ldv); } while (0)
#define SC_YRED(c) do { const LAS unsigned char* yb_ = F.lds + SC_YOFF + ((c) & 1) * SC_YB; _Pragma("unroll") for (int j = 0; j < 2; ++j) { const int o_ = u + 256 * j, tau_ = o_ >> 4, row_ = o_ & 15; \
            const LAS f32x4* s_ = (const LAS f32x4*)(yb_ + tau_ * 1024 + row_ * 64); const f32x4 s0 = s_[0], s1 = s_[1], s2 = s_[2], s3 = s_[3]; \
            const float tot_ = (((s0.x + s0.y) + (s0.z + s0.w)) + ((s1.x + s1.y) + (s1.z + s1.w))) + (((s2.x + s2.y) + (s2.z + s2.w)) + ((s3.x + s3.y) + (s3.z + s3.w))); \
            const int n_ = (c) * SC_TC + tau_, t_ = z ? (T - 1 - n_) : n_; yout[(mb + t_) * CW + h * 64 + rg * 16 + row_] = tot_; } } while (0)
        SC_LOAD(0); SC_WRITE(0); SC_LOAD(1);
        __syncthreads();
#pragma unroll 1
        for (int c = 0; c < NCH; ++c) {
            if (c + 1 < NCH) SC_WRITE((c + 1) & 1);
            if (c + 2 < NCH) SC_LOAD(c + 2);
            if (c >= 1) SC_YRED(c - 1);
            __syncthreads();
        }
        SC_YRED(NCH - 1);
#undef SC_LOAD
#undef SC_W1
#undef SC_WRITE
#undef SC_YRED
    } else {
        const int cg4 = lane & 15, row = wave * 4 + (lane >> 4);
        f32x4 S = {0.f, 0.f, 0.f, 0.f};
        __syncthreads();
#pragma unroll 1
        for (int c = 0; c < NCH; ++c) {
            const LAS unsigned char* st = F.lds + (c & 1) * SC_STAGE + cg4 * 16;
            const LAS unsigned char* sv = F.lds + (c & 1) * SC_STAGE + 1280 + row * 4;
            LAS float* yb = (LAS float*)(F.lds + SC_YOFF + (c & 1) * SC_YB) + wave * 64 + lane;
#pragma unroll 8
            for (int tau = 0; tau < SC_TC; ++tau) {
                const f32x4 kk4 = *(const LAS f32x4*)(st + tau * SC_REC), w4 = *(const LAS f32x4*)(st + tau * SC_REC + 256), ak4 = *(const LAS f32x4*)(st + tau * SC_REC + 512),
                            k4 = *(const LAS f32x4*)(st + tau * SC_REC + 768), r4 = *(const LAS f32x4*)(st + tau * SC_REC + 1024);
                const float vv = *(const LAS float*)(sv + tau * SC_REC);
                const f32x4 pk = S * kk4;
                const float sa = row16_sum((pk.x + pk.y) + (pk.z + pk.w));
                const f32x4 Sp = S * w4 + k4 * vv;
                S = Sp - ak4 * sa;
                const f32x4 yr = S * r4;
                yb[tau * 256] = (yr.x + yr.y) + (yr.z + yr.w);
            }
            __syncthreads();
        }
    }
    __syncthreads();
}

__device__ __forceinline__ void combine_phase(const Frame& F, const Args& a) {
    unsigned char* ws = a.ws;
    const bf16* att = (const bf16*)(ws + WS_ATT); const bf16* rr = (const bf16*)(ws + WS_R); const bf16* vv = (const bf16*)(ws + WS_V);
    const bf16* kd = (const bf16*)(ws + WS_KDIR); const bf16* gg = (const bf16*)(ws + WS_G); const float* y = (const float*)(ws + WS_Y);
    bf16* mix = (bf16*)(ws + WS_MIX);
    const float* anw = a.in[4]; const float* r_k = a.in[14]; const float* ln_w = a.in[15]; const float* ln_b = a.in[16];
    const int lane = F.lane, c0 = 8 * lane;
    float nw[8], rk[8], lw[8], lb[8];
#pragma unroll
    for (int i = 0; i < 8; ++i) { nw[i] = anw[c0 + i]; rk[i] = r_k[c0 + i]; lw[i] = ln_w[c0 + i]; lb[i] = ln_b[c0 + i]; }
    const int gw = F.vcu * 8 + F.wave, NGW = F.G * 8;
    for (int m = gw; m < M; m += NGW) {
        const size_t o = (size_t)m * CW + c0;
        float f[8];
        unpack8(*(const u32x4*)(att + o), f);
        float ss = 0.f;
#pragma unroll
        for (int i = 0; i < 8; ++i) ss += f[i] * f[i];
        const float rs = rsqrtf(wave_sum(ss) * (1.f / CW) + RMS_EPS);
#pragma unroll
        for (int i = 0; i < 8; ++i) f[i] = f[i] * rs * nw[i];
        *(u32x4*)(mix + (size_t)m * D + c0) = pack8(f);
        const f32x4 y0a = *(const f32x4*)(y + o), y0b = *(const f32x4*)(y + o + 4), y1a = *(const f32x4*)(y + (size_t)M * CW + o), y1b = *(const f32x4*)(y + (size_t)M * CW + o + 4);
        float yv[8] = {y0a.x + y1a.x, y0a.y + y1a.y, y0a.z + y1a.z, y0a.w + y1a.w, y0b.x + y1b.x, y0b.y + y1b.y, y0b.z + y1b.z, y0b.w + y1b.w};
        float s1 = 0.f;
#pragma unroll
        for (int i = 0; i < 8; ++i) s1 += yv[i];
        s1 += __shfl_xor(s1, 1); s1 += __shfl_xor(s1, 2); s1 += __shfl_xor(s1, 4);
        const float mean = s1 * (1.f / 64.f);
        float s2 = 0.f;
#pragma unroll
        for (int i = 0; i < 8; ++i) { yv[i] -= mean; s2 += yv[i] * yv[i]; }
        s2 += __shfl_xor(s2, 1); s2 += __shfl_xor(s2, 2); s2 += __shfl_xor(s2, 4);
        const float rstd = rsqrtf(s2 * (1.f / 64.f) + GN_EPS);
        float rf[8], k0[8], k1[8], vf[8], gf[8];
        unpack8(*(const u32x4*)(rr + o), rf); unpack8(*(const u32x4*)(kd + o), k0); unpack8(*(const u32x4*)(kd + (size_t)M * CW + o), k1);
        unpack8(*(const u32x4*)(vv + o), vf); unpack8(*(const u32x4*)(gg + o), gf);
        float cf = 0.f;
#pragma unroll
        for (int i = 0; i < 8; ++i) cf += rf[i] * (k0[i] + k1[i]) * rk[i];
        cf += __shfl_xor(cf, 1); cf += __shfl_xor(cf, 2); cf += __shfl_xor(cf, 4);
#pragma unroll
        for (int i = 0; i < 8; ++i) f[i] = (yv[i] * rstd * lw[i] + lb[i] + cf * vf[i]) * gf[i];
        *(u32x4*)(mix + (size_t)m * D + CW + c0) = pack8(f);
    }
}

constexpr int RT_W = 0, RT_HIST = 131072, RT_LOG = 131072 + 256;
__device__ __forceinline__ void router_phase(const Frame& F, const Args& a) {
    unsigned char* ws = a.ws;
    const float* hbuf = (const float*)(ws + WS_H); bf16* hn2 = (bf16*)(ws + WS_HN2);
    int* eidx = (int*)(ws + WS_EIDX); float* gate = (float*)(ws + WS_GATE); int* rank = (int*)(ws + WS_RANK);
    unsigned* ctl = (unsigned*)(ws + WS_CTL);
    const float* n2w = a.in[18]; const float* rw = a.in[19]; const float* rb = a.in[20];
    LAS float* wT = (LAS float*)(F.lds + RT_W); LAS int* hist = (LAS int*)(F.lds + RT_HIST); LAS float* lg = (LAS float*)(F.lds + RT_LOG) + F.wave * 64;
    for (int i = F.tid; i < 32768; i += 512) { const int d = i >> 5, e = i & 31; wT[e * 1024 + d] = rw[i]; }
    if (F.tid < 32) hist[F.tid] = 0;
    __syncthreads();
    const int lane = F.lane;
    f32x4 wn[4];
#pragma unroll
    for (int j = 0; j < 4; ++j) wn[j] = *((const f32x4*)n2w + lane + 64 * j);
    const float rbias = rb[lane & 31];
    const int blk = F.vcu;
    for (int pr = 0; pr < 8; ++pr) {
        const int m0 = blk * 128 + F.wave * 16 + pr * 2;
        f32x4 xv[2][4];
#pragma unroll
        for (int tk = 0; tk < 2; ++tk) {
            const f32x4* hr = (const f32x4*)(hbuf + (size_t)(m0 + tk) * D) + lane;
            float s = 0.f;
#pragma unroll
            for (int j = 0; j < 4; ++j) { xv[tk][j] = hr[64 * j]; s += (xv[tk][j].x * xv[tk][j].x + xv[tk][j].y * xv[tk][j].y) + (xv[tk][j].z * xv[tk][j].z + xv[tk][j].w * xv[tk][j].w); }
            const float rs = rsqrtf(wave_sum(s) * (1.f / D) + RMS_EPS);
            u32x2* o8 = (u32x2*)(hn2 + (size_t)(m0 + tk) * D) + lane;
#pragma unroll
            for (int j = 0; j < 4; ++j) { xv[tk][j] = xv[tk][j] * rs * wn[j]; u32x2 o; o.x = cvt_pk_bf16(xv[tk][j].x, xv[tk][j].y); o.y = cvt_pk_bf16(xv[tk][j].z, xv[tk][j].w); o8[64 * j] = o; }
        }
        float mine = 0.f;
#pragma unroll 4
        for (int e = 0; e < 32; ++e) {
            float p0 = 0.f, p1 = 0.f;
#pragma unroll
            for (int j = 0; j < 4; ++j) { const f32x4 w4 = *(const LAS f32x4*)(wT + e * 1024 + 256 * j + 4 * lane);
                p0 += (w4.x * xv[0][j].x + w4.y * xv[0][j].y) + (w4.z * xv[0][j].z + w4.w * xv[0][j].w);
                p1 += (w4.x * xv[1][j].x + w4.y * xv[1][j].y) + (w4.z * xv[1][j].z + w4.w * xv[1][j].w); }
            p0 = wave_sum(p0); p1 = wave_sum(p1);
            if (lane == e) mine = p0; if (lane == 32 + e) mine = p1;
        }
        lg[lane] = mine + rbias;
        asm volatile("s_waitcnt lgkmcnt(0)" ::: "memory");
        if (lane < 2) {
            const LAS float* L = lg + lane * 32; const int m = m0 + lane;
            float v[32];
#pragma unroll
            for (int e = 0; e < 32; ++e) v[e] = L[e];
            float tv[4]; int ti[4];
#pragma unroll
            for (int kx = 0; kx < 4; ++kx) { float best = -3.0e38f; int bi = 0;
#pragma unroll
                for (int e = 0; e < 32; ++e) { if (v[e] > best) { best = v[e]; bi = e; } }
                tv[kx] = best; ti[kx] = bi;
#pragma unroll
                for (int e = 0; e < 32; ++e) { if (e == bi) v[e] = -3.0e38f; } }
            const float e0 = 1.0f, e1 = __expf(tv[1] - tv[0]), e2 = __expf(tv[2] - tv[0]), e3 = __expf(tv[3] - tv[0]);
            const float is = 1.0f / (e0 + e1 + e2 + e3);
            const float gs[4] = {e0 * is, e1 * is, e2 * is, e3 * is};
#pragma unroll
            for (int kx = 0; kx < 4; ++kx) { eidx[m * 4 + kx] = ti[kx]; gate[m * 4 + kx] = gs[kx]; rank[m * 4 + kx] = __hip_atomic_fetch_add(&hist[ti[kx]], 1, __ATOMIC_RELAXED, __HIP_MEMORY_SCOPE_WORKGROUP); }
        }
        asm volatile("s_waitcnt lgkmcnt(0)" ::: "memory");
    }
    __syncthreads();
    if (F.tid < 32) ctl[CW_CNT + blk * 32 + F.tid] = (unsigned)hist[F.tid];
}

__device__ __forceinline__ void dispatch_phase(const Frame& F, const Args& a) {
    unsigned char* ws = a.ws;
    unsigned* ctl = (unsigned*)(ws + WS_CTL);
    const int* eidx = (const int*)(ws + WS_EIDX); const int* rank = (const int*)(ws + WS_RANK); int* dest = (int*)(ws + WS_DEST);
    const bf16* hn2 = (const bf16*)(ws + WS_HN2); bf16* xbuf = (bf16*)(ws + WS_XBUF);
    LAS int* part = (LAS int*)F.lds;
    LAS int* tot = part + 1024;
    const int blk = F.vcu, G = F.G;
    { const int e = F.tid & 31, pt = F.tid >> 5; int s = 0, sb = 0;
      for (int bb = pt; bb < G; bb += 16) { const int cval = (int)ld_u32_agent(ctl + CW_CNT + bb * 32 + e); s += cval; if (bb < blk) sb += cval; }
      part[pt * 32 + e] = s; part[512 + pt * 32 + e] = sb; }
    __syncthreads();
    if (F.tid < 32) { int s = 0, sb = 0;
        for (int pt = 0; pt < 16; ++pt) { s += part[pt * 32 + F.tid]; sb += part[512 + pt * 32 + F.tid]; }
        tot[F.tid] = s; tot[32 + F.tid] = sb; tot[96 + F.tid] = (s + 255) & ~255; }
    __syncthreads();
    if (F.tid == 0) { int ps = 0; for (int e = 0; e < 32; ++e) { tot[64 + e] = ps; ps += tot[96 + e]; }
        tot[128] = ps >> 8; }
    __syncthreads();
    if (blk == 0) {
        if (F.tid == 0) ctl[CW_NT] = (unsigned)tot[128];
        for (int e = F.tid >> 4; e < 32; e += 32) { const int t0 = tot[64 + e] >> 8, nt = tot[96 + e] >> 8; for (int i = F.tid & 15; i < nt; i += 16) ctl[CW_TEXP + t0 + i] = (unsigned)e; }
    }
    const int lane = F.lane;
    for (int i = 0; i < 16; ++i) {
        const int m = blk * 128 + F.wave * 16 + i;
        const u32x4* srow = (const u32x4*)(hn2 + (size_t)m * D);
        const u32x4 v0 = srow[lane], v1 = srow[64 + lane];
#pragma unroll
        for (int kx = 0; kx < 4; ++kx) {
            const int e = eidx[m * 4 + kx]; const int d = tot[64 + e] + tot[32 + e] + rank[m * 4 + kx];
            if (lane == 0) dest[m * 4 + kx] = d;
            u32x4* drow = (u32x4*)(xbuf + (size_t)d * D);
            drow[lane] = v0; drow[64 + lane] = v1;
        }
    }
    { const int e = blk & 31, pt = blk >> 5, np = G >> 5; const int r0 = tot[64 + e] + tot[e], r1 = tot[64 + e] + tot[96 + e]; const u32x4 zero = {0u, 0u, 0u, 0u};
      if (np > 0) for (int r = r0 + pt * 8 + F.wave; r < r1; r += np * 8) { u32x4* drow = (u32x4*)(xbuf + (size_t)r * D); drow[lane] = zero; drow[64 + lane] = zero; } }
}

__device__ __forceinline__ void final_phase(const Frame& F, const Args& a) {
    unsigned char* ws = a.ws;
    const float* hbuf = (const float*)(ws + WS_H); const bf16* ybuf = (const bf16*)(ws + WS_YBUF);
    const int* dest = (const int*)(ws + WS_DEST); const float* gate = (const float*)(ws + WS_GATE);
    const float* fw = a.in[25]; float* out = a.out;
    const int lane = F.lane;
    f32x4 wn[4];
#pragma unroll
    for (int j = 0; j < 4; ++j) wn[j] = *((const f32x4*)fw + lane + 64 * j);
    const int gw = F.vcu * 8 + F.wave, NGW = F.G * 8;
    for (int m = gw; m < M; m += NGW) {
        const f32x4* hr = (const f32x4*)(hbuf + (size_t)m * D) + lane;
        f32x4 v[4];
#pragma unroll
        for (int j = 0; j < 4; ++j) v[j] = hr[64 * j];
#pragma unroll
        for (int kx = 0; kx < 4; ++kx) {
            const int d = dest[m * 4 + kx]; const float gt = gate[m * 4 + kx];
            const u32x2* yr = (const u32x2*)(ybuf + (size_t)d * D) + lane;
#pragma unroll
            for (int j = 0; j < 4; ++j) { const u32x2 w = yr[64 * j]; v[j].x += gt * bflo(w.x); v[j].y += gt * bfhi(w.x); v[j].z += gt * bflo(w.y); v[j].w += gt * bfhi(w.y); }
        }
        float s = 0.f;
#pragma unroll
        for (int j = 0; j < 4; ++j) s += (v[j].x * v[j].x + v[j].y * v[j].y) + (v[j].z * v[j].z + v[j].w * v[j].w);
        const float rs = rsqrtf(wave_sum(s) * (1.f / D) + RMS_EPS);
        f32x4* orow = (f32x4*)(out + (size_t)m * D) + lane;
#pragma unroll
        for (int j = 0; j < 4; ++j) orow[64 * j] = v[j] * rs * wn[j];
    }
}

__global__ void __launch_bounds__(512, 2) fwd_megakernel(Args args) {
    extern __shared__ __attribute__((aligned(16))) unsigned char lds_raw[];
    Frame F;
    F.lds = (LAS unsigned char*)lds_raw;
    F.tid = threadIdx.x; F.lane = F.tid & 63; F.wave = __builtin_amdgcn_readfirstlane(F.tid >> 6);
    F.G = gridDim.x; { const int bx = blockIdx.x; F.vcu = (F.G % 8 == 0) ? (bx % 8) * (F.G / 8) + bx / 8 : bx; }
    unsigned char* ws = args.ws;
    const int lo = args.ph_lo, hi = args.ph_hi;
#define IN(k) (lo <= (k) && (k) < hi)
#if MK_SPLIT
#define SEAM(k) do { } while (0)
#else
    cg::grid_group grid = cg::this_grid();
#define SEAM(k) do { if (IN(k) && IN((k) + 1)) grid.sync(); } while (0)
#endif
    if (IN(0)) p0_prologue(F, args);
    SEAM(0);
    if (IN(1)) {
        pg8::Gemm g{(const bf16*)(ws + WS_HN), (const bf16*)(ws + WS_WINT), 1024, nullptr, 0};
        pg8::StaticOrder S; S.init(M / 256, NPROJ_PAD / 256, F.G, (int)blockIdx.x);
        pg8::EpiProj E{(bf16*)(ws + WS_Q), (bf16*)(ws + WS_K), (bf16*)(ws + WS_VT), (bf16*)(ws + WS_P)};
        pg8::gemm_phase<pg8::EpiProj, true, true>(F.lds, g, S, E);
    }
    SEAM(1);
    if (IN(2)) { prep_phase(F, args); attn_phase(F, args); }
    SEAM(2);
    if (IN(3)) scan_phase(F, args);
    SEAM(3);
    if (IN(4)) combine_phase(F, args);
    SEAM(4);
    if (IN(5)) {
        pg8::Gemm g{(const bf16*)(ws + WS_MIX), (const bf16*)(ws + WS_WOT), 1024, nullptr, 0};
        pg8::StaticOrder S; S.init(M / 256, D / 256, F.G, (int)blockIdx.x);
        pg8::EpiWo E{args.in[0], (float*)(ws + WS_H)};
        pg8::gemm_phase<pg8::EpiWo, true, true>(F.lds, g, S, E);
    }
    SEAM(5);
    if (IN(6)) router_phase(F, args);
    SEAM(6);
    if (IN(7)) dispatch_phase(F, args);
    SEAM(7);
    if (IN(8)) {
        const unsigned* ctl = (const unsigned*)(ws + WS_CTL);
        const int ntile = (int)ld_u32_agent(ctl + CW_NT);
        pg8::Gemm g{(const bf16*)(ws + WS_XBUF), (const bf16*)(ws + WS_WUPT), 1024, ctl + CW_TEXP, (size_t)2048 * 1024 * 2};
        pg8::StaticOrder S; S.init(ntile, 8, F.G, (int)blockIdx.x);
        pg8::EpiUp E{args.in[22], (bf16*)(ws + WS_ACT)};
        pg8::gemm_phase<pg8::EpiUp, true, true>(F.lds, g, S, E);
    }
    SEAM(8);
    if (IN(9)) {
        const unsigned* ctl = (const unsigned*)(ws + WS_CTL);
        const int ntile = (int)ld_u32_agent(ctl + CW_NT);
        pg8::Gemm g{(const bf16*)(ws + WS_ACT), (const bf16*)(ws + WS_WDNT), 1024, ctl + CW_TEXP, (size_t)1024 * 1024 * 2};
        pg8::StaticOrder S; S.init(ntile, 4, F.G, (int)blockIdx.x);
        pg8::EpiDown E{args.in[24], (bf16*)(ws + WS_YBUF)};
        pg8::gemm_phase<pg8::EpiDown, true, true>(F.lds, g, S, E);
    }
    SEAM(9);
    if (IN(10)) final_phase(F, args);
#undef IN
#undef SEAM
}

extern "C" void kernel_launch(void* const* d_in, const int* in_sizes, int n_in, void* d_out, int out_size, void* d_ws, size_t ws_size, hipStream_t stream) {
    static int grid = 0;
    if (grid == 0) {
        if (n_in != 26 || in_sizes[0] != M * D || out_size != M * D || ws_size < WS_END) { fprintf(stderr, "kernel_launch: unexpected problem (n_in %d, in0 %d, out %d, ws %zu)\n", n_in, n_in > 0 ? in_sizes[0] : -1, out_size, ws_size); grid = -1; return; }
        int dev = 0, cus = 0, per_cu = 0;
        if (hipGetDevice(&dev) != hipSuccess || hipDeviceGetAttribute(&cus, hipDeviceAttributeMultiprocessorCount, dev) != hipSuccess) { grid = -1; return; }
        if (hipFuncSetAttribute((const void*)fwd_megakernel, hipFuncAttributeMaxDynamicSharedMemorySize, LDS_BYTES) != hipSuccess) { fprintf(stderr, "kernel_launch: hipFuncSetAttribute failed\n"); grid = -1; return; }
        if (hipOccupancyMaxActiveBlocksPerMultiprocessor(&per_cu, (const void*)fwd_megakernel, 512, LDS_BYTES) != hipSuccess || per_cu < 1) { fprintf(stderr, "kernel_launch: occupancy query says %d\n", per_cu); per_cu = 1; }
        (void)hipGetLastError();
        grid = cus * 1;
        if (grid != 256) fprintf(stderr, "kernel_launch: note: %d CUs\n", cus);
    }
    if (grid < 0) return;
    Args a{};
    for (int i = 0; i < 26; ++i) a.in[i] = (const float*)d_in[i];
    a.out = (float*)d_out; a.ws = (unsigned char*)d_ws;
#if MK_SPLIT
    for (int ph = 0; ph < NPHASE; ++ph) { a.ph_lo = ph; a.ph_hi = ph + 1; hipLaunchKernelGGL(fwd_megakernel, dim3(grid), dim3(512), LDS_BYTES, stream, a); }
#else
    a.ph_lo = 0; a.ph_hi = NPHASE;
    void* kargs[] = {&a};
    hipError_t e = hipLaunchCooperativeKernel((const void*)fwd_megakernel, dim3(grid), dim3(512), kargs, LDS_BYTES, stream);
    if (e != hipSuccess) fprintf(stderr, "kernel_launch: cooperative launch failed: %s (grid %d)\n", hipGetErrorString(e), grid);
#endif
}
```

```cpp
#include <hip/hip_runtime.h>
#include <hip/hip_cooperative_groups.h>
#include <cstdio>
#include <cstdint>
namespace cg = cooperative_groups;

#ifndef MK_SPLIT
#define MK_SPLIT 0
#endif

#ifndef MK_REPEAT
#define MK_REPEAT 0
#endif
#define LAS __attribute__((address_space(3)))
typedef unsigned short bf16;
typedef float f32x4 __attribute__((ext_vector_type(4)));
typedef float f32x2 __attribute__((ext_vector_type(2)));
typedef unsigned u32x4 __attribute__((ext_vector_type(4)));
typedef unsigned u32x2 __attribute__((ext_vector_type(2)));
typedef short bf16x8 __attribute__((ext_vector_type(8)));

constexpr int BATCH = 4, T = 8192, D = 1024, M = BATCH * T;
constexpr int NH = 8, HD = 64, CW = 512;
constexpr int SHIFT_W = 1920, NPROJ = 3456, NPROJ_PAD = 3584, PW = 2048;
constexpr int NE = 32, TOPK = 4, DE = 1024;
constexpr int GRIDW = 64, GROWS = 128;
constexpr int P_TILES_MAX = 544, P_ROWS = P_TILES_MAX * 256;
constexpr float RMS_EPS = 1e-5f, GN_EPS = 64e-5f;
constexpr int NPHASE = 11;

constexpr size_t MiB = 1u << 20;
constexpr size_t WS_CTL = 0;
constexpr size_t WS_W2T = 1 * MiB, WS_A2T = WS_W2T + 131072, WS_G2T = WS_A2T + 131072;
constexpr size_t WS_WINT = 2 * MiB, WS_WOT = 9 * MiB, WS_WUPT = 12 * MiB, WS_WDNT = 140 * MiB;
constexpr size_t WS_EIDX = 204 * MiB, WS_GATE = WS_EIDX + 524288, WS_RANK = WS_GATE + 524288, WS_DEST = WS_RANK + 524288;
constexpr size_t WS_R = 208 * MiB, WS_V = 240 * MiB, WS_KK = 272 * MiB, WS_DECAY = 304 * MiB, WS_KDIR = 368 * MiB, WS_AKK = 432 * MiB,
                 WS_G = 496 * MiB, WS_ATT = 528 * MiB;
constexpr size_t WS_Q = 560 * MiB, WS_K = 592 * MiB, WS_VT = 624 * MiB, WS_P = 656 * MiB, WS_HN = 784 * MiB, WS_Y = 848 * MiB;
constexpr size_t WS_MIX = 560 * MiB, WS_H = 752 * MiB, WS_HN2 = 880 * MiB, WS_XBUF = 208 * MiB, WS_ACT = 480 * MiB, WS_YBUF = 208 * MiB;
constexpr size_t WS_END = 976 * MiB;
constexpr int CW_NT = 0, CW_TEXP = 64, CW_CNT = 1024, CW_BAR = 16384;

constexpr int LDS_BYTES = 159744, LDS_MISC = LDS_BYTES - 256;

typedef __bf16 bf16x2_t __attribute__((ext_vector_type(2)));
__device__ __forceinline__ unsigned cvt_pk_bf16(float lo, float hi) { const f32x2 v = {lo, hi}; return __builtin_bit_cast(unsigned, __builtin_convertvector(v, bf16x2_t)); }
__device__ __forceinline__ float bflo(unsigned u) { return __uint_as_float(u << 16); }
__device__ __forceinline__ float bfhi(unsigned u) { return __uint_as_float(u & 0xffff0000u); }
__device__ __forceinline__ float bf1(bf16 v) { return __uint_as_float(((unsigned)v) << 16); }
__device__ __forceinline__ void unpack8(const u32x4 u, float* f) { f[0] = bflo(u.x); f[1] = bfhi(u.x); f[2] = bflo(u.y); f[3] = bfhi(u.y); f[4] = bflo(u.z); f[5] = bfhi(u.z); f[6] = bflo(u.w); f[7] = bfhi(u.w); }
__device__ __forceinline__ u32x4 pack8(const float* f) { u32x4 o; o.x = cvt_pk_bf16(f[0], f[1]); o.y = cvt_pk_bf16(f[2], f[3]); o.z = cvt_pk_bf16(f[4], f[5]); o.w = cvt_pk_bf16(f[6], f[7]); return o; }
__device__ __forceinline__ float wave_sum(float v) {
#pragma unroll
    for (int o = 1; o < 64; o <<= 1) v += __shfl_xor(v, o);
    return v;
}
__device__ __forceinline__ float sigmoidf_(float x) { return 1.0f / (1.0f + __expf(-x)); }
__device__ __forceinline__ unsigned ld_u32_agent(const unsigned* p) { return __hip_atomic_load(p, __ATOMIC_RELAXED, __HIP_MEMORY_SCOPE_AGENT); }

namespace pg8 {
constexpr int BM = 256, BK = 64, HALF = 128, HTB = HALF * BK * 2, STAGE_BYTES = 8 * HTB, NXCD = 8, WGM = 8;
__host__ __device__ __forceinline__ int lds_byte(int r, int c) { const int st = (r >> 4) * 2 + (c >> 5), rr = r & 15, cc = c & 31, ob = rr * 64 + cc * 2; return st * 1024 + (ob ^ (((ob >> 9) & 1) << 5)); }
__host__ __device__ __forceinline__ void stage_rc(int b, int& R, int& C) { const int st = b / 1024, sb = b % 1024, swz = sb ^ (((sb >> 9) & 1) << 5); R = (st >> 1) * 16 + swz / 64; C = (st & 1) * 32 + (swz % 64) / 2; }
__host__ __device__ __forceinline__ int perm32(int rho) { const int n = rho >> 4, i = rho & 15; return 8 * (i >> 2) + 4 * n + (i & 3); }

struct Unit { int pm, pn, e; };
struct Gemm { const bf16* A; const bf16* Bt; int K; const unsigned* texp; size_t bstride; };

struct StaticOrder {
    int nM, nN, nwg, G, c;
    __device__ void init(int nM_, int nN_, int G_, int c_) { nM = nM_; nN = nN_; nwg = nM * nN; G = G_; c = c_; }
    __device__ bool next(int i, Unit& u) const {
        const long L = (long)i * G + c; if (L >= nwg) return false;
        int wgid = (int)L; { const int q = nwg / NXCD, r = nwg % NXCD, xcd = wgid % NXCD, off = wgid / NXCD; wgid = (xcd < r ? xcd * (q + 1) : r * (q + 1) + (xcd - r) * q) + off; }
        const int nig = WGM * nN, gid = wgid / nig, fm = gid * WGM, gsz = (nM - fm) < WGM ? (nM - fm) : WGM;
        u.pm = fm + ((wgid % nig) % gsz); u.pn = (wgid % nig) / gsz; u.e = 0; return true;
    }
};

template <class Epi, bool ALIGN_EPI, bool SP2>
__device__ __forceinline__ void gemm_phase(LAS unsigned char* lds, const Gemm g, const StaticOrder& S, const Epi& E) {
    const int tid = threadIdx.x, wid = __builtin_amdgcn_readfirstlane(tid >> 6), lane = tid & 63, wr = wid >> 2, wc = wid & 3, fr = lane & 15, fq = lane >> 4;
    const int K = g.K, nt = K / BK;
    unsigned voffA[2], voffB[2];
#pragma unroll
    for (int i = 0; i < 2; ++i) { int R, C; stage_rc(tid * 16 + i * 8192, R, C); const int Rb = Epi::PERM ? ((R & ~31) + perm32(R & 31)) : R;
        voffA[i] = (unsigned)(R * K + C) * 2u; voffB[i] = (unsigned)(Rb * K + C) * 2u; }
    const size_t kstep = (size_t)(BK * 2);
    const size_t hstep = (size_t)HALF * K * 2;
    const size_t tstep = 2 * hstep;
    const unsigned ldsw = (unsigned)wid * 1024u;
    const int aoff = lds_byte(wr * 64 + fr, fq * 8), boff = lds_byte(wc * 32 + fr, fq * 8);
#define PG8_SA(b, h) (((b) * 2 + (h)) * HTB)
#define PG8_SB(b, h) ((4 + (b) * 2 + (h)) * HTB)
#define PG8_STAGE(bufoff, gbase, voff) do { _Pragma("unroll") for (int _i = 0; _i < 2; ++_i) \
        __builtin_amdgcn_global_load_lds((const unsigned*)((const char*)(gbase) + (voff)[_i]), (LAS unsigned*)(lds + (bufoff) + ldsw + _i * 8192), 16, 0, 0); } while (0)
#define PG8_LDA(dst, b, h) do { _Pragma("unroll") for (int m = 0; m < 4; ++m) _Pragma("unroll") for (int k = 0; k < 2; ++k) dst[m][k] = *(const LAS bf16x8*)(lds + PG8_SA(b, h) + aoff + m * 2048 + k * 1024); } while (0)
#define PG8_LDB(dst, b, h) do { _Pragma("unroll") for (int n = 0; n < 2; ++n) _Pragma("unroll") for (int k = 0; k < 2; ++k) dst[n][k] = *(const LAS bf16x8*)(lds + PG8_SB(b, h) + boff + n * 2048 + k * 1024); } while (0)
#define PG8_MMA(ai, bj, At, Bt) do { __builtin_amdgcn_s_setprio(1); _Pragma("unroll") for (int m = 0; m < 4; ++m) _Pragma("unroll") for (int n = 0; n < 2; ++n) _Pragma("unroll") for (int k = 0; k < 2; ++k) \
        acc[ai][bj][m][n] = __builtin_amdgcn_mfma_f32_16x16x32_bf16(Bt[n][k], At[m][k], acc[ai][bj][m][n], 0, 0, 0); __builtin_amdgcn_s_setprio(0); } while (0)
#define PG8_WAIT_V(n) asm volatile("s_waitcnt vmcnt(" #n ")" ::: "memory")
#define PG8_WAIT_L(n) asm volatile("s_waitcnt lgkmcnt(" #n ")" ::: "memory")
#define PG8_BAR __builtin_amdgcn_s_barrier()
#define PG8_SCHED __builtin_amdgcn_sched_barrier(0)
#define PG8_UPTR(u, pa, pb) do { unsigned _e = g.texp ? ld_u32_agent(g.texp + (u).pm) : 0u; _e = (unsigned)__builtin_amdgcn_readfirstlane((int)_e); (u).e = (int)_e; \
        pa = (const char*)g.A + (size_t)(u).pm * tstep; pb = (const char*)g.Bt + (size_t)_e * g.bstride + (size_t)(u).pn * tstep; } while (0)
    Unit cur, nxt; int ui = 0;
    if (!S.next(0, cur)) return;
    f32x4 acc[2][2][4][2];
#pragma unroll
    for (int a = 0; a < 2; ++a)
#pragma unroll
        for (int b = 0; b < 2; ++b)
#pragma unroll
            for (int m = 0; m < 4; ++m)
#pragma unroll
                for (int n = 0; n < 2; ++n) acc[a][b][m][n] = (f32x4){0.f, 0.f, 0.f, 0.f};
    bf16x8 At[4][2], B0[2][2], B1[2][2];
    const char* cA; const char* cB;
    PG8_UPTR(cur, cA, cB);
    if constexpr (SP2) {
        PG8_STAGE(PG8_SB(0, 0), cB, voffB); PG8_STAGE(PG8_SB(0, 1), cB + hstep, voffB); PG8_STAGE(PG8_SA(0, 0), cA, voffA); PG8_STAGE(PG8_SA(0, 1), cA + hstep, voffA);
        if (wr == 1) PG8_BAR;
        PG8_WAIT_V(2); PG8_BAR;
        PG8_STAGE(PG8_SB(1, 0), cB + kstep, voffB); PG8_STAGE(PG8_SA(1, 0), cA + kstep, voffA); PG8_STAGE(PG8_SB(1, 1), cB + hstep + kstep, voffB);
        PG8_WAIT_V(6); PG8_BAR;
    } else {
        PG8_STAGE(PG8_SB(0, 0), cB, voffB); PG8_STAGE(PG8_SA(0, 0), cA, voffA); PG8_STAGE(PG8_SB(0, 1), cB + hstep, voffB); PG8_STAGE(PG8_SA(0, 1), cA + hstep, voffA);
        if (wr == 1) PG8_BAR;
        PG8_WAIT_V(4); PG8_BAR;
        PG8_STAGE(PG8_SB(1, 0), cB + kstep, voffB); PG8_STAGE(PG8_SA(1, 0), cA + kstep, voffA); PG8_STAGE(PG8_SB(1, 1), cB + hstep + kstep, voffB);
        PG8_WAIT_V(6); PG8_BAR;
    }
    for (;;) {
        const bool has_next = S.next(ui + 1, nxt);
        const char* nA = cA; const char* nB = cB;
        if (has_next) PG8_UPTR(nxt, nA, nB);
        for (int t = 0; t < nt; t += 2) {
            const bool last = (t == nt - 2);
            const char* a1 = cA + (size_t)(t + 1) * kstep;
            const char* a2 = last ? nA : cA + (size_t)(t + 2) * kstep; const char* b2 = last ? nB : cB + (size_t)(t + 2) * kstep;
            const char* a3 = a2 + kstep; const char* b3 = b2 + kstep;
            if constexpr (SP2) {
            PG8_LDB(B0, 0, 0); PG8_LDB(B1, 0, 1); PG8_SCHED; PG8_LDA(At, 0, 0); PG8_STAGE(PG8_SA(1, 1), a1 + hstep, voffA);
            PG8_WAIT_V(8); PG8_WAIT_L(0); PG8_BAR; PG8_MMA(0, 0, At, B0); PG8_MMA(0, 1, At, B1); PG8_BAR; PG8_SCHED;
            PG8_LDA(At, 0, 1); PG8_STAGE(PG8_SB(0, 0), b2, voffB); PG8_STAGE(PG8_SB(0, 1), b2 + hstep, voffB); PG8_STAGE(PG8_SA(0, 0), a2, voffA);
            PG8_WAIT_V(8); PG8_WAIT_L(0); PG8_BAR; PG8_MMA(1, 0, At, B0); PG8_MMA(1, 1, At, B1); PG8_BAR; PG8_SCHED;
            PG8_LDB(B0, 1, 0); PG8_LDB(B1, 1, 1); PG8_SCHED; PG8_LDA(At, 1, 0); PG8_STAGE(PG8_SA(0, 1), a2 + hstep, voffA);
            PG8_WAIT_V(8); PG8_WAIT_L(0); PG8_BAR; PG8_MMA(0, 0, At, B0); PG8_MMA(0, 1, At, B1); PG8_BAR; PG8_SCHED;
            PG8_LDA(At, 1, 1); PG8_STAGE(PG8_SB(1, 0), b3, voffB); PG8_STAGE(PG8_SB(1, 1), b3 + hstep, voffB); PG8_STAGE(PG8_SA(1, 0), a3, voffA);
            PG8_WAIT_V(8); PG8_WAIT_L(0); PG8_BAR; PG8_MMA(1, 0, At, B0); PG8_MMA(1, 1, At, B1); PG8_BAR; PG8_SCHED;
            } else {
            PG8_LDB(B0, 0, 0); PG8_SCHED; PG8_LDA(At, 0, 0); PG8_STAGE(PG8_SA(1, 1), a1 + hstep, voffA);
            PG8_WAIT_L(8); PG8_BAR; PG8_WAIT_L(0); PG8_MMA(0, 0, At, B0); PG8_BAR; PG8_SCHED;
            PG8_LDB(B1, 0, 1); PG8_STAGE(PG8_SB(0, 0), b2, voffB);
            PG8_BAR; PG8_WAIT_L(0); PG8_MMA(0, 1, At, B1); PG8_BAR;
            PG8_LDA(At, 0, 1); PG8_STAGE(PG8_SA(0, 0), a2, voffA);
            PG8_BAR; PG8_WAIT_L(0); PG8_MMA(1, 0, At, B0); PG8_BAR; PG8_SCHED;
            PG8_STAGE(PG8_SB(0, 1), b2 + hstep, voffB);
            PG8_WAIT_V(6); PG8_BAR; PG8_MMA(1, 1, At, B1); PG8_BAR;
            PG8_LDB(B0, 1, 0); PG8_SCHED; PG8_LDA(At, 1, 0); PG8_STAGE(PG8_SA(0, 1), a2 + hstep, voffA);
            PG8_WAIT_L(8); PG8_BAR; PG8_WAIT_L(0); PG8_MMA(0, 0, At, B0); PG8_BAR; PG8_SCHED;
            PG8_LDB(B1, 1, 1); PG8_STAGE(PG8_SB(1, 0), b3, voffB);
            PG8_BAR; PG8_WAIT_L(0); PG8_MMA(0, 1, At, B1); PG8_BAR;
            PG8_LDA(At, 1, 1); PG8_STAGE(PG8_SA(1, 0), a3, voffA);
            PG8_BAR; PG8_WAIT_L(0); PG8_MMA(1, 0, At, B0); PG8_BAR; PG8_SCHED;
            PG8_STAGE(PG8_SB(1, 1), b3 + hstep, voffB);
            PG8_WAIT_V(6); PG8_BAR; PG8_MMA(1, 1, At, B1); PG8_BAR;
            }
        }
        if constexpr (ALIGN_EPI) { if (wr == 0) PG8_BAR; }
        E(acc, cur, wr, wc, fr, fq);
        if (!has_next) break;
#pragma unroll
        for (int a = 0; a < 2; ++a)
#pragma unroll
            for (int b = 0; b < 2; ++b)
#pragma unroll
                for (int m = 0; m < 4; ++m)
#pragma unroll
                    for (int n = 0; n < 2; ++n) acc[a][b][m][n] = (f32x4){0.f, 0.f, 0.f, 0.f};
        cur = nxt; cA = nA; cB = nB; ++ui;
        if constexpr (ALIGN_EPI) { if (wr == 1) PG8_BAR; }
    }
    PG8_WAIT_V(0);
    if constexpr (!ALIGN_EPI) { if (wr == 0) PG8_BAR; }
    PG8_BAR;
#undef PG8_SA
#undef PG8_SB
#undef PG8_STAGE
#undef PG8_LDA
#undef PG8_LDB
#undef PG8_MMA
#undef PG8_WAIT_V
#undef PG8_WAIT_L
#undef PG8_BAR
#undef PG8_SCHED
#undef PG8_UPTR
}

struct EpiProj {
    static constexpr bool PERM = true;
    bf16 *q, *k, *vT, *p;
    __device__ __forceinline__ void operator()(const f32x4 (&acc)[2][2][4][2], const Unit& u, int wr, int wc, int fr, int fq) const {
        const int row0 = u.pm * BM + wr * 64 + fr;
        const int pn = u.pn;
#pragma unroll
        for (int ai = 0; ai < 2; ++ai)
#pragma unroll
            for (int m = 0; m < 4; ++m) {
                const int row = row0 + ai * HALF + m * 16;
#pragma unroll
                for (int bj = 0; bj < 2; ++bj) {
                    f32x4 v0 = acc[ai][bj][m][0], v1 = acc[ai][bj][m][1];
                    const int col = pn * BM + bj * HALF + wc * 32 + 8 * fq;
                    if (pn >= 4 && pn < 6) {
                        const int cv = col - 1024, hh = cv >> 6, dim = cv & 63, b = row / T, t = row % T;
                        bf16* dst = vT + ((size_t)((b * NH + hh) * HD + dim)) * T + t;
                        const unsigned w0 = cvt_pk_bf16(v0[0], v0[1]), w1 = cvt_pk_bf16(v0[2], v0[3]), w2 = cvt_pk_bf16(v1[0], v1[1]), w3 = cvt_pk_bf16(v1[2], v1[3]);
                        dst[0 * (size_t)T] = (bf16)(w0 & 0xffff); dst[1 * (size_t)T] = (bf16)(w0 >> 16); dst[2 * (size_t)T] = (bf16)(w1 & 0xffff); dst[3 * (size_t)T] = (bf16)(w1 >> 16);
                        dst[4 * (size_t)T] = (bf16)(w2 & 0xffff); dst[5 * (size_t)T] = (bf16)(w2 >> 16); dst[6 * (size_t)T] = (bf16)(w3 & 0xffff); dst[7 * (size_t)T] = (bf16)(w3 >> 16);
                    } else {
                        bf16* dst;
                        if (pn < 2) { v0 = v0 * 0.125f; v1 = v1 * 0.125f; dst = q + (size_t)row * CW + col; }
                        else if (pn < 4) dst = k + (size_t)row * CW + (col - 512);
                        else dst = p + (size_t)row * PW + (col - 1536);
                        u32x4 w; w.x = cvt_pk_bf16(v0[0], v0[1]); w.y = cvt_pk_bf16(v0[2], v0[3]); w.z = cvt_pk_bf16(v1[0], v1[1]); w.w = cvt_pk_bf16(v1[2], v1[3]);
                        *(u32x4*)dst = w;
                    }
                }
            }
    }
};
struct EpiWo {
    static constexpr bool PERM = false;
    const float* x; float* h;
    __device__ __forceinline__ void operator()(const f32x4 (&acc)[2][2][4][2], const Unit& u, int wr, int wc, int fr, int fq) const {
        const int row0 = u.pm * BM + wr * 64 + fr, col0 = u.pn * BM + wc * 32 + 4 * fq;
#pragma unroll
        for (int ai = 0; ai < 2; ++ai)
#pragma unroll
            for (int m = 0; m < 4; ++m) { const size_t off = (size_t)(row0 + ai * HALF + m * 16) * D + col0;
#pragma unroll
                for (int bj = 0; bj < 2; ++bj)
#pragma unroll
                    for (int n = 0; n < 2; ++n) { const f32x4 xv = *(const f32x4*)(x + off + bj * HALF + n * 16); *(f32x4*)(h + off + bj * HALF + n * 16) = acc[ai][bj][m][n] + xv; } }
    }
};
struct EpiUp {
    static constexpr bool PERM = true;
    const float* b_up; bf16* act;
    __device__ __forceinline__ void operator()(const f32x4 (&acc)[2][2][4][2], const Unit& u, int wr, int wc, int fr, int fq) const {
        const int row0 = u.pm * BM + wr * 64 + fr, ch = u.pn * 128 + wc * 32 + 8 * fq;
        const float* bg = b_up + (size_t)u.e * 2048 + ch; const float* bl = bg + 1024;
        const f32x4 bg0 = *(const f32x4*)bg, bg1 = *(const f32x4*)(bg + 4), bl0 = *(const f32x4*)bl, bl1 = *(const f32x4*)(bl + 4);
#pragma unroll
        for (int ai = 0; ai < 2; ++ai)
#pragma unroll
            for (int m = 0; m < 4; ++m) {
                float o[8];
#pragma unroll
                for (int n = 0; n < 2; ++n) { const f32x4 gv = acc[ai][0][m][n] + (n ? bg1 : bg0), lv = acc[ai][1][m][n] + (n ? bl1 : bl0);
#pragma unroll
                    for (int j = 0; j < 4; ++j) { const float gt = fminf(gv[j], 7.0f), li = fminf(fmaxf(lv[j], -7.0f), 7.0f); o[n * 4 + j] = (li + 1.0f) * gt * sigmoidf_(1.702f * gt); } }
                *(u32x4*)(act + (size_t)(row0 + ai * HALF + m * 16) * DE + ch) = pack8(o);
            }
    }
};
struct EpiDown {
    static constexpr bool PERM = true;
    const float* b_dn; bf16* y;
    __device__ __forceinline__ void operator()(const f32x4 (&acc)[2][2][4][2], const Unit& u, int wr, int wc, int fr, int fq) const {
        const int row0 = u.pm * BM + wr * 64 + fr, col0 = u.pn * BM + wc * 32 + 8 * fq;
        const float* bb = b_dn + (size_t)u.e * D + col0;
        f32x4 bv[2][2];
#pragma unroll
        for (int bj = 0; bj < 2; ++bj)
#pragma unroll
            for (int n = 0; n < 2; ++n) bv[bj][n] = *(const f32x4*)(bb + bj * HALF + 4 * n);
#pragma unroll
        for (int ai = 0; ai < 2; ++ai)
#pragma unroll
            for (int m = 0; m < 4; ++m) { bf16* rowp = y + (size_t)(row0 + ai * HALF + m * 16) * D + col0;
#pragma unroll
                for (int bj = 0; bj < 2; ++bj) { const f32x4 v0 = acc[ai][bj][m][0] + bv[bj][0], v1 = acc[ai][bj][m][1] + bv[bj][1];
                    u32x4 w; w.x = cvt_pk_bf16(v0[0], v0[1]); w.y = cvt_pk_bf16(v0[2], v0[3]); w.z = cvt_pk_bf16(v1[0], v1[1]); w.w = cvt_pk_bf16(v1[2], v1[3]);
                    *(u32x4*)(rowp + bj * HALF) = w; } }
    }
};
}


#define XB_TMO      128
#define XB_XCNT(j)  (256  + 64 * (j))
#define XB_XSUB(j)  (1280 + 64 * (j))
#define XB_XGEN(j)  (2304 + 64 * (j))
#define XB_TOP      3328
#define XB_TOPGEN   3392
#define XCD_BAR_WORDS 3456
#define XB_SPIN_CAP (1u << 20)
__device__ __forceinline__ unsigned xb_ld(unsigned* p)              { return __hip_atomic_load(p, __ATOMIC_RELAXED, __HIP_MEMORY_SCOPE_AGENT); }
__device__ __forceinline__ unsigned xb_add(unsigned* p, unsigned v) { return __hip_atomic_fetch_add(p, v, __ATOMIC_RELAXED, __HIP_MEMORY_SCOPE_AGENT); }
__device__ __forceinline__ unsigned xb_xcc_id() { return (unsigned)__builtin_amdgcn_s_getreg((3 << 11) | 20) & 0xFu; }
#define XB_SPIN(cond, bar) do { unsigned _sp = 0; while (cond) { __builtin_amdgcn_s_sleep(1); \
    if ((++_sp & 255u) == 0u) { if (xb_ld(&(bar)[XB_TMO])) break; if (_sp > XB_SPIN_CAP) { atomicAdd(&(bar)[XB_TMO], 1u); break; } } } } while (0)
struct XcdBarrier { unsigned* bar; unsigned x; volatile LAS unsigned* st; };
__device__ __forceinline__ XcdBarrier xcd_barrier_post(unsigned* bar, volatile LAS unsigned* st) {
    XcdBarrier b; b.bar = bar; b.x = xb_xcc_id(); b.st = st;
    if (threadIdx.x == 0) (void)xb_add(&bar[XB_XCNT(b.x)], 1u);
    return b;
}
__device__ __forceinline__ void xcd_barrier_complete(unsigned* bar, unsigned x, unsigned& nloc, unsigned& nx) {
    const unsigned G = gridDim.x * gridDim.y * gridDim.z;
    unsigned sum, cnt, mine, sp = 0u;
    for (;;) {
        sum = 0u; cnt = 0u; mine = 0u;
#pragma unroll
        for (unsigned j = 0; j < 16; ++j) { const unsigned c = xb_ld(&bar[XB_XCNT(j)]); sum += c; cnt += (c > 0u) ? 1u : 0u; mine = (j == x) ? c : mine; }
        if (sum == G) break;
        __builtin_amdgcn_s_sleep(1);
        if ((++sp & 255u) == 0u) { if (xb_ld(&bar[XB_TMO])) break; if (sp > XB_SPIN_CAP) { atomicAdd(&bar[XB_TMO], 1u); break; } }
    }
    nloc = mine > 0u ? mine : 1u; nx = cnt > 0u ? cnt : 1u;
}
__device__ __forceinline__ void xcd_barrier(const XcdBarrier& b) {
    asm volatile("s_waitcnt vmcnt(0)" ::: "memory");
    __syncthreads();
    if (threadIdx.x == 0) {
        unsigned* bar = b.bar;
        __builtin_amdgcn_s_waitcnt(0);
        unsigned nloc = b.st[0], nx = b.st[1];
        if (nloc == 0u) { xcd_barrier_complete(bar, b.x, nloc, nx); b.st[0] = nloc; b.st[1] = nx; }
        const unsigned old = xb_add(&bar[XB_XSUB(b.x)], 1u);
        const unsigned gen = old / nloc;
        if (old + 1u == (gen + 1u) * nloc) {
            __builtin_amdgcn_fence(__ATOMIC_RELEASE, "agent");
            asm volatile("s_waitcnt vmcnt(0)" ::: "memory");
            const unsigned og = xb_add(&bar[XB_TOP], 1u);
            const unsigned tg = og / nx;
            if (og + 1u == (tg + 1u) * nx) xb_add(&bar[XB_TOPGEN], 1u);
            else XB_SPIN(xb_ld(&bar[XB_TOPGEN]) == tg, bar);
            __builtin_amdgcn_fence(__ATOMIC_ACQUIRE, "agent");
            xb_add(&bar[XB_XGEN(b.x)], 1u);
            asm volatile("s_waitcnt vmcnt(0)" ::: "memory");
        } else {
            XB_SPIN(xb_ld(&bar[XB_XGEN(b.x)]) == gen, bar);
            __builtin_amdgcn_fence(__ATOMIC_ACQUIRE, "agent");
            asm volatile("s_waitcnt vmcnt(0)" ::: "memory");
        }
    }
    __syncthreads();
}

struct Args { const float* in[26]; float* out; unsigned char* ws; int ph_lo, ph_hi; };

struct Frame { LAS unsigned char* lds; int tid, lane, wave, G, vcu; };

__device__ __forceinline__ void transpose_item(const float* W, int K, int N, bf16* WT, int k0, int n0, int orow0, LAS float* scr, int lane) {
#pragma unroll 8
    for (int i = 0; i < 32; ++i) { const int kk = 2 * i + (lane >> 5); scr[kk * 33 + (lane & 31)] = W[(size_t)(k0 + kk) * N + n0 + (lane & 31)]; }
    asm volatile("s_waitcnt lgkmcnt(0)" ::: "memory");
    const int c = lane & 7;
#pragma unroll
    for (int j = 0; j < 4; ++j) { const int n = (lane >> 3) + 8 * j; const LAS float* s = scr + (8 * c) * 33 + n;
        u32x4 o; o.x = cvt_pk_bf16(s[0 * 33], s[1 * 33]); o.y = cvt_pk_bf16(s[2 * 33], s[3 * 33]); o.z = cvt_pk_bf16(s[4 * 33], s[5 * 33]); o.w = cvt_pk_bf16(s[6 * 33], s[7 * 33]);
        *(u32x4*)(WT + (size_t)(orow0 + n) * K + k0 + 8 * c) = o; }
    asm volatile("s_waitcnt lgkmcnt(0)" ::: "memory");
}

__device__ __forceinline__ void p0_prologue(const Frame& F, const Args& a) {
    unsigned char* ws = a.ws;
    LAS float* scr = (LAS float*)(F.lds + F.wave * 8448);
    const int gw = F.vcu * 8 + F.wave, NGW = F.G * 8;
    constexpr int I_IN = 16 * 108, I_O = 16 * 32, I_UP = 32 * 16 * 64, I_DN = 32 * 16 * 32, I_L = 16, I_G = 32;
    constexpr int NITEMS = I_IN + I_O + I_UP + I_DN + 2 * I_L + 2 * I_L + I_G;
    for (int it = gw; it < NITEMS; it += NGW) {
        int r = it;
        if (r < I_UP) {
            const int e = r / 1024, q = r % 1024, kb = q / 64, nb = q % 64, n0 = nb * 32;
            const int orow0 = n0 < 1024 ? 256 * (n0 >> 7) + (n0 & 127) : 256 * ((n0 - 1024) >> 7) + 128 + ((n0 - 1024) & 127);
            transpose_item(a.in[21] + (size_t)e * 1024 * 2048, 1024, 2048, (bf16*)(ws + WS_WUPT) + (size_t)e * 2048 * 1024, kb * 64, n0, orow0, scr, F.lane); continue; }
        r -= I_UP;
        if (r < I_DN) { const int e = r / 512, q = r % 512, kb = q / 32, nb = q % 32;
            transpose_item(a.in[23] + (size_t)e * 1024 * 1024, 1024, 1024, (bf16*)(ws + WS_WDNT) + (size_t)e * 1024 * 1024, kb * 64, nb * 32, nb * 32, scr, F.lane); continue; }
        r -= I_DN;
        if (r < I_IN) { const int kb = r / 108, nb = r % 108; transpose_item(a.in[2], 1024, NPROJ, (bf16*)(ws + WS_WINT), kb * 64, nb * 32, nb * 32, scr, F.lane); continue; }
        r -= I_IN;
        if (r < I_O) { const int kb = r / 32, nb = r % 32; transpose_item(a.in[17], 1024, 1024, (bf16*)(ws + WS_WOT), kb * 64, nb * 32, nb * 32, scr, F.lane); continue; }
        r -= I_O;
        if (r < 2 * I_L) { const int z = r / 16, nb = r % 16; transpose_item(a.in[8] + (size_t)z * 64 * 512, 64, 512, (bf16*)(ws + WS_W2T) + (size_t)z * 512 * 64, 0, nb * 32, nb * 32, scr, F.lane); continue; }
        r -= 2 * I_L;
        if (r < 2 * I_L) { const int z = r / 16, nb = r % 16; transpose_item(a.in[10] + (size_t)z * 64 * 512, 64, 512, (bf16*)(ws + WS_A2T) + (size_t)z * 512 * 64, 0, nb * 32, nb * 32, scr, F.lane); continue; }
        r -= 2 * I_L;
        { const int kb = r / 16, nb = r % 16; transpose_item(a.in[11], 128, 512, (bf16*)(ws + WS_G2T), kb * 64, nb * 32, nb * 32, scr, F.lane); }
    }
    { u32x4* z = (u32x4*)(ws + WS_WINT + (size_t)NPROJ * 1024 * 2); const u32x4 zero = {0u, 0u, 0u, 0u};
      for (int i = F.vcu * 512 + F.tid; i < 16384; i += F.G * 512) z[i] = zero; }
    const float* x = a.in[0]; const float* nw = a.in[1]; bf16* hn = (bf16*)(ws + WS_HN);
    f32x4 wv[4];
#pragma unroll
    for (int j = 0; j < 4; ++j) wv[j] = *((const f32x4*)nw + F.lane + 64 * j);
    for (int m = gw; m < M; m += NGW) {
        const f32x4* xr = (const f32x4*)(x + (size_t)m * D) + F.lane;
        f32x4 v[4]; float s = 0.f;
#pragma unroll
        for (int j = 0; j < 4; ++j) { v[j] = xr[64 * j]; s += (v[j].x * v[j].x + v[j].y * v[j].y) + (v[j].z * v[j].z + v[j].w * v[j].w); }
        const float rs = rsqrtf(wave_sum(s) * (1.f / D) + RMS_EPS);
        u32x2* o8 = (u32x2*)(hn + (size_t)m * D) + F.lane;
#pragma unroll
        for (int j = 0; j < 4; ++j) { u32x2 o; o.x = cvt_pk_bf16(v[j].x * rs * wv[j].x, v[j].y * rs * wv[j].y); o.y = cvt_pk_bf16(v[j].z * rs * wv[j].z, v[j].w * rs * wv[j].w); o8[64 * j] = o; }
    }
}

constexpr int PREP_KBUF = 0, PREP_INV = 65536, PREP_AW = 67584, PREP_AA = PREP_AW + 17408, PREP_AG = PREP_AA + 17408, PREP_LD = 136;
template <bool STORE>
__device__ __forceinline__ void prep_phase(const Frame& F, const Args& a) {
    unsigned char* ws = a.ws;
    const bf16* p = (const bf16*)(ws + WS_P);
    bf16* r_out = (bf16*)(ws + WS_R); bf16* v_out = (bf16*)(ws + WS_V); bf16* kk_out = (bf16*)(ws + WS_KK);
    bf16* decay_out = (bf16*)(ws + WS_DECAY); bf16* kdir_out = (bf16*)(ws + WS_KDIR); bf16* akk_out = (bf16*)(ws + WS_AKK); bf16* g_out = (bf16*)(ws + WS_G);
    const bf16* w2T = (const bf16*)(ws + WS_W2T); const bf16* a2T = (const bf16*)(ws + WS_A2T); const bf16* g2T = (const bf16*)(ws + WS_G2T);
    const float* mu_p = a.in[5]; const float* mu_n = a.in[6]; const float* w0 = a.in[7]; const float* a0 = a.in[9];
    const float* k_k = a.in[12]; const float* k_a = a.in[13];
    LAS bf16* kbuf = (LAS bf16*)(F.lds + PREP_KBUF); LAS float* invb = (LAS float*)(F.lds + PREP_INV);
    LAS bf16* Aw = (LAS bf16*)(F.lds + PREP_AW); LAS bf16* Aa = (LAS bf16*)(F.lds + PREP_AA); LAS bf16* Ag = (LAS bf16*)(F.lds + PREP_AG);
    const int lane = F.lane, wave = F.wave, fr = lane & 15, fg = lane >> 4;
    for (int tile = F.vcu; tile < M / 64; tile += F.G) {
        const int m0 = tile * 64;
#pragma unroll 1
        for (int jj = 0; jj < 4; ++jj) {
            const int q = lane + 64 * jj; const bool valid = q < 240; const int c0 = 8 * q;
            float mp[8], mn[8];
#pragma unroll
            for (int i = 0; i < 8; ++i) { mp[i] = valid ? mu_p[c0 + i] : 0.f; mn[i] = valid ? mu_n[c0 + i] : 0.f; }
            const int mfirst = m0 + wave * 8;
            const u32x4 zero = {0u, 0u, 0u, 0u};
            u32x4 prev = (valid && (mfirst % T) != 0) ? *(const u32x4*)(p + (size_t)(mfirst - 1) * PW + c0) : zero;
            u32x4 cur = valid ? *(const u32x4*)(p + (size_t)mfirst * PW + c0) : zero;
#pragma unroll 1
            for (int i = 0; i < 8; ++i) {
                const int m = mfirst + i, it = wave * 8 + i;
                const u32x4 nxt = (valid && (m % T) != T - 1) ? *(const u32x4*)(p + (size_t)(m + 1) * PW + c0) : zero;
                float fp[8], fc[8], fn[8], s[8];
                unpack8(prev, fp); unpack8(cur, fc); unpack8(nxt, fn);
#pragma unroll
                for (int e = 0; e < 8; ++e) s[e] = fc[e] + mp[e] * (fp[e] - fc[e]) + mn[e] * (fn[e] - fc[e]);
                if (jj == 0) { if (STORE) { *(u32x4*)(r_out + (size_t)m * CW + c0) = pack8(s); } }
                else if (jj == 1) {
                    const int c = c0 - 512;
                    *(LAS u32x4*)(kbuf + it * 512 + c) = pack8(s);
                    float kr[8]; float ss = 0.f;
#pragma unroll
                    for (int e = 0; e < 8; ++e) { kr[e] = s[e] * k_k[c + e]; ss += kr[e] * kr[e]; }
                    ss += __shfl_xor(ss, 1); ss += __shfl_xor(ss, 2); ss += __shfl_xor(ss, 4);
                    const float inv = 1.0f / fmaxf(sqrtf(ss), 1e-12f);
#pragma unroll
                    for (int e = 0; e < 8; ++e) kr[e] *= inv;
                    if (STORE) { *(u32x4*)(kk_out + (size_t)m * CW + c) = pack8(kr); }
                    if ((lane & 7) == 0) invb[it * 8 + (lane >> 3)] = inv;
                }
                else if (jj == 2) { if (STORE) { *(u32x4*)(v_out + (size_t)m * CW + (c0 - 1024)) = pack8(s); } }
                else if (valid) {
                    const int seg = lane >> 4, cw = 8 * (lane & 15);
                    if (seg == 0) {
#pragma unroll
                        for (int e = 0; e < 8; ++e) s[e] = 1.0f - 2.0f / (__expf(2.0f * s[e]) + 1.0f);
                        *(LAS u32x4*)(Aw + it * PREP_LD + cw) = pack8(s);
                    } else if (seg == 1) { *(LAS u32x4*)(Aa + it * PREP_LD + cw) = pack8(s); }
                    else {
#pragma unroll
                        for (int e = 0; e < 8; ++e) s[e] = sigmoidf_(s[e]);
                        *(LAS u32x4*)(Ag + it * PREP_LD + cw) = pack8(s);
                    }
                }
                prev = cur; cur = nxt;
            }
        }
        __syncthreads();
        const int nb = 64 * wave;
#pragma unroll 1
        for (int job = 0; job < 5; ++job) {
            const int z = job & 1;
            const bf16* WT = job < 2 ? w2T + (size_t)z * 512 * 64 : (job < 4 ? a2T + (size_t)z * 512 * 64 : g2T);
            const LAS bf16* Ax = job < 2 ? Aw + z * 64 : (job < 4 ? Aa + z * 64 : Ag);
            const int kw = job < 4 ? 64 : 128, nks = kw / 32;
            f32x4 acc[4][4];
#pragma unroll
            for (int mt = 0; mt < 4; ++mt)
#pragma unroll
                for (int nt = 0; nt < 4; ++nt) acc[mt][nt] = (f32x4){0.f, 0.f, 0.f, 0.f};
#pragma unroll 1
            for (int ks = 0; ks < nks; ++ks) {
                bf16x8 af[4], wf[4];
#pragma unroll
                for (int mt = 0; mt < 4; ++mt) af[mt] = *(const LAS bf16x8*)(Ax + (16 * mt + fr) * PREP_LD + 32 * ks + 8 * fg);
#pragma unroll
                for (int nt = 0; nt < 4; ++nt) wf[nt] = *(const bf16x8*)(WT + (size_t)(nb + 16 * nt + fr) * kw + 32 * ks + 8 * fg);
#pragma unroll
                for (int mt = 0; mt < 4; ++mt)
#pragma unroll
                    for (int nt = 0; nt < 4; ++nt) acc[mt][nt] = __builtin_amdgcn_mfma_f32_16x16x32_bf16(wf[nt], af[mt], acc[mt][nt], 0, 0, 0);
            }
#pragma unroll
            for (int mt = 0; mt < 4; ++mt) {
                const int it = 16 * mt + fr; const size_t m = (size_t)(m0 + it);
#pragma unroll
                for (int nt = 0; nt < 4; ++nt) {
                    const int n = nb + 16 * nt + 4 * fg;
                    const f32x4 v = acc[mt][nt];
                    if (job < 2) {
                        const f32x4 b = *(const f32x4*)(w0 + z * 512 + n);
                        float o[4];
#pragma unroll
                        for (int i = 0; i < 4; ++i) o[i] = __expf(-0.60653066f * sigmoidf_(v[i] + b[i]));
                        u32x2 w; w.x = cvt_pk_bf16(o[0], o[1]); w.y = cvt_pk_bf16(o[2], o[3]);
                        if (STORE) { *(u32x2*)(decay_out + ((size_t)z * M + m) * CW + n) = w; }
                    } else if (job < 4) {
                        const f32x4 b = *(const f32x4*)(a0 + z * 512 + n), kkc = *(const f32x4*)(k_k + n), kac = *(const f32x4*)(k_a + n);
                        const u32x2 kb = *(const LAS u32x2*)(kbuf + it * 512 + n);
                        const float kv[4] = {bflo(kb.x), bfhi(kb.x), bflo(kb.y), bfhi(kb.y)};
                        const float inv = invb[it * 8 + wave];
                        float kd[4], ak[4];
#pragma unroll
                        for (int i = 0; i < 4; ++i) { const float av = sigmoidf_(v[i] + b[i]); kd[i] = kv[i] * (1.0f + (av - 1.0f) * kac[i]); ak[i] = av * (kv[i] * kkc[i] * inv); }
                        u32x2 w; w.x = cvt_pk_bf16(kd[0], kd[1]); w.y = cvt_pk_bf16(kd[2], kd[3]);
                        if (STORE) { *(u32x2*)(kdir_out + ((size_t)z * M + m) * CW + n) = w; }
                        w.x = cvt_pk_bf16(ak[0], ak[1]); w.y = cvt_pk_bf16(ak[2], ak[3]);
                        if (STORE) { *(u32x2*)(akk_out + ((size_t)z * M + m) * CW + n) = w; }
                    } else {
                        u32x2 w; w.x = cvt_pk_bf16(v[0], v[1]); w.y = cvt_pk_bf16(v[2], v[3]);
                        if (STORE) { *(u32x2*)(g_out + m * CW + n) = w; }
                    }
                }
            }
        }
        __syncthreads();
    }
}

__device__ __forceinline__ void attn_phase(const Frame& F, const Args& a) {
    unsigned char* ws = a.ws;
    const bf16* q = (const bf16*)(ws + WS_Q); const bf16* k = (const bf16*)(ws + WS_K); const bf16* vT = (const bf16*)(ws + WS_VT);
    bf16* att = (bf16*)(ws + WS_ATT);
    LAS float* bias = (LAS float*)F.lds;
    for (int i = F.tid; i < 8 * 15 * 31; i += 512) bias[i] = a.in[3][i];
    __syncthreads();
    const int lane = F.lane, fr = lane & 15, fg = lane >> 4;
    const int NGW = F.G * 8, gw = F.vcu * 8 + F.wave;
    const int per = (16384 + NGW - 1) / NGW;
    for (int task = gw * per; task < (gw + 1) * per && task < 16384; ++task) {
        const int cgp = task & 3, r = (task >> 2) & 127, h = (task >> 9) & 7, b = task >> 12;
        const int c0 = 16 * cgp, wsc = min(max(c0 - 8, 0), 32), rs = min(max(r - 4, 0), GROWS - 8);
        const int c = c0 + fr, cs = min(max(c - 8, 0), 48);
        const size_t tq = (size_t)b * T + r * 64 + c;
        bf16x8 qf[2];
#pragma unroll
        for (int ks = 0; ks < 2; ++ks) qf[ks] = *(const bf16x8*)(q + tq * CW + h * 64 + 32 * ks + 8 * fg);
        f32x4 sc[16];
        const int kcol_a = wsc + 8 * (fr >> 2) + (fr & 3);
#pragma unroll
        for (int u = 0; u < 8; ++u)
#pragma unroll
            for (int par = 0; par < 2; ++par) {
                const size_t tk = (size_t)b * T + (rs + u) * 64 + kcol_a + 4 * par;
                const bf16x8 k0 = *(const bf16x8*)(k + tk * CW + h * 64 + 8 * fg), k1 = *(const bf16x8*)(k + tk * CW + h * 64 + 32 + 8 * fg);
                f32x4 s = {0.f, 0.f, 0.f, 0.f};
                s = __builtin_amdgcn_mfma_f32_16x16x32_bf16(k0, qf[0], s, 0, 0, 0);
                s = __builtin_amdgcn_mfma_f32_16x16x32_bf16(k1, qf[1], s, 0, 0, 0);
                sc[2 * u + par] = s;
            }
        float mx = -1e30f;
#pragma unroll
        for (int u = 0; u < 8; ++u) {
            const int dr = rs + u - r + 7;
#pragma unroll
            for (int par = 0; par < 2; ++par)
#pragma unroll
                for (int i = 0; i < 4; ++i) {
                    const int kc = wsc + 8 * fg + 4 * par + i; const bool ok = (kc >= cs) && (kc < cs + 16);
                    const int dc = min(max(kc - c + 15, 0), 30);
                    const float s = ok ? sc[2 * u + par][i] + bias[(h * 15 + dr) * 31 + dc] : -1e30f;
                    sc[2 * u + par][i] = s; mx = fmaxf(mx, s);
                }
        }
        mx = fmaxf(mx, __shfl_xor(mx, 16)); mx = fmaxf(mx, __shfl_xor(mx, 32));
        float sum = 0.f;
#pragma unroll
        for (int t = 0; t < 16; ++t)
#pragma unroll
            for (int i = 0; i < 4; ++i) { const float pv = sc[t][i] > -1e29f ? __expf(sc[t][i] - mx) : 0.f; sc[t][i] = pv; sum += pv; }
        sum += __shfl_xor(sum, 16); sum += __shfl_xor(sum, 32);
        const float inv = 1.0f / sum;
        f32x4 o[4];
#pragma unroll
        for (int nt = 0; nt < 4; ++nt) o[nt] = (f32x4){0.f, 0.f, 0.f, 0.f};
#pragma unroll
        for (int u = 0; u < 8; ++u) {
            union { u32x4 w; bf16x8 h8; } pf;
            pf.w.x = cvt_pk_bf16(sc[2 * u][0], sc[2 * u][1]); pf.w.y = cvt_pk_bf16(sc[2 * u][2], sc[2 * u][3]);
            pf.w.z = cvt_pk_bf16(sc[2 * u + 1][0], sc[2 * u + 1][1]); pf.w.w = cvt_pk_bf16(sc[2 * u + 1][2], sc[2 * u + 1][3]);
            const size_t tv = (size_t)(rs + u) * 64 + wsc + 8 * fg;
#pragma unroll
            for (int nt = 0; nt < 4; ++nt) {
                const bf16x8 vf = *(const bf16x8*)(vT + ((size_t)((b * NH + h) * HD + 16 * nt + fr)) * T + tv);
                o[nt] = __builtin_amdgcn_mfma_f32_16x16x32_bf16(vf, pf.h8, o[nt], 0, 0, 0);
            }
        }
#pragma unroll
        for (int nt = 0; nt < 4; ++nt) { u32x2 w; w.x = cvt_pk_bf16(o[nt][0] * inv, o[nt][1] * inv); w.y = cvt_pk_bf16(o[nt][2] * inv, o[nt][3] * inv);
            *(u32x2*)(att + tq * CW + h * 64 + 16 * nt + 4 * fg) = w; }
    }
    __syncthreads();
}

constexpr int SC_TC = 32, SC_REC = 1344, SC_STAGE = SC_TC * SC_REC  , SC_YB = SC_TC * 1024, SC_YOFF = 2 * SC_STAGE  ;
__device__ __forceinline__ float row16_sum(float v) {
    v += __builtin_bit_cast(float, __builtin_amdgcn_update_dpp(0, __builtin_bit_cast(int, v), 0xB1, 0xF, 0xF, true));
    v += __builtin_bit_cast(float, __builtin_amdgcn_update_dpp(0, __builtin_bit_cast(int, v), 0x4E, 0xF, 0xF, true));
    v += __builtin_bit_cast(float, __builtin_amdgcn_update_dpp(0, __builtin_bit_cast(int, v), 0x141, 0xF, 0xF, true));
    v += __builtin_bit_cast(float, __builtin_amdgcn_update_dpp(0, __builtin_bit_cast(int, v), 0x140, 0xF, 0xF, true));
    return v;
}
__device__ __forceinline__ void scan_phase(const Frame& F, const Args& a) {
    unsigned char* ws = a.ws;
    const int seq = F.vcu >> 2, rg = F.vcu & 3;
    if (seq >= 64) return;
    const int z = seq >> 5, b = (seq >> 3) & 3, h = seq & 7;
    const bf16* vsrc = (const bf16*)(ws + WS_V);
    float* yout = (float*)(ws + WS_Y) + (size_t)z * M * CW;
    const size_t mb = (size_t)b * T;
    const int lane = F.lane, wave = F.wave;
    constexpr int NCH = T / SC_TC;
    if (wave >= 4) {
        const int u = F.tid - 256;
        const bf16* gp[5]; int ldo[5];
        const long tstep = z ? -(long)CW : (long)CW;
#pragma unroll
        for (int j = 0; j < 5; ++j) { const int piece = u + 256 * j, tau = piece / 40, w = piece % 40, arr = w >> 3, part = w & 7;
            const bf16* base = arr == 0 ? (const bf16*)(ws + WS_KK) : arr == 1 ? (const bf16*)(ws + WS_DECAY) + (size_t)z * M * CW : arr == 2 ? (const bf16*)(ws + WS_AKK) + (size_t)z * M * CW
                             : arr == 3 ? (const bf16*)(ws + WS_KDIR) + (size_t)z * M * CW : (const bf16*)(ws + WS_R);
            const int t0 = z ? (T - 1 - tau) : tau;
            gp[j] = base + (mb + t0) * CW + h * 64 + part * 8; ldo[j] = tau * SC_REC + w * 32; }
        const int vtau = (u & 63) >> 1, vpart = u & 1;
        const bf16* gv = vsrc + (mb + (z ? (T - 1 - vtau) : vtau)) * CW + h * 64 + rg * 16 + vpart * 8;
        const int ldv = vtau * SC_REC + 1280 + vpart * 32;
        u32x4 reg0, reg1, reg2, reg3, reg4, regv = {0u, 0u, 0u, 0u};
#define SC_LOAD(c) do { const long adv = (long)(c) * SC_TC * tstep; reg0 = *(const u32x4*)(gp[0] + adv); reg1 = *(const u32x4*)(gp[1] + adv); reg2 = *(const u32x4*)(gp[2] + adv); \
            reg3 = *(const u32x4*)(gp[3] + adv); reg4 = *(const u32x4*)(gp[4] + adv); if (u < 64) regv = *(const u32x4*)(gv + adv); } while (0)
#define SC_W1(rg_, off_) do { float f_[8]; unpack8(rg_, f_); LAS f32x4* d_ = (LAS f32x4*)(st_ + (off_)); d_[0] = (f32x4){f_[0], f_[1], f_[2], f_[3]}; d_[1] = (f32x4){f_[4], f_[5], f_[6], f_[7]}; } while (0)
#define SC_WRITE(buf) do { LAS unsigned char* st_ = F.lds + (buf) * SC_STAGE; SC_W1(reg0, ldo[0]); SC_W1(reg1, ldo[1]); SC_W1(reg2, ldo[2]); SC_W1(reg3, ldo[3]); SC_W1(reg4, ldo[4]); \
            if (u < 64) SC_W1(regv, ldv); } while (0)
#define SC_YRED(c) do { const LAS unsigned char* yb_ = F.lds + SC_YOFF + ((c) & 1) * SC_YB; _Pragma("unroll") for (int j = 0; j < 2; ++j) { const int o_ = u + 256 * j, tau_ = o_ >> 4, row_ = o_ & 15; \
            const LAS f32x4* s_ = (const LAS f32x4*)(yb_ + tau_ * 1024 + row_ * 64); const f32x4 s0 = s_[0], s1 = s_[1], s2 = s_[2], s3 = s_[3]; \
            const float tot_ = (((s0.x + s0.y) + (s0.z + s0.w)) + ((s1.x + s1.y) + (s1.z + s1.w))) + (((s2.x + s2.y) + (s2.z + s2.w)) + ((s3.x + s3.y) + (s3.z + s3.w))); \
            const int n_ = (c) * SC_TC + tau_, t_ = z ? (T - 1 - n_) : n_; yout[(mb + t_) * CW + h * 64 + rg * 16 + row_] = tot_; } } while (0)
        SC_LOAD(0); SC_WRITE(0); SC_LOAD(1);
        __syncthreads();
#pragma unroll 1
        for (int c = 0; c < NCH; ++c) {
            if (c + 1 < NCH) SC_WRITE((c + 1) & 1);
            if (c + 2 < NCH) SC_LOAD(c + 2);
            if (c >= 1) SC_YRED(c - 1);
            __syncthreads();
        }
        SC_YRED(NCH - 1);
#undef SC_LOAD
#undef SC_W1
#undef SC_WRITE
#undef SC_YRED
    } else {
        const int cg4 = lane & 15, row = wave * 4 + (lane >> 4);
        f32x2 S01 = {0.f, 0.f}, S23 = {0.f, 0.f};
        __syncthreads();
#pragma unroll 1
        for (int c = 0; c < NCH; ++c) {
            const LAS unsigned char* st = F.lds + (c & 1) * SC_STAGE + cg4 * 16;
            const LAS unsigned char* sv = F.lds + (c & 1) * SC_STAGE + 1280 + row * 4;
            LAS float* yb = (LAS float*)(F.lds + SC_YOFF + (c & 1) * SC_YB) + wave * 64 + lane;
            f32x4 Rkk[3], Rw[3], Rak[3], Rk[3], Rr[3]; float Rv[3];
#define SC_LDSTEP(t_, s_) do { Rkk[s_] = *(const LAS f32x4*)(st + (t_) * SC_REC); Rw[s_] = *(const LAS f32x4*)(st + (t_) * SC_REC + 256); Rak[s_] = *(const LAS f32x4*)(st + (t_) * SC_REC + 512); \
                Rk[s_] = *(const LAS f32x4*)(st + (t_) * SC_REC + 768); Rr[s_] = *(const LAS f32x4*)(st + (t_) * SC_REC + 1024); Rv[s_] = *(const LAS float*)(sv + (t_) * SC_REC); } while (0)
            SC_LDSTEP(0, 0); SC_LDSTEP(1, 1);
#pragma unroll
            for (int tau = 0; tau < SC_TC; ++tau) {
                const int sx = tau % 3;
                if (tau + 2 < SC_TC) { const int sn = (tau + 2) % 3; SC_LDSTEP(tau + 2, sn); }
                const f32x2 kk01 = {Rkk[sx].x, Rkk[sx].y}, kk23 = {Rkk[sx].z, Rkk[sx].w};
                f32x2 pd = S01 * kk01; pd = __builtin_elementwise_fma(S23, kk23, pd);
                const float sa = row16_sum(pd.x + pd.y);
                const f32x2 vv = {Rv[sx], Rv[sx]}, nsa = {-sa, -sa};
                const f32x2 w01 = {Rw[sx].x, Rw[sx].y}, w23 = {Rw[sx].z, Rw[sx].w}, k01 = {Rk[sx].x, Rk[sx].y}, k23 = {Rk[sx].z, Rk[sx].w};
                const f32x2 a01 = {Rak[sx].x, Rak[sx].y}, a23 = {Rak[sx].z, Rak[sx].w}, r01 = {Rr[sx].x, Rr[sx].y}, r23 = {Rr[sx].z, Rr[sx].w};
                f32x2 t01 = __builtin_elementwise_fma(S01, w01, k01 * vv), t23 = __builtin_elementwise_fma(S23, w23, k23 * vv);
                S01 = __builtin_elementwise_fma(a01, nsa, t01); S23 = __builtin_elementwise_fma(a23, nsa, t23);
                f32x2 yr = S01 * r01; yr = __builtin_elementwise_fma(S23, r23, yr);
                yb[tau * 256] = yr.x + yr.y;
            }
#undef SC_LDSTEP
            __syncthreads();
        }
    }
    __syncthreads();
}

__device__ __forceinline__ void combine_phase(const Frame& F, const Args& a) {
    unsigned char* ws = a.ws;
    const bf16* att = (const bf16*)(ws + WS_ATT); const bf16* rr = (const bf16*)(ws + WS_R); const bf16* vv = (const bf16*)(ws + WS_V);
    const bf16* kd = (const bf16*)(ws + WS_KDIR); const bf16* gg = (const bf16*)(ws + WS_G); const float* y = (const float*)(ws + WS_Y);
    bf16* mix = (bf16*)(ws + WS_MIX);
    const float* anw = a.in[4]; const float* r_k = a.in[14]; const float* ln_w = a.in[15]; const float* ln_b = a.in[16];
    const int lane = F.lane, c0 = 8 * lane;
    float nw[8], rk[8], lw[8], lb[8];
#pragma unroll
    for (int i = 0; i < 8; ++i) { nw[i] = anw[c0 + i]; rk[i] = r_k[c0 + i]; lw[i] = ln_w[c0 + i]; lb[i] = ln_b[c0 + i]; }
    const int gw = F.vcu * 8 + F.wave, NGW = F.G * 8;
    for (int m = gw; m < M; m += NGW) {
        const size_t o = (size_t)m * CW + c0;
        float f[8];
        unpack8(*(const u32x4*)(att + o), f);
        float ss = 0.f;
#pragma unroll
        for (int i = 0; i < 8; ++i) ss += f[i] * f[i];
        const float rs = rsqrtf(wave_sum(ss) * (1.f / CW) + RMS_EPS);
#pragma unroll
        for (int i = 0; i < 8; ++i) f[i] = f[i] * rs * nw[i];
        *(u32x4*)(mix + (size_t)m * D + c0) = pack8(f);
        const f32x4 y0a = *(const f32x4*)(y + o), y0b = *(const f32x4*)(y + o + 4), y1a = *(const f32x4*)(y + (size_t)M * CW + o), y1b = *(const f32x4*)(y + (size_t)M * CW + o + 4);
        float yv[8] = {y0a.x + y1a.x, y0a.y + y1a.y, y0a.z + y1a.z, y0a.w + y1a.w, y0b.x + y1b.x, y0b.y + y1b.y, y0b.z + y1b.z, y0b.w + y1b.w};
        float s1 = 0.f;
#pragma unroll
        for (int i = 0; i < 8; ++i) s1 += yv[i];
        s1 += __shfl_xor(s1, 1); s1 += __shfl_xor(s1, 2); s1 += __shfl_xor(s1, 4);
        const float mean = s1 * (1.f / 64.f);
        float s2 = 0.f;
#pragma unroll
        for (int i = 0; i < 8; ++i) { yv[i] -= mean; s2 += yv[i] * yv[i]; }
        s2 += __shfl_xor(s2, 1); s2 += __shfl_xor(s2, 2); s2 += __shfl_xor(s2, 4);
        const float rstd = rsqrtf(s2 * (1.f / 64.f) + GN_EPS);
        float rf[8], k0[8], k1[8], vf[8], gf[8];
        unpack8(*(const u32x4*)(rr + o), rf); unpack8(*(const u32x4*)(kd + o), k0); unpack8(*(const u32x4*)(kd + (size_t)M * CW + o), k1);
        unpack8(*(const u32x4*)(vv + o), vf); unpack8(*(const u32x4*)(gg + o), gf);
        float cf = 0.f;
#pragma unroll
        for (int i = 0; i < 8; ++i) cf += rf[i] * (k0[i] + k1[i]) * rk[i];
        cf += __shfl_xor(cf, 1); cf += __shfl_xor(cf, 2); cf += __shfl_xor(cf, 4);
#pragma unroll
        for (int i = 0; i < 8; ++i) f[i] = (yv[i] * rstd * lw[i] + lb[i] + cf * vf[i]) * gf[i];
        *(u32x4*)(mix + (size_t)m * D + CW + c0) = pack8(f);
    }
}

constexpr int RT_W = 0, RT_HIST = 131072, RT_LOG = 131072 + 256;
__device__ __forceinline__ void router_phase(const Frame& F, const Args& a) {
    unsigned char* ws = a.ws;
    const float* hbuf = (const float*)(ws + WS_H); bf16* hn2 = (bf16*)(ws + WS_HN2);
    int* eidx = (int*)(ws + WS_EIDX); float* gate = (float*)(ws + WS_GATE); int* rank = (int*)(ws + WS_RANK);
    unsigned* ctl = (unsigned*)(ws + WS_CTL);
    const float* n2w = a.in[18]; const float* rw = a.in[19]; const float* rb = a.in[20];
    LAS float* wT = (LAS float*)(F.lds + RT_W); LAS int* hist = (LAS int*)(F.lds + RT_HIST); LAS float* lg = (LAS float*)(F.lds + RT_LOG) + F.wave * 64; LAS int* eL = (LAS int*)(F.lds + RT_LOG + 2048);
    for (int i = F.tid; i < 32768; i += 512) { const int d = i >> 5, e = i & 31; wT[e * 1024 + d] = rw[i]; }
    if (F.tid < 32) hist[F.tid] = 0;
    __syncthreads();
    const int lane = F.lane;
    f32x4 wn[4];
#pragma unroll
    for (int j = 0; j < 4; ++j) wn[j] = *((const f32x4*)n2w + lane + 64 * j);
    const float rbias = rb[lane & 31];
    const int blk = F.vcu;
    for (int pr = 0; pr < 8; ++pr) {
        const int m0 = blk * 128 + F.wave * 16 + pr * 2;
        f32x4 xv[2][4];
#pragma unroll
        for (int tk = 0; tk < 2; ++tk) {
            const f32x4* hr = (const f32x4*)(hbuf + (size_t)(m0 + tk) * D) + lane;
            float s = 0.f;
#pragma unroll
            for (int j = 0; j < 4; ++j) { xv[tk][j] = hr[64 * j]; s += (xv[tk][j].x * xv[tk][j].x + xv[tk][j].y * xv[tk][j].y) + (xv[tk][j].z * xv[tk][j].z + xv[tk][j].w * xv[tk][j].w); }
            const float rs = rsqrtf(wave_sum(s) * (1.f / D) + RMS_EPS);
            u32x2* o8 = (u32x2*)(hn2 + (size_t)(m0 + tk) * D) + lane;
#pragma unroll
            for (int j = 0; j < 4; ++j) { xv[tk][j] = xv[tk][j] * rs * wn[j]; u32x2 o; o.x = cvt_pk_bf16(xv[tk][j].x, xv[tk][j].y); o.y = cvt_pk_bf16(xv[tk][j].z, xv[tk][j].w); o8[64 * j] = o; }
        }
        float mine = 0.f;
#pragma unroll 4
        for (int e = 0; e < 32; ++e) {
            float p0 = 0.f, p1 = 0.f;
#pragma unroll
            for (int j = 0; j < 4; ++j) { const f32x4 w4 = *(const LAS f32x4*)(wT + e * 1024 + 256 * j + 4 * lane);
                p0 += (w4.x * xv[0][j].x + w4.y * xv[0][j].y) + (w4.z * xv[0][j].z + w4.w * xv[0][j].w);
                p1 += (w4.x * xv[1][j].x + w4.y * xv[1][j].y) + (w4.z * xv[1][j].z + w4.w * xv[1][j].w); }
            p0 = wave_sum(p0); p1 = wave_sum(p1);
            if (lane == e) mine = p0; if (lane == 32 + e) mine = p1;
        }
        lg[lane] = mine + rbias;
        asm volatile("s_waitcnt lgkmcnt(0)" ::: "memory");
        if (lane < 2) {
            const LAS float* L = lg + lane * 32; const int m = m0 + lane;
            float v[32];
#pragma unroll
            for (int e = 0; e < 32; ++e) v[e] = L[e];
            float tv[4]; int ti[4];
#pragma unroll
            for (int kx = 0; kx < 4; ++kx) { float best = -3.0e38f; int bi = 0;
#pragma unroll
                for (int e = 0; e < 32; ++e) { if (v[e] > best) { best = v[e]; bi = e; } }
                tv[kx] = best; ti[kx] = bi;
#pragma unroll
                for (int e = 0; e < 32; ++e) { if (e == bi) v[e] = -3.0e38f; } }
            const float e0 = 1.0f, e1 = __expf(tv[1] - tv[0]), e2 = __expf(tv[2] - tv[0]), e3 = __expf(tv[3] - tv[0]);
            const float is = 1.0f / (e0 + e1 + e2 + e3);
            const float gs[4] = {e0 * is, e1 * is, e2 * is, e3 * is};
#pragma unroll
            for (int kx = 0; kx < 4; ++kx) { eidx[m * 4 + kx] = ti[kx]; gate[m * 4 + kx] = gs[kx]; eL[(m - blk * 128) * 4 + kx] = ti[kx]; }
        }
        asm volatile("s_waitcnt lgkmcnt(0)" ::: "memory");
    }
    __syncthreads();
    { const int t = F.tid, e = eL[t]; int rk = 0;
      for (int u = 0; u < t; ++u) rk += (eL[u] == e) ? 1 : 0;
      rank[(blk * 128) * 4 + t] = rk;
      __hip_atomic_fetch_add(&hist[e], 1, __ATOMIC_RELAXED, __HIP_MEMORY_SCOPE_WORKGROUP); }
    __syncthreads();
    if (F.tid < 32) ctl[CW_CNT + blk * 32 + F.tid] = (unsigned)hist[F.tid];
}

__device__ __forceinline__ void dispatch_phase(const Frame& F, const Args& a) {
    unsigned char* ws = a.ws;
    unsigned* ctl = (unsigned*)(ws + WS_CTL);
    const int* eidx = (const int*)(ws + WS_EIDX); const int* rank = (const int*)(ws + WS_RANK); int* dest = (int*)(ws + WS_DEST);
    const bf16* hn2 = (const bf16*)(ws + WS_HN2); bf16* xbuf = (bf16*)(ws + WS_XBUF);
    LAS int* part = (LAS int*)F.lds;
    LAS int* tot = part + 1024;
    const int blk = F.vcu, G = F.G;
    { const int e = F.tid & 31, pt = F.tid >> 5; int s = 0, sb = 0;
      for (int bb = pt; bb < G; bb += 16) { const int cval = (int)ld_u32_agent(ctl + CW_CNT + bb * 32 + e); s += cval; if (bb < blk) sb += cval; }
      part[pt * 32 + e] = s; part[512 + pt * 32 + e] = sb; }
    __syncthreads();
    if (F.tid < 32) { int s = 0, sb = 0;
        for (int pt = 0; pt < 16; ++pt) { s += part[pt * 32 + F.tid]; sb += part[512 + pt * 32 + F.tid]; }
        tot[F.tid] = s; tot[32 + F.tid] = sb; tot[96 + F.tid] = (s + 255) & ~255; }
    __syncthreads();
    if (F.tid == 0) { int ps = 0; for (int e = 0; e < 32; ++e) { tot[64 + e] = ps; ps += tot[96 + e]; }
        tot[128] = ps >> 8; }
    __syncthreads();
    if (blk == 0) {
        if (F.tid == 0) ctl[CW_NT] = (unsigned)tot[128];
        for (int e = F.tid >> 4; e < 32; e += 32) { const int t0 = tot[64 + e] >> 8, nt = tot[96 + e] >> 8; for (int i = F.tid & 15; i < nt; i += 16) ctl[CW_TEXP + t0 + i] = (unsigned)e; }
    }
    const int lane = F.lane;
    for (int i = 0; i < 16; ++i) {
        const int m = blk * 128 + F.wave * 16 + i;
        const u32x4* srow = (const u32x4*)(hn2 + (size_t)m * D);
        const u32x4 v0 = srow[lane], v1 = srow[64 + lane];
#pragma unroll
        for (int kx = 0; kx < 4; ++kx) {
            const int e = eidx[m * 4 + kx]; const int d = tot[64 + e] + tot[32 + e] + rank[m * 4 + kx];
            if (lane == 0) dest[m * 4 + kx] = d;
            u32x4* drow = (u32x4*)(xbuf + (size_t)d * D);
            drow[lane] = v0; drow[64 + lane] = v1;
        }
    }
    { const int e = blk & 31, pt = blk >> 5, np = G >> 5; const int r0 = tot[64 + e] + tot[e], r1 = tot[64 + e] + tot[96 + e]; const u32x4 zero = {0u, 0u, 0u, 0u};
      if (np > 0) for (int r = r0 + pt * 8 + F.wave; r < r1; r += np * 8) { u32x4* drow = (u32x4*)(xbuf + (size_t)r * D); drow[lane] = zero; drow[64 + lane] = zero; } }
}

__device__ __forceinline__ void final_phase(const Frame& F, const Args& a) {
    unsigned char* ws = a.ws;
    const float* hbuf = (const float*)(ws + WS_H); const bf16* ybuf = (const bf16*)(ws + WS_YBUF);
    const int* dest = (const int*)(ws + WS_DEST); const float* gate = (const float*)(ws + WS_GATE);
    const float* fw = a.in[25]; float* out = a.out;
    const int lane = F.lane;
    f32x4 wn[4];
#pragma unroll
    for (int j = 0; j < 4; ++j) wn[j] = *((const f32x4*)fw + lane + 64 * j);
    const int gw = F.vcu * 8 + F.wave, NGW = F.G * 8;
    for (int m = gw; m < M; m += NGW) {
        const f32x4* hr = (const f32x4*)(hbuf + (size_t)m * D) + lane;
        f32x4 v[4];
#pragma unroll
        for (int j = 0; j < 4; ++j) v[j] = hr[64 * j];
#pragma unroll
        for (int kx = 0; kx < 4; ++kx) {
            const int d = dest[m * 4 + kx]; const float gt = gate[m * 4 + kx];
            const u32x2* yr = (const u32x2*)(ybuf + (size_t)d * D) + lane;
#pragma unroll
            for (int j = 0; j < 4; ++j) { const u32x2 w = yr[64 * j]; v[j].x += gt * bflo(w.x); v[j].y += gt * bfhi(w.x); v[j].z += gt * bflo(w.y); v[j].w += gt * bfhi(w.y); }
        }
        float s = 0.f;
#pragma unroll
        for (int j = 0; j < 4; ++j) s += (v[j].x * v[j].x + v[j].y * v[j].y) + (v[j].z * v[j].z + v[j].w * v[j].w);
        const float rs = rsqrtf(wave_sum(s) * (1.f / D) + RMS_EPS);
        f32x4* orow = (f32x4*)(out + (size_t)m * D) + lane;
#pragma unroll
        for (int j = 0; j < 4; ++j) orow[64 * j] = v[j] * rs * wn[j];
    }
}

__global__ void __launch_bounds__(512, 2) fwd_megakernel(Args args) {
    extern __shared__ __attribute__((aligned(16))) unsigned char lds_raw[];
    Frame F;
    F.lds = (LAS unsigned char*)lds_raw;
    F.tid = threadIdx.x; F.lane = F.tid & 63; F.wave = __builtin_amdgcn_readfirstlane(F.tid >> 6);
    F.G = gridDim.x; { const int bx = blockIdx.x; F.vcu = (F.G % 8 == 0) ? (bx % 8) * (F.G / 8) + bx / 8 : bx; }
    unsigned char* ws = args.ws;
    const int lo = args.ph_lo, hi = args.ph_hi;
#define IN(k) (lo <= (k) && (k) < hi)
#if MK_SPLIT
#define SEAM(k) do { } while (0)
#else
    cg::grid_group grid = cg::this_grid();
    { volatile LAS unsigned* st = (volatile LAS unsigned*)(F.lds + LDS_MISC); if (F.tid < 2) st[F.tid] = 0u; __syncthreads(); }
    const XcdBarrier xbar = xcd_barrier_post((unsigned*)(ws + WS_CTL) + CW_BAR, (volatile LAS unsigned*)(F.lds + LDS_MISC));
#define SEAM(k) do { if (IN(k) && IN((k) + 1)) { if ((k) == 0) { \
        asm volatile("s_waitcnt vmcnt(0) lgkmcnt(0)" ::: "memory"); \
        __builtin_amdgcn_fence(__ATOMIC_RELEASE, "agent"); \
        asm volatile("s_waitcnt vmcnt(0)" ::: "memory"); \
        grid.sync(); \
        __builtin_amdgcn_fence(__ATOMIC_ACQUIRE, "agent"); \
        asm volatile("s_waitcnt vmcnt(0)" ::: "memory"); } else xcd_barrier(xbar); } } while (0)
#endif
#define REP2(k) if constexpr (((MK_REPEAT >> (k)) & 1) != 0)
#define PH1 { pg8::Gemm g{(const bf16*)(ws + WS_HN), (const bf16*)(ws + WS_WINT), 1024, nullptr, 0}; \
        pg8::StaticOrder S; S.init(M / 256, NPROJ_PAD / 256, F.G, (int)blockIdx.x); \
        pg8::EpiProj E{(bf16*)(ws + WS_Q), (bf16*)(ws + WS_K), (bf16*)(ws + WS_VT), (bf16*)(ws + WS_P)}; \
        pg8::gemm_phase<pg8::EpiProj, true, true>(F.lds, g, S, E); }
#define PH5 { pg8::Gemm g{(const bf16*)(ws + WS_MIX), (const bf16*)(ws + WS_WOT), 1024, nullptr, 0}; \
        pg8::StaticOrder S; S.init(M / 256, D / 256, F.G, (int)blockIdx.x); \
        pg8::EpiWo E{args.in[0], (float*)(ws + WS_H)}; \
        pg8::gemm_phase<pg8::EpiWo, true, true>(F.lds, g, S, E); }
#define PH8 { const unsigned* ctl = (const unsigned*)(ws + WS_CTL); const int ntile = (int)ld_u32_agent(ctl + CW_NT); \
        pg8::Gemm g{(const bf16*)(ws + WS_XBUF), (const bf16*)(ws + WS_WUPT), 1024, ctl + CW_TEXP, (size_t)2048 * 1024 * 2}; \
        pg8::StaticOrder S; S.init(ntile, 8, F.G, (int)blockIdx.x); \
        pg8::EpiUp E{args.in[22], (bf16*)(ws + WS_ACT)}; \
        pg8::gemm_phase<pg8::EpiUp, true, true>(F.lds, g, S, E); }
#define PH9 { const unsigned* ctl = (const unsigned*)(ws + WS_CTL); const int ntile = (int)ld_u32_agent(ctl + CW_NT); \
        pg8::Gemm g{(const bf16*)(ws + WS_ACT), (const bf16*)(ws + WS_WDNT), 1024, ctl + CW_TEXP, (size_t)1024 * 1024 * 2}; \
        pg8::StaticOrder S; S.init(ntile, 4, F.G, (int)blockIdx.x); \
        pg8::EpiDown E{args.in[24], (bf16*)(ws + WS_YBUF)}; \
        pg8::gemm_phase<pg8::EpiDown, true, true>(F.lds, g, S, E); }
    if (IN(0)) { p0_prologue(F, args); REP2(0) p0_prologue(F, args); }
    SEAM(0);
    if (IN(1)) { PH1 REP2(1) PH1 }
    SEAM(1);
    if (IN(2)) { prep_phase<true>(F, args); REP2(2) prep_phase<true>(F, args); attn_phase(F, args); REP2(11) attn_phase(F, args); }
    SEAM(2);
    if (IN(3)) { scan_phase(F, args); REP2(3) scan_phase(F, args); }
    SEAM(3);
    if (IN(4)) { combine_phase(F, args); REP2(4) combine_phase(F, args); }
    SEAM(4);
    if (IN(5)) { PH5 REP2(5) PH5 }
    SEAM(5);
    if (IN(6)) { router_phase(F, args); REP2(6) { __syncthreads(); router_phase(F, args); } }
    SEAM(6);
    if (IN(7)) { dispatch_phase(F, args); REP2(7) { __syncthreads(); dispatch_phase(F, args); } }
    SEAM(7);
    if (IN(8)) { PH8 REP2(8) PH8 }
    SEAM(8);
    if (IN(9)) { PH9 REP2(9) PH9 }
    SEAM(9);
    if (IN(10)) { final_phase(F, args); REP2(10) final_phase(F, args); }
#undef IN
#undef SEAM
}

extern "C" void kernel_launch(void* const* d_in, const int* in_sizes, int n_in, void* d_out, int out_size, void* d_ws, size_t ws_size, hipStream_t stream) {
    static int grid = 0;
    if (grid == 0) {
        if (n_in != 26 || in_sizes[0] != M * D || out_size != M * D || ws_size < WS_END) { fprintf(stderr, "kernel_launch: unexpected problem (n_in %d, in0 %d, out %d, ws %zu)\n", n_in, n_in > 0 ? in_sizes[0] : -1, out_size, ws_size); grid = -1; return; }
        int dev = 0, cus = 0, per_cu = 0;
        if (hipGetDevice(&dev) != hipSuccess || hipDeviceGetAttribute(&cus, hipDeviceAttributeMultiprocessorCount, dev) != hipSuccess) { grid = -1; return; }
        if (hipFuncSetAttribute((const void*)fwd_megakernel, hipFuncAttributeMaxDynamicSharedMemorySize, LDS_BYTES) != hipSuccess) { fprintf(stderr, "kernel_launch: hipFuncSetAttribute failed\n"); grid = -1; return; }
        if (hipOccupancyMaxActiveBlocksPerMultiprocessor(&per_cu, (const void*)fwd_megakernel, 512, LDS_BYTES) != hipSuccess || per_cu < 1) { fprintf(stderr, "kernel_launch: occupancy query says %d\n", per_cu); per_cu = 1; }
        (void)hipGetLastError();
        grid = cus * 1;
        if (grid != 256) fprintf(stderr, "kernel_launch: note: %d CUs\n", cus);
    }
    if (grid < 0) return;
    if (hipMemsetAsync((char*)d_ws + WS_CTL + (size_t)CW_BAR * 4, 0, XCD_BAR_WORDS * 4, stream) != hipSuccess) { fprintf(stderr, "kernel_launch: memset failed\n"); return; }
    Args a{};
    for (int i = 0; i < 26; ++i) a.in[i] = (const float*)d_in[i];
    a.out = (float*)d_out; a.ws = (unsigned char*)d_ws;
#if MK_SPLIT
    for (int ph = 0; ph < NPHASE; ++ph) { a.ph_lo = ph; a.ph_hi = ph + 1; hipLaunchKernelGGL(fwd_megakernel, dim3(grid), dim3(512), LDS_BYTES, stream, a); }
#else
    a.ph_lo = 0; a.ph_hi = NPHASE;
    void* kargs[] = {&a};
    hipError_t e = hipLaunchCooperativeKernel((const void*)fwd_megakernel, dim3(grid), dim3(512), kargs, LDS_BYTES, stream);
    if (e != hipSuccess) fprintf(stderr, "kernel_launch: cooperative launch failed: %s (grid %d)\n", hipGetErrorString(e), grid);
#endif
}
```

```cpp
#include <hip/hip_runtime.h>
#include <hip/hip_cooperative_groups.h>
#include <cstdio>
#include <cstdint>
namespace cg = cooperative_groups;

#ifndef MK_SPLIT
#define MK_SPLIT 0
#endif

#ifndef MK_REPEAT
#define MK_REPEAT 0
#endif
#define LAS __attribute__((address_space(3)))
typedef unsigned short bf16;
typedef float f32x4 __attribute__((ext_vector_type(4)));
typedef float f32x2 __attribute__((ext_vector_type(2)));
typedef unsigned u32x4 __attribute__((ext_vector_type(4)));
typedef unsigned u32x2 __attribute__((ext_vector_type(2)));
typedef short bf16x8 __attribute__((ext_vector_type(8)));

constexpr int BATCH = 4, T = 8192, D = 1024, M = BATCH * T;
constexpr int NH = 8, HD = 64, CW = 512;
constexpr int SHIFT_W = 1920, NPROJ = 3456, NPROJ_PAD = 3584, PW = 2048;
constexpr int NE = 32, TOPK = 4, DE = 1024;
constexpr int GRIDW = 64, GROWS = 128;
constexpr int P_TILES_MAX = 544, P_ROWS = P_TILES_MAX * 256;
constexpr float RMS_EPS = 1e-5f, GN_EPS = 64e-5f;
constexpr int NPHASE = 11;

constexpr size_t MiB = 1u << 20;
constexpr size_t WS_CTL = 0;
constexpr size_t WS_W2T = 1 * MiB, WS_A2T = WS_W2T + 131072, WS_G2T = WS_A2T + 131072;
constexpr size_t WS_WINT = 2 * MiB, WS_WOT = 9 * MiB, WS_WUPT = 12 * MiB, WS_WDNT = 140 * MiB;
constexpr size_t WS_EIDX = 204 * MiB, WS_GATE = WS_EIDX + 524288, WS_RANK = WS_GATE + 524288, WS_DEST = WS_RANK + 524288;
constexpr size_t WS_R = 208 * MiB, WS_V = 240 * MiB, WS_KK = 272 * MiB, WS_DECAY = 304 * MiB, WS_KDIR = 368 * MiB, WS_AKK = 432 * MiB,
                 WS_G = 496 * MiB, WS_ATT = 528 * MiB;
constexpr size_t WS_Q = 560 * MiB, WS_K = 592 * MiB, WS_VT = 624 * MiB, WS_P = 656 * MiB, WS_HN = 784 * MiB, WS_Y = 848 * MiB;
constexpr size_t WS_MIX = 560 * MiB, WS_H = 752 * MiB, WS_HN2 = 880 * MiB, WS_XBUF = 208 * MiB, WS_ACT = 480 * MiB, WS_YBUF = 208 * MiB;
constexpr size_t WS_END = 976 * MiB;
constexpr int CW_NT = 0, CW_TEXP = 64, CW_CNT = 1024, CW_BAR = 16384;

constexpr int LDS_BYTES = 159744, LDS_MISC = LDS_BYTES - 256;

typedef __bf16 bf16x2_t __attribute__((ext_vector_type(2)));
__device__ __forceinline__ unsigned cvt_pk_bf16(float lo, float hi) { const f32x2 v = {lo, hi}; return __builtin_bit_cast(unsigned, __builtin_convertvector(v, bf16x2_t)); }
__device__ __forceinline__ float bflo(unsigned u) { return __uint_as_float(u << 16); }
__device__ __forceinline__ float bfhi(unsigned u) { return __uint_as_float(u & 0xffff0000u); }
__device__ __forceinline__ float bf1(bf16 v) { return __uint_as_float(((unsigned)v) << 16); }
__device__ __forceinline__ void unpack8(const u32x4 u, float* f) { f[0] = bflo(u.x); f[1] = bfhi(u.x); f[2] = bflo(u.y); f[3] = bfhi(u.y); f[4] = bflo(u.z); f[5] = bfhi(u.z); f[6] = bflo(u.w); f[7] = bfhi(u.w); }
__device__ __forceinline__ u32x4 pack8(const float* f) { u32x4 o; o.x = cvt_pk_bf16(f[0], f[1]); o.y = cvt_pk_bf16(f[2], f[3]); o.z = cvt_pk_bf16(f[4], f[5]); o.w = cvt_pk_bf16(f[6], f[7]); return o; }
__device__ __forceinline__ float wave_sum(float v) {
#pragma unroll
    for (int o = 1; o < 64; o <<= 1) v += __shfl_xor(v, o);
    return v;
}
__device__ __forceinline__ float sigmoidf_(float x) { return __builtin_amdgcn_rcpf(1.0f + __expf(-x)); }
__device__ __forceinline__ unsigned ld_u32_agent(const unsigned* p) { return __hip_atomic_load(p, __ATOMIC_RELAXED, __HIP_MEMORY_SCOPE_AGENT); }

namespace pg8 {
constexpr int BM = 256, BK = 64, HALF = 128, HTB = HALF * BK * 2, STAGE_BYTES = 8 * HTB, NXCD = 8, WGM = 8;
__host__ __device__ __forceinline__ int lds_byte(int r, int c) { const int st = (r >> 4) * 2 + (c >> 5), rr = r & 15, cc = c & 31, ob = rr * 64 + cc * 2; return st * 1024 + (ob ^ (((ob >> 9) & 1) << 5)); }
__host__ __device__ __forceinline__ void stage_rc(int b, int& R, int& C) { const int st = b / 1024, sb = b % 1024, swz = sb ^ (((sb >> 9) & 1) << 5); R = (st >> 1) * 16 + swz / 64; C = (st & 1) * 32 + (swz % 64) / 2; }
__host__ __device__ __forceinline__ int perm32(int rho) { const int n = rho >> 4, i = rho & 15; return 8 * (i >> 2) + 4 * n + (i & 3); }

struct Unit { int pm, pn, e; };
struct Gemm { const bf16* A; const bf16* Bt; int K; const unsigned* texp; size_t bstride; };

struct StaticOrder {
    int nM, nN, nwg, G, c;
    __device__ void init(int nM_, int nN_, int G_, int c_) { nM = nM_; nN = nN_; nwg = nM * nN; G = G_; c = c_; }
    __device__ bool next(int i, Unit& u) const {
        const long L = (long)i * G + c; if (L >= nwg) return false;
        int wgid = (int)L; { const int q = nwg / NXCD, r = nwg % NXCD, xcd = wgid % NXCD, off = wgid / NXCD; wgid = (xcd < r ? xcd * (q + 1) : r * (q + 1) + (xcd - r) * q) + off; }
        const int nig = WGM * nN, gid = wgid / nig, fm = gid * WGM, gsz = (nM - fm) < WGM ? (nM - fm) : WGM;
        u.pm = fm + ((wgid % nig) % gsz); u.pn = (wgid % nig) / gsz; u.e = 0; return true;
    }
};

template <class Epi, bool ALIGN_EPI, bool SP2>
__device__ __forceinline__ void gemm_phase(LAS unsigned char* lds, const Gemm g, const StaticOrder& S, const Epi& E) {
    const int tid = threadIdx.x, wid = __builtin_amdgcn_readfirstlane(tid >> 6), lane = tid & 63, wr = wid >> 2, wc = wid & 3, fr = lane & 15, fq = lane >> 4;
    const int K = g.K, nt = K / BK;
    unsigned voffA[2], voffB[2];
#pragma unroll
    for (int i = 0; i < 2; ++i) { int R, C; stage_rc(tid * 16 + i * 8192, R, C); const int Rb = Epi::PERM ? ((R & ~31) + perm32(R & 31)) : R;
        voffA[i] = (unsigned)(R * K + C) * 2u; voffB[i] = (unsigned)(Rb * K + C) * 2u; }
    const size_t kstep = (size_t)(BK * 2);
    const size_t hstep = (size_t)HALF * K * 2;
    const size_t tstep = 2 * hstep;
    const unsigned ldsw = (unsigned)wid * 1024u;
    const int aoff = lds_byte(wr * 64 + fr, fq * 8), boff = lds_byte(wc * 32 + fr, fq * 8);
#define PG8_SA(b, h) (((b) * 2 + (h)) * HTB)
#define PG8_SB(b, h) ((4 + (b) * 2 + (h)) * HTB)
#define PG8_STAGE(bufoff, gbase, voff) do { _Pragma("unroll") for (int _i = 0; _i < 2; ++_i) \
        __builtin_amdgcn_global_load_lds((const unsigned*)((const char*)(gbase) + (voff)[_i]), (LAS unsigned*)(lds + (bufoff) + ldsw + _i * 8192), 16, 0, 0); } while (0)
#define PG8_LDA(dst, b, h) do { _Pragma("unroll") for (int m = 0; m < 4; ++m) _Pragma("unroll") for (int k = 0; k < 2; ++k) dst[m][k] = *(const LAS bf16x8*)(lds + PG8_SA(b, h) + aoff + m * 2048 + k * 1024); } while (0)
#define PG8_LDB(dst, b, h) do { _Pragma("unroll") for (int n = 0; n < 2; ++n) _Pragma("unroll") for (int k = 0; k < 2; ++k) dst[n][k] = *(const LAS bf16x8*)(lds + PG8_SB(b, h) + boff + n * 2048 + k * 1024); } while (0)
#define PG8_MMA(ai, bj, At, Bt) do { __builtin_amdgcn_s_setprio(1); _Pragma("unroll") for (int m = 0; m < 4; ++m) _Pragma("unroll") for (int n = 0; n < 2; ++n) _Pragma("unroll") for (int k = 0; k < 2; ++k) \
        acc[ai][bj][m][n] = __builtin_amdgcn_mfma_f32_16x16x32_bf16(Bt[n][k], At[m][k], acc[ai][bj][m][n], 0, 0, 0); __builtin_amdgcn_s_setprio(0); } while (0)
#define PG8_WAIT_V(n) asm volatile("s_waitcnt vmcnt(" #n ")" ::: "memory")
#define PG8_WAIT_L(n) asm volatile("s_waitcnt lgkmcnt(" #n ")" ::: "memory")
#define PG8_BAR __builtin_amdgcn_s_barrier()
#define PG8_SCHED __builtin_amdgcn_sched_barrier(0)
#define PG8_UPTR(u, pa, pb) do { unsigned _e = g.texp ? ld_u32_agent(g.texp + (u).pm) : 0u; _e = (unsigned)__builtin_amdgcn_readfirstlane((int)_e); (u).e = (int)_e; \
        pa = (const char*)g.A + (size_t)(u).pm * tstep; pb = (const char*)g.Bt + (size_t)_e * g.bstride + (size_t)(u).pn * tstep; } while (0)
    Unit cur, nxt; int ui = 0;
    if (!S.next(0, cur)) return;
    f32x4 acc[2][2][4][2];
#pragma unroll
    for (int a = 0; a < 2; ++a)
#pragma unroll
        for (int b = 0; b < 2; ++b)
#pragma unroll
            for (int m = 0; m < 4; ++m)
#pragma unroll
                for (int n = 0; n < 2; ++n) acc[a][b][m][n] = (f32x4){0.f, 0.f, 0.f, 0.f};
    bf16x8 At[4][2], B0[2][2], B1[2][2];
    const char* cA; const char* cB;
    PG8_UPTR(cur, cA, cB);
    if constexpr (SP2) {
        PG8_STAGE(PG8_SB(0, 0), cB, voffB); PG8_STAGE(PG8_SB(0, 1), cB + hstep, voffB); PG8_STAGE(PG8_SA(0, 0), cA, voffA); PG8_STAGE(PG8_SA(0, 1), cA + hstep, voffA);
        if (wr == 1) PG8_BAR;
        PG8_WAIT_V(2); PG8_BAR;
        PG8_STAGE(PG8_SB(1, 0), cB + kstep, voffB); PG8_STAGE(PG8_SA(1, 0), cA + kstep, voffA); PG8_STAGE(PG8_SB(1, 1), cB + hstep + kstep, voffB);
        PG8_WAIT_V(6); PG8_BAR;
    } else {
        PG8_STAGE(PG8_SB(0, 0), cB, voffB); PG8_STAGE(PG8_SA(0, 0), cA, voffA); PG8_STAGE(PG8_SB(0, 1), cB + hstep, voffB); PG8_STAGE(PG8_SA(0, 1), cA + hstep, voffA);
        if (wr == 1) PG8_BAR;
        PG8_WAIT_V(4); PG8_BAR;
        PG8_STAGE(PG8_SB(1, 0), cB + kstep, voffB); PG8_STAGE(PG8_SA(1, 0), cA + kstep, voffA); PG8_STAGE(PG8_SB(1, 1), cB + hstep + kstep, voffB);
        PG8_WAIT_V(6); PG8_BAR;
    }
    for (;;) {
        const bool has_next = S.next(ui + 1, nxt);
        const char* nA = cA; const char* nB = cB;
        if (has_next) PG8_UPTR(nxt, nA, nB);
        for (int t = 0; t < nt; t += 2) {
            const bool last = (t == nt - 2);
            const char* a1 = cA + (size_t)(t + 1) * kstep;
            const char* a2 = last ? nA : cA + (size_t)(t + 2) * kstep; const char* b2 = last ? nB : cB + (size_t)(t + 2) * kstep;
            const char* a3 = a2 + kstep; const char* b3 = b2 + kstep;
            if constexpr (SP2) {
            PG8_LDB(B0, 0, 0); PG8_LDB(B1, 0, 1); PG8_SCHED; PG8_LDA(At, 0, 0); PG8_STAGE(PG8_SA(1, 1), a1 + hstep, voffA);
            PG8_WAIT_V(8); PG8_WAIT_L(0); PG8_BAR; PG8_MMA(0, 0, At, B0); PG8_MMA(0, 1, At, B1); PG8_BAR; PG8_SCHED;
            PG8_LDA(At, 0, 1); PG8_STAGE(PG8_SB(0, 0), b2, voffB); PG8_STAGE(PG8_SB(0, 1), b2 + hstep, voffB); PG8_STAGE(PG8_SA(0, 0), a2, voffA);
            PG8_WAIT_V(8); PG8_WAIT_L(0); PG8_BAR; PG8_MMA(1, 0, At, B0); PG8_MMA(1, 1, At, B1); PG8_BAR; PG8_SCHED;
            PG8_LDB(B0, 1, 0); PG8_LDB(B1, 1, 1); PG8_SCHED; PG8_LDA(At, 1, 0); PG8_STAGE(PG8_SA(0, 1), a2 + hstep, voffA);
            PG8_WAIT_V(8); PG8_WAIT_L(0); PG8_BAR; PG8_MMA(0, 0, At, B0); PG8_MMA(0, 1, At, B1); PG8_BAR; PG8_SCHED;
            PG8_LDA(At, 1, 1); PG8_STAGE(PG8_SB(1, 0), b3, voffB); PG8_STAGE(PG8_SB(1, 1), b3 + hstep, voffB); PG8_STAGE(PG8_SA(1, 0), a3, voffA);
            PG8_WAIT_V(8); PG8_WAIT_L(0); PG8_BAR; PG8_MMA(1, 0, At, B0); PG8_MMA(1, 1, At, B1); PG8_BAR; PG8_SCHED;
            } else {
            PG8_LDB(B0, 0, 0); PG8_SCHED; PG8_LDA(At, 0, 0); PG8_STAGE(PG8_SA(1, 1), a1 + hstep, voffA);
            PG8_WAIT_L(8); PG8_BAR; PG8_WAIT_L(0); PG8_MMA(0, 0, At, B0); PG8_BAR; PG8_SCHED;
            PG8_LDB(B1, 0, 1); PG8_STAGE(PG8_SB(0, 0), b2, voffB);
            PG8_BAR; PG8_WAIT_L(0); PG8_MMA(0, 1, At, B1); PG8_BAR;
            PG8_LDA(At, 0, 1); PG8_STAGE(PG8_SA(0, 0), a2, voffA);
            PG8_BAR; PG8_WAIT_L(0); PG8_MMA(1, 0, At, B0); PG8_BAR; PG8_SCHED;
            PG8_STAGE(PG8_SB(0, 1), b2 + hstep, voffB);
            PG8_WAIT_V(6); PG8_BAR; PG8_MMA(1, 1, At, B1); PG8_BAR;
            PG8_LDB(B0, 1, 0); PG8_SCHED; PG8_LDA(At, 1, 0); PG8_STAGE(PG8_SA(0, 1), a2 + hstep, voffA);
            PG8_WAIT_L(8); PG8_BAR; PG8_WAIT_L(0); PG8_MMA(0, 0, At, B0); PG8_BAR; PG8_SCHED;
            PG8_LDB(B1, 1, 1); PG8_STAGE(PG8_SB(1, 0), b3, voffB);
            PG8_BAR; PG8_WAIT_L(0); PG8_MMA(0, 1, At, B1); PG8_BAR;
            PG8_LDA(At, 1, 1); PG8_STAGE(PG8_SA(1, 0), a3, voffA);
            PG8_BAR; PG8_WAIT_L(0); PG8_MMA(1, 0, At, B0); PG8_BAR; PG8_SCHED;
            PG8_STAGE(PG8_SB(1, 1), b3 + hstep, voffB);
            PG8_WAIT_V(6); PG8_BAR; PG8_MMA(1, 1, At, B1); PG8_BAR;
            }
        }
        if constexpr (ALIGN_EPI) { if (wr == 0) PG8_BAR; }
        E(acc, cur, wr, wc, fr, fq);
        if (!has_next) break;
#pragma unroll
        for (int a = 0; a < 2; ++a)
#pragma unroll
            for (int b = 0; b < 2; ++b)
#pragma unroll
                for (int m = 0; m < 4; ++m)
#pragma unroll
                    for (int n = 0; n < 2; ++n) acc[a][b][m][n] = (f32x4){0.f, 0.f, 0.f, 0.f};
        cur = nxt; cA = nA; cB = nB; ++ui;
        if constexpr (ALIGN_EPI) { if (wr == 1) PG8_BAR; }
    }
    PG8_WAIT_V(0);
    if constexpr (!ALIGN_EPI) { if (wr == 0) PG8_BAR; }
    PG8_BAR;
#undef PG8_SA
#undef PG8_SB
#undef PG8_STAGE
#undef PG8_LDA
#undef PG8_LDB
#undef PG8_MMA
#undef PG8_WAIT_V
#undef PG8_WAIT_L
#undef PG8_BAR
#undef PG8_SCHED
#undef PG8_UPTR
}

struct EpiProj {
    static constexpr bool PERM = true;
    bf16 *q, *k, *vT, *p;
    __device__ __forceinline__ void operator()(const f32x4 (&acc)[2][2][4][2], const Unit& u, int wr, int wc, int fr, int fq) const {
        const int row0 = u.pm * BM + wr * 64 + fr;
        const int pn = u.pn;
#pragma unroll
        for (int ai = 0; ai < 2; ++ai)
#pragma unroll
            for (int m = 0; m < 4; ++m) {
                const int row = row0 + ai * HALF + m * 16;
#pragma unroll
                for (int bj = 0; bj < 2; ++bj) {
                    f32x4 v0 = acc[ai][bj][m][0], v1 = acc[ai][bj][m][1];
                    const int col = pn * BM + bj * HALF + wc * 32 + 8 * fq;
                    if (pn >= 4 && pn < 6) {
                        const int cv = col - 1024, hh = cv >> 6, dim = cv & 63, b = row / T, t = row % T;
                        bf16* dst = vT + ((size_t)((b * NH + hh) * HD + dim)) * T + t;
                        const unsigned w0 = cvt_pk_bf16(v0[0], v0[1]), w1 = cvt_pk_bf16(v0[2], v0[3]), w2 = cvt_pk_bf16(v1[0], v1[1]), w3 = cvt_pk_bf16(v1[2], v1[3]);
                        dst[0 * (size_t)T] = (bf16)(w0 & 0xffff); dst[1 * (size_t)T] = (bf16)(w0 >> 16); dst[2 * (size_t)T] = (bf16)(w1 & 0xffff); dst[3 * (size_t)T] = (bf16)(w1 >> 16);
                        dst[4 * (size_t)T] = (bf16)(w2 & 0xffff); dst[5 * (size_t)T] = (bf16)(w2 >> 16); dst[6 * (size_t)T] = (bf16)(w3 & 0xffff); dst[7 * (size_t)T] = (bf16)(w3 >> 16);
                    } else {
                        bf16* dst;
                        if (pn < 2) { v0 = v0 * 0.125f; v1 = v1 * 0.125f; dst = q + (size_t)row * CW + col; }
                        else if (pn < 4) dst = k + (size_t)row * CW + (col - 512);
                        else dst = p + (size_t)row * PW + (col - 1536);
                        u32x4 w; w.x = cvt_pk_bf16(v0[0], v0[1]); w.y = cvt_pk_bf16(v0[2], v0[3]); w.z = cvt_pk_bf16(v1[0], v1[1]); w.w = cvt_pk_bf16(v1[2], v1[3]);
                        *(u32x4*)dst = w;
                    }
                }
            }
    }
};
struct EpiWo {
    static constexpr bool PERM = false;
    const float* x; float* h;
    __device__ __forceinline__ void operator()(const f32x4 (&acc)[2][2][4][2], const Unit& u, int wr, int wc, int fr, int fq) const {
        const int row0 = u.pm * BM + wr * 64 + fr, col0 = u.pn * BM + wc * 32 + 4 * fq;
#pragma unroll
        for (int ai = 0; ai < 2; ++ai)
#pragma unroll
            for (int m = 0; m < 4; ++m) { const size_t off = (size_t)(row0 + ai * HALF + m * 16) * D + col0;
#pragma unroll
                for (int bj = 0; bj < 2; ++bj)
#pragma unroll
                    for (int n = 0; n < 2; ++n) { const f32x4 xv = *(const f32x4*)(x + off + bj * HALF + n * 16); *(f32x4*)(h + off + bj * HALF + n * 16) = acc[ai][bj][m][n] + xv; } }
    }
};
struct EpiUp {
    static constexpr bool PERM = true;
    const float* b_up; bf16* act;
    __device__ __forceinline__ void operator()(const f32x4 (&acc)[2][2][4][2], const Unit& u, int wr, int wc, int fr, int fq) const {
        const int row0 = u.pm * BM + wr * 64 + fr, ch = u.pn * 128 + wc * 32 + 8 * fq;
        const float* bg = b_up + (size_t)u.e * 2048 + ch; const float* bl = bg + 1024;
        const f32x4 bg0 = *(const f32x4*)bg, bg1 = *(const f32x4*)(bg + 4), bl0 = *(const f32x4*)bl, bl1 = *(const f32x4*)(bl + 4);
#pragma unroll
        for (int ai = 0; ai < 2; ++ai)
#pragma unroll
            for (int m = 0; m < 4; ++m) {
                float o[8];
#pragma unroll
                for (int n = 0; n < 2; ++n) { const f32x4 gv = acc[ai][0][m][n] + (n ? bg1 : bg0), lv = acc[ai][1][m][n] + (n ? bl1 : bl0);
#pragma unroll
                    for (int j = 0; j < 4; ++j) { const float gt = fminf(gv[j], 7.0f), li = fminf(fmaxf(lv[j], -7.0f), 7.0f); o[n * 4 + j] = (li + 1.0f) * gt * sigmoidf_(1.702f * gt); } }
                *(u32x4*)(act + (size_t)(row0 + ai * HALF + m * 16) * DE + ch) = pack8(o);
            }
    }
};
struct EpiDown {
    static constexpr bool PERM = true;
    const float* b_dn; bf16* y;
    __device__ __forceinline__ void operator()(const f32x4 (&acc)[2][2][4][2], const Unit& u, int wr, int wc, int fr, int fq) const {
        const int row0 = u.pm * BM + wr * 64 + fr, col0 = u.pn * BM + wc * 32 + 8 * fq;
        const float* bb = b_dn + (size_t)u.e * D + col0;
        f32x4 bv[2][2];
#pragma unroll
        for (int bj = 0; bj < 2; ++bj)
#pragma unroll
            for (int n = 0; n < 2; ++n) bv[bj][n] = *(const f32x4*)(bb + bj * HALF + 4 * n);
#pragma unroll
        for (int ai = 0; ai < 2; ++ai)
#pragma unroll
            for (int m = 0; m < 4; ++m) { bf16* rowp = y + (size_t)(row0 + ai * HALF + m * 16) * D + col0;
#pragma unroll
                for (int bj = 0; bj < 2; ++bj) { const f32x4 v0 = acc[ai][bj][m][0] + bv[bj][0], v1 = acc[ai][bj][m][1] + bv[bj][1];
                    u32x4 w; w.x = cvt_pk_bf16(v0[0], v0[1]); w.y = cvt_pk_bf16(v0[2], v0[3]); w.z = cvt_pk_bf16(v1[0], v1[1]); w.w = cvt_pk_bf16(v1[2], v1[3]);
                    *(u32x4*)(rowp + bj * HALF) = w; } }
    }
};
}


#define XB_TMO      128
#define XB_XCNT(j)  (256  + 64 * (j))
#define XB_XSUB(j)  (1280 + 64 * (j))
#define XB_XGEN(j)  (2304 + 64 * (j))
#define XB_TOP      3328
#define XB_TOPGEN   3392
#define XCD_BAR_WORDS 3456
#define XB_SPIN_CAP (1u << 20)
__device__ __forceinline__ unsigned xb_ld(unsigned* p)              { return __hip_atomic_load(p, __ATOMIC_RELAXED, __HIP_MEMORY_SCOPE_AGENT); }
__device__ __forceinline__ unsigned xb_add(unsigned* p, unsigned v) { return __hip_atomic_fetch_add(p, v, __ATOMIC_RELAXED, __HIP_MEMORY_SCOPE_AGENT); }
__device__ __forceinline__ unsigned xb_xcc_id() { return (unsigned)__builtin_amdgcn_s_getreg((3 << 11) | 20) & 0xFu; }
#define XB_SPIN(cond, bar) do { unsigned _sp = 0; while (cond) { __builtin_amdgcn_s_sleep(1); \
    if ((++_sp & 255u) == 0u) { if (xb_ld(&(bar)[XB_TMO])) break; if (_sp > XB_SPIN_CAP) { atomicAdd(&(bar)[XB_TMO], 1u); break; } } } } while (0)
struct XcdBarrier { unsigned* bar; unsigned x; volatile LAS unsigned* st; };
__device__ __forceinline__ XcdBarrier xcd_barrier_post(unsigned* bar, volatile LAS unsigned* st) {
    XcdBarrier b; b.bar = bar; b.x = xb_xcc_id(); b.st = st;
    if (threadIdx.x == 0) (void)xb_add(&bar[XB_XCNT(b.x)], 1u);
    return b;
}
__device__ __forceinline__ void xcd_barrier_complete(unsigned* bar, unsigned x, unsigned& nloc, unsigned& nx) {
    const unsigned G = gridDim.x * gridDim.y * gridDim.z;
    unsigned sum, cnt, mine, sp = 0u;
    for (;;) {
        sum = 0u; cnt = 0u; mine = 0u;
#pragma unroll
        for (unsigned j = 0; j < 16; ++j) { const unsigned c = xb_ld(&bar[XB_XCNT(j)]); sum += c; cnt += (c > 0u) ? 1u : 0u; mine = (j == x) ? c : mine; }
        if (sum == G) break;
        __builtin_amdgcn_s_sleep(1);
        if ((++sp & 255u) == 0u) { if (xb_ld(&bar[XB_TMO])) break; if (sp > XB_SPIN_CAP) { atomicAdd(&bar[XB_TMO], 1u); break; } }
    }
    nloc = mine > 0u ? mine : 1u; nx = cnt > 0u ? cnt : 1u;
}
__device__ __forceinline__ void xcd_barrier(const XcdBarrier& b) {
    asm volatile("s_waitcnt vmcnt(0)" ::: "memory");
    __syncthreads();
    if (threadIdx.x == 0) {
        unsigned* bar = b.bar;
        __builtin_amdgcn_s_waitcnt(0);
        unsigned nloc = b.st[0], nx = b.st[1];
        if (nloc == 0u) { xcd_barrier_complete(bar, b.x, nloc, nx); b.st[0] = nloc; b.st[1] = nx; }
        const unsigned old = xb_add(&bar[XB_XSUB(b.x)], 1u);
        const unsigned gen = old / nloc;
        if (old + 1u == (gen + 1u) * nloc) {
            __builtin_amdgcn_fence(__ATOMIC_RELEASE, "agent");
            asm volatile("s_waitcnt vmcnt(0)" ::: "memory");
            const unsigned og = xb_add(&bar[XB_TOP], 1u);
            const unsigned tg = og / nx;
            if (og + 1u == (tg + 1u) * nx) xb_add(&bar[XB_TOPGEN], 1u);
            else XB_SPIN(xb_ld(&bar[XB_TOPGEN]) == tg, bar);
            __builtin_amdgcn_fence(__ATOMIC_ACQUIRE, "agent");
            xb_add(&bar[XB_XGEN(b.x)], 1u);
            asm volatile("s_waitcnt vmcnt(0)" ::: "memory");
        } else {
            XB_SPIN(xb_ld(&bar[XB_XGEN(b.x)]) == gen, bar);
            __builtin_amdgcn_fence(__ATOMIC_ACQUIRE, "agent");
            asm volatile("s_waitcnt vmcnt(0)" ::: "memory");
        }
    }
    __syncthreads();
}

struct Args { const float* in[26]; float* out; unsigned char* ws; int ph_lo, ph_hi; };

struct Frame { LAS unsigned char* lds; int tid, lane, wave, G, vcu; };

__device__ __forceinline__ void transpose_item(const float* W, int K, int N, bf16* WT, int k0, int n0, int orow0, LAS float* scr, int lane) {
#pragma unroll 8
    for (int i = 0; i < 32; ++i) { const int kk = 2 * i + (lane >> 5); scr[kk * 33 + (lane & 31)] = W[(size_t)(k0 + kk) * N + n0 + (lane & 31)]; }
    asm volatile("s_waitcnt lgkmcnt(0)" ::: "memory");
    const int c = lane & 7;
#pragma unroll
    for (int j = 0; j < 4; ++j) { const int n = (lane >> 3) + 8 * j; const LAS float* s = scr + (8 * c) * 33 + n;
        u32x4 o; o.x = cvt_pk_bf16(s[0 * 33], s[1 * 33]); o.y = cvt_pk_bf16(s[2 * 33], s[3 * 33]); o.z = cvt_pk_bf16(s[4 * 33], s[5 * 33]); o.w = cvt_pk_bf16(s[6 * 33], s[7 * 33]);
        *(u32x4*)(WT + (size_t)(orow0 + n) * K + k0 + 8 * c) = o; }
    asm volatile("s_waitcnt lgkmcnt(0)" ::: "memory");
}

__device__ __forceinline__ void p0_prologue(const Frame& F, const Args& a) {
    unsigned char* ws = a.ws;
    LAS float* scr = (LAS float*)(F.lds + F.wave * 8448);
    const int gw = F.vcu * 8 + F.wave, NGW = F.G * 8;
    constexpr int I_IN = 16 * 108, I_O = 16 * 32, I_UP = 32 * 16 * 64, I_DN = 32 * 16 * 32, I_L = 16, I_G = 32;
    constexpr int NITEMS = I_IN + I_O + I_UP + I_DN + 2 * I_L + 2 * I_L + I_G;
    for (int it = gw; it < NITEMS; it += NGW) {
        int r = it;
        if (r < I_UP) {
            const int e = r / 1024, q = r % 1024, kb = q / 64, nb = q % 64, n0 = nb * 32;
            const int orow0 = n0 < 1024 ? 256 * (n0 >> 7) + (n0 & 127) : 256 * ((n0 - 1024) >> 7) + 128 + ((n0 - 1024) & 127);
            transpose_item(a.in[21] + (size_t)e * 1024 * 2048, 1024, 2048, (bf16*)(ws + WS_WUPT) + (size_t)e * 2048 * 1024, kb * 64, n0, orow0, scr, F.lane); continue; }
        r -= I_UP;
        if (r < I_DN) { const int e = r / 512, q = r % 512, kb = q / 32, nb = q % 32;
            transpose_item(a.in[23] + (size_t)e * 1024 * 1024, 1024, 1024, (bf16*)(ws + WS_WDNT) + (size_t)e * 1024 * 1024, kb * 64, nb * 32, nb * 32, scr, F.lane); continue; }
        r -= I_DN;
        if (r < I_IN) { const int kb = r / 108, nb = r % 108; transpose_item(a.in[2], 1024, NPROJ, (bf16*)(ws + WS_WINT), kb * 64, nb * 32, nb * 32, scr, F.lane); continue; }
        r -= I_IN;
        if (r < I_O) { const int kb = r / 32, nb = r % 32; transpose_item(a.in[17], 1024, 1024, (bf16*)(ws + WS_WOT), kb * 64, nb * 32, nb * 32, scr, F.lane); continue; }
        r -= I_O;
        if (r < 2 * I_L) { const int z = r / 16, nb = r % 16; transpose_item(a.in[8] + (size_t)z * 64 * 512, 64, 512, (bf16*)(ws + WS_W2T) + (size_t)z * 512 * 64, 0, nb * 32, nb * 32, scr, F.lane); continue; }
        r -= 2 * I_L;
        if (r < 2 * I_L) { const int z = r / 16, nb = r % 16; transpose_item(a.in[10] + (size_t)z * 64 * 512, 64, 512, (bf16*)(ws + WS_A2T) + (size_t)z * 512 * 64, 0, nb * 32, nb * 32, scr, F.lane); continue; }
        r -= 2 * I_L;
        { const int kb = r / 16, nb = r % 16; transpose_item(a.in[11], 128, 512, (bf16*)(ws + WS_G2T), kb * 64, nb * 32, nb * 32, scr, F.lane); }
    }
    { u32x4* z = (u32x4*)(ws + WS_WINT + (size_t)NPROJ * 1024 * 2); const u32x4 zero = {0u, 0u, 0u, 0u};
      for (int i = F.vcu * 512 + F.tid; i < 16384; i += F.G * 512) z[i] = zero; }
    const float* x = a.in[0]; const float* nw = a.in[1]; bf16* hn = (bf16*)(ws + WS_HN);
    f32x4 wv[4];
#pragma unroll
    for (int j = 0; j < 4; ++j) wv[j] = *((const f32x4*)nw + F.lane + 64 * j);
    for (int m = gw; m < M; m += NGW) {
        const f32x4* xr = (const f32x4*)(x + (size_t)m * D) + F.lane;
        f32x4 v[4]; float s = 0.f;
#pragma unroll
        for (int j = 0; j < 4; ++j) { v[j] = xr[64 * j]; s += (v[j].x * v[j].x + v[j].y * v[j].y) + (v[j].z * v[j].z + v[j].w * v[j].w); }
        const float rs = rsqrtf(wave_sum(s) * (1.f / D) + RMS_EPS);
        u32x2* o8 = (u32x2*)(hn + (size_t)m * D) + F.lane;
#pragma unroll
        for (int j = 0; j < 4; ++j) { u32x2 o; o.x = cvt_pk_bf16(v[j].x * rs * wv[j].x, v[j].y * rs * wv[j].y); o.y = cvt_pk_bf16(v[j].z * rs * wv[j].z, v[j].w * rs * wv[j].w); o8[64 * j] = o; }
    }
}

constexpr int PREP_KBUF = 0, PREP_INV = 65536, PREP_AW = 67584, PREP_AA = PREP_AW + 17408, PREP_AG = PREP_AA + 17408, PREP_LD = 136;
template <bool STORE>
__device__ __forceinline__ void prep_phase(const Frame& F, const Args& a) {
    unsigned char* ws = a.ws;
    const bf16* p = (const bf16*)(ws + WS_P);
    bf16* r_out = (bf16*)(ws + WS_R); bf16* v_out = (bf16*)(ws + WS_V); bf16* kk_out = (bf16*)(ws + WS_KK);
    bf16* decay_out = (bf16*)(ws + WS_DECAY); bf16* kdir_out = (bf16*)(ws + WS_KDIR); bf16* akk_out = (bf16*)(ws + WS_AKK); bf16* g_out = (bf16*)(ws + WS_G);
    const bf16* w2T = (const bf16*)(ws + WS_W2T); const bf16* a2T = (const bf16*)(ws + WS_A2T); const bf16* g2T = (const bf16*)(ws + WS_G2T);
    const float* mu_p = a.in[5]; const float* mu_n = a.in[6]; const float* w0 = a.in[7]; const float* a0 = a.in[9];
    const float* k_k = a.in[12]; const float* k_a = a.in[13];
    LAS bf16* kbuf = (LAS bf16*)(F.lds + PREP_KBUF); LAS float* invb = (LAS float*)(F.lds + PREP_INV);
    LAS bf16* Aw = (LAS bf16*)(F.lds + PREP_AW); LAS bf16* Aa = (LAS bf16*)(F.lds + PREP_AA); LAS bf16* Ag = (LAS bf16*)(F.lds + PREP_AG);
    const int lane = F.lane, wave = F.wave, fr = lane & 15, fg = lane >> 4;
    for (int tile = F.vcu; tile < M / 64; tile += F.G) {
        const int m0 = tile * 64;
#pragma unroll 1
        for (int jj = 0; jj < 4; ++jj) {
            const int q = lane + 64 * jj; const bool valid = q < 240; const int c0 = 8 * q;
            float mp[8], mn[8];
#pragma unroll
            for (int i = 0; i < 8; ++i) { mp[i] = valid ? mu_p[c0 + i] : 0.f; mn[i] = valid ? mu_n[c0 + i] : 0.f; }
            const int mfirst = m0 + wave * 8;
            const u32x4 zero = {0u, 0u, 0u, 0u};
            u32x4 rows[10];
#pragma unroll
            for (int rI = 0; rI < 10; ++rI) { const int mr = mfirst - 1 + rI;
                const bool ok = valid && !(rI == 0 && (mfirst % T) == 0) && !(rI == 9 && ((mfirst + 7) % T) == T - 1);
                rows[rI] = ok ? *(const u32x4*)(p + (size_t)mr * PW + c0) : zero; }
#pragma unroll
            for (int i = 0; i < 8; ++i) {
                const int m = mfirst + i, it = wave * 8 + i;
                const u32x4 prev = rows[i], cur = rows[i + 1], nxt = rows[i + 2];
                float fp[8], fc[8], fn[8], s[8];
                unpack8(prev, fp); unpack8(cur, fc); unpack8(nxt, fn);
#pragma unroll
                for (int e = 0; e < 8; ++e) s[e] = fc[e] + mp[e] * (fp[e] - fc[e]) + mn[e] * (fn[e] - fc[e]);
                if (jj == 0) { if (STORE) { *(u32x4*)(r_out + (size_t)m * CW + c0) = pack8(s); } }
                else if (jj == 1) {
                    const int c = c0 - 512;
                    *(LAS u32x4*)(kbuf + it * 512 + c) = pack8(s);
                    float kr[8]; float ss = 0.f;
#pragma unroll
                    for (int e = 0; e < 8; ++e) { kr[e] = s[e] * k_k[c + e]; ss += kr[e] * kr[e]; }
                    ss += __shfl_xor(ss, 1); ss += __shfl_xor(ss, 2); ss += __shfl_xor(ss, 4);
                    const float inv = fminf(__builtin_amdgcn_rsqf(ss), 1e12f);
#pragma unroll
                    for (int e = 0; e < 8; ++e) kr[e] *= inv;
                    if (STORE) { *(u32x4*)(kk_out + (size_t)m * CW + c) = pack8(kr); }
                    if ((lane & 7) == 0) invb[it * 8 + (lane >> 3)] = inv;
                }
                else if (jj == 2) { if (STORE) { *(u32x4*)(v_out + (size_t)m * CW + (c0 - 1024)) = pack8(s); } }
                else if (valid) {
                    const int seg = lane >> 4, cw = 8 * (lane & 15);
                    if (seg == 0) {
#pragma unroll
                        for (int e = 0; e < 8; ++e) s[e] = 1.0f - 2.0f * __builtin_amdgcn_rcpf(__expf(2.0f * s[e]) + 1.0f);
                        *(LAS u32x4*)(Aw + it * PREP_LD + cw) = pack8(s);
                    } else if (seg == 1) { *(LAS u32x4*)(Aa + it * PREP_LD + cw) = pack8(s); }
                    else {
#pragma unroll
                        for (int e = 0; e < 8; ++e) s[e] = sigmoidf_(s[e]);
                        *(LAS u32x4*)(Ag + it * PREP_LD + cw) = pack8(s);
                    }
                }
            }
        }
        __syncthreads();
        const int nb = 64 * wave;
#pragma unroll 1
        for (int job = 0; job < 5; ++job) {
            const int z = job & 1;
            const bf16* WT = job < 2 ? w2T + (size_t)z * 512 * 64 : (job < 4 ? a2T + (size_t)z * 512 * 64 : g2T);
            const LAS bf16* Ax = job < 2 ? Aw + z * 64 : (job < 4 ? Aa + z * 64 : Ag);
            const int kw = job < 4 ? 64 : 128, nks = kw / 32;
            f32x4 acc[4][4];
#pragma unroll
            for (int mt = 0; mt < 4; ++mt)
#pragma unroll
                for (int nt = 0; nt < 4; ++nt) acc[mt][nt] = (f32x4){0.f, 0.f, 0.f, 0.f};
#pragma unroll 1
            for (int ks = 0; ks < nks; ++ks) {
                bf16x8 af[4], wf[4];
#pragma unroll
                for (int mt = 0; mt < 4; ++mt) af[mt] = *(const LAS bf16x8*)(Ax + (16 * mt + fr) * PREP_LD + 32 * ks + 8 * fg);
#pragma unroll
                for (int nt = 0; nt < 4; ++nt) wf[nt] = *(const bf16x8*)(WT + (size_t)(nb + 16 * nt + fr) * kw + 32 * ks + 8 * fg);
#pragma unroll
                for (int mt = 0; mt < 4; ++mt)
#pragma unroll
                    for (int nt = 0; nt < 4; ++nt) acc[mt][nt] = __builtin_amdgcn_mfma_f32_16x16x32_bf16(wf[nt], af[mt], acc[mt][nt], 0, 0, 0);
            }
#pragma unroll
            for (int mt = 0; mt < 4; ++mt) {
                const int it = 16 * mt + fr; const size_t m = (size_t)(m0 + it);
#pragma unroll
                for (int nt = 0; nt < 4; ++nt) {
                    const int n = nb + 16 * nt + 4 * fg;
                    const f32x4 v = acc[mt][nt];
                    if (job < 2) {
                        const f32x4 b = *(const f32x4*)(w0 + z * 512 + n);
                        float o[4];
#pragma unroll
                        for (int i = 0; i < 4; ++i) o[i] = __expf(-0.60653066f * sigmoidf_(v[i] + b[i]));
                        u32x2 w; w.x = cvt_pk_bf16(o[0], o[1]); w.y = cvt_pk_bf16(o[2], o[3]);
                        if (STORE) { *(u32x2*)(decay_out + ((size_t)z * M + m) * CW + n) = w; }
                    } else if (job < 4) {
                        const f32x4 b = *(const f32x4*)(a0 + z * 512 + n), kkc = *(const f32x4*)(k_k + n), kac = *(const f32x4*)(k_a + n);
                        const u32x2 kb = *(const LAS u32x2*)(kbuf + it * 512 + n);
                        const float kv[4] = {bflo(kb.x), bfhi(kb.x), bflo(kb.y), bfhi(kb.y)};
                        const float inv = invb[it * 8 + wave];
                        float kd[4], ak[4];
#pragma unroll
                        for (int i = 0; i < 4; ++i) { const float av = sigmoidf_(v[i] + b[i]); kd[i] = kv[i] * (1.0f + (av - 1.0f) * kac[i]); ak[i] = av * (kv[i] * kkc[i] * inv); }
                        u32x2 w; w.x = cvt_pk_bf16(kd[0], kd[1]); w.y = cvt_pk_bf16(kd[2], kd[3]);
                        if (STORE) { *(u32x2*)(kdir_out + ((size_t)z * M + m) * CW + n) = w; }
                        w.x = cvt_pk_bf16(ak[0], ak[1]); w.y = cvt_pk_bf16(ak[2], ak[3]);
                        if (STORE) { *(u32x2*)(akk_out + ((size_t)z * M + m) * CW + n) = w; }
                    } else {
                        u32x2 w; w.x = cvt_pk_bf16(v[0], v[1]); w.y = cvt_pk_bf16(v[2], v[3]);
                        if (STORE) { *(u32x2*)(g_out + m * CW + n) = w; }
                    }
                }
            }
        }
        __syncthreads();
    }
}

__device__ __forceinline__ void attn_phase(const Frame& F, const Args& a) {
    unsigned char* ws = a.ws;
    const bf16* q = (const bf16*)(ws + WS_Q); const bf16* k = (const bf16*)(ws + WS_K); const bf16* vT = (const bf16*)(ws + WS_VT);
    bf16* att = (bf16*)(ws + WS_ATT);
    LAS float* bias = (LAS float*)F.lds;
    for (int i = F.tid; i < 8 * 15 * 31; i += 512) bias[i] = a.in[3][i];
    __syncthreads();
    const int lane = F.lane, fr = lane & 15, fg = lane >> 4;
    const int NGW = F.G * 8, gw = F.vcu * 8 + F.wave;
    const int per = (16384 + NGW - 1) / NGW;
    for (int task = gw * per; task < (gw + 1) * per && task < 16384; ++task) {
        const int cgp = task & 3, r = (task >> 2) & 127, h = (task >> 9) & 7, b = task >> 12;
        const int c0 = 16 * cgp, wsc = min(max(c0 - 8, 0), 32), rs = min(max(r - 4, 0), GROWS - 8);
        const int c = c0 + fr, cs = min(max(c - 8, 0), 48);
        const size_t tq = (size_t)b * T + r * 64 + c;
        bf16x8 qf[2];
#pragma unroll
        for (int ks = 0; ks < 2; ++ks) qf[ks] = *(const bf16x8*)(q + tq * CW + h * 64 + 32 * ks + 8 * fg);
        f32x4 sc[16];
        const int kcol_a = wsc + 8 * (fr >> 2) + (fr & 3);
#pragma unroll
        for (int u = 0; u < 8; ++u)
#pragma unroll
            for (int par = 0; par < 2; ++par) {
                const size_t tk = (size_t)b * T + (rs + u) * 64 + kcol_a + 4 * par;
                const bf16x8 k0 = *(const bf16x8*)(k + tk * CW + h * 64 + 8 * fg), k1 = *(const bf16x8*)(k + tk * CW + h * 64 + 32 + 8 * fg);
                f32x4 s = {0.f, 0.f, 0.f, 0.f};
                s = __builtin_amdgcn_mfma_f32_16x16x32_bf16(k0, qf[0], s, 0, 0, 0);
                s = __builtin_amdgcn_mfma_f32_16x16x32_bf16(k1, qf[1], s, 0, 0, 0);
                sc[2 * u + par] = s;
            }
        float mx = -1e30f;
#pragma unroll
        for (int u = 0; u < 8; ++u) {
            const int dr = rs + u - r + 7;
#pragma unroll
            for (int par = 0; par < 2; ++par)
#pragma unroll
                for (int i = 0; i < 4; ++i) {
                    const int kc = wsc + 8 * fg + 4 * par + i; const bool ok = (kc >= cs) && (kc < cs + 16);
                    const int dc = min(max(kc - c + 15, 0), 30);
                    const float s = ok ? sc[2 * u + par][i] + bias[(h * 15 + dr) * 31 + dc] : -1e30f;
                    sc[2 * u + par][i] = s; mx = fmaxf(mx, s);
                }
        }
        mx = fmaxf(mx, __shfl_xor(mx, 16)); mx = fmaxf(mx, __shfl_xor(mx, 32));
        float sum = 0.f;
#pragma unroll
        for (int t = 0; t < 16; ++t)
#pragma unroll
            for (int i = 0; i < 4; ++i) { const float pv = sc[t][i] > -1e29f ? __expf(sc[t][i] - mx) : 0.f; sc[t][i] = pv; sum += pv; }
        sum += __shfl_xor(sum, 16); sum += __shfl_xor(sum, 32);
        const float inv = 1.0f / sum;
        f32x4 o[4];
#pragma unroll
        for (int nt = 0; nt < 4; ++nt) o[nt] = (f32x4){0.f, 0.f, 0.f, 0.f};
#pragma unroll
        for (int u = 0; u < 8; ++u) {
            union { u32x4 w; bf16x8 h8; } pf;
            pf.w.x = cvt_pk_bf16(sc[2 * u][0], sc[2 * u][1]); pf.w.y = cvt_pk_bf16(sc[2 * u][2], sc[2 * u][3]);
            pf.w.z = cvt_pk_bf16(sc[2 * u + 1][0], sc[2 * u + 1][1]); pf.w.w = cvt_pk_bf16(sc[2 * u + 1][2], sc[2 * u + 1][3]);
            const size_t tv = (size_t)(rs + u) * 64 + wsc + 8 * fg;
#pragma unroll
            for (int nt = 0; nt < 4; ++nt) {
                const bf16x8 vf = *(const bf16x8*)(vT + ((size_t)((b * NH + h) * HD + 16 * nt + fr)) * T + tv);
                o[nt] = __builtin_amdgcn_mfma_f32_16x16x32_bf16(vf, pf.h8, o[nt], 0, 0, 0);
            }
        }
#pragma unroll
        for (int nt = 0; nt < 4; ++nt) { u32x2 w; w.x = cvt_pk_bf16(o[nt][0] * inv, o[nt][1] * inv); w.y = cvt_pk_bf16(o[nt][2] * inv, o[nt][3] * inv);
            *(u32x2*)(att + tq * CW + h * 64 + 16 * nt + 4 * fg) = w; }
    }
    __syncthreads();
}

constexpr int SC_TC = 32, SC_REC = 1344, SC_STAGE = SC_TC * SC_REC  , SC_YB = SC_TC * 1024, SC_YOFF = 2 * SC_STAGE  ;
__device__ __forceinline__ float row16_sum(float v) {
    v += __builtin_bit_cast(float, __builtin_amdgcn_update_dpp(0, __builtin_bit_cast(int, v), 0xB1, 0xF, 0xF, true));
    v += __builtin_bit_cast(float, __builtin_amdgcn_update_dpp(0, __builtin_bit_cast(int, v), 0x4E, 0xF, 0xF, true));
    v += __builtin_bit_cast(float, __builtin_amdgcn_update_dpp(0, __builtin_bit_cast(int, v), 0x141, 0xF, 0xF, true));
    v += __builtin_bit_cast(float, __builtin_amdgcn_update_dpp(0, __builtin_bit_cast(int, v), 0x140, 0xF, 0xF, true));
    return v;
}
__device__ __forceinline__ void scan_phase(const Frame& F, const Args& a) {
    unsigned char* ws = a.ws;
    const int seq = F.vcu >> 2, rg = F.vcu & 3;
    if (seq >= 64) return;
    const int z = seq >> 5, b = (seq >> 3) & 3, h = seq & 7;
    const bf16* vsrc = (const bf16*)(ws + WS_V);
    float* yout = (float*)(ws + WS_Y) + (size_t)z * M * CW;
    const size_t mb = (size_t)b * T;
    const int lane = F.lane, wave = F.wave;
    constexpr int NCH = T / SC_TC;
    if (wave >= 4) {
        const int u = F.tid - 256;
        const bf16* gp[5]; int ldo[5];
        const long tstep = z ? -(long)CW : (long)CW;
#pragma unroll
        for (int j = 0; j < 5; ++j) { const int piece = u + 256 * j, tau = piece / 40, w = piece % 40, arr = w >> 3, part = w & 7;
            const bf16* base = arr == 0 ? (const bf16*)(ws + WS_KK) : arr == 1 ? (const bf16*)(ws + WS_DECAY) + (size_t)z * M * CW : arr == 2 ? (const bf16*)(ws + WS_AKK) + (size_t)z * M * CW
                             : arr == 3 ? (const bf16*)(ws + WS_KDIR) + (size_t)z * M * CW : (const bf16*)(ws + WS_R);
            const int t0 = z ? (T - 1 - tau) : tau;
            gp[j] = base + (mb + t0) * CW + h * 64 + part * 8; ldo[j] = tau * SC_REC + w * 32; }
        const int vtau = (u & 63) >> 1, vpart = u & 1;
        const bf16* gv = vsrc + (mb + (z ? (T - 1 - vtau) : vtau)) * CW + h * 64 + rg * 16 + vpart * 8;
        const int ldv = vtau * SC_REC + 1280 + vpart * 32;
        u32x4 reg0, reg1, reg2, reg3, reg4, regv = {0u, 0u, 0u, 0u};
#define SC_LOAD(c) do { const long adv = (long)(c) * SC_TC * tstep; reg0 = *(const u32x4*)(gp[0] + adv); reg1 = *(const u32x4*)(gp[1] + adv); reg2 = *(const u32x4*)(gp[2] + adv); \
            reg3 = *(const u32x4*)(gp[3] + adv); reg4 = *(const u32x4*)(gp[4] + adv); if (u < 64) regv = *(const u32x4*)(gv + adv); } while (0)
#define SC_W1(rg_, off_) do { float f_[8]; unpack8(rg_, f_); LAS f32x4* d_ = (LAS f32x4*)(st_ + (off_)); d_[0] = (f32x4){f_[0], f_[1], f_[2], f_[3]}; d_[1] = (f32x4){f_[4], f_[5], f_[6], f_[7]}; } while (0)
#define SC_WRITE(buf) do { LAS unsigned char* st_ = F.lds + (buf) * SC_STAGE; SC_W1(reg0, ldo[0]); SC_W1(reg1, ldo[1]); SC_W1(reg2, ldo[2]); SC_W1(reg3, ldo[3]); SC_W1(reg4, ldo[4]); \
            if (u < 64) SC_W1(regv, ldv); } while (0)
#define SC_YRED(c) do { const LAS unsigned char* yb_ = F.lds + SC_YOFF + ((c) & 1) * SC_YB; _Pragma("unroll") for (int j = 0; j < 2; ++j) { const int o_ = u + 256 * j, tau_ = o_ >> 4, row_ = o_ & 15; \
            const LAS f32x4* s_ = (const LAS f32x4*)(yb_ + tau_ * 1024 + row_ * 64); const f32x4 s0 = s_[0], s1 = s_[1], s2 = s_[2], s3 = s_[3]; \
            const float tot_ = (((s0.x + s0.y) + (s0.z + s0.w)) + ((s1.x + s1.y) + (s1.z + s1.w))) + (((s2.x + s2.y) + (s2.z + s2.w)) + ((s3.x + s3.y) + (s3.z + s3.w))); \
            const int n_ = (c) * SC_TC + tau_, t_ = z ? (T - 1 - n_) : n_; yout[(mb + t_) * CW + h * 64 + rg * 16 + row_] = tot_; } } while (0)
        SC_LOAD(0); SC_WRITE(0); SC_LOAD(1);
        __syncthreads();
#pragma unroll 1
        for (int c = 0; c < NCH; ++c) {
            if (c + 1 < NCH) SC_WRITE((c + 1) & 1);
            if (c + 2 < NCH) SC_LOAD(c + 2);
            if (c >= 1) SC_YRED(c - 1);
            __syncthreads();
        }
        SC_YRED(NCH - 1);
#undef SC_LOAD
#undef SC_W1
#undef SC_WRITE
#undef SC_YRED
    } else {
        const int cg4 = lane & 15, row = wave * 4 + (lane >> 4);
        f32x2 S01 = {0.f, 0.f}, S23 = {0.f, 0.f};
        __syncthreads();
#pragma unroll 1
        for (int c = 0; c < NCH; ++c) {
            const LAS unsigned char* st = F.lds + (c & 1) * SC_STAGE + cg4 * 16;
            const LAS unsigned char* sv = F.lds + (c & 1) * SC_STAGE + 1280 + row * 4;
            LAS float* yb = (LAS float*)(F.lds + SC_YOFF + (c & 1) * SC_YB) + wave * 64 + lane;
            f32x4 Rkk[3], Rw[3], Rak[3], Rk[3], Rr[3]; float Rv[3];
#define SC_LDSTEP(t_, s_) do { Rkk[s_] = *(const LAS f32x4*)(st + (t_) * SC_REC); Rw[s_] = *(const LAS f32x4*)(st + (t_) * SC_REC + 256); Rak[s_] = *(const LAS f32x4*)(st + (t_) * SC_REC + 512); \
                Rk[s_] = *(const LAS f32x4*)(st + (t_) * SC_REC + 768); Rr[s_] = *(const LAS f32x4*)(st + (t_) * SC_REC + 1024); Rv[s_] = *(const LAS float*)(sv + (t_) * SC_REC); } while (0)
            SC_LDSTEP(0, 0); SC_LDSTEP(1, 1);
#pragma unroll
            for (int tau = 0; tau < SC_TC; ++tau) {
                const int sx = tau % 3;
                if (tau + 2 < SC_TC) { const int sn = (tau + 2) % 3; SC_LDSTEP(tau + 2, sn); }
                const f32x2 kk01 = {Rkk[sx].x, Rkk[sx].y}, kk23 = {Rkk[sx].z, Rkk[sx].w};
                f32x2 pd = S01 * kk01; pd = __builtin_elementwise_fma(S23, kk23, pd);
                const float sa = row16_sum(pd.x + pd.y);
                const f32x2 vv = {Rv[sx], Rv[sx]}, nsa = {-sa, -sa};
                const f32x2 w01 = {Rw[sx].x, Rw[sx].y}, w23 = {Rw[sx].z, Rw[sx].w}, k01 = {Rk[sx].x, Rk[sx].y}, k23 = {Rk[sx].z, Rk[sx].w};
                const f32x2 a01 = {Rak[sx].x, Rak[sx].y}, a23 = {Rak[sx].z, Rak[sx].w}, r01 = {Rr[sx].x, Rr[sx].y}, r23 = {Rr[sx].z, Rr[sx].w};
                f32x2 t01 = __builtin_elementwise_fma(S01, w01, k01 * vv), t23 = __builtin_elementwise_fma(S23, w23, k23 * vv);
                S01 = __builtin_elementwise_fma(a01, nsa, t01); S23 = __builtin_elementwise_fma(a23, nsa, t23);
                f32x2 yr = S01 * r01; yr = __builtin_elementwise_fma(S23, r23, yr);
                yb[tau * 256] = yr.x + yr.y;
            }
#undef SC_LDSTEP
            __syncthreads();
        }
    }
    __syncthreads();
}

__device__ __forceinline__ void combine_phase(const Frame& F, const Args& a) {
    unsigned char* ws = a.ws;
    const bf16* att = (const bf16*)(ws + WS_ATT); const bf16* rr = (const bf16*)(ws + WS_R); const bf16* vv = (const bf16*)(ws + WS_V);
    const bf16* kd = (const bf16*)(ws + WS_KDIR); const bf16* gg = (const bf16*)(ws + WS_G); const float* y = (const float*)(ws + WS_Y);
    bf16* mix = (bf16*)(ws + WS_MIX);
    const float* anw = a.in[4]; const float* r_k = a.in[14]; const float* ln_w = a.in[15]; const float* ln_b = a.in[16];
    const int lane = F.lane, c0 = 8 * lane;
    float nw[8], rk[8], lw[8], lb[8];
#pragma unroll
    for (int i = 0; i < 8; ++i) { nw[i] = anw[c0 + i]; rk[i] = r_k[c0 + i]; lw[i] = ln_w[c0 + i]; lb[i] = ln_b[c0 + i]; }
    const int gw = F.vcu * 8 + F.wave, NGW = F.G * 8;
#pragma unroll 2
    for (int m = gw; m < M; m += NGW) {
        const size_t o = (size_t)m * CW + c0;
        float f[8];
        unpack8(*(const u32x4*)(att + o), f);
        float ss = 0.f;
#pragma unroll
        for (int i = 0; i < 8; ++i) ss += f[i] * f[i];
        const float rs = rsqrtf(wave_sum(ss) * (1.f / CW) + RMS_EPS);
#pragma unroll
        for (int i = 0; i < 8; ++i) f[i] = f[i] * rs * nw[i];
        *(u32x4*)(mix + (size_t)m * D + c0) = pack8(f);
        const f32x4 y0a = *(const f32x4*)(y + o), y0b = *(const f32x4*)(y + o + 4), y1a = *(const f32x4*)(y + (size_t)M * CW + o), y1b = *(const f32x4*)(y + (size_t)M * CW + o + 4);
        float yv[8] = {y0a.x + y1a.x, y0a.y + y1a.y, y0a.z + y1a.z, y0a.w + y1a.w, y0b.x + y1b.x, y0b.y + y1b.y, y0b.z + y1b.z, y0b.w + y1b.w};
        float s1 = 0.f;
#pragma unroll
        for (int i = 0; i < 8; ++i) s1 += yv[i];
        s1 += __shfl_xor(s1, 1); s1 += __shfl_xor(s1, 2); s1 += __shfl_xor(s1, 4);
        const float mean = s1 * (1.f / 64.f);
        float s2 = 0.f;
#pragma unroll
        for (int i = 0; i < 8; ++i) { yv[i] -= mean; s2 += yv[i] * yv[i]; }
        s2 += __shfl_xor(s2, 1); s2 += __shfl_xor(s2, 2); s2 += __shfl_xor(s2, 4);
        const float rstd = rsqrtf(s2 * (1.f / 64.f) + GN_EPS);
        float rf[8], k0[8], k1[8], vf[8], gf[8];
        unpack8(*(const u32x4*)(rr + o), rf); unpack8(*(const u32x4*)(kd + o), k0); unpack8(*(const u32x4*)(kd + (size_t)M * CW + o), k1);
        unpack8(*(const u32x4*)(vv + o), vf); unpack8(*(const u32x4*)(gg + o), gf);
        float cf = 0.f;
#pragma unroll
        for (int i = 0; i < 8; ++i) cf += rf[i] * (k0[i] + k1[i]) * rk[i];
        cf += __shfl_xor(cf, 1); cf += __shfl_xor(cf, 2); cf += __shfl_xor(cf, 4);
#pragma unroll
        for (int i = 0; i < 8; ++i) f[i] = (yv[i] * rstd * lw[i] + lb[i] + cf * vf[i]) * gf[i];
        *(u32x4*)(mix + (size_t)m * D + CW + c0) = pack8(f);
    }
}

constexpr int RT_W = 0, RT_HIST = 131072, RT_LOG = 131072 + 256;
__device__ __forceinline__ void router_phase(const Frame& F, const Args& a) {
    unsigned char* ws = a.ws;
    const float* hbuf = (const float*)(ws + WS_H); bf16* hn2 = (bf16*)(ws + WS_HN2);
    int* eidx = (int*)(ws + WS_EIDX); float* gate = (float*)(ws + WS_GATE); int* rank = (int*)(ws + WS_RANK);
    unsigned* ctl = (unsigned*)(ws + WS_CTL);
    const float* n2w = a.in[18]; const float* rw = a.in[19]; const float* rb = a.in[20];
    LAS float* wT = (LAS float*)(F.lds + RT_W); LAS int* hist = (LAS int*)(F.lds + RT_HIST); LAS float* lg = (LAS float*)(F.lds + RT_LOG) + F.wave * 64; LAS int* eL = (LAS int*)(F.lds + RT_LOG + 2048);
    { f32x4 tmp[16];
#pragma unroll
      for (int j = 0; j < 16; ++j) tmp[j] = *((const f32x4*)rw + F.tid + 512 * j);
#pragma unroll
      for (int j = 0; j < 16; ++j) { const int q = F.tid + 512 * j, d = q >> 3, e0 = 4 * (q & 7);
          wT[(e0 + 0) * 1024 + d] = tmp[j].x; wT[(e0 + 1) * 1024 + d] = tmp[j].y; wT[(e0 + 2) * 1024 + d] = tmp[j].z; wT[(e0 + 3) * 1024 + d] = tmp[j].w; } }
    if (F.tid < 32) hist[F.tid] = 0;
    __syncthreads();
    const int lane = F.lane;
    f32x4 wn[4];
#pragma unroll
    for (int j = 0; j < 4; ++j) wn[j] = *((const f32x4*)n2w + lane + 64 * j);
    const int blk = F.vcu;
    for (int pr = 0; pr < 8; ++pr) {
        const int m0 = blk * 128 + F.wave * 16 + pr * 2;
        f32x4 xv[2][4];
#pragma unroll
        for (int tk = 0; tk < 2; ++tk) {
            const f32x4* hr = (const f32x4*)(hbuf + (size_t)(m0 + tk) * D) + lane;
            float s = 0.f;
#pragma unroll
            for (int j = 0; j < 4; ++j) { xv[tk][j] = hr[64 * j]; s += (xv[tk][j].x * xv[tk][j].x + xv[tk][j].y * xv[tk][j].y) + (xv[tk][j].z * xv[tk][j].z + xv[tk][j].w * xv[tk][j].w); }
            const float rs = rsqrtf(wave_sum(s) * (1.f / D) + RMS_EPS);
            u32x2* o8 = (u32x2*)(hn2 + (size_t)(m0 + tk) * D) + lane;
#pragma unroll
            for (int j = 0; j < 4; ++j) { xv[tk][j] = xv[tk][j] * rs * wn[j]; u32x2 o; o.x = cvt_pk_bf16(xv[tk][j].x, xv[tk][j].y); o.y = cvt_pk_bf16(xv[tk][j].z, xv[tk][j].w); o8[64 * j] = o; }
        }
        float kA0 = 0.f, kB0 = 0.f, kA1 = 0.f, kB1 = 0.f;
#pragma unroll 4
        for (int e = 0; e < 32; ++e) {
            float p0 = 0.f, p1 = 0.f;
#pragma unroll
            for (int j = 0; j < 4; ++j) { const f32x4 w4 = *(const LAS f32x4*)(wT + e * 1024 + 256 * j + 4 * lane);
                p0 += (w4.x * xv[0][j].x + w4.y * xv[0][j].y) + (w4.z * xv[0][j].z + w4.w * xv[0][j].w);
                p1 += (w4.x * xv[1][j].x + w4.y * xv[1][j].y) + (w4.z * xv[1][j].z + w4.w * xv[1][j].w); }
            p0 = row16_sum(p0); p1 = row16_sum(p1);
            const bool me = (lane & 15) == (e & 15);
            if (e < 16) { kA0 = me ? p0 : kA0; kA1 = me ? p1 : kA1; } else { kB0 = me ? p0 : kB0; kB1 = me ? p1 : kB1; }
        }
        kA0 += __shfl_xor(kA0, 16); kA0 += __shfl_xor(kA0, 32); kB0 += __shfl_xor(kB0, 16); kB0 += __shfl_xor(kB0, 32);
        kA1 += __shfl_xor(kA1, 16); kA1 += __shfl_xor(kA1, 32); kB1 += __shfl_xor(kB1, 16); kB1 += __shfl_xor(kB1, 32);
        if (lane < 32) { const int tk = lane >> 4, el = lane & 15; lg[tk * 32 + el] = (tk ? kA1 : kA0) + rb[el]; lg[tk * 32 + 16 + el] = (tk ? kB1 : kB0) + rb[16 + el]; }
        asm volatile("s_waitcnt lgkmcnt(0)" ::: "memory");
        if (lane < 2) {
            const LAS float* L = lg + lane * 32; const int m = m0 + lane;
            float v[32];
#pragma unroll
            for (int e = 0; e < 32; ++e) v[e] = L[e];
            float tv[4]; int ti[4];
#pragma unroll
            for (int kx = 0; kx < 4; ++kx) { float best = -3.0e38f; int bi = 0;
#pragma unroll
                for (int e = 0; e < 32; ++e) { if (v[e] > best) { best = v[e]; bi = e; } }
                tv[kx] = best; ti[kx] = bi;
#pragma unroll
                for (int e = 0; e < 32; ++e) { if (e == bi) v[e] = -3.0e38f; } }
            const float e0 = 1.0f, e1 = __expf(tv[1] - tv[0]), e2 = __expf(tv[2] - tv[0]), e3 = __expf(tv[3] - tv[0]);
            const float is = 1.0f / (e0 + e1 + e2 + e3);
            const float gs[4] = {e0 * is, e1 * is, e2 * is, e3 * is};
#pragma unroll
            for (int kx = 0; kx < 4; ++kx) { eidx[m * 4 + kx] = ti[kx]; gate[m * 4 + kx] = gs[kx]; eL[(m - blk * 128) * 4 + kx] = ti[kx]; }
        }
        asm volatile("s_waitcnt lgkmcnt(0)" ::: "memory");
    }
    __syncthreads();
    { const int t = F.tid, e = eL[t]; int rk = 0;
      for (int u = 0; u < t; ++u) rk += (eL[u] == e) ? 1 : 0;
      rank[(blk * 128) * 4 + t] = rk;
      __hip_atomic_fetch_add(&hist[e], 1, __ATOMIC_RELAXED, __HIP_MEMORY_SCOPE_WORKGROUP); }
    __syncthreads();
    if (F.tid < 32) ctl[CW_CNT + blk * 32 + F.tid] = (unsigned)hist[F.tid];
}

__device__ __forceinline__ void dispatch_phase(const Frame& F, const Args& a) {
    unsigned char* ws = a.ws;
    unsigned* ctl = (unsigned*)(ws + WS_CTL);
    const int* eidx = (const int*)(ws + WS_EIDX); const int* rank = (const int*)(ws + WS_RANK); int* dest = (int*)(ws + WS_DEST);
    const bf16* hn2 = (const bf16*)(ws + WS_HN2); bf16* xbuf = (bf16*)(ws + WS_XBUF);
    LAS int* part = (LAS int*)F.lds;
    LAS int* tot = part + 1024;
    const int blk = F.vcu, G = F.G;
    { const int e = F.tid & 31, pt = F.tid >> 5; int s = 0, sb = 0;
      if (G == 256) { int cv[16];
#pragma unroll
          for (int q = 0; q < 16; ++q) cv[q] = (int)ld_u32_agent(ctl + CW_CNT + (pt + 16 * q) * 32 + e);
#pragma unroll
          for (int q = 0; q < 16; ++q) { s += cv[q]; if (pt + 16 * q < blk) sb += cv[q]; } }
      else for (int bb = pt; bb < G; bb += 16) { const int cval = (int)ld_u32_agent(ctl + CW_CNT + bb * 32 + e); s += cval; if (bb < blk) sb += cval; }
      part[pt * 32 + e] = s; part[512 + pt * 32 + e] = sb; }
    __syncthreads();
    if (F.tid < 32) { int s = 0, sb = 0;
        for (int pt = 0; pt < 16; ++pt) { s += part[pt * 32 + F.tid]; sb += part[512 + pt * 32 + F.tid]; }
        tot[F.tid] = s; tot[32 + F.tid] = sb; tot[96 + F.tid] = (s + 255) & ~255; }
    __syncthreads();
    if (F.tid == 0) { int ps = 0; for (int e = 0; e < 32; ++e) { tot[64 + e] = ps; ps += tot[96 + e]; }
        tot[128] = ps >> 8; }
    __syncthreads();
    if (blk == 0) {
        if (F.tid == 0) ctl[CW_NT] = (unsigned)tot[128];
        for (int e = F.tid >> 4; e < 32; e += 32) { const int t0 = tot[64 + e] >> 8, nt = tot[96 + e] >> 8; for (int i = F.tid & 15; i < nt; i += 16) ctl[CW_TEXP + t0 + i] = (unsigned)e; }
    }
    const int lane = F.lane;
    const int mw = blk * 128 + F.wave * 16;
    int dl;
    { const int e = eidx[mw * 4 + lane]; dl = tot[64 + e] + tot[32 + e] + rank[mw * 4 + lane]; dest[mw * 4 + lane] = dl; }
#pragma unroll 2
    for (int i = 0; i < 16; ++i) {
        const u32x4* srow = (const u32x4*)(hn2 + (size_t)(mw + i) * D);
        const u32x4 v0 = srow[lane], v1 = srow[64 + lane];
#pragma unroll
        for (int kx = 0; kx < 4; ++kx) {
            const int d = __shfl(dl, 4 * i + kx);
            u32x4* drow = (u32x4*)(xbuf + (size_t)d * D);
            drow[lane] = v0; drow[64 + lane] = v1;
        }
    }
    { const int e = blk & 31, pt = blk >> 5, np = G >> 5; const int r0 = tot[64 + e] + tot[e], r1 = tot[64 + e] + tot[96 + e]; const u32x4 zero = {0u, 0u, 0u, 0u};
      if (np > 0) for (int r = r0 + pt * 8 + F.wave; r < r1; r += np * 8) { u32x4* drow = (u32x4*)(xbuf + (size_t)r * D); drow[lane] = zero; drow[64 + lane] = zero; } }
}

__device__ __forceinline__ void final_phase(const Frame& F, const Args& a) {
    unsigned char* ws = a.ws;
    const float* hbuf = (const float*)(ws + WS_H); const bf16* ybuf = (const bf16*)(ws + WS_YBUF);
    const int* dest = (const int*)(ws + WS_DEST); const float* gate = (const float*)(ws + WS_GATE);
    const float* fw = a.in[25]; float* out = a.out;
    const int lane = F.lane;
    f32x4 wn[4];
#pragma unroll
    for (int j = 0; j < 4; ++j) wn[j] = *((const f32x4*)fw + lane + 64 * j);
    const int gw = F.vcu * 8 + F.wave, NGW = F.G * 8;
    const int per = M / NGW;
    const int mw = gw * per;
    int dl = 0; float gl = 0.f;
    if (lane < 4 * per && per <= 16) { dl = dest[mw * 4 + lane]; gl = gate[mw * 4 + lane]; }
#pragma unroll 2
    for (int i = 0; i < per; ++i) {
        const int m = mw + i;
        const f32x4* hr = (const f32x4*)(hbuf + (size_t)m * D) + lane;
        f32x4 v[4];
#pragma unroll
        for (int j = 0; j < 4; ++j) v[j] = hr[64 * j];
#pragma unroll
        for (int kx = 0; kx < 4; ++kx) {
            const int d = per <= 16 ? __shfl(dl, 4 * i + kx) : dest[m * 4 + kx]; const float gt = per <= 16 ? __shfl(gl, 4 * i + kx) : gate[m * 4 + kx];
            const u32x2* yr = (const u32x2*)(ybuf + (size_t)d * D) + lane;
#pragma unroll
            for (int j = 0; j < 4; ++j) { const u32x2 w = yr[64 * j]; v[j].x += gt * bflo(w.x); v[j].y += gt * bfhi(w.x); v[j].z += gt * bflo(w.y); v[j].w += gt * bfhi(w.y); }
        }
        float s = 0.f;
#pragma unroll
        for (int j = 0; j < 4; ++j) s += (v[j].x * v[j].x + v[j].y * v[j].y) + (v[j].z * v[j].z + v[j].w * v[j].w);
        const float rs = rsqrtf(wave_sum(s) * (1.f / D) + RMS_EPS);
        f32x4* orow = (f32x4*)(out + (size_t)m * D) + lane;
#pragma unroll
        for (int j = 0; j < 4; ++j) orow[64 * j] = v[j] * rs * wn[j];
    }
}

__global__ void __launch_bounds__(512, 2) fwd_megakernel(Args args) {
    extern __shared__ __attribute__((aligned(16))) unsigned char lds_raw[];
    Frame F;
    F.lds = (LAS unsigned char*)lds_raw;
    F.tid = threadIdx.x; F.lane = F.tid & 63; F.wave = __builtin_amdgcn_readfirstlane(F.tid >> 6);
    F.G = gridDim.x; { const int bx = blockIdx.x; F.vcu = (F.G % 8 == 0) ? (bx % 8) * (F.G / 8) + bx / 8 : bx; }
    unsigned char* ws = args.ws;
    const int lo = args.ph_lo, hi = args.ph_hi;
#define IN(k) (lo <= (k) && (k) < hi)
#if MK_SPLIT
#define SEAM(k) do { } while (0)
#else
    cg::grid_group grid = cg::this_grid();
    { volatile LAS unsigned* st = (volatile LAS unsigned*)(F.lds + LDS_MISC); if (F.tid < 2) st[F.tid] = 0u; __syncthreads(); }
    const XcdBarrier xbar = xcd_barrier_post((unsigned*)(ws + WS_CTL) + CW_BAR, (volatile LAS unsigned*)(F.lds + LDS_MISC));
    if (lo < 0) grid.sync();
#define SEAM(k) do { if (IN(k) && IN((k) + 1)) xcd_barrier(xbar); } while (0)
#endif
#define REP2(k) if constexpr (((MK_REPEAT >> (k)) & 1) != 0)
#define PH1 { pg8::Gemm g{(const bf16*)(ws + WS_HN), (const bf16*)(ws + WS_WINT), 1024, nullptr, 0}; \
        pg8::StaticOrder S; S.init(M / 256, NPROJ_PAD / 256, F.G, (int)blockIdx.x); \
        pg8::EpiProj E{(bf16*)(ws + WS_Q), (bf16*)(ws + WS_K), (bf16*)(ws + WS_VT), (bf16*)(ws + WS_P)}; \
        pg8::gemm_phase<pg8::EpiProj, true, true>(F.lds, g, S, E); }
#define PH5 { pg8::Gemm g{(const bf16*)(ws + WS_MIX), (const bf16*)(ws + WS_WOT), 1024, nullptr, 0}; \
        pg8::StaticOrder S; S.init(M / 256, D / 256, F.G, (int)blockIdx.x); \
        pg8::EpiWo E{args.in[0], (float*)(ws + WS_H)}; \
        pg8::gemm_phase<pg8::EpiWo, true, true>(F.lds, g, S, E); }
#define PH8 { const unsigned* ctl = (const unsigned*)(ws + WS_CTL); const int ntile = (int)ld_u32_agent(ctl + CW_NT); \
        pg8::Gemm g{(const bf16*)(ws + WS_XBUF), (const bf16*)(ws + WS_WUPT), 1024, ctl + CW_TEXP, (size_t)2048 * 1024 * 2}; \
        pg8::StaticOrder S; S.init(ntile, 8, F.G, (int)blockIdx.x); \
        pg8::EpiUp E{args.in[22], (bf16*)(ws + WS_ACT)}; \
        pg8::gemm_phase<pg8::EpiUp, true, true>(F.lds, g, S, E); }
#define PH9 { const unsigned* ctl = (const unsigned*)(ws + WS_CTL); const int ntile = (int)ld_u32_agent(ctl + CW_NT); \
        pg8::Gemm g{(const bf16*)(ws + WS_ACT), (const bf16*)(ws + WS_WDNT), 1024, ctl + CW_TEXP, (size_t)1024 * 1024 * 2}; \
        pg8::StaticOrder S; S.init(ntile, 4, F.G, (int)blockIdx.x); \
        pg8::EpiDown E{args.in[24], (bf16*)(ws + WS_YBUF)}; \
        pg8::gemm_phase<pg8::EpiDown, true, true>(F.lds, g, S, E); }
    if (IN(0)) { p0_prologue(F, args); REP2(0) p0_prologue(F, args); }
    SEAM(0);
    if (IN(1)) { PH1 REP2(1) PH1 }
    SEAM(1);
    if (IN(2)) { prep_phase<true>(F, args); REP2(2) prep_phase<true>(F, args); attn_phase(F, args); REP2(11) attn_phase(F, args); }
    SEAM(2);
    if (IN(3)) { scan_phase(F, args); REP2(3) scan_phase(F, args); }
    SEAM(3);
    if (IN(4)) { combine_phase(F, args); REP2(4) combine_phase(F, args); }
    SEAM(4);
    if (IN(5)) { PH5 REP2(5) PH5 }
    SEAM(5);
    if (IN(6)) { router_phase(F, args); REP2(6) { __syncthreads(); router_phase(F, args); } }
    SEAM(6);
    if (IN(7)) { dispatch_phase(F, args); REP2(7) { __syncthreads(); dispatch_phase(F, args); } }
    SEAM(7);
    if (IN(8)) { PH8 REP2(8) PH8 }
    SEAM(8);
    if (IN(9)) { PH9 REP2(9) PH9 }
    SEAM(9);
    if (IN(10)) { final_phase(F, args); REP2(10) final_phase(F, args); }
#undef IN
#undef SEAM
}

extern "C" void kernel_launch(void* const* d_in, const int* in_sizes, int n_in, void* d_out, int out_size, void* d_ws, size_t ws_size, hipStream_t stream) {
    static int grid = 0;
    if (grid == 0) {
        if (n_in != 26 || in_sizes[0] != M * D || out_size != M * D || ws_size < WS_END) { fprintf(stderr, "kernel_launch: unexpected problem (n_in %d, in0 %d, out %d, ws %zu)\n", n_in, n_in > 0 ? in_sizes[0] : -1, out_size, ws_size); grid = -1; return; }
        int dev = 0, cus = 0, per_cu = 0;
        if (hipGetDevice(&dev) != hipSuccess || hipDeviceGetAttribute(&cus, hipDeviceAttributeMultiprocessorCount, dev) != hipSuccess) { grid = -1; return; }
        if (hipFuncSetAttribute((const void*)fwd_megakernel, hipFuncAttributeMaxDynamicSharedMemorySize, LDS_BYTES) != hipSuccess) { fprintf(stderr, "kernel_launch: hipFuncSetAttribute failed\n"); grid = -1; return; }
        if (hipOccupancyMaxActiveBlocksPerMultiprocessor(&per_cu, (const void*)fwd_megakernel, 512, LDS_BYTES) != hipSuccess || per_cu < 1) { fprintf(stderr, "kernel_launch: occupancy query says %d\n", per_cu); per_cu = 1; }
        (void)hipGetLastError();
        grid = cus * 1;
        if (grid != 256) fprintf(stderr, "kernel_launch: note: %d CUs\n", cus);
    }
    if (grid < 0) return;
    if (hipMemsetAsync((char*)d_ws + WS_CTL + (size_t)CW_BAR * 4, 0, XCD_BAR_WORDS * 4, stream) != hipSuccess) { fprintf(stderr, "kernel_launch: memset failed\n"); return; }
    Args a{};
    for (int i = 0; i < 26; ++i) a.in[i] = (const float*)d_in[i];
    a.out = (float*)d_out; a.ws = (unsigned char*)d_ws;
#if MK_SPLIT
    for (int ph = 0; ph < NPHASE; ++ph) { a.ph_lo = ph; a.ph_hi = ph + 1; hipLaunchKernelGGL(fwd_megakernel, dim3(grid), dim3(512), LDS_BYTES, stream, a); }
#else
    a.ph_lo = 0; a.ph_hi = NPHASE;
    void* kargs[] = {&a};
    hipError_t e = hipLaunchCooperativeKernel((const void*)fwd_megakernel, dim3(grid), dim3(512), kargs, LDS_BYTES, stream);
    if (e != hipSuccess) fprintf(stderr, "kernel_launch: cooperative launch failed: %s (grid %d)\n", hipGetErrorString(e), grid);
#endif
}
```

```cpp
#include <hip/hip_runtime.h>
#include <hip/hip_cooperative_groups.h>
#include <cstdio>
#include <cstdint>
namespace cg = cooperative_groups;

#ifndef MK_SPLIT
#define MK_SPLIT 0
#endif

#ifndef MK_REPEAT
#define MK_REPEAT 0
#endif
#define LAS __attribute__((address_space(3)))
typedef unsigned short bf16;
typedef float f32x4 __attribute__((ext_vector_type(4)));
typedef float f32x2 __attribute__((ext_vector_type(2)));
typedef unsigned u32x4 __attribute__((ext_vector_type(4)));
typedef unsigned u32x2 __attribute__((ext_vector_type(2)));
typedef short bf16x8 __attribute__((ext_vector_type(8)));

constexpr int BATCH = 4, T = 8192, D = 1024, M = BATCH * T;
constexpr int NH = 8, HD = 64, CW = 512;
constexpr int SHIFT_W = 1920, NPROJ = 3456, NPROJ_PAD = 3584, PW = 2048;
constexpr int NE = 32, TOPK = 4, DE = 1024;
constexpr int GRIDW = 64, GROWS = 128;
constexpr int P_TILES_MAX = 544, P_ROWS = P_TILES_MAX * 256;
constexpr float RMS_EPS = 1e-5f, GN_EPS = 64e-5f;
constexpr int NPHASE = 11;

constexpr size_t MiB = 1u << 20;
constexpr size_t WS_CTL = 0;
constexpr size_t WS_W2T = 1 * MiB, WS_A2T = WS_W2T + 131072, WS_G2T = WS_A2T + 131072;
constexpr size_t WS_WINT = 2 * MiB, WS_WOT = 9 * MiB, WS_WUPT = 12 * MiB, WS_WDNT = 140 * MiB;
constexpr size_t WS_EIDX = 204 * MiB, WS_GATE = WS_EIDX + 524288, WS_RANK = WS_GATE + 524288, WS_DEST = WS_RANK + 524288;
constexpr size_t WS_R = 208 * MiB, WS_V = 240 * MiB, WS_KK = 272 * MiB, WS_DECAY = 304 * MiB, WS_KDIR = 368 * MiB, WS_AKK = 432 * MiB,
                 WS_G = 496 * MiB, WS_ATT = 528 * MiB;
constexpr size_t WS_Q = 560 * MiB, WS_K = 592 * MiB, WS_VT = 624 * MiB, WS_P = 656 * MiB, WS_HN = 784 * MiB, WS_Y = 848 * MiB;
constexpr size_t WS_MIX = 560 * MiB, WS_H = 752 * MiB, WS_HN2 = 880 * MiB, WS_XBUF = 208 * MiB, WS_ACT = 480 * MiB, WS_YBUF = 208 * MiB;
constexpr size_t WS_END = 976 * MiB;
constexpr int CW_NT = 0, CW_TEXP = 64, CW_CNT = 1024, CW_BAR = 16384;

constexpr int LDS_BYTES = 159744, LDS_MISC = LDS_BYTES - 256;

typedef __bf16 bf16x2_t __attribute__((ext_vector_type(2)));
__device__ __forceinline__ unsigned cvt_pk_bf16(float lo, float hi) { const f32x2 v = {lo, hi}; return __builtin_bit_cast(unsigned, __builtin_convertvector(v, bf16x2_t)); }
__device__ __forceinline__ float bflo(unsigned u) { return __uint_as_float(u << 16); }
__device__ __forceinline__ float bfhi(unsigned u) { return __uint_as_float(u & 0xffff0000u); }
__device__ __forceinline__ float bf1(bf16 v) { return __uint_as_float(((unsigned)v) << 16); }
__device__ __forceinline__ void unpack8(const u32x4 u, float* f) { f[0] = bflo(u.x); f[1] = bfhi(u.x); f[2] = bflo(u.y); f[3] = bfhi(u.y); f[4] = bflo(u.z); f[5] = bfhi(u.z); f[6] = bflo(u.w); f[7] = bfhi(u.w); }
__device__ __forceinline__ u32x4 pack8(const float* f) { u32x4 o; o.x = cvt_pk_bf16(f[0], f[1]); o.y = cvt_pk_bf16(f[2], f[3]); o.z = cvt_pk_bf16(f[4], f[5]); o.w = cvt_pk_bf16(f[6], f[7]); return o; }
__device__ __forceinline__ float wave_sum(float v) {
#pragma unroll
    for (int o = 1; o < 64; o <<= 1) v += __shfl_xor(v, o);
    return v;
}
__device__ __forceinline__ float sigmoidf_(float x) { return __builtin_amdgcn_rcpf(1.0f + __expf(-x)); }
__device__ __forceinline__ unsigned ld_u32_agent(const unsigned* p) { return __hip_atomic_load(p, __ATOMIC_RELAXED, __HIP_MEMORY_SCOPE_AGENT); }

namespace pg8 {
constexpr int BM = 256, BK = 64, HALF = 128, HTB = HALF * BK * 2, STAGE_BYTES = 8 * HTB, NXCD = 8, WGM = 8;
__host__ __device__ __forceinline__ int lds_byte(int r, int c) { const int st = (r >> 4) * 2 + (c >> 5), rr = r & 15, cc = c & 31, ob = rr * 64 + cc * 2; return st * 1024 + (ob ^ (((ob >> 9) & 1) << 5)); }
__host__ __device__ __forceinline__ void stage_rc(int b, int& R, int& C) { const int st = b / 1024, sb = b % 1024, swz = sb ^ (((sb >> 9) & 1) << 5); R = (st >> 1) * 16 + swz / 64; C = (st & 1) * 32 + (swz % 64) / 2; }
__host__ __device__ __forceinline__ int perm32(int rho) { const int n = rho >> 4, i = rho & 15; return 8 * (i >> 2) + 4 * n + (i & 3); }

struct Unit { int pm, pn, e; };
struct Gemm { const bf16* A; const bf16* Bt; int K; const unsigned* texp; size_t bstride; };

struct StaticOrder {
    int nM, nN, nwg, G, c;
    __device__ void init(int nM_, int nN_, int G_, int c_) { nM = nM_; nN = nN_; nwg = nM * nN; G = G_; c = c_; }
    __device__ bool next(int i, Unit& u) const {
        const long L = (long)i * G + c; if (L >= nwg) return false;
        int wgid = (int)L; { const int q = nwg / NXCD, r = nwg % NXCD, xcd = wgid % NXCD, off = wgid / NXCD; wgid = (xcd < r ? xcd * (q + 1) : r * (q + 1) + (xcd - r) * q) + off; }
        const int nig = WGM * nN, gid = wgid / nig, fm = gid * WGM, gsz = (nM - fm) < WGM ? (nM - fm) : WGM;
        u.pm = fm + ((wgid % nig) % gsz); u.pn = (wgid % nig) / gsz; u.e = 0; return true;
    }
};

template <class Epi, bool ALIGN_EPI, bool SP2>
__device__ __forceinline__ void gemm_phase(LAS unsigned char* lds, const Gemm g, const StaticOrder& S, const Epi& E) {
    const int tid = threadIdx.x, wid = __builtin_amdgcn_readfirstlane(tid >> 6), lane = tid & 63, wr = wid >> 2, wc = wid & 3, fr = lane & 15, fq = lane >> 4;
    const int K = g.K, nt = K / BK;
    unsigned voffA[2], voffB[2];
#pragma unroll
    for (int i = 0; i < 2; ++i) { int R, C; stage_rc(tid * 16 + i * 8192, R, C); const int Rb = Epi::PERM ? ((R & ~31) + perm32(R & 31)) : R;
        voffA[i] = (unsigned)(R * K + C) * 2u; voffB[i] = (unsigned)(Rb * K + C) * 2u; }
    const size_t kstep = (size_t)(BK * 2);
    const size_t hstep = (size_t)HALF * K * 2;
    const size_t tstep = 2 * hstep;
    const unsigned ldsw = (unsigned)wid * 1024u;
    const int aoff = lds_byte(wr * 64 + fr, fq * 8), boff = lds_byte(wc * 32 + fr, fq * 8);
#define PG8_SA(b, h) (((b) * 2 + (h)) * HTB)
#define PG8_SB(b, h) ((4 + (b) * 2 + (h)) * HTB)
#define PG8_STAGE(bufoff, gbase, voff) do { _Pragma("unroll") for (int _i = 0; _i < 2; ++_i) \
        __builtin_amdgcn_global_load_lds((const unsigned*)((const char*)(gbase) + (voff)[_i]), (LAS unsigned*)(lds + (bufoff) + ldsw + _i * 8192), 16, 0, 0); } while (0)
#define PG8_LDA(dst, b, h) do { _Pragma("unroll") for (int m = 0; m < 4; ++m) _Pragma("unroll") for (int k = 0; k < 2; ++k) dst[m][k] = *(const LAS bf16x8*)(lds + PG8_SA(b, h) + aoff + m * 2048 + k * 1024); } while (0)
#define PG8_LDB(dst, b, h) do { _Pragma("unroll") for (int n = 0; n < 2; ++n) _Pragma("unroll") for (int k = 0; k < 2; ++k) dst[n][k] = *(const LAS bf16x8*)(lds + PG8_SB(b, h) + boff + n * 2048 + k * 1024); } while (0)
#define PG8_MMA(ai, bj, At, Bt) do { __builtin_amdgcn_s_setprio(1); _Pragma("unroll") for (int m = 0; m < 4; ++m) _Pragma("unroll") for (int n = 0; n < 2; ++n) _Pragma("unroll") for (int k = 0; k < 2; ++k) \
        acc[ai][bj][m][n] = __builtin_amdgcn_mfma_f32_16x16x32_bf16(Bt[n][k], At[m][k], acc[ai][bj][m][n], 0, 0, 0); __builtin_amdgcn_s_setprio(0); } while (0)
#define PG8_WAIT_V(n) asm volatile("s_waitcnt vmcnt(" #n ")" ::: "memory")
#define PG8_WAIT_L(n) asm volatile("s_waitcnt lgkmcnt(" #n ")" ::: "memory")
#define PG8_BAR __builtin_amdgcn_s_barrier()
#define PG8_SCHED __builtin_amdgcn_sched_barrier(0)
#define PG8_UPTR(u, pa, pb) do { unsigned _e = g.texp ? ld_u32_agent(g.texp + (u).pm) : 0u; _e = (unsigned)__builtin_amdgcn_readfirstlane((int)_e); (u).e = (int)_e; \
        pa = (const char*)g.A + (size_t)(u).pm * tstep; pb = (const char*)g.Bt + (size_t)_e * g.bstride + (size_t)(u).pn * tstep; } while (0)
    Unit cur, nxt; int ui = 0;
    if (!S.next(0, cur)) return;
    f32x4 acc[2][2][4][2];
#pragma unroll
    for (int a = 0; a < 2; ++a)
#pragma unroll
        for (int b = 0; b < 2; ++b)
#pragma unroll
            for (int m = 0; m < 4; ++m)
#pragma unroll
                for (int n = 0; n < 2; ++n) acc[a][b][m][n] = (f32x4){0.f, 0.f, 0.f, 0.f};
    bf16x8 At[4][2], B0[2][2], B1[2][2];
    const char* cA; const char* cB;
    PG8_UPTR(cur, cA, cB);
    if constexpr (SP2) {
        PG8_STAGE(PG8_SB(0, 0), cB, voffB); PG8_STAGE(PG8_SB(0, 1), cB + hstep, voffB); PG8_STAGE(PG8_SA(0, 0), cA, voffA); PG8_STAGE(PG8_SA(0, 1), cA + hstep, voffA);
        if (wr == 1) PG8_BAR;
        PG8_WAIT_V(2); PG8_BAR;
        PG8_STAGE(PG8_SB(1, 0), cB + kstep, voffB); PG8_STAGE(PG8_SA(1, 0), cA + kstep, voffA); PG8_STAGE(PG8_SB(1, 1), cB + hstep + kstep, voffB);
        PG8_WAIT_V(6); PG8_BAR;
    } else {
        PG8_STAGE(PG8_SB(0, 0), cB, voffB); PG8_STAGE(PG8_SA(0, 0), cA, voffA); PG8_STAGE(PG8_SB(0, 1), cB + hstep, voffB); PG8_STAGE(PG8_SA(0, 1), cA + hstep, voffA);
        if (wr == 1) PG8_BAR;
        PG8_WAIT_V(4); PG8_BAR;
        PG8_STAGE(PG8_SB(1, 0), cB + kstep, voffB); PG8_STAGE(PG8_SA(1, 0), cA + kstep, voffA); PG8_STAGE(PG8_SB(1, 1), cB + hstep + kstep, voffB);
        PG8_WAIT_V(6); PG8_BAR;
    }
    for (;;) {
        const bool has_next = S.next(ui + 1, nxt);
        const char* nA = cA; const char* nB = cB;
        if (has_next) PG8_UPTR(nxt, nA, nB);
        for (int t = 0; t < nt; t += 2) {
            const bool last = (t == nt - 2);
            const char* a1 = cA + (size_t)(t + 1) * kstep;
            const char* a2 = last ? nA : cA + (size_t)(t + 2) * kstep; const char* b2 = last ? nB : cB + (size_t)(t + 2) * kstep;
            const char* a3 = a2 + kstep; const char* b3 = b2 + kstep;
            if constexpr (SP2) {
            PG8_LDB(B0, 0, 0); PG8_LDB(B1, 0, 1); PG8_SCHED; PG8_LDA(At, 0, 0); PG8_STAGE(PG8_SA(1, 1), a1 + hstep, voffA);
            PG8_WAIT_V(8); PG8_WAIT_L(0); PG8_BAR; PG8_MMA(0, 0, At, B0); PG8_MMA(0, 1, At, B1); PG8_BAR; PG8_SCHED;
            PG8_LDA(At, 0, 1); PG8_STAGE(PG8_SB(0, 0), b2, voffB); PG8_STAGE(PG8_SB(0, 1), b2 + hstep, voffB); PG8_STAGE(PG8_SA(0, 0), a2, voffA);
            PG8_WAIT_V(8); PG8_WAIT_L(0); PG8_BAR; PG8_MMA(1, 0, At, B0); PG8_MMA(1, 1, At, B1); PG8_BAR; PG8_SCHED;
            PG8_LDB(B0, 1, 0); PG8_LDB(B1, 1, 1); PG8_SCHED; PG8_LDA(At, 1, 0); PG8_STAGE(PG8_SA(0, 1), a2 + hstep, voffA);
            PG8_WAIT_V(8); PG8_WAIT_L(0); PG8_BAR; PG8_MMA(0, 0, At, B0); PG8_MMA(0, 1, At, B1); PG8_BAR; PG8_SCHED;
            PG8_LDA(At, 1, 1); PG8_STAGE(PG8_SB(1, 0), b3, voffB); PG8_STAGE(PG8_SB(1, 1), b3 + hstep, voffB); PG8_STAGE(PG8_SA(1, 0), a3, voffA);
            PG8_WAIT_V(8); PG8_WAIT_L(0); PG8_BAR; PG8_MMA(1, 0, At, B0); PG8_MMA(1, 1, At, B1); PG8_BAR; PG8_SCHED;
            } else {
            PG8_LDB(B0, 0, 0); PG8_SCHED; PG8_LDA(At, 0, 0); PG8_STAGE(PG8_SA(1, 1), a1 + hstep, voffA);
            PG8_WAIT_L(8); PG8_BAR; PG8_WAIT_L(0); PG8_MMA(0, 0, At, B0); PG8_BAR; PG8_SCHED;
            PG8_LDB(B1, 0, 1); PG8_STAGE(PG8_SB(0, 0), b2, voffB);
            PG8_BAR; PG8_WAIT_L(0); PG8_MMA(0, 1, At, B1); PG8_BAR;
            PG8_LDA(At, 0, 1); PG8_STAGE(PG8_SA(0, 0), a2, voffA);
            PG8_BAR; PG8_WAIT_L(0); PG8_MMA(1, 0, At, B0); PG8_BAR; PG8_SCHED;
            PG8_STAGE(PG8_SB(0, 1), b2 + hstep, voffB);
            PG8_WAIT_V(6); PG8_BAR; PG8_MMA(1, 1, At, B1); PG8_BAR;
            PG8_LDB(B0, 1, 0); PG8_SCHED; PG8_LDA(At, 1, 0); PG8_STAGE(PG8_SA(0, 1), a2 + hstep, voffA);
            PG8_WAIT_L(8); PG8_BAR; PG8_WAIT_L(0); PG8_MMA(0, 0, At, B0); PG8_BAR; PG8_SCHED;
            PG8_LDB(B1, 1, 1); PG8_STAGE(PG8_SB(1, 0), b3, voffB);
            PG8_BAR; PG8_WAIT_L(0); PG8_MMA(0, 1, At, B1); PG8_BAR;
            PG8_LDA(At, 1, 1); PG8_STAGE(PG8_SA(1, 0), a3, voffA);
            PG8_BAR; PG8_WAIT_L(0); PG8_MMA(1, 0, At, B0); PG8_BAR; PG8_SCHED;
            PG8_STAGE(PG8_SB(1, 1), b3 + hstep, voffB);
            PG8_WAIT_V(6); PG8_BAR; PG8_MMA(1, 1, At, B1); PG8_BAR;
            }
        }
        if constexpr (ALIGN_EPI) { if (wr == 0) PG8_BAR; }
        E(acc, cur, wr, wc, fr, fq);
        if (!has_next) break;
#pragma unroll
        for (int a = 0; a < 2; ++a)
#pragma unroll
            for (int b = 0; b < 2; ++b)
#pragma unroll
                for (int m = 0; m < 4; ++m)
#pragma unroll
                    for (int n = 0; n < 2; ++n) acc[a][b][m][n] = (f32x4){0.f, 0.f, 0.f, 0.f};
        cur = nxt; cA = nA; cB = nB; ++ui;
        if constexpr (ALIGN_EPI) { if (wr == 1) PG8_BAR; }
    }
    PG8_WAIT_V(0);
    if constexpr (!ALIGN_EPI) { if (wr == 0) PG8_BAR; }
    PG8_BAR;
#undef PG8_SA
#undef PG8_SB
#undef PG8_STAGE
#undef PG8_LDA
#undef PG8_LDB
#undef PG8_MMA
#undef PG8_WAIT_V
#undef PG8_WAIT_L
#undef PG8_BAR
#undef PG8_SCHED
#undef PG8_UPTR
}

struct EpiProj {
    static constexpr bool PERM = true;
    bf16 *q, *k, *vT, *p;
    __device__ __forceinline__ void operator()(const f32x4 (&acc)[2][2][4][2], const Unit& u, int wr, int wc, int fr, int fq) const {
        const int row0 = u.pm * BM + wr * 64 + fr;
        const int pn = u.pn;
#pragma unroll
        for (int ai = 0; ai < 2; ++ai)
#pragma unroll
            for (int m = 0; m < 4; ++m) {
                const int row = row0 + ai * HALF + m * 16;
#pragma unroll
                for (int bj = 0; bj < 2; ++bj) {
                    f32x4 v0 = acc[ai][bj][m][0], v1 = acc[ai][bj][m][1];
                    const int col = pn * BM + bj * HALF + wc * 32 + 8 * fq;
                    if (pn >= 4 && pn < 6) {
                        const int cv = col - 1024, hh = cv >> 6, dim = cv & 63, b = row / T, t = row % T;
                        bf16* dst = vT + ((size_t)((b * NH + hh) * HD + dim)) * T + t;
                        const unsigned w0 = cvt_pk_bf16(v0[0], v0[1]), w1 = cvt_pk_bf16(v0[2], v0[3]), w2 = cvt_pk_bf16(v1[0], v1[1]), w3 = cvt_pk_bf16(v1[2], v1[3]);
                        dst[0 * (size_t)T] = (bf16)(w0 & 0xffff); dst[1 * (size_t)T] = (bf16)(w0 >> 16); dst[2 * (size_t)T] = (bf16)(w1 & 0xffff); dst[3 * (size_t)T] = (bf16)(w1 >> 16);
                        dst[4 * (size_t)T] = (bf16)(w2 & 0xffff); dst[5 * (size_t)T] = (bf16)(w2 >> 16); dst[6 * (size_t)T] = (bf16)(w3 & 0xffff); dst[7 * (size_t)T] = (bf16)(w3 >> 16);
                    } else {
                        bf16* dst;
                        if (pn < 2) { v0 = v0 * 0.125f; v1 = v1 * 0.125f; dst = q + (size_t)row * CW + col; }
                        else if (pn < 4) dst = k + (size_t)row * CW + (col - 512);
                        else dst = p + (size_t)row * PW + (col - 1536);
                        u32x4 w; w.x = cvt_pk_bf16(v0[0], v0[1]); w.y = cvt_pk_bf16(v0[2], v0[3]); w.z = cvt_pk_bf16(v1[0], v1[1]); w.w = cvt_pk_bf16(v1[2], v1[3]);
                        *(u32x4*)dst = w;
                    }
                }
            }
    }
};
struct EpiWo {
    static constexpr bool PERM = false;
    const float* x; float* h;
    __device__ __forceinline__ void operator()(const f32x4 (&acc)[2][2][4][2], const Unit& u, int wr, int wc, int fr, int fq) const {
        const int row0 = u.pm * BM + wr * 64 + fr, col0 = u.pn * BM + wc * 32 + 4 * fq;
#pragma unroll
        for (int ai = 0; ai < 2; ++ai)
#pragma unroll
            for (int m = 0; m < 4; ++m) { const size_t off = (size_t)(row0 + ai * HALF + m * 16) * D + col0;
#pragma unroll
                for (int bj = 0; bj < 2; ++bj)
#pragma unroll
                    for (int n = 0; n < 2; ++n) { const f32x4 xv = *(const f32x4*)(x + off + bj * HALF + n * 16); *(f32x4*)(h + off + bj * HALF + n * 16) = acc[ai][bj][m][n] + xv; } }
    }
};
struct EpiUp {
    static constexpr bool PERM = true;
    const float* b_up; bf16* act;
    __device__ __forceinline__ void operator()(const f32x4 (&acc)[2][2][4][2], const Unit& u, int wr, int wc, int fr, int fq) const {
        const int row0 = u.pm * BM + wr * 64 + fr, ch = u.pn * 128 + wc * 32 + 8 * fq;
        const float* bg = b_up + (size_t)u.e * 2048 + ch; const float* bl = bg + 1024;
        const f32x4 bg0 = *(const f32x4*)bg, bg1 = *(const f32x4*)(bg + 4), bl0 = *(const f32x4*)bl, bl1 = *(const f32x4*)(bl + 4);
#pragma unroll
        for (int ai = 0; ai < 2; ++ai)
#pragma unroll
            for (int m = 0; m < 4; ++m) {
                float o[8];
#pragma unroll
                for (int n = 0; n < 2; ++n) { const f32x4 gv = acc[ai][0][m][n] + (n ? bg1 : bg0), lv = acc[ai][1][m][n] + (n ? bl1 : bl0);
#pragma unroll
                    for (int j = 0; j < 4; ++j) { const float gt = fminf(gv[j], 7.0f), li = fminf(fmaxf(lv[j], -7.0f), 7.0f); o[n * 4 + j] = (li + 1.0f) * gt * sigmoidf_(1.702f * gt); } }
                *(u32x4*)(act + (size_t)(row0 + ai * HALF + m * 16) * DE + ch) = pack8(o);
            }
    }
};
struct EpiDown {
    static constexpr bool PERM = true;
    const float* b_dn; bf16* y;
    __device__ __forceinline__ void operator()(const f32x4 (&acc)[2][2][4][2], const Unit& u, int wr, int wc, int fr, int fq) const {
        const int row0 = u.pm * BM + wr * 64 + fr, col0 = u.pn * BM + wc * 32 + 8 * fq;
        const float* bb = b_dn + (size_t)u.e * D + col0;
        f32x4 bv[2][2];
#pragma unroll
        for (int bj = 0; bj < 2; ++bj)
#pragma unroll
            for (int n = 0; n < 2; ++n) bv[bj][n] = *(const f32x4*)(bb + bj * HALF + 4 * n);
#pragma unroll
        for (int ai = 0; ai < 2; ++ai)
#pragma unroll
            for (int m = 0; m < 4; ++m) { bf16* rowp = y + (size_t)(row0 + ai * HALF + m * 16) * D + col0;
#pragma unroll
                for (int bj = 0; bj < 2; ++bj) { const f32x4 v0 = acc[ai][bj][m][0] + bv[bj][0], v1 = acc[ai][bj][m][1] + bv[bj][1];
                    u32x4 w; w.x = cvt_pk_bf16(v0[0], v0[1]); w.y = cvt_pk_bf16(v0[2], v0[3]); w.z = cvt_pk_bf16(v1[0], v1[1]); w.w = cvt_pk_bf16(v1[2], v1[3]);
                    *(u32x4*)(rowp + bj * HALF) = w; } }
    }
};
}


#define XB_TMO      128
#define XB_XCNT(j)  (256  + 64 * (j))
#define XB_XSUB(j)  (1280 + 64 * (j))
#define XB_XGEN(j)  (2304 + 64 * (j))
#define XB_TOP      3328
#define XB_TOPGEN   3392
#define XCD_BAR_WORDS 3456
#define XB_SPIN_CAP (1u << 20)
__device__ __forceinline__ unsigned xb_ld(unsigned* p)              { return __hip_atomic_load(p, __ATOMIC_RELAXED, __HIP_MEMORY_SCOPE_AGENT); }
__device__ __forceinline__ unsigned xb_add(unsigned* p, unsigned v) { return __hip_atomic_fetch_add(p, v, __ATOMIC_RELAXED, __HIP_MEMORY_SCOPE_AGENT); }
__device__ __forceinline__ unsigned xb_xcc_id() { return (unsigned)__builtin_amdgcn_s_getreg((3 << 11) | 20) & 0xFu; }
#define XB_SPIN(cond, bar) do { unsigned _sp = 0; while (cond) { __builtin_amdgcn_s_sleep(1); \
    if ((++_sp & 255u) == 0u) { if (xb_ld(&(bar)[XB_TMO])) break; if (_sp > XB_SPIN_CAP) { atomicAdd(&(bar)[XB_TMO], 1u); break; } } } } while (0)
struct XcdBarrier { unsigned* bar; unsigned x; volatile LAS unsigned* st; };
__device__ __forceinline__ XcdBarrier xcd_barrier_post(unsigned* bar, volatile LAS unsigned* st) {
    XcdBarrier b; b.bar = bar; b.x = xb_xcc_id(); b.st = st;
    if (threadIdx.x == 0) (void)xb_add(&bar[XB_XCNT(b.x)], 1u);
    return b;
}
__device__ __forceinline__ void xcd_barrier_complete(unsigned* bar, unsigned x, unsigned& nloc, unsigned& nx) {
    const unsigned G = gridDim.x * gridDim.y * gridDim.z;
    unsigned sum, cnt, mine, sp = 0u;
    for (;;) {
        sum = 0u; cnt = 0u; mine = 0u;
#pragma unroll
        for (unsigned j = 0; j < 16; ++j) { const unsigned c = xb_ld(&bar[XB_XCNT(j)]); sum += c; cnt += (c > 0u) ? 1u : 0u; mine = (j == x) ? c : mine; }
        if (sum == G) break;
        __builtin_amdgcn_s_sleep(1);
        if ((++sp & 255u) == 0u) { if (xb_ld(&bar[XB_TMO])) break; if (sp > XB_SPIN_CAP) { atomicAdd(&bar[XB_TMO], 1u); break; } }
    }
    nloc = mine > 0u ? mine : 1u; nx = cnt > 0u ? cnt : 1u;
}
__device__ __forceinline__ void xcd_barrier(const XcdBarrier& b) {
    asm volatile("s_waitcnt vmcnt(0)" ::: "memory");
    __syncthreads();
    if (threadIdx.x == 0) {
        unsigned* bar = b.bar;
        __builtin_amdgcn_s_waitcnt(0);
        unsigned nloc = b.st[0], nx = b.st[1];
        if (nloc == 0u) { xcd_barrier_complete(bar, b.x, nloc, nx); b.st[0] = nloc; b.st[1] = nx; }
        const unsigned old = xb_add(&bar[XB_XSUB(b.x)], 1u);
        const unsigned gen = old / nloc;
        if (old + 1u == (gen + 1u) * nloc) {
            __builtin_amdgcn_fence(__ATOMIC_RELEASE, "agent");
            asm volatile("s_waitcnt vmcnt(0)" ::: "memory");
            const unsigned og = xb_add(&bar[XB_TOP], 1u);
            const unsigned tg = og / nx;
            if (og + 1u == (tg + 1u) * nx) xb_add(&bar[XB_TOPGEN], 1u);
            else XB_SPIN(xb_ld(&bar[XB_TOPGEN]) == tg, bar);
            __builtin_amdgcn_fence(__ATOMIC_ACQUIRE, "agent");
            xb_add(&bar[XB_XGEN(b.x)], 1u);
            asm volatile("s_waitcnt vmcnt(0)" ::: "memory");
        } else {
            XB_SPIN(xb_ld(&bar[XB_XGEN(b.x)]) == gen, bar);
            __builtin_amdgcn_fence(__ATOMIC_ACQUIRE, "agent");
            asm volatile("s_waitcnt vmcnt(0)" ::: "memory");
        }
    }
    __syncthreads();
}

struct Args { const float* in[26]; float* out; unsigned char* ws; int ph_lo, ph_hi; };

struct Frame { LAS unsigned char* lds; int tid, lane, wave, G, vcu; };

__device__ __forceinline__ void transpose_item(const float* W, int K, int N, bf16* WT, int k0, int n0, int orow0, LAS float* scr, int lane) {
#pragma unroll 8
    for (int i = 0; i < 32; ++i) { const int kk = 2 * i + (lane >> 5); scr[kk * 33 + (lane & 31)] = W[(size_t)(k0 + kk) * N + n0 + (lane & 31)]; }
    asm volatile("s_waitcnt lgkmcnt(0)" ::: "memory");
    const int c = lane & 7;
#pragma unroll
    for (int j = 0; j < 4; ++j) { const int n = (lane >> 3) + 8 * j; const LAS float* s = scr + (8 * c) * 33 + n;
        u32x4 o; o.x = cvt_pk_bf16(s[0 * 33], s[1 * 33]); o.y = cvt_pk_bf16(s[2 * 33], s[3 * 33]); o.z = cvt_pk_bf16(s[4 * 33], s[5 * 33]); o.w = cvt_pk_bf16(s[6 * 33], s[7 * 33]);
        *(u32x4*)(WT + (size_t)(orow0 + n) * K + k0 + 8 * c) = o; }
    asm volatile("s_waitcnt lgkmcnt(0)" ::: "memory");
}

__device__ __forceinline__ void p0_prologue(const Frame& F, const Args& a) {
    unsigned char* ws = a.ws;
    LAS float* scr = (LAS float*)(F.lds + F.wave * 8448);
    const int gw = F.vcu * 8 + F.wave, NGW = F.G * 8;
    constexpr int I_IN = 16 * 108, I_O = 16 * 32, I_UP = 0, I_DN = 0, I_L = 16, I_G = 32;
    constexpr int NITEMS = I_IN + I_O + I_UP + I_DN + 2 * I_L + 2 * I_L + I_G;
    for (int it = gw; it < NITEMS; it += NGW) {
        int r = it;
        if (r < I_UP) {
            const int e = r / 1024, q = r % 1024, kb = q / 64, nb = q % 64, n0 = nb * 32;
            const int orow0 = n0 < 1024 ? 256 * (n0 >> 7) + (n0 & 127) : 256 * ((n0 - 1024) >> 7) + 128 + ((n0 - 1024) & 127);
            transpose_item(a.in[21] + (size_t)e * 1024 * 2048, 1024, 2048, (bf16*)(ws + WS_WUPT) + (size_t)e * 2048 * 1024, kb * 64, n0, orow0, scr, F.lane); continue; }
        r -= I_UP;
        if (r < I_DN) { const int e = r / 512, q = r % 512, kb = q / 32, nb = q % 32;
            transpose_item(a.in[23] + (size_t)e * 1024 * 1024, 1024, 1024, (bf16*)(ws + WS_WDNT) + (size_t)e * 1024 * 1024, kb * 64, nb * 32, nb * 32, scr, F.lane); continue; }
        r -= I_DN;
        if (r < I_IN) { const int kb = r / 108, nb = r % 108; transpose_item(a.in[2], 1024, NPROJ, (bf16*)(ws + WS_WINT), kb * 64, nb * 32, nb * 32, scr, F.lane); continue; }
        r -= I_IN;
        if (r < I_O) { const int kb = r / 32, nb = r % 32; transpose_item(a.in[17], 1024, 1024, (bf16*)(ws + WS_WOT), kb * 64, nb * 32, nb * 32, scr, F.lane); continue; }
        r -= I_O;
        if (r < 2 * I_L) { const int z = r / 16, nb = r % 16; transpose_item(a.in[8] + (size_t)z * 64 * 512, 64, 512, (bf16*)(ws + WS_W2T) + (size_t)z * 512 * 64, 0, nb * 32, nb * 32, scr, F.lane); continue; }
        r -= 2 * I_L;
        if (r < 2 * I_L) { const int z = r / 16, nb = r % 16; transpose_item(a.in[10] + (size_t)z * 64 * 512, 64, 512, (bf16*)(ws + WS_A2T) + (size_t)z * 512 * 64, 0, nb * 32, nb * 32, scr, F.lane); continue; }
        r -= 2 * I_L;
        { const int kb = r / 16, nb = r % 16; transpose_item(a.in[11], 128, 512, (bf16*)(ws + WS_G2T), kb * 64, nb * 32, nb * 32, scr, F.lane); }
    }
    { u32x4* z = (u32x4*)(ws + WS_WINT + (size_t)NPROJ * 1024 * 2); const u32x4 zero = {0u, 0u, 0u, 0u};
      for (int i = F.vcu * 512 + F.tid; i < 16384; i += F.G * 512) z[i] = zero; }
    const float* x = a.in[0]; const float* nw = a.in[1]; bf16* hn = (bf16*)(ws + WS_HN);
    f32x4 wv[4];
#pragma unroll
    for (int j = 0; j < 4; ++j) wv[j] = *((const f32x4*)nw + F.lane + 64 * j);
    for (int m = gw; m < M; m += NGW) {
        const f32x4* xr = (const f32x4*)(x + (size_t)m * D) + F.lane;
        f32x4 v[4]; float s = 0.f;
#pragma unroll
        for (int j = 0; j < 4; ++j) { v[j] = xr[64 * j]; s += (v[j].x * v[j].x + v[j].y * v[j].y) + (v[j].z * v[j].z + v[j].w * v[j].w); }
        const float rs = rsqrtf(wave_sum(s) * (1.f / D) + RMS_EPS);
        u32x2* o8 = (u32x2*)(hn + (size_t)m * D) + F.lane;
#pragma unroll
        for (int j = 0; j < 4; ++j) { u32x2 o; o.x = cvt_pk_bf16(v[j].x * rs * wv[j].x, v[j].y * rs * wv[j].y); o.y = cvt_pk_bf16(v[j].z * rs * wv[j].z, v[j].w * rs * wv[j].w); o8[64 * j] = o; }
    }
}

constexpr int PREP_KBUF = 0, PREP_INV = 65536, PREP_AW = 67584, PREP_AA = PREP_AW + 17408, PREP_AG = PREP_AA + 17408, PREP_LD = 136;
template <bool STORE>
__device__ __forceinline__ void prep_phase(const Frame& F, const Args& a) {
    unsigned char* ws = a.ws;
    const bf16* p = (const bf16*)(ws + WS_P);
    bf16* r_out = (bf16*)(ws + WS_R); bf16* v_out = (bf16*)(ws + WS_V); bf16* kk_out = (bf16*)(ws + WS_KK);
    bf16* decay_out = (bf16*)(ws + WS_DECAY); bf16* kdir_out = (bf16*)(ws + WS_KDIR); bf16* akk_out = (bf16*)(ws + WS_AKK); bf16* g_out = (bf16*)(ws + WS_G);
    const bf16* w2T = (const bf16*)(ws + WS_W2T); const bf16* a2T = (const bf16*)(ws + WS_A2T); const bf16* g2T = (const bf16*)(ws + WS_G2T);
    const float* mu_p = a.in[5]; const float* mu_n = a.in[6]; const float* w0 = a.in[7]; const float* a0 = a.in[9];
    const float* k_k = a.in[12]; const float* k_a = a.in[13];
    LAS bf16* kbuf = (LAS bf16*)(F.lds + PREP_KBUF); LAS float* invb = (LAS float*)(F.lds + PREP_INV);
    LAS bf16* Aw = (LAS bf16*)(F.lds + PREP_AW); LAS bf16* Aa = (LAS bf16*)(F.lds + PREP_AA); LAS bf16* Ag = (LAS bf16*)(F.lds + PREP_AG);
    const int lane = F.lane, wave = F.wave, fr = lane & 15, fg = lane >> 4;
    for (int tile = F.vcu; tile < M / 64; tile += F.G) {
        const int m0 = tile * 64;
#pragma unroll 1
        for (int jj = 0; jj < 4; ++jj) {
            const int q = lane + 64 * jj; const bool valid = q < 240; const int c0 = 8 * q;
            float mp[8], mn[8];
#pragma unroll
            for (int i = 0; i < 8; ++i) { mp[i] = valid ? mu_p[c0 + i] : 0.f; mn[i] = valid ? mu_n[c0 + i] : 0.f; }
            const int mfirst = m0 + wave * 8;
            const u32x4 zero = {0u, 0u, 0u, 0u};
            u32x4 rows[10];
#pragma unroll
            for (int rI = 0; rI < 10; ++rI) { const int mr = mfirst - 1 + rI;
                const bool ok = valid && !(rI == 0 && (mfirst % T) == 0) && !(rI == 9 && ((mfirst + 7) % T) == T - 1);
                rows[rI] = ok ? *(const u32x4*)(p + (size_t)mr * PW + c0) : zero; }
#pragma unroll
            for (int i = 0; i < 8; ++i) {
                const int m = mfirst + i, it = wave * 8 + i;
                const u32x4 prev = rows[i], cur = rows[i + 1], nxt = rows[i + 2];
                float fp[8], fc[8], fn[8], s[8];
                unpack8(prev, fp); unpack8(cur, fc); unpack8(nxt, fn);
#pragma unroll
                for (int e = 0; e < 8; ++e) s[e] = fc[e] + mp[e] * (fp[e] - fc[e]) + mn[e] * (fn[e] - fc[e]);
                if (jj == 0) { if (STORE) { *(u32x4*)(r_out + (size_t)m * CW + c0) = pack8(s); } }
                else if (jj == 1) {
                    const int c = c0 - 512;
                    *(LAS u32x4*)(kbuf + it * 512 + c) = pack8(s);
                    float kr[8]; float ss = 0.f;
#pragma unroll
                    for (int e = 0; e < 8; ++e) { kr[e] = s[e] * k_k[c + e]; ss += kr[e] * kr[e]; }
                    ss += __shfl_xor(ss, 1); ss += __shfl_xor(ss, 2); ss += __shfl_xor(ss, 4);
                    const float inv = fminf(__builtin_amdgcn_rsqf(ss), 1e12f);
#pragma unroll
                    for (int e = 0; e < 8; ++e) kr[e] *= inv;
                    if (STORE) { *(u32x4*)(kk_out + (size_t)m * CW + c) = pack8(kr); }
                    if ((lane & 7) == 0) invb[it * 8 + (lane >> 3)] = inv;
                }
                else if (jj == 2) { if (STORE) { *(u32x4*)(v_out + (size_t)m * CW + (c0 - 1024)) = pack8(s); } }
                else if (valid) {
                    const int seg = lane >> 4, cw = 8 * (lane & 15);
                    if (seg == 0) {
#pragma unroll
                        for (int e = 0; e < 8; ++e) s[e] = 1.0f - 2.0f * __builtin_amdgcn_rcpf(__expf(2.0f * s[e]) + 1.0f);
                        *(LAS u32x4*)(Aw + it * PREP_LD + cw) = pack8(s);
                    } else if (seg == 1) { *(LAS u32x4*)(Aa + it * PREP_LD + cw) = pack8(s); }
                    else {
#pragma unroll
                        for (int e = 0; e < 8; ++e) s[e] = sigmoidf_(s[e]);
                        *(LAS u32x4*)(Ag + it * PREP_LD + cw) = pack8(s);
                    }
                }
            }
        }
        __syncthreads();
        const int nb = 64 * wave;
#pragma unroll 1
        for (int job = 0; job < 5; ++job) {
            const int z = job & 1;
            const bf16* WT = job < 2 ? w2T + (size_t)z * 512 * 64 : (job < 4 ? a2T + (size_t)z * 512 * 64 : g2T);
            const LAS bf16* Ax = job < 2 ? Aw + z * 64 : (job < 4 ? Aa + z * 64 : Ag);
            const int kw = job < 4 ? 64 : 128, nks = kw / 32;
            f32x4 acc[4][4];
#pragma unroll
            for (int mt = 0; mt < 4; ++mt)
#pragma unroll
                for (int nt = 0; nt < 4; ++nt) acc[mt][nt] = (f32x4){0.f, 0.f, 0.f, 0.f};
#pragma unroll 1
            for (int ks = 0; ks < nks; ++ks) {
                bf16x8 af[4], wf[4];
#pragma unroll
                for (int mt = 0; mt < 4; ++mt) af[mt] = *(const LAS bf16x8*)(Ax + (16 * mt + fr) * PREP_LD + 32 * ks + 8 * fg);
#pragma unroll
                for (int nt = 0; nt < 4; ++nt) wf[nt] = *(const bf16x8*)(WT + (size_t)(nb + 16 * nt + fr) * kw + 32 * ks + 8 * fg);
#pragma unroll
                for (int mt = 0; mt < 4; ++mt)
#pragma unroll
                    for (int nt = 0; nt < 4; ++nt) acc[mt][nt] = __builtin_amdgcn_mfma_f32_16x16x32_bf16(wf[nt], af[mt], acc[mt][nt], 0, 0, 0);
            }
#pragma unroll
            for (int mt = 0; mt < 4; ++mt) {
                const int it = 16 * mt + fr; const size_t m = (size_t)(m0 + it);
#pragma unroll
                for (int nt = 0; nt < 4; ++nt) {
                    const int n = nb + 16 * nt + 4 * fg;
                    const f32x4 v = acc[mt][nt];
                    if (job < 2) {
                        const f32x4 b = *(const f32x4*)(w0 + z * 512 + n);
                        float o[4];
#pragma unroll
                        for (int i = 0; i < 4; ++i) o[i] = __expf(-0.60653066f * sigmoidf_(v[i] + b[i]));
                        u32x2 w; w.x = cvt_pk_bf16(o[0], o[1]); w.y = cvt_pk_bf16(o[2], o[3]);
                        if (STORE) { *(u32x2*)(decay_out + ((size_t)z * M + m) * CW + n) = w; }
                    } else if (job < 4) {
                        const f32x4 b = *(const f32x4*)(a0 + z * 512 + n), kkc = *(const f32x4*)(k_k + n), kac = *(const f32x4*)(k_a + n);
                        const u32x2 kb = *(const LAS u32x2*)(kbuf + it * 512 + n);
                        const float kv[4] = {bflo(kb.x), bfhi(kb.x), bflo(kb.y), bfhi(kb.y)};
                        const float inv = invb[it * 8 + wave];
                        float kd[4], ak[4];
#pragma unroll
                        for (int i = 0; i < 4; ++i) { const float av = sigmoidf_(v[i] + b[i]); kd[i] = kv[i] * (1.0f + (av - 1.0f) * kac[i]); ak[i] = av * (kv[i] * kkc[i] * inv); }
                        u32x2 w; w.x = cvt_pk_bf16(kd[0], kd[1]); w.y = cvt_pk_bf16(kd[2], kd[3]);
                        if (STORE) { *(u32x2*)(kdir_out + ((size_t)z * M + m) * CW + n) = w; }
                        w.x = cvt_pk_bf16(ak[0], ak[1]); w.y = cvt_pk_bf16(ak[2], ak[3]);
                        if (STORE) { *(u32x2*)(akk_out + ((size_t)z * M + m) * CW + n) = w; }
                    } else {
                        u32x2 w; w.x = cvt_pk_bf16(v[0], v[1]); w.y = cvt_pk_bf16(v[2], v[3]);
                        if (STORE) { *(u32x2*)(g_out + m * CW + n) = w; }
                    }
                }
            }
        }
        __syncthreads();
    }
}

__device__ __forceinline__ void attn_phase(const Frame& F, const Args& a) {
    unsigned char* ws = a.ws;
    const bf16* q = (const bf16*)(ws + WS_Q); const bf16* k = (const bf16*)(ws + WS_K); const bf16* vT = (const bf16*)(ws + WS_VT);
    bf16* att = (bf16*)(ws + WS_ATT);
    LAS float* bias = (LAS float*)F.lds;
    for (int i = F.tid; i < 8 * 15 * 31; i += 512) bias[i] = a.in[3][i];
    __syncthreads();
    const int lane = F.lane, fr = lane & 15, fg = lane >> 4;
    const int NGW = F.G * 8, gw = F.vcu * 8 + F.wave;
    const int per = (16384 + NGW - 1) / NGW;
    for (int task = gw * per; task < (gw + 1) * per && task < 16384; ++task) {
        const int cgp = task & 3, r = (task >> 2) & 127, h = (task >> 9) & 7, b = task >> 12;
        const int c0 = 16 * cgp, wsc = min(max(c0 - 8, 0), 32), rs = min(max(r - 4, 0), GROWS - 8);
        const int c = c0 + fr, cs = min(max(c - 8, 0), 48);
        const size_t tq = (size_t)b * T + r * 64 + c;
        bf16x8 qf[2];
#pragma unroll
        for (int ks = 0; ks < 2; ++ks) qf[ks] = *(const bf16x8*)(q + tq * CW + h * 64 + 32 * ks + 8 * fg);
        f32x4 sc[16];
        const int kcol_a = wsc + 8 * (fr >> 2) + (fr & 3);
#pragma unroll
        for (int u = 0; u < 8; ++u)
#pragma unroll
            for (int par = 0; par < 2; ++par) {
                const size_t tk = (size_t)b * T + (rs + u) * 64 + kcol_a + 4 * par;
                const bf16x8 k0 = *(const bf16x8*)(k + tk * CW + h * 64 + 8 * fg), k1 = *(const bf16x8*)(k + tk * CW + h * 64 + 32 + 8 * fg);
                f32x4 s = {0.f, 0.f, 0.f, 0.f};
                s = __builtin_amdgcn_mfma_f32_16x16x32_bf16(k0, qf[0], s, 0, 0, 0);
                s = __builtin_amdgcn_mfma_f32_16x16x32_bf16(k1, qf[1], s, 0, 0, 0);
                sc[2 * u + par] = s;
            }
        float mx = -1e30f;
#pragma unroll
        for (int u = 0; u < 8; ++u) {
            const int dr = rs + u - r + 7;
#pragma unroll
            for (int par = 0; par < 2; ++par)
#pragma unroll
                for (int i = 0; i < 4; ++i) {
                    const int kc = wsc + 8 * fg + 4 * par + i; const bool ok = (kc >= cs) && (kc < cs + 16);
                    const int dc = min(max(kc - c + 15, 0), 30);
                    const float s = ok ? sc[2 * u + par][i] + bias[(h * 15 + dr) * 31 + dc] : -1e30f;
                    sc[2 * u + par][i] = s; mx = fmaxf(mx, s);
                }
        }
        mx = fmaxf(mx, __shfl_xor(mx, 16)); mx = fmaxf(mx, __shfl_xor(mx, 32));
        float sum = 0.f;
#pragma unroll
        for (int t = 0; t < 16; ++t)
#pragma unroll
            for (int i = 0; i < 4; ++i) { const float pv = sc[t][i] > -1e29f ? __expf(sc[t][i] - mx) : 0.f; sc[t][i] = pv; sum += pv; }
        sum += __shfl_xor(sum, 16); sum += __shfl_xor(sum, 32);
        const float inv = 1.0f / sum;
        f32x4 o[4];
#pragma unroll
        for (int nt = 0; nt < 4; ++nt) o[nt] = (f32x4){0.f, 0.f, 0.f, 0.f};
#pragma unroll
        for (int u = 0; u < 8; ++u) {
            union { u32x4 w; bf16x8 h8; } pf;
            pf.w.x = cvt_pk_bf16(sc[2 * u][0], sc[2 * u][1]); pf.w.y = cvt_pk_bf16(sc[2 * u][2], sc[2 * u][3]);
            pf.w.z = cvt_pk_bf16(sc[2 * u + 1][0], sc[2 * u + 1][1]); pf.w.w = cvt_pk_bf16(sc[2 * u + 1][2], sc[2 * u + 1][3]);
            const size_t tv = (size_t)(rs + u) * 64 + wsc + 8 * fg;
#pragma unroll
            for (int nt = 0; nt < 4; ++nt) {
                const bf16x8 vf = *(const bf16x8*)(vT + ((size_t)((b * NH + h) * HD + 16 * nt + fr)) * T + tv);
                o[nt] = __builtin_amdgcn_mfma_f32_16x16x32_bf16(vf, pf.h8, o[nt], 0, 0, 0);
            }
        }
#pragma unroll
        for (int nt = 0; nt < 4; ++nt) { u32x2 w; w.x = cvt_pk_bf16(o[nt][0] * inv, o[nt][1] * inv); w.y = cvt_pk_bf16(o[nt][2] * inv, o[nt][3] * inv);
            *(u32x2*)(att + tq * CW + h * 64 + 16 * nt + 4 * fg) = w; }
    }
    __syncthreads();
}

constexpr int SC_TC = 32, SC_REC = 1344, SC_STAGE = SC_TC * SC_REC  , SC_YB = SC_TC * 1024, SC_YOFF = 2 * SC_STAGE  ;
__device__ __forceinline__ float row16_sum(float v) {
    v += __builtin_bit_cast(float, __builtin_amdgcn_update_dpp(0, __builtin_bit_cast(int, v), 0xB1, 0xF, 0xF, true));
    v += __builtin_bit_cast(float, __builtin_amdgcn_update_dpp(0, __builtin_bit_cast(int, v), 0x4E, 0xF, 0xF, true));
    v += __builtin_bit_cast(float, __builtin_amdgcn_update_dpp(0, __builtin_bit_cast(int, v), 0x141, 0xF, 0xF, true));
    v += __builtin_bit_cast(float, __builtin_amdgcn_update_dpp(0, __builtin_bit_cast(int, v), 0x140, 0xF, 0xF, true));
    return v;
}
__device__ __forceinline__ void scan_phase(const Frame& F, const Args& a) {
    unsigned char* ws = a.ws;
    const int seq = F.vcu >> 2, rg = F.vcu & 3;
    if (seq >= 64) return;
    const int z = seq >> 5, b = (seq >> 3) & 3, h = seq & 7;
    const bf16* vsrc = (const bf16*)(ws + WS_V);
    float* yout = (float*)(ws + WS_Y) + (size_t)z * M * CW;
    const size_t mb = (size_t)b * T;
    const int lane = F.lane, wave = F.wave;
    constexpr int NCH = T / SC_TC;
    if (wave >= 4) {
        const int u = F.tid - 256;
        const bf16* gp[5]; int ldo[5];
        const long tstep = z ? -(long)CW : (long)CW;
#pragma unroll
        for (int j = 0; j < 5; ++j) { const int piece = u + 256 * j, tau = piece / 40, w = piece % 40, arr = w >> 3, part = w & 7;
            const bf16* base = arr == 0 ? (const bf16*)(ws + WS_KK) : arr == 1 ? (const bf16*)(ws + WS_DECAY) + (size_t)z * M * CW : arr == 2 ? (const bf16*)(ws + WS_AKK) + (size_t)z * M * CW
                             : arr == 3 ? (const bf16*)(ws + WS_KDIR) + (size_t)z * M * CW : (const bf16*)(ws + WS_R);
            const int t0 = z ? (T - 1 - tau) : tau;
            gp[j] = base + (mb + t0) * CW + h * 64 + part * 8; ldo[j] = tau * SC_REC + w * 32; }
        const int vtau = (u & 63) >> 1, vpart = u & 1;
        const bf16* gv = vsrc + (mb + (z ? (T - 1 - vtau) : vtau)) * CW + h * 64 + rg * 16 + vpart * 8;
        const int ldv = vtau * SC_REC + 1280 + vpart * 32;
        u32x4 reg0, reg1, reg2, reg3, reg4, regv = {0u, 0u, 0u, 0u};
#define SC_LOAD(c) do { const long adv = (long)(c) * SC_TC * tstep; reg0 = *(const u32x4*)(gp[0] + adv); reg1 = *(const u32x4*)(gp[1] + adv); reg2 = *(const u32x4*)(gp[2] + adv); \
            reg3 = *(const u32x4*)(gp[3] + adv); reg4 = *(const u32x4*)(gp[4] + adv); if (u < 64) regv = *(const u32x4*)(gv + adv); } while (0)
#define SC_W1(rg_, off_) do { float f_[8]; unpack8(rg_, f_); LAS f32x4* d_ = (LAS f32x4*)(st_ + (off_)); d_[0] = (f32x4){f_[0], f_[1], f_[2], f_[3]}; d_[1] = (f32x4){f_[4], f_[5], f_[6], f_[7]}; } while (0)
#define SC_WRITE(buf) do { LAS unsigned char* st_ = F.lds + (buf) * SC_STAGE; SC_W1(reg0, ldo[0]); SC_W1(reg1, ldo[1]); SC_W1(reg2, ldo[2]); SC_W1(reg3, ldo[3]); SC_W1(reg4, ldo[4]); \
            if (u < 64) SC_W1(regv, ldv); } while (0)
#define SC_YRED(c) do { const LAS unsigned char* yb_ = F.lds + SC_YOFF + ((c) & 1) * SC_YB; _Pragma("unroll") for (int j = 0; j < 2; ++j) { const int o_ = u + 256 * j, tau_ = o_ >> 4, row_ = o_ & 15; \
            const LAS f32x4* s_ = (const LAS f32x4*)(yb_ + tau_ * 1024 + row_ * 64); const f32x4 s0 = s_[0], s1 = s_[1], s2 = s_[2], s3 = s_[3]; \
            const float tot_ = (((s0.x + s0.y) + (s0.z + s0.w)) + ((s1.x + s1.y) + (s1.z + s1.w))) + (((s2.x + s2.y) + (s2.z + s2.w)) + ((s3.x + s3.y) + (s3.z + s3.w))); \
            const int n_ = (c) * SC_TC + tau_, t_ = z ? (T - 1 - n_) : n_; yout[(mb + t_) * CW + h * 64 + rg * 16 + row_] = tot_; } } while (0)
        const int lw = F.vcu * 4 + (wave - 4);
        float wv[32]; const float* wsrc = nullptr; bf16* wdst = nullptr; int wN = 0;
#pragma unroll
        for (int q = 0; q < 32; ++q) wv[q] = 0.f;
        SC_LOAD(0); SC_WRITE(0); SC_LOAD(1);
        __syncthreads();
#pragma unroll 1
        for (int c = 0; c < NCH; ++c) {
            if (c + 1 < NCH) SC_WRITE((c + 1) & 1);
            if (c + 2 < NCH) SC_LOAD(c + 2);
            if (c >= 1) SC_YRED(c - 1);
            const int ph5 = c % 5, j5 = c / 5;
            if (ph5 == 0 && j5 < 48) {
                const int id = lw + 1024 * j5;
                int e, kb, n0, orow, K_ = 1024;
                if (id < 32768) { e = id >> 10; const int q = id & 1023; kb = q >> 5; n0 = (q & 31) * 64; wN = 2048;
                    orow = n0 < 1024 ? 256 * (n0 >> 7) + (n0 & 127) : 256 * ((n0 - 1024) >> 7) + 128 + ((n0 - 1024) & 127);
                    wsrc = a.in[21] + (size_t)e * 1024 * 2048 + (size_t)(kb * 32) * 2048 + n0 + lane; wdst = (bf16*)(ws + WS_WUPT) + (size_t)e * 2048 * 1024 + (size_t)(orow + lane) * K_ + kb * 32; }
                else { const int i2 = id - 32768; e = i2 >> 9; const int q = i2 & 511; kb = q >> 4; n0 = (q & 15) * 64; wN = 1024;
                    wsrc = a.in[23] + (size_t)e * 1024 * 1024 + (size_t)(kb * 32) * 1024 + n0 + lane; wdst = (bf16*)(ws + WS_WDNT) + (size_t)e * 1024 * 1024 + (size_t)(n0 + lane) * K_ + kb * 32; }
#pragma unroll
                for (int q = 0; q < 32; ++q) wv[q] = wsrc[(size_t)q * wN];
            } else if (ph5 == 1 && j5 < 48) {
#pragma unroll
                for (int q4 = 0; q4 < 4; ++q4) { u32x4 o; o.x = cvt_pk_bf16(wv[8 * q4 + 0], wv[8 * q4 + 1]); o.y = cvt_pk_bf16(wv[8 * q4 + 2], wv[8 * q4 + 3]); o.z = cvt_pk_bf16(wv[8 * q4 + 4], wv[8 * q4 + 5]); o.w = cvt_pk_bf16(wv[8 * q4 + 6], wv[8 * q4 + 7]);
                    *(u32x4*)(wdst + 8 * q4) = o; }
            }
            __syncthreads();
        }
        SC_YRED(NCH - 1);
#undef SC_LOAD
#undef SC_W1
#undef SC_WRITE
#undef SC_YRED
    } else {
        const int cg4 = lane & 15, row = wave * 4 + (lane >> 4);
        f32x2 S01 = {0.f, 0.f}, S23 = {0.f, 0.f};
        __syncthreads();
#pragma unroll 1
        for (int c = 0; c < NCH; ++c) {
            const LAS unsigned char* st = F.lds + (c & 1) * SC_STAGE + cg4 * 16;
            const LAS unsigned char* sv = F.lds + (c & 1) * SC_STAGE + 1280 + row * 4;
            LAS float* yb = (LAS float*)(F.lds + SC_YOFF + (c & 1) * SC_YB) + wave * 64 + lane;
            f32x4 Rkk[3], Rw[3], Rak[3], Rk[3], Rr[3]; float Rv[3];
#define SC_LDSTEP(t_, s_) do { Rkk[s_] = *(const LAS f32x4*)(st + (t_) * SC_REC); Rw[s_] = *(const LAS f32x4*)(st + (t_) * SC_REC + 256); Rak[s_] = *(const LAS f32x4*)(st + (t_) * SC_REC + 512); \
                Rk[s_] = *(const LAS f32x4*)(st + (t_) * SC_REC + 768); Rr[s_] = *(const LAS f32x4*)(st + (t_) * SC_REC + 1024); Rv[s_] = *(const LAS float*)(sv + (t_) * SC_REC); } while (0)
            SC_LDSTEP(0, 0); SC_LDSTEP(1, 1);
#pragma unroll
            for (int tau = 0; tau < SC_TC; ++tau) {
                const int sx = tau % 3;
                if (tau + 2 < SC_TC) { const int sn = (tau + 2) % 3; SC_LDSTEP(tau + 2, sn); }
                const f32x2 kk01 = {Rkk[sx].x, Rkk[sx].y}, kk23 = {Rkk[sx].z, Rkk[sx].w};
                f32x2 pd = S01 * kk01; pd = __builtin_elementwise_fma(S23, kk23, pd);
                const float sa = row16_sum(pd.x + pd.y);
                const f32x2 vv = {Rv[sx], Rv[sx]}, nsa = {-sa, -sa};
                const f32x2 w01 = {Rw[sx].x, Rw[sx].y}, w23 = {Rw[sx].z, Rw[sx].w}, k01 = {Rk[sx].x, Rk[sx].y}, k23 = {Rk[sx].z, Rk[sx].w};
                const f32x2 a01 = {Rak[sx].x, Rak[sx].y}, a23 = {Rak[sx].z, Rak[sx].w}, r01 = {Rr[sx].x, Rr[sx].y}, r23 = {Rr[sx].z, Rr[sx].w};
                f32x2 t01 = __builtin_elementwise_fma(S01, w01, k01 * vv), t23 = __builtin_elementwise_fma(S23, w23, k23 * vv);
                S01 = __builtin_elementwise_fma(a01, nsa, t01); S23 = __builtin_elementwise_fma(a23, nsa, t23);
                f32x2 yr = S01 * r01; yr = __builtin_elementwise_fma(S23, r23, yr);
                yb[tau * 256] = yr.x + yr.y;
            }
#undef SC_LDSTEP
            __syncthreads();
        }
    }
    __syncthreads();
}

__device__ __forceinline__ void combine_phase(const Frame& F, const Args& a) {
    unsigned char* ws = a.ws;
    const bf16* att = (const bf16*)(ws + WS_ATT); const bf16* rr = (const bf16*)(ws + WS_R); const bf16* vv = (const bf16*)(ws + WS_V);
    const bf16* kd = (const bf16*)(ws + WS_KDIR); const bf16* gg = (const bf16*)(ws + WS_G); const float* y = (const float*)(ws + WS_Y);
    bf16* mix = (bf16*)(ws + WS_MIX);
    const float* anw = a.in[4]; const float* r_k = a.in[14]; const float* ln_w = a.in[15]; const float* ln_b = a.in[16];
    const int lane = F.lane, c0 = 8 * lane;
    float nw[8], rk[8], lw[8], lb[8];
#pragma unroll
    for (int i = 0; i < 8; ++i) { nw[i] = anw[c0 + i]; rk[i] = r_k[c0 + i]; lw[i] = ln_w[c0 + i]; lb[i] = ln_b[c0 + i]; }
    const int gw = F.vcu * 8 + F.wave, NGW = F.G * 8;
#pragma unroll 2
    for (int m = gw; m < M; m += NGW) {
        const size_t o = (size_t)m * CW + c0;
        float f[8];
        unpack8(*(const u32x4*)(att + o), f);
        float ss = 0.f;
#pragma unroll
        for (int i = 0; i < 8; ++i) ss += f[i] * f[i];
        const float rs = rsqrtf(wave_sum(ss) * (1.f / CW) + RMS_EPS);
#pragma unroll
        for (int i = 0; i < 8; ++i) f[i] = f[i] * rs * nw[i];
        *(u32x4*)(mix + (size_t)m * D + c0) = pack8(f);
        const f32x4 y0a = *(const f32x4*)(y + o), y0b = *(const f32x4*)(y + o + 4), y1a = *(const f32x4*)(y + (size_t)M * CW + o), y1b = *(const f32x4*)(y + (size_t)M * CW + o + 4);
        float yv[8] = {y0a.x + y1a.x, y0a.y + y1a.y, y0a.z + y1a.z, y0a.w + y1a.w, y0b.x + y1b.x, y0b.y + y1b.y, y0b.z + y1b.z, y0b.w + y1b.w};
        float s1 = 0.f;
#pragma unroll
        for (int i = 0; i < 8; ++i) s1 += yv[i];
        s1 += __shfl_xor(s1, 1); s1 += __shfl_xor(s1, 2); s1 += __shfl_xor(s1, 4);
        const float mean = s1 * (1.f / 64.f);
        float s2 = 0.f;
#pragma unroll
        for (int i = 0; i < 8; ++i) { yv[i] -= mean; s2 += yv[i] * yv[i]; }
        s2 += __shfl_xor(s2, 1); s2 += __shfl_xor(s2, 2); s2 += __shfl_xor(s2, 4);
        const float rstd = rsqrtf(s2 * (1.f / 64.f) + GN_EPS);
        float rf[8], k0[8], k1[8], vf[8], gf[8];
        unpack8(*(const u32x4*)(rr + o), rf); unpack8(*(const u32x4*)(kd + o), k0); unpack8(*(const u32x4*)(kd + (size_t)M * CW + o), k1);
        unpack8(*(const u32x4*)(vv + o), vf); unpack8(*(const u32x4*)(gg + o), gf);
        float cf = 0.f;
#pragma unroll
        for (int i = 0; i < 8; ++i) cf += rf[i] * (k0[i] + k1[i]) * rk[i];
        cf += __shfl_xor(cf, 1); cf += __shfl_xor(cf, 2); cf += __shfl_xor(cf, 4);
#pragma unroll
        for (int i = 0; i < 8; ++i) f[i] = (yv[i] * rstd * lw[i] + lb[i] + cf * vf[i]) * gf[i];
        *(u32x4*)(mix + (size_t)m * D + CW + c0) = pack8(f);
    }
}

constexpr int RT_W = 0, RT_HIST = 131072, RT_LOG = 131072 + 256;
__device__ __forceinline__ void router_phase(const Frame& F, const Args& a) {
    unsigned char* ws = a.ws;
    const float* hbuf = (const float*)(ws + WS_H); bf16* hn2 = (bf16*)(ws + WS_HN2);
    int* eidx = (int*)(ws + WS_EIDX); float* gate = (float*)(ws + WS_GATE); int* rank = (int*)(ws + WS_RANK);
    unsigned* ctl = (unsigned*)(ws + WS_CTL);
    const float* n2w = a.in[18]; const float* rw = a.in[19]; const float* rb = a.in[20];
    LAS float* wT = (LAS float*)(F.lds + RT_W); LAS int* hist = (LAS int*)(F.lds + RT_HIST); LAS float* lg = (LAS float*)(F.lds + RT_LOG) + F.wave * 64; LAS int* eL = (LAS int*)(F.lds + RT_LOG + 2048);
    { f32x4 tmp[16];
#pragma unroll
      for (int j = 0; j < 16; ++j) tmp[j] = *((const f32x4*)rw + F.tid + 512 * j);
#pragma unroll
      for (int j = 0; j < 16; ++j) { const int q = F.tid + 512 * j, d = q >> 3, e0 = 4 * (q & 7);
          wT[(e0 + 0) * 1024 + d] = tmp[j].x; wT[(e0 + 1) * 1024 + d] = tmp[j].y; wT[(e0 + 2) * 1024 + d] = tmp[j].z; wT[(e0 + 3) * 1024 + d] = tmp[j].w; } }
    if (F.tid < 32) hist[F.tid] = 0;
    __syncthreads();
    const int lane = F.lane;
    f32x4 wn[4];
#pragma unroll
    for (int j = 0; j < 4; ++j) wn[j] = *((const f32x4*)n2w + lane + 64 * j);
    const int blk = F.vcu;
    for (int pr = 0; pr < 8; ++pr) {
        const int m0 = blk * 128 + F.wave * 16 + pr * 2;
        f32x4 xv[2][4];
#pragma unroll
        for (int tk = 0; tk < 2; ++tk) {
            const f32x4* hr = (const f32x4*)(hbuf + (size_t)(m0 + tk) * D) + lane;
            float s = 0.f;
#pragma unroll
            for (int j = 0; j < 4; ++j) { xv[tk][j] = hr[64 * j]; s += (xv[tk][j].x * xv[tk][j].x + xv[tk][j].y * xv[tk][j].y) + (xv[tk][j].z * xv[tk][j].z + xv[tk][j].w * xv[tk][j].w); }
            const float rs = rsqrtf(wave_sum(s) * (1.f / D) + RMS_EPS);
            u32x2* o8 = (u32x2*)(hn2 + (size_t)(m0 + tk) * D) + lane;
#pragma unroll
            for (int j = 0; j < 4; ++j) { xv[tk][j] = xv[tk][j] * rs * wn[j]; u32x2 o; o.x = cvt_pk_bf16(xv[tk][j].x, xv[tk][j].y); o.y = cvt_pk_bf16(xv[tk][j].z, xv[tk][j].w); o8[64 * j] = o; }
        }
        float kA0 = 0.f, kB0 = 0.f, kA1 = 0.f, kB1 = 0.f;
#pragma unroll 4
        for (int e = 0; e < 32; ++e) {
            float p0 = 0.f, p1 = 0.f;
#pragma unroll
            for (int j = 0; j < 4; ++j) { const f32x4 w4 = *(const LAS f32x4*)(wT + e * 1024 + 256 * j + 4 * lane);
                p0 += (w4.x * xv[0][j].x + w4.y * xv[0][j].y) + (w4.z * xv[0][j].z + w4.w * xv[0][j].w);
                p1 += (w4.x * xv[1][j].x + w4.y * xv[1][j].y) + (w4.z * xv[1][j].z + w4.w * xv[1][j].w); }
            p0 = row16_sum(p0); p1 = row16_sum(p1);
            const bool me = (lane & 15) == (e & 15);
            if (e < 16) { kA0 = me ? p0 : kA0; kA1 = me ? p1 : kA1; } else { kB0 = me ? p0 : kB0; kB1 = me ? p1 : kB1; }
        }
        kA0 += __shfl_xor(kA0, 16); kA0 += __shfl_xor(kA0, 32); kB0 += __shfl_xor(kB0, 16); kB0 += __shfl_xor(kB0, 32);
        kA1 += __shfl_xor(kA1, 16); kA1 += __shfl_xor(kA1, 32); kB1 += __shfl_xor(kB1, 16); kB1 += __shfl_xor(kB1, 32);
        if (lane < 32) { const int tk = lane >> 4, el = lane & 15; lg[tk * 32 + el] = (tk ? kA1 : kA0) + rb[el]; lg[tk * 32 + 16 + el] = (tk ? kB1 : kB0) + rb[16 + el]; }
        asm volatile("s_waitcnt lgkmcnt(0)" ::: "memory");
        if (lane < 2) {
            const LAS float* L = lg + lane * 32; const int m = m0 + lane;
            float v[32];
#pragma unroll
            for (int e = 0; e < 32; ++e) v[e] = L[e];
            float tv[4]; int ti[4];
#pragma unroll
            for (int kx = 0; kx < 4; ++kx) { float best = -3.0e38f; int bi = 0;
#pragma unroll
                for (int e = 0; e < 32; ++e) { if (v[e] > best) { best = v[e]; bi = e; } }
                tv[kx] = best; ti[kx] = bi;
#pragma unroll
                for (int e = 0; e < 32; ++e) { if (e == bi) v[e] = -3.0e38f; } }
            const float e0 = 1.0f, e1 = __expf(tv[1] - tv[0]), e2 = __expf(tv[2] - tv[0]), e3 = __expf(tv[3] - tv[0]);
            const float is = 1.0f / (e0 + e1 + e2 + e3);
            const float gs[4] = {e0 * is, e1 * is, e2 * is, e3 * is};
#pragma unroll
            for (int kx = 0; kx < 4; ++kx) { eidx[m * 4 + kx] = ti[kx]; gate[m * 4 + kx] = gs[kx]; eL[(m - blk * 128) * 4 + kx] = ti[kx]; }
        }
        asm volatile("s_waitcnt lgkmcnt(0)" ::: "memory");
    }
    __syncthreads();
    { const int t = F.tid, e = eL[t]; int rk = 0;
      for (int u = 0; u < t; ++u) rk += (eL[u] == e) ? 1 : 0;
      rank[(blk * 128) * 4 + t] = rk;
      __hip_atomic_fetch_add(&hist[e], 1, __ATOMIC_RELAXED, __HIP_MEMORY_SCOPE_WORKGROUP); }
    __syncthreads();
    if (F.tid < 32) ctl[CW_CNT + blk * 32 + F.tid] = (unsigned)hist[F.tid];
}

__device__ __forceinline__ void dispatch_phase(const Frame& F, const Args& a) {
    unsigned char* ws = a.ws;
    unsigned* ctl = (unsigned*)(ws + WS_CTL);
    const int* eidx = (const int*)(ws + WS_EIDX); const int* rank = (const int*)(ws + WS_RANK); int* dest = (int*)(ws + WS_DEST);
    const bf16* hn2 = (const bf16*)(ws + WS_HN2); bf16* xbuf = (bf16*)(ws + WS_XBUF);
    LAS int* part = (LAS int*)F.lds;
    LAS int* tot = part + 1024;
    const int blk = F.vcu, G = F.G;
    { const int e = F.tid & 31, pt = F.tid >> 5; int s = 0, sb = 0;
      if (G == 256) { int cv[16];
#pragma unroll
          for (int q = 0; q < 16; ++q) cv[q] = (int)ld_u32_agent(ctl + CW_CNT + (pt + 16 * q) * 32 + e);
#pragma unroll
          for (int q = 0; q < 16; ++q) { s += cv[q]; if (pt + 16 * q < blk) sb += cv[q]; } }
      else for (int bb = pt; bb < G; bb += 16) { const int cval = (int)ld_u32_agent(ctl + CW_CNT + bb * 32 + e); s += cval; if (bb < blk) sb += cval; }
      part[pt * 32 + e] = s; part[512 + pt * 32 + e] = sb; }
    __syncthreads();
    if (F.tid < 32) { int s = 0, sb = 0;
        for (int pt = 0; pt < 16; ++pt) { s += part[pt * 32 + F.tid]; sb += part[512 + pt * 32 + F.tid]; }
        tot[F.tid] = s; tot[32 + F.tid] = sb; tot[96 + F.tid] = (s + 255) & ~255; }
    __syncthreads();
    if (F.tid == 0) { int ps = 0; for (int e = 0; e < 32; ++e) { tot[64 + e] = ps; ps += tot[96 + e]; }
        tot[128] = ps >> 8; }
    __syncthreads();
    if (blk == 0) {
        if (F.tid == 0) ctl[CW_NT] = (unsigned)tot[128];
        for (int e = F.tid >> 4; e < 32; e += 32) { const int t0 = tot[64 + e] >> 8, nt = tot[96 + e] >> 8; for (int i = F.tid & 15; i < nt; i += 16) ctl[CW_TEXP + t0 + i] = (unsigned)e; }
    }
    const int lane = F.lane;
    const int mw = blk * 128 + F.wave * 16;
    int dl;
    { const int e = eidx[mw * 4 + lane]; dl = tot[64 + e] + tot[32 + e] + rank[mw * 4 + lane]; dest[mw * 4 + lane] = dl; }
#pragma unroll 2
    for (int i = 0; i < 16; ++i) {
        const u32x4* srow = (const u32x4*)(hn2 + (size_t)(mw + i) * D);
        const u32x4 v0 = srow[lane], v1 = srow[64 + lane];
#pragma unroll
        for (int kx = 0; kx < 4; ++kx) {
            const int d = __shfl(dl, 4 * i + kx);
            u32x4* drow = (u32x4*)(xbuf + (size_t)d * D);
            drow[lane] = v0; drow[64 + lane] = v1;
        }
    }
    { const int e = blk & 31, pt = blk >> 5, np = G >> 5; const int r0 = tot[64 + e] + tot[e], r1 = tot[64 + e] + tot[96 + e]; const u32x4 zero = {0u, 0u, 0u, 0u};
      if (np > 0) for (int r = r0 + pt * 8 + F.wave; r < r1; r += np * 8) { u32x4* drow = (u32x4*)(xbuf + (size_t)r * D); drow[lane] = zero; drow[64 + lane] = zero; } }
}

__device__ __forceinline__ void final_phase(const Frame& F, const Args& a) {
    unsigned char* ws = a.ws;
    const float* hbuf = (const float*)(ws + WS_H); const bf16* ybuf = (const bf16*)(ws + WS_YBUF);
    const int* dest = (const int*)(ws + WS_DEST); const float* gate = (const float*)(ws + WS_GATE);
    const float* fw = a.in[25]; float* out = a.out;
    const int lane = F.lane;
    f32x4 wn[4];
#pragma unroll
    for (int j = 0; j < 4; ++j) wn[j] = *((const f32x4*)fw + lane + 64 * j);
    const int gw = F.vcu * 8 + F.wave, NGW = F.G * 8;
    const int per = M / NGW;
    const int mw = gw * per;
    int dl = 0; float gl = 0.f;
    if (lane < 4 * per && per <= 16) { dl = dest[mw * 4 + lane]; gl = gate[mw * 4 + lane]; }
#pragma unroll 2
    for (int i = 0; i < per; ++i) {
        const int m = mw + i;
        const f32x4* hr = (const f32x4*)(hbuf + (size_t)m * D) + lane;
        f32x4 v[4];
#pragma unroll
        for (int j = 0; j < 4; ++j) v[j] = hr[64 * j];
#pragma unroll
        for (int kx = 0; kx < 4; ++kx) {
            const int d = per <= 16 ? __shfl(dl, 4 * i + kx) : dest[m * 4 + kx]; const float gt = per <= 16 ? __shfl(gl, 4 * i + kx) : gate[m * 4 + kx];
            const u32x2* yr = (const u32x2*)(ybuf + (size_t)d * D) + lane;
#pragma unroll
            for (int j = 0; j < 4; ++j) { const u32x2 w = yr[64 * j]; v[j].x += gt * bflo(w.x); v[j].y += gt * bfhi(w.x); v[j].z += gt * bflo(w.y); v[j].w += gt * bfhi(w.y); }
        }
        float s = 0.f;
#pragma unroll
        for (int j = 0; j < 4; ++j) s += (v[j].x * v[j].x + v[j].y * v[j].y) + (v[j].z * v[j].z + v[j].w * v[j].w);
        const float rs = rsqrtf(wave_sum(s) * (1.f / D) + RMS_EPS);
        f32x4* orow = (f32x4*)(out + (size_t)m * D) + lane;
#pragma unroll
        for (int j = 0; j < 4; ++j) orow[64 * j] = v[j] * rs * wn[j];
    }
}

__global__ void __launch_bounds__(512, 2) fwd_megakernel(Args args) {
    extern __shared__ __attribute__((aligned(16))) unsigned char lds_raw[];
    Frame F;
    F.lds = (LAS unsigned char*)lds_raw;
    F.tid = threadIdx.x; F.lane = F.tid & 63; F.wave = __builtin_amdgcn_readfirstlane(F.tid >> 6);
    F.G = gridDim.x; { const int bx = blockIdx.x; F.vcu = (F.G % 8 == 0) ? (bx % 8) * (F.G / 8) + bx / 8 : bx; }
    unsigned char* ws = args.ws;
    const int lo = args.ph_lo, hi = args.ph_hi;
#define IN(k) (lo <= (k) && (k) < hi)
#if MK_SPLIT
#define SEAM(k) do { } while (0)
#else
    cg::grid_group grid = cg::this_grid();
    { volatile LAS unsigned* st = (volatile LAS unsigned*)(F.lds + LDS_MISC); if (F.tid < 2) st[F.tid] = 0u; __syncthreads(); }
    const XcdBarrier xbar = xcd_barrier_post((unsigned*)(ws + WS_CTL) + CW_BAR, (volatile LAS unsigned*)(F.lds + LDS_MISC));
    if (lo < 0) grid.sync();
#define SEAM(k) do { if (IN(k) && IN((k) + 1)) xcd_barrier(xbar); } while (0)
#endif
#define REP2(k) if constexpr (((MK_REPEAT >> (k)) & 1) != 0)
#define PH1 { pg8::Gemm g{(const bf16*)(ws + WS_HN), (const bf16*)(ws + WS_WINT), 1024, nullptr, 0}; \
        pg8::StaticOrder S; S.init(M / 256, NPROJ_PAD / 256, F.G, (int)blockIdx.x); \
        pg8::EpiProj E{(bf16*)(ws + WS_Q), (bf16*)(ws + WS_K), (bf16*)(ws + WS_VT), (bf16*)(ws + WS_P)}; \
        pg8::gemm_phase<pg8::EpiProj, true, true>(F.lds, g, S, E); }
#define PH5 { pg8::Gemm g{(const bf16*)(ws + WS_MIX), (const bf16*)(ws + WS_WOT), 1024, nullptr, 0}; \
        pg8::StaticOrder S; S.init(M / 256, D / 256, F.G, (int)blockIdx.x); \
        pg8::EpiWo E{args.in[0], (float*)(ws + WS_H)}; \
        pg8::gemm_phase<pg8::EpiWo, true, true>(F.lds, g, S, E); }
#define PH8 { const unsigned* ctl = (const unsigned*)(ws + WS_CTL); const int ntile = (int)ld_u32_agent(ctl + CW_NT); \
        pg8::Gemm g{(const bf16*)(ws + WS_XBUF), (const bf16*)(ws + WS_WUPT), 1024, ctl + CW_TEXP, (size_t)2048 * 1024 * 2}; \
        pg8::StaticOrder S; S.init(ntile, 8, F.G, (int)blockIdx.x); \
        pg8::EpiUp E{args.in[22], (bf16*)(ws + WS_ACT)}; \
        pg8::gemm_phase<pg8::EpiUp, true, true>(F.lds, g, S, E); }
#define PH9 { const unsigned* ctl = (const unsigned*)(ws + WS_CTL); const int ntile = (int)ld_u32_agent(ctl + CW_NT); \
        pg8::Gemm g{(const bf16*)(ws + WS_ACT), (const bf16*)(ws + WS_WDNT), 1024, ctl + CW_TEXP, (size_t)1024 * 1024 * 2}; \
        pg8::StaticOrder S; S.init(ntile, 4, F.G, (int)blockIdx.x); \
        pg8::EpiDown E{args.in[24], (bf16*)(ws + WS_YBUF)}; \
        pg8::gemm_phase<pg8::EpiDown, true, true>(F.lds, g, S, E); }
    if (IN(0)) { p0_prologue(F, args); REP2(0) p0_prologue(F, args); }
    SEAM(0);
    if (IN(1)) { PH1 REP2(1) PH1 }
    SEAM(1);
    if (IN(2)) { prep_phase<true>(F, args); REP2(2) prep_phase<true>(F, args); attn_phase(F, args); REP2(11) attn_phase(F, args); }
    SEAM(2);
    if (IN(3)) { scan_phase(F, args); REP2(3) scan_phase(F, args); }
    SEAM(3);
    if (IN(4)) { combine_phase(F, args); REP2(4) combine_phase(F, args); }
    SEAM(4);
    if (IN(5)) { PH5 REP2(5) PH5 }
    SEAM(5);
    if (IN(6)) { router_phase(F, args); REP2(6) { __syncthreads(); router_phase(F, args); } }
    SEAM(6);
    if (IN(7)) { dispatch_phase(F, args); REP2(7) { __syncthreads(); dispatch_phase(F, args); } }
    SEAM(7);
    if (IN(8)) { PH8 REP2(8) PH8 }
    SEAM(8);
    if (IN(9)) { PH9 REP2(9) PH9 }
    SEAM(9);
    if (IN(10)) { final_phase(F, args); REP2(10) final_phase(F, args); }
#undef IN
#undef SEAM
}

extern "C" void kernel_launch(void* const* d_in, const int* in_sizes, int n_in, void* d_out, int out_size, void* d_ws, size_t ws_size, hipStream_t stream) {
    static int grid = 0;
    if (grid == 0) {
        if (n_in != 26 || in_sizes[0] != M * D || out_size != M * D || ws_size < WS_END) { fprintf(stderr, "kernel_launch: unexpected problem (n_in %d, in0 %d, out %d, ws %zu)\n", n_in, n_in > 0 ? in_sizes[0] : -1, out_size, ws_size); grid = -1; return; }
        int dev = 0, cus = 0, per_cu = 0;
        if (hipGetDevice(&dev) != hipSuccess || hipDeviceGetAttribute(&cus, hipDeviceAttributeMultiprocessorCount, dev) != hipSuccess) { grid = -1; return; }
        if (hipFuncSetAttribute((const void*)fwd_megakernel, hipFuncAttributeMaxDynamicSharedMemorySize, LDS_BYTES) != hipSuccess) { fprintf(stderr, "kernel_launch: hipFuncSetAttribute failed\n"); grid = -1; return; }
        if (hipOccupancyMaxActiveBlocksPerMultiprocessor(&per_cu, (const void*)fwd_megakernel, 512, LDS_BYTES) != hipSuccess || per_cu < 1) { fprintf(stderr, "kernel_launch: occupancy query says %d\n", per_cu); per_cu = 1; }
        (void)hipGetLastError();
        grid = cus * 1;
        if (grid != 256) fprintf(stderr, "kernel_launch: note: %d CUs\n", cus);
    }
    if (grid < 0) return;
    if (hipMemsetAsync((char*)d_ws + WS_CTL + (size_t)CW_BAR * 4, 0, XCD_BAR_WORDS * 4, stream) != hipSuccess) { fprintf(stderr, "kernel_launch: memset failed\n"); return; }
    Args a{};
    for (int i = 0; i < 26; ++i) a.in[i] = (const float*)d_in[i];
    a.out = (float*)d_out; a.ws = (unsigned char*)d_ws;
#if MK_SPLIT
    for (int ph = 0; ph < NPHASE; ++ph) { a.ph_lo = ph; a.ph_hi = ph + 1; hipLaunchKernelGGL(fwd_megakernel, dim3(grid), dim3(512), LDS_BYTES, stream, a); }
#else
    a.ph_lo = 0; a.ph_hi = NPHASE;
    void* kargs[] = {&a};
    hipError_t e = hipLaunchCooperativeKernel((const void*)fwd_megakernel, dim3(grid), dim3(512), kargs, LDS_BYTES, stream);
    if (e != hipSuccess) fprintf(stderr, "kernel_launch: cooperative launch failed: %s (grid %d)\n", hipGetErrorString(e), grid);
#endif
}
```

```cpp
#include <hip/hip_runtime.h>
#include <hip/hip_cooperative_groups.h>
#include <cstdio>
#include <cstdint>
namespace cg = cooperative_groups;

#ifndef MK_SPLIT
#define MK_SPLIT 0
#endif

#ifndef MK_REPEAT
#define MK_REPEAT 0
#endif
#define LAS __attribute__((address_space(3)))
typedef unsigned short bf16;
typedef float f32x4 __attribute__((ext_vector_type(4)));
typedef float f32x2 __attribute__((ext_vector_type(2)));
typedef unsigned u32x4 __attribute__((ext_vector_type(4)));
typedef unsigned u32x2 __attribute__((ext_vector_type(2)));
typedef short bf16x8 __attribute__((ext_vector_type(8)));

constexpr int BATCH = 4, T = 8192, D = 1024, M = BATCH * T;
constexpr int NH = 8, HD = 64, CW = 512;
constexpr int SHIFT_W = 1920, NPROJ = 3456, NPROJ_PAD = 3584, PW = 2048;
constexpr int NE = 32, TOPK = 4, DE = 1024;
constexpr int GRIDW = 64, GROWS = 128;
constexpr int P_TILES_MAX = 544, P_ROWS = P_TILES_MAX * 256;
constexpr float RMS_EPS = 1e-5f, GN_EPS = 64e-5f;
constexpr int NPHASE = 11;

constexpr size_t MiB = 1u << 20;
constexpr size_t WS_CTL = 0;
constexpr size_t WS_W2T = 1 * MiB, WS_A2T = WS_W2T + 131072, WS_G2T = WS_A2T + 131072;
constexpr size_t WS_WINT = 2 * MiB, WS_WOT = 9 * MiB, WS_WUPT = 12 * MiB, WS_WDNT = 140 * MiB;
constexpr size_t WS_EIDX = 204 * MiB, WS_GATE = WS_EIDX + 524288, WS_RANK = WS_GATE + 524288, WS_DEST = WS_RANK + 524288, WS_ROWTOK = WS_DEST + 524288;
constexpr size_t WS_R = 208 * MiB, WS_V = 240 * MiB, WS_KK = 272 * MiB, WS_DECAY = 304 * MiB, WS_KDIR = 368 * MiB, WS_AKK = 432 * MiB,
                 WS_G = 496 * MiB, WS_ATT = 528 * MiB;
constexpr size_t WS_Q = 560 * MiB, WS_K = 592 * MiB, WS_VT = 624 * MiB, WS_P = 656 * MiB, WS_HN = 784 * MiB, WS_Y = 848 * MiB;
constexpr size_t WS_MIX = 560 * MiB, WS_H = 752 * MiB, WS_HN2 = 880 * MiB, WS_XBUF = 208 * MiB, WS_ACT = 480 * MiB, WS_YBUF = 208 * MiB;
constexpr size_t WS_END = 976 * MiB;
constexpr int CW_NT = 0, CW_TEXP = 64, CW_CNT = 1024, CW_BAR = 16384;

constexpr int LDS_BYTES = 159744, LDS_MISC = LDS_BYTES - 256;

typedef __bf16 bf16x2_t __attribute__((ext_vector_type(2)));
__device__ __forceinline__ unsigned cvt_pk_bf16(float lo, float hi) { const f32x2 v = {lo, hi}; return __builtin_bit_cast(unsigned, __builtin_convertvector(v, bf16x2_t)); }
__device__ __forceinline__ float bflo(unsigned u) { return __uint_as_float(u << 16); }
__device__ __forceinline__ float bfhi(unsigned u) { return __uint_as_float(u & 0xffff0000u); }
__device__ __forceinline__ float bf1(bf16 v) { return __uint_as_float(((unsigned)v) << 16); }
__device__ __forceinline__ void unpack8(const u32x4 u, float* f) { f[0] = bflo(u.x); f[1] = bfhi(u.x); f[2] = bflo(u.y); f[3] = bfhi(u.y); f[4] = bflo(u.z); f[5] = bfhi(u.z); f[6] = bflo(u.w); f[7] = bfhi(u.w); }
__device__ __forceinline__ u32x4 pack8(const float* f) { u32x4 o; o.x = cvt_pk_bf16(f[0], f[1]); o.y = cvt_pk_bf16(f[2], f[3]); o.z = cvt_pk_bf16(f[4], f[5]); o.w = cvt_pk_bf16(f[6], f[7]); return o; }
__device__ __forceinline__ float wave_sum(float v) {
#pragma unroll
    for (int o = 1; o < 64; o <<= 1) v += __shfl_xor(v, o);
    return v;
}
__device__ __forceinline__ float sigmoidf_(float x) { return __builtin_amdgcn_rcpf(1.0f + __expf(-x)); }
__device__ __forceinline__ unsigned ld_u32_agent(const unsigned* p) { return __hip_atomic_load(p, __ATOMIC_RELAXED, __HIP_MEMORY_SCOPE_AGENT); }

namespace pg8 {
constexpr int BM = 256, BK = 64, HALF = 128, HTB = HALF * BK * 2, STAGE_BYTES = 8 * HTB, NXCD = 8, WGM = 8;
__host__ __device__ __forceinline__ int lds_byte(int r, int c) { const int st = (r >> 4) * 2 + (c >> 5), rr = r & 15, cc = c & 31, ob = rr * 64 + cc * 2; return st * 1024 + (ob ^ (((ob >> 9) & 1) << 5)); }
__host__ __device__ __forceinline__ void stage_rc(int b, int& R, int& C) { const int st = b / 1024, sb = b % 1024, swz = sb ^ (((sb >> 9) & 1) << 5); R = (st >> 1) * 16 + swz / 64; C = (st & 1) * 32 + (swz % 64) / 2; }
__host__ __device__ __forceinline__ int perm32(int rho) { const int n = rho >> 4, i = rho & 15; return 8 * (i >> 2) + 4 * n + (i & 3); }

struct Unit { int pm, pn, e; };
struct Gemm { const bf16* A; const bf16* Bt; int K; const unsigned* texp; size_t bstride; const int* rowtok; };

struct StaticOrder {
    int nM, nN, nwg, G, c;
    __device__ void init(int nM_, int nN_, int G_, int c_) { nM = nM_; nN = nN_; nwg = nM * nN; G = G_; c = c_; }
    __device__ bool next(int i, Unit& u) const {
        const long L = (long)i * G + c; if (L >= nwg) return false;
        int wgid = (int)L; { const int q = nwg / NXCD, r = nwg % NXCD, xcd = wgid % NXCD, off = wgid / NXCD; wgid = (xcd < r ? xcd * (q + 1) : r * (q + 1) + (xcd - r) * q) + off; }
        const int nig = WGM * nN, gid = wgid / nig, fm = gid * WGM, gsz = (nM - fm) < WGM ? (nM - fm) : WGM;
        u.pm = fm + ((wgid % nig) % gsz); u.pn = (wgid % nig) / gsz; u.e = 0; return true;
    }
};

template <class Epi, bool ALIGN_EPI, bool SP2, bool GATHER = false>
__device__ __forceinline__ void gemm_phase(LAS unsigned char* lds, const Gemm g, const StaticOrder& S, const Epi& E) {
    const int tid = threadIdx.x, wid = __builtin_amdgcn_readfirstlane(tid >> 6), lane = tid & 63, wr = wid >> 2, wc = wid & 3, fr = lane & 15, fq = lane >> 4;
    const int K = g.K, nt = K / BK;
    unsigned voffA[2], voffB[2];
#pragma unroll
    for (int i = 0; i < 2; ++i) { int R, C; stage_rc(tid * 16 + i * 8192, R, C); const int Rb = Epi::PERM ? ((R & ~31) + perm32(R & 31)) : R;
        voffA[i] = (unsigned)(R * K + C) * 2u; voffB[i] = (unsigned)(Rb * K + C) * 2u; }
    unsigned vC[2][2];
#define PG8_GROWS(u, dst) do { _Pragma("unroll") for (int h_ = 0; h_ < 2; ++h_) _Pragma("unroll") for (int i_ = 0; i_ < 2; ++i_) { int R_, C_; stage_rc(tid * 16 + i_ * 8192, R_, C_); \
        dst[h_][i_] = (unsigned)g.rowtok[(u).pm * BM + h_ * HALF + R_] * (unsigned)(K * 2) + (unsigned)(C_ * 2); } } while (0)
    const size_t kstep = (size_t)(BK * 2);
    const size_t hstep = (size_t)HALF * K * 2;
    const size_t tstep = 2 * hstep;
    const unsigned ldsw = (unsigned)wid * 1024u;
    const int aoff = lds_byte(wr * 64 + fr, fq * 8), boff = lds_byte(wc * 32 + fr, fq * 8);
#define PG8_SA(b, h) (((b) * 2 + (h)) * HTB)
#define PG8_SB(b, h) ((4 + (b) * 2 + (h)) * HTB)
#define PG8_STAGE(bufoff, gbase, voff) do { _Pragma("unroll") for (int _i = 0; _i < 2; ++_i) \
        __builtin_amdgcn_global_load_lds((const unsigned*)((const char*)(gbase) + (voff)[_i]), (LAS unsigned*)(lds + (bufoff) + ldsw + _i * 8192), 16, 0, 0); } while (0)
#define PG8_STAGE_A(bufoff, p, h, nx) do { if constexpr (GATHER) { PG8_STAGE(bufoff, p, vC[h]); } else PG8_STAGE(bufoff, (p) + (h) * hstep, voffA); } while (0)
#define PG8_LDA(dst, b, h) do { _Pragma("unroll") for (int m = 0; m < 4; ++m) _Pragma("unroll") for (int k = 0; k < 2; ++k) dst[m][k] = *(const LAS bf16x8*)(lds + PG8_SA(b, h) + aoff + m * 2048 + k * 1024); } while (0)
#define PG8_LDB(dst, b, h) do { _Pragma("unroll") for (int n = 0; n < 2; ++n) _Pragma("unroll") for (int k = 0; k < 2; ++k) dst[n][k] = *(const LAS bf16x8*)(lds + PG8_SB(b, h) + boff + n * 2048 + k * 1024); } while (0)
#define PG8_MMA(ai, bj, At, Bt) do { __builtin_amdgcn_s_setprio(1); _Pragma("unroll") for (int m = 0; m < 4; ++m) _Pragma("unroll") for (int n = 0; n < 2; ++n) _Pragma("unroll") for (int k = 0; k < 2; ++k) \
        acc[ai][bj][m][n] = __builtin_amdgcn_mfma_f32_16x16x32_bf16(Bt[n][k], At[m][k], acc[ai][bj][m][n], 0, 0, 0); __builtin_amdgcn_s_setprio(0); } while (0)
#define PG8_WAIT_V(n) asm volatile("s_waitcnt vmcnt(" #n ")" ::: "memory")
#define PG8_WAIT_L(n) asm volatile("s_waitcnt lgkmcnt(" #n ")" ::: "memory")
#define PG8_BAR __builtin_amdgcn_s_barrier()
#define PG8_SCHED __builtin_amdgcn_sched_barrier(0)
#define PG8_UPTR(u, pa, pb) do { unsigned _e = g.texp ? ld_u32_agent(g.texp + (u).pm) : 0u; _e = (unsigned)__builtin_amdgcn_readfirstlane((int)_e); (u).e = (int)_e; \
        pa = GATHER ? (const char*)g.A : (const char*)g.A + (size_t)(u).pm * tstep; pb = (const char*)g.Bt + (size_t)_e * g.bstride + (size_t)(u).pn * tstep; } while (0)
    Unit cur, nxt; int ui = 0;
    if (!S.next(0, cur)) return;
    f32x4 acc[2][2][4][2];
#pragma unroll
    for (int a = 0; a < 2; ++a)
#pragma unroll
        for (int b = 0; b < 2; ++b)
#pragma unroll
            for (int m = 0; m < 4; ++m)
#pragma unroll
                for (int n = 0; n < 2; ++n) acc[a][b][m][n] = (f32x4){0.f, 0.f, 0.f, 0.f};
    bf16x8 At[4][2], B0[2][2], B1[2][2];
    const char* cA; const char* cB;
    PG8_UPTR(cur, cA, cB);
    if constexpr (GATHER) { PG8_GROWS(cur, vC); }
    if constexpr (SP2) {
        PG8_STAGE(PG8_SB(0, 0), cB, voffB); PG8_STAGE(PG8_SB(0, 1), cB + hstep, voffB); PG8_STAGE_A(PG8_SA(0, 0), cA, 0, false); PG8_STAGE_A(PG8_SA(0, 1), cA, 1, false);
        if (wr == 1) PG8_BAR;
        PG8_WAIT_V(2); PG8_BAR;
        PG8_STAGE(PG8_SB(1, 0), cB + kstep, voffB); PG8_STAGE_A(PG8_SA(1, 0), cA + kstep, 0, false); PG8_STAGE(PG8_SB(1, 1), cB + hstep + kstep, voffB);
        PG8_WAIT_V(6); PG8_BAR;
    } else {
        PG8_STAGE(PG8_SB(0, 0), cB, voffB); PG8_STAGE_A(PG8_SA(0, 0), cA, 0, false); PG8_STAGE(PG8_SB(0, 1), cB + hstep, voffB); PG8_STAGE_A(PG8_SA(0, 1), cA, 1, false);
        if (wr == 1) PG8_BAR;
        PG8_WAIT_V(4); PG8_BAR;
        PG8_STAGE(PG8_SB(1, 0), cB + kstep, voffB); PG8_STAGE_A(PG8_SA(1, 0), cA + kstep, 0, false); PG8_STAGE(PG8_SB(1, 1), cB + hstep + kstep, voffB);
        PG8_WAIT_V(6); PG8_BAR;
    }
    for (;;) {
        const bool has_next = S.next(ui + 1, nxt);
        const char* nA = cA; const char* nB = cB;
        if (has_next) PG8_UPTR(nxt, nA, nB);
        for (int t = 0; t < nt; t += 2) {
            const bool last = (t == nt - 2);
            const char* a1 = cA + (size_t)(t + 1) * kstep;
            const char* a2 = last ? nA : cA + (size_t)(t + 2) * kstep; const char* b2 = last ? nB : cB + (size_t)(t + 2) * kstep;
            const char* a3 = a2 + kstep; const char* b3 = b2 + kstep;
            if constexpr (SP2) {
            PG8_LDB(B0, 0, 0); PG8_LDB(B1, 0, 1); PG8_SCHED; PG8_LDA(At, 0, 0); PG8_STAGE_A(PG8_SA(1, 1), a1, 1, false);
            if constexpr (GATHER) { if (last && has_next) { PG8_GROWS(nxt, vC); } }
            PG8_WAIT_V(8); PG8_WAIT_L(0); PG8_BAR; PG8_MMA(0, 0, At, B0); PG8_MMA(0, 1, At, B1); PG8_BAR; PG8_SCHED;
            PG8_LDA(At, 0, 1); PG8_STAGE(PG8_SB(0, 0), b2, voffB); PG8_STAGE(PG8_SB(0, 1), b2 + hstep, voffB); PG8_STAGE_A(PG8_SA(0, 0), a2, 0, last);
            PG8_WAIT_V(8); PG8_WAIT_L(0); PG8_BAR; PG8_MMA(1, 0, At, B0); PG8_MMA(1, 1, At, B1); PG8_BAR; PG8_SCHED;
            PG8_LDB(B0, 1, 0); PG8_LDB(B1, 1, 1); PG8_SCHED; PG8_LDA(At, 1, 0); PG8_STAGE_A(PG8_SA(0, 1), a2, 1, last);
            PG8_WAIT_V(8); PG8_WAIT_L(0); PG8_BAR; PG8_MMA(0, 0, At, B0); PG8_MMA(0, 1, At, B1); PG8_BAR; PG8_SCHED;
            PG8_LDA(At, 1, 1); PG8_STAGE(PG8_SB(1, 0), b3, voffB); PG8_STAGE(PG8_SB(1, 1), b3 + hstep, voffB); PG8_STAGE_A(PG8_SA(1, 0), a3, 0, last);
            PG8_WAIT_V(8); PG8_WAIT_L(0); PG8_BAR; PG8_MMA(1, 0, At, B0); PG8_MMA(1, 1, At, B1); PG8_BAR; PG8_SCHED;
            } else {
            PG8_LDB(B0, 0, 0); PG8_SCHED; PG8_LDA(At, 0, 0); PG8_STAGE_A(PG8_SA(1, 1), a1, 1, false);
            if constexpr (GATHER) { if (last && has_next) { PG8_GROWS(nxt, vC); } }
            PG8_WAIT_L(8); PG8_BAR; PG8_WAIT_L(0); PG8_MMA(0, 0, At, B0); PG8_BAR; PG8_SCHED;
            PG8_LDB(B1, 0, 1); PG8_STAGE(PG8_SB(0, 0), b2, voffB);
            PG8_BAR; PG8_WAIT_L(0); PG8_MMA(0, 1, At, B1); PG8_BAR;
            PG8_LDA(At, 0, 1); PG8_STAGE_A(PG8_SA(0, 0), a2, 0, last);
            PG8_BAR; PG8_WAIT_L(0); PG8_MMA(1, 0, At, B0); PG8_BAR; PG8_SCHED;
            PG8_STAGE(PG8_SB(0, 1), b2 + hstep, voffB);
            PG8_WAIT_V(6); PG8_BAR; PG8_MMA(1, 1, At, B1); PG8_BAR;
            PG8_LDB(B0, 1, 0); PG8_SCHED; PG8_LDA(At, 1, 0); PG8_STAGE_A(PG8_SA(0, 1), a2, 1, last);
            PG8_WAIT_L(8); PG8_BAR; PG8_WAIT_L(0); PG8_MMA(0, 0, At, B0); PG8_BAR; PG8_SCHED;
            PG8_LDB(B1, 1, 1); PG8_STAGE(PG8_SB(1, 0), b3, voffB);
            PG8_BAR; PG8_WAIT_L(0); PG8_MMA(0, 1, At, B1); PG8_BAR;
            PG8_LDA(At, 1, 1); PG8_STAGE_A(PG8_SA(1, 0), a3, 0, last);
            PG8_BAR; PG8_WAIT_L(0); PG8_MMA(1, 0, At, B0); PG8_BAR; PG8_SCHED;
            PG8_STAGE(PG8_SB(1, 1), b3 + hstep, voffB);
            PG8_WAIT_V(6); PG8_BAR; PG8_MMA(1, 1, At, B1); PG8_BAR;
            }
        }
        if constexpr (ALIGN_EPI) { if (wr == 0) PG8_BAR; }
        E(acc, cur, wr, wc, fr, fq);
        if (!has_next) break;
#pragma unroll
        for (int a = 0; a < 2; ++a)
#pragma unroll
            for (int b = 0; b < 2; ++b)
#pragma unroll
                for (int m = 0; m < 4; ++m)
#pragma unroll
                    for (int n = 0; n < 2; ++n) acc[a][b][m][n] = (f32x4){0.f, 0.f, 0.f, 0.f};
        cur = nxt; cA = nA; cB = nB; ++ui;
        if constexpr (ALIGN_EPI) { if (wr == 1) PG8_BAR; }
    }
    PG8_WAIT_V(0);
    if constexpr (!ALIGN_EPI) { if (wr == 0) PG8_BAR; }
    PG8_BAR;
#undef PG8_SA
#undef PG8_SB
#undef PG8_STAGE
#undef PG8_LDA
#undef PG8_LDB
#undef PG8_MMA
#undef PG8_WAIT_V
#undef PG8_WAIT_L
#undef PG8_BAR
#undef PG8_SCHED
#undef PG8_UPTR
#undef PG8_STAGE_A
#undef PG8_GROWS
}

struct EpiProj {
    static constexpr bool PERM = true;
    bf16 *q, *k, *vT, *p;
    __device__ __forceinline__ void operator()(const f32x4 (&acc)[2][2][4][2], const Unit& u, int wr, int wc, int fr, int fq) const {
        const int row0 = u.pm * BM + wr * 64 + fr;
        const int pn = u.pn;
#pragma unroll
        for (int ai = 0; ai < 2; ++ai)
#pragma unroll
            for (int m = 0; m < 4; ++m) {
                const int row = row0 + ai * HALF + m * 16;
#pragma unroll
                for (int bj = 0; bj < 2; ++bj) {
                    f32x4 v0 = acc[ai][bj][m][0], v1 = acc[ai][bj][m][1];
                    const int col = pn * BM + bj * HALF + wc * 32 + 8 * fq;
                    if (pn >= 4 && pn < 6) {
                        const int cv = col - 1024, hh = cv >> 6, dim = cv & 63, b = row / T, t = row % T;
                        bf16* dst = vT + ((size_t)((b * NH + hh) * HD + dim)) * T + t;
                        const unsigned w0 = cvt_pk_bf16(v0[0], v0[1]), w1 = cvt_pk_bf16(v0[2], v0[3]), w2 = cvt_pk_bf16(v1[0], v1[1]), w3 = cvt_pk_bf16(v1[2], v1[3]);
                        dst[0 * (size_t)T] = (bf16)(w0 & 0xffff); dst[1 * (size_t)T] = (bf16)(w0 >> 16); dst[2 * (size_t)T] = (bf16)(w1 & 0xffff); dst[3 * (size_t)T] = (bf16)(w1 >> 16);
                        dst[4 * (size_t)T] = (bf16)(w2 & 0xffff); dst[5 * (size_t)T] = (bf16)(w2 >> 16); dst[6 * (size_t)T] = (bf16)(w3 & 0xffff); dst[7 * (size_t)T] = (bf16)(w3 >> 16);
                    } else {
                        bf16* dst;
                        if (pn < 2) { v0 = v0 * 0.125f; v1 = v1 * 0.125f; dst = q + (size_t)row * CW + col; }
                        else if (pn < 4) dst = k + (size_t)row * CW + (col - 512);
                        else dst = p + (size_t)row * PW + (col - 1536);
                        u32x4 w; w.x = cvt_pk_bf16(v0[0], v0[1]); w.y = cvt_pk_bf16(v0[2], v0[3]); w.z = cvt_pk_bf16(v1[0], v1[1]); w.w = cvt_pk_bf16(v1[2], v1[3]);
                        *(u32x4*)dst = w;
                    }
                }
            }
    }
};
struct EpiWo {
    static constexpr bool PERM = false;
    const float* x; float* h;
    __device__ __forceinline__ void operator()(const f32x4 (&acc)[2][2][4][2], const Unit& u, int wr, int wc, int fr, int fq) const {
        const int row0 = u.pm * BM + wr * 64 + fr, col0 = u.pn * BM + wc * 32 + 4 * fq;
#pragma unroll
        for (int ai = 0; ai < 2; ++ai)
#pragma unroll
            for (int m = 0; m < 4; ++m) { const size_t off = (size_t)(row0 + ai * HALF + m * 16) * D + col0;
#pragma unroll
                for (int bj = 0; bj < 2; ++bj)
#pragma unroll
                    for (int n = 0; n < 2; ++n) { const f32x4 xv = *(const f32x4*)(x + off + bj * HALF + n * 16); *(f32x4*)(h + off + bj * HALF + n * 16) = acc[ai][bj][m][n] + xv; } }
    }
};
struct EpiUp {
    static constexpr bool PERM = true;
    const float* b_up; bf16* act;
    __device__ __forceinline__ void operator()(const f32x4 (&acc)[2][2][4][2], const Unit& u, int wr, int wc, int fr, int fq) const {
        const int row0 = u.pm * BM + wr * 64 + fr, ch = u.pn * 128 + wc * 32 + 8 * fq;
        const float* bg = b_up + (size_t)u.e * 2048 + ch; const float* bl = bg + 1024;
        const f32x4 bg0 = *(const f32x4*)bg, bg1 = *(const f32x4*)(bg + 4), bl0 = *(const f32x4*)bl, bl1 = *(const f32x4*)(bl + 4);
#pragma unroll
        for (int ai = 0; ai < 2; ++ai)
#pragma unroll
            for (int m = 0; m < 4; ++m) {
                float o[8];
#pragma unroll
                for (int n = 0; n < 2; ++n) { const f32x4 gv = acc[ai][0][m][n] + (n ? bg1 : bg0), lv = acc[ai][1][m][n] + (n ? bl1 : bl0);
#pragma unroll
                    for (int j = 0; j < 4; ++j) { const float gt = fminf(gv[j], 7.0f), li = fminf(fmaxf(lv[j], -7.0f), 7.0f); o[n * 4 + j] = (li + 1.0f) * gt * sigmoidf_(1.702f * gt); } }
                *(u32x4*)(act + (size_t)(row0 + ai * HALF + m * 16) * DE + ch) = pack8(o);
            }
    }
};
struct EpiDown {
    static constexpr bool PERM = true;
    const float* b_dn; bf16* y;
    __device__ __forceinline__ void operator()(const f32x4 (&acc)[2][2][4][2], const Unit& u, int wr, int wc, int fr, int fq) const {
        const int row0 = u.pm * BM + wr * 64 + fr, col0 = u.pn * BM + wc * 32 + 8 * fq;
        const float* bb = b_dn + (size_t)u.e * D + col0;
        f32x4 bv[2][2];
#pragma unroll
        for (int bj = 0; bj < 2; ++bj)
#pragma unroll
            for (int n = 0; n < 2; ++n) bv[bj][n] = *(const f32x4*)(bb + bj * HALF + 4 * n);
#pragma unroll
        for (int ai = 0; ai < 2; ++ai)
#pragma unroll
            for (int m = 0; m < 4; ++m) { bf16* rowp = y + (size_t)(row0 + ai * HALF + m * 16) * D + col0;
#pragma unroll
                for (int bj = 0; bj < 2; ++bj) { const f32x4 v0 = acc[ai][bj][m][0] + bv[bj][0], v1 = acc[ai][bj][m][1] + bv[bj][1];
                    u32x4 w; w.x = cvt_pk_bf16(v0[0], v0[1]); w.y = cvt_pk_bf16(v0[2], v0[3]); w.z = cvt_pk_bf16(v1[0], v1[1]); w.w = cvt_pk_bf16(v1[2], v1[3]);
                    *(u32x4*)(rowp + bj * HALF) = w; } }
    }
};
}


#define XB_TMO      128
#define XB_XCNT(j)  (256  + 64 * (j))
#define XB_XSUB(j)  (1280 + 64 * (j))
#define XB_XGEN(j)  (2304 + 64 * (j))
#define XB_TOP      3328
#define XB_TOPGEN   3392
#define XCD_BAR_WORDS 3456
#define XB_SPIN_CAP (1u << 20)
__device__ __forceinline__ unsigned xb_ld(unsigned* p)              { return __hip_atomic_load(p, __ATOMIC_RELAXED, __HIP_MEMORY_SCOPE_AGENT); }
__device__ __forceinline__ unsigned xb_add(unsigned* p, unsigned v) { return __hip_atomic_fetch_add(p, v, __ATOMIC_RELAXED, __HIP_MEMORY_SCOPE_AGENT); }
__device__ __forceinline__ unsigned xb_xcc_id() { return (unsigned)__builtin_amdgcn_s_getreg((3 << 11) | 20) & 0xFu; }
#define XB_SPIN(cond, bar) do { unsigned _sp = 0; while (cond) { __builtin_amdgcn_s_sleep(1); \
    if ((++_sp & 255u) == 0u) { if (xb_ld(&(bar)[XB_TMO])) break; if (_sp > XB_SPIN_CAP) { atomicAdd(&(bar)[XB_TMO], 1u); break; } } } } while (0)
struct XcdBarrier { unsigned* bar; unsigned x; volatile LAS unsigned* st; };
__device__ __forceinline__ XcdBarrier xcd_barrier_post(unsigned* bar, volatile LAS unsigned* st) {
    XcdBarrier b; b.bar = bar; b.x = xb_xcc_id(); b.st = st;
    if (threadIdx.x == 0) (void)xb_add(&bar[XB_XCNT(b.x)], 1u);
    return b;
}
__device__ __forceinline__ void xcd_barrier_complete(unsigned* bar, unsigned x, unsigned& nloc, unsigned& nx) {
    const unsigned G = gridDim.x * gridDim.y * gridDim.z;
    unsigned sum, cnt, mine, sp = 0u;
    for (;;) {
        sum = 0u; cnt = 0u; mine = 0u;
#pragma unroll
        for (unsigned j = 0; j < 16; ++j) { const unsigned c = xb_ld(&bar[XB_XCNT(j)]); sum += c; cnt += (c > 0u) ? 1u : 0u; mine = (j == x) ? c : mine; }
        if (sum == G) break;
        __builtin_amdgcn_s_sleep(1);
        if ((++sp & 255u) == 0u) { if (xb_ld(&bar[XB_TMO])) break; if (sp > XB_SPIN_CAP) { atomicAdd(&bar[XB_TMO], 1u); break; } }
    }
    nloc = mine > 0u ? mine : 1u; nx = cnt > 0u ? cnt : 1u;
}
__device__ __forceinline__ void xcd_barrier(const XcdBarrier& b) {
    asm volatile("s_waitcnt vmcnt(0)" ::: "memory");
    __syncthreads();
    if (threadIdx.x == 0) {
        unsigned* bar = b.bar;
        __builtin_amdgcn_s_waitcnt(0);
        unsigned nloc = b.st[0], nx = b.st[1];
        if (nloc == 0u) { xcd_barrier_complete(bar, b.x, nloc, nx); b.st[0] = nloc; b.st[1] = nx; }
        const unsigned old = xb_add(&bar[XB_XSUB(b.x)], 1u);
        const unsigned gen = old / nloc;
        if (old + 1u == (gen + 1u) * nloc) {
            __builtin_amdgcn_fence(__ATOMIC_RELEASE, "agent");
            asm volatile("s_waitcnt vmcnt(0)" ::: "memory");
            const unsigned og = xb_add(&bar[XB_TOP], 1u);
            const unsigned tg = og / nx;
            if (og + 1u == (tg + 1u) * nx) xb_add(&bar[XB_TOPGEN], 1u);
            else XB_SPIN(xb_ld(&bar[XB_TOPGEN]) == tg, bar);
            __builtin_amdgcn_fence(__ATOMIC_ACQUIRE, "agent");
            xb_add(&bar[XB_XGEN(b.x)], 1u);
            asm volatile("s_waitcnt vmcnt(0)" ::: "memory");
        } else {
            XB_SPIN(xb_ld(&bar[XB_XGEN(b.x)]) == gen, bar);
            __builtin_amdgcn_fence(__ATOMIC_ACQUIRE, "agent");
            asm volatile("s_waitcnt vmcnt(0)" ::: "memory");
        }
    }
    __syncthreads();
}

struct Args { const float* in[26]; float* out; unsigned char* ws; int ph_lo, ph_hi; };

struct Frame { LAS unsigned char* lds; int tid, lane, wave, G, vcu; };

__device__ __forceinline__ void transpose_item(const float* W, int K, int N, bf16* WT, int k0, int n0, int orow0, LAS float* scr, int lane) {
#pragma unroll 8
    for (int i = 0; i < 32; ++i) { const int kk = 2 * i + (lane >> 5); scr[kk * 33 + (lane & 31)] = W[(size_t)(k0 + kk) * N + n0 + (lane & 31)]; }
    asm volatile("s_waitcnt lgkmcnt(0)" ::: "memory");
    const int c = lane & 7;
#pragma unroll
    for (int j = 0; j < 4; ++j) { const int n = (lane >> 3) + 8 * j; const LAS float* s = scr + (8 * c) * 33 + n;
        u32x4 o; o.x = cvt_pk_bf16(s[0 * 33], s[1 * 33]); o.y = cvt_pk_bf16(s[2 * 33], s[3 * 33]); o.z = cvt_pk_bf16(s[4 * 33], s[5 * 33]); o.w = cvt_pk_bf16(s[6 * 33], s[7 * 33]);
        *(u32x4*)(WT + (size_t)(orow0 + n) * K + k0 + 8 * c) = o; }
    asm volatile("s_waitcnt lgkmcnt(0)" ::: "memory");
}

__device__ __forceinline__ void p0_prologue(const Frame& F, const Args& a) {
    unsigned char* ws = a.ws;
    LAS float* scr = (LAS float*)(F.lds + F.wave * 8448);
    const int gw = F.vcu * 8 + F.wave, NGW = F.G * 8;
    constexpr int I_IN = 16 * 108, I_O = 16 * 32, I_UP = 0, I_DN = 0, I_L = 16, I_G = 32;
    constexpr int NITEMS = I_IN + I_O + I_UP + I_DN + 2 * I_L + 2 * I_L + I_G;
    for (int it = gw; it < NITEMS; it += NGW) {
        int r = it;
        if (r < I_UP) {
            const int e = r / 1024, q = r % 1024, kb = q / 64, nb = q % 64, n0 = nb * 32;
            const int orow0 = n0 < 1024 ? 256 * (n0 >> 7) + (n0 & 127) : 256 * ((n0 - 1024) >> 7) + 128 + ((n0 - 1024) & 127);
            transpose_item(a.in[21] + (size_t)e * 1024 * 2048, 1024, 2048, (bf16*)(ws + WS_WUPT) + (size_t)e * 2048 * 1024, kb * 64, n0, orow0, scr, F.lane); continue; }
        r -= I_UP;
        if (r < I_DN) { const int e = r / 512, q = r % 512, kb = q / 32, nb = q % 32;
            transpose_item(a.in[23] + (size_t)e * 1024 * 1024, 1024, 1024, (bf16*)(ws + WS_WDNT) + (size_t)e * 1024 * 1024, kb * 64, nb * 32, nb * 32, scr, F.lane); continue; }
        r -= I_DN;
        if (r < I_IN) { const int kb = r / 108, nb = r % 108; transpose_item(a.in[2], 1024, NPROJ, (bf16*)(ws + WS_WINT), kb * 64, nb * 32, nb * 32, scr, F.lane); continue; }
        r -= I_IN;
        if (r < I_O) { const int kb = r / 32, nb = r % 32; transpose_item(a.in[17], 1024, 1024, (bf16*)(ws + WS_WOT), kb * 64, nb * 32, nb * 32, scr, F.lane); continue; }
        r -= I_O;
        if (r < 2 * I_L) { const int z = r / 16, nb = r % 16; transpose_item(a.in[8] + (size_t)z * 64 * 512, 64, 512, (bf16*)(ws + WS_W2T) + (size_t)z * 512 * 64, 0, nb * 32, nb * 32, scr, F.lane); continue; }
        r -= 2 * I_L;
        if (r < 2 * I_L) { const int z = r / 16, nb = r % 16; transpose_item(a.in[10] + (size_t)z * 64 * 512, 64, 512, (bf16*)(ws + WS_A2T) + (size_t)z * 512 * 64, 0, nb * 32, nb * 32, scr, F.lane); continue; }
        r -= 2 * I_L;
        { const int kb = r / 16, nb = r % 16; transpose_item(a.in[11], 128, 512, (bf16*)(ws + WS_G2T), kb * 64, nb * 32, nb * 32, scr, F.lane); }
    }
    { u32x4* z = (u32x4*)(ws + WS_WINT + (size_t)NPROJ * 1024 * 2); const u32x4 zero = {0u, 0u, 0u, 0u};
      for (int i = F.vcu * 512 + F.tid; i < 16384; i += F.G * 512) z[i] = zero; }
    const float* x = a.in[0]; const float* nw = a.in[1]; bf16* hn = (bf16*)(ws + WS_HN);
    f32x4 wv[4];
#pragma unroll
    for (int j = 0; j < 4; ++j) wv[j] = *((const f32x4*)nw + F.lane + 64 * j);
    for (int m = gw; m < M; m += NGW) {
        const f32x4* xr = (const f32x4*)(x + (size_t)m * D) + F.lane;
        f32x4 v[4]; float s = 0.f;
#pragma unroll
        for (int j = 0; j < 4; ++j) { v[j] = xr[64 * j]; s += (v[j].x * v[j].x + v[j].y * v[j].y) + (v[j].z * v[j].z + v[j].w * v[j].w); }
        const float rs = rsqrtf(wave_sum(s) * (1.f / D) + RMS_EPS);
        u32x2* o8 = (u32x2*)(hn + (size_t)m * D) + F.lane;
#pragma unroll
        for (int j = 0; j < 4; ++j) { u32x2 o; o.x = cvt_pk_bf16(v[j].x * rs * wv[j].x, v[j].y * rs * wv[j].y); o.y = cvt_pk_bf16(v[j].z * rs * wv[j].z, v[j].w * rs * wv[j].w); o8[64 * j] = o; }
    }
}

constexpr int PREP_KBUF = 0, PREP_INV = 65536, PREP_AW = 67584, PREP_AA = PREP_AW + 17408, PREP_AG = PREP_AA + 17408, PREP_LD = 136;
template <bool STORE>
__device__ __forceinline__ void prep_phase(const Frame& F, const Args& a) {
    unsigned char* ws = a.ws;
    const bf16* p = (const bf16*)(ws + WS_P);
    bf16* r_out = (bf16*)(ws + WS_R); bf16* v_out = (bf16*)(ws + WS_V); bf16* kk_out = (bf16*)(ws + WS_KK);
    bf16* decay_out = (bf16*)(ws + WS_DECAY); bf16* kdir_out = (bf16*)(ws + WS_KDIR); bf16* akk_out = (bf16*)(ws + WS_AKK); bf16* g_out = (bf16*)(ws + WS_G);
    const bf16* w2T = (const bf16*)(ws + WS_W2T); const bf16* a2T = (const bf16*)(ws + WS_A2T); const bf16* g2T = (const bf16*)(ws + WS_G2T);
    const float* mu_p = a.in[5]; const float* mu_n = a.in[6]; const float* w0 = a.in[7]; const float* a0 = a.in[9];
    const float* k_k = a.in[12]; const float* k_a = a.in[13];
    LAS bf16* kbuf = (LAS bf16*)(F.lds + PREP_KBUF); LAS float* invb = (LAS float*)(F.lds + PREP_INV);
    LAS bf16* Aw = (LAS bf16*)(F.lds + PREP_AW); LAS bf16* Aa = (LAS bf16*)(F.lds + PREP_AA); LAS bf16* Ag = (LAS bf16*)(F.lds + PREP_AG);
    const int lane = F.lane, wave = F.wave, fr = lane & 15, fg = lane >> 4;
    for (int tile = F.vcu; tile < M / 64; tile += F.G) {
        const int m0 = tile * 64;
#pragma unroll 1
        for (int jj = 0; jj < 4; ++jj) {
            const int q = lane + 64 * jj; const bool valid = q < 240; const int c0 = 8 * q;
            float mp[8], mn[8];
#pragma unroll
            for (int i = 0; i < 8; ++i) { mp[i] = valid ? mu_p[c0 + i] : 0.f; mn[i] = valid ? mu_n[c0 + i] : 0.f; }
            const int mfirst = m0 + wave * 8;
            const u32x4 zero = {0u, 0u, 0u, 0u};
            u32x4 rows[10];
#pragma unroll
            for (int rI = 0; rI < 10; ++rI) { const int mr = mfirst - 1 + rI;
                const bool ok = valid && !(rI == 0 && (mfirst % T) == 0) && !(rI == 9 && ((mfirst + 7) % T) == T - 1);
                rows[rI] = ok ? *(const u32x4*)(p + (size_t)mr * PW + c0) : zero; }
#pragma unroll
            for (int i = 0; i < 8; ++i) {
                const int m = mfirst + i, it = wave * 8 + i;
                const u32x4 prev = rows[i], cur = rows[i + 1], nxt = rows[i + 2];
                float fp[8], fc[8], fn[8], s[8];
                unpack8(prev, fp); unpack8(cur, fc); unpack8(nxt, fn);
#pragma unroll
                for (int e = 0; e < 8; ++e) s[e] = fc[e] + mp[e] * (fp[e] - fc[e]) + mn[e] * (fn[e] - fc[e]);
                if (jj == 0) { if (STORE) { *(u32x4*)(r_out + (size_t)m * CW + c0) = pack8(s); } }
                else if (jj == 1) {
                    const int c = c0 - 512;
                    *(LAS u32x4*)(kbuf + it * 512 + c) = pack8(s);
                    float kr[8]; float ss = 0.f;
#pragma unroll
                    for (int e = 0; e < 8; ++e) { kr[e] = s[e] * k_k[c + e]; ss += kr[e] * kr[e]; }
                    ss += __shfl_xor(ss, 1); ss += __shfl_xor(ss, 2); ss += __shfl_xor(ss, 4);
                    const float inv = fminf(__builtin_amdgcn_rsqf(ss), 1e12f);
#pragma unroll
                    for (int e = 0; e < 8; ++e) kr[e] *= inv;
                    if (STORE) { *(u32x4*)(kk_out + (size_t)m * CW + c) = pack8(kr); }
                    if ((lane & 7) == 0) invb[it * 8 + (lane >> 3)] = inv;
                }
                else if (jj == 2) { if (STORE) { *(u32x4*)(v_out + (size_t)m * CW + (c0 - 1024)) = pack8(s); } }
                else if (valid) {
                    const int seg = lane >> 4, cw = 8 * (lane & 15);
                    if (seg == 0) {
#pragma unroll
                        for (int e = 0; e < 8; ++e) s[e] = 1.0f - 2.0f * __builtin_amdgcn_rcpf(__expf(2.0f * s[e]) + 1.0f);
                        *(LAS u32x4*)(Aw + it * PREP_LD + cw) = pack8(s);
                    } else if (seg == 1) { *(LAS u32x4*)(Aa + it * PREP_LD + cw) = pack8(s); }
                    else {
#pragma unroll
                        for (int e = 0; e < 8; ++e) s[e] = sigmoidf_(s[e]);
                        *(LAS u32x4*)(Ag + it * PREP_LD + cw) = pack8(s);
                    }
                }
            }
        }
        __syncthreads();
        const int nb = 64 * wave;
#pragma unroll 1
        for (int job = 0; job < 5; ++job) {
            const int z = job & 1;
            const bf16* WT = job < 2 ? w2T + (size_t)z * 512 * 64 : (job < 4 ? a2T + (size_t)z * 512 * 64 : g2T);
            const LAS bf16* Ax = job < 2 ? Aw + z * 64 : (job < 4 ? Aa + z * 64 : Ag);
            const int kw = job < 4 ? 64 : 128, nks = kw / 32;
            f32x4 acc[4][4];
#pragma unroll
            for (int mt = 0; mt < 4; ++mt)
#pragma unroll
                for (int nt = 0; nt < 4; ++nt) acc[mt][nt] = (f32x4){0.f, 0.f, 0.f, 0.f};
#pragma unroll 1
            for (int ks = 0; ks < nks; ++ks) {
                bf16x8 af[4], wf[4];
#pragma unroll
                for (int mt = 0; mt < 4; ++mt) af[mt] = *(const LAS bf16x8*)(Ax + (16 * mt + fr) * PREP_LD + 32 * ks + 8 * fg);
#pragma unroll
                for (int nt = 0; nt < 4; ++nt) wf[nt] = *(const bf16x8*)(WT + (size_t)(nb + 16 * nt + fr) * kw + 32 * ks + 8 * fg);
#pragma unroll
                for (int mt = 0; mt < 4; ++mt)
#pragma unroll
                    for (int nt = 0; nt < 4; ++nt) acc[mt][nt] = __builtin_amdgcn_mfma_f32_16x16x32_bf16(wf[nt], af[mt], acc[mt][nt], 0, 0, 0);
            }
#pragma unroll
            for (int mt = 0; mt < 4; ++mt) {
                const int it = 16 * mt + fr; const size_t m = (size_t)(m0 + it);
#pragma unroll
                for (int nt = 0; nt < 4; ++nt) {
                    const int n = nb + 16 * nt + 4 * fg;
                    const f32x4 v = acc[mt][nt];
                    if (job < 2) {
                        const f32x4 b = *(const f32x4*)(w0 + z * 512 + n);
                        float o[4];
#pragma unroll
                        for (int i = 0; i < 4; ++i) o[i] = __expf(-0.60653066f * sigmoidf_(v[i] + b[i]));
                        u32x2 w; w.x = cvt_pk_bf16(o[0], o[1]); w.y = cvt_pk_bf16(o[2], o[3]);
                        if (STORE) { *(u32x2*)(decay_out + ((size_t)z * M + m) * CW + n) = w; }
                    } else if (job < 4) {
                        const f32x4 b = *(const f32x4*)(a0 + z * 512 + n), kkc = *(const f32x4*)(k_k + n), kac = *(const f32x4*)(k_a + n);
                        const u32x2 kb = *(const LAS u32x2*)(kbuf + it * 512 + n);
                        const float kv[4] = {bflo(kb.x), bfhi(kb.x), bflo(kb.y), bfhi(kb.y)};
                        const float inv = invb[it * 8 + wave];
                        float kd[4], ak[4];
#pragma unroll
                        for (int i = 0; i < 4; ++i) { const float av = sigmoidf_(v[i] + b[i]); kd[i] = kv[i] * (1.0f + (av - 1.0f) * kac[i]); ak[i] = av * (kv[i] * kkc[i] * inv); }
                        u32x2 w; w.x = cvt_pk_bf16(kd[0], kd[1]); w.y = cvt_pk_bf16(kd[2], kd[3]);
                        if (STORE) { *(u32x2*)(kdir_out + ((size_t)z * M + m) * CW + n) = w; }
                        w.x = cvt_pk_bf16(ak[0], ak[1]); w.y = cvt_pk_bf16(ak[2], ak[3]);
                        if (STORE) { *(u32x2*)(akk_out + ((size_t)z * M + m) * CW + n) = w; }
                    } else {
                        u32x2 w; w.x = cvt_pk_bf16(v[0], v[1]); w.y = cvt_pk_bf16(v[2], v[3]);
                        if (STORE) { *(u32x2*)(g_out + m * CW + n) = w; }
                    }
                }
            }
        }
        __syncthreads();
    }
}

__device__ __forceinline__ void attn_phase(const Frame& F, const Args& a) {
    unsigned char* ws = a.ws;
    const bf16* q = (const bf16*)(ws + WS_Q); const bf16* k = (const bf16*)(ws + WS_K); const bf16* vT = (const bf16*)(ws + WS_VT);
    bf16* att = (bf16*)(ws + WS_ATT);
    LAS float* bias = (LAS float*)F.lds;
    for (int i = F.tid; i < 8 * 15 * 31; i += 512) bias[i] = a.in[3][i];
    __syncthreads();
    const int lane = F.lane, fr = lane & 15, fg = lane >> 4;
    const int NGW = F.G * 8, gw = F.vcu * 8 + F.wave;
    const int per = (16384 + NGW - 1) / NGW;
    for (int task = gw * per; task < (gw + 1) * per && task < 16384; ++task) {
        const int cgp = task & 3, r = (task >> 2) & 127, h = (task >> 9) & 7, b = task >> 12;
        const int c0 = 16 * cgp, wsc = min(max(c0 - 8, 0), 32), rs = min(max(r - 4, 0), GROWS - 8);
        const int c = c0 + fr, cs = min(max(c - 8, 0), 48);
        const size_t tq = (size_t)b * T + r * 64 + c;
        bf16x8 qf[2];
#pragma unroll
        for (int ks = 0; ks < 2; ++ks) qf[ks] = *(const bf16x8*)(q + tq * CW + h * 64 + 32 * ks + 8 * fg);
        f32x4 sc[16];
        const int kcol_a = wsc + 8 * (fr >> 2) + (fr & 3);
#pragma unroll
        for (int hb = 0; hb < 2; ++hb) {
            bf16x8 kf[8][2];
#pragma unroll
            for (int tl = 0; tl < 8; ++tl) { const int t = 8 * hb + tl, u = t >> 1, par = t & 1;
                const size_t tk = (size_t)b * T + (rs + u) * 64 + kcol_a + 4 * par;
                kf[tl][0] = *(const bf16x8*)(k + tk * CW + h * 64 + 8 * fg); kf[tl][1] = *(const bf16x8*)(k + tk * CW + h * 64 + 32 + 8 * fg); }
#pragma unroll
            for (int tl = 0; tl < 8; ++tl) { f32x4 s = {0.f, 0.f, 0.f, 0.f};
                s = __builtin_amdgcn_mfma_f32_16x16x32_bf16(kf[tl][0], qf[0], s, 0, 0, 0);
                s = __builtin_amdgcn_mfma_f32_16x16x32_bf16(kf[tl][1], qf[1], s, 0, 0, 0);
                sc[8 * hb + tl] = s; }
        }
        float mx = -1e30f;
#pragma unroll
        for (int u = 0; u < 8; ++u) {
            const int dr = rs + u - r + 7;
#pragma unroll
            for (int par = 0; par < 2; ++par)
#pragma unroll
                for (int i = 0; i < 4; ++i) {
                    const int kc = wsc + 8 * fg + 4 * par + i; const bool ok = (kc >= cs) && (kc < cs + 16);
                    const int dc = min(max(kc - c + 15, 0), 30);
                    const float s = ok ? sc[2 * u + par][i] + bias[(h * 15 + dr) * 31 + dc] : -1e30f;
                    sc[2 * u + par][i] = s; mx = fmaxf(mx, s);
                }
        }
        mx = fmaxf(mx, __shfl_xor(mx, 16)); mx = fmaxf(mx, __shfl_xor(mx, 32));
        float sum = 0.f;
#pragma unroll
        for (int t = 0; t < 16; ++t)
#pragma unroll
            for (int i = 0; i < 4; ++i) { const float pv = sc[t][i] > -1e29f ? __expf(sc[t][i] - mx) : 0.f; sc[t][i] = pv; sum += pv; }
        sum += __shfl_xor(sum, 16); sum += __shfl_xor(sum, 32);
        const float inv = 1.0f / sum;
        f32x4 o[4];
#pragma unroll
        for (int nt = 0; nt < 4; ++nt) o[nt] = (f32x4){0.f, 0.f, 0.f, 0.f};
#pragma unroll
        for (int hb = 0; hb < 2; ++hb) {
            bf16x8 vf[4][4];
#pragma unroll
            for (int ul = 0; ul < 4; ++ul) { const int u = 4 * hb + ul; const size_t tv = (size_t)(rs + u) * 64 + wsc + 8 * fg;
#pragma unroll
                for (int nt = 0; nt < 4; ++nt) vf[ul][nt] = *(const bf16x8*)(vT + ((size_t)((b * NH + h) * HD + 16 * nt + fr)) * T + tv); }
#pragma unroll
            for (int ul = 0; ul < 4; ++ul) { const int u = 4 * hb + ul;
                union { u32x4 w; bf16x8 h8; } pf;
                pf.w.x = cvt_pk_bf16(sc[2 * u][0], sc[2 * u][1]); pf.w.y = cvt_pk_bf16(sc[2 * u][2], sc[2 * u][3]);
                pf.w.z = cvt_pk_bf16(sc[2 * u + 1][0], sc[2 * u + 1][1]); pf.w.w = cvt_pk_bf16(sc[2 * u + 1][2], sc[2 * u + 1][3]);
#pragma unroll
                for (int nt = 0; nt < 4; ++nt) o[nt] = __builtin_amdgcn_mfma_f32_16x16x32_bf16(vf[ul][nt], pf.h8, o[nt], 0, 0, 0); }
        }
#pragma unroll
        for (int nt = 0; nt < 4; ++nt) { u32x2 w; w.x = cvt_pk_bf16(o[nt][0] * inv, o[nt][1] * inv); w.y = cvt_pk_bf16(o[nt][2] * inv, o[nt][3] * inv);
            *(u32x2*)(att + tq * CW + h * 64 + 16 * nt + 4 * fg) = w; }
    }
    __syncthreads();
}

constexpr int SC_TC = 32, SC_REC = 1344, SC_STAGE = SC_TC * SC_REC  , SC_YB = SC_TC * 1024, SC_YOFF = 2 * SC_STAGE  ;
__device__ __forceinline__ float row16_sum(float v) {
    v += __builtin_bit_cast(float, __builtin_amdgcn_update_dpp(0, __builtin_bit_cast(int, v), 0xB1, 0xF, 0xF, true));
    v += __builtin_bit_cast(float, __builtin_amdgcn_update_dpp(0, __builtin_bit_cast(int, v), 0x4E, 0xF, 0xF, true));
    v += __builtin_bit_cast(float, __builtin_amdgcn_update_dpp(0, __builtin_bit_cast(int, v), 0x141, 0xF, 0xF, true));
    v += __builtin_bit_cast(float, __builtin_amdgcn_update_dpp(0, __builtin_bit_cast(int, v), 0x140, 0xF, 0xF, true));
    return v;
}
__device__ __forceinline__ void scan_phase(const Frame& F, const Args& a) {
    unsigned char* ws = a.ws;
    const int seq = F.vcu >> 2, rg = F.vcu & 3;
    if (seq >= 64) return;
    const int z = seq >> 5, b = (seq >> 3) & 3, h = seq & 7;
    const bf16* vsrc = (const bf16*)(ws + WS_V);
    float* yout = (float*)(ws + WS_Y) + (size_t)z * M * CW;
    const size_t mb = (size_t)b * T;
    const int lane = F.lane, wave = F.wave;
    constexpr int NCH = T / SC_TC;
    if (wave >= 4) {
        const int u = F.tid - 256;
        const bf16* gp[5]; int ldo[5];
        const long tstep = z ? -(long)CW : (long)CW;
#pragma unroll
        for (int j = 0; j < 5; ++j) { const int piece = u + 256 * j, tau = piece / 40, w = piece % 40, arr = w >> 3, part = w & 7;
            const bf16* base = arr == 0 ? (const bf16*)(ws + WS_KK) : arr == 1 ? (const bf16*)(ws + WS_DECAY) + (size_t)z * M * CW : arr == 2 ? (const bf16*)(ws + WS_AKK) + (size_t)z * M * CW
                             : arr == 3 ? (const bf16*)(ws + WS_KDIR) + (size_t)z * M * CW : (const bf16*)(ws + WS_R);
            const int t0 = z ? (T - 1 - tau) : tau;
            gp[j] = base + (mb + t0) * CW + h * 64 + part * 8; ldo[j] = tau * SC_REC + w * 32; }
        const int vtau = (u & 63) >> 1, vpart = u & 1;
        const bf16* gv = vsrc + (mb + (z ? (T - 1 - vtau) : vtau)) * CW + h * 64 + rg * 16 + vpart * 8;
        const int ldv = vtau * SC_REC + 1280 + vpart * 32;
        u32x4 reg0, reg1, reg2, reg3, reg4, regv = {0u, 0u, 0u, 0u};
#define SC_LOAD(c) do { const long adv = (long)(c) * SC_TC * tstep; reg0 = *(const u32x4*)(gp[0] + adv); reg1 = *(const u32x4*)(gp[1] + adv); reg2 = *(const u32x4*)(gp[2] + adv); \
            reg3 = *(const u32x4*)(gp[3] + adv); reg4 = *(const u32x4*)(gp[4] + adv); if (u < 64) regv = *(const u32x4*)(gv + adv); } while (0)
#define SC_W1(rg_, off_) do { float f_[8]; unpack8(rg_, f_); LAS f32x4* d_ = (LAS f32x4*)(st_ + (off_)); d_[0] = (f32x4){f_[0], f_[1], f_[2], f_[3]}; d_[1] = (f32x4){f_[4], f_[5], f_[6], f_[7]}; } while (0)
#define SC_WRITE(buf) do { LAS unsigned char* st_ = F.lds + (buf) * SC_STAGE; SC_W1(reg0, ldo[0]); SC_W1(reg1, ldo[1]); SC_W1(reg2, ldo[2]); SC_W1(reg3, ldo[3]); SC_W1(reg4, ldo[4]); \
            if (u < 64) SC_W1(regv, ldv); } while (0)
#define SC_YRED(c) do { const LAS unsigned char* yb_ = F.lds + SC_YOFF + ((c) & 1) * SC_YB; _Pragma("unroll") for (int j = 0; j < 2; ++j) { const int o_ = u + 256 * j, tau_ = o_ >> 4, row_ = o_ & 15; \
            const LAS f32x4* s_ = (const LAS f32x4*)(yb_ + tau_ * 1024 + row_ * 64); const f32x4 s0 = s_[0], s1 = s_[1], s2 = s_[2], s3 = s_[3]; \
            const float tot_ = (((s0.x + s0.y) + (s0.z + s0.w)) + ((s1.x + s1.y) + (s1.z + s1.w))) + (((s2.x + s2.y) + (s2.z + s2.w)) + ((s3.x + s3.y) + (s3.z + s3.w))); \
            const int n_ = (c) * SC_TC + tau_, t_ = z ? (T - 1 - n_) : n_; yout[(mb + t_) * CW + h * 64 + rg * 16 + row_] = tot_; } } while (0)
        const int lw = F.vcu * 4 + (wave - 4);
        float wv[32]; const float* wsrc = nullptr; bf16* wdst = nullptr; int wN = 0;
#pragma unroll
        for (int q = 0; q < 32; ++q) wv[q] = 0.f;
        SC_LOAD(0); SC_WRITE(0); SC_LOAD(1);
        __syncthreads();
#pragma unroll 1
        for (int c = 0; c < NCH; ++c) {
            if (c + 1 < NCH) SC_WRITE((c + 1) & 1);
            if (c + 2 < NCH) SC_LOAD(c + 2);
            if (c >= 1) SC_YRED(c - 1);
            const int ph5 = c % 5, j5 = c / 5;
            if (ph5 == 0 && j5 < 48) {
                const int id = lw + 1024 * j5;
                int e, kb, n0, orow, K_ = 1024;
                if (id < 32768) { e = id >> 10; const int q = id & 1023; kb = q >> 5; n0 = (q & 31) * 64; wN = 2048;
                    orow = n0 < 1024 ? 256 * (n0 >> 7) + (n0 & 127) : 256 * ((n0 - 1024) >> 7) + 128 + ((n0 - 1024) & 127);
                    wsrc = a.in[21] + (size_t)e * 1024 * 2048 + (size_t)(kb * 32) * 2048 + n0 + lane; wdst = (bf16*)(ws + WS_WUPT) + (size_t)e * 2048 * 1024 + (size_t)(orow + lane) * K_ + kb * 32; }
                else { const int i2 = id - 32768; e = i2 >> 9; const int q = i2 & 511; kb = q >> 4; n0 = (q & 15) * 64; wN = 1024;
                    wsrc = a.in[23] + (size_t)e * 1024 * 1024 + (size_t)(kb * 32) * 1024 + n0 + lane; wdst = (bf16*)(ws + WS_WDNT) + (size_t)e * 1024 * 1024 + (size_t)(n0 + lane) * K_ + kb * 32; }
#pragma unroll
                for (int q = 0; q < 32; ++q) wv[q] = wsrc[(size_t)q * wN];
            } else if (ph5 == 1 && j5 < 48) {
#pragma unroll
                for (int q4 = 0; q4 < 4; ++q4) { u32x4 o; o.x = cvt_pk_bf16(wv[8 * q4 + 0], wv[8 * q4 + 1]); o.y = cvt_pk_bf16(wv[8 * q4 + 2], wv[8 * q4 + 3]); o.z = cvt_pk_bf16(wv[8 * q4 + 4], wv[8 * q4 + 5]); o.w = cvt_pk_bf16(wv[8 * q4 + 6], wv[8 * q4 + 7]);
                    *(u32x4*)(wdst + 8 * q4) = o; }
            }
            __syncthreads();
        }
        SC_YRED(NCH - 1);
#undef SC_LOAD
#undef SC_W1
#undef SC_WRITE
#undef SC_YRED
    } else {
        const int cg4 = lane & 15, row = wave * 4 + (lane >> 4);
        f32x2 S01 = {0.f, 0.f}, S23 = {0.f, 0.f};
        __syncthreads();
#pragma unroll 1
        for (int c = 0; c < NCH; ++c) {
            const LAS unsigned char* st = F.lds + (c & 1) * SC_STAGE + cg4 * 16;
            const LAS unsigned char* sv = F.lds + (c & 1) * SC_STAGE + 1280 + row * 4;
            LAS float* yb = (LAS float*)(F.lds + SC_YOFF + (c & 1) * SC_YB) + wave * 64 + lane;
            f32x4 Rkk[3], Rw[3], Rak[3], Rk[3], Rr[3]; float Rv[3];
#define SC_LDSTEP(t_, s_) do { Rkk[s_] = *(const LAS f32x4*)(st + (t_) * SC_REC); Rw[s_] = *(const LAS f32x4*)(st + (t_) * SC_REC + 256); Rak[s_] = *(const LAS f32x4*)(st + (t_) * SC_REC + 512); \
                Rk[s_] = *(const LAS f32x4*)(st + (t_) * SC_REC + 768); Rr[s_] = *(const LAS f32x4*)(st + (t_) * SC_REC + 1024); Rv[s_] = *(const LAS float*)(sv + (t_) * SC_REC); } while (0)
            SC_LDSTEP(0, 0); SC_LDSTEP(1, 1);
#pragma unroll
            for (int tau = 0; tau < SC_TC; ++tau) {
                const int sx = tau % 3;
                if (tau + 2 < SC_TC) { const int sn = (tau + 2) % 3; SC_LDSTEP(tau + 2, sn); }
                const f32x2 kk01 = {Rkk[sx].x, Rkk[sx].y}, kk23 = {Rkk[sx].z, Rkk[sx].w};
                f32x2 pd = S01 * kk01; pd = __builtin_elementwise_fma(S23, kk23, pd);
                const float sa = row16_sum(pd.x + pd.y);
                const f32x2 vv = {Rv[sx], Rv[sx]}, nsa = {-sa, -sa};
                const f32x2 w01 = {Rw[sx].x, Rw[sx].y}, w23 = {Rw[sx].z, Rw[sx].w}, k01 = {Rk[sx].x, Rk[sx].y}, k23 = {Rk[sx].z, Rk[sx].w};
                const f32x2 a01 = {Rak[sx].x, Rak[sx].y}, a23 = {Rak[sx].z, Rak[sx].w}, r01 = {Rr[sx].x, Rr[sx].y}, r23 = {Rr[sx].z, Rr[sx].w};
                f32x2 t01 = __builtin_elementwise_fma(S01, w01, k01 * vv), t23 = __builtin_elementwise_fma(S23, w23, k23 * vv);
                S01 = __builtin_elementwise_fma(a01, nsa, t01); S23 = __builtin_elementwise_fma(a23, nsa, t23);
                f32x2 yr = S01 * r01; yr = __builtin_elementwise_fma(S23, r23, yr);
                yb[tau * 256] = yr.x + yr.y;
            }
#undef SC_LDSTEP
            __syncthreads();
        }
    }
    __syncthreads();
}

__device__ __forceinline__ void combine_phase(const Frame& F, const Args& a) {
    unsigned char* ws = a.ws;
    const bf16* att = (const bf16*)(ws + WS_ATT); const bf16* rr = (const bf16*)(ws + WS_R); const bf16* vv = (const bf16*)(ws + WS_V);
    const bf16* kd = (const bf16*)(ws + WS_KDIR); const bf16* gg = (const bf16*)(ws + WS_G); const float* y = (const float*)(ws + WS_Y);
    bf16* mix = (bf16*)(ws + WS_MIX);
    const float* anw = a.in[4]; const float* r_k = a.in[14]; const float* ln_w = a.in[15]; const float* ln_b = a.in[16];
    const int lane = F.lane, c0 = 8 * lane;
    float nw[8], rk[8], lw[8], lb[8];
#pragma unroll
    for (int i = 0; i < 8; ++i) { nw[i] = anw[c0 + i]; rk[i] = r_k[c0 + i]; lw[i] = ln_w[c0 + i]; lb[i] = ln_b[c0 + i]; }
    const int gw = F.vcu * 8 + F.wave, NGW = F.G * 8;
#pragma unroll 2
    for (int m = gw; m < M; m += NGW) {
        const size_t o = (size_t)m * CW + c0;
        float f[8];
        unpack8(*(const u32x4*)(att + o), f);
        float ss = 0.f;
#pragma unroll
        for (int i = 0; i < 8; ++i) ss += f[i] * f[i];
        const float rs = rsqrtf(wave_sum(ss) * (1.f / CW) + RMS_EPS);
#pragma unroll
        for (int i = 0; i < 8; ++i) f[i] = f[i] * rs * nw[i];
        *(u32x4*)(mix + (size_t)m * D + c0) = pack8(f);
        const f32x4 y0a = *(const f32x4*)(y + o), y0b = *(const f32x4*)(y + o + 4), y1a = *(const f32x4*)(y + (size_t)M * CW + o), y1b = *(const f32x4*)(y + (size_t)M * CW + o + 4);
        float yv[8] = {y0a.x + y1a.x, y0a.y + y1a.y, y0a.z + y1a.z, y0a.w + y1a.w, y0b.x + y1b.x, y0b.y + y1b.y, y0b.z + y1b.z, y0b.w + y1b.w};
        float s1 = 0.f;
#pragma unroll
        for (int i = 0; i < 8; ++i) s1 += yv[i];
        s1 += __shfl_xor(s1, 1); s1 += __shfl_xor(s1, 2); s1 += __shfl_xor(s1, 4);
        const float mean = s1 * (1.f / 64.f);
        float s2 = 0.f;
#pragma unroll
        for (int i = 0; i < 8; ++i) { yv[i] -= mean; s2 += yv[i] * yv[i]; }
        s2 += __shfl_xor(s2, 1); s2 += __shfl_xor(s2, 2); s2 += __shfl_xor(s2, 4);
        const float rstd = rsqrtf(s2 * (1.f / 64.f) + GN_EPS);
        float rf[8], k0[8], k1[8], vf[8], gf[8];
        unpack8(*(const u32x4*)(rr + o), rf); unpack8(*(const u32x4*)(kd + o), k0); unpack8(*(const u32x4*)(kd + (size_t)M * CW + o), k1);
        unpack8(*(const u32x4*)(vv + o), vf); unpack8(*(const u32x4*)(gg + o), gf);
        float cf = 0.f;
#pragma unroll
        for (int i = 0; i < 8; ++i) cf += rf[i] * (k0[i] + k1[i]) * rk[i];
        cf += __shfl_xor(cf, 1); cf += __shfl_xor(cf, 2); cf += __shfl_xor(cf, 4);
#pragma unroll
        for (int i = 0; i < 8; ++i) f[i] = (yv[i] * rstd * lw[i] + lb[i] + cf * vf[i]) * gf[i];
        *(u32x4*)(mix + (size_t)m * D + CW + c0) = pack8(f);
    }
}

constexpr int RT_W = 0, RT_HIST = 131072, RT_LOG = 131072 + 256;
__device__ __forceinline__ void router_phase(const Frame& F, const Args& a) {
    unsigned char* ws = a.ws;
    const float* hbuf = (const float*)(ws + WS_H); bf16* hn2 = (bf16*)(ws + WS_HN2);
    int* eidx = (int*)(ws + WS_EIDX); float* gate = (float*)(ws + WS_GATE); int* rank = (int*)(ws + WS_RANK);
    unsigned* ctl = (unsigned*)(ws + WS_CTL);
    const float* n2w = a.in[18]; const float* rw = a.in[19]; const float* rb = a.in[20];
    LAS float* wT = (LAS float*)(F.lds + RT_W); LAS int* hist = (LAS int*)(F.lds + RT_HIST); LAS float* lg = (LAS float*)(F.lds + RT_LOG) + F.wave * 64; LAS int* eL = (LAS int*)(F.lds + RT_LOG + 2048);
    { f32x4 tmp[16];
#pragma unroll
      for (int j = 0; j < 16; ++j) tmp[j] = *((const f32x4*)rw + F.tid + 512 * j);
#pragma unroll
      for (int j = 0; j < 16; ++j) { const int q = F.tid + 512 * j, d = q >> 3, e0 = 4 * (q & 7);
          wT[(e0 + 0) * 1024 + d] = tmp[j].x; wT[(e0 + 1) * 1024 + d] = tmp[j].y; wT[(e0 + 2) * 1024 + d] = tmp[j].z; wT[(e0 + 3) * 1024 + d] = tmp[j].w; } }
    if (F.tid < 32) hist[F.tid] = 0;
    __syncthreads();
    const int lane = F.lane;
    f32x4 wn[4];
#pragma unroll
    for (int j = 0; j < 4; ++j) wn[j] = *((const f32x4*)n2w + lane + 64 * j);
    const int blk = F.vcu;
    for (int pr = 0; pr < 8; ++pr) {
        const int m0 = blk * 128 + F.wave * 16 + pr * 2;
        f32x4 xv[2][4];
#pragma unroll
        for (int tk = 0; tk < 2; ++tk) {
            const f32x4* hr = (const f32x4*)(hbuf + (size_t)(m0 + tk) * D) + lane;
            float s = 0.f;
#pragma unroll
            for (int j = 0; j < 4; ++j) { xv[tk][j] = hr[64 * j]; s += (xv[tk][j].x * xv[tk][j].x + xv[tk][j].y * xv[tk][j].y) + (xv[tk][j].z * xv[tk][j].z + xv[tk][j].w * xv[tk][j].w); }
            const float rs = rsqrtf(wave_sum(s) * (1.f / D) + RMS_EPS);
            u32x2* o8 = (u32x2*)(hn2 + (size_t)(m0 + tk) * D) + lane;
#pragma unroll
            for (int j = 0; j < 4; ++j) { xv[tk][j] = xv[tk][j] * rs * wn[j]; u32x2 o; o.x = cvt_pk_bf16(xv[tk][j].x, xv[tk][j].y); o.y = cvt_pk_bf16(xv[tk][j].z, xv[tk][j].w); o8[64 * j] = o; }
        }
        float kA0 = 0.f, kB0 = 0.f, kA1 = 0.f, kB1 = 0.f;
#pragma unroll 4
        for (int e = 0; e < 32; ++e) {
            float p0 = 0.f, p1 = 0.f;
#pragma unroll
            for (int j = 0; j < 4; ++j) { const f32x4 w4 = *(const LAS f32x4*)(wT + e * 1024 + 256 * j + 4 * lane);
                p0 += (w4.x * xv[0][j].x + w4.y * xv[0][j].y) + (w4.z * xv[0][j].z + w4.w * xv[0][j].w);
                p1 += (w4.x * xv[1][j].x + w4.y * xv[1][j].y) + (w4.z * xv[1][j].z + w4.w * xv[1][j].w); }
            p0 = row16_sum(p0); p1 = row16_sum(p1);
            const bool me = (lane & 15) == (e & 15);
            if (e < 16) { kA0 = me ? p0 : kA0; kA1 = me ? p1 : kA1; } else { kB0 = me ? p0 : kB0; kB1 = me ? p1 : kB1; }
        }
        kA0 += __shfl_xor(kA0, 16); kA0 += __shfl_xor(kA0, 32); kB0 += __shfl_xor(kB0, 16); kB0 += __shfl_xor(kB0, 32);
        kA1 += __shfl_xor(kA1, 16); kA1 += __shfl_xor(kA1, 32); kB1 += __shfl_xor(kB1, 16); kB1 += __shfl_xor(kB1, 32);
        if (lane < 32) { const int tk = lane >> 4, el = lane & 15; lg[tk * 32 + el] = (tk ? kA1 : kA0) + rb[el]; lg[tk * 32 + 16 + el] = (tk ? kB1 : kB0) + rb[16 + el]; }
        asm volatile("s_waitcnt lgkmcnt(0)" ::: "memory");
        if (lane < 2) {
            const LAS float* L = lg + lane * 32; const int m = m0 + lane;
            float v[32];
#pragma unroll
            for (int e = 0; e < 32; ++e) v[e] = L[e];
            float tv[4]; int ti[4];
#pragma unroll
            for (int kx = 0; kx < 4; ++kx) { float best = -3.0e38f; int bi = 0;
#pragma unroll
                for (int e = 0; e < 32; ++e) { if (v[e] > best) { best = v[e]; bi = e; } }
                tv[kx] = best; ti[kx] = bi;
#pragma unroll
                for (int e = 0; e < 32; ++e) { if (e == bi) v[e] = -3.0e38f; } }
            const float e0 = 1.0f, e1 = __expf(tv[1] - tv[0]), e2 = __expf(tv[2] - tv[0]), e3 = __expf(tv[3] - tv[0]);
            const float is = 1.0f / (e0 + e1 + e2 + e3);
            const float gs[4] = {e0 * is, e1 * is, e2 * is, e3 * is};
#pragma unroll
            for (int kx = 0; kx < 4; ++kx) { eidx[m * 4 + kx] = ti[kx]; gate[m * 4 + kx] = gs[kx]; eL[(m - blk * 128) * 4 + kx] = ti[kx]; }
        }
        asm volatile("s_waitcnt lgkmcnt(0)" ::: "memory");
    }
    __syncthreads();
    { const int t = F.tid, e = eL[t]; int rk = 0;
      for (int u = 0; u < t; ++u) rk += (eL[u] == e) ? 1 : 0;
      rank[(blk * 128) * 4 + t] = rk;
      __hip_atomic_fetch_add(&hist[e], 1, __ATOMIC_RELAXED, __HIP_MEMORY_SCOPE_WORKGROUP); }
    __syncthreads();
    if (F.tid < 32) ctl[CW_CNT + blk * 32 + F.tid] = (unsigned)hist[F.tid];
}

__device__ __forceinline__ void dispatch_phase(const Frame& F, const Args& a) {
    unsigned char* ws = a.ws;
    unsigned* ctl = (unsigned*)(ws + WS_CTL);
    const int* eidx = (const int*)(ws + WS_EIDX); const int* rank = (const int*)(ws + WS_RANK); int* dest = (int*)(ws + WS_DEST);
    LAS int* part = (LAS int*)F.lds;
    LAS int* tot = part + 1024;
    const int blk = F.vcu, G = F.G;
    { const int e = F.tid & 31, pt = F.tid >> 5; int s = 0, sb = 0;
      if (G == 256) { int cv[16];
#pragma unroll
          for (int q = 0; q < 16; ++q) cv[q] = (int)ld_u32_agent(ctl + CW_CNT + (pt + 16 * q) * 32 + e);
#pragma unroll
          for (int q = 0; q < 16; ++q) { s += cv[q]; if (pt + 16 * q < blk) sb += cv[q]; } }
      else for (int bb = pt; bb < G; bb += 16) { const int cval = (int)ld_u32_agent(ctl + CW_CNT + bb * 32 + e); s += cval; if (bb < blk) sb += cval; }
      part[pt * 32 + e] = s; part[512 + pt * 32 + e] = sb; }
    __syncthreads();
    if (F.tid < 32) { int s = 0, sb = 0;
        for (int pt = 0; pt < 16; ++pt) { s += part[pt * 32 + F.tid]; sb += part[512 + pt * 32 + F.tid]; }
        tot[F.tid] = s; tot[32 + F.tid] = sb; tot[96 + F.tid] = (s + 255) & ~255; }
    __syncthreads();
    if (F.tid == 0) { int ps = 0; for (int e = 0; e < 32; ++e) { tot[64 + e] = ps; ps += tot[96 + e]; }
        tot[128] = ps >> 8; }
    __syncthreads();
    if (blk == 0) {
        if (F.tid == 0) ctl[CW_NT] = (unsigned)tot[128];
        for (int e = F.tid >> 4; e < 32; e += 32) { const int t0 = tot[64 + e] >> 8, nt = tot[96 + e] >> 8; for (int i = F.tid & 15; i < nt; i += 16) ctl[CW_TEXP + t0 + i] = (unsigned)e; }
    }
    const int lane = F.lane;
    const int mw = blk * 128 + F.wave * 16;
    int* rowtok = (int*)(ws + WS_ROWTOK);
    { const int e = eidx[mw * 4 + lane]; const int dl = tot[64 + e] + tot[32 + e] + rank[mw * 4 + lane]; dest[mw * 4 + lane] = dl; rowtok[dl] = mw + (lane >> 2); }
    { const int e = blk & 31, pt = blk >> 5, np = G >> 5; const int r0 = tot[64 + e] + tot[e], r1 = tot[64 + e] + tot[96 + e];
      if (np > 0) for (int r = r0 + pt * 512 + F.tid; r < r1; r += np * 512) rowtok[r] = 0; }
}

__device__ __forceinline__ void final_phase(const Frame& F, const Args& a) {
    unsigned char* ws = a.ws;
    const float* hbuf = (const float*)(ws + WS_H); const bf16* ybuf = (const bf16*)(ws + WS_YBUF);
    const int* dest = (const int*)(ws + WS_DEST); const float* gate = (const float*)(ws + WS_GATE);
    const float* fw = a.in[25]; float* out = a.out;
    const int lane = F.lane;
    f32x4 wn[4];
#pragma unroll
    for (int j = 0; j < 4; ++j) wn[j] = *((const f32x4*)fw + lane + 64 * j);
    const int gw = F.vcu * 8 + F.wave, NGW = F.G * 8;
    const int per = M / NGW;
    const int mw = gw * per;
    int dl = 0; float gl = 0.f;
    if (lane < 4 * per && per <= 16) { dl = dest[mw * 4 + lane]; gl = gate[mw * 4 + lane]; }
#pragma unroll 2
    for (int i = 0; i < per; ++i) {
        const int m = mw + i;
        const f32x4* hr = (const f32x4*)(hbuf + (size_t)m * D) + lane;
        f32x4 v[4];
#pragma unroll
        for (int j = 0; j < 4; ++j) v[j] = hr[64 * j];
#pragma unroll
        for (int kx = 0; kx < 4; ++kx) {
            const int d = per <= 16 ? __shfl(dl, 4 * i + kx) : dest[m * 4 + kx]; const float gt = per <= 16 ? __shfl(gl, 4 * i + kx) : gate[m * 4 + kx];
            const u32x2* yr = (const u32x2*)(ybuf + (size_t)d * D) + lane;
#pragma unroll
            for (int j = 0; j < 4; ++j) { const u32x2 w = yr[64 * j]; v[j].x += gt * bflo(w.x); v[j].y += gt * bfhi(w.x); v[j].z += gt * bflo(w.y); v[j].w += gt * bfhi(w.y); }
        }
        float s = 0.f;
#pragma unroll
        for (int j = 0; j < 4; ++j) s += (v[j].x * v[j].x + v[j].y * v[j].y) + (v[j].z * v[j].z + v[j].w * v[j].w);
        const float rs = rsqrtf(wave_sum(s) * (1.f / D) + RMS_EPS);
        f32x4* orow = (f32x4*)(out + (size_t)m * D) + lane;
#pragma unroll
        for (int j = 0; j < 4; ++j) orow[64 * j] = v[j] * rs * wn[j];
    }
}

__global__ void __launch_bounds__(512, 2) fwd_megakernel(Args args) {
    extern __shared__ __attribute__((aligned(16))) unsigned char lds_raw[];
    Frame F;
    F.lds = (LAS unsigned char*)lds_raw;
    F.tid = threadIdx.x; F.lane = F.tid & 63; F.wave = __builtin_amdgcn_readfirstlane(F.tid >> 6);
    F.G = gridDim.x; { const int bx = blockIdx.x; F.vcu = (F.G % 8 == 0) ? (bx % 8) * (F.G / 8) + bx / 8 : bx; }
    unsigned char* ws = args.ws;
    const int lo = args.ph_lo, hi = args.ph_hi;
#define IN(k) (lo <= (k) && (k) < hi)
#if MK_SPLIT
#define SEAM(k) do { } while (0)
#else
    cg::grid_group grid = cg::this_grid();
    { volatile LAS unsigned* st = (volatile LAS unsigned*)(F.lds + LDS_MISC); if (F.tid < 2) st[F.tid] = 0u; __syncthreads(); }
    const XcdBarrier xbar = xcd_barrier_post((unsigned*)(ws + WS_CTL) + CW_BAR, (volatile LAS unsigned*)(F.lds + LDS_MISC));
    if (lo < 0) grid.sync();
#define SEAM(k) do { if (IN(k) && IN((k) + 1)) xcd_barrier(xbar); } while (0)
#endif
#define REP2(k) if constexpr (((MK_REPEAT >> (k)) & 1) != 0)
#define PH1 { pg8::Gemm g{(const bf16*)(ws + WS_HN), (const bf16*)(ws + WS_WINT), 1024, nullptr, 0, nullptr}; \
        pg8::StaticOrder S; S.init(M / 256, NPROJ_PAD / 256, F.G, (int)blockIdx.x); \
        pg8::EpiProj E{(bf16*)(ws + WS_Q), (bf16*)(ws + WS_K), (bf16*)(ws + WS_VT), (bf16*)(ws + WS_P)}; \
        pg8::gemm_phase<pg8::EpiProj, true, true>(F.lds, g, S, E); }
#define PH5 { pg8::Gemm g{(const bf16*)(ws + WS_MIX), (const bf16*)(ws + WS_WOT), 1024, nullptr, 0, nullptr}; \
        pg8::StaticOrder S; S.init(M / 256, D / 256, F.G, (int)blockIdx.x); \
        pg8::EpiWo E{args.in[0], (float*)(ws + WS_H)}; \
        pg8::gemm_phase<pg8::EpiWo, true, true>(F.lds, g, S, E); }
#define PH8 { const unsigned* ctl = (const unsigned*)(ws + WS_CTL); const int ntile = (int)ld_u32_agent(ctl + CW_NT); \
        pg8::Gemm g{(const bf16*)(ws + WS_HN2), (const bf16*)(ws + WS_WUPT), 1024, ctl + CW_TEXP, (size_t)2048 * 1024 * 2, (const int*)(ws + WS_ROWTOK)}; \
        pg8::StaticOrder S; S.init(ntile, 8, F.G, (int)blockIdx.x); \
        pg8::EpiUp E{args.in[22], (bf16*)(ws + WS_ACT)}; \
        pg8::gemm_phase<pg8::EpiUp, true, true, true>(F.lds, g, S, E); }
#define PH9 { const unsigned* ctl = (const unsigned*)(ws + WS_CTL); const int ntile = (int)ld_u32_agent(ctl + CW_NT); \
        pg8::Gemm g{(const bf16*)(ws + WS_ACT), (const bf16*)(ws + WS_WDNT), 1024, ctl + CW_TEXP, (size_t)1024 * 1024 * 2, nullptr}; \
        pg8::StaticOrder S; S.init(ntile, 4, F.G, (int)blockIdx.x); \
        pg8::EpiDown E{args.in[24], (bf16*)(ws + WS_YBUF)}; \
        pg8::gemm_phase<pg8::EpiDown, true, true>(F.lds, g, S, E); }
    if (IN(0)) { p0_prologue(F, args); REP2(0) p0_prologue(F, args); }
    SEAM(0);
    if (IN(1)) { PH1 REP2(1) PH1 }
    SEAM(1);
    if (IN(2)) { prep_phase<true>(F, args); REP2(2) prep_phase<true>(F, args); attn_phase(F, args); REP2(11) attn_phase(F, args); }
    SEAM(2);
    if (IN(3)) { scan_phase(F, args); REP2(3) scan_phase(F, args); }
    SEAM(3);
    if (IN(4)) { combine_phase(F, args); REP2(4) combine_phase(F, args); }
    SEAM(4);
    if (IN(5)) { PH5 REP2(5) PH5 }
    SEAM(5);
    if (IN(6)) { router_phase(F, args); REP2(6) { __syncthreads(); router_phase(F, args); } }
    SEAM(6);
    if (IN(7)) { dispatch_phase(F, args); REP2(7) { __syncthreads(); dispatch_phase(F, args); } }
    SEAM(7);
    if (IN(8)) { PH8 REP2(8) PH8 }
    SEAM(8);
    if (IN(9)) { PH9 REP2(9) PH9 }
    SEAM(9);
    if (IN(10)) { final_phase(F, args); REP2(10) final_phase(F, args); }
#undef IN
#undef SEAM
}

extern "C" void kernel_launch(void* const* d_in, const int* in_sizes, int n_in, void* d_out, int out_size, void* d_ws, size_t ws_size, hipStream_t stream) {
    static int grid = 0;
    if (grid == 0) {
        if (n_in != 26 || in_sizes[0] != M * D || out_size != M * D || ws_size < WS_END) { fprintf(stderr, "kernel_launch: unexpected problem (n_in %d, in0 %d, out %d, ws %zu)\n", n_in, n_in > 0 ? in_sizes[0] : -1, out_size, ws_size); grid = -1; return; }
        int dev = 0, cus = 0, per_cu = 0;
        if (hipGetDevice(&dev) != hipSuccess || hipDeviceGetAttribute(&cus, hipDeviceAttributeMultiprocessorCount, dev) != hipSuccess) { grid = -1; return; }
        if (hipFuncSetAttribute((const void*)fwd_megakernel, hipFuncAttributeMaxDynamicSharedMemorySize, LDS_BYTES) != hipSuccess) { fprintf(stderr, "kernel_launch: hipFuncSetAttribute failed\n"); grid = -1; return; }
        if (hipOccupancyMaxActiveBlocksPerMultiprocessor(&per_cu, (const void*)fwd_megakernel, 512, LDS_BYTES) != hipSuccess || per_cu < 1) { fprintf(stderr, "kernel_launch: occupancy query says %d\n", per_cu); per_cu = 1; }
        (void)hipGetLastError();
        grid = cus * 1;
        if (grid != 256) fprintf(stderr, "kernel_launch: note: %d CUs\n", cus);
    }
    if (grid < 0) return;
    if (hipMemsetAsync((char*)d_ws + WS_CTL + (size_t)CW_BAR * 4, 0, XCD_BAR_WORDS * 4, stream) != hipSuccess) { fprintf(stderr, "kernel_launch: memset failed\n"); return; }
    Args a{};
    for (int i = 0; i < 26; ++i) a.in[i] = (const float*)d_in[i];
    a.out = (float*)d_out; a.ws = (unsigned char*)d_ws;
#if MK_SPLIT
    for (int ph = 0; ph < NPHASE; ++ph) { a.ph_lo = ph; a.ph_hi = ph + 1; hipLaunchKernelGGL(fwd_megakernel, dim3(grid), dim3(512), LDS_BYTES, stream, a); }
#else
    a.ph_lo = 0; a.ph_hi = NPHASE;
    void* kargs[] = {&a};
    hipError_t e = hipLaunchCooperativeKernel((const void*)fwd_megakernel, dim3(grid), dim3(512), kargs, LDS_BYTES, stream);
    if (e != hipSuccess) fprintf(stderr, "kernel_launch: cooperative launch failed: %s (grid %d)\n", hipGetErrorString(e), grid);
#endif
}
```

```cpp
#include <hip/hip_runtime.h>
#include <hip/hip_cooperative_groups.h>
#include <cstdio>
#include <cstdint>
namespace cg = cooperative_groups;

#ifndef MK_SPLIT
#define MK_SPLIT 0
#endif

#ifndef MK_REPEAT
#define MK_REPEAT 0
#endif
#define LAS __attribute__((address_space(3)))
typedef unsigned short bf16;
typedef float f32x4 __attribute__((ext_vector_type(4)));
typedef float f32x2 __attribute__((ext_vector_type(2)));
typedef unsigned u32x4 __attribute__((ext_vector_type(4)));
typedef unsigned u32x2 __attribute__((ext_vector_type(2)));
typedef short bf16x8 __attribute__((ext_vector_type(8)));

constexpr int BATCH = 4, T = 8192, D = 1024, M = BATCH * T;
constexpr int NH = 8, HD = 64, CW = 512;
constexpr int SHIFT_W = 1920, NPROJ = 3456, NPROJ_PAD = 3584, PW = 2048;
constexpr int NE = 32, TOPK = 4, DE = 1024;
constexpr int GRIDW = 64, GROWS = 128;
constexpr int P_TILES_MAX = 544, P_ROWS = P_TILES_MAX * 256;
constexpr float RMS_EPS = 1e-5f, GN_EPS = 64e-5f;
constexpr int NPHASE = 11;

constexpr size_t MiB = 1u << 20;
constexpr size_t WS_CTL = 0;
constexpr size_t WS_W2T = 1 * MiB, WS_A2T = WS_W2T + 131072, WS_G2T = WS_A2T + 131072;
constexpr size_t WS_WINT = 2 * MiB, WS_WOT = 9 * MiB, WS_WUPT = 12 * MiB, WS_WDNT = 140 * MiB;
constexpr size_t WS_EIDX = 204 * MiB, WS_GATE = WS_EIDX + 524288, WS_RANK = WS_GATE + 524288, WS_DEST = WS_RANK + 524288, WS_ROWTOK = WS_DEST + 524288;
constexpr size_t WS_R = 208 * MiB, WS_V = 240 * MiB, WS_KK = 272 * MiB, WS_DECAY = 304 * MiB, WS_KDIR = 368 * MiB, WS_AKK = 432 * MiB,
                 WS_G = 496 * MiB, WS_ATT = 528 * MiB;
constexpr size_t WS_Q = 560 * MiB, WS_K = 592 * MiB, WS_VT = 624 * MiB, WS_P = 656 * MiB, WS_HN = 784 * MiB, WS_Y = 848 * MiB;
constexpr size_t WS_MIX = 560 * MiB, WS_H = 752 * MiB, WS_HN2 = 880 * MiB, WS_XBUF = 208 * MiB, WS_ACT = 480 * MiB, WS_YBUF = 208 * MiB;
constexpr size_t WS_END = 976 * MiB;
constexpr int CW_NT = 0, CW_TEXP = 64, CW_CNT = 1024, CW_BAR = 16384;

constexpr int LDS_BYTES = 159744, LDS_MISC = LDS_BYTES - 256;

typedef __bf16 bf16x2_t __attribute__((ext_vector_type(2)));
__device__ __forceinline__ unsigned cvt_pk_bf16(float lo, float hi) { const f32x2 v = {lo, hi}; return __builtin_bit_cast(unsigned, __builtin_convertvector(v, bf16x2_t)); }
__device__ __forceinline__ float bflo(unsigned u) { return __uint_as_float(u << 16); }
__device__ __forceinline__ float bfhi(unsigned u) { return __uint_as_float(u & 0xffff0000u); }
__device__ __forceinline__ float bf1(bf16 v) { return __uint_as_float(((unsigned)v) << 16); }
__device__ __forceinline__ void unpack8(const u32x4 u, float* f) { f[0] = bflo(u.x); f[1] = bfhi(u.x); f[2] = bflo(u.y); f[3] = bfhi(u.y); f[4] = bflo(u.z); f[5] = bfhi(u.z); f[6] = bflo(u.w); f[7] = bfhi(u.w); }
__device__ __forceinline__ u32x4 pack8(const float* f) { u32x4 o; o.x = cvt_pk_bf16(f[0], f[1]); o.y = cvt_pk_bf16(f[2], f[3]); o.z = cvt_pk_bf16(f[4], f[5]); o.w = cvt_pk_bf16(f[6], f[7]); return o; }
__device__ __forceinline__ float wave_sum(float v) {
#pragma unroll
    for (int o = 1; o < 64; o <<= 1) v += __shfl_xor(v, o);
    return v;
}
__device__ __forceinline__ float sigmoidf_(float x) { return __builtin_amdgcn_rcpf(1.0f + __expf(-x)); }
__device__ __forceinline__ unsigned ld_u32_agent(const unsigned* p) { return __hip_atomic_load(p, __ATOMIC_RELAXED, __HIP_MEMORY_SCOPE_AGENT); }

namespace pg8 {
constexpr int BM = 256, BK = 64, HALF = 128, HTB = HALF * BK * 2, STAGE_BYTES = 8 * HTB, NXCD = 8, WGM = 8;
__host__ __device__ __forceinline__ int lds_byte(int r, int c) { const int st = (r >> 4) * 2 + (c >> 5), rr = r & 15, cc = c & 31, ob = rr * 64 + cc * 2; return st * 1024 + (ob ^ (((ob >> 9) & 1) << 5)); }
__host__ __device__ __forceinline__ void stage_rc(int b, int& R, int& C) { const int st = b / 1024, sb = b % 1024, swz = sb ^ (((sb >> 9) & 1) << 5); R = (st >> 1) * 16 + swz / 64; C = (st & 1) * 32 + (swz % 64) / 2; }
__host__ __device__ __forceinline__ int perm32(int rho) { const int n = rho >> 4, i = rho & 15; return 8 * (i >> 2) + 4 * n + (i & 3); }

struct Unit { int pm, pn, e; };
struct Gemm { const bf16* A; const bf16* Bt; int K; const unsigned* texp; size_t bstride; const int* rowtok; };

struct StaticOrder {
    int nM, nN, nwg, G, c;
    __device__ void init(int nM_, int nN_, int G_, int c_) { nM = nM_; nN = nN_; nwg = nM * nN; G = G_; c = c_; }
    __device__ bool next(int i, Unit& u) const {
        const long L = (long)i * G + c; if (L >= nwg) return false;
        int wgid = (int)L; { const int q = nwg / NXCD, r = nwg % NXCD, xcd = wgid % NXCD, off = wgid / NXCD; wgid = (xcd < r ? xcd * (q + 1) : r * (q + 1) + (xcd - r) * q) + off; }
        const int nig = WGM * nN, gid = wgid / nig, fm = gid * WGM, gsz = (nM - fm) < WGM ? (nM - fm) : WGM;
        u.pm = fm + ((wgid % nig) % gsz); u.pn = (wgid % nig) / gsz; u.e = 0; return true;
    }
};

template <class Epi, bool ALIGN_EPI, bool SP2, bool GATHER = false>
__device__ __forceinline__ void gemm_phase(LAS unsigned char* lds, const Gemm g, const StaticOrder& S, const Epi& E) {
    const int tid = threadIdx.x, wid = __builtin_amdgcn_readfirstlane(tid >> 6), lane = tid & 63, wr = wid >> 2, wc = wid & 3, fr = lane & 15, fq = lane >> 4;
    const int K = g.K, nt = K / BK;
    unsigned voffA[2], voffB[2];
#pragma unroll
    for (int i = 0; i < 2; ++i) { int R, C; stage_rc(tid * 16 + i * 8192, R, C); const int Rb = Epi::PERM ? ((R & ~31) + perm32(R & 31)) : R;
        voffA[i] = (unsigned)(R * K + C) * 2u; voffB[i] = (unsigned)(Rb * K + C) * 2u; }
    unsigned vC[2][2];
#define PG8_GROWS(u, dst) do { _Pragma("unroll") for (int h_ = 0; h_ < 2; ++h_) _Pragma("unroll") for (int i_ = 0; i_ < 2; ++i_) { int R_, C_; stage_rc(tid * 16 + i_ * 8192, R_, C_); \
        dst[h_][i_] = (unsigned)g.rowtok[(u).pm * BM + h_ * HALF + R_] * (unsigned)(K * 2) + (unsigned)(C_ * 2); } } while (0)
    const size_t kstep = (size_t)(BK * 2);
    const size_t hstep = (size_t)HALF * K * 2;
    const size_t tstep = 2 * hstep;
    const unsigned ldsw = (unsigned)wid * 1024u;
    const int aoff = lds_byte(wr * 64 + fr, fq * 8), boff = lds_byte(wc * 32 + fr, fq * 8);
#define PG8_SA(b, h) (((b) * 2 + (h)) * HTB)
#define PG8_SB(b, h) ((4 + (b) * 2 + (h)) * HTB)
#define PG8_STAGE(bufoff, gbase, voff) do { _Pragma("unroll") for (int _i = 0; _i < 2; ++_i) \
        __builtin_amdgcn_global_load_lds((const unsigned*)((const char*)(gbase) + (voff)[_i]), (LAS unsigned*)(lds + (bufoff) + ldsw + _i * 8192), 16, 0, 0); } while (0)
#define PG8_STAGE_A(bufoff, p, h, nx) do { if constexpr (GATHER) { PG8_STAGE(bufoff, p, vC[h]); } else PG8_STAGE(bufoff, (p) + (h) * hstep, voffA); } while (0)
#define PG8_LDA(dst, b, h) do { _Pragma("unroll") for (int m = 0; m < 4; ++m) _Pragma("unroll") for (int k = 0; k < 2; ++k) dst[m][k] = *(const LAS bf16x8*)(lds + PG8_SA(b, h) + aoff + m * 2048 + k * 1024); } while (0)
#define PG8_LDB(dst, b, h) do { _Pragma("unroll") for (int n = 0; n < 2; ++n) _Pragma("unroll") for (int k = 0; k < 2; ++k) dst[n][k] = *(const LAS bf16x8*)(lds + PG8_SB(b, h) + boff + n * 2048 + k * 1024); } while (0)
#define PG8_MMA(ai, bj, At, Bt) do { __builtin_amdgcn_s_setprio(1); _Pragma("unroll") for (int m = 0; m < 4; ++m) _Pragma("unroll") for (int n = 0; n < 2; ++n) _Pragma("unroll") for (int k = 0; k < 2; ++k) \
        acc[ai][bj][m][n] = __builtin_amdgcn_mfma_f32_16x16x32_bf16(Bt[n][k], At[m][k], acc[ai][bj][m][n], 0, 0, 0); __builtin_amdgcn_s_setprio(0); } while (0)
#define PG8_WAIT_V(n) asm volatile("s_waitcnt vmcnt(" #n ")" ::: "memory")
#define PG8_WAIT_L(n) asm volatile("s_waitcnt lgkmcnt(" #n ")" ::: "memory")
#define PG8_BAR __builtin_amdgcn_s_barrier()
#define PG8_SCHED __builtin_amdgcn_sched_barrier(0)
#define PG8_UPTR(u, pa, pb) do { unsigned _e = g.texp ? ld_u32_agent(g.texp + (u).pm) : 0u; _e = (unsigned)__builtin_amdgcn_readfirstlane((int)_e); (u).e = (int)_e; \
        pa = GATHER ? (const char*)g.A : (const char*)g.A + (size_t)(u).pm * tstep; pb = (const char*)g.Bt + (size_t)_e * g.bstride + (size_t)(u).pn * tstep; } while (0)
    Unit cur, nxt; int ui = 0;
    if (!S.next(0, cur)) return;
    f32x4 acc[2][2][4][2];
#pragma unroll
    for (int a = 0; a < 2; ++a)
#pragma unroll
        for (int b = 0; b < 2; ++b)
#pragma unroll
            for (int m = 0; m < 4; ++m)
#pragma unroll
                for (int n = 0; n < 2; ++n) acc[a][b][m][n] = (f32x4){0.f, 0.f, 0.f, 0.f};
    bf16x8 At[4][2], B0[2][2], B1[2][2];
    const char* cA; const char* cB;
    PG8_UPTR(cur, cA, cB);
    if constexpr (GATHER) { PG8_GROWS(cur, vC); }
    if constexpr (SP2) {
        PG8_STAGE(PG8_SB(0, 0), cB, voffB); PG8_STAGE(PG8_SB(0, 1), cB + hstep, voffB); PG8_STAGE_A(PG8_SA(0, 0), cA, 0, false); PG8_STAGE_A(PG8_SA(0, 1), cA, 1, false);
        if (wr == 1) PG8_BAR;
        PG8_WAIT_V(2); PG8_BAR;
        PG8_STAGE(PG8_SB(1, 0), cB + kstep, voffB); PG8_STAGE_A(PG8_SA(1, 0), cA + kstep, 0, false); PG8_STAGE(PG8_SB(1, 1), cB + hstep + kstep, voffB);
        PG8_WAIT_V(6); PG8_BAR;
    } else {
        PG8_STAGE(PG8_SB(0, 0), cB, voffB); PG8_STAGE_A(PG8_SA(0, 0), cA, 0, false); PG8_STAGE(PG8_SB(0, 1), cB + hstep, voffB); PG8_STAGE_A(PG8_SA(0, 1), cA, 1, false);
        if (wr == 1) PG8_BAR;
        PG8_WAIT_V(4); PG8_BAR;
        PG8_STAGE(PG8_SB(1, 0), cB + kstep, voffB); PG8_STAGE_A(PG8_SA(1, 0), cA + kstep, 0, false); PG8_STAGE(PG8_SB(1, 1), cB + hstep + kstep, voffB);
        PG8_WAIT_V(6); PG8_BAR;
    }
    for (;;) {
        const bool has_next = S.next(ui + 1, nxt);
        const char* nA = cA; const char* nB = cB;
        if (has_next) PG8_UPTR(nxt, nA, nB);
        for (int t = 0; t < nt; t += 2) {
            const bool last = (t == nt - 2);
            const char* a1 = cA + (size_t)(t + 1) * kstep;
            const char* a2 = last ? nA : cA + (size_t)(t + 2) * kstep; const char* b2 = last ? nB : cB + (size_t)(t + 2) * kstep;
            const char* a3 = a2 + kstep; const char* b3 = b2 + kstep;
            if constexpr (SP2) {
            PG8_LDB(B0, 0, 0); PG8_LDB(B1, 0, 1); PG8_SCHED; PG8_LDA(At, 0, 0); PG8_STAGE_A(PG8_SA(1, 1), a1, 1, false);
            if constexpr (GATHER) { if (last && has_next) { PG8_GROWS(nxt, vC); } }
            PG8_WAIT_V(8); PG8_WAIT_L(0); PG8_BAR; PG8_MMA(0, 0, At, B0); PG8_MMA(0, 1, At, B1); PG8_BAR; PG8_SCHED;
            PG8_LDA(At, 0, 1); PG8_STAGE(PG8_SB(0, 0), b2, voffB); PG8_STAGE(PG8_SB(0, 1), b2 + hstep, voffB); PG8_STAGE_A(PG8_SA(0, 0), a2, 0, last);
            PG8_WAIT_V(8); PG8_WAIT_L(0); PG8_BAR; PG8_MMA(1, 0, At, B0); PG8_MMA(1, 1, At, B1); PG8_BAR; PG8_SCHED;
            PG8_LDB(B0, 1, 0); PG8_LDB(B1, 1, 1); PG8_SCHED; PG8_LDA(At, 1, 0); PG8_STAGE_A(PG8_SA(0, 1), a2, 1, last);
            PG8_WAIT_V(8); PG8_WAIT_L(0); PG8_BAR; PG8_MMA(0, 0, At, B0); PG8_MMA(0, 1, At, B1); PG8_BAR; PG8_SCHED;
            PG8_LDA(At, 1, 1); PG8_STAGE(PG8_SB(1, 0), b3, voffB); PG8_STAGE(PG8_SB(1, 1), b3 + hstep, voffB); PG8_STAGE_A(PG8_SA(1, 0), a3, 0, last);
            PG8_WAIT_V(8); PG8_WAIT_L(0); PG8_BAR; PG8_MMA(1, 0, At, B0); PG8_MMA(1, 1, At, B1); PG8_BAR; PG8_SCHED;
            } else {
            PG8_LDB(B0, 0, 0); PG8_SCHED; PG8_LDA(At, 0, 0); PG8_STAGE_A(PG8_SA(1, 1), a1, 1, false);
            if constexpr (GATHER) { if (last && has_next) { PG8_GROWS(nxt, vC); } }
            PG8_WAIT_L(8); PG8_BAR; PG8_WAIT_L(0); PG8_MMA(0, 0, At, B0); PG8_BAR; PG8_SCHED;
            PG8_LDB(B1, 0, 1); PG8_STAGE(PG8_SB(0, 0), b2, voffB);
            PG8_BAR; PG8_WAIT_L(0); PG8_MMA(0, 1, At, B1); PG8_BAR;
            PG8_LDA(At, 0, 1); PG8_STAGE_A(PG8_SA(0, 0), a2, 0, last);
            PG8_BAR; PG8_WAIT_L(0); PG8_MMA(1, 0, At, B0); PG8_BAR; PG8_SCHED;
            PG8_STAGE(PG8_SB(0, 1), b2 + hstep, voffB);
            PG8_WAIT_V(6); PG8_BAR; PG8_MMA(1, 1, At, B1); PG8_BAR;
            PG8_LDB(B0, 1, 0); PG8_SCHED; PG8_LDA(At, 1, 0); PG8_STAGE_A(PG8_SA(0, 1), a2, 1, last);
            PG8_WAIT_L(8); PG8_BAR; PG8_WAIT_L(0); PG8_MMA(0, 0, At, B0); PG8_BAR; PG8_SCHED;
            PG8_LDB(B1, 1, 1); PG8_STAGE(PG8_SB(1, 0), b3, voffB);
            PG8_BAR; PG8_WAIT_L(0); PG8_MMA(0, 1, At, B1); PG8_BAR;
            PG8_LDA(At, 1, 1); PG8_STAGE_A(PG8_SA(1, 0), a3, 0, last);
            PG8_BAR; PG8_WAIT_L(0); PG8_MMA(1, 0, At, B0); PG8_BAR; PG8_SCHED;
            PG8_STAGE(PG8_SB(1, 1), b3 + hstep, voffB);
            PG8_WAIT_V(6); PG8_BAR; PG8_MMA(1, 1, At, B1); PG8_BAR;
            }
        }
        if constexpr (ALIGN_EPI) { if (wr == 0) PG8_BAR; }
        E(acc, cur, wr, wc, fr, fq);
        if (!has_next) break;
#pragma unroll
        for (int a = 0; a < 2; ++a)
#pragma unroll
            for (int b = 0; b < 2; ++b)
#pragma unroll
                for (int m = 0; m < 4; ++m)
#pragma unroll
                    for (int n = 0; n < 2; ++n) acc[a][b][m][n] = (f32x4){0.f, 0.f, 0.f, 0.f};
        cur = nxt; cA = nA; cB = nB; ++ui;
        if constexpr (ALIGN_EPI) { if (wr == 1) PG8_BAR; }
    }
    PG8_WAIT_V(0);
    if constexpr (!ALIGN_EPI) { if (wr == 0) PG8_BAR; }
    PG8_BAR;
#undef PG8_SA
#undef PG8_SB
#undef PG8_STAGE
#undef PG8_LDA
#undef PG8_LDB
#undef PG8_MMA
#undef PG8_WAIT_V
#undef PG8_WAIT_L
#undef PG8_BAR
#undef PG8_SCHED
#undef PG8_UPTR
#undef PG8_STAGE_A
#undef PG8_GROWS
}

struct EpiProj {
    static constexpr bool PERM = true;
    bf16 *q, *k, *vT, *p;
    __device__ __forceinline__ void operator()(const f32x4 (&acc)[2][2][4][2], const Unit& u, int wr, int wc, int fr, int fq) const {
        const int row0 = u.pm * BM + wr * 64 + fr;
        const int pn = u.pn;
#pragma unroll
        for (int ai = 0; ai < 2; ++ai)
#pragma unroll
            for (int m = 0; m < 4; ++m) {
                const int row = row0 + ai * HALF + m * 16;
#pragma unroll
                for (int bj = 0; bj < 2; ++bj) {
                    f32x4 v0 = acc[ai][bj][m][0], v1 = acc[ai][bj][m][1];
                    const int col = pn * BM + bj * HALF + wc * 32 + 8 * fq;
                    if (pn >= 4 && pn < 6) {
                        const int cv = col - 1024, hh = cv >> 6, dim = cv & 63, b = row / T, t = row % T;
                        bf16* dst = vT + ((size_t)((b * NH + hh) * HD + dim)) * T + t;
                        const unsigned w0 = cvt_pk_bf16(v0[0], v0[1]), w1 = cvt_pk_bf16(v0[2], v0[3]), w2 = cvt_pk_bf16(v1[0], v1[1]), w3 = cvt_pk_bf16(v1[2], v1[3]);
                        dst[0 * (size_t)T] = (bf16)(w0 & 0xffff); dst[1 * (size_t)T] = (bf16)(w0 >> 16); dst[2 * (size_t)T] = (bf16)(w1 & 0xffff); dst[3 * (size_t)T] = (bf16)(w1 >> 16);
                        dst[4 * (size_t)T] = (bf16)(w2 & 0xffff); dst[5 * (size_t)T] = (bf16)(w2 >> 16); dst[6 * (size_t)T] = (bf16)(w3 & 0xffff); dst[7 * (size_t)T] = (bf16)(w3 >> 16);
                    } else {
                        bf16* dst;
                        if (pn < 2) { v0 = v0 * 0.125f; v1 = v1 * 0.125f; dst = q + (size_t)row * CW + col; }
                        else if (pn < 4) dst = k + (size_t)row * CW + (col - 512);
                        else dst = p + (size_t)row * PW + (col - 1536);
                        u32x4 w; w.x = cvt_pk_bf16(v0[0], v0[1]); w.y = cvt_pk_bf16(v0[2], v0[3]); w.z = cvt_pk_bf16(v1[0], v1[1]); w.w = cvt_pk_bf16(v1[2], v1[3]);
                        *(u32x4*)dst = w;
                    }
                }
            }
    }
};
struct EpiWo {
    static constexpr bool PERM = false;
    const float* x; float* h;
    __device__ __forceinline__ void operator()(const f32x4 (&acc)[2][2][4][2], const Unit& u, int wr, int wc, int fr, int fq) const {
        const int row0 = u.pm * BM + wr * 64 + fr, col0 = u.pn * BM + wc * 32 + 4 * fq;
#pragma unroll
        for (int ai = 0; ai < 2; ++ai)
#pragma unroll
            for (int m = 0; m < 4; ++m) { const size_t off = (size_t)(row0 + ai * HALF + m * 16) * D + col0;
#pragma unroll
                for (int bj = 0; bj < 2; ++bj)
#pragma unroll
                    for (int n = 0; n < 2; ++n) { const f32x4 xv = *(const f32x4*)(x + off + bj * HALF + n * 16); *(f32x4*)(h + off + bj * HALF + n * 16) = acc[ai][bj][m][n] + xv; } }
    }
};
struct EpiUp {
    static constexpr bool PERM = true;
    const float* b_up; bf16* act;
    __device__ __forceinline__ void operator()(const f32x4 (&acc)[2][2][4][2], const Unit& u, int wr, int wc, int fr, int fq) const {
        const int row0 = u.pm * BM + wr * 64 + fr, ch = u.pn * 128 + wc * 32 + 8 * fq;
        const float* bg = b_up + (size_t)u.e * 2048 + ch; const float* bl = bg + 1024;
        const f32x4 bg0 = *(const f32x4*)bg, bg1 = *(const f32x4*)(bg + 4), bl0 = *(const f32x4*)bl, bl1 = *(const f32x4*)(bl + 4);
#pragma unroll
        for (int ai = 0; ai < 2; ++ai)
#pragma unroll
            for (int m = 0; m < 4; ++m) {
                float o[8];
#pragma unroll
                for (int n = 0; n < 2; ++n) { const f32x4 gv = acc[ai][0][m][n] + (n ? bg1 : bg0), lv = acc[ai][1][m][n] + (n ? bl1 : bl0);
#pragma unroll
                    for (int j = 0; j < 4; ++j) { const float gt = fminf(gv[j], 7.0f), li = fminf(fmaxf(lv[j], -7.0f), 7.0f); o[n * 4 + j] = (li + 1.0f) * gt * sigmoidf_(1.702f * gt); } }
                *(u32x4*)(act + (size_t)(row0 + ai * HALF + m * 16) * DE + ch) = pack8(o);
            }
    }
};
struct EpiDown {
    static constexpr bool PERM = true;
    const float* b_dn; bf16* y;
    __device__ __forceinline__ void operator()(const f32x4 (&acc)[2][2][4][2], const Unit& u, int wr, int wc, int fr, int fq) const {
        const int row0 = u.pm * BM + wr * 64 + fr, col0 = u.pn * BM + wc * 32 + 8 * fq;
        const float* bb = b_dn + (size_t)u.e * D + col0;
        f32x4 bv[2][2];
#pragma unroll
        for (int bj = 0; bj < 2; ++bj)
#pragma unroll
            for (int n = 0; n < 2; ++n) bv[bj][n] = *(const f32x4*)(bb + bj * HALF + 4 * n);
#pragma unroll
        for (int ai = 0; ai < 2; ++ai)
#pragma unroll
            for (int m = 0; m < 4; ++m) { bf16* rowp = y + (size_t)(row0 + ai * HALF + m * 16) * D + col0;
#pragma unroll
                for (int bj = 0; bj < 2; ++bj) { const f32x4 v0 = acc[ai][bj][m][0] + bv[bj][0], v1 = acc[ai][bj][m][1] + bv[bj][1];
                    u32x4 w; w.x = cvt_pk_bf16(v0[0], v0[1]); w.y = cvt_pk_bf16(v0[2], v0[3]); w.z = cvt_pk_bf16(v1[0], v1[1]); w.w = cvt_pk_bf16(v1[2], v1[3]);
                    *(u32x4*)(rowp + bj * HALF) = w; } }
    }
};
}


#define XB_TMO      128
#define XB_XCNT(j)  (256  + 64 * (j))
#define XB_XSUB(j)  (1280 + 64 * (j))
#define XB_XGEN(j)  (2304 + 64 * (j))
#define XB_TOP      3328
#define XB_TOPGEN   3392
#define XCD_BAR_WORDS 3456
#define XB_SPIN_CAP (1u << 20)
__device__ __forceinline__ unsigned xb_ld(unsigned* p)              { return __hip_atomic_load(p, __ATOMIC_RELAXED, __HIP_MEMORY_SCOPE_AGENT); }
__device__ __forceinline__ unsigned xb_add(unsigned* p, unsigned v) { return __hip_atomic_fetch_add(p, v, __ATOMIC_RELAXED, __HIP_MEMORY_SCOPE_AGENT); }
__device__ __forceinline__ unsigned xb_xcc_id() { return (unsigned)__builtin_amdgcn_s_getreg((3 << 11) | 20) & 0xFu; }
#define XB_SPIN(cond, bar) do { unsigned _sp = 0; while (cond) { __builtin_amdgcn_s_sleep(1); \
    if ((++_sp & 255u) == 0u) { if (xb_ld(&(bar)[XB_TMO])) break; if (_sp > XB_SPIN_CAP) { atomicAdd(&(bar)[XB_TMO], 1u); break; } } } } while (0)
struct XcdBarrier { unsigned* bar; unsigned x; volatile LAS unsigned* st; };
__device__ __forceinline__ XcdBarrier xcd_barrier_post(unsigned* bar, volatile LAS unsigned* st) {
    XcdBarrier b; b.bar = bar; b.x = xb_xcc_id(); b.st = st;
    if (threadIdx.x == 0) (void)xb_add(&bar[XB_XCNT(b.x)], 1u);
    return b;
}
__device__ __forceinline__ void xcd_barrier_complete(unsigned* bar, unsigned x, unsigned& nloc, unsigned& nx) {
    const unsigned G = gridDim.x * gridDim.y * gridDim.z;
    unsigned sum, cnt, mine, sp = 0u;
    for (;;) {
        sum = 0u; cnt = 0u; mine = 0u;
#pragma unroll
        for (unsigned j = 0; j < 16; ++j) { const unsigned c = xb_ld(&bar[XB_XCNT(j)]); sum += c; cnt += (c > 0u) ? 1u : 0u; mine = (j == x) ? c : mine; }
        if (sum == G) break;
        __builtin_amdgcn_s_sleep(1);
        if ((++sp & 255u) == 0u) { if (xb_ld(&bar[XB_TMO])) break; if (sp > XB_SPIN_CAP) { atomicAdd(&bar[XB_TMO], 1u); break; } }
    }
    nloc = mine > 0u ? mine : 1u; nx = cnt > 0u ? cnt : 1u;
}
__device__ __forceinline__ void xcd_barrier(const XcdBarrier& b) {
    asm volatile("s_waitcnt vmcnt(0)" ::: "memory");
    __syncthreads();
    if (threadIdx.x == 0) {
        unsigned* bar = b.bar;
        __builtin_amdgcn_s_waitcnt(0);
        unsigned nloc = b.st[0], nx = b.st[1];
        if (nloc == 0u) { xcd_barrier_complete(bar, b.x, nloc, nx); b.st[0] = nloc; b.st[1] = nx; }
        const unsigned old = xb_add(&bar[XB_XSUB(b.x)], 1u);
        const unsigned gen = old / nloc;
        if (old + 1u == (gen + 1u) * nloc) {
            __builtin_amdgcn_fence(__ATOMIC_RELEASE, "agent");
            asm volatile("s_waitcnt vmcnt(0)" ::: "memory");
            const unsigned og = xb_add(&bar[XB_TOP], 1u);
            const unsigned tg = og / nx;
            if (og + 1u == (tg + 1u) * nx) xb_add(&bar[XB_TOPGEN], 1u);
            else XB_SPIN(xb_ld(&bar[XB_TOPGEN]) == tg, bar);
            __builtin_amdgcn_fence(__ATOMIC_ACQUIRE, "agent");
            xb_add(&bar[XB_XGEN(b.x)], 1u);
            asm volatile("s_waitcnt vmcnt(0)" ::: "memory");
        } else {
            XB_SPIN(xb_ld(&bar[XB_XGEN(b.x)]) == gen, bar);
            __builtin_amdgcn_fence(__ATOMIC_ACQUIRE, "agent");
            asm volatile("s_waitcnt vmcnt(0)" ::: "memory");
        }
    }
    __syncthreads();
}

struct Args { const float* in[26]; float* out; unsigned char* ws; int ph_lo, ph_hi; };

struct Frame { LAS unsigned char* lds; int tid, lane, wave, G, vcu; };

__device__ __forceinline__ void transpose_item(const float* W, int K, int N, bf16* WT, int k0, int n0, int orow0, LAS float* scr, int lane) {
#pragma unroll 8
    for (int i = 0; i < 32; ++i) { const int kk = 2 * i + (lane >> 5); scr[kk * 33 + (lane & 31)] = W[(size_t)(k0 + kk) * N + n0 + (lane & 31)]; }
    asm volatile("s_waitcnt lgkmcnt(0)" ::: "memory");
    const int c = lane & 7;
#pragma unroll
    for (int j = 0; j < 4; ++j) { const int n = (lane >> 3) + 8 * j; const LAS float* s = scr + (8 * c) * 33 + n;
        u32x4 o; o.x = cvt_pk_bf16(s[0 * 33], s[1 * 33]); o.y = cvt_pk_bf16(s[2 * 33], s[3 * 33]); o.z = cvt_pk_bf16(s[4 * 33], s[5 * 33]); o.w = cvt_pk_bf16(s[6 * 33], s[7 * 33]);
        *(u32x4*)(WT + (size_t)(orow0 + n) * K + k0 + 8 * c) = o; }
    asm volatile("s_waitcnt lgkmcnt(0)" ::: "memory");
}

__device__ __forceinline__ void p0_prologue(const Frame& F, const Args& a) {
    unsigned char* ws = a.ws;
    LAS float* scr = (LAS float*)(F.lds + F.wave * 8448);
    const int gw = F.vcu * 8 + F.wave, NGW = F.G * 8;
    constexpr int I_IN = 16 * 108, I_O = 16 * 32, I_UP = 0, I_DN = 0, I_L = 16, I_G = 32;
    constexpr int NITEMS = I_IN + I_O + I_UP + I_DN + 2 * I_L + 2 * I_L + I_G;
    for (int it = gw; it < NITEMS; it += NGW) {
        int r = it;
        if (r < I_UP) {
            const int e = r / 1024, q = r % 1024, kb = q / 64, nb = q % 64, n0 = nb * 32;
            const int orow0 = n0 < 1024 ? 256 * (n0 >> 7) + (n0 & 127) : 256 * ((n0 - 1024) >> 7) + 128 + ((n0 - 1024) & 127);
            transpose_item(a.in[21] + (size_t)e * 1024 * 2048, 1024, 2048, (bf16*)(ws + WS_WUPT) + (size_t)e * 2048 * 1024, kb * 64, n0, orow0, scr, F.lane); continue; }
        r -= I_UP;
        if (r < I_DN) { const int e = r / 512, q = r % 512, kb = q / 32, nb = q % 32;
            transpose_item(a.in[23] + (size_t)e * 1024 * 1024, 1024, 1024, (bf16*)(ws + WS_WDNT) + (size_t)e * 1024 * 1024, kb * 64, nb * 32, nb * 32, scr, F.lane); continue; }
        r -= I_DN;
        if (r < I_IN) { const int kb = r / 108, nb = r % 108; transpose_item(a.in[2], 1024, NPROJ, (bf16*)(ws + WS_WINT), kb * 64, nb * 32, nb * 32, scr, F.lane); continue; }
        r -= I_IN;
        if (r < I_O) { const int kb = r / 32, nb = r % 32; transpose_item(a.in[17], 1024, 1024, (bf16*)(ws + WS_WOT), kb * 64, nb * 32, nb * 32, scr, F.lane); continue; }
        r -= I_O;
        if (r < 2 * I_L) { const int z = r / 16, nb = r % 16; transpose_item(a.in[8] + (size_t)z * 64 * 512, 64, 512, (bf16*)(ws + WS_W2T) + (size_t)z * 512 * 64, 0, nb * 32, nb * 32, scr, F.lane); continue; }
        r -= 2 * I_L;
        if (r < 2 * I_L) { const int z = r / 16, nb = r % 16; transpose_item(a.in[10] + (size_t)z * 64 * 512, 64, 512, (bf16*)(ws + WS_A2T) + (size_t)z * 512 * 64, 0, nb * 32, nb * 32, scr, F.lane); continue; }
        r -= 2 * I_L;
        { const int kb = r / 16, nb = r % 16; transpose_item(a.in[11], 128, 512, (bf16*)(ws + WS_G2T), kb * 64, nb * 32, nb * 32, scr, F.lane); }
    }
    { u32x4* z = (u32x4*)(ws + WS_WINT + (size_t)NPROJ * 1024 * 2); const u32x4 zero = {0u, 0u, 0u, 0u};
      for (int i = F.vcu * 512 + F.tid; i < 16384; i += F.G * 512) z[i] = zero; }
    const float* x = a.in[0]; const float* nw = a.in[1]; bf16* hn = (bf16*)(ws + WS_HN);
    f32x4 wv[4];
#pragma unroll
    for (int j = 0; j < 4; ++j) wv[j] = *((const f32x4*)nw + F.lane + 64 * j);
    for (int m = gw; m < M; m += NGW) {
        const f32x4* xr = (const f32x4*)(x + (size_t)m * D) + F.lane;
        f32x4 v[4]; float s = 0.f;
#pragma unroll
        for (int j = 0; j < 4; ++j) { v[j] = xr[64 * j]; s += (v[j].x * v[j].x + v[j].y * v[j].y) + (v[j].z * v[j].z + v[j].w * v[j].w); }
        const float rs = rsqrtf(wave_sum(s) * (1.f / D) + RMS_EPS);
        u32x2* o8 = (u32x2*)(hn + (size_t)m * D) + F.lane;
#pragma unroll
        for (int j = 0; j < 4; ++j) { u32x2 o; o.x = cvt_pk_bf16(v[j].x * rs * wv[j].x, v[j].y * rs * wv[j].y); o.y = cvt_pk_bf16(v[j].z * rs * wv[j].z, v[j].w * rs * wv[j].w); o8[64 * j] = o; }
    }
}

constexpr int PREP_KBUF = 0, PREP_INV = 65536, PREP_AW = 67584, PREP_AA = PREP_AW + 17408, PREP_AG = PREP_AA + 17408, PREP_LD = 136;
template <bool STORE>
__device__ __forceinline__ void prep_phase(const Frame& F, const Args& a) {
    unsigned char* ws = a.ws;
    const bf16* p = (const bf16*)(ws + WS_P);
    bf16* r_out = (bf16*)(ws + WS_R); bf16* v_out = (bf16*)(ws + WS_V); bf16* kk_out = (bf16*)(ws + WS_KK);
    bf16* decay_out = (bf16*)(ws + WS_DECAY); bf16* kdir_out = (bf16*)(ws + WS_KDIR); bf16* akk_out = (bf16*)(ws + WS_AKK); bf16* g_out = (bf16*)(ws + WS_G);
    const bf16* w2T = (const bf16*)(ws + WS_W2T); const bf16* a2T = (const bf16*)(ws + WS_A2T); const bf16* g2T = (const bf16*)(ws + WS_G2T);
    const float* mu_p = a.in[5]; const float* mu_n = a.in[6]; const float* w0 = a.in[7]; const float* a0 = a.in[9];
    const float* k_k = a.in[12]; const float* k_a = a.in[13];
    LAS bf16* kbuf = (LAS bf16*)(F.lds + PREP_KBUF); LAS float* invb = (LAS float*)(F.lds + PREP_INV);
    LAS bf16* Aw = (LAS bf16*)(F.lds + PREP_AW); LAS bf16* Aa = (LAS bf16*)(F.lds + PREP_AA); LAS bf16* Ag = (LAS bf16*)(F.lds + PREP_AG);
    const int lane = F.lane, wave = F.wave, fr = lane & 15, fg = lane >> 4;
    for (int tile = F.vcu; tile < M / 64; tile += F.G) {
        const int m0 = tile * 64;
#pragma unroll 1
        for (int jj = 0; jj < 4; ++jj) {
            const int q = lane + 64 * jj; const bool valid = q < 240; const int c0 = 8 * q;
            float mp[8], mn[8];
#pragma unroll
            for (int i = 0; i < 8; ++i) { mp[i] = valid ? mu_p[c0 + i] : 0.f; mn[i] = valid ? mu_n[c0 + i] : 0.f; }
            const int mfirst = m0 + wave * 8;
            const u32x4 zero = {0u, 0u, 0u, 0u};
            u32x4 rows[10];
#pragma unroll
            for (int rI = 0; rI < 10; ++rI) { const int mr = mfirst - 1 + rI;
                const bool ok = valid && !(rI == 0 && (mfirst % T) == 0) && !(rI == 9 && ((mfirst + 7) % T) == T - 1);
                rows[rI] = ok ? *(const u32x4*)(p + (size_t)mr * PW + c0) : zero; }
#pragma unroll
            for (int i = 0; i < 8; ++i) {
                const int m = mfirst + i, it = wave * 8 + i;
                const u32x4 prev = rows[i], cur = rows[i + 1], nxt = rows[i + 2];
                float fp[8], fc[8], fn[8], s[8];
                unpack8(prev, fp); unpack8(cur, fc); unpack8(nxt, fn);
#pragma unroll
                for (int e = 0; e < 8; ++e) s[e] = fc[e] + mp[e] * (fp[e] - fc[e]) + mn[e] * (fn[e] - fc[e]);
                if (jj == 0) { if (STORE) { *(u32x4*)(r_out + (size_t)m * CW + c0) = pack8(s); } }
                else if (jj == 1) {
                    const int c = c0 - 512;
                    *(LAS u32x4*)(kbuf + it * 512 + c) = pack8(s);
                    float kr[8]; float ss = 0.f;
#pragma unroll
                    for (int e = 0; e < 8; ++e) { kr[e] = s[e] * k_k[c + e]; ss += kr[e] * kr[e]; }
                    ss += __shfl_xor(ss, 1); ss += __shfl_xor(ss, 2); ss += __shfl_xor(ss, 4);
                    const float inv = fminf(__builtin_amdgcn_rsqf(ss), 1e12f);
#pragma unroll
                    for (int e = 0; e < 8; ++e) kr[e] *= inv;
                    if (STORE) { *(u32x4*)(kk_out + (size_t)m * CW + c) = pack8(kr); }
                    if ((lane & 7) == 0) invb[it * 8 + (lane >> 3)] = inv;
                }
                else if (jj == 2) { if (STORE) { *(u32x4*)(v_out + (size_t)m * CW + (c0 - 1024)) = pack8(s); } }
                else if (valid) {
                    const int seg = lane >> 4, cw = 8 * (lane & 15);
                    if (seg == 0) {
#pragma unroll
                        for (int e = 0; e < 8; ++e) s[e] = 1.0f - 2.0f * __builtin_amdgcn_rcpf(__expf(2.0f * s[e]) + 1.0f);
                        *(LAS u32x4*)(Aw + it * PREP_LD + cw) = pack8(s);
                    } else if (seg == 1) { *(LAS u32x4*)(Aa + it * PREP_LD + cw) = pack8(s); }
                    else {
#pragma unroll
                        for (int e = 0; e < 8; ++e) s[e] = sigmoidf_(s[e]);
                        *(LAS u32x4*)(Ag + it * PREP_LD + cw) = pack8(s);
                    }
                }
            }
        }
        __syncthreads();
        const int nb = 64 * wave;
#pragma unroll 1
        for (int job = 0; job < 5; ++job) {
            const int z = job & 1;
            const bf16* WT = job < 2 ? w2T + (size_t)z * 512 * 64 : (job < 4 ? a2T + (size_t)z * 512 * 64 : g2T);
            const LAS bf16* Ax = job < 2 ? Aw + z * 64 : (job < 4 ? Aa + z * 64 : Ag);
            const int kw = job < 4 ? 64 : 128, nks = kw / 32;
            f32x4 acc[4][4];
#pragma unroll
            for (int mt = 0; mt < 4; ++mt)
#pragma unroll
                for (int nt = 0; nt < 4; ++nt) acc[mt][nt] = (f32x4){0.f, 0.f, 0.f, 0.f};
#pragma unroll 1
            for (int ks = 0; ks < nks; ++ks) {
                bf16x8 af[4], wf[4];
#pragma unroll
                for (int mt = 0; mt < 4; ++mt) af[mt] = *(const LAS bf16x8*)(Ax + (16 * mt + fr) * PREP_LD + 32 * ks + 8 * fg);
#pragma unroll
                for (int nt = 0; nt < 4; ++nt) wf[nt] = *(const bf16x8*)(WT + (size_t)(nb + 16 * nt + fr) * kw + 32 * ks + 8 * fg);
#pragma unroll
                for (int mt = 0; mt < 4; ++mt)
#pragma unroll
                    for (int nt = 0; nt < 4; ++nt) acc[mt][nt] = __builtin_amdgcn_mfma_f32_16x16x32_bf16(wf[nt], af[mt], acc[mt][nt], 0, 0, 0);
            }
#pragma unroll
            for (int mt = 0; mt < 4; ++mt) {
                const int it = 16 * mt + fr; const size_t m = (size_t)(m0 + it);
#pragma unroll
                for (int nt = 0; nt < 4; ++nt) {
                    const int n = nb + 16 * nt + 4 * fg;
                    const f32x4 v = acc[mt][nt];
                    if (job < 2) {
                        const f32x4 b = *(const f32x4*)(w0 + z * 512 + n);
                        float o[4];
#pragma unroll
                        for (int i = 0; i < 4; ++i) o[i] = __expf(-0.60653066f * sigmoidf_(v[i] + b[i]));
                        u32x2 w; w.x = cvt_pk_bf16(o[0], o[1]); w.y = cvt_pk_bf16(o[2], o[3]);
                        if (STORE) { *(u32x2*)(decay_out + ((size_t)z * M + m) * CW + n) = w; }
                    } else if (job < 4) {
                        const f32x4 b = *(const f32x4*)(a0 + z * 512 + n), kkc = *(const f32x4*)(k_k + n), kac = *(const f32x4*)(k_a + n);
                        const u32x2 kb = *(const LAS u32x2*)(kbuf + it * 512 + n);
                        const float kv[4] = {bflo(kb.x), bfhi(kb.x), bflo(kb.y), bfhi(kb.y)};
                        const float inv = invb[it * 8 + wave];
                        float kd[4], ak[4];
#pragma unroll
                        for (int i = 0; i < 4; ++i) { const float av = sigmoidf_(v[i] + b[i]); kd[i] = kv[i] * (1.0f + (av - 1.0f) * kac[i]); ak[i] = av * (kv[i] * kkc[i] * inv); }
                        u32x2 w; w.x = cvt_pk_bf16(kd[0], kd[1]); w.y = cvt_pk_bf16(kd[2], kd[3]);
                        if (STORE) { *(u32x2*)(kdir_out + ((size_t)z * M + m) * CW + n) = w; }
                        w.x = cvt_pk_bf16(ak[0], ak[1]); w.y = cvt_pk_bf16(ak[2], ak[3]);
                        if (STORE) { *(u32x2*)(akk_out + ((size_t)z * M + m) * CW + n) = w; }
                    } else {
                        u32x2 w; w.x = cvt_pk_bf16(v[0], v[1]); w.y = cvt_pk_bf16(v[2], v[3]);
                        if (STORE) { *(u32x2*)(g_out + m * CW + n) = w; }
                    }
                }
            }
        }
        __syncthreads();
    }
}

__device__ __forceinline__ void attn_phase(const Frame& F, const Args& a) {
    unsigned char* ws = a.ws;
    const bf16* q = (const bf16*)(ws + WS_Q); const bf16* k = (const bf16*)(ws + WS_K); const bf16* vT = (const bf16*)(ws + WS_VT);
    bf16* att = (bf16*)(ws + WS_ATT);
    LAS float* bias = (LAS float*)F.lds;
    for (int i = F.tid; i < 8 * 15 * 31; i += 512) bias[i] = a.in[3][i];
    __syncthreads();
    const int lane = F.lane, fr = lane & 15, fg = lane >> 4;
    const int NGW = F.G * 8, gw = F.vcu * 8 + F.wave;
    const int per = (16384 + NGW - 1) / NGW;
    for (int task = gw * per; task < (gw + 1) * per && task < 16384; ++task) {
        const int cgp = task & 3, r = (task >> 2) & 127, h = (task >> 9) & 7, b = task >> 12;
        const int c0 = 16 * cgp, wsc = min(max(c0 - 8, 0), 32), rs = min(max(r - 4, 0), GROWS - 8);
        const int c = c0 + fr, cs = min(max(c - 8, 0), 48);
        const size_t tq = (size_t)b * T + r * 64 + c;
        bf16x8 qf[2];
#pragma unroll
        for (int ks = 0; ks < 2; ++ks) qf[ks] = *(const bf16x8*)(q + tq * CW + h * 64 + 32 * ks + 8 * fg);
        f32x4 sc[16];
        const int kcol_a = wsc + 8 * (fr >> 2) + (fr & 3);
#pragma unroll
        for (int hb = 0; hb < 2; ++hb) {
            bf16x8 kf[8][2];
#pragma unroll
            for (int tl = 0; tl < 8; ++tl) { const int t = 8 * hb + tl, u = t >> 1, par = t & 1;
                const size_t tk = (size_t)b * T + (rs + u) * 64 + kcol_a + 4 * par;
                kf[tl][0] = *(const bf16x8*)(k + tk * CW + h * 64 + 8 * fg); kf[tl][1] = *(const bf16x8*)(k + tk * CW + h * 64 + 32 + 8 * fg); }
#pragma unroll
            for (int tl = 0; tl < 8; ++tl) { f32x4 s = {0.f, 0.f, 0.f, 0.f};
                s = __builtin_amdgcn_mfma_f32_16x16x32_bf16(kf[tl][0], qf[0], s, 0, 0, 0);
                s = __builtin_amdgcn_mfma_f32_16x16x32_bf16(kf[tl][1], qf[1], s, 0, 0, 0);
                sc[8 * hb + tl] = s; }
        }
        float mx = -1e30f;
#pragma unroll
        for (int u = 0; u < 8; ++u) {
            const int dr = rs + u - r + 7;
#pragma unroll
            for (int par = 0; par < 2; ++par)
#pragma unroll
                for (int i = 0; i < 4; ++i) {
                    const int kc = wsc + 8 * fg + 4 * par + i; const bool ok = (kc >= cs) && (kc < cs + 16);
                    const int dc = min(max(kc - c + 15, 0), 30);
                    const float s = ok ? sc[2 * u + par][i] + bias[(h * 15 + dr) * 31 + dc] : -1e30f;
                    sc[2 * u + par][i] = s; mx = fmaxf(mx, s);
                }
        }
        mx = fmaxf(mx, __shfl_xor(mx, 16)); mx = fmaxf(mx, __shfl_xor(mx, 32));
        float sum = 0.f;
#pragma unroll
        for (int t = 0; t < 16; ++t)
#pragma unroll
            for (int i = 0; i < 4; ++i) { const float pv = sc[t][i] > -1e29f ? __expf(sc[t][i] - mx) : 0.f; sc[t][i] = pv; sum += pv; }
        sum += __shfl_xor(sum, 16); sum += __shfl_xor(sum, 32);
        const float inv = 1.0f / sum;
        f32x4 o[4];
#pragma unroll
        for (int nt = 0; nt < 4; ++nt) o[nt] = (f32x4){0.f, 0.f, 0.f, 0.f};
#pragma unroll
        for (int hb = 0; hb < 2; ++hb) {
            bf16x8 vf[4][4];
#pragma unroll
            for (int ul = 0; ul < 4; ++ul) { const int u = 4 * hb + ul; const size_t tv = (size_t)(rs + u) * 64 + wsc + 8 * fg;
#pragma unroll
                for (int nt = 0; nt < 4; ++nt) vf[ul][nt] = *(const bf16x8*)(vT + ((size_t)((b * NH + h) * HD + 16 * nt + fr)) * T + tv); }
#pragma unroll
            for (int ul = 0; ul < 4; ++ul) { const int u = 4 * hb + ul;
                union { u32x4 w; bf16x8 h8; } pf;
                pf.w.x = cvt_pk_bf16(sc[2 * u][0], sc[2 * u][1]); pf.w.y = cvt_pk_bf16(sc[2 * u][2], sc[2 * u][3]);
                pf.w.z = cvt_pk_bf16(sc[2 * u + 1][0], sc[2 * u + 1][1]); pf.w.w = cvt_pk_bf16(sc[2 * u + 1][2], sc[2 * u + 1][3]);
#pragma unroll
                for (int nt = 0; nt < 4; ++nt) o[nt] = __builtin_amdgcn_mfma_f32_16x16x32_bf16(vf[ul][nt], pf.h8, o[nt], 0, 0, 0); }
        }
#pragma unroll
        for (int nt = 0; nt < 4; ++nt) { u32x2 w; w.x = cvt_pk_bf16(o[nt][0] * inv, o[nt][1] * inv); w.y = cvt_pk_bf16(o[nt][2] * inv, o[nt][3] * inv);
            *(u32x2*)(att + tq * CW + h * 64 + 16 * nt + 4 * fg) = w; }
    }
    __syncthreads();
}

constexpr int SC_TC = 32, SC_REC = 1344, SC_STAGE = SC_TC * SC_REC  , SC_YB = SC_TC * 1024, SC_YOFF = 2 * SC_STAGE  ;
__device__ __forceinline__ float row16_sum(float v) {
    v += __builtin_bit_cast(float, __builtin_amdgcn_update_dpp(0, __builtin_bit_cast(int, v), 0xB1, 0xF, 0xF, true));
    v += __builtin_bit_cast(float, __builtin_amdgcn_update_dpp(0, __builtin_bit_cast(int, v), 0x4E, 0xF, 0xF, true));
    v += __builtin_bit_cast(float, __builtin_amdgcn_update_dpp(0, __builtin_bit_cast(int, v), 0x141, 0xF, 0xF, true));
    v += __builtin_bit_cast(float, __builtin_amdgcn_update_dpp(0, __builtin_bit_cast(int, v), 0x140, 0xF, 0xF, true));
    return v;
}
__device__ __forceinline__ void scan_phase(const Frame& F, const Args& a) {
    unsigned char* ws = a.ws;
    const int seq = F.vcu >> 2, rg = F.vcu & 3;
    if (seq >= 64) return;
    const int z = seq >> 5, b = (seq >> 3) & 3, h = seq & 7;
    const bf16* vsrc = (const bf16*)(ws + WS_V);
    float* yout = (float*)(ws + WS_Y) + (size_t)z * M * CW;
    const size_t mb = (size_t)b * T;
    const int lane = F.lane, wave = F.wave;
    constexpr int NCH = T / SC_TC;
    if (wave >= 4) {
        const int u = F.tid - 256;
        const bf16* gp[5]; int ldo[5];
        const long tstep = z ? -(long)CW : (long)CW;
#pragma unroll
        for (int j = 0; j < 5; ++j) { const int piece = u + 256 * j, tau = piece / 40, w = piece % 40, arr = w >> 3, part = w & 7;
            const bf16* base = arr == 0 ? (const bf16*)(ws + WS_KK) : arr == 1 ? (const bf16*)(ws + WS_DECAY) + (size_t)z * M * CW : arr == 2 ? (const bf16*)(ws + WS_AKK) + (size_t)z * M * CW
                             : arr == 3 ? (const bf16*)(ws + WS_KDIR) + (size_t)z * M * CW : (const bf16*)(ws + WS_R);
            const int t0 = z ? (T - 1 - tau) : tau;
            gp[j] = base + (mb + t0) * CW + h * 64 + part * 8; ldo[j] = tau * SC_REC + w * 32; }
        const int vtau = (u & 63) >> 1, vpart = u & 1;
        const bf16* gv = vsrc + (mb + (z ? (T - 1 - vtau) : vtau)) * CW + h * 64 + rg * 16 + vpart * 8;
        const int ldv = vtau * SC_REC + 1280 + vpart * 32;
        u32x4 reg0, reg1, reg2, reg3, reg4, regv = {0u, 0u, 0u, 0u};
#define SC_LOAD(c) do { const long adv = (long)(c) * SC_TC * tstep; reg0 = *(const u32x4*)(gp[0] + adv); reg1 = *(const u32x4*)(gp[1] + adv); reg2 = *(const u32x4*)(gp[2] + adv); \
            reg3 = *(const u32x4*)(gp[3] + adv); reg4 = *(const u32x4*)(gp[4] + adv); if (u < 64) regv = *(const u32x4*)(gv + adv); } while (0)
#define SC_W1(rg_, off_) do { float f_[8]; unpack8(rg_, f_); LAS f32x4* d_ = (LAS f32x4*)(st_ + (off_)); d_[0] = (f32x4){f_[0], f_[1], f_[2], f_[3]}; d_[1] = (f32x4){f_[4], f_[5], f_[6], f_[7]}; } while (0)
#define SC_WRITE(buf) do { LAS unsigned char* st_ = F.lds + (buf) * SC_STAGE; SC_W1(reg0, ldo[0]); SC_W1(reg1, ldo[1]); SC_W1(reg2, ldo[2]); SC_W1(reg3, ldo[3]); SC_W1(reg4, ldo[4]); \
            if (u < 64) SC_W1(regv, ldv); } while (0)
#define SC_YRED(c) do { const LAS unsigned char* yb_ = F.lds + SC_YOFF + ((c) & 1) * SC_YB; _Pragma("unroll") for (int j = 0; j < 2; ++j) { const int o_ = u + 256 * j, tau_ = o_ >> 4, row_ = o_ & 15; \
            const LAS f32x4* s_ = (const LAS f32x4*)(yb_ + tau_ * 1024 + row_ * 64); const f32x4 s0 = s_[0], s1 = s_[1], s2 = s_[2], s3 = s_[3]; \
            const float tot_ = (((s0.x + s0.y) + (s0.z + s0.w)) + ((s1.x + s1.y) + (s1.z + s1.w))) + (((s2.x + s2.y) + (s2.z + s2.w)) + ((s3.x + s3.y) + (s3.z + s3.w))); \
            const int n_ = (c) * SC_TC + tau_, t_ = z ? (T - 1 - n_) : n_; yout[(mb + t_) * CW + h * 64 + rg * 16 + row_] = tot_; } } while (0)
        const int lw = F.vcu * 4 + (wave - 4);
        float wv[32]; const float* wsrc = nullptr; bf16* wdst = nullptr; int wN = 0;
#pragma unroll
        for (int q = 0; q < 32; ++q) wv[q] = 0.f;
        SC_LOAD(0); SC_WRITE(0); SC_LOAD(1);
        __syncthreads();
#pragma unroll 1
        for (int c = 0; c < NCH; ++c) {
            if (c + 1 < NCH) SC_WRITE((c + 1) & 1);
            if (c + 2 < NCH) SC_LOAD(c + 2);
            if (c >= 1) SC_YRED(c - 1);
            const int ph5 = c % 5, j5 = c / 5;
            if (ph5 == 0 && j5 < 48) {
                const int id = lw + 1024 * j5;
                int e, kb, n0, orow, K_ = 1024;
                if (id < 32768) { e = id >> 10; const int q = id & 1023; kb = q >> 5; n0 = (q & 31) * 64; wN = 2048;
                    orow = n0 < 1024 ? 256 * (n0 >> 7) + (n0 & 127) : 256 * ((n0 - 1024) >> 7) + 128 + ((n0 - 1024) & 127);
                    wsrc = a.in[21] + (size_t)e * 1024 * 2048 + (size_t)(kb * 32) * 2048 + n0 + lane; wdst = (bf16*)(ws + WS_WUPT) + (size_t)e * 2048 * 1024 + (size_t)(orow + lane) * K_ + kb * 32; }
                else { const int i2 = id - 32768; e = i2 >> 9; const int q = i2 & 511; kb = q >> 4; n0 = (q & 15) * 64; wN = 1024;
                    wsrc = a.in[23] + (size_t)e * 1024 * 1024 + (size_t)(kb * 32) * 1024 + n0 + lane; wdst = (bf16*)(ws + WS_WDNT) + (size_t)e * 1024 * 1024 + (size_t)(n0 + lane) * K_ + kb * 32; }
#pragma unroll
                for (int q = 0; q < 32; ++q) wv[q] = wsrc[(size_t)q * wN];
            } else if (ph5 == 1 && j5 < 48) {
#pragma unroll
                for (int q4 = 0; q4 < 4; ++q4) { u32x4 o; o.x = cvt_pk_bf16(wv[8 * q4 + 0], wv[8 * q4 + 1]); o.y = cvt_pk_bf16(wv[8 * q4 + 2], wv[8 * q4 + 3]); o.z = cvt_pk_bf16(wv[8 * q4 + 4], wv[8 * q4 + 5]); o.w = cvt_pk_bf16(wv[8 * q4 + 6], wv[8 * q4 + 7]);
                    *(u32x4*)(wdst + 8 * q4) = o; }
            }
            __syncthreads();
        }
        SC_YRED(NCH - 1);
#undef SC_LOAD
#undef SC_W1
#undef SC_WRITE
#undef SC_YRED
    } else {
        const int cg4 = lane & 15, row = wave * 4 + (lane >> 4);
        f32x2 S01 = {0.f, 0.f}, S23 = {0.f, 0.f};
        __builtin_amdgcn_s_setprio(3);
        __syncthreads();
#pragma unroll 1
        for (int c = 0; c < NCH; ++c) {
            const LAS unsigned char* st = F.lds + (c & 1) * SC_STAGE + cg4 * 16;
            const LAS unsigned char* sv = F.lds + (c & 1) * SC_STAGE + 1280 + row * 4;
            LAS float* yb = (LAS float*)(F.lds + SC_YOFF + (c & 1) * SC_YB) + wave * 64 + lane;
            f32x4 Rkk[3], Rw[3], Rak[3], Rk[3], Rr[3]; float Rv[3];
#define SC_LDSTEP(t_, s_) do { Rkk[s_] = *(const LAS f32x4*)(st + (t_) * SC_REC); Rw[s_] = *(const LAS f32x4*)(st + (t_) * SC_REC + 256); Rak[s_] = *(const LAS f32x4*)(st + (t_) * SC_REC + 512); \
                Rk[s_] = *(const LAS f32x4*)(st + (t_) * SC_REC + 768); Rr[s_] = *(const LAS f32x4*)(st + (t_) * SC_REC + 1024); Rv[s_] = *(const LAS float*)(sv + (t_) * SC_REC); } while (0)
            SC_LDSTEP(0, 0); SC_LDSTEP(1, 1);
#pragma unroll
            for (int tau = 0; tau < SC_TC; ++tau) {
                const int sx = tau % 3;
                if (tau + 2 < SC_TC) { const int sn = (tau + 2) % 3; SC_LDSTEP(tau + 2, sn); }
                const f32x2 kk01 = {Rkk[sx].x, Rkk[sx].y}, kk23 = {Rkk[sx].z, Rkk[sx].w};
                f32x2 pd = S01 * kk01; pd = __builtin_elementwise_fma(S23, kk23, pd);
                const float sa = row16_sum(pd.x + pd.y);
                const f32x2 vv = {Rv[sx], Rv[sx]}, nsa = {-sa, -sa};
                const f32x2 w01 = {Rw[sx].x, Rw[sx].y}, w23 = {Rw[sx].z, Rw[sx].w}, k01 = {Rk[sx].x, Rk[sx].y}, k23 = {Rk[sx].z, Rk[sx].w};
                const f32x2 a01 = {Rak[sx].x, Rak[sx].y}, a23 = {Rak[sx].z, Rak[sx].w}, r01 = {Rr[sx].x, Rr[sx].y}, r23 = {Rr[sx].z, Rr[sx].w};
                f32x2 t01 = __builtin_elementwise_fma(S01, w01, k01 * vv), t23 = __builtin_elementwise_fma(S23, w23, k23 * vv);
                S01 = __builtin_elementwise_fma(a01, nsa, t01); S23 = __builtin_elementwise_fma(a23, nsa, t23);
                f32x2 yr = S01 * r01; yr = __builtin_elementwise_fma(S23, r23, yr);
                yb[tau * 256] = yr.x + yr.y;
            }
#undef SC_LDSTEP
            __syncthreads();
        }
        __builtin_amdgcn_s_setprio(0);
    }
    __syncthreads();
}

__device__ __forceinline__ void combine_phase(const Frame& F, const Args& a) {
    unsigned char* ws = a.ws;
    const bf16* att = (const bf16*)(ws + WS_ATT); const bf16* rr = (const bf16*)(ws + WS_R); const bf16* vv = (const bf16*)(ws + WS_V);
    const bf16* kd = (const bf16*)(ws + WS_KDIR); const bf16* gg = (const bf16*)(ws + WS_G); const float* y = (const float*)(ws + WS_Y);
    bf16* mix = (bf16*)(ws + WS_MIX);
    const float* anw = a.in[4]; const float* r_k = a.in[14]; const float* ln_w = a.in[15]; const float* ln_b = a.in[16];
    const int lane = F.lane, c0 = 8 * lane;
    float nw[8], rk[8], lw[8], lb[8];
#pragma unroll
    for (int i = 0; i < 8; ++i) { nw[i] = anw[c0 + i]; rk[i] = r_k[c0 + i]; lw[i] = ln_w[c0 + i]; lb[i] = ln_b[c0 + i]; }
    const int gw = F.vcu * 8 + F.wave, NGW = F.G * 8;
#pragma unroll 2
    for (int m = gw; m < M; m += NGW) {
        const size_t o = (size_t)m * CW + c0;
        float f[8];
        unpack8(*(const u32x4*)(att + o), f);
        float ss = 0.f;
#pragma unroll
        for (int i = 0; i < 8; ++i) ss += f[i] * f[i];
        const float rs = rsqrtf(wave_sum(ss) * (1.f / CW) + RMS_EPS);
#pragma unroll
        for (int i = 0; i < 8; ++i) f[i] = f[i] * rs * nw[i];
        *(u32x4*)(mix + (size_t)m * D + c0) = pack8(f);
        const f32x4 y0a = *(const f32x4*)(y + o), y0b = *(const f32x4*)(y + o + 4), y1a = *(const f32x4*)(y + (size_t)M * CW + o), y1b = *(const f32x4*)(y + (size_t)M * CW + o + 4);
        float yv[8] = {y0a.x + y1a.x, y0a.y + y1a.y, y0a.z + y1a.z, y0a.w + y1a.w, y0b.x + y1b.x, y0b.y + y1b.y, y0b.z + y1b.z, y0b.w + y1b.w};
        float s1 = 0.f;
#pragma unroll
        for (int i = 0; i < 8; ++i) s1 += yv[i];
        s1 += __shfl_xor(s1, 1); s1 += __shfl_xor(s1, 2); s1 += __shfl_xor(s1, 4);
        const float mean = s1 * (1.f / 64.f);
        float s2 = 0.f;
#pragma unroll
        for (int i = 0; i < 8; ++i) { yv[i] -= mean; s2 += yv[i] * yv[i]; }
        s2 += __shfl_xor(s2, 1); s2 += __shfl_xor(s2, 2); s2 += __shfl_xor(s2, 4);
        const float rstd = rsqrtf(s2 * (1.f / 64.f) + GN_EPS);
        float rf[8], k0[8], k1[8], vf[8], gf[8];
        unpack8(*(const u32x4*)(rr + o), rf); unpack8(*(const u32x4*)(kd + o), k0); unpack8(*(const u32x4*)(kd + (size_t)M * CW + o), k1);
        unpack8(*(const u32x4*)(vv + o), vf); unpack8(*(const u32x4*)(gg + o), gf);
        float cf = 0.f;
#pragma unroll
        for (int i = 0; i < 8; ++i) cf += rf[i] * (k0[i] + k1[i]) * rk[i];
        cf += __shfl_xor(cf, 1); cf += __shfl_xor(cf, 2); cf += __shfl_xor(cf, 4);
#pragma unroll
        for (int i = 0; i < 8; ++i) f[i] = (yv[i] * rstd * lw[i] + lb[i] + cf * vf[i]) * gf[i];
        *(u32x4*)(mix + (size_t)m * D + CW + c0) = pack8(f);
    }
}

constexpr int RT_W = 0, RT_HIST = 131072, RT_LOG = 131072 + 256;
__device__ __forceinline__ void router_phase(const Frame& F, const Args& a) {
    unsigned char* ws = a.ws;
    const float* hbuf = (const float*)(ws + WS_H); bf16* hn2 = (bf16*)(ws + WS_HN2);
    int* eidx = (int*)(ws + WS_EIDX); float* gate = (float*)(ws + WS_GATE); int* rank = (int*)(ws + WS_RANK);
    unsigned* ctl = (unsigned*)(ws + WS_CTL);
    const float* n2w = a.in[18]; const float* rw = a.in[19]; const float* rb = a.in[20];
    LAS float* wT = (LAS float*)(F.lds + RT_W); LAS int* hist = (LAS int*)(F.lds + RT_HIST); LAS float* lg = (LAS float*)(F.lds + RT_LOG) + F.wave * 64; LAS int* eL = (LAS int*)(F.lds + RT_LOG + 2048);
    { f32x4 tmp[16];
#pragma unroll
      for (int j = 0; j < 16; ++j) tmp[j] = *((const f32x4*)rw + F.tid + 512 * j);
#pragma unroll
      for (int j = 0; j < 16; ++j) { const int q = F.tid + 512 * j, d = q >> 3, e0 = 4 * (q & 7);
          wT[(e0 + 0) * 1024 + d] = tmp[j].x; wT[(e0 + 1) * 1024 + d] = tmp[j].y; wT[(e0 + 2) * 1024 + d] = tmp[j].z; wT[(e0 + 3) * 1024 + d] = tmp[j].w; } }
    if (F.tid < 32) hist[F.tid] = 0;
    __syncthreads();
    const int lane = F.lane;
    f32x4 wn[4];
#pragma unroll
    for (int j = 0; j < 4; ++j) wn[j] = *((const f32x4*)n2w + lane + 64 * j);
    const int blk = F.vcu;
    for (int pr = 0; pr < 8; ++pr) {
        const int m0 = blk * 128 + F.wave * 16 + pr * 2;
        f32x4 xv[2][4];
#pragma unroll
        for (int tk = 0; tk < 2; ++tk) {
            const f32x4* hr = (const f32x4*)(hbuf + (size_t)(m0 + tk) * D) + lane;
            float s = 0.f;
#pragma unroll
            for (int j = 0; j < 4; ++j) { xv[tk][j] = hr[64 * j]; s += (xv[tk][j].x * xv[tk][j].x + xv[tk][j].y * xv[tk][j].y) + (xv[tk][j].z * xv[tk][j].z + xv[tk][j].w * xv[tk][j].w); }
            const float rs = rsqrtf(wave_sum(s) * (1.f / D) + RMS_EPS);
            u32x2* o8 = (u32x2*)(hn2 + (size_t)(m0 + tk) * D) + lane;
#pragma unroll
            for (int j = 0; j < 4; ++j) { xv[tk][j] = xv[tk][j] * rs * wn[j]; u32x2 o; o.x = cvt_pk_bf16(xv[tk][j].x, xv[tk][j].y); o.y = cvt_pk_bf16(xv[tk][j].z, xv[tk][j].w); o8[64 * j] = o; }
        }
        float kA0 = 0.f, kB0 = 0.f, kA1 = 0.f, kB1 = 0.f;
#pragma unroll 4
        for (int e = 0; e < 32; ++e) {
            float p0 = 0.f, p1 = 0.f;
#pragma unroll
            for (int j = 0; j < 4; ++j) { const f32x4 w4 = *(const LAS f32x4*)(wT + e * 1024 + 256 * j + 4 * lane);
                p0 += (w4.x * xv[0][j].x + w4.y * xv[0][j].y) + (w4.z * xv[0][j].z + w4.w * xv[0][j].w);
                p1 += (w4.x * xv[1][j].x + w4.y * xv[1][j].y) + (w4.z * xv[1][j].z + w4.w * xv[1][j].w); }
            p0 = row16_sum(p0); p1 = row16_sum(p1);
            const bool me = (lane & 15) == (e & 15);
            if (e < 16) { kA0 = me ? p0 : kA0; kA1 = me ? p1 : kA1; } else { kB0 = me ? p0 : kB0; kB1 = me ? p1 : kB1; }
        }
        kA0 += __shfl_xor(kA0, 16); kA0 += __shfl_xor(kA0, 32); kB0 += __shfl_xor(kB0, 16); kB0 += __shfl_xor(kB0, 32);
        kA1 += __shfl_xor(kA1, 16); kA1 += __shfl_xor(kA1, 32); kB1 += __shfl_xor(kB1, 16); kB1 += __shfl_xor(kB1, 32);
        if (lane < 32) { const int tk = lane >> 4, el = lane & 15; lg[tk * 32 + el] = (tk ? kA1 : kA0) + rb[el]; lg[tk * 32 + 16 + el] = (tk ? kB1 : kB0) + rb[16 + el]; }
        asm volatile("s_waitcnt lgkmcnt(0)" ::: "memory");
        if (lane < 2) {
            const LAS float* L = lg + lane * 32; const int m = m0 + lane;
            float v[32];
#pragma unroll
            for (int e = 0; e < 32; ++e) v[e] = L[e];
            float tv[4]; int ti[4];
#pragma unroll
            for (int kx = 0; kx < 4; ++kx) { float best = -3.0e38f; int bi = 0;
#pragma unroll
                for (int e = 0; e < 32; ++e) { if (v[e] > best) { best = v[e]; bi = e; } }
                tv[kx] = best; ti[kx] = bi;
#pragma unroll
                for (int e = 0; e < 32; ++e) { if (e == bi) v[e] = -3.0e38f; } }
            const float e0 = 1.0f, e1 = __expf(tv[1] - tv[0]), e2 = __expf(tv[2] - tv[0]), e3 = __expf(tv[3] - tv[0]);
            const float is = 1.0f / (e0 + e1 + e2 + e3);
            const float gs[4] = {e0 * is, e1 * is, e2 * is, e3 * is};
#pragma unroll
            for (int kx = 0; kx < 4; ++kx) { eidx[m * 4 + kx] = ti[kx]; gate[m * 4 + kx] = gs[kx]; eL[(m - blk * 128) * 4 + kx] = ti[kx]; }
        }
        asm volatile("s_waitcnt lgkmcnt(0)" ::: "memory");
    }
    __syncthreads();
    { const int t = F.tid, e = eL[t]; int rk = 0;
      for (int u = 0; u < t; ++u) rk += (eL[u] == e) ? 1 : 0;
      rank[(blk * 128) * 4 + t] = rk;
      __hip_atomic_fetch_add(&hist[e], 1, __ATOMIC_RELAXED, __HIP_MEMORY_SCOPE_WORKGROUP); }
    __syncthreads();
    if (F.tid < 32) ctl[CW_CNT + blk * 32 + F.tid] = (unsigned)hist[F.tid];
}

__device__ __forceinline__ void dispatch_phase(const Frame& F, const Args& a) {
    unsigned char* ws = a.ws;
    unsigned* ctl = (unsigned*)(ws + WS_CTL);
    const int* eidx = (const int*)(ws + WS_EIDX); const int* rank = (const int*)(ws + WS_RANK); int* dest = (int*)(ws + WS_DEST);
    LAS int* part = (LAS int*)F.lds;
    LAS int* tot = part + 1024;
    const int blk = F.vcu, G = F.G;
    { const int e = F.tid & 31, pt = F.tid >> 5; int s = 0, sb = 0;
      if (G == 256) { int cv[16];
#pragma unroll
          for (int q = 0; q < 16; ++q) cv[q] = (int)ld_u32_agent(ctl + CW_CNT + (pt + 16 * q) * 32 + e);
#pragma unroll
          for (int q = 0; q < 16; ++q) { s += cv[q]; if (pt + 16 * q < blk) sb += cv[q]; } }
      else for (int bb = pt; bb < G; bb += 16) { const int cval = (int)ld_u32_agent(ctl + CW_CNT + bb * 32 + e); s += cval; if (bb < blk) sb += cval; }
      part[pt * 32 + e] = s; part[512 + pt * 32 + e] = sb; }
    __syncthreads();
    if (F.tid < 32) { int s = 0, sb = 0;
        for (int pt = 0; pt < 16; ++pt) { s += part[pt * 32 + F.tid]; sb += part[512 + pt * 32 + F.tid]; }
        tot[F.tid] = s; tot[32 + F.tid] = sb; tot[96 + F.tid] = (s + 255) & ~255; }
    __syncthreads();
    if (F.tid == 0) { int ps = 0; for (int e = 0; e < 32; ++e) { tot[64 + e] = ps; ps += tot[96 + e]; }
        tot[128] = ps >> 8; }
    __syncthreads();
    if (blk == 0) {
        if (F.tid == 0) ctl[CW_NT] = (unsigned)tot[128];
        for (int e = F.tid >> 4; e < 32; e += 32) { const int t0 = tot[64 + e] >> 8, nt = tot[96 + e] >> 8; for (int i = F.tid & 15; i < nt; i += 16) ctl[CW_TEXP + t0 + i] = (unsigned)e; }
    }
    const int lane = F.lane;
    const int mw = blk * 128 + F.wave * 16;
    int* rowtok = (int*)(ws + WS_ROWTOK);
    { const int e = eidx[mw * 4 + lane]; const int dl = tot[64 + e] + tot[32 + e] + rank[mw * 4 + lane]; dest[mw * 4 + lane] = dl; rowtok[dl] = mw + (lane >> 2); }
    { const int e = blk & 31, pt = blk >> 5, np = G >> 5; const int r0 = tot[64 + e] + tot[e], r1 = tot[64 + e] + tot[96 + e];
      if (np > 0) for (int r = r0 + pt * 512 + F.tid; r < r1; r += np * 512) rowtok[r] = 0; }
}

__device__ __forceinline__ void final_phase(const Frame& F, const Args& a) {
    unsigned char* ws = a.ws;
    const float* hbuf = (const float*)(ws + WS_H); const bf16* ybuf = (const bf16*)(ws + WS_YBUF);
    const int* dest = (const int*)(ws + WS_DEST); const float* gate = (const float*)(ws + WS_GATE);
    const float* fw = a.in[25]; float* out = a.out;
    const int lane = F.lane;
    f32x4 wn[4];
#pragma unroll
    for (int j = 0; j < 4; ++j) wn[j] = *((const f32x4*)fw + lane + 64 * j);
    const int gw = F.vcu * 8 + F.wave, NGW = F.G * 8;
    const int per = M / NGW;
    const int mw = gw * per;
    int dl = 0; float gl = 0.f;
    if (lane < 4 * per && per <= 16) { dl = dest[mw * 4 + lane]; gl = gate[mw * 4 + lane]; }
#pragma unroll 2
    for (int i = 0; i < per; ++i) {
        const int m = mw + i;
        const f32x4* hr = (const f32x4*)(hbuf + (size_t)m * D) + lane;
        f32x4 v[4];
#pragma unroll
        for (int j = 0; j < 4; ++j) v[j] = hr[64 * j];
#pragma unroll
        for (int kx = 0; kx < 4; ++kx) {
            const int d = per <= 16 ? __shfl(dl, 4 * i + kx) : dest[m * 4 + kx]; const float gt = per <= 16 ? __shfl(gl, 4 * i + kx) : gate[m * 4 + kx];
            const u32x2* yr = (const u32x2*)(ybuf + (size_t)d * D) + lane;
#pragma unroll
            for (int j = 0; j < 4; ++j) { const u32x2 w = yr[64 * j]; v[j].x += gt * bflo(w.x); v[j].y += gt * bfhi(w.x); v[j].z += gt * bflo(w.y); v[j].w += gt * bfhi(w.y); }
        }
        float s = 0.f;
#pragma unroll
        for (int j = 0; j < 4; ++j) s += (v[j].x * v[j].x + v[j].y * v[j].y) + (v[j].z * v[j].z + v[j].w * v[j].w);
        const float rs = rsqrtf(wave_sum(s) * (1.f / D) + RMS_EPS);
        f32x4* orow = (f32x4*)(out + (size_t)m * D) + lane;
#pragma unroll
        for (int j = 0; j < 4; ++j) orow[64 * j] = v[j] * rs * wn[j];
    }
}

__global__ void __launch_bounds__(512, 2) fwd_megakernel(Args args) {
    extern __shared__ __attribute__((aligned(16))) unsigned char lds_raw[];
    Frame F;
    F.lds = (LAS unsigned char*)lds_raw;
    F.tid = threadIdx.x; F.lane = F.tid & 63; F.wave = __builtin_amdgcn_readfirstlane(F.tid >> 6);
    F.G = gridDim.x; { const int bx = blockIdx.x; F.vcu = (F.G % 8 == 0) ? (bx % 8) * (F.G / 8) + bx / 8 : bx; }
    unsigned char* ws = args.ws;
    const int lo = args.ph_lo, hi = args.ph_hi;
#define IN(k) (lo <= (k) && (k) < hi)
#if MK_SPLIT
#define SEAM(k) do { } while (0)
#else
    cg::grid_group grid = cg::this_grid();
    { volatile LAS unsigned* st = (volatile LAS unsigned*)(F.lds + LDS_MISC); if (F.tid < 2) st[F.tid] = 0u; __syncthreads(); }
    const XcdBarrier xbar = xcd_barrier_post((unsigned*)(ws + WS_CTL) + CW_BAR, (volatile LAS unsigned*)(F.lds + LDS_MISC));
    if (lo < 0) grid.sync();
#define SEAM(k) do { if (IN(k) && IN((k) + 1)) xcd_barrier(xbar); } while (0)
#endif
#define REP2(k) if constexpr (((MK_REPEAT >> (k)) & 1) != 0)
#define PH1 { pg8::Gemm g{(const bf16*)(ws + WS_HN), (const bf16*)(ws + WS_WINT), 1024, nullptr, 0, nullptr}; \
        pg8::StaticOrder S; S.init(M / 256, NPROJ_PAD / 256, F.G, (int)blockIdx.x); \
        pg8::EpiProj E{(bf16*)(ws + WS_Q), (bf16*)(ws + WS_K), (bf16*)(ws + WS_VT), (bf16*)(ws + WS_P)}; \
        pg8::gemm_phase<pg8::EpiProj, true, true>(F.lds, g, S, E); }
#define PH5 { pg8::Gemm g{(const bf16*)(ws + WS_MIX), (const bf16*)(ws + WS_WOT), 1024, nullptr, 0, nullptr}; \
        pg8::StaticOrder S; S.init(M / 256, D / 256, F.G, (int)blockIdx.x); \
        pg8::EpiWo E{args.in[0], (float*)(ws + WS_H)}; \
        pg8::gemm_phase<pg8::EpiWo, true, true>(F.lds, g, S, E); }
#define PH8 { const unsigned* ctl = (const unsigned*)(ws + WS_CTL); const int ntile = (int)ld_u32_agent(ctl + CW_NT); \
        pg8::Gemm g{(const bf16*)(ws + WS_HN2), (const bf16*)(ws + WS_WUPT), 1024, ctl + CW_TEXP, (size_t)2048 * 1024 * 2, (const int*)(ws + WS_ROWTOK)}; \
        pg8::StaticOrder S; S.init(ntile, 8, F.G, (int)blockIdx.x); \
        pg8::EpiUp E{args.in[22], (bf16*)(ws + WS_ACT)}; \
        pg8::gemm_phase<pg8::EpiUp, true, true, true>(F.lds, g, S, E); }
#define PH9 { const unsigned* ctl = (const unsigned*)(ws + WS_CTL); const int ntile = (int)ld_u32_agent(ctl + CW_NT); \
        pg8::Gemm g{(const bf16*)(ws + WS_ACT), (const bf16*)(ws + WS_WDNT), 1024, ctl + CW_TEXP, (size_t)1024 * 1024 * 2, nullptr}; \
        pg8::StaticOrder S; S.init(ntile, 4, F.G, (int)blockIdx.x); \
        pg8::EpiDown E{args.in[24], (bf16*)(ws + WS_YBUF)}; \
        pg8::gemm_phase<pg8::EpiDown, true, true>(F.lds, g, S, E); }
    if (IN(0)) { p0_prologue(F, args); REP2(0) p0_prologue(F, args); }
    SEAM(0);
    if (IN(1)) { PH1 REP2(1) PH1 }
    SEAM(1);
    if (IN(2)) { prep_phase<true>(F, args); REP2(2) prep_phase<true>(F, args); attn_phase(F, args); REP2(11) attn_phase(F, args); }
    SEAM(2);
    if (IN(3)) { scan_phase(F, args); REP2(3) scan_phase(F, args); }
    SEAM(3);
    if (IN(4)) { combine_phase(F, args); REP2(4) combine_phase(F, args); }
    SEAM(4);
    if (IN(5)) { PH5 REP2(5) PH5 }
    SEAM(5);
    if (IN(6)) { router_phase(F, args); REP2(6) { __syncthreads(); router_phase(F, args); } }
    SEAM(6);
    if (IN(7)) { dispatch_phase(F, args); REP2(7) { __syncthreads(); dispatch_phase(F, args); } }
    SEAM(7);
    if (IN(8)) { PH8 REP2(8) PH8 }
    SEAM(8);
    if (IN(9)) { PH9 REP2(9) PH9 }
    SEAM(9);
    if (IN(10)) { final_phase(F, args); REP2(10) final_phase(F, args); }
#undef IN
#undef SEAM
}

extern "C" void kernel_launch(void* const* d_in, const int* in_sizes, int n_in, void* d_out, int out_size, void* d_ws, size_t ws_size, hipStream_t stream) {
    static int grid = 0;
    if (grid == 0) {
        if (n_in != 26 || in_sizes[0] != M * D || out_size != M * D || ws_size < WS_END) { fprintf(stderr, "kernel_launch: unexpected problem (n_in %d, in0 %d, out %d, ws %zu)\n", n_in, n_in > 0 ? in_sizes[0] : -1, out_size, ws_size); grid = -1; return; }
        int dev = 0, cus = 0, per_cu = 0;
        if (hipGetDevice(&dev) != hipSuccess || hipDeviceGetAttribute(&cus, hipDeviceAttributeMultiprocessorCount, dev) != hipSuccess) { grid = -1; return; }
        if (hipFuncSetAttribute((const void*)fwd_megakernel, hipFuncAttributeMaxDynamicSharedMemorySize, LDS_BYTES) != hipSuccess) { fprintf(stderr, "kernel_launch: hipFuncSetAttribute failed\n"); grid = -1; return; }
        if (hipOccupancyMaxActiveBlocksPerMultiprocessor(&per_cu, (const void*)fwd_megakernel, 512, LDS_BYTES) != hipSuccess || per_cu < 1) { fprintf(stderr, "kernel_launch: occupancy query says %d\n", per_cu); per_cu = 1; }
        (void)hipGetLastError();
        grid = cus * 1;
        if (grid != 256) fprintf(stderr, "kernel_launch: note: %d CUs\n", cus);
    }
    if (grid < 0) return;
    if (hipMemsetAsync((char*)d_ws + WS_CTL + (size_t)CW_BAR * 4, 0, XCD_BAR_WORDS * 4, stream) != hipSuccess) { fprintf(stderr, "kernel_launch: memset failed\n"); return; }
    Args a{};
    for (int i = 0; i < 26; ++i) a.in[i] = (const float*)d_in[i];
    a.out = (float*)d_out; a.ws = (unsigned char*)d_ws;
#if MK_SPLIT
    for (int ph = 0; ph < NPHASE; ++ph) { a.ph_lo = ph; a.ph_hi = ph + 1; hipLaunchKernelGGL(fwd_megakernel, dim3(grid), dim3(512), LDS_BYTES, stream, a); }
#else
    a.ph_lo = 0; a.ph_hi = NPHASE;
    void* kargs[] = {&a};
    hipError_t e = hipLaunchCooperativeKernel((const void*)fwd_megakernel, dim3(grid), dim3(512), kargs, LDS_BYTES, stream);
    if (e != hipSuccess) fprintf(stderr, "kernel_launch: cooperative launch failed: %s (grid %d)\n", hipGetErrorString(e), grid);
#endif
}
```

```cpp
#include <hip/hip_runtime.h>
#include <hip/hip_cooperative_groups.h>
#include <cstdio>
#include <cstdint>
namespace cg = cooperative_groups;

#ifndef MK_SPLIT
#define MK_SPLIT 0
#endif

#ifndef MK_REPEAT
#define MK_REPEAT 0
#endif
#define LAS __attribute__((address_space(3)))
typedef unsigned short bf16;
typedef float f32x4 __attribute__((ext_vector_type(4)));
typedef float f32x2 __attribute__((ext_vector_type(2)));
typedef unsigned u32x4 __attribute__((ext_vector_type(4)));
typedef unsigned u32x2 __attribute__((ext_vector_type(2)));
typedef short bf16x8 __attribute__((ext_vector_type(8)));

constexpr int BATCH = 4, T = 8192, D = 1024, M = BATCH * T;
constexpr int NH = 8, HD = 64, CW = 512;
constexpr int SHIFT_W = 1920, NPROJ = 3456, NPROJ_PAD = 3584, PW = 2048;
constexpr int NE = 32, TOPK = 4, DE = 1024;
constexpr int GRIDW = 64, GROWS = 128;
constexpr int P_TILES_MAX = 544, P_ROWS = P_TILES_MAX * 256;
constexpr float RMS_EPS = 1e-5f, GN_EPS = 64e-5f;
constexpr int NPHASE = 11;

constexpr size_t MiB = 1u << 20;
constexpr size_t WS_CTL = 0;
constexpr size_t WS_W2T = 1 * MiB, WS_A2T = WS_W2T + 131072, WS_G2T = WS_A2T + 131072;
constexpr size_t WS_WINT = 2 * MiB, WS_WOT = 9 * MiB, WS_WUPT = 12 * MiB, WS_WDNT = 140 * MiB;
constexpr size_t WS_EIDX = 204 * MiB, WS_GATE = WS_EIDX + 524288, WS_RANK = WS_GATE + 524288, WS_DEST = WS_RANK + 524288, WS_ROWTOK = WS_DEST + 524288;
constexpr size_t WS_R = 208 * MiB, WS_V = 240 * MiB, WS_KK = 272 * MiB, WS_DECAY = 304 * MiB, WS_KDIR = 368 * MiB, WS_AKK = 432 * MiB,
                 WS_G = 496 * MiB, WS_ATT = 528 * MiB;
constexpr size_t WS_Q = 560 * MiB, WS_K = 592 * MiB, WS_VT = 624 * MiB, WS_P = 656 * MiB, WS_HN = 784 * MiB, WS_Y = 848 * MiB;
constexpr size_t WS_MIX = 560 * MiB, WS_H = 752 * MiB, WS_HN2 = 880 * MiB, WS_XBUF = 208 * MiB, WS_ACT = 480 * MiB, WS_YBUF = 208 * MiB;
constexpr size_t WS_END = 976 * MiB;
constexpr int CW_NT = 0, CW_TEXP = 64, CW_CNT = 1024, CW_BAR = 16384;

constexpr int LDS_BYTES = 159744, LDS_MISC = LDS_BYTES - 256;

typedef __bf16 bf16x2_t __attribute__((ext_vector_type(2)));
__device__ __forceinline__ unsigned cvt_pk_bf16(float lo, float hi) { const f32x2 v = {lo, hi}; return __builtin_bit_cast(unsigned, __builtin_convertvector(v, bf16x2_t)); }
__device__ __forceinline__ float bflo(unsigned u) { return __uint_as_float(u << 16); }
__device__ __forceinline__ float bfhi(unsigned u) { return __uint_as_float(u & 0xffff0000u); }
__device__ __forceinline__ float bf1(bf16 v) { return __uint_as_float(((unsigned)v) << 16); }
__device__ __forceinline__ void unpack8(const u32x4 u, float* f) { f[0] = bflo(u.x); f[1] = bfhi(u.x); f[2] = bflo(u.y); f[3] = bfhi(u.y); f[4] = bflo(u.z); f[5] = bfhi(u.z); f[6] = bflo(u.w); f[7] = bfhi(u.w); }
__device__ __forceinline__ u32x4 pack8(const float* f) { u32x4 o; o.x = cvt_pk_bf16(f[0], f[1]); o.y = cvt_pk_bf16(f[2], f[3]); o.z = cvt_pk_bf16(f[4], f[5]); o.w = cvt_pk_bf16(f[6], f[7]); return o; }
__device__ __forceinline__ float wave_sum(float v) {
#pragma unroll
    for (int o = 1; o < 64; o <<= 1) v += __shfl_xor(v, o);
    return v;
}
__device__ __forceinline__ float sigmoidf_(float x) { return __builtin_amdgcn_rcpf(1.0f + __expf(-x)); }
__device__ __forceinline__ unsigned ld_u32_agent(const unsigned* p) { return __hip_atomic_load(p, __ATOMIC_RELAXED, __HIP_MEMORY_SCOPE_AGENT); }

namespace pg8 {
constexpr int BM = 256, BK = 64, HALF = 128, HTB = HALF * BK * 2, STAGE_BYTES = 8 * HTB, NXCD = 8, WGM = 8;
__host__ __device__ __forceinline__ int lds_byte(int r, int c) { const int st = (r >> 4) * 2 + (c >> 5), rr = r & 15, cc = c & 31, ob = rr * 64 + cc * 2; return st * 1024 + (ob ^ (((ob >> 9) & 1) << 5)); }
__host__ __device__ __forceinline__ void stage_rc(int b, int& R, int& C) { const int st = b / 1024, sb = b % 1024, swz = sb ^ (((sb >> 9) & 1) << 5); R = (st >> 1) * 16 + swz / 64; C = (st & 1) * 32 + (swz % 64) / 2; }
__host__ __device__ __forceinline__ int perm32(int rho) { const int n = rho >> 4, i = rho & 15; return 8 * (i >> 2) + 4 * n + (i & 3); }

struct Unit { int pm, pn, e; };
struct Gemm { const bf16* A; const bf16* Bt; int K; const unsigned* texp; size_t bstride; const int* rowtok; };

struct StaticOrder {
    int nM, nN, nwg, G, c;
    __device__ void init(int nM_, int nN_, int G_, int c_) { nM = nM_; nN = nN_; nwg = nM * nN; G = G_; c = c_; }
    __device__ bool next(int i, Unit& u) const {
        const long L = (long)i * G + c; if (L >= nwg) return false;
        int wgid = (int)L; { const int q = nwg / NXCD, r = nwg % NXCD, xcd = wgid % NXCD, off = wgid / NXCD; wgid = (xcd < r ? xcd * (q + 1) : r * (q + 1) + (xcd - r) * q) + off; }
        const int nig = WGM * nN, gid = wgid / nig, fm = gid * WGM, gsz = (nM - fm) < WGM ? (nM - fm) : WGM;
        u.pm = fm + ((wgid % nig) % gsz); u.pn = (wgid % nig) / gsz; u.e = 0; return true;
    }
};

template <class Epi, bool ALIGN_EPI, bool SP2, bool GATHER = false>
__device__ __forceinline__ void gemm_phase(LAS unsigned char* lds, const Gemm g, const StaticOrder& S, const Epi& E) {
    const int tid = threadIdx.x, wid = __builtin_amdgcn_readfirstlane(tid >> 6), lane = tid & 63, wr = wid >> 2, wc = wid & 3, fr = lane & 15, fq = lane >> 4;
    const int K = g.K, nt = K / BK;
    unsigned voffA[2], voffB[2];
#pragma unroll
    for (int i = 0; i < 2; ++i) { int R, C; stage_rc(tid * 16 + i * 8192, R, C); const int Rb = Epi::PERM ? ((R & ~31) + perm32(R & 31)) : R;
        voffA[i] = (unsigned)(R * K + C) * 2u; voffB[i] = (unsigned)(Rb * K + C) * 2u; }
    unsigned vC[2][2];
#define PG8_GROWS(u, dst) do { _Pragma("unroll") for (int h_ = 0; h_ < 2; ++h_) _Pragma("unroll") for (int i_ = 0; i_ < 2; ++i_) { int R_, C_; stage_rc(tid * 16 + i_ * 8192, R_, C_); \
        dst[h_][i_] = (unsigned)g.rowtok[(u).pm * BM + h_ * HALF + R_] * (unsigned)(K * 2) + (unsigned)(C_ * 2); } } while (0)
    const size_t kstep = (size_t)(BK * 2);
    const size_t hstep = (size_t)HALF * K * 2;
    const size_t tstep = 2 * hstep;
    const unsigned ldsw = (unsigned)wid * 1024u;
    const int aoff = lds_byte(wr * 64 + fr, fq * 8), boff = lds_byte(wc * 32 + fr, fq * 8);
#define PG8_SA(b, h) (((b) * 2 + (h)) * HTB)
#define PG8_SB(b, h) ((4 + (b) * 2 + (h)) * HTB)
#define PG8_STAGE(bufoff, gbase, voff) do { _Pragma("unroll") for (int _i = 0; _i < 2; ++_i) \
        __builtin_amdgcn_global_load_lds((const unsigned*)((const char*)(gbase) + (voff)[_i]), (LAS unsigned*)(lds + (bufoff) + ldsw + _i * 8192), 16, 0, 0); } while (0)
#define PG8_STAGE_A(bufoff, p, h, nx) do { if constexpr (GATHER) { PG8_STAGE(bufoff, p, vC[h]); } else PG8_STAGE(bufoff, (p) + (h) * hstep, voffA); } while (0)
#define PG8_LDA(dst, b, h) do { _Pragma("unroll") for (int m = 0; m < 4; ++m) _Pragma("unroll") for (int k = 0; k < 2; ++k) dst[m][k] = *(const LAS bf16x8*)(lds + PG8_SA(b, h) + aoff + m * 2048 + k * 1024); } while (0)
#define PG8_LDB(dst, b, h) do { _Pragma("unroll") for (int n = 0; n < 2; ++n) _Pragma("unroll") for (int k = 0; k < 2; ++k) dst[n][k] = *(const LAS bf16x8*)(lds + PG8_SB(b, h) + boff + n * 2048 + k * 1024); } while (0)
#define PG8_MMA(ai, bj, At, Bt) do { __builtin_amdgcn_s_setprio(1); _Pragma("unroll") for (int m = 0; m < 4; ++m) _Pragma("unroll") for (int n = 0; n < 2; ++n) _Pragma("unroll") for (int k = 0; k < 2; ++k) \
        acc[ai][bj][m][n] = __builtin_amdgcn_mfma_f32_16x16x32_bf16(Bt[n][k], At[m][k], acc[ai][bj][m][n], 0, 0, 0); __builtin_amdgcn_s_setprio(0); } while (0)
#define PG8_WAIT_V(n) asm volatile("s_waitcnt vmcnt(" #n ")" ::: "memory")
#define PG8_WAIT_L(n) asm volatile("s_waitcnt lgkmcnt(" #n ")" ::: "memory")
#define PG8_BAR __builtin_amdgcn_s_barrier()
#define PG8_SCHED __builtin_amdgcn_sched_barrier(0)
#define PG8_UPTR(u, pa, pb) do { unsigned _e = g.texp ? ld_u32_agent(g.texp + (u).pm) : 0u; _e = (unsigned)__builtin_amdgcn_readfirstlane((int)_e); (u).e = (int)_e; \
        pa = GATHER ? (const char*)g.A : (const char*)g.A + (size_t)(u).pm * tstep; pb = (const char*)g.Bt + (size_t)_e * g.bstride + (size_t)(u).pn * tstep; } while (0)
    Unit cur, nxt; int ui = 0;
    if (!S.next(0, cur)) return;
    f32x4 acc[2][2][4][2];
#pragma unroll
    for (int a = 0; a < 2; ++a)
#pragma unroll
        for (int b = 0; b < 2; ++b)
#pragma unroll
            for (int m = 0; m < 4; ++m)
#pragma unroll
                for (int n = 0; n < 2; ++n) acc[a][b][m][n] = (f32x4){0.f, 0.f, 0.f, 0.f};
    bf16x8 At[4][2], B0[2][2], B1[2][2];
    const char* cA; const char* cB;
    PG8_UPTR(cur, cA, cB);
    if constexpr (GATHER) { PG8_GROWS(cur, vC); }
    if constexpr (SP2) {
        PG8_STAGE(PG8_SB(0, 0), cB, voffB); PG8_STAGE(PG8_SB(0, 1), cB + hstep, voffB); PG8_STAGE_A(PG8_SA(0, 0), cA, 0, false); PG8_STAGE_A(PG8_SA(0, 1), cA, 1, false);
        if (wr == 1) PG8_BAR;
        PG8_WAIT_V(2); PG8_BAR;
        PG8_STAGE(PG8_SB(1, 0), cB + kstep, voffB); PG8_STAGE_A(PG8_SA(1, 0), cA + kstep, 0, false); PG8_STAGE(PG8_SB(1, 1), cB + hstep + kstep, voffB);
        PG8_WAIT_V(6); PG8_BAR;
    } else {
        PG8_STAGE(PG8_SB(0, 0), cB, voffB); PG8_STAGE_A(PG8_SA(0, 0), cA, 0, false); PG8_STAGE(PG8_SB(0, 1), cB + hstep, voffB); PG8_STAGE_A(PG8_SA(0, 1), cA, 1, false);
        if (wr == 1) PG8_BAR;
        PG8_WAIT_V(4); PG8_BAR;
        PG8_STAGE(PG8_SB(1, 0), cB + kstep, voffB); PG8_STAGE_A(PG8_SA(1, 0), cA + kstep, 0, false); PG8_STAGE(PG8_SB(1, 1), cB + hstep + kstep, voffB);
        PG8_WAIT_V(6); PG8_BAR;
    }
    for (;;) {
        const bool has_next = S.next(ui + 1, nxt);
        const char* nA = cA; const char* nB = cB;
        if (has_next) PG8_UPTR(nxt, nA, nB);
        for (int t = 0; t < nt; t += 2) {
            const bool last = (t == nt - 2);
            const char* a1 = cA + (size_t)(t + 1) * kstep;
            const char* a2 = last ? nA : cA + (size_t)(t + 2) * kstep; const char* b2 = last ? nB : cB + (size_t)(t + 2) * kstep;
            const char* a3 = a2 + kstep; const char* b3 = b2 + kstep;
            if constexpr (SP2) {
            PG8_LDB(B0, 0, 0); PG8_LDB(B1, 0, 1); PG8_SCHED; PG8_LDA(At, 0, 0); PG8_STAGE_A(PG8_SA(1, 1), a1, 1, false);
            if constexpr (GATHER) { if (last && has_next) { PG8_GROWS(nxt, vC); } }
            PG8_WAIT_V(8); PG8_WAIT_L(0); PG8_BAR; PG8_MMA(0, 0, At, B0); PG8_MMA(0, 1, At, B1); PG8_BAR; PG8_SCHED;
            PG8_LDA(At, 0, 1); PG8_STAGE(PG8_SB(0, 0), b2, voffB); PG8_STAGE(PG8_SB(0, 1), b2 + hstep, voffB); PG8_STAGE_A(PG8_SA(0, 0), a2, 0, last);
            PG8_WAIT_V(8); PG8_WAIT_L(0); PG8_BAR; PG8_MMA(1, 0, At, B0); PG8_MMA(1, 1, At, B1); PG8_BAR; PG8_SCHED;
            PG8_LDB(B0, 1, 0); PG8_LDB(B1, 1, 1); PG8_SCHED; PG8_LDA(At, 1, 0); PG8_STAGE_A(PG8_SA(0, 1), a2, 1, last);
            PG8_WAIT_V(8); PG8_WAIT_L(0); PG8_BAR; PG8_MMA(0, 0, At, B0); PG8_MMA(0, 1, At, B1); PG8_BAR; PG8_SCHED;
            PG8_LDA(At, 1, 1); PG8_STAGE(PG8_SB(1, 0), b3, voffB); PG8_STAGE(PG8_SB(1, 1), b3 + hstep, voffB); PG8_STAGE_A(PG8_SA(1, 0), a3, 0, last);
            PG8_WAIT_V(8); PG8_WAIT_L(0); PG8_BAR; PG8_MMA(1, 0, At, B0); PG8_MMA(1, 1, At, B1); PG8_BAR; PG8_SCHED;
            } else {
            PG8_LDB(B0, 0, 0); PG8_SCHED; PG8_LDA(At, 0, 0); PG8_STAGE_A(PG8_SA(1, 1), a1, 1, false);
            if constexpr (GATHER) { if (last && has_next) { PG8_GROWS(nxt, vC); } }
            PG8_WAIT_L(8); PG8_BAR; PG8_WAIT_L(0); PG8_MMA(0, 0, At, B0); PG8_BAR; PG8_SCHED;
            PG8_LDB(B1, 0, 1); PG8_STAGE(PG8_SB(0, 0), b2, voffB);
            PG8_BAR; PG8_WAIT_L(0); PG8_MMA(0, 1, At, B1); PG8_BAR;
            PG8_LDA(At, 0, 1); PG8_STAGE_A(PG8_SA(0, 0), a2, 0, last);
            PG8_BAR; PG8_WAIT_L(0); PG8_MMA(1, 0, At, B0); PG8_BAR; PG8_SCHED;
            PG8_STAGE(PG8_SB(0, 1), b2 + hstep, voffB);
            PG8_WAIT_V(6); PG8_BAR; PG8_MMA(1, 1, At, B1); PG8_BAR;
            PG8_LDB(B0, 1, 0); PG8_SCHED; PG8_LDA(At, 1, 0); PG8_STAGE_A(PG8_SA(0, 1), a2, 1, last);
            PG8_WAIT_L(8); PG8_BAR; PG8_WAIT_L(0); PG8_MMA(0, 0, At, B0); PG8_BAR; PG8_SCHED;
            PG8_LDB(B1, 1, 1); PG8_STAGE(PG8_SB(1, 0), b3, voffB);
            PG8_BAR; PG8_WAIT_L(0); PG8_MMA(0, 1, At, B1); PG8_BAR;
            PG8_LDA(At, 1, 1); PG8_STAGE_A(PG8_SA(1, 0), a3, 0, last);
            PG8_BAR; PG8_WAIT_L(0); PG8_MMA(1, 0, At, B0); PG8_BAR; PG8_SCHED;
            PG8_STAGE(PG8_SB(1, 1), b3 + hstep, voffB);
            PG8_WAIT_V(6); PG8_BAR; PG8_MMA(1, 1, At, B1); PG8_BAR;
            }
        }
        if constexpr (ALIGN_EPI) { if (wr == 0) PG8_BAR; }
        E(acc, cur, wr, wc, fr, fq);
        if (!has_next) break;
#pragma unroll
        for (int a = 0; a < 2; ++a)
#pragma unroll
            for (int b = 0; b < 2; ++b)
#pragma unroll
                for (int m = 0; m < 4; ++m)
#pragma unroll
                    for (int n = 0; n < 2; ++n) acc[a][b][m][n] = (f32x4){0.f, 0.f, 0.f, 0.f};
        cur = nxt; cA = nA; cB = nB; ++ui;
        if constexpr (ALIGN_EPI) { if (wr == 1) PG8_BAR; }
    }
    PG8_WAIT_V(0);
    if constexpr (!ALIGN_EPI) { if (wr == 0) PG8_BAR; }
    PG8_BAR;
#undef PG8_SA
#undef PG8_SB
#undef PG8_STAGE
#undef PG8_LDA
#undef PG8_LDB
#undef PG8_MMA
#undef PG8_WAIT_V
#undef PG8_WAIT_L
#undef PG8_BAR
#undef PG8_SCHED
#undef PG8_UPTR
#undef PG8_STAGE_A
#undef PG8_GROWS
}

struct EpiProj {
    static constexpr bool PERM = true;
    bf16 *q, *k, *vT, *p;
    __device__ __forceinline__ void operator()(const f32x4 (&acc)[2][2][4][2], const Unit& u, int wr, int wc, int fr, int fq) const {
        const int row0 = u.pm * BM + wr * 64 + fr;
        const int pn = u.pn;
#pragma unroll
        for (int ai = 0; ai < 2; ++ai)
#pragma unroll
            for (int m = 0; m < 4; ++m) {
                const int row = row0 + ai * HALF + m * 16;
#pragma unroll
                for (int bj = 0; bj < 2; ++bj) {
                    f32x4 v0 = acc[ai][bj][m][0], v1 = acc[ai][bj][m][1];
                    const int col = pn * BM + bj * HALF + wc * 32 + 8 * fq;
                    if (pn >= 4 && pn < 6) {
                        const int cv = col - 1024, hh = cv >> 6, dim = cv & 63, b = row / T, t = row % T;
                        bf16* dst = vT + ((size_t)((b * NH + hh) * HD + dim)) * T + t;
                        const unsigned w0 = cvt_pk_bf16(v0[0], v0[1]), w1 = cvt_pk_bf16(v0[2], v0[3]), w2 = cvt_pk_bf16(v1[0], v1[1]), w3 = cvt_pk_bf16(v1[2], v1[3]);
                        dst[0 * (size_t)T] = (bf16)(w0 & 0xffff); dst[1 * (size_t)T] = (bf16)(w0 >> 16); dst[2 * (size_t)T] = (bf16)(w1 & 0xffff); dst[3 * (size_t)T] = (bf16)(w1 >> 16);
                        dst[4 * (size_t)T] = (bf16)(w2 & 0xffff); dst[5 * (size_t)T] = (bf16)(w2 >> 16); dst[6 * (size_t)T] = (bf16)(w3 & 0xffff); dst[7 * (size_t)T] = (bf16)(w3 >> 16);
                    } else {
                        bf16* dst;
                        if (pn < 2) { v0 = v0 * 0.125f; v1 = v1 * 0.125f; dst = q + (size_t)row * CW + col; }
                        else if (pn < 4) dst = k + (size_t)row * CW + (col - 512);
                        else dst = p + (size_t)row * PW + (col - 1536);
                        u32x4 w; w.x = cvt_pk_bf16(v0[0], v0[1]); w.y = cvt_pk_bf16(v0[2], v0[3]); w.z = cvt_pk_bf16(v1[0], v1[1]); w.w = cvt_pk_bf16(v1[2], v1[3]);
                        *(u32x4*)dst = w;
                    }
                }
            }
    }
};
struct EpiWo {
    static constexpr bool PERM = false;
    const float* x; float* h;
    __device__ __forceinline__ void operator()(const f32x4 (&acc)[2][2][4][2], const Unit& u, int wr, int wc, int fr, int fq) const {
        const int row0 = u.pm * BM + wr * 64 + fr, col0 = u.pn * BM + wc * 32 + 4 * fq;
#pragma unroll
        for (int ai = 0; ai < 2; ++ai)
#pragma unroll
            for (int m = 0; m < 4; ++m) { const size_t off = (size_t)(row0 + ai * HALF + m * 16) * D + col0;
#pragma unroll
                for (int bj = 0; bj < 2; ++bj)
#pragma unroll
                    for (int n = 0; n < 2; ++n) { const f32x4 xv = *(const f32x4*)(x + off + bj * HALF + n * 16); *(f32x4*)(h + off + bj * HALF + n * 16) = acc[ai][bj][m][n] + xv; } }
    }
};
struct EpiUp {
    static constexpr bool PERM = true;
    const float* b_up; bf16* act;
    __device__ __forceinline__ void operator()(const f32x4 (&acc)[2][2][4][2], const Unit& u, int wr, int wc, int fr, int fq) const {
        const int row0 = u.pm * BM + wr * 64 + fr, ch = u.pn * 128 + wc * 32 + 8 * fq;
        const float* bg = b_up + (size_t)u.e * 2048 + ch; const float* bl = bg + 1024;
        const f32x4 bg0 = *(const f32x4*)bg, bg1 = *(const f32x4*)(bg + 4), bl0 = *(const f32x4*)bl, bl1 = *(const f32x4*)(bl + 4);
#pragma unroll
        for (int ai = 0; ai < 2; ++ai)
#pragma unroll
            for (int m = 0; m < 4; ++m) {
                float o[8];
#pragma unroll
                for (int n = 0; n < 2; ++n) { const f32x4 gv = acc[ai][0][m][n] + (n ? bg1 : bg0), lv = acc[ai][1][m][n] + (n ? bl1 : bl0);
#pragma unroll
                    for (int j = 0; j < 4; ++j) { const float gt = fminf(gv[j], 7.0f), li = fminf(fmaxf(lv[j], -7.0f), 7.0f); o[n * 4 + j] = (li + 1.0f) * gt * sigmoidf_(1.702f * gt); } }
                *(u32x4*)(act + (size_t)(row0 + ai * HALF + m * 16) * DE + ch) = pack8(o);
            }
    }
};
struct EpiDown {
    static constexpr bool PERM = true;
    const float* b_dn; bf16* y;
    __device__ __forceinline__ void operator()(const f32x4 (&acc)[2][2][4][2], const Unit& u, int wr, int wc, int fr, int fq) const {
        const int row0 = u.pm * BM + wr * 64 + fr, col0 = u.pn * BM + wc * 32 + 8 * fq;
        const float* bb = b_dn + (size_t)u.e * D + col0;
        f32x4 bv[2][2];
#pragma unroll
        for (int bj = 0; bj < 2; ++bj)
#pragma unroll
            for (int n = 0; n < 2; ++n) bv[bj][n] = *(const f32x4*)(bb + bj * HALF + 4 * n);
#pragma unroll
        for (int ai = 0; ai < 2; ++ai)
#pragma unroll
            for (int m = 0; m < 4; ++m) { bf16* rowp = y + (size_t)(row0 + ai * HALF + m * 16) * D + col0;
#pragma unroll
                for (int bj = 0; bj < 2; ++bj) { const f32x4 v0 = acc[ai][bj][m][0] + bv[bj][0], v1 = acc[ai][bj][m][1] + bv[bj][1];
                    u32x4 w; w.x = cvt_pk_bf16(v0[0], v0[1]); w.y = cvt_pk_bf16(v0[2], v0[3]); w.z = cvt_pk_bf16(v1[0], v1[1]); w.w = cvt_pk_bf16(v1[2], v1[3]);
                    *(u32x4*)(rowp + bj * HALF) = w; } }
    }
};
}


#define XB_TMO      128
#define XB_XCNT(j)  (256  + 64 * (j))
#define XB_XSUB(j)  (1280 + 64 * (j))
#define XB_XGEN(j)  (2304 + 64 * (j))
#define XB_TOP      3328
#define XB_TOPGEN   3392
#define XCD_BAR_WORDS 3456
#define XB_SPIN_CAP (1u << 20)
__device__ __forceinline__ unsigned xb_ld(unsigned* p)              { return __hip_atomic_load(p, __ATOMIC_RELAXED, __HIP_MEMORY_SCOPE_AGENT); }
__device__ __forceinline__ unsigned xb_add(unsigned* p, unsigned v) { return __hip_atomic_fetch_add(p, v, __ATOMIC_RELAXED, __HIP_MEMORY_SCOPE_AGENT); }
__device__ __forceinline__ unsigned xb_xcc_id() { return (unsigned)__builtin_amdgcn_s_getreg((3 << 11) | 20) & 0xFu; }
#define XB_SPIN(cond, bar) do { unsigned _sp = 0; while (cond) { __builtin_amdgcn_s_sleep(1); \
    if ((++_sp & 255u) == 0u) { if (xb_ld(&(bar)[XB_TMO])) break; if (_sp > XB_SPIN_CAP) { atomicAdd(&(bar)[XB_TMO], 1u); break; } } } } while (0)
struct XcdBarrier { unsigned* bar; unsigned x; volatile LAS unsigned* st; };
__device__ __forceinline__ XcdBarrier xcd_barrier_post(unsigned* bar, volatile LAS unsigned* st) {
    XcdBarrier b; b.bar = bar; b.x = xb_xcc_id(); b.st = st;
    if (threadIdx.x == 0) (void)xb_add(&bar[XB_XCNT(b.x)], 1u);
    return b;
}
__device__ __forceinline__ void xcd_barrier_complete(unsigned* bar, unsigned x, unsigned& nloc, unsigned& nx) {
    const unsigned G = gridDim.x * gridDim.y * gridDim.z;
    unsigned sum, cnt, mine, sp = 0u;
    for (;;) {
        sum = 0u; cnt = 0u; mine = 0u;
#pragma unroll
        for (unsigned j = 0; j < 16; ++j) { const unsigned c = xb_ld(&bar[XB_XCNT(j)]); sum += c; cnt += (c > 0u) ? 1u : 0u; mine = (j == x) ? c : mine; }
        if (sum == G) break;
        __builtin_amdgcn_s_sleep(1);
        if ((++sp & 255u) == 0u) { if (xb_ld(&bar[XB_TMO])) break; if (sp > XB_SPIN_CAP) { atomicAdd(&bar[XB_TMO], 1u); break; } }
    }
    nloc = mine > 0u ? mine : 1u; nx = cnt > 0u ? cnt : 1u;
}
__device__ __forceinline__ void xcd_barrier(const XcdBarrier& b) {
    asm volatile("s_waitcnt vmcnt(0)" ::: "memory");
    __syncthreads();
    if (threadIdx.x == 0) {
        unsigned* bar = b.bar;
        __builtin_amdgcn_s_waitcnt(0);
        unsigned nloc = b.st[0], nx = b.st[1];
        if (nloc == 0u) { xcd_barrier_complete(bar, b.x, nloc, nx); b.st[0] = nloc; b.st[1] = nx; }
        const unsigned old = xb_add(&bar[XB_XSUB(b.x)], 1u);
        const unsigned gen = old / nloc;
        if (old + 1u == (gen + 1u) * nloc) {
            __builtin_amdgcn_fence(__ATOMIC_RELEASE, "agent");
            asm volatile("s_waitcnt vmcnt(0)" ::: "memory");
            const unsigned og = xb_add(&bar[XB_TOP], 1u);
            const unsigned tg = og / nx;
            if (og + 1u == (tg + 1u) * nx) xb_add(&bar[XB_TOPGEN], 1u);
            else XB_SPIN(xb_ld(&bar[XB_TOPGEN]) == tg, bar);
            __builtin_amdgcn_fence(__ATOMIC_ACQUIRE, "agent");
            xb_add(&bar[XB_XGEN(b.x)], 1u);
            asm volatile("s_waitcnt vmcnt(0)" ::: "memory");
        } else {
            XB_SPIN(xb_ld(&bar[XB_XGEN(b.x)]) == gen, bar);
            __builtin_amdgcn_fence(__ATOMIC_ACQUIRE, "agent");
            asm volatile("s_waitcnt vmcnt(0)" ::: "memory");
        }
    }
    __syncthreads();
}

struct Args { const float* in[26]; float* out; unsigned char* ws; int ph_lo, ph_hi; };

struct Frame { LAS unsigned char* lds; int tid, lane, wave, G, vcu; };

__device__ __forceinline__ void transpose_item(const float* W, int K, int N, bf16* WT, int k0, int n0, int orow0, LAS float* scr, int lane) {
#pragma unroll 8
    for (int i = 0; i < 32; ++i) { const int kk = 2 * i + (lane >> 5); scr[kk * 33 + (lane & 31)] = W[(size_t)(k0 + kk) * N + n0 + (lane & 31)]; }
    asm volatile("s_waitcnt lgkmcnt(0)" ::: "memory");
    const int c = lane & 7;
#pragma unroll
    for (int j = 0; j < 4; ++j) { const int n = (lane >> 3) + 8 * j; const LAS float* s = scr + (8 * c) * 33 + n;
        u32x4 o; o.x = cvt_pk_bf16(s[0 * 33], s[1 * 33]); o.y = cvt_pk_bf16(s[2 * 33], s[3 * 33]); o.z = cvt_pk_bf16(s[4 * 33], s[5 * 33]); o.w = cvt_pk_bf16(s[6 * 33], s[7 * 33]);
        *(u32x4*)(WT + (size_t)(orow0 + n) * K + k0 + 8 * c) = o; }
    asm volatile("s_waitcnt lgkmcnt(0)" ::: "memory");
}

__device__ __forceinline__ void p0_prologue(const Frame& F, const Args& a) {
    unsigned char* ws = a.ws;
    LAS float* scr = (LAS float*)(F.lds + F.wave * 8448);
    const int gw = F.vcu * 8 + F.wave, NGW = F.G * 8;
    constexpr int I_IN = 16 * 108, I_O = 16 * 32, I_UP = 32 * 16 * 64, I_DN = 32 * 16 * 32, I_L = 16, I_G = 32;
    constexpr int NITEMS = I_IN + I_O + I_UP + I_DN + 2 * I_L + 2 * I_L + I_G;
    for (int it = gw; it < NITEMS; it += NGW) {
        int r = it;
        if (r < I_UP) {
            const int e = r / 1024, q = r % 1024, kb = q / 64, nb = q % 64, n0 = nb * 32;
            const int orow0 = n0 < 1024 ? 256 * (n0 >> 7) + (n0 & 127) : 256 * ((n0 - 1024) >> 7) + 128 + ((n0 - 1024) & 127);
            transpose_item(a.in[21] + (size_t)e * 1024 * 2048, 1024, 2048, (bf16*)(ws + WS_WUPT) + (size_t)e * 2048 * 1024, kb * 64, n0, orow0, scr, F.lane); continue; }
        r -= I_UP;
        if (r < I_DN) { const int e = r / 512, q = r % 512, kb = q / 32, nb = q % 32;
            transpose_item(a.in[23] + (size_t)e * 1024 * 1024, 1024, 1024, (bf16*)(ws + WS_WDNT) + (size_t)e * 1024 * 1024, kb * 64, nb * 32, nb * 32, scr, F.lane); continue; }
        r -= I_DN;
        if (r < I_IN) { const int kb = r / 108, nb = r % 108; transpose_item(a.in[2], 1024, NPROJ, (bf16*)(ws + WS_WINT), kb * 64, nb * 32, nb * 32, scr, F.lane); continue; }
        r -= I_IN;
        if (r < I_O) { const int kb = r / 32, nb = r % 32; transpose_item(a.in[17], 1024, 1024, (bf16*)(ws + WS_WOT), kb * 64, nb * 32, nb * 32, scr, F.lane); continue; }
        r -= I_O;
        if (r < 2 * I_L) { const int z = r / 16, nb = r % 16; transpose_item(a.in[8] + (size_t)z * 64 * 512, 64, 512, (bf16*)(ws + WS_W2T) + (size_t)z * 512 * 64, 0, nb * 32, nb * 32, scr, F.lane); continue; }
        r -= 2 * I_L;
        if (r < 2 * I_L) { const int z = r / 16, nb = r % 16; transpose_item(a.in[10] + (size_t)z * 64 * 512, 64, 512, (bf16*)(ws + WS_A2T) + (size_t)z * 512 * 64, 0, nb * 32, nb * 32, scr, F.lane); continue; }
        r -= 2 * I_L;
        { const int kb = r / 16, nb = r % 16; transpose_item(a.in[11], 128, 512, (bf16*)(ws + WS_G2T), kb * 64, nb * 32, nb * 32, scr, F.lane); }
    }
    { u32x4* z = (u32x4*)(ws + WS_WINT + (size_t)NPROJ * 1024 * 2); const u32x4 zero = {0u, 0u, 0u, 0u};
      for (int i = F.vcu * 512 + F.tid; i < 16384; i += F.G * 512) z[i] = zero; }
    const float* x = a.in[0]; const float* nw = a.in[1]; bf16* hn = (bf16*)(ws + WS_HN);
    f32x4 wv[4];
#pragma unroll
    for (int j = 0; j < 4; ++j) wv[j] = *((const f32x4*)nw + F.lane + 64 * j);
    for (int m = gw; m < M; m += NGW) {
        const f32x4* xr = (const f32x4*)(x + (size_t)m * D) + F.lane;
        f32x4 v[4]; float s = 0.f;
#pragma unroll
        for (int j = 0; j < 4; ++j) { v[j] = xr[64 * j]; s += (v[j].x * v[j].x + v[j].y * v[j].y) + (v[j].z * v[j].z + v[j].w * v[j].w); }
        const float rs = rsqrtf(wave_sum(s) * (1.f / D) + RMS_EPS);
        u32x2* o8 = (u32x2*)(hn + (size_t)m * D) + F.lane;
#pragma unroll
        for (int j = 0; j < 4; ++j) { u32x2 o; o.x = cvt_pk_bf16(v[j].x * rs * wv[j].x, v[j].y * rs * wv[j].y); o.y = cvt_pk_bf16(v[j].z * rs * wv[j].z, v[j].w * rs * wv[j].w); o8[64 * j] = o; }
    }
}

constexpr int PREP_KBUF = 0, PREP_INV = 65536, PREP_AW = 67584, PREP_AA = PREP_AW + 17408, PREP_AG = PREP_AA + 17408, PREP_LD = 136;
template <bool STORE>
__device__ __forceinline__ void prep_phase(const Frame& F, const Args& a) {
    unsigned char* ws = a.ws;
    const bf16* p = (const bf16*)(ws + WS_P);
    bf16* r_out = (bf16*)(ws + WS_R); bf16* v_out = (bf16*)(ws + WS_V); bf16* kk_out = (bf16*)(ws + WS_KK);
    bf16* decay_out = (bf16*)(ws + WS_DECAY); bf16* kdir_out = (bf16*)(ws + WS_KDIR); bf16* akk_out = (bf16*)(ws + WS_AKK); bf16* g_out = (bf16*)(ws + WS_G);
    const bf16* w2T = (const bf16*)(ws + WS_W2T); const bf16* a2T = (const bf16*)(ws + WS_A2T); const bf16* g2T = (const bf16*)(ws + WS_G2T);
    const float* mu_p = a.in[5]; const float* mu_n = a.in[6]; const float* w0 = a.in[7]; const float* a0 = a.in[9];
    const float* k_k = a.in[12]; const float* k_a = a.in[13];
    LAS bf16* kbuf = (LAS bf16*)(F.lds + PREP_KBUF); LAS float* invb = (LAS float*)(F.lds + PREP_INV);
    LAS bf16* Aw = (LAS bf16*)(F.lds + PREP_AW); LAS bf16* Aa = (LAS bf16*)(F.lds + PREP_AA); LAS bf16* Ag = (LAS bf16*)(F.lds + PREP_AG);
    const int lane = F.lane, wave = F.wave, fr = lane & 15, fg = lane >> 4;
    for (int tile = F.vcu; tile < M / 64; tile += F.G) {
        const int m0 = tile * 64;
#pragma unroll 1
        for (int jj = 0; jj < 4; ++jj) {
            const int q = lane + 64 * jj; const bool valid = q < 240; const int c0 = 8 * q;
            float mp[8], mn[8];
#pragma unroll
            for (int i = 0; i < 8; ++i) { mp[i] = valid ? mu_p[c0 + i] : 0.f; mn[i] = valid ? mu_n[c0 + i] : 0.f; }
            const int mfirst = m0 + wave * 8;
            const u32x4 zero = {0u, 0u, 0u, 0u};
            u32x4 rows[10];
#pragma unroll
            for (int rI = 0; rI < 10; ++rI) { const int mr = mfirst - 1 + rI;
                const bool ok = valid && !(rI == 0 && (mfirst % T) == 0) && !(rI == 9 && ((mfirst + 7) % T) == T - 1);
                rows[rI] = ok ? *(const u32x4*)(p + (size_t)mr * PW + c0) : zero; }
#pragma unroll
            for (int i = 0; i < 8; ++i) {
                const int m = mfirst + i, it = wave * 8 + i;
                const u32x4 prev = rows[i], cur = rows[i + 1], nxt = rows[i + 2];
                float fp[8], fc[8], fn[8], s[8];
                unpack8(prev, fp); unpack8(cur, fc); unpack8(nxt, fn);
#pragma unroll
                for (int e = 0; e < 8; ++e) s[e] = fc[e] + mp[e] * (fp[e] - fc[e]) + mn[e] * (fn[e] - fc[e]);
                if (jj == 0) { if (STORE) { *(u32x4*)(r_out + (size_t)m * CW + c0) = pack8(s); } }
                else if (jj == 1) {
                    const int c = c0 - 512;
                    *(LAS u32x4*)(kbuf + it * 512 + c) = pack8(s);
                    float kr[8]; float ss = 0.f;
#pragma unroll
                    for (int e = 0; e < 8; ++e) { kr[e] = s[e] * k_k[c + e]; ss += kr[e] * kr[e]; }
                    ss += __shfl_xor(ss, 1); ss += __shfl_xor(ss, 2); ss += __shfl_xor(ss, 4);
                    const float inv = fminf(__builtin_amdgcn_rsqf(ss), 1e12f);
#pragma unroll
                    for (int e = 0; e < 8; ++e) kr[e] *= inv;
                    if (STORE) { *(u32x4*)(kk_out + (size_t)m * CW + c) = pack8(kr); }
                    if ((lane & 7) == 0) invb[it * 8 + (lane >> 3)] = inv;
                }
                else if (jj == 2) { if (STORE) { *(u32x4*)(v_out + (size_t)m * CW + (c0 - 1024)) = pack8(s); } }
                else if (valid) {
                    const int seg = lane >> 4, cw = 8 * (lane & 15);
                    if (seg == 0) {
#pragma unroll
                        for (int e = 0; e < 8; ++e) s[e] = 1.0f - 2.0f * __builtin_amdgcn_rcpf(__expf(2.0f * s[e]) + 1.0f);
                        *(LAS u32x4*)(Aw + it * PREP_LD + cw) = pack8(s);
                    } else if (seg == 1) { *(LAS u32x4*)(Aa + it * PREP_LD + cw) = pack8(s); }
                    else {
#pragma unroll
                        for (int e = 0; e < 8; ++e) s[e] = sigmoidf_(s[e]);
                        *(LAS u32x4*)(Ag + it * PREP_LD + cw) = pack8(s);
                    }
                }
            }
        }
        __syncthreads();
        const int nb = 64 * wave;
#pragma unroll 1
        for (int job = 0; job < 5; ++job) {
            const int z = job & 1;
            const bf16* WT = job < 2 ? w2T + (size_t)z * 512 * 64 : (job < 4 ? a2T + (size_t)z * 512 * 64 : g2T);
            const LAS bf16* Ax = job < 2 ? Aw + z * 64 : (job < 4 ? Aa + z * 64 : Ag);
            const int kw = job < 4 ? 64 : 128, nks = kw / 32;
            f32x4 acc[4][4];
#pragma unroll
            for (int mt = 0; mt < 4; ++mt)
#pragma unroll
                for (int nt = 0; nt < 4; ++nt) acc[mt][nt] = (f32x4){0.f, 0.f, 0.f, 0.f};
#pragma unroll 1
            for (int ks = 0; ks < nks; ++ks) {
                bf16x8 af[4], wf[4];
#pragma unroll
                for (int mt = 0; mt < 4; ++mt) af[mt] = *(const LAS bf16x8*)(Ax + (16 * mt + fr) * PREP_LD + 32 * ks + 8 * fg);
#pragma unroll
                for (int nt = 0; nt < 4; ++nt) wf[nt] = *(const bf16x8*)(WT + (size_t)(nb + 16 * nt + fr) * kw + 32 * ks + 8 * fg);
#pragma unroll
                for (int mt = 0; mt < 4; ++mt)
#pragma unroll
                    for (int nt = 0; nt < 4; ++nt) acc[mt][nt] = __builtin_amdgcn_mfma_f32_16x16x32_bf16(wf[nt], af[mt], acc[mt][nt], 0, 0, 0);
            }
#pragma unroll
            for (int mt = 0; mt < 4; ++mt) {
                const int it = 16 * mt + fr; const size_t m = (size_t)(m0 + it);
#pragma unroll
                for (int nt = 0; nt < 4; ++nt) {
                    const int n = nb + 16 * nt + 4 * fg;
                    const f32x4 v = acc[mt][nt];
                    if (job < 2) {
                        const f32x4 b = *(const f32x4*)(w0 + z * 512 + n);
                        float o[4];
#pragma unroll
                        for (int i = 0; i < 4; ++i) o[i] = __expf(-0.60653066f * sigmoidf_(v[i] + b[i]));
                        u32x2 w; w.x = cvt_pk_bf16(o[0], o[1]); w.y = cvt_pk_bf16(o[2], o[3]);
                        if (STORE) { *(u32x2*)(decay_out + ((size_t)z * M + m) * CW + n) = w; }
                    } else if (job < 4) {
                        const f32x4 b = *(const f32x4*)(a0 + z * 512 + n), kkc = *(const f32x4*)(k_k + n), kac = *(const f32x4*)(k_a + n);
                        const u32x2 kb = *(const LAS u32x2*)(kbuf + it * 512 + n);
                        const float kv[4] = {bflo(kb.x), bfhi(kb.x), bflo(kb.y), bfhi(kb.y)};
                        const float inv = invb[it * 8 + wave];
                        float kd[4], ak[4];
#pragma unroll
                        for (int i = 0; i < 4; ++i) { const float av = sigmoidf_(v[i] + b[i]); kd[i] = kv[i] * (1.0f + (av - 1.0f) * kac[i]); ak[i] = av * (kv[i] * kkc[i] * inv); }
                        u32x2 w; w.x = cvt_pk_bf16(kd[0], kd[1]); w.y = cvt_pk_bf16(kd[2], kd[3]);
                        if (STORE) { *(u32x2*)(kdir_out + ((size_t)z * M + m) * CW + n) = w; }
                        w.x = cvt_pk_bf16(ak[0], ak[1]); w.y = cvt_pk_bf16(ak[2], ak[3]);
                        if (STORE) { *(u32x2*)(akk_out + ((size_t)z * M + m) * CW + n) = w; }
                    } else {
                        u32x2 w; w.x = cvt_pk_bf16(v[0], v[1]); w.y = cvt_pk_bf16(v[2], v[3]);
                        if (STORE) { *(u32x2*)(g_out + m * CW + n) = w; }
                    }
                }
            }
        }
        __syncthreads();
    }
}

__device__ __forceinline__ void attn_phase(const Frame& F, const Args& a) {
    unsigned char* ws = a.ws;
    const bf16* q = (const bf16*)(ws + WS_Q); const bf16* k = (const bf16*)(ws + WS_K); const bf16* vT = (const bf16*)(ws + WS_VT);
    bf16* att = (bf16*)(ws + WS_ATT);
    LAS float* bias = (LAS float*)F.lds;
    for (int i = F.tid; i < 8 * 15 * 31; i += 512) bias[i] = a.in[3][i];
    __syncthreads();
    const int lane = F.lane, fr = lane & 15, fg = lane >> 4;
    const int NGW = F.G * 8, gw = F.vcu * 8 + F.wave;
    const int per = (16384 + NGW - 1) / NGW;
    for (int task = gw * per; task < (gw + 1) * per && task < 16384; ++task) {
        const int cgp = task & 3, r = (task >> 2) & 127, h = (task >> 9) & 7, b = task >> 12;
        const int c0 = 16 * cgp, wsc = min(max(c0 - 8, 0), 32), rs = min(max(r - 4, 0), GROWS - 8);
        const int c = c0 + fr, cs = min(max(c - 8, 0), 48);
        const size_t tq = (size_t)b * T + r * 64 + c;
        bf16x8 qf[2];
#pragma unroll
        for (int ks = 0; ks < 2; ++ks) qf[ks] = *(const bf16x8*)(q + tq * CW + h * 64 + 32 * ks + 8 * fg);
        f32x4 sc[16];
        const int kcol_a = wsc + 8 * (fr >> 2) + (fr & 3);
#pragma unroll
        for (int hb = 0; hb < 2; ++hb) {
            bf16x8 kf[8][2];
#pragma unroll
            for (int tl = 0; tl < 8; ++tl) { const int t = 8 * hb + tl, u = t >> 1, par = t & 1;
                const size_t tk = (size_t)b * T + (rs + u) * 64 + kcol_a + 4 * par;
                kf[tl][0] = *(const bf16x8*)(k + tk * CW + h * 64 + 8 * fg); kf[tl][1] = *(const bf16x8*)(k + tk * CW + h * 64 + 32 + 8 * fg); }
#pragma unroll
            for (int tl = 0; tl < 8; ++tl) { f32x4 s = {0.f, 0.f, 0.f, 0.f};
                s = __builtin_amdgcn_mfma_f32_16x16x32_bf16(kf[tl][0], qf[0], s, 0, 0, 0);
                s = __builtin_amdgcn_mfma_f32_16x16x32_bf16(kf[tl][1], qf[1], s, 0, 0, 0);
                sc[8 * hb + tl] = s; }
        }
        float mx = -1e30f;
#pragma unroll
        for (int u = 0; u < 8; ++u) {
            const int dr = rs + u - r + 7;
#pragma unroll
            for (int par = 0; par < 2; ++par)
#pragma unroll
                for (int i = 0; i < 4; ++i) {
                    const int kc = wsc + 8 * fg + 4 * par + i; const bool ok = (kc >= cs) && (kc < cs + 16);
                    const int dc = min(max(kc - c + 15, 0), 30);
                    const float s = ok ? sc[2 * u + par][i] + bias[(h * 15 + dr) * 31 + dc] : -1e30f;
                    sc[2 * u + par][i] = s; mx = fmaxf(mx, s);
                }
        }
        mx = fmaxf(mx, __shfl_xor(mx, 16)); mx = fmaxf(mx, __shfl_xor(mx, 32));
        float sum = 0.f;
#pragma unroll
        for (int t = 0; t < 16; ++t)
#pragma unroll
            for (int i = 0; i < 4; ++i) { const float pv = sc[t][i] > -1e29f ? __expf(sc[t][i] - mx) : 0.f; sc[t][i] = pv; sum += pv; }
        sum += __shfl_xor(sum, 16); sum += __shfl_xor(sum, 32);
        const float inv = 1.0f / sum;
        f32x4 o[4];
#pragma unroll
        for (int nt = 0; nt < 4; ++nt) o[nt] = (f32x4){0.f, 0.f, 0.f, 0.f};
#pragma unroll
        for (int hb = 0; hb < 2; ++hb) {
            bf16x8 vf[4][4];
#pragma unroll
            for (int ul = 0; ul < 4; ++ul) { const int u = 4 * hb + ul; const size_t tv = (size_t)(rs + u) * 64 + wsc + 8 * fg;
#pragma unroll
                for (int nt = 0; nt < 4; ++nt) vf[ul][nt] = *(const bf16x8*)(vT + ((size_t)((b * NH + h) * HD + 16 * nt + fr)) * T + tv); }
#pragma unroll
            for (int ul = 0; ul < 4; ++ul) { const int u = 4 * hb + ul;
                union { u32x4 w; bf16x8 h8; } pf;
                pf.w.x = cvt_pk_bf16(sc[2 * u][0], sc[2 * u][1]); pf.w.y = cvt_pk_bf16(sc[2 * u][2], sc[2 * u][3]);
                pf.w.z = cvt_pk_bf16(sc[2 * u + 1][0], sc[2 * u + 1][1]); pf.w.w = cvt_pk_bf16(sc[2 * u + 1][2], sc[2 * u + 1][3]);
#pragma unroll
                for (int nt = 0; nt < 4; ++nt) o[nt] = __builtin_amdgcn_mfma_f32_16x16x32_bf16(vf[ul][nt], pf.h8, o[nt], 0, 0, 0); }
        }
#pragma unroll
        for (int nt = 0; nt < 4; ++nt) { u32x2 w; w.x = cvt_pk_bf16(o[nt][0] * inv, o[nt][1] * inv); w.y = cvt_pk_bf16(o[nt][2] * inv, o[nt][3] * inv);
            *(u32x2*)(att + tq * CW + h * 64 + 16 * nt + 4 * fg) = w; }
    }
    __syncthreads();
}

__device__ __forceinline__ float row16_sum(float v) {
    v += __builtin_bit_cast(float, __builtin_amdgcn_update_dpp(0, __builtin_bit_cast(int, v), 0xB1, 0xF, 0xF, true));
    v += __builtin_bit_cast(float, __builtin_amdgcn_update_dpp(0, __builtin_bit_cast(int, v), 0x4E, 0xF, 0xF, true));
    v += __builtin_bit_cast(float, __builtin_amdgcn_update_dpp(0, __builtin_bit_cast(int, v), 0x141, 0xF, 0xF, true));
    v += __builtin_bit_cast(float, __builtin_amdgcn_update_dpp(0, __builtin_bit_cast(int, v), 0x140, 0xF, 0xF, true));
    return v;
}
constexpr int CS_R = 8;
constexpr int CS_AT = 0, CS_RT = 2304, CS_KHT = 4608, CS_BHT = 6656, CS_VT = 8704, CS_TT = 9216, CS_AAK = 9728, CS_ARK = 10240, CS_ARB = 10752, CS_PL = 11264, CS_SLOT = 11520;
constexpr int CS_LD = 72;
constexpr int CS_SCR = CS_R * CS_SLOT  , CS_SCRW = 2304 * 2 + 1024  , CS_FLAG = CS_SCR + 7 * CS_SCRW  ;
__device__ __forceinline__ bf16 f2bf(float f) { return (bf16)(cvt_pk_bf16(f, 0.f) & 0xffffu); }
__device__ __forceinline__ void scan_phase(const Frame& F, const Args& a) {
    unsigned char* ws = a.ws;
    const int seq = F.vcu >> 2, ig = F.vcu & 3;
    if (seq >= 64) return;
    const int z = seq >> 5, b = (seq >> 3) & 3, h = seq & 7;
    const size_t mb = (size_t)b * T;
    const int lane = F.lane, wave = F.wave, fr = lane & 15, fg = lane >> 4;
    constexpr int NCK = T / 16;
    volatile LAS unsigned* flg = (volatile LAS unsigned*)(F.lds + CS_FLAG);
    if (F.tid < 16) flg[F.tid] = 0u;
    __syncthreads();
    if (wave == 0) {
        float* yout = (float*)(ws + WS_Y) + (size_t)z * M * CW + h * 64 + ig * 16 + fr;
        f32x4 zacc[4];
#pragma unroll
        for (int mt = 0; mt < 4; ++mt) zacc[mt] = (f32x4){0.f, 0.f, 0.f, 0.f};
        const bf16x8 zero8 = {0, 0, 0, 0, 0, 0, 0, 0};
        const bool lo2 = fg < 2;
#pragma unroll 1
        for (int n = 0; n < NCK; ++n) {
            const int slot = n & (CS_R - 1);
            { unsigned sp = 0; while (flg[slot] != (unsigned)(n + 1)) { __builtin_amdgcn_s_sleep(1); if (++sp > (1u << 24)) break; } }
            __builtin_amdgcn_fence(__ATOMIC_ACQUIRE, "workgroup");
            const LAS unsigned char* sl = F.lds + slot * CS_SLOT;
            union { u32x4 w; bf16x8 h8; } zb0, zb1, ap0, ap1, rp0, rp1;
            zb0.w.x = cvt_pk_bf16(zacc[0][0], zacc[0][1]); zb0.w.y = cvt_pk_bf16(zacc[0][2], zacc[0][3]); zb0.w.z = cvt_pk_bf16(zacc[1][0], zacc[1][1]); zb0.w.w = cvt_pk_bf16(zacc[1][2], zacc[1][3]);
            zb1.w.x = cvt_pk_bf16(zacc[2][0], zacc[2][1]); zb1.w.y = cvt_pk_bf16(zacc[2][2], zacc[2][3]); zb1.w.z = cvt_pk_bf16(zacc[3][0], zacc[3][1]); zb1.w.w = cvt_pk_bf16(zacc[3][2], zacc[3][3]);
            { const LAS unsigned char* pa = sl + CS_AT + fr * (CS_LD * 2) + fg * 8; const LAS unsigned char* pr = sl + CS_RT + fr * (CS_LD * 2) + fg * 8;
              const u32x2 a00 = *(const LAS u32x2*)(pa), a01 = *(const LAS u32x2*)(pa + 32), a10 = *(const LAS u32x2*)(pa + 64), a11 = *(const LAS u32x2*)(pa + 96);
              const u32x2 r00 = *(const LAS u32x2*)(pr), r01 = *(const LAS u32x2*)(pr + 32), r10 = *(const LAS u32x2*)(pr + 64), r11 = *(const LAS u32x2*)(pr + 96);
              ap0.w = (u32x4){a00.x, a00.y, a01.x, a01.y}; ap1.w = (u32x4){a10.x, a10.y, a11.x, a11.y}; rp0.w = (u32x4){r00.x, r00.y, r01.x, r01.y}; rp1.w = (u32x4){r10.x, r10.y, r11.x, r11.y}; }
            const bf16x8 aak = lo2 ? *(const LAS bf16x8*)(sl + CS_AAK + fr * 32 + fg * 16) : zero8;
            const bf16x8 ark = lo2 ? *(const LAS bf16x8*)(sl + CS_ARK + fr * 32 + fg * 16) : zero8;
            const bf16x8 vb  = lo2 ? *(const LAS bf16x8*)(sl + CS_VT + fr * 32 + fg * 16) : zero8;
            union { u32x4 w; bf16x8 h8; } tp, arbp;
            { const u32x2 t2 = *(const LAS u32x2*)(sl + CS_TT + fr * 32 + fg * 8), r2 = *(const LAS u32x2*)(sl + CS_ARB + fr * 32 + fg * 8); tp.w = (u32x4){t2.x, t2.y, 0u, 0u}; arbp.w = (u32x4){r2.x, r2.y, 0u, 0u}; }
            f32x4 Wc = {0.f, 0.f, 0.f, 0.f};
            Wc = __builtin_amdgcn_mfma_f32_16x16x32_bf16(ap0.h8, zb0.h8, Wc, 0, 0, 0);
            Wc = __builtin_amdgcn_mfma_f32_16x16x32_bf16(ap1.h8, zb1.h8, Wc, 0, 0, 0);
            Wc = __builtin_amdgcn_mfma_f32_16x16x32_bf16(aak, vb, Wc, 0, 0, 0);
            union { u32x4 w; bf16x8 h8; } wb, ub;
            wb.w = (u32x4){cvt_pk_bf16(Wc[0], Wc[1]), cvt_pk_bf16(Wc[2], Wc[3]), 0u, 0u};
            f32x4 Uc = {0.f, 0.f, 0.f, 0.f};
            Uc = __builtin_amdgcn_mfma_f32_16x16x32_bf16(tp.h8, wb.h8, Uc, 0, 0, 0);
            ub.w = (u32x4){cvt_pk_bf16(Uc[0], Uc[1]), cvt_pk_bf16(Uc[2], Uc[3]), 0u, 0u};
            f32x4 Yc = {0.f, 0.f, 0.f, 0.f};
            Yc = __builtin_amdgcn_mfma_f32_16x16x32_bf16(rp0.h8, zb0.h8, Yc, 0, 0, 0);
            Yc = __builtin_amdgcn_mfma_f32_16x16x32_bf16(rp1.h8, zb1.h8, Yc, 0, 0, 0);
            Yc = __builtin_amdgcn_mfma_f32_16x16x32_bf16(ark, vb, Yc, 0, 0, 0);
            Yc = __builtin_amdgcn_mfma_f32_16x16x32_bf16(arbp.h8, ub.h8, Yc, 0, 0, 0);
#pragma unroll
            for (int mt = 0; mt < 4; ++mt) {
                const f32x4 pl = *(const LAS f32x4*)(sl + CS_PL + (16 * mt + 4 * fg) * 4);
                const bf16x8 kh = lo2 ? *(const LAS bf16x8*)(sl + CS_KHT + (16 * mt + fr) * 32 + fg * 16) : zero8;
                union { u32x4 w; bf16x8 h8; } bh; { const u32x2 b2 = *(const LAS u32x2*)(sl + CS_BHT + (16 * mt + fr) * 32 + fg * 8); bh.w = (u32x4){b2.x, b2.y, 0u, 0u}; }
                f32x4 zz = zacc[mt] * pl;
                zz = __builtin_amdgcn_mfma_f32_16x16x32_bf16(kh, vb, zz, 0, 0, 0);
                zz = __builtin_amdgcn_mfma_f32_16x16x32_bf16(bh.h8, ub.h8, zz, 0, 0, 0);
                zacc[mt] = zz;
            }
            __builtin_amdgcn_fence(__ATOMIC_RELEASE, "workgroup");
            if (lane == 0) flg[8] = (unsigned)(n + 1);
#pragma unroll
            for (int rr = 0; rr < 4; ++rr) { const int q = 16 * n + 4 * fg + rr, t = z ? (T - 1 - q) : q; yout[(mb + t) * CW] = Yc[rr]; }
        }
    } else {
        const int pi = wave - 1;
        LAS unsigned char* scr = F.lds + CS_SCR + pi * CS_SCRW;
        LAS bf16* KT = (LAS bf16*)scr; LAS bf16* BT = (LAS bf16*)(scr + 2304); LAS float* AABF = (LAS float*)(scr + 4608);
        const bf16* gw_ = (const bf16*)(ws + WS_DECAY) + (size_t)z * M * CW + h * 64 + lane;
        const bf16* gkk = (const bf16*)(ws + WS_KK) + h * 64 + lane;
        const bf16* gak = (const bf16*)(ws + WS_AKK) + (size_t)z * M * CW + h * 64 + lane;
        const bf16* gk = (const bf16*)(ws + WS_KDIR) + (size_t)z * M * CW + h * 64 + lane;
        const bf16* gr = (const bf16*)(ws + WS_R) + h * 64 + lane;
        const bf16* gv = (const bf16*)(ws + WS_V) + h * 64 + ig * 16 + fr;
        bf16 nw[16], nkk[16], nak[16], nk[16], nr[16], nv[4];
#define CS_FETCH(nn) do { if ((nn) < NCK) { _Pragma("unroll") for (int tt = 0; tt < 16; ++tt) { const int q_ = 16 * (nn) + tt; const size_t m_ = mb + (z ? (T - 1 - q_) : q_); \
            nw[tt] = gw_[m_ * CW]; nkk[tt] = gkk[m_ * CW]; nak[tt] = gak[m_ * CW]; nk[tt] = gk[m_ * CW]; nr[tt] = gr[m_ * CW]; } \
            _Pragma("unroll") for (int q4 = 0; q4 < 4; ++q4) { const int q_ = 16 * (nn) + fg + 4 * q4; const size_t m_ = mb + (z ? (T - 1 - q_) : q_); nv[q4] = gv[m_ * CW]; } } } while (0)
        CS_FETCH(pi);
#pragma unroll 1
        for (int n = pi; n < NCK; n += 7) {
            const int slot = n & (CS_R - 1);
            float wv[16], kkv[16], akv[16], kv[16], rv[16], vq[4];
#pragma unroll
            for (int tt = 0; tt < 16; ++tt) { unsigned x0 = nw[tt], x1 = nkk[tt], x2 = nak[tt], x3 = nk[tt], x4 = nr[tt];
                asm volatile("" : "+v"(x0), "+v"(x1), "+v"(x2), "+v"(x3), "+v"(x4));
                wv[tt] = __uint_as_float(x0 << 16); kkv[tt] = __uint_as_float(x1 << 16); akv[tt] = __uint_as_float(x2 << 16); kv[tt] = __uint_as_float(x3 << 16); rv[tt] = __uint_as_float(x4 << 16); }
#pragma unroll
            for (int q4 = 0; q4 < 4; ++q4) { unsigned x0 = nv[q4]; asm volatile("" : "+v"(x0)); vq[q4] = __uint_as_float(x0 << 16); }
            CS_FETCH(n + 7);
            { unsigned sp = 0; while ((int)flg[8] < n - (CS_R - 3)) { __builtin_amdgcn_s_sleep(2); if (++sp > (1u << 24)) break; } }
            __builtin_amdgcn_fence(__ATOMIC_ACQUIRE, "workgroup");
            LAS unsigned char* sl = F.lds + slot * CS_SLOT;
            float P[16];
            P[0] = wv[0];
#pragma unroll
            for (int tt = 1; tt < 16; ++tt) P[tt] = P[tt - 1] * wv[tt];
            const float PL = P[15];
            float khat[16], bhat[16];
#pragma unroll
            for (int tt = 0; tt < 16; ++tt) {
                const float pm1 = tt ? P[tt - 1] : 1.0f, inv = __builtin_amdgcn_rcpf(P[tt]);
                const float at = kkv[tt] * pm1, rt = rv[tt] * P[tt], kt = kv[tt] * inv, bt = -akv[tt] * inv;
                khat[tt] = kt * PL; bhat[tt] = bt * PL;
                *(LAS bf16*)(sl + CS_AT + (tt * CS_LD + lane) * 2) = f2bf(at); *(LAS bf16*)(sl + CS_RT + (tt * CS_LD + lane) * 2) = f2bf(rt);
                KT[tt * CS_LD + lane] = f2bf(kt); BT[tt * CS_LD + lane] = f2bf(bt);
            }
            { u32x4 o0, o1;
              o0.x = cvt_pk_bf16(khat[0], khat[1]); o0.y = cvt_pk_bf16(khat[2], khat[3]); o0.z = cvt_pk_bf16(khat[4], khat[5]); o0.w = cvt_pk_bf16(khat[6], khat[7]);
              o1.x = cvt_pk_bf16(khat[8], khat[9]); o1.y = cvt_pk_bf16(khat[10], khat[11]); o1.z = cvt_pk_bf16(khat[12], khat[13]); o1.w = cvt_pk_bf16(khat[14], khat[15]);
              *(LAS u32x4*)(sl + CS_KHT + lane * 32) = o0; *(LAS u32x4*)(sl + CS_KHT + lane * 32 + 16) = o1;
              o0.x = cvt_pk_bf16(bhat[0], bhat[1]); o0.y = cvt_pk_bf16(bhat[2], bhat[3]); o0.z = cvt_pk_bf16(bhat[4], bhat[5]); o0.w = cvt_pk_bf16(bhat[6], bhat[7]);
              o1.x = cvt_pk_bf16(bhat[8], bhat[9]); o1.y = cvt_pk_bf16(bhat[10], bhat[11]); o1.z = cvt_pk_bf16(bhat[12], bhat[13]); o1.w = cvt_pk_bf16(bhat[14], bhat[15]);
              *(LAS u32x4*)(sl + CS_BHT + lane * 32) = o0; *(LAS u32x4*)(sl + CS_BHT + lane * 32 + 16) = o1; }
            *(LAS float*)(sl + CS_PL + lane * 4) = PL;
#pragma unroll
            for (int q4 = 0; q4 < 4; ++q4) *(LAS bf16*)(sl + CS_VT + (fr * 16 + fg + 4 * q4) * 2) = f2bf(vq[q4]);
            asm volatile("s_waitcnt lgkmcnt(0)" ::: "memory");
            bf16x8 af[2], rf[2], kf[2], bf_[2];
#pragma unroll
            for (int ks = 0; ks < 2; ++ks) { af[ks] = *(const LAS bf16x8*)(sl + CS_AT + (fr * CS_LD + 32 * ks + 8 * fg) * 2); rf[ks] = *(const LAS bf16x8*)(sl + CS_RT + (fr * CS_LD + 32 * ks + 8 * fg) * 2);
                kf[ks] = *(const LAS bf16x8*)(KT + fr * CS_LD + 32 * ks + 8 * fg); bf_[ks] = *(const LAS bf16x8*)(BT + fr * CS_LD + 32 * ks + 8 * fg); }
            f32x4 Aab = {0.f, 0.f, 0.f, 0.f}, Aak = Aab, Arb = Aab, Ark = Aab;
#pragma unroll
            for (int ks = 0; ks < 2; ++ks) { Aab = __builtin_amdgcn_mfma_f32_16x16x32_bf16(af[ks], bf_[ks], Aab, 0, 0, 0); Aak = __builtin_amdgcn_mfma_f32_16x16x32_bf16(af[ks], kf[ks], Aak, 0, 0, 0);
                Arb = __builtin_amdgcn_mfma_f32_16x16x32_bf16(rf[ks], bf_[ks], Arb, 0, 0, 0); Ark = __builtin_amdgcn_mfma_f32_16x16x32_bf16(rf[ks], kf[ks], Ark, 0, 0, 0); }
#pragma unroll
            for (int rr = 0; rr < 4; ++rr) { const int t = 4 * fg + rr; const bool sl_ = fr < t, le_ = fr <= t;
                AABF[t * 16 + fr] = sl_ ? Aab[rr] : 0.f;
                *(LAS bf16*)(sl + CS_AAK + (t * 16 + fr) * 2) = f2bf(sl_ ? Aak[rr] : 0.f);
                *(LAS bf16*)(sl + CS_ARK + (t * 16 + fr) * 2) = f2bf(le_ ? Ark[rr] : 0.f);
                *(LAS bf16*)(sl + CS_ARB + (t * 16 + fr) * 2) = f2bf(le_ ? Arb[rr] : 0.f); }
            asm volatile("s_waitcnt lgkmcnt(0)" ::: "memory");
            float Tc[16];
#pragma unroll
            for (int t = 0; t < 16; ++t) {
                float acc = (t == fr) ? 1.0f : 0.f;
                const f32x4 r0 = *(const LAS f32x4*)(AABF + t * 16), r1 = *(const LAS f32x4*)(AABF + t * 16 + 4), r2 = *(const LAS f32x4*)(AABF + t * 16 + 8), r3 = *(const LAS f32x4*)(AABF + t * 16 + 12);
                const float rowv[16] = {r0.x, r0.y, r0.z, r0.w, r1.x, r1.y, r1.z, r1.w, r2.x, r2.y, r2.z, r2.w, r3.x, r3.y, r3.z, r3.w};
#pragma unroll
                for (int uu = 0; uu < 16; ++uu) if (uu < t) acc += rowv[uu] * Tc[uu];
                Tc[t] = acc;
            }
            if (fg == 0) {
#pragma unroll
                for (int t = 0; t < 16; ++t) *(LAS bf16*)(sl + CS_TT + (t * 16 + fr) * 2) = f2bf(Tc[t]);
            }
            asm volatile("s_waitcnt lgkmcnt(0)" ::: "memory");
            __builtin_amdgcn_fence(__ATOMIC_RELEASE, "workgroup");
            if (lane == 0) flg[slot] = (unsigned)(n + 1);
        }
#undef CS_FETCH
    }
    __syncthreads();
}

__device__ __forceinline__ void combine_phase(const Frame& F, const Args& a) {
    unsigned char* ws = a.ws;
    const bf16* att = (const bf16*)(ws + WS_ATT); const bf16* rr = (const bf16*)(ws + WS_R); const bf16* vv = (const bf16*)(ws + WS_V);
    const bf16* kd = (const bf16*)(ws + WS_KDIR); const bf16* gg = (const bf16*)(ws + WS_G); const float* y = (const float*)(ws + WS_Y);
    bf16* mix = (bf16*)(ws + WS_MIX);
    const float* anw = a.in[4]; const float* r_k = a.in[14]; const float* ln_w = a.in[15]; const float* ln_b = a.in[16];
    const int lane = F.lane, c0 = 8 * lane;
    float nw[8], rk[8], lw[8], lb[8];
#pragma unroll
    for (int i = 0; i < 8; ++i) { nw[i] = anw[c0 + i]; rk[i] = r_k[c0 + i]; lw[i] = ln_w[c0 + i]; lb[i] = ln_b[c0 + i]; }
    const int gw = F.vcu * 8 + F.wave, NGW = F.G * 8;
#pragma unroll 2
    for (int m = gw; m < M; m += NGW) {
        const size_t o = (size_t)m * CW + c0;
        float f[8];
        unpack8(*(const u32x4*)(att + o), f);
        float ss = 0.f;
#pragma unroll
        for (int i = 0; i < 8; ++i) ss += f[i] * f[i];
        const float rs = rsqrtf(wave_sum(ss) * (1.f / CW) + RMS_EPS);
#pragma unroll
        for (int i = 0; i < 8; ++i) f[i] = f[i] * rs * nw[i];
        *(u32x4*)(mix + (size_t)m * D + c0) = pack8(f);
        const f32x4 y0a = *(const f32x4*)(y + o), y0b = *(const f32x4*)(y + o + 4), y1a = *(const f32x4*)(y + (size_t)M * CW + o), y1b = *(const f32x4*)(y + (size_t)M * CW + o + 4);
        float yv[8] = {y0a.x + y1a.x, y0a.y + y1a.y, y0a.z + y1a.z, y0a.w + y1a.w, y0b.x + y1b.x, y0b.y + y1b.y, y0b.z + y1b.z, y0b.w + y1b.w};
        float s1 = 0.f;
#pragma unroll
        for (int i = 0; i < 8; ++i) s1 += yv[i];
        s1 += __shfl_xor(s1, 1); s1 += __shfl_xor(s1, 2); s1 += __shfl_xor(s1, 4);
        const float mean = s1 * (1.f / 64.f);
        float s2 = 0.f;
#pragma unroll
        for (int i = 0; i < 8; ++i) { yv[i] -= mean; s2 += yv[i] * yv[i]; }
        s2 += __shfl_xor(s2, 1); s2 += __shfl_xor(s2, 2); s2 += __shfl_xor(s2, 4);
        const float rstd = rsqrtf(s2 * (1.f / 64.f) + GN_EPS);
        float rf[8], k0[8], k1[8], vf[8], gf[8];
        unpack8(*(const u32x4*)(rr + o), rf); unpack8(*(const u32x4*)(kd + o), k0); unpack8(*(const u32x4*)(kd + (size_t)M * CW + o), k1);
        unpack8(*(const u32x4*)(vv + o), vf); unpack8(*(const u32x4*)(gg + o), gf);
        float cf = 0.f;
#pragma unroll
        for (int i = 0; i < 8; ++i) cf += rf[i] * (k0[i] + k1[i]) * rk[i];
        cf += __shfl_xor(cf, 1); cf += __shfl_xor(cf, 2); cf += __shfl_xor(cf, 4);
#pragma unroll
        for (int i = 0; i < 8; ++i) f[i] = (yv[i] * rstd * lw[i] + lb[i] + cf * vf[i]) * gf[i];
        *(u32x4*)(mix + (size_t)m * D + CW + c0) = pack8(f);
    }
}

constexpr int RT_W = 0, RT_HIST = 131072, RT_LOG = 131072 + 256;
__device__ __forceinline__ void router_phase(const Frame& F, const Args& a) {
    unsigned char* ws = a.ws;
    const float* hbuf = (const float*)(ws + WS_H); bf16* hn2 = (bf16*)(ws + WS_HN2);
    int* eidx = (int*)(ws + WS_EIDX); float* gate = (float*)(ws + WS_GATE); int* rank = (int*)(ws + WS_RANK);
    unsigned* ctl = (unsigned*)(ws + WS_CTL);
    const float* n2w = a.in[18]; const float* rw = a.in[19]; const float* rb = a.in[20];
    LAS float* wT = (LAS float*)(F.lds + RT_W); LAS int* hist = (LAS int*)(F.lds + RT_HIST); LAS float* lg = (LAS float*)(F.lds + RT_LOG) + F.wave * 64; LAS int* eL = (LAS int*)(F.lds + RT_LOG + 2048);
    { f32x4 tmp[16];
#pragma unroll
      for (int j = 0; j < 16; ++j) tmp[j] = *((const f32x4*)rw + F.tid + 512 * j);
#pragma unroll
      for (int j = 0; j < 16; ++j) { const int q = F.tid + 512 * j, d = q >> 3, e0 = 4 * (q & 7);
          wT[(e0 + 0) * 1024 + d] = tmp[j].x; wT[(e0 + 1) * 1024 + d] = tmp[j].y; wT[(e0 + 2) * 1024 + d] = tmp[j].z; wT[(e0 + 3) * 1024 + d] = tmp[j].w; } }
    if (F.tid < 32) hist[F.tid] = 0;
    __syncthreads();
    const int lane = F.lane;
    f32x4 wn[4];
#pragma unroll
    for (int j = 0; j < 4; ++j) wn[j] = *((const f32x4*)n2w + lane + 64 * j);
    const int blk = F.vcu;
    for (int pr = 0; pr < 8; ++pr) {
        const int m0 = blk * 128 + F.wave * 16 + pr * 2;
        f32x4 xv[2][4];
#pragma unroll
        for (int tk = 0; tk < 2; ++tk) {
            const f32x4* hr = (const f32x4*)(hbuf + (size_t)(m0 + tk) * D) + lane;
            float s = 0.f;
#pragma unroll
            for (int j = 0; j < 4; ++j) { xv[tk][j] = hr[64 * j]; s += (xv[tk][j].x * xv[tk][j].x + xv[tk][j].y * xv[tk][j].y) + (xv[tk][j].z * xv[tk][j].z + xv[tk][j].w * xv[tk][j].w); }
            const float rs = rsqrtf(wave_sum(s) * (1.f / D) + RMS_EPS);
            u32x2* o8 = (u32x2*)(hn2 + (size_t)(m0 + tk) * D) + lane;
#pragma unroll
            for (int j = 0; j < 4; ++j) { xv[tk][j] = xv[tk][j] * rs * wn[j]; u32x2 o; o.x = cvt_pk_bf16(xv[tk][j].x, xv[tk][j].y); o.y = cvt_pk_bf16(xv[tk][j].z, xv[tk][j].w); o8[64 * j] = o; }
        }
        float kA0 = 0.f, kB0 = 0.f, kA1 = 0.f, kB1 = 0.f;
#pragma unroll 4
        for (int e = 0; e < 32; ++e) {
            float p0 = 0.f, p1 = 0.f;
#pragma unroll
            for (int j = 0; j < 4; ++j) { const f32x4 w4 = *(const LAS f32x4*)(wT + e * 1024 + 256 * j + 4 * lane);
                p0 += (w4.x * xv[0][j].x + w4.y * xv[0][j].y) + (w4.z * xv[0][j].z + w4.w * xv[0][j].w);
                p1 += (w4.x * xv[1][j].x + w4.y * xv[1][j].y) + (w4.z * xv[1][j].z + w4.w * xv[1][j].w); }
            p0 = row16_sum(p0); p1 = row16_sum(p1);
            const bool me = (lane & 15) == (e & 15);
            if (e < 16) { kA0 = me ? p0 : kA0; kA1 = me ? p1 : kA1; } else { kB0 = me ? p0 : kB0; kB1 = me ? p1 : kB1; }
        }
        kA0 += __shfl_xor(kA0, 16); kA0 += __shfl_xor(kA0, 32); kB0 += __shfl_xor(kB0, 16); kB0 += __shfl_xor(kB0, 32);
        kA1 += __shfl_xor(kA1, 16); kA1 += __shfl_xor(kA1, 32); kB1 += __shfl_xor(kB1, 16); kB1 += __shfl_xor(kB1, 32);
        if (lane < 32) { const int tk = lane >> 4, el = lane & 15; lg[tk * 32 + el] = (tk ? kA1 : kA0) + rb[el]; lg[tk * 32 + 16 + el] = (tk ? kB1 : kB0) + rb[16 + el]; }
        asm volatile("s_waitcnt lgkmcnt(0)" ::: "memory");
        if (lane < 2) {
            const LAS float* L = lg + lane * 32; const int m = m0 + lane;
            float v[32];
#pragma unroll
            for (int e = 0; e < 32; ++e) v[e] = L[e];
            float tv[4]; int ti[4];
#pragma unroll
            for (int kx = 0; kx < 4; ++kx) { float best = -3.0e38f; int bi = 0;
#pragma unroll
                for (int e = 0; e < 32; ++e) { if (v[e] > best) { best = v[e]; bi = e; } }
                tv[kx] = best; ti[kx] = bi;
#pragma unroll
                for (int e = 0; e < 32; ++e) { if (e == bi) v[e] = -3.0e38f; } }
            const float e0 = 1.0f, e1 = __expf(tv[1] - tv[0]), e2 = __expf(tv[2] - tv[0]), e3 = __expf(tv[3] - tv[0]);
            const float is = 1.0f / (e0 + e1 + e2 + e3);
            const float gs[4] = {e0 * is, e1 * is, e2 * is, e3 * is};
#pragma unroll
            for (int kx = 0; kx < 4; ++kx) { eidx[m * 4 + kx] = ti[kx]; gate[m * 4 + kx] = gs[kx]; eL[(m - blk * 128) * 4 + kx] = ti[kx]; }
        }
        asm volatile("s_waitcnt lgkmcnt(0)" ::: "memory");
    }
    __syncthreads();
    { const int t = F.tid, e = eL[t]; int rk = 0;
      for (int u = 0; u < t; ++u) rk += (eL[u] == e) ? 1 : 0;
      rank[(blk * 128) * 4 + t] = rk;
      __hip_atomic_fetch_add(&hist[e], 1, __ATOMIC_RELAXED, __HIP_MEMORY_SCOPE_WORKGROUP); }
    __syncthreads();
    if (F.tid < 32) ctl[CW_CNT + blk * 32 + F.tid] = (unsigned)hist[F.tid];
}

__device__ __forceinline__ void dispatch_phase(const Frame& F, const Args& a) {
    unsigned char* ws = a.ws;
    unsigned* ctl = (unsigned*)(ws + WS_CTL);
    const int* eidx = (const int*)(ws + WS_EIDX); const int* rank = (const int*)(ws + WS_RANK); int* dest = (int*)(ws + WS_DEST);
    LAS int* part = (LAS int*)F.lds;
    LAS int* tot = part + 1024;
    const int blk = F.vcu, G = F.G;
    { const int e = F.tid & 31, pt = F.tid >> 5; int s = 0, sb = 0;
      if (G == 256) { int cv[16];
#pragma unroll
          for (int q = 0; q < 16; ++q) cv[q] = (int)ld_u32_agent(ctl + CW_CNT + (pt + 16 * q) * 32 + e);
#pragma unroll
          for (int q = 0; q < 16; ++q) { s += cv[q]; if (pt + 16 * q < blk) sb += cv[q]; } }
      else for (int bb = pt; bb < G; bb += 16) { const int cval = (int)ld_u32_agent(ctl + CW_CNT + bb * 32 + e); s += cval; if (bb < blk) sb += cval; }
      part[pt * 32 + e] = s; part[512 + pt * 32 + e] = sb; }
    __syncthreads();
    if (F.tid < 32) { int s = 0, sb = 0;
        for (int pt = 0; pt < 16; ++pt) { s += part[pt * 32 + F.tid]; sb += part[512 + pt * 32 + F.tid]; }
        tot[F.tid] = s; tot[32 + F.tid] = sb; tot[96 + F.tid] = (s + 255) & ~255; }
    __syncthreads();
    if (F.tid == 0) { int ps = 0; for (int e = 0; e < 32; ++e) { tot[64 + e] = ps; ps += tot[96 + e]; }
        tot[128] = ps >> 8; }
    __syncthreads();
    if (blk == 0) {
        if (F.tid == 0) ctl[CW_NT] = (unsigned)tot[128];
        for (int e = F.tid >> 4; e < 32; e += 32) { const int t0 = tot[64 + e] >> 8, nt = tot[96 + e] >> 8; for (int i = F.tid & 15; i < nt; i += 16) ctl[CW_TEXP + t0 + i] = (unsigned)e; }
    }
    const int lane = F.lane;
    const int mw = blk * 128 + F.wave * 16;
    int* rowtok = (int*)(ws + WS_ROWTOK);
    { const int e = eidx[mw * 4 + lane]; const int dl = tot[64 + e] + tot[32 + e] + rank[mw * 4 + lane]; dest[mw * 4 + lane] = dl; rowtok[dl] = mw + (lane >> 2); }
    { const int e = blk & 31, pt = blk >> 5, np = G >> 5; const int r0 = tot[64 + e] + tot[e], r1 = tot[64 + e] + tot[96 + e];
      if (np > 0) for (int r = r0 + pt * 512 + F.tid; r < r1; r += np * 512) rowtok[r] = 0; }
}

__device__ __forceinline__ void final_phase(const Frame& F, const Args& a) {
    unsigned char* ws = a.ws;
    const float* hbuf = (const float*)(ws + WS_H); const bf16* ybuf = (const bf16*)(ws + WS_YBUF);
    const int* dest = (const int*)(ws + WS_DEST); const float* gate = (const float*)(ws + WS_GATE);
    const float* fw = a.in[25]; float* out = a.out;
    const int lane = F.lane;
    f32x4 wn[4];
#pragma unroll
    for (int j = 0; j < 4; ++j) wn[j] = *((const f32x4*)fw + lane + 64 * j);
    const int gw = F.vcu * 8 + F.wave, NGW = F.G * 8;
    const int per = M / NGW;
    const int mw = gw * per;
    int dl = 0; float gl = 0.f;
    if (lane < 4 * per && per <= 16) { dl = dest[mw * 4 + lane]; gl = gate[mw * 4 + lane]; }
#pragma unroll 2
    for (int i = 0; i < per; ++i) {
        const int m = mw + i;
        const f32x4* hr = (const f32x4*)(hbuf + (size_t)m * D) + lane;
        f32x4 v[4];
#pragma unroll
        for (int j = 0; j < 4; ++j) v[j] = hr[64 * j];
#pragma unroll
        for (int kx = 0; kx < 4; ++kx) {
            const int d = per <= 16 ? __shfl(dl, 4 * i + kx) : dest[m * 4 + kx]; const float gt = per <= 16 ? __shfl(gl, 4 * i + kx) : gate[m * 4 + kx];
            const u32x2* yr = (const u32x2*)(ybuf + (size_t)d * D) + lane;
#pragma unroll
            for (int j = 0; j < 4; ++j) { const u32x2 w = yr[64 * j]; v[j].x += gt * bflo(w.x); v[j].y += gt * bfhi(w.x); v[j].z += gt * bflo(w.y); v[j].w += gt * bfhi(w.y); }
        }
        float s = 0.f;
#pragma unroll
        for (int j = 0; j < 4; ++j) s += (v[j].x * v[j].x + v[j].y * v[j].y) + (v[j].z * v[j].z + v[j].w * v[j].w);
        const float rs = rsqrtf(wave_sum(s) * (1.f / D) + RMS_EPS);
        f32x4* orow = (f32x4*)(out + (size_t)m * D) + lane;
#pragma unroll
        for (int j = 0; j < 4; ++j) orow[64 * j] = v[j] * rs * wn[j];
    }
}

__global__ void __launch_bounds__(512, 2) fwd_megakernel(Args args) {
    extern __shared__ __attribute__((aligned(16))) unsigned char lds_raw[];
    Frame F;
    F.lds = (LAS unsigned char*)lds_raw;
    F.tid = threadIdx.x; F.lane = F.tid & 63; F.wave = __builtin_amdgcn_readfirstlane(F.tid >> 6);
    F.G = gridDim.x; { const int bx = blockIdx.x; F.vcu = (F.G % 8 == 0) ? (bx % 8) * (F.G / 8) + bx / 8 : bx; }
    unsigned char* ws = args.ws;
    const int lo = args.ph_lo, hi = args.ph_hi;
#define IN(k) (lo <= (k) && (k) < hi)
#if MK_SPLIT
#define SEAM(k) do { } while (0)
#else
    cg::grid_group grid = cg::this_grid();
    { volatile LAS unsigned* st = (volatile LAS unsigned*)(F.lds + LDS_MISC); if (F.tid < 2) st[F.tid] = 0u; __syncthreads(); }
    const XcdBarrier xbar = xcd_barrier_post((unsigned*)(ws + WS_CTL) + CW_BAR, (volatile LAS unsigned*)(F.lds + LDS_MISC));
    if (lo < 0) grid.sync();
#define SEAM(k) do { if (IN(k) && IN((k) + 1)) xcd_barrier(xbar); } while (0)
#endif
#define REP2(k) if constexpr (((MK_REPEAT >> (k)) & 1) != 0)
#define PH1 { pg8::Gemm g{(const bf16*)(ws + WS_HN), (const bf16*)(ws + WS_WINT), 1024, nullptr, 0, nullptr}; \
        pg8::StaticOrder S; S.init(M / 256, NPROJ_PAD / 256, F.G, (int)blockIdx.x); \
        pg8::EpiProj E{(bf16*)(ws + WS_Q), (bf16*)(ws + WS_K), (bf16*)(ws + WS_VT), (bf16*)(ws + WS_P)}; \
        pg8::gemm_phase<pg8::EpiProj, true, true>(F.lds, g, S, E); }
#define PH5 { pg8::Gemm g{(const bf16*)(ws + WS_MIX), (const bf16*)(ws + WS_WOT), 1024, nullptr, 0, nullptr}; \
        pg8::StaticOrder S; S.init(M / 256, D / 256, F.G, (int)blockIdx.x); \
        pg8::EpiWo E{args.in[0], (float*)(ws + WS_H)}; \
        pg8::gemm_phase<pg8::EpiWo, true, true>(F.lds, g, S, E); }
#define PH8 { const unsigned* ctl = (const unsigned*)(ws + WS_CTL); const int ntile = (int)ld_u32_agent(ctl + CW_NT); \
        pg8::Gemm g{(const bf16*)(ws + WS_HN2), (const bf16*)(ws + WS_WUPT), 1024, ctl + CW_TEXP, (size_t)2048 * 1024 * 2, (const int*)(ws + WS_ROWTOK)}; \
        pg8::StaticOrder S; S.init(ntile, 8, F.G, (int)blockIdx.x); \
        pg8::EpiUp E{args.in[22], (bf16*)(ws + WS_ACT)}; \
        pg8::gemm_phase<pg8::EpiUp, true, true, true>(F.lds, g, S, E); }
#define PH9 { const unsigned* ctl = (const unsigned*)(ws + WS_CTL); const int ntile = (int)ld_u32_agent(ctl + CW_NT); \
        pg8::Gemm g{(const bf16*)(ws + WS_ACT), (const bf16*)(ws + WS_WDNT), 1024, ctl + CW_TEXP, (size_t)1024 * 1024 * 2, nullptr}; \
        pg8::StaticOrder S; S.init(ntile, 4, F.G, (int)blockIdx.x); \
        pg8::EpiDown E{args.in[24], (bf16*)(ws + WS_YBUF)}; \
        pg8::gemm_phase<pg8::EpiDown, true, true>(F.lds, g, S, E); }
    if (IN(0)) { p0_prologue(F, args); REP2(0) p0_prologue(F, args); }
    SEAM(0);
    if (IN(1)) { PH1 REP2(1) PH1 }
    SEAM(1);
    if (IN(2)) { prep_phase<true>(F, args); REP2(2) prep_phase<true>(F, args); attn_phase(F, args); REP2(11) attn_phase(F, args); }
    SEAM(2);
    if (IN(3)) { scan_phase(F, args); REP2(3) scan_phase(F, args); }
    SEAM(3);
    if (IN(4)) { combine_phase(F, args); REP2(4) combine_phase(F, args); }
    SEAM(4);
    if (IN(5)) { PH5 REP2(5) PH5 }
    SEAM(5);
    if (IN(6)) { router_phase(F, args); REP2(6) { __syncthreads(); router_phase(F, args); } }
    SEAM(6);
    if (IN(7)) { dispatch_phase(F, args); REP2(7) { __syncthreads(); dispatch_phase(F, args); } }
    SEAM(7);
    if (IN(8)) { PH8 REP2(8) PH8 }
    SEAM(8);
    if (IN(9)) { PH9 REP2(9) PH9 }
    SEAM(9);
    if (IN(10)) { final_phase(F, args); REP2(10) final_phase(F, args); }
#undef IN
#undef SEAM
}

extern "C" void kernel_launch(void* const* d_in, const int* in_sizes, int n_in, void* d_out, int out_size, void* d_ws, size_t ws_size, hipStream_t stream) {
    static int grid = 0;
    if (grid == 0) {
        if (n_in != 26 || in_sizes[0] != M * D || out_size != M * D || ws_size < WS_END) { fprintf(stderr, "kernel_launch: unexpected problem (n_in %d, in0 %d, out %d, ws %zu)\n", n_in, n_in > 0 ? in_sizes[0] : -1, out_size, ws_size); grid = -1; return; }
        int dev = 0, cus = 0, per_cu = 0;
        if (hipGetDevice(&dev) != hipSuccess || hipDeviceGetAttribute(&cus, hipDeviceAttributeMultiprocessorCount, dev) != hipSuccess) { grid = -1; return; }
        if (hipFuncSetAttribute((const void*)fwd_megakernel, hipFuncAttributeMaxDynamicSharedMemorySize, LDS_BYTES) != hipSuccess) { fprintf(stderr, "kernel_launch: hipFuncSetAttribute failed\n"); grid = -1; return; }
        if (hipOccupancyMaxActiveBlocksPerMultiprocessor(&per_cu, (const void*)fwd_megakernel, 512, LDS_BYTES) != hipSuccess || per_cu < 1) { fprintf(stderr, "kernel_launch: occupancy query says %d\n", per_cu); per_cu = 1; }
        (void)hipGetLastError();
        grid = cus * 1;
        if (grid != 256) fprintf(stderr, "kernel_launch: note: %d CUs\n", cus);
    }
    if (grid < 0) return;
    if (hipMemsetAsync((char*)d_ws + WS_CTL + (size_t)CW_BAR * 4, 0, XCD_BAR_WORDS * 4, stream) != hipSuccess) { fprintf(stderr, "kernel_launch: memset failed\n"); return; }
    Args a{};
    for (int i = 0; i < 26; ++i) a.in[i] = (const float*)d_in[i];
    a.out = (float*)d_out; a.ws = (unsigned char*)d_ws;
#if MK_SPLIT
    for (int ph = 0; ph < NPHASE; ++ph) { a.ph_lo = ph; a.ph_hi = ph + 1; hipLaunchKernelGGL(fwd_megakernel, dim3(grid), dim3(512), LDS_BYTES, stream, a); }
#else
    a.ph_lo = 0; a.ph_hi = NPHASE;
    void* kargs[] = {&a};
    hipError_t e = hipLaunchCooperativeKernel((const void*)fwd_megakernel, dim3(grid), dim3(512), kargs, LDS_BYTES, stream);
    if (e != hipSuccess) fprintf(stderr, "kernel_launch: cooperative launch failed: %s (grid %d)\n", hipGetErrorString(e), grid);
#endif
}
```

```cpp
#include <hip/hip_runtime.h>
#include <hip/hip_cooperative_groups.h>
#include <cstdio>
#include <cstdint>
namespace cg = cooperative_groups;

#ifndef MK_SPLIT
#define MK_SPLIT 0
#endif

#ifndef MK_REPEAT
#define MK_REPEAT 0
#endif
#define LAS __attribute__((address_space(3)))
typedef unsigned short bf16;
typedef float f32x4 __attribute__((ext_vector_type(4)));
typedef float f32x2 __attribute__((ext_vector_type(2)));
typedef unsigned u32x4 __attribute__((ext_vector_type(4)));
typedef unsigned u32x2 __attribute__((ext_vector_type(2)));
typedef short bf16x8 __attribute__((ext_vector_type(8)));

constexpr int BATCH = 4, T = 8192, D = 1024, M = BATCH * T;
constexpr int NH = 8, HD = 64, CW = 512;
constexpr int SHIFT_W = 1920, NPROJ = 3456, NPROJ_PAD = 3584, PW = 2048;
constexpr int NE = 32, TOPK = 4, DE = 1024;
constexpr int GRIDW = 64, GROWS = 128;
constexpr int P_TILES_MAX = 544, P_ROWS = P_TILES_MAX * 256;
constexpr float RMS_EPS = 1e-5f, GN_EPS = 64e-5f;
constexpr int NPHASE = 11;

constexpr size_t MiB = 1u << 20;
constexpr size_t WS_CTL = 0;
constexpr size_t WS_W2T = 1 * MiB, WS_A2T = WS_W2T + 131072, WS_G2T = WS_A2T + 131072;
constexpr size_t WS_WINT = 2 * MiB, WS_WOT = 9 * MiB, WS_WUPT = 12 * MiB, WS_WDNT = 140 * MiB;
constexpr size_t WS_EIDX = 204 * MiB, WS_GATE = WS_EIDX + 524288, WS_RANK = WS_GATE + 524288, WS_DEST = WS_RANK + 524288, WS_ROWTOK = WS_DEST + 524288;
constexpr size_t WS_R = 208 * MiB, WS_V = 240 * MiB, WS_KK = 272 * MiB, WS_DECAY = 304 * MiB, WS_KDIR = 368 * MiB, WS_AKK = 432 * MiB,
                 WS_G = 496 * MiB, WS_ATT = 528 * MiB;
constexpr size_t WS_Q = 560 * MiB, WS_K = 592 * MiB, WS_VT = 624 * MiB, WS_P = 656 * MiB, WS_HN = 784 * MiB, WS_Y = 848 * MiB;
constexpr size_t WS_MIX = 560 * MiB, WS_H = 752 * MiB, WS_HN2 = 880 * MiB, WS_XBUF = 208 * MiB, WS_ACT = 480 * MiB, WS_YBUF = 208 * MiB;
constexpr size_t WS_END = 976 * MiB;
constexpr int CW_NT = 0, CW_TEXP = 64, CW_CNT = 1024, CW_BAR = 16384;

constexpr int LDS_BYTES = 159744, LDS_MISC = LDS_BYTES - 256;

typedef __bf16 bf16x2_t __attribute__((ext_vector_type(2)));
__device__ __forceinline__ unsigned cvt_pk_bf16(float lo, float hi) { const f32x2 v = {lo, hi}; return __builtin_bit_cast(unsigned, __builtin_convertvector(v, bf16x2_t)); }
typedef int i32x8 __attribute__((ext_vector_type(8)));
typedef int i32x4 __attribute__((ext_vector_type(4)));
#ifndef F8_SCALE1
#define F8_SCALE1 0
#endif
constexpr float F8_SX = 32.0f, F8_SW = 128.0f, F8_SACT = 8.0f;
__device__ __forceinline__ float f8clamp(float v) { return __builtin_amdgcn_fmed3f(v, -448.0f, 448.0f); }
__device__ __forceinline__ unsigned pk4_fp8(float a, float b, float c, float d) { int w = 0; w = __builtin_amdgcn_cvt_pk_fp8_f32(f8clamp(a), f8clamp(b), w, false); w = __builtin_amdgcn_cvt_pk_fp8_f32(f8clamp(c), f8clamp(d), w, true); return (unsigned)w; }
__device__ __forceinline__ float bflo(unsigned u) { return __uint_as_float(u << 16); }
__device__ __forceinline__ float bfhi(unsigned u) { return __uint_as_float(u & 0xffff0000u); }
__device__ __forceinline__ float bf1(bf16 v) { return __uint_as_float(((unsigned)v) << 16); }
__device__ __forceinline__ void unpack8(const u32x4 u, float* f) { f[0] = bflo(u.x); f[1] = bfhi(u.x); f[2] = bflo(u.y); f[3] = bfhi(u.y); f[4] = bflo(u.z); f[5] = bfhi(u.z); f[6] = bflo(u.w); f[7] = bfhi(u.w); }
__device__ __forceinline__ u32x4 pack8(const float* f) { u32x4 o; o.x = cvt_pk_bf16(f[0], f[1]); o.y = cvt_pk_bf16(f[2], f[3]); o.z = cvt_pk_bf16(f[4], f[5]); o.w = cvt_pk_bf16(f[6], f[7]); return o; }
__device__ __forceinline__ float wave_sum(float v) {
#pragma unroll
    for (int o = 1; o < 64; o <<= 1) v += __shfl_xor(v, o);
    return v;
}
__device__ __forceinline__ float sigmoidf_(float x) { return __builtin_amdgcn_rcpf(1.0f + __expf(-x)); }
__device__ __forceinline__ unsigned ld_u32_agent(const unsigned* p) { return __hip_atomic_load(p, __ATOMIC_RELAXED, __HIP_MEMORY_SCOPE_AGENT); }

namespace pg8 {
constexpr int BM = 256, BK = 64, HALF = 128, HTB = HALF * BK * 2, STAGE_BYTES = 8 * HTB, NXCD = 8, WGM = 8;
__host__ __device__ __forceinline__ int lds_byte(int r, int c) { const int st = (r >> 4) * 2 + (c >> 5), rr = r & 15, cc = c & 31, ob = rr * 64 + cc * 2; return st * 1024 + (ob ^ (((ob >> 9) & 1) << 5)); }
__host__ __device__ __forceinline__ void stage_rc(int b, int& R, int& C) { const int st = b / 1024, sb = b % 1024, swz = sb ^ (((sb >> 9) & 1) << 5); R = (st >> 1) * 16 + swz / 64; C = (st & 1) * 32 + (swz % 64) / 2; }
__host__ __device__ __forceinline__ int perm32(int rho) { const int n = rho >> 4, i = rho & 15; return 8 * (i >> 2) + 4 * n + (i & 3); }

struct Unit { int pm, pn, e; };
struct Gemm { const bf16* A; const bf16* Bt; int K; const unsigned* texp; size_t bstride; const int* rowtok; };

struct StaticOrder {
    int nM, nN, nwg, G, c;
    __device__ void init(int nM_, int nN_, int G_, int c_) { nM = nM_; nN = nN_; nwg = nM * nN; G = G_; c = c_; }
    __device__ bool next(int i, Unit& u) const {
        const long L = (long)i * G + c; if (L >= nwg) return false;
        int wgid = (int)L; { const int q = nwg / NXCD, r = nwg % NXCD, xcd = wgid % NXCD, off = wgid / NXCD; wgid = (xcd < r ? xcd * (q + 1) : r * (q + 1) + (xcd - r) * q) + off; }
        const int nig = WGM * nN, gid = wgid / nig, fm = gid * WGM, gsz = (nM - fm) < WGM ? (nM - fm) : WGM;
        u.pm = fm + ((wgid % nig) % gsz); u.pn = (wgid % nig) / gsz; u.e = 0; return true;
    }
};

__device__ __forceinline__ i32x8 cat8(const bf16x8 lo, const bf16x8 hi) { return __builtin_shufflevector(__builtin_bit_cast(i32x4, lo), __builtin_bit_cast(i32x4, hi), 0, 1, 2, 3, 4, 5, 6, 7); }
template <class Epi, bool ALIGN_EPI, bool SP2, bool GATHER = false, bool FP8 = false>
__device__ __forceinline__ void gemm_phase(LAS unsigned char* lds, const Gemm g, const StaticOrder& S, const Epi& E) {
    const int tid = threadIdx.x, wid = __builtin_amdgcn_readfirstlane(tid >> 6), lane = tid & 63, wr = wid >> 2, wc = wid & 3, fr = lane & 15, fq = lane >> 4;
    const int K = g.K, nt = K / BK;
    unsigned voffA[2], voffB[2];
#pragma unroll
    for (int i = 0; i < 2; ++i) { int R, C; stage_rc(tid * 16 + i * 8192, R, C); const int Rb = Epi::PERM ? ((R & ~31) + perm32(R & 31)) : R;
        voffA[i] = (unsigned)(R * K + C) * 2u; voffB[i] = (unsigned)(Rb * K + C) * 2u; }
    unsigned vC[2][2];
#define PG8_GROWS(u, dst) do { _Pragma("unroll") for (int h_ = 0; h_ < 2; ++h_) _Pragma("unroll") for (int i_ = 0; i_ < 2; ++i_) { int R_, C_; stage_rc(tid * 16 + i_ * 8192, R_, C_); \
        dst[h_][i_] = (unsigned)g.rowtok[(u).pm * BM + h_ * HALF + R_] * (unsigned)(K * 2) + (unsigned)(C_ * 2); } } while (0)
    const size_t kstep = (size_t)(BK * 2);
    const size_t hstep = (size_t)HALF * K * 2;
    const size_t tstep = 2 * hstep;
    const unsigned ldsw = (unsigned)wid * 1024u;
    const int aoff = lds_byte(wr * 64 + fr, fq * 8), boff = lds_byte(wc * 32 + fr, fq * 8);
#define PG8_SA(b, h) (((b) * 2 + (h)) * HTB)
#define PG8_SB(b, h) ((4 + (b) * 2 + (h)) * HTB)
#define PG8_STAGE(bufoff, gbase, voff) do { _Pragma("unroll") for (int _i = 0; _i < 2; ++_i) \
        __builtin_amdgcn_global_load_lds((const unsigned*)((const char*)(gbase) + (voff)[_i]), (LAS unsigned*)(lds + (bufoff) + ldsw + _i * 8192), 16, 0, 0); } while (0)
#define PG8_STAGE_A(bufoff, p, h, nx) do { if constexpr (GATHER) { PG8_STAGE(bufoff, p, vC[h]); } else PG8_STAGE(bufoff, (p) + (h) * hstep, voffA); } while (0)
#define PG8_LDA(dst, b, h) do { _Pragma("unroll") for (int m = 0; m < 4; ++m) _Pragma("unroll") for (int k = 0; k < 2; ++k) dst[m][k] = *(const LAS bf16x8*)(lds + PG8_SA(b, h) + aoff + m * 2048 + k * 1024); } while (0)
#define PG8_LDB(dst, b, h) do { _Pragma("unroll") for (int n = 0; n < 2; ++n) _Pragma("unroll") for (int k = 0; k < 2; ++k) dst[n][k] = *(const LAS bf16x8*)(lds + PG8_SB(b, h) + boff + n * 2048 + k * 1024); } while (0)
#define PG8_MMA(ai, bj, At, Bt) do { __builtin_amdgcn_s_setprio(1); \
        if constexpr (FP8) { _Pragma("unroll") for (int m = 0; m < 4; ++m) _Pragma("unroll") for (int n = 0; n < 2; ++n) \
            { const i32x8 b8_ = cat8(Bt[n][0], Bt[n][1]), a8_ = cat8(At[m][0], At[m][1]); asm volatile("v_mfma_f32_16x16x128_f8f6f4 %0, %1, %2, %0" : "+v"(acc[ai][bj][m][n]) : "v"(b8_), "v"(a8_)); } } \
        else { _Pragma("unroll") for (int m = 0; m < 4; ++m) _Pragma("unroll") for (int n = 0; n < 2; ++n) _Pragma("unroll") for (int k = 0; k < 2; ++k) \
            acc[ai][bj][m][n] = __builtin_amdgcn_mfma_f32_16x16x32_bf16(Bt[n][k], At[m][k], acc[ai][bj][m][n], 0, 0, 0); } \
        __builtin_amdgcn_s_setprio(0); } while (0)
#define PG8_WAIT_V(n) asm volatile("s_waitcnt vmcnt(" #n ")" ::: "memory")
#define PG8_WAIT_L(n) asm volatile("s_waitcnt lgkmcnt(" #n ")" ::: "memory")
#define PG8_BAR __builtin_amdgcn_s_barrier()
#define PG8_SCHED __builtin_amdgcn_sched_barrier(0)
#define PG8_UPTR(u, pa, pb) do { unsigned _e = g.texp ? ld_u32_agent(g.texp + (u).pm) : 0u; _e = (unsigned)__builtin_amdgcn_readfirstlane((int)_e); (u).e = (int)_e; \
        pa = GATHER ? (const char*)g.A : (const char*)g.A + (size_t)(u).pm * tstep; pb = (const char*)g.Bt + (size_t)_e * g.bstride + (size_t)(u).pn * tstep; } while (0)
    Unit cur, nxt; int ui = 0;
    if (!S.next(0, cur)) return;
    f32x4 acc[2][2][4][2];
#pragma unroll
    for (int a = 0; a < 2; ++a)
#pragma unroll
        for (int b = 0; b < 2; ++b)
#pragma unroll
            for (int m = 0; m < 4; ++m)
#pragma unroll
                for (int n = 0; n < 2; ++n) acc[a][b][m][n] = (f32x4){0.f, 0.f, 0.f, 0.f};
    bf16x8 At[4][2], B0[2][2], B1[2][2];
    const char* cA; const char* cB;
    PG8_UPTR(cur, cA, cB);
    if constexpr (GATHER) { PG8_GROWS(cur, vC); }
    if constexpr (SP2) {
        PG8_STAGE(PG8_SB(0, 0), cB, voffB); PG8_STAGE(PG8_SB(0, 1), cB + hstep, voffB); PG8_STAGE_A(PG8_SA(0, 0), cA, 0, false); PG8_STAGE_A(PG8_SA(0, 1), cA, 1, false);
        if (wr == 1) PG8_BAR;
        PG8_WAIT_V(2); PG8_BAR;
        PG8_STAGE(PG8_SB(1, 0), cB + kstep, voffB); PG8_STAGE_A(PG8_SA(1, 0), cA + kstep, 0, false); PG8_STAGE(PG8_SB(1, 1), cB + hstep + kstep, voffB);
        PG8_WAIT_V(6); PG8_BAR;
    } else {
        PG8_STAGE(PG8_SB(0, 0), cB, voffB); PG8_STAGE_A(PG8_SA(0, 0), cA, 0, false); PG8_STAGE(PG8_SB(0, 1), cB + hstep, voffB); PG8_STAGE_A(PG8_SA(0, 1), cA, 1, false);
        if (wr == 1) PG8_BAR;
        PG8_WAIT_V(4); PG8_BAR;
        PG8_STAGE(PG8_SB(1, 0), cB + kstep, voffB); PG8_STAGE_A(PG8_SA(1, 0), cA + kstep, 0, false); PG8_STAGE(PG8_SB(1, 1), cB + hstep + kstep, voffB);
        PG8_WAIT_V(6); PG8_BAR;
    }
    for (;;) {
        const bool has_next = S.next(ui + 1, nxt);
        const char* nA = cA; const char* nB = cB;
        if (has_next) PG8_UPTR(nxt, nA, nB);
#pragma unroll 1
        for (int t = 0; t < nt; t += 2) {
            const bool last = (t == nt - 2);
            const char* a1 = cA + (size_t)(t + 1) * kstep;
            const char* a2 = last ? nA : cA + (size_t)(t + 2) * kstep; const char* b2 = last ? nB : cB + (size_t)(t + 2) * kstep;
            const char* a3 = a2 + kstep; const char* b3 = b2 + kstep;
            if constexpr (SP2) {
            PG8_LDB(B0, 0, 0); PG8_LDB(B1, 0, 1); PG8_SCHED; PG8_LDA(At, 0, 0); PG8_STAGE_A(PG8_SA(1, 1), a1, 1, false);
            if constexpr (GATHER) { if (last && has_next) { PG8_GROWS(nxt, vC); } }
            PG8_WAIT_V(8); PG8_WAIT_L(0); PG8_BAR; PG8_MMA(0, 0, At, B0); PG8_MMA(0, 1, At, B1); PG8_BAR; PG8_SCHED;
            PG8_LDA(At, 0, 1); PG8_STAGE(PG8_SB(0, 0), b2, voffB); PG8_STAGE(PG8_SB(0, 1), b2 + hstep, voffB); PG8_STAGE_A(PG8_SA(0, 0), a2, 0, last);
            PG8_WAIT_V(8); PG8_WAIT_L(0); PG8_BAR; PG8_MMA(1, 0, At, B0); PG8_MMA(1, 1, At, B1); PG8_BAR; PG8_SCHED;
            PG8_LDB(B0, 1, 0); PG8_LDB(B1, 1, 1); PG8_SCHED; PG8_LDA(At, 1, 0); PG8_STAGE_A(PG8_SA(0, 1), a2, 1, last);
            PG8_WAIT_V(8); PG8_WAIT_L(0); PG8_BAR; PG8_MMA(0, 0, At, B0); PG8_MMA(0, 1, At, B1); PG8_BAR; PG8_SCHED;
            PG8_LDA(At, 1, 1); PG8_STAGE(PG8_SB(1, 0), b3, voffB); PG8_STAGE(PG8_SB(1, 1), b3 + hstep, voffB); PG8_STAGE_A(PG8_SA(1, 0), a3, 0, last);
            PG8_WAIT_V(8); PG8_WAIT_L(0); PG8_BAR; PG8_MMA(1, 0, At, B0); PG8_MMA(1, 1, At, B1); PG8_BAR; PG8_SCHED;
            } else {
            PG8_LDB(B0, 0, 0); PG8_SCHED; PG8_LDA(At, 0, 0); PG8_STAGE_A(PG8_SA(1, 1), a1, 1, false);
            if constexpr (GATHER) { if (last && has_next) { PG8_GROWS(nxt, vC); } }
            PG8_WAIT_L(8); PG8_BAR; PG8_WAIT_L(0); PG8_MMA(0, 0, At, B0); PG8_BAR; PG8_SCHED;
            PG8_LDB(B1, 0, 1); PG8_STAGE(PG8_SB(0, 0), b2, voffB);
            PG8_BAR; PG8_WAIT_L(0); PG8_MMA(0, 1, At, B1); PG8_BAR;
            PG8_LDA(At, 0, 1); PG8_STAGE_A(PG8_SA(0, 0), a2, 0, last);
            PG8_BAR; PG8_WAIT_L(0); PG8_MMA(1, 0, At, B0); PG8_BAR; PG8_SCHED;
            PG8_STAGE(PG8_SB(0, 1), b2 + hstep, voffB);
            PG8_WAIT_V(6); PG8_BAR; PG8_MMA(1, 1, At, B1); PG8_BAR;
            PG8_LDB(B0, 1, 0); PG8_SCHED; PG8_LDA(At, 1, 0); PG8_STAGE_A(PG8_SA(0, 1), a2, 1, last);
            PG8_WAIT_L(8); PG8_BAR; PG8_WAIT_L(0); PG8_MMA(0, 0, At, B0); PG8_BAR; PG8_SCHED;
            PG8_LDB(B1, 1, 1); PG8_STAGE(PG8_SB(1, 0), b3, voffB);
            PG8_BAR; PG8_WAIT_L(0); PG8_MMA(0, 1, At, B1); PG8_BAR;
            PG8_LDA(At, 1, 1); PG8_STAGE_A(PG8_SA(1, 0), a3, 0, last);
            PG8_BAR; PG8_WAIT_L(0); PG8_MMA(1, 0, At, B0); PG8_BAR; PG8_SCHED;
            PG8_STAGE(PG8_SB(1, 1), b3 + hstep, voffB);
            PG8_WAIT_V(6); PG8_BAR; PG8_MMA(1, 1, At, B1); PG8_BAR;
            }
        }
        if constexpr (ALIGN_EPI) { if (wr == 0) PG8_BAR; }
        if constexpr (FP8) { asm volatile("s_nop 15\n\ts_nop 15" ::: "memory"); PG8_SCHED; }
        E(acc, cur, wr, wc, fr, fq);
        if (!has_next) break;
#pragma unroll
        for (int a = 0; a < 2; ++a)
#pragma unroll
            for (int b = 0; b < 2; ++b)
#pragma unroll
                for (int m = 0; m < 4; ++m)
#pragma unroll
                    for (int n = 0; n < 2; ++n) acc[a][b][m][n] = (f32x4){0.f, 0.f, 0.f, 0.f};
        cur = nxt; cA = nA; cB = nB; ++ui;
        if constexpr (ALIGN_EPI) { if (wr == 1) PG8_BAR; }
    }
    PG8_WAIT_V(0);
    if constexpr (!ALIGN_EPI) { if (wr == 0) PG8_BAR; }
    PG8_BAR;
#undef PG8_SA
#undef PG8_SB
#undef PG8_STAGE
#undef PG8_LDA
#undef PG8_LDB
#undef PG8_MMA
#undef PG8_WAIT_V
#undef PG8_WAIT_L
#undef PG8_BAR
#undef PG8_SCHED
#undef PG8_UPTR
#undef PG8_STAGE_A
#undef PG8_GROWS
}

struct EpiProj {
    static constexpr bool PERM = true;
    bf16 *q, *k, *vT, *p;
    __device__ __forceinline__ void operator()(const f32x4 (&acc)[2][2][4][2], const Unit& u, int wr, int wc, int fr, int fq) const {
        const int row0 = u.pm * BM + wr * 64 + fr;
        const int pn = u.pn;
#pragma unroll
        for (int ai = 0; ai < 2; ++ai)
#pragma unroll
            for (int m = 0; m < 4; ++m) {
                const int row = row0 + ai * HALF + m * 16;
#pragma unroll
                for (int bj = 0; bj < 2; ++bj) {
                    f32x4 v0 = acc[ai][bj][m][0], v1 = acc[ai][bj][m][1];
                    const int col = pn * BM + bj * HALF + wc * 32 + 8 * fq;
                    if (pn >= 4 && pn < 6) {
                        const int cv = col - 1024, hh = cv >> 6, dim = cv & 63, b = row / T, t = row % T;
                        bf16* dst = vT + ((size_t)((b * NH + hh) * HD + dim)) * T + t;
                        const unsigned w0 = cvt_pk_bf16(v0[0], v0[1]), w1 = cvt_pk_bf16(v0[2], v0[3]), w2 = cvt_pk_bf16(v1[0], v1[1]), w3 = cvt_pk_bf16(v1[2], v1[3]);
                        dst[0 * (size_t)T] = (bf16)(w0 & 0xffff); dst[1 * (size_t)T] = (bf16)(w0 >> 16); dst[2 * (size_t)T] = (bf16)(w1 & 0xffff); dst[3 * (size_t)T] = (bf16)(w1 >> 16);
                        dst[4 * (size_t)T] = (bf16)(w2 & 0xffff); dst[5 * (size_t)T] = (bf16)(w2 >> 16); dst[6 * (size_t)T] = (bf16)(w3 & 0xffff); dst[7 * (size_t)T] = (bf16)(w3 >> 16);
                    } else {
                        bf16* dst;
                        if (pn < 2) { v0 = v0 * 0.125f; v1 = v1 * 0.125f; dst = q + (size_t)row * CW + col; }
                        else if (pn < 4) dst = k + (size_t)row * CW + (col - 512);
                        else dst = p + (size_t)row * PW + (col - 1536);
                        u32x4 w; w.x = cvt_pk_bf16(v0[0], v0[1]); w.y = cvt_pk_bf16(v0[2], v0[3]); w.z = cvt_pk_bf16(v1[0], v1[1]); w.w = cvt_pk_bf16(v1[2], v1[3]);
                        *(u32x4*)dst = w;
                    }
                }
            }
    }
};
struct EpiWo {
    static constexpr bool PERM = false;
    const float* x; float* h;
    __device__ __forceinline__ void operator()(const f32x4 (&acc)[2][2][4][2], const Unit& u, int wr, int wc, int fr, int fq) const {
        const int row0 = u.pm * BM + wr * 64 + fr, col0 = u.pn * BM + wc * 32 + 4 * fq;
#pragma unroll
        for (int ai = 0; ai < 2; ++ai)
#pragma unroll
            for (int m = 0; m < 4; ++m) { const size_t off = (size_t)(row0 + ai * HALF + m * 16) * D + col0;
#pragma unroll
                for (int bj = 0; bj < 2; ++bj)
#pragma unroll
                    for (int n = 0; n < 2; ++n) { const f32x4 xv = *(const f32x4*)(x + off + bj * HALF + n * 16); *(f32x4*)(h + off + bj * HALF + n * 16) = acc[ai][bj][m][n] + xv; } }
    }
};
struct EpiUp {
    static constexpr bool PERM = true;
    const float* b_up; unsigned char* act;
    __device__ __forceinline__ void operator()(const f32x4 (&acc)[2][2][4][2], const Unit& u, int wr, int wc, int fr, int fq) const {
        const int row0 = u.pm * BM + wr * 64 + fr, ch = u.pn * 128 + wc * 32 + 8 * fq;
        const float* bg = b_up + (size_t)u.e * 2048 + ch; const float* bl = bg + 1024;
        const f32x4 bg0 = *(const f32x4*)bg, bg1 = *(const f32x4*)(bg + 4), bl0 = *(const f32x4*)bl, bl1 = *(const f32x4*)(bl + 4);
#pragma unroll
        for (int ai = 0; ai < 2; ++ai)
#pragma unroll
            for (int m = 0; m < 4; ++m) {
                float o[8];
#pragma unroll
                for (int n = 0; n < 2; ++n) { const f32x4 gv = acc[ai][0][m][n] * (1.0f / (F8_SX * F8_SW)) + (n ? bg1 : bg0), lv = acc[ai][1][m][n] * (1.0f / (F8_SX * F8_SW)) + (n ? bl1 : bl0);
#pragma unroll
                    for (int j = 0; j < 4; ++j) { const float gt = fminf(gv[j], 7.0f), li = fminf(fmaxf(lv[j], -7.0f), 7.0f); o[n * 4 + j] = (li + 1.0f) * gt * sigmoidf_(1.702f * gt) * F8_SACT; } }
                u32x2 w8; w8.x = pk4_fp8(o[0], o[1], o[2], o[3]); w8.y = pk4_fp8(o[4], o[5], o[6], o[7]);
                *(u32x2*)(act + (size_t)(row0 + ai * HALF + m * 16) * DE + ch) = w8;
            }
    }
};
struct EpiDown {
    static constexpr bool PERM = true;
    const float* b_dn; bf16* y;
    __device__ __forceinline__ void operator()(const f32x4 (&acc)[2][2][4][2], const Unit& u, int wr, int wc, int fr, int fq) const {
        const int row0 = u.pm * BM + wr * 64 + fr, col0 = u.pn * BM + wc * 32 + 8 * fq;
        const float* bb = b_dn + (size_t)u.e * D + col0;
        f32x4 bv[2][2];
#pragma unroll
        for (int bj = 0; bj < 2; ++bj)
#pragma unroll
            for (int n = 0; n < 2; ++n) bv[bj][n] = *(const f32x4*)(bb + bj * HALF + 4 * n);
#pragma unroll
        for (int ai = 0; ai < 2; ++ai)
#pragma unroll
            for (int m = 0; m < 4; ++m) { bf16* rowp = y + (size_t)(row0 + ai * HALF + m * 16) * D + col0;
#pragma unroll
                for (int bj = 0; bj < 2; ++bj) { const f32x4 v0 = acc[ai][bj][m][0] * (1.0f / (F8_SACT * F8_SW)) + bv[bj][0], v1 = acc[ai][bj][m][1] * (1.0f / (F8_SACT * F8_SW)) + bv[bj][1];
                    u32x4 w; w.x = cvt_pk_bf16(v0[0], v0[1]); w.y = cvt_pk_bf16(v0[2], v0[3]); w.z = cvt_pk_bf16(v1[0], v1[1]); w.w = cvt_pk_bf16(v1[2], v1[3]);
                    *(u32x4*)(rowp + bj * HALF) = w; } }
    }
};
}


#define XB_TMO      128
#define XB_XCNT(j)  (256  + 64 * (j))
#define XB_XSUB(j)  (1280 + 64 * (j))
#define XB_XGEN(j)  (2304 + 64 * (j))
#define XB_TOP      3328
#define XB_TOPGEN   3392
#define XCD_BAR_WORDS 3456
#define XB_SPIN_CAP (1u << 20)
__device__ __forceinline__ unsigned xb_ld(unsigned* p)              { return __hip_atomic_load(p, __ATOMIC_RELAXED, __HIP_MEMORY_SCOPE_AGENT); }
__device__ __forceinline__ unsigned xb_add(unsigned* p, unsigned v) { return __hip_atomic_fetch_add(p, v, __ATOMIC_RELAXED, __HIP_MEMORY_SCOPE_AGENT); }
__device__ __forceinline__ unsigned xb_xcc_id() { return (unsigned)__builtin_amdgcn_s_getreg((3 << 11) | 20) & 0xFu; }
#define XB_SPIN(cond, bar) do { unsigned _sp = 0; while (cond) { __builtin_amdgcn_s_sleep(1); \
    if ((++_sp & 255u) == 0u) { if (xb_ld(&(bar)[XB_TMO])) break; if (_sp > XB_SPIN_CAP) { atomicAdd(&(bar)[XB_TMO], 1u); break; } } } } while (0)
struct XcdBarrier { unsigned* bar; unsigned x; volatile LAS unsigned* st; };
__device__ __forceinline__ XcdBarrier xcd_barrier_post(unsigned* bar, volatile LAS unsigned* st) {
    XcdBarrier b; b.bar = bar; b.x = xb_xcc_id(); b.st = st;
    if (threadIdx.x == 0) (void)xb_add(&bar[XB_XCNT(b.x)], 1u);
    return b;
}
__device__ __forceinline__ void xcd_barrier_complete(unsigned* bar, unsigned x, unsigned& nloc, unsigned& nx) {
    const unsigned G = gridDim.x * gridDim.y * gridDim.z;
    unsigned sum, cnt, mine, sp = 0u;
    for (;;) {
        sum = 0u; cnt = 0u; mine = 0u;
#pragma unroll
        for (unsigned j = 0; j < 16; ++j) { const unsigned c = xb_ld(&bar[XB_XCNT(j)]); sum += c; cnt += (c > 0u) ? 1u : 0u; mine = (j == x) ? c : mine; }
        if (sum == G) break;
        __builtin_amdgcn_s_sleep(1);
        if ((++sp & 255u) == 0u) { if (xb_ld(&bar[XB_TMO])) break; if (sp > XB_SPIN_CAP) { atomicAdd(&bar[XB_TMO], 1u); break; } }
    }
    nloc = mine > 0u ? mine : 1u; nx = cnt > 0u ? cnt : 1u;
}
__device__ __forceinline__ void xcd_barrier(const XcdBarrier& b) {
    asm volatile("s_waitcnt vmcnt(0)" ::: "memory");
    __syncthreads();
    if (threadIdx.x == 0) {
        unsigned* bar = b.bar;
        __builtin_amdgcn_s_waitcnt(0);
        unsigned nloc = b.st[0], nx = b.st[1];
        if (nloc == 0u) { xcd_barrier_complete(bar, b.x, nloc, nx); b.st[0] = nloc; b.st[1] = nx; }
        const unsigned old = xb_add(&bar[XB_XSUB(b.x)], 1u);
        const unsigned gen = old / nloc;
        if (old + 1u == (gen + 1u) * nloc) {
            __builtin_amdgcn_fence(__ATOMIC_RELEASE, "agent");
            asm volatile("s_waitcnt vmcnt(0)" ::: "memory");
            const unsigned og = xb_add(&bar[XB_TOP], 1u);
            const unsigned tg = og / nx;
            if (og + 1u == (tg + 1u) * nx) xb_add(&bar[XB_TOPGEN], 1u);
            else XB_SPIN(xb_ld(&bar[XB_TOPGEN]) == tg, bar);
            __builtin_amdgcn_fence(__ATOMIC_ACQUIRE, "agent");
            xb_add(&bar[XB_XGEN(b.x)], 1u);
            asm volatile("s_waitcnt vmcnt(0)" ::: "memory");
        } else {
            XB_SPIN(xb_ld(&bar[XB_XGEN(b.x)]) == gen, bar);
            __builtin_amdgcn_fence(__ATOMIC_ACQUIRE, "agent");
            asm volatile("s_waitcnt vmcnt(0)" ::: "memory");
        }
    }
    __syncthreads();
}

struct Args { const float* in[26]; float* out; unsigned char* ws; int ph_lo, ph_hi; };

struct Frame { LAS unsigned char* lds; int tid, lane, wave, G, vcu; };

__device__ __forceinline__ void transpose_item(const float* W, int K, int N, bf16* WT, int k0, int n0, int orow0, LAS float* scr, int lane) {
#pragma unroll 8
    for (int i = 0; i < 32; ++i) { const int kk = 2 * i + (lane >> 5); scr[kk * 33 + (lane & 31)] = W[(size_t)(k0 + kk) * N + n0 + (lane & 31)]; }
    asm volatile("s_waitcnt lgkmcnt(0)" ::: "memory");
    const int c = lane & 7;
#pragma unroll
    for (int j = 0; j < 4; ++j) { const int n = (lane >> 3) + 8 * j; const LAS float* s = scr + (8 * c) * 33 + n;
        u32x4 o; o.x = cvt_pk_bf16(s[0 * 33], s[1 * 33]); o.y = cvt_pk_bf16(s[2 * 33], s[3 * 33]); o.z = cvt_pk_bf16(s[4 * 33], s[5 * 33]); o.w = cvt_pk_bf16(s[6 * 33], s[7 * 33]);
        *(u32x4*)(WT + (size_t)(orow0 + n) * K + k0 + 8 * c) = o; }
    asm volatile("s_waitcnt lgkmcnt(0)" ::: "memory");
}

__device__ __forceinline__ void transpose_item8(const float* W, int K, int N, unsigned char* WT, int k0, int n0, int orow0, LAS float* scr, int lane) {
#pragma unroll 8
    for (int i = 0; i < 32; ++i) { const int kk = 2 * i + (lane >> 5); scr[kk * 33 + (lane & 31)] = W[(size_t)(k0 + kk) * N + n0 + (lane & 31)]; }
    asm volatile("s_waitcnt lgkmcnt(0)" ::: "memory");
    const int c = lane & 7;
#pragma unroll
    for (int j = 0; j < 4; ++j) { const int n = (lane >> 3) + 8 * j; const LAS float* s = scr + (8 * c) * 33 + n;
        u32x2 o; o.x = pk4_fp8(s[0 * 33] * F8_SW, s[1 * 33] * F8_SW, s[2 * 33] * F8_SW, s[3 * 33] * F8_SW); o.y = pk4_fp8(s[4 * 33] * F8_SW, s[5 * 33] * F8_SW, s[6 * 33] * F8_SW, s[7 * 33] * F8_SW);
        *(u32x2*)(WT + (size_t)(orow0 + n) * K + k0 + 8 * c) = o; }
    asm volatile("s_waitcnt lgkmcnt(0)" ::: "memory");
}

__device__ __forceinline__ void p0_prologue(const Frame& F, const Args& a) {
    unsigned char* ws = a.ws;
    LAS float* scr = (LAS float*)(F.lds + F.wave * 8448);
    const int gw = F.vcu * 8 + F.wave, NGW = F.G * 8;
    constexpr int I_IN = 16 * 108, I_O = 16 * 32, I_UP = 32 * 16 * 64, I_DN = 32 * 16 * 32, I_L = 16, I_G = 32;
    constexpr int NITEMS = I_IN + I_O + I_UP + I_DN + 2 * I_L + 2 * I_L + I_G;
    for (int it = gw; it < NITEMS; it += NGW) {
        int r = it;
        if (r < I_UP) {
            const int e = r / 1024, q = r % 1024, kb = q / 64, nb = q % 64, n0 = nb * 32;
            const int orow0 = n0 < 1024 ? 256 * (n0 >> 7) + (n0 & 127) : 256 * ((n0 - 1024) >> 7) + 128 + ((n0 - 1024) & 127);
            transpose_item8(a.in[21] + (size_t)e * 1024 * 2048, 1024, 2048, ws + WS_WUPT + (size_t)e * 2048 * 1024, kb * 64, n0, orow0, scr, F.lane); continue; }
        r -= I_UP;
        if (r < I_DN) { const int e = r / 512, q = r % 512, kb = q / 32, nb = q % 32;
            transpose_item8(a.in[23] + (size_t)e * 1024 * 1024, 1024, 1024, ws + WS_WDNT + (size_t)e * 1024 * 1024, kb * 64, nb * 32, nb * 32, scr, F.lane); continue; }
        r -= I_DN;
        if (r < I_IN) { const int kb = r / 108, nb = r % 108; transpose_item(a.in[2], 1024, NPROJ, (bf16*)(ws + WS_WINT), kb * 64, nb * 32, nb * 32, scr, F.lane); continue; }
        r -= I_IN;
        if (r < I_O) { const int kb = r / 32, nb = r % 32; transpose_item(a.in[17], 1024, 1024, (bf16*)(ws + WS_WOT), kb * 64, nb * 32, nb * 32, scr, F.lane); continue; }
        r -= I_O;
        if (r < 2 * I_L) { const int z = r / 16, nb = r % 16; transpose_item(a.in[8] + (size_t)z * 64 * 512, 64, 512, (bf16*)(ws + WS_W2T) + (size_t)z * 512 * 64, 0, nb * 32, nb * 32, scr, F.lane); continue; }
        r -= 2 * I_L;
        if (r < 2 * I_L) { const int z = r / 16, nb = r % 16; transpose_item(a.in[10] + (size_t)z * 64 * 512, 64, 512, (bf16*)(ws + WS_A2T) + (size_t)z * 512 * 64, 0, nb * 32, nb * 32, scr, F.lane); continue; }
        r -= 2 * I_L;
        { const int kb = r / 16, nb = r % 16; transpose_item(a.in[11], 128, 512, (bf16*)(ws + WS_G2T), kb * 64, nb * 32, nb * 32, scr, F.lane); }
    }
    { u32x4* z = (u32x4*)(ws + WS_WINT + (size_t)NPROJ * 1024 * 2); const u32x4 zero = {0u, 0u, 0u, 0u};
      for (int i = F.vcu * 512 + F.tid; i < 16384; i += F.G * 512) z[i] = zero; }
    const float* x = a.in[0]; const float* nw = a.in[1]; bf16* hn = (bf16*)(ws + WS_HN);
    f32x4 wv[4];
#pragma unroll
    for (int j = 0; j < 4; ++j) wv[j] = *((const f32x4*)nw + F.lane + 64 * j);
    for (int m = gw; m < M; m += NGW) {
        const f32x4* xr = (const f32x4*)(x + (size_t)m * D) + F.lane;
        f32x4 v[4]; float s = 0.f;
#pragma unroll
        for (int j = 0; j < 4; ++j) { v[j] = xr[64 * j]; s += (v[j].x * v[j].x + v[j].y * v[j].y) + (v[j].z * v[j].z + v[j].w * v[j].w); }
        const float rs = rsqrtf(wave_sum(s) * (1.f / D) + RMS_EPS);
        u32x2* o8 = (u32x2*)(hn + (size_t)m * D) + F.lane;
#pragma unroll
        for (int j = 0; j < 4; ++j) { u32x2 o; o.x = cvt_pk_bf16(v[j].x * rs * wv[j].x, v[j].y * rs * wv[j].y); o.y = cvt_pk_bf16(v[j].z * rs * wv[j].z, v[j].w * rs * wv[j].w); o8[64 * j] = o; }
    }
}

constexpr int PREP_KBUF = 0, PREP_INV = 65536, PREP_AW = 67584, PREP_AA = PREP_AW + 17408, PREP_AG = PREP_AA + 17408, PREP_LD = 136;
template <bool STORE>
__device__ __forceinline__ void prep_phase(const Frame& F, const Args& a) {
    unsigned char* ws = a.ws;
    const bf16* p = (const bf16*)(ws + WS_P);
    bf16* r_out = (bf16*)(ws + WS_R); bf16* v_out = (bf16*)(ws + WS_V); bf16* kk_out = (bf16*)(ws + WS_KK);
    bf16* decay_out = (bf16*)(ws + WS_DECAY); bf16* kdir_out = (bf16*)(ws + WS_KDIR); bf16* akk_out = (bf16*)(ws + WS_AKK); bf16* g_out = (bf16*)(ws + WS_G);
    const bf16* w2T = (const bf16*)(ws + WS_W2T); const bf16* a2T = (const bf16*)(ws + WS_A2T); const bf16* g2T = (const bf16*)(ws + WS_G2T);
    const float* mu_p = a.in[5]; const float* mu_n = a.in[6]; const float* w0 = a.in[7]; const float* a0 = a.in[9];
    const float* k_k = a.in[12]; const float* k_a = a.in[13];
    LAS bf16* kbuf = (LAS bf16*)(F.lds + PREP_KBUF); LAS float* invb = (LAS float*)(F.lds + PREP_INV);
    LAS bf16* Aw = (LAS bf16*)(F.lds + PREP_AW); LAS bf16* Aa = (LAS bf16*)(F.lds + PREP_AA); LAS bf16* Ag = (LAS bf16*)(F.lds + PREP_AG);
    const int lane = F.lane, wave = F.wave, fr = lane & 15, fg = lane >> 4;
    for (int tile = F.vcu; tile < M / 64; tile += F.G) {
        const int m0 = tile * 64;
#pragma unroll 1
        for (int jj = 0; jj < 4; ++jj) {
            const int q = lane + 64 * jj; const bool valid = q < 240; const int c0 = 8 * q;
            float mp[8], mn[8];
#pragma unroll
            for (int i = 0; i < 8; ++i) { mp[i] = valid ? mu_p[c0 + i] : 0.f; mn[i] = valid ? mu_n[c0 + i] : 0.f; }
            const int mfirst = m0 + wave * 8;
            const u32x4 zero = {0u, 0u, 0u, 0u};
            u32x4 rows[10];
#pragma unroll
            for (int rI = 0; rI < 10; ++rI) { const int mr = mfirst - 1 + rI;
                const bool ok = valid && !(rI == 0 && (mfirst % T) == 0) && !(rI == 9 && ((mfirst + 7) % T) == T - 1);
                rows[rI] = ok ? *(const u32x4*)(p + (size_t)mr * PW + c0) : zero; }
#pragma unroll
            for (int i = 0; i < 8; ++i) {
                const int m = mfirst + i, it = wave * 8 + i;
                const u32x4 prev = rows[i], cur = rows[i + 1], nxt = rows[i + 2];
                float fp[8], fc[8], fn[8], s[8];
                unpack8(prev, fp); unpack8(cur, fc); unpack8(nxt, fn);
#pragma unroll
                for (int e = 0; e < 8; ++e) s[e] = fc[e] + mp[e] * (fp[e] - fc[e]) + mn[e] * (fn[e] - fc[e]);
                if (jj == 0) { if (STORE) { *(u32x4*)(r_out + (size_t)m * CW + c0) = pack8(s); } }
                else if (jj == 1) {
                    const int c = c0 - 512;
                    *(LAS u32x4*)(kbuf + it * 512 + c) = pack8(s);
                    float kr[8]; float ss = 0.f;
#pragma unroll
                    for (int e = 0; e < 8; ++e) { kr[e] = s[e] * k_k[c + e]; ss += kr[e] * kr[e]; }
                    ss += __shfl_xor(ss, 1); ss += __shfl_xor(ss, 2); ss += __shfl_xor(ss, 4);
                    const float inv = fminf(__builtin_amdgcn_rsqf(ss), 1e12f);
#pragma unroll
                    for (int e = 0; e < 8; ++e) kr[e] *= inv;
                    if (STORE) { *(u32x4*)(kk_out + (size_t)m * CW + c) = pack8(kr); }
                    if ((lane & 7) == 0) invb[it * 8 + (lane >> 3)] = inv;
                }
                else if (jj == 2) { if (STORE) { *(u32x4*)(v_out + (size_t)m * CW + (c0 - 1024)) = pack8(s); } }
                else if (valid) {
                    const int seg = lane >> 4, cw = 8 * (lane & 15);
                    if (seg == 0) {
#pragma unroll
                        for (int e = 0; e < 8; ++e) s[e] = 1.0f - 2.0f * __builtin_amdgcn_rcpf(__expf(2.0f * s[e]) + 1.0f);
                        *(LAS u32x4*)(Aw + it * PREP_LD + cw) = pack8(s);
                    } else if (seg == 1) { *(LAS u32x4*)(Aa + it * PREP_LD + cw) = pack8(s); }
                    else {
#pragma unroll
                        for (int e = 0; e < 8; ++e) s[e] = sigmoidf_(s[e]);
                        *(LAS u32x4*)(Ag + it * PREP_LD + cw) = pack8(s);
                    }
                }
            }
        }
        __syncthreads();
        const int nb = 64 * wave;
#pragma unroll 1
        for (int job = 0; job < 5; ++job) {
            const int z = job & 1;
            const bf16* WT = job < 2 ? w2T + (size_t)z * 512 * 64 : (job < 4 ? a2T + (size_t)z * 512 * 64 : g2T);
            const LAS bf16* Ax = job < 2 ? Aw + z * 64 : (job < 4 ? Aa + z * 64 : Ag);
            const int kw = job < 4 ? 64 : 128, nks = kw / 32;
            f32x4 acc[4][4];
#pragma unroll
            for (int mt = 0; mt < 4; ++mt)
#pragma unroll
                for (int nt = 0; nt < 4; ++nt) acc[mt][nt] = (f32x4){0.f, 0.f, 0.f, 0.f};
#pragma unroll 1
            for (int ks = 0; ks < nks; ++ks) {
                bf16x8 af[4], wf[4];
#pragma unroll
                for (int mt = 0; mt < 4; ++mt) af[mt] = *(const LAS bf16x8*)(Ax + (16 * mt + fr) * PREP_LD + 32 * ks + 8 * fg);
#pragma unroll
                for (int nt = 0; nt < 4; ++nt) wf[nt] = *(const bf16x8*)(WT + (size_t)(nb + 16 * nt + fr) * kw + 32 * ks + 8 * fg);
#pragma unroll
                for (int mt = 0; mt < 4; ++mt)
#pragma unroll
                    for (int nt = 0; nt < 4; ++nt) acc[mt][nt] = __builtin_amdgcn_mfma_f32_16x16x32_bf16(wf[nt], af[mt], acc[mt][nt], 0, 0, 0);
            }
#pragma unroll
            for (int mt = 0; mt < 4; ++mt) {
                const int it = 16 * mt + fr; const size_t m = (size_t)(m0 + it);
#pragma unroll
                for (int nt = 0; nt < 4; ++nt) {
                    const int n = nb + 16 * nt + 4 * fg;
                    const f32x4 v = acc[mt][nt];
                    if (job < 2) {
                        const f32x4 b = *(const f32x4*)(w0 + z * 512 + n);
                        float o[4];
#pragma unroll
                        for (int i = 0; i < 4; ++i) o[i] = __expf(-0.60653066f * sigmoidf_(v[i] + b[i]));
                        u32x2 w; w.x = cvt_pk_bf16(o[0], o[1]); w.y = cvt_pk_bf16(o[2], o[3]);
                        if (STORE) { *(u32x2*)(decay_out + ((size_t)z * M + m) * CW + n) = w; }
                    } else if (job < 4) {
                        const f32x4 b = *(const f32x4*)(a0 + z * 512 + n), kkc = *(const f32x4*)(k_k + n), kac = *(const f32x4*)(k_a + n);
                        const u32x2 kb = *(const LAS u32x2*)(kbuf + it * 512 + n);
                        const float kv[4] = {bflo(kb.x), bfhi(kb.x), bflo(kb.y), bfhi(kb.y)};
                        const float inv = invb[it * 8 + wave];
                        float kd[4], ak[4];
#pragma unroll
                        for (int i = 0; i < 4; ++i) { const float av = sigmoidf_(v[i] + b[i]); kd[i] = kv[i] * (1.0f + (av - 1.0f) * kac[i]); ak[i] = av * (kv[i] * kkc[i] * inv); }
                        u32x2 w; w.x = cvt_pk_bf16(kd[0], kd[1]); w.y = cvt_pk_bf16(kd[2], kd[3]);
                        if (STORE) { *(u32x2*)(kdir_out + ((size_t)z * M + m) * CW + n) = w; }
                        w.x = cvt_pk_bf16(ak[0], ak[1]); w.y = cvt_pk_bf16(ak[2], ak[3]);
                        if (STORE) { *(u32x2*)(akk_out + ((size_t)z * M + m) * CW + n) = w; }
                    } else {
                        u32x2 w; w.x = cvt_pk_bf16(v[0], v[1]); w.y = cvt_pk_bf16(v[2], v[3]);
                        if (STORE) { *(u32x2*)(g_out + m * CW + n) = w; }
                    }
                }
            }
        }
        __syncthreads();
    }
}

__device__ __forceinline__ void attn_phase(const Frame& F, const Args& a) {
    unsigned char* ws = a.ws;
    const bf16* q = (const bf16*)(ws + WS_Q); const bf16* k = (const bf16*)(ws + WS_K); const bf16* vT = (const bf16*)(ws + WS_VT);
    bf16* att = (bf16*)(ws + WS_ATT);
    LAS float* bias = (LAS float*)F.lds;
    for (int i = F.tid; i < 8 * 15 * 31; i += 512) bias[i] = a.in[3][i];
    __syncthreads();
    const int lane = F.lane, fr = lane & 15, fg = lane >> 4;
    const int NGW = F.G * 8, gw = F.vcu * 8 + F.wave;
    const int per = (16384 + NGW - 1) / NGW;
    for (int task = gw * per; task < (gw + 1) * per && task < 16384; ++task) {
        const int cgp = task & 3, r = (task >> 2) & 127, h = (task >> 9) & 7, b = task >> 12;
        const int c0 = 16 * cgp, wsc = min(max(c0 - 8, 0), 32), rs = min(max(r - 4, 0), GROWS - 8);
        const int c = c0 + fr, cs = min(max(c - 8, 0), 48);
        const size_t tq = (size_t)b * T + r * 64 + c;
        bf16x8 qf[2];
#pragma unroll
        for (int ks = 0; ks < 2; ++ks) qf[ks] = *(const bf16x8*)(q + tq * CW + h * 64 + 32 * ks + 8 * fg);
        f32x4 sc[16];
        const int kcol_a = wsc + 8 * (fr >> 2) + (fr & 3);
#pragma unroll
        for (int hb = 0; hb < 2; ++hb) {
            bf16x8 kf[8][2];
#pragma unroll
            for (int tl = 0; tl < 8; ++tl) { const int t = 8 * hb + tl, u = t >> 1, par = t & 1;
                const size_t tk = (size_t)b * T + (rs + u) * 64 + kcol_a + 4 * par;
                kf[tl][0] = *(const bf16x8*)(k + tk * CW + h * 64 + 8 * fg); kf[tl][1] = *(const bf16x8*)(k + tk * CW + h * 64 + 32 + 8 * fg); }
#pragma unroll
            for (int tl = 0; tl < 8; ++tl) { f32x4 s = {0.f, 0.f, 0.f, 0.f};
                s = __builtin_amdgcn_mfma_f32_16x16x32_bf16(kf[tl][0], qf[0], s, 0, 0, 0);
                s = __builtin_amdgcn_mfma_f32_16x16x32_bf16(kf[tl][1], qf[1], s, 0, 0, 0);
                sc[8 * hb + tl] = s; }
        }
        float mx = -1e30f;
#pragma unroll
        for (int u = 0; u < 8; ++u) {
            const int dr = rs + u - r + 7;
#pragma unroll
            for (int par = 0; par < 2; ++par)
#pragma unroll
                for (int i = 0; i < 4; ++i) {
                    const int kc = wsc + 8 * fg + 4 * par + i; const bool ok = (kc >= cs) && (kc < cs + 16);
                    const int dc = min(max(kc - c + 15, 0), 30);
                    const float s = ok ? sc[2 * u + par][i] + bias[(h * 15 + dr) * 31 + dc] : -1e30f;
                    sc[2 * u + par][i] = s; mx = fmaxf(mx, s);
                }
        }
        mx = fmaxf(mx, __shfl_xor(mx, 16)); mx = fmaxf(mx, __shfl_xor(mx, 32));
        float sum = 0.f;
#pragma unroll
        for (int t = 0; t < 16; ++t)
#pragma unroll
            for (int i = 0; i < 4; ++i) { const float pv = sc[t][i] > -1e29f ? __expf(sc[t][i] - mx) : 0.f; sc[t][i] = pv; sum += pv; }
        sum += __shfl_xor(sum, 16); sum += __shfl_xor(sum, 32);
        const float inv = 1.0f / sum;
        f32x4 o[4];
#pragma unroll
        for (int nt = 0; nt < 4; ++nt) o[nt] = (f32x4){0.f, 0.f, 0.f, 0.f};
#pragma unroll
        for (int hb = 0; hb < 2; ++hb) {
            bf16x8 vf[4][4];
#pragma unroll
            for (int ul = 0; ul < 4; ++ul) { const int u = 4 * hb + ul; const size_t tv = (size_t)(rs + u) * 64 + wsc + 8 * fg;
#pragma unroll
                for (int nt = 0; nt < 4; ++nt) vf[ul][nt] = *(const bf16x8*)(vT + ((size_t)((b * NH + h) * HD + 16 * nt + fr)) * T + tv); }
#pragma unroll
            for (int ul = 0; ul < 4; ++ul) { const int u = 4 * hb + ul;
                union { u32x4 w; bf16x8 h8; } pf;
                pf.w.x = cvt_pk_bf16(sc[2 * u][0], sc[2 * u][1]); pf.w.y = cvt_pk_bf16(sc[2 * u][2], sc[2 * u][3]);
                pf.w.z = cvt_pk_bf16(sc[2 * u + 1][0], sc[2 * u + 1][1]); pf.w.w = cvt_pk_bf16(sc[2 * u + 1][2], sc[2 * u + 1][3]);
#pragma unroll
                for (int nt = 0; nt < 4; ++nt) o[nt] = __builtin_amdgcn_mfma_f32_16x16x32_bf16(vf[ul][nt], pf.h8, o[nt], 0, 0, 0); }
        }
#pragma unroll
        for (int nt = 0; nt < 4; ++nt) { u32x2 w; w.x = cvt_pk_bf16(o[nt][0] * inv, o[nt][1] * inv); w.y = cvt_pk_bf16(o[nt][2] * inv, o[nt][3] * inv);
            *(u32x2*)(att + tq * CW + h * 64 + 16 * nt + 4 * fg) = w; }
    }
    __syncthreads();
}

__device__ __forceinline__ float row16_sum(float v) {
    v += __builtin_bit_cast(float, __builtin_amdgcn_update_dpp(0, __builtin_bit_cast(int, v), 0xB1, 0xF, 0xF, true));
    v += __builtin_bit_cast(float, __builtin_amdgcn_update_dpp(0, __builtin_bit_cast(int, v), 0x4E, 0xF, 0xF, true));
    v += __builtin_bit_cast(float, __builtin_amdgcn_update_dpp(0, __builtin_bit_cast(int, v), 0x141, 0xF, 0xF, true));
    v += __builtin_bit_cast(float, __builtin_amdgcn_update_dpp(0, __builtin_bit_cast(int, v), 0x140, 0xF, 0xF, true));
    return v;
}
constexpr int CS_R = 8;
constexpr int CS_AT = 0, CS_RT = 2304, CS_KHT = 4608, CS_BHT = 6656, CS_VT = 8704, CS_TT = 9216, CS_AAK = 9728, CS_ARK = 10240, CS_ARB = 10752, CS_PL = 11264, CS_SLOT = 11520;
constexpr int CS_LD = 72;
constexpr int CS_SCR = CS_R * CS_SLOT  , CS_SCRW = 2304 * 2 + 1024  , CS_FLAG = CS_SCR + 7 * CS_SCRW  ;
__device__ __forceinline__ bf16 f2bf(float f) { return (bf16)(cvt_pk_bf16(f, 0.f) & 0xffffu); }
__device__ __forceinline__ void scan_phase(const Frame& F, const Args& a) {
    unsigned char* ws = a.ws;
    const int seq = F.vcu >> 2, ig = F.vcu & 3;
    if (seq >= 64) return;
    const int z = seq >> 5, b = (seq >> 3) & 3, h = seq & 7;
    const size_t mb = (size_t)b * T;
    const int lane = F.lane, wave = F.wave, fr = lane & 15, fg = lane >> 4;
    constexpr int NCK = T / 16;
    volatile LAS unsigned* flg = (volatile LAS unsigned*)(F.lds + CS_FLAG);
    if (F.tid < 16) flg[F.tid] = 0u;
    __syncthreads();
    if (wave == 0) {
        float* yout = (float*)(ws + WS_Y) + (size_t)z * M * CW + h * 64 + ig * 16 + fr;
        f32x4 zacc[4];
#pragma unroll
        for (int mt = 0; mt < 4; ++mt) zacc[mt] = (f32x4){0.f, 0.f, 0.f, 0.f};
        const bf16x8 zero8 = {0, 0, 0, 0, 0, 0, 0, 0};
        const bool lo2 = fg < 2;
#pragma unroll 1
        for (int n = 0; n < NCK; ++n) {
            const int slot = n & (CS_R - 1);
            { unsigned sp = 0; while (flg[slot] != (unsigned)(n + 1)) { __builtin_amdgcn_s_sleep(1); if (++sp > (1u << 24)) break; } }
            __builtin_amdgcn_fence(__ATOMIC_ACQUIRE, "workgroup");
            const LAS unsigned char* sl = F.lds + slot * CS_SLOT;
            union { u32x4 w; bf16x8 h8; } zb0, zb1, ap0, ap1, rp0, rp1;
            zb0.w.x = cvt_pk_bf16(zacc[0][0], zacc[0][1]); zb0.w.y = cvt_pk_bf16(zacc[0][2], zacc[0][3]); zb0.w.z = cvt_pk_bf16(zacc[1][0], zacc[1][1]); zb0.w.w = cvt_pk_bf16(zacc[1][2], zacc[1][3]);
            zb1.w.x = cvt_pk_bf16(zacc[2][0], zacc[2][1]); zb1.w.y = cvt_pk_bf16(zacc[2][2], zacc[2][3]); zb1.w.z = cvt_pk_bf16(zacc[3][0], zacc[3][1]); zb1.w.w = cvt_pk_bf16(zacc[3][2], zacc[3][3]);
            { const LAS unsigned char* pa = sl + CS_AT + fr * (CS_LD * 2) + fg * 8; const LAS unsigned char* pr = sl + CS_RT + fr * (CS_LD * 2) + fg * 8;
              const u32x2 a00 = *(const LAS u32x2*)(pa), a01 = *(const LAS u32x2*)(pa + 32), a10 = *(const LAS u32x2*)(pa + 64), a11 = *(const LAS u32x2*)(pa + 96);
              const u32x2 r00 = *(const LAS u32x2*)(pr), r01 = *(const LAS u32x2*)(pr + 32), r10 = *(const LAS u32x2*)(pr + 64), r11 = *(const LAS u32x2*)(pr + 96);
              ap0.w = (u32x4){a00.x, a00.y, a01.x, a01.y}; ap1.w = (u32x4){a10.x, a10.y, a11.x, a11.y}; rp0.w = (u32x4){r00.x, r00.y, r01.x, r01.y}; rp1.w = (u32x4){r10.x, r10.y, r11.x, r11.y}; }
            const bf16x8 aak = lo2 ? *(const LAS bf16x8*)(sl + CS_AAK + fr * 32 + fg * 16) : zero8;
            const bf16x8 ark = lo2 ? *(const LAS bf16x8*)(sl + CS_ARK + fr * 32 + fg * 16) : zero8;
            const bf16x8 vb  = lo2 ? *(const LAS bf16x8*)(sl + CS_VT + fr * 32 + fg * 16) : zero8;
            union { u32x4 w; bf16x8 h8; } tp, arbp;
            { const u32x2 t2 = *(const LAS u32x2*)(sl + CS_TT + fr * 32 + fg * 8), r2 = *(const LAS u32x2*)(sl + CS_ARB + fr * 32 + fg * 8); tp.w = (u32x4){t2.x, t2.y, 0u, 0u}; arbp.w = (u32x4){r2.x, r2.y, 0u, 0u}; }
            f32x4 Wc = {0.f, 0.f, 0.f, 0.f};
            Wc = __builtin_amdgcn_mfma_f32_16x16x32_bf16(ap0.h8, zb0.h8, Wc, 0, 0, 0);
            Wc = __builtin_amdgcn_mfma_f32_16x16x32_bf16(ap1.h8, zb1.h8, Wc, 0, 0, 0);
            Wc = __builtin_amdgcn_mfma_f32_16x16x32_bf16(aak, vb, Wc, 0, 0, 0);
            union { u32x4 w; bf16x8 h8; } wb, ub;
            wb.w = (u32x4){cvt_pk_bf16(Wc[0], Wc[1]), cvt_pk_bf16(Wc[2], Wc[3]), 0u, 0u};
            f32x4 Uc = {0.f, 0.f, 0.f, 0.f};
            Uc = __builtin_amdgcn_mfma_f32_16x16x32_bf16(tp.h8, wb.h8, Uc, 0, 0, 0);
            ub.w = (u32x4){cvt_pk_bf16(Uc[0], Uc[1]), cvt_pk_bf16(Uc[2], Uc[3]), 0u, 0u};
            f32x4 Yc = {0.f, 0.f, 0.f, 0.f};
            Yc = __builtin_amdgcn_mfma_f32_16x16x32_bf16(rp0.h8, zb0.h8, Yc, 0, 0, 0);
            Yc = __builtin_amdgcn_mfma_f32_16x16x32_bf16(rp1.h8, zb1.h8, Yc, 0, 0, 0);
            Yc = __builtin_amdgcn_mfma_f32_16x16x32_bf16(ark, vb, Yc, 0, 0, 0);
            Yc = __builtin_amdgcn_mfma_f32_16x16x32_bf16(arbp.h8, ub.h8, Yc, 0, 0, 0);
#pragma unroll
            for (int mt = 0; mt < 4; ++mt) {
                const f32x4 pl = *(const LAS f32x4*)(sl + CS_PL + (16 * mt + 4 * fg) * 4);
                const bf16x8 kh = lo2 ? *(const LAS bf16x8*)(sl + CS_KHT + (16 * mt + fr) * 32 + fg * 16) : zero8;
                union { u32x4 w; bf16x8 h8; } bh; { const u32x2 b2 = *(const LAS u32x2*)(sl + CS_BHT + (16 * mt + fr) * 32 + fg * 8); bh.w = (u32x4){b2.x, b2.y, 0u, 0u}; }
                f32x4 zz = zacc[mt] * pl;
                zz = __builtin_amdgcn_mfma_f32_16x16x32_bf16(kh, vb, zz, 0, 0, 0);
                zz = __builtin_amdgcn_mfma_f32_16x16x32_bf16(bh.h8, ub.h8, zz, 0, 0, 0);
                zacc[mt] = zz;
            }
            __builtin_amdgcn_fence(__ATOMIC_RELEASE, "workgroup");
            if (lane == 0) flg[8] = (unsigned)(n + 1);
#pragma unroll
            for (int rr = 0; rr < 4; ++rr) { const int q = 16 * n + 4 * fg + rr, t = z ? (T - 1 - q) : q; yout[(mb + t) * CW] = Yc[rr]; }
        }
    } else {
        const int pi = wave - 1;
        LAS unsigned char* scr = F.lds + CS_SCR + pi * CS_SCRW;
        LAS bf16* KT = (LAS bf16*)scr; LAS bf16* BT = (LAS bf16*)(scr + 2304); LAS float* AABF = (LAS float*)(scr + 4608);
        const bf16* gw_ = (const bf16*)(ws + WS_DECAY) + (size_t)z * M * CW + h * 64 + lane;
        const bf16* gkk = (const bf16*)(ws + WS_KK) + h * 64 + lane;
        const bf16* gak = (const bf16*)(ws + WS_AKK) + (size_t)z * M * CW + h * 64 + lane;
        const bf16* gk = (const bf16*)(ws + WS_KDIR) + (size_t)z * M * CW + h * 64 + lane;
        const bf16* gr = (const bf16*)(ws + WS_R) + h * 64 + lane;
        const bf16* gv = (const bf16*)(ws + WS_V) + h * 64 + ig * 16 + fr;
        bf16 nw[16], nkk[16], nak[16], nk[16], nr[16], nv[4];
#define CS_FETCH(nn) do { if ((nn) < NCK) { _Pragma("unroll") for (int tt = 0; tt < 16; ++tt) { const int q_ = 16 * (nn) + tt; const size_t m_ = mb + (z ? (T - 1 - q_) : q_); \
            nw[tt] = gw_[m_ * CW]; nkk[tt] = gkk[m_ * CW]; nak[tt] = gak[m_ * CW]; nk[tt] = gk[m_ * CW]; nr[tt] = gr[m_ * CW]; } \
            _Pragma("unroll") for (int q4 = 0; q4 < 4; ++q4) { const int q_ = 16 * (nn) + fg + 4 * q4; const size_t m_ = mb + (z ? (T - 1 - q_) : q_); nv[q4] = gv[m_ * CW]; } } } while (0)
        CS_FETCH(pi);
#pragma unroll 1
        for (int n = pi; n < NCK; n += 7) {
            const int slot = n & (CS_R - 1);
            float wv[16], kkv[16], akv[16], kv[16], rv[16], vq[4];
#pragma unroll
            for (int tt = 0; tt < 16; ++tt) { unsigned x0 = nw[tt], x1 = nkk[tt], x2 = nak[tt], x3 = nk[tt], x4 = nr[tt];
                asm volatile("" : "+v"(x0), "+v"(x1), "+v"(x2), "+v"(x3), "+v"(x4));
                wv[tt] = __uint_as_float(x0 << 16); kkv[tt] = __uint_as_float(x1 << 16); akv[tt] = __uint_as_float(x2 << 16); kv[tt] = __uint_as_float(x3 << 16); rv[tt] = __uint_as_float(x4 << 16); }
#pragma unroll
            for (int q4 = 0; q4 < 4; ++q4) { unsigned x0 = nv[q4]; asm volatile("" : "+v"(x0)); vq[q4] = __uint_as_float(x0 << 16); }
            CS_FETCH(n + 7);
            { unsigned sp = 0; while ((int)flg[8] < n - (CS_R - 3)) { __builtin_amdgcn_s_sleep(2); if (++sp > (1u << 24)) break; } }
            __builtin_amdgcn_fence(__ATOMIC_ACQUIRE, "workgroup");
            LAS unsigned char* sl = F.lds + slot * CS_SLOT;
            float P[16];
            P[0] = wv[0];
#pragma unroll
            for (int tt = 1; tt < 16; ++tt) P[tt] = P[tt - 1] * wv[tt];
            const float PL = P[15];
            float khat[16], bhat[16];
#pragma unroll
            for (int tt = 0; tt < 16; ++tt) {
                const float pm1 = tt ? P[tt - 1] : 1.0f, inv = __builtin_amdgcn_rcpf(P[tt]);
                const float at = kkv[tt] * pm1, rt = rv[tt] * P[tt], kt = kv[tt] * inv, bt = -akv[tt] * inv;
                khat[tt] = kt * PL; bhat[tt] = bt * PL;
                *(LAS bf16*)(sl + CS_AT + (tt * CS_LD + lane) * 2) = f2bf(at); *(LAS bf16*)(sl + CS_RT + (tt * CS_LD + lane) * 2) = f2bf(rt);
                KT[tt * CS_LD + lane] = f2bf(kt); BT[tt * CS_LD + lane] = f2bf(bt);
            }
            { u32x4 o0, o1;
              o0.x = cvt_pk_bf16(khat[0], khat[1]); o0.y = cvt_pk_bf16(khat[2], khat[3]); o0.z = cvt_pk_bf16(khat[4], khat[5]); o0.w = cvt_pk_bf16(khat[6], khat[7]);
              o1.x = cvt_pk_bf16(khat[8], khat[9]); o1.y = cvt_pk_bf16(khat[10], khat[11]); o1.z = cvt_pk_bf16(khat[12], khat[13]); o1.w = cvt_pk_bf16(khat[14], khat[15]);
              *(LAS u32x4*)(sl + CS_KHT + lane * 32) = o0; *(LAS u32x4*)(sl + CS_KHT + lane * 32 + 16) = o1;
              o0.x = cvt_pk_bf16(bhat[0], bhat[1]); o0.y = cvt_pk_bf16(bhat[2], bhat[3]); o0.z = cvt_pk_bf16(bhat[4], bhat[5]); o0.w = cvt_pk_bf16(bhat[6], bhat[7]);
              o1.x = cvt_pk_bf16(bhat[8], bhat[9]); o1.y = cvt_pk_bf16(bhat[10], bhat[11]); o1.z = cvt_pk_bf16(bhat[12], bhat[13]); o1.w = cvt_pk_bf16(bhat[14], bhat[15]);
              *(LAS u32x4*)(sl + CS_BHT + lane * 32) = o0; *(LAS u32x4*)(sl + CS_BHT + lane * 32 + 16) = o1; }
            *(LAS float*)(sl + CS_PL + lane * 4) = PL;
#pragma unroll
            for (int q4 = 0; q4 < 4; ++q4) *(LAS bf16*)(sl + CS_VT + (fr * 16 + fg + 4 * q4) * 2) = f2bf(vq[q4]);
            asm volatile("s_waitcnt lgkmcnt(0)" ::: "memory");
            bf16x8 af[2], rf[2], kf[2], bf_[2];
#pragma unroll
            for (int ks = 0; ks < 2; ++ks) { af[ks] = *(const LAS bf16x8*)(sl + CS_AT + (fr * CS_LD + 32 * ks + 8 * fg) * 2); rf[ks] = *(const LAS bf16x8*)(sl + CS_RT + (fr * CS_LD + 32 * ks + 8 * fg) * 2);
                kf[ks] = *(const LAS bf16x8*)(KT + fr * CS_LD + 32 * ks + 8 * fg); bf_[ks] = *(const LAS bf16x8*)(BT + fr * CS_LD + 32 * ks + 8 * fg); }
            f32x4 Aab = {0.f, 0.f, 0.f, 0.f}, Aak = Aab, Arb = Aab, Ark = Aab;
#pragma unroll
            for (int ks = 0; ks < 2; ++ks) { Aab = __builtin_amdgcn_mfma_f32_16x16x32_bf16(af[ks], bf_[ks], Aab, 0, 0, 0); Aak = __builtin_amdgcn_mfma_f32_16x16x32_bf16(af[ks], kf[ks], Aak, 0, 0, 0);
                Arb = __builtin_amdgcn_mfma_f32_16x16x32_bf16(rf[ks], bf_[ks], Arb, 0, 0, 0); Ark = __builtin_amdgcn_mfma_f32_16x16x32_bf16(rf[ks], kf[ks], Ark, 0, 0, 0); }
#pragma unroll
            for (int rr = 0; rr < 4; ++rr) { const int t = 4 * fg + rr; const bool sl_ = fr < t, le_ = fr <= t;
                AABF[t * 16 + fr] = sl_ ? Aab[rr] : 0.f;
                *(LAS bf16*)(sl + CS_AAK + (t * 16 + fr) * 2) = f2bf(sl_ ? Aak[rr] : 0.f);
                *(LAS bf16*)(sl + CS_ARK + (t * 16 + fr) * 2) = f2bf(le_ ? Ark[rr] : 0.f);
                *(LAS bf16*)(sl + CS_ARB + (t * 16 + fr) * 2) = f2bf(le_ ? Arb[rr] : 0.f); }
            asm volatile("s_waitcnt lgkmcnt(0)" ::: "memory");
            float Tc[16];
#pragma unroll
            for (int t = 0; t < 16; ++t) {
                float acc = (t == fr) ? 1.0f : 0.f;
                const f32x4 r0 = *(const LAS f32x4*)(AABF + t * 16), r1 = *(const LAS f32x4*)(AABF + t * 16 + 4), r2 = *(const LAS f32x4*)(AABF + t * 16 + 8), r3 = *(const LAS f32x4*)(AABF + t * 16 + 12);
                const float rowv[16] = {r0.x, r0.y, r0.z, r0.w, r1.x, r1.y, r1.z, r1.w, r2.x, r2.y, r2.z, r2.w, r3.x, r3.y, r3.z, r3.w};
#pragma unroll
                for (int uu = 0; uu < 16; ++uu) if (uu < t) acc += rowv[uu] * Tc[uu];
                Tc[t] = acc;
            }
            if (fg == 0) {
#pragma unroll
                for (int t = 0; t < 16; ++t) *(LAS bf16*)(sl + CS_TT + (t * 16 + fr) * 2) = f2bf(Tc[t]);
            }
            asm volatile("s_waitcnt lgkmcnt(0)" ::: "memory");
            __builtin_amdgcn_fence(__ATOMIC_RELEASE, "workgroup");
            if (lane == 0) flg[slot] = (unsigned)(n + 1);
        }
#undef CS_FETCH
    }
    __syncthreads();
}

__device__ __forceinline__ void combine_phase(const Frame& F, const Args& a) {
    unsigned char* ws = a.ws;
    const bf16* att = (const bf16*)(ws + WS_ATT); const bf16* rr = (const bf16*)(ws + WS_R); const bf16* vv = (const bf16*)(ws + WS_V);
    const bf16* kd = (const bf16*)(ws + WS_KDIR); const bf16* gg = (const bf16*)(ws + WS_G); const float* y = (const float*)(ws + WS_Y);
    bf16* mix = (bf16*)(ws + WS_MIX);
    const float* anw = a.in[4]; const float* r_k = a.in[14]; const float* ln_w = a.in[15]; const float* ln_b = a.in[16];
    const int lane = F.lane, c0 = 8 * lane;
    float nw[8], rk[8], lw[8], lb[8];
#pragma unroll
    for (int i = 0; i < 8; ++i) { nw[i] = anw[c0 + i]; rk[i] = r_k[c0 + i]; lw[i] = ln_w[c0 + i]; lb[i] = ln_b[c0 + i]; }
    const int gw = F.vcu * 8 + F.wave, NGW = F.G * 8;
#pragma unroll 2
    for (int m = gw; m < M; m += NGW) {
        const size_t o = (size_t)m * CW + c0;
        float f[8];
        unpack8(*(const u32x4*)(att + o), f);
        float ss = 0.f;
#pragma unroll
        for (int i = 0; i < 8; ++i) ss += f[i] * f[i];
        const float rs = rsqrtf(wave_sum(ss) * (1.f / CW) + RMS_EPS);
#pragma unroll
        for (int i = 0; i < 8; ++i) f[i] = f[i] * rs * nw[i];
        *(u32x4*)(mix + (size_t)m * D + c0) = pack8(f);
        const f32x4 y0a = *(const f32x4*)(y + o), y0b = *(const f32x4*)(y + o + 4), y1a = *(const f32x4*)(y + (size_t)M * CW + o), y1b = *(const f32x4*)(y + (size_t)M * CW + o + 4);
        float yv[8] = {y0a.x + y1a.x, y0a.y + y1a.y, y0a.z + y1a.z, y0a.w + y1a.w, y0b.x + y1b.x, y0b.y + y1b.y, y0b.z + y1b.z, y0b.w + y1b.w};
        float s1 = 0.f;
#pragma unroll
        for (int i = 0; i < 8; ++i) s1 += yv[i];
        s1 += __shfl_xor(s1, 1); s1 += __shfl_xor(s1, 2); s1 += __shfl_xor(s1, 4);
        const float mean = s1 * (1.f / 64.f);
        float s2 = 0.f;
#pragma unroll
        for (int i = 0; i < 8; ++i) { yv[i] -= mean; s2 += yv[i] * yv[i]; }
        s2 += __shfl_xor(s2, 1); s2 += __shfl_xor(s2, 2); s2 += __shfl_xor(s2, 4);
        const float rstd = rsqrtf(s2 * (1.f / 64.f) + GN_EPS);
        float rf[8], k0[8], k1[8], vf[8], gf[8];
        unpack8(*(const u32x4*)(rr + o), rf); unpack8(*(const u32x4*)(kd + o), k0); unpack8(*(const u32x4*)(kd + (size_t)M * CW + o), k1);
        unpack8(*(const u32x4*)(vv + o), vf); unpack8(*(const u32x4*)(gg + o), gf);
        float cf = 0.f;
#pragma unroll
        for (int i = 0; i < 8; ++i) cf += rf[i] * (k0[i] + k1[i]) * rk[i];
        cf += __shfl_xor(cf, 1); cf += __shfl_xor(cf, 2); cf += __shfl_xor(cf, 4);
#pragma unroll
        for (int i = 0; i < 8; ++i) f[i] = (yv[i] * rstd * lw[i] + lb[i] + cf * vf[i]) * gf[i];
        *(u32x4*)(mix + (size_t)m * D + CW + c0) = pack8(f);
    }
}

constexpr int RT_W = 0, RT_HIST = 131072, RT_LOG = 131072 + 256;
__device__ __forceinline__ void router_phase(const Frame& F, const Args& a) {
    unsigned char* ws = a.ws;
    const float* hbuf = (const float*)(ws + WS_H); unsigned char* hn2 = ws + WS_HN2;
    int* eidx = (int*)(ws + WS_EIDX); float* gate = (float*)(ws + WS_GATE); int* rank = (int*)(ws + WS_RANK);
    unsigned* ctl = (unsigned*)(ws + WS_CTL);
    const float* n2w = a.in[18]; const float* rw = a.in[19]; const float* rb = a.in[20];
    LAS float* wT = (LAS float*)(F.lds + RT_W); LAS int* hist = (LAS int*)(F.lds + RT_HIST); LAS float* lg = (LAS float*)(F.lds + RT_LOG) + F.wave * 64; LAS int* eL = (LAS int*)(F.lds + RT_LOG + 2048);
    { f32x4 tmp[16];
#pragma unroll
      for (int j = 0; j < 16; ++j) tmp[j] = *((const f32x4*)rw + F.tid + 512 * j);
#pragma unroll
      for (int j = 0; j < 16; ++j) { const int q = F.tid + 512 * j, d = q >> 3, e0 = 4 * (q & 7);
          wT[(e0 + 0) * 1024 + d] = tmp[j].x; wT[(e0 + 1) * 1024 + d] = tmp[j].y; wT[(e0 + 2) * 1024 + d] = tmp[j].z; wT[(e0 + 3) * 1024 + d] = tmp[j].w; } }
    if (F.tid < 32) hist[F.tid] = 0;
    __syncthreads();
    const int lane = F.lane;
    f32x4 wn[4];
#pragma unroll
    for (int j = 0; j < 4; ++j) wn[j] = *((const f32x4*)n2w + lane + 64 * j);
    const int blk = F.vcu;
    for (int pr = 0; pr < 8; ++pr) {
        const int m0 = blk * 128 + F.wave * 16 + pr * 2;
        f32x4 xv[2][4];
#pragma unroll
        for (int tk = 0; tk < 2; ++tk) {
            const f32x4* hr = (const f32x4*)(hbuf + (size_t)(m0 + tk) * D) + lane;
            float s = 0.f;
#pragma unroll
            for (int j = 0; j < 4; ++j) { xv[tk][j] = hr[64 * j]; s += (xv[tk][j].x * xv[tk][j].x + xv[tk][j].y * xv[tk][j].y) + (xv[tk][j].z * xv[tk][j].z + xv[tk][j].w * xv[tk][j].w); }
            const float rs = rsqrtf(wave_sum(s) * (1.f / D) + RMS_EPS);
            unsigned* o4 = (unsigned*)(hn2 + (size_t)(m0 + tk) * D) + lane;
#pragma unroll
            for (int j = 0; j < 4; ++j) { xv[tk][j] = xv[tk][j] * rs * wn[j]; o4[64 * j] = pk4_fp8(xv[tk][j].x * F8_SX, xv[tk][j].y * F8_SX, xv[tk][j].z * F8_SX, xv[tk][j].w * F8_SX); }
        }
        float kA0 = 0.f, kB0 = 0.f, kA1 = 0.f, kB1 = 0.f;
#pragma unroll 4
        for (int e = 0; e < 32; ++e) {
            float p0 = 0.f, p1 = 0.f;
#pragma unroll
            for (int j = 0; j < 4; ++j) { const f32x4 w4 = *(const LAS f32x4*)(wT + e * 1024 + 256 * j + 4 * lane);
                p0 += (w4.x * xv[0][j].x + w4.y * xv[0][j].y) + (w4.z * xv[0][j].z + w4.w * xv[0][j].w);
                p1 += (w4.x * xv[1][j].x + w4.y * xv[1][j].y) + (w4.z * xv[1][j].z + w4.w * xv[1][j].w); }
            p0 = row16_sum(p0); p1 = row16_sum(p1);
            const bool me = (lane & 15) == (e & 15);
            if (e < 16) { kA0 = me ? p0 : kA0; kA1 = me ? p1 : kA1; } else { kB0 = me ? p0 : kB0; kB1 = me ? p1 : kB1; }
        }
        kA0 += __shfl_xor(kA0, 16); kA0 += __shfl_xor(kA0, 32); kB0 += __shfl_xor(kB0, 16); kB0 += __shfl_xor(kB0, 32);
        kA1 += __shfl_xor(kA1, 16); kA1 += __shfl_xor(kA1, 32); kB1 += __shfl_xor(kB1, 16); kB1 += __shfl_xor(kB1, 32);
        if (lane < 32) { const int tk = lane >> 4, el = lane & 15; lg[tk * 32 + el] = (tk ? kA1 : kA0) + rb[el]; lg[tk * 32 + 16 + el] = (tk ? kB1 : kB0) + rb[16 + el]; }
        asm volatile("s_waitcnt lgkmcnt(0)" ::: "memory");
        if (lane < 2) {
            const LAS float* L = lg + lane * 32; const int m = m0 + lane;
            float v[32];
#pragma unroll
            for (int e = 0; e < 32; ++e) v[e] = L[e];
            float tv[4]; int ti[4];
#pragma unroll
            for (int kx = 0; kx < 4; ++kx) { float best = -3.0e38f; int bi = 0;
#pragma unroll
                for (int e = 0; e < 32; ++e) { if (v[e] > best) { best = v[e]; bi = e; } }
                tv[kx] = best; ti[kx] = bi;
#pragma unroll
                for (int e = 0; e < 32; ++e) { if (e == bi) v[e] = -3.0e38f; } }
            const float e0 = 1.0f, e1 = __expf(tv[1] - tv[0]), e2 = __expf(tv[2] - tv[0]), e3 = __expf(tv[3] - tv[0]);
            const float is = 1.0f / (e0 + e1 + e2 + e3);
            const float gs[4] = {e0 * is, e1 * is, e2 * is, e3 * is};
#pragma unroll
            for (int kx = 0; kx < 4; ++kx) { eidx[m * 4 + kx] = ti[kx]; gate[m * 4 + kx] = gs[kx]; eL[(m - blk * 128) * 4 + kx] = ti[kx]; }
        }
        asm volatile("s_waitcnt lgkmcnt(0)" ::: "memory");
    }
    __syncthreads();
    { const int t = F.tid, e = eL[t]; int rk = 0;
      for (int u = 0; u < t; ++u) rk += (eL[u] == e) ? 1 : 0;
      rank[(blk * 128) * 4 + t] = rk;
      __hip_atomic_fetch_add(&hist[e], 1, __ATOMIC_RELAXED, __HIP_MEMORY_SCOPE_WORKGROUP); }
    __syncthreads();
    if (F.tid < 32) ctl[CW_CNT + blk * 32 + F.tid] = (unsigned)hist[F.tid];
}

__device__ __forceinline__ void dispatch_phase(const Frame& F, const Args& a) {
    unsigned char* ws = a.ws;
    unsigned* ctl = (unsigned*)(ws + WS_CTL);
    const int* eidx = (const int*)(ws + WS_EIDX); const int* rank = (const int*)(ws + WS_RANK); int* dest = (int*)(ws + WS_DEST);
    LAS int* part = (LAS int*)F.lds;
    LAS int* tot = part + 1024;
    const int blk = F.vcu, G = F.G;
    { const int e = F.tid & 31, pt = F.tid >> 5; int s = 0, sb = 0;
      if (G == 256) { int cv[16];
#pragma unroll
          for (int q = 0; q < 16; ++q) cv[q] = (int)ld_u32_agent(ctl + CW_CNT + (pt + 16 * q) * 32 + e);
#pragma unroll
          for (int q = 0; q < 16; ++q) { s += cv[q]; if (pt + 16 * q < blk) sb += cv[q]; } }
      else for (int bb = pt; bb < G; bb += 16) { const int cval = (int)ld_u32_agent(ctl + CW_CNT + bb * 32 + e); s += cval; if (bb < blk) sb += cval; }
      part[pt * 32 + e] = s; part[512 + pt * 32 + e] = sb; }
    __syncthreads();
    if (F.tid < 32) { int s = 0, sb = 0;
        for (int pt = 0; pt < 16; ++pt) { s += part[pt * 32 + F.tid]; sb += part[512 + pt * 32 + F.tid]; }
        tot[F.tid] = s; tot[32 + F.tid] = sb; tot[96 + F.tid] = (s + 255) & ~255; }
    __syncthreads();
    if (F.tid == 0) { int ps = 0; for (int e = 0; e < 32; ++e) { tot[64 + e] = ps; ps += tot[96 + e]; }
        tot[128] = ps >> 8; }
    __syncthreads();
    if (blk == 0) {
        if (F.tid == 0) ctl[CW_NT] = (unsigned)tot[128];
        for (int e = F.tid >> 4; e < 32; e += 32) { const int t0 = tot[64 + e] >> 8, nt = tot[96 + e] >> 8; for (int i = F.tid & 15; i < nt; i += 16) ctl[CW_TEXP + t0 + i] = (unsigned)e; }
    }
    const int lane = F.lane;
    const int mw = blk * 128 + F.wave * 16;
    int* rowtok = (int*)(ws + WS_ROWTOK);
    { const int e = eidx[mw * 4 + lane]; const int dl = tot[64 + e] + tot[32 + e] + rank[mw * 4 + lane]; dest[mw * 4 + lane] = dl; rowtok[dl] = mw + (lane >> 2); }
    { const int e = blk & 31, pt = blk >> 5, np = G >> 5; const int r0 = tot[64 + e] + tot[e], r1 = tot[64 + e] + tot[96 + e];
      if (np > 0) for (int r = r0 + pt * 512 + F.tid; r < r1; r += np * 512) rowtok[r] = 0; }
}

__device__ __forceinline__ void final_phase(const Frame& F, const Args& a) {
    unsigned char* ws = a.ws;
    const float* hbuf = (const float*)(ws + WS_H); const bf16* ybuf = (const bf16*)(ws + WS_YBUF);
    const int* dest = (const int*)(ws + WS_DEST); const float* gate = (const float*)(ws + WS_GATE);
    const float* fw = a.in[25]; float* out = a.out;
    const int lane = F.lane;
    f32x4 wn[4];
#pragma unroll
    for (int j = 0; j < 4; ++j) wn[j] = *((const f32x4*)fw + lane + 64 * j);
    const int gw = F.vcu * 8 + F.wave, NGW = F.G * 8;
    const int per = M / NGW;
    const int mw = gw * per;
    int dl = 0; float gl = 0.f;
    if (lane < 4 * per && per <= 16) { dl = dest[mw * 4 + lane]; gl = gate[mw * 4 + lane]; }
#pragma unroll 2
    for (int i = 0; i < per; ++i) {
        const int m = mw + i;
        const f32x4* hr = (const f32x4*)(hbuf + (size_t)m * D) + lane;
        f32x4 v[4];
#pragma unroll
        for (int j = 0; j < 4; ++j) v[j] = hr[64 * j];
#pragma unroll
        for (int kx = 0; kx < 4; ++kx) {
            const int d = per <= 16 ? __shfl(dl, 4 * i + kx) : dest[m * 4 + kx]; const float gt = per <= 16 ? __shfl(gl, 4 * i + kx) : gate[m * 4 + kx];
            const u32x2* yr = (const u32x2*)(ybuf + (size_t)d * D) + lane;
#pragma unroll
            for (int j = 0; j < 4; ++j) { const u32x2 w = yr[64 * j]; v[j].x += gt * bflo(w.x); v[j].y += gt * bfhi(w.x); v[j].z += gt * bflo(w.y); v[j].w += gt * bfhi(w.y); }
        }
        float s = 0.f;
#pragma unroll
        for (int j = 0; j < 4; ++j) s += (v[j].x * v[j].x + v[j].y * v[j].y) + (v[j].z * v[j].z + v[j].w * v[j].w);
        const float rs = rsqrtf(wave_sum(s) * (1.f / D) + RMS_EPS);
        f32x4* orow = (f32x4*)(out + (size_t)m * D) + lane;
#pragma unroll
        for (int j = 0; j < 4; ++j) orow[64 * j] = v[j] * rs * wn[j];
    }
}

__global__ void __launch_bounds__(512, 2) fwd_megakernel(Args args) {
    extern __shared__ __attribute__((aligned(16))) unsigned char lds_raw[];
    Frame F;
    F.lds = (LAS unsigned char*)lds_raw;
    F.tid = threadIdx.x; F.lane = F.tid & 63; F.wave = __builtin_amdgcn_readfirstlane(F.tid >> 6);
    F.G = gridDim.x; { const int bx = blockIdx.x; F.vcu = (F.G % 8 == 0) ? (bx % 8) * (F.G / 8) + bx / 8 : bx; }
    unsigned char* ws = args.ws;
    const int lo = args.ph_lo, hi = args.ph_hi;
#define IN(k) (lo <= (k) && (k) < hi)
#if MK_SPLIT
#define SEAM(k) do { } while (0)
#else
    cg::grid_group grid = cg::this_grid();
    { volatile LAS unsigned* st = (volatile LAS unsigned*)(F.lds + LDS_MISC); if (F.tid < 2) st[F.tid] = 0u; __syncthreads(); }
    const XcdBarrier xbar = xcd_barrier_post((unsigned*)(ws + WS_CTL) + CW_BAR, (volatile LAS unsigned*)(F.lds + LDS_MISC));
    if (lo < 0) grid.sync();
#define SEAM(k) do { if (IN(k) && IN((k) + 1)) xcd_barrier(xbar); } while (0)
#endif
#define REP2(k) if constexpr (((MK_REPEAT >> (k)) & 1) != 0)
#define PH1 { pg8::Gemm g{(const bf16*)(ws + WS_HN), (const bf16*)(ws + WS_WINT), 1024, nullptr, 0, nullptr}; \
        pg8::StaticOrder S; S.init(M / 256, NPROJ_PAD / 256, F.G, (int)blockIdx.x); \
        pg8::EpiProj E{(bf16*)(ws + WS_Q), (bf16*)(ws + WS_K), (bf16*)(ws + WS_VT), (bf16*)(ws + WS_P)}; \
        pg8::gemm_phase<pg8::EpiProj, true, true>(F.lds, g, S, E); }
#define PH5 { pg8::Gemm g{(const bf16*)(ws + WS_MIX), (const bf16*)(ws + WS_WOT), 1024, nullptr, 0, nullptr}; \
        pg8::StaticOrder S; S.init(M / 256, D / 256, F.G, (int)blockIdx.x); \
        pg8::EpiWo E{args.in[0], (float*)(ws + WS_H)}; \
        pg8::gemm_phase<pg8::EpiWo, true, true>(F.lds, g, S, E); }
#define PH8 { const unsigned* ctl = (const unsigned*)(ws + WS_CTL); const int ntile = (int)ld_u32_agent(ctl + CW_NT); \
        pg8::Gemm g{(const bf16*)(ws + WS_HN2), (const bf16*)(ws + WS_WUPT), 512, ctl + CW_TEXP, (size_t)2048 * 1024, (const int*)(ws + WS_ROWTOK)}; \
        pg8::StaticOrder S; S.init(ntile, 8, F.G, (int)blockIdx.x); \
        pg8::EpiUp E{args.in[22], ws + WS_ACT}; \
        pg8::gemm_phase<pg8::EpiUp, true, true, true, true>(F.lds, g, S, E); }
#define PH9 { const unsigned* ctl = (const unsigned*)(ws + WS_CTL); const int ntile = (int)ld_u32_agent(ctl + CW_NT); \
        pg8::Gemm g{(const bf16*)(ws + WS_ACT), (const bf16*)(ws + WS_WDNT), 512, ctl + CW_TEXP, (size_t)1024 * 1024, nullptr}; \
        pg8::StaticOrder S; S.init(ntile, 4, F.G, (int)blockIdx.x); \
        pg8::EpiDown E{args.in[24], (bf16*)(ws + WS_YBUF)}; \
        pg8::gemm_phase<pg8::EpiDown, true, true, false, true>(F.lds, g, S, E); }
    if (IN(0)) { p0_prologue(F, args); REP2(0) p0_prologue(F, args); }
    SEAM(0);
    if (IN(1)) { PH1 REP2(1) PH1 }
    SEAM(1);
    if (IN(2)) { prep_phase<true>(F, args); REP2(2) prep_phase<true>(F, args); attn_phase(F, args); REP2(11) attn_phase(F, args); }
    SEAM(2);
    if (IN(3)) { scan_phase(F, args); REP2(3) scan_phase(F, args); }
    SEAM(3);
    if (IN(4)) { combine_phase(F, args); REP2(4) combine_phase(F, args); }
    SEAM(4);
    if (IN(5)) { PH5 REP2(5) PH5 }
    SEAM(5);
    if (IN(6)) { router_phase(F, args); REP2(6) { __syncthreads(); router_phase(F, args); } }
    SEAM(6);
    if (IN(7)) { dispatch_phase(F, args); REP2(7) { __syncthreads(); dispatch_phase(F, args); } }
    SEAM(7);
    if (IN(8)) { PH8 REP2(8) PH8 }
    SEAM(8);
    if (IN(9)) { PH9 REP2(9) PH9 }
    SEAM(9);
    if (IN(10)) { final_phase(F, args); REP2(10) final_phase(F, args); }
#undef IN
#undef SEAM
}

extern "C" void kernel_launch(void* const* d_in, const int* in_sizes, int n_in, void* d_out, int out_size, void* d_ws, size_t ws_size, hipStream_t stream) {
    static int grid = 0;
    if (grid == 0) {
        if (n_in != 26 || in_sizes[0] != M * D || out_size != M * D || ws_size < WS_END) { fprintf(stderr, "kernel_launch: unexpected problem (n_in %d, in0 %d, out %d, ws %zu)\n", n_in, n_in > 0 ? in_sizes[0] : -1, out_size, ws_size); grid = -1; return; }
        int dev = 0, cus = 0, per_cu = 0;
        if (hipGetDevice(&dev) != hipSuccess || hipDeviceGetAttribute(&cus, hipDeviceAttributeMultiprocessorCount, dev) != hipSuccess) { grid = -1; return; }
        if (hipFuncSetAttribute((const void*)fwd_megakernel, hipFuncAttributeMaxDynamicSharedMemorySize, LDS_BYTES) != hipSuccess) { fprintf(stderr, "kernel_launch: hipFuncSetAttribute failed\n"); grid = -1; return; }
        if (hipOccupancyMaxActiveBlocksPerMultiprocessor(&per_cu, (const void*)fwd_megakernel, 512, LDS_BYTES) != hipSuccess || per_cu < 1) { fprintf(stderr, "kernel_launch: occupancy query says %d\n", per_cu); per_cu = 1; }
        (void)hipGetLastError();
        grid = cus * 1;
        if (grid != 256) fprintf(stderr, "kernel_launch: note: %d CUs\n", cus);
    }
    if (grid < 0) return;
    if (hipMemsetAsync((char*)d_ws + WS_CTL + (size_t)CW_BAR * 4, 0, XCD_BAR_WORDS * 4, stream) != hipSuccess) { fprintf(stderr, "kernel_launch: memset failed\n"); return; }
    Args a{};
    for (int i = 0; i < 26; ++i) a.in[i] = (const float*)d_in[i];
    a.out = (float*)d_out; a.ws = (unsigned char*)d_ws;
#if MK_SPLIT
    for (int ph = 0; ph < NPHASE; ++ph) { a.ph_lo = ph; a.ph_hi = ph + 1; hipLaunchKernelGGL(fwd_megakernel, dim3(grid), dim3(512), LDS_BYTES, stream, a); }
#else
    a.ph_lo = 0; a.ph_hi = NPHASE;
    void* kargs[] = {&a};
    hipError_t e = hipLaunchCooperativeKernel((const void*)fwd_megakernel, dim3(grid), dim3(512), kargs, LDS_BYTES, stream);
    if (e != hipSuccess) fprintf(stderr, "kernel_launch: cooperative launch failed: %s (grid %d)\n", hipGetErrorString(e), grid);
#endif
}
```

```cpp
#include <hip/hip_runtime.h>
#include <hip/hip_cooperative_groups.h>
#include <cstdio>
#include <cstdint>
namespace cg = cooperative_groups;

#ifndef MK_SPLIT
#define MK_SPLIT 0
#endif

#ifndef MK_REPEAT
#define MK_REPEAT 0
#endif
#define LAS __attribute__((address_space(3)))
typedef unsigned short bf16;
typedef float f32x4 __attribute__((ext_vector_type(4)));
typedef float f32x2 __attribute__((ext_vector_type(2)));
typedef unsigned u32x4 __attribute__((ext_vector_type(4)));
typedef unsigned u32x2 __attribute__((ext_vector_type(2)));
typedef short bf16x8 __attribute__((ext_vector_type(8)));
typedef short s16x4 __attribute__((ext_vector_type(4)));

constexpr int BATCH = 4, T = 8192, D = 1024, M = BATCH * T;
constexpr int NH = 8, HD = 64, CW = 512;
constexpr int SHIFT_W = 1920, NPROJ = 3456, NPROJ_PAD = 3584, PW = 2048;
constexpr int NE = 32, TOPK = 4, DE = 1024;
constexpr int GRIDW = 64, GROWS = 128;
constexpr int P_TILES_MAX = 544, P_ROWS = P_TILES_MAX * 256;
constexpr float RMS_EPS = 1e-5f, GN_EPS = 64e-5f;
constexpr int NPHASE = 11;

constexpr size_t MiB = 1u << 20;
constexpr size_t WS_CTL = 0;
constexpr size_t WS_W2T = 1 * MiB, WS_A2T = WS_W2T + 131072, WS_G2T = WS_A2T + 131072;
constexpr size_t WS_WINT = 2 * MiB, WS_WOT = 9 * MiB, WS_WUPT = 12 * MiB, WS_WDNT = 140 * MiB;
constexpr size_t WS_EIDX = 204 * MiB, WS_GATE = WS_EIDX + 524288, WS_RANK = WS_GATE + 524288, WS_DEST = WS_RANK + 524288, WS_ROWTOK = WS_DEST + 524288;
constexpr size_t WS_R = 208 * MiB, WS_V = 240 * MiB, WS_KK = 272 * MiB, WS_DECAY = 304 * MiB, WS_KDIR = 368 * MiB, WS_AKK = 432 * MiB,
                 WS_G = 496 * MiB, WS_ATT = 528 * MiB;
constexpr size_t WS_Q = 560 * MiB, WS_K = 592 * MiB, WS_VT = 624 * MiB, WS_P = 656 * MiB, WS_HN = 784 * MiB, WS_Y = 848 * MiB;
constexpr size_t WS_MIX = 560 * MiB, WS_H = 752 * MiB, WS_HN2 = 880 * MiB, WS_XBUF = 208 * MiB, WS_ACT = 480 * MiB, WS_YBUF = 208 * MiB;
constexpr size_t WS_END = 976 * MiB;
constexpr int CW_NT = 0, CW_TEXP = 64, CW_CNT = 1024, CW_BAR = 16384;

constexpr int LDS_BYTES = 159744, LDS_MISC = LDS_BYTES - 256;

typedef __bf16 bf16x2_t __attribute__((ext_vector_type(2)));
__device__ __forceinline__ unsigned cvt_pk_bf16(float lo, float hi) { const f32x2 v = {lo, hi}; return __builtin_bit_cast(unsigned, __builtin_convertvector(v, bf16x2_t)); }
typedef int i32x8 __attribute__((ext_vector_type(8)));
typedef int i32x4 __attribute__((ext_vector_type(4)));
#ifndef F8_SCALE1
#define F8_SCALE1 0
#endif
constexpr float F8_SX = 32.0f, F8_SW = 128.0f, F8_SACT = 8.0f;
__device__ __forceinline__ float f8clamp(float v) { return __builtin_amdgcn_fmed3f(v, -448.0f, 448.0f); }
__device__ __forceinline__ unsigned pk4_fp8(float a, float b, float c, float d) { int w = 0; w = __builtin_amdgcn_cvt_pk_fp8_f32(f8clamp(a), f8clamp(b), w, false); w = __builtin_amdgcn_cvt_pk_fp8_f32(f8clamp(c), f8clamp(d), w, true); return (unsigned)w; }
__device__ __forceinline__ float bflo(unsigned u) { return __uint_as_float(u << 16); }
__device__ __forceinline__ float bfhi(unsigned u) { return __uint_as_float(u & 0xffff0000u); }
__device__ __forceinline__ float bf1(bf16 v) { return __uint_as_float(((unsigned)v) << 16); }
__device__ __forceinline__ void unpack8(const u32x4 u, float* f) { f[0] = bflo(u.x); f[1] = bfhi(u.x); f[2] = bflo(u.y); f[3] = bfhi(u.y); f[4] = bflo(u.z); f[5] = bfhi(u.z); f[6] = bflo(u.w); f[7] = bfhi(u.w); }
__device__ __forceinline__ u32x4 pack8(const float* f) { u32x4 o; o.x = cvt_pk_bf16(f[0], f[1]); o.y = cvt_pk_bf16(f[2], f[3]); o.z = cvt_pk_bf16(f[4], f[5]); o.w = cvt_pk_bf16(f[6], f[7]); return o; }
__device__ __forceinline__ float wave_sum(float v) {
#pragma unroll
    for (int o = 1; o < 64; o <<= 1) v += __shfl_xor(v, o);
    return v;
}
__device__ __forceinline__ float sigmoidf_(float x) { return __builtin_amdgcn_rcpf(1.0f + __expf(-x)); }
__device__ __forceinline__ unsigned ld_u32_agent(const unsigned* p) { return __hip_atomic_load(p, __ATOMIC_RELAXED, __HIP_MEMORY_SCOPE_AGENT); }

namespace pg8 {
constexpr int BM = 256, BK = 64, HALF = 128, HTB = HALF * BK * 2, STAGE_BYTES = 8 * HTB, NXCD = 8, WGM = 8;
__host__ __device__ __forceinline__ int lds_byte(int r, int c) { const int st = (r >> 4) * 2 + (c >> 5), rr = r & 15, cc = c & 31, ob = rr * 64 + cc * 2; return st * 1024 + (ob ^ (((ob >> 9) & 1) << 5)); }
__host__ __device__ __forceinline__ void stage_rc(int b, int& R, int& C) { const int st = b / 1024, sb = b % 1024, swz = sb ^ (((sb >> 9) & 1) << 5); R = (st >> 1) * 16 + swz / 64; C = (st & 1) * 32 + (swz % 64) / 2; }
__host__ __device__ __forceinline__ int perm32(int rho) { const int n = rho >> 4, i = rho & 15; return 8 * (i >> 2) + 4 * n + (i & 3); }

struct Unit { int pm, pn, e; };
struct Gemm { const bf16* A; const bf16* Bt; int K; const unsigned* texp; size_t bstride; const int* rowtok; };

struct StaticOrder {
    int nM, nN, nwg, G, c;
    __device__ void init(int nM_, int nN_, int G_, int c_) { nM = nM_; nN = nN_; nwg = nM * nN; G = G_; c = c_; }
    __device__ bool next(int i, Unit& u) const {
        const long L = (long)i * G + c; if (L >= nwg) return false;
        int wgid = (int)L; { const int q = nwg / NXCD, r = nwg % NXCD, xcd = wgid % NXCD, off = wgid / NXCD; wgid = (xcd < r ? xcd * (q + 1) : r * (q + 1) + (xcd - r) * q) + off; }
        const int nig = WGM * nN, gid = wgid / nig, fm = gid * WGM, gsz = (nM - fm) < WGM ? (nM - fm) : WGM;
        u.pm = fm + ((wgid % nig) % gsz); u.pn = (wgid % nig) / gsz; u.e = 0; return true;
    }
};

__device__ __forceinline__ i32x8 cat8(const bf16x8 lo, const bf16x8 hi) { return __builtin_shufflevector(__builtin_bit_cast(i32x4, lo), __builtin_bit_cast(i32x4, hi), 0, 1, 2, 3, 4, 5, 6, 7); }
template <class Epi, bool ALIGN_EPI, bool SP2, bool GATHER = false, bool FP8 = false>
__device__ __forceinline__ void gemm_phase(LAS unsigned char* lds, const Gemm g, const StaticOrder& S, const Epi& E) {
    const int tid = threadIdx.x, wid = __builtin_amdgcn_readfirstlane(tid >> 6), lane = tid & 63, wr = wid >> 2, wc = wid & 3, fr = lane & 15, fq = lane >> 4;
    const int K = g.K, nt = K / BK;
    unsigned voffA[2], voffB[2];
#pragma unroll
    for (int i = 0; i < 2; ++i) { int R, C; stage_rc(tid * 16 + i * 8192, R, C); const int Rb = Epi::PERM ? ((R & ~31) + perm32(R & 31)) : R;
        voffA[i] = (unsigned)(R * K + C) * 2u; voffB[i] = (unsigned)(Rb * K + C) * 2u; }
    unsigned vC[2][2];
#define PG8_GROWS(u, dst) do { _Pragma("unroll") for (int h_ = 0; h_ < 2; ++h_) _Pragma("unroll") for (int i_ = 0; i_ < 2; ++i_) { int R_, C_; stage_rc(tid * 16 + i_ * 8192, R_, C_); \
        dst[h_][i_] = (unsigned)g.rowtok[(u).pm * BM + h_ * HALF + R_] * (unsigned)(K * 2) + (unsigned)(C_ * 2); } } while (0)
    const size_t kstep = (size_t)(BK * 2);
    const size_t hstep = (size_t)HALF * K * 2;
    const size_t tstep = 2 * hstep;
    const unsigned ldsw = (unsigned)wid * 1024u;
    const int aoff = lds_byte(wr * 64 + fr, fq * 8), boff = lds_byte(wc * 32 + fr, fq * 8);
#define PG8_SA(b, h) (((b) * 2 + (h)) * HTB)
#define PG8_SB(b, h) ((4 + (b) * 2 + (h)) * HTB)
#define PG8_STAGE(bufoff, gbase, voff) do { _Pragma("unroll") for (int _i = 0; _i < 2; ++_i) \
        __builtin_amdgcn_global_load_lds((const unsigned*)((const char*)(gbase) + (voff)[_i]), (LAS unsigned*)(lds + (bufoff) + ldsw + _i * 8192), 16, 0, 0); } while (0)
#define PG8_STAGE_A(bufoff, p, h, nx) do { if constexpr (GATHER) { PG8_STAGE(bufoff, p, vC[h]); } else PG8_STAGE(bufoff, (p) + (h) * hstep, voffA); } while (0)
#define PG8_LDA(dst, b, h) do { _Pragma("unroll") for (int m = 0; m < 4; ++m) _Pragma("unroll") for (int k = 0; k < 2; ++k) dst[m][k] = *(const LAS bf16x8*)(lds + PG8_SA(b, h) + aoff + m * 2048 + k * 1024); } while (0)
#define PG8_LDB(dst, b, h) do { _Pragma("unroll") for (int n = 0; n < 2; ++n) _Pragma("unroll") for (int k = 0; k < 2; ++k) dst[n][k] = *(const LAS bf16x8*)(lds + PG8_SB(b, h) + boff + n * 2048 + k * 1024); } while (0)
#define PG8_MMA(ai, bj, At, Bt) do { __builtin_amdgcn_s_setprio(1); \
        if constexpr (FP8) { _Pragma("unroll") for (int m = 0; m < 4; ++m) _Pragma("unroll") for (int n = 0; n < 2; ++n) \
            { const i32x8 b8_ = cat8(Bt[n][0], Bt[n][1]), a8_ = cat8(At[m][0], At[m][1]); asm volatile("v_mfma_f32_16x16x128_f8f6f4 %0, %1, %2, %0" : "+v"(acc[ai][bj][m][n]) : "v"(b8_), "v"(a8_)); } } \
        else { _Pragma("unroll") for (int m = 0; m < 4; ++m) _Pragma("unroll") for (int n = 0; n < 2; ++n) _Pragma("unroll") for (int k = 0; k < 2; ++k) \
            acc[ai][bj][m][n] = __builtin_amdgcn_mfma_f32_16x16x32_bf16(Bt[n][k], At[m][k], acc[ai][bj][m][n], 0, 0, 0); } \
        __builtin_amdgcn_s_setprio(0); } while (0)
#define PG8_WAIT_V(n) asm volatile("s_waitcnt vmcnt(" #n ")" ::: "memory")
#define PG8_WAIT_L(n) asm volatile("s_waitcnt lgkmcnt(" #n ")" ::: "memory")
#define PG8_BAR __builtin_amdgcn_s_barrier()
#define PG8_SCHED __builtin_amdgcn_sched_barrier(0)
#define PG8_UPTR(u, pa, pb) do { unsigned _e = g.texp ? ld_u32_agent(g.texp + (u).pm) : 0u; _e = (unsigned)__builtin_amdgcn_readfirstlane((int)_e); (u).e = (int)_e; \
        pa = GATHER ? (const char*)g.A : (const char*)g.A + (size_t)(u).pm * tstep; pb = (const char*)g.Bt + (size_t)_e * g.bstride + (size_t)(u).pn * tstep; } while (0)
    Unit cur, nxt; int ui = 0;
    if (!S.next(0, cur)) return;
    f32x4 acc[2][2][4][2];
#pragma unroll
    for (int a = 0; a < 2; ++a)
#pragma unroll
        for (int b = 0; b < 2; ++b)
#pragma unroll
            for (int m = 0; m < 4; ++m)
#pragma unroll
                for (int n = 0; n < 2; ++n) acc[a][b][m][n] = (f32x4){0.f, 0.f, 0.f, 0.f};
    bf16x8 At[4][2], B0[2][2], B1[2][2];
    const char* cA; const char* cB;
    PG8_UPTR(cur, cA, cB);
    if constexpr (GATHER) { PG8_GROWS(cur, vC); }
    if constexpr (SP2) {
        PG8_STAGE(PG8_SB(0, 0), cB, voffB); PG8_STAGE(PG8_SB(0, 1), cB + hstep, voffB); PG8_STAGE_A(PG8_SA(0, 0), cA, 0, false); PG8_STAGE_A(PG8_SA(0, 1), cA, 1, false);
        if (wr == 1) PG8_BAR;
        PG8_WAIT_V(2); PG8_BAR;
        PG8_STAGE(PG8_SB(1, 0), cB + kstep, voffB); PG8_STAGE_A(PG8_SA(1, 0), cA + kstep, 0, false); PG8_STAGE(PG8_SB(1, 1), cB + hstep + kstep, voffB);
        PG8_WAIT_V(6); PG8_BAR;
    } else {
        PG8_STAGE(PG8_SB(0, 0), cB, voffB); PG8_STAGE_A(PG8_SA(0, 0), cA, 0, false); PG8_STAGE(PG8_SB(0, 1), cB + hstep, voffB); PG8_STAGE_A(PG8_SA(0, 1), cA, 1, false);
        if (wr == 1) PG8_BAR;
        PG8_WAIT_V(4); PG8_BAR;
        PG8_STAGE(PG8_SB(1, 0), cB + kstep, voffB); PG8_STAGE_A(PG8_SA(1, 0), cA + kstep, 0, false); PG8_STAGE(PG8_SB(1, 1), cB + hstep + kstep, voffB);
        PG8_WAIT_V(6); PG8_BAR;
    }
    for (;;) {
        const bool has_next = S.next(ui + 1, nxt);
        const char* nA = cA; const char* nB = cB;
        if (has_next) PG8_UPTR(nxt, nA, nB);
#pragma unroll 1
        for (int t = 0; t < nt; t += 2) {
            const bool last = (t == nt - 2);
            const char* a1 = cA + (size_t)(t + 1) * kstep;
            const char* a2 = last ? nA : cA + (size_t)(t + 2) * kstep; const char* b2 = last ? nB : cB + (size_t)(t + 2) * kstep;
            const char* a3 = a2 + kstep; const char* b3 = b2 + kstep;
            if constexpr (SP2) {
            PG8_LDB(B0, 0, 0); PG8_LDB(B1, 0, 1); PG8_SCHED; PG8_LDA(At, 0, 0); PG8_STAGE_A(PG8_SA(1, 1), a1, 1, false);
            if constexpr (GATHER) { if (last && has_next) { PG8_GROWS(nxt, vC); } }
            PG8_WAIT_V(8); PG8_WAIT_L(0); PG8_BAR; PG8_MMA(0, 0, At, B0); PG8_MMA(0, 1, At, B1); PG8_BAR; PG8_SCHED;
            PG8_LDA(At, 0, 1); PG8_STAGE(PG8_SB(0, 0), b2, voffB); PG8_STAGE(PG8_SB(0, 1), b2 + hstep, voffB); PG8_STAGE_A(PG8_SA(0, 0), a2, 0, last);
            PG8_WAIT_V(8); PG8_WAIT_L(0); PG8_BAR; PG8_MMA(1, 0, At, B0); PG8_MMA(1, 1, At, B1); PG8_BAR; PG8_SCHED;
            PG8_LDB(B0, 1, 0); PG8_LDB(B1, 1, 1); PG8_SCHED; PG8_LDA(At, 1, 0); PG8_STAGE_A(PG8_SA(0, 1), a2, 1, last);
            PG8_WAIT_V(8); PG8_WAIT_L(0); PG8_BAR; PG8_MMA(0, 0, At, B0); PG8_MMA(0, 1, At, B1); PG8_BAR; PG8_SCHED;
            PG8_LDA(At, 1, 1); PG8_STAGE(PG8_SB(1, 0), b3, voffB); PG8_STAGE(PG8_SB(1, 1), b3 + hstep, voffB); PG8_STAGE_A(PG8_SA(1, 0), a3, 0, last);
            PG8_WAIT_V(8); PG8_WAIT_L(0); PG8_BAR; PG8_MMA(1, 0, At, B0); PG8_MMA(1, 1, At, B1); PG8_BAR; PG8_SCHED;
            } else {
            PG8_LDB(B0, 0, 0); PG8_SCHED; PG8_LDA(At, 0, 0); PG8_STAGE_A(PG8_SA(1, 1), a1, 1, false);
            if constexpr (GATHER) { if (last && has_next) { PG8_GROWS(nxt, vC); } }
            PG8_WAIT_L(8); PG8_BAR; PG8_WAIT_L(0); PG8_MMA(0, 0, At, B0); PG8_BAR; PG8_SCHED;
            PG8_LDB(B1, 0, 1); PG8_STAGE(PG8_SB(0, 0), b2, voffB);
            PG8_BAR; PG8_WAIT_L(0); PG8_MMA(0, 1, At, B1); PG8_BAR;
            PG8_LDA(At, 0, 1); PG8_STAGE_A(PG8_SA(0, 0), a2, 0, last);
            PG8_BAR; PG8_WAIT_L(0); PG8_MMA(1, 0, At, B0); PG8_BAR; PG8_SCHED;
            PG8_STAGE(PG8_SB(0, 1), b2 + hstep, voffB);
            PG8_WAIT_V(6); PG8_BAR; PG8_MMA(1, 1, At, B1); PG8_BAR;
            PG8_LDB(B0, 1, 0); PG8_SCHED; PG8_LDA(At, 1, 0); PG8_STAGE_A(PG8_SA(0, 1), a2, 1, last);
            PG8_WAIT_L(8); PG8_BAR; PG8_WAIT_L(0); PG8_MMA(0, 0, At, B0); PG8_BAR; PG8_SCHED;
            PG8_LDB(B1, 1, 1); PG8_STAGE(PG8_SB(1, 0), b3, voffB);
            PG8_BAR; PG8_WAIT_L(0); PG8_MMA(0, 1, At, B1); PG8_BAR;
            PG8_LDA(At, 1, 1); PG8_STAGE_A(PG8_SA(1, 0), a3, 0, last);
            PG8_BAR; PG8_WAIT_L(0); PG8_MMA(1, 0, At, B0); PG8_BAR; PG8_SCHED;
            PG8_STAGE(PG8_SB(1, 1), b3 + hstep, voffB);
            PG8_WAIT_V(6); PG8_BAR; PG8_MMA(1, 1, At, B1); PG8_BAR;
            }
        }
        if constexpr (ALIGN_EPI) { if (wr == 0) PG8_BAR; }
        if constexpr (FP8) { asm volatile("s_nop 15\n\ts_nop 15" ::: "memory"); PG8_SCHED; }
        E(acc, cur, wr, wc, fr, fq);
        if (!has_next) break;
#pragma unroll
        for (int a = 0; a < 2; ++a)
#pragma unroll
            for (int b = 0; b < 2; ++b)
#pragma unroll
                for (int m = 0; m < 4; ++m)
#pragma unroll
                    for (int n = 0; n < 2; ++n) acc[a][b][m][n] = (f32x4){0.f, 0.f, 0.f, 0.f};
        cur = nxt; cA = nA; cB = nB; ++ui;
        if constexpr (ALIGN_EPI) { if (wr == 1) PG8_BAR; }
    }
    PG8_WAIT_V(0);
    if constexpr (!ALIGN_EPI) { if (wr == 0) PG8_BAR; }
    PG8_BAR;
#undef PG8_SA
#undef PG8_SB
#undef PG8_STAGE
#undef PG8_LDA
#undef PG8_LDB
#undef PG8_MMA
#undef PG8_WAIT_V
#undef PG8_WAIT_L
#undef PG8_BAR
#undef PG8_SCHED
#undef PG8_UPTR
#undef PG8_STAGE_A
#undef PG8_GROWS
}

struct EpiProj {
    static constexpr bool PERM = true;
    bf16 *q, *k, *vT, *p;
    __device__ __forceinline__ void operator()(const f32x4 (&acc)[2][2][4][2], const Unit& u, int wr, int wc, int fr, int fq) const {
        const int row0 = u.pm * BM + wr * 64 + fr;
        const int pn = u.pn;
#pragma unroll
        for (int ai = 0; ai < 2; ++ai)
#pragma unroll
            for (int m = 0; m < 4; ++m) {
                const int row = row0 + ai * HALF + m * 16;
#pragma unroll
                for (int bj = 0; bj < 2; ++bj) {
                    f32x4 v0 = acc[ai][bj][m][0], v1 = acc[ai][bj][m][1];
                    const int col = pn * BM + bj * HALF + wc * 32 + 8 * fq;
                    if (pn >= 4 && pn < 6) {
                        const int cv = col - 1024, hh = cv >> 6, dim = cv & 63, b = row / T, t = row % T;
                        bf16* dst = vT + ((size_t)(((b * NH + hh) * GROWS + (t >> 6)) * HD + dim)) * 64 + (t & 63);
                        const unsigned w0 = cvt_pk_bf16(v0[0], v0[1]), w1 = cvt_pk_bf16(v0[2], v0[3]), w2 = cvt_pk_bf16(v1[0], v1[1]), w3 = cvt_pk_bf16(v1[2], v1[3]);
                        dst[0 * 64] = (bf16)(w0 & 0xffff); dst[1 * 64] = (bf16)(w0 >> 16); dst[2 * 64] = (bf16)(w1 & 0xffff); dst[3 * 64] = (bf16)(w1 >> 16);
                        dst[4 * 64] = (bf16)(w2 & 0xffff); dst[5 * 64] = (bf16)(w2 >> 16); dst[6 * 64] = (bf16)(w3 & 0xffff); dst[7 * 64] = (bf16)(w3 >> 16);
                    } else {
                        bf16* dst;
                        if (pn < 2) { v0 = v0 * 0.125f; v1 = v1 * 0.125f; dst = q + (size_t)row * CW + col; }
                        else if (pn < 4) dst = k + (size_t)row * CW + (col - 512);
                        else dst = p + (size_t)row * PW + (col - 1536);
                        u32x4 w; w.x = cvt_pk_bf16(v0[0], v0[1]); w.y = cvt_pk_bf16(v0[2], v0[3]); w.z = cvt_pk_bf16(v1[0], v1[1]); w.w = cvt_pk_bf16(v1[2], v1[3]);
                        *(u32x4*)dst = w;
                    }
                }
            }
    }
};
struct EpiWo {
    static constexpr bool PERM = false;
    const float* x; float* h;
    __device__ __forceinline__ void operator()(const f32x4 (&acc)[2][2][4][2], const Unit& u, int wr, int wc, int fr, int fq) const {
        const int row0 = u.pm * BM + wr * 64 + fr, col0 = u.pn * BM + wc * 32 + 4 * fq;
#pragma unroll
        for (int ai = 0; ai < 2; ++ai)
#pragma unroll
            for (int m = 0; m < 4; ++m) { const size_t off = (size_t)(row0 + ai * HALF + m * 16) * D + col0;
#pragma unroll
                for (int bj = 0; bj < 2; ++bj)
#pragma unroll
                    for (int n = 0; n < 2; ++n) { const f32x4 xv = *(const f32x4*)(x + off + bj * HALF + n * 16); *(f32x4*)(h + off + bj * HALF + n * 16) = acc[ai][bj][m][n] + xv; } }
    }
};
struct EpiUp {
    static constexpr bool PERM = true;
    const float* b_up; unsigned char* act;
    __device__ __forceinline__ void operator()(const f32x4 (&acc)[2][2][4][2], const Unit& u, int wr, int wc, int fr, int fq) const {
        const int row0 = u.pm * BM + wr * 64 + fr, ch = u.pn * 128 + wc * 32 + 8 * fq;
        const float* bg = b_up + (size_t)u.e * 2048 + ch; const float* bl = bg + 1024;
        const f32x4 bg0 = *(const f32x4*)bg, bg1 = *(const f32x4*)(bg + 4), bl0 = *(const f32x4*)bl, bl1 = *(const f32x4*)(bl + 4);
#pragma unroll
        for (int ai = 0; ai < 2; ++ai)
#pragma unroll
            for (int m = 0; m < 4; ++m) {
                float o[8];
#pragma unroll
                for (int n = 0; n < 2; ++n) { const f32x4 gv = acc[ai][0][m][n] * (1.0f / (F8_SX * F8_SW)) + (n ? bg1 : bg0), lv = acc[ai][1][m][n] * (1.0f / (F8_SX * F8_SW)) + (n ? bl1 : bl0);
#pragma unroll
                    for (int j = 0; j < 4; ++j) { const float gt = fminf(gv[j], 7.0f), li = fminf(fmaxf(lv[j], -7.0f), 7.0f); o[n * 4 + j] = (li + 1.0f) * gt * sigmoidf_(1.702f * gt) * F8_SACT; } }
                u32x2 w8; w8.x = pk4_fp8(o[0], o[1], o[2], o[3]); w8.y = pk4_fp8(o[4], o[5], o[6], o[7]);
                *(u32x2*)(act + (size_t)(row0 + ai * HALF + m * 16) * DE + ch) = w8;
            }
    }
};
struct EpiDown {
    static constexpr bool PERM = true;
    const float* b_dn; bf16* y;
    __device__ __forceinline__ void operator()(const f32x4 (&acc)[2][2][4][2], const Unit& u, int wr, int wc, int fr, int fq) const {
        const int row0 = u.pm * BM + wr * 64 + fr, col0 = u.pn * BM + wc * 32 + 8 * fq;
        const float* bb = b_dn + (size_t)u.e * D + col0;
        f32x4 bv[2][2];
#pragma unroll
        for (int bj = 0; bj < 2; ++bj)
#pragma unroll
            for (int n = 0; n < 2; ++n) bv[bj][n] = *(const f32x4*)(bb + bj * HALF + 4 * n);
#pragma unroll
        for (int ai = 0; ai < 2; ++ai)
#pragma unroll
            for (int m = 0; m < 4; ++m) { bf16* rowp = y + (size_t)(row0 + ai * HALF + m * 16) * D + col0;
#pragma unroll
                for (int bj = 0; bj < 2; ++bj) { const f32x4 v0 = acc[ai][bj][m][0] * (1.0f / (F8_SACT * F8_SW)) + bv[bj][0], v1 = acc[ai][bj][m][1] * (1.0f / (F8_SACT * F8_SW)) + bv[bj][1];
                    u32x4 w; w.x = cvt_pk_bf16(v0[0], v0[1]); w.y = cvt_pk_bf16(v0[2], v0[3]); w.z = cvt_pk_bf16(v1[0], v1[1]); w.w = cvt_pk_bf16(v1[2], v1[3]);
                    *(u32x4*)(rowp + bj * HALF) = w; } }
    }
};
}


#define XB_TMO      128
#define XB_XCNT(j)  (256  + 64 * (j))
#define XB_XSUB(j)  (1280 + 64 * (j))
#define XB_XGEN(j)  (2304 + 64 * (j))
#define XB_TOP      3328
#define XB_TOPGEN   3392
#define XCD_BAR_WORDS 3456
#define XB_SPIN_CAP (1u << 20)
__device__ __forceinline__ unsigned xb_ld(unsigned* p)              { return __hip_atomic_load(p, __ATOMIC_RELAXED, __HIP_MEMORY_SCOPE_AGENT); }
__device__ __forceinline__ unsigned xb_add(unsigned* p, unsigned v) { return __hip_atomic_fetch_add(p, v, __ATOMIC_RELAXED, __HIP_MEMORY_SCOPE_AGENT); }
__device__ __forceinline__ unsigned xb_xcc_id() { return (unsigned)__builtin_amdgcn_s_getreg((3 << 11) | 20) & 0xFu; }
#define XB_SPIN(cond, bar) do { unsigned _sp = 0; while (cond) { __builtin_amdgcn_s_sleep(1); \
    if ((++_sp & 255u) == 0u) { if (xb_ld(&(bar)[XB_TMO])) break; if (_sp > XB_SPIN_CAP) { atomicAdd(&(bar)[XB_TMO], 1u); break; } } } } while (0)
struct XcdBarrier { unsigned* bar; unsigned x; volatile LAS unsigned* st; };
__device__ __forceinline__ XcdBarrier xcd_barrier_post(unsigned* bar, volatile LAS unsigned* st) {
    XcdBarrier b; b.bar = bar; b.x = xb_xcc_id(); b.st = st;
    if (threadIdx.x == 0) (void)xb_add(&bar[XB_XCNT(b.x)], 1u);
    return b;
}
__device__ __forceinline__ void xcd_barrier_complete(unsigned* bar, unsigned x, unsigned& nloc, unsigned& nx) {
    const unsigned G = gridDim.x * gridDim.y * gridDim.z;
    unsigned sum, cnt, mine, sp = 0u;
    for (;;) {
        sum = 0u; cnt = 0u; mine = 0u;
#pragma unroll
        for (unsigned j = 0; j < 16; ++j) { const unsigned c = xb_ld(&bar[XB_XCNT(j)]); sum += c; cnt += (c > 0u) ? 1u : 0u; mine = (j == x) ? c : mine; }
        if (sum == G) break;
        __builtin_amdgcn_s_sleep(1);
        if ((++sp & 255u) == 0u) { if (xb_ld(&bar[XB_TMO])) break; if (sp > XB_SPIN_CAP) { atomicAdd(&bar[XB_TMO], 1u); break; } }
    }
    nloc = mine > 0u ? mine : 1u; nx = cnt > 0u ? cnt : 1u;
}
__device__ __forceinline__ void xcd_barrier(const XcdBarrier& b) {
    asm volatile("s_waitcnt vmcnt(0)" ::: "memory");
    __syncthreads();
    if (threadIdx.x == 0) {
        unsigned* bar = b.bar;
        __builtin_amdgcn_s_waitcnt(0);
        unsigned nloc = b.st[0], nx = b.st[1];
        if (nloc == 0u) { xcd_barrier_complete(bar, b.x, nloc, nx); b.st[0] = nloc; b.st[1] = nx; }
        const unsigned old = xb_add(&bar[XB_XSUB(b.x)], 1u);
        const unsigned gen = old / nloc;
        if (old + 1u == (gen + 1u) * nloc) {
            __builtin_amdgcn_fence(__ATOMIC_RELEASE, "agent");
            asm volatile("s_waitcnt vmcnt(0)" ::: "memory");
            const unsigned og = xb_add(&bar[XB_TOP], 1u);
            const unsigned tg = og / nx;
            if (og + 1u == (tg + 1u) * nx) xb_add(&bar[XB_TOPGEN], 1u);
            else XB_SPIN(xb_ld(&bar[XB_TOPGEN]) == tg, bar);
            __builtin_amdgcn_fence(__ATOMIC_ACQUIRE, "agent");
            xb_add(&bar[XB_XGEN(b.x)], 1u);
            asm volatile("s_waitcnt vmcnt(0)" ::: "memory");
        } else {
            XB_SPIN(xb_ld(&bar[XB_XGEN(b.x)]) == gen, bar);
            __builtin_amdgcn_fence(__ATOMIC_ACQUIRE, "agent");
            asm volatile("s_waitcnt vmcnt(0)" ::: "memory");
        }
    }
    __syncthreads();
}

struct Args { const float* in[26]; float* out; unsigned char* ws; int ph_lo, ph_hi; };

struct Frame { LAS unsigned char* lds; int tid, lane, wave, G, vcu; };

__device__ __forceinline__ void transpose_item(const float* W, int K, int N, bf16* WT, int k0, int n0, int orow0, LAS float* scr, int lane) {
#pragma unroll 8
    for (int i = 0; i < 32; ++i) { const int kk = 2 * i + (lane >> 5); scr[kk * 33 + (lane & 31)] = W[(size_t)(k0 + kk) * N + n0 + (lane & 31)]; }
    asm volatile("s_waitcnt lgkmcnt(0)" ::: "memory");
    const int c = lane & 7;
#pragma unroll
    for (int j = 0; j < 4; ++j) { const int n = (lane >> 3) + 8 * j; const LAS float* s = scr + (8 * c) * 33 + n;
        u32x4 o; o.x = cvt_pk_bf16(s[0 * 33], s[1 * 33]); o.y = cvt_pk_bf16(s[2 * 33], s[3 * 33]); o.z = cvt_pk_bf16(s[4 * 33], s[5 * 33]); o.w = cvt_pk_bf16(s[6 * 33], s[7 * 33]);
        *(u32x4*)(WT + (size_t)(orow0 + n) * K + k0 + 8 * c) = o; }
    asm volatile("s_waitcnt lgkmcnt(0)" ::: "memory");
}

__device__ __forceinline__ void transpose_item8(const float* W, int K, int N, unsigned char* WT, int k0, int n0, int orow0, LAS float* scr, int lane) {
#pragma unroll 8
    for (int i = 0; i < 32; ++i) { const int kk = 2 * i + (lane >> 5); scr[kk * 33 + (lane & 31)] = W[(size_t)(k0 + kk) * N + n0 + (lane & 31)]; }
    asm volatile("s_waitcnt lgkmcnt(0)" ::: "memory");
    const int c = lane & 7;
#pragma unroll
    for (int j = 0; j < 4; ++j) { const int n = (lane >> 3) + 8 * j; const LAS float* s = scr + (8 * c) * 33 + n;
        u32x2 o; o.x = pk4_fp8(s[0 * 33] * F8_SW, s[1 * 33] * F8_SW, s[2 * 33] * F8_SW, s[3 * 33] * F8_SW); o.y = pk4_fp8(s[4 * 33] * F8_SW, s[5 * 33] * F8_SW, s[6 * 33] * F8_SW, s[7 * 33] * F8_SW);
        *(u32x2*)(WT + (size_t)(orow0 + n) * K + k0 + 8 * c) = o; }
    asm volatile("s_waitcnt lgkmcnt(0)" ::: "memory");
}

__device__ __forceinline__ void p0_prologue(const Frame& F, const Args& a) {
    unsigned char* ws = a.ws;
    LAS float* scr = (LAS float*)(F.lds + F.wave * 8448);
    const int gw = F.vcu * 8 + F.wave, NGW = F.G * 8;
    constexpr int I_IN = 16 * 108, I_O = 16 * 32, I_UP = 32 * 16 * 64, I_DN = 32 * 16 * 32, I_L = 16, I_G = 32;
    constexpr int NITEMS = I_IN + I_O + I_UP + I_DN + 2 * I_L + 2 * I_L + I_G;
    for (int it = gw; it < NITEMS; it += NGW) {
        int r = it;
        if (r < I_UP) {
            const int e = r / 1024, q = r % 1024, kb = q / 64, nb = q % 64, n0 = nb * 32;
            const int orow0 = n0 < 1024 ? 256 * (n0 >> 7) + (n0 & 127) : 256 * ((n0 - 1024) >> 7) + 128 + ((n0 - 1024) & 127);
            transpose_item8(a.in[21] + (size_t)e * 1024 * 2048, 1024, 2048, ws + WS_WUPT + (size_t)e * 2048 * 1024, kb * 64, n0, orow0, scr, F.lane); continue; }
        r -= I_UP;
        if (r < I_DN) { const int e = r / 512, q = r % 512, kb = q / 32, nb = q % 32;
            transpose_item8(a.in[23] + (size_t)e * 1024 * 1024, 1024, 1024, ws + WS_WDNT + (size_t)e * 1024 * 1024, kb * 64, nb * 32, nb * 32, scr, F.lane); continue; }
        r -= I_DN;
        if (r < I_IN) { const int kb = r / 108, nb = r % 108; transpose_item(a.in[2], 1024, NPROJ, (bf16*)(ws + WS_WINT), kb * 64, nb * 32, nb * 32, scr, F.lane); continue; }
        r -= I_IN;
        if (r < I_O) { const int kb = r / 32, nb = r % 32; transpose_item(a.in[17], 1024, 1024, (bf16*)(ws + WS_WOT), kb * 64, nb * 32, nb * 32, scr, F.lane); continue; }
        r -= I_O;
        if (r < 2 * I_L) { const int z = r / 16, nb = r % 16; transpose_item(a.in[8] + (size_t)z * 64 * 512, 64, 512, (bf16*)(ws + WS_W2T) + (size_t)z * 512 * 64, 0, nb * 32, nb * 32, scr, F.lane); continue; }
        r -= 2 * I_L;
        if (r < 2 * I_L) { const int z = r / 16, nb = r % 16; transpose_item(a.in[10] + (size_t)z * 64 * 512, 64, 512, (bf16*)(ws + WS_A2T) + (size_t)z * 512 * 64, 0, nb * 32, nb * 32, scr, F.lane); continue; }
        r -= 2 * I_L;
        { const int kb = r / 16, nb = r % 16; transpose_item(a.in[11], 128, 512, (bf16*)(ws + WS_G2T), kb * 64, nb * 32, nb * 32, scr, F.lane); }
    }
    { u32x4* z = (u32x4*)(ws + WS_WINT + (size_t)NPROJ * 1024 * 2); const u32x4 zero = {0u, 0u, 0u, 0u};
      for (int i = F.vcu * 512 + F.tid; i < 16384; i += F.G * 512) z[i] = zero; }
    const float* x = a.in[0]; const float* nw = a.in[1]; bf16* hn = (bf16*)(ws + WS_HN);
    f32x4 wv[4];
#pragma unroll
    for (int j = 0; j < 4; ++j) wv[j] = *((const f32x4*)nw + F.lane + 64 * j);
    for (int m = gw; m < M; m += NGW) {
        const f32x4* xr = (const f32x4*)(x + (size_t)m * D) + F.lane;
        f32x4 v[4]; float s = 0.f;
#pragma unroll
        for (int j = 0; j < 4; ++j) { v[j] = xr[64 * j]; s += (v[j].x * v[j].x + v[j].y * v[j].y) + (v[j].z * v[j].z + v[j].w * v[j].w); }
        const float rs = rsqrtf(wave_sum(s) * (1.f / D) + RMS_EPS);
        u32x2* o8 = (u32x2*)(hn + (size_t)m * D) + F.lane;
#pragma unroll
        for (int j = 0; j < 4; ++j) { u32x2 o; o.x = cvt_pk_bf16(v[j].x * rs * wv[j].x, v[j].y * rs * wv[j].y); o.y = cvt_pk_bf16(v[j].z * rs * wv[j].z, v[j].w * rs * wv[j].w); o8[64 * j] = o; }
    }
}

constexpr int PREP_KBUF = 0, PREP_INV = 65536, PREP_AW = 67584, PREP_AA = PREP_AW + 17408, PREP_AG = PREP_AA + 17408, PREP_LD = 136;
template <bool STORE>
__device__ __forceinline__ void prep_phase(const Frame& F, const Args& a) {
    unsigned char* ws = a.ws;
    const bf16* p = (const bf16*)(ws + WS_P);
    bf16* r_out = (bf16*)(ws + WS_R); bf16* v_out = (bf16*)(ws + WS_V); bf16* kk_out = (bf16*)(ws + WS_KK);
    bf16* decay_out = (bf16*)(ws + WS_DECAY); bf16* kdir_out = (bf16*)(ws + WS_KDIR); bf16* akk_out = (bf16*)(ws + WS_AKK); bf16* g_out = (bf16*)(ws + WS_G);
    const bf16* w2T = (const bf16*)(ws + WS_W2T); const bf16* a2T = (const bf16*)(ws + WS_A2T); const bf16* g2T = (const bf16*)(ws + WS_G2T);
    const float* mu_p = a.in[5]; const float* mu_n = a.in[6]; const float* w0 = a.in[7]; const float* a0 = a.in[9];
    const float* k_k = a.in[12]; const float* k_a = a.in[13];
    LAS bf16* kbuf = (LAS bf16*)(F.lds + PREP_KBUF); LAS float* invb = (LAS float*)(F.lds + PREP_INV);
    LAS bf16* Aw = (LAS bf16*)(F.lds + PREP_AW); LAS bf16* Aa = (LAS bf16*)(F.lds + PREP_AA); LAS bf16* Ag = (LAS bf16*)(F.lds + PREP_AG);
    const int lane = F.lane, wave = F.wave, fr = lane & 15, fg = lane >> 4;
    for (int tile = F.vcu; tile < M / 64; tile += F.G) {
        const int m0 = tile * 64;
#pragma unroll 1
        for (int jj = 0; jj < 4; ++jj) {
            const int q = lane + 64 * jj; const bool valid = q < 240; const int c0 = 8 * q;
            float mp[8], mn[8];
#pragma unroll
            for (int i = 0; i < 8; ++i) { mp[i] = valid ? mu_p[c0 + i] : 0.f; mn[i] = valid ? mu_n[c0 + i] : 0.f; }
            const int mfirst = m0 + wave * 8;
            const u32x4 zero = {0u, 0u, 0u, 0u};
            u32x4 rows[10];
#pragma unroll
            for (int rI = 0; rI < 10; ++rI) { const int mr = mfirst - 1 + rI;
                const bool ok = valid && !(rI == 0 && (mfirst % T) == 0) && !(rI == 9 && ((mfirst + 7) % T) == T - 1);
                rows[rI] = ok ? *(const u32x4*)(p + (size_t)mr * PW + c0) : zero; }
#pragma unroll
            for (int i = 0; i < 8; ++i) {
                const int m = mfirst + i, it = wave * 8 + i;
                const u32x4 prev = rows[i], cur = rows[i + 1], nxt = rows[i + 2];
                float fp[8], fc[8], fn[8], s[8];
                unpack8(prev, fp); unpack8(cur, fc); unpack8(nxt, fn);
#pragma unroll
                for (int e = 0; e < 8; ++e) s[e] = fc[e] + mp[e] * (fp[e] - fc[e]) + mn[e] * (fn[e] - fc[e]);
                if (jj == 0) { if (STORE) { *(u32x4*)(r_out + (size_t)m * CW + c0) = pack8(s); } }
                else if (jj == 1) {
                    const int c = c0 - 512;
                    *(LAS u32x4*)(kbuf + it * 512 + c) = pack8(s);
                    float kr[8]; float ss = 0.f;
#pragma unroll
                    for (int e = 0; e < 8; ++e) { kr[e] = s[e] * k_k[c + e]; ss += kr[e] * kr[e]; }
                    ss += __shfl_xor(ss, 1); ss += __shfl_xor(ss, 2); ss += __shfl_xor(ss, 4);
                    const float inv = fminf(__builtin_amdgcn_rsqf(ss), 1e12f);
#pragma unroll
                    for (int e = 0; e < 8; ++e) kr[e] *= inv;
                    if (STORE) { *(u32x4*)(kk_out + (size_t)m * CW + c) = pack8(kr); }
                    if ((lane & 7) == 0) invb[it * 8 + (lane >> 3)] = inv;
                }
                else if (jj == 2) { if (STORE) { *(u32x4*)(v_out + (size_t)m * CW + (c0 - 1024)) = pack8(s); } }
                else if (valid) {
                    const int seg = lane >> 4, cw = 8 * (lane & 15);
                    if (seg == 0) {
#pragma unroll
                        for (int e = 0; e < 8; ++e) s[e] = 1.0f - 2.0f * __builtin_amdgcn_rcpf(__expf(2.0f * s[e]) + 1.0f);
                        *(LAS u32x4*)(Aw + it * PREP_LD + cw) = pack8(s);
                    } else if (seg == 1) { *(LAS u32x4*)(Aa + it * PREP_LD + cw) = pack8(s); }
                    else {
#pragma unroll
                        for (int e = 0; e < 8; ++e) s[e] = sigmoidf_(s[e]);
                        *(LAS u32x4*)(Ag + it * PREP_LD + cw) = pack8(s);
                    }
                }
            }
        }
        __syncthreads();
        const int nb = 64 * wave;
#pragma unroll 1
        for (int job = 0; job < 5; ++job) {
            const int z = job & 1;
            const bf16* WT = job < 2 ? w2T + (size_t)z * 512 * 64 : (job < 4 ? a2T + (size_t)z * 512 * 64 : g2T);
            const LAS bf16* Ax = job < 2 ? Aw + z * 64 : (job < 4 ? Aa + z * 64 : Ag);
            const int kw = job < 4 ? 64 : 128, nks = kw / 32;
            f32x4 acc[4][4];
#pragma unroll
            for (int mt = 0; mt < 4; ++mt)
#pragma unroll
                for (int nt = 0; nt < 4; ++nt) acc[mt][nt] = (f32x4){0.f, 0.f, 0.f, 0.f};
#pragma unroll 1
            for (int ks = 0; ks < nks; ++ks) {
                bf16x8 af[4], wf[4];
#pragma unroll
                for (int mt = 0; mt < 4; ++mt) af[mt] = *(const LAS bf16x8*)(Ax + (16 * mt + fr) * PREP_LD + 32 * ks + 8 * fg);
#pragma unroll
                for (int nt = 0; nt < 4; ++nt) wf[nt] = *(const bf16x8*)(WT + (size_t)(nb + 16 * nt + fr) * kw + 32 * ks + 8 * fg);
#pragma unroll
                for (int mt = 0; mt < 4; ++mt)
#pragma unroll
                    for (int nt = 0; nt < 4; ++nt) acc[mt][nt] = __builtin_amdgcn_mfma_f32_16x16x32_bf16(wf[nt], af[mt], acc[mt][nt], 0, 0, 0);
            }
#pragma unroll
            for (int mt = 0; mt < 4; ++mt) {
                const int it = 16 * mt + fr; const size_t m = (size_t)(m0 + it);
#pragma unroll
                for (int nt = 0; nt < 4; ++nt) {
                    const int n = nb + 16 * nt + 4 * fg;
                    const f32x4 v = acc[mt][nt];
                    if (job < 2) {
                        const f32x4 b = *(const f32x4*)(w0 + z * 512 + n);
                        float o[4];
#pragma unroll
                        for (int i = 0; i < 4; ++i) o[i] = __expf(-0.60653066f * sigmoidf_(v[i] + b[i]));
                        u32x2 w; w.x = cvt_pk_bf16(o[0], o[1]); w.y = cvt_pk_bf16(o[2], o[3]);
                        if (STORE) { *(u32x2*)(decay_out + ((size_t)z * M + m) * CW + n) = w; }
                    } else if (job < 4) {
                        const f32x4 b = *(const f32x4*)(a0 + z * 512 + n), kkc = *(const f32x4*)(k_k + n), kac = *(const f32x4*)(k_a + n);
                        const u32x2 kb = *(const LAS u32x2*)(kbuf + it * 512 + n);
                        const float kv[4] = {bflo(kb.x), bfhi(kb.x), bflo(kb.y), bfhi(kb.y)};
                        const float inv = invb[it * 8 + wave];
                        float kd[4], ak[4];
#pragma unroll
                        for (int i = 0; i < 4; ++i) { const float av = sigmoidf_(v[i] + b[i]); kd[i] = kv[i] * (1.0f + (av - 1.0f) * kac[i]); ak[i] = av * (kv[i] * kkc[i] * inv); }
                        u32x2 w; w.x = cvt_pk_bf16(kd[0], kd[1]); w.y = cvt_pk_bf16(kd[2], kd[3]);
                        if (STORE) { *(u32x2*)(kdir_out + ((size_t)z * M + m) * CW + n) = w; }
                        w.x = cvt_pk_bf16(ak[0], ak[1]); w.y = cvt_pk_bf16(ak[2], ak[3]);
                        if (STORE) { *(u32x2*)(akk_out + ((size_t)z * M + m) * CW + n) = w; }
                    } else {
                        u32x2 w; w.x = cvt_pk_bf16(v[0], v[1]); w.y = cvt_pk_bf16(v[2], v[3]);
                        if (STORE) { *(u32x2*)(g_out + m * CW + n) = w; }
                    }
                }
            }
        }
        __syncthreads();
    }
}

__device__ __forceinline__ void attn_phase(const Frame& F, const Args& a) {
    unsigned char* ws = a.ws;
    const bf16* q = (const bf16*)(ws + WS_Q); const bf16* k = (const bf16*)(ws + WS_K); const bf16* vT = (const bf16*)(ws + WS_VT);
    bf16* att = (bf16*)(ws + WS_ATT);
    LAS float* bias = (LAS float*)F.lds;
    for (int i = F.tid; i < 8 * 15 * 31; i += 512) bias[i] = a.in[3][i];
    __syncthreads();
    const int lane = F.lane, fr = lane & 15, fg = lane >> 4;
    const int NGW = F.G * 8, gw = F.vcu * 8 + F.wave;
    const int per = (16384 + NGW - 1) / NGW;
    for (int task = gw * per; task < (gw + 1) * per && task < 16384; ++task) {
        const int cgp = task & 3, r = (task >> 2) & 127, h = (task >> 9) & 7, b = task >> 12;
        const int c0 = 16 * cgp, wsc = min(max(c0 - 8, 0), 32), rs = min(max(r - 4, 0), GROWS - 8);
        const int c = c0 + fr, cs = min(max(c - 8, 0), 48);
        const size_t tq = (size_t)b * T + r * 64 + c;
        bf16x8 qf[2];
#pragma unroll
        for (int ks = 0; ks < 2; ++ks) qf[ks] = *(const bf16x8*)(q + tq * CW + h * 64 + 32 * ks + 8 * fg);
        f32x4 sc[16];
        const int kcol_a = wsc + 8 * (fr >> 2) + (fr & 3);
#pragma unroll
        for (int hb = 0; hb < 2; ++hb) {
            bf16x8 kf[8][2];
#pragma unroll
            for (int tl = 0; tl < 8; ++tl) { const int t = 8 * hb + tl, u = t >> 1, par = t & 1;
                const size_t tk = (size_t)b * T + (rs + u) * 64 + kcol_a + 4 * par;
                kf[tl][0] = *(const bf16x8*)(k + tk * CW + h * 64 + 8 * fg); kf[tl][1] = *(const bf16x8*)(k + tk * CW + h * 64 + 32 + 8 * fg); }
#pragma unroll
            for (int tl = 0; tl < 8; ++tl) { f32x4 s = {0.f, 0.f, 0.f, 0.f};
                s = __builtin_amdgcn_mfma_f32_16x16x32_bf16(kf[tl][0], qf[0], s, 0, 0, 0);
                s = __builtin_amdgcn_mfma_f32_16x16x32_bf16(kf[tl][1], qf[1], s, 0, 0, 0);
                sc[8 * hb + tl] = s; }
        }
        float mx = -1e30f;
#pragma unroll
        for (int u = 0; u < 8; ++u) {
            const int dr = rs + u - r + 7;
#pragma unroll
            for (int par = 0; par < 2; ++par)
#pragma unroll
                for (int i = 0; i < 4; ++i) {
                    const int kc = wsc + 8 * fg + 4 * par + i; const bool ok = (kc >= cs) && (kc < cs + 16);
                    const int dc = min(max(kc - c + 15, 0), 30);
                    const float s = ok ? sc[2 * u + par][i] + bias[(h * 15 + dr) * 31 + dc] : -1e30f;
                    sc[2 * u + par][i] = s; mx = fmaxf(mx, s);
                }
        }
        mx = fmaxf(mx, __shfl_xor(mx, 16)); mx = fmaxf(mx, __shfl_xor(mx, 32));
        float sum = 0.f;
#pragma unroll
        for (int t = 0; t < 16; ++t)
#pragma unroll
            for (int i = 0; i < 4; ++i) { const float pv = sc[t][i] > -1e29f ? __expf(sc[t][i] - mx) : 0.f; sc[t][i] = pv; sum += pv; }
        sum += __shfl_xor(sum, 16); sum += __shfl_xor(sum, 32);
        const float inv = 1.0f / sum;
        f32x4 o[4];
#pragma unroll
        for (int nt = 0; nt < 4; ++nt) o[nt] = (f32x4){0.f, 0.f, 0.f, 0.f};
#pragma unroll
        for (int hb = 0; hb < 2; ++hb) {
            bf16x8 vf[4][4];
#pragma unroll
            for (int ul = 0; ul < 4; ++ul) { const int u = 4 * hb + ul; const bf16* vblk = vT + ((size_t)((b * NH + h) * GROWS + rs + u)) * (HD * 64) + wsc + 8 * fg;
#pragma unroll
                for (int nt = 0; nt < 4; ++nt) vf[ul][nt] = *(const bf16x8*)(vblk + (16 * nt + fr) * 64); }
#pragma unroll
            for (int ul = 0; ul < 4; ++ul) { const int u = 4 * hb + ul;
                union { u32x4 w; bf16x8 h8; } pf;
                pf.w.x = cvt_pk_bf16(sc[2 * u][0], sc[2 * u][1]); pf.w.y = cvt_pk_bf16(sc[2 * u][2], sc[2 * u][3]);
                pf.w.z = cvt_pk_bf16(sc[2 * u + 1][0], sc[2 * u + 1][1]); pf.w.w = cvt_pk_bf16(sc[2 * u + 1][2], sc[2 * u + 1][3]);
#pragma unroll
                for (int nt = 0; nt < 4; ++nt) o[nt] = __builtin_amdgcn_mfma_f32_16x16x32_bf16(vf[ul][nt], pf.h8, o[nt], 0, 0, 0); }
        }
#pragma unroll
        for (int nt = 0; nt < 4; ++nt) { u32x2 w; w.x = cvt_pk_bf16(o[nt][0] * inv, o[nt][1] * inv); w.y = cvt_pk_bf16(o[nt][2] * inv, o[nt][3] * inv);
            *(u32x2*)(att + tq * CW + h * 64 + 16 * nt + 4 * fg) = w; }
    }
    __syncthreads();
}

__device__ __forceinline__ float row16_sum(float v) {
    v += __builtin_bit_cast(float, __builtin_amdgcn_update_dpp(0, __builtin_bit_cast(int, v), 0xB1, 0xF, 0xF, true));
    v += __builtin_bit_cast(float, __builtin_amdgcn_update_dpp(0, __builtin_bit_cast(int, v), 0x4E, 0xF, 0xF, true));
    v += __builtin_bit_cast(float, __builtin_amdgcn_update_dpp(0, __builtin_bit_cast(int, v), 0x141, 0xF, 0xF, true));
    v += __builtin_bit_cast(float, __builtin_amdgcn_update_dpp(0, __builtin_bit_cast(int, v), 0x140, 0xF, 0xF, true));
    return v;
}
constexpr int CS_R = 8;
constexpr int CS_AT = 0, CS_RT = 2304, CS_KHT = 4608, CS_BHT = 6656, CS_VT = 8704, CS_TT = 9216, CS_AAK = 9728, CS_ARK = 10240, CS_ARB = 10752, CS_PL = 11264, CS_SLOT = 11520;
constexpr int CS_LD = 72;
constexpr int CS_SCR = CS_R * CS_SLOT  , CS_SCRW = 2304 * 2 + 1024  , CS_FLAG = CS_SCR + 7 * CS_SCRW  ;
__device__ __forceinline__ bf16 f2bf(float f) { return (bf16)(cvt_pk_bf16(f, 0.f) & 0xffffu); }
__device__ __forceinline__ void scan_phase(const Frame& F, const Args& a) {
    unsigned char* ws = a.ws;
    const int seq = F.vcu >> 2, ig = F.vcu & 3;
    if (seq >= 64) return;
    const int z = seq >> 5, b = (seq >> 3) & 3, h = seq & 7;
    const size_t mb = (size_t)b * T;
    const int lane = F.lane, wave = F.wave, fr = lane & 15, fg = lane >> 4;
    constexpr int NCK = T / 16;
    volatile LAS unsigned* flg = (volatile LAS unsigned*)(F.lds + CS_FLAG);
    if (F.tid < 16) flg[F.tid] = 0u;
    __syncthreads();
    const int o16 = fr * 32 + fg * 8;
#define CS_M32(A_, B_, C_) __builtin_amdgcn_mfma_f32_16x16x32_bf16(A_, B_, C_, 0, 0, 0)
#define CS_M16(A_, B_, C_) __builtin_amdgcn_mfma_f32_16x16x16bf16_1k(__builtin_bit_cast(s16x4, A_), __builtin_bit_cast(s16x4, B_), C_, 0, 0, 0)
    if (wave == 0) {
        float* yout = (float*)(ws + WS_Y) + (size_t)z * M * CW + h * 64 + ig * 16 + fr;
        f32x4 zacc[4];
#pragma unroll
        for (int mt = 0; mt < 4; ++mt) zacc[mt] = (f32x4){0.f, 0.f, 0.f, 0.f};
#pragma unroll 1
        for (int n = 0; n < NCK; ++n) {
            const int slot = n & (CS_R - 1);
            { unsigned sp = 0; while (flg[slot] != (unsigned)(n + 1)) { __builtin_amdgcn_s_sleep(1); if (++sp > (1u << 24)) break; } }
            __builtin_amdgcn_fence(__ATOMIC_ACQUIRE, "workgroup");
            const LAS unsigned char* sl = F.lds + slot * CS_SLOT;
            u32x2 a4[4], r4[4], kh[4], bh[4]; f32x4 pl[4];
            { const LAS unsigned char* pa = sl + CS_AT + fr * (CS_LD * 2) + fg * 8; const LAS unsigned char* pr = sl + CS_RT + fr * (CS_LD * 2) + fg * 8;
#pragma unroll
              for (int kq = 0; kq < 4; ++kq) { a4[kq] = *(const LAS u32x2*)(pa + 32 * kq); r4[kq] = *(const LAS u32x2*)(pr + 32 * kq); } }
            const u32x2 aak = *(const LAS u32x2*)(sl + CS_AAK + o16), ark = *(const LAS u32x2*)(sl + CS_ARK + o16), arb = *(const LAS u32x2*)(sl + CS_ARB + o16), tt_ = *(const LAS u32x2*)(sl + CS_TT + o16);
            const u32x2 vb = *(const LAS u32x2*)(sl + CS_VT + o16);
#pragma unroll
            for (int mt = 0; mt < 4; ++mt) { pl[mt] = *(const LAS f32x4*)(sl + CS_PL + (16 * mt + 4 * fg) * 4);
                kh[mt] = *(const LAS u32x2*)(sl + CS_KHT + 512 * mt + o16); bh[mt] = *(const LAS u32x2*)(sl + CS_BHT + 512 * mt + o16); }
            union { u32x4 w; bf16x8 h8; } zb0, zb1, ap0, ap1, rp0, rp1;
            zb0.w.x = cvt_pk_bf16(zacc[0][0], zacc[0][1]); zb0.w.y = cvt_pk_bf16(zacc[0][2], zacc[0][3]); zb0.w.z = cvt_pk_bf16(zacc[1][0], zacc[1][1]); zb0.w.w = cvt_pk_bf16(zacc[1][2], zacc[1][3]);
            zb1.w.x = cvt_pk_bf16(zacc[2][0], zacc[2][1]); zb1.w.y = cvt_pk_bf16(zacc[2][2], zacc[2][3]); zb1.w.z = cvt_pk_bf16(zacc[3][0], zacc[3][1]); zb1.w.w = cvt_pk_bf16(zacc[3][2], zacc[3][3]);
            asm volatile("s_waitcnt lgkmcnt(0)" ::: "memory");
            if (lane == 0) flg[8] = (unsigned)(n + 1);
            asm volatile("" ::: "memory");
            ap0.w = (u32x4){a4[0].x, a4[0].y, a4[1].x, a4[1].y}; ap1.w = (u32x4){a4[2].x, a4[2].y, a4[3].x, a4[3].y};
            rp0.w = (u32x4){r4[0].x, r4[0].y, r4[1].x, r4[1].y}; rp1.w = (u32x4){r4[2].x, r4[2].y, r4[3].x, r4[3].y};
            const f32x4 zero4 = {0.f, 0.f, 0.f, 0.f};
            f32x4 Wc = CS_M16(aak, vb, zero4);
            Wc = CS_M32(ap0.h8, zb0.h8, Wc); Wc = CS_M32(ap1.h8, zb1.h8, Wc);
            f32x4 Yc = CS_M16(ark, vb, zero4);
            Yc = CS_M32(rp0.h8, zb0.h8, Yc); Yc = CS_M32(rp1.h8, zb1.h8, Yc);
            f32x4 zz[4];
#pragma unroll
            for (int mt = 0; mt < 4; ++mt) zz[mt] = CS_M16(kh[mt], vb, zacc[mt] * pl[mt]);
            u32x2 wb, ub;
            wb.x = cvt_pk_bf16(Wc[0], Wc[1]); wb.y = cvt_pk_bf16(Wc[2], Wc[3]);
            const f32x4 Uc = CS_M16(tt_, wb, zero4);
            ub.x = cvt_pk_bf16(Uc[0], Uc[1]); ub.y = cvt_pk_bf16(Uc[2], Uc[3]);
            Yc = CS_M16(arb, ub, Yc);
#pragma unroll
            for (int mt = 0; mt < 4; ++mt) zacc[mt] = CS_M16(bh[mt], ub, zz[mt]);
#pragma unroll
            for (int rr = 0; rr < 4; ++rr) { const int q = 16 * n + 4 * fg + rr, t = z ? (T - 1 - q) : q; yout[(mb + t) * CW] = Yc[rr]; }
        }
    } else {
        const int pi = wave - 1;
        LAS unsigned char* scr = F.lds + CS_SCR + pi * CS_SCRW;
        LAS bf16* KT = (LAS bf16*)scr; LAS bf16* BT = (LAS bf16*)(scr + 2304);
        const bf16* gw_ = (const bf16*)(ws + WS_DECAY) + (size_t)z * M * CW + h * 64;
        const bf16* gkk = (const bf16*)(ws + WS_KK) + h * 64;
        const bf16* gak = (const bf16*)(ws + WS_AKK) + (size_t)z * M * CW + h * 64;
        const bf16* gk = (const bf16*)(ws + WS_KDIR) + (size_t)z * M * CW + h * 64;
        const bf16* gr = (const bf16*)(ws + WS_R) + h * 64;
        const bf16* gv = (const bf16*)(ws + WS_V) + h * 64 + ig * 16;
        bf16 nw[16], nkk[16], nak[16], nk[16], nr[16], nv[4];
#define CS_FETCH(nn) do { if ((nn) < NCK) { _Pragma("unroll") for (int tt = 0; tt < 16; ++tt) { const int q_ = 16 * (nn) + tt; const size_t m_ = (mb + (z ? (T - 1 - q_) : q_)) * CW; \
            nw[tt] = (gw_ + m_)[lane]; nkk[tt] = (gkk + m_)[lane]; nak[tt] = (gak + m_)[lane]; nk[tt] = (gk + m_)[lane]; nr[tt] = (gr + m_)[lane]; } \
            _Pragma("unroll") for (int q4 = 0; q4 < 4; ++q4) { const int q_ = 16 * (nn) + fg + 4 * q4; const size_t m_ = (mb + (z ? (T - 1 - q_) : q_)) * CW; nv[q4] = (gv + m_)[fr]; } } } while (0)
        CS_FETCH(pi);
#pragma unroll 1
        for (int n = pi; n < NCK; n += 7) {
            const int slot = n & (CS_R - 1);
            float wv[16], kkv[16], akv[16], kv[16], rv[16], vq[4];
#pragma unroll
            for (int tt = 0; tt < 16; ++tt) { unsigned x0 = nw[tt], x1 = nkk[tt], x2 = nak[tt], x3 = nk[tt], x4 = nr[tt];
                asm volatile("" : "+v"(x0), "+v"(x1), "+v"(x2), "+v"(x3), "+v"(x4));
                wv[tt] = __uint_as_float(x0 << 16); kkv[tt] = __uint_as_float(x1 << 16); akv[tt] = __uint_as_float(x2 << 16); kv[tt] = __uint_as_float(x3 << 16); rv[tt] = __uint_as_float(x4 << 16); }
#pragma unroll
            for (int q4 = 0; q4 < 4; ++q4) { unsigned x0 = nv[q4]; asm volatile("" : "+v"(x0)); vq[q4] = __uint_as_float(x0 << 16); }
            CS_FETCH(n + 7);
            { unsigned sp = 0; while ((int)flg[8] < n - (CS_R - 3)) { __builtin_amdgcn_s_sleep(2); if (++sp > (1u << 24)) break; } }
            __builtin_amdgcn_fence(__ATOMIC_ACQUIRE, "workgroup");
            LAS unsigned char* sl = F.lds + slot * CS_SLOT;
            float P[16];
            P[0] = wv[0];
#pragma unroll
            for (int tt = 1; tt < 16; ++tt) P[tt] = P[tt - 1] * wv[tt];
            const float PL = P[15];
            float khat[16], bhat[16];
#pragma unroll
            for (int tt = 0; tt < 16; ++tt) {
                const float pm1 = tt ? P[tt - 1] : 1.0f, inv = __builtin_amdgcn_rcpf(P[tt]);
                const float at = kkv[tt] * pm1, rt = rv[tt] * P[tt], kt = kv[tt] * inv, bt = -akv[tt] * inv;
                khat[tt] = kt * PL; bhat[tt] = bt * PL;
                *(LAS bf16*)(sl + CS_AT + (tt * CS_LD + lane) * 2) = f2bf(at); *(LAS bf16*)(sl + CS_RT + (tt * CS_LD + lane) * 2) = f2bf(rt);
                KT[tt * CS_LD + lane] = f2bf(kt); BT[tt * CS_LD + lane] = f2bf(bt);
            }
            { u32x4 o0, o1;
              o0.x = cvt_pk_bf16(khat[0], khat[1]); o0.y = cvt_pk_bf16(khat[2], khat[3]); o0.z = cvt_pk_bf16(khat[4], khat[5]); o0.w = cvt_pk_bf16(khat[6], khat[7]);
              o1.x = cvt_pk_bf16(khat[8], khat[9]); o1.y = cvt_pk_bf16(khat[10], khat[11]); o1.z = cvt_pk_bf16(khat[12], khat[13]); o1.w = cvt_pk_bf16(khat[14], khat[15]);
              *(LAS u32x4*)(sl + CS_KHT + lane * 32) = o0; *(LAS u32x4*)(sl + CS_KHT + lane * 32 + 16) = o1;
              o0.x = cvt_pk_bf16(bhat[0], bhat[1]); o0.y = cvt_pk_bf16(bhat[2], bhat[3]); o0.z = cvt_pk_bf16(bhat[4], bhat[5]); o0.w = cvt_pk_bf16(bhat[6], bhat[7]);
              o1.x = cvt_pk_bf16(bhat[8], bhat[9]); o1.y = cvt_pk_bf16(bhat[10], bhat[11]); o1.z = cvt_pk_bf16(bhat[12], bhat[13]); o1.w = cvt_pk_bf16(bhat[14], bhat[15]);
              *(LAS u32x4*)(sl + CS_BHT + lane * 32) = o0; *(LAS u32x4*)(sl + CS_BHT + lane * 32 + 16) = o1; }
            *(LAS float*)(sl + CS_PL + lane * 4) = PL;
#pragma unroll
            for (int q4 = 0; q4 < 4; ++q4) *(LAS bf16*)(sl + CS_VT + (fr * 16 + fg + 4 * q4) * 2) = f2bf(vq[q4]);
            asm volatile("s_waitcnt lgkmcnt(0)" ::: "memory");
            bf16x8 af[2], rf[2], kf[2], bf_[2];
#pragma unroll
            for (int ks = 0; ks < 2; ++ks) { af[ks] = *(const LAS bf16x8*)(sl + CS_AT + (fr * CS_LD + 32 * ks + 8 * fg) * 2); rf[ks] = *(const LAS bf16x8*)(sl + CS_RT + (fr * CS_LD + 32 * ks + 8 * fg) * 2);
                kf[ks] = *(const LAS bf16x8*)(KT + fr * CS_LD + 32 * ks + 8 * fg); bf_[ks] = *(const LAS bf16x8*)(BT + fr * CS_LD + 32 * ks + 8 * fg); }
            const f32x4 zero4 = {0.f, 0.f, 0.f, 0.f};
            f32x4 Xc = zero4, Xt = zero4, AakT = zero4, ArbT = zero4, ArkT = zero4;
#pragma unroll
            for (int ks = 0; ks < 2; ++ks) { Xc = CS_M32(af[ks], bf_[ks], Xc); Xt = CS_M32(bf_[ks], af[ks], Xt);
                AakT = CS_M32(kf[ks], af[ks], AakT); ArbT = CS_M32(bf_[ks], rf[ks], ArbT); ArkT = CS_M32(kf[ks], rf[ks], ArkT); }
            f32x4 S1;
#pragma unroll
            for (int rr = 0; rr < 4; ++rr) { const int q = 4 * fg + rr;
                Xc[rr] = (fr < q) ? Xc[rr] : 0.f; Xt[rr] = (q < fr) ? Xt[rr] : 0.f; S1[rr] = Xt[rr] + ((q == fr) ? 1.0f : 0.f);
                AakT[rr] = (q < fr) ? AakT[rr] : 0.f; ArkT[rr] = (q <= fr) ? ArkT[rr] : 0.f; ArbT[rr] = (q <= fr) ? ArbT[rr] : 0.f; }
            { u32x2 w; w.x = cvt_pk_bf16(AakT[0], AakT[1]); w.y = cvt_pk_bf16(AakT[2], AakT[3]); *(LAS u32x2*)(sl + CS_AAK + o16) = w;
              w.x = cvt_pk_bf16(ArkT[0], ArkT[1]); w.y = cvt_pk_bf16(ArkT[2], ArkT[3]); *(LAS u32x2*)(sl + CS_ARK + o16) = w;
              w.x = cvt_pk_bf16(ArbT[0], ArbT[1]); w.y = cvt_pk_bf16(ArbT[2], ArbT[3]); *(LAS u32x2*)(sl + CS_ARB + o16) = w; }
#define CS_PK(v) ((u32x2){cvt_pk_bf16((v)[0], (v)[1]), cvt_pk_bf16((v)[2], (v)[3])})
            const u32x2 xc = CS_PK(Xc), xt = CS_PK(Xt), s1 = CS_PK(S1);
            const f32x4 X2c = CS_M16(xt, xc, zero4), X2t = CS_M16(xc, xt, zero4);
            const u32x2 x2c = CS_PK(X2c), x2t = CS_PK(X2t);
            const f32x4 S2 = CS_M16(x2c, s1, S1);
            const f32x4 X4c = CS_M16(x2t, x2c, zero4), X4t = CS_M16(x2c, x2t, zero4);
            const u32x2 x4c = CS_PK(X4c), x4t = CS_PK(X4t), s2 = CS_PK(S2);
            const f32x4 S4 = CS_M16(x4c, s2, S2);
            const f32x4 X8c = CS_M16(x4t, x4c, zero4);
            const u32x2 x8c = CS_PK(X8c), s4 = CS_PK(S4);
            const f32x4 S8 = CS_M16(x8c, s4, S4);
            *(LAS u32x2*)(sl + CS_TT + o16) = CS_PK(S8);
#undef CS_PK
            asm volatile("s_waitcnt lgkmcnt(0)" ::: "memory");
            __builtin_amdgcn_fence(__ATOMIC_RELEASE, "workgroup");
            if (lane == 0) flg[slot] = (unsigned)(n + 1);
        }
#undef CS_FETCH
    }
#undef CS_M32
#undef CS_M16
    __syncthreads();
}

__device__ __forceinline__ void combine_phase(const Frame& F, const Args& a) {
    unsigned char* ws = a.ws;
    const bf16* att = (const bf16*)(ws + WS_ATT); const bf16* rr = (const bf16*)(ws + WS_R); const bf16* vv = (const bf16*)(ws + WS_V);
    const bf16* kd = (const bf16*)(ws + WS_KDIR); const bf16* gg = (const bf16*)(ws + WS_G); const float* y = (const float*)(ws + WS_Y);
    bf16* mix = (bf16*)(ws + WS_MIX);
    const float* anw = a.in[4]; const float* r_k = a.in[14]; const float* ln_w = a.in[15]; const float* ln_b = a.in[16];
    const int lane = F.lane, c0 = 8 * lane;
    float nw[8], rk[8], lw[8], lb[8];
#pragma unroll
    for (int i = 0; i < 8; ++i) { nw[i] = anw[c0 + i]; rk[i] = r_k[c0 + i]; lw[i] = ln_w[c0 + i]; lb[i] = ln_b[c0 + i]; }
    const int gw = F.vcu * 8 + F.wave, NGW = F.G * 8;
#pragma unroll 2
    for (int m = gw; m < M; m += NGW) {
        const size_t o = (size_t)m * CW + c0;
        float f[8];
        unpack8(*(const u32x4*)(att + o), f);
        float ss = 0.f;
#pragma unroll
        for (int i = 0; i < 8; ++i) ss += f[i] * f[i];
        const float rs = rsqrtf(wave_sum(ss) * (1.f / CW) + RMS_EPS);
#pragma unroll
        for (int i = 0; i < 8; ++i) f[i] = f[i] * rs * nw[i];
        *(u32x4*)(mix + (size_t)m * D + c0) = pack8(f);
        const f32x4 y0a = *(const f32x4*)(y + o), y0b = *(const f32x4*)(y + o + 4), y1a = *(const f32x4*)(y + (size_t)M * CW + o), y1b = *(const f32x4*)(y + (size_t)M * CW + o + 4);
        float yv[8] = {y0a.x + y1a.x, y0a.y + y1a.y, y0a.z + y1a.z, y0a.w + y1a.w, y0b.x + y1b.x, y0b.y + y1b.y, y0b.z + y1b.z, y0b.w + y1b.w};
        float s1 = 0.f;
#pragma unroll
        for (int i = 0; i < 8; ++i) s1 += yv[i];
        s1 += __shfl_xor(s1, 1); s1 += __shfl_xor(s1, 2); s1 += __shfl_xor(s1, 4);
        const float mean = s1 * (1.f / 64.f);
        float s2 = 0.f;
#pragma unroll
        for (int i = 0; i < 8; ++i) { yv[i] -= mean; s2 += yv[i] * yv[i]; }
        s2 += __shfl_xor(s2, 1); s2 += __shfl_xor(s2, 2); s2 += __shfl_xor(s2, 4);
        const float rstd = rsqrtf(s2 * (1.f / 64.f) + GN_EPS);
        float rf[8], k0[8], k1[8], vf[8], gf[8];
        unpack8(*(const u32x4*)(rr + o), rf); unpack8(*(const u32x4*)(kd + o), k0); unpack8(*(const u32x4*)(kd + (size_t)M * CW + o), k1);
        unpack8(*(const u32x4*)(vv + o), vf); unpack8(*(const u32x4*)(gg + o), gf);
        float cf = 0.f;
#pragma unroll
        for (int i = 0; i < 8; ++i) cf += rf[i] * (k0[i] + k1[i]) * rk[i];
        cf += __shfl_xor(cf, 1); cf += __shfl_xor(cf, 2); cf += __shfl_xor(cf, 4);
#pragma unroll
        for (int i = 0; i < 8; ++i) f[i] = (yv[i] * rstd * lw[i] + lb[i] + cf * vf[i]) * gf[i];
        *(u32x4*)(mix + (size_t)m * D + CW + c0) = pack8(f);
    }
}

constexpr int RT_W = 0, RT_HIST = 131072, RT_LOG = 131072 + 256;
__device__ __forceinline__ void router_phase(const Frame& F, const Args& a) {
    unsigned char* ws = a.ws;
    const float* hbuf = (const float*)(ws + WS_H); unsigned char* hn2 = ws + WS_HN2;
    int* eidx = (int*)(ws + WS_EIDX); float* gate = (float*)(ws + WS_GATE); int* rank = (int*)(ws + WS_RANK);
    unsigned* ctl = (unsigned*)(ws + WS_CTL);
    const float* n2w = a.in[18]; const float* rw = a.in[19]; const float* rb = a.in[20];
    LAS float* wT = (LAS float*)(F.lds + RT_W); LAS int* hist = (LAS int*)(F.lds + RT_HIST); LAS float* lg = (LAS float*)(F.lds + RT_LOG) + F.wave * 64; LAS int* eL = (LAS int*)(F.lds + RT_LOG + 2048);
    { f32x4 tmp[16];
#pragma unroll
      for (int j = 0; j < 16; ++j) tmp[j] = *((const f32x4*)rw + F.tid + 512 * j);
#pragma unroll
      for (int j = 0; j < 16; ++j) { const int q = F.tid + 512 * j, d = q >> 3, e0 = 4 * (q & 7);
          wT[(e0 + 0) * 1024 + d] = tmp[j].x; wT[(e0 + 1) * 1024 + d] = tmp[j].y; wT[(e0 + 2) * 1024 + d] = tmp[j].z; wT[(e0 + 3) * 1024 + d] = tmp[j].w; } }
    if (F.tid < 32) hist[F.tid] = 0;
    __syncthreads();
    const int lane = F.lane;
    f32x4 wn[4];
#pragma unroll
    for (int j = 0; j < 4; ++j) wn[j] = *((const f32x4*)n2w + lane + 64 * j);
    const int blk = F.vcu;
    for (int pr = 0; pr < 8; ++pr) {
        const int m0 = blk * 128 + F.wave * 16 + pr * 2;
        f32x4 xv[2][4];
#pragma unroll
        for (int tk = 0; tk < 2; ++tk) {
            const f32x4* hr = (const f32x4*)(hbuf + (size_t)(m0 + tk) * D) + lane;
            float s = 0.f;
#pragma unroll
            for (int j = 0; j < 4; ++j) { xv[tk][j] = hr[64 * j]; s += (xv[tk][j].x * xv[tk][j].x + xv[tk][j].y * xv[tk][j].y) + (xv[tk][j].z * xv[tk][j].z + xv[tk][j].w * xv[tk][j].w); }
            const float rs = rsqrtf(wave_sum(s) * (1.f / D) + RMS_EPS);
            unsigned* o4 = (unsigned*)(hn2 + (size_t)(m0 + tk) * D) + lane;
#pragma unroll
            for (int j = 0; j < 4; ++j) { xv[tk][j] = xv[tk][j] * rs * wn[j]; o4[64 * j] = pk4_fp8(xv[tk][j].x * F8_SX, xv[tk][j].y * F8_SX, xv[tk][j].z * F8_SX, xv[tk][j].w * F8_SX); }
        }
        float kA0 = 0.f, kB0 = 0.f, kA1 = 0.f, kB1 = 0.f;
#pragma unroll 4
        for (int e = 0; e < 32; ++e) {
            float p0 = 0.f, p1 = 0.f;
#pragma unroll
            for (int j = 0; j < 4; ++j) { const f32x4 w4 = *(const LAS f32x4*)(wT + e * 1024 + 256 * j + 4 * lane);
                p0 += (w4.x * xv[0][j].x + w4.y * xv[0][j].y) + (w4.z * xv[0][j].z + w4.w * xv[0][j].w);
                p1 += (w4.x * xv[1][j].x + w4.y * xv[1][j].y) + (w4.z * xv[1][j].z + w4.w * xv[1][j].w); }
            p0 = row16_sum(p0); p1 = row16_sum(p1);
            const bool me = (lane & 15) == (e & 15);
            if (e < 16) { kA0 = me ? p0 : kA0; kA1 = me ? p1 : kA1; } else { kB0 = me ? p0 : kB0; kB1 = me ? p1 : kB1; }
        }
        kA0 += __shfl_xor(kA0, 16); kA0 += __shfl_xor(kA0, 32); kB0 += __shfl_xor(kB0, 16); kB0 += __shfl_xor(kB0, 32);
        kA1 += __shfl_xor(kA1, 16); kA1 += __shfl_xor(kA1, 32); kB1 += __shfl_xor(kB1, 16); kB1 += __shfl_xor(kB1, 32);
        if (lane < 32) { const int tk = lane >> 4, el = lane & 15; lg[tk * 32 + el] = (tk ? kA1 : kA0) + rb[el]; lg[tk * 32 + 16 + el] = (tk ? kB1 : kB0) + rb[16 + el]; }
        asm volatile("s_waitcnt lgkmcnt(0)" ::: "memory");
        if (lane < 2) {
            const LAS float* L = lg + lane * 32; const int m = m0 + lane;
            float v[32];
#pragma unroll
            for (int e = 0; e < 32; ++e) v[e] = L[e];
            float tv[4]; int ti[4];
#pragma unroll
            for (int kx = 0; kx < 4; ++kx) { float best = -3.0e38f; int bi = 0;
#pragma unroll
                for (int e = 0; e < 32; ++e) { if (v[e] > best) { best = v[e]; bi = e; } }
                tv[kx] = best; ti[kx] = bi;
#pragma unroll
                for (int e = 0; e < 32; ++e) { if (e == bi) v[e] = -3.0e38f; } }
            const float e0 = 1.0f, e1 = __expf(tv[1] - tv[0]), e2 = __expf(tv[2] - tv[0]), e3 = __expf(tv[3] - tv[0]);
            const float is = 1.0f / (e0 + e1 + e2 + e3);
            const float gs[4] = {e0 * is, e1 * is, e2 * is, e3 * is};
#pragma unroll
            for (int kx = 0; kx < 4; ++kx) { eidx[m * 4 + kx] = ti[kx]; gate[m * 4 + kx] = gs[kx]; eL[(m - blk * 128) * 4 + kx] = ti[kx]; }
        }
        asm volatile("s_waitcnt lgkmcnt(0)" ::: "memory");
    }
    __syncthreads();
    { const int t = F.tid, e = eL[t]; int rk = 0;
      for (int u = 0; u < t; ++u) rk += (eL[u] == e) ? 1 : 0;
      rank[(blk * 128) * 4 + t] = rk;
      __hip_atomic_fetch_add(&hist[e], 1, __ATOMIC_RELAXED, __HIP_MEMORY_SCOPE_WORKGROUP); }
    __syncthreads();
    if (F.tid < 32) ctl[CW_CNT + blk * 32 + F.tid] = (unsigned)hist[F.tid];
}

__device__ __forceinline__ void dispatch_phase(const Frame& F, const Args& a) {
    unsigned char* ws = a.ws;
    unsigned* ctl = (unsigned*)(ws + WS_CTL);
    const int* eidx = (const int*)(ws + WS_EIDX); const int* rank = (const int*)(ws + WS_RANK); int* dest = (int*)(ws + WS_DEST);
    LAS int* part = (LAS int*)F.lds;
    LAS int* tot = part + 1024;
    const int blk = F.vcu, G = F.G;
    { const int e = F.tid & 31, pt = F.tid >> 5; int s = 0, sb = 0;
      if (G == 256) { int cv[16];
#pragma unroll
          for (int q = 0; q < 16; ++q) cv[q] = (int)ld_u32_agent(ctl + CW_CNT + (pt + 16 * q) * 32 + e);
#pragma unroll
          for (int q = 0; q < 16; ++q) { s += cv[q]; if (pt + 16 * q < blk) sb += cv[q]; } }
      else for (int bb = pt; bb < G; bb += 16) { const int cval = (int)ld_u32_agent(ctl + CW_CNT + bb * 32 + e); s += cval; if (bb < blk) sb += cval; }
      part[pt * 32 + e] = s; part[512 + pt * 32 + e] = sb; }
    __syncthreads();
    if (F.tid < 32) { int s = 0, sb = 0;
        for (int pt = 0; pt < 16; ++pt) { s += part[pt * 32 + F.tid]; sb += part[512 + pt * 32 + F.tid]; }
        tot[F.tid] = s; tot[32 + F.tid] = sb; tot[96 + F.tid] = (s + 255) & ~255; }
    __syncthreads();
    if (F.tid == 0) { int ps = 0; for (int e = 0; e < 32; ++e) { tot[64 + e] = ps; ps += tot[96 + e]; }
        tot[128] = ps >> 8; }
    __syncthreads();
    if (blk == 0) {
        if (F.tid == 0) ctl[CW_NT] = (unsigned)tot[128];
        for (int e = F.tid >> 4; e < 32; e += 32) { const int t0 = tot[64 + e] >> 8, nt = tot[96 + e] >> 8; for (int i = F.tid & 15; i < nt; i += 16) ctl[CW_TEXP + t0 + i] = (unsigned)e; }
    }
    const int lane = F.lane;
    const int mw = blk * 128 + F.wave * 16;
    int* rowtok = (int*)(ws + WS_ROWTOK);
    { const int e = eidx[mw * 4 + lane]; const int dl = tot[64 + e] + tot[32 + e] + rank[mw * 4 + lane]; dest[mw * 4 + lane] = dl; rowtok[dl] = mw + (lane >> 2); }
    { const int e = blk & 31, pt = blk >> 5, np = G >> 5; const int r0 = tot[64 + e] + tot[e], r1 = tot[64 + e] + tot[96 + e];
      if (np > 0) for (int r = r0 + pt * 512 + F.tid; r < r1; r += np * 512) rowtok[r] = 0; }
}

__device__ __forceinline__ void final_phase(const Frame& F, const Args& a) {
    unsigned char* ws = a.ws;
    const float* hbuf = (const float*)(ws + WS_H); const bf16* ybuf = (const bf16*)(ws + WS_YBUF);
    const int* dest = (const int*)(ws + WS_DEST); const float* gate = (const float*)(ws + WS_GATE);
    const float* fw = a.in[25]; float* out = a.out;
    const int lane = F.lane;
    f32x4 wn[4];
#pragma unroll
    for (int j = 0; j < 4; ++j) wn[j] = *((const f32x4*)fw + lane + 64 * j);
    const int gw = F.vcu * 8 + F.wave, NGW = F.G * 8;
    const int per = M / NGW;
    const int mw = gw * per;
    int dl = 0; float gl = 0.f;
    if (lane < 4 * per && per <= 16) { dl = dest[mw * 4 + lane]; gl = gate[mw * 4 + lane]; }
#pragma unroll 2
    for (int i = 0; i < per; ++i) {
        const int m = mw + i;
        const f32x4* hr = (const f32x4*)(hbuf + (size_t)m * D) + lane;
        f32x4 v[4];
#pragma unroll
        for (int j = 0; j < 4; ++j) v[j] = hr[64 * j];
#pragma unroll
        for (int kx = 0; kx < 4; ++kx) {
            const int d = per <= 16 ? __shfl(dl, 4 * i + kx) : dest[m * 4 + kx]; const float gt = per <= 16 ? __shfl(gl, 4 * i + kx) : gate[m * 4 + kx];
            const u32x2* yr = (const u32x2*)(ybuf + (size_t)d * D) + lane;
#pragma unroll
            for (int j = 0; j < 4; ++j) { const u32x2 w = yr[64 * j]; v[j].x += gt * bflo(w.x); v[j].y += gt * bfhi(w.x); v[j].z += gt * bflo(w.y); v[j].w += gt * bfhi(w.y); }
        }
        float s = 0.f;
#pragma unroll
        for (int j = 0; j < 4; ++j) s += (v[j].x * v[j].x + v[j].y * v[j].y) + (v[j].z * v[j].z + v[j].w * v[j].w);
        const float rs = rsqrtf(wave_sum(s) * (1.f / D) + RMS_EPS);
        f32x4* orow = (f32x4*)(out + (size_t)m * D) + lane;
#pragma unroll
        for (int j = 0; j < 4; ++j) orow[64 * j] = v[j] * rs * wn[j];
    }
}

__global__ void __launch_bounds__(512, 2) fwd_megakernel(Args args) {
    extern __shared__ __attribute__((aligned(16))) unsigned char lds_raw[];
    Frame F;
    F.lds = (LAS unsigned char*)lds_raw;
    F.tid = threadIdx.x; F.lane = F.tid & 63; F.wave = __builtin_amdgcn_readfirstlane(F.tid >> 6);
    F.G = gridDim.x; { const int bx = blockIdx.x; F.vcu = (F.G % 8 == 0) ? (bx % 8) * (F.G / 8) + bx / 8 : bx; }
    unsigned char* ws = args.ws;
    const int lo = args.ph_lo, hi = args.ph_hi;
#define IN(k) (lo <= (k) && (k) < hi)
#if MK_SPLIT
#define SEAM(k) do { } while (0)
#else
    cg::grid_group grid = cg::this_grid();
    { volatile LAS unsigned* st = (volatile LAS unsigned*)(F.lds + LDS_MISC); if (F.tid < 2) st[F.tid] = 0u; __syncthreads(); }
    const XcdBarrier xbar = xcd_barrier_post((unsigned*)(ws + WS_CTL) + CW_BAR, (volatile LAS unsigned*)(F.lds + LDS_MISC));
    if (lo < 0) grid.sync();
#define SEAM(k) do { if (IN(k) && IN((k) + 1)) xcd_barrier(xbar); } while (0)
#endif
#define REP2(k) if constexpr (((MK_REPEAT >> (k)) & 1) != 0)
#define PH1 { pg8::Gemm g{(const bf16*)(ws + WS_HN), (const bf16*)(ws + WS_WINT), 1024, nullptr, 0, nullptr}; \
        pg8::StaticOrder S; S.init(M / 256, NPROJ_PAD / 256, F.G, (int)blockIdx.x); \
        pg8::EpiProj E{(bf16*)(ws + WS_Q), (bf16*)(ws + WS_K), (bf16*)(ws + WS_VT), (bf16*)(ws + WS_P)}; \
        pg8::gemm_phase<pg8::EpiProj, true, true>(F.lds, g, S, E); }
#define PH5 { pg8::Gemm g{(const bf16*)(ws + WS_MIX), (const bf16*)(ws + WS_WOT), 1024, nullptr, 0, nullptr}; \
        pg8::StaticOrder S; S.init(M / 256, D / 256, F.G, (int)blockIdx.x); \
        pg8::EpiWo E{args.in[0], (float*)(ws + WS_H)}; \
        pg8::gemm_phase<pg8::EpiWo, true, true>(F.lds, g, S, E); }
#define PH8 { const unsigned* ctl = (const unsigned*)(ws + WS_CTL); const int ntile = (int)ld_u32_agent(ctl + CW_NT); \
        pg8::Gemm g{(const bf16*)(ws + WS_HN2), (const bf16*)(ws + WS_WUPT), 512, ctl + CW_TEXP, (size_t)2048 * 1024, (const int*)(ws + WS_ROWTOK)}; \
        pg8::StaticOrder S; S.init(ntile, 8, F.G, (int)blockIdx.x); \
        pg8::EpiUp E{args.in[22], ws + WS_ACT}; \
        pg8::gemm_phase<pg8::EpiUp, true, true, true, true>(F.lds, g, S, E); }
#define PH9 { const unsigned* ctl = (const unsigned*)(ws + WS_CTL); const int ntile = (int)ld_u32_agent(ctl + CW_NT); \
        pg8::Gemm g{(const bf16*)(ws + WS_ACT), (const bf16*)(ws + WS_WDNT), 512, ctl + CW_TEXP, (size_t)1024 * 1024, nullptr}; \
        pg8::StaticOrder S; S.init(ntile, 4, F.G, (int)blockIdx.x); \
        pg8::EpiDown E{args.in[24], (bf16*)(ws + WS_YBUF)}; \
        pg8::gemm_phase<pg8::EpiDown, true, true, false, true>(F.lds, g, S, E); }
    if (IN(0)) { p0_prologue(F, args); REP2(0) p0_prologue(F, args); }
    SEAM(0);
    if (IN(1)) { PH1 REP2(1) PH1 }
    SEAM(1);
    if (IN(2)) { prep_phase<true>(F, args); REP2(2) prep_phase<true>(F, args); attn_phase(F, args); REP2(11) attn_phase(F, args); }
    SEAM(2);
    if (IN(3)) { scan_phase(F, args); REP2(3) scan_phase(F, args); }
    SEAM(3);
    if (IN(4)) { combine_phase(F, args); REP2(4) combine_phase(F, args); }
    SEAM(4);
    if (IN(5)) { PH5 REP2(5) PH5 }
    SEAM(5);
    if (IN(6)) { router_phase(F, args); REP2(6) { __syncthreads(); router_phase(F, args); } }
    SEAM(6);
    if (IN(7)) { dispatch_phase(F, args); REP2(7) { __syncthreads(); dispatch_phase(F, args); } }
    SEAM(7);
    if (IN(8)) { PH8 REP2(8) PH8 }
    SEAM(8);
    if (IN(9)) { PH9 REP2(9) PH9 }
    SEAM(9);
    if (IN(10)) { final_phase(F, args); REP2(10) final_phase(F, args); }
#undef IN
#undef SEAM
}

extern "C" void kernel_launch(void* const* d_in, const int* in_sizes, int n_in, void* d_out, int out_size, void* d_ws, size_t ws_size, hipStream_t stream) {
    static int grid = 0;
    if (grid == 0) {
        if (n_in != 26 || in_sizes[0] != M * D || out_size != M * D || ws_size < WS_END) { fprintf(stderr, "kernel_launch: unexpected problem (n_in %d, in0 %d, out %d, ws %zu)\n", n_in, n_in > 0 ? in_sizes[0] : -1, out_size, ws_size); grid = -1; return; }
        int dev = 0, cus = 0, per_cu = 0;
        if (hipGetDevice(&dev) != hipSuccess || hipDeviceGetAttribute(&cus, hipDeviceAttributeMultiprocessorCount, dev) != hipSuccess) { grid = -1; return; }
        if (hipFuncSetAttribute((const void*)fwd_megakernel, hipFuncAttributeMaxDynamicSharedMemorySize, LDS_BYTES) != hipSuccess) { fprintf(stderr, "kernel_launch: hipFuncSetAttribute failed\n"); grid = -1; return; }
        if (hipOccupancyMaxActiveBlocksPerMultiprocessor(&per_cu, (const void*)fwd_megakernel, 512, LDS_BYTES) != hipSuccess || per_cu < 1) { fprintf(stderr, "kernel_launch: occupancy query says %d\n", per_cu); per_cu = 1; }
        (void)hipGetLastError();
        grid = cus * 1;
        if (grid != 256) fprintf(stderr, "kernel_launch: note: %d CUs\n", cus);
    }
    if (grid < 0) return;
    if (hipMemsetAsync((char*)d_ws + WS_CTL + (size_t)CW_BAR * 4, 0, XCD_BAR_WORDS * 4, stream) != hipSuccess) { fprintf(stderr, "kernel_launch: memset failed\n"); return; }
    Args a{};
    for (int i = 0; i < 26; ++i) a.in[i] = (const float*)d_in[i];
    a.out = (float*)d_out; a.ws = (unsigned char*)d_ws;
#if MK_SPLIT
    for (int ph = 0; ph < NPHASE; ++ph) { a.ph_lo = ph; a.ph_hi = ph + 1; hipLaunchKernelGGL(fwd_megakernel, dim3(grid), dim3(512), LDS_BYTES, stream, a); }
#else
    a.ph_lo = 0; a.ph_hi = NPHASE;
    void* kargs[] = {&a};
    hipError_t e = hipLaunchCooperativeKernel((const void*)fwd_megakernel, dim3(grid), dim3(512), kargs, LDS_BYTES, stream);
    if (e != hipSuccess) fprintf(stderr, "kernel_launch: cooperative launch failed: %s (grid %d)\n", hipGetErrorString(e), grid);
#endif
}
```

```cpp
#include <hip/hip_runtime.h>
#include <hip/hip_cooperative_groups.h>
#include <cstdio>
#include <cstdint>
namespace cg = cooperative_groups;

#ifndef MK_SPLIT
#define MK_SPLIT 0
#endif

#ifndef MK_REPEAT
#define MK_REPEAT 0
#endif
#define LAS __attribute__((address_space(3)))
typedef unsigned short bf16;
typedef float f32x4 __attribute__((ext_vector_type(4)));
typedef float f32x2 __attribute__((ext_vector_type(2)));
typedef unsigned u32x4 __attribute__((ext_vector_type(4)));
typedef unsigned u32x2 __attribute__((ext_vector_type(2)));
typedef short bf16x8 __attribute__((ext_vector_type(8)));
typedef short s16x4 __attribute__((ext_vector_type(4)));

constexpr int BATCH = 4, T = 8192, D = 1024, M = BATCH * T;
constexpr int NH = 8, HD = 64, CW = 512;
constexpr int SHIFT_W = 1920, NPROJ = 3456, NPROJ_PAD = 3584, PW = 2048;
constexpr int NE = 32, TOPK = 4, DE = 1024;
constexpr int GRIDW = 64, GROWS = 128;
constexpr int P_TILES_MAX = 544, P_ROWS = P_TILES_MAX * 256;
constexpr float RMS_EPS = 1e-5f, GN_EPS = 64e-5f;
constexpr int NPHASE = 11;

constexpr size_t MiB = 1u << 20;
constexpr size_t WS_CTL = 0;
constexpr size_t WS_W2T = 1 * MiB, WS_A2T = WS_W2T + 131072, WS_G2T = WS_A2T + 131072;
constexpr size_t WS_WINT = 2 * MiB, WS_WOT = 9 * MiB, WS_WUPT = 12 * MiB, WS_WDNT = 140 * MiB;
constexpr size_t WS_EIDX = 204 * MiB, WS_GATE = WS_EIDX + 524288, WS_RANK = WS_GATE + 524288, WS_DEST = WS_RANK + 524288, WS_ROWTOK = WS_DEST + 524288;
constexpr size_t WS_R = 208 * MiB, WS_V = 240 * MiB, WS_KK = 272 * MiB, WS_DECAY = 304 * MiB, WS_KDIR = 368 * MiB, WS_AKK = 432 * MiB,
                 WS_G = 496 * MiB, WS_ATT = 528 * MiB;
constexpr size_t WS_Q = 560 * MiB, WS_K = 592 * MiB, WS_VT = 624 * MiB, WS_P = 656 * MiB, WS_HN = 784 * MiB, WS_Y = 848 * MiB;
constexpr size_t WS_MIX = 560 * MiB, WS_H = 752 * MiB, WS_HN2 = 880 * MiB, WS_XBUF = 208 * MiB, WS_ACT = 480 * MiB, WS_YBUF = 208 * MiB;
constexpr size_t WS_END = 976 * MiB;
constexpr int CW_NT = 0, CW_TEXP = 64, CW_CNT = 1024, CW_BAR = 16384;

constexpr int LDS_BYTES = 159744, LDS_MISC = LDS_BYTES - 256;

typedef __bf16 bf16x2_t __attribute__((ext_vector_type(2)));
__device__ __forceinline__ unsigned cvt_pk_bf16(float lo, float hi) { const f32x2 v = {lo, hi}; return __builtin_bit_cast(unsigned, __builtin_convertvector(v, bf16x2_t)); }
typedef int i32x8 __attribute__((ext_vector_type(8)));
typedef int i32x4 __attribute__((ext_vector_type(4)));
#ifndef F8_SCALE1
#define F8_SCALE1 0
#endif
constexpr float F8_SX = 32.0f, F8_SW = 128.0f, F8_SACT = 8.0f;
__device__ __forceinline__ float f8clamp(float v) { return __builtin_amdgcn_fmed3f(v, -448.0f, 448.0f); }
__device__ __forceinline__ unsigned pk4_fp8(float a, float b, float c, float d) { int w = 0; w = __builtin_amdgcn_cvt_pk_fp8_f32(f8clamp(a), f8clamp(b), w, false); w = __builtin_amdgcn_cvt_pk_fp8_f32(f8clamp(c), f8clamp(d), w, true); return (unsigned)w; }
__device__ __forceinline__ float bflo(unsigned u) { return __uint_as_float(u << 16); }
__device__ __forceinline__ float bfhi(unsigned u) { return __uint_as_float(u & 0xffff0000u); }
__device__ __forceinline__ float bf1(bf16 v) { return __uint_as_float(((unsigned)v) << 16); }
__device__ __forceinline__ void unpack8(const u32x4 u, float* f) { f[0] = bflo(u.x); f[1] = bfhi(u.x); f[2] = bflo(u.y); f[3] = bfhi(u.y); f[4] = bflo(u.z); f[5] = bfhi(u.z); f[6] = bflo(u.w); f[7] = bfhi(u.w); }
__device__ __forceinline__ u32x4 pack8(const float* f) { u32x4 o; o.x = cvt_pk_bf16(f[0], f[1]); o.y = cvt_pk_bf16(f[2], f[3]); o.z = cvt_pk_bf16(f[4], f[5]); o.w = cvt_pk_bf16(f[6], f[7]); return o; }
__device__ __forceinline__ float wave_sum(float v) {
#pragma unroll
    for (int o = 1; o < 64; o <<= 1) v += __shfl_xor(v, o);
    return v;
}
__device__ __forceinline__ float sigmoidf_(float x) { return __builtin_amdgcn_rcpf(1.0f + __expf(-x)); }
__device__ __forceinline__ unsigned ld_u32_agent(const unsigned* p) { return __hip_atomic_load(p, __ATOMIC_RELAXED, __HIP_MEMORY_SCOPE_AGENT); }

namespace pg8 {
constexpr int BM = 256, BK = 64, HALF = 128, HTB = HALF * BK * 2, STAGE_BYTES = 8 * HTB, NXCD = 8, WGM = 8;
__host__ __device__ __forceinline__ int lds_byte(int r, int c) { const int st = (r >> 4) * 2 + (c >> 5), rr = r & 15, cc = c & 31, ob = rr * 64 + cc * 2; return st * 1024 + (ob ^ (((ob >> 9) & 1) << 5)); }
__host__ __device__ __forceinline__ void stage_rc(int b, int& R, int& C) { const int st = b / 1024, sb = b % 1024, swz = sb ^ (((sb >> 9) & 1) << 5); R = (st >> 1) * 16 + swz / 64; C = (st & 1) * 32 + (swz % 64) / 2; }
__host__ __device__ __forceinline__ int perm32(int rho) { const int n = rho >> 4, i = rho & 15; return 8 * (i >> 2) + 4 * n + (i & 3); }

struct Unit { int pm, pn, e; };
struct Gemm { const bf16* A; const bf16* Bt; int K; const unsigned* texp; size_t bstride; const int* rowtok; };

struct StaticOrder {
    int nM, nN, nwg, G, c;
    __device__ void init(int nM_, int nN_, int G_, int c_) { nM = nM_; nN = nN_; nwg = nM * nN; G = G_; c = c_; }
    __device__ bool next(int i, Unit& u) const {
        const long L = (long)i * G + c; if (L >= nwg) return false;
        int wgid = (int)L; { const int q = nwg / NXCD, r = nwg % NXCD, xcd = wgid % NXCD, off = wgid / NXCD; wgid = (xcd < r ? xcd * (q + 1) : r * (q + 1) + (xcd - r) * q) + off; }
        const int nig = WGM * nN, gid = wgid / nig, fm = gid * WGM, gsz = (nM - fm) < WGM ? (nM - fm) : WGM;
        u.pm = fm + ((wgid % nig) % gsz); u.pn = (wgid % nig) / gsz; u.e = 0; return true;
    }
};

__device__ __forceinline__ i32x8 cat8(const bf16x8 lo, const bf16x8 hi) { return __builtin_shufflevector(__builtin_bit_cast(i32x4, lo), __builtin_bit_cast(i32x4, hi), 0, 1, 2, 3, 4, 5, 6, 7); }
template <class Epi, bool ALIGN_EPI, bool SP2, bool GATHER = false, bool FP8 = false>
__device__ __forceinline__ void gemm_phase(LAS unsigned char* lds, const Gemm g, const StaticOrder& S, const Epi& E) {
    const int tid = threadIdx.x, wid = __builtin_amdgcn_readfirstlane(tid >> 6), lane = tid & 63, wr = wid >> 2, wc = wid & 3, fr = lane & 15, fq = lane >> 4;
    const int K = g.K, nt = K / BK;
    unsigned voffA[2], voffB[2];
#pragma unroll
    for (int i = 0; i < 2; ++i) { int R, C; stage_rc(tid * 16 + i * 8192, R, C); const int Rb = Epi::PERM ? ((R & ~31) + perm32(R & 31)) : R;
        voffA[i] = (unsigned)(R * K + C) * 2u; voffB[i] = (unsigned)(Rb * K + C) * 2u; }
    unsigned vC[2][2];
#define PG8_GROWS(u, dst) do { _Pragma("unroll") for (int h_ = 0; h_ < 2; ++h_) _Pragma("unroll") for (int i_ = 0; i_ < 2; ++i_) { int R_, C_; stage_rc(tid * 16 + i_ * 8192, R_, C_); \
        dst[h_][i_] = (unsigned)g.rowtok[(u).pm * BM + h_ * HALF + R_] * (unsigned)(K * 2) + (unsigned)(C_ * 2); } } while (0)
    const size_t kstep = (size_t)(BK * 2);
    const size_t hstep = (size_t)HALF * K * 2;
    const size_t tstep = 2 * hstep;
    const unsigned ldsw = (unsigned)wid * 1024u;
    const int aoff = lds_byte(wr * 64 + fr, fq * 8), boff = lds_byte(wc * 32 + fr, fq * 8);
#define PG8_SA(b, h) (((b) * 2 + (h)) * HTB)
#define PG8_SB(b, h) ((4 + (b) * 2 + (h)) * HTB)
#define PG8_STAGE(bufoff, gbase, voff) do { _Pragma("unroll") for (int _i = 0; _i < 2; ++_i) \
        __builtin_amdgcn_global_load_lds((const unsigned*)((const char*)(gbase) + (voff)[_i]), (LAS unsigned*)(lds + (bufoff) + ldsw + _i * 8192), 16, 0, 0); } while (0)
#define PG8_STAGE_A(bufoff, p, h, nx) do { if constexpr (GATHER) { PG8_STAGE(bufoff, p, vC[h]); } else PG8_STAGE(bufoff, (p) + (h) * hstep, voffA); } while (0)
#define PG8_LDA(dst, b, h) do { _Pragma("unroll") for (int m = 0; m < 4; ++m) _Pragma("unroll") for (int k = 0; k < 2; ++k) dst[m][k] = *(const LAS bf16x8*)(lds + PG8_SA(b, h) + aoff + m * 2048 + k * 1024); } while (0)
#define PG8_LDB(dst, b, h) do { _Pragma("unroll") for (int n = 0; n < 2; ++n) _Pragma("unroll") for (int k = 0; k < 2; ++k) dst[n][k] = *(const LAS bf16x8*)(lds + PG8_SB(b, h) + boff + n * 2048 + k * 1024); } while (0)
#define PG8_MMA(ai, bj, At, Bt) do { __builtin_amdgcn_s_setprio(1); \
        if constexpr (FP8) { _Pragma("unroll") for (int m = 0; m < 4; ++m) _Pragma("unroll") for (int n = 0; n < 2; ++n) \
            { const i32x8 b8_ = cat8(Bt[n][0], Bt[n][1]), a8_ = cat8(At[m][0], At[m][1]); asm volatile("v_mfma_f32_16x16x128_f8f6f4 %0, %1, %2, %0" : "+v"(acc[ai][bj][m][n]) : "v"(b8_), "v"(a8_)); } } \
        else { _Pragma("unroll") for (int m = 0; m < 4; ++m) _Pragma("unroll") for (int n = 0; n < 2; ++n) _Pragma("unroll") for (int k = 0; k < 2; ++k) \
            acc[ai][bj][m][n] = __builtin_amdgcn_mfma_f32_16x16x32_bf16(Bt[n][k], At[m][k], acc[ai][bj][m][n], 0, 0, 0); } \
        __builtin_amdgcn_s_setprio(0); } while (0)
#define PG8_WAIT_V(n) asm volatile("s_waitcnt vmcnt(" #n ")" ::: "memory")
#define PG8_WAIT_L(n) asm volatile("s_waitcnt lgkmcnt(" #n ")" ::: "memory")
#define PG8_BAR __builtin_amdgcn_s_barrier()
#define PG8_SCHED __builtin_amdgcn_sched_barrier(0)
#define PG8_UPTR(u, pa, pb) do { unsigned _e = g.texp ? ld_u32_agent(g.texp + (u).pm) : 0u; _e = (unsigned)__builtin_amdgcn_readfirstlane((int)_e); (u).e = (int)_e; \
        pa = GATHER ? (const char*)g.A : (const char*)g.A + (size_t)(u).pm * tstep; pb = (const char*)g.Bt + (size_t)_e * g.bstride + (size_t)(u).pn * tstep; } while (0)
    Unit cur, nxt; int ui = 0;
    if (!S.next(0, cur)) return;
    f32x4 acc[2][2][4][2];
#pragma unroll
    for (int a = 0; a < 2; ++a)
#pragma unroll
        for (int b = 0; b < 2; ++b)
#pragma unroll
            for (int m = 0; m < 4; ++m)
#pragma unroll
                for (int n = 0; n < 2; ++n) acc[a][b][m][n] = (f32x4){0.f, 0.f, 0.f, 0.f};
    bf16x8 At[4][2], B0[2][2], B1[2][2];
    const char* cA; const char* cB;
    PG8_UPTR(cur, cA, cB);
    if constexpr (GATHER) { PG8_GROWS(cur, vC); }
    if constexpr (SP2) {
        PG8_STAGE(PG8_SB(0, 0), cB, voffB); PG8_STAGE(PG8_SB(0, 1), cB + hstep, voffB); PG8_STAGE_A(PG8_SA(0, 0), cA, 0, false); PG8_STAGE_A(PG8_SA(0, 1), cA, 1, false);
        if (wr == 1) PG8_BAR;
        PG8_WAIT_V(2); PG8_BAR;
        PG8_STAGE(PG8_SB(1, 0), cB + kstep, voffB); PG8_STAGE_A(PG8_SA(1, 0), cA + kstep, 0, false); PG8_STAGE(PG8_SB(1, 1), cB + hstep + kstep, voffB);
        PG8_WAIT_V(6); PG8_BAR;
    } else {
        PG8_STAGE(PG8_SB(0, 0), cB, voffB); PG8_STAGE_A(PG8_SA(0, 0), cA, 0, false); PG8_STAGE(PG8_SB(0, 1), cB + hstep, voffB); PG8_STAGE_A(PG8_SA(0, 1), cA, 1, false);
        if (wr == 1) PG8_BAR;
        PG8_WAIT_V(4); PG8_BAR;
        PG8_STAGE(PG8_SB(1, 0), cB + kstep, voffB); PG8_STAGE_A(PG8_SA(1, 0), cA + kstep, 0, false); PG8_STAGE(PG8_SB(1, 1), cB + hstep + kstep, voffB);
        PG8_WAIT_V(6); PG8_BAR;
    }
    for (;;) {
        const bool has_next = S.next(ui + 1, nxt);
        const char* nA = cA; const char* nB = cB;
        if (has_next) PG8_UPTR(nxt, nA, nB);
#pragma unroll 1
        for (int t = 0; t < nt; t += 2) {
            const bool last = (t == nt - 2);
            const char* a1 = cA + (size_t)(t + 1) * kstep;
            const char* a2 = last ? nA : cA + (size_t)(t + 2) * kstep; const char* b2 = last ? nB : cB + (size_t)(t + 2) * kstep;
            const char* a3 = a2 + kstep; const char* b3 = b2 + kstep;
            if constexpr (SP2) {
            PG8_LDB(B0, 0, 0); PG8_LDB(B1, 0, 1); PG8_SCHED; PG8_LDA(At, 0, 0); PG8_STAGE_A(PG8_SA(1, 1), a1, 1, false);
            if constexpr (GATHER) { if (last && has_next) { PG8_GROWS(nxt, vC); } }
            PG8_WAIT_V(8); PG8_WAIT_L(0); PG8_BAR; PG8_MMA(0, 0, At, B0); PG8_MMA(0, 1, At, B1); PG8_BAR; PG8_SCHED;
            PG8_LDA(At, 0, 1); PG8_STAGE(PG8_SB(0, 0), b2, voffB); PG8_STAGE(PG8_SB(0, 1), b2 + hstep, voffB); PG8_STAGE_A(PG8_SA(0, 0), a2, 0, last);
            PG8_WAIT_V(8); PG8_WAIT_L(0); PG8_BAR; PG8_MMA(1, 0, At, B0); PG8_MMA(1, 1, At, B1); PG8_BAR; PG8_SCHED;
            PG8_LDB(B0, 1, 0); PG8_LDB(B1, 1, 1); PG8_SCHED; PG8_LDA(At, 1, 0); PG8_STAGE_A(PG8_SA(0, 1), a2, 1, last);
            PG8_WAIT_V(8); PG8_WAIT_L(0); PG8_BAR; PG8_MMA(0, 0, At, B0); PG8_MMA(0, 1, At, B1); PG8_BAR; PG8_SCHED;
            PG8_LDA(At, 1, 1); PG8_STAGE(PG8_SB(1, 0), b3, voffB); PG8_STAGE(PG8_SB(1, 1), b3 + hstep, voffB); PG8_STAGE_A(PG8_SA(1, 0), a3, 0, last);
            PG8_WAIT_V(8); PG8_WAIT_L(0); PG8_BAR; PG8_MMA(1, 0, At, B0); PG8_MMA(1, 1, At, B1); PG8_BAR; PG8_SCHED;
            } else {
            PG8_LDB(B0, 0, 0); PG8_SCHED; PG8_LDA(At, 0, 0); PG8_STAGE_A(PG8_SA(1, 1), a1, 1, false);
            if constexpr (GATHER) { if (last && has_next) { PG8_GROWS(nxt, vC); } }
            PG8_WAIT_L(8); PG8_BAR; PG8_WAIT_L(0); PG8_MMA(0, 0, At, B0); PG8_BAR; PG8_SCHED;
            PG8_LDB(B1, 0, 1); PG8_STAGE(PG8_SB(0, 0), b2, voffB);
            PG8_BAR; PG8_WAIT_L(0); PG8_MMA(0, 1, At, B1); PG8_BAR;
            PG8_LDA(At, 0, 1); PG8_STAGE_A(PG8_SA(0, 0), a2, 0, last);
            PG8_BAR; PG8_WAIT_L(0); PG8_MMA(1, 0, At, B0); PG8_BAR; PG8_SCHED;
            PG8_STAGE(PG8_SB(0, 1), b2 + hstep, voffB);
            PG8_WAIT_V(6); PG8_BAR; PG8_MMA(1, 1, At, B1); PG8_BAR;
            PG8_LDB(B0, 1, 0); PG8_SCHED; PG8_LDA(At, 1, 0); PG8_STAGE_A(PG8_SA(0, 1), a2, 1, last);
            PG8_WAIT_L(8); PG8_BAR; PG8_WAIT_L(0); PG8_MMA(0, 0, At, B0); PG8_BAR; PG8_SCHED;
            PG8_LDB(B1, 1, 1); PG8_STAGE(PG8_SB(1, 0), b3, voffB);
            PG8_BAR; PG8_WAIT_L(0); PG8_MMA(0, 1, At, B1); PG8_BAR;
            PG8_LDA(At, 1, 1); PG8_STAGE_A(PG8_SA(1, 0), a3, 0, last);
            PG8_BAR; PG8_WAIT_L(0); PG8_MMA(1, 0, At, B0); PG8_BAR; PG8_SCHED;
            PG8_STAGE(PG8_SB(1, 1), b3 + hstep, voffB);
            PG8_WAIT_V(6); PG8_BAR; PG8_MMA(1, 1, At, B1); PG8_BAR;
            }
        }
        if constexpr (ALIGN_EPI) { if (wr == 0) PG8_BAR; }
        if constexpr (FP8) { asm volatile("s_nop 15\n\ts_nop 15" ::: "memory"); PG8_SCHED; }
        E(acc, cur, wr, wc, fr, fq);
        if (!has_next) break;
#pragma unroll
        for (int a = 0; a < 2; ++a)
#pragma unroll
            for (int b = 0; b < 2; ++b)
#pragma unroll
                for (int m = 0; m < 4; ++m)
#pragma unroll
                    for (int n = 0; n < 2; ++n) acc[a][b][m][n] = (f32x4){0.f, 0.f, 0.f, 0.f};
        cur = nxt; cA = nA; cB = nB; ++ui;
        if constexpr (ALIGN_EPI) { if (wr == 1) PG8_BAR; }
    }
    PG8_WAIT_V(0);
    if constexpr (!ALIGN_EPI) { if (wr == 0) PG8_BAR; }
    PG8_BAR;
#undef PG8_SA
#undef PG8_SB
#undef PG8_STAGE
#undef PG8_LDA
#undef PG8_LDB
#undef PG8_MMA
#undef PG8_WAIT_V
#undef PG8_WAIT_L
#undef PG8_BAR
#undef PG8_SCHED
#undef PG8_UPTR
#undef PG8_STAGE_A
#undef PG8_GROWS
}

struct EpiProj {
    static constexpr bool PERM = true;
    bf16 *q, *k, *vT, *p;
    __device__ __forceinline__ void operator()(const f32x4 (&acc)[2][2][4][2], const Unit& u, int wr, int wc, int fr, int fq) const {
        const int row0 = u.pm * BM + wr * 64 + fr;
        const int pn = u.pn;
#pragma unroll
        for (int ai = 0; ai < 2; ++ai)
#pragma unroll
            for (int m = 0; m < 4; ++m) {
                const int row = row0 + ai * HALF + m * 16;
#pragma unroll
                for (int bj = 0; bj < 2; ++bj) {
                    f32x4 v0 = acc[ai][bj][m][0], v1 = acc[ai][bj][m][1];
                    const int col = pn * BM + bj * HALF + wc * 32 + 8 * fq;
                    if (pn >= 4 && pn < 6) {
                        const int cv = col - 1024, hh = cv >> 6, dim = cv & 63, b = row / T, t = row % T;
                        bf16* dst = vT + ((size_t)(((b * NH + hh) * GROWS + (t >> 6)) * HD + dim)) * 64 + (t & 63);
                        const unsigned w0 = cvt_pk_bf16(v0[0], v0[1]), w1 = cvt_pk_bf16(v0[2], v0[3]), w2 = cvt_pk_bf16(v1[0], v1[1]), w3 = cvt_pk_bf16(v1[2], v1[3]);
                        dst[0 * 64] = (bf16)(w0 & 0xffff); dst[1 * 64] = (bf16)(w0 >> 16); dst[2 * 64] = (bf16)(w1 & 0xffff); dst[3 * 64] = (bf16)(w1 >> 16);
                        dst[4 * 64] = (bf16)(w2 & 0xffff); dst[5 * 64] = (bf16)(w2 >> 16); dst[6 * 64] = (bf16)(w3 & 0xffff); dst[7 * 64] = (bf16)(w3 >> 16);
                    } else {
                        bf16* dst;
                        if (pn < 2) { v0 = v0 * 0.125f; v1 = v1 * 0.125f; dst = q + (size_t)row * CW + col; }
                        else if (pn < 4) dst = k + (size_t)row * CW + (col - 512);
                        else dst = p + (size_t)row * PW + (col - 1536);
                        u32x4 w; w.x = cvt_pk_bf16(v0[0], v0[1]); w.y = cvt_pk_bf16(v0[2], v0[3]); w.z = cvt_pk_bf16(v1[0], v1[1]); w.w = cvt_pk_bf16(v1[2], v1[3]);
                        *(u32x4*)dst = w;
                    }
                }
            }
    }
};
struct EpiWo {
    static constexpr bool PERM = false;
    const float* x; float* h;
    __device__ __forceinline__ void operator()(const f32x4 (&acc)[2][2][4][2], const Unit& u, int wr, int wc, int fr, int fq) const {
        const int row0 = u.pm * BM + wr * 64 + fr, col0 = u.pn * BM + wc * 32 + 4 * fq;
#pragma unroll
        for (int ai = 0; ai < 2; ++ai)
#pragma unroll
            for (int m = 0; m < 4; ++m) { const size_t off = (size_t)(row0 + ai * HALF + m * 16) * D + col0;
#pragma unroll
                for (int bj = 0; bj < 2; ++bj)
#pragma unroll
                    for (int n = 0; n < 2; ++n) { const f32x4 xv = *(const f32x4*)(x + off + bj * HALF + n * 16); *(f32x4*)(h + off + bj * HALF + n * 16) = acc[ai][bj][m][n] + xv; } }
    }
};
struct EpiUp {
    static constexpr bool PERM = true;
    const float* b_up; unsigned char* act;
    __device__ __forceinline__ void operator()(const f32x4 (&acc)[2][2][4][2], const Unit& u, int wr, int wc, int fr, int fq) const {
        const int row0 = u.pm * BM + wr * 64 + fr, ch = u.pn * 128 + wc * 32 + 8 * fq;
        const float* bg = b_up + (size_t)u.e * 2048 + ch; const float* bl = bg + 1024;
        const f32x4 bg0 = *(const f32x4*)bg * F8_SACT, bg1 = *(const f32x4*)(bg + 4) * F8_SACT, bl0 = *(const f32x4*)bl, bl1 = *(const f32x4*)(bl + 4);
        constexpr float SG = F8_SACT / (F8_SX * F8_SW), SL = 1.0f / (F8_SX * F8_SW), KE = -1.702f * 1.44269504f / F8_SACT;
#pragma unroll
        for (int ai = 0; ai < 2; ++ai)
#pragma unroll
            for (int m = 0; m < 4; ++m) {
                float o[8];
#pragma unroll
                for (int n = 0; n < 2; ++n) { const f32x4 gv = acc[ai][0][m][n] * SG + (n ? bg1 : bg0), lv = acc[ai][1][m][n] * SL + (n ? bl1 : bl0);
#pragma unroll
                    for (int j = 0; j < 4; ++j) { const float gt = fminf(gv[j], 7.0f * F8_SACT), li = __builtin_amdgcn_fmed3f(lv[j], -7.0f, 7.0f);
                        const float t = gt * __builtin_amdgcn_rcpf(1.0f + __builtin_amdgcn_exp2f(gt * KE)); o[n * 4 + j] = __builtin_fmaf(li, t, t); } }
                int w0 = 0, w1 = 0;
                w0 = __builtin_amdgcn_cvt_pk_fp8_f32(o[0], o[1], w0, false); w0 = __builtin_amdgcn_cvt_pk_fp8_f32(o[2], o[3], w0, true);
                w1 = __builtin_amdgcn_cvt_pk_fp8_f32(o[4], o[5], w1, false); w1 = __builtin_amdgcn_cvt_pk_fp8_f32(o[6], o[7], w1, true);
                u32x2 w8; w8.x = (unsigned)w0; w8.y = (unsigned)w1;
                *(u32x2*)(act + (size_t)(row0 + ai * HALF + m * 16) * DE + ch) = w8;
            }
    }
};
struct EpiDown {
    static constexpr bool PERM = true;
    const float* b_dn; bf16* y;
    __device__ __forceinline__ void operator()(const f32x4 (&acc)[2][2][4][2], const Unit& u, int wr, int wc, int fr, int fq) const {
        const int row0 = u.pm * BM + wr * 64 + fr, col0 = u.pn * BM + wc * 32 + 8 * fq;
        const float* bb = b_dn + (size_t)u.e * D + col0;
        f32x4 bv[2][2];
#pragma unroll
        for (int bj = 0; bj < 2; ++bj)
#pragma unroll
            for (int n = 0; n < 2; ++n) bv[bj][n] = *(const f32x4*)(bb + bj * HALF + 4 * n);
#pragma unroll
        for (int ai = 0; ai < 2; ++ai)
#pragma unroll
            for (int m = 0; m < 4; ++m) { bf16* rowp = y + (size_t)(row0 + ai * HALF + m * 16) * D + col0;
#pragma unroll
                for (int bj = 0; bj < 2; ++bj) { const f32x4 v0 = acc[ai][bj][m][0] * (1.0f / (F8_SACT * F8_SW)) + bv[bj][0], v1 = acc[ai][bj][m][1] * (1.0f / (F8_SACT * F8_SW)) + bv[bj][1];
                    u32x4 w; w.x = cvt_pk_bf16(v0[0], v0[1]); w.y = cvt_pk_bf16(v0[2], v0[3]); w.z = cvt_pk_bf16(v1[0], v1[1]); w.w = cvt_pk_bf16(v1[2], v1[3]);
                    *(u32x4*)(rowp + bj * HALF) = w; } }
    }
};
}


#define XB_TMO      128
#define XB_XCNT(j)  (256  + 64 * (j))
#define XB_XSUB(j)  (1280 + 64 * (j))
#define XB_XGEN(j)  (2304 + 64 * (j))
#define XB_TOP      3328
#define XB_TOPGEN   3392
#define XCD_BAR_WORDS 3456
#define XB_SPIN_CAP (1u << 20)
__device__ __forceinline__ unsigned xb_ld(unsigned* p)              { return __hip_atomic_load(p, __ATOMIC_RELAXED, __HIP_MEMORY_SCOPE_AGENT); }
__device__ __forceinline__ unsigned xb_add(unsigned* p, unsigned v) { return __hip_atomic_fetch_add(p, v, __ATOMIC_RELAXED, __HIP_MEMORY_SCOPE_AGENT); }
__device__ __forceinline__ unsigned xb_xcc_id() { return (unsigned)__builtin_amdgcn_s_getreg((3 << 11) | 20) & 0xFu; }
#define XB_SPIN(cond, bar) do { unsigned _sp = 0; while (cond) { __builtin_amdgcn_s_sleep(1); \
    if ((++_sp & 255u) == 0u) { if (xb_ld(&(bar)[XB_TMO])) break; if (_sp > XB_SPIN_CAP) { atomicAdd(&(bar)[XB_TMO], 1u); break; } } } } while (0)
struct XcdBarrier { unsigned* bar; unsigned x; volatile LAS unsigned* st; };
__device__ __forceinline__ XcdBarrier xcd_barrier_post(unsigned* bar, volatile LAS unsigned* st) {
    XcdBarrier b; b.bar = bar; b.x = xb_xcc_id(); b.st = st;
    if (threadIdx.x == 0) (void)xb_add(&bar[XB_XCNT(b.x)], 1u);
    return b;
}
__device__ __forceinline__ void xcd_barrier_complete(unsigned* bar, unsigned x, unsigned& nloc, unsigned& nx) {
    const unsigned G = gridDim.x * gridDim.y * gridDim.z;
    unsigned sum, cnt, mine, sp = 0u;
    for (;;) {
        sum = 0u; cnt = 0u; mine = 0u;
#pragma unroll
        for (unsigned j = 0; j < 16; ++j) { const unsigned c = xb_ld(&bar[XB_XCNT(j)]); sum += c; cnt += (c > 0u) ? 1u : 0u; mine = (j == x) ? c : mine; }
        if (sum == G) break;
        __builtin_amdgcn_s_sleep(1);
        if ((++sp & 255u) == 0u) { if (xb_ld(&bar[XB_TMO])) break; if (sp > XB_SPIN_CAP) { atomicAdd(&bar[XB_TMO], 1u); break; } }
    }
    nloc = mine > 0u ? mine : 1u; nx = cnt > 0u ? cnt : 1u;
}
__device__ __forceinline__ void xcd_barrier(const XcdBarrier& b) {
    asm volatile("s_waitcnt vmcnt(0)" ::: "memory");
    __syncthreads();
    if (threadIdx.x == 0) {
        unsigned* bar = b.bar;
        __builtin_amdgcn_s_waitcnt(0);
        unsigned nloc = b.st[0], nx = b.st[1];
        if (nloc == 0u) { xcd_barrier_complete(bar, b.x, nloc, nx); b.st[0] = nloc; b.st[1] = nx; }
        const unsigned old = xb_add(&bar[XB_XSUB(b.x)], 1u);
        const unsigned gen = old / nloc;
        if (old + 1u == (gen + 1u) * nloc) {
            __builtin_amdgcn_fence(__ATOMIC_RELEASE, "agent");
            asm volatile("s_waitcnt vmcnt(0)" ::: "memory");
            const unsigned og = xb_add(&bar[XB_TOP], 1u);
            const unsigned tg = og / nx;
            if (og + 1u == (tg + 1u) * nx) xb_add(&bar[XB_TOPGEN], 1u);
            else XB_SPIN(xb_ld(&bar[XB_TOPGEN]) == tg, bar);
            __builtin_amdgcn_fence(__ATOMIC_ACQUIRE, "agent");
            xb_add(&bar[XB_XGEN(b.x)], 1u);
            asm volatile("s_waitcnt vmcnt(0)" ::: "memory");
        } else {
            XB_SPIN(xb_ld(&bar[XB_XGEN(b.x)]) == gen, bar);
            __builtin_amdgcn_fence(__ATOMIC_ACQUIRE, "agent");
            asm volatile("s_waitcnt vmcnt(0)" ::: "memory");
        }
    }
    __syncthreads();
}

struct Args { const float* in[26]; float* out; unsigned char* ws; int ph_lo, ph_hi; };

struct Frame { LAS unsigned char* lds; int tid, lane, wave, G, vcu; };

__device__ __forceinline__ void transpose_item(const float* W, int K, int N, bf16* WT, int k0, int n0, int orow0, LAS float* scr, int lane) {
#pragma unroll 8
    for (int i = 0; i < 32; ++i) { const int kk = 2 * i + (lane >> 5); scr[kk * 33 + (lane & 31)] = W[(size_t)(k0 + kk) * N + n0 + (lane & 31)]; }
    asm volatile("s_waitcnt lgkmcnt(0)" ::: "memory");
    const int c = lane & 7;
#pragma unroll
    for (int j = 0; j < 4; ++j) { const int n = (lane >> 3) + 8 * j; const LAS float* s = scr + (8 * c) * 33 + n;
        u32x4 o; o.x = cvt_pk_bf16(s[0 * 33], s[1 * 33]); o.y = cvt_pk_bf16(s[2 * 33], s[3 * 33]); o.z = cvt_pk_bf16(s[4 * 33], s[5 * 33]); o.w = cvt_pk_bf16(s[6 * 33], s[7 * 33]);
        *(u32x4*)(WT + (size_t)(orow0 + n) * K + k0 + 8 * c) = o; }
    asm volatile("s_waitcnt lgkmcnt(0)" ::: "memory");
}

__device__ __forceinline__ void transpose_item8(const float* W, int K, int N, unsigned char* WT, int k0, int n0, int orow0, LAS float* scr, int lane) {
#pragma unroll 8
    for (int i = 0; i < 32; ++i) { const int kk = 2 * i + (lane >> 5); scr[kk * 33 + (lane & 31)] = W[(size_t)(k0 + kk) * N + n0 + (lane & 31)]; }
    asm volatile("s_waitcnt lgkmcnt(0)" ::: "memory");
    const int c = lane & 7;
#pragma unroll
    for (int j = 0; j < 4; ++j) { const int n = (lane >> 3) + 8 * j; const LAS float* s = scr + (8 * c) * 33 + n;
        u32x2 o; o.x = pk4_fp8(s[0 * 33] * F8_SW, s[1 * 33] * F8_SW, s[2 * 33] * F8_SW, s[3 * 33] * F8_SW); o.y = pk4_fp8(s[4 * 33] * F8_SW, s[5 * 33] * F8_SW, s[6 * 33] * F8_SW, s[7 * 33] * F8_SW);
        *(u32x2*)(WT + (size_t)(orow0 + n) * K + k0 + 8 * c) = o; }
    asm volatile("s_waitcnt lgkmcnt(0)" ::: "memory");
}

__device__ __forceinline__ void p0_prologue(const Frame& F, const Args& a) {
    unsigned char* ws = a.ws;
    LAS float* scr = (LAS float*)(F.lds + F.wave * 8448);
    const int gw = F.vcu * 8 + F.wave, NGW = F.G * 8;
    constexpr int I_IN = 16 * 108, I_O = 16 * 32, I_UP = 32 * 16 * 64, I_DN = 32 * 16 * 32, I_L = 16, I_G = 32;
    constexpr int NITEMS = I_IN + I_O + I_UP + I_DN + 2 * I_L + 2 * I_L + I_G;
    for (int it = gw; it < NITEMS; it += NGW) {
        int r = it;
        if (r < I_UP) {
            const int e = r / 1024, q = r % 1024, kb = q / 64, nb = q % 64, n0 = nb * 32;
            const int orow0 = n0 < 1024 ? 256 * (n0 >> 7) + (n0 & 127) : 256 * ((n0 - 1024) >> 7) + 128 + ((n0 - 1024) & 127);
            transpose_item8(a.in[21] + (size_t)e * 1024 * 2048, 1024, 2048, ws + WS_WUPT + (size_t)e * 2048 * 1024, kb * 64, n0, orow0, scr, F.lane); continue; }
        r -= I_UP;
        if (r < I_DN) { const int e = r / 512, q = r % 512, kb = q / 32, nb = q % 32;
            transpose_item8(a.in[23] + (size_t)e * 1024 * 1024, 1024, 1024, ws + WS_WDNT + (size_t)e * 1024 * 1024, kb * 64, nb * 32, nb * 32, scr, F.lane); continue; }
        r -= I_DN;
        if (r < I_IN) { const int kb = r / 108, nb = r % 108; transpose_item(a.in[2], 1024, NPROJ, (bf16*)(ws + WS_WINT), kb * 64, nb * 32, nb * 32, scr, F.lane); continue; }
        r -= I_IN;
        if (r < I_O) { const int kb = r / 32, nb = r % 32; transpose_item(a.in[17], 1024, 1024, (bf16*)(ws + WS_WOT), kb * 64, nb * 32, nb * 32, scr, F.lane); continue; }
        r -= I_O;
        if (r < 2 * I_L) { const int z = r / 16, nb = r % 16; transpose_item(a.in[8] + (size_t)z * 64 * 512, 64, 512, (bf16*)(ws + WS_W2T) + (size_t)z * 512 * 64, 0, nb * 32, nb * 32, scr, F.lane); continue; }
        r -= 2 * I_L;
        if (r < 2 * I_L) { const int z = r / 16, nb = r % 16; transpose_item(a.in[10] + (size_t)z * 64 * 512, 64, 512, (bf16*)(ws + WS_A2T) + (size_t)z * 512 * 64, 0, nb * 32, nb * 32, scr, F.lane); continue; }
        r -= 2 * I_L;
        { const int kb = r / 16, nb = r % 16; transpose_item(a.in[11], 128, 512, (bf16*)(ws + WS_G2T), kb * 64, nb * 32, nb * 32, scr, F.lane); }
    }
    { u32x4* z = (u32x4*)(ws + WS_WINT + (size_t)NPROJ * 1024 * 2); const u32x4 zero = {0u, 0u, 0u, 0u};
      for (int i = F.vcu * 512 + F.tid; i < 16384; i += F.G * 512) z[i] = zero; }
    const float* x = a.in[0]; const float* nw = a.in[1]; bf16* hn = (bf16*)(ws + WS_HN);
    f32x4 wv[4];
#pragma unroll
    for (int j = 0; j < 4; ++j) wv[j] = *((const f32x4*)nw + F.lane + 64 * j);
    for (int m = gw; m < M; m += NGW) {
        const f32x4* xr = (const f32x4*)(x + (size_t)m * D) + F.lane;
        f32x4 v[4]; float s = 0.f;
#pragma unroll
        for (int j = 0; j < 4; ++j) { v[j] = xr[64 * j]; s += (v[j].x * v[j].x + v[j].y * v[j].y) + (v[j].z * v[j].z + v[j].w * v[j].w); }
        const float rs = rsqrtf(wave_sum(s) * (1.f / D) + RMS_EPS);
        u32x2* o8 = (u32x2*)(hn + (size_t)m * D) + F.lane;
#pragma unroll
        for (int j = 0; j < 4; ++j) { u32x2 o; o.x = cvt_pk_bf16(v[j].x * rs * wv[j].x, v[j].y * rs * wv[j].y); o.y = cvt_pk_bf16(v[j].z * rs * wv[j].z, v[j].w * rs * wv[j].w); o8[64 * j] = o; }
    }
}

constexpr int PREP_KBUF = 0, PREP_INV = 65536, PREP_AW = 67584, PREP_AA = PREP_AW + 17408, PREP_AG = PREP_AA + 17408, PREP_LD = 136;
template <bool STORE>
__device__ __forceinline__ void prep_phase(const Frame& F, const Args& a) {
    unsigned char* ws = a.ws;
    const bf16* p = (const bf16*)(ws + WS_P);
    bf16* r_out = (bf16*)(ws + WS_R); bf16* v_out = (bf16*)(ws + WS_V); bf16* kk_out = (bf16*)(ws + WS_KK);
    bf16* decay_out = (bf16*)(ws + WS_DECAY); bf16* kdir_out = (bf16*)(ws + WS_KDIR); bf16* akk_out = (bf16*)(ws + WS_AKK); bf16* g_out = (bf16*)(ws + WS_G);
    const bf16* w2T = (const bf16*)(ws + WS_W2T); const bf16* a2T = (const bf16*)(ws + WS_A2T); const bf16* g2T = (const bf16*)(ws + WS_G2T);
    const float* mu_p = a.in[5]; const float* mu_n = a.in[6]; const float* w0 = a.in[7]; const float* a0 = a.in[9];
    const float* k_k = a.in[12]; const float* k_a = a.in[13];
    LAS bf16* kbuf = (LAS bf16*)(F.lds + PREP_KBUF); LAS float* invb = (LAS float*)(F.lds + PREP_INV);
    LAS bf16* Aw = (LAS bf16*)(F.lds + PREP_AW); LAS bf16* Aa = (LAS bf16*)(F.lds + PREP_AA); LAS bf16* Ag = (LAS bf16*)(F.lds + PREP_AG);
    const int lane = F.lane, wave = F.wave, fr = lane & 15, fg = lane >> 4;
    for (int tile = F.vcu; tile < M / 64; tile += F.G) {
        const int m0 = tile * 64;
#pragma unroll 1
        for (int jj = 0; jj < 4; ++jj) {
            const int q = lane + 64 * jj; const bool valid = q < 240; const int c0 = 8 * q;
            float mp[8], mn[8];
#pragma unroll
            for (int i = 0; i < 8; ++i) { mp[i] = valid ? mu_p[c0 + i] : 0.f; mn[i] = valid ? mu_n[c0 + i] : 0.f; }
            const int mfirst = m0 + wave * 8;
            const u32x4 zero = {0u, 0u, 0u, 0u};
            u32x4 rows[10];
#pragma unroll
            for (int rI = 0; rI < 10; ++rI) { const int mr = mfirst - 1 + rI;
                const bool ok = valid && !(rI == 0 && (mfirst % T) == 0) && !(rI == 9 && ((mfirst + 7) % T) == T - 1);
                rows[rI] = ok ? *(const u32x4*)(p + (size_t)mr * PW + c0) : zero; }
#pragma unroll
            for (int i = 0; i < 8; ++i) {
                const int m = mfirst + i, it = wave * 8 + i;
                const u32x4 prev = rows[i], cur = rows[i + 1], nxt = rows[i + 2];
                float fp[8], fc[8], fn[8], s[8];
                unpack8(prev, fp); unpack8(cur, fc); unpack8(nxt, fn);
#pragma unroll
                for (int e = 0; e < 8; ++e) s[e] = fc[e] + mp[e] * (fp[e] - fc[e]) + mn[e] * (fn[e] - fc[e]);
                if (jj == 0) { if (STORE) { *(u32x4*)(r_out + (size_t)m * CW + c0) = pack8(s); } }
                else if (jj == 1) {
                    const int c = c0 - 512;
                    *(LAS u32x4*)(kbuf + it * 512 + c) = pack8(s);
                    float kr[8]; float ss = 0.f;
#pragma unroll
                    for (int e = 0; e < 8; ++e) { kr[e] = s[e] * k_k[c + e]; ss += kr[e] * kr[e]; }
                    ss += __shfl_xor(ss, 1); ss += __shfl_xor(ss, 2); ss += __shfl_xor(ss, 4);
                    const float inv = fminf(__builtin_amdgcn_rsqf(ss), 1e12f);
#pragma unroll
                    for (int e = 0; e < 8; ++e) kr[e] *= inv;
                    if (STORE) { *(u32x4*)(kk_out + (size_t)m * CW + c) = pack8(kr); }
                    if ((lane & 7) == 0) invb[it * 8 + (lane >> 3)] = inv;
                }
                else if (jj == 2) { if (STORE) { *(u32x4*)(v_out + (size_t)m * CW + (c0 - 1024)) = pack8(s); } }
                else if (valid) {
                    const int seg = lane >> 4, cw = 8 * (lane & 15);
                    if (seg == 0) {
#pragma unroll
                        for (int e = 0; e < 8; ++e) s[e] = 1.0f - 2.0f * __builtin_amdgcn_rcpf(__expf(2.0f * s[e]) + 1.0f);
                        *(LAS u32x4*)(Aw + it * PREP_LD + cw) = pack8(s);
                    } else if (seg == 1) { *(LAS u32x4*)(Aa + it * PREP_LD + cw) = pack8(s); }
                    else {
#pragma unroll
                        for (int e = 0; e < 8; ++e) s[e] = sigmoidf_(s[e]);
                        *(LAS u32x4*)(Ag + it * PREP_LD + cw) = pack8(s);
                    }
                }
            }
        }
        __syncthreads();
        const int nb = 64 * wave;
#pragma unroll 1
        for (int job = 0; job < 5; ++job) {
            const int z = job & 1;
            const bf16* WT = job < 2 ? w2T + (size_t)z * 512 * 64 : (job < 4 ? a2T + (size_t)z * 512 * 64 : g2T);
            const LAS bf16* Ax = job < 2 ? Aw + z * 64 : (job < 4 ? Aa + z * 64 : Ag);
            const int kw = job < 4 ? 64 : 128, nks = kw / 32;
            f32x4 acc[4][4];
#pragma unroll
            for (int mt = 0; mt < 4; ++mt)
#pragma unroll
                for (int nt = 0; nt < 4; ++nt) acc[mt][nt] = (f32x4){0.f, 0.f, 0.f, 0.f};
#pragma unroll 1
            for (int ks = 0; ks < nks; ++ks) {
                bf16x8 af[4], wf[4];
#pragma unroll
                for (int mt = 0; mt < 4; ++mt) af[mt] = *(const LAS bf16x8*)(Ax + (16 * mt + fr) * PREP_LD + 32 * ks + 8 * fg);
#pragma unroll
                for (int nt = 0; nt < 4; ++nt) wf[nt] = *(const bf16x8*)(WT + (size_t)(nb + 16 * nt + fr) * kw + 32 * ks + 8 * fg);
#pragma unroll
                for (int mt = 0; mt < 4; ++mt)
#pragma unroll
                    for (int nt = 0; nt < 4; ++nt) acc[mt][nt] = __builtin_amdgcn_mfma_f32_16x16x32_bf16(wf[nt], af[mt], acc[mt][nt], 0, 0, 0);
            }
#pragma unroll
            for (int mt = 0; mt < 4; ++mt) {
                const int it = 16 * mt + fr; const size_t m = (size_t)(m0 + it);
#pragma unroll
                for (int nt = 0; nt < 4; ++nt) {
                    const int n = nb + 16 * nt + 4 * fg;
                    const f32x4 v = acc[mt][nt];
                    if (job < 2) {
                        const f32x4 b = *(const f32x4*)(w0 + z * 512 + n);
                        float o[4];
#pragma unroll
                        for (int i = 0; i < 4; ++i) o[i] = __expf(-0.60653066f * sigmoidf_(v[i] + b[i]));
                        u32x2 w; w.x = cvt_pk_bf16(o[0], o[1]); w.y = cvt_pk_bf16(o[2], o[3]);
                        if (STORE) { *(u32x2*)(decay_out + ((size_t)z * M + m) * CW + n) = w; }
                    } else if (job < 4) {
                        const f32x4 b = *(const f32x4*)(a0 + z * 512 + n), kkc = *(const f32x4*)(k_k + n), kac = *(const f32x4*)(k_a + n);
                        const u32x2 kb = *(const LAS u32x2*)(kbuf + it * 512 + n);
                        const float kv[4] = {bflo(kb.x), bfhi(kb.x), bflo(kb.y), bfhi(kb.y)};
                        const float inv = invb[it * 8 + wave];
                        float kd[4], ak[4];
#pragma unroll
                        for (int i = 0; i < 4; ++i) { const float av = sigmoidf_(v[i] + b[i]); kd[i] = kv[i] * (1.0f + (av - 1.0f) * kac[i]); ak[i] = av * (kv[i] * kkc[i] * inv); }
                        u32x2 w; w.x = cvt_pk_bf16(kd[0], kd[1]); w.y = cvt_pk_bf16(kd[2], kd[3]);
                        if (STORE) { *(u32x2*)(kdir_out + ((size_t)z * M + m) * CW + n) = w; }
                        w.x = cvt_pk_bf16(ak[0], ak[1]); w.y = cvt_pk_bf16(ak[2], ak[3]);
                        if (STORE) { *(u32x2*)(akk_out + ((size_t)z * M + m) * CW + n) = w; }
                    } else {
                        u32x2 w; w.x = cvt_pk_bf16(v[0], v[1]); w.y = cvt_pk_bf16(v[2], v[3]);
                        if (STORE) { *(u32x2*)(g_out + m * CW + n) = w; }
                    }
                }
            }
        }
        __syncthreads();
    }
}

__device__ __forceinline__ void attn_phase(const Frame& F, const Args& a) {
    unsigned char* ws = a.ws;
    const bf16* q = (const bf16*)(ws + WS_Q); const bf16* k = (const bf16*)(ws + WS_K); const bf16* vT = (const bf16*)(ws + WS_VT);
    bf16* att = (bf16*)(ws + WS_ATT);
    LAS float* bias = (LAS float*)F.lds;
    for (int i = F.tid; i < 8 * 15 * 31; i += 512) bias[i] = a.in[3][i];
    __syncthreads();
    const int lane = F.lane, fr = lane & 15, fg = lane >> 4;
    const int NGW = F.G * 8, gw = F.vcu * 8 + F.wave;
    const int per = (16384 + NGW - 1) / NGW;
    for (int task = gw * per; task < (gw + 1) * per && task < 16384; ++task) {
        const int cgp = task & 3, r = (task >> 2) & 127, h = (task >> 9) & 7, b = task >> 12;
        const int c0 = 16 * cgp, wsc = min(max(c0 - 8, 0), 32), rs = min(max(r - 4, 0), GROWS - 8);
        const int c = c0 + fr, cs = min(max(c - 8, 0), 48);
        const size_t tq = (size_t)b * T + r * 64 + c;
        bf16x8 qf[2];
#pragma unroll
        for (int ks = 0; ks < 2; ++ks) qf[ks] = *(const bf16x8*)(q + tq * CW + h * 64 + 32 * ks + 8 * fg);
        f32x4 sc[16];
        const int kcol_a = wsc + 8 * (fr >> 2) + (fr & 3);
#pragma unroll
        for (int hb = 0; hb < 2; ++hb) {
            bf16x8 kf[8][2];
#pragma unroll
            for (int tl = 0; tl < 8; ++tl) { const int t = 8 * hb + tl, u = t >> 1, par = t & 1;
                const size_t tk = (size_t)b * T + (rs + u) * 64 + kcol_a + 4 * par;
                kf[tl][0] = *(const bf16x8*)(k + tk * CW + h * 64 + 8 * fg); kf[tl][1] = *(const bf16x8*)(k + tk * CW + h * 64 + 32 + 8 * fg); }
#pragma unroll
            for (int tl = 0; tl < 8; ++tl) { f32x4 s = {0.f, 0.f, 0.f, 0.f};
                s = __builtin_amdgcn_mfma_f32_16x16x32_bf16(kf[tl][0], qf[0], s, 0, 0, 0);
                s = __builtin_amdgcn_mfma_f32_16x16x32_bf16(kf[tl][1], qf[1], s, 0, 0, 0);
                sc[8 * hb + tl] = s; }
        }
        float mx = -1e30f;
#pragma unroll
        for (int u = 0; u < 8; ++u) {
            const int dr = rs + u - r + 7;
#pragma unroll
            for (int par = 0; par < 2; ++par)
#pragma unroll
                for (int i = 0; i < 4; ++i) {
                    const int kc = wsc + 8 * fg + 4 * par + i; const bool ok = (kc >= cs) && (kc < cs + 16);
                    const int dc = min(max(kc - c + 15, 0), 30);
                    const float s = ok ? sc[2 * u + par][i] + bias[(h * 15 + dr) * 31 + dc] : -1e30f;
                    sc[2 * u + par][i] = s; mx = fmaxf(mx, s);
                }
        }
        mx = fmaxf(mx, __shfl_xor(mx, 16)); mx = fmaxf(mx, __shfl_xor(mx, 32));
        float sum = 0.f;
#pragma unroll
        for (int t = 0; t < 16; ++t)
#pragma unroll
            for (int i = 0; i < 4; ++i) { const float pv = sc[t][i] > -1e29f ? __expf(sc[t][i] - mx) : 0.f; sc[t][i] = pv; sum += pv; }
        sum += __shfl_xor(sum, 16); sum += __shfl_xor(sum, 32);
        const float inv = 1.0f / sum;
        f32x4 o[4];
#pragma unroll
        for (int nt = 0; nt < 4; ++nt) o[nt] = (f32x4){0.f, 0.f, 0.f, 0.f};
#pragma unroll
        for (int hb = 0; hb < 2; ++hb) {
            bf16x8 vf[4][4];
#pragma unroll
            for (int ul = 0; ul < 4; ++ul) { const int u = 4 * hb + ul; const bf16* vblk = vT + ((size_t)((b * NH + h) * GROWS + rs + u)) * (HD * 64) + wsc + 8 * fg;
#pragma unroll
                for (int nt = 0; nt < 4; ++nt) vf[ul][nt] = *(const bf16x8*)(vblk + (16 * nt + fr) * 64); }
#pragma unroll
            for (int ul = 0; ul < 4; ++ul) { const int u = 4 * hb + ul;
                union { u32x4 w; bf16x8 h8; } pf;
                pf.w.x = cvt_pk_bf16(sc[2 * u][0], sc[2 * u][1]); pf.w.y = cvt_pk_bf16(sc[2 * u][2], sc[2 * u][3]);
                pf.w.z = cvt_pk_bf16(sc[2 * u + 1][0], sc[2 * u + 1][1]); pf.w.w = cvt_pk_bf16(sc[2 * u + 1][2], sc[2 * u + 1][3]);
#pragma unroll
                for (int nt = 0; nt < 4; ++nt) o[nt] = __builtin_amdgcn_mfma_f32_16x16x32_bf16(vf[ul][nt], pf.h8, o[nt], 0, 0, 0); }
        }
#pragma unroll
        for (int nt = 0; nt < 4; ++nt) { u32x2 w; w.x = cvt_pk_bf16(o[nt][0] * inv, o[nt][1] * inv); w.y = cvt_pk_bf16(o[nt][2] * inv, o[nt][3] * inv);
            *(u32x2*)(att + tq * CW + h * 64 + 16 * nt + 4 * fg) = w; }
    }
    __syncthreads();
}

__device__ __forceinline__ float row16_sum(float v) {
    v += __builtin_bit_cast(float, __builtin_amdgcn_update_dpp(0, __builtin_bit_cast(int, v), 0xB1, 0xF, 0xF, true));
    v += __builtin_bit_cast(float, __builtin_amdgcn_update_dpp(0, __builtin_bit_cast(int, v), 0x4E, 0xF, 0xF, true));
    v += __builtin_bit_cast(float, __builtin_amdgcn_update_dpp(0, __builtin_bit_cast(int, v), 0x141, 0xF, 0xF, true));
    v += __builtin_bit_cast(float, __builtin_amdgcn_update_dpp(0, __builtin_bit_cast(int, v), 0x140, 0xF, 0xF, true));
    return v;
}
constexpr int CS_R = 8;
constexpr int CS_AT = 0, CS_RT = 2304, CS_KHT = 4608, CS_BHT = 6656, CS_VT = 8704, CS_TT = 9216, CS_AAK = 9728, CS_ARK = 10240, CS_ARB = 10752, CS_PL = 11264, CS_SLOT = 11520;
constexpr int CS_LD = 72;
constexpr int CS_SCR = CS_R * CS_SLOT  , CS_SCRW = 2304 * 2 + 1024  , CS_FLAG = CS_SCR + 7 * CS_SCRW  ;
__device__ __forceinline__ bf16 f2bf(float f) { return (bf16)cvt_pk_bf16(f, 0.f); }
struct ChainOps { u32x2 a4[4], r4[4], kh[4], bh[4], aak, ark, arb, tt, vb; f32x4 pl[4]; };
__device__ __forceinline__ void chain_load(const LAS unsigned char* sl, int fr, int fg, ChainOps& o) {
    const int o16 = fr * 32 + fg * 8;
    const LAS unsigned char* pa = sl + CS_AT + fr * (CS_LD * 2) + fg * 8; const LAS unsigned char* pr = sl + CS_RT + fr * (CS_LD * 2) + fg * 8;
#pragma unroll
    for (int kq = 0; kq < 4; ++kq) { o.a4[kq] = *(const LAS u32x2*)(pa + 32 * kq); o.r4[kq] = *(const LAS u32x2*)(pr + 32 * kq); }
    o.aak = *(const LAS u32x2*)(sl + CS_AAK + o16); o.ark = *(const LAS u32x2*)(sl + CS_ARK + o16); o.arb = *(const LAS u32x2*)(sl + CS_ARB + o16); o.tt = *(const LAS u32x2*)(sl + CS_TT + o16);
    o.vb = *(const LAS u32x2*)(sl + CS_VT + o16);
#pragma unroll
    for (int mt = 0; mt < 4; ++mt) { o.pl[mt] = *(const LAS f32x4*)(sl + CS_PL + (16 * mt + 4 * fg) * 4);
        o.kh[mt] = *(const LAS u32x2*)(sl + CS_KHT + 512 * mt + o16); o.bh[mt] = *(const LAS u32x2*)(sl + CS_BHT + 512 * mt + o16); }
}
__device__ __forceinline__ f32x4 chain_compute(const ChainOps& o, f32x4 (&zacc)[4]) {
#define CS_M32(A_, B_, C_) __builtin_amdgcn_mfma_f32_16x16x32_bf16(A_, B_, C_, 0, 0, 0)
#define CS_M16(A_, B_, C_) __builtin_amdgcn_mfma_f32_16x16x16bf16_1k(__builtin_bit_cast(s16x4, A_), __builtin_bit_cast(s16x4, B_), C_, 0, 0, 0)
    union { u32x4 w; bf16x8 h8; } zb0, zb1, ap0, ap1, rp0, rp1;
    zb0.w.x = cvt_pk_bf16(zacc[0][0], zacc[0][1]); zb0.w.y = cvt_pk_bf16(zacc[0][2], zacc[0][3]); zb0.w.z = cvt_pk_bf16(zacc[1][0], zacc[1][1]); zb0.w.w = cvt_pk_bf16(zacc[1][2], zacc[1][3]);
    zb1.w.x = cvt_pk_bf16(zacc[2][0], zacc[2][1]); zb1.w.y = cvt_pk_bf16(zacc[2][2], zacc[2][3]); zb1.w.z = cvt_pk_bf16(zacc[3][0], zacc[3][1]); zb1.w.w = cvt_pk_bf16(zacc[3][2], zacc[3][3]);
    ap0.w = (u32x4){o.a4[0].x, o.a4[0].y, o.a4[1].x, o.a4[1].y}; ap1.w = (u32x4){o.a4[2].x, o.a4[2].y, o.a4[3].x, o.a4[3].y};
    rp0.w = (u32x4){o.r4[0].x, o.r4[0].y, o.r4[1].x, o.r4[1].y}; rp1.w = (u32x4){o.r4[2].x, o.r4[2].y, o.r4[3].x, o.r4[3].y};
    const f32x4 zero4 = {0.f, 0.f, 0.f, 0.f};
    f32x4 Wc = CS_M16(o.aak, o.vb, zero4);
    Wc = CS_M32(ap0.h8, zb0.h8, Wc); Wc = CS_M32(ap1.h8, zb1.h8, Wc);
    f32x4 Yc = CS_M16(o.ark, o.vb, zero4);
    Yc = CS_M32(rp0.h8, zb0.h8, Yc); Yc = CS_M32(rp1.h8, zb1.h8, Yc);
    f32x4 zz[4];
#pragma unroll
    for (int mt = 0; mt < 4; ++mt) zz[mt] = CS_M16(o.kh[mt], o.vb, zacc[mt] * o.pl[mt]);
    u32x2 wb, ub;
    wb.x = cvt_pk_bf16(Wc[0], Wc[1]); wb.y = cvt_pk_bf16(Wc[2], Wc[3]);
    const f32x4 Uc = CS_M16(o.tt, wb, zero4);
    ub.x = cvt_pk_bf16(Uc[0], Uc[1]); ub.y = cvt_pk_bf16(Uc[2], Uc[3]);
    Yc = CS_M16(o.arb, ub, Yc);
#pragma unroll
    for (int mt = 0; mt < 4; ++mt) zacc[mt] = CS_M16(o.bh[mt], ub, zz[mt]);
#undef CS_M32
#undef CS_M16
    return Yc;
}
template <int z>
__device__ __forceinline__ void scan_phase_z(const Frame& F, const Args& a) {
    unsigned char* ws = a.ws;
    const int seq = F.vcu >> 2, ig = F.vcu & 3;
    const int b = (seq >> 3) & 3, h = seq & 7;
    const size_t mb = (size_t)b * T;
    const int lane = F.lane, wave = F.wave, fr = lane & 15, fg = lane >> 4;
    constexpr int NCK = T / 16;
    volatile LAS unsigned* flg = (volatile LAS unsigned*)(F.lds + CS_FLAG);
    if (F.tid < 16) flg[F.tid] = 0u;
    __syncthreads();
    const int o16 = fr * 32 + fg * 8;
#define CS_M32(A_, B_, C_) __builtin_amdgcn_mfma_f32_16x16x32_bf16(A_, B_, C_, 0, 0, 0)
#define CS_M16(A_, B_, C_) __builtin_amdgcn_mfma_f32_16x16x16bf16_1k(__builtin_bit_cast(s16x4, A_), __builtin_bit_cast(s16x4, B_), C_, 0, 0, 0)
    if (wave == 0) {
        __builtin_amdgcn_s_setprio(3);
        float* yout = (float*)(ws + WS_Y) + (size_t)z * M * CW + h * 64 + ig * 16 + fr;
        f32x4 zacc[4];
#pragma unroll
        for (int mt = 0; mt < 4; ++mt) zacc[mt] = (f32x4){0.f, 0.f, 0.f, 0.f};
        ChainOps opA, opB;
#define CS_READY(nn) do { unsigned sp_ = 0; while (flg[(nn) & (CS_R - 1)] != (unsigned)((nn) + 1)) { __builtin_amdgcn_s_sleep(1); if (++sp_ > (1u << 24)) break; } __builtin_amdgcn_fence(__ATOMIC_ACQUIRE, "workgroup"); } while (0)
#define CS_HANDBACK(nn) do { asm volatile("s_waitcnt lgkmcnt(0)" ::: "memory"); if (lane == 0) flg[8] = (unsigned)((nn) + 1); asm volatile("" ::: "memory"); } while (0)
#define CS_YSTORE(nn, Y_) do { _Pragma("unroll") for (int rr = 0; rr < 4; ++rr) { const int q_ = 16 * (nn) + 4 * fg + rr, t_ = z ? (T - 1 - q_) : q_; yout[(mb + t_) * CW] = (Y_)[rr]; } } while (0)
        CS_READY(0); chain_load(F.lds, fr, fg, opA);
#pragma unroll 1
        for (int n = 0; n < NCK; n += 2) {
            CS_READY(n + 1); CS_HANDBACK(n);
            chain_load(F.lds + ((n + 1) & (CS_R - 1)) * CS_SLOT, fr, fg, opB);
            { const f32x4 Yc = chain_compute(opA, zacc); CS_YSTORE(n, Yc); }
            if (n + 2 < NCK) CS_READY(n + 2);
            CS_HANDBACK(n + 1);
            if (n + 2 < NCK) chain_load(F.lds + ((n + 2) & (CS_R - 1)) * CS_SLOT, fr, fg, opA);
            { const f32x4 Yc = chain_compute(opB, zacc); CS_YSTORE(n + 1, Yc); }
        }
#undef CS_READY
#undef CS_HANDBACK
#undef CS_YSTORE
        __builtin_amdgcn_s_setprio(0);
    } else {
        const int pi = wave - 1;
        LAS unsigned char* scr = F.lds + CS_SCR + pi * CS_SCRW;
        LAS bf16* KT = (LAS bf16*)scr; LAS bf16* BT = (LAS bf16*)(scr + 2304);
        const bf16* gw_ = (const bf16*)(ws + WS_DECAY) + (size_t)z * M * CW + h * 64;
        const bf16* gkk = (const bf16*)(ws + WS_KK) + h * 64;
        const bf16* gak = (const bf16*)(ws + WS_AKK) + (size_t)z * M * CW + h * 64;
        const bf16* gk = (const bf16*)(ws + WS_KDIR) + (size_t)z * M * CW + h * 64;
        const bf16* gr = (const bf16*)(ws + WS_R) + h * 64;
        const bf16* gv = (const bf16*)(ws + WS_V) + h * 64 + ig * 16;
        unsigned nw[16], nkk[16], nak[16], nk[16], nr[16], nv[4];
        constexpr long RSTEP = z ? -(long)CW : (long)CW;
#define CS_FETCH(nn) do { if ((nn) < NCK) { const size_t m0_ = (mb + (z ? (T - 1 - 16 * (nn)) : 16 * (nn))) * CW + lane; \
            const bf16* pw_ = gw_ + m0_; const bf16* pkk_ = gkk + m0_; const bf16* pak_ = gak + m0_; const bf16* pk_ = gk + m0_; const bf16* pr_ = gr + m0_; \
            _Pragma("unroll") for (int tt = 0; tt < 16; ++tt) { nw[tt] = pw_[tt * RSTEP]; nkk[tt] = pkk_[tt * RSTEP]; nak[tt] = pak_[tt * RSTEP]; nk[tt] = pk_[tt * RSTEP]; nr[tt] = pr_[tt * RSTEP]; } \
            const bf16* pv_ = gv + (mb + (z ? (T - 1 - 16 * (nn) - fg) : 16 * (nn) + fg)) * CW + fr; \
            _Pragma("unroll") for (int q4 = 0; q4 < 4; ++q4) nv[q4] = pv_[4 * q4 * RSTEP]; } } while (0)
        CS_FETCH(pi);
#pragma unroll 1
        for (int n = pi; n < NCK; n += 7) {
            const int slot = n & (CS_R - 1);
            float wv[16], kkv[16], akv[16], kv[16], rv[16], vq[4];
#pragma unroll
            for (int tt = 0; tt < 16; ++tt) { unsigned x0 = nw[tt], x1 = nkk[tt], x2 = nak[tt], x3 = nk[tt], x4 = nr[tt];
                asm volatile("" : "+v"(x0), "+v"(x1), "+v"(x2), "+v"(x3), "+v"(x4));
                wv[tt] = __uint_as_float(x0 << 16); kkv[tt] = __uint_as_float(x1 << 16); akv[tt] = __uint_as_float(x2 << 16); kv[tt] = __uint_as_float(x3 << 16); rv[tt] = __uint_as_float(x4 << 16); }
#pragma unroll
            for (int q4 = 0; q4 < 4; ++q4) { unsigned x0 = nv[q4]; asm volatile("" : "+v"(x0)); vq[q4] = __uint_as_float(x0 << 16); }
            CS_FETCH(n + 7);
            { unsigned sp = 0; while ((int)flg[8] < n - (CS_R - 3)) { __builtin_amdgcn_s_sleep(2); if (++sp > (1u << 24)) break; } }
            __builtin_amdgcn_fence(__ATOMIC_ACQUIRE, "workgroup");
            LAS unsigned char* sl = F.lds + slot * CS_SLOT;
            float P[16];
            P[0] = wv[0];
#pragma unroll
            for (int tt = 1; tt < 16; ++tt) P[tt] = P[tt - 1] * wv[tt];
            const float PL = P[15];
            float khat[16], bhat[16];
#pragma unroll
            for (int tt = 0; tt < 16; ++tt) {
                const float pm1 = tt ? P[tt - 1] : 1.0f, inv = __builtin_amdgcn_rcpf(P[tt]);
                const float at = kkv[tt] * pm1, rt = rv[tt] * P[tt], kt = kv[tt] * inv, bt = -akv[tt] * inv;
                khat[tt] = kt * PL; bhat[tt] = bt * PL;
                { const unsigned w_ = cvt_pk_bf16(at, rt); *(LAS bf16*)(sl + CS_AT + (tt * CS_LD + lane) * 2) = (bf16)w_; *(LAS bf16*)(sl + CS_RT + (tt * CS_LD + lane) * 2) = (bf16)(w_ >> 16); }
                { const unsigned w_ = cvt_pk_bf16(kt, bt); KT[tt * CS_LD + lane] = (bf16)w_; BT[tt * CS_LD + lane] = (bf16)(w_ >> 16); }
            }
            { u32x4 o0, o1;
              o0.x = cvt_pk_bf16(khat[0], khat[1]); o0.y = cvt_pk_bf16(khat[2], khat[3]); o0.z = cvt_pk_bf16(khat[4], khat[5]); o0.w = cvt_pk_bf16(khat[6], khat[7]);
              o1.x = cvt_pk_bf16(khat[8], khat[9]); o1.y = cvt_pk_bf16(khat[10], khat[11]); o1.z = cvt_pk_bf16(khat[12], khat[13]); o1.w = cvt_pk_bf16(khat[14], khat[15]);
              *(LAS u32x4*)(sl + CS_KHT + lane * 32) = o0; *(LAS u32x4*)(sl + CS_KHT + lane * 32 + 16) = o1;
              o0.x = cvt_pk_bf16(bhat[0], bhat[1]); o0.y = cvt_pk_bf16(bhat[2], bhat[3]); o0.z = cvt_pk_bf16(bhat[4], bhat[5]); o0.w = cvt_pk_bf16(bhat[6], bhat[7]);
              o1.x = cvt_pk_bf16(bhat[8], bhat[9]); o1.y = cvt_pk_bf16(bhat[10], bhat[11]); o1.z = cvt_pk_bf16(bhat[12], bhat[13]); o1.w = cvt_pk_bf16(bhat[14], bhat[15]);
              *(LAS u32x4*)(sl + CS_BHT + lane * 32) = o0; *(LAS u32x4*)(sl + CS_BHT + lane * 32 + 16) = o1; }
            *(LAS float*)(sl + CS_PL + lane * 4) = PL;
#pragma unroll
            for (int q4 = 0; q4 < 4; ++q4) *(LAS bf16*)(sl + CS_VT + (fr * 16 + fg + 4 * q4) * 2) = f2bf(vq[q4]);
            asm volatile("s_waitcnt lgkmcnt(0)" ::: "memory");
            bf16x8 af[2], rf[2], kf[2], bf_[2];
#pragma unroll
            for (int ks = 0; ks < 2; ++ks) { af[ks] = *(const LAS bf16x8*)(sl + CS_AT + (fr * CS_LD + 32 * ks + 8 * fg) * 2); rf[ks] = *(const LAS bf16x8*)(sl + CS_RT + (fr * CS_LD + 32 * ks + 8 * fg) * 2);
                kf[ks] = *(const LAS bf16x8*)(KT + fr * CS_LD + 32 * ks + 8 * fg); bf_[ks] = *(const LAS bf16x8*)(BT + fr * CS_LD + 32 * ks + 8 * fg); }
            const f32x4 zero4 = {0.f, 0.f, 0.f, 0.f};
            f32x4 Xc = zero4, Xt = zero4, AakT = zero4, ArbT = zero4, ArkT = zero4;
#pragma unroll
            for (int ks = 0; ks < 2; ++ks) { Xc = CS_M32(af[ks], bf_[ks], Xc); Xt = CS_M32(bf_[ks], af[ks], Xt);
                AakT = CS_M32(kf[ks], af[ks], AakT); ArbT = CS_M32(bf_[ks], rf[ks], ArbT); ArkT = CS_M32(kf[ks], rf[ks], ArkT); }
            f32x4 S1;
#pragma unroll
            for (int rr = 0; rr < 4; ++rr) { const int q = 4 * fg + rr;
                Xc[rr] = (fr < q) ? Xc[rr] : 0.f; Xt[rr] = (q < fr) ? Xt[rr] : 0.f; S1[rr] = Xt[rr] + ((q == fr) ? 1.0f : 0.f);
                AakT[rr] = (q < fr) ? AakT[rr] : 0.f; ArkT[rr] = (q <= fr) ? ArkT[rr] : 0.f; ArbT[rr] = (q <= fr) ? ArbT[rr] : 0.f; }
            { u32x2 w; w.x = cvt_pk_bf16(AakT[0], AakT[1]); w.y = cvt_pk_bf16(AakT[2], AakT[3]); *(LAS u32x2*)(sl + CS_AAK + o16) = w;
              w.x = cvt_pk_bf16(ArkT[0], ArkT[1]); w.y = cvt_pk_bf16(ArkT[2], ArkT[3]); *(LAS u32x2*)(sl + CS_ARK + o16) = w;
              w.x = cvt_pk_bf16(ArbT[0], ArbT[1]); w.y = cvt_pk_bf16(ArbT[2], ArbT[3]); *(LAS u32x2*)(sl + CS_ARB + o16) = w; }
#define CS_PK(v) ((u32x2){cvt_pk_bf16((v)[0], (v)[1]), cvt_pk_bf16((v)[2], (v)[3])})
            const u32x2 xc = CS_PK(Xc), xt = CS_PK(Xt), s1 = CS_PK(S1);
            const f32x4 X2c = CS_M16(xt, xc, zero4), X2t = CS_M16(xc, xt, zero4);
            const u32x2 x2c = CS_PK(X2c), x2t = CS_PK(X2t);
            const f32x4 S2 = CS_M16(x2c, s1, S1);
            const f32x4 X4c = CS_M16(x2t, x2c, zero4), X4t = CS_M16(x2c, x2t, zero4);
            const u32x2 x4c = CS_PK(X4c), x4t = CS_PK(X4t), s2 = CS_PK(S2);
            const f32x4 S4 = CS_M16(x4c, s2, S2);
            const f32x4 X8c = CS_M16(x4t, x4c, zero4);
            const u32x2 x8c = CS_PK(X8c), s4 = CS_PK(S4);
            const f32x4 S8 = CS_M16(x8c, s4, S4);
            *(LAS u32x2*)(sl + CS_TT + o16) = CS_PK(S8);
#undef CS_PK
            asm volatile("s_waitcnt lgkmcnt(0)" ::: "memory");
            __builtin_amdgcn_fence(__ATOMIC_RELEASE, "workgroup");
            if (lane == 0) flg[slot] = (unsigned)(n + 1);
        }
#undef CS_FETCH
    }
#undef CS_M32
#undef CS_M16
    __syncthreads();
}

__device__ __forceinline__ void scan_phase(const Frame& F, const Args& a) {
    const int seq = F.vcu >> 2;
    if (seq >= 64) return;
    if (seq >> 5) scan_phase_z<1>(F, a); else scan_phase_z<0>(F, a);
}

__device__ __forceinline__ void combine_phase(const Frame& F, const Args& a) {
    unsigned char* ws = a.ws;
    const bf16* att = (const bf16*)(ws + WS_ATT); const bf16* rr = (const bf16*)(ws + WS_R); const bf16* vv = (const bf16*)(ws + WS_V);
    const bf16* kd = (const bf16*)(ws + WS_KDIR); const bf16* gg = (const bf16*)(ws + WS_G); const float* y = (const float*)(ws + WS_Y);
    bf16* mix = (bf16*)(ws + WS_MIX);
    const float* anw = a.in[4]; const float* r_k = a.in[14]; const float* ln_w = a.in[15]; const float* ln_b = a.in[16];
    const int lane = F.lane, c0 = 8 * lane;
    float nw[8], rk[8], lw[8], lb[8];
#pragma unroll
    for (int i = 0; i < 8; ++i) { nw[i] = anw[c0 + i]; rk[i] = r_k[c0 + i]; lw[i] = ln_w[c0 + i]; lb[i] = ln_b[c0 + i]; }
    const int gw = F.vcu * 8 + F.wave, NGW = F.G * 8;
#pragma unroll 2
    for (int m = gw; m < M; m += NGW) {
        const size_t o = (size_t)m * CW + c0;
        float f[8];
        unpack8(*(const u32x4*)(att + o), f);
        float ss = 0.f;
#pragma unroll
        for (int i = 0; i < 8; ++i) ss += f[i] * f[i];
        const float rs = rsqrtf(wave_sum(ss) * (1.f / CW) + RMS_EPS);
#pragma unroll
        for (int i = 0; i < 8; ++i) f[i] = f[i] * rs * nw[i];
        *(u32x4*)(mix + (size_t)m * D + c0) = pack8(f);
        const f32x4 y0a = *(const f32x4*)(y + o), y0b = *(const f32x4*)(y + o + 4), y1a = *(const f32x4*)(y + (size_t)M * CW + o), y1b = *(const f32x4*)(y + (size_t)M * CW + o + 4);
        float yv[8] = {y0a.x + y1a.x, y0a.y + y1a.y, y0a.z + y1a.z, y0a.w + y1a.w, y0b.x + y1b.x, y0b.y + y1b.y, y0b.z + y1b.z, y0b.w + y1b.w};
        float s1 = 0.f;
#pragma unroll
        for (int i = 0; i < 8; ++i) s1 += yv[i];
        s1 += __shfl_xor(s1, 1); s1 += __shfl_xor(s1, 2); s1 += __shfl_xor(s1, 4);
        const float mean = s1 * (1.f / 64.f);
        float s2 = 0.f;
#pragma unroll
        for (int i = 0; i < 8; ++i) { yv[i] -= mean; s2 += yv[i] * yv[i]; }
        s2 += __shfl_xor(s2, 1); s2 += __shfl_xor(s2, 2); s2 += __shfl_xor(s2, 4);
        const float rstd = rsqrtf(s2 * (1.f / 64.f) + GN_EPS);
        float rf[8], k0[8], k1[8], vf[8], gf[8];
        unpack8(*(const u32x4*)(rr + o), rf); unpack8(*(const u32x4*)(kd + o), k0); unpack8(*(const u32x4*)(kd + (size_t)M * CW + o), k1);
        unpack8(*(const u32x4*)(vv + o), vf); unpack8(*(const u32x4*)(gg + o), gf);
        float cf = 0.f;
#pragma unroll
        for (int i = 0; i < 8; ++i) cf += rf[i] * (k0[i] + k1[i]) * rk[i];
        cf += __shfl_xor(cf, 1); cf += __shfl_xor(cf, 2); cf += __shfl_xor(cf, 4);
#pragma unroll
        for (int i = 0; i < 8; ++i) f[i] = (yv[i] * rstd * lw[i] + lb[i] + cf * vf[i]) * gf[i];
        *(u32x4*)(mix + (size_t)m * D + CW + c0) = pack8(f);
    }
}

constexpr int RT_W = 0, RT_HIST = 131072, RT_LOG = 131072 + 256;
__device__ __forceinline__ void router_phase(const Frame& F, const Args& a) {
    unsigned char* ws = a.ws;
    const float* hbuf = (const float*)(ws + WS_H); unsigned char* hn2 = ws + WS_HN2;
    int* eidx = (int*)(ws + WS_EIDX); float* gate = (float*)(ws + WS_GATE); int* rank = (int*)(ws + WS_RANK);
    unsigned* ctl = (unsigned*)(ws + WS_CTL);
    const float* n2w = a.in[18]; const float* rw = a.in[19]; const float* rb = a.in[20];
    LAS float* wT = (LAS float*)(F.lds + RT_W); LAS int* hist = (LAS int*)(F.lds + RT_HIST); LAS float* lg = (LAS float*)(F.lds + RT_LOG) + F.wave * 64; LAS int* eL = (LAS int*)(F.lds + RT_LOG + 2048);
    { f32x4 tmp[16];
#pragma unroll
      for (int j = 0; j < 16; ++j) tmp[j] = *((const f32x4*)rw + F.tid + 512 * j);
#pragma unroll
      for (int j = 0; j < 16; ++j) { const int q = F.tid + 512 * j, d = q >> 3, e0 = 4 * (q & 7);
          wT[(e0 + 0) * 1024 + d] = tmp[j].x; wT[(e0 + 1) * 1024 + d] = tmp[j].y; wT[(e0 + 2) * 1024 + d] = tmp[j].z; wT[(e0 + 3) * 1024 + d] = tmp[j].w; } }
    if (F.tid < 32) hist[F.tid] = 0;
    __syncthreads();
    const int lane = F.lane;
    f32x4 wn[4];
#pragma unroll
    for (int j = 0; j < 4; ++j) wn[j] = *((const f32x4*)n2w + lane + 64 * j);
    const int blk = F.vcu;
    for (int pr = 0; pr < 8; ++pr) {
        const int m0 = blk * 128 + F.wave * 16 + pr * 2;
        f32x4 xv[2][4];
#pragma unroll
        for (int tk = 0; tk < 2; ++tk) {
            const f32x4* hr = (const f32x4*)(hbuf + (size_t)(m0 + tk) * D) + lane;
            float s = 0.f;
#pragma unroll
            for (int j = 0; j < 4; ++j) { xv[tk][j] = hr[64 * j]; s += (xv[tk][j].x * xv[tk][j].x + xv[tk][j].y * xv[tk][j].y) + (xv[tk][j].z * xv[tk][j].z + xv[tk][j].w * xv[tk][j].w); }
            const float rs = rsqrtf(wave_sum(s) * (1.f / D) + RMS_EPS);
            unsigned* o4 = (unsigned*)(hn2 + (size_t)(m0 + tk) * D) + lane;
#pragma unroll
            for (int j = 0; j < 4; ++j) { xv[tk][j] = xv[tk][j] * rs * wn[j]; o4[64 * j] = pk4_fp8(xv[tk][j].x * F8_SX, xv[tk][j].y * F8_SX, xv[tk][j].z * F8_SX, xv[tk][j].w * F8_SX); }
        }
        float kA0 = 0.f, kB0 = 0.f, kA1 = 0.f, kB1 = 0.f;
#pragma unroll 4
        for (int e = 0; e < 32; ++e) {
            float p0 = 0.f, p1 = 0.f;
#pragma unroll
            for (int j = 0; j < 4; ++j) { const f32x4 w4 = *(const LAS f32x4*)(wT + e * 1024 + 256 * j + 4 * lane);
                p0 += (w4.x * xv[0][j].x + w4.y * xv[0][j].y) + (w4.z * xv[0][j].z + w4.w * xv[0][j].w);
                p1 += (w4.x * xv[1][j].x + w4.y * xv[1][j].y) + (w4.z * xv[1][j].z + w4.w * xv[1][j].w); }
            p0 = row16_sum(p0); p1 = row16_sum(p1);
            const bool me = (lane & 15) == (e & 15);
            if (e < 16) { kA0 = me ? p0 : kA0; kA1 = me ? p1 : kA1; } else { kB0 = me ? p0 : kB0; kB1 = me ? p1 : kB1; }
        }
        kA0 += __shfl_xor(kA0, 16); kA0 += __shfl_xor(kA0, 32); kB0 += __shfl_xor(kB0, 16); kB0 += __shfl_xor(kB0, 32);
        kA1 += __shfl_xor(kA1, 16); kA1 += __shfl_xor(kA1, 32); kB1 += __shfl_xor(kB1, 16); kB1 += __shfl_xor(kB1, 32);
        if (lane < 32) { const int tk = lane >> 4, el = lane & 15; lg[tk * 32 + el] = (tk ? kA1 : kA0) + rb[el]; lg[tk * 32 + 16 + el] = (tk ? kB1 : kB0) + rb[16 + el]; }
        asm volatile("s_waitcnt lgkmcnt(0)" ::: "memory");
        if (lane < 2) {
            const LAS float* L = lg + lane * 32; const int m = m0 + lane;
            float v[32];
#pragma unroll
            for (int e = 0; e < 32; ++e) v[e] = L[e];
            float tv[4]; int ti[4];
#pragma unroll
            for (int kx = 0; kx < 4; ++kx) { float best = -3.0e38f; int bi = 0;
#pragma unroll
                for (int e = 0; e < 32; ++e) { if (v[e] > best) { best = v[e]; bi = e; } }
                tv[kx] = best; ti[kx] = bi;
#pragma unroll
                for (int e = 0; e < 32; ++e) { if (e == bi) v[e] = -3.0e38f; } }
            const float e0 = 1.0f, e1 = __expf(tv[1] - tv[0]), e2 = __expf(tv[2] - tv[0]), e3 = __expf(tv[3] - tv[0]);
            const float is = 1.0f / (e0 + e1 + e2 + e3);
            const float gs[4] = {e0 * is, e1 * is, e2 * is, e3 * is};
#pragma unroll
            for (int kx = 0; kx < 4; ++kx) { eidx[m * 4 + kx] = ti[kx]; gate[m * 4 + kx] = gs[kx]; eL[(m - blk * 128) * 4 + kx] = ti[kx]; }
        }
        asm volatile("s_waitcnt lgkmcnt(0)" ::: "memory");
    }
    __syncthreads();
    { const int t = F.tid, e = eL[t]; int rk = 0;
      for (int u = 0; u < t; ++u) rk += (eL[u] == e) ? 1 : 0;
      rank[(blk * 128) * 4 + t] = rk;
      __hip_atomic_fetch_add(&hist[e], 1, __ATOMIC_RELAXED, __HIP_MEMORY_SCOPE_WORKGROUP); }
    __syncthreads();
    if (F.tid < 32) ctl[CW_CNT + blk * 32 + F.tid] = (unsigned)hist[F.tid];
}

__device__ __forceinline__ void dispatch_phase(const Frame& F, const Args& a) {
    unsigned char* ws = a.ws;
    unsigned* ctl = (unsigned*)(ws + WS_CTL);
    const int* eidx = (const int*)(ws + WS_EIDX); const int* rank = (const int*)(ws + WS_RANK); int* dest = (int*)(ws + WS_DEST);
    LAS int* part = (LAS int*)F.lds;
    LAS int* tot = part + 1024;
    const int blk = F.vcu, G = F.G;
    { const int e = F.tid & 31, pt = F.tid >> 5; int s = 0, sb = 0;
      if (G == 256) { int cv[16];
#pragma unroll
          for (int q = 0; q < 16; ++q) cv[q] = (int)ld_u32_agent(ctl + CW_CNT + (pt + 16 * q) * 32 + e);
#pragma unroll
          for (int q = 0; q < 16; ++q) { s += cv[q]; if (pt + 16 * q < blk) sb += cv[q]; } }
      else for (int bb = pt; bb < G; bb += 16) { const int cval = (int)ld_u32_agent(ctl + CW_CNT + bb * 32 + e); s += cval; if (bb < blk) sb += cval; }
      part[pt * 32 + e] = s; part[512 + pt * 32 + e] = sb; }
    __syncthreads();
    if (F.tid < 32) { int s = 0, sb = 0;
        for (int pt = 0; pt < 16; ++pt) { s += part[pt * 32 + F.tid]; sb += part[512 + pt * 32 + F.tid]; }
        tot[F.tid] = s; tot[32 + F.tid] = sb; tot[96 + F.tid] = (s + 255) & ~255; }
    __syncthreads();
    if (F.tid == 0) { int ps = 0; for (int e = 0; e < 32; ++e) { tot[64 + e] = ps; ps += tot[96 + e]; }
        tot[128] = ps >> 8; }
    __syncthreads();
    if (blk == 0) {
        if (F.tid == 0) ctl[CW_NT] = (unsigned)tot[128];
        for (int e = F.tid >> 4; e < 32; e += 32) { const int t0 = tot[64 + e] >> 8, nt = tot[96 + e] >> 8; for (int i = F.tid & 15; i < nt; i += 16) ctl[CW_TEXP + t0 + i] = (unsigned)e; }
    }
    const int lane = F.lane;
    const int mw = blk * 128 + F.wave * 16;
    int* rowtok = (int*)(ws + WS_ROWTOK);
    { const int e = eidx[mw * 4 + lane]; const int dl = tot[64 + e] + tot[32 + e] + rank[mw * 4 + lane]; dest[mw * 4 + lane] = dl; rowtok[dl] = mw + (lane >> 2); }
    { const int e = blk & 31, pt = blk >> 5, np = G >> 5; const int r0 = tot[64 + e] + tot[e], r1 = tot[64 + e] + tot[96 + e];
      if (np > 0) for (int r = r0 + pt * 512 + F.tid; r < r1; r += np * 512) rowtok[r] = 0; }
}

__device__ __forceinline__ void final_phase(const Frame& F, const Args& a) {
    unsigned char* ws = a.ws;
    const float* hbuf = (const float*)(ws + WS_H); const bf16* ybuf = (const bf16*)(ws + WS_YBUF);
    const int* dest = (const int*)(ws + WS_DEST); const float* gate = (const float*)(ws + WS_GATE);
    const float* fw = a.in[25]; float* out = a.out;
    const int lane = F.lane;
    f32x4 wn[4];
#pragma unroll
    for (int j = 0; j < 4; ++j) wn[j] = *((const f32x4*)fw + lane + 64 * j);
    const int gw = F.vcu * 8 + F.wave, NGW = F.G * 8;
    const int per = M / NGW;
    const int mw = gw * per;
    int dl = 0; float gl = 0.f;
    if (lane < 4 * per && per <= 16) { dl = dest[mw * 4 + lane]; gl = gate[mw * 4 + lane]; }
#pragma unroll 2
    for (int i = 0; i < per; ++i) {
        const int m = mw + i;
        const f32x4* hr = (const f32x4*)(hbuf + (size_t)m * D) + lane;
        f32x4 v[4];
#pragma unroll
        for (int j = 0; j < 4; ++j) v[j] = hr[64 * j];
#pragma unroll
        for (int kx = 0; kx < 4; ++kx) {
            const int d = per <= 16 ? __shfl(dl, 4 * i + kx) : dest[m * 4 + kx]; const float gt = per <= 16 ? __shfl(gl, 4 * i + kx) : gate[m * 4 + kx];
            const u32x2* yr = (const u32x2*)(ybuf + (size_t)d * D) + lane;
#pragma unroll
            for (int j = 0; j < 4; ++j) { const u32x2 w = yr[64 * j]; v[j].x += gt * bflo(w.x); v[j].y += gt * bfhi(w.x); v[j].z += gt * bflo(w.y); v[j].w += gt * bfhi(w.y); }
        }
        float s = 0.f;
#pragma unroll
        for (int j = 0; j < 4; ++j) s += (v[j].x * v[j].x + v[j].y * v[j].y) + (v[j].z * v[j].z + v[j].w * v[j].w);
        const float rs = rsqrtf(wave_sum(s) * (1.f / D) + RMS_EPS);
        f32x4* orow = (f32x4*)(out + (size_t)m * D) + lane;
#pragma unroll
        for (int j = 0; j < 4; ++j) orow[64 * j] = v[j] * rs * wn[j];
    }
}

__global__ void __launch_bounds__(512, 2) fwd_megakernel(Args args) {
    extern __shared__ __attribute__((aligned(16))) unsigned char lds_raw[];
    Frame F;
    F.lds = (LAS unsigned char*)lds_raw;
    F.tid = threadIdx.x; F.lane = F.tid & 63; F.wave = __builtin_amdgcn_readfirstlane(F.tid >> 6);
    F.G = gridDim.x; { const int bx = blockIdx.x; F.vcu = (F.G % 8 == 0) ? (bx % 8) * (F.G / 8) + bx / 8 : bx; }
    unsigned char* ws = args.ws;
    const int lo = args.ph_lo, hi = args.ph_hi;
#define IN(k) (lo <= (k) && (k) < hi)
#if MK_SPLIT
#define SEAM(k) do { } while (0)
#else
    cg::grid_group grid = cg::this_grid();
    { volatile LAS unsigned* st = (volatile LAS unsigned*)(F.lds + LDS_MISC); if (F.tid < 2) st[F.tid] = 0u; __syncthreads(); }
    const XcdBarrier xbar = xcd_barrier_post((unsigned*)(ws + WS_CTL) + CW_BAR, (volatile LAS unsigned*)(F.lds + LDS_MISC));
    if (lo < 0) grid.sync();
#define SEAM(k) do { if (IN(k) && IN((k) + 1)) xcd_barrier(xbar); } while (0)
#endif
#define REP2(k) if constexpr (((MK_REPEAT >> (k)) & 1) != 0)
#define PH1 { pg8::Gemm g{(const bf16*)(ws + WS_HN), (const bf16*)(ws + WS_WINT), 1024, nullptr, 0, nullptr}; \
        pg8::StaticOrder S; S.init(M / 256, NPROJ_PAD / 256, F.G, (int)blockIdx.x); \
        pg8::EpiProj E{(bf16*)(ws + WS_Q), (bf16*)(ws + WS_K), (bf16*)(ws + WS_VT), (bf16*)(ws + WS_P)}; \
        pg8::gemm_phase<pg8::EpiProj, true, true>(F.lds, g, S, E); }
#define PH5 { pg8::Gemm g{(const bf16*)(ws + WS_MIX), (const bf16*)(ws + WS_WOT), 1024, nullptr, 0, nullptr}; \
        pg8::StaticOrder S; S.init(M / 256, D / 256, F.G, (int)blockIdx.x); \
        pg8::EpiWo E{args.in[0], (float*)(ws + WS_H)}; \
        pg8::gemm_phase<pg8::EpiWo, true, true>(F.lds, g, S, E); }
#define PH8 { const unsigned* ctl = (const unsigned*)(ws + WS_CTL); const int ntile = (int)ld_u32_agent(ctl + CW_NT); \
        pg8::Gemm g{(const bf16*)(ws + WS_HN2), (const bf16*)(ws + WS_WUPT), 512, ctl + CW_TEXP, (size_t)2048 * 1024, (const int*)(ws + WS_ROWTOK)}; \
        pg8::StaticOrder S; S.init(ntile, 8, F.G, (int)blockIdx.x); \
        pg8::EpiUp E{args.in[22], ws + WS_ACT}; \
        pg8::gemm_phase<pg8::EpiUp, true, true, true, true>(F.lds, g, S, E); }
#define PH9 { const unsigned* ctl = (const unsigned*)(ws + WS_CTL); const int ntile = (int)ld_u32_agent(ctl + CW_NT); \
        pg8::Gemm g{(const bf16*)(ws + WS_ACT), (const bf16*)(ws + WS_WDNT), 512, ctl + CW_TEXP, (size_t)1024 * 1024, nullptr}; \
        pg8::StaticOrder S; S.init(ntile, 4, F.G, (int)blockIdx.x); \
        pg8::EpiDown E{args.in[24], (bf16*)(ws + WS_YBUF)}; \
        pg8::gemm_phase<pg8::EpiDown, true, true, false, true>(F.lds, g, S, E); }
    if (IN(0)) { p0_prologue(F, args); REP2(0) p0_prologue(F, args); }
    SEAM(0);
    if (IN(1)) { PH1 REP2(1) PH1 }
    SEAM(1);
    if (IN(2)) { prep_phase<true>(F, args); REP2(2) prep_phase<true>(F, args); attn_phase(F, args); REP2(11) attn_phase(F, args); }
    SEAM(2);
    if (IN(3)) { scan_phase(F, args); REP2(3) scan_phase(F, args); }
    SEAM(3);
    if (IN(4)) { combine_phase(F, args); REP2(4) combine_phase(F, args); }
    SEAM(4);
    if (IN(5)) { PH5 REP2(5) PH5 }
    SEAM(5);
    if (IN(6)) { router_phase(F, args); REP2(6) { __syncthreads(); router_phase(F, args); } }
    SEAM(6);
    if (IN(7)) { dispatch_phase(F, args); REP2(7) { __syncthreads(); dispatch_phase(F, args); } }
    SEAM(7);
    if (IN(8)) { PH8 REP2(8) PH8 }
    SEAM(8);
    if (IN(9)) { PH9 REP2(9) PH9 }
    SEAM(9);
    if (IN(10)) { final_phase(F, args); REP2(10) final_phase(F, args); }
#undef IN
#undef SEAM
}

extern "C" void kernel_launch(void* const* d_in, const int* in_sizes, int n_in, void* d_out, int out_size, void* d_ws, size_t ws_size, hipStream_t stream) {
    static int grid = 0;
    if (grid == 0) {
        if (n_in != 26 || in_sizes[0] != M * D || out_size != M * D || ws_size < WS_END) { fprintf(stderr, "kernel_launch: unexpected problem (n_in %d, in0 %d, out %d, ws %zu)\n", n_in, n_in > 0 ? in_sizes[0] : -1, out_size, ws_size); grid = -1; return; }
        int dev = 0, cus = 0, per_cu = 0;
        if (hipGetDevice(&dev) != hipSuccess || hipDeviceGetAttribute(&cus, hipDeviceAttributeMultiprocessorCount, dev) != hipSuccess) { grid = -1; return; }
        if (hipFuncSetAttribute((const void*)fwd_megakernel, hipFuncAttributeMaxDynamicSharedMemorySize, LDS_BYTES) != hipSuccess) { fprintf(stderr, "kernel_launch: hipFuncSetAttribute failed\n"); grid = -1; return; }
        if (hipOccupancyMaxActiveBlocksPerMultiprocessor(&per_cu, (const void*)fwd_megakernel, 512, LDS_BYTES) != hipSuccess || per_cu < 1) { fprintf(stderr, "kernel_launch: occupancy query says %d\n", per_cu); per_cu = 1; }
        (void)hipGetLastError();
        grid = cus * 1;
        if (grid != 256) fprintf(stderr, "kernel_launch: note: %d CUs\n", cus);
    }
    if (grid < 0) return;
    if (hipMemsetAsync((char*)d_ws + WS_CTL + (size_t)CW_BAR * 4, 0, XCD_BAR_WORDS * 4, stream) != hipSuccess) { fprintf(stderr, "kernel_launch: memset failed\n"); return; }
    Args a{};
    for (int i = 0; i < 26; ++i) a.in[i] = (const float*)d_in[i];
    a.out = (float*)d_out; a.ws = (unsigned char*)d_ws;
#if MK_SPLIT
    for (int ph = 0; ph < NPHASE; ++ph) { a.ph_lo = ph; a.ph_hi = ph + 1; hipLaunchKernelGGL(fwd_megakernel, dim3(grid), dim3(512), LDS_BYTES, stream, a); }
#else
    a.ph_lo = 0; a.ph_hi = NPHASE;
    void* kargs[] = {&a};
    hipError_t e = hipLaunchCooperativeKernel((const void*)fwd_megakernel, dim3(grid), dim3(512), kargs, LDS_BYTES, stream);
    if (e != hipSuccess) fprintf(stderr, "kernel_launch: cooperative launch failed: %s (grid %d)\n", hipGetErrorString(e), grid);
#endif
}
```

```cpp
#include <hip/hip_runtime.h>
#include <hip/hip_cooperative_groups.h>
#include <cstdio>
#include <cstdint>
namespace cg = cooperative_groups;

#ifndef MK_SPLIT
#define MK_SPLIT 0
#endif

#ifndef MK_REPEAT
#define MK_REPEAT 0
#endif
#define LAS __attribute__((address_space(3)))
typedef unsigned short bf16;
typedef float f32x4 __attribute__((ext_vector_type(4)));
typedef float f32x2 __attribute__((ext_vector_type(2)));
typedef unsigned u32x4 __attribute__((ext_vector_type(4)));
typedef unsigned u32x2 __attribute__((ext_vector_type(2)));
typedef short bf16x8 __attribute__((ext_vector_type(8)));
typedef short s16x4 __attribute__((ext_vector_type(4)));

constexpr int BATCH = 4, T = 8192, D = 1024, M = BATCH * T;
constexpr int NH = 8, HD = 64, CW = 512;
constexpr int SHIFT_W = 1920, NPROJ = 3456, NPROJ_PAD = 3584, PW = 2048;
constexpr int NE = 32, TOPK = 4, DE = 1024;
constexpr int GRIDW = 64, GROWS = 128;
constexpr int P_TILES_MAX = 544, P_ROWS = P_TILES_MAX * 256;
constexpr float RMS_EPS = 1e-5f, GN_EPS = 64e-5f;
constexpr int NPHASE = 11;

constexpr size_t MiB = 1u << 20;
constexpr size_t WS_CTL = 0;
constexpr size_t WS_W2T = 1 * MiB, WS_A2T = WS_W2T + 131072, WS_G2T = WS_A2T + 131072;
constexpr size_t WS_WINT = 2 * MiB, WS_WOT = 9 * MiB, WS_WUPT = 12 * MiB, WS_WDNT = 140 * MiB;
constexpr size_t WS_EIDX = 204 * MiB, WS_GATE = WS_EIDX + 524288, WS_RANK = WS_GATE + 524288, WS_DEST = WS_RANK + 524288, WS_ROWTOK = WS_DEST + 524288;
constexpr size_t WS_R = 208 * MiB, WS_V = 240 * MiB, WS_KK = 272 * MiB, WS_DECAY = 304 * MiB, WS_KDIR = 368 * MiB, WS_AKK = 432 * MiB,
                 WS_G = 496 * MiB, WS_ATT = 528 * MiB;
constexpr size_t WS_Q = 560 * MiB, WS_K = 592 * MiB, WS_VT = 624 * MiB, WS_P = 656 * MiB, WS_HN = 784 * MiB, WS_Y = 848 * MiB;
constexpr size_t WS_MIX = 560 * MiB, WS_H = 752 * MiB, WS_HN2 = 880 * MiB, WS_XBUF = 208 * MiB, WS_ACT = 480 * MiB, WS_YBUF = 208 * MiB;
constexpr size_t WS_END = 976 * MiB;
constexpr int CW_NT = 0, CW_TEXP = 64, CW_CNT = 1024, CW_BAR = 16384;

constexpr int LDS_BYTES = 159744, LDS_MISC = LDS_BYTES - 256;

typedef __bf16 bf16x2_t __attribute__((ext_vector_type(2)));
__device__ __forceinline__ unsigned cvt_pk_bf16(float lo, float hi) { const f32x2 v = {lo, hi}; return __builtin_bit_cast(unsigned, __builtin_convertvector(v, bf16x2_t)); }
typedef int i32x8 __attribute__((ext_vector_type(8)));
typedef int i32x4 __attribute__((ext_vector_type(4)));
#ifndef F8_SCALE1
#define F8_SCALE1 0
#endif
constexpr float F8_SX = 32.0f, F8_SW = 128.0f, F8_SACT = 8.0f;
__device__ __forceinline__ float f8clamp(float v) { return __builtin_amdgcn_fmed3f(v, -448.0f, 448.0f); }
__device__ __forceinline__ unsigned pk4_fp8(float a, float b, float c, float d) { int w = 0; w = __builtin_amdgcn_cvt_pk_fp8_f32(f8clamp(a), f8clamp(b), w, false); w = __builtin_amdgcn_cvt_pk_fp8_f32(f8clamp(c), f8clamp(d), w, true); return (unsigned)w; }
__device__ __forceinline__ float bflo(unsigned u) { return __uint_as_float(u << 16); }
__device__ __forceinline__ float bfhi(unsigned u) { return __uint_as_float(u & 0xffff0000u); }
__device__ __forceinline__ float bf1(bf16 v) { return __uint_as_float(((unsigned)v) << 16); }
__device__ __forceinline__ void unpack8(const u32x4 u, float* f) { f[0] = bflo(u.x); f[1] = bfhi(u.x); f[2] = bflo(u.y); f[3] = bfhi(u.y); f[4] = bflo(u.z); f[5] = bfhi(u.z); f[6] = bflo(u.w); f[7] = bfhi(u.w); }
__device__ __forceinline__ u32x4 pack8(const float* f) { u32x4 o; o.x = cvt_pk_bf16(f[0], f[1]); o.y = cvt_pk_bf16(f[2], f[3]); o.z = cvt_pk_bf16(f[4], f[5]); o.w = cvt_pk_bf16(f[6], f[7]); return o; }
__device__ __forceinline__ float wave_sum(float v) {
#pragma unroll
    for (int o = 1; o < 64; o <<= 1) v += __shfl_xor(v, o);
    return v;
}
__device__ __forceinline__ float sigmoidf_(float x) { return __builtin_amdgcn_rcpf(1.0f + __expf(-x)); }
__device__ __forceinline__ unsigned ld_u32_agent(const unsigned* p) { return __hip_atomic_load(p, __ATOMIC_RELAXED, __HIP_MEMORY_SCOPE_AGENT); }

namespace pg8 {
constexpr int BM = 256, BK = 64, HALF = 128, HTB = HALF * BK * 2, STAGE_BYTES = 8 * HTB, NXCD = 8, WGM = 8;
__host__ __device__ __forceinline__ int lds_byte(int r, int c) { const int st = (r >> 4) * 2 + (c >> 5), rr = r & 15, cc = c & 31, ob = rr * 64 + cc * 2; return st * 1024 + (ob ^ (((ob >> 9) & 1) << 5)); }
__host__ __device__ __forceinline__ void stage_rc(int b, int& R, int& C) { const int st = b / 1024, sb = b % 1024, swz = sb ^ (((sb >> 9) & 1) << 5); R = (st >> 1) * 16 + swz / 64; C = (st & 1) * 32 + (swz % 64) / 2; }
__host__ __device__ __forceinline__ int perm32(int rho) { const int n = rho >> 4, i = rho & 15; return 8 * (i >> 2) + 4 * n + (i & 3); }

struct Unit { int pm, pn, e; };
struct Gemm { const bf16* A; const bf16* Bt; int K; const unsigned* texp; size_t bstride; const int* rowtok; };

struct StaticOrder {
    int nM, nN, nwg, G, c;
    __device__ void init(int nM_, int nN_, int G_, int c_) { nM = nM_; nN = nN_; nwg = nM * nN; G = G_; c = c_; }
    __device__ bool next(int i, Unit& u) const {
        const long L = (long)i * G + c; if (L >= nwg) return false;
        int wgid = (int)L; { const int q = nwg / NXCD, r = nwg % NXCD, xcd = wgid % NXCD, off = wgid / NXCD; wgid = (xcd < r ? xcd * (q + 1) : r * (q + 1) + (xcd - r) * q) + off; }
        const int nig = WGM * nN, gid = wgid / nig, fm = gid * WGM, gsz = (nM - fm) < WGM ? (nM - fm) : WGM;
        u.pm = fm + ((wgid % nig) % gsz); u.pn = (wgid % nig) / gsz; u.e = 0; return true;
    }
};

__device__ __forceinline__ i32x8 cat8(const bf16x8 lo, const bf16x8 hi) { return __builtin_shufflevector(__builtin_bit_cast(i32x4, lo), __builtin_bit_cast(i32x4, hi), 0, 1, 2, 3, 4, 5, 6, 7); }
template <class Epi, bool ALIGN_EPI, bool SP2, bool GATHER = false, bool FP8 = false>
__device__ __forceinline__ void gemm_phase(LAS unsigned char* lds, const Gemm g, const StaticOrder& S, const Epi& E) {
    const int tid = threadIdx.x, wid = __builtin_amdgcn_readfirstlane(tid >> 6), lane = tid & 63, wr = wid >> 2, wc = wid & 3, fr = lane & 15, fq = lane >> 4;
    const int K = g.K, nt = K / BK;
    unsigned voffA[2], voffB[2];
#pragma unroll
    for (int i = 0; i < 2; ++i) { int R, C; stage_rc(tid * 16 + i * 8192, R, C); const int Rb = Epi::PERM ? ((R & ~31) + perm32(R & 31)) : R;
        voffA[i] = (unsigned)(R * K + C) * 2u; voffB[i] = (unsigned)(Rb * K + C) * 2u; }
    unsigned vC[2][2];
#define PG8_GROWS(u, dst) do { _Pragma("unroll") for (int h_ = 0; h_ < 2; ++h_) _Pragma("unroll") for (int i_ = 0; i_ < 2; ++i_) { int R_, C_; stage_rc(tid * 16 + i_ * 8192, R_, C_); \
        dst[h_][i_] = (unsigned)g.rowtok[(u).pm * BM + h_ * HALF + R_] * (unsigned)(K * 2) + (unsigned)(C_ * 2); } } while (0)
    const size_t kstep = (size_t)(BK * 2);
    const size_t hstep = (size_t)HALF * K * 2;
    const size_t tstep = 2 * hstep;
    const unsigned ldsw = (unsigned)wid * 1024u;
    const int aoff = lds_byte(wr * 64 + fr, fq * 8), boff = lds_byte(wc * 32 + fr, fq * 8);
#define PG8_SA(b, h) (((b) * 2 + (h)) * HTB)
#define PG8_SB(b, h) ((4 + (b) * 2 + (h)) * HTB)
#define PG8_STAGE(bufoff, gbase, voff) do { _Pragma("unroll") for (int _i = 0; _i < 2; ++_i) \
        __builtin_amdgcn_global_load_lds((const unsigned*)((const char*)(gbase) + (voff)[_i]), (LAS unsigned*)(lds + (bufoff) + ldsw + _i * 8192), 16, 0, 0); } while (0)
#define PG8_STAGE_A(bufoff, p, h, nx) do { if constexpr (GATHER) { PG8_STAGE(bufoff, p, vC[h]); } else PG8_STAGE(bufoff, (p) + (h) * hstep, voffA); } while (0)
#define PG8_LDA(dst, b, h) do { _Pragma("unroll") for (int m = 0; m < 4; ++m) _Pragma("unroll") for (int k = 0; k < 2; ++k) dst[m][k] = *(const LAS bf16x8*)(lds + PG8_SA(b, h) + aoff + m * 2048 + k * 1024); } while (0)
#define PG8_LDB(dst, b, h) do { _Pragma("unroll") for (int n = 0; n < 2; ++n) _Pragma("unroll") for (int k = 0; k < 2; ++k) dst[n][k] = *(const LAS bf16x8*)(lds + PG8_SB(b, h) + boff + n * 2048 + k * 1024); } while (0)
#define PG8_MMA(ai, bj, At, Bt) do { __builtin_amdgcn_s_setprio(1); \
        if constexpr (FP8) { _Pragma("unroll") for (int m = 0; m < 4; ++m) _Pragma("unroll") for (int n = 0; n < 2; ++n) \
            { const i32x8 b8_ = cat8(Bt[n][0], Bt[n][1]), a8_ = cat8(At[m][0], At[m][1]); asm volatile("v_mfma_f32_16x16x128_f8f6f4 %0, %1, %2, %0" : "+v"(acc[ai][bj][m][n]) : "v"(b8_), "v"(a8_)); } } \
        else { _Pragma("unroll") for (int m = 0; m < 4; ++m) _Pragma("unroll") for (int n = 0; n < 2; ++n) _Pragma("unroll") for (int k = 0; k < 2; ++k) \
            acc[ai][bj][m][n] = __builtin_amdgcn_mfma_f32_16x16x32_bf16(Bt[n][k], At[m][k], acc[ai][bj][m][n], 0, 0, 0); } \
        __builtin_amdgcn_s_setprio(0); } while (0)
#define PG8_WAIT_V(n) asm volatile("s_waitcnt vmcnt(" #n ")" ::: "memory")
#define PG8_WAIT_L(n) asm volatile("s_waitcnt lgkmcnt(" #n ")" ::: "memory")
#define PG8_BAR __builtin_amdgcn_s_barrier()
#define PG8_SCHED __builtin_amdgcn_sched_barrier(0)
#define PG8_UPTR(u, pa, pb) do { unsigned _e = g.texp ? ld_u32_agent(g.texp + (u).pm) : 0u; _e = (unsigned)__builtin_amdgcn_readfirstlane((int)_e); (u).e = (int)_e; \
        pa = GATHER ? (const char*)g.A : (const char*)g.A + (size_t)(u).pm * tstep; pb = (const char*)g.Bt + (size_t)_e * g.bstride + (size_t)(u).pn * tstep; } while (0)
    Unit cur, nxt; int ui = 0;
    if (!S.next(0, cur)) return;
    f32x4 acc[2][2][4][2];
#pragma unroll
    for (int a = 0; a < 2; ++a)
#pragma unroll
        for (int b = 0; b < 2; ++b)
#pragma unroll
            for (int m = 0; m < 4; ++m)
#pragma unroll
                for (int n = 0; n < 2; ++n) acc[a][b][m][n] = (f32x4){0.f, 0.f, 0.f, 0.f};
    bf16x8 At[4][2], B0[2][2], B1[2][2];
    const char* cA; const char* cB;
    PG8_UPTR(cur, cA, cB);
    if constexpr (GATHER) { PG8_GROWS(cur, vC); }
    if constexpr (SP2) {
        PG8_STAGE(PG8_SB(0, 0), cB, voffB); PG8_STAGE(PG8_SB(0, 1), cB + hstep, voffB); PG8_STAGE_A(PG8_SA(0, 0), cA, 0, false); PG8_STAGE_A(PG8_SA(0, 1), cA, 1, false);
        if (wr == 1) PG8_BAR;
        PG8_WAIT_V(2); PG8_BAR;
        PG8_STAGE(PG8_SB(1, 0), cB + kstep, voffB); PG8_STAGE_A(PG8_SA(1, 0), cA + kstep, 0, false); PG8_STAGE(PG8_SB(1, 1), cB + hstep + kstep, voffB);
        PG8_WAIT_V(6); PG8_BAR;
    } else {
        PG8_STAGE(PG8_SB(0, 0), cB, voffB); PG8_STAGE_A(PG8_SA(0, 0), cA, 0, false); PG8_STAGE(PG8_SB(0, 1), cB + hstep, voffB); PG8_STAGE_A(PG8_SA(0, 1), cA, 1, false);
        if (wr == 1) PG8_BAR;
        PG8_WAIT_V(4); PG8_BAR;
        PG8_STAGE(PG8_SB(1, 0), cB + kstep, voffB); PG8_STAGE_A(PG8_SA(1, 0), cA + kstep, 0, false); PG8_STAGE(PG8_SB(1, 1), cB + hstep + kstep, voffB);
        PG8_WAIT_V(6); PG8_BAR;
    }
    for (;;) {
        const bool has_next = S.next(ui + 1, nxt);
        const char* nA = cA; const char* nB = cB;
        if (has_next) PG8_UPTR(nxt, nA, nB);
#pragma unroll 1
        for (int t = 0; t < nt; t += 2) {
            const bool last = (t == nt - 2);
            const char* a1 = cA + (size_t)(t + 1) * kstep;
            const char* a2 = last ? nA : cA + (size_t)(t + 2) * kstep; const char* b2 = last ? nB : cB + (size_t)(t + 2) * kstep;
            const char* a3 = a2 + kstep; const char* b3 = b2 + kstep;
            if constexpr (SP2) {
            PG8_LDB(B0, 0, 0); PG8_LDB(B1, 0, 1); PG8_SCHED; PG8_LDA(At, 0, 0); PG8_STAGE_A(PG8_SA(1, 1), a1, 1, false);
            if constexpr (GATHER) { if (last && has_next) { PG8_GROWS(nxt, vC); } }
            PG8_WAIT_V(8); PG8_WAIT_L(0); PG8_BAR; PG8_MMA(0, 0, At, B0); PG8_MMA(0, 1, At, B1); PG8_BAR; PG8_SCHED;
            PG8_LDA(At, 0, 1); PG8_STAGE(PG8_SB(0, 0), b2, voffB); PG8_STAGE(PG8_SB(0, 1), b2 + hstep, voffB); PG8_STAGE_A(PG8_SA(0, 0), a2, 0, last);
            PG8_WAIT_V(8); PG8_WAIT_L(0); PG8_BAR; PG8_MMA(1, 0, At, B0); PG8_MMA(1, 1, At, B1); PG8_BAR; PG8_SCHED;
            PG8_LDB(B0, 1, 0); PG8_LDB(B1, 1, 1); PG8_SCHED; PG8_LDA(At, 1, 0); PG8_STAGE_A(PG8_SA(0, 1), a2, 1, last);
            PG8_WAIT_V(8); PG8_WAIT_L(0); PG8_BAR; PG8_MMA(0, 0, At, B0); PG8_MMA(0, 1, At, B1); PG8_BAR; PG8_SCHED;
            PG8_LDA(At, 1, 1); PG8_STAGE(PG8_SB(1, 0), b3, voffB); PG8_STAGE(PG8_SB(1, 1), b3 + hstep, voffB); PG8_STAGE_A(PG8_SA(1, 0), a3, 0, last);
            PG8_WAIT_V(8); PG8_WAIT_L(0); PG8_BAR; PG8_MMA(1, 0, At, B0); PG8_MMA(1, 1, At, B1); PG8_BAR; PG8_SCHED;
            } else {
            PG8_LDB(B0, 0, 0); PG8_SCHED; PG8_LDA(At, 0, 0); PG8_STAGE_A(PG8_SA(1, 1), a1, 1, false);
            if constexpr (GATHER) { if (last && has_next) { PG8_GROWS(nxt, vC); } }
            PG8_WAIT_L(8); PG8_BAR; PG8_WAIT_L(0); PG8_MMA(0, 0, At, B0); PG8_BAR; PG8_SCHED;
            PG8_LDB(B1, 0, 1); PG8_STAGE(PG8_SB(0, 0), b2, voffB);
            PG8_BAR; PG8_WAIT_L(0); PG8_MMA(0, 1, At, B1); PG8_BAR;
            PG8_LDA(At, 0, 1); PG8_STAGE_A(PG8_SA(0, 0), a2, 0, last);
            PG8_BAR; PG8_WAIT_L(0); PG8_MMA(1, 0, At, B0); PG8_BAR; PG8_SCHED;
            PG8_STAGE(PG8_SB(0, 1), b2 + hstep, voffB);
            PG8_WAIT_V(6); PG8_BAR; PG8_MMA(1, 1, At, B1); PG8_BAR;
            PG8_LDB(B0, 1, 0); PG8_SCHED; PG8_LDA(At, 1, 0); PG8_STAGE_A(PG8_SA(0, 1), a2, 1, last);
            PG8_WAIT_L(8); PG8_BAR; PG8_WAIT_L(0); PG8_MMA(0, 0, At, B0); PG8_BAR; PG8_SCHED;
            PG8_LDB(B1, 1, 1); PG8_STAGE(PG8_SB(1, 0), b3, voffB);
            PG8_BAR; PG8_WAIT_L(0); PG8_MMA(0, 1, At, B1); PG8_BAR;
            PG8_LDA(At, 1, 1); PG8_STAGE_A(PG8_SA(1, 0), a3, 0, last);
            PG8_BAR; PG8_WAIT_L(0); PG8_MMA(1, 0, At, B0); PG8_BAR; PG8_SCHED;
            PG8_STAGE(PG8_SB(1, 1), b3 + hstep, voffB);
            PG8_WAIT_V(6); PG8_BAR; PG8_MMA(1, 1, At, B1); PG8_BAR;
            }
        }
        if constexpr (ALIGN_EPI) { if (wr == 0) PG8_BAR; }
        if constexpr (FP8) { asm volatile("s_nop 15\n\ts_nop 15" ::: "memory"); PG8_SCHED; }
        E(acc, cur, wr, wc, fr, fq);
        if (!has_next) break;
#pragma unroll
        for (int a = 0; a < 2; ++a)
#pragma unroll
            for (int b = 0; b < 2; ++b)
#pragma unroll
                for (int m = 0; m < 4; ++m)
#pragma unroll
                    for (int n = 0; n < 2; ++n) acc[a][b][m][n] = (f32x4){0.f, 0.f, 0.f, 0.f};
        cur = nxt; cA = nA; cB = nB; ++ui;
        if constexpr (ALIGN_EPI) { if (wr == 1) PG8_BAR; }
    }
    PG8_WAIT_V(0);
    if constexpr (!ALIGN_EPI) { if (wr == 0) PG8_BAR; }
    PG8_BAR;
#undef PG8_SA
#undef PG8_SB
#undef PG8_STAGE
#undef PG8_LDA
#undef PG8_LDB
#undef PG8_MMA
#undef PG8_WAIT_V
#undef PG8_WAIT_L
#undef PG8_BAR
#undef PG8_SCHED
#undef PG8_UPTR
#undef PG8_STAGE_A
#undef PG8_GROWS
}

struct EpiProj {
    static constexpr bool PERM = true;
    bf16 *q, *k, *vT, *p;
    __device__ __forceinline__ void operator()(const f32x4 (&acc)[2][2][4][2], const Unit& u, int wr, int wc, int fr, int fq) const {
        const int row0 = u.pm * BM + wr * 64 + fr;
        const int pn = u.pn;
#pragma unroll
        for (int ai = 0; ai < 2; ++ai)
#pragma unroll
            for (int m = 0; m < 4; ++m) {
                const int row = row0 + ai * HALF + m * 16;
#pragma unroll
                for (int bj = 0; bj < 2; ++bj) {
                    f32x4 v0 = acc[ai][bj][m][0], v1 = acc[ai][bj][m][1];
                    const int col = pn * BM + bj * HALF + wc * 32 + 8 * fq;
                    if (pn >= 4 && pn < 6) {
                        const int cv = col - 1024, hh = cv >> 6, dim = cv & 63, b = row / T, t = row % T;
                        bf16* dst = vT + ((size_t)(((b * NH + hh) * GROWS + (t >> 6)) * HD + dim)) * 64 + (t & 63);
                        const unsigned w0 = cvt_pk_bf16(v0[0], v0[1]), w1 = cvt_pk_bf16(v0[2], v0[3]), w2 = cvt_pk_bf16(v1[0], v1[1]), w3 = cvt_pk_bf16(v1[2], v1[3]);
                        dst[0 * 64] = (bf16)(w0 & 0xffff); dst[1 * 64] = (bf16)(w0 >> 16); dst[2 * 64] = (bf16)(w1 & 0xffff); dst[3 * 64] = (bf16)(w1 >> 16);
                        dst[4 * 64] = (bf16)(w2 & 0xffff); dst[5 * 64] = (bf16)(w2 >> 16); dst[6 * 64] = (bf16)(w3 & 0xffff); dst[7 * 64] = (bf16)(w3 >> 16);
                    } else {
                        bf16* dst;
                        if (pn < 2) { v0 = v0 * 0.125f; v1 = v1 * 0.125f; dst = q + (size_t)row * CW + col; }
                        else if (pn < 4) dst = k + (size_t)row * CW + (col - 512);
                        else dst = p + (size_t)row * PW + (col - 1536);
                        u32x4 w; w.x = cvt_pk_bf16(v0[0], v0[1]); w.y = cvt_pk_bf16(v0[2], v0[3]); w.z = cvt_pk_bf16(v1[0], v1[1]); w.w = cvt_pk_bf16(v1[2], v1[3]);
                        *(u32x4*)dst = w;
                    }
                }
            }
    }
};
struct EpiWo {
    static constexpr bool PERM = false;
    const float* x; float* h;
    __device__ __forceinline__ void operator()(const f32x4 (&acc)[2][2][4][2], const Unit& u, int wr, int wc, int fr, int fq) const {
        const int row0 = u.pm * BM + wr * 64 + fr, col0 = u.pn * BM + wc * 32 + 4 * fq;
#pragma unroll
        for (int ai = 0; ai < 2; ++ai)
#pragma unroll
            for (int m = 0; m < 4; ++m) { const size_t off = (size_t)(row0 + ai * HALF + m * 16) * D + col0;
#pragma unroll
                for (int bj = 0; bj < 2; ++bj)
#pragma unroll
                    for (int n = 0; n < 2; ++n) { const f32x4 xv = *(const f32x4*)(x + off + bj * HALF + n * 16); *(f32x4*)(h + off + bj * HALF + n * 16) = acc[ai][bj][m][n] + xv; } }
    }
};
struct EpiUp {
    static constexpr bool PERM = true;
    const float* b_up; unsigned char* act;
    __device__ __forceinline__ void operator()(const f32x4 (&acc)[2][2][4][2], const Unit& u, int wr, int wc, int fr, int fq) const {
        const int row0 = u.pm * BM + wr * 64 + fr, ch = u.pn * 128 + wc * 32 + 8 * fq;
        const float* bg = b_up + (size_t)u.e * 2048 + ch; const float* bl = bg + 1024;
        const f32x4 bg0 = *(const f32x4*)bg * F8_SACT, bg1 = *(const f32x4*)(bg + 4) * F8_SACT, bl0 = *(const f32x4*)bl, bl1 = *(const f32x4*)(bl + 4);
        constexpr float SG = F8_SACT / (F8_SX * F8_SW), SL = 1.0f / (F8_SX * F8_SW), KE = -1.702f * 1.44269504f / F8_SACT;
#pragma unroll
        for (int ai = 0; ai < 2; ++ai)
#pragma unroll
            for (int m = 0; m < 4; ++m) {
                float o[8];
#pragma unroll
                for (int n = 0; n < 2; ++n) { const f32x4 gv = acc[ai][0][m][n] * SG + (n ? bg1 : bg0), lv = acc[ai][1][m][n] * SL + (n ? bl1 : bl0);
#pragma unroll
                    for (int j = 0; j < 4; ++j) { const float gt = fminf(gv[j], 7.0f * F8_SACT), li = __builtin_amdgcn_fmed3f(lv[j], -7.0f, 7.0f);
                        const float t = gt * __builtin_amdgcn_rcpf(1.0f + __builtin_amdgcn_exp2f(gt * KE)); o[n * 4 + j] = __builtin_fmaf(li, t, t); } }
                int w0 = 0, w1 = 0;
                w0 = __builtin_amdgcn_cvt_pk_fp8_f32(o[0], o[1], w0, false); w0 = __builtin_amdgcn_cvt_pk_fp8_f32(o[2], o[3], w0, true);
                w1 = __builtin_amdgcn_cvt_pk_fp8_f32(o[4], o[5], w1, false); w1 = __builtin_amdgcn_cvt_pk_fp8_f32(o[6], o[7], w1, true);
                u32x2 w8; w8.x = (unsigned)w0; w8.y = (unsigned)w1;
                *(u32x2*)(act + (size_t)(row0 + ai * HALF + m * 16) * DE + ch) = w8;
            }
    }
};
struct EpiDown {
    static constexpr bool PERM = true;
    const float* b_dn; bf16* y;
    __device__ __forceinline__ void operator()(const f32x4 (&acc)[2][2][4][2], const Unit& u, int wr, int wc, int fr, int fq) const {
        const int row0 = u.pm * BM + wr * 64 + fr, col0 = u.pn * BM + wc * 32 + 8 * fq;
        const float* bb = b_dn + (size_t)u.e * D + col0;
        f32x4 bv[2][2];
#pragma unroll
        for (int bj = 0; bj < 2; ++bj)
#pragma unroll
            for (int n = 0; n < 2; ++n) bv[bj][n] = *(const f32x4*)(bb + bj * HALF + 4 * n);
#pragma unroll
        for (int ai = 0; ai < 2; ++ai)
#pragma unroll
            for (int m = 0; m < 4; ++m) { bf16* rowp = y + (size_t)(row0 + ai * HALF + m * 16) * D + col0;
#pragma unroll
                for (int bj = 0; bj < 2; ++bj) { const f32x4 v0 = acc[ai][bj][m][0] * (1.0f / (F8_SACT * F8_SW)) + bv[bj][0], v1 = acc[ai][bj][m][1] * (1.0f / (F8_SACT * F8_SW)) + bv[bj][1];
                    u32x4 w; w.x = cvt_pk_bf16(v0[0], v0[1]); w.y = cvt_pk_bf16(v0[2], v0[3]); w.z = cvt_pk_bf16(v1[0], v1[1]); w.w = cvt_pk_bf16(v1[2], v1[3]);
                    *(u32x4*)(rowp + bj * HALF) = w; } }
    }
};
}


#define XB_TMO      128
#define XB_XCNT(j)  (256  + 64 * (j))
#define XB_XSUB(j)  (1280 + 64 * (j))
#define XB_XGEN(j)  (2304 + 64 * (j))
#define XB_TOP      3328
#define XB_TOPGEN   3392
#define XCD_BAR_WORDS 3456
#define XB_SPIN_CAP (1u << 20)
__device__ __forceinline__ unsigned xb_ld(unsigned* p)              { return __hip_atomic_load(p, __ATOMIC_RELAXED, __HIP_MEMORY_SCOPE_AGENT); }
__device__ __forceinline__ unsigned xb_add(unsigned* p, unsigned v) { return __hip_atomic_fetch_add(p, v, __ATOMIC_RELAXED, __HIP_MEMORY_SCOPE_AGENT); }
__device__ __forceinline__ unsigned xb_xcc_id() { return (unsigned)__builtin_amdgcn_s_getreg((3 << 11) | 20) & 0xFu; }
#define XB_SPIN(cond, bar) do { unsigned _sp = 0; while (cond) { __builtin_amdgcn_s_sleep(1); \
    if ((++_sp & 255u) == 0u) { if (xb_ld(&(bar)[XB_TMO])) break; if (_sp > XB_SPIN_CAP) { atomicAdd(&(bar)[XB_TMO], 1u); break; } } } } while (0)
struct XcdBarrier { unsigned* bar; unsigned x; volatile LAS unsigned* st; };
__device__ __forceinline__ XcdBarrier xcd_barrier_post(unsigned* bar, volatile LAS unsigned* st) {
    XcdBarrier b; b.bar = bar; b.x = xb_xcc_id(); b.st = st;
    if (threadIdx.x == 0) (void)xb_add(&bar[XB_XCNT(b.x)], 1u);
    return b;
}
__device__ __forceinline__ void xcd_barrier_complete(unsigned* bar, unsigned x, unsigned& nloc, unsigned& nx) {
    const unsigned G = gridDim.x * gridDim.y * gridDim.z;
    unsigned sum, cnt, mine, sp = 0u;
    for (;;) {
        sum = 0u; cnt = 0u; mine = 0u;
#pragma unroll
        for (unsigned j = 0; j < 16; ++j) { const unsigned c = xb_ld(&bar[XB_XCNT(j)]); sum += c; cnt += (c > 0u) ? 1u : 0u; mine = (j == x) ? c : mine; }
        if (sum == G) break;
        __builtin_amdgcn_s_sleep(1);
        if ((++sp & 255u) == 0u) { if (xb_ld(&bar[XB_TMO])) break; if (sp > XB_SPIN_CAP) { atomicAdd(&bar[XB_TMO], 1u); break; } }
    }
    nloc = mine > 0u ? mine : 1u; nx = cnt > 0u ? cnt : 1u;
}
__device__ __forceinline__ void xcd_barrier(const XcdBarrier& b) {
    asm volatile("s_waitcnt vmcnt(0)" ::: "memory");
    __syncthreads();
    if (threadIdx.x == 0) {
        unsigned* bar = b.bar;
        __builtin_amdgcn_s_waitcnt(0);
        unsigned nloc = b.st[0], nx = b.st[1];
        if (nloc == 0u) { xcd_barrier_complete(bar, b.x, nloc, nx); b.st[0] = nloc; b.st[1] = nx; }
        const unsigned old = xb_add(&bar[XB_XSUB(b.x)], 1u);
        const unsigned gen = old / nloc;
        if (old + 1u == (gen + 1u) * nloc) {
            __builtin_amdgcn_fence(__ATOMIC_RELEASE, "agent");
            asm volatile("s_waitcnt vmcnt(0)" ::: "memory");
            const unsigned og = xb_add(&bar[XB_TOP], 1u);
            const unsigned tg = og / nx;
            if (og + 1u == (tg + 1u) * nx) xb_add(&bar[XB_TOPGEN], 1u);
            else XB_SPIN(xb_ld(&bar[XB_TOPGEN]) == tg, bar);
            __builtin_amdgcn_fence(__ATOMIC_ACQUIRE, "agent");
            xb_add(&bar[XB_XGEN(b.x)], 1u);
            asm volatile("s_waitcnt vmcnt(0)" ::: "memory");
        } else {
            XB_SPIN(xb_ld(&bar[XB_XGEN(b.x)]) == gen, bar);
            __builtin_amdgcn_fence(__ATOMIC_ACQUIRE, "agent");
            asm volatile("s_waitcnt vmcnt(0)" ::: "memory");
        }
    }
    __syncthreads();
}

struct Args { const float* in[26]; float* out; unsigned char* ws; int ph_lo, ph_hi; };

struct Frame { LAS unsigned char* lds; int tid, lane, wave, G, vcu; };

__device__ __forceinline__ void transpose_item(const float* W, int K, int N, bf16* WT, int k0, int n0, int orow0, LAS float* scr, int lane) {
#pragma unroll 8
    for (int i = 0; i < 32; ++i) { const int kk = 2 * i + (lane >> 5); scr[kk * 33 + (lane & 31)] = W[(size_t)(k0 + kk) * N + n0 + (lane & 31)]; }
    asm volatile("s_waitcnt lgkmcnt(0)" ::: "memory");
    const int c = lane & 7;
#pragma unroll
    for (int j = 0; j < 4; ++j) { const int n = (lane >> 3) + 8 * j; const LAS float* s = scr + (8 * c) * 33 + n;
        u32x4 o; o.x = cvt_pk_bf16(s[0 * 33], s[1 * 33]); o.y = cvt_pk_bf16(s[2 * 33], s[3 * 33]); o.z = cvt_pk_bf16(s[4 * 33], s[5 * 33]); o.w = cvt_pk_bf16(s[6 * 33], s[7 * 33]);
        *(u32x4*)(WT + (size_t)(orow0 + n) * K + k0 + 8 * c) = o; }
    asm volatile("s_waitcnt lgkmcnt(0)" ::: "memory");
}

__device__ __forceinline__ void transpose_item8(const float* W, int K, int N, unsigned char* WT, int k0, int n0, int orow0, LAS float* scr, int lane) {
#pragma unroll 8
    for (int i = 0; i < 32; ++i) { const int kk = 2 * i + (lane >> 5); scr[kk * 33 + (lane & 31)] = W[(size_t)(k0 + kk) * N + n0 + (lane & 31)]; }
    asm volatile("s_waitcnt lgkmcnt(0)" ::: "memory");
    const int c = lane & 7;
#pragma unroll
    for (int j = 0; j < 4; ++j) { const int n = (lane >> 3) + 8 * j; const LAS float* s = scr + (8 * c) * 33 + n;
        u32x2 o; o.x = pk4_fp8(s[0 * 33] * F8_SW, s[1 * 33] * F8_SW, s[2 * 33] * F8_SW, s[3 * 33] * F8_SW); o.y = pk4_fp8(s[4 * 33] * F8_SW, s[5 * 33] * F8_SW, s[6 * 33] * F8_SW, s[7 * 33] * F8_SW);
        *(u32x2*)(WT + (size_t)(orow0 + n) * K + k0 + 8 * c) = o; }
    asm volatile("s_waitcnt lgkmcnt(0)" ::: "memory");
}

__device__ __forceinline__ void p0_prologue(const Frame& F, const Args& a) {
    unsigned char* ws = a.ws;
    LAS float* scr = (LAS float*)(F.lds + F.wave * 8448);
    const int gw = F.vcu * 8 + F.wave, NGW = F.G * 8;
    constexpr int I_IN = 16 * 108, I_O = 16 * 32, I_UP = 32 * 16 * 64, I_DN = 32 * 16 * 32, I_L = 16, I_G = 32;
    constexpr int NITEMS = I_IN + I_O + I_UP + I_DN + 2 * I_L + 2 * I_L + I_G;
    for (int it = gw; it < NITEMS; it += NGW) {
        int r = it;
        if (r < I_UP) {
            const int e = r / 1024, q = r % 1024, kb = q / 64, nb = q % 64, n0 = nb * 32;
            const int orow0 = n0 < 1024 ? 256 * (n0 >> 7) + (n0 & 127) : 256 * ((n0 - 1024) >> 7) + 128 + ((n0 - 1024) & 127);
            transpose_item8(a.in[21] + (size_t)e * 1024 * 2048, 1024, 2048, ws + WS_WUPT + (size_t)e * 2048 * 1024, kb * 64, n0, orow0, scr, F.lane); continue; }
        r -= I_UP;
        if (r < I_DN) { const int e = r / 512, q = r % 512, kb = q / 32, nb = q % 32;
            transpose_item8(a.in[23] + (size_t)e * 1024 * 1024, 1024, 1024, ws + WS_WDNT + (size_t)e * 1024 * 1024, kb * 64, nb * 32, nb * 32, scr, F.lane); continue; }
        r -= I_DN;
        if (r < I_IN) { const int kb = r / 108, nb = r % 108; transpose_item(a.in[2], 1024, NPROJ, (bf16*)(ws + WS_WINT), kb * 64, nb * 32, nb * 32, scr, F.lane); continue; }
        r -= I_IN;
        if (r < I_O) { const int kb = r / 32, nb = r % 32; transpose_item(a.in[17], 1024, 1024, (bf16*)(ws + WS_WOT), kb * 64, nb * 32, nb * 32, scr, F.lane); continue; }
        r -= I_O;
        if (r < 2 * I_L) { const int z = r / 16, nb = r % 16; transpose_item(a.in[8] + (size_t)z * 64 * 512, 64, 512, (bf16*)(ws + WS_W2T) + (size_t)z * 512 * 64, 0, nb * 32, nb * 32, scr, F.lane); continue; }
        r -= 2 * I_L;
        if (r < 2 * I_L) { const int z = r / 16, nb = r % 16; transpose_item(a.in[10] + (size_t)z * 64 * 512, 64, 512, (bf16*)(ws + WS_A2T) + (size_t)z * 512 * 64, 0, nb * 32, nb * 32, scr, F.lane); continue; }
        r -= 2 * I_L;
        { const int kb = r / 16, nb = r % 16; transpose_item(a.in[11], 128, 512, (bf16*)(ws + WS_G2T), kb * 64, nb * 32, nb * 32, scr, F.lane); }
    }
    { u32x4* z = (u32x4*)(ws + WS_WINT + (size_t)NPROJ * 1024 * 2); const u32x4 zero = {0u, 0u, 0u, 0u};
      for (int i = F.vcu * 512 + F.tid; i < 16384; i += F.G * 512) z[i] = zero; }
    const float* x = a.in[0]; const float* nw = a.in[1]; bf16* hn = (bf16*)(ws + WS_HN);
    f32x4 wv[4];
#pragma unroll
    for (int j = 0; j < 4; ++j) wv[j] = *((const f32x4*)nw + F.lane + 64 * j);
    for (int m = gw; m < M; m += 2 * NGW) {
        const int m1 = m + NGW; const bool has1 = m1 < M;
        const f32x4* xr0 = (const f32x4*)(x + (size_t)m * D) + F.lane; const f32x4* xr1 = (const f32x4*)(x + (size_t)(has1 ? m1 : m) * D) + F.lane;
        f32x4 v0[4], v1[4]; float s0 = 0.f, s1 = 0.f;
#pragma unroll
        for (int j = 0; j < 4; ++j) { v0[j] = xr0[64 * j]; v1[j] = xr1[64 * j]; }
#pragma unroll
        for (int j = 0; j < 4; ++j) { s0 += (v0[j].x * v0[j].x + v0[j].y * v0[j].y) + (v0[j].z * v0[j].z + v0[j].w * v0[j].w); s1 += (v1[j].x * v1[j].x + v1[j].y * v1[j].y) + (v1[j].z * v1[j].z + v1[j].w * v1[j].w); }
        const float rs0 = rsqrtf(wave_sum(s0) * (1.f / D) + RMS_EPS), rs1 = rsqrtf(wave_sum(s1) * (1.f / D) + RMS_EPS);
        u32x2* o0 = (u32x2*)(hn + (size_t)m * D) + F.lane; u32x2* o1 = (u32x2*)(hn + (size_t)m1 * D) + F.lane;
#pragma unroll
        for (int j = 0; j < 4; ++j) { u32x2 o; o.x = cvt_pk_bf16(v0[j].x * rs0 * wv[j].x, v0[j].y * rs0 * wv[j].y); o.y = cvt_pk_bf16(v0[j].z * rs0 * wv[j].z, v0[j].w * rs0 * wv[j].w); o0[64 * j] = o; }
        if (has1) {
#pragma unroll
            for (int j = 0; j < 4; ++j) { u32x2 o; o.x = cvt_pk_bf16(v1[j].x * rs1 * wv[j].x, v1[j].y * rs1 * wv[j].y); o.y = cvt_pk_bf16(v1[j].z * rs1 * wv[j].z, v1[j].w * rs1 * wv[j].w); o1[64 * j] = o; } }
    }
}

constexpr int PREP_KBUF = 0, PREP_INV = 65536, PREP_AW = 67584, PREP_AA = PREP_AW + 17408, PREP_AG = PREP_AA + 17408, PREP_LD = 136;
template <bool STORE>
__device__ __forceinline__ void prep_phase(const Frame& F, const Args& a) {
    unsigned char* ws = a.ws;
    const bf16* p = (const bf16*)(ws + WS_P);
    bf16* r_out = (bf16*)(ws + WS_R); bf16* v_out = (bf16*)(ws + WS_V); bf16* kk_out = (bf16*)(ws + WS_KK);
    bf16* decay_out = (bf16*)(ws + WS_DECAY); bf16* kdir_out = (bf16*)(ws + WS_KDIR); bf16* akk_out = (bf16*)(ws + WS_AKK); bf16* g_out = (bf16*)(ws + WS_G);
    const bf16* w2T = (const bf16*)(ws + WS_W2T); const bf16* a2T = (const bf16*)(ws + WS_A2T); const bf16* g2T = (const bf16*)(ws + WS_G2T);
    const float* mu_p = a.in[5]; const float* mu_n = a.in[6]; const float* w0 = a.in[7]; const float* a0 = a.in[9];
    const float* k_k = a.in[12]; const float* k_a = a.in[13];
    LAS bf16* kbuf = (LAS bf16*)(F.lds + PREP_KBUF); LAS float* invb = (LAS float*)(F.lds + PREP_INV);
    LAS bf16* Aw = (LAS bf16*)(F.lds + PREP_AW); LAS bf16* Aa = (LAS bf16*)(F.lds + PREP_AA); LAS bf16* Ag = (LAS bf16*)(F.lds + PREP_AG);
    const int lane = F.lane, wave = F.wave, fr = lane & 15, fg = lane >> 4;
    for (int tile = F.vcu; tile < M / 64; tile += F.G) {
        const int m0 = tile * 64;
#pragma unroll 1
        for (int jj = 0; jj < 4; ++jj) {
            const int q = lane + 64 * jj; const bool valid = q < 240; const int c0 = 8 * q;
            float mp[8], mn[8];
#pragma unroll
            for (int i = 0; i < 8; ++i) { mp[i] = valid ? mu_p[c0 + i] : 0.f; mn[i] = valid ? mu_n[c0 + i] : 0.f; }
            const int mfirst = m0 + wave * 8;
            const u32x4 zero = {0u, 0u, 0u, 0u};
            u32x4 rows[10];
#pragma unroll
            for (int rI = 0; rI < 10; ++rI) { const int mr = mfirst - 1 + rI;
                const bool ok = valid && !(rI == 0 && (mfirst % T) == 0) && !(rI == 9 && ((mfirst + 7) % T) == T - 1);
                rows[rI] = ok ? *(const u32x4*)(p + (size_t)mr * PW + c0) : zero; }
#pragma unroll
            for (int i = 0; i < 8; ++i) {
                const int m = mfirst + i, it = wave * 8 + i;
                const u32x4 prev = rows[i], cur = rows[i + 1], nxt = rows[i + 2];
                float fp[8], fc[8], fn[8], s[8];
                unpack8(prev, fp); unpack8(cur, fc); unpack8(nxt, fn);
#pragma unroll
                for (int e = 0; e < 8; ++e) s[e] = fc[e] + mp[e] * (fp[e] - fc[e]) + mn[e] * (fn[e] - fc[e]);
                if (jj == 0) { if (STORE) { *(u32x4*)(r_out + (size_t)m * CW + c0) = pack8(s); } }
                else if (jj == 1) {
                    const int c = c0 - 512;
                    *(LAS u32x4*)(kbuf + it * 512 + c) = pack8(s);
                    float kr[8]; float ss = 0.f;
#pragma unroll
                    for (int e = 0; e < 8; ++e) { kr[e] = s[e] * k_k[c + e]; ss += kr[e] * kr[e]; }
                    ss += __shfl_xor(ss, 1); ss += __shfl_xor(ss, 2); ss += __shfl_xor(ss, 4);
                    const float inv = fminf(__builtin_amdgcn_rsqf(ss), 1e12f);
#pragma unroll
                    for (int e = 0; e < 8; ++e) kr[e] *= inv;
                    if (STORE) { *(u32x4*)(kk_out + (size_t)m * CW + c) = pack8(kr); }
                    if ((lane & 7) == 0) invb[it * 8 + (lane >> 3)] = inv;
                }
                else if (jj == 2) { if (STORE) { *(u32x4*)(v_out + (size_t)m * CW + (c0 - 1024)) = pack8(s); } }
                else if (valid) {
                    const int seg = lane >> 4, cw = 8 * (lane & 15);
                    if (seg == 0) {
#pragma unroll
                        for (int e = 0; e < 8; ++e) s[e] = 1.0f - 2.0f * __builtin_amdgcn_rcpf(__expf(2.0f * s[e]) + 1.0f);
                        *(LAS u32x4*)(Aw + it * PREP_LD + cw) = pack8(s);
                    } else if (seg == 1) { *(LAS u32x4*)(Aa + it * PREP_LD + cw) = pack8(s); }
                    else {
#pragma unroll
                        for (int e = 0; e < 8; ++e) s[e] = sigmoidf_(s[e]);
                        *(LAS u32x4*)(Ag + it * PREP_LD + cw) = pack8(s);
                    }
                }
            }
        }
        __syncthreads();
        const int nb = 64 * wave;
#define PREP_PROW(nt_) (nb + 32 * ((nt_) >> 1) + 8 * (fr >> 2) + 4 * ((nt_) & 1) + (fr & 3))
#define PREP_COL(nt_)  (nb + 32 * ((nt_) >> 1) + 8 * fg + 4 * ((nt_) & 1))
#pragma unroll 1
        for (int job = 0; job < 4; ++job) {
            const int z = job & 1;
            const bf16* WT = job < 2 ? w2T + (size_t)z * 512 * 64 : a2T + (size_t)z * 512 * 64;
            const LAS bf16* Ax = job < 2 ? Aw + z * 64 : Aa + z * 64;
            bf16x8 wf[2][4];
#pragma unroll
            for (int ks = 0; ks < 2; ++ks)
#pragma unroll
                for (int nt = 0; nt < 4; ++nt) wf[ks][nt] = *(const bf16x8*)(WT + (size_t)PREP_PROW(nt) * 64 + 32 * ks + 8 * fg);
            f32x4 pb[4], pkk[4], pka[4];
#pragma unroll
            for (int nt = 0; nt < 4; ++nt) { const int n = PREP_COL(nt);
                pb[nt] = *(const f32x4*)((job < 2 ? w0 : a0) + z * 512 + n); pkk[nt] = *(const f32x4*)(k_k + n); pka[nt] = *(const f32x4*)(k_a + n); }
            f32x4 acc[4][4];
#pragma unroll
            for (int mt = 0; mt < 4; ++mt)
#pragma unroll
                for (int nt = 0; nt < 4; ++nt) acc[mt][nt] = (f32x4){0.f, 0.f, 0.f, 0.f};
#pragma unroll
            for (int ks = 0; ks < 2; ++ks) {
                bf16x8 af[4];
#pragma unroll
                for (int mt = 0; mt < 4; ++mt) af[mt] = *(const LAS bf16x8*)(Ax + (16 * mt + fr) * PREP_LD + 32 * ks + 8 * fg);
#pragma unroll
                for (int mt = 0; mt < 4; ++mt)
#pragma unroll
                    for (int nt = 0; nt < 4; ++nt) acc[mt][nt] = __builtin_amdgcn_mfma_f32_16x16x32_bf16(wf[ks][nt], af[mt], acc[mt][nt], 0, 0, 0);
            }
#pragma unroll
            for (int mt = 0; mt < 4; ++mt) {
                const int it = 16 * mt + fr; const size_t m = (size_t)(m0 + it);
#pragma unroll
                for (int np = 0; np < 2; ++np) {
                    const int c8 = nb + 32 * np + 8 * fg;
                    if (job < 2) {
                        float o[8];
#pragma unroll
                        for (int hh = 0; hh < 2; ++hh) { const f32x4 v = acc[mt][2 * np + hh], bq = pb[2 * np + hh];
#pragma unroll
                            for (int i = 0; i < 4; ++i) o[4 * hh + i] = __expf(-0.60653066f * sigmoidf_(v[i] + bq[i])); }
                        if (STORE) { *(u32x4*)(decay_out + ((size_t)z * M + m) * CW + c8) = pack8(o); }
                    } else {
                        const u32x4 kb = *(const LAS u32x4*)(kbuf + it * 512 + c8);
                        float kv[8]; unpack8(kb, kv);
                        const float inv = invb[it * 8 + wave];
                        float kd[8], ak[8];
#pragma unroll
                        for (int hh = 0; hh < 2; ++hh) { const f32x4 v = acc[mt][2 * np + hh], bq = pb[2 * np + hh], kkc = pkk[2 * np + hh], kac = pka[2 * np + hh];
#pragma unroll
                            for (int i = 0; i < 4; ++i) { const float av = sigmoidf_(v[i] + bq[i]), kx = kv[4 * hh + i]; kd[4 * hh + i] = kx * (1.0f + (av - 1.0f) * kac[i]); ak[4 * hh + i] = av * (kx * kkc[i] * inv); } }
                        if (STORE) { *(u32x4*)(kdir_out + ((size_t)z * M + m) * CW + c8) = pack8(kd); *(u32x4*)(akk_out + ((size_t)z * M + m) * CW + c8) = pack8(ak); }
                    }
                }
            }
        }
        {
            bf16x8 wf[4][4];
#pragma unroll
            for (int ks = 0; ks < 4; ++ks)
#pragma unroll
                for (int nt = 0; nt < 4; ++nt) wf[ks][nt] = *(const bf16x8*)(g2T + (size_t)PREP_PROW(nt) * 128 + 32 * ks + 8 * fg);
            f32x4 acc[4][4];
#pragma unroll
            for (int mt = 0; mt < 4; ++mt)
#pragma unroll
                for (int nt = 0; nt < 4; ++nt) acc[mt][nt] = (f32x4){0.f, 0.f, 0.f, 0.f};
#pragma unroll
            for (int ks = 0; ks < 4; ++ks) {
                bf16x8 af[4];
#pragma unroll
                for (int mt = 0; mt < 4; ++mt) af[mt] = *(const LAS bf16x8*)(Ag + (16 * mt + fr) * PREP_LD + 32 * ks + 8 * fg);
#pragma unroll
                for (int mt = 0; mt < 4; ++mt)
#pragma unroll
                    for (int nt = 0; nt < 4; ++nt) acc[mt][nt] = __builtin_amdgcn_mfma_f32_16x16x32_bf16(wf[ks][nt], af[mt], acc[mt][nt], 0, 0, 0);
            }
#pragma unroll
            for (int mt = 0; mt < 4; ++mt) { const size_t m = (size_t)(m0 + 16 * mt + fr);
#pragma unroll
                for (int np = 0; np < 2; ++np) { const f32x4 v0 = acc[mt][2 * np], v1 = acc[mt][2 * np + 1];
                    u32x4 w; w.x = cvt_pk_bf16(v0[0], v0[1]); w.y = cvt_pk_bf16(v0[2], v0[3]); w.z = cvt_pk_bf16(v1[0], v1[1]); w.w = cvt_pk_bf16(v1[2], v1[3]);
                    if (STORE) { *(u32x4*)(g_out + m * CW + nb + 32 * np + 8 * fg) = w; } } }
        }
#undef PREP_PROW
#undef PREP_COL
        __syncthreads();
    }
}

__device__ __forceinline__ void attn_phase(const Frame& F, const Args& a) {
    unsigned char* ws = a.ws;
    const bf16* q = (const bf16*)(ws + WS_Q); const bf16* k = (const bf16*)(ws + WS_K); const bf16* vT = (const bf16*)(ws + WS_VT);
    bf16* att = (bf16*)(ws + WS_ATT);
    LAS float* bias = (LAS float*)F.lds;
    for (int i = F.tid; i < 8 * 15 * 31; i += 512) bias[i] = a.in[3][i];
    __syncthreads();
    const int lane = F.lane, fr = lane & 15, fg = lane >> 4;
    const int NGW = F.G * 8, gw = F.vcu * 8 + F.wave;
    const int per = (16384 + NGW - 1) / NGW;
    for (int task = gw * per; task < (gw + 1) * per && task < 16384; ++task) {
        const int cgp = task & 3, r = (task >> 2) & 127, h = (task >> 9) & 7, b = task >> 12;
        const int c0 = 16 * cgp, wsc = min(max(c0 - 8, 0), 32), rs = min(max(r - 4, 0), GROWS - 8);
        const int c = c0 + fr, cs = min(max(c - 8, 0), 48);
        const size_t tq = (size_t)b * T + r * 64 + c;
        bf16x8 qf[2];
#pragma unroll
        for (int ks = 0; ks < 2; ++ks) qf[ks] = *(const bf16x8*)(q + tq * CW + h * 64 + 32 * ks + 8 * fg);
        f32x4 sc[16];
        const int kcol_a = wsc + 8 * (fr >> 2) + (fr & 3);
#pragma unroll
        for (int hb = 0; hb < 2; ++hb) {
            bf16x8 kf[8][2];
#pragma unroll
            for (int tl = 0; tl < 8; ++tl) { const int t = 8 * hb + tl, u = t >> 1, par = t & 1;
                const size_t tk = (size_t)b * T + (rs + u) * 64 + kcol_a + 4 * par;
                kf[tl][0] = *(const bf16x8*)(k + tk * CW + h * 64 + 8 * fg); kf[tl][1] = *(const bf16x8*)(k + tk * CW + h * 64 + 32 + 8 * fg); }
#pragma unroll
            for (int tl = 0; tl < 8; ++tl) { f32x4 s = {0.f, 0.f, 0.f, 0.f};
                s = __builtin_amdgcn_mfma_f32_16x16x32_bf16(kf[tl][0], qf[0], s, 0, 0, 0);
                s = __builtin_amdgcn_mfma_f32_16x16x32_bf16(kf[tl][1], qf[1], s, 0, 0, 0);
                sc[8 * hb + tl] = s; }
        }
        float mx = -1e30f;
#pragma unroll
        for (int u = 0; u < 8; ++u) {
            const int dr = rs + u - r + 7;
#pragma unroll
            for (int par = 0; par < 2; ++par)
#pragma unroll
                for (int i = 0; i < 4; ++i) {
                    const int kc = wsc + 8 * fg + 4 * par + i; const bool ok = (kc >= cs) && (kc < cs + 16);
                    const int dc = min(max(kc - c + 15, 0), 30);
                    const float s = ok ? sc[2 * u + par][i] + bias[(h * 15 + dr) * 31 + dc] : -1e30f;
                    sc[2 * u + par][i] = s; mx = fmaxf(mx, s);
                }
        }
        mx = fmaxf(mx, __shfl_xor(mx, 16)); mx = fmaxf(mx, __shfl_xor(mx, 32));
        float sum = 0.f;
#pragma unroll
        for (int t = 0; t < 16; ++t)
#pragma unroll
            for (int i = 0; i < 4; ++i) { const float pv = sc[t][i] > -1e29f ? __expf(sc[t][i] - mx) : 0.f; sc[t][i] = pv; sum += pv; }
        sum += __shfl_xor(sum, 16); sum += __shfl_xor(sum, 32);
        const float inv = 1.0f / sum;
        f32x4 o[4];
#pragma unroll
        for (int nt = 0; nt < 4; ++nt) o[nt] = (f32x4){0.f, 0.f, 0.f, 0.f};
#pragma unroll
        for (int hb = 0; hb < 2; ++hb) {
            bf16x8 vf[4][4];
#pragma unroll
            for (int ul = 0; ul < 4; ++ul) { const int u = 4 * hb + ul; const bf16* vblk = vT + ((size_t)((b * NH + h) * GROWS + rs + u)) * (HD * 64) + wsc + 8 * fg;
#pragma unroll
                for (int nt = 0; nt < 4; ++nt) vf[ul][nt] = *(const bf16x8*)(vblk + (16 * nt + fr) * 64); }
#pragma unroll
            for (int ul = 0; ul < 4; ++ul) { const int u = 4 * hb + ul;
                union { u32x4 w; bf16x8 h8; } pf;
                pf.w.x = cvt_pk_bf16(sc[2 * u][0], sc[2 * u][1]); pf.w.y = cvt_pk_bf16(sc[2 * u][2], sc[2 * u][3]);
                pf.w.z = cvt_pk_bf16(sc[2 * u + 1][0], sc[2 * u + 1][1]); pf.w.w = cvt_pk_bf16(sc[2 * u + 1][2], sc[2 * u + 1][3]);
#pragma unroll
                for (int nt = 0; nt < 4; ++nt) o[nt] = __builtin_amdgcn_mfma_f32_16x16x32_bf16(vf[ul][nt], pf.h8, o[nt], 0, 0, 0); }
        }
#pragma unroll
        for (int nt = 0; nt < 4; ++nt) { u32x2 w; w.x = cvt_pk_bf16(o[nt][0] * inv, o[nt][1] * inv); w.y = cvt_pk_bf16(o[nt][2] * inv, o[nt][3] * inv);
            *(u32x2*)(att + tq * CW + h * 64 + 16 * nt + 4 * fg) = w; }
    }
    __syncthreads();
}

__device__ __forceinline__ float row16_sum(float v) {
    v += __builtin_bit_cast(float, __builtin_amdgcn_update_dpp(0, __builtin_bit_cast(int, v), 0xB1, 0xF, 0xF, true));
    v += __builtin_bit_cast(float, __builtin_amdgcn_update_dpp(0, __builtin_bit_cast(int, v), 0x4E, 0xF, 0xF, true));
    v += __builtin_bit_cast(float, __builtin_amdgcn_update_dpp(0, __builtin_bit_cast(int, v), 0x141, 0xF, 0xF, true));
    v += __builtin_bit_cast(float, __builtin_amdgcn_update_dpp(0, __builtin_bit_cast(int, v), 0x140, 0xF, 0xF, true));
    return v;
}
constexpr int CS_R = 8;
constexpr int CS_AT = 0, CS_RT = 2304, CS_KHT = 4608, CS_BHT = 6656, CS_VT = 8704, CS_TT = 9216, CS_AAK = 9728, CS_ARK = 10240, CS_ARB = 10752, CS_PL = 11264, CS_SLOT = 11520;
constexpr int CS_LD = 72;
constexpr int CS_SCR = CS_R * CS_SLOT  , CS_SCRW = 2304 * 2 + 1024  , CS_FLAG = CS_SCR + 7 * CS_SCRW  ;
__device__ __forceinline__ bf16 f2bf(float f) { return (bf16)cvt_pk_bf16(f, 0.f); }
struct ChainOps { u32x2 a4[4], r4[4], kh[4], bh[4], aak, ark, arb, tt, vb; f32x4 pl[4]; };
__device__ __forceinline__ void chain_load(const LAS unsigned char* sl, int fr, int fg, ChainOps& o) {
    const int o16 = fr * 32 + fg * 8;
    const LAS unsigned char* pa = sl + CS_AT + fr * (CS_LD * 2) + fg * 8; const LAS unsigned char* pr = sl + CS_RT + fr * (CS_LD * 2) + fg * 8;
#pragma unroll
    for (int kq = 0; kq < 4; ++kq) { o.a4[kq] = *(const LAS u32x2*)(pa + 32 * kq); o.r4[kq] = *(const LAS u32x2*)(pr + 32 * kq); }
    o.aak = *(const LAS u32x2*)(sl + CS_AAK + o16); o.ark = *(const LAS u32x2*)(sl + CS_ARK + o16); o.arb = *(const LAS u32x2*)(sl + CS_ARB + o16); o.tt = *(const LAS u32x2*)(sl + CS_TT + o16);
    o.vb = *(const LAS u32x2*)(sl + CS_VT + o16);
#pragma unroll
    for (int mt = 0; mt < 4; ++mt) { o.pl[mt] = *(const LAS f32x4*)(sl + CS_PL + (16 * mt + 4 * fg) * 4);
        o.kh[mt] = *(const LAS u32x2*)(sl + CS_KHT + 512 * mt + o16); o.bh[mt] = *(const LAS u32x2*)(sl + CS_BHT + 512 * mt + o16); }
}
__device__ __forceinline__ f32x4 chain_compute(const ChainOps& o, f32x4 (&zacc)[4]) {
#define CS_M32(A_, B_, C_) __builtin_amdgcn_mfma_f32_16x16x32_bf16(A_, B_, C_, 0, 0, 0)
#define CS_M16(A_, B_, C_) __builtin_amdgcn_mfma_f32_16x16x16bf16_1k(__builtin_bit_cast(s16x4, A_), __builtin_bit_cast(s16x4, B_), C_, 0, 0, 0)
    union { u32x4 w; bf16x8 h8; } zb0, zb1, ap0, ap1, rp0, rp1;
    zb0.w.x = cvt_pk_bf16(zacc[0][0], zacc[0][1]); zb0.w.y = cvt_pk_bf16(zacc[0][2], zacc[0][3]); zb0.w.z = cvt_pk_bf16(zacc[1][0], zacc[1][1]); zb0.w.w = cvt_pk_bf16(zacc[1][2], zacc[1][3]);
    zb1.w.x = cvt_pk_bf16(zacc[2][0], zacc[2][1]); zb1.w.y = cvt_pk_bf16(zacc[2][2], zacc[2][3]); zb1.w.z = cvt_pk_bf16(zacc[3][0], zacc[3][1]); zb1.w.w = cvt_pk_bf16(zacc[3][2], zacc[3][3]);
    ap0.w = (u32x4){o.a4[0].x, o.a4[0].y, o.a4[1].x, o.a4[1].y}; ap1.w = (u32x4){o.a4[2].x, o.a4[2].y, o.a4[3].x, o.a4[3].y};
    rp0.w = (u32x4){o.r4[0].x, o.r4[0].y, o.r4[1].x, o.r4[1].y}; rp1.w = (u32x4){o.r4[2].x, o.r4[2].y, o.r4[3].x, o.r4[3].y};
    const f32x4 zero4 = {0.f, 0.f, 0.f, 0.f};
    f32x4 Wc = CS_M16(o.aak, o.vb, zero4);
    Wc = CS_M32(ap0.h8, zb0.h8, Wc); Wc = CS_M32(ap1.h8, zb1.h8, Wc);
    f32x4 Yc = CS_M16(o.ark, o.vb, zero4);
    Yc = CS_M32(rp0.h8, zb0.h8, Yc); Yc = CS_M32(rp1.h8, zb1.h8, Yc);
    f32x4 zz[4];
#pragma unroll
    for (int mt = 0; mt < 4; ++mt) zz[mt] = CS_M16(o.kh[mt], o.vb, zacc[mt] * o.pl[mt]);
    u32x2 wb, ub;
    wb.x = cvt_pk_bf16(Wc[0], Wc[1]); wb.y = cvt_pk_bf16(Wc[2], Wc[3]);
    const f32x4 Uc = CS_M16(o.tt, wb, zero4);
    ub.x = cvt_pk_bf16(Uc[0], Uc[1]); ub.y = cvt_pk_bf16(Uc[2], Uc[3]);
    Yc = CS_M16(o.arb, ub, Yc);
#pragma unroll
    for (int mt = 0; mt < 4; ++mt) zacc[mt] = CS_M16(o.bh[mt], ub, zz[mt]);
#undef CS_M32
#undef CS_M16
    return Yc;
}
template <int z>
__device__ __forceinline__ void scan_phase_z(const Frame& F, const Args& a) {
    unsigned char* ws = a.ws;
    const int seq = F.vcu >> 2, ig = F.vcu & 3;
    const int b = (seq >> 3) & 3, h = seq & 7;
    const size_t mb = (size_t)b * T;
    const int lane = F.lane, wave = F.wave, fr = lane & 15, fg = lane >> 4;
    constexpr int NCK = T / 16;
    volatile LAS unsigned* flg = (volatile LAS unsigned*)(F.lds + CS_FLAG);
    if (F.tid < 16) flg[F.tid] = 0u;
    __syncthreads();
    const int o16 = fr * 32 + fg * 8;
#define CS_M32(A_, B_, C_) __builtin_amdgcn_mfma_f32_16x16x32_bf16(A_, B_, C_, 0, 0, 0)
#define CS_M16(A_, B_, C_) __builtin_amdgcn_mfma_f32_16x16x16bf16_1k(__builtin_bit_cast(s16x4, A_), __builtin_bit_cast(s16x4, B_), C_, 0, 0, 0)
    if (wave == 0) {
        __builtin_amdgcn_s_setprio(3);
        float* yout = (float*)(ws + WS_Y) + (size_t)z * M * CW + h * 64 + ig * 16 + fr;
        f32x4 zacc[4];
#pragma unroll
        for (int mt = 0; mt < 4; ++mt) zacc[mt] = (f32x4){0.f, 0.f, 0.f, 0.f};
        ChainOps opA, opB;
#define CS_READY(nn) do { unsigned sp_ = 0; while (flg[(nn) & (CS_R - 1)] != (unsigned)((nn) + 1)) { __builtin_amdgcn_s_sleep(1); if (++sp_ > (1u << 24)) break; } __builtin_amdgcn_fence(__ATOMIC_ACQUIRE, "workgroup"); } while (0)
#define CS_HANDBACK(nn) do { asm volatile("s_waitcnt lgkmcnt(0)" ::: "memory"); if (lane == 0) flg[8] = (unsigned)((nn) + 1); asm volatile("" ::: "memory"); } while (0)
#define CS_YSTORE(nn, Y_) do { _Pragma("unroll") for (int rr = 0; rr < 4; ++rr) { const int q_ = 16 * (nn) + 4 * fg + rr, t_ = z ? (T - 1 - q_) : q_; yout[(mb + t_) * CW] = (Y_)[rr]; } } while (0)
        CS_READY(0); chain_load(F.lds, fr, fg, opA);
#pragma unroll 1
        for (int n = 0; n < NCK; n += 2) {
            CS_READY(n + 1); CS_HANDBACK(n);
            chain_load(F.lds + ((n + 1) & (CS_R - 1)) * CS_SLOT, fr, fg, opB);
            { const f32x4 Yc = chain_compute(opA, zacc); CS_YSTORE(n, Yc); }
            if (n + 2 < NCK) CS_READY(n + 2);
            CS_HANDBACK(n + 1);
            if (n + 2 < NCK) chain_load(F.lds + ((n + 2) & (CS_R - 1)) * CS_SLOT, fr, fg, opA);
            { const f32x4 Yc = chain_compute(opB, zacc); CS_YSTORE(n + 1, Yc); }
        }
#undef CS_READY
#undef CS_HANDBACK
#undef CS_YSTORE
        __builtin_amdgcn_s_setprio(0);
    } else {
        const int pi = wave - 1;
        LAS unsigned char* scr = F.lds + CS_SCR + pi * CS_SCRW;
        LAS bf16* KT = (LAS bf16*)scr; LAS bf16* BT = (LAS bf16*)(scr + 2304);
        const bf16* gw_ = (const bf16*)(ws + WS_DECAY) + (size_t)z * M * CW + h * 64;
        const bf16* gkk = (const bf16*)(ws + WS_KK) + h * 64;
        const bf16* gak = (const bf16*)(ws + WS_AKK) + (size_t)z * M * CW + h * 64;
        const bf16* gk = (const bf16*)(ws + WS_KDIR) + (size_t)z * M * CW + h * 64;
        const bf16* gr = (const bf16*)(ws + WS_R) + h * 64;
        const bf16* gv = (const bf16*)(ws + WS_V) + h * 64 + ig * 16;
        unsigned nw[16], nkk[16], nak[16], nk[16], nr[16], nv[4];
        constexpr long RSTEP = z ? -(long)CW : (long)CW;
#define CS_FETCH(nn) do { if ((nn) < NCK) { const size_t m0_ = (mb + (z ? (T - 1 - 16 * (nn)) : 16 * (nn))) * CW + lane; \
            const bf16* pw_ = gw_ + m0_; const bf16* pkk_ = gkk + m0_; const bf16* pak_ = gak + m0_; const bf16* pk_ = gk + m0_; const bf16* pr_ = gr + m0_; \
            _Pragma("unroll") for (int tt = 0; tt < 16; ++tt) { nw[tt] = pw_[tt * RSTEP]; nkk[tt] = pkk_[tt * RSTEP]; nak[tt] = pak_[tt * RSTEP]; nk[tt] = pk_[tt * RSTEP]; nr[tt] = pr_[tt * RSTEP]; } \
            const bf16* pv_ = gv + (mb + (z ? (T - 1 - 16 * (nn) - fg) : 16 * (nn) + fg)) * CW + fr; \
            _Pragma("unroll") for (int q4 = 0; q4 < 4; ++q4) nv[q4] = pv_[4 * q4 * RSTEP]; } } while (0)
        CS_FETCH(pi);
#pragma unroll 1
        for (int n = pi; n < NCK; n += 7) {
            const int slot = n & (CS_R - 1);
            float wv[16], kkv[16], akv[16], kv[16], rv[16], vq[4];
#pragma unroll
            for (int tt = 0; tt < 16; ++tt) { unsigned x0 = nw[tt], x1 = nkk[tt], x2 = nak[tt], x3 = nk[tt], x4 = nr[tt];
                asm volatile("" : "+v"(x0), "+v"(x1), "+v"(x2), "+v"(x3), "+v"(x4));
                wv[tt] = __uint_as_float(x0 << 16); kkv[tt] = __uint_as_float(x1 << 16); akv[tt] = __uint_as_float(x2 << 16); kv[tt] = __uint_as_float(x3 << 16); rv[tt] = __uint_as_float(x4 << 16); }
#pragma unroll
            for (int q4 = 0; q4 < 4; ++q4) { unsigned x0 = nv[q4]; asm volatile("" : "+v"(x0)); vq[q4] = __uint_as_float(x0 << 16); }
            CS_FETCH(n + 7);
            { unsigned sp = 0; while ((int)flg[8] < n - (CS_R - 3)) { __builtin_amdgcn_s_sleep(2); if (++sp > (1u << 24)) break; } }
            __builtin_amdgcn_fence(__ATOMIC_ACQUIRE, "workgroup");
            LAS unsigned char* sl = F.lds + slot * CS_SLOT;
            float P[16];
            P[0] = wv[0];
#pragma unroll
            for (int tt = 1; tt < 16; ++tt) P[tt] = P[tt - 1] * wv[tt];
            const float PL = P[15];
            float khat[16], bhat[16];
#pragma unroll
            for (int tt = 0; tt < 16; ++tt) {
                const float pm1 = tt ? P[tt - 1] : 1.0f, inv = __builtin_amdgcn_rcpf(P[tt]);
                const float at = kkv[tt] * pm1, rt = rv[tt] * P[tt], kt = kv[tt] * inv, bt = -akv[tt] * inv;
                khat[tt] = kt * PL; bhat[tt] = bt * PL;
                { const unsigned w_ = cvt_pk_bf16(at, rt); *(LAS bf16*)(sl + CS_AT + (tt * CS_LD + lane) * 2) = (bf16)w_; *(LAS bf16*)(sl + CS_RT + (tt * CS_LD + lane) * 2) = (bf16)(w_ >> 16); }
                { const unsigned w_ = cvt_pk_bf16(kt, bt); KT[tt * CS_LD + lane] = (bf16)w_; BT[tt * CS_LD + lane] = (bf16)(w_ >> 16); }
            }
            { u32x4 o0, o1;
              o0.x = cvt_pk_bf16(khat[0], khat[1]); o0.y = cvt_pk_bf16(khat[2], khat[3]); o0.z = cvt_pk_bf16(khat[4], khat[5]); o0.w = cvt_pk_bf16(khat[6], khat[7]);
              o1.x = cvt_pk_bf16(khat[8], khat[9]); o1.y = cvt_pk_bf16(khat[10], khat[11]); o1.z = cvt_pk_bf16(khat[12], khat[13]); o1.w = cvt_pk_bf16(khat[14], khat[15]);
              *(LAS u32x4*)(sl + CS_KHT + lane * 32) = o0; *(LAS u32x4*)(sl + CS_KHT + lane * 32 + 16) = o1;
              o0.x = cvt_pk_bf16(bhat[0], bhat[1]); o0.y = cvt_pk_bf16(bhat[2], bhat[3]); o0.z = cvt_pk_bf16(bhat[4], bhat[5]); o0.w = cvt_pk_bf16(bhat[6], bhat[7]);
              o1.x = cvt_pk_bf16(bhat[8], bhat[9]); o1.y = cvt_pk_bf16(bhat[10], bhat[11]); o1.z = cvt_pk_bf16(bhat[12], bhat[13]); o1.w = cvt_pk_bf16(bhat[14], bhat[15]);
              *(LAS u32x4*)(sl + CS_BHT + lane * 32) = o0; *(LAS u32x4*)(sl + CS_BHT + lane * 32 + 16) = o1; }
            *(LAS float*)(sl + CS_PL + lane * 4) = PL;
#pragma unroll
            for (int q4 = 0; q4 < 4; ++q4) *(LAS bf16*)(sl + CS_VT + (fr * 16 + fg + 4 * q4) * 2) = f2bf(vq[q4]);
            asm volatile("s_waitcnt lgkmcnt(0)" ::: "memory");
            bf16x8 af[2], rf[2], kf[2], bf_[2];
#pragma unroll
            for (int ks = 0; ks < 2; ++ks) { af[ks] = *(const LAS bf16x8*)(sl + CS_AT + (fr * CS_LD + 32 * ks + 8 * fg) * 2); rf[ks] = *(const LAS bf16x8*)(sl + CS_RT + (fr * CS_LD + 32 * ks + 8 * fg) * 2);
                kf[ks] = *(const LAS bf16x8*)(KT + fr * CS_LD + 32 * ks + 8 * fg); bf_[ks] = *(const LAS bf16x8*)(BT + fr * CS_LD + 32 * ks + 8 * fg); }
            const f32x4 zero4 = {0.f, 0.f, 0.f, 0.f};
            f32x4 Xc = zero4, Xt = zero4, AakT = zero4, ArbT = zero4, ArkT = zero4;
#pragma unroll
            for (int ks = 0; ks < 2; ++ks) { Xc = CS_M32(af[ks], bf_[ks], Xc); Xt = CS_M32(bf_[ks], af[ks], Xt);
                AakT = CS_M32(kf[ks], af[ks], AakT); ArbT = CS_M32(bf_[ks], rf[ks], ArbT); ArkT = CS_M32(kf[ks], rf[ks], ArkT); }
            f32x4 S1;
#pragma unroll
            for (int rr = 0; rr < 4; ++rr) { const int q = 4 * fg + rr;
                Xc[rr] = (fr < q) ? Xc[rr] : 0.f; Xt[rr] = (q < fr) ? Xt[rr] : 0.f; S1[rr] = Xt[rr] + ((q == fr) ? 1.0f : 0.f);
                AakT[rr] = (q < fr) ? AakT[rr] : 0.f; ArkT[rr] = (q <= fr) ? ArkT[rr] : 0.f; ArbT[rr] = (q <= fr) ? ArbT[rr] : 0.f; }
            { u32x2 w; w.x = cvt_pk_bf16(AakT[0], AakT[1]); w.y = cvt_pk_bf16(AakT[2], AakT[3]); *(LAS u32x2*)(sl + CS_AAK + o16) = w;
              w.x = cvt_pk_bf16(ArkT[0], ArkT[1]); w.y = cvt_pk_bf16(ArkT[2], ArkT[3]); *(LAS u32x2*)(sl + CS_ARK + o16) = w;
              w.x = cvt_pk_bf16(ArbT[0], ArbT[1]); w.y = cvt_pk_bf16(ArbT[2], ArbT[3]); *(LAS u32x2*)(sl + CS_ARB + o16) = w; }
#define CS_PK(v) ((u32x2){cvt_pk_bf16((v)[0], (v)[1]), cvt_pk_bf16((v)[2], (v)[3])})
            const u32x2 xc = CS_PK(Xc), xt = CS_PK(Xt), s1 = CS_PK(S1);
            const f32x4 X2c = CS_M16(xt, xc, zero4), X2t = CS_M16(xc, xt, zero4);
            const u32x2 x2c = CS_PK(X2c), x2t = CS_PK(X2t);
            const f32x4 S2 = CS_M16(x2c, s1, S1);
            const f32x4 X4c = CS_M16(x2t, x2c, zero4), X4t = CS_M16(x2c, x2t, zero4);
            const u32x2 x4c = CS_PK(X4c), x4t = CS_PK(X4t), s2 = CS_PK(S2);
            const f32x4 S4 = CS_M16(x4c, s2, S2);
            const f32x4 X8c = CS_M16(x4t, x4c, zero4);
            const u32x2 x8c = CS_PK(X8c), s4 = CS_PK(S4);
            const f32x4 S8 = CS_M16(x8c, s4, S4);
            *(LAS u32x2*)(sl + CS_TT + o16) = CS_PK(S8);
#undef CS_PK
            asm volatile("s_waitcnt lgkmcnt(0)" ::: "memory");
            __builtin_amdgcn_fence(__ATOMIC_RELEASE, "workgroup");
            if (lane == 0) flg[slot] = (unsigned)(n + 1);
        }
#undef CS_FETCH
    }
#undef CS_M32
#undef CS_M16
    __syncthreads();
}

__device__ __forceinline__ void scan_phase(const Frame& F, const Args& a) {
    const int seq = F.vcu >> 2;
    if (seq >= 64) return;
    if (seq >> 5) scan_phase_z<1>(F, a); else scan_phase_z<0>(F, a);
}

__device__ __forceinline__ void combine_phase(const Frame& F, const Args& a) {
    unsigned char* ws = a.ws;
    const bf16* att = (const bf16*)(ws + WS_ATT); const bf16* rr = (const bf16*)(ws + WS_R); const bf16* vv = (const bf16*)(ws + WS_V);
    const bf16* kd = (const bf16*)(ws + WS_KDIR); const bf16* gg = (const bf16*)(ws + WS_G); const float* y = (const float*)(ws + WS_Y);
    bf16* mix = (bf16*)(ws + WS_MIX);
    const float* anw = a.in[4]; const float* r_k = a.in[14]; const float* ln_w = a.in[15]; const float* ln_b = a.in[16];
    const int lane = F.lane, c0 = 8 * lane;
    float nw[8], rk[8], lw[8], lb[8];
#pragma unroll
    for (int i = 0; i < 8; ++i) { nw[i] = anw[c0 + i]; rk[i] = r_k[c0 + i]; lw[i] = ln_w[c0 + i]; lb[i] = ln_b[c0 + i]; }
    const int gw = F.vcu * 8 + F.wave, NGW = F.G * 8;
#pragma unroll 2
    for (int m = gw; m < M; m += NGW) {
        const size_t o = (size_t)m * CW + c0;
        float f[8];
        unpack8(*(const u32x4*)(att + o), f);
        float ss = 0.f;
#pragma unroll
        for (int i = 0; i < 8; ++i) ss += f[i] * f[i];
        const float rs = rsqrtf(wave_sum(ss) * (1.f / CW) + RMS_EPS);
#pragma unroll
        for (int i = 0; i < 8; ++i) f[i] = f[i] * rs * nw[i];
        *(u32x4*)(mix + (size_t)m * D + c0) = pack8(f);
        const f32x4 y0a = *(const f32x4*)(y + o), y0b = *(const f32x4*)(y + o + 4), y1a = *(const f32x4*)(y + (size_t)M * CW + o), y1b = *(const f32x4*)(y + (size_t)M * CW + o + 4);
        float yv[8] = {y0a.x + y1a.x, y0a.y + y1a.y, y0a.z + y1a.z, y0a.w + y1a.w, y0b.x + y1b.x, y0b.y + y1b.y, y0b.z + y1b.z, y0b.w + y1b.w};
        float s1 = 0.f;
#pragma unroll
        for (int i = 0; i < 8; ++i) s1 += yv[i];
        s1 += __shfl_xor(s1, 1); s1 += __shfl_xor(s1, 2); s1 += __shfl_xor(s1, 4);
        const float mean = s1 * (1.f / 64.f);
        float s2 = 0.f;
#pragma unroll
        for (int i = 0; i < 8; ++i) { yv[i] -= mean; s2 += yv[i] * yv[i]; }
        s2 += __shfl_xor(s2, 1); s2 += __shfl_xor(s2, 2); s2 += __shfl_xor(s2, 4);
        const float rstd = rsqrtf(s2 * (1.f / 64.f) + GN_EPS);
        float rf[8], k0[8], k1[8], vf[8], gf[8];
        unpack8(*(const u32x4*)(rr + o), rf); unpack8(*(const u32x4*)(kd + o), k0); unpack8(*(const u32x4*)(kd + (size_t)M * CW + o), k1);
        unpack8(*(const u32x4*)(vv + o), vf); unpack8(*(const u32x4*)(gg + o), gf);
        float cf = 0.f;
#pragma unroll
        for (int i = 0; i < 8; ++i) cf += rf[i] * (k0[i] + k1[i]) * rk[i];
        cf += __shfl_xor(cf, 1); cf += __shfl_xor(cf, 2); cf += __shfl_xor(cf, 4);
#pragma unroll
        for (int i = 0; i < 8; ++i) f[i] = (yv[i] * rstd * lw[i] + lb[i] + cf * vf[i]) * gf[i];
        *(u32x4*)(mix + (size_t)m * D + CW + c0) = pack8(f);
    }
}

constexpr int RT_PITCH = 1032, RT_WH = 0, RT_WL = 32 * RT_PITCH * 2, RT_HIST = 2 * RT_WL, RT_EL = RT_HIST + 256;
__device__ __forceinline__ void router_phase(const Frame& F, const Args& a) {
    unsigned char* ws = a.ws;
    const float* hbuf = (const float*)(ws + WS_H); unsigned char* hn2 = ws + WS_HN2;
    int* eidx = (int*)(ws + WS_EIDX); float* gate = (float*)(ws + WS_GATE); int* rank = (int*)(ws + WS_RANK);
    unsigned* ctl = (unsigned*)(ws + WS_CTL);
    const float* n2w = a.in[18]; const float* rw = a.in[19]; const float* rb = a.in[20];
    LAS bf16* wh = (LAS bf16*)(F.lds + RT_WH); LAS bf16* wl = (LAS bf16*)(F.lds + RT_WL); LAS int* hist = (LAS int*)(F.lds + RT_HIST); LAS int* eL = (LAS int*)(F.lds + RT_EL);
    { f32x4 tmp[16];
#pragma unroll
      for (int j = 0; j < 16; ++j) tmp[j] = *((const f32x4*)rw + F.tid + 512 * j);
#pragma unroll
      for (int j = 0; j < 16; ++j) { const int q = F.tid + 512 * j, d = q >> 3, e0 = 4 * (q & 7);
#pragma unroll
          for (int i = 0; i < 4; ++i) { const float w = tmp[j][i]; const unsigned hb = cvt_pk_bf16(w, 0.f) & 0xffffu; const float lo = w - __uint_as_float(hb << 16);
              wh[(e0 + i) * RT_PITCH + d] = (bf16)hb; wl[(e0 + i) * RT_PITCH + d] = (bf16)cvt_pk_bf16(lo, 0.f); } } }
    if (F.tid < 32) hist[F.tid] = 0;
    __syncthreads();
    const int lane = F.lane, tk = lane & 15, g = lane >> 4;
    const int blk = F.vcu;
    const int m = blk * 128 + F.wave * 16 + tk;
    const float* hrow = hbuf + (size_t)m * D + 8 * g;
    float ss = 0.f;
#pragma unroll 8
    for (int ks = 0; ks < 32; ++ks) { const f32x4 x0 = *(const f32x4*)(hrow + 32 * ks), x1 = *(const f32x4*)(hrow + 32 * ks + 4);
        ss += (x0.x * x0.x + x0.y * x0.y) + (x0.z * x0.z + x0.w * x0.w) + (x1.x * x1.x + x1.y * x1.y) + (x1.z * x1.z + x1.w * x1.w); }
    ss += __shfl_xor(ss, 16); ss += __shfl_xor(ss, 32);
    const float rs = rsqrtf(ss * (1.f / D) + RMS_EPS);
    f32x4 acc0 = {0.f, 0.f, 0.f, 0.f}, acc1 = acc0;
    unsigned char* hrow8 = hn2 + (size_t)m * D + 8 * g;
    const LAS bf16* wh0 = wh + tk * RT_PITCH + 8 * g; const LAS bf16* wl0 = wl + tk * RT_PITCH + 8 * g;
#pragma unroll 4
    for (int ks = 0; ks < 32; ++ks) {
        const f32x4 x0 = *(const f32x4*)(hrow + 32 * ks), x1 = *(const f32x4*)(hrow + 32 * ks + 4);
        const f32x4 n0 = *(const f32x4*)(n2w + 32 * ks + 8 * g), n1 = *(const f32x4*)(n2w + 32 * ks + 8 * g + 4);
        const f32x4 y0 = x0 * rs * n0, y1 = x1 * rs * n1;
        { u32x2 w8; w8.x = pk4_fp8(y0.x * F8_SX, y0.y * F8_SX, y0.z * F8_SX, y0.w * F8_SX); w8.y = pk4_fp8(y1.x * F8_SX, y1.y * F8_SX, y1.z * F8_SX, y1.w * F8_SX); *(u32x2*)(hrow8 + 32 * ks) = w8; }
        union { u32x4 w; bf16x8 h8; } xh, xl;
        xh.w.x = cvt_pk_bf16(y0.x, y0.y); xh.w.y = cvt_pk_bf16(y0.z, y0.w); xh.w.z = cvt_pk_bf16(y1.x, y1.y); xh.w.w = cvt_pk_bf16(y1.z, y1.w);
        xl.w.x = cvt_pk_bf16(y0.x - bflo(xh.w.x), y0.y - bfhi(xh.w.x)); xl.w.y = cvt_pk_bf16(y0.z - bflo(xh.w.y), y0.w - bfhi(xh.w.y));
        xl.w.z = cvt_pk_bf16(y1.x - bflo(xh.w.z), y1.y - bfhi(xh.w.z)); xl.w.w = cvt_pk_bf16(y1.z - bflo(xh.w.w), y1.w - bfhi(xh.w.w));
        const bf16x8 a0h = *(const LAS bf16x8*)(wh0 + 32 * ks), a1h = *(const LAS bf16x8*)(wh0 + 16 * RT_PITCH + 32 * ks);
        const bf16x8 a0l = *(const LAS bf16x8*)(wl0 + 32 * ks), a1l = *(const LAS bf16x8*)(wl0 + 16 * RT_PITCH + 32 * ks);
        acc0 = __builtin_amdgcn_mfma_f32_16x16x32_bf16(a0h, xh.h8, acc0, 0, 0, 0); acc1 = __builtin_amdgcn_mfma_f32_16x16x32_bf16(a1h, xh.h8, acc1, 0, 0, 0);
        acc0 = __builtin_amdgcn_mfma_f32_16x16x32_bf16(a0h, xl.h8, acc0, 0, 0, 0); acc1 = __builtin_amdgcn_mfma_f32_16x16x32_bf16(a1h, xl.h8, acc1, 0, 0, 0);
        acc0 = __builtin_amdgcn_mfma_f32_16x16x32_bf16(a0l, xh.h8, acc0, 0, 0, 0); acc1 = __builtin_amdgcn_mfma_f32_16x16x32_bf16(a1l, xh.h8, acc1, 0, 0, 0);
    }
    float lv[8]; int li[8];
    { const f32x4 b0 = *(const f32x4*)(rb + 4 * g), b1 = *(const f32x4*)(rb + 16 + 4 * g);
#pragma unroll
      for (int i = 0; i < 4; ++i) { lv[i] = acc0[i] + b0[i]; li[i] = 4 * g + i; lv[4 + i] = acc1[i] + b1[i]; li[4 + i] = 16 + 4 * g + i; } }
    float tv[4]; int ti[4];
#pragma unroll
    for (int kx = 0; kx < 4; ++kx) {
        float bv = lv[0]; int bi = li[0];
#pragma unroll
        for (int i = 1; i < 8; ++i) { const bool gt = lv[i] > bv; bv = gt ? lv[i] : bv; bi = gt ? li[i] : bi; }
#pragma unroll
        for (int o = 16; o < 64; o <<= 1) { const float ov = __shfl_xor(bv, o); const int oi = __shfl_xor(bi, o); const bool tko = (ov > bv) || (ov == bv && oi < bi); bv = tko ? ov : bv; bi = tko ? oi : bi; }
        tv[kx] = bv; ti[kx] = bi;
#pragma unroll
        for (int i = 0; i < 8; ++i) lv[i] = (li[i] == bi) ? -3.0e38f : lv[i];
    }
    if (g == 0) {
        const float e0 = 1.0f, e1 = __expf(tv[1] - tv[0]), e2 = __expf(tv[2] - tv[0]), e3 = __expf(tv[3] - tv[0]);
        const float is = 1.0f / (e0 + e1 + e2 + e3);
        const float gs[4] = {e0 * is, e1 * is, e2 * is, e3 * is};
#pragma unroll
        for (int kx = 0; kx < 4; ++kx) { eidx[m * 4 + kx] = ti[kx]; gate[m * 4 + kx] = gs[kx]; eL[(m - blk * 128) * 4 + kx] = ti[kx]; }
    }
    __syncthreads();
    { const int t = F.tid, e = eL[t]; int rk = 0;
      for (int u = 0; u < t; ++u) rk += (eL[u] == e) ? 1 : 0;
      rank[(blk * 128) * 4 + t] = rk;
      __hip_atomic_fetch_add(&hist[e], 1, __ATOMIC_RELAXED, __HIP_MEMORY_SCOPE_WORKGROUP); }
    __syncthreads();
    if (F.tid < 32) ctl[CW_CNT + blk * 32 + F.tid] = (unsigned)hist[F.tid];
}

__device__ __forceinline__ void dispatch_phase(const Frame& F, const Args& a) {
    unsigned char* ws = a.ws;
    unsigned* ctl = (unsigned*)(ws + WS_CTL);
    const int* eidx = (const int*)(ws + WS_EIDX); const int* rank = (const int*)(ws + WS_RANK); int* dest = (int*)(ws + WS_DEST);
    LAS int* part = (LAS int*)F.lds;
    LAS int* tot = part + 1024;
    const int blk = F.vcu, G = F.G;
    { const int e = F.tid & 31, pt = F.tid >> 5; int s = 0, sb = 0;
      if (G == 256) { int cv[16];
#pragma unroll
          for (int q = 0; q < 16; ++q) cv[q] = (int)ld_u32_agent(ctl + CW_CNT + (pt + 16 * q) * 32 + e);
#pragma unroll
          for (int q = 0; q < 16; ++q) { s += cv[q]; if (pt + 16 * q < blk) sb += cv[q]; } }
      else for (int bb = pt; bb < G; bb += 16) { const int cval = (int)ld_u32_agent(ctl + CW_CNT + bb * 32 + e); s += cval; if (bb < blk) sb += cval; }
      part[pt * 32 + e] = s; part[512 + pt * 32 + e] = sb; }
    __syncthreads();
    if (F.tid < 32) { int s = 0, sb = 0;
        for (int pt = 0; pt < 16; ++pt) { s += part[pt * 32 + F.tid]; sb += part[512 + pt * 32 + F.tid]; }
        tot[F.tid] = s; tot[32 + F.tid] = sb; tot[96 + F.tid] = (s + 255) & ~255; }
    __syncthreads();
    if (F.tid == 0) { int ps = 0; for (int e = 0; e < 32; ++e) { tot[64 + e] = ps; ps += tot[96 + e]; }
        tot[128] = ps >> 8; }
    __syncthreads();
    if (blk == 0) {
        if (F.tid == 0) ctl[CW_NT] = (unsigned)tot[128];
        for (int e = F.tid >> 4; e < 32; e += 32) { const int t0 = tot[64 + e] >> 8, nt = tot[96 + e] >> 8; for (int i = F.tid & 15; i < nt; i += 16) ctl[CW_TEXP + t0 + i] = (unsigned)e; }
    }
    const int lane = F.lane;
    const int mw = blk * 128 + F.wave * 16;
    int* rowtok = (int*)(ws + WS_ROWTOK);
    { const int e = eidx[mw * 4 + lane]; const int dl = tot[64 + e] + tot[32 + e] + rank[mw * 4 + lane]; dest[mw * 4 + lane] = dl; rowtok[dl] = mw + (lane >> 2); }
    { const int e = blk & 31, pt = blk >> 5, np = G >> 5; const int r0 = tot[64 + e] + tot[e], r1 = tot[64 + e] + tot[96 + e];
      if (np > 0) for (int r = r0 + pt * 512 + F.tid; r < r1; r += np * 512) rowtok[r] = 0; }
}

__device__ __forceinline__ void final_phase(const Frame& F, const Args& a) {
    unsigned char* ws = a.ws;
    const float* hbuf = (const float*)(ws + WS_H); const bf16* ybuf = (const bf16*)(ws + WS_YBUF);
    const int* dest = (const int*)(ws + WS_DEST); const float* gate = (const float*)(ws + WS_GATE);
    const float* fw = a.in[25]; float* out = a.out;
    const int lane = F.lane;
    f32x4 wn[4];
#pragma unroll
    for (int j = 0; j < 4; ++j) wn[j] = *((const f32x4*)fw + lane + 64 * j);
    const int gw = F.vcu * 8 + F.wave, NGW = F.G * 8;
    const int per = M / NGW;
    const int mw = gw * per;
    int dl = 0; float gl = 0.f;
    if (lane < 4 * per && per <= 16) { dl = dest[mw * 4 + lane]; gl = gate[mw * 4 + lane]; }
#pragma unroll 2
    for (int i = 0; i < per; ++i) {
        const int m = mw + i;
        const f32x4* hr = (const f32x4*)(hbuf + (size_t)m * D) + lane;
        f32x4 v[4];
#pragma unroll
        for (int j = 0; j < 4; ++j) v[j] = hr[64 * j];
#pragma unroll
        for (int kx = 0; kx < 4; ++kx) {
            const int d = per <= 16 ? __shfl(dl, 4 * i + kx) : dest[m * 4 + kx]; const float gt = per <= 16 ? __shfl(gl, 4 * i + kx) : gate[m * 4 + kx];
            const u32x2* yr = (const u32x2*)(ybuf + (size_t)d * D) + lane;
#pragma unroll
            for (int j = 0; j < 4; ++j) { const u32x2 w = yr[64 * j]; v[j].x += gt * bflo(w.x); v[j].y += gt * bfhi(w.x); v[j].z += gt * bflo(w.y); v[j].w += gt * bfhi(w.y); }
        }
        float s = 0.f;
#pragma unroll
        for (int j = 0; j < 4; ++j) s += (v[j].x * v[j].x + v[j].y * v[j].y) + (v[j].z * v[j].z + v[j].w * v[j].w);
        const float rs = rsqrtf(wave_sum(s) * (1.f / D) + RMS_EPS);
        f32x4* orow = (f32x4*)(out + (size_t)m * D) + lane;
#pragma unroll
        for (int j = 0; j < 4; ++j) orow[64 * j] = v[j] * rs * wn[j];
    }
}

__global__ void __launch_bounds__(512, 2) fwd_megakernel(Args args) {
    extern __shared__ __attribute__((aligned(16))) unsigned char lds_raw[];
    Frame F;
    F.lds = (LAS unsigned char*)lds_raw;
    F.tid = threadIdx.x; F.lane = F.tid & 63; F.wave = __builtin_amdgcn_readfirstlane(F.tid >> 6);
    F.G = gridDim.x; { const int bx = blockIdx.x; F.vcu = (F.G % 8 == 0) ? (bx % 8) * (F.G / 8) + bx / 8 : bx; }
    unsigned char* ws = args.ws;
    const int lo = args.ph_lo, hi = args.ph_hi;
#define IN(k) (lo <= (k) && (k) < hi)
#if MK_SPLIT
#define SEAM(k) do { } while (0)
#else
    cg::grid_group grid = cg::this_grid();
    { volatile LAS unsigned* st = (volatile LAS unsigned*)(F.lds + LDS_MISC); if (F.tid < 2) st[F.tid] = 0u; __syncthreads(); }
    const XcdBarrier xbar = xcd_barrier_post((unsigned*)(ws + WS_CTL) + CW_BAR, (volatile LAS unsigned*)(F.lds + LDS_MISC));
    if (lo < 0) grid.sync();
#define SEAM(k) do { if (IN(k) && IN((k) + 1)) xcd_barrier(xbar); } while (0)
#endif
#define REP2(k) if constexpr (((MK_REPEAT >> (k)) & 1) != 0)
#define PH1 { pg8::Gemm g{(const bf16*)(ws + WS_HN), (const bf16*)(ws + WS_WINT), 1024, nullptr, 0, nullptr}; \
        pg8::StaticOrder S; S.init(M / 256, NPROJ_PAD / 256, F.G, (int)blockIdx.x); \
        pg8::EpiProj E{(bf16*)(ws + WS_Q), (bf16*)(ws + WS_K), (bf16*)(ws + WS_VT), (bf16*)(ws + WS_P)}; \
        pg8::gemm_phase<pg8::EpiProj, true, true>(F.lds, g, S, E); }
#define PH5 { pg8::Gemm g{(const bf16*)(ws + WS_MIX), (const bf16*)(ws + WS_WOT), 1024, nullptr, 0, nullptr}; \
        pg8::StaticOrder S; S.init(M / 256, D / 256, F.G, (int)blockIdx.x); \
        pg8::EpiWo E{args.in[0], (float*)(ws + WS_H)}; \
        pg8::gemm_phase<pg8::EpiWo, true, true>(F.lds, g, S, E); }
#define PH8 { const unsigned* ctl = (const unsigned*)(ws + WS_CTL); const int ntile = (int)ld_u32_agent(ctl + CW_NT); \
        pg8::Gemm g{(const bf16*)(ws + WS_HN2), (const bf16*)(ws + WS_WUPT), 512, ctl + CW_TEXP, (size_t)2048 * 1024, (const int*)(ws + WS_ROWTOK)}; \
        pg8::StaticOrder S; S.init(ntile, 8, F.G, (int)blockIdx.x); \
        pg8::EpiUp E{args.in[22], ws + WS_ACT}; \
        pg8::gemm_phase<pg8::EpiUp, true, true, true, true>(F.lds, g, S, E); }
#define PH9 { const unsigned* ctl = (const unsigned*)(ws + WS_CTL); const int ntile = (int)ld_u32_agent(ctl + CW_NT); \
        pg8::Gemm g{(const bf16*)(ws + WS_ACT), (const bf16*)(ws + WS_WDNT), 512, ctl + CW_TEXP, (size_t)1024 * 1024, nullptr}; \
        pg8::StaticOrder S; S.init(ntile, 4, F.G, (int)blockIdx.x); \
        pg8::EpiDown E{args.in[24], (bf16*)(ws + WS_YBUF)}; \
        pg8::gemm_phase<pg8::EpiDown, true, true, false, true>(F.lds, g, S, E); }
    if (IN(0)) { p0_prologue(F, args); REP2(0) p0_prologue(F, args); }
    SEAM(0);
    if (IN(1)) { PH1 REP2(1) PH1 }
    SEAM(1);
    if (IN(2)) { prep_phase<true>(F, args); REP2(2) prep_phase<true>(F, args); attn_phase(F, args); REP2(11) attn_phase(F, args); }
    SEAM(2);
    if (IN(3)) { scan_phase(F, args); REP2(3) scan_phase(F, args); }
    SEAM(3);
    if (IN(4)) { combine_phase(F, args); REP2(4) combine_phase(F, args); }
    SEAM(4);
    if (IN(5)) { PH5 REP2(5) PH5 }
    SEAM(5);
    if (IN(6)) { router_phase(F, args); REP2(6) { __syncthreads(); router_phase(F, args); } }
    SEAM(6);
    if (IN(7)) { dispatch_phase(F, args); REP2(7) { __syncthreads(); dispatch_phase(F, args); } }
    SEAM(7);
    if (IN(8)) { PH8 REP2(8) PH8 }
    SEAM(8);
    if (IN(9)) { PH9 REP2(9) PH9 }
    SEAM(9);
    if (IN(10)) { final_phase(F, args); REP2(10) final_phase(F, args); }
#undef IN
#undef SEAM
}

extern "C" void kernel_launch(void* const* d_in, const int* in_sizes, int n_in, void* d_out, int out_size, void* d_ws, size_t ws_size, hipStream_t stream) {
    static int grid = 0;
    if (grid == 0) {
        if (n_in != 26 || in_sizes[0] != M * D || out_size != M * D || ws_size < WS_END) { fprintf(stderr, "kernel_launch: unexpected problem (n_in %d, in0 %d, out %d, ws %zu)\n", n_in, n_in > 0 ? in_sizes[0] : -1, out_size, ws_size); grid = -1; return; }
        int dev = 0, cus = 0, per_cu = 0;
        if (hipGetDevice(&dev) != hipSuccess || hipDeviceGetAttribute(&cus, hipDeviceAttributeMultiprocessorCount, dev) != hipSuccess) { grid = -1; return; }
        if (hipFuncSetAttribute((const void*)fwd_megakernel, hipFuncAttributeMaxDynamicSharedMemorySize, LDS_BYTES) != hipSuccess) { fprintf(stderr, "kernel_launch: hipFuncSetAttribute failed\n"); grid = -1; return; }
        if (hipOccupancyMaxActiveBlocksPerMultiprocessor(&per_cu, (const void*)fwd_megakernel, 512, LDS_BYTES) != hipSuccess || per_cu < 1) { fprintf(stderr, "kernel_launch: occupancy query says %d\n", per_cu); per_cu = 1; }
        (void)hipGetLastError();
        grid = cus * 1;
        if (grid != 256) fprintf(stderr, "kernel_launch: note: %d CUs\n", cus);
    }
    if (grid < 0) return;
    if (hipMemsetAsync((char*)d_ws + WS_CTL + (size_t)CW_BAR * 4, 0, XCD_BAR_WORDS * 4, stream) != hipSuccess) { fprintf(stderr, "kernel_launch: memset failed\n"); return; }
    Args a{};
    for (int i = 0; i < 26; ++i) a.in[i] = (const float*)d_in[i];
    a.out = (float*)d_out; a.ws = (unsigned char*)d_ws;
#if MK_SPLIT
    for (int ph = 0; ph < NPHASE; ++ph) { a.ph_lo = ph; a.ph_hi = ph + 1; hipLaunchKernelGGL(fwd_megakernel, dim3(grid), dim3(512), LDS_BYTES, stream, a); }
#else
    a.ph_lo = 0; a.ph_hi = NPHASE;
    void* kargs[] = {&a};
    hipError_t e = hipLaunchCooperativeKernel((const void*)fwd_megakernel, dim3(grid), dim3(512), kargs, LDS_BYTES, stream);
    if (e != hipSuccess) fprintf(stderr, "kernel_launch: cooperative launch failed: %s (grid %d)\n", hipGetErrorString(e), grid);
#endif
}
```

```cpp
#include <hip/hip_runtime.h>
#include <hip/hip_cooperative_groups.h>
#include <cstdio>
#include <cstdint>
namespace cg = cooperative_groups;

#ifndef MK_SPLIT
#define MK_SPLIT 0
#endif

#ifndef MK_REPEAT
#define MK_REPEAT 0
#endif
#define LAS __attribute__((address_space(3)))
typedef unsigned short bf16;
typedef float f32x4 __attribute__((ext_vector_type(4)));
typedef float f32x2 __attribute__((ext_vector_type(2)));
typedef unsigned u32x4 __attribute__((ext_vector_type(4)));
typedef unsigned u32x2 __attribute__((ext_vector_type(2)));
typedef short bf16x8 __attribute__((ext_vector_type(8)));
typedef short s16x4 __attribute__((ext_vector_type(4)));

constexpr int BATCH = 4, T = 8192, D = 1024, M = BATCH * T;
constexpr int NH = 8, HD = 64, CW = 512;
constexpr int SHIFT_W = 1920, NPROJ = 3456, NPROJ_PAD = 3584, PW = 2048;
constexpr int NE = 32, TOPK = 4, DE = 1024;
constexpr int GRIDW = 64, GROWS = 128;
constexpr int P_TILES_MAX = 544, P_ROWS = P_TILES_MAX * 256;
constexpr float RMS_EPS = 1e-5f, GN_EPS = 64e-5f;
constexpr int NPHASE = 11;

constexpr size_t MiB = 1u << 20;
constexpr size_t WS_CTL = 0;
constexpr size_t WS_W2T = 1 * MiB, WS_A2T = WS_W2T + 131072, WS_G2T = WS_A2T + 131072;
constexpr size_t WS_WINT = 2 * MiB, WS_WOT = 9 * MiB, WS_WUPT = 12 * MiB, WS_WDNT = 140 * MiB;
constexpr size_t WS_EIDX = 204 * MiB, WS_GATE = WS_EIDX + 524288, WS_RANK = WS_GATE + 524288, WS_DEST = WS_RANK + 524288, WS_ROWTOK = WS_DEST + 524288;
constexpr size_t WS_R = 208 * MiB, WS_V = 240 * MiB, WS_KK = 272 * MiB, WS_DECAY = 304 * MiB, WS_KDIR = 368 * MiB, WS_AKK = 432 * MiB,
                 WS_G = 496 * MiB, WS_ATT = 528 * MiB;
constexpr size_t WS_Q = 560 * MiB, WS_K = 592 * MiB, WS_VT = 624 * MiB, WS_P = 656 * MiB, WS_HN = 784 * MiB, WS_Y = 848 * MiB;
constexpr size_t WS_MIX = 560 * MiB, WS_H = 752 * MiB, WS_HN2 = 880 * MiB, WS_XBUF = 208 * MiB, WS_ACT = 480 * MiB, WS_YBUF = 208 * MiB;
constexpr size_t WS_END = 976 * MiB;
constexpr int CW_NT = 0, CW_TEXP = 64, CW_CNT = 1024, CW_BAR = 16384;

constexpr int LDS_BYTES = 159744, LDS_MISC = LDS_BYTES - 256;

typedef __bf16 bf16x2_t __attribute__((ext_vector_type(2)));
__device__ __forceinline__ unsigned cvt_pk_bf16(float lo, float hi) { const f32x2 v = {lo, hi}; return __builtin_bit_cast(unsigned, __builtin_convertvector(v, bf16x2_t)); }
typedef int i32x8 __attribute__((ext_vector_type(8)));
typedef int i32x4 __attribute__((ext_vector_type(4)));
#ifndef F8_SCALE1
#define F8_SCALE1 0
#endif
constexpr float F8_SX = 32.0f, F8_SW = 128.0f, F8_SACT = 8.0f;
__device__ __forceinline__ float f8clamp(float v) { return __builtin_amdgcn_fmed3f(v, -448.0f, 448.0f); }
__device__ __forceinline__ unsigned pk4_fp8(float a, float b, float c, float d) { int w = 0; w = __builtin_amdgcn_cvt_pk_fp8_f32(f8clamp(a), f8clamp(b), w, false); w = __builtin_amdgcn_cvt_pk_fp8_f32(f8clamp(c), f8clamp(d), w, true); return (unsigned)w; }
__device__ __forceinline__ float bflo(unsigned u) { return __uint_as_float(u << 16); }
__device__ __forceinline__ float bfhi(unsigned u) { return __uint_as_float(u & 0xffff0000u); }
__device__ __forceinline__ float bf1(bf16 v) { return __uint_as_float(((unsigned)v) << 16); }
__device__ __forceinline__ void unpack8(const u32x4 u, float* f) { f[0] = bflo(u.x); f[1] = bfhi(u.x); f[2] = bflo(u.y); f[3] = bfhi(u.y); f[4] = bflo(u.z); f[5] = bfhi(u.z); f[6] = bflo(u.w); f[7] = bfhi(u.w); }
__device__ __forceinline__ u32x4 pack8(const float* f) { u32x4 o; o.x = cvt_pk_bf16(f[0], f[1]); o.y = cvt_pk_bf16(f[2], f[3]); o.z = cvt_pk_bf16(f[4], f[5]); o.w = cvt_pk_bf16(f[6], f[7]); return o; }
__device__ __forceinline__ float wave_sum(float v) {
#pragma unroll
    for (int o = 1; o < 64; o <<= 1) v += __shfl_xor(v, o);
    return v;
}
__device__ __forceinline__ float sigmoidf_(float x) { return __builtin_amdgcn_rcpf(1.0f + __expf(-x)); }
__device__ __forceinline__ unsigned ld_u32_agent(const unsigned* p) { return __hip_atomic_load(p, __ATOMIC_RELAXED, __HIP_MEMORY_SCOPE_AGENT); }

namespace pg8 {
constexpr int BM = 256, BK = 64, HALF = 128, HTB = HALF * BK * 2, STAGE_BYTES = 8 * HTB, NXCD = 8, WGM = 8;
__host__ __device__ __forceinline__ int lds_byte(int r, int c) { const int st = (r >> 4) * 2 + (c >> 5), rr = r & 15, cc = c & 31, ob = rr * 64 + cc * 2; return st * 1024 + (ob ^ (((ob >> 9) & 1) << 5)); }
__host__ __device__ __forceinline__ void stage_rc(int b, int& R, int& C) { const int st = b / 1024, sb = b % 1024, swz = sb ^ (((sb >> 9) & 1) << 5); R = (st >> 1) * 16 + swz / 64; C = (st & 1) * 32 + (swz % 64) / 2; }
__host__ __device__ __forceinline__ int perm32(int rho) { const int n = rho >> 4, i = rho & 15; return 8 * (i >> 2) + 4 * n + (i & 3); }

struct Unit { int pm, pn, e; };
struct Gemm { const bf16* A; const bf16* Bt; int K; const unsigned* texp; size_t bstride; const int* rowtok; };

struct StaticOrder {
    int nM, nN, nwg, G, c;
    __device__ void init(int nM_, int nN_, int G_, int c_) { nM = nM_; nN = nN_; nwg = nM * nN; G = G_; c = c_; }
    __device__ bool next(int i, Unit& u) const {
        const long L = (long)i * G + c; if (L >= nwg) return false;
        int wgid = (int)L; { const int q = nwg / NXCD, r = nwg % NXCD, xcd = wgid % NXCD, off = wgid / NXCD; wgid = (xcd < r ? xcd * (q + 1) : r * (q + 1) + (xcd - r) * q) + off; }
        const int nig = WGM * nN, gid = wgid / nig, fm = gid * WGM, gsz = (nM - fm) < WGM ? (nM - fm) : WGM;
        u.pm = fm + ((wgid % nig) % gsz); u.pn = (wgid % nig) / gsz; u.e = 0; return true;
    }
};

__device__ __forceinline__ i32x8 cat8(const bf16x8 lo, const bf16x8 hi) { return __builtin_shufflevector(__builtin_bit_cast(i32x4, lo), __builtin_bit_cast(i32x4, hi), 0, 1, 2, 3, 4, 5, 6, 7); }
template <class Epi, bool ALIGN_EPI, bool SP2, bool GATHER = false, bool FP8 = false>
__device__ __forceinline__ void gemm_phase(LAS unsigned char* lds, const Gemm g, const StaticOrder& S, const Epi& E) {
    const int tid = threadIdx.x, wid = __builtin_amdgcn_readfirstlane(tid >> 6), lane = tid & 63, wr = wid >> 2, wc = wid & 3, fr = lane & 15, fq = lane >> 4;
    const int K = g.K, nt = K / BK;
    unsigned voffA[2], voffB[2];
#pragma unroll
    for (int i = 0; i < 2; ++i) { int R, C; stage_rc(tid * 16 + i * 8192, R, C); const int Rb = Epi::PERM ? ((R & ~31) + perm32(R & 31)) : R;
        voffA[i] = (unsigned)(R * K + C) * 2u; voffB[i] = (unsigned)(Rb * K + C) * 2u; }
    unsigned vC[2][2];
#define PG8_GROWS(u, dst) do { _Pragma("unroll") for (int h_ = 0; h_ < 2; ++h_) _Pragma("unroll") for (int i_ = 0; i_ < 2; ++i_) { int R_, C_; stage_rc(tid * 16 + i_ * 8192, R_, C_); \
        dst[h_][i_] = (unsigned)g.rowtok[(u).pm * BM + h_ * HALF + R_] * (unsigned)(K * 2) + (unsigned)(C_ * 2); } } while (0)
    const size_t kstep = (size_t)(BK * 2);
    const size_t hstep = (size_t)HALF * K * 2;
    const size_t tstep = 2 * hstep;
    const unsigned ldsw = (unsigned)wid * 1024u;
    const int aoff = lds_byte(wr * 64 + fr, fq * 8), boff = lds_byte(wc * 32 + fr, fq * 8);
#define PG8_SA(b, h) (((b) * 2 + (h)) * HTB)
#define PG8_SB(b, h) ((4 + (b) * 2 + (h)) * HTB)
#define PG8_STAGE(bufoff, gbase, voff) do { _Pragma("unroll") for (int _i = 0; _i < 2; ++_i) \
        __builtin_amdgcn_global_load_lds((const unsigned*)((const char*)(gbase) + (voff)[_i]), (LAS unsigned*)(lds + (bufoff) + ldsw + _i * 8192), 16, 0, 0); } while (0)
#define PG8_STAGE_A(bufoff, p, h, nx) do { if constexpr (GATHER) { PG8_STAGE(bufoff, p, vC[h]); } else PG8_STAGE(bufoff, (p) + (h) * hstep, voffA); } while (0)
#define PG8_LDA(dst, b, h) do { _Pragma("unroll") for (int m = 0; m < 4; ++m) _Pragma("unroll") for (int k = 0; k < 2; ++k) dst[m][k] = *(const LAS bf16x8*)(lds + PG8_SA(b, h) + aoff + m * 2048 + k * 1024); } while (0)
#define PG8_LDB(dst, b, h) do { _Pragma("unroll") for (int n = 0; n < 2; ++n) _Pragma("unroll") for (int k = 0; k < 2; ++k) dst[n][k] = *(const LAS bf16x8*)(lds + PG8_SB(b, h) + boff + n * 2048 + k * 1024); } while (0)
#define PG8_MMA(ai, bj, At, Bt) do { __builtin_amdgcn_s_setprio(1); \
        if constexpr (FP8) { _Pragma("unroll") for (int m = 0; m < 4; ++m) _Pragma("unroll") for (int n = 0; n < 2; ++n) \
            { const i32x8 b8_ = cat8(Bt[n][0], Bt[n][1]), a8_ = cat8(At[m][0], At[m][1]); asm volatile("v_mfma_f32_16x16x128_f8f6f4 %0, %1, %2, %0" : "+v"(acc[ai][bj][m][n]) : "v"(b8_), "v"(a8_)); } } \
        else { _Pragma("unroll") for (int m = 0; m < 4; ++m) _Pragma("unroll") for (int n = 0; n < 2; ++n) _Pragma("unroll") for (int k = 0; k < 2; ++k) \
            acc[ai][bj][m][n] = __builtin_amdgcn_mfma_f32_16x16x32_bf16(Bt[n][k], At[m][k], acc[ai][bj][m][n], 0, 0, 0); } \
        __builtin_amdgcn_s_setprio(0); } while (0)
#define PG8_WAIT_V(n) asm volatile("s_waitcnt vmcnt(" #n ")" ::: "memory")
#define PG8_WAIT_L(n) asm volatile("s_waitcnt lgkmcnt(" #n ")" ::: "memory")
#define PG8_BAR __builtin_amdgcn_s_barrier()
#define PG8_SCHED __builtin_amdgcn_sched_barrier(0)
#define PG8_UPTR(u, pa, pb) do { unsigned _e = g.texp ? ld_u32_agent(g.texp + (u).pm) : 0u; _e = (unsigned)__builtin_amdgcn_readfirstlane((int)_e); (u).e = (int)_e; \
        pa = GATHER ? (const char*)g.A : (const char*)g.A + (size_t)(u).pm * tstep; pb = (const char*)g.Bt + (size_t)_e * g.bstride + (size_t)(u).pn * tstep; } while (0)
    Unit cur, nxt; int ui = 0;
    if (!S.next(0, cur)) return;
    f32x4 acc[2][2][4][2];
#pragma unroll
    for (int a = 0; a < 2; ++a)
#pragma unroll
        for (int b = 0; b < 2; ++b)
#pragma unroll
            for (int m = 0; m < 4; ++m)
#pragma unroll
                for (int n = 0; n < 2; ++n) acc[a][b][m][n] = (f32x4){0.f, 0.f, 0.f, 0.f};
    bf16x8 At[4][2], B0[2][2], B1[2][2];
    const char* cA; const char* cB;
    PG8_UPTR(cur, cA, cB);
    if constexpr (GATHER) { PG8_GROWS(cur, vC); }
    if constexpr (SP2) {
        PG8_STAGE(PG8_SB(0, 0), cB, voffB); PG8_STAGE(PG8_SB(0, 1), cB + hstep, voffB); PG8_STAGE_A(PG8_SA(0, 0), cA, 0, false); PG8_STAGE_A(PG8_SA(0, 1), cA, 1, false);
        if (wr == 1) PG8_BAR;
        PG8_WAIT_V(2); PG8_BAR;
        PG8_STAGE(PG8_SB(1, 0), cB + kstep, voffB); PG8_STAGE_A(PG8_SA(1, 0), cA + kstep, 0, false); PG8_STAGE(PG8_SB(1, 1), cB + hstep + kstep, voffB);
        PG8_WAIT_V(6); PG8_BAR;
    } else {
        PG8_STAGE(PG8_SB(0, 0), cB, voffB); PG8_STAGE_A(PG8_SA(0, 0), cA, 0, false); PG8_STAGE(PG8_SB(0, 1), cB + hstep, voffB); PG8_STAGE_A(PG8_SA(0, 1), cA, 1, false);
        if (wr == 1) PG8_BAR;
        PG8_WAIT_V(4); PG8_BAR;
        PG8_STAGE(PG8_SB(1, 0), cB + kstep, voffB); PG8_STAGE_A(PG8_SA(1, 0), cA + kstep, 0, false); PG8_STAGE(PG8_SB(1, 1), cB + hstep + kstep, voffB);
        PG8_WAIT_V(6); PG8_BAR;
    }
    for (;;) {
        const bool has_next = S.next(ui + 1, nxt);
        const char* nA = cA; const char* nB = cB;
        if (has_next) PG8_UPTR(nxt, nA, nB);
#pragma unroll 1
        for (int t = 0; t < nt; t += 2) {
            const bool last = (t == nt - 2);
            const char* a1 = cA + (size_t)(t + 1) * kstep;
            const char* a2 = last ? nA : cA + (size_t)(t + 2) * kstep; const char* b2 = last ? nB : cB + (size_t)(t + 2) * kstep;
            const char* a3 = a2 + kstep; const char* b3 = b2 + kstep;
            if constexpr (SP2) {
            PG8_LDB(B0, 0, 0); PG8_LDB(B1, 0, 1); PG8_SCHED; PG8_LDA(At, 0, 0); PG8_STAGE_A(PG8_SA(1, 1), a1, 1, false);
            if constexpr (GATHER) { if (last && has_next) { PG8_GROWS(nxt, vC); } }
            PG8_WAIT_V(8); PG8_WAIT_L(0); PG8_BAR; PG8_MMA(0, 0, At, B0); PG8_MMA(0, 1, At, B1); PG8_BAR; PG8_SCHED;
            PG8_LDA(At, 0, 1); PG8_STAGE(PG8_SB(0, 0), b2, voffB); PG8_STAGE(PG8_SB(0, 1), b2 + hstep, voffB); PG8_STAGE_A(PG8_SA(0, 0), a2, 0, last);
            PG8_WAIT_V(8); PG8_WAIT_L(0); PG8_BAR; PG8_MMA(1, 0, At, B0); PG8_MMA(1, 1, At, B1); PG8_BAR; PG8_SCHED;
            PG8_LDB(B0, 1, 0); PG8_LDB(B1, 1, 1); PG8_SCHED; PG8_LDA(At, 1, 0); PG8_STAGE_A(PG8_SA(0, 1), a2, 1, last);
            PG8_WAIT_V(8); PG8_WAIT_L(0); PG8_BAR; PG8_MMA(0, 0, At, B0); PG8_MMA(0, 1, At, B1); PG8_BAR; PG8_SCHED;
            PG8_LDA(At, 1, 1); PG8_STAGE(PG8_SB(1, 0), b3, voffB); PG8_STAGE(PG8_SB(1, 1), b3 + hstep, voffB); PG8_STAGE_A(PG8_SA(1, 0), a3, 0, last);
            PG8_WAIT_V(8); PG8_WAIT_L(0); PG8_BAR; PG8_MMA(1, 0, At, B0); PG8_MMA(1, 1, At, B1); PG8_BAR; PG8_SCHED;
            } else {
            PG8_LDB(B0, 0, 0); PG8_SCHED; PG8_LDA(At, 0, 0); PG8_STAGE_A(PG8_SA(1, 1), a1, 1, false);
            if constexpr (GATHER) { if (last && has_next) { PG8_GROWS(nxt, vC); } }
            PG8_WAIT_L(8); PG8_BAR; PG8_WAIT_L(0); PG8_MMA(0, 0, At, B0); PG8_BAR; PG8_SCHED;
            PG8_LDB(B1, 0, 1); PG8_STAGE(PG8_SB(0, 0), b2, voffB);
            PG8_BAR; PG8_WAIT_L(0); PG8_MMA(0, 1, At, B1); PG8_BAR;
            PG8_LDA(At, 0, 1); PG8_STAGE_A(PG8_SA(0, 0), a2, 0, last);
            PG8_BAR; PG8_WAIT_L(0); PG8_MMA(1, 0, At, B0); PG8_BAR; PG8_SCHED;
            PG8_STAGE(PG8_SB(0, 1), b2 + hstep, voffB);
            PG8_WAIT_V(6); PG8_BAR; PG8_MMA(1, 1, At, B1); PG8_BAR;
            PG8_LDB(B0, 1, 0); PG8_SCHED; PG8_LDA(At, 1, 0); PG8_STAGE_A(PG8_SA(0, 1), a2, 1, last);
            PG8_WAIT_L(8); PG8_BAR; PG8_WAIT_L(0); PG8_MMA(0, 0, At, B0); PG8_BAR; PG8_SCHED;
            PG8_LDB(B1, 1, 1); PG8_STAGE(PG8_SB(1, 0), b3, voffB);
            PG8_BAR; PG8_WAIT_L(0); PG8_MMA(0, 1, At, B1); PG8_BAR;
            PG8_LDA(At, 1, 1); PG8_STAGE_A(PG8_SA(1, 0), a3, 0, last);
            PG8_BAR; PG8_WAIT_L(0); PG8_MMA(1, 0, At, B0); PG8_BAR; PG8_SCHED;
            PG8_STAGE(PG8_SB(1, 1), b3 + hstep, voffB);
            PG8_WAIT_V(6); PG8_BAR; PG8_MMA(1, 1, At, B1); PG8_BAR;
            }
        }
        if constexpr (ALIGN_EPI) { if (wr == 0) PG8_BAR; }
        if constexpr (FP8) { asm volatile("s_nop 15\n\ts_nop 15" ::: "memory"); PG8_SCHED; }
        E(acc, cur, wr, wc, fr, fq);
        if (!has_next) break;
#pragma unroll
        for (int a = 0; a < 2; ++a)
#pragma unroll
            for (int b = 0; b < 2; ++b)
#pragma unroll
                for (int m = 0; m < 4; ++m)
#pragma unroll
                    for (int n = 0; n < 2; ++n) acc[a][b][m][n] = (f32x4){0.f, 0.f, 0.f, 0.f};
        cur = nxt; cA = nA; cB = nB; ++ui;
        if constexpr (ALIGN_EPI) { if (wr == 1) PG8_BAR; }
    }
    PG8_WAIT_V(0);
    if constexpr (!ALIGN_EPI) { if (wr == 0) PG8_BAR; }
    PG8_BAR;
#undef PG8_SA
#undef PG8_SB
#undef PG8_STAGE
#undef PG8_LDA
#undef PG8_LDB
#undef PG8_MMA
#undef PG8_WAIT_V
#undef PG8_WAIT_L
#undef PG8_BAR
#undef PG8_SCHED
#undef PG8_UPTR
#undef PG8_STAGE_A
#undef PG8_GROWS
}

struct EpiProj {
    static constexpr bool PERM = true;
    bf16 *q, *k, *vT, *p;
    __device__ __forceinline__ void operator()(const f32x4 (&acc)[2][2][4][2], const Unit& u, int wr, int wc, int fr, int fq) const {
        const int row0 = u.pm * BM + wr * 64 + fr;
        const int pn = u.pn;
#pragma unroll
        for (int ai = 0; ai < 2; ++ai)
#pragma unroll
            for (int m = 0; m < 4; ++m) {
                const int row = row0 + ai * HALF + m * 16;
#pragma unroll
                for (int bj = 0; bj < 2; ++bj) {
                    f32x4 v0 = acc[ai][bj][m][0], v1 = acc[ai][bj][m][1];
                    const int col = pn * BM + bj * HALF + wc * 32 + 8 * fq;
                    if (pn >= 4 && pn < 6) {
                        const int cv = col - 1024, hh = cv >> 6, dim = cv & 63, b = row / T, t = row % T;
                        bf16* dst = vT + ((size_t)(((b * NH + hh) * GROWS + (t >> 6)) * HD + dim)) * 64 + (t & 63);
                        const unsigned w0 = cvt_pk_bf16(v0[0], v0[1]), w1 = cvt_pk_bf16(v0[2], v0[3]), w2 = cvt_pk_bf16(v1[0], v1[1]), w3 = cvt_pk_bf16(v1[2], v1[3]);
                        dst[0 * 64] = (bf16)(w0 & 0xffff); dst[1 * 64] = (bf16)(w0 >> 16); dst[2 * 64] = (bf16)(w1 & 0xffff); dst[3 * 64] = (bf16)(w1 >> 16);
                        dst[4 * 64] = (bf16)(w2 & 0xffff); dst[5 * 64] = (bf16)(w2 >> 16); dst[6 * 64] = (bf16)(w3 & 0xffff); dst[7 * 64] = (bf16)(w3 >> 16);
                    } else {
                        bf16* dst;
                        if (pn < 2) { v0 = v0 * 0.125f; v1 = v1 * 0.125f; dst = q + (size_t)row * CW + col; }
                        else if (pn < 4) dst = k + (size_t)row * CW + (col - 512);
                        else dst = p + (size_t)row * PW + (col - 1536);
                        u32x4 w; w.x = cvt_pk_bf16(v0[0], v0[1]); w.y = cvt_pk_bf16(v0[2], v0[3]); w.z = cvt_pk_bf16(v1[0], v1[1]); w.w = cvt_pk_bf16(v1[2], v1[3]);
                        *(u32x4*)dst = w;
                    }
                }
            }
    }
};
struct EpiWo {
    static constexpr bool PERM = true;
    const float* x; bf16* h;
    __device__ __forceinline__ void operator()(const f32x4 (&acc)[2][2][4][2], const Unit& u, int wr, int wc, int fr, int fq) const {
        const int row0 = u.pm * BM + wr * 64 + fr, col0 = u.pn * BM + wc * 32 + 8 * fq;
#pragma unroll
        for (int ai = 0; ai < 2; ++ai)
#pragma unroll
            for (int m = 0; m < 4; ++m) { const size_t off = (size_t)(row0 + ai * HALF + m * 16) * D + col0;
#pragma unroll
                for (int bj = 0; bj < 2; ++bj) { const f32x4 v0 = acc[ai][bj][m][0] + *(const f32x4*)(x + off + bj * HALF), v1 = acc[ai][bj][m][1] + *(const f32x4*)(x + off + bj * HALF + 4);
                    u32x4 w; w.x = cvt_pk_bf16(v0[0], v0[1]); w.y = cvt_pk_bf16(v0[2], v0[3]); w.z = cvt_pk_bf16(v1[0], v1[1]); w.w = cvt_pk_bf16(v1[2], v1[3]);
                    *(u32x4*)(h + off + bj * HALF) = w; } }
    }
};
struct EpiUp {
    static constexpr bool PERM = true;
    const float* b_up; unsigned char* act;
    __device__ __forceinline__ void operator()(const f32x4 (&acc)[2][2][4][2], const Unit& u, int wr, int wc, int fr, int fq) const {
        const int row0 = u.pm * BM + wr * 64 + fr, ch = u.pn * 128 + wc * 32 + 8 * fq;
        const float* bg = b_up + (size_t)u.e * 2048 + ch; const float* bl = bg + 1024;
        const f32x4 bg0 = *(const f32x4*)bg * F8_SACT, bg1 = *(const f32x4*)(bg + 4) * F8_SACT, bl0 = *(const f32x4*)bl, bl1 = *(const f32x4*)(bl + 4);
        constexpr float SG = F8_SACT / (F8_SX * F8_SW), SL = 1.0f / (F8_SX * F8_SW), KE = -1.702f * 1.44269504f / F8_SACT;
#pragma unroll
        for (int ai = 0; ai < 2; ++ai)
#pragma unroll
            for (int m = 0; m < 4; ++m) {
                float o[8];
#pragma unroll
                for (int n = 0; n < 2; ++n) { const f32x4 gv = acc[ai][0][m][n] * SG + (n ? bg1 : bg0), lv = acc[ai][1][m][n] * SL + (n ? bl1 : bl0);
#pragma unroll
                    for (int j = 0; j < 4; ++j) { const float gt = fminf(gv[j], 7.0f * F8_SACT), li = __builtin_amdgcn_fmed3f(lv[j], -7.0f, 7.0f);
                        const float t = gt * __builtin_amdgcn_rcpf(1.0f + __builtin_amdgcn_exp2f(gt * KE)); o[n * 4 + j] = __builtin_fmaf(li, t, t); } }
                int w0 = 0, w1 = 0;
                w0 = __builtin_amdgcn_cvt_pk_fp8_f32(o[0], o[1], w0, false); w0 = __builtin_amdgcn_cvt_pk_fp8_f32(o[2], o[3], w0, true);
                w1 = __builtin_amdgcn_cvt_pk_fp8_f32(o[4], o[5], w1, false); w1 = __builtin_amdgcn_cvt_pk_fp8_f32(o[6], o[7], w1, true);
                u32x2 w8; w8.x = (unsigned)w0; w8.y = (unsigned)w1;
                *(u32x2*)(act + (size_t)(row0 + ai * HALF + m * 16) * DE + ch) = w8;
            }
    }
};
struct EpiDown {
    static constexpr bool PERM = true;
    const float* b_dn; bf16* y;
    __device__ __forceinline__ void operator()(const f32x4 (&acc)[2][2][4][2], const Unit& u, int wr, int wc, int fr, int fq) const {
        const int row0 = u.pm * BM + wr * 64 + fr, col0 = u.pn * BM + wc * 32 + 8 * fq;
        const float* bb = b_dn + (size_t)u.e * D + col0;
        f32x4 bv[2][2];
#pragma unroll
        for (int bj = 0; bj < 2; ++bj)
#pragma unroll
            for (int n = 0; n < 2; ++n) bv[bj][n] = *(const f32x4*)(bb + bj * HALF + 4 * n);
#pragma unroll
        for (int ai = 0; ai < 2; ++ai)
#pragma unroll
            for (int m = 0; m < 4; ++m) { bf16* rowp = y + (size_t)(row0 + ai * HALF + m * 16) * D + col0;
#pragma unroll
                for (int bj = 0; bj < 2; ++bj) { const f32x4 v0 = acc[ai][bj][m][0] * (1.0f / (F8_SACT * F8_SW)) + bv[bj][0], v1 = acc[ai][bj][m][1] * (1.0f / (F8_SACT * F8_SW)) + bv[bj][1];
                    u32x4 w; w.x = cvt_pk_bf16(v0[0], v0[1]); w.y = cvt_pk_bf16(v0[2], v0[3]); w.z = cvt_pk_bf16(v1[0], v1[1]); w.w = cvt_pk_bf16(v1[2], v1[3]);
                    *(u32x4*)(rowp + bj * HALF) = w; } }
    }
};
}


#define XB_TMO      128
#define XB_XCNT(j)  (256  + 64 * (j))
#define XB_XSUB(j)  (1280 + 64 * (j))
#define XB_XGEN(j)  (2304 + 64 * (j))
#define XB_TOP      3328
#define XB_TOPGEN   3392
#define XCD_BAR_WORDS 3456
#define XB_SPIN_CAP (1u << 20)
__device__ __forceinline__ unsigned xb_ld(unsigned* p)              { return __hip_atomic_load(p, __ATOMIC_RELAXED, __HIP_MEMORY_SCOPE_AGENT); }
__device__ __forceinline__ unsigned xb_add(unsigned* p, unsigned v) { return __hip_atomic_fetch_add(p, v, __ATOMIC_RELAXED, __HIP_MEMORY_SCOPE_AGENT); }
__device__ __forceinline__ unsigned xb_xcc_id() { return (unsigned)__builtin_amdgcn_s_getreg((3 << 11) | 20) & 0xFu; }
#define XB_SPIN(cond, bar) do { unsigned _sp = 0; while (cond) { __builtin_amdgcn_s_sleep(1); \
    if ((++_sp & 255u) == 0u) { if (xb_ld(&(bar)[XB_TMO])) break; if (_sp > XB_SPIN_CAP) { atomicAdd(&(bar)[XB_TMO], 1u); break; } } } } while (0)
struct XcdBarrier { unsigned* bar; unsigned x; volatile LAS unsigned* st; };
__device__ __forceinline__ XcdBarrier xcd_barrier_post(unsigned* bar, volatile LAS unsigned* st) {
    XcdBarrier b; b.bar = bar; b.x = xb_xcc_id(); b.st = st;
    if (threadIdx.x == 0) (void)xb_add(&bar[XB_XCNT(b.x)], 1u);
    return b;
}
__device__ __forceinline__ void xcd_barrier_complete(unsigned* bar, unsigned x, unsigned& nloc, unsigned& nx) {
    const unsigned G = gridDim.x * gridDim.y * gridDim.z;
    unsigned sum, cnt, mine, sp = 0u;
    for (;;) {
        sum = 0u; cnt = 0u; mine = 0u;
#pragma unroll
        for (unsigned j = 0; j < 16; ++j) { const unsigned c = xb_ld(&bar[XB_XCNT(j)]); sum += c; cnt += (c > 0u) ? 1u : 0u; mine = (j == x) ? c : mine; }
        if (sum == G) break;
        __builtin_amdgcn_s_sleep(1);
        if ((++sp & 255u) == 0u) { if (xb_ld(&bar[XB_TMO])) break; if (sp > XB_SPIN_CAP) { atomicAdd(&bar[XB_TMO], 1u); break; } }
    }
    nloc = mine > 0u ? mine : 1u; nx = cnt > 0u ? cnt : 1u;
}
__device__ __forceinline__ void xcd_barrier(const XcdBarrier& b) {
    asm volatile("s_waitcnt vmcnt(0)" ::: "memory");
    __syncthreads();
    if (threadIdx.x == 0) {
        unsigned* bar = b.bar;
        __builtin_amdgcn_s_waitcnt(0);
        unsigned nloc = b.st[0], nx = b.st[1];
        if (nloc == 0u) { xcd_barrier_complete(bar, b.x, nloc, nx); b.st[0] = nloc; b.st[1] = nx; }
        const unsigned old = xb_add(&bar[XB_XSUB(b.x)], 1u);
        const unsigned gen = old / nloc;
        if (old + 1u == (gen + 1u) * nloc) {
            __builtin_amdgcn_fence(__ATOMIC_RELEASE, "agent");
            asm volatile("s_waitcnt vmcnt(0)" ::: "memory");
            const unsigned og = xb_add(&bar[XB_TOP], 1u);
            const unsigned tg = og / nx;
            if (og + 1u == (tg + 1u) * nx) xb_add(&bar[XB_TOPGEN], 1u);
            else XB_SPIN(xb_ld(&bar[XB_TOPGEN]) == tg, bar);
            __builtin_amdgcn_fence(__ATOMIC_ACQUIRE, "agent");
            xb_add(&bar[XB_XGEN(b.x)], 1u);
            asm volatile("s_waitcnt vmcnt(0)" ::: "memory");
        } else {
            XB_SPIN(xb_ld(&bar[XB_XGEN(b.x)]) == gen, bar);
            __builtin_amdgcn_fence(__ATOMIC_ACQUIRE, "agent");
            asm volatile("s_waitcnt vmcnt(0)" ::: "memory");
        }
    }
    __syncthreads();
}

struct Args { const float* in[26]; float* out; unsigned char* ws; int ph_lo, ph_hi; };

struct Frame { LAS unsigned char* lds; int tid, lane, wave, G, vcu; };

__device__ __forceinline__ void transpose_item(const float* W, int K, int N, bf16* WT, int k0, int n0, int orow0, LAS float* scr, int lane) {
#pragma unroll 8
    for (int i = 0; i < 32; ++i) { const int kk = 2 * i + (lane >> 5); scr[kk * 33 + (lane & 31)] = W[(size_t)(k0 + kk) * N + n0 + (lane & 31)]; }
    asm volatile("s_waitcnt lgkmcnt(0)" ::: "memory");
    const int c = lane & 7;
#pragma unroll
    for (int j = 0; j < 4; ++j) { const int n = (lane >> 3) + 8 * j; const LAS float* s = scr + (8 * c) * 33 + n;
        u32x4 o; o.x = cvt_pk_bf16(s[0 * 33], s[1 * 33]); o.y = cvt_pk_bf16(s[2 * 33], s[3 * 33]); o.z = cvt_pk_bf16(s[4 * 33], s[5 * 33]); o.w = cvt_pk_bf16(s[6 * 33], s[7 * 33]);
        *(u32x4*)(WT + (size_t)(orow0 + n) * K + k0 + 8 * c) = o; }
    asm volatile("s_waitcnt lgkmcnt(0)" ::: "memory");
}

__device__ __forceinline__ void transpose_item8(const float* W, int K, int N, unsigned char* WT, int k0, int n0, int orow0, LAS float* scr, int lane) {
#pragma unroll 8
    for (int i = 0; i < 32; ++i) { const int kk = 2 * i + (lane >> 5); scr[kk * 33 + (lane & 31)] = W[(size_t)(k0 + kk) * N + n0 + (lane & 31)]; }
    asm volatile("s_waitcnt lgkmcnt(0)" ::: "memory");
    const int c = lane & 7;
#pragma unroll
    for (int j = 0; j < 4; ++j) { const int n = (lane >> 3) + 8 * j; const LAS float* s = scr + (8 * c) * 33 + n;
        u32x2 o; o.x = pk4_fp8(s[0 * 33] * F8_SW, s[1 * 33] * F8_SW, s[2 * 33] * F8_SW, s[3 * 33] * F8_SW); o.y = pk4_fp8(s[4 * 33] * F8_SW, s[5 * 33] * F8_SW, s[6 * 33] * F8_SW, s[7 * 33] * F8_SW);
        *(u32x2*)(WT + (size_t)(orow0 + n) * K + k0 + 8 * c) = o; }
    asm volatile("s_waitcnt lgkmcnt(0)" ::: "memory");
}

__device__ __forceinline__ void p0_prologue(const Frame& F, const Args& a) {
    unsigned char* ws = a.ws;
    LAS float* scr = (LAS float*)(F.lds + F.wave * 8448);
    const int gw = F.vcu * 8 + F.wave, NGW = F.G * 8;
    constexpr int I_IN = 16 * 108, I_O = 16 * 32, I_UP = 32 * 16 * 64, I_DN = 32 * 16 * 32, I_L = 16, I_G = 32;
    constexpr int NITEMS = I_IN + I_O + I_UP + I_DN + 2 * I_L + 2 * I_L + I_G;
    for (int it = gw; it < NITEMS; it += NGW) {
        int r = it;
        if (r < I_UP) {
            const int e = r / 1024, q = r % 1024, kb = q / 64, nb = q % 64, n0 = nb * 32;
            const int orow0 = n0 < 1024 ? 256 * (n0 >> 7) + (n0 & 127) : 256 * ((n0 - 1024) >> 7) + 128 + ((n0 - 1024) & 127);
            transpose_item8(a.in[21] + (size_t)e * 1024 * 2048, 1024, 2048, ws + WS_WUPT + (size_t)e * 2048 * 1024, kb * 64, n0, orow0, scr, F.lane); continue; }
        r -= I_UP;
        if (r < I_DN) { const int e = r / 512, q = r % 512, kb = q / 32, nb = q % 32;
            transpose_item8(a.in[23] + (size_t)e * 1024 * 1024, 1024, 1024, ws + WS_WDNT + (size_t)e * 1024 * 1024, kb * 64, nb * 32, nb * 32, scr, F.lane); continue; }
        r -= I_DN;
        if (r < I_IN) { const int kb = r / 108, nb = r % 108; transpose_item(a.in[2], 1024, NPROJ, (bf16*)(ws + WS_WINT), kb * 64, nb * 32, nb * 32, scr, F.lane); continue; }
        r -= I_IN;
        if (r < I_O) { const int kb = r / 32, nb = r % 32; transpose_item(a.in[17], 1024, 1024, (bf16*)(ws + WS_WOT), kb * 64, nb * 32, nb * 32, scr, F.lane); continue; }
        r -= I_O;
        if (r < 2 * I_L) { const int z = r / 16, nb = r % 16; transpose_item(a.in[8] + (size_t)z * 64 * 512, 64, 512, (bf16*)(ws + WS_W2T) + (size_t)z * 512 * 64, 0, nb * 32, nb * 32, scr, F.lane); continue; }
        r -= 2 * I_L;
        if (r < 2 * I_L) { const int z = r / 16, nb = r % 16; transpose_item(a.in[10] + (size_t)z * 64 * 512, 64, 512, (bf16*)(ws + WS_A2T) + (size_t)z * 512 * 64, 0, nb * 32, nb * 32, scr, F.lane); continue; }
        r -= 2 * I_L;
        { const int kb = r / 16, nb = r % 16; transpose_item(a.in[11], 128, 512, (bf16*)(ws + WS_G2T), kb * 64, nb * 32, nb * 32, scr, F.lane); }
    }
    { u32x4* z = (u32x4*)(ws + WS_WINT + (size_t)NPROJ * 1024 * 2); const u32x4 zero = {0u, 0u, 0u, 0u};
      for (int i = F.vcu * 512 + F.tid; i < 16384; i += F.G * 512) z[i] = zero; }
    const float* x = a.in[0]; const float* nw = a.in[1]; bf16* hn = (bf16*)(ws + WS_HN);
    f32x4 wv[4];
#pragma unroll
    for (int j = 0; j < 4; ++j) wv[j] = *((const f32x4*)nw + F.lane + 64 * j);
    for (int m = gw; m < M; m += 2 * NGW) {
        const int m1 = m + NGW; const bool has1 = m1 < M;
        const f32x4* xr0 = (const f32x4*)(x + (size_t)m * D) + F.lane; const f32x4* xr1 = (const f32x4*)(x + (size_t)(has1 ? m1 : m) * D) + F.lane;
        f32x4 v0[4], v1[4]; float s0 = 0.f, s1 = 0.f;
#pragma unroll
        for (int j = 0; j < 4; ++j) { v0[j] = xr0[64 * j]; v1[j] = xr1[64 * j]; }
#pragma unroll
        for (int j = 0; j < 4; ++j) { s0 += (v0[j].x * v0[j].x + v0[j].y * v0[j].y) + (v0[j].z * v0[j].z + v0[j].w * v0[j].w); s1 += (v1[j].x * v1[j].x + v1[j].y * v1[j].y) + (v1[j].z * v1[j].z + v1[j].w * v1[j].w); }
        const float rs0 = rsqrtf(wave_sum(s0) * (1.f / D) + RMS_EPS), rs1 = rsqrtf(wave_sum(s1) * (1.f / D) + RMS_EPS);
        u32x2* o0 = (u32x2*)(hn + (size_t)m * D) + F.lane; u32x2* o1 = (u32x2*)(hn + (size_t)m1 * D) + F.lane;
#pragma unroll
        for (int j = 0; j < 4; ++j) { u32x2 o; o.x = cvt_pk_bf16(v0[j].x * rs0 * wv[j].x, v0[j].y * rs0 * wv[j].y); o.y = cvt_pk_bf16(v0[j].z * rs0 * wv[j].z, v0[j].w * rs0 * wv[j].w); o0[64 * j] = o; }
        if (has1) {
#pragma unroll
            for (int j = 0; j < 4; ++j) { u32x2 o; o.x = cvt_pk_bf16(v1[j].x * rs1 * wv[j].x, v1[j].y * rs1 * wv[j].y); o.y = cvt_pk_bf16(v1[j].z * rs1 * wv[j].z, v1[j].w * rs1 * wv[j].w); o1[64 * j] = o; } }
    }
}

constexpr int PREP_KBUF = 0, PREP_INV = 65536, PREP_AW = 67584, PREP_AA = PREP_AW + 17408, PREP_AG = PREP_AA + 17408, PREP_LD = 136;
template <bool STORE>
__device__ __forceinline__ void prep_phase(const Frame& F, const Args& a) {
    unsigned char* ws = a.ws;
    const bf16* p = (const bf16*)(ws + WS_P);
    bf16* r_out = (bf16*)(ws + WS_R); bf16* v_out = (bf16*)(ws + WS_V); bf16* kk_out = (bf16*)(ws + WS_KK);
    bf16* decay_out = (bf16*)(ws + WS_DECAY); bf16* kdir_out = (bf16*)(ws + WS_KDIR); bf16* akk_out = (bf16*)(ws + WS_AKK); bf16* g_out = (bf16*)(ws + WS_G);
    const bf16* w2T = (const bf16*)(ws + WS_W2T); const bf16* a2T = (const bf16*)(ws + WS_A2T); const bf16* g2T = (const bf16*)(ws + WS_G2T);
    const float* mu_p = a.in[5]; const float* mu_n = a.in[6]; const float* w0 = a.in[7]; const float* a0 = a.in[9];
    const float* k_k = a.in[12]; const float* k_a = a.in[13];
    LAS bf16* kbuf = (LAS bf16*)(F.lds + PREP_KBUF); LAS float* invb = (LAS float*)(F.lds + PREP_INV);
    LAS bf16* Aw = (LAS bf16*)(F.lds + PREP_AW); LAS bf16* Aa = (LAS bf16*)(F.lds + PREP_AA); LAS bf16* Ag = (LAS bf16*)(F.lds + PREP_AG);
    const int lane = F.lane, wave = F.wave, fr = lane & 15, fg = lane >> 4;
    for (int tile = F.vcu; tile < M / 64; tile += F.G) {
        const int m0 = tile * 64;
#pragma unroll 1
        for (int jj = 0; jj < 4; ++jj) {
            const int q = lane + 64 * jj; const bool valid = q < 240; const int c0 = 8 * q;
            float mp[8], mn[8];
#pragma unroll
            for (int i = 0; i < 8; ++i) { mp[i] = valid ? mu_p[c0 + i] : 0.f; mn[i] = valid ? mu_n[c0 + i] : 0.f; }
            const int mfirst = m0 + wave * 8;
            const u32x4 zero = {0u, 0u, 0u, 0u};
            u32x4 rows[10];
#pragma unroll
            for (int rI = 0; rI < 10; ++rI) { const int mr = mfirst - 1 + rI;
                const bool ok = valid && !(rI == 0 && (mfirst % T) == 0) && !(rI == 9 && ((mfirst + 7) % T) == T - 1);
                rows[rI] = ok ? *(const u32x4*)(p + (size_t)mr * PW + c0) : zero; }
#pragma unroll
            for (int i = 0; i < 8; ++i) {
                const int m = mfirst + i, it = wave * 8 + i;
                const u32x4 prev = rows[i], cur = rows[i + 1], nxt = rows[i + 2];
                float fp[8], fc[8], fn[8], s[8];
                unpack8(prev, fp); unpack8(cur, fc); unpack8(nxt, fn);
#pragma unroll
                for (int e = 0; e < 8; ++e) s[e] = fc[e] + mp[e] * (fp[e] - fc[e]) + mn[e] * (fn[e] - fc[e]);
                if (jj == 0) { if (STORE) { *(u32x4*)(r_out + (size_t)m * CW + c0) = pack8(s); } }
                else if (jj == 1) {
                    const int c = c0 - 512;
                    *(LAS u32x4*)(kbuf + it * 512 + c) = pack8(s);
                    float kr[8]; float ss = 0.f;
#pragma unroll
                    for (int e = 0; e < 8; ++e) { kr[e] = s[e] * k_k[c + e]; ss += kr[e] * kr[e]; }
                    ss += __shfl_xor(ss, 1); ss += __shfl_xor(ss, 2); ss += __shfl_xor(ss, 4);
                    const float inv = fminf(__builtin_amdgcn_rsqf(ss), 1e12f);
#pragma unroll
                    for (int e = 0; e < 8; ++e) kr[e] *= inv;
                    if (STORE) { *(u32x4*)(kk_out + (size_t)m * CW + c) = pack8(kr); }
                    if ((lane & 7) == 0) invb[it * 8 + (lane >> 3)] = inv;
                }
                else if (jj == 2) { if (STORE) { *(u32x4*)(v_out + (size_t)m * CW + (c0 - 1024)) = pack8(s); } }
                else if (valid) {
                    const int seg = lane >> 4, cw = 8 * (lane & 15);
                    if (seg == 0) {
#pragma unroll
                        for (int e = 0; e < 8; ++e) s[e] = 1.0f - 2.0f * __builtin_amdgcn_rcpf(__expf(2.0f * s[e]) + 1.0f);
                        *(LAS u32x4*)(Aw + it * PREP_LD + cw) = pack8(s);
                    } else if (seg == 1) { *(LAS u32x4*)(Aa + it * PREP_LD + cw) = pack8(s); }
                    else {
#pragma unroll
                        for (int e = 0; e < 8; ++e) s[e] = sigmoidf_(s[e]);
                        *(LAS u32x4*)(Ag + it * PREP_LD + cw) = pack8(s);
                    }
                }
            }
        }
        __syncthreads();
        const int nb = 64 * wave;
#define PREP_PROW(nt_) (nb + 32 * ((nt_) >> 1) + 8 * (fr >> 2) + 4 * ((nt_) & 1) + (fr & 3))
#define PREP_COL(nt_)  (nb + 32 * ((nt_) >> 1) + 8 * fg + 4 * ((nt_) & 1))
#pragma unroll 1
        for (int job = 0; job < 4; ++job) {
            const int z = job & 1;
            const bf16* WT = job < 2 ? w2T + (size_t)z * 512 * 64 : a2T + (size_t)z * 512 * 64;
            const LAS bf16* Ax = job < 2 ? Aw + z * 64 : Aa + z * 64;
            bf16x8 wf[2][4];
#pragma unroll
            for (int ks = 0; ks < 2; ++ks)
#pragma unroll
                for (int nt = 0; nt < 4; ++nt) wf[ks][nt] = *(const bf16x8*)(WT + (size_t)PREP_PROW(nt) * 64 + 32 * ks + 8 * fg);
            f32x4 pb[4], pkk[4], pka[4];
#pragma unroll
            for (int nt = 0; nt < 4; ++nt) { const int n = PREP_COL(nt);
                pb[nt] = *(const f32x4*)((job < 2 ? w0 : a0) + z * 512 + n); pkk[nt] = *(const f32x4*)(k_k + n); pka[nt] = *(const f32x4*)(k_a + n); }
            f32x4 acc[4][4];
#pragma unroll
            for (int mt = 0; mt < 4; ++mt)
#pragma unroll
                for (int nt = 0; nt < 4; ++nt) acc[mt][nt] = (f32x4){0.f, 0.f, 0.f, 0.f};
#pragma unroll
            for (int ks = 0; ks < 2; ++ks) {
                bf16x8 af[4];
#pragma unroll
                for (int mt = 0; mt < 4; ++mt) af[mt] = *(const LAS bf16x8*)(Ax + (16 * mt + fr) * PREP_LD + 32 * ks + 8 * fg);
#pragma unroll
                for (int mt = 0; mt < 4; ++mt)
#pragma unroll
                    for (int nt = 0; nt < 4; ++nt) acc[mt][nt] = __builtin_amdgcn_mfma_f32_16x16x32_bf16(wf[ks][nt], af[mt], acc[mt][nt], 0, 0, 0);
            }
#pragma unroll
            for (int mt = 0; mt < 4; ++mt) {
                const int it = 16 * mt + fr; const size_t m = (size_t)(m0 + it);
#pragma unroll
                for (int np = 0; np < 2; ++np) {
                    const int c8 = nb + 32 * np + 8 * fg;
                    if (job < 2) {
                        float o[8];
#pragma unroll
                        for (int hh = 0; hh < 2; ++hh) { const f32x4 v = acc[mt][2 * np + hh], bq = pb[2 * np + hh];
#pragma unroll
                            for (int i = 0; i < 4; ++i) o[4 * hh + i] = __expf(-0.60653066f * sigmoidf_(v[i] + bq[i])); }
                        if (STORE) { *(u32x4*)(decay_out + ((size_t)z * M + m) * CW + c8) = pack8(o); }
                    } else {
                        const u32x4 kb = *(const LAS u32x4*)(kbuf + it * 512 + c8);
                        float kv[8]; unpack8(kb, kv);
                        const float inv = invb[it * 8 + wave];
                        float kd[8], ak[8];
#pragma unroll
                        for (int hh = 0; hh < 2; ++hh) { const f32x4 v = acc[mt][2 * np + hh], bq = pb[2 * np + hh], kkc = pkk[2 * np + hh], kac = pka[2 * np + hh];
#pragma unroll
                            for (int i = 0; i < 4; ++i) { const float av = sigmoidf_(v[i] + bq[i]), kx = kv[4 * hh + i]; kd[4 * hh + i] = kx * (1.0f + (av - 1.0f) * kac[i]); ak[4 * hh + i] = av * (kx * kkc[i] * inv); } }
                        if (STORE) { *(u32x4*)(kdir_out + ((size_t)z * M + m) * CW + c8) = pack8(kd); *(u32x4*)(akk_out + ((size_t)z * M + m) * CW + c8) = pack8(ak); }
                    }
                }
            }
        }
        {
            bf16x8 wf[4][4];
#pragma unroll
            for (int ks = 0; ks < 4; ++ks)
#pragma unroll
                for (int nt = 0; nt < 4; ++nt) wf[ks][nt] = *(const bf16x8*)(g2T + (size_t)PREP_PROW(nt) * 128 + 32 * ks + 8 * fg);
            f32x4 acc[4][4];
#pragma unroll
            for (int mt = 0; mt < 4; ++mt)
#pragma unroll
                for (int nt = 0; nt < 4; ++nt) acc[mt][nt] = (f32x4){0.f, 0.f, 0.f, 0.f};
#pragma unroll
            for (int ks = 0; ks < 4; ++ks) {
                bf16x8 af[4];
#pragma unroll
                for (int mt = 0; mt < 4; ++mt) af[mt] = *(const LAS bf16x8*)(Ag + (16 * mt + fr) * PREP_LD + 32 * ks + 8 * fg);
#pragma unroll
                for (int mt = 0; mt < 4; ++mt)
#pragma unroll
                    for (int nt = 0; nt < 4; ++nt) acc[mt][nt] = __builtin_amdgcn_mfma_f32_16x16x32_bf16(wf[ks][nt], af[mt], acc[mt][nt], 0, 0, 0);
            }
#pragma unroll
            for (int mt = 0; mt < 4; ++mt) { const size_t m = (size_t)(m0 + 16 * mt + fr);
#pragma unroll
                for (int np = 0; np < 2; ++np) { const f32x4 v0 = acc[mt][2 * np], v1 = acc[mt][2 * np + 1];
                    u32x4 w; w.x = cvt_pk_bf16(v0[0], v0[1]); w.y = cvt_pk_bf16(v0[2], v0[3]); w.z = cvt_pk_bf16(v1[0], v1[1]); w.w = cvt_pk_bf16(v1[2], v1[3]);
                    if (STORE) { *(u32x4*)(g_out + m * CW + nb + 32 * np + 8 * fg) = w; } } }
        }
#undef PREP_PROW
#undef PREP_COL
        __syncthreads();
    }
}

__device__ __forceinline__ void attn_phase(const Frame& F, const Args& a) {
    unsigned char* ws = a.ws;
    const bf16* q = (const bf16*)(ws + WS_Q); const bf16* k = (const bf16*)(ws + WS_K); const bf16* vT = (const bf16*)(ws + WS_VT);
    bf16* att = (bf16*)(ws + WS_ATT);
    LAS float* bias = (LAS float*)F.lds;
    for (int i = F.tid; i < 8 * 15 * 31; i += 512) bias[i] = a.in[3][i];
    __syncthreads();
    const int lane = F.lane, fr = lane & 15, fg = lane >> 4;
    const int NGW = F.G * 8, gw = F.vcu * 8 + F.wave;
    const int per = (16384 + NGW - 1) / NGW;
    for (int task = gw * per; task < (gw + 1) * per && task < 16384; ++task) {
        const int cgp = task & 3, r = (task >> 2) & 127, h = (task >> 9) & 7, b = task >> 12;
        const int c0 = 16 * cgp, wsc = min(max(c0 - 8, 0), 32), rs = min(max(r - 4, 0), GROWS - 8);
        const int c = c0 + fr, cs = min(max(c - 8, 0), 48);
        const size_t tq = (size_t)b * T + r * 64 + c;
        bf16x8 qf[2];
#pragma unroll
        for (int ks = 0; ks < 2; ++ks) qf[ks] = *(const bf16x8*)(q + tq * CW + h * 64 + 32 * ks + 8 * fg);
        f32x4 sc[16];
        const int kcol_a = wsc + 8 * (fr >> 2) + (fr & 3);
        { bf16x8 kf[16][2];
#pragma unroll
          for (int t = 0; t < 16; ++t) { const int u = t >> 1, par = t & 1;
              const size_t tk = (size_t)b * T + (rs + u) * 64 + kcol_a + 4 * par;
              kf[t][0] = *(const bf16x8*)(k + tk * CW + h * 64 + 8 * fg); kf[t][1] = *(const bf16x8*)(k + tk * CW + h * 64 + 32 + 8 * fg); }
#pragma unroll
          for (int t = 0; t < 16; ++t) { f32x4 s = {0.f, 0.f, 0.f, 0.f};
              s = __builtin_amdgcn_mfma_f32_16x16x32_bf16(kf[t][0], qf[0], s, 0, 0, 0);
              s = __builtin_amdgcn_mfma_f32_16x16x32_bf16(kf[t][1], qf[1], s, 0, 0, 0);
              sc[t] = s; } }
        float mx = -1e30f;
#pragma unroll
        for (int u = 0; u < 8; ++u) {
            const int dr = rs + u - r + 7;
#pragma unroll
            for (int par = 0; par < 2; ++par)
#pragma unroll
                for (int i = 0; i < 4; ++i) {
                    const int kc = wsc + 8 * fg + 4 * par + i; const bool ok = (kc >= cs) && (kc < cs + 16);
                    const int dc = min(max(kc - c + 15, 0), 30);
                    const float s = ok ? sc[2 * u + par][i] + bias[(h * 15 + dr) * 31 + dc] : -1e30f;
                    sc[2 * u + par][i] = s; mx = fmaxf(mx, s);
                }
        }
        mx = fmaxf(mx, __shfl_xor(mx, 16)); mx = fmaxf(mx, __shfl_xor(mx, 32));
        float sum = 0.f;
#pragma unroll
        for (int t = 0; t < 16; ++t)
#pragma unroll
            for (int i = 0; i < 4; ++i) { const float pv = sc[t][i] > -1e29f ? __expf(sc[t][i] - mx) : 0.f; sc[t][i] = pv; sum += pv; }
        sum += __shfl_xor(sum, 16); sum += __shfl_xor(sum, 32);
        const float inv = 1.0f / sum;
        f32x4 o[4];
#pragma unroll
        for (int nt = 0; nt < 4; ++nt) o[nt] = (f32x4){0.f, 0.f, 0.f, 0.f};
        { bf16x8 vf[8][4];
#pragma unroll
          for (int u = 0; u < 8; ++u) { const bf16* vblk = vT + ((size_t)((b * NH + h) * GROWS + rs + u)) * (HD * 64) + wsc + 8 * fg;
#pragma unroll
              for (int nt = 0; nt < 4; ++nt) vf[u][nt] = *(const bf16x8*)(vblk + (16 * nt + fr) * 64); }
#pragma unroll
          for (int u = 0; u < 8; ++u) {
              union { u32x4 w; bf16x8 h8; } pf;
              pf.w.x = cvt_pk_bf16(sc[2 * u][0], sc[2 * u][1]); pf.w.y = cvt_pk_bf16(sc[2 * u][2], sc[2 * u][3]);
              pf.w.z = cvt_pk_bf16(sc[2 * u + 1][0], sc[2 * u + 1][1]); pf.w.w = cvt_pk_bf16(sc[2 * u + 1][2], sc[2 * u + 1][3]);
#pragma unroll
              for (int nt = 0; nt < 4; ++nt) o[nt] = __builtin_amdgcn_mfma_f32_16x16x32_bf16(vf[u][nt], pf.h8, o[nt], 0, 0, 0); } }
#pragma unroll
        for (int nt = 0; nt < 4; ++nt) { u32x2 w; w.x = cvt_pk_bf16(o[nt][0] * inv, o[nt][1] * inv); w.y = cvt_pk_bf16(o[nt][2] * inv, o[nt][3] * inv);
            *(u32x2*)(att + tq * CW + h * 64 + 16 * nt + 4 * fg) = w; }
    }
    __syncthreads();
}

__device__ __forceinline__ float row16_sum(float v) {
    v += __builtin_bit_cast(float, __builtin_amdgcn_update_dpp(0, __builtin_bit_cast(int, v), 0xB1, 0xF, 0xF, true));
    v += __builtin_bit_cast(float, __builtin_amdgcn_update_dpp(0, __builtin_bit_cast(int, v), 0x4E, 0xF, 0xF, true));
    v += __builtin_bit_cast(float, __builtin_amdgcn_update_dpp(0, __builtin_bit_cast(int, v), 0x141, 0xF, 0xF, true));
    v += __builtin_bit_cast(float, __builtin_amdgcn_update_dpp(0, __builtin_bit_cast(int, v), 0x140, 0xF, 0xF, true));
    return v;
}
constexpr int CS_R = 8;
constexpr int CS_AT = 0, CS_RT = 2304, CS_KHT = 4608, CS_BHT = 6656, CS_VT = 8704, CS_TT = 9216, CS_AAK = 9728, CS_ARK = 10240, CS_ARB = 10752, CS_PL = 11264, CS_SLOT = 11520;
constexpr int CS_LD = 72;
constexpr int CS_SCR = CS_R * CS_SLOT  , CS_SCRW = 2304 * 2 + 1024  , CS_FLAG = CS_SCR + 7 * CS_SCRW  ;
__device__ __forceinline__ bf16 f2bf(float f) { return (bf16)cvt_pk_bf16(f, 0.f); }
struct ChainOps { u32x2 a4[4], r4[4], kh[4], bh[4], aak, ark, arb, tt, vb; f32x4 pl[4]; };
__device__ __forceinline__ void chain_load(const LAS unsigned char* sl, int fr, int fg, ChainOps& o) {
    const int o16 = fr * 32 + fg * 8;
    const LAS unsigned char* pa = sl + CS_AT + fr * (CS_LD * 2) + fg * 8; const LAS unsigned char* pr = sl + CS_RT + fr * (CS_LD * 2) + fg * 8;
#pragma unroll
    for (int kq = 0; kq < 4; ++kq) { o.a4[kq] = *(const LAS u32x2*)(pa + 32 * kq); o.r4[kq] = *(const LAS u32x2*)(pr + 32 * kq); }
    o.aak = *(const LAS u32x2*)(sl + CS_AAK + o16); o.ark = *(const LAS u32x2*)(sl + CS_ARK + o16); o.arb = *(const LAS u32x2*)(sl + CS_ARB + o16); o.tt = *(const LAS u32x2*)(sl + CS_TT + o16);
    o.vb = *(const LAS u32x2*)(sl + CS_VT + o16);
#pragma unroll
    for (int mt = 0; mt < 4; ++mt) { o.pl[mt] = *(const LAS f32x4*)(sl + CS_PL + (16 * mt + 4 * fg) * 4);
        o.kh[mt] = *(const LAS u32x2*)(sl + CS_KHT + 512 * mt + o16); o.bh[mt] = *(const LAS u32x2*)(sl + CS_BHT + 512 * mt + o16); }
}
__device__ __forceinline__ f32x4 chain_compute(const ChainOps& o, f32x4 (&zacc)[4]) {
#define CS_M32(A_, B_, C_) __builtin_amdgcn_mfma_f32_16x16x32_bf16(A_, B_, C_, 0, 0, 0)
#define CS_M16(A_, B_, C_) __builtin_amdgcn_mfma_f32_16x16x16bf16_1k(__builtin_bit_cast(s16x4, A_), __builtin_bit_cast(s16x4, B_), C_, 0, 0, 0)
    union { u32x4 w; bf16x8 h8; } zb0, zb1, ap0, ap1, rp0, rp1;
    zb0.w.x = cvt_pk_bf16(zacc[0][0], zacc[0][1]); zb0.w.y = cvt_pk_bf16(zacc[0][2], zacc[0][3]); zb0.w.z = cvt_pk_bf16(zacc[1][0], zacc[1][1]); zb0.w.w = cvt_pk_bf16(zacc[1][2], zacc[1][3]);
    zb1.w.x = cvt_pk_bf16(zacc[2][0], zacc[2][1]); zb1.w.y = cvt_pk_bf16(zacc[2][2], zacc[2][3]); zb1.w.z = cvt_pk_bf16(zacc[3][0], zacc[3][1]); zb1.w.w = cvt_pk_bf16(zacc[3][2], zacc[3][3]);
    ap0.w = (u32x4){o.a4[0].x, o.a4[0].y, o.a4[1].x, o.a4[1].y}; ap1.w = (u32x4){o.a4[2].x, o.a4[2].y, o.a4[3].x, o.a4[3].y};
    rp0.w = (u32x4){o.r4[0].x, o.r4[0].y, o.r4[1].x, o.r4[1].y}; rp1.w = (u32x4){o.r4[2].x, o.r4[2].y, o.r4[3].x, o.r4[3].y};
    const f32x4 zero4 = {0.f, 0.f, 0.f, 0.f};
    f32x4 Wc = CS_M16(o.aak, o.vb, zero4);
    Wc = CS_M32(ap0.h8, zb0.h8, Wc); Wc = CS_M32(ap1.h8, zb1.h8, Wc);
    f32x4 Yc = CS_M16(o.ark, o.vb, zero4);
    Yc = CS_M32(rp0.h8, zb0.h8, Yc); Yc = CS_M32(rp1.h8, zb1.h8, Yc);
    f32x4 zz[4];
#pragma unroll
    for (int mt = 0; mt < 4; ++mt) zz[mt] = CS_M16(o.kh[mt], o.vb, zacc[mt] * o.pl[mt]);
    u32x2 wb, ub;
    wb.x = cvt_pk_bf16(Wc[0], Wc[1]); wb.y = cvt_pk_bf16(Wc[2], Wc[3]);
    const f32x4 Uc = CS_M16(o.tt, wb, zero4);
    ub.x = cvt_pk_bf16(Uc[0], Uc[1]); ub.y = cvt_pk_bf16(Uc[2], Uc[3]);
    Yc = CS_M16(o.arb, ub, Yc);
#pragma unroll
    for (int mt = 0; mt < 4; ++mt) zacc[mt] = CS_M16(o.bh[mt], ub, zz[mt]);
#undef CS_M32
#undef CS_M16
    return Yc;
}
template <int z>
__device__ __forceinline__ void scan_phase_z(const Frame& F, const Args& a) {
    unsigned char* ws = a.ws;
    const int seq = F.vcu >> 2, ig = F.vcu & 3;
    const int b = (seq >> 3) & 3, h = seq & 7;
    const size_t mb = (size_t)b * T;
    const int lane = F.lane, wave = F.wave, fr = lane & 15, fg = lane >> 4;
    constexpr int NCK = T / 16;
    volatile LAS unsigned* flg = (volatile LAS unsigned*)(F.lds + CS_FLAG);
    if (F.tid < 16) flg[F.tid] = 0u;
    __syncthreads();
    const int o16 = fr * 32 + fg * 8;
#define CS_M32(A_, B_, C_) __builtin_amdgcn_mfma_f32_16x16x32_bf16(A_, B_, C_, 0, 0, 0)
#define CS_M16(A_, B_, C_) __builtin_amdgcn_mfma_f32_16x16x16bf16_1k(__builtin_bit_cast(s16x4, A_), __builtin_bit_cast(s16x4, B_), C_, 0, 0, 0)
    if (wave == 0) {
        __builtin_amdgcn_s_setprio(3);
        float* yout = (float*)(ws + WS_Y) + (size_t)z * M * CW + h * 64 + ig * 16 + fr;
        f32x4 zacc[4];
#pragma unroll
        for (int mt = 0; mt < 4; ++mt) zacc[mt] = (f32x4){0.f, 0.f, 0.f, 0.f};
        ChainOps opA, opB;
#define CS_READY(nn) do { unsigned sp_ = 0; while (flg[(nn) & (CS_R - 1)] != (unsigned)((nn) + 1)) { __builtin_amdgcn_s_sleep(1); if (++sp_ > (1u << 24)) break; } __builtin_amdgcn_fence(__ATOMIC_ACQUIRE, "workgroup"); } while (0)
#define CS_HANDBACK(nn) do { asm volatile("s_waitcnt lgkmcnt(0)" ::: "memory"); if (lane == 0) flg[8] = (unsigned)((nn) + 1); asm volatile("" ::: "memory"); } while (0)
#define CS_YSTORE(nn, Y_) do { _Pragma("unroll") for (int rr = 0; rr < 4; ++rr) { const int q_ = 16 * (nn) + 4 * fg + rr, t_ = z ? (T - 1 - q_) : q_; yout[(mb + t_) * CW] = (Y_)[rr]; } } while (0)
        CS_READY(0); chain_load(F.lds, fr, fg, opA);
#pragma unroll 1
        for (int n = 0; n < NCK; n += 2) {
            CS_READY(n + 1); CS_HANDBACK(n);
            chain_load(F.lds + ((n + 1) & (CS_R - 1)) * CS_SLOT, fr, fg, opB);
            { const f32x4 Yc = chain_compute(opA, zacc); CS_YSTORE(n, Yc); }
            if (n + 2 < NCK) CS_READY(n + 2);
            CS_HANDBACK(n + 1);
            if (n + 2 < NCK) chain_load(F.lds + ((n + 2) & (CS_R - 1)) * CS_SLOT, fr, fg, opA);
            { const f32x4 Yc = chain_compute(opB, zacc); CS_YSTORE(n + 1, Yc); }
        }
#undef CS_READY
#undef CS_HANDBACK
#undef CS_YSTORE
        __builtin_amdgcn_s_setprio(0);
    } else {
        const int pi = wave - 1;
        LAS unsigned char* scr = F.lds + CS_SCR + pi * CS_SCRW;
        LAS bf16* KT = (LAS bf16*)scr; LAS bf16* BT = (LAS bf16*)(scr + 2304);
        const bf16* gw_ = (const bf16*)(ws + WS_DECAY) + (size_t)z * M * CW + h * 64;
        const bf16* gkk = (const bf16*)(ws + WS_KK) + h * 64;
        const bf16* gak = (const bf16*)(ws + WS_AKK) + (size_t)z * M * CW + h * 64;
        const bf16* gk = (const bf16*)(ws + WS_KDIR) + (size_t)z * M * CW + h * 64;
        const bf16* gr = (const bf16*)(ws + WS_R) + h * 64;
        const bf16* gv = (const bf16*)(ws + WS_V) + h * 64 + ig * 16;
        unsigned nw[16], nkk[16], nak[16], nk[16], nr[16], nv[4];
        constexpr long RSTEP = z ? -(long)CW : (long)CW;
#define CS_FETCH(nn) do { if ((nn) < NCK) { const size_t m0_ = (mb + (z ? (T - 1 - 16 * (nn)) : 16 * (nn))) * CW + lane; \
            const bf16* pw_ = gw_ + m0_; const bf16* pkk_ = gkk + m0_; const bf16* pak_ = gak + m0_; const bf16* pk_ = gk + m0_; const bf16* pr_ = gr + m0_; \
            _Pragma("unroll") for (int tt = 0; tt < 16; ++tt) { nw[tt] = pw_[tt * RSTEP]; nkk[tt] = pkk_[tt * RSTEP]; nak[tt] = pak_[tt * RSTEP]; nk[tt] = pk_[tt * RSTEP]; nr[tt] = pr_[tt * RSTEP]; } \
            const bf16* pv_ = gv + (mb + (z ? (T - 1 - 16 * (nn) - fg) : 16 * (nn) + fg)) * CW + fr; \
            _Pragma("unroll") for (int q4 = 0; q4 < 4; ++q4) nv[q4] = pv_[4 * q4 * RSTEP]; } } while (0)
        CS_FETCH(pi);
#pragma unroll 1
        for (int n = pi; n < NCK; n += 7) {
            const int slot = n & (CS_R - 1);
            float wv[16], kkv[16], akv[16], kv[16], rv[16], vq[4];
#pragma unroll
            for (int tt = 0; tt < 16; ++tt) { unsigned x0 = nw[tt], x1 = nkk[tt], x2 = nak[tt], x3 = nk[tt], x4 = nr[tt];
                asm volatile("" : "+v"(x0), "+v"(x1), "+v"(x2), "+v"(x3), "+v"(x4));
                wv[tt] = __uint_as_float(x0 << 16); kkv[tt] = __uint_as_float(x1 << 16); akv[tt] = __uint_as_float(x2 << 16); kv[tt] = __uint_as_float(x3 << 16); rv[tt] = __uint_as_float(x4 << 16); }
#pragma unroll
            for (int q4 = 0; q4 < 4; ++q4) { unsigned x0 = nv[q4]; asm volatile("" : "+v"(x0)); vq[q4] = __uint_as_float(x0 << 16); }
            CS_FETCH(n + 7);
            { unsigned sp = 0; while ((int)flg[8] < n - (CS_R - 3)) { __builtin_amdgcn_s_sleep(2); if (++sp > (1u << 24)) break; } }
            __builtin_amdgcn_fence(__ATOMIC_ACQUIRE, "workgroup");
            LAS unsigned char* sl = F.lds + slot * CS_SLOT;
            float P[16];
            P[0] = wv[0];
#pragma unroll
            for (int tt = 1; tt < 16; ++tt) P[tt] = P[tt - 1] * wv[tt];
            const float PL = P[15];
            float khat[16], bhat[16];
#pragma unroll
            for (int tt = 0; tt < 16; ++tt) {
                const float pm1 = tt ? P[tt - 1] : 1.0f, inv = __builtin_amdgcn_rcpf(P[tt]);
                const float at = kkv[tt] * pm1, rt = rv[tt] * P[tt], kt = kv[tt] * inv, bt = -akv[tt] * inv;
                khat[tt] = kt * PL; bhat[tt] = bt * PL;
                { const unsigned w_ = cvt_pk_bf16(at, rt); *(LAS bf16*)(sl + CS_AT + (tt * CS_LD + lane) * 2) = (bf16)w_; *(LAS bf16*)(sl + CS_RT + (tt * CS_LD + lane) * 2) = (bf16)(w_ >> 16); }
                { const unsigned w_ = cvt_pk_bf16(kt, bt); KT[tt * CS_LD + lane] = (bf16)w_; BT[tt * CS_LD + lane] = (bf16)(w_ >> 16); }
            }
            { u32x4 o0, o1;
              o0.x = cvt_pk_bf16(khat[0], khat[1]); o0.y = cvt_pk_bf16(khat[2], khat[3]); o0.z = cvt_pk_bf16(khat[4], khat[5]); o0.w = cvt_pk_bf16(khat[6], khat[7]);
              o1.x = cvt_pk_bf16(khat[8], khat[9]); o1.y = cvt_pk_bf16(khat[10], khat[11]); o1.z = cvt_pk_bf16(khat[12], khat[13]); o1.w = cvt_pk_bf16(khat[14], khat[15]);
              *(LAS u32x4*)(sl + CS_KHT + lane * 32) = o0; *(LAS u32x4*)(sl + CS_KHT + lane * 32 + 16) = o1;
              o0.x = cvt_pk_bf16(bhat[0], bhat[1]); o0.y = cvt_pk_bf16(bhat[2], bhat[3]); o0.z = cvt_pk_bf16(bhat[4], bhat[5]); o0.w = cvt_pk_bf16(bhat[6], bhat[7]);
              o1.x = cvt_pk_bf16(bhat[8], bhat[9]); o1.y = cvt_pk_bf16(bhat[10], bhat[11]); o1.z = cvt_pk_bf16(bhat[12], bhat[13]); o1.w = cvt_pk_bf16(bhat[14], bhat[15]);
              *(LAS u32x4*)(sl + CS_BHT + lane * 32) = o0; *(LAS u32x4*)(sl + CS_BHT + lane * 32 + 16) = o1; }
            *(LAS float*)(sl + CS_PL + lane * 4) = PL;
#pragma unroll
            for (int q4 = 0; q4 < 4; ++q4) *(LAS bf16*)(sl + CS_VT + (fr * 16 + fg + 4 * q4) * 2) = f2bf(vq[q4]);
            asm volatile("s_waitcnt lgkmcnt(0)" ::: "memory");
            bf16x8 af[2], rf[2], kf[2], bf_[2];
#pragma unroll
            for (int ks = 0; ks < 2; ++ks) { af[ks] = *(const LAS bf16x8*)(sl + CS_AT + (fr * CS_LD + 32 * ks + 8 * fg) * 2); rf[ks] = *(const LAS bf16x8*)(sl + CS_RT + (fr * CS_LD + 32 * ks + 8 * fg) * 2);
                kf[ks] = *(const LAS bf16x8*)(KT + fr * CS_LD + 32 * ks + 8 * fg); bf_[ks] = *(const LAS bf16x8*)(BT + fr * CS_LD + 32 * ks + 8 * fg); }
            const f32x4 zero4 = {0.f, 0.f, 0.f, 0.f};
            f32x4 Xc = zero4, Xt = zero4, AakT = zero4, ArbT = zero4, ArkT = zero4;
#pragma unroll
            for (int ks = 0; ks < 2; ++ks) { Xc = CS_M32(af[ks], bf_[ks], Xc); Xt = CS_M32(bf_[ks], af[ks], Xt);
                AakT = CS_M32(kf[ks], af[ks], AakT); ArbT = CS_M32(bf_[ks], rf[ks], ArbT); ArkT = CS_M32(kf[ks], rf[ks], ArkT); }
            f32x4 S1;
#pragma unroll
            for (int rr = 0; rr < 4; ++rr) { const int q = 4 * fg + rr;
                Xc[rr] = (fr < q) ? Xc[rr] : 0.f; Xt[rr] = (q < fr) ? Xt[rr] : 0.f; S1[rr] = Xt[rr] + ((q == fr) ? 1.0f : 0.f);
                AakT[rr] = (q < fr) ? AakT[rr] : 0.f; ArkT[rr] = (q <= fr) ? ArkT[rr] : 0.f; ArbT[rr] = (q <= fr) ? ArbT[rr] : 0.f; }
            { u32x2 w; w.x = cvt_pk_bf16(AakT[0], AakT[1]); w.y = cvt_pk_bf16(AakT[2], AakT[3]); *(LAS u32x2*)(sl + CS_AAK + o16) = w;
              w.x = cvt_pk_bf16(ArkT[0], ArkT[1]); w.y = cvt_pk_bf16(ArkT[2], ArkT[3]); *(LAS u32x2*)(sl + CS_ARK + o16) = w;
              w.x = cvt_pk_bf16(ArbT[0], ArbT[1]); w.y = cvt_pk_bf16(ArbT[2], ArbT[3]); *(LAS u32x2*)(sl + CS_ARB + o16) = w; }
#define CS_PK(v) ((u32x2){cvt_pk_bf16((v)[0], (v)[1]), cvt_pk_bf16((v)[2], (v)[3])})
            const u32x2 xc = CS_PK(Xc), xt = CS_PK(Xt), s1 = CS_PK(S1);
            const f32x4 X2c = CS_M16(xt, xc, zero4), X2t = CS_M16(xc, xt, zero4);
            const u32x2 x2c = CS_PK(X2c), x2t = CS_PK(X2t);
            const f32x4 S2 = CS_M16(x2c, s1, S1);
            const f32x4 X4c = CS_M16(x2t, x2c, zero4), X4t = CS_M16(x2c, x2t, zero4);
            const u32x2 x4c = CS_PK(X4c), x4t = CS_PK(X4t), s2 = CS_PK(S2);
            const f32x4 S4 = CS_M16(x4c, s2, S2);
            const f32x4 X8c = CS_M16(x4t, x4c, zero4);
            const u32x2 x8c = CS_PK(X8c), s4 = CS_PK(S4);
            const f32x4 S8 = CS_M16(x8c, s4, S4);
            *(LAS u32x2*)(sl + CS_TT + o16) = CS_PK(S8);
#undef CS_PK
            asm volatile("s_waitcnt lgkmcnt(0)" ::: "memory");
            __builtin_amdgcn_fence(__ATOMIC_RELEASE, "workgroup");
            if (lane == 0) flg[slot] = (unsigned)(n + 1);
        }
#undef CS_FETCH
    }
#undef CS_M32
#undef CS_M16
    __syncthreads();
}

__device__ __forceinline__ void scan_phase(const Frame& F, const Args& a) {
    const int seq = F.vcu >> 2;
    if (seq >= 64) return;
    if (seq >> 5) scan_phase_z<1>(F, a); else scan_phase_z<0>(F, a);
}

__device__ __forceinline__ void combine_phase(const Frame& F, const Args& a) {
    unsigned char* ws = a.ws;
    const bf16* att = (const bf16*)(ws + WS_ATT); const bf16* rr = (const bf16*)(ws + WS_R); const bf16* vv = (const bf16*)(ws + WS_V);
    const bf16* kd = (const bf16*)(ws + WS_KDIR); const bf16* gg = (const bf16*)(ws + WS_G); const float* y = (const float*)(ws + WS_Y);
    bf16* mix = (bf16*)(ws + WS_MIX);
    const float* anw = a.in[4]; const float* r_k = a.in[14]; const float* ln_w = a.in[15]; const float* ln_b = a.in[16];
    const int lane = F.lane, c0 = 8 * lane;
    float nw[8], rk[8], lw[8], lb[8];
#pragma unroll
    for (int i = 0; i < 8; ++i) { nw[i] = anw[c0 + i]; rk[i] = r_k[c0 + i]; lw[i] = ln_w[c0 + i]; lb[i] = ln_b[c0 + i]; }
    const int gw = F.vcu * 8 + F.wave, NGW = F.G * 8;
#pragma unroll 2
    for (int m = gw; m < M; m += NGW) {
        const size_t o = (size_t)m * CW + c0;
        float f[8];
        unpack8(*(const u32x4*)(att + o), f);
        float ss = 0.f;
#pragma unroll
        for (int i = 0; i < 8; ++i) ss += f[i] * f[i];
        const float rs = rsqrtf(wave_sum(ss) * (1.f / CW) + RMS_EPS);
#pragma unroll
        for (int i = 0; i < 8; ++i) f[i] = f[i] * rs * nw[i];
        *(u32x4*)(mix + (size_t)m * D + c0) = pack8(f);
        const f32x4 y0a = *(const f32x4*)(y + o), y0b = *(const f32x4*)(y + o + 4), y1a = *(const f32x4*)(y + (size_t)M * CW + o), y1b = *(const f32x4*)(y + (size_t)M * CW + o + 4);
        float yv[8] = {y0a.x + y1a.x, y0a.y + y1a.y, y0a.z + y1a.z, y0a.w + y1a.w, y0b.x + y1b.x, y0b.y + y1b.y, y0b.z + y1b.z, y0b.w + y1b.w};
        float s1 = 0.f;
#pragma unroll
        for (int i = 0; i < 8; ++i) s1 += yv[i];
        s1 += __shfl_xor(s1, 1); s1 += __shfl_xor(s1, 2); s1 += __shfl_xor(s1, 4);
        const float mean = s1 * (1.f / 64.f);
        float s2 = 0.f;
#pragma unroll
        for (int i = 0; i < 8; ++i) { yv[i] -= mean; s2 += yv[i] * yv[i]; }
        s2 += __shfl_xor(s2, 1); s2 += __shfl_xor(s2, 2); s2 += __shfl_xor(s2, 4);
        const float rstd = rsqrtf(s2 * (1.f / 64.f) + GN_EPS);
        float rf[8], k0[8], k1[8], vf[8], gf[8];
        unpack8(*(const u32x4*)(rr + o), rf); unpack8(*(const u32x4*)(kd + o), k0); unpack8(*(const u32x4*)(kd + (size_t)M * CW + o), k1);
        unpack8(*(const u32x4*)(vv + o), vf); unpack8(*(const u32x4*)(gg + o), gf);
        float cf = 0.f;
#pragma unroll
        for (int i = 0; i < 8; ++i) cf += rf[i] * (k0[i] + k1[i]) * rk[i];
        cf += __shfl_xor(cf, 1); cf += __shfl_xor(cf, 2); cf += __shfl_xor(cf, 4);
#pragma unroll
        for (int i = 0; i < 8; ++i) f[i] = (yv[i] * rstd * lw[i] + lb[i] + cf * vf[i]) * gf[i];
        *(u32x4*)(mix + (size_t)m * D + CW + c0) = pack8(f);
    }
}

constexpr int RT_PITCH = 1032, RT_WH = 0, RT_WL = 32 * RT_PITCH * 2, RT_HIST = 2 * RT_WL, RT_EL = RT_HIST + 256;
__device__ __forceinline__ void router_phase(const Frame& F, const Args& a) {
    unsigned char* ws = a.ws;
    const bf16* hbuf = (const bf16*)(ws + WS_H); unsigned char* hn2 = ws + WS_HN2;
    int* eidx = (int*)(ws + WS_EIDX); float* gate = (float*)(ws + WS_GATE); int* rank = (int*)(ws + WS_RANK);
    unsigned* ctl = (unsigned*)(ws + WS_CTL);
    const float* n2w = a.in[18]; const float* rw = a.in[19]; const float* rb = a.in[20];
    LAS bf16* wh = (LAS bf16*)(F.lds + RT_WH); LAS bf16* wl = (LAS bf16*)(F.lds + RT_WL); LAS int* hist = (LAS int*)(F.lds + RT_HIST); LAS int* eL = (LAS int*)(F.lds + RT_EL);
    { f32x4 tmp[16];
#pragma unroll
      for (int j = 0; j < 16; ++j) tmp[j] = *((const f32x4*)rw + F.tid + 512 * j);
#pragma unroll
      for (int j = 0; j < 16; ++j) { const int q = F.tid + 512 * j, d = q >> 3, e0 = 4 * (q & 7);
#pragma unroll
          for (int i = 0; i < 4; ++i) { const float w = tmp[j][i]; const unsigned hb = cvt_pk_bf16(w, 0.f) & 0xffffu; const float lo = w - __uint_as_float(hb << 16);
              wh[(e0 + i) * RT_PITCH + d] = (bf16)hb; wl[(e0 + i) * RT_PITCH + d] = (bf16)cvt_pk_bf16(lo, 0.f); } } }
    if (F.tid < 32) hist[F.tid] = 0;
    __syncthreads();
    const int lane = F.lane, tk = lane & 15, g = lane >> 4;
    const int blk = F.vcu;
    const int m = blk * 128 + F.wave * 16 + tk;
    const bf16* hrow = hbuf + (size_t)m * D + 8 * g;
    float ss = 0.f;
#pragma unroll 8
    for (int ks = 0; ks < 32; ++ks) { float xf[8]; unpack8(*(const u32x4*)(hrow + 32 * ks), xf);
        ss += (xf[0] * xf[0] + xf[1] * xf[1]) + (xf[2] * xf[2] + xf[3] * xf[3]) + (xf[4] * xf[4] + xf[5] * xf[5]) + (xf[6] * xf[6] + xf[7] * xf[7]); }
    ss += __shfl_xor(ss, 16); ss += __shfl_xor(ss, 32);
    const float rs = rsqrtf(ss * (1.f / D) + RMS_EPS);
    f32x4 acc0 = {0.f, 0.f, 0.f, 0.f}, acc1 = acc0;
    unsigned char* hrow8 = hn2 + (size_t)m * D + 8 * g;
    const LAS bf16* wh0 = wh + tk * RT_PITCH + 8 * g; const LAS bf16* wl0 = wl + tk * RT_PITCH + 8 * g;
#pragma unroll 4
    for (int ks = 0; ks < 32; ++ks) {
        float xf[8]; unpack8(*(const u32x4*)(hrow + 32 * ks), xf);
        const f32x4 x0 = {xf[0], xf[1], xf[2], xf[3]}, x1 = {xf[4], xf[5], xf[6], xf[7]};
        const f32x4 n0 = *(const f32x4*)(n2w + 32 * ks + 8 * g), n1 = *(const f32x4*)(n2w + 32 * ks + 8 * g + 4);
        const f32x4 y0 = x0 * rs * n0, y1 = x1 * rs * n1;
        { u32x2 w8; w8.x = pk4_fp8(y0.x * F8_SX, y0.y * F8_SX, y0.z * F8_SX, y0.w * F8_SX); w8.y = pk4_fp8(y1.x * F8_SX, y1.y * F8_SX, y1.z * F8_SX, y1.w * F8_SX); *(u32x2*)(hrow8 + 32 * ks) = w8; }
        union { u32x4 w; bf16x8 h8; } xh, xl;
        xh.w.x = cvt_pk_bf16(y0.x, y0.y); xh.w.y = cvt_pk_bf16(y0.z, y0.w); xh.w.z = cvt_pk_bf16(y1.x, y1.y); xh.w.w = cvt_pk_bf16(y1.z, y1.w);
        xl.w.x = cvt_pk_bf16(y0.x - bflo(xh.w.x), y0.y - bfhi(xh.w.x)); xl.w.y = cvt_pk_bf16(y0.z - bflo(xh.w.y), y0.w - bfhi(xh.w.y));
        xl.w.z = cvt_pk_bf16(y1.x - bflo(xh.w.z), y1.y - bfhi(xh.w.z)); xl.w.w = cvt_pk_bf16(y1.z - bflo(xh.w.w), y1.w - bfhi(xh.w.w));
        const bf16x8 a0h = *(const LAS bf16x8*)(wh0 + 32 * ks), a1h = *(const LAS bf16x8*)(wh0 + 16 * RT_PITCH + 32 * ks);
        const bf16x8 a0l = *(const LAS bf16x8*)(wl0 + 32 * ks), a1l = *(const LAS bf16x8*)(wl0 + 16 * RT_PITCH + 32 * ks);
        acc0 = __builtin_amdgcn_mfma_f32_16x16x32_bf16(a0h, xh.h8, acc0, 0, 0, 0); acc1 = __builtin_amdgcn_mfma_f32_16x16x32_bf16(a1h, xh.h8, acc1, 0, 0, 0);
        acc0 = __builtin_amdgcn_mfma_f32_16x16x32_bf16(a0h, xl.h8, acc0, 0, 0, 0); acc1 = __builtin_amdgcn_mfma_f32_16x16x32_bf16(a1h, xl.h8, acc1, 0, 0, 0);
        acc0 = __builtin_amdgcn_mfma_f32_16x16x32_bf16(a0l, xh.h8, acc0, 0, 0, 0); acc1 = __builtin_amdgcn_mfma_f32_16x16x32_bf16(a1l, xh.h8, acc1, 0, 0, 0);
    }
    float lv[8]; int li[8];
    { const f32x4 b0 = *(const f32x4*)(rb + 4 * g), b1 = *(const f32x4*)(rb + 16 + 4 * g);
#pragma unroll
      for (int i = 0; i < 4; ++i) { lv[i] = acc0[i] + b0[i]; li[i] = 4 * g + i; lv[4 + i] = acc1[i] + b1[i]; li[4 + i] = 16 + 4 * g + i; } }
    float tv[4]; int ti[4];
#pragma unroll
    for (int kx = 0; kx < 4; ++kx) {
        float bv = lv[0]; int bi = li[0];
#pragma unroll
        for (int i = 1; i < 8; ++i) { const bool gt = lv[i] > bv; bv = gt ? lv[i] : bv; bi = gt ? li[i] : bi; }
#pragma unroll
        for (int o = 16; o < 64; o <<= 1) { const float ov = __shfl_xor(bv, o); const int oi = __shfl_xor(bi, o); const bool tko = (ov > bv) || (ov == bv && oi < bi); bv = tko ? ov : bv; bi = tko ? oi : bi; }
        tv[kx] = bv; ti[kx] = bi;
#pragma unroll
        for (int i = 0; i < 8; ++i) lv[i] = (li[i] == bi) ? -3.0e38f : lv[i];
    }
    if (g == 0) {
        const float e0 = 1.0f, e1 = __expf(tv[1] - tv[0]), e2 = __expf(tv[2] - tv[0]), e3 = __expf(tv[3] - tv[0]);
        const float is = 1.0f / (e0 + e1 + e2 + e3);
        const float gs[4] = {e0 * is, e1 * is, e2 * is, e3 * is};
#pragma unroll
        for (int kx = 0; kx < 4; ++kx) { eidx[m * 4 + kx] = ti[kx]; gate[m * 4 + kx] = gs[kx]; eL[(m - blk * 128) * 4 + kx] = ti[kx]; }
    }
    __syncthreads();
    { const int t = F.tid, e = eL[t]; int rk = 0;
      for (int u = 0; u < t; ++u) rk += (eL[u] == e) ? 1 : 0;
      rank[(blk * 128) * 4 + t] = rk;
      __hip_atomic_fetch_add(&hist[e], 1, __ATOMIC_RELAXED, __HIP_MEMORY_SCOPE_WORKGROUP); }
    __syncthreads();
    if (F.tid < 32) ctl[CW_CNT + blk * 32 + F.tid] = (unsigned)hist[F.tid];
}

__device__ __forceinline__ void dispatch_phase(const Frame& F, const Args& a) {
    unsigned char* ws = a.ws;
    unsigned* ctl = (unsigned*)(ws + WS_CTL);
    const int* eidx = (const int*)(ws + WS_EIDX); const int* rank = (const int*)(ws + WS_RANK); int* dest = (int*)(ws + WS_DEST);
    LAS int* part = (LAS int*)F.lds;
    LAS int* tot = part + 1024;
    const int blk = F.vcu, G = F.G;
    { const int e = F.tid & 31, pt = F.tid >> 5; int s = 0, sb = 0;
      if (G == 256) { int cv[16];
#pragma unroll
          for (int q = 0; q < 16; ++q) cv[q] = (int)ld_u32_agent(ctl + CW_CNT + (pt + 16 * q) * 32 + e);
#pragma unroll
          for (int q = 0; q < 16; ++q) { s += cv[q]; if (pt + 16 * q < blk) sb += cv[q]; } }
      else for (int bb = pt; bb < G; bb += 16) { const int cval = (int)ld_u32_agent(ctl + CW_CNT + bb * 32 + e); s += cval; if (bb < blk) sb += cval; }
      part[pt * 32 + e] = s; part[512 + pt * 32 + e] = sb; }
    __syncthreads();
    if (F.tid < 32) { int s = 0, sb = 0;
        for (int pt = 0; pt < 16; ++pt) { s += part[pt * 32 + F.tid]; sb += part[512 + pt * 32 + F.tid]; }
        tot[F.tid] = s; tot[32 + F.tid] = sb; tot[96 + F.tid] = (s + 255) & ~255; }
    __syncthreads();
    if (F.tid == 0) { int ps = 0; for (int e = 0; e < 32; ++e) { tot[64 + e] = ps; ps += tot[96 + e]; }
        tot[128] = ps >> 8; }
    __syncthreads();
    if (blk == 0) {
        if (F.tid == 0) ctl[CW_NT] = (unsigned)tot[128];
        for (int e = F.tid >> 4; e < 32; e += 32) { const int t0 = tot[64 + e] >> 8, nt = tot[96 + e] >> 8; for (int i = F.tid & 15; i < nt; i += 16) ctl[CW_TEXP + t0 + i] = (unsigned)e; }
    }
    const int lane = F.lane;
    const int mw = blk * 128 + F.wave * 16;
    int* rowtok = (int*)(ws + WS_ROWTOK);
    { const int e = eidx[mw * 4 + lane]; const int dl = tot[64 + e] + tot[32 + e] + rank[mw * 4 + lane]; dest[mw * 4 + lane] = dl; rowtok[dl] = mw + (lane >> 2); }
    { const int e = blk & 31, pt = blk >> 5, np = G >> 5; const int r0 = tot[64 + e] + tot[e], r1 = tot[64 + e] + tot[96 + e];
      if (np > 0) for (int r = r0 + pt * 512 + F.tid; r < r1; r += np * 512) rowtok[r] = 0; }
}

__device__ __forceinline__ void final_phase(const Frame& F, const Args& a) {
    unsigned char* ws = a.ws;
    const bf16* hbuf = (const bf16*)(ws + WS_H); const bf16* ybuf = (const bf16*)(ws + WS_YBUF);
    const int* dest = (const int*)(ws + WS_DEST); const float* gate = (const float*)(ws + WS_GATE);
    const float* fw = a.in[25]; float* out = a.out;
    const int lane = F.lane;
    f32x4 wn[4];
#pragma unroll
    for (int j = 0; j < 4; ++j) wn[j] = *((const f32x4*)fw + lane + 64 * j);
    const int gw = F.vcu * 8 + F.wave, NGW = F.G * 8;
    const int per = M / NGW;
    const int mw = gw * per;
    int dl = 0; float gl = 0.f;
    if (lane < 4 * per && per <= 16) { dl = dest[mw * 4 + lane]; gl = gate[mw * 4 + lane]; }
#pragma unroll 2
    for (int i = 0; i < per; ++i) {
        const int m = mw + i;
        const u32x2* hr = (const u32x2*)(hbuf + (size_t)m * D) + lane;
        f32x4 v[4];
#pragma unroll
        for (int j = 0; j < 4; ++j) { const u32x2 w = hr[64 * j]; v[j] = (f32x4){bflo(w.x), bfhi(w.x), bflo(w.y), bfhi(w.y)}; }
#pragma unroll
        for (int kx = 0; kx < 4; ++kx) {
            const int d = per <= 16 ? __shfl(dl, 4 * i + kx) : dest[m * 4 + kx]; const float gt = per <= 16 ? __shfl(gl, 4 * i + kx) : gate[m * 4 + kx];
            const u32x2* yr = (const u32x2*)(ybuf + (size_t)d * D) + lane;
#pragma unroll
            for (int j = 0; j < 4; ++j) { const u32x2 w = yr[64 * j]; v[j].x += gt * bflo(w.x); v[j].y += gt * bfhi(w.x); v[j].z += gt * bflo(w.y); v[j].w += gt * bfhi(w.y); }
        }
        float s = 0.f;
#pragma unroll
        for (int j = 0; j < 4; ++j) s += (v[j].x * v[j].x + v[j].y * v[j].y) + (v[j].z * v[j].z + v[j].w * v[j].w);
        const float rs = rsqrtf(wave_sum(s) * (1.f / D) + RMS_EPS);
        f32x4* orow = (f32x4*)(out + (size_t)m * D) + lane;
#pragma unroll
        for (int j = 0; j < 4; ++j) orow[64 * j] = v[j] * rs * wn[j];
    }
}

__global__ void __launch_bounds__(512, 2) fwd_megakernel(Args args) {
    extern __shared__ __attribute__((aligned(16))) unsigned char lds_raw[];
    Frame F;
    F.lds = (LAS unsigned char*)lds_raw;
    F.tid = threadIdx.x; F.lane = F.tid & 63; F.wave = __builtin_amdgcn_readfirstlane(F.tid >> 6);
    F.G = gridDim.x; { const int bx = blockIdx.x; F.vcu = (F.G % 8 == 0) ? (bx % 8) * (F.G / 8) + bx / 8 : bx; }
    unsigned char* ws = args.ws;
    const int lo = args.ph_lo, hi = args.ph_hi;
#define IN(k) (lo <= (k) && (k) < hi)
#if MK_SPLIT
#define SEAM(k) do { } while (0)
#else
    cg::grid_group grid = cg::this_grid();
    { volatile LAS unsigned* st = (volatile LAS unsigned*)(F.lds + LDS_MISC); if (F.tid < 2) st[F.tid] = 0u; __syncthreads(); }
    const XcdBarrier xbar = xcd_barrier_post((unsigned*)(ws + WS_CTL) + CW_BAR, (volatile LAS unsigned*)(F.lds + LDS_MISC));
    if (lo < 0) grid.sync();
#define SEAM(k) do { if (IN(k) && IN((k) + 1)) xcd_barrier(xbar); } while (0)
#endif
#define REP2(k) if constexpr (((MK_REPEAT >> (k)) & 1) != 0)
#define PH1 { pg8::Gemm g{(const bf16*)(ws + WS_HN), (const bf16*)(ws + WS_WINT), 1024, nullptr, 0, nullptr}; \
        pg8::StaticOrder S; S.init(M / 256, NPROJ_PAD / 256, F.G, (int)blockIdx.x); \
        pg8::EpiProj E{(bf16*)(ws + WS_Q), (bf16*)(ws + WS_K), (bf16*)(ws + WS_VT), (bf16*)(ws + WS_P)}; \
        pg8::gemm_phase<pg8::EpiProj, true, true>(F.lds, g, S, E); }
#define PH5 { pg8::Gemm g{(const bf16*)(ws + WS_MIX), (const bf16*)(ws + WS_WOT), 1024, nullptr, 0, nullptr}; \
        pg8::StaticOrder S; S.init(M / 256, D / 256, F.G, (int)blockIdx.x); \
        pg8::EpiWo E{args.in[0], (bf16*)(ws + WS_H)}; \
        pg8::gemm_phase<pg8::EpiWo, true, true>(F.lds, g, S, E); }
#define PH8 { const unsigned* ctl = (const unsigned*)(ws + WS_CTL); const int ntile = (int)ld_u32_agent(ctl + CW_NT); \
        pg8::Gemm g{(const bf16*)(ws + WS_HN2), (const bf16*)(ws + WS_WUPT), 512, ctl + CW_TEXP, (size_t)2048 * 1024, (const int*)(ws + WS_ROWTOK)}; \
        pg8::StaticOrder S; S.init(ntile, 8, F.G, (int)blockIdx.x); \
        pg8::EpiUp E{args.in[22], ws + WS_ACT}; \
        pg8::gemm_phase<pg8::EpiUp, true, true, true, true>(F.lds, g, S, E); }
#define PH9 { const unsigned* ctl = (const unsigned*)(ws + WS_CTL); const int ntile = (int)ld_u32_agent(ctl + CW_NT); \
        pg8::Gemm g{(const bf16*)(ws + WS_ACT), (const bf16*)(ws + WS_WDNT), 512, ctl + CW_TEXP, (size_t)1024 * 1024, nullptr}; \
        pg8::StaticOrder S; S.init(ntile, 4, F.G, (int)blockIdx.x); \
        pg8::EpiDown E{args.in[24], (bf16*)(ws + WS_YBUF)}; \
        pg8::gemm_phase<pg8::EpiDown, true, true, false, true>(F.lds, g, S, E); }
    if (IN(0)) { p0_prologue(F, args); REP2(0) p0_prologue(F, args); }
    SEAM(0);
    if (IN(1)) { PH1 REP2(1) PH1 }
    SEAM(1);
    if (IN(2)) { prep_phase<true>(F, args); REP2(2) prep_phase<true>(F, args); attn_phase(F, args); REP2(11) attn_phase(F, args); }
    SEAM(2);
    if (IN(3)) { scan_phase(F, args); REP2(3) scan_phase(F, args); }
    SEAM(3);
    if (IN(4)) { combine_phase(F, args); REP2(4) combine_phase(F, args); }
    SEAM(4);
    if (IN(5)) { PH5 REP2(5) PH5 }
    SEAM(5);
    if (IN(6)) { router_phase(F, args); REP2(6) { __syncthreads(); router_phase(F, args); } }
    SEAM(6);
    if (IN(7)) { dispatch_phase(F, args); REP2(7) { __syncthreads(); dispatch_phase(F, args); } }
    SEAM(7);
    if (IN(8)) { PH8 REP2(8) PH8 }
    SEAM(8);
    if (IN(9)) { PH9 REP2(9) PH9 }
    SEAM(9);
    if (IN(10)) { final_phase(F, args); REP2(10) final_phase(F, args); }
#undef IN
#undef SEAM
}

extern "C" void kernel_launch(void* const* d_in, const int* in_sizes, int n_in, void* d_out, int out_size, void* d_ws, size_t ws_size, hipStream_t stream) {
    static int grid = 0;
    if (grid == 0) {
        if (n_in != 26 || in_sizes[0] != M * D || out_size != M * D || ws_size < WS_END) { fprintf(stderr, "kernel_launch: unexpected problem (n_in %d, in0 %d, out %d, ws %zu)\n", n_in, n_in > 0 ? in_sizes[0] : -1, out_size, ws_size); grid = -1; return; }
        int dev = 0, cus = 0, per_cu = 0;
        if (hipGetDevice(&dev) != hipSuccess || hipDeviceGetAttribute(&cus, hipDeviceAttributeMultiprocessorCount, dev) != hipSuccess) { grid = -1; return; }
        if (hipFuncSetAttribute((const void*)fwd_megakernel, hipFuncAttributeMaxDynamicSharedMemorySize, LDS_BYTES) != hipSuccess) { fprintf(stderr, "kernel_launch: hipFuncSetAttribute failed\n"); grid = -1; return; }
        if (hipOccupancyMaxActiveBlocksPerMultiprocessor(&per_cu, (const void*)fwd_megakernel, 512, LDS_BYTES) != hipSuccess || per_cu < 1) { fprintf(stderr, "kernel_launch: occupancy query says %d\n", per_cu); per_cu = 1; }
        (void)hipGetLastError();
        grid = cus * 1;
        if (grid != 256) fprintf(stderr, "kernel_launch: note: %d CUs\n", cus);
    }
    if (grid < 0) return;
    if (hipMemsetAsync((char*)d_ws + WS_CTL + (size_t)CW_BAR * 4, 0, XCD_BAR_WORDS * 4, stream) != hipSuccess) { fprintf(stderr, "kernel_launch: memset failed\n"); return; }
    Args a{};
    for (int i = 0; i < 26; ++i) a.in[i] = (const float*)d_in[i];
    a.out = (float*)d_out; a.ws = (unsigned char*)d_ws;
#if MK_SPLIT
    for (int ph = 0; ph < NPHASE; ++ph) { a.ph_lo = ph; a.ph_hi = ph + 1; hipLaunchKernelGGL(fwd_megakernel, dim3(grid), dim3(512), LDS_BYTES, stream, a); }
#else
    a.ph_lo = 0; a.ph_hi = NPHASE;
    void* kargs[] = {&a};
    hipError_t e = hipLaunchCooperativeKernel((const void*)fwd_megakernel, dim3(grid), dim3(512), kargs, LDS_BYTES, stream);
    if (e != hipSuccess) fprintf(stderr, "kernel_launch: cooperative launch failed: %s (grid %d)\n", hipGetErrorString(e), grid);
#endif
}
```

```cpp
#include <hip/hip_runtime.h>
#include <hip/hip_cooperative_groups.h>
#include <cstdio>
#include <cstdint>
namespace cg = cooperative_groups;

#ifndef MK_SPLIT
#define MK_SPLIT 0
#endif

#ifndef MK_REPEAT
#define MK_REPEAT 0
#endif
#define LAS __attribute__((address_space(3)))
typedef unsigned short bf16;
typedef float f32x4 __attribute__((ext_vector_type(4)));
typedef float f32x2 __attribute__((ext_vector_type(2)));
typedef unsigned u32x4 __attribute__((ext_vector_type(4)));
typedef unsigned u32x2 __attribute__((ext_vector_type(2)));
typedef short bf16x8 __attribute__((ext_vector_type(8)));
typedef short s16x4 __attribute__((ext_vector_type(4)));

constexpr int BATCH = 4, T = 8192, D = 1024, M = BATCH * T;
constexpr int NH = 8, HD = 64, CW = 512;
constexpr int SHIFT_W = 1920, NPROJ = 3456, NPROJ_PAD = 3584, PW = 2048;
constexpr int NE = 32, TOPK = 4, DE = 1024;
constexpr int GRIDW = 64, GROWS = 128;
constexpr int P_TILES_MAX = 544, P_ROWS = P_TILES_MAX * 256;
constexpr float RMS_EPS = 1e-5f, GN_EPS = 64e-5f;
constexpr int NPHASE = 11;

constexpr size_t MiB = 1u << 20;
constexpr size_t WS_CTL = 0;
constexpr size_t WS_W2T = 1 * MiB, WS_A2T = WS_W2T + 131072, WS_G2T = WS_A2T + 131072;
constexpr size_t WS_WINT = 2 * MiB, WS_WOT = 9 * MiB, WS_WUPT = 12 * MiB, WS_WDNT = 140 * MiB;
constexpr size_t WS_EIDX = 204 * MiB, WS_GATE = WS_EIDX + 524288, WS_RANK = WS_GATE + 524288, WS_DEST = WS_RANK + 524288, WS_ROWTOK = WS_DEST + 524288;
constexpr size_t WS_R = 208 * MiB, WS_V = 240 * MiB, WS_KK = 272 * MiB, WS_DECAY = 304 * MiB, WS_KDIR = 368 * MiB, WS_AKK = 432 * MiB,
                 WS_G = 496 * MiB, WS_ATT = 528 * MiB;
constexpr size_t WS_Q = 560 * MiB, WS_K = 592 * MiB, WS_VT = 624 * MiB, WS_P = 656 * MiB, WS_HN = 784 * MiB, WS_Y = 848 * MiB;
constexpr size_t WS_MIX = 560 * MiB, WS_H = 752 * MiB, WS_HN2 = 880 * MiB, WS_XBUF = 208 * MiB, WS_ACT = 480 * MiB, WS_YBUF = 208 * MiB;
constexpr size_t WS_END = 976 * MiB;
constexpr int CW_NT = 0, CW_TEXP = 64, CW_CNT = 1024, CW_BAR = 16384;

constexpr int LDS_BYTES = 159744, LDS_MISC = LDS_BYTES - 256;

typedef __bf16 bf16x2_t __attribute__((ext_vector_type(2)));
__device__ __forceinline__ unsigned cvt_pk_bf16(float lo, float hi) { const f32x2 v = {lo, hi}; return __builtin_bit_cast(unsigned, __builtin_convertvector(v, bf16x2_t)); }
typedef int i32x8 __attribute__((ext_vector_type(8)));
typedef int i32x4 __attribute__((ext_vector_type(4)));
#ifndef F8_SCALE1
#define F8_SCALE1 0
#endif
constexpr float F8_SX = 32.0f, F8_SW = 128.0f, F8_SACT = 8.0f, F8_SY = 32.0f;
__device__ __forceinline__ float f8clamp(float v) { return __builtin_amdgcn_fmed3f(v, -448.0f, 448.0f); }
__device__ __forceinline__ unsigned pk4_fp8(float a, float b, float c, float d) { int w = 0; w = __builtin_amdgcn_cvt_pk_fp8_f32(f8clamp(a), f8clamp(b), w, false); w = __builtin_amdgcn_cvt_pk_fp8_f32(f8clamp(c), f8clamp(d), w, true); return (unsigned)w; }
__device__ __forceinline__ float bflo(unsigned u) { return __uint_as_float(u << 16); }
__device__ __forceinline__ float bfhi(unsigned u) { return __uint_as_float(u & 0xffff0000u); }
__device__ __forceinline__ float bf1(bf16 v) { return __uint_as_float(((unsigned)v) << 16); }
__device__ __forceinline__ void unpack8(const u32x4 u, float* f) { f[0] = bflo(u.x); f[1] = bfhi(u.x); f[2] = bflo(u.y); f[3] = bfhi(u.y); f[4] = bflo(u.z); f[5] = bfhi(u.z); f[6] = bflo(u.w); f[7] = bfhi(u.w); }
__device__ __forceinline__ u32x4 pack8(const float* f) { u32x4 o; o.x = cvt_pk_bf16(f[0], f[1]); o.y = cvt_pk_bf16(f[2], f[3]); o.z = cvt_pk_bf16(f[4], f[5]); o.w = cvt_pk_bf16(f[6], f[7]); return o; }
__device__ __forceinline__ float wave_sum(float v) {
#pragma unroll
    for (int o = 1; o < 64; o <<= 1) v += __shfl_xor(v, o);
    return v;
}
__device__ __forceinline__ float sigmoidf_(float x) { return __builtin_amdgcn_rcpf(1.0f + __expf(-x)); }
__device__ __forceinline__ unsigned ld_u32_agent(const unsigned* p) { return __hip_atomic_load(p, __ATOMIC_RELAXED, __HIP_MEMORY_SCOPE_AGENT); }

namespace pg8 {
constexpr int BM = 256, BK = 64, HALF = 128, HTB = HALF * BK * 2, STAGE_BYTES = 8 * HTB, NXCD = 8, WGM = 8;
__host__ __device__ __forceinline__ int lds_byte(int r, int c) { const int st = (r >> 4) * 2 + (c >> 5), rr = r & 15, cc = c & 31, ob = rr * 64 + cc * 2; return st * 1024 + (ob ^ (((ob >> 9) & 1) << 5)); }
__host__ __device__ __forceinline__ void stage_rc(int b, int& R, int& C) { const int st = b / 1024, sb = b % 1024, swz = sb ^ (((sb >> 9) & 1) << 5); R = (st >> 1) * 16 + swz / 64; C = (st & 1) * 32 + (swz % 64) / 2; }
__host__ __device__ __forceinline__ int perm32(int rho) { const int n = rho >> 4, i = rho & 15; return 8 * (i >> 2) + 4 * n + (i & 3); }

struct Unit { int pm, pn, e; };
struct Gemm { const bf16* A; const bf16* Bt; int K; const unsigned* texp; size_t bstride; const int* rowtok; };

struct StaticOrder {
    int nM, nN, nwg, G, c;
    __device__ void init(int nM_, int nN_, int G_, int c_) { nM = nM_; nN = nN_; nwg = nM * nN; G = G_; c = c_; }
    __device__ bool next(int i, Unit& u) const {
        const long L = (long)i * G + c; if (L >= nwg) return false;
        int wgid = (int)L; { const int q = nwg / NXCD, r = nwg % NXCD, xcd = wgid % NXCD, off = wgid / NXCD; wgid = (xcd < r ? xcd * (q + 1) : r * (q + 1) + (xcd - r) * q) + off; }
        const int nig = WGM * nN, gid = wgid / nig, fm = gid * WGM, gsz = (nM - fm) < WGM ? (nM - fm) : WGM;
        u.pm = fm + ((wgid % nig) % gsz); u.pn = (wgid % nig) / gsz; u.e = 0; return true;
    }
};

__device__ __forceinline__ i32x8 cat8(const bf16x8 lo, const bf16x8 hi) { return __builtin_shufflevector(__builtin_bit_cast(i32x4, lo), __builtin_bit_cast(i32x4, hi), 0, 1, 2, 3, 4, 5, 6, 7); }
template <class Epi, bool ALIGN_EPI, bool SP2, bool GATHER = false, bool FP8 = false>
__device__ __forceinline__ void gemm_phase(LAS unsigned char* lds, const Gemm g, const StaticOrder& S, const Epi& E) {
    const int tid = threadIdx.x, wid = __builtin_amdgcn_readfirstlane(tid >> 6), lane = tid & 63, wr = wid >> 2, wc = wid & 3, fr = lane & 15, fq = lane >> 4;
    const int K = g.K, nt = K / BK;
    unsigned voffA[2], voffB[2];
#pragma unroll
    for (int i = 0; i < 2; ++i) { int R, C; stage_rc(tid * 16 + i * 8192, R, C); const int Rb = Epi::PERM ? ((R & ~31) + perm32(R & 31)) : R;
        voffA[i] = (unsigned)(R * K + C) * 2u; voffB[i] = (unsigned)(Rb * K + C) * 2u; }
    unsigned vC[2][2];
#define PG8_GROWS(u, dst) do { _Pragma("unroll") for (int h_ = 0; h_ < 2; ++h_) _Pragma("unroll") for (int i_ = 0; i_ < 2; ++i_) { int R_, C_; stage_rc(tid * 16 + i_ * 8192, R_, C_); \
        dst[h_][i_] = (unsigned)g.rowtok[(u).pm * BM + h_ * HALF + R_] * (unsigned)(K * 2) + (unsigned)(C_ * 2); } } while (0)
    const size_t kstep = (size_t)(BK * 2);
    const size_t hstep = (size_t)HALF * K * 2;
    const size_t tstep = 2 * hstep;
    const unsigned ldsw = (unsigned)wid * 1024u;
    const int aoff = lds_byte(wr * 64 + fr, fq * 8), boff = lds_byte(wc * 32 + fr, fq * 8);
#define PG8_SA(b, h) (((b) * 2 + (h)) * HTB)
#define PG8_SB(b, h) ((4 + (b) * 2 + (h)) * HTB)
#define PG8_STAGE(bufoff, gbase, voff) do { _Pragma("unroll") for (int _i = 0; _i < 2; ++_i) \
        __builtin_amdgcn_global_load_lds((const unsigned*)((const char*)(gbase) + (voff)[_i]), (LAS unsigned*)(lds + (bufoff) + ldsw + _i * 8192), 16, 0, 0); } while (0)
#define PG8_STAGE_A(bufoff, p, h, nx) do { if constexpr (GATHER) { PG8_STAGE(bufoff, p, vC[h]); } else PG8_STAGE(bufoff, (p) + (h) * hstep, voffA); } while (0)
#define PG8_LDA(dst, b, h) do { _Pragma("unroll") for (int m = 0; m < 4; ++m) _Pragma("unroll") for (int k = 0; k < 2; ++k) dst[m][k] = *(const LAS bf16x8*)(lds + PG8_SA(b, h) + aoff + m * 2048 + k * 1024); } while (0)
#define PG8_LDB(dst, b, h) do { _Pragma("unroll") for (int n = 0; n < 2; ++n) _Pragma("unroll") for (int k = 0; k < 2; ++k) dst[n][k] = *(const LAS bf16x8*)(lds + PG8_SB(b, h) + boff + n * 2048 + k * 1024); } while (0)
#define PG8_MMA(ai, bj, At, Bt) do { __builtin_amdgcn_s_setprio(1); \
        if constexpr (FP8) { _Pragma("unroll") for (int m = 0; m < 4; ++m) _Pragma("unroll") for (int n = 0; n < 2; ++n) \
            { const i32x8 b8_ = cat8(Bt[n][0], Bt[n][1]), a8_ = cat8(At[m][0], At[m][1]); asm volatile("v_mfma_f32_16x16x128_f8f6f4 %0, %1, %2, %0" : "+v"(acc[ai][bj][m][n]) : "v"(b8_), "v"(a8_)); } } \
        else { _Pragma("unroll") for (int m = 0; m < 4; ++m) _Pragma("unroll") for (int n = 0; n < 2; ++n) _Pragma("unroll") for (int k = 0; k < 2; ++k) \
            acc[ai][bj][m][n] = __builtin_amdgcn_mfma_f32_16x16x32_bf16(Bt[n][k], At[m][k], acc[ai][bj][m][n], 0, 0, 0); } \
        __builtin_amdgcn_s_setprio(0); } while (0)
#define PG8_WAIT_V(n) asm volatile("s_waitcnt vmcnt(" #n ")" ::: "memory")
#define PG8_WAIT_L(n) asm volatile("s_waitcnt lgkmcnt(" #n ")" ::: "memory")
#define PG8_BAR __builtin_amdgcn_s_barrier()
#define PG8_SCHED __builtin_amdgcn_sched_barrier(0)
#define PG8_UPTR(u, pa, pb) do { unsigned _e = g.texp ? ld_u32_agent(g.texp + (u).pm) : 0u; _e = (unsigned)__builtin_amdgcn_readfirstlane((int)_e); (u).e = (int)_e; \
        pa = GATHER ? (const char*)g.A : (const char*)g.A + (size_t)(u).pm * tstep; pb = (const char*)g.Bt + (size_t)_e * g.bstride + (size_t)(u).pn * tstep; } while (0)
    Unit cur, nxt; int ui = 0;
    if (!S.next(0, cur)) return;
    f32x4 acc[2][2][4][2];
#pragma unroll
    for (int a = 0; a < 2; ++a)
#pragma unroll
        for (int b = 0; b < 2; ++b)
#pragma unroll
            for (int m = 0; m < 4; ++m)
#pragma unroll
                for (int n = 0; n < 2; ++n) acc[a][b][m][n] = (f32x4){0.f, 0.f, 0.f, 0.f};
    bf16x8 At[4][2], B0[2][2], B1[2][2];
    const char* cA; const char* cB;
    PG8_UPTR(cur, cA, cB);
    if constexpr (GATHER) { PG8_GROWS(cur, vC); }
    if constexpr (SP2) {
        PG8_STAGE(PG8_SB(0, 0), cB, voffB); PG8_STAGE(PG8_SB(0, 1), cB + hstep, voffB); PG8_STAGE_A(PG8_SA(0, 0), cA, 0, false); PG8_STAGE_A(PG8_SA(0, 1), cA, 1, false);
        if (wr == 1) PG8_BAR;
        PG8_WAIT_V(2); PG8_BAR;
        PG8_STAGE(PG8_SB(1, 0), cB + kstep, voffB); PG8_STAGE_A(PG8_SA(1, 0), cA + kstep, 0, false); PG8_STAGE(PG8_SB(1, 1), cB + hstep + kstep, voffB);
        PG8_WAIT_V(6); PG8_BAR;
    } else {
        PG8_STAGE(PG8_SB(0, 0), cB, voffB); PG8_STAGE_A(PG8_SA(0, 0), cA, 0, false); PG8_STAGE(PG8_SB(0, 1), cB + hstep, voffB); PG8_STAGE_A(PG8_SA(0, 1), cA, 1, false);
        if (wr == 1) PG8_BAR;
        PG8_WAIT_V(4); PG8_BAR;
        PG8_STAGE(PG8_SB(1, 0), cB + kstep, voffB); PG8_STAGE_A(PG8_SA(1, 0), cA + kstep, 0, false); PG8_STAGE(PG8_SB(1, 1), cB + hstep + kstep, voffB);
        PG8_WAIT_V(6); PG8_BAR;
    }
    for (;;) {
        const bool has_next = S.next(ui + 1, nxt);
        const char* nA = cA; const char* nB = cB;
        if (has_next) PG8_UPTR(nxt, nA, nB);
#pragma unroll 1
        for (int t = 0; t < nt; t += 2) {
            const bool last = (t == nt - 2);
            const char* a1 = cA + (size_t)(t + 1) * kstep;
            const char* a2 = last ? nA : cA + (size_t)(t + 2) * kstep; const char* b2 = last ? nB : cB + (size_t)(t + 2) * kstep;
            const char* a3 = a2 + kstep; const char* b3 = b2 + kstep;
            if constexpr (SP2) {
            PG8_LDB(B0, 0, 0); PG8_LDB(B1, 0, 1); PG8_SCHED; PG8_LDA(At, 0, 0); PG8_STAGE_A(PG8_SA(1, 1), a1, 1, false);
            if constexpr (GATHER) { if (last && has_next) { PG8_GROWS(nxt, vC); } }
            PG8_WAIT_V(8); PG8_WAIT_L(0); PG8_BAR; PG8_MMA(0, 0, At, B0); PG8_MMA(0, 1, At, B1); PG8_BAR; PG8_SCHED;
            PG8_LDA(At, 0, 1); PG8_STAGE(PG8_SB(0, 0), b2, voffB); PG8_STAGE(PG8_SB(0, 1), b2 + hstep, voffB); PG8_STAGE_A(PG8_SA(0, 0), a2, 0, last);
            PG8_WAIT_V(8); PG8_WAIT_L(0); PG8_BAR; PG8_MMA(1, 0, At, B0); PG8_MMA(1, 1, At, B1); PG8_BAR; PG8_SCHED;
            PG8_LDB(B0, 1, 0); PG8_LDB(B1, 1, 1); PG8_SCHED; PG8_LDA(At, 1, 0); PG8_STAGE_A(PG8_SA(0, 1), a2, 1, last);
            PG8_WAIT_V(8); PG8_WAIT_L(0); PG8_BAR; PG8_MMA(0, 0, At, B0); PG8_MMA(0, 1, At, B1); PG8_BAR; PG8_SCHED;
            PG8_LDA(At, 1, 1); PG8_STAGE(PG8_SB(1, 0), b3, voffB); PG8_STAGE(PG8_SB(1, 1), b3 + hstep, voffB); PG8_STAGE_A(PG8_SA(1, 0), a3, 0, last);
            PG8_WAIT_V(8); PG8_WAIT_L(0); PG8_BAR; PG8_MMA(1, 0, At, B0); PG8_MMA(1, 1, At, B1); PG8_BAR; PG8_SCHED;
            } else {
            PG8_LDB(B0, 0, 0); PG8_SCHED; PG8_LDA(At, 0, 0); PG8_STAGE_A(PG8_SA(1, 1), a1, 1, false);
            if constexpr (GATHER) { if (last && has_next) { PG8_GROWS(nxt, vC); } }
            PG8_WAIT_L(8); PG8_BAR; PG8_WAIT_L(0); PG8_MMA(0, 0, At, B0); PG8_BAR; PG8_SCHED;
            PG8_LDB(B1, 0, 1); PG8_STAGE(PG8_SB(0, 0), b2, voffB);
            PG8_BAR; PG8_WAIT_L(0); PG8_MMA(0, 1, At, B1); PG8_BAR;
            PG8_LDA(At, 0, 1); PG8_STAGE_A(PG8_SA(0, 0), a2, 0, last);
            PG8_BAR; PG8_WAIT_L(0); PG8_MMA(1, 0, At, B0); PG8_BAR; PG8_SCHED;
            PG8_STAGE(PG8_SB(0, 1), b2 + hstep, voffB);
            PG8_WAIT_V(6); PG8_BAR; PG8_MMA(1, 1, At, B1); PG8_BAR;
            PG8_LDB(B0, 1, 0); PG8_SCHED; PG8_LDA(At, 1, 0); PG8_STAGE_A(PG8_SA(0, 1), a2, 1, last);
            PG8_WAIT_L(8); PG8_BAR; PG8_WAIT_L(0); PG8_MMA(0, 0, At, B0); PG8_BAR; PG8_SCHED;
            PG8_LDB(B1, 1, 1); PG8_STAGE(PG8_SB(1, 0), b3, voffB);
            PG8_BAR; PG8_WAIT_L(0); PG8_MMA(0, 1, At, B1); PG8_BAR;
            PG8_LDA(At, 1, 1); PG8_STAGE_A(PG8_SA(1, 0), a3, 0, last);
            PG8_BAR; PG8_WAIT_L(0); PG8_MMA(1, 0, At, B0); PG8_BAR; PG8_SCHED;
            PG8_STAGE(PG8_SB(1, 1), b3 + hstep, voffB);
            PG8_WAIT_V(6); PG8_BAR; PG8_MMA(1, 1, At, B1); PG8_BAR;
            }
        }
        if constexpr (ALIGN_EPI) { if (wr == 0) PG8_BAR; }
        if constexpr (FP8) { asm volatile("s_nop 15\n\ts_nop 15" ::: "memory"); PG8_SCHED; }
        E(acc, cur, wr, wc, fr, fq);
        if (!has_next) break;
#pragma unroll
        for (int a = 0; a < 2; ++a)
#pragma unroll
            for (int b = 0; b < 2; ++b)
#pragma unroll
                for (int m = 0; m < 4; ++m)
#pragma unroll
                    for (int n = 0; n < 2; ++n) acc[a][b][m][n] = (f32x4){0.f, 0.f, 0.f, 0.f};
        cur = nxt; cA = nA; cB = nB; ++ui;
        if constexpr (ALIGN_EPI) { if (wr == 1) PG8_BAR; }
    }
    PG8_WAIT_V(0);
    if constexpr (!ALIGN_EPI) { if (wr == 0) PG8_BAR; }
    PG8_BAR;
#undef PG8_SA
#undef PG8_SB
#undef PG8_STAGE
#undef PG8_LDA
#undef PG8_LDB
#undef PG8_MMA
#undef PG8_WAIT_V
#undef PG8_WAIT_L
#undef PG8_BAR
#undef PG8_SCHED
#undef PG8_UPTR
#undef PG8_STAGE_A
#undef PG8_GROWS
}

struct EpiProj {
    static constexpr bool PERM = true;
    bf16 *q, *k, *vT, *p;
    __device__ __forceinline__ void operator()(const f32x4 (&acc)[2][2][4][2], const Unit& u, int wr, int wc, int fr, int fq) const {
        const int row0 = u.pm * BM + wr * 64 + fr;
        const int pn = u.pn;
#pragma unroll
        for (int ai = 0; ai < 2; ++ai)
#pragma unroll
            for (int m = 0; m < 4; ++m) {
                const int row = row0 + ai * HALF + m * 16;
#pragma unroll
                for (int bj = 0; bj < 2; ++bj) {
                    f32x4 v0 = acc[ai][bj][m][0], v1 = acc[ai][bj][m][1];
                    const int col = pn * BM + bj * HALF + wc * 32 + 8 * fq;
                    if (pn >= 4 && pn < 6) {
                        const int cv = col - 1024, hh = cv >> 6, dim = cv & 63, b = row / T, t = row % T;
                        bf16* dst = vT + ((size_t)(((b * NH + hh) * GROWS + (t >> 6)) * HD + dim)) * 64 + (t & 63);
                        const unsigned w0 = cvt_pk_bf16(v0[0], v0[1]), w1 = cvt_pk_bf16(v0[2], v0[3]), w2 = cvt_pk_bf16(v1[0], v1[1]), w3 = cvt_pk_bf16(v1[2], v1[3]);
                        dst[0 * 64] = (bf16)(w0 & 0xffff); dst[1 * 64] = (bf16)(w0 >> 16); dst[2 * 64] = (bf16)(w1 & 0xffff); dst[3 * 64] = (bf16)(w1 >> 16);
                        dst[4 * 64] = (bf16)(w2 & 0xffff); dst[5 * 64] = (bf16)(w2 >> 16); dst[6 * 64] = (bf16)(w3 & 0xffff); dst[7 * 64] = (bf16)(w3 >> 16);
                    } else {
                        bf16* dst;
                        if (pn < 2) { v0 = v0 * 0.125f; v1 = v1 * 0.125f; dst = q + (size_t)row * CW + col; }
                        else if (pn < 4) dst = k + (size_t)row * CW + (col - 512);
                        else dst = p + (size_t)row * PW + (col - 1536);
                        u32x4 w; w.x = cvt_pk_bf16(v0[0], v0[1]); w.y = cvt_pk_bf16(v0[2], v0[3]); w.z = cvt_pk_bf16(v1[0], v1[1]); w.w = cvt_pk_bf16(v1[2], v1[3]);
                        *(u32x4*)dst = w;
                    }
                }
            }
    }
};
struct EpiWo {
    static constexpr bool PERM = true;
    const float* x; bf16* h;
    __device__ __forceinline__ void operator()(const f32x4 (&acc)[2][2][4][2], const Unit& u, int wr, int wc, int fr, int fq) const {
        const int row0 = u.pm * BM + wr * 64 + fr, col0 = u.pn * BM + wc * 32 + 8 * fq;
#pragma unroll
        for (int ai = 0; ai < 2; ++ai)
#pragma unroll
            for (int m = 0; m < 4; ++m) { const size_t off = (size_t)(row0 + ai * HALF + m * 16) * D + col0;
#pragma unroll
                for (int bj = 0; bj < 2; ++bj) { const f32x4 v0 = acc[ai][bj][m][0] + *(const f32x4*)(x + off + bj * HALF), v1 = acc[ai][bj][m][1] + *(const f32x4*)(x + off + bj * HALF + 4);
                    u32x4 w; w.x = cvt_pk_bf16(v0[0], v0[1]); w.y = cvt_pk_bf16(v0[2], v0[3]); w.z = cvt_pk_bf16(v1[0], v1[1]); w.w = cvt_pk_bf16(v1[2], v1[3]);
                    *(u32x4*)(h + off + bj * HALF) = w; } }
    }
};
struct EpiUp {
    static constexpr bool PERM = true;
    const float* b_up; unsigned char* act;
    __device__ __forceinline__ void operator()(const f32x4 (&acc)[2][2][4][2], const Unit& u, int wr, int wc, int fr, int fq) const {
        const int row0 = u.pm * BM + wr * 64 + fr, ch = u.pn * 128 + wc * 32 + 8 * fq;
        const float* bg = b_up + (size_t)u.e * 2048 + ch; const float* bl = bg + 1024;
        const f32x4 bg0 = *(const f32x4*)bg * F8_SACT, bg1 = *(const f32x4*)(bg + 4) * F8_SACT, bl0 = *(const f32x4*)bl, bl1 = *(const f32x4*)(bl + 4);
        constexpr float SG = F8_SACT / (F8_SX * F8_SW), SL = 1.0f / (F8_SX * F8_SW), KE = -1.702f * 1.44269504f / F8_SACT;
#pragma unroll
        for (int ai = 0; ai < 2; ++ai)
#pragma unroll
            for (int m = 0; m < 4; ++m) {
                float o[8];
#pragma unroll
                for (int n = 0; n < 2; ++n) { const f32x4 gv = acc[ai][0][m][n] * SG + (n ? bg1 : bg0), lv = acc[ai][1][m][n] * SL + (n ? bl1 : bl0);
#pragma unroll
                    for (int j = 0; j < 4; ++j) { const float gt = fminf(gv[j], 7.0f * F8_SACT), li = __builtin_amdgcn_fmed3f(lv[j], -7.0f, 7.0f);
                        const float t = gt * __builtin_amdgcn_rcpf(1.0f + __builtin_amdgcn_exp2f(gt * KE)); o[n * 4 + j] = __builtin_fmaf(li, t, t); } }
                int w0 = 0, w1 = 0;
                w0 = __builtin_amdgcn_cvt_pk_fp8_f32(o[0], o[1], w0, false); w0 = __builtin_amdgcn_cvt_pk_fp8_f32(o[2], o[3], w0, true);
                w1 = __builtin_amdgcn_cvt_pk_fp8_f32(o[4], o[5], w1, false); w1 = __builtin_amdgcn_cvt_pk_fp8_f32(o[6], o[7], w1, true);
                u32x2 w8; w8.x = (unsigned)w0; w8.y = (unsigned)w1;
                *(u32x2*)(act + (size_t)(row0 + ai * HALF + m * 16) * DE + ch) = w8;
            }
    }
};
struct EpiDown {
    static constexpr bool PERM = true;
    const float* b_dn; unsigned char* y;
    __device__ __forceinline__ void operator()(const f32x4 (&acc)[2][2][4][2], const Unit& u, int wr, int wc, int fr, int fq) const {
        const int row0 = u.pm * BM + wr * 64 + fr, col0 = u.pn * BM + wc * 32 + 8 * fq;
        const float* bb = b_dn + (size_t)u.e * D + col0;
        f32x4 bv[2][2];
#pragma unroll
        for (int bj = 0; bj < 2; ++bj)
#pragma unroll
            for (int n = 0; n < 2; ++n) bv[bj][n] = *(const f32x4*)(bb + bj * HALF + 4 * n) * F8_SY;
#pragma unroll
        for (int ai = 0; ai < 2; ++ai)
#pragma unroll
            for (int m = 0; m < 4; ++m) { unsigned char* rowp = y + (size_t)(row0 + ai * HALF + m * 16) * D + col0;
#pragma unroll
                for (int bj = 0; bj < 2; ++bj) { const f32x4 v0 = acc[ai][bj][m][0] * (F8_SY / (F8_SACT * F8_SW)) + bv[bj][0], v1 = acc[ai][bj][m][1] * (F8_SY / (F8_SACT * F8_SW)) + bv[bj][1];
                    u32x2 w; w.x = pk4_fp8(v0[0], v0[1], v0[2], v0[3]); w.y = pk4_fp8(v1[0], v1[1], v1[2], v1[3]);
                    *(u32x2*)(rowp + bj * HALF) = w; } }
    }
};
}


#define XB_TMO      128
#define XB_XCNT(j)  (256  + 64 * (j))
#define XB_XSUB(j)  (1280 + 64 * (j))
#define XB_XGEN(j)  (2304 + 64 * (j))
#define XB_TOP      3328
#define XB_TOPGEN   3392
#define XCD_BAR_WORDS 3456
#define XB_SPIN_CAP (1u << 20)
__device__ __forceinline__ unsigned xb_ld(unsigned* p)              { return __hip_atomic_load(p, __ATOMIC_RELAXED, __HIP_MEMORY_SCOPE_AGENT); }
__device__ __forceinline__ unsigned xb_add(unsigned* p, unsigned v) { return __hip_atomic_fetch_add(p, v, __ATOMIC_RELAXED, __HIP_MEMORY_SCOPE_AGENT); }
__device__ __forceinline__ unsigned xb_xcc_id() { return (unsigned)__builtin_amdgcn_s_getreg((3 << 11) | 20) & 0xFu; }
#define XB_SPIN(cond, bar) do { unsigned _sp = 0; while (cond) { __builtin_amdgcn_s_sleep(1); \
    if ((++_sp & 255u) == 0u) { if (xb_ld(&(bar)[XB_TMO])) break; if (_sp > XB_SPIN_CAP) { atomicAdd(&(bar)[XB_TMO], 1u); break; } } } } while (0)
struct XcdBarrier { unsigned* bar; unsigned x; volatile LAS unsigned* st; };
__device__ __forceinline__ XcdBarrier xcd_barrier_post(unsigned* bar, volatile LAS unsigned* st) {
    XcdBarrier b; b.bar = bar; b.x = xb_xcc_id(); b.st = st;
    if (threadIdx.x == 0) (void)xb_add(&bar[XB_XCNT(b.x)], 1u);
    return b;
}
__device__ __forceinline__ void xcd_barrier_complete(unsigned* bar, unsigned x, unsigned& nloc, unsigned& nx) {
    const unsigned G = gridDim.x * gridDim.y * gridDim.z;
    unsigned sum, cnt, mine, sp = 0u;
    for (;;) {
        sum = 0u; cnt = 0u; mine = 0u;
#pragma unroll
        for (unsigned j = 0; j < 16; ++j) { const unsigned c = xb_ld(&bar[XB_XCNT(j)]); sum += c; cnt += (c > 0u) ? 1u : 0u; mine = (j == x) ? c : mine; }
        if (sum == G) break;
        __builtin_amdgcn_s_sleep(1);
        if ((++sp & 255u) == 0u) { if (xb_ld(&bar[XB_TMO])) break; if (sp > XB_SPIN_CAP) { atomicAdd(&bar[XB_TMO], 1u); break; } }
    }
    nloc = mine > 0u ? mine : 1u; nx = cnt > 0u ? cnt : 1u;
}
__device__ __forceinline__ void xcd_barrier(const XcdBarrier& b) {
    asm volatile("s_waitcnt vmcnt(0)" ::: "memory");
    __syncthreads();
    if (threadIdx.x == 0) {
        unsigned* bar = b.bar;
        __builtin_amdgcn_s_waitcnt(0);
        unsigned nloc = b.st[0], nx = b.st[1];
        if (nloc == 0u) { xcd_barrier_complete(bar, b.x, nloc, nx); b.st[0] = nloc; b.st[1] = nx; }
        const unsigned old = xb_add(&bar[XB_XSUB(b.x)], 1u);
        const unsigned gen = old / nloc;
        if (old + 1u == (gen + 1u) * nloc) {
            __builtin_amdgcn_fence(__ATOMIC_RELEASE, "agent");
            asm volatile("s_waitcnt vmcnt(0)" ::: "memory");
            const unsigned og = xb_add(&bar[XB_TOP], 1u);
            const unsigned tg = og / nx;
            if (og + 1u == (tg + 1u) * nx) xb_add(&bar[XB_TOPGEN], 1u);
            else XB_SPIN(xb_ld(&bar[XB_TOPGEN]) == tg, bar);
            __builtin_amdgcn_fence(__ATOMIC_ACQUIRE, "agent");
            xb_add(&bar[XB_XGEN(b.x)], 1u);
            asm volatile("s_waitcnt vmcnt(0)" ::: "memory");
        } else {
            XB_SPIN(xb_ld(&bar[XB_XGEN(b.x)]) == gen, bar);
            __builtin_amdgcn_fence(__ATOMIC_ACQUIRE, "agent");
            asm volatile("s_waitcnt vmcnt(0)" ::: "memory");
        }
    }
    __syncthreads();
}

struct Args { const float* in[26]; float* out; unsigned char* ws; int ph_lo, ph_hi; };

struct Frame { LAS unsigned char* lds; int tid, lane, wave, G, vcu; };

__device__ __forceinline__ void transpose_item(const float* W, int K, int N, bf16* WT, int k0, int n0, int orow0, LAS float* scr, int lane) {
#pragma unroll 8
    for (int i = 0; i < 32; ++i) { const int kk = 2 * i + (lane >> 5); scr[kk * 33 + (lane & 31)] = W[(size_t)(k0 + kk) * N + n0 + (lane & 31)]; }
    asm volatile("s_waitcnt lgkmcnt(0)" ::: "memory");
    const int c = lane & 7;
#pragma unroll
    for (int j = 0; j < 4; ++j) { const int n = (lane >> 3) + 8 * j; const LAS float* s = scr + (8 * c) * 33 + n;
        u32x4 o; o.x = cvt_pk_bf16(s[0 * 33], s[1 * 33]); o.y = cvt_pk_bf16(s[2 * 33], s[3 * 33]); o.z = cvt_pk_bf16(s[4 * 33], s[5 * 33]); o.w = cvt_pk_bf16(s[6 * 33], s[7 * 33]);
        *(u32x4*)(WT + (size_t)(orow0 + n) * K + k0 + 8 * c) = o; }
    asm volatile("s_waitcnt lgkmcnt(0)" ::: "memory");
}

__device__ __forceinline__ void transpose_item8(const float* W, int K, int N, unsigned char* WT, int k0, int n0, int orow0, LAS float* scr, int lane) {
#pragma unroll 8
    for (int i = 0; i < 32; ++i) { const int kk = 2 * i + (lane >> 5); scr[kk * 33 + (lane & 31)] = W[(size_t)(k0 + kk) * N + n0 + (lane & 31)]; }
    asm volatile("s_waitcnt lgkmcnt(0)" ::: "memory");
    const int c = lane & 7;
#pragma unroll
    for (int j = 0; j < 4; ++j) { const int n = (lane >> 3) + 8 * j; const LAS float* s = scr + (8 * c) * 33 + n;
        u32x2 o; o.x = pk4_fp8(s[0 * 33] * F8_SW, s[1 * 33] * F8_SW, s[2 * 33] * F8_SW, s[3 * 33] * F8_SW); o.y = pk4_fp8(s[4 * 33] * F8_SW, s[5 * 33] * F8_SW, s[6 * 33] * F8_SW, s[7 * 33] * F8_SW);
        *(u32x2*)(WT + (size_t)(orow0 + n) * K + k0 + 8 * c) = o; }
    asm volatile("s_waitcnt lgkmcnt(0)" ::: "memory");
}

__device__ __forceinline__ void p0_prologue(const Frame& F, const Args& a) {
    unsigned char* ws = a.ws;
    LAS float* scr = (LAS float*)(F.lds + F.wave * 8448);
    const int gw = F.vcu * 8 + F.wave, NGW = F.G * 8;
    constexpr int I_IN = 16 * 108, I_O = 16 * 32, I_UP = 32 * 16 * 64, I_DN = 32 * 16 * 32, I_L = 16, I_G = 32;
    constexpr int NITEMS = I_IN + I_O + I_UP + I_DN + 2 * I_L + 2 * I_L + I_G;
    for (int it = gw; it < NITEMS; it += NGW) {
        int r = it;
        if (r < I_UP) {
            const int e = r / 1024, q = r % 1024, kb = q / 64, nb = q % 64, n0 = nb * 32;
            const int orow0 = n0 < 1024 ? 256 * (n0 >> 7) + (n0 & 127) : 256 * ((n0 - 1024) >> 7) + 128 + ((n0 - 1024) & 127);
            transpose_item8(a.in[21] + (size_t)e * 1024 * 2048, 1024, 2048, ws + WS_WUPT + (size_t)e * 2048 * 1024, kb * 64, n0, orow0, scr, F.lane); continue; }
        r -= I_UP;
        if (r < I_DN) { const int e = r / 512, q = r % 512, kb = q / 32, nb = q % 32;
            transpose_item8(a.in[23] + (size_t)e * 1024 * 1024, 1024, 1024, ws + WS_WDNT + (size_t)e * 1024 * 1024, kb * 64, nb * 32, nb * 32, scr, F.lane); continue; }
        r -= I_DN;
        if (r < I_IN) { const int kb = r / 108, nb = r % 108; transpose_item(a.in[2], 1024, NPROJ, (bf16*)(ws + WS_WINT), kb * 64, nb * 32, nb * 32, scr, F.lane); continue; }
        r -= I_IN;
        if (r < I_O) { const int kb = r / 32, nb = r % 32; transpose_item(a.in[17], 1024, 1024, (bf16*)(ws + WS_WOT), kb * 64, nb * 32, nb * 32, scr, F.lane); continue; }
        r -= I_O;
        if (r < 2 * I_L) { const int z = r / 16, nb = r % 16; transpose_item(a.in[8] + (size_t)z * 64 * 512, 64, 512, (bf16*)(ws + WS_W2T) + (size_t)z * 512 * 64, 0, nb * 32, nb * 32, scr, F.lane); continue; }
        r -= 2 * I_L;
        if (r < 2 * I_L) { const int z = r / 16, nb = r % 16; transpose_item(a.in[10] + (size_t)z * 64 * 512, 64, 512, (bf16*)(ws + WS_A2T) + (size_t)z * 512 * 64, 0, nb * 32, nb * 32, scr, F.lane); continue; }
        r -= 2 * I_L;
        { const int kb = r / 16, nb = r % 16; transpose_item(a.in[11], 128, 512, (bf16*)(ws + WS_G2T), kb * 64, nb * 32, nb * 32, scr, F.lane); }
    }
    { u32x4* z = (u32x4*)(ws + WS_WINT + (size_t)NPROJ * 1024 * 2); const u32x4 zero = {0u, 0u, 0u, 0u};
      for (int i = F.vcu * 512 + F.tid; i < 16384; i += F.G * 512) z[i] = zero; }
    const float* x = a.in[0]; const float* nw = a.in[1]; bf16* hn = (bf16*)(ws + WS_HN);
    f32x4 wv[4];
#pragma unroll
    for (int j = 0; j < 4; ++j) wv[j] = *((const f32x4*)nw + F.lane + 64 * j);
    for (int m = gw; m < M; m += 2 * NGW) {
        const int m1 = m + NGW; const bool has1 = m1 < M;
        const f32x4* xr0 = (const f32x4*)(x + (size_t)m * D) + F.lane; const f32x4* xr1 = (const f32x4*)(x + (size_t)(has1 ? m1 : m) * D) + F.lane;
        f32x4 v0[4], v1[4]; float s0 = 0.f, s1 = 0.f;
#pragma unroll
        for (int j = 0; j < 4; ++j) { v0[j] = xr0[64 * j]; v1[j] = xr1[64 * j]; }
#pragma unroll
        for (int j = 0; j < 4; ++j) { s0 += (v0[j].x * v0[j].x + v0[j].y * v0[j].y) + (v0[j].z * v0[j].z + v0[j].w * v0[j].w); s1 += (v1[j].x * v1[j].x + v1[j].y * v1[j].y) + (v1[j].z * v1[j].z + v1[j].w * v1[j].w); }
        const float rs0 = rsqrtf(wave_sum(s0) * (1.f / D) + RMS_EPS), rs1 = rsqrtf(wave_sum(s1) * (1.f / D) + RMS_EPS);
        u32x2* o0 = (u32x2*)(hn + (size_t)m * D) + F.lane; u32x2* o1 = (u32x2*)(hn + (size_t)m1 * D) + F.lane;
#pragma unroll
        for (int j = 0; j < 4; ++j) { u32x2 o; o.x = cvt_pk_bf16(v0[j].x * rs0 * wv[j].x, v0[j].y * rs0 * wv[j].y); o.y = cvt_pk_bf16(v0[j].z * rs0 * wv[j].z, v0[j].w * rs0 * wv[j].w); o0[64 * j] = o; }
        if (has1) {
#pragma unroll
            for (int j = 0; j < 4; ++j) { u32x2 o; o.x = cvt_pk_bf16(v1[j].x * rs1 * wv[j].x, v1[j].y * rs1 * wv[j].y); o.y = cvt_pk_bf16(v1[j].z * rs1 * wv[j].z, v1[j].w * rs1 * wv[j].w); o1[64 * j] = o; } }
    }
}

constexpr int PREP_KBUF = 0, PREP_INV = 65536, PREP_AW = 67584, PREP_AA = PREP_AW + 17408, PREP_AG = PREP_AA + 17408, PREP_LD = 136;
template <bool STORE>
__device__ __forceinline__ void prep_phase(const Frame& F, const Args& a) {
    unsigned char* ws = a.ws;
    const bf16* p = (const bf16*)(ws + WS_P);
    bf16* r_out = (bf16*)(ws + WS_R); bf16* v_out = (bf16*)(ws + WS_V); bf16* kk_out = (bf16*)(ws + WS_KK);
    bf16* decay_out = (bf16*)(ws + WS_DECAY); bf16* kdir_out = (bf16*)(ws + WS_KDIR); bf16* akk_out = (bf16*)(ws + WS_AKK); bf16* g_out = (bf16*)(ws + WS_G);
    const bf16* w2T = (const bf16*)(ws + WS_W2T); const bf16* a2T = (const bf16*)(ws + WS_A2T); const bf16* g2T = (const bf16*)(ws + WS_G2T);
    const float* mu_p = a.in[5]; const float* mu_n = a.in[6]; const float* w0 = a.in[7]; const float* a0 = a.in[9];
    const float* k_k = a.in[12]; const float* k_a = a.in[13];
    LAS bf16* kbuf = (LAS bf16*)(F.lds + PREP_KBUF); LAS float* invb = (LAS float*)(F.lds + PREP_INV);
    LAS bf16* Aw = (LAS bf16*)(F.lds + PREP_AW); LAS bf16* Aa = (LAS bf16*)(F.lds + PREP_AA); LAS bf16* Ag = (LAS bf16*)(F.lds + PREP_AG);
    const int lane = F.lane, wave = F.wave, fr = lane & 15, fg = lane >> 4;
    for (int tile = F.vcu; tile < M / 64; tile += F.G) {
        const int m0 = tile * 64;
#pragma unroll 1
        for (int jj = 0; jj < 4; ++jj) {
            const int q = lane + 64 * jj; const bool valid = q < 240; const int c0 = 8 * q;
            float mp[8], mn[8];
#pragma unroll
            for (int i = 0; i < 8; ++i) { mp[i] = valid ? mu_p[c0 + i] : 0.f; mn[i] = valid ? mu_n[c0 + i] : 0.f; }
            const int mfirst = m0 + wave * 8;
            const u32x4 zero = {0u, 0u, 0u, 0u};
            u32x4 rows[10];
#pragma unroll
            for (int rI = 0; rI < 10; ++rI) { const int mr = mfirst - 1 + rI;
                const bool ok = valid && !(rI == 0 && (mfirst % T) == 0) && !(rI == 9 && ((mfirst + 7) % T) == T - 1);
                rows[rI] = ok ? *(const u32x4*)(p + (size_t)mr * PW + c0) : zero; }
#pragma unroll
            for (int i = 0; i < 8; ++i) {
                const int m = mfirst + i, it = wave * 8 + i;
                const u32x4 prev = rows[i], cur = rows[i + 1], nxt = rows[i + 2];
                float fp[8], fc[8], fn[8], s[8];
                unpack8(prev, fp); unpack8(cur, fc); unpack8(nxt, fn);
#pragma unroll
                for (int e = 0; e < 8; ++e) s[e] = fc[e] + mp[e] * (fp[e] - fc[e]) + mn[e] * (fn[e] - fc[e]);
                if (jj == 0) { if (STORE) { *(u32x4*)(r_out + (size_t)m * CW + c0) = pack8(s); } }
                else if (jj == 1) {
                    const int c = c0 - 512;
                    *(LAS u32x4*)(kbuf + it * 512 + c) = pack8(s);
                    float kr[8]; float ss = 0.f;
#pragma unroll
                    for (int e = 0; e < 8; ++e) { kr[e] = s[e] * k_k[c + e]; ss += kr[e] * kr[e]; }
                    ss += __shfl_xor(ss, 1); ss += __shfl_xor(ss, 2); ss += __shfl_xor(ss, 4);
                    const float inv = fminf(__builtin_amdgcn_rsqf(ss), 1e12f);
#pragma unroll
                    for (int e = 0; e < 8; ++e) kr[e] *= inv;
                    if (STORE) { *(u32x4*)(kk_out + (size_t)m * CW + c) = pack8(kr); }
                    if ((lane & 7) == 0) invb[it * 8 + (lane >> 3)] = inv;
                }
                else if (jj == 2) { if (STORE) { *(u32x4*)(v_out + (size_t)m * CW + (c0 - 1024)) = pack8(s); } }
                else if (valid) {
                    const int seg = lane >> 4, cw = 8 * (lane & 15);
                    if (seg == 0) {
#pragma unroll
                        for (int e = 0; e < 8; ++e) s[e] = 1.0f - 2.0f * __builtin_amdgcn_rcpf(__expf(2.0f * s[e]) + 1.0f);
                        *(LAS u32x4*)(Aw + it * PREP_LD + cw) = pack8(s);
                    } else if (seg == 1) { *(LAS u32x4*)(Aa + it * PREP_LD + cw) = pack8(s); }
                    else {
#pragma unroll
                        for (int e = 0; e < 8; ++e) s[e] = sigmoidf_(s[e]);
                        *(LAS u32x4*)(Ag + it * PREP_LD + cw) = pack8(s);
                    }
                }
            }
        }
        __syncthreads();
        const int nb = 64 * wave;
#define PREP_PROW(nt_) (nb + 32 * ((nt_) >> 1) + 8 * (fr >> 2) + 4 * ((nt_) & 1) + (fr & 3))
#define PREP_COL(nt_)  (nb + 32 * ((nt_) >> 1) + 8 * fg + 4 * ((nt_) & 1))
#pragma unroll 1
        for (int job = 0; job < 4; ++job) {
            const int z = job & 1;
            const bf16* WT = job < 2 ? w2T + (size_t)z * 512 * 64 : a2T + (size_t)z * 512 * 64;
            const LAS bf16* Ax = job < 2 ? Aw + z * 64 : Aa + z * 64;
            bf16x8 wf[2][4];
#pragma unroll
            for (int ks = 0; ks < 2; ++ks)
#pragma unroll
                for (int nt = 0; nt < 4; ++nt) wf[ks][nt] = *(const bf16x8*)(WT + (size_t)PREP_PROW(nt) * 64 + 32 * ks + 8 * fg);
            f32x4 pb[4], pkk[4], pka[4];
#pragma unroll
            for (int nt = 0; nt < 4; ++nt) { const int n = PREP_COL(nt);
                pb[nt] = *(const f32x4*)((job < 2 ? w0 : a0) + z * 512 + n); pkk[nt] = *(const f32x4*)(k_k + n); pka[nt] = *(const f32x4*)(k_a + n); }
            f32x4 acc[4][4];
#pragma unroll
            for (int mt = 0; mt < 4; ++mt)
#pragma unroll
                for (int nt = 0; nt < 4; ++nt) acc[mt][nt] = (f32x4){0.f, 0.f, 0.f, 0.f};
#pragma unroll
            for (int ks = 0; ks < 2; ++ks) {
                bf16x8 af[4];
#pragma unroll
                for (int mt = 0; mt < 4; ++mt) af[mt] = *(const LAS bf16x8*)(Ax + (16 * mt + fr) * PREP_LD + 32 * ks + 8 * fg);
#pragma unroll
                for (int mt = 0; mt < 4; ++mt)
#pragma unroll
                    for (int nt = 0; nt < 4; ++nt) acc[mt][nt] = __builtin_amdgcn_mfma_f32_16x16x32_bf16(wf[ks][nt], af[mt], acc[mt][nt], 0, 0, 0);
            }
#pragma unroll
            for (int mt = 0; mt < 4; ++mt) {
                const int it = 16 * mt + fr; const size_t m = (size_t)(m0 + it);
#pragma unroll
                for (int np = 0; np < 2; ++np) {
                    const int c8 = nb + 32 * np + 8 * fg;
                    if (job < 2) {
                        float o[8];
#pragma unroll
                        for (int hh = 0; hh < 2; ++hh) { const f32x4 v = acc[mt][2 * np + hh], bq = pb[2 * np + hh];
#pragma unroll
                            for (int i = 0; i < 4; ++i) o[4 * hh + i] = __expf(-0.60653066f * sigmoidf_(v[i] + bq[i])); }
                        if (STORE) { *(u32x4*)(decay_out + ((size_t)z * M + m) * CW + c8) = pack8(o); }
                    } else {
                        const u32x4 kb = *(const LAS u32x4*)(kbuf + it * 512 + c8);
                        float kv[8]; unpack8(kb, kv);
                        const float inv = invb[it * 8 + wave];
                        float kd[8], ak[8];
#pragma unroll
                        for (int hh = 0; hh < 2; ++hh) { const f32x4 v = acc[mt][2 * np + hh], bq = pb[2 * np + hh], kkc = pkk[2 * np + hh], kac = pka[2 * np + hh];
#pragma unroll
                            for (int i = 0; i < 4; ++i) { const float av = sigmoidf_(v[i] + bq[i]), kx = kv[4 * hh + i]; kd[4 * hh + i] = kx * (1.0f + (av - 1.0f) * kac[i]); ak[4 * hh + i] = av * (kx * kkc[i] * inv); } }
                        if (STORE) { *(u32x4*)(kdir_out + ((size_t)z * M + m) * CW + c8) = pack8(kd); *(u32x4*)(akk_out + ((size_t)z * M + m) * CW + c8) = pack8(ak); }
                    }
                }
            }
        }
        {
            bf16x8 wf[4][4];
#pragma unroll
            for (int ks = 0; ks < 4; ++ks)
#pragma unroll
                for (int nt = 0; nt < 4; ++nt) wf[ks][nt] = *(const bf16x8*)(g2T + (size_t)PREP_PROW(nt) * 128 + 32 * ks + 8 * fg);
            f32x4 acc[4][4];
#pragma unroll
            for (int mt = 0; mt < 4; ++mt)
#pragma unroll
                for (int nt = 0; nt < 4; ++nt) acc[mt][nt] = (f32x4){0.f, 0.f, 0.f, 0.f};
#pragma unroll
            for (int ks = 0; ks < 4; ++ks) {
                bf16x8 af[4];
#pragma unroll
                for (int mt = 0; mt < 4; ++mt) af[mt] = *(const LAS bf16x8*)(Ag + (16 * mt + fr) * PREP_LD + 32 * ks + 8 * fg);
#pragma unroll
                for (int mt = 0; mt < 4; ++mt)
#pragma unroll
                    for (int nt = 0; nt < 4; ++nt) acc[mt][nt] = __builtin_amdgcn_mfma_f32_16x16x32_bf16(wf[ks][nt], af[mt], acc[mt][nt], 0, 0, 0);
            }
#pragma unroll
            for (int mt = 0; mt < 4; ++mt) { const size_t m = (size_t)(m0 + 16 * mt + fr);
#pragma unroll
                for (int np = 0; np < 2; ++np) { const f32x4 v0 = acc[mt][2 * np], v1 = acc[mt][2 * np + 1];
                    u32x4 w; w.x = cvt_pk_bf16(v0[0], v0[1]); w.y = cvt_pk_bf16(v0[2], v0[3]); w.z = cvt_pk_bf16(v1[0], v1[1]); w.w = cvt_pk_bf16(v1[2], v1[3]);
                    if (STORE) { *(u32x4*)(g_out + m * CW + nb + 32 * np + 8 * fg) = w; } } }
        }
#undef PREP_PROW
#undef PREP_COL
        __syncthreads();
    }
}

__device__ __forceinline__ void attn_phase(const Frame& F, const Args& a) {
    unsigned char* ws = a.ws;
    const bf16* q = (const bf16*)(ws + WS_Q); const bf16* k = (const bf16*)(ws + WS_K); const bf16* vT = (const bf16*)(ws + WS_VT);
    bf16* att = (bf16*)(ws + WS_ATT);
    LAS float* bias = (LAS float*)F.lds;
    for (int i = F.tid; i < 8 * 15 * 31; i += 512) bias[i] = a.in[3][i];
    __syncthreads();
    const int lane = F.lane, fr = lane & 15, fg = lane >> 4;
    const int NGW = F.G * 8, gw = F.vcu * 8 + F.wave;
    const int per = (16384 + NGW - 1) / NGW;
    for (int task = gw * per; task < (gw + 1) * per && task < 16384; ++task) {
        const int cgp = task & 3, r = (task >> 2) & 127, h = (task >> 9) & 7, b = task >> 12;
        const int c0 = 16 * cgp, wsc = min(max(c0 - 8, 0), 32), rs = min(max(r - 4, 0), GROWS - 8);
        const int c = c0 + fr, cs = min(max(c - 8, 0), 48);
        const size_t tq = (size_t)b * T + r * 64 + c;
        bf16x8 qf[2];
#pragma unroll
        for (int ks = 0; ks < 2; ++ks) qf[ks] = *(const bf16x8*)(q + tq * CW + h * 64 + 32 * ks + 8 * fg);
        f32x4 sc[16];
        const int kcol_a = wsc + 8 * (fr >> 2) + (fr & 3);
        { bf16x8 kf[16][2];
#pragma unroll
          for (int t = 0; t < 16; ++t) { const int u = t >> 1, par = t & 1;
              const size_t tk = (size_t)b * T + (rs + u) * 64 + kcol_a + 4 * par;
              kf[t][0] = *(const bf16x8*)(k + tk * CW + h * 64 + 8 * fg); kf[t][1] = *(const bf16x8*)(k + tk * CW + h * 64 + 32 + 8 * fg); }
#pragma unroll
          for (int t = 0; t < 16; ++t) { f32x4 s = {0.f, 0.f, 0.f, 0.f};
              s = __builtin_amdgcn_mfma_f32_16x16x32_bf16(kf[t][0], qf[0], s, 0, 0, 0);
              s = __builtin_amdgcn_mfma_f32_16x16x32_bf16(kf[t][1], qf[1], s, 0, 0, 0);
              sc[t] = s; } }
        float mx = -1e30f;
#pragma unroll
        for (int u = 0; u < 8; ++u) {
            const int dr = rs + u - r + 7;
#pragma unroll
            for (int par = 0; par < 2; ++par)
#pragma unroll
                for (int i = 0; i < 4; ++i) {
                    const int kc = wsc + 8 * fg + 4 * par + i; const bool ok = (kc >= cs) && (kc < cs + 16);
                    const int dc = min(max(kc - c + 15, 0), 30);
                    const float s = ok ? sc[2 * u + par][i] + bias[(h * 15 + dr) * 31 + dc] : -1e30f;
                    sc[2 * u + par][i] = s; mx = fmaxf(mx, s);
                }
        }
        mx = fmaxf(mx, __shfl_xor(mx, 16)); mx = fmaxf(mx, __shfl_xor(mx, 32));
        float sum = 0.f;
#pragma unroll
        for (int t = 0; t < 16; ++t)
#pragma unroll
            for (int i = 0; i < 4; ++i) { const float pv = sc[t][i] > -1e29f ? __expf(sc[t][i] - mx) : 0.f; sc[t][i] = pv; sum += pv; }
        sum += __shfl_xor(sum, 16); sum += __shfl_xor(sum, 32);
        const float inv = 1.0f / sum;
        f32x4 o[4];
#pragma unroll
        for (int nt = 0; nt < 4; ++nt) o[nt] = (f32x4){0.f, 0.f, 0.f, 0.f};
        { bf16x8 vf[8][4];
#pragma unroll
          for (int u = 0; u < 8; ++u) { const bf16* vblk = vT + ((size_t)((b * NH + h) * GROWS + rs + u)) * (HD * 64) + wsc + 8 * fg;
#pragma unroll
              for (int nt = 0; nt < 4; ++nt) vf[u][nt] = *(const bf16x8*)(vblk + (16 * nt + fr) * 64); }
#pragma unroll
          for (int u = 0; u < 8; ++u) {
              union { u32x4 w; bf16x8 h8; } pf;
              pf.w.x = cvt_pk_bf16(sc[2 * u][0], sc[2 * u][1]); pf.w.y = cvt_pk_bf16(sc[2 * u][2], sc[2 * u][3]);
              pf.w.z = cvt_pk_bf16(sc[2 * u + 1][0], sc[2 * u + 1][1]); pf.w.w = cvt_pk_bf16(sc[2 * u + 1][2], sc[2 * u + 1][3]);
#pragma unroll
              for (int nt = 0; nt < 4; ++nt) o[nt] = __builtin_amdgcn_mfma_f32_16x16x32_bf16(vf[u][nt], pf.h8, o[nt], 0, 0, 0); } }
#pragma unroll
        for (int nt = 0; nt < 4; ++nt) { u32x2 w; w.x = cvt_pk_bf16(o[nt][0] * inv, o[nt][1] * inv); w.y = cvt_pk_bf16(o[nt][2] * inv, o[nt][3] * inv);
            *(u32x2*)(att + tq * CW + h * 64 + 16 * nt + 4 * fg) = w; }
    }
    __syncthreads();
}

__device__ __forceinline__ float row16_sum(float v) {
    v += __builtin_bit_cast(float, __builtin_amdgcn_update_dpp(0, __builtin_bit_cast(int, v), 0xB1, 0xF, 0xF, true));
    v += __builtin_bit_cast(float, __builtin_amdgcn_update_dpp(0, __builtin_bit_cast(int, v), 0x4E, 0xF, 0xF, true));
    v += __builtin_bit_cast(float, __builtin_amdgcn_update_dpp(0, __builtin_bit_cast(int, v), 0x141, 0xF, 0xF, true));
    v += __builtin_bit_cast(float, __builtin_amdgcn_update_dpp(0, __builtin_bit_cast(int, v), 0x140, 0xF, 0xF, true));
    return v;
}
constexpr int CS_R = 8;
constexpr int CS_AT = 0, CS_RT = 2304, CS_KHT = 4608, CS_BHT = 6656, CS_VT = 8704, CS_TT = 9216, CS_AAK = 9728, CS_ARK = 10240, CS_ARB = 10752, CS_PL = 11264, CS_SLOT = 11520;
constexpr int CS_LD = 72;
constexpr int CS_SCR = CS_R * CS_SLOT  , CS_SCRW = 2304 * 2 + 1024  , CS_FLAG = CS_SCR + 7 * CS_SCRW  ;
__device__ __forceinline__ bf16 f2bf(float f) { return (bf16)cvt_pk_bf16(f, 0.f); }
struct ChainOps { u32x2 a4[4], r4[4], kh[4], bh[4], aak, ark, arb, tt, vb; f32x4 pl[4]; };
__device__ __forceinline__ void chain_load(const LAS unsigned char* sl, int fr, int fg, ChainOps& o) {
    const int o16 = fr * 32 + fg * 8;
    const LAS unsigned char* pa = sl + CS_AT + fr * (CS_LD * 2) + fg * 8; const LAS unsigned char* pr = sl + CS_RT + fr * (CS_LD * 2) + fg * 8;
#pragma unroll
    for (int kq = 0; kq < 4; ++kq) { o.a4[kq] = *(const LAS u32x2*)(pa + 32 * kq); o.r4[kq] = *(const LAS u32x2*)(pr + 32 * kq); }
    o.aak = *(const LAS u32x2*)(sl + CS_AAK + o16); o.ark = *(const LAS u32x2*)(sl + CS_ARK + o16); o.arb = *(const LAS u32x2*)(sl + CS_ARB + o16); o.tt = *(const LAS u32x2*)(sl + CS_TT + o16);
    o.vb = *(const LAS u32x2*)(sl + CS_VT + o16);
#pragma unroll
    for (int mt = 0; mt < 4; ++mt) { o.pl[mt] = *(const LAS f32x4*)(sl + CS_PL + (16 * mt + 4 * fg) * 4);
        o.kh[mt] = *(const LAS u32x2*)(sl + CS_KHT + 512 * mt + o16); o.bh[mt] = *(const LAS u32x2*)(sl + CS_BHT + 512 * mt + o16); }
}
__device__ __forceinline__ f32x4 chain_compute(const ChainOps& o, f32x4 (&zacc)[4]) {
#define CS_M32(A_, B_, C_) __builtin_amdgcn_mfma_f32_16x16x32_bf16(A_, B_, C_, 0, 0, 0)
#define CS_M16(A_, B_, C_) __builtin_amdgcn_mfma_f32_16x16x16bf16_1k(__builtin_bit_cast(s16x4, A_), __builtin_bit_cast(s16x4, B_), C_, 0, 0, 0)
    union { u32x4 w; bf16x8 h8; } zb0, zb1, ap0, ap1, rp0, rp1;
    zb0.w.x = cvt_pk_bf16(zacc[0][0], zacc[0][1]); zb0.w.y = cvt_pk_bf16(zacc[0][2], zacc[0][3]); zb0.w.z = cvt_pk_bf16(zacc[1][0], zacc[1][1]); zb0.w.w = cvt_pk_bf16(zacc[1][2], zacc[1][3]);
    zb1.w.x = cvt_pk_bf16(zacc[2][0], zacc[2][1]); zb1.w.y = cvt_pk_bf16(zacc[2][2], zacc[2][3]); zb1.w.z = cvt_pk_bf16(zacc[3][0], zacc[3][1]); zb1.w.w = cvt_pk_bf16(zacc[3][2], zacc[3][3]);
    ap0.w = (u32x4){o.a4[0].x, o.a4[0].y, o.a4[1].x, o.a4[1].y}; ap1.w = (u32x4){o.a4[2].x, o.a4[2].y, o.a4[3].x, o.a4[3].y};
    rp0.w = (u32x4){o.r4[0].x, o.r4[0].y, o.r4[1].x, o.r4[1].y}; rp1.w = (u32x4){o.r4[2].x, o.r4[2].y, o.r4[3].x, o.r4[3].y};
    const f32x4 zero4 = {0.f, 0.f, 0.f, 0.f};
    f32x4 Wc = CS_M16(o.aak, o.vb, zero4);
    Wc = CS_M32(ap0.h8, zb0.h8, Wc); Wc = CS_M32(ap1.h8, zb1.h8, Wc);
    f32x4 Yc = CS_M16(o.ark, o.vb, zero4);
    Yc = CS_M32(rp0.h8, zb0.h8, Yc); Yc = CS_M32(rp1.h8, zb1.h8, Yc);
    f32x4 zz[4];
#pragma unroll
    for (int mt = 0; mt < 4; ++mt) zz[mt] = CS_M16(o.kh[mt], o.vb, zacc[mt] * o.pl[mt]);
    u32x2 wb, ub;
    wb.x = cvt_pk_bf16(Wc[0], Wc[1]); wb.y = cvt_pk_bf16(Wc[2], Wc[3]);
    const f32x4 Uc = CS_M16(o.tt, wb, zero4);
    ub.x = cvt_pk_bf16(Uc[0], Uc[1]); ub.y = cvt_pk_bf16(Uc[2], Uc[3]);
    Yc = CS_M16(o.arb, ub, Yc);
#pragma unroll
    for (int mt = 0; mt < 4; ++mt) zacc[mt] = CS_M16(o.bh[mt], ub, zz[mt]);
#undef CS_M32
#undef CS_M16
    return Yc;
}
template <int z>
__device__ __forceinline__ void scan_phase_z(const Frame& F, const Args& a) {
    unsigned char* ws = a.ws;
    const int seq = F.vcu >> 2, ig = F.vcu & 3;
    const int b = (seq >> 3) & 3, h = seq & 7;
    const size_t mb = (size_t)b * T;
    const int lane = F.lane, wave = F.wave, fr = lane & 15, fg = lane >> 4;
    constexpr int NCK = T / 16;
    volatile LAS unsigned* flg = (volatile LAS unsigned*)(F.lds + CS_FLAG);
    if (F.tid < 16) flg[F.tid] = 0u;
    __syncthreads();
    const int o16 = fr * 32 + fg * 8;
#define CS_M32(A_, B_, C_) __builtin_amdgcn_mfma_f32_16x16x32_bf16(A_, B_, C_, 0, 0, 0)
#define CS_M16(A_, B_, C_) __builtin_amdgcn_mfma_f32_16x16x16bf16_1k(__builtin_bit_cast(s16x4, A_), __builtin_bit_cast(s16x4, B_), C_, 0, 0, 0)
    if (wave == 0) {
        __builtin_amdgcn_s_setprio(3);
        bf16* yout = (bf16*)(ws + WS_Y) + (size_t)z * M * CW + h * 64 + ig * 16 + fr;
        f32x4 zacc[4];
#pragma unroll
        for (int mt = 0; mt < 4; ++mt) zacc[mt] = (f32x4){0.f, 0.f, 0.f, 0.f};
        ChainOps opA, opB;
#define CS_READY(nn) do { unsigned sp_ = 0; while (flg[(nn) & (CS_R - 1)] != (unsigned)((nn) + 1)) { __builtin_amdgcn_s_sleep(1); if (++sp_ > (1u << 24)) break; } __builtin_amdgcn_fence(__ATOMIC_ACQUIRE, "workgroup"); } while (0)
#define CS_HANDBACK(nn) do { asm volatile("s_waitcnt lgkmcnt(0)" ::: "memory"); if (lane == 0) flg[8] = (unsigned)((nn) + 1); asm volatile("" ::: "memory"); } while (0)
#define CS_YSTORE(nn, Y_) do { _Pragma("unroll") for (int rr = 0; rr < 4; ++rr) { const int q_ = 16 * (nn) + 4 * fg + rr, t_ = z ? (T - 1 - q_) : q_; yout[(mb + t_) * CW] = f2bf((Y_)[rr]); } } while (0)
        CS_READY(0); chain_load(F.lds, fr, fg, opA);
#pragma unroll 1
        for (int n = 0; n < NCK; n += 2) {
            CS_READY(n + 1); CS_HANDBACK(n);
            chain_load(F.lds + ((n + 1) & (CS_R - 1)) * CS_SLOT, fr, fg, opB);
            { const f32x4 Yc = chain_compute(opA, zacc); CS_YSTORE(n, Yc); }
            if (n + 2 < NCK) CS_READY(n + 2);
            CS_HANDBACK(n + 1);
            if (n + 2 < NCK) chain_load(F.lds + ((n + 2) & (CS_R - 1)) * CS_SLOT, fr, fg, opA);
            { const f32x4 Yc = chain_compute(opB, zacc); CS_YSTORE(n + 1, Yc); }
        }
#undef CS_READY
#undef CS_HANDBACK
#undef CS_YSTORE
        __builtin_amdgcn_s_setprio(0);
    } else {
        const int pi = wave - 1;
        LAS unsigned char* scr = F.lds + CS_SCR + pi * CS_SCRW;
        LAS bf16* KT = (LAS bf16*)scr; LAS bf16* BT = (LAS bf16*)(scr + 2304);
        const bf16* gw_ = (const bf16*)(ws + WS_DECAY) + (size_t)z * M * CW + h * 64;
        const bf16* gkk = (const bf16*)(ws + WS_KK) + h * 64;
        const bf16* gak = (const bf16*)(ws + WS_AKK) + (size_t)z * M * CW + h * 64;
        const bf16* gk = (const bf16*)(ws + WS_KDIR) + (size_t)z * M * CW + h * 64;
        const bf16* gr = (const bf16*)(ws + WS_R) + h * 64;
        const bf16* gv = (const bf16*)(ws + WS_V) + h * 64 + ig * 16;
        unsigned nw[16], nkk[16], nak[16], nk[16], nr[16], nv[4];
        constexpr long RSTEP = z ? -(long)CW : (long)CW;
#define CS_FETCH(nn) do { if ((nn) < NCK) { const size_t m0_ = (mb + (z ? (T - 1 - 16 * (nn)) : 16 * (nn))) * CW + lane; \
            const bf16* pw_ = gw_ + m0_; const bf16* pkk_ = gkk + m0_; const bf16* pak_ = gak + m0_; const bf16* pk_ = gk + m0_; const bf16* pr_ = gr + m0_; \
            _Pragma("unroll") for (int tt = 0; tt < 16; ++tt) { nw[tt] = pw_[tt * RSTEP]; nkk[tt] = pkk_[tt * RSTEP]; nak[tt] = pak_[tt * RSTEP]; nk[tt] = pk_[tt * RSTEP]; nr[tt] = pr_[tt * RSTEP]; } \
            const bf16* pv_ = gv + (mb + (z ? (T - 1 - 16 * (nn) - fg) : 16 * (nn) + fg)) * CW + fr; \
            _Pragma("unroll") for (int q4 = 0; q4 < 4; ++q4) nv[q4] = pv_[4 * q4 * RSTEP]; } } while (0)
        CS_FETCH(pi);
#pragma unroll 1
        for (int n = pi; n < NCK; n += 7) {
            const int slot = n & (CS_R - 1);
            float wv[16], kkv[16], akv[16], kv[16], rv[16], vq[4];
#pragma unroll
            for (int tt = 0; tt < 16; ++tt) { unsigned x0 = nw[tt], x1 = nkk[tt], x2 = nak[tt], x3 = nk[tt], x4 = nr[tt];
                asm volatile("" : "+v"(x0), "+v"(x1), "+v"(x2), "+v"(x3), "+v"(x4));
                wv[tt] = __uint_as_float(x0 << 16); kkv[tt] = __uint_as_float(x1 << 16); akv[tt] = __uint_as_float(x2 << 16); kv[tt] = __uint_as_float(x3 << 16); rv[tt] = __uint_as_float(x4 << 16); }
#pragma unroll
            for (int q4 = 0; q4 < 4; ++q4) { unsigned x0 = nv[q4]; asm volatile("" : "+v"(x0)); vq[q4] = __uint_as_float(x0 << 16); }
            CS_FETCH(n + 7);
            { unsigned sp = 0; while ((int)flg[8] < n - (CS_R - 3)) { __builtin_amdgcn_s_sleep(2); if (++sp > (1u << 24)) break; } }
            __builtin_amdgcn_fence(__ATOMIC_ACQUIRE, "workgroup");
            LAS unsigned char* sl = F.lds + slot * CS_SLOT;
            float P[16];
            P[0] = wv[0];
#pragma unroll
            for (int tt = 1; tt < 16; ++tt) P[tt] = P[tt - 1] * wv[tt];
            const float PL = P[15];
            float khat[16], bhat[16];
#pragma unroll
            for (int tt = 0; tt < 16; ++tt) {
                const float pm1 = tt ? P[tt - 1] : 1.0f, inv = __builtin_amdgcn_rcpf(P[tt]);
                const float at = kkv[tt] * pm1, rt = rv[tt] * P[tt], kt = kv[tt] * inv, bt = -akv[tt] * inv;
                khat[tt] = kt * PL; bhat[tt] = bt * PL;
                { const unsigned w_ = cvt_pk_bf16(at, rt); *(LAS bf16*)(sl + CS_AT + (tt * CS_LD + lane) * 2) = (bf16)w_; *(LAS bf16*)(sl + CS_RT + (tt * CS_LD + lane) * 2) = (bf16)(w_ >> 16); }
                { const unsigned w_ = cvt_pk_bf16(kt, bt); KT[tt * CS_LD + lane] = (bf16)w_; BT[tt * CS_LD + lane] = (bf16)(w_ >> 16); }
            }
            { u32x4 o0, o1;
              o0.x = cvt_pk_bf16(khat[0], khat[1]); o0.y = cvt_pk_bf16(khat[2], khat[3]); o0.z = cvt_pk_bf16(khat[4], khat[5]); o0.w = cvt_pk_bf16(khat[6], khat[7]);
              o1.x = cvt_pk_bf16(khat[8], khat[9]); o1.y = cvt_pk_bf16(khat[10], khat[11]); o1.z = cvt_pk_bf16(khat[12], khat[13]); o1.w = cvt_pk_bf16(khat[14], khat[15]);
              *(LAS u32x4*)(sl + CS_KHT + lane * 32) = o0; *(LAS u32x4*)(sl + CS_KHT + lane * 32 + 16) = o1;
              o0.x = cvt_pk_bf16(bhat[0], bhat[1]); o0.y = cvt_pk_bf16(bhat[2], bhat[3]); o0.z = cvt_pk_bf16(bhat[4], bhat[5]); o0.w = cvt_pk_bf16(bhat[6], bhat[7]);
              o1.x = cvt_pk_bf16(bhat[8], bhat[9]); o1.y = cvt_pk_bf16(bhat[10], bhat[11]); o1.z = cvt_pk_bf16(bhat[12], bhat[13]); o1.w = cvt_pk_bf16(bhat[14], bhat[15]);
              *(LAS u32x4*)(sl + CS_BHT + lane * 32) = o0; *(LAS u32x4*)(sl + CS_BHT + lane * 32 + 16) = o1; }
            *(LAS float*)(sl + CS_PL + lane * 4) = PL;
#pragma unroll
            for (int q4 = 0; q4 < 4; ++q4) *(LAS bf16*)(sl + CS_VT + (fr * 16 + fg + 4 * q4) * 2) = f2bf(vq[q4]);
            asm volatile("s_waitcnt lgkmcnt(0)" ::: "memory");
            bf16x8 af[2], rf[2], kf[2], bf_[2];
#pragma unroll
            for (int ks = 0; ks < 2; ++ks) { af[ks] = *(const LAS bf16x8*)(sl + CS_AT + (fr * CS_LD + 32 * ks + 8 * fg) * 2); rf[ks] = *(const LAS bf16x8*)(sl + CS_RT + (fr * CS_LD + 32 * ks + 8 * fg) * 2);
                kf[ks] = *(const LAS bf16x8*)(KT + fr * CS_LD + 32 * ks + 8 * fg); bf_[ks] = *(const LAS bf16x8*)(BT + fr * CS_LD + 32 * ks + 8 * fg); }
            const f32x4 zero4 = {0.f, 0.f, 0.f, 0.f};
            f32x4 Xc = zero4, Xt = zero4, AakT = zero4, ArbT = zero4, ArkT = zero4;
#pragma unroll
            for (int ks = 0; ks < 2; ++ks) { Xc = CS_M32(af[ks], bf_[ks], Xc); Xt = CS_M32(bf_[ks], af[ks], Xt);
                AakT = CS_M32(kf[ks], af[ks], AakT); ArbT = CS_M32(bf_[ks], rf[ks], ArbT); ArkT = CS_M32(kf[ks], rf[ks], ArkT); }
            f32x4 S1;
#pragma unroll
            for (int rr = 0; rr < 4; ++rr) { const int q = 4 * fg + rr;
                Xc[rr] = (fr < q) ? Xc[rr] : 0.f; Xt[rr] = (q < fr) ? Xt[rr] : 0.f; S1[rr] = Xt[rr] + ((q == fr) ? 1.0f : 0.f);
                AakT[rr] = (q < fr) ? AakT[rr] : 0.f; ArkT[rr] = (q <= fr) ? ArkT[rr] : 0.f; ArbT[rr] = (q <= fr) ? ArbT[rr] : 0.f; }
            { u32x2 w; w.x = cvt_pk_bf16(AakT[0], AakT[1]); w.y = cvt_pk_bf16(AakT[2], AakT[3]); *(LAS u32x2*)(sl + CS_AAK + o16) = w;
              w.x = cvt_pk_bf16(ArkT[0], ArkT[1]); w.y = cvt_pk_bf16(ArkT[2], ArkT[3]); *(LAS u32x2*)(sl + CS_ARK + o16) = w;
              w.x = cvt_pk_bf16(ArbT[0], ArbT[1]); w.y = cvt_pk_bf16(ArbT[2], ArbT[3]); *(LAS u32x2*)(sl + CS_ARB + o16) = w; }
#define CS_PK(v) ((u32x2){cvt_pk_bf16((v)[0], (v)[1]), cvt_pk_bf16((v)[2], (v)[3])})
            const u32x2 xc = CS_PK(Xc), xt = CS_PK(Xt), s1 = CS_PK(S1);
            const f32x4 X2c = CS_M16(xt, xc, zero4), X2t = CS_M16(xc, xt, zero4);
            const u32x2 x2c = CS_PK(X2c), x2t = CS_PK(X2t);
            const f32x4 S2 = CS_M16(x2c, s1, S1);
            const f32x4 X4c = CS_M16(x2t, x2c, zero4), X4t = CS_M16(x2c, x2t, zero4);
            const u32x2 x4c = CS_PK(X4c), x4t = CS_PK(X4t), s2 = CS_PK(S2);
            const f32x4 S4 = CS_M16(x4c, s2, S2);
            const f32x4 X8c = CS_M16(x4t, x4c, zero4);
            const u32x2 x8c = CS_PK(X8c), s4 = CS_PK(S4);
            const f32x4 S8 = CS_M16(x8c, s4, S4);
            *(LAS u32x2*)(sl + CS_TT + o16) = CS_PK(S8);
#undef CS_PK
            asm volatile("s_waitcnt lgkmcnt(0)" ::: "memory");
            __builtin_amdgcn_fence(__ATOMIC_RELEASE, "workgroup");
            if (lane == 0) flg[slot] = (unsigned)(n + 1);
        }
#undef CS_FETCH
    }
#undef CS_M32
#undef CS_M16
    __syncthreads();
}

__device__ __forceinline__ void scan_phase(const Frame& F, const Args& a) {
    const int seq = F.vcu >> 2;
    if (seq >= 64) return;
    if (seq >> 5) scan_phase_z<1>(F, a); else scan_phase_z<0>(F, a);
}

__device__ __forceinline__ void combine_phase(const Frame& F, const Args& a) {
    unsigned char* ws = a.ws;
    const bf16* att = (const bf16*)(ws + WS_ATT); const bf16* rr = (const bf16*)(ws + WS_R); const bf16* vv = (const bf16*)(ws + WS_V);
    const bf16* kd = (const bf16*)(ws + WS_KDIR); const bf16* gg = (const bf16*)(ws + WS_G); const bf16* y = (const bf16*)(ws + WS_Y);
    bf16* mix = (bf16*)(ws + WS_MIX);
    const float* anw = a.in[4]; const float* r_k = a.in[14]; const float* ln_w = a.in[15]; const float* ln_b = a.in[16];
    const int lane = F.lane, c0 = 8 * lane;
    float nw[8], rk[8], lw[8], lb[8];
#pragma unroll
    for (int i = 0; i < 8; ++i) { nw[i] = anw[c0 + i]; rk[i] = r_k[c0 + i]; lw[i] = ln_w[c0 + i]; lb[i] = ln_b[c0 + i]; }
    const int gw = F.vcu * 8 + F.wave, NGW = F.G * 8;
#pragma unroll 2
    for (int m = gw; m < M; m += NGW) {
        const size_t o = (size_t)m * CW + c0;
        float f[8];
        unpack8(*(const u32x4*)(att + o), f);
        float ss = 0.f;
#pragma unroll
        for (int i = 0; i < 8; ++i) ss += f[i] * f[i];
        const float rs = rsqrtf(wave_sum(ss) * (1.f / CW) + RMS_EPS);
#pragma unroll
        for (int i = 0; i < 8; ++i) f[i] = f[i] * rs * nw[i];
        *(u32x4*)(mix + (size_t)m * D + c0) = pack8(f);
        float yv[8], yw[8];
        unpack8(*(const u32x4*)(y + o), yv); unpack8(*(const u32x4*)(y + (size_t)M * CW + o), yw);
#pragma unroll
        for (int i = 0; i < 8; ++i) yv[i] += yw[i];
        float s1 = 0.f;
#pragma unroll
        for (int i = 0; i < 8; ++i) s1 += yv[i];
        s1 += __shfl_xor(s1, 1); s1 += __shfl_xor(s1, 2); s1 += __shfl_xor(s1, 4);
        const float mean = s1 * (1.f / 64.f);
        float s2 = 0.f;
#pragma unroll
        for (int i = 0; i < 8; ++i) { yv[i] -= mean; s2 += yv[i] * yv[i]; }
        s2 += __shfl_xor(s2, 1); s2 += __shfl_xor(s2, 2); s2 += __shfl_xor(s2, 4);
        const float rstd = rsqrtf(s2 * (1.f / 64.f) + GN_EPS);
        float rf[8], k0[8], k1[8], vf[8], gf[8];
        unpack8(*(const u32x4*)(rr + o), rf); unpack8(*(const u32x4*)(kd + o), k0); unpack8(*(const u32x4*)(kd + (size_t)M * CW + o), k1);
        unpack8(*(const u32x4*)(vv + o), vf); unpack8(*(const u32x4*)(gg + o), gf);
        float cf = 0.f;
#pragma unroll
        for (int i = 0; i < 8; ++i) cf += rf[i] * (k0[i] + k1[i]) * rk[i];
        cf += __shfl_xor(cf, 1); cf += __shfl_xor(cf, 2); cf += __shfl_xor(cf, 4);
#pragma unroll
        for (int i = 0; i < 8; ++i) f[i] = (yv[i] * rstd * lw[i] + lb[i] + cf * vf[i]) * gf[i];
        *(u32x4*)(mix + (size_t)m * D + CW + c0) = pack8(f);
    }
}

constexpr int RT_PITCH = 1032, RT_WH = 0, RT_WL = 32 * RT_PITCH * 2, RT_HIST = 2 * RT_WL, RT_EL = RT_HIST + 256;
__device__ __forceinline__ void router_phase(const Frame& F, const Args& a) {
    unsigned char* ws = a.ws;
    const bf16* hbuf = (const bf16*)(ws + WS_H); unsigned char* hn2 = ws + WS_HN2;
    int* eidx = (int*)(ws + WS_EIDX); float* gate = (float*)(ws + WS_GATE); int* rank = (int*)(ws + WS_RANK);
    unsigned* ctl = (unsigned*)(ws + WS_CTL);
    const float* n2w = a.in[18]; const float* rw = a.in[19]; const float* rb = a.in[20];
    LAS bf16* wh = (LAS bf16*)(F.lds + RT_WH); LAS bf16* wl = (LAS bf16*)(F.lds + RT_WL); LAS int* hist = (LAS int*)(F.lds + RT_HIST); LAS int* eL = (LAS int*)(F.lds + RT_EL);
    { f32x4 tmp[16];
#pragma unroll
      for (int j = 0; j < 16; ++j) tmp[j] = *((const f32x4*)rw + F.tid + 512 * j);
#pragma unroll
      for (int j = 0; j < 16; ++j) { const int q = F.tid + 512 * j, d = q >> 3, e0 = 4 * (q & 7);
#pragma unroll
          for (int i = 0; i < 4; ++i) { const float w = tmp[j][i]; const unsigned hb = cvt_pk_bf16(w, 0.f) & 0xffffu; const float lo = w - __uint_as_float(hb << 16);
              wh[(e0 + i) * RT_PITCH + d] = (bf16)hb; wl[(e0 + i) * RT_PITCH + d] = (bf16)cvt_pk_bf16(lo, 0.f); } } }
    if (F.tid < 32) hist[F.tid] = 0;
    __syncthreads();
    const int lane = F.lane, tk = lane & 15, g = lane >> 4;
    const int blk = F.vcu;
    const int m = blk * 128 + F.wave * 16 + tk;
    const bf16* hrow = hbuf + (size_t)m * D + 8 * g;
    float ss = 0.f;
#pragma unroll 8
    for (int ks = 0; ks < 32; ++ks) { float xf[8]; unpack8(*(const u32x4*)(hrow + 32 * ks), xf);
        ss += (xf[0] * xf[0] + xf[1] * xf[1]) + (xf[2] * xf[2] + xf[3] * xf[3]) + (xf[4] * xf[4] + xf[5] * xf[5]) + (xf[6] * xf[6] + xf[7] * xf[7]); }
    ss += __shfl_xor(ss, 16); ss += __shfl_xor(ss, 32);
    const float rs = rsqrtf(ss * (1.f / D) + RMS_EPS);
    f32x4 acc0 = {0.f, 0.f, 0.f, 0.f}, acc1 = acc0;
    unsigned char* hrow8 = hn2 + (size_t)m * D + 8 * g;
    const LAS bf16* wh0 = wh + tk * RT_PITCH + 8 * g; const LAS bf16* wl0 = wl + tk * RT_PITCH + 8 * g;
#pragma unroll 4
    for (int ks = 0; ks < 32; ++ks) {
        float xf[8]; unpack8(*(const u32x4*)(hrow + 32 * ks), xf);
        const f32x4 x0 = {xf[0], xf[1], xf[2], xf[3]}, x1 = {xf[4], xf[5], xf[6], xf[7]};
        const f32x4 n0 = *(const f32x4*)(n2w + 32 * ks + 8 * g), n1 = *(const f32x4*)(n2w + 32 * ks + 8 * g + 4);
        const f32x4 y0 = x0 * rs * n0, y1 = x1 * rs * n1;
        { u32x2 w8; w8.x = pk4_fp8(y0.x * F8_SX, y0.y * F8_SX, y0.z * F8_SX, y0.w * F8_SX); w8.y = pk4_fp8(y1.x * F8_SX, y1.y * F8_SX, y1.z * F8_SX, y1.w * F8_SX); *(u32x2*)(hrow8 + 32 * ks) = w8; }
        union { u32x4 w; bf16x8 h8; } xh, xl;
        xh.w.x = cvt_pk_bf16(y0.x, y0.y); xh.w.y = cvt_pk_bf16(y0.z, y0.w); xh.w.z = cvt_pk_bf16(y1.x, y1.y); xh.w.w = cvt_pk_bf16(y1.z, y1.w);
        xl.w.x = cvt_pk_bf16(y0.x - bflo(xh.w.x), y0.y - bfhi(xh.w.x)); xl.w.y = cvt_pk_bf16(y0.z - bflo(xh.w.y), y0.w - bfhi(xh.w.y));
        xl.w.z = cvt_pk_bf16(y1.x - bflo(xh.w.z), y1.y - bfhi(xh.w.z)); xl.w.w = cvt_pk_bf16(y1.z - bflo(xh.w.w), y1.w - bfhi(xh.w.w));
        const bf16x8 a0h = *(const LAS bf16x8*)(wh0 + 32 * ks), a1h = *(const LAS bf16x8*)(wh0 + 16 * RT_PITCH + 32 * ks);
        const bf16x8 a0l = *(const LAS bf16x8*)(wl0 + 32 * ks), a1l = *(const LAS bf16x8*)(wl0 + 16 * RT_PITCH + 32 * ks);
        acc0 = __builtin_amdgcn_mfma_f32_16x16x32_bf16(a0h, xh.h8, acc0, 0, 0, 0); acc1 = __builtin_amdgcn_mfma_f32_16x16x32_bf16(a1h, xh.h8, acc1, 0, 0, 0);
        acc0 = __builtin_amdgcn_mfma_f32_16x16x32_bf16(a0h, xl.h8, acc0, 0, 0, 0); acc1 = __builtin_amdgcn_mfma_f32_16x16x32_bf16(a1h, xl.h8, acc1, 0, 0, 0);
        acc0 = __builtin_amdgcn_mfma_f32_16x16x32_bf16(a0l, xh.h8, acc0, 0, 0, 0); acc1 = __builtin_amdgcn_mfma_f32_16x16x32_bf16(a1l, xh.h8, acc1, 0, 0, 0);
    }
    float lv[8]; int li[8];
    { const f32x4 b0 = *(const f32x4*)(rb + 4 * g), b1 = *(const f32x4*)(rb + 16 + 4 * g);
#pragma unroll
      for (int i = 0; i < 4; ++i) { lv[i] = acc0[i] + b0[i]; li[i] = 4 * g + i; lv[4 + i] = acc1[i] + b1[i]; li[4 + i] = 16 + 4 * g + i; } }
    float tv[4]; int ti[4];
#pragma unroll
    for (int kx = 0; kx < 4; ++kx) {
        float bv = lv[0]; int bi = li[0];
#pragma unroll
        for (int i = 1; i < 8; ++i) { const bool gt = lv[i] > bv; bv = gt ? lv[i] : bv; bi = gt ? li[i] : bi; }
#pragma unroll
        for (int o = 16; o < 64; o <<= 1) { const float ov = __shfl_xor(bv, o); const int oi = __shfl_xor(bi, o); const bool tko = (ov > bv) || (ov == bv && oi < bi); bv = tko ? ov : bv; bi = tko ? oi : bi; }
        tv[kx] = bv; ti[kx] = bi;
#pragma unroll
        for (int i = 0; i < 8; ++i) lv[i] = (li[i] == bi) ? -3.0e38f : lv[i];
    }
    if (g == 0) {
        const float e0 = 1.0f, e1 = __expf(tv[1] - tv[0]), e2 = __expf(tv[2] - tv[0]), e3 = __expf(tv[3] - tv[0]);
        const float is = 1.0f / (e0 + e1 + e2 + e3);
        const float gs[4] = {e0 * is, e1 * is, e2 * is, e3 * is};
#pragma unroll
        for (int kx = 0; kx < 4; ++kx) { eidx[m * 4 + kx] = ti[kx]; gate[m * 4 + kx] = gs[kx]; eL[(m - blk * 128) * 4 + kx] = ti[kx]; }
    }
    __syncthreads();
    { const int t = F.tid, e = eL[t]; int rk = 0;
      for (int u = 0; u < t; ++u) rk += (eL[u] == e) ? 1 : 0;
      rank[(blk * 128) * 4 + t] = rk;
      __hip_atomic_fetch_add(&hist[e], 1, __ATOMIC_RELAXED, __HIP_MEMORY_SCOPE_WORKGROUP); }
    __syncthreads();
    if (F.tid < 32) ctl[CW_CNT + blk * 32 + F.tid] = (unsigned)hist[F.tid];
}

__device__ __forceinline__ void dispatch_phase(const Frame& F, const Args& a) {
    unsigned char* ws = a.ws;
    unsigned* ctl = (unsigned*)(ws + WS_CTL);
    const int* eidx = (const int*)(ws + WS_EIDX); const int* rank = (const int*)(ws + WS_RANK); int* dest = (int*)(ws + WS_DEST);
    LAS int* part = (LAS int*)F.lds;
    LAS int* tot = part + 1024;
    const int blk = F.vcu, G = F.G;
    { const int e = F.tid & 31, pt = F.tid >> 5; int s = 0, sb = 0;
      if (G == 256) { int cv[16];
#pragma unroll
          for (int q = 0; q < 16; ++q) cv[q] = (int)ld_u32_agent(ctl + CW_CNT + (pt + 16 * q) * 32 + e);
#pragma unroll
          for (int q = 0; q < 16; ++q) { s += cv[q]; if (pt + 16 * q < blk) sb += cv[q]; } }
      else for (int bb = pt; bb < G; bb += 16) { const int cval = (int)ld_u32_agent(ctl + CW_CNT + bb * 32 + e); s += cval; if (bb < blk) sb += cval; }
      part[pt * 32 + e] = s; part[512 + pt * 32 + e] = sb; }
    __syncthreads();
    if (F.tid < 32) { int s = 0, sb = 0;
        for (int pt = 0; pt < 16; ++pt) { s += part[pt * 32 + F.tid]; sb += part[512 + pt * 32 + F.tid]; }
        tot[F.tid] = s; tot[32 + F.tid] = sb; tot[96 + F.tid] = (s + 255) & ~255; }
    __syncthreads();
    if (F.tid == 0) { int ps = 0; for (int e = 0; e < 32; ++e) { tot[64 + e] = ps; ps += tot[96 + e]; }
        tot[128] = ps >> 8; }
    __syncthreads();
    if (blk == 0) {
        if (F.tid == 0) ctl[CW_NT] = (unsigned)tot[128];
        for (int e = F.tid >> 4; e < 32; e += 32) { const int t0 = tot[64 + e] >> 8, nt = tot[96 + e] >> 8; for (int i = F.tid & 15; i < nt; i += 16) ctl[CW_TEXP + t0 + i] = (unsigned)e; }
    }
    const int lane = F.lane;
    const int mw = blk * 128 + F.wave * 16;
    int* rowtok = (int*)(ws + WS_ROWTOK);
    { const int e = eidx[mw * 4 + lane]; const int dl = tot[64 + e] + tot[32 + e] + rank[mw * 4 + lane]; dest[mw * 4 + lane] = dl; rowtok[dl] = mw + (lane >> 2); }
    { const int e = blk & 31, pt = blk >> 5, np = G >> 5; const int r0 = tot[64 + e] + tot[e], r1 = tot[64 + e] + tot[96 + e];
      if (np > 0) for (int r = r0 + pt * 512 + F.tid; r < r1; r += np * 512) rowtok[r] = 0; }
}

__device__ __forceinline__ void final_phase(const Frame& F, const Args& a) {
    unsigned char* ws = a.ws;
    const bf16* hbuf = (const bf16*)(ws + WS_H); const unsigned char* ybuf = ws + WS_YBUF;
    const int* dest = (const int*)(ws + WS_DEST); const float* gate = (const float*)(ws + WS_GATE);
    const float* fw = a.in[25]; float* out = a.out;
    const int lane = F.lane;
    f32x4 wn[4];
#pragma unroll
    for (int j = 0; j < 4; ++j) wn[j] = *((const f32x4*)fw + lane + 64 * j);
    const int gw = F.vcu * 8 + F.wave, NGW = F.G * 8;
    const int per = M / NGW;
    const int mw = gw * per;
    int dl = 0; float gl = 0.f;
    if (lane < 4 * per && per <= 16) { dl = dest[mw * 4 + lane]; gl = gate[mw * 4 + lane]; }
#pragma unroll 2
    for (int i = 0; i < per; ++i) {
        const int m = mw + i;
        const u32x2* hr = (const u32x2*)(hbuf + (size_t)m * D) + lane;
        f32x4 v[4];
#pragma unroll
        for (int j = 0; j < 4; ++j) { const u32x2 w = hr[64 * j]; v[j] = (f32x4){bflo(w.x), bfhi(w.x), bflo(w.y), bfhi(w.y)}; }
#pragma unroll
        for (int kx = 0; kx < 4; ++kx) {
            const int d = per <= 16 ? __shfl(dl, 4 * i + kx) : dest[m * 4 + kx]; const float gt = (per <= 16 ? __shfl(gl, 4 * i + kx) : gate[m * 4 + kx]) * (1.0f / F8_SY);
            const unsigned* yr = (const unsigned*)(ybuf + (size_t)d * D) + lane;
#pragma unroll
            for (int j = 0; j < 4; ++j) { const unsigned w = yr[64 * j]; const f32x2 lo = __builtin_amdgcn_cvt_pk_f32_fp8((int)w, false), hi = __builtin_amdgcn_cvt_pk_f32_fp8((int)w, true);
                v[j].x += gt * lo.x; v[j].y += gt * lo.y; v[j].z += gt * hi.x; v[j].w += gt * hi.y; }
        }
        float s = 0.f;
#pragma unroll
        for (int j = 0; j < 4; ++j) s += (v[j].x * v[j].x + v[j].y * v[j].y) + (v[j].z * v[j].z + v[j].w * v[j].w);
        const float rs = rsqrtf(wave_sum(s) * (1.f / D) + RMS_EPS);
        f32x4* orow = (f32x4*)(out + (size_t)m * D) + lane;
#pragma unroll
        for (int j = 0; j < 4; ++j) orow[64 * j] = v[j] * rs * wn[j];
    }
}

__global__ void __launch_bounds__(512, 2) fwd_megakernel(Args args) {
    extern __shared__ __attribute__((aligned(16))) unsigned char lds_raw[];
    Frame F;
    F.lds = (LAS unsigned char*)lds_raw;
    F.tid = threadIdx.x; F.lane = F.tid & 63; F.wave = __builtin_amdgcn_readfirstlane(F.tid >> 6);
    F.G = gridDim.x; { const int bx = blockIdx.x; F.vcu = (F.G % 8 == 0) ? (bx % 8) * (F.G / 8) + bx / 8 : bx; }
    unsigned char* ws = args.ws;
    const int lo = args.ph_lo, hi = args.ph_hi;
#define IN(k) (lo <= (k) && (k) < hi)
#if MK_SPLIT
#define SEAM(k) do { } while (0)
#else
    cg::grid_group grid = cg::this_grid();
    { volatile LAS unsigned* st = (volatile LAS unsigned*)(F.lds + LDS_MISC); if (F.tid < 2) st[F.tid] = 0u; __syncthreads(); }
    const XcdBarrier xbar = xcd_barrier_post((unsigned*)(ws + WS_CTL) + CW_BAR, (volatile LAS unsigned*)(F.lds + LDS_MISC));
    if (lo < 0) grid.sync();
#define SEAM(k) do { if (IN(k) && IN((k) + 1)) xcd_barrier(xbar); } while (0)
#endif
#define REP2(k) if constexpr (((MK_REPEAT >> (k)) & 1) != 0)
#define PH1 { pg8::Gemm g{(const bf16*)(ws + WS_HN), (const bf16*)(ws + WS_WINT), 1024, nullptr, 0, nullptr}; \
        pg8::StaticOrder S; S.init(M / 256, NPROJ_PAD / 256, F.G, (int)blockIdx.x); \
        pg8::EpiProj E{(bf16*)(ws + WS_Q), (bf16*)(ws + WS_K), (bf16*)(ws + WS_VT), (bf16*)(ws + WS_P)}; \
        pg8::gemm_phase<pg8::EpiProj, true, true>(F.lds, g, S, E); }
#define PH5 { pg8::Gemm g{(const bf16*)(ws + WS_MIX), (const bf16*)(ws + WS_WOT), 1024, nullptr, 0, nullptr}; \
        pg8::StaticOrder S; S.init(M / 256, D / 256, F.G, (int)blockIdx.x); \
        pg8::EpiWo E{args.in[0], (bf16*)(ws + WS_H)}; \
        pg8::gemm_phase<pg8::EpiWo, true, true>(F.lds, g, S, E); }
#define PH8 { const unsigned* ctl = (const unsigned*)(ws + WS_CTL); const int ntile = (int)ld_u32_agent(ctl + CW_NT); \
        pg8::Gemm g{(const bf16*)(ws + WS_HN2), (const bf16*)(ws + WS_WUPT), 512, ctl + CW_TEXP, (size_t)2048 * 1024, (const int*)(ws + WS_ROWTOK)}; \
        pg8::StaticOrder S; S.init(ntile, 8, F.G, (int)blockIdx.x); \
        pg8::EpiUp E{args.in[22], ws + WS_ACT}; \
        pg8::gemm_phase<pg8::EpiUp, true, true, true, true>(F.lds, g, S, E); }
#define PH9 { const unsigned* ctl = (const unsigned*)(ws + WS_CTL); const int ntile = (int)ld_u32_agent(ctl + CW_NT); \
        pg8::Gemm g{(const bf16*)(ws + WS_ACT), (const bf16*)(ws + WS_WDNT), 512, ctl + CW_TEXP, (size_t)1024 * 1024, nullptr}; \
        pg8::StaticOrder S; S.init(ntile, 4, F.G, (int)blockIdx.x); \
        pg8::EpiDown E{args.in[24], ws + WS_YBUF}; \
        pg8::gemm_phase<pg8::EpiDown, true, true, false, true>(F.lds, g, S, E); }
    if (IN(0)) { p0_prologue(F, args); REP2(0) p0_prologue(F, args); }
    SEAM(0);
    if (IN(1)) { PH1 REP2(1) PH1 }
    SEAM(1);
    if (IN(2)) { prep_phase<true>(F, args); REP2(2) prep_phase<true>(F, args); attn_phase(F, args); REP2(11) attn_phase(F, args); }
    SEAM(2);
    if (IN(3)) { scan_phase(F, args); REP2(3) scan_phase(F, args); }
    SEAM(3);
    if (IN(4)) { combine_phase(F, args); REP2(4) combine_phase(F, args); }
    SEAM(4);
    if (IN(5)) { PH5 REP2(5) PH5 }
    SEAM(5);
    if (IN(6)) { router_phase(F, args); REP2(6) { __syncthreads(); router_phase(F, args); } }
    SEAM(6);
    if (IN(7)) { dispatch_phase(F, args); REP2(7) { __syncthreads(); dispatch_phase(F, args); } }
    SEAM(7);
    if (IN(8)) { PH8 REP2(8) PH8 }
    SEAM(8);
    if (IN(9)) { PH9 REP2(9) PH9 }
    SEAM(9);
    if (IN(10)) { final_phase(F, args); REP2(10) final_phase(F, args); }
#undef IN
#undef SEAM
}

extern "C" void kernel_launch(void* const* d_in, const int* in_sizes, int n_in, void* d_out, int out_size, void* d_ws, size_t ws_size, hipStream_t stream) {
    static int grid = 0;
    if (grid == 0) {
        if (n_in != 26 || in_sizes[0] != M * D || out_size != M * D || ws_size < WS_END) { fprintf(stderr, "kernel_launch: unexpected problem (n_in %d, in0 %d, out %d, ws %zu)\n", n_in, n_in > 0 ? in_sizes[0] : -1, out_size, ws_size); grid = -1; return; }
        int dev = 0, cus = 0, per_cu = 0;
        if (hipGetDevice(&dev) != hipSuccess || hipDeviceGetAttribute(&cus, hipDeviceAttributeMultiprocessorCount, dev) != hipSuccess) { grid = -1; return; }
        if (hipFuncSetAttribute((const void*)fwd_megakernel, hipFuncAttributeMaxDynamicSharedMemorySize, LDS_BYTES) != hipSuccess) { fprintf(stderr, "kernel_launch: hipFuncSetAttribute failed\n"); grid = -1; return; }
        if (hipOccupancyMaxActiveBlocksPerMultiprocessor(&per_cu, (const void*)fwd_megakernel, 512, LDS_BYTES) != hipSuccess || per_cu < 1) { fprintf(stderr, "kernel_launch: occupancy query says %d\n", per_cu); per_cu = 1; }
        (void)hipGetLastError();
        grid = cus * 1;
        if (grid != 256) fprintf(stderr, "kernel_launch: note: %d CUs\n", cus);
    }
    if (grid < 0) return;
    if (hipMemsetAsync((char*)d_ws + WS_CTL + (size_t)CW_BAR * 4, 0, XCD_BAR_WORDS * 4, stream) != hipSuccess) { fprintf(stderr, "kernel_launch: memset failed\n"); return; }
    Args a{};
    for (int i = 0; i < 26; ++i) a.in[i] = (const float*)d_in[i];
    a.out = (float*)d_out; a.ws = (unsigned char*)d_ws;
#if MK_SPLIT
    for (int ph = 0; ph < NPHASE; ++ph) { a.ph_lo = ph; a.ph_hi = ph + 1; hipLaunchKernelGGL(fwd_megakernel, dim3(grid), dim3(512), LDS_BYTES, stream, a); }
#else
    a.ph_lo = 0; a.ph_hi = NPHASE;
    void* kargs[] = {&a};
    hipError_t e = hipLaunchCooperativeKernel((const void*)fwd_megakernel, dim3(grid), dim3(512), kargs, LDS_BYTES, stream);
    if (e != hipSuccess) fprintf(stderr, "kernel_launch: cooperative launch failed: %s (grid %d)\n", hipGetErrorString(e), grid);
#endif
}
```

```cpp
#include <hip/hip_runtime.h>
#include <hip/hip_cooperative_groups.h>
#include <cstdio>
#include <cstdint>
namespace cg = cooperative_groups;

#ifndef MK_SPLIT
#define MK_SPLIT 0
#endif

#ifndef MK_REPEAT
#define MK_REPEAT 0
#endif
#define LAS __attribute__((address_space(3)))
typedef unsigned short bf16;
typedef float f32x4 __attribute__((ext_vector_type(4)));
typedef float f32x2 __attribute__((ext_vector_type(2)));
typedef unsigned u32x4 __attribute__((ext_vector_type(4)));
typedef unsigned u32x2 __attribute__((ext_vector_type(2)));
typedef short bf16x8 __attribute__((ext_vector_type(8)));
typedef short s16x4 __attribute__((ext_vector_type(4)));

constexpr int BATCH = 4, T = 8192, D = 1024, M = BATCH * T;
constexpr int NH = 8, HD = 64, CW = 512;
constexpr int SHIFT_W = 1920, NPROJ = 3456, NPROJ_PAD = 3584, PW = 2048;
constexpr int NE = 32, TOPK = 4, DE = 1024;
constexpr int GRIDW = 64, GROWS = 128;
constexpr int P_TILES_MAX = 544, P_ROWS = P_TILES_MAX * 256;
constexpr float RMS_EPS = 1e-5f, GN_EPS = 64e-5f;
constexpr int NPHASE = 11;

constexpr size_t MiB = 1u << 20;
constexpr size_t WS_CTL = 0;
constexpr size_t WS_W2T = 1 * MiB, WS_A2T = WS_W2T + 131072, WS_G2T = WS_A2T + 131072;
constexpr size_t WS_WINT = 2 * MiB, WS_WOT = 9 * MiB, WS_WUPT = 12 * MiB, WS_WDNT = 140 * MiB;
constexpr size_t WS_EIDX = 204 * MiB, WS_GATE = WS_EIDX + 524288, WS_RANK = WS_GATE + 524288, WS_DEST = WS_RANK + 524288, WS_ROWTOK = WS_DEST + 524288;
constexpr size_t WS_R = 208 * MiB, WS_V = 240 * MiB, WS_KK = 272 * MiB, WS_DECAY = 304 * MiB, WS_KDIR = 368 * MiB, WS_AKK = 432 * MiB,
                 WS_G = 496 * MiB, WS_ATT = 528 * MiB;
constexpr size_t WS_Q = 560 * MiB, WS_K = 592 * MiB, WS_VT = 624 * MiB, WS_P = 656 * MiB, WS_HN = 784 * MiB, WS_Y = 848 * MiB;
constexpr size_t WS_MIX = 560 * MiB, WS_H = 752 * MiB, WS_HN2 = 880 * MiB, WS_XBUF = 208 * MiB, WS_ACT = 480 * MiB, WS_YBUF = 208 * MiB;
constexpr size_t WS_END = 976 * MiB;
constexpr int CW_NT = 0, CW_TEXP = 64, CW_CNT = 1024, CW_BAR = 16384;

constexpr int LDS_BYTES = 159744, LDS_MISC = LDS_BYTES - 256;

typedef __bf16 bf16x2_t __attribute__((ext_vector_type(2)));
__device__ __forceinline__ unsigned cvt_pk_bf16(float lo, float hi) { const f32x2 v = {lo, hi}; return __builtin_bit_cast(unsigned, __builtin_convertvector(v, bf16x2_t)); }
typedef int i32x8 __attribute__((ext_vector_type(8)));
typedef int i32x4 __attribute__((ext_vector_type(4)));
#ifndef F8_SCALE1
#define F8_SCALE1 0
#endif
constexpr float F8_SX = 32.0f, F8_SW = 128.0f, F8_SACT = 8.0f, F8_SY = 32.0f;
__device__ __forceinline__ float f8clamp(float v) { return __builtin_amdgcn_fmed3f(v, -448.0f, 448.0f); }
__device__ __forceinline__ unsigned pk4_fp8(float a, float b, float c, float d) { int w = 0; w = __builtin_amdgcn_cvt_pk_fp8_f32(f8clamp(a), f8clamp(b), w, false); w = __builtin_amdgcn_cvt_pk_fp8_f32(f8clamp(c), f8clamp(d), w, true); return (unsigned)w; }
__device__ __forceinline__ float bflo(unsigned u) { return __uint_as_float(u << 16); }
__device__ __forceinline__ float bfhi(unsigned u) { return __uint_as_float(u & 0xffff0000u); }
__device__ __forceinline__ float bf1(bf16 v) { return __uint_as_float(((unsigned)v) << 16); }
__device__ __forceinline__ void unpack8(const u32x4 u, float* f) { f[0] = bflo(u.x); f[1] = bfhi(u.x); f[2] = bflo(u.y); f[3] = bfhi(u.y); f[4] = bflo(u.z); f[5] = bfhi(u.z); f[6] = bflo(u.w); f[7] = bfhi(u.w); }
__device__ __forceinline__ u32x4 pack8(const float* f) { u32x4 o; o.x = cvt_pk_bf16(f[0], f[1]); o.y = cvt_pk_bf16(f[2], f[3]); o.z = cvt_pk_bf16(f[4], f[5]); o.w = cvt_pk_bf16(f[6], f[7]); return o; }
__device__ __forceinline__ float wave_sum(float v) {
#pragma unroll
    for (int o = 1; o < 64; o <<= 1) v += __shfl_xor(v, o);
    return v;
}
__device__ __forceinline__ float sigmoidf_(float x) { return __builtin_amdgcn_rcpf(1.0f + __expf(-x)); }
__device__ __forceinline__ unsigned ld_u32_agent(const unsigned* p) { return __hip_atomic_load(p, __ATOMIC_RELAXED, __HIP_MEMORY_SCOPE_AGENT); }

namespace pg8 {
constexpr int BM = 256, BK = 64, HALF = 128, HTB = HALF * BK * 2, STAGE_BYTES = 8 * HTB, NXCD = 8, WGM = 8;
__host__ __device__ __forceinline__ int lds_byte(int r, int c) { const int st = (r >> 4) * 2 + (c >> 5), rr = r & 15, cc = c & 31, ob = rr * 64 + cc * 2; return st * 1024 + (ob ^ (((ob >> 9) & 1) << 5)); }
__host__ __device__ __forceinline__ void stage_rc(int b, int& R, int& C) { const int st = b / 1024, sb = b % 1024, swz = sb ^ (((sb >> 9) & 1) << 5); R = (st >> 1) * 16 + swz / 64; C = (st & 1) * 32 + (swz % 64) / 2; }
__host__ __device__ __forceinline__ int perm32(int rho) { const int n = rho >> 4, i = rho & 15; return 8 * (i >> 2) + 4 * n + (i & 3); }

struct Unit { int pm, pn, e; };
struct Gemm { const bf16* A; const bf16* Bt; int K; const unsigned* texp; size_t bstride; const int* rowtok; };

struct StaticOrder {
    int nM, nN, nwg, G, c;
    __device__ void init(int nM_, int nN_, int G_, int c_) { nM = nM_; nN = nN_; nwg = nM * nN; G = G_; c = c_; }
    __device__ bool next(int i, Unit& u) const {
        const long L = (long)i * G + c; if (L >= nwg) return false;
        int wgid = (int)L; { const int q = nwg / NXCD, r = nwg % NXCD, xcd = wgid % NXCD, off = wgid / NXCD; wgid = (xcd < r ? xcd * (q + 1) : r * (q + 1) + (xcd - r) * q) + off; }
        const int nig = WGM * nN, gid = wgid / nig, fm = gid * WGM, gsz = (nM - fm) < WGM ? (nM - fm) : WGM;
        u.pm = fm + ((wgid % nig) % gsz); u.pn = (wgid % nig) / gsz; u.e = 0; return true;
    }
};

__device__ __forceinline__ i32x8 cat8(const bf16x8 lo, const bf16x8 hi) { return __builtin_shufflevector(__builtin_bit_cast(i32x4, lo), __builtin_bit_cast(i32x4, hi), 0, 1, 2, 3, 4, 5, 6, 7); }
template <class Epi, bool ALIGN_EPI, bool SP2, bool GATHER = false, bool FP8 = false>
__device__ __forceinline__ void gemm_phase(LAS unsigned char* lds, const Gemm g, const StaticOrder& S, const Epi& E) {
    const int tid = threadIdx.x, wid = __builtin_amdgcn_readfirstlane(tid >> 6), lane = tid & 63, wr = wid >> 2, wc = wid & 3, fr = lane & 15, fq = lane >> 4;
    const int K = g.K, nt = K / BK;
    unsigned voffA[2], voffB[2];
#pragma unroll
    for (int i = 0; i < 2; ++i) { int R, C; stage_rc(tid * 16 + i * 8192, R, C); const int Rb = Epi::PERM ? ((R & ~31) + perm32(R & 31)) : R;
        voffA[i] = (unsigned)(R * K + C) * 2u; voffB[i] = (unsigned)(Rb * K + C) * 2u; }
    unsigned vC[2][2];
#define PG8_GROWS(u, dst) do { _Pragma("unroll") for (int h_ = 0; h_ < 2; ++h_) _Pragma("unroll") for (int i_ = 0; i_ < 2; ++i_) { int R_, C_; stage_rc(tid * 16 + i_ * 8192, R_, C_); \
        dst[h_][i_] = (unsigned)g.rowtok[(u).pm * BM + h_ * HALF + R_] * (unsigned)(K * 2) + (unsigned)(C_ * 2); } } while (0)
    const size_t kstep = (size_t)(BK * 2);
    const size_t hstep = (size_t)HALF * K * 2;
    const size_t tstep = 2 * hstep;
    const unsigned ldsw = (unsigned)wid * 1024u;
    const int aoff = lds_byte(wr * 64 + fr, fq * 8), boff = lds_byte(wc * 32 + fr, fq * 8);
#define PG8_SA(b, h) (((b) * 2 + (h)) * HTB)
#define PG8_SB(b, h) ((4 + (b) * 2 + (h)) * HTB)
#define PG8_STAGE(bufoff, gbase, voff) do { _Pragma("unroll") for (int _i = 0; _i < 2; ++_i) \
        __builtin_amdgcn_global_load_lds((const unsigned*)((const char*)(gbase) + (voff)[_i]), (LAS unsigned*)(lds + (bufoff) + ldsw + _i * 8192), 16, 0, 0); } while (0)
#define PG8_STAGE_A(bufoff, p, h, nx) do { if constexpr (GATHER) { PG8_STAGE(bufoff, p, vC[h]); } else PG8_STAGE(bufoff, (p) + (h) * hstep, voffA); } while (0)
#define PG8_LDA(dst, b, h) do { _Pragma("unroll") for (int m = 0; m < 4; ++m) _Pragma("unroll") for (int k = 0; k < 2; ++k) dst[m][k] = *(const LAS bf16x8*)(lds + PG8_SA(b, h) + aoff + m * 2048 + k * 1024); } while (0)
#define PG8_LDB(dst, b, h) do { _Pragma("unroll") for (int n = 0; n < 2; ++n) _Pragma("unroll") for (int k = 0; k < 2; ++k) dst[n][k] = *(const LAS bf16x8*)(lds + PG8_SB(b, h) + boff + n * 2048 + k * 1024); } while (0)
#define PG8_MMA(ai, bj, At, Bt) do { __builtin_amdgcn_s_setprio(1); \
        if constexpr (FP8) { _Pragma("unroll") for (int m = 0; m < 4; ++m) _Pragma("unroll") for (int n = 0; n < 2; ++n) \
            { const i32x8 b8_ = cat8(Bt[n][0], Bt[n][1]), a8_ = cat8(At[m][0], At[m][1]); asm volatile("v_mfma_f32_16x16x128_f8f6f4 %0, %1, %2, %0" : "+v"(acc[ai][bj][m][n]) : "v"(b8_), "v"(a8_)); } } \
        else { _Pragma("unroll") for (int m = 0; m < 4; ++m) _Pragma("unroll") for (int n = 0; n < 2; ++n) _Pragma("unroll") for (int k = 0; k < 2; ++k) \
            acc[ai][bj][m][n] = __builtin_amdgcn_mfma_f32_16x16x32_bf16(Bt[n][k], At[m][k], acc[ai][bj][m][n], 0, 0, 0); } \
        __builtin_amdgcn_s_setprio(0); } while (0)
#define PG8_WAIT_V(n) asm volatile("s_waitcnt vmcnt(" #n ")" ::: "memory")
#define PG8_WAIT_L(n) asm volatile("s_waitcnt lgkmcnt(" #n ")" ::: "memory")
#define PG8_BAR __builtin_amdgcn_s_barrier()
#define PG8_SCHED __builtin_amdgcn_sched_barrier(0)
#define PG8_UPTR(u, pa, pb) do { unsigned _e = g.texp ? ld_u32_agent(g.texp + (u).pm) : 0u; _e = (unsigned)__builtin_amdgcn_readfirstlane((int)_e); (u).e = (int)_e; \
        pa = GATHER ? (const char*)g.A : (const char*)g.A + (size_t)(u).pm * tstep; pb = (const char*)g.Bt + (size_t)_e * g.bstride + (size_t)(u).pn * tstep; } while (0)
    Unit cur, nxt; int ui = 0;
    if (!S.next(0, cur)) return;
    f32x4 acc[2][2][4][2];
#pragma unroll
    for (int a = 0; a < 2; ++a)
#pragma unroll
        for (int b = 0; b < 2; ++b)
#pragma unroll
            for (int m = 0; m < 4; ++m)
#pragma unroll
                for (int n = 0; n < 2; ++n) acc[a][b][m][n] = (f32x4){0.f, 0.f, 0.f, 0.f};
    bf16x8 At[4][2], B0[2][2], B1[2][2];
    const char* cA; const char* cB;
    PG8_UPTR(cur, cA, cB);
    if constexpr (GATHER) { PG8_GROWS(cur, vC); }
    if constexpr (SP2) {
        PG8_STAGE(PG8_SB(0, 0), cB, voffB); PG8_STAGE(PG8_SB(0, 1), cB + hstep, voffB); PG8_STAGE_A(PG8_SA(0, 0), cA, 0, false); PG8_STAGE_A(PG8_SA(0, 1), cA, 1, false);
        if (wr == 1) PG8_BAR;
        PG8_WAIT_V(2); PG8_BAR;
        PG8_STAGE(PG8_SB(1, 0), cB + kstep, voffB); PG8_STAGE_A(PG8_SA(1, 0), cA + kstep, 0, false); PG8_STAGE(PG8_SB(1, 1), cB + hstep + kstep, voffB);
        PG8_WAIT_V(6); PG8_BAR;
    } else {
        PG8_STAGE(PG8_SB(0, 0), cB, voffB); PG8_STAGE_A(PG8_SA(0, 0), cA, 0, false); PG8_STAGE(PG8_SB(0, 1), cB + hstep, voffB); PG8_STAGE_A(PG8_SA(0, 1), cA, 1, false);
        if (wr == 1) PG8_BAR;
        PG8_WAIT_V(4); PG8_BAR;
        PG8_STAGE(PG8_SB(1, 0), cB + kstep, voffB); PG8_STAGE_A(PG8_SA(1, 0), cA + kstep, 0, false); PG8_STAGE(PG8_SB(1, 1), cB + hstep + kstep, voffB);
        PG8_WAIT_V(6); PG8_BAR;
    }
    for (;;) {
        const bool has_next = S.next(ui + 1, nxt);
        const char* nA = cA; const char* nB = cB;
        if (has_next) PG8_UPTR(nxt, nA, nB);
#pragma unroll 1
        for (int t = 0; t < nt; t += 2) {
            const bool last = (t == nt - 2);
            const char* a1 = cA + (size_t)(t + 1) * kstep;
            const char* a2 = last ? nA : cA + (size_t)(t + 2) * kstep; const char* b2 = last ? nB : cB + (size_t)(t + 2) * kstep;
            const char* a3 = a2 + kstep; const char* b3 = b2 + kstep;
            if constexpr (SP2) {
            PG8_LDB(B0, 0, 0); PG8_LDB(B1, 0, 1); PG8_SCHED; PG8_LDA(At, 0, 0); PG8_STAGE_A(PG8_SA(1, 1), a1, 1, false);
            if constexpr (GATHER) { if (last && has_next) { PG8_GROWS(nxt, vC); } }
            PG8_WAIT_V(8); PG8_WAIT_L(0); PG8_BAR; PG8_MMA(0, 0, At, B0); PG8_MMA(0, 1, At, B1); PG8_BAR; PG8_SCHED;
            PG8_LDA(At, 0, 1); PG8_STAGE(PG8_SB(0, 0), b2, voffB); PG8_STAGE(PG8_SB(0, 1), b2 + hstep, voffB); PG8_STAGE_A(PG8_SA(0, 0), a2, 0, last);
            PG8_WAIT_V(8); PG8_WAIT_L(0); PG8_BAR; PG8_MMA(1, 0, At, B0); PG8_MMA(1, 1, At, B1); PG8_BAR; PG8_SCHED;
            PG8_LDB(B0, 1, 0); PG8_LDB(B1, 1, 1); PG8_SCHED; PG8_LDA(At, 1, 0); PG8_STAGE_A(PG8_SA(0, 1), a2, 1, last);
            PG8_WAIT_V(8); PG8_WAIT_L(0); PG8_BAR; PG8_MMA(0, 0, At, B0); PG8_MMA(0, 1, At, B1); PG8_BAR; PG8_SCHED;
            PG8_LDA(At, 1, 1); PG8_STAGE(PG8_SB(1, 0), b3, voffB); PG8_STAGE(PG8_SB(1, 1), b3 + hstep, voffB); PG8_STAGE_A(PG8_SA(1, 0), a3, 0, last);
            PG8_WAIT_V(8); PG8_WAIT_L(0); PG8_BAR; PG8_MMA(1, 0, At, B0); PG8_MMA(1, 1, At, B1); PG8_BAR; PG8_SCHED;
            } else {
            PG8_LDB(B0, 0, 0); PG8_SCHED; PG8_LDA(At, 0, 0); PG8_STAGE_A(PG8_SA(1, 1), a1, 1, false);
            if constexpr (GATHER) { if (last && has_next) { PG8_GROWS(nxt, vC); } }
            PG8_WAIT_L(8); PG8_BAR; PG8_WAIT_L(0); PG8_MMA(0, 0, At, B0); PG8_BAR; PG8_SCHED;
            PG8_LDB(B1, 0, 1); PG8_STAGE(PG8_SB(0, 0), b2, voffB);
            PG8_BAR; PG8_WAIT_L(0); PG8_MMA(0, 1, At, B1); PG8_BAR;
            PG8_LDA(At, 0, 1); PG8_STAGE_A(PG8_SA(0, 0), a2, 0, last);
            PG8_BAR; PG8_WAIT_L(0); PG8_MMA(1, 0, At, B0); PG8_BAR; PG8_SCHED;
            PG8_STAGE(PG8_SB(0, 1), b2 + hstep, voffB);
            PG8_WAIT_V(6); PG8_BAR; PG8_MMA(1, 1, At, B1); PG8_BAR;
            PG8_LDB(B0, 1, 0); PG8_SCHED; PG8_LDA(At, 1, 0); PG8_STAGE_A(PG8_SA(0, 1), a2, 1, last);
            PG8_WAIT_L(8); PG8_BAR; PG8_WAIT_L(0); PG8_MMA(0, 0, At, B0); PG8_BAR; PG8_SCHED;
            PG8_LDB(B1, 1, 1); PG8_STAGE(PG8_SB(1, 0), b3, voffB);
            PG8_BAR; PG8_WAIT_L(0); PG8_MMA(0, 1, At, B1); PG8_BAR;
            PG8_LDA(At, 1, 1); PG8_STAGE_A(PG8_SA(1, 0), a3, 0, last);
            PG8_BAR; PG8_WAIT_L(0); PG8_MMA(1, 0, At, B0); PG8_BAR; PG8_SCHED;
            PG8_STAGE(PG8_SB(1, 1), b3 + hstep, voffB);
            PG8_WAIT_V(6); PG8_BAR; PG8_MMA(1, 1, At, B1); PG8_BAR;
            }
        }
        if constexpr (ALIGN_EPI) { if (wr == 0) PG8_BAR; }
        if constexpr (FP8) { asm volatile("s_nop 15\n\ts_nop 15" ::: "memory"); PG8_SCHED; }
        E(acc, cur, wr, wc, fr, fq);
        if (!has_next) break;
#pragma unroll
        for (int a = 0; a < 2; ++a)
#pragma unroll
            for (int b = 0; b < 2; ++b)
#pragma unroll
                for (int m = 0; m < 4; ++m)
#pragma unroll
                    for (int n = 0; n < 2; ++n) acc[a][b][m][n] = (f32x4){0.f, 0.f, 0.f, 0.f};
        cur = nxt; cA = nA; cB = nB; ++ui;
        if constexpr (ALIGN_EPI) { if (wr == 1) PG8_BAR; }
    }
    PG8_WAIT_V(0);
    if constexpr (!ALIGN_EPI) { if (wr == 0) PG8_BAR; }
    PG8_BAR;
#undef PG8_SA
#undef PG8_SB
#undef PG8_STAGE
#undef PG8_LDA
#undef PG8_LDB
#undef PG8_MMA
#undef PG8_WAIT_V
#undef PG8_WAIT_L
#undef PG8_BAR
#undef PG8_SCHED
#undef PG8_UPTR
#undef PG8_STAGE_A
#undef PG8_GROWS
}

struct EpiProj {
    static constexpr bool PERM = true;
    bf16 *q, *k, *vT, *p;
    __device__ __forceinline__ void operator()(const f32x4 (&acc)[2][2][4][2], const Unit& u, int wr, int wc, int fr, int fq) const {
        const int row0 = u.pm * BM + wr * 64 + fr;
        const int pn = u.pn;
#pragma unroll
        for (int ai = 0; ai < 2; ++ai)
#pragma unroll
            for (int m = 0; m < 4; ++m) {
                const int row = row0 + ai * HALF + m * 16;
#pragma unroll
                for (int bj = 0; bj < 2; ++bj) {
                    f32x4 v0 = acc[ai][bj][m][0], v1 = acc[ai][bj][m][1];
                    const int col = pn * BM + bj * HALF + wc * 32 + 8 * fq;
                    if (pn >= 4 && pn < 6) {
                        const int cv = col - 1024, hh = cv >> 6, dim = cv & 63, b = row / T, t = row % T;
                        bf16* dst = vT + ((size_t)(((b * NH + hh) * GROWS + (t >> 6)) * HD + dim)) * 64 + (t & 63);
                        const unsigned w0 = cvt_pk_bf16(v0[0], v0[1]), w1 = cvt_pk_bf16(v0[2], v0[3]), w2 = cvt_pk_bf16(v1[0], v1[1]), w3 = cvt_pk_bf16(v1[2], v1[3]);
                        dst[0 * 64] = (bf16)(w0 & 0xffff); dst[1 * 64] = (bf16)(w0 >> 16); dst[2 * 64] = (bf16)(w1 & 0xffff); dst[3 * 64] = (bf16)(w1 >> 16);
                        dst[4 * 64] = (bf16)(w2 & 0xffff); dst[5 * 64] = (bf16)(w2 >> 16); dst[6 * 64] = (bf16)(w3 & 0xffff); dst[7 * 64] = (bf16)(w3 >> 16);
                        asm volatile("s_waitcnt vmcnt(40)" ::: "memory");
                    } else {
                        bf16* dst;
                        if (pn < 2) { v0 = v0 * 0.125f; v1 = v1 * 0.125f; dst = q + (size_t)row * CW + col; }
                        else if (pn < 4) dst = k + (size_t)row * CW + (col - 512);
                        else dst = p + (size_t)row * PW + (col - 1536);
                        u32x4 w; w.x = cvt_pk_bf16(v0[0], v0[1]); w.y = cvt_pk_bf16(v0[2], v0[3]); w.z = cvt_pk_bf16(v1[0], v1[1]); w.w = cvt_pk_bf16(v1[2], v1[3]);
                        *(u32x4*)dst = w;
                    }
                }
            }
    }
};
struct EpiWo {
    static constexpr bool PERM = true;
    const float* x; bf16* h;
    __device__ __forceinline__ void operator()(const f32x4 (&acc)[2][2][4][2], const Unit& u, int wr, int wc, int fr, int fq) const {
        const int row0 = u.pm * BM + wr * 64 + fr, col0 = u.pn * BM + wc * 32 + 8 * fq;
#pragma unroll
        for (int ai = 0; ai < 2; ++ai)
#pragma unroll
            for (int m = 0; m < 4; ++m) { const size_t off = (size_t)(row0 + ai * HALF + m * 16) * D + col0;
#pragma unroll
                for (int bj = 0; bj < 2; ++bj) { const f32x4 v0 = acc[ai][bj][m][0] + *(const f32x4*)(x + off + bj * HALF), v1 = acc[ai][bj][m][1] + *(const f32x4*)(x + off + bj * HALF + 4);
                    u32x4 w; w.x = cvt_pk_bf16(v0[0], v0[1]); w.y = cvt_pk_bf16(v0[2], v0[3]); w.z = cvt_pk_bf16(v1[0], v1[1]); w.w = cvt_pk_bf16(v1[2], v1[3]);
                    *(u32x4*)(h + off + bj * HALF) = w; } }
    }
};
struct EpiUp {
    static constexpr bool PERM = true;
    const float* b_up; unsigned char* act;
    __device__ __forceinline__ void operator()(const f32x4 (&acc)[2][2][4][2], const Unit& u, int wr, int wc, int fr, int fq) const {
        const int row0 = u.pm * BM + wr * 64 + fr, ch = u.pn * 128 + wc * 32 + 8 * fq;
        const float* bg = b_up + (size_t)u.e * 2048 + ch; const float* bl = bg + 1024;
        const f32x4 bg0 = *(const f32x4*)bg * F8_SACT, bg1 = *(const f32x4*)(bg + 4) * F8_SACT, bl0 = *(const f32x4*)bl, bl1 = *(const f32x4*)(bl + 4);
        constexpr float SG = F8_SACT / (F8_SX * F8_SW), SL = 1.0f / (F8_SX * F8_SW), KE = -1.702f * 1.44269504f / F8_SACT;
#pragma unroll
        for (int ai = 0; ai < 2; ++ai)
#pragma unroll
            for (int m = 0; m < 4; ++m) {
                float o[8];
#pragma unroll
                for (int n = 0; n < 2; ++n) { const f32x4 gv = acc[ai][0][m][n] * SG + (n ? bg1 : bg0), lv = acc[ai][1][m][n] * SL + (n ? bl1 : bl0);
#pragma unroll
                    for (int j = 0; j < 4; ++j) { const float gt = fminf(gv[j], 7.0f * F8_SACT), li = __builtin_amdgcn_fmed3f(lv[j], -7.0f, 7.0f);
                        const float t = gt * __builtin_amdgcn_rcpf(1.0f + __builtin_amdgcn_exp2f(gt * KE)); o[n * 4 + j] = __builtin_fmaf(li, t, t); } }
                int w0 = 0, w1 = 0;
                w0 = __builtin_amdgcn_cvt_pk_fp8_f32(o[0], o[1], w0, false); w0 = __builtin_amdgcn_cvt_pk_fp8_f32(o[2], o[3], w0, true);
                w1 = __builtin_amdgcn_cvt_pk_fp8_f32(o[4], o[5], w1, false); w1 = __builtin_amdgcn_cvt_pk_fp8_f32(o[6], o[7], w1, true);
                u32x2 w8; w8.x = (unsigned)w0; w8.y = (unsigned)w1;
                *(u32x2*)(act + (size_t)(row0 + ai * HALF + m * 16) * DE + ch) = w8;
            }
    }
};
struct EpiDown {
    static constexpr bool PERM = true;
    const float* b_dn; unsigned char* y;
    __device__ __forceinline__ void operator()(const f32x4 (&acc)[2][2][4][2], const Unit& u, int wr, int wc, int fr, int fq) const {
        const int row0 = u.pm * BM + wr * 64 + fr, col0 = u.pn * BM + wc * 32 + 8 * fq;
        const float* bb = b_dn + (size_t)u.e * D + col0;
        f32x4 bv[2][2];
#pragma unroll
        for (int bj = 0; bj < 2; ++bj)
#pragma unroll
            for (int n = 0; n < 2; ++n) bv[bj][n] = *(const f32x4*)(bb + bj * HALF + 4 * n) * F8_SY;
#pragma unroll
        for (int ai = 0; ai < 2; ++ai)
#pragma unroll
            for (int m = 0; m < 4; ++m) { unsigned char* rowp = y + (size_t)(row0 + ai * HALF + m * 16) * D + col0;
#pragma unroll
                for (int bj = 0; bj < 2; ++bj) { const f32x4 v0 = acc[ai][bj][m][0] * (F8_SY / (F8_SACT * F8_SW)) + bv[bj][0], v1 = acc[ai][bj][m][1] * (F8_SY / (F8_SACT * F8_SW)) + bv[bj][1];
                    u32x2 w; w.x = pk4_fp8(v0[0], v0[1], v0[2], v0[3]); w.y = pk4_fp8(v1[0], v1[1], v1[2], v1[3]);
                    *(u32x2*)(rowp + bj * HALF) = w; } }
    }
};
}


#define XB_TMO      128
#define XB_XCNT(j)  (256  + 64 * (j))
#define XB_XSUB(j)  (1280 + 64 * (j))
#define XB_XGEN(j)  (2304 + 64 * (j))
#define XB_TOP      3328
#define XB_TOPGEN   3392
#define XCD_BAR_WORDS 3456
#define XB_SPIN_CAP (1u << 20)
__device__ __forceinline__ unsigned xb_ld(unsigned* p)              { return __hip_atomic_load(p, __ATOMIC_RELAXED, __HIP_MEMORY_SCOPE_AGENT); }
__device__ __forceinline__ unsigned xb_add(unsigned* p, unsigned v) { return __hip_atomic_fetch_add(p, v, __ATOMIC_RELAXED, __HIP_MEMORY_SCOPE_AGENT); }
__device__ __forceinline__ unsigned xb_xcc_id() { return (unsigned)__builtin_amdgcn_s_getreg((3 << 11) | 20) & 0xFu; }
#define XB_SPIN(cond, bar) do { unsigned _sp = 0; while (cond) { __builtin_amdgcn_s_sleep(1); \
    if ((++_sp & 255u) == 0u) { if (xb_ld(&(bar)[XB_TMO])) break; if (_sp > XB_SPIN_CAP) { atomicAdd(&(bar)[XB_TMO], 1u); break; } } } } while (0)
struct XcdBarrier { unsigned* bar; unsigned x; volatile LAS unsigned* st; };
__device__ __forceinline__ XcdBarrier xcd_barrier_post(unsigned* bar, volatile LAS unsigned* st) {
    XcdBarrier b; b.bar = bar; b.x = xb_xcc_id(); b.st = st;
    if (threadIdx.x == 0) (void)xb_add(&bar[XB_XCNT(b.x)], 1u);
    return b;
}
__device__ __forceinline__ void xcd_barrier_complete(unsigned* bar, unsigned x, unsigned& nloc, unsigned& nx) {
    const unsigned G = gridDim.x * gridDim.y * gridDim.z;
    unsigned sum, cnt, mine, sp = 0u;
    for (;;) {
        sum = 0u; cnt = 0u; mine = 0u;
#pragma unroll
        for (unsigned j = 0; j < 16; ++j) { const unsigned c = xb_ld(&bar[XB_XCNT(j)]); sum += c; cnt += (c > 0u) ? 1u : 0u; mine = (j == x) ? c : mine; }
        if (sum == G) break;
        __builtin_amdgcn_s_sleep(1);
        if ((++sp & 255u) == 0u) { if (xb_ld(&bar[XB_TMO])) break; if (sp > XB_SPIN_CAP) { atomicAdd(&bar[XB_TMO], 1u); break; } }
    }
    nloc = mine > 0u ? mine : 1u; nx = cnt > 0u ? cnt : 1u;
}
__device__ __forceinline__ void xcd_barrier(const XcdBarrier& b) {
    asm volatile("s_waitcnt vmcnt(0)" ::: "memory");
    __syncthreads();
    if (threadIdx.x == 0) {
        unsigned* bar = b.bar;
        __builtin_amdgcn_s_waitcnt(0);
        unsigned nloc = b.st[0], nx = b.st[1];
        if (nloc == 0u) { xcd_barrier_complete(bar, b.x, nloc, nx); b.st[0] = nloc; b.st[1] = nx; }
        const unsigned old = xb_add(&bar[XB_XSUB(b.x)], 1u);
        const unsigned gen = old / nloc;
        if (old + 1u == (gen + 1u) * nloc) {
            __builtin_amdgcn_fence(__ATOMIC_RELEASE, "agent");
            asm volatile("s_waitcnt vmcnt(0)" ::: "memory");
            const unsigned og = xb_add(&bar[XB_TOP], 1u);
            const unsigned tg = og / nx;
            if (og + 1u == (tg + 1u) * nx) xb_add(&bar[XB_TOPGEN], 1u);
            else XB_SPIN(xb_ld(&bar[XB_TOPGEN]) == tg, bar);
            __builtin_amdgcn_fence(__ATOMIC_ACQUIRE, "agent");
            xb_add(&bar[XB_XGEN(b.x)], 1u);
            asm volatile("s_waitcnt vmcnt(0)" ::: "memory");
        } else {
            XB_SPIN(xb_ld(&bar[XB_XGEN(b.x)]) == gen, bar);
            __builtin_amdgcn_fence(__ATOMIC_ACQUIRE, "agent");
            asm volatile("s_waitcnt vmcnt(0)" ::: "memory");
        }
    }
    __syncthreads();
}

struct Args { const float* in[26]; float* out; unsigned char* ws; int ph_lo, ph_hi; };

struct Frame { LAS unsigned char* lds; int tid, lane, wave, G, vcu; };

__device__ __forceinline__ void transpose_item(const float* W, int K, int N, bf16* WT, int k0, int n0, int orow0, LAS float* scr, int lane) {
#pragma unroll 8
    for (int i = 0; i < 32; ++i) { const int kk = 2 * i + (lane >> 5); scr[kk * 33 + (lane & 31)] = W[(size_t)(k0 + kk) * N + n0 + (lane & 31)]; }
    asm volatile("s_waitcnt lgkmcnt(0)" ::: "memory");
    const int c = lane & 7;
#pragma unroll
    for (int j = 0; j < 4; ++j) { const int n = (lane >> 3) + 8 * j; const LAS float* s = scr + (8 * c) * 33 + n;
        u32x4 o; o.x = cvt_pk_bf16(s[0 * 33], s[1 * 33]); o.y = cvt_pk_bf16(s[2 * 33], s[3 * 33]); o.z = cvt_pk_bf16(s[4 * 33], s[5 * 33]); o.w = cvt_pk_bf16(s[6 * 33], s[7 * 33]);
        *(u32x4*)(WT + (size_t)(orow0 + n) * K + k0 + 8 * c) = o; }
    asm volatile("s_waitcnt lgkmcnt(0)" ::: "memory");
}

__device__ __forceinline__ void transpose_item8(const float* W, int K, int N, unsigned char* WT, int k0, int n0, int orow0, LAS float* scr, int lane) {
#pragma unroll 8
    for (int i = 0; i < 32; ++i) { const int kk = 2 * i + (lane >> 5); scr[kk * 33 + (lane & 31)] = W[(size_t)(k0 + kk) * N + n0 + (lane & 31)]; }
    asm volatile("s_waitcnt lgkmcnt(0)" ::: "memory");
    const int c = lane & 7;
#pragma unroll
    for (int j = 0; j < 4; ++j) { const int n = (lane >> 3) + 8 * j; const LAS float* s = scr + (8 * c) * 33 + n;
        u32x2 o; o.x = pk4_fp8(s[0 * 33] * F8_SW, s[1 * 33] * F8_SW, s[2 * 33] * F8_SW, s[3 * 33] * F8_SW); o.y = pk4_fp8(s[4 * 33] * F8_SW, s[5 * 33] * F8_SW, s[6 * 33] * F8_SW, s[7 * 33] * F8_SW);
        *(u32x2*)(WT + (size_t)(orow0 + n) * K + k0 + 8 * c) = o; }
    asm volatile("s_waitcnt lgkmcnt(0)" ::: "memory");
}

__device__ __forceinline__ void p0_prologue(const Frame& F, const Args& a) {
    unsigned char* ws = a.ws;
    LAS float* scr = (LAS float*)(F.lds + F.wave * 8448);
    const int gw = F.vcu * 8 + F.wave, NGW = F.G * 8;
    constexpr int I_IN = 16 * 108, I_O = 16 * 32, I_L = 16, I_G = 32;
    constexpr int NITEMS = I_IN + I_O + 2 * I_L + 2 * I_L + I_G;
    for (int it = gw; it < NITEMS; it += NGW) {
        int r = it;
        if (r < I_IN) { const int kb = r / 108, nb = r % 108; transpose_item(a.in[2], 1024, NPROJ, (bf16*)(ws + WS_WINT), kb * 64, nb * 32, nb * 32, scr, F.lane); continue; }
        r -= I_IN;
        if (r < I_O) { const int kb = r / 32, nb = r % 32; transpose_item(a.in[17], 1024, 1024, (bf16*)(ws + WS_WOT), kb * 64, nb * 32, nb * 32, scr, F.lane); continue; }
        r -= I_O;
        if (r < 2 * I_L) { const int z = r / 16, nb = r % 16; transpose_item(a.in[8] + (size_t)z * 64 * 512, 64, 512, (bf16*)(ws + WS_W2T) + (size_t)z * 512 * 64, 0, nb * 32, nb * 32, scr, F.lane); continue; }
        r -= 2 * I_L;
        if (r < 2 * I_L) { const int z = r / 16, nb = r % 16; transpose_item(a.in[10] + (size_t)z * 64 * 512, 64, 512, (bf16*)(ws + WS_A2T) + (size_t)z * 512 * 64, 0, nb * 32, nb * 32, scr, F.lane); continue; }
        r -= 2 * I_L;
        { const int kb = r / 16, nb = r % 16; transpose_item(a.in[11], 128, 512, (bf16*)(ws + WS_G2T), kb * 64, nb * 32, nb * 32, scr, F.lane); }
    }
    { u32x4* z = (u32x4*)(ws + WS_WINT + (size_t)NPROJ * 1024 * 2); const u32x4 zero = {0u, 0u, 0u, 0u};
      for (int i = F.vcu * 512 + F.tid; i < 16384; i += F.G * 512) z[i] = zero; }
    const float* x = a.in[0]; const float* nw = a.in[1]; bf16* hn = (bf16*)(ws + WS_HN);
    f32x4 wv[4];
#pragma unroll
    for (int j = 0; j < 4; ++j) wv[j] = *((const f32x4*)nw + F.lane + 64 * j);
    for (int m = gw; m < M; m += 2 * NGW) {
        const int m1 = m + NGW; const bool has1 = m1 < M;
        const f32x4* xr0 = (const f32x4*)(x + (size_t)m * D) + F.lane; const f32x4* xr1 = (const f32x4*)(x + (size_t)(has1 ? m1 : m) * D) + F.lane;
        f32x4 v0[4], v1[4]; float s0 = 0.f, s1 = 0.f;
#pragma unroll
        for (int j = 0; j < 4; ++j) { v0[j] = xr0[64 * j]; v1[j] = xr1[64 * j]; }
#pragma unroll
        for (int j = 0; j < 4; ++j) { s0 += (v0[j].x * v0[j].x + v0[j].y * v0[j].y) + (v0[j].z * v0[j].z + v0[j].w * v0[j].w); s1 += (v1[j].x * v1[j].x + v1[j].y * v1[j].y) + (v1[j].z * v1[j].z + v1[j].w * v1[j].w); }
        const float rs0 = rsqrtf(wave_sum(s0) * (1.f / D) + RMS_EPS), rs1 = rsqrtf(wave_sum(s1) * (1.f / D) + RMS_EPS);
        u32x2* o0 = (u32x2*)(hn + (size_t)m * D) + F.lane; u32x2* o1 = (u32x2*)(hn + (size_t)m1 * D) + F.lane;
#pragma unroll
        for (int j = 0; j < 4; ++j) { u32x2 o; o.x = cvt_pk_bf16(v0[j].x * rs0 * wv[j].x, v0[j].y * rs0 * wv[j].y); o.y = cvt_pk_bf16(v0[j].z * rs0 * wv[j].z, v0[j].w * rs0 * wv[j].w); o0[64 * j] = o; }
        if (has1) {
#pragma unroll
            for (int j = 0; j < 4; ++j) { u32x2 o; o.x = cvt_pk_bf16(v1[j].x * rs1 * wv[j].x, v1[j].y * rs1 * wv[j].y); o.y = cvt_pk_bf16(v1[j].z * rs1 * wv[j].z, v1[j].w * rs1 * wv[j].w); o1[64 * j] = o; } }
    }
}

constexpr int PREP_KBUF = 0, PREP_INV = 65536, PREP_AW = 67584, PREP_AA = PREP_AW + 17408, PREP_AG = PREP_AA + 17408, PREP_LD = 136;
template <bool STORE>
__device__ __forceinline__ void prep_phase(const Frame& F, const Args& a) {
    unsigned char* ws = a.ws;
    const bf16* p = (const bf16*)(ws + WS_P);
    bf16* r_out = (bf16*)(ws + WS_R); bf16* v_out = (bf16*)(ws + WS_V); bf16* kk_out = (bf16*)(ws + WS_KK);
    bf16* decay_out = (bf16*)(ws + WS_DECAY); bf16* kdir_out = (bf16*)(ws + WS_KDIR); bf16* akk_out = (bf16*)(ws + WS_AKK); bf16* g_out = (bf16*)(ws + WS_G);
    const bf16* w2T = (const bf16*)(ws + WS_W2T); const bf16* a2T = (const bf16*)(ws + WS_A2T); const bf16* g2T = (const bf16*)(ws + WS_G2T);
    const float* mu_p = a.in[5]; const float* mu_n = a.in[6]; const float* w0 = a.in[7]; const float* a0 = a.in[9];
    const float* k_k = a.in[12]; const float* k_a = a.in[13];
    LAS bf16* kbuf = (LAS bf16*)(F.lds + PREP_KBUF); LAS float* invb = (LAS float*)(F.lds + PREP_INV);
    LAS bf16* Aw = (LAS bf16*)(F.lds + PREP_AW); LAS bf16* Aa = (LAS bf16*)(F.lds + PREP_AA); LAS bf16* Ag = (LAS bf16*)(F.lds + PREP_AG);
    const int lane = F.lane, wave = F.wave, fr = lane & 15, fg = lane >> 4;
    for (int tile = F.vcu; tile < M / 64; tile += F.G) {
        const int m0 = tile * 64;
#pragma unroll 1
        for (int jj = 0; jj < 4; ++jj) {
            const int q = lane + 64 * jj; const bool valid = q < 240; const int c0 = 8 * q;
            float mp[8], mn[8];
#pragma unroll
            for (int i = 0; i < 8; ++i) { mp[i] = valid ? mu_p[c0 + i] : 0.f; mn[i] = valid ? mu_n[c0 + i] : 0.f; }
            const int mfirst = m0 + wave * 8;
            const u32x4 zero = {0u, 0u, 0u, 0u};
            u32x4 rows[10];
#pragma unroll
            for (int rI = 0; rI < 10; ++rI) { const int mr = mfirst - 1 + rI;
                const bool ok = valid && !(rI == 0 && (mfirst % T) == 0) && !(rI == 9 && ((mfirst + 7) % T) == T - 1);
                rows[rI] = ok ? *(const u32x4*)(p + (size_t)mr * PW + c0) : zero; }
#pragma unroll
            for (int i = 0; i < 8; ++i) {
                const int m = mfirst + i, it = wave * 8 + i;
                const u32x4 prev = rows[i], cur = rows[i + 1], nxt = rows[i + 2];
                float fp[8], fc[8], fn[8], s[8];
                unpack8(prev, fp); unpack8(cur, fc); unpack8(nxt, fn);
#pragma unroll
                for (int e = 0; e < 8; ++e) s[e] = fc[e] + mp[e] * (fp[e] - fc[e]) + mn[e] * (fn[e] - fc[e]);
                if (jj == 0) { if (STORE) { *(u32x4*)(r_out + (size_t)m * CW + c0) = pack8(s); } }
                else if (jj == 1) {
                    const int c = c0 - 512;
                    *(LAS u32x4*)(kbuf + it * 512 + c) = pack8(s);
                    float kr[8]; float ss = 0.f;
#pragma unroll
                    for (int e = 0; e < 8; ++e) { kr[e] = s[e] * k_k[c + e]; ss += kr[e] * kr[e]; }
                    ss += __shfl_xor(ss, 1); ss += __shfl_xor(ss, 2); ss += __shfl_xor(ss, 4);
                    const float inv = fminf(__builtin_amdgcn_rsqf(ss), 1e12f);
#pragma unroll
                    for (int e = 0; e < 8; ++e) kr[e] *= inv;
                    if (STORE) { *(u32x4*)(kk_out + (size_t)m * CW + c) = pack8(kr); }
                    if ((lane & 7) == 0) invb[it * 8 + (lane >> 3)] = inv;
                }
                else if (jj == 2) { if (STORE) { *(u32x4*)(v_out + (size_t)m * CW + (c0 - 1024)) = pack8(s); } }
                else if (valid) {
                    const int seg = lane >> 4, cw = 8 * (lane & 15);
                    if (seg == 0) {
#pragma unroll
                        for (int e = 0; e < 8; ++e) s[e] = 1.0f - 2.0f * __builtin_amdgcn_rcpf(__expf(2.0f * s[e]) + 1.0f);
                        *(LAS u32x4*)(Aw + it * PREP_LD + cw) = pack8(s);
                    } else if (seg == 1) { *(LAS u32x4*)(Aa + it * PREP_LD + cw) = pack8(s); }
                    else {
#pragma unroll
                        for (int e = 0; e < 8; ++e) s[e] = sigmoidf_(s[e]);
                        *(LAS u32x4*)(Ag + it * PREP_LD + cw) = pack8(s);
                    }
                }
            }
        }
        __syncthreads();
        const int nb = 64 * wave;
#define PREP_PROW(nt_) (nb + 32 * ((nt_) >> 1) + 8 * (fr >> 2) + 4 * ((nt_) & 1) + (fr & 3))
#define PREP_COL(nt_)  (nb + 32 * ((nt_) >> 1) + 8 * fg + 4 * ((nt_) & 1))
#pragma unroll 1
        for (int job = 0; job < 4; ++job) {
            const int z = job & 1;
            const bf16* WT = job < 2 ? w2T + (size_t)z * 512 * 64 : a2T + (size_t)z * 512 * 64;
            const LAS bf16* Ax = job < 2 ? Aw + z * 64 : Aa + z * 64;
            bf16x8 wf[2][4];
#pragma unroll
            for (int ks = 0; ks < 2; ++ks)
#pragma unroll
                for (int nt = 0; nt < 4; ++nt) wf[ks][nt] = *(const bf16x8*)(WT + (size_t)PREP_PROW(nt) * 64 + 32 * ks + 8 * fg);
            f32x4 pb[4], pkk[4], pka[4];
#pragma unroll
            for (int nt = 0; nt < 4; ++nt) { const int n = PREP_COL(nt);
                pb[nt] = *(const f32x4*)((job < 2 ? w0 : a0) + z * 512 + n); pkk[nt] = *(const f32x4*)(k_k + n); pka[nt] = *(const f32x4*)(k_a + n); }
            f32x4 acc[4][4];
#pragma unroll
            for (int mt = 0; mt < 4; ++mt)
#pragma unroll
                for (int nt = 0; nt < 4; ++nt) acc[mt][nt] = (f32x4){0.f, 0.f, 0.f, 0.f};
#pragma unroll
            for (int ks = 0; ks < 2; ++ks) {
                bf16x8 af[4];
#pragma unroll
                for (int mt = 0; mt < 4; ++mt) af[mt] = *(const LAS bf16x8*)(Ax + (16 * mt + fr) * PREP_LD + 32 * ks + 8 * fg);
#pragma unroll
                for (int mt = 0; mt < 4; ++mt)
#pragma unroll
                    for (int nt = 0; nt < 4; ++nt) acc[mt][nt] = __builtin_amdgcn_mfma_f32_16x16x32_bf16(wf[ks][nt], af[mt], acc[mt][nt], 0, 0, 0);
            }
#pragma unroll
            for (int mt = 0; mt < 4; ++mt) {
                const int it = 16 * mt + fr; const size_t m = (size_t)(m0 + it);
#pragma unroll
                for (int np = 0; np < 2; ++np) {
                    const int c8 = nb + 32 * np + 8 * fg;
                    if (job < 2) {
                        float o[8];
#pragma unroll
                        for (int hh = 0; hh < 2; ++hh) { const f32x4 v = acc[mt][2 * np + hh], bq = pb[2 * np + hh];
#pragma unroll
                            for (int i = 0; i < 4; ++i) o[4 * hh + i] = __expf(-0.60653066f * sigmoidf_(v[i] + bq[i])); }
                        if (STORE) { *(u32x4*)(decay_out + ((size_t)z * M + m) * CW + c8) = pack8(o); }
                    } else {
                        const u32x4 kb = *(const LAS u32x4*)(kbuf + it * 512 + c8);
                        float kv[8]; unpack8(kb, kv);
                        const float inv = invb[it * 8 + wave];
                        float kd[8], ak[8];
#pragma unroll
                        for (int hh = 0; hh < 2; ++hh) { const f32x4 v = acc[mt][2 * np + hh], bq = pb[2 * np + hh], kkc = pkk[2 * np + hh], kac = pka[2 * np + hh];
#pragma unroll
                            for (int i = 0; i < 4; ++i) { const float av = sigmoidf_(v[i] + bq[i]), kx = kv[4 * hh + i]; kd[4 * hh + i] = kx * (1.0f + (av - 1.0f) * kac[i]); ak[4 * hh + i] = av * (kx * kkc[i] * inv); } }
                        if (STORE) { *(u32x4*)(kdir_out + ((size_t)z * M + m) * CW + c8) = pack8(kd); *(u32x4*)(akk_out + ((size_t)z * M + m) * CW + c8) = pack8(ak); }
                    }
                }
            }
        }
        {
            bf16x8 wf[4][4];
#pragma unroll
            for (int ks = 0; ks < 4; ++ks)
#pragma unroll
                for (int nt = 0; nt < 4; ++nt) wf[ks][nt] = *(const bf16x8*)(g2T + (size_t)PREP_PROW(nt) * 128 + 32 * ks + 8 * fg);
            f32x4 acc[4][4];
#pragma unroll
            for (int mt = 0; mt < 4; ++mt)
#pragma unroll
                for (int nt = 0; nt < 4; ++nt) acc[mt][nt] = (f32x4){0.f, 0.f, 0.f, 0.f};
#pragma unroll
            for (int ks = 0; ks < 4; ++ks) {
                bf16x8 af[4];
#pragma unroll
                for (int mt = 0; mt < 4; ++mt) af[mt] = *(const LAS bf16x8*)(Ag + (16 * mt + fr) * PREP_LD + 32 * ks + 8 * fg);
#pragma unroll
                for (int mt = 0; mt < 4; ++mt)
#pragma unroll
                    for (int nt = 0; nt < 4; ++nt) acc[mt][nt] = __builtin_amdgcn_mfma_f32_16x16x32_bf16(wf[ks][nt], af[mt], acc[mt][nt], 0, 0, 0);
            }
#pragma unroll
            for (int mt = 0; mt < 4; ++mt) { const size_t m = (size_t)(m0 + 16 * mt + fr);
#pragma unroll
                for (int np = 0; np < 2; ++np) { const f32x4 v0 = acc[mt][2 * np], v1 = acc[mt][2 * np + 1];
                    u32x4 w; w.x = cvt_pk_bf16(v0[0], v0[1]); w.y = cvt_pk_bf16(v0[2], v0[3]); w.z = cvt_pk_bf16(v1[0], v1[1]); w.w = cvt_pk_bf16(v1[2], v1[3]);
                    if (STORE) { *(u32x4*)(g_out + m * CW + nb + 32 * np + 8 * fg) = w; } } }
        }
#undef PREP_PROW
#undef PREP_COL
        __syncthreads();
    }
}

__device__ __forceinline__ void attn_phase(const Frame& F, const Args& a, const int widx, const int nworkers) {
    unsigned char* ws = a.ws;
    const bf16* q = (const bf16*)(ws + WS_Q); const bf16* k = (const bf16*)(ws + WS_K); const bf16* vT = (const bf16*)(ws + WS_VT);
    bf16* att = (bf16*)(ws + WS_ATT);
    LAS float* bias = (LAS float*)F.lds;
    for (int i = F.tid; i < 8 * 15 * 31; i += 512) bias[i] = a.in[3][i];
    __syncthreads();
    const int lane = F.lane, fr = lane & 15, fg = lane >> 4;
    const int NGW = nworkers * 8, gw = widx * 8 + F.wave;
    const int per = (16384 + NGW - 1) / NGW;
    for (int task = gw * per; task < (gw + 1) * per && task < 16384; ++task) {
        const int cgp = task & 3, r = (task >> 2) & 127, h = (task >> 9) & 7, b = task >> 12;
        const int c0 = 16 * cgp, wsc = min(max(c0 - 8, 0), 32), rs = min(max(r - 4, 0), GROWS - 8);
        const int c = c0 + fr, cs = min(max(c - 8, 0), 48);
        const size_t tq = (size_t)b * T + r * 64 + c;
        bf16x8 qf[2];
#pragma unroll
        for (int ks = 0; ks < 2; ++ks) qf[ks] = *(const bf16x8*)(q + tq * CW + h * 64 + 32 * ks + 8 * fg);
        f32x4 sc[16];
        const int kcol_a = wsc + 8 * (fr >> 2) + (fr & 3);
        { bf16x8 kf[16][2];
#pragma unroll
          for (int t = 0; t < 16; ++t) { const int u = t >> 1, par = t & 1;
              const size_t tk = (size_t)b * T + (rs + u) * 64 + kcol_a + 4 * par;
              kf[t][0] = *(const bf16x8*)(k + tk * CW + h * 64 + 8 * fg); kf[t][1] = *(const bf16x8*)(k + tk * CW + h * 64 + 32 + 8 * fg); }
#pragma unroll
          for (int t = 0; t < 16; ++t) { f32x4 s = {0.f, 0.f, 0.f, 0.f};
              s = __builtin_amdgcn_mfma_f32_16x16x32_bf16(kf[t][0], qf[0], s, 0, 0, 0);
              s = __builtin_amdgcn_mfma_f32_16x16x32_bf16(kf[t][1], qf[1], s, 0, 0, 0);
              sc[t] = s; } }
        float mx = -1e30f;
#pragma unroll
        for (int u = 0; u < 8; ++u) {
            const int dr = rs + u - r + 7;
#pragma unroll
            for (int par = 0; par < 2; ++par)
#pragma unroll
                for (int i = 0; i < 4; ++i) {
                    const int kc = wsc + 8 * fg + 4 * par + i; const bool ok = (kc >= cs) && (kc < cs + 16);
                    const int dc = min(max(kc - c + 15, 0), 30);
                    const float s = ok ? sc[2 * u + par][i] + bias[(h * 15 + dr) * 31 + dc] : -1e30f;
                    sc[2 * u + par][i] = s; mx = fmaxf(mx, s);
                }
        }
        mx = fmaxf(mx, __shfl_xor(mx, 16)); mx = fmaxf(mx, __shfl_xor(mx, 32));
        float sum = 0.f;
#pragma unroll
        for (int t = 0; t < 16; ++t)
#pragma unroll
            for (int i = 0; i < 4; ++i) { const float pv = sc[t][i] > -1e29f ? __expf(sc[t][i] - mx) : 0.f; sc[t][i] = pv; sum += pv; }
        sum += __shfl_xor(sum, 16); sum += __shfl_xor(sum, 32);
        const float inv = 1.0f / sum;
        f32x4 o[4];
#pragma unroll
        for (int nt = 0; nt < 4; ++nt) o[nt] = (f32x4){0.f, 0.f, 0.f, 0.f};
        { bf16x8 vf[8][4];
#pragma unroll
          for (int u = 0; u < 8; ++u) { const bf16* vblk = vT + ((size_t)((b * NH + h) * GROWS + rs + u)) * (HD * 64) + wsc + 8 * fg;
#pragma unroll
              for (int nt = 0; nt < 4; ++nt) vf[u][nt] = *(const bf16x8*)(vblk + (16 * nt + fr) * 64); }
#pragma unroll
          for (int u = 0; u < 8; ++u) {
              union { u32x4 w; bf16x8 h8; } pf;
              pf.w.x = cvt_pk_bf16(sc[2 * u][0], sc[2 * u][1]); pf.w.y = cvt_pk_bf16(sc[2 * u][2], sc[2 * u][3]);
              pf.w.z = cvt_pk_bf16(sc[2 * u + 1][0], sc[2 * u + 1][1]); pf.w.w = cvt_pk_bf16(sc[2 * u + 1][2], sc[2 * u + 1][3]);
#pragma unroll
              for (int nt = 0; nt < 4; ++nt) o[nt] = __builtin_amdgcn_mfma_f32_16x16x32_bf16(vf[u][nt], pf.h8, o[nt], 0, 0, 0); } }
#pragma unroll
        for (int nt = 0; nt < 4; ++nt) { u32x2 w; w.x = cvt_pk_bf16(o[nt][0] * inv, o[nt][1] * inv); w.y = cvt_pk_bf16(o[nt][2] * inv, o[nt][3] * inv);
            *(u32x2*)(att + tq * CW + h * 64 + 16 * nt + 4 * fg) = w; }
    }
    __syncthreads();
}

__device__ __forceinline__ void side_phase(const Frame& F, const Args& a, const int widx, const int nworkers) {
    attn_phase(F, a, widx, nworkers);
    unsigned char* ws = a.ws;
    LAS float* scr = (LAS float*)(F.lds + F.wave * 8448);
    constexpr int I_UP = 32 * 16 * 64, I_DN = 32 * 16 * 32;
    for (int r = widx * 8 + F.wave; r < I_UP + I_DN; r += nworkers * 8) {
        if (r < I_UP) {
            const int e = r / 1024, q = r % 1024, kb = q / 64, nb = q % 64, n0 = nb * 32;
            const int orow0 = n0 < 1024 ? 256 * (n0 >> 7) + (n0 & 127) : 256 * ((n0 - 1024) >> 7) + 128 + ((n0 - 1024) & 127);
            transpose_item8(a.in[21] + (size_t)e * 1024 * 2048, 1024, 2048, ws + WS_WUPT + (size_t)e * 2048 * 1024, kb * 64, n0, orow0, scr, F.lane); }
        else { const int r2 = r - I_UP, e = r2 / 512, q = r2 % 512, kb = q / 32, nb = q % 32;
            transpose_item8(a.in[23] + (size_t)e * 1024 * 1024, 1024, 1024, ws + WS_WDNT + (size_t)e * 1024 * 1024, kb * 64, nb * 32, nb * 32, scr, F.lane); }
    }
}

__device__ __forceinline__ float row16_sum(float v) {
    v += __builtin_bit_cast(float, __builtin_amdgcn_update_dpp(0, __builtin_bit_cast(int, v), 0xB1, 0xF, 0xF, true));
    v += __builtin_bit_cast(float, __builtin_amdgcn_update_dpp(0, __builtin_bit_cast(int, v), 0x4E, 0xF, 0xF, true));
    v += __builtin_bit_cast(float, __builtin_amdgcn_update_dpp(0, __builtin_bit_cast(int, v), 0x141, 0xF, 0xF, true));
    v += __builtin_bit_cast(float, __builtin_amdgcn_update_dpp(0, __builtin_bit_cast(int, v), 0x140, 0xF, 0xF, true));
    return v;
}
constexpr int CS_R = 8;
constexpr int CS_NCH = 4, CS_NPR = 4;
constexpr int CS_AT = 0, CS_RT = 2304, CS_KHT = 4608, CS_BHT = 6656, CS_VT = 8704  , CS_TT = 10752, CS_AAK = 11264, CS_ARK = 11776, CS_ARB = 12288, CS_PL = 12800, CS_SLOT = 13056;
constexpr int CS_LD = 72;
constexpr int CS_SCR = CS_R * CS_SLOT  , CS_SCRW = 2304 * 2  , CS_FLAG = CS_SCR + CS_NPR * CS_SCRW  ;
__device__ __forceinline__ bf16 f2bf(float f) { return (bf16)cvt_pk_bf16(f, 0.f); }
struct ChainOps { u32x2 a4[4], r4[4], kh[4], bh[4], aak, ark, arb, tt, vb; f32x4 pl[4]; };
__device__ __forceinline__ void chain_load(const LAS unsigned char* sl, int fr, int fg, int c, ChainOps& o) {
    const int o16 = fr * 32 + fg * 8;
    const LAS unsigned char* pa = sl + CS_AT + fr * (CS_LD * 2) + fg * 8; const LAS unsigned char* pr = sl + CS_RT + fr * (CS_LD * 2) + fg * 8;
#pragma unroll
    for (int kq = 0; kq < 4; ++kq) { o.a4[kq] = *(const LAS u32x2*)(pa + 32 * kq); o.r4[kq] = *(const LAS u32x2*)(pr + 32 * kq); }
    o.aak = *(const LAS u32x2*)(sl + CS_AAK + o16); o.ark = *(const LAS u32x2*)(sl + CS_ARK + o16); o.arb = *(const LAS u32x2*)(sl + CS_ARB + o16); o.tt = *(const LAS u32x2*)(sl + CS_TT + o16);
    o.vb = *(const LAS u32x2*)(sl + CS_VT + c * 512 + o16);
#pragma unroll
    for (int mt = 0; mt < 4; ++mt) { o.pl[mt] = *(const LAS f32x4*)(sl + CS_PL + (16 * mt + 4 * fg) * 4);
        o.kh[mt] = *(const LAS u32x2*)(sl + CS_KHT + 512 * mt + o16); o.bh[mt] = *(const LAS u32x2*)(sl + CS_BHT + 512 * mt + o16); }
}
__device__ __forceinline__ f32x4 chain_compute(const ChainOps& o, f32x4 (&zacc)[4]) {
#define CS_M32(A_, B_, C_) __builtin_amdgcn_mfma_f32_16x16x32_bf16(A_, B_, C_, 0, 0, 0)
#define CS_M16(A_, B_, C_) __builtin_amdgcn_mfma_f32_16x16x16bf16_1k(__builtin_bit_cast(s16x4, A_), __builtin_bit_cast(s16x4, B_), C_, 0, 0, 0)
    union { u32x4 w; bf16x8 h8; } zb0, zb1, ap0, ap1, rp0, rp1;
    zb0.w.x = cvt_pk_bf16(zacc[0][0], zacc[0][1]); zb0.w.y = cvt_pk_bf16(zacc[0][2], zacc[0][3]); zb0.w.z = cvt_pk_bf16(zacc[1][0], zacc[1][1]); zb0.w.w = cvt_pk_bf16(zacc[1][2], zacc[1][3]);
    zb1.w.x = cvt_pk_bf16(zacc[2][0], zacc[2][1]); zb1.w.y = cvt_pk_bf16(zacc[2][2], zacc[2][3]); zb1.w.z = cvt_pk_bf16(zacc[3][0], zacc[3][1]); zb1.w.w = cvt_pk_bf16(zacc[3][2], zacc[3][3]);
    ap0.w = (u32x4){o.a4[0].x, o.a4[0].y, o.a4[1].x, o.a4[1].y}; ap1.w = (u32x4){o.a4[2].x, o.a4[2].y, o.a4[3].x, o.a4[3].y};
    rp0.w = (u32x4){o.r4[0].x, o.r4[0].y, o.r4[1].x, o.r4[1].y}; rp1.w = (u32x4){o.r4[2].x, o.r4[2].y, o.r4[3].x, o.r4[3].y};
    const f32x4 zero4 = {0.f, 0.f, 0.f, 0.f};
    f32x4 Wc = CS_M16(o.aak, o.vb, zero4);
    Wc = CS_M32(ap0.h8, zb0.h8, Wc); Wc = CS_M32(ap1.h8, zb1.h8, Wc);
    f32x4 Yc = CS_M16(o.ark, o.vb, zero4);
    Yc = CS_M32(rp0.h8, zb0.h8, Yc); Yc = CS_M32(rp1.h8, zb1.h8, Yc);
    f32x4 zz[4];
#pragma unroll
    for (int mt = 0; mt < 4; ++mt) zz[mt] = CS_M16(o.kh[mt], o.vb, zacc[mt] * o.pl[mt]);
    u32x2 wb, ub;
    wb.x = cvt_pk_bf16(Wc[0], Wc[1]); wb.y = cvt_pk_bf16(Wc[2], Wc[3]);
    const f32x4 Uc = CS_M16(o.tt, wb, zero4);
    ub.x = cvt_pk_bf16(Uc[0], Uc[1]); ub.y = cvt_pk_bf16(Uc[2], Uc[3]);
    Yc = CS_M16(o.arb, ub, Yc);
#pragma unroll
    for (int mt = 0; mt < 4; ++mt) zacc[mt] = CS_M16(o.bh[mt], ub, zz[mt]);
#undef CS_M32
#undef CS_M16
    return Yc;
}
template <int z>
__device__ __forceinline__ void scan_phase_z(const Frame& F, const Args& a, const int seq) {
    unsigned char* ws = a.ws;
    const int b = (seq >> 3) & 3, h = seq & 7;
    const size_t mb = (size_t)b * T;
    const int lane = F.lane, wave = F.wave, fr = lane & 15, fg = lane >> 4;
    constexpr int NCK = T / 16;
    volatile LAS unsigned* flg = (volatile LAS unsigned*)(F.lds + CS_FLAG);
    if (F.tid < 16) flg[F.tid] = 0u;
    __syncthreads();
    const int o16 = fr * 32 + fg * 8;
#define CS_M32(A_, B_, C_) __builtin_amdgcn_mfma_f32_16x16x32_bf16(A_, B_, C_, 0, 0, 0)
#define CS_M16(A_, B_, C_) __builtin_amdgcn_mfma_f32_16x16x16bf16_1k(__builtin_bit_cast(s16x4, A_), __builtin_bit_cast(s16x4, B_), C_, 0, 0, 0)
    if (wave < CS_NCH) {
        const int c = wave;
        __builtin_amdgcn_s_setprio(3);
        bf16* yout = (bf16*)(ws + WS_Y) + (size_t)z * M * CW + h * 64 + c * 16 + fr;
        f32x4 zacc[4];
#pragma unroll
        for (int mt = 0; mt < 4; ++mt) zacc[mt] = (f32x4){0.f, 0.f, 0.f, 0.f};
        ChainOps opA, opB;
#define CS_READY(nn) do { unsigned sp_ = 0; while (flg[(nn) & (CS_R - 1)] != (unsigned)((nn) + 1)) { __builtin_amdgcn_s_sleep(1); if (++sp_ > (1u << 24)) break; } __builtin_amdgcn_fence(__ATOMIC_ACQUIRE, "workgroup"); } while (0)
#define CS_HANDBACK(nn) do { asm volatile("s_waitcnt lgkmcnt(0)" ::: "memory"); if (lane == 0) flg[8 + c] = (unsigned)((nn) + 1); asm volatile("" ::: "memory"); } while (0)
#define CS_YSTORE(nn, Y_) do { asm volatile("s_waitcnt vmcnt(24)" ::: "memory");   _Pragma("unroll") for (int rr = 0; rr < 4; ++rr) { const int q_ = 16 * (nn) + 4 * fg + rr, t_ = z ? (T - 1 - q_) : q_; yout[(mb + t_) * CW] = f2bf((Y_)[rr]); } } while (0)
        CS_READY(0); chain_load(F.lds, fr, fg, c, opA);
#pragma unroll 1
        for (int n = 0; n < NCK; n += 2) {
            CS_READY(n + 1); CS_HANDBACK(n);
            chain_load(F.lds + ((n + 1) & (CS_R - 1)) * CS_SLOT, fr, fg, c, opB);
            { const f32x4 Yc = chain_compute(opA, zacc); CS_YSTORE(n, Yc); }
            if (n + 2 < NCK) CS_READY(n + 2);
            CS_HANDBACK(n + 1);
            if (n + 2 < NCK) chain_load(F.lds + ((n + 2) & (CS_R - 1)) * CS_SLOT, fr, fg, c, opA);
            { const f32x4 Yc = chain_compute(opB, zacc); CS_YSTORE(n + 1, Yc); }
        }
#undef CS_READY
#undef CS_HANDBACK
#undef CS_YSTORE
        __builtin_amdgcn_s_setprio(0);
    } else {
        const int pi = wave - CS_NCH;
        LAS unsigned char* scr = F.lds + CS_SCR + pi * CS_SCRW;
        LAS bf16* KT = (LAS bf16*)scr; LAS bf16* BT = (LAS bf16*)(scr + 2304);
        const bf16* gw_ = (const bf16*)(ws + WS_DECAY) + (size_t)z * M * CW + h * 64;
        const bf16* gkk = (const bf16*)(ws + WS_KK) + h * 64;
        const bf16* gak = (const bf16*)(ws + WS_AKK) + (size_t)z * M * CW + h * 64;
        const bf16* gk = (const bf16*)(ws + WS_KDIR) + (size_t)z * M * CW + h * 64;
        const bf16* gr = (const bf16*)(ws + WS_R) + h * 64;
        const bf16* gv = (const bf16*)(ws + WS_V) + h * 64;
        unsigned nw[16], nkk[16], nak[16], nk[16], nr[16], nv[16];
        constexpr long RSTEP = z ? -(long)CW : (long)CW;
#define CS_FETCH_A(nn) do { if ((nn) < NCK) { const size_t m0_ = (mb + (z ? (T - 1 - 16 * (nn)) : 16 * (nn))) * CW + lane; const bf16* pw_ = gw_ + m0_; const bf16* pkk_ = gkk + m0_; \
            _Pragma("unroll") for (int tt = 0; tt < 16; ++tt) { nw[tt] = pw_[tt * RSTEP]; nkk[tt] = pkk_[tt * RSTEP]; } } } while (0)
#define CS_FETCH_B(nn) do { if ((nn) < NCK) { asm volatile("s_waitcnt vmcnt(30)" ::: "memory"); const size_t m0_ = (mb + (z ? (T - 1 - 16 * (nn)) : 16 * (nn))) * CW + lane; const bf16* pak_ = gak + m0_; const bf16* pk_ = gk + m0_; \
            _Pragma("unroll") for (int tt = 0; tt < 16; ++tt) { nak[tt] = pak_[tt * RSTEP]; nk[tt] = pk_[tt * RSTEP]; } } } while (0)
#define CS_FETCH_C(nn) do { if ((nn) < NCK) { asm volatile("s_waitcnt vmcnt(30)" ::: "memory"); const size_t m0_ = (mb + (z ? (T - 1 - 16 * (nn)) : 16 * (nn))) * CW + lane; const bf16* pr_ = gr + m0_; const bf16* pv_ = gv + m0_; \
            _Pragma("unroll") for (int tt = 0; tt < 16; ++tt) { nr[tt] = pr_[tt * RSTEP]; nv[tt] = pv_[tt * RSTEP]; } } } while (0)
        CS_FETCH_A(pi); CS_FETCH_B(pi); CS_FETCH_C(pi);
#pragma unroll 1
        for (int n = pi; n < NCK; n += CS_NPR) {
            const int slot = n & (CS_R - 1);
            float wv[16], kkv[16], akv[16], kv[16], rv[16]; unsigned vq[16];
#pragma unroll
            for (int tt = 0; tt < 16; ++tt) { unsigned x0 = nw[tt], x1 = nkk[tt], x2 = nak[tt], x3 = nk[tt], x4 = nr[tt];
                asm volatile("" : "+v"(x0), "+v"(x1), "+v"(x2), "+v"(x3), "+v"(x4));
                wv[tt] = __uint_as_float(x0 << 16); kkv[tt] = __uint_as_float(x1 << 16); akv[tt] = __uint_as_float(x2 << 16); kv[tt] = __uint_as_float(x3 << 16); rv[tt] = __uint_as_float(x4 << 16); }
#pragma unroll
            for (int tt = 0; tt < 16; ++tt) { unsigned x0 = nv[tt]; asm volatile("" : "+v"(x0)); vq[tt] = x0; }
            CS_FETCH_A(n + CS_NPR);
            { unsigned sp = 0; for (;;) { const u32x4 pg = *(const volatile LAS u32x4*)(flg + 8); const int mn = (int)min(min(pg.x, pg.y), min(pg.z, pg.w));
                  if (mn >= n - (CS_R - 3)) break; __builtin_amdgcn_s_sleep(2); if (++sp > (1u << 24)) break; } }
            __builtin_amdgcn_fence(__ATOMIC_ACQUIRE, "workgroup");
            LAS unsigned char* sl = F.lds + slot * CS_SLOT;
            float P[16];
            P[0] = wv[0];
#pragma unroll
            for (int tt = 1; tt < 16; ++tt) P[tt] = P[tt - 1] * wv[tt];
            const float PL = P[15];
            float khat[16], bhat[16];
#pragma unroll
            for (int tt = 0; tt < 16; ++tt) {
                const float pm1 = tt ? P[tt - 1] : 1.0f, inv = __builtin_amdgcn_rcpf(P[tt]);
                const float at = kkv[tt] * pm1, rt = rv[tt] * P[tt], kt = kv[tt] * inv, bt = -akv[tt] * inv;
                khat[tt] = kt * PL; bhat[tt] = bt * PL;
                { const unsigned w_ = cvt_pk_bf16(at, rt); *(LAS bf16*)(sl + CS_AT + (tt * CS_LD + lane) * 2) = (bf16)w_; *(LAS bf16*)(sl + CS_RT + (tt * CS_LD + lane) * 2) = (bf16)(w_ >> 16); }
                { const unsigned w_ = cvt_pk_bf16(kt, bt); KT[tt * CS_LD + lane] = (bf16)w_; BT[tt * CS_LD + lane] = (bf16)(w_ >> 16); }
            }
            CS_FETCH_B(n + CS_NPR);
            { u32x4 o0, o1;
              o0.x = cvt_pk_bf16(khat[0], khat[1]); o0.y = cvt_pk_bf16(khat[2], khat[3]); o0.z = cvt_pk_bf16(khat[4], khat[5]); o0.w = cvt_pk_bf16(khat[6], khat[7]);
              o1.x = cvt_pk_bf16(khat[8], khat[9]); o1.y = cvt_pk_bf16(khat[10], khat[11]); o1.z = cvt_pk_bf16(khat[12], khat[13]); o1.w = cvt_pk_bf16(khat[14], khat[15]);
              *(LAS u32x4*)(sl + CS_KHT + lane * 32) = o0; *(LAS u32x4*)(sl + CS_KHT + lane * 32 + 16) = o1;
              o0.x = cvt_pk_bf16(bhat[0], bhat[1]); o0.y = cvt_pk_bf16(bhat[2], bhat[3]); o0.z = cvt_pk_bf16(bhat[4], bhat[5]); o0.w = cvt_pk_bf16(bhat[6], bhat[7]);
              o1.x = cvt_pk_bf16(bhat[8], bhat[9]); o1.y = cvt_pk_bf16(bhat[10], bhat[11]); o1.z = cvt_pk_bf16(bhat[12], bhat[13]); o1.w = cvt_pk_bf16(bhat[14], bhat[15]);
              *(LAS u32x4*)(sl + CS_BHT + lane * 32) = o0; *(LAS u32x4*)(sl + CS_BHT + lane * 32 + 16) = o1; }
            *(LAS float*)(sl + CS_PL + lane * 4) = PL;
            { u32x4 o0, o1;
              o0.x = vq[0] | (vq[1] << 16); o0.y = vq[2] | (vq[3] << 16); o0.z = vq[4] | (vq[5] << 16); o0.w = vq[6] | (vq[7] << 16);
              o1.x = vq[8] | (vq[9] << 16); o1.y = vq[10] | (vq[11] << 16); o1.z = vq[12] | (vq[13] << 16); o1.w = vq[14] | (vq[15] << 16);
              *(LAS u32x4*)(sl + CS_VT + lane * 32) = o0; *(LAS u32x4*)(sl + CS_VT + lane * 32 + 16) = o1; }
            asm volatile("s_waitcnt lgkmcnt(0)" ::: "memory");
            bf16x8 af[2], rf[2], kf[2], bf_[2];
#pragma unroll
            for (int ks = 0; ks < 2; ++ks) { af[ks] = *(const LAS bf16x8*)(sl + CS_AT + (fr * CS_LD + 32 * ks + 8 * fg) * 2); rf[ks] = *(const LAS bf16x8*)(sl + CS_RT + (fr * CS_LD + 32 * ks + 8 * fg) * 2);
                kf[ks] = *(const LAS bf16x8*)(KT + fr * CS_LD + 32 * ks + 8 * fg); bf_[ks] = *(const LAS bf16x8*)(BT + fr * CS_LD + 32 * ks + 8 * fg); }
            const f32x4 zero4 = {0.f, 0.f, 0.f, 0.f};
            f32x4 Xc = zero4, Xt = zero4, AakT = zero4, ArbT = zero4, ArkT = zero4;
#pragma unroll
            for (int ks = 0; ks < 2; ++ks) { Xc = CS_M32(af[ks], bf_[ks], Xc); Xt = CS_M32(bf_[ks], af[ks], Xt);
                AakT = CS_M32(kf[ks], af[ks], AakT); ArbT = CS_M32(bf_[ks], rf[ks], ArbT); ArkT = CS_M32(kf[ks], rf[ks], ArkT); }
            CS_FETCH_C(n + CS_NPR);
            f32x4 S1;
#pragma unroll
            for (int rr = 0; rr < 4; ++rr) { const int q = 4 * fg + rr;
                Xc[rr] = (fr < q) ? Xc[rr] : 0.f; Xt[rr] = (q < fr) ? Xt[rr] : 0.f; S1[rr] = Xt[rr] + ((q == fr) ? 1.0f : 0.f);
                AakT[rr] = (q < fr) ? AakT[rr] : 0.f; ArkT[rr] = (q <= fr) ? ArkT[rr] : 0.f; ArbT[rr] = (q <= fr) ? ArbT[rr] : 0.f; }
            { u32x2 w; w.x = cvt_pk_bf16(AakT[0], AakT[1]); w.y = cvt_pk_bf16(AakT[2], AakT[3]); *(LAS u32x2*)(sl + CS_AAK + o16) = w;
              w.x = cvt_pk_bf16(ArkT[0], ArkT[1]); w.y = cvt_pk_bf16(ArkT[2], ArkT[3]); *(LAS u32x2*)(sl + CS_ARK + o16) = w;
              w.x = cvt_pk_bf16(ArbT[0], ArbT[1]); w.y = cvt_pk_bf16(ArbT[2], ArbT[3]); *(LAS u32x2*)(sl + CS_ARB + o16) = w; }
#define CS_PK(v) ((u32x2){cvt_pk_bf16((v)[0], (v)[1]), cvt_pk_bf16((v)[2], (v)[3])})
            const u32x2 xc = CS_PK(Xc), xt = CS_PK(Xt), s1 = CS_PK(S1);
            const f32x4 X2c = CS_M16(xt, xc, zero4), X2t = CS_M16(xc, xt, zero4);
            const u32x2 x2c = CS_PK(X2c), x2t = CS_PK(X2t);
            const f32x4 S2 = CS_M16(x2c, s1, S1);
            const f32x4 X4c = CS_M16(x2t, x2c, zero4), X4t = CS_M16(x2c, x2t, zero4);
            const u32x2 x4c = CS_PK(X4c), x4t = CS_PK(X4t), s2 = CS_PK(S2);
            const f32x4 S4 = CS_M16(x4c, s2, S2);
            const f32x4 X8c = CS_M16(x4t, x4c, zero4);
            const u32x2 x8c = CS_PK(X8c), s4 = CS_PK(S4);
            const f32x4 S8 = CS_M16(x8c, s4, S4);
            *(LAS u32x2*)(sl + CS_TT + o16) = CS_PK(S8);
#undef CS_PK
            asm volatile("s_waitcnt lgkmcnt(0)" ::: "memory");
            __builtin_amdgcn_fence(__ATOMIC_RELEASE, "workgroup");
            if (lane == 0) flg[slot] = (unsigned)(n + 1);
        }
#undef CS_FETCH_A
#undef CS_FETCH_B
#undef CS_FETCH_C
    }
#undef CS_M32
#undef CS_M16
    __syncthreads();
}

__device__ __forceinline__ void scan_phase(const Frame& F, const Args& a, const int seq) {
    if (seq >> 5) scan_phase_z<1>(F, a, seq); else scan_phase_z<0>(F, a, seq);
}

__device__ __forceinline__ void combine_phase(const Frame& F, const Args& a) {
    unsigned char* ws = a.ws;
    const bf16* att = (const bf16*)(ws + WS_ATT); const bf16* rr = (const bf16*)(ws + WS_R); const bf16* vv = (const bf16*)(ws + WS_V);
    const bf16* kd = (const bf16*)(ws + WS_KDIR); const bf16* gg = (const bf16*)(ws + WS_G); const bf16* y = (const bf16*)(ws + WS_Y);
    bf16* mix = (bf16*)(ws + WS_MIX);
    const float* anw = a.in[4]; const float* r_k = a.in[14]; const float* ln_w = a.in[15]; const float* ln_b = a.in[16];
    const int lane = F.lane, c0 = 8 * lane;
    float nw[8], rk[8], lw[8], lb[8];
#pragma unroll
    for (int i = 0; i < 8; ++i) { nw[i] = anw[c0 + i]; rk[i] = r_k[c0 + i]; lw[i] = ln_w[c0 + i]; lb[i] = ln_b[c0 + i]; }
    const int gw = F.vcu * 8 + F.wave, NGW = F.G * 8;
#pragma unroll 2
    for (int m = gw; m < M; m += NGW) {
        const size_t o = (size_t)m * CW + c0;
        float f[8];
        unpack8(*(const u32x4*)(att + o), f);
        float ss = 0.f;
#pragma unroll
        for (int i = 0; i < 8; ++i) ss += f[i] * f[i];
        const float rs = rsqrtf(wave_sum(ss) * (1.f / CW) + RMS_EPS);
#pragma unroll
        for (int i = 0; i < 8; ++i) f[i] = f[i] * rs * nw[i];
        *(u32x4*)(mix + (size_t)m * D + c0) = pack8(f);
        float yv[8], yw[8];
        unpack8(*(const u32x4*)(y + o), yv); unpack8(*(const u32x4*)(y + (size_t)M * CW + o), yw);
#pragma unroll
        for (int i = 0; i < 8; ++i) yv[i] += yw[i];
        float s1 = 0.f;
#pragma unroll
        for (int i = 0; i < 8; ++i) s1 += yv[i];
        s1 += __shfl_xor(s1, 1); s1 += __shfl_xor(s1, 2); s1 += __shfl_xor(s1, 4);
        const float mean = s1 * (1.f / 64.f);
        float s2 = 0.f;
#pragma unroll
        for (int i = 0; i < 8; ++i) { yv[i] -= mean; s2 += yv[i] * yv[i]; }
        s2 += __shfl_xor(s2, 1); s2 += __shfl_xor(s2, 2); s2 += __shfl_xor(s2, 4);
        const float rstd = rsqrtf(s2 * (1.f / 64.f) + GN_EPS);
        float rf[8], k0[8], k1[8], vf[8], gf[8];
        unpack8(*(const u32x4*)(rr + o), rf); unpack8(*(const u32x4*)(kd + o), k0); unpack8(*(const u32x4*)(kd + (size_t)M * CW + o), k1);
        unpack8(*(const u32x4*)(vv + o), vf); unpack8(*(const u32x4*)(gg + o), gf);
        float cf = 0.f;
#pragma unroll
        for (int i = 0; i < 8; ++i) cf += rf[i] * (k0[i] + k1[i]) * rk[i];
        cf += __shfl_xor(cf, 1); cf += __shfl_xor(cf, 2); cf += __shfl_xor(cf, 4);
#pragma unroll
        for (int i = 0; i < 8; ++i) f[i] = (yv[i] * rstd * lw[i] + lb[i] + cf * vf[i]) * gf[i];
        *(u32x4*)(mix + (size_t)m * D + CW + c0) = pack8(f);
    }
}

constexpr int RT_PITCH = 1032, RT_WH = 0, RT_WL = 32 * RT_PITCH * 2, RT_HIST = 2 * RT_WL, RT_EL = RT_HIST + 256;
__device__ __forceinline__ void router_phase(const Frame& F, const Args& a) {
    unsigned char* ws = a.ws;
    const bf16* hbuf = (const bf16*)(ws + WS_H); unsigned char* hn2 = ws + WS_HN2;
    int* eidx = (int*)(ws + WS_EIDX); float* gate = (float*)(ws + WS_GATE); int* rank = (int*)(ws + WS_RANK);
    unsigned* ctl = (unsigned*)(ws + WS_CTL);
    const float* n2w = a.in[18]; const float* rw = a.in[19]; const float* rb = a.in[20];
    LAS bf16* wh = (LAS bf16*)(F.lds + RT_WH); LAS bf16* wl = (LAS bf16*)(F.lds + RT_WL); LAS int* hist = (LAS int*)(F.lds + RT_HIST); LAS int* eL = (LAS int*)(F.lds + RT_EL);
    { f32x4 tmp[16];
#pragma unroll
      for (int j = 0; j < 16; ++j) tmp[j] = *((const f32x4*)rw + F.tid + 512 * j);
#pragma unroll
      for (int j = 0; j < 16; ++j) { const int q = F.tid + 512 * j, d = q >> 3, e0 = 4 * (q & 7);
#pragma unroll
          for (int i = 0; i < 4; ++i) { const float w = tmp[j][i]; const unsigned hb = cvt_pk_bf16(w, 0.f) & 0xffffu; const float lo = w - __uint_as_float(hb << 16);
              wh[(e0 + i) * RT_PITCH + d] = (bf16)hb; wl[(e0 + i) * RT_PITCH + d] = (bf16)cvt_pk_bf16(lo, 0.f); } } }
    if (F.tid < 32) hist[F.tid] = 0;
    __syncthreads();
    const int lane = F.lane, tk = lane & 15, g = lane >> 4;
    const int blk = F.vcu;
    const int m = blk * 128 + F.wave * 16 + tk;
    const bf16* hrow = hbuf + (size_t)m * D + 8 * g;
    float ss = 0.f;
#pragma unroll 8
    for (int ks = 0; ks < 32; ++ks) { float xf[8]; unpack8(*(const u32x4*)(hrow + 32 * ks), xf);
        ss += (xf[0] * xf[0] + xf[1] * xf[1]) + (xf[2] * xf[2] + xf[3] * xf[3]) + (xf[4] * xf[4] + xf[5] * xf[5]) + (xf[6] * xf[6] + xf[7] * xf[7]); }
    ss += __shfl_xor(ss, 16); ss += __shfl_xor(ss, 32);
    const float rs = rsqrtf(ss * (1.f / D) + RMS_EPS);
    f32x4 acc0 = {0.f, 0.f, 0.f, 0.f}, acc1 = acc0;
    unsigned char* hrow8 = hn2 + (size_t)m * D + 8 * g;
    const LAS bf16* wh0 = wh + tk * RT_PITCH + 8 * g; const LAS bf16* wl0 = wl + tk * RT_PITCH + 8 * g;
#pragma unroll 4
    for (int ks = 0; ks < 32; ++ks) {
        float xf[8]; unpack8(*(const u32x4*)(hrow + 32 * ks), xf);
        const f32x4 x0 = {xf[0], xf[1], xf[2], xf[3]}, x1 = {xf[4], xf[5], xf[6], xf[7]};
        const f32x4 n0 = *(const f32x4*)(n2w + 32 * ks + 8 * g), n1 = *(const f32x4*)(n2w + 32 * ks + 8 * g + 4);
        const f32x4 y0 = x0 * rs * n0, y1 = x1 * rs * n1;
        { u32x2 w8; w8.x = pk4_fp8(y0.x * F8_SX, y0.y * F8_SX, y0.z * F8_SX, y0.w * F8_SX); w8.y = pk4_fp8(y1.x * F8_SX, y1.y * F8_SX, y1.z * F8_SX, y1.w * F8_SX); *(u32x2*)(hrow8 + 32 * ks) = w8; }
        union { u32x4 w; bf16x8 h8; } xh, xl;
        xh.w.x = cvt_pk_bf16(y0.x, y0.y); xh.w.y = cvt_pk_bf16(y0.z, y0.w); xh.w.z = cvt_pk_bf16(y1.x, y1.y); xh.w.w = cvt_pk_bf16(y1.z, y1.w);
        xl.w.x = cvt_pk_bf16(y0.x - bflo(xh.w.x), y0.y - bfhi(xh.w.x)); xl.w.y = cvt_pk_bf16(y0.z - bflo(xh.w.y), y0.w - bfhi(xh.w.y));
        xl.w.z = cvt_pk_bf16(y1.x - bflo(xh.w.z), y1.y - bfhi(xh.w.z)); xl.w.w = cvt_pk_bf16(y1.z - bflo(xh.w.w), y1.w - bfhi(xh.w.w));
        const bf16x8 a0h = *(const LAS bf16x8*)(wh0 + 32 * ks), a1h = *(const LAS bf16x8*)(wh0 + 16 * RT_PITCH + 32 * ks);
        const bf16x8 a0l = *(const LAS bf16x8*)(wl0 + 32 * ks), a1l = *(const LAS bf16x8*)(wl0 + 16 * RT_PITCH + 32 * ks);
        acc0 = __builtin_amdgcn_mfma_f32_16x16x32_bf16(a0h, xh.h8, acc0, 0, 0, 0); acc1 = __builtin_amdgcn_mfma_f32_16x16x32_bf16(a1h, xh.h8, acc1, 0, 0, 0);
        acc0 = __builtin_amdgcn_mfma_f32_16x16x32_bf16(a0h, xl.h8, acc0, 0, 0, 0); acc1 = __builtin_amdgcn_mfma_f32_16x16x32_bf16(a1h, xl.h8, acc1, 0, 0, 0);
        acc0 = __builtin_amdgcn_mfma_f32_16x16x32_bf16(a0l, xh.h8, acc0, 0, 0, 0); acc1 = __builtin_amdgcn_mfma_f32_16x16x32_bf16(a1l, xh.h8, acc1, 0, 0, 0);
    }
    float lv[8]; int li[8];
    { const f32x4 b0 = *(const f32x4*)(rb + 4 * g), b1 = *(const f32x4*)(rb + 16 + 4 * g);
#pragma unroll
      for (int i = 0; i < 4; ++i) { lv[i] = acc0[i] + b0[i]; li[i] = 4 * g + i; lv[4 + i] = acc1[i] + b1[i]; li[4 + i] = 16 + 4 * g + i; } }
    float tv[4]; int ti[4];
#pragma unroll
    for (int kx = 0; kx < 4; ++kx) {
        float bv = lv[0]; int bi = li[0];
#pragma unroll
        for (int i = 1; i < 8; ++i) { const bool gt = lv[i] > bv; bv = gt ? lv[i] : bv; bi = gt ? li[i] : bi; }
#pragma unroll
        for (int o = 16; o < 64; o <<= 1) { const float ov = __shfl_xor(bv, o); const int oi = __shfl_xor(bi, o); const bool tko = (ov > bv) || (ov == bv && oi < bi); bv = tko ? ov : bv; bi = tko ? oi : bi; }
        tv[kx] = bv; ti[kx] = bi;
#pragma unroll
        for (int i = 0; i < 8; ++i) lv[i] = (li[i] == bi) ? -3.0e38f : lv[i];
    }
    if (g == 0) {
        const float e0 = 1.0f, e1 = __expf(tv[1] - tv[0]), e2 = __expf(tv[2] - tv[0]), e3 = __expf(tv[3] - tv[0]);
        const float is = 1.0f / (e0 + e1 + e2 + e3);
        const float gs[4] = {e0 * is, e1 * is, e2 * is, e3 * is};
#pragma unroll
        for (int kx = 0; kx < 4; ++kx) { eidx[m * 4 + kx] = ti[kx]; gate[m * 4 + kx] = gs[kx]; eL[(m - blk * 128) * 4 + kx] = ti[kx]; }
    }
    __syncthreads();
    { const int t = F.tid, e = eL[t]; int rk = 0;
      for (int u = 0; u < t; ++u) rk += (eL[u] == e) ? 1 : 0;
      rank[(blk * 128) * 4 + t] = rk;
      __hip_atomic_fetch_add(&hist[e], 1, __ATOMIC_RELAXED, __HIP_MEMORY_SCOPE_WORKGROUP); }
    __syncthreads();
    if (F.tid < 32) ctl[CW_CNT + blk * 32 + F.tid] = (unsigned)hist[F.tid];
}

__device__ __forceinline__ void dispatch_phase(const Frame& F, const Args& a) {
    unsigned char* ws = a.ws;
    unsigned* ctl = (unsigned*)(ws + WS_CTL);
    const int* eidx = (const int*)(ws + WS_EIDX); const int* rank = (const int*)(ws + WS_RANK); int* dest = (int*)(ws + WS_DEST);
    LAS int* part = (LAS int*)F.lds;
    LAS int* tot = part + 1024;
    const int blk = F.vcu, G = F.G;
    { const int e = F.tid & 31, pt = F.tid >> 5; int s = 0, sb = 0;
      if (G == 256) { int cv[16];
#pragma unroll
          for (int q = 0; q < 16; ++q) cv[q] = (int)ld_u32_agent(ctl + CW_CNT + (pt + 16 * q) * 32 + e);
#pragma unroll
          for (int q = 0; q < 16; ++q) { s += cv[q]; if (pt + 16 * q < blk) sb += cv[q]; } }
      else for (int bb = pt; bb < G; bb += 16) { const int cval = (int)ld_u32_agent(ctl + CW_CNT + bb * 32 + e); s += cval; if (bb < blk) sb += cval; }
      part[pt * 32 + e] = s; part[512 + pt * 32 + e] = sb; }
    __syncthreads();
    if (F.tid < 32) { int s = 0, sb = 0;
        for (int pt = 0; pt < 16; ++pt) { s += part[pt * 32 + F.tid]; sb += part[512 + pt * 32 + F.tid]; }
        tot[F.tid] = s; tot[32 + F.tid] = sb; tot[96 + F.tid] = (s + 255) & ~255; }
    __syncthreads();
    if (F.tid == 0) { int ps = 0; for (int e = 0; e < 32; ++e) { tot[64 + e] = ps; ps += tot[96 + e]; }
        tot[128] = ps >> 8; }
    __syncthreads();
    if (blk == 0) {
        if (F.tid == 0) ctl[CW_NT] = (unsigned)tot[128];
        for (int e = F.tid >> 4; e < 32; e += 32) { const int t0 = tot[64 + e] >> 8, nt = tot[96 + e] >> 8; for (int i = F.tid & 15; i < nt; i += 16) ctl[CW_TEXP + t0 + i] = (unsigned)e; }
    }
    const int lane = F.lane;
    const int mw = blk * 128 + F.wave * 16;
    int* rowtok = (int*)(ws + WS_ROWTOK);
    { const int e = eidx[mw * 4 + lane]; const int dl = tot[64 + e] + tot[32 + e] + rank[mw * 4 + lane]; dest[mw * 4 + lane] = dl; rowtok[dl] = mw + (lane >> 2); }
    { const int e = blk & 31, pt = blk >> 5, np = G >> 5; const int r0 = tot[64 + e] + tot[e], r1 = tot[64 + e] + tot[96 + e];
      if (np > 0) for (int r = r0 + pt * 512 + F.tid; r < r1; r += np * 512) rowtok[r] = 0; }
}

__device__ __forceinline__ void final_phase(const Frame& F, const Args& a) {
    unsigned char* ws = a.ws;
    const bf16* hbuf = (const bf16*)(ws + WS_H); const unsigned char* ybuf = ws + WS_YBUF;
    const int* dest = (const int*)(ws + WS_DEST); const float* gate = (const float*)(ws + WS_GATE);
    const float* fw = a.in[25]; float* out = a.out;
    const int lane = F.lane;
    f32x4 wn[4];
#pragma unroll
    for (int j = 0; j < 4; ++j) wn[j] = *((const f32x4*)fw + lane + 64 * j);
    const int gw = F.vcu * 8 + F.wave, NGW = F.G * 8;
    const int per = M / NGW;
    const int mw = gw * per;
    int dl = 0; float gl = 0.f;
    if (lane < 4 * per && per <= 16) { dl = dest[mw * 4 + lane]; gl = gate[mw * 4 + lane]; }
#pragma unroll 2
    for (int i = 0; i < per; ++i) {
        const int m = mw + i;
        const u32x2* hr = (const u32x2*)(hbuf + (size_t)m * D) + lane;
        f32x4 v[4];
#pragma unroll
        for (int j = 0; j < 4; ++j) { const u32x2 w = hr[64 * j]; v[j] = (f32x4){bflo(w.x), bfhi(w.x), bflo(w.y), bfhi(w.y)}; }
#pragma unroll
        for (int kx = 0; kx < 4; ++kx) {
            const int d = per <= 16 ? __shfl(dl, 4 * i + kx) : dest[m * 4 + kx]; const float gt = (per <= 16 ? __shfl(gl, 4 * i + kx) : gate[m * 4 + kx]) * (1.0f / F8_SY);
            const unsigned* yr = (const unsigned*)(ybuf + (size_t)d * D) + lane;
#pragma unroll
            for (int j = 0; j < 4; ++j) { const unsigned w = yr[64 * j]; const f32x2 lo = __builtin_amdgcn_cvt_pk_f32_fp8((int)w, false), hi = __builtin_amdgcn_cvt_pk_f32_fp8((int)w, true);
                v[j].x += gt * lo.x; v[j].y += gt * lo.y; v[j].z += gt * hi.x; v[j].w += gt * hi.y; }
        }
        float s = 0.f;
#pragma unroll
        for (int j = 0; j < 4; ++j) s += (v[j].x * v[j].x + v[j].y * v[j].y) + (v[j].z * v[j].z + v[j].w * v[j].w);
        const float rs = rsqrtf(wave_sum(s) * (1.f / D) + RMS_EPS);
        f32x4* orow = (f32x4*)(out + (size_t)m * D) + lane;
#pragma unroll
        for (int j = 0; j < 4; ++j) orow[64 * j] = v[j] * rs * wn[j];
    }
}

__global__ void __launch_bounds__(512, 2) fwd_megakernel(Args args) {
    extern __shared__ __attribute__((aligned(16))) unsigned char lds_raw[];
    Frame F;
    F.lds = (LAS unsigned char*)lds_raw;
    F.tid = threadIdx.x; F.lane = F.tid & 63; F.wave = __builtin_amdgcn_readfirstlane(F.tid >> 6);
    F.G = gridDim.x; { const int bx = blockIdx.x; F.vcu = (F.G % 8 == 0) ? (bx % 8) * (F.G / 8) + bx / 8 : bx; }
    unsigned char* ws = args.ws;
    const int lo = args.ph_lo, hi = args.ph_hi;
#define IN(k) (lo <= (k) && (k) < hi)
#if MK_SPLIT
#define SEAM(k) do { } while (0)
#else
    cg::grid_group grid = cg::this_grid();
    { volatile LAS unsigned* st = (volatile LAS unsigned*)(F.lds + LDS_MISC); if (F.tid < 2) st[F.tid] = 0u; __syncthreads(); }
    const XcdBarrier xbar = xcd_barrier_post((unsigned*)(ws + WS_CTL) + CW_BAR, (volatile LAS unsigned*)(F.lds + LDS_MISC));
    if (lo < 0) grid.sync();
#define SEAM(k) do { if (IN(k) && IN((k) + 1)) xcd_barrier(xbar); } while (0)
#endif
#define REP2(k) if constexpr (((MK_REPEAT >> (k)) & 1) != 0)
#define PH1 { pg8::Gemm g{(const bf16*)(ws + WS_HN), (const bf16*)(ws + WS_WINT), 1024, nullptr, 0, nullptr}; \
        pg8::StaticOrder S; S.init(M / 256, NPROJ_PAD / 256, F.G, (int)blockIdx.x); \
        pg8::EpiProj E{(bf16*)(ws + WS_Q), (bf16*)(ws + WS_K), (bf16*)(ws + WS_VT), (bf16*)(ws + WS_P)}; \
        pg8::gemm_phase<pg8::EpiProj, true, true>(F.lds, g, S, E); }
#define PH5 { pg8::Gemm g{(const bf16*)(ws + WS_MIX), (const bf16*)(ws + WS_WOT), 1024, nullptr, 0, nullptr}; \
        pg8::StaticOrder S; S.init(M / 256, D / 256, F.G, (int)blockIdx.x); \
        pg8::EpiWo E{args.in[0], (bf16*)(ws + WS_H)}; \
        pg8::gemm_phase<pg8::EpiWo, true, true>(F.lds, g, S, E); }
#define PH8 { const unsigned* ctl = (const unsigned*)(ws + WS_CTL); const int ntile = (int)ld_u32_agent(ctl + CW_NT); \
        pg8::Gemm g{(const bf16*)(ws + WS_HN2), (const bf16*)(ws + WS_WUPT), 512, ctl + CW_TEXP, (size_t)2048 * 1024, (const int*)(ws + WS_ROWTOK)}; \
        pg8::StaticOrder S; S.init(ntile, 8, F.G, (int)blockIdx.x); \
        pg8::EpiUp E{args.in[22], ws + WS_ACT}; \
        pg8::gemm_phase<pg8::EpiUp, true, true, true, true>(F.lds, g, S, E); }
#define PH9 { const unsigned* ctl = (const unsigned*)(ws + WS_CTL); const int ntile = (int)ld_u32_agent(ctl + CW_NT); \
        pg8::Gemm g{(const bf16*)(ws + WS_ACT), (const bf16*)(ws + WS_WDNT), 512, ctl + CW_TEXP, (size_t)1024 * 1024, nullptr}; \
        pg8::StaticOrder S; S.init(ntile, 4, F.G, (int)blockIdx.x); \
        pg8::EpiDown E{args.in[24], ws + WS_YBUF}; \
        pg8::gemm_phase<pg8::EpiDown, true, true, false, true>(F.lds, g, S, E); }
    if (IN(0)) { p0_prologue(F, args); REP2(0) p0_prologue(F, args); }
    SEAM(0);
    if (IN(1)) { PH1 REP2(1) PH1 }
    SEAM(1);
    if (IN(2)) { prep_phase<true>(F, args); REP2(2) prep_phase<true>(F, args); }
    SEAM(2);
    if (IN(3)) {
        if ((F.vcu & 3) == 0 && (F.vcu >> 2) < 64) { scan_phase(F, args, F.vcu >> 2); REP2(3) scan_phase(F, args, F.vcu >> 2); }
        else { const int nside = F.G - min(F.G / 4 + ((F.G & 3) ? 1 : 0), 64); const int q_ = min((F.vcu + 3) >> 2, 64); side_phase(F, args, F.vcu - q_, nside); REP2(11) side_phase(F, args, F.vcu - q_, nside); }
    }
    SEAM(3);
    if (IN(4)) { combine_phase(F, args); REP2(4) combine_phase(F, args); }
    SEAM(4);
    if (IN(5)) { PH5 REP2(5) PH5 }
    SEAM(5);
    if (IN(6)) { router_phase(F, args); REP2(6) { __syncthreads(); router_phase(F, args); } }
    SEAM(6);
    if (IN(7)) { dispatch_phase(F, args); REP2(7) { __syncthreads(); dispatch_phase(F, args); } }
    SEAM(7);
    if (IN(8)) { PH8 REP2(8) PH8 }
    SEAM(8);
    if (IN(9)) { PH9 REP2(9) PH9 }
    SEAM(9);
    if (IN(10)) { final_phase(F, args); REP2(10) final_phase(F, args); }
#undef IN
#undef SEAM
}

extern "C" void kernel_launch(void* const* d_in, const int* in_sizes, int n_in, void* d_out, int out_size, void* d_ws, size_t ws_size, hipStream_t stream) {
    static int grid = 0;
    if (grid == 0) {
        if (n_in != 26 || in_sizes[0] != M * D || out_size != M * D || ws_size < WS_END) { fprintf(stderr, "kernel_launch: unexpected problem (n_in %d, in0 %d, out %d, ws %zu)\n", n_in, n_in > 0 ? in_sizes[0] : -1, out_size, ws_size); grid = -1; return; }
        int dev = 0, cus = 0, per_cu = 0;
        if (hipGetDevice(&dev) != hipSuccess || hipDeviceGetAttribute(&cus, hipDeviceAttributeMultiprocessorCount, dev) != hipSuccess) { grid = -1; return; }
        if (hipFuncSetAttribute((const void*)fwd_megakernel, hipFuncAttributeMaxDynamicSharedMemorySize, LDS_BYTES) != hipSuccess) { fprintf(stderr, "kernel_launch: hipFuncSetAttribute failed\n"); grid = -1; return; }
        if (hipOccupancyMaxActiveBlocksPerMultiprocessor(&per_cu, (const void*)fwd_megakernel, 512, LDS_BYTES) != hipSuccess || per_cu < 1) { fprintf(stderr, "kernel_launch: occupancy query says %d\n", per_cu); per_cu = 1; }
        (void)hipGetLastError();
        grid = cus * 1;
        if (grid != 256) fprintf(stderr, "kernel_launch: note: %d CUs\n", cus);
    }
    if (grid < 0) return;
    if (hipMemsetAsync((char*)d_ws + WS_CTL + (size_t)CW_BAR * 4, 0, XCD_BAR_WORDS * 4, stream) != hipSuccess) { fprintf(stderr, "kernel_launch: memset failed\n"); return; }
    Args a{};
    for (int i = 0; i < 26; ++i) a.in[i] = (const float*)d_in[i];
    a.out = (float*)d_out; a.ws = (unsigned char*)d_ws;
#if MK_SPLIT
    for (int ph = 0; ph < NPHASE; ++ph) { a.ph_lo = ph; a.ph_hi = ph + 1; hipLaunchKernelGGL(fwd_megakernel, dim3(grid), dim3(512), LDS_BYTES, stream, a); }
#else
    a.ph_lo = 0; a.ph_hi = NPHASE;
    void* kargs[] = {&a};
    hipError_t e = hipLaunchCooperativeKernel((const void*)fwd_megakernel, dim3(grid), dim3(512), kargs, LDS_BYTES, stream);
    if (e != hipSuccess) fprintf(stderr, "kernel_launch: cooperative launch failed: %s (grid %d)\n", hipGetErrorString(e), grid);
#endif
}
```

```cpp
#include <hip/hip_runtime.h>
#include <hip/hip_cooperative_groups.h>
#include <cstdio>
#include <cstdint>
namespace cg = cooperative_groups;

#ifndef MK_SPLIT
#define MK_SPLIT 0
#endif

#ifndef MK_REPEAT
#define MK_REPEAT 0
#endif
#define LAS __attribute__((address_space(3)))
typedef unsigned short bf16;
typedef float f32x4 __attribute__((ext_vector_type(4)));
typedef float f32x2 __attribute__((ext_vector_type(2)));
typedef unsigned u32x4 __attribute__((ext_vector_type(4)));
typedef unsigned u32x2 __attribute__((ext_vector_type(2)));
typedef short bf16x8 __attribute__((ext_vector_type(8)));
typedef short s16x4 __attribute__((ext_vector_type(4)));

constexpr int BATCH = 4, T = 8192, D = 1024, M = BATCH * T;
constexpr int NH = 8, HD = 64, CW = 512;
constexpr int SHIFT_W = 1920, NPROJ = 3456, NPROJ_PAD = 3584, PW = 2048;
constexpr int NE = 32, TOPK = 4, DE = 1024;
constexpr int GRIDW = 64, GROWS = 128;
constexpr int P_TILES_MAX = 544, P_ROWS = P_TILES_MAX * 256;
constexpr float RMS_EPS = 1e-5f, GN_EPS = 64e-5f;
constexpr int NPHASE = 11;

constexpr size_t MiB = 1u << 20;
constexpr size_t WS_CTL = 0;
constexpr size_t WS_W2T = 1 * MiB, WS_A2T = WS_W2T + 131072, WS_G2T = WS_A2T + 131072;
constexpr size_t WS_WINT = 2 * MiB, WS_WOT = 9 * MiB, WS_WUPT = 12 * MiB, WS_WDNT = 140 * MiB;
constexpr size_t WS_EIDX = 204 * MiB, WS_GATE = WS_EIDX + 524288, WS_RANK = WS_GATE + 524288, WS_DEST = WS_RANK + 524288, WS_ROWTOK = WS_DEST + 524288;
constexpr size_t WS_R = 208 * MiB, WS_V = 240 * MiB, WS_KK = 272 * MiB, WS_DECAY = 304 * MiB, WS_KDIR = 368 * MiB, WS_AKK = 432 * MiB,
                 WS_G = 496 * MiB, WS_ATT = 528 * MiB;
constexpr size_t WS_Q = 560 * MiB, WS_K = 592 * MiB, WS_VT = 624 * MiB, WS_P = 656 * MiB, WS_HN = 784 * MiB, WS_Y = 848 * MiB;
constexpr size_t WS_MIX = 560 * MiB, WS_H = 752 * MiB, WS_HN2 = 880 * MiB, WS_XBUF = 208 * MiB, WS_ACT = 480 * MiB, WS_YBUF = 208 * MiB;
constexpr size_t WS_END = 976 * MiB;
constexpr int CW_NT = 0, CW_TEXP = 64, CW_CNT = 1024, CW_BAR = 16384;

constexpr int LDS_BYTES = 159744, LDS_MISC = LDS_BYTES - 256;

typedef __bf16 bf16x2_t __attribute__((ext_vector_type(2)));
__device__ __forceinline__ unsigned cvt_pk_bf16(float lo, float hi) { const f32x2 v = {lo, hi}; return __builtin_bit_cast(unsigned, __builtin_convertvector(v, bf16x2_t)); }
typedef int i32x8 __attribute__((ext_vector_type(8)));
typedef int i32x4 __attribute__((ext_vector_type(4)));
#ifndef F8_SCALE1
#define F8_SCALE1 0
#endif
constexpr float F8_SX = 32.0f, F8_SW = 128.0f, F8_SACT = 8.0f, F8_SY = 32.0f;
__device__ __forceinline__ float f8clamp(float v) { return __builtin_amdgcn_fmed3f(v, -448.0f, 448.0f); }
__device__ __forceinline__ unsigned pk4_fp8(float a, float b, float c, float d) { int w = 0; w = __builtin_amdgcn_cvt_pk_fp8_f32(f8clamp(a), f8clamp(b), w, false); w = __builtin_amdgcn_cvt_pk_fp8_f32(f8clamp(c), f8clamp(d), w, true); return (unsigned)w; }
__device__ __forceinline__ float bflo(unsigned u) { return __uint_as_float(u << 16); }
__device__ __forceinline__ float bfhi(unsigned u) { return __uint_as_float(u & 0xffff0000u); }
__device__ __forceinline__ float bf1(bf16 v) { return __uint_as_float(((unsigned)v) << 16); }
__device__ __forceinline__ void unpack8(const u32x4 u, float* f) { f[0] = bflo(u.x); f[1] = bfhi(u.x); f[2] = bflo(u.y); f[3] = bfhi(u.y); f[4] = bflo(u.z); f[5] = bfhi(u.z); f[6] = bflo(u.w); f[7] = bfhi(u.w); }
__device__ __forceinline__ u32x4 pack8(const float* f) { u32x4 o; o.x = cvt_pk_bf16(f[0], f[1]); o.y = cvt_pk_bf16(f[2], f[3]); o.z = cvt_pk_bf16(f[4], f[5]); o.w = cvt_pk_bf16(f[6], f[7]); return o; }
__device__ __forceinline__ float wave_sum(float v) {
#pragma unroll
    for (int o = 1; o < 64; o <<= 1) v += __shfl_xor(v, o);
    return v;
}
__device__ __forceinline__ float sigmoidf_(float x) { return __builtin_amdgcn_rcpf(1.0f + __expf(-x)); }
__device__ __forceinline__ unsigned ld_u32_agent(const unsigned* p) { return __hip_atomic_load(p, __ATOMIC_RELAXED, __HIP_MEMORY_SCOPE_AGENT); }

namespace pg8 {
constexpr int BM = 256, BK = 64, HALF = 128, HTB = HALF * BK * 2, STAGE_BYTES = 8 * HTB, NXCD = 8, WGM = 8;
__host__ __device__ __forceinline__ int lds_byte(int r, int c) { const int st = (r >> 4) * 2 + (c >> 5), rr = r & 15, cc = c & 31, ob = rr * 64 + cc * 2; return st * 1024 + (ob ^ (((ob >> 9) & 1) << 5)); }
__host__ __device__ __forceinline__ void stage_rc(int b, int& R, int& C) { const int st = b / 1024, sb = b % 1024, swz = sb ^ (((sb >> 9) & 1) << 5); R = (st >> 1) * 16 + swz / 64; C = (st & 1) * 32 + (swz % 64) / 2; }
__host__ __device__ __forceinline__ int perm32(int rho) { const int n = rho >> 4, i = rho & 15; return 8 * (i >> 2) + 4 * n + (i & 3); }

struct Unit { int pm, pn, e; };
struct Gemm { const bf16* A; const bf16* Bt; int K; const unsigned* texp; size_t bstride; const int* rowtok; };

struct StaticOrder {
    int nM, nN, nwg, G, c;
    __device__ void init(int nM_, int nN_, int G_, int c_) { nM = nM_; nN = nN_; nwg = nM * nN; G = G_; c = c_; }
    __device__ bool next(int i, Unit& u) const {
        const long L = (long)i * G + c; if (L >= nwg) return false;
        int wgid = (int)L; { const int q = nwg / NXCD, r = nwg % NXCD, xcd = wgid % NXCD, off = wgid / NXCD; wgid = (xcd < r ? xcd * (q + 1) : r * (q + 1) + (xcd - r) * q) + off; }
        const int nig = WGM * nN, gid = wgid / nig, fm = gid * WGM, gsz = (nM - fm) < WGM ? (nM - fm) : WGM;
        u.pm = fm + ((wgid % nig) % gsz); u.pn = (wgid % nig) / gsz; u.e = 0; return true;
    }
};

__device__ __forceinline__ i32x8 cat8(const bf16x8 lo, const bf16x8 hi) { return __builtin_shufflevector(__builtin_bit_cast(i32x4, lo), __builtin_bit_cast(i32x4, hi), 0, 1, 2, 3, 4, 5, 6, 7); }
template <class Epi, bool ALIGN_EPI, bool SP2, bool GATHER = false, bool FP8 = false>
__device__ __forceinline__ void gemm_phase(LAS unsigned char* lds, const Gemm g, const StaticOrder& S, const Epi& E) {
    const int tid = threadIdx.x, wid = __builtin_amdgcn_readfirstlane(tid >> 6), lane = tid & 63, wr = wid >> 2, wc = wid & 3, fr = lane & 15, fq = lane >> 4;
    const int K = g.K, nt = K / BK;
    unsigned voffA[2], voffB[2];
#pragma unroll
    for (int i = 0; i < 2; ++i) { int R, C; stage_rc(tid * 16 + i * 8192, R, C); const int Rb = Epi::PERM ? ((R & ~31) + perm32(R & 31)) : R;
        voffA[i] = (unsigned)(R * K + C) * 2u; voffB[i] = (unsigned)(Rb * K + C) * 2u; }
    unsigned vC[2][2];
#define PG8_GROWS(u, dst) do { _Pragma("unroll") for (int h_ = 0; h_ < 2; ++h_) _Pragma("unroll") for (int i_ = 0; i_ < 2; ++i_) { int R_, C_; stage_rc(tid * 16 + i_ * 8192, R_, C_); \
        dst[h_][i_] = (unsigned)g.rowtok[(u).pm * BM + h_ * HALF + R_] * (unsigned)(K * 2) + (unsigned)(C_ * 2); } } while (0)
    const size_t kstep = (size_t)(BK * 2);
    const size_t hstep = (size_t)HALF * K * 2;
    const size_t tstep = 2 * hstep;
    const unsigned ldsw = (unsigned)wid * 1024u;
    const int aoff = lds_byte(wr * 64 + fr, fq * 8), boff = lds_byte(wc * 32 + fr, fq * 8);
#define PG8_SA(b, h) (((b) * 2 + (h)) * HTB)
#define PG8_SB(b, h) ((4 + (b) * 2 + (h)) * HTB)
#define PG8_STAGE(bufoff, gbase, voff) do { _Pragma("unroll") for (int _i = 0; _i < 2; ++_i) \
        __builtin_amdgcn_global_load_lds((const unsigned*)((const char*)(gbase) + (voff)[_i]), (LAS unsigned*)(lds + (bufoff) + ldsw + _i * 8192), 16, 0, 0); } while (0)
#define PG8_STAGE_A(bufoff, p, h, nx) do { if constexpr (GATHER) { PG8_STAGE(bufoff, p, vC[h]); } else PG8_STAGE(bufoff, (p) + (h) * hstep, voffA); } while (0)
#define PG8_LDA(dst, b, h) do { _Pragma("unroll") for (int m = 0; m < 4; ++m) _Pragma("unroll") for (int k = 0; k < 2; ++k) dst[m][k] = *(const LAS bf16x8*)(lds + PG8_SA(b, h) + aoff + m * 2048 + k * 1024); } while (0)
#define PG8_LDB(dst, b, h) do { _Pragma("unroll") for (int n = 0; n < 2; ++n) _Pragma("unroll") for (int k = 0; k < 2; ++k) dst[n][k] = *(const LAS bf16x8*)(lds + PG8_SB(b, h) + boff + n * 2048 + k * 1024); } while (0)
#define PG8_MMA(ai, bj, At, Bt) do { __builtin_amdgcn_s_setprio(1); \
        if constexpr (FP8) { _Pragma("unroll") for (int m = 0; m < 4; ++m) _Pragma("unroll") for (int n = 0; n < 2; ++n) \
            { const i32x8 b8_ = cat8(Bt[n][0], Bt[n][1]), a8_ = cat8(At[m][0], At[m][1]); asm volatile("v_mfma_f32_16x16x128_f8f6f4 %0, %1, %2, %0" : "+v"(acc[ai][bj][m][n]) : "v"(b8_), "v"(a8_)); } } \
        else { _Pragma("unroll") for (int m = 0; m < 4; ++m) _Pragma("unroll") for (int n = 0; n < 2; ++n) _Pragma("unroll") for (int k = 0; k < 2; ++k) \
            acc[ai][bj][m][n] = __builtin_amdgcn_mfma_f32_16x16x32_bf16(Bt[n][k], At[m][k], acc[ai][bj][m][n], 0, 0, 0); } \
        __builtin_amdgcn_s_setprio(0); } while (0)
#define PG8_WAIT_V(n) asm volatile("s_waitcnt vmcnt(" #n ")" ::: "memory")
#define PG8_WAIT_L(n) asm volatile("s_waitcnt lgkmcnt(" #n ")" ::: "memory")
#define PG8_BAR __builtin_amdgcn_s_barrier()
#define PG8_SCHED __builtin_amdgcn_sched_barrier(0)
#define PG8_UPTR(u, pa, pb) do { unsigned _e = g.texp ? ld_u32_agent(g.texp + (u).pm) : 0u; _e = (unsigned)__builtin_amdgcn_readfirstlane((int)_e); (u).e = (int)_e; \
        pa = GATHER ? (const char*)g.A : (const char*)g.A + (size_t)(u).pm * tstep; pb = (const char*)g.Bt + (size_t)_e * g.bstride + (size_t)(u).pn * tstep; } while (0)
    Unit cur, nxt; int ui = 0;
    if (!S.next(0, cur)) return;
    f32x4 acc[2][2][4][2];
#pragma unroll
    for (int a = 0; a < 2; ++a)
#pragma unroll
        for (int b = 0; b < 2; ++b)
#pragma unroll
            for (int m = 0; m < 4; ++m)
#pragma unroll
                for (int n = 0; n < 2; ++n) acc[a][b][m][n] = (f32x4){0.f, 0.f, 0.f, 0.f};
    bf16x8 At[4][2], B0[2][2], B1[2][2];
    const char* cA; const char* cB;
    PG8_UPTR(cur, cA, cB);
    if constexpr (GATHER) { PG8_GROWS(cur, vC); }
    if constexpr (SP2) {
        PG8_STAGE(PG8_SB(0, 0), cB, voffB); PG8_STAGE(PG8_SB(0, 1), cB + hstep, voffB); PG8_STAGE_A(PG8_SA(0, 0), cA, 0, false); PG8_STAGE_A(PG8_SA(0, 1), cA, 1, false);
        if (wr == 1) PG8_BAR;
        PG8_WAIT_V(2); PG8_BAR;
        PG8_STAGE(PG8_SB(1, 0), cB + kstep, voffB); PG8_STAGE_A(PG8_SA(1, 0), cA + kstep, 0, false); PG8_STAGE(PG8_SB(1, 1), cB + hstep + kstep, voffB);
        PG8_WAIT_V(6); PG8_BAR;
    } else {
        PG8_STAGE(PG8_SB(0, 0), cB, voffB); PG8_STAGE_A(PG8_SA(0, 0), cA, 0, false); PG8_STAGE(PG8_SB(0, 1), cB + hstep, voffB); PG8_STAGE_A(PG8_SA(0, 1), cA, 1, false);
        if (wr == 1) PG8_BAR;
        PG8_WAIT_V(4); PG8_BAR;
        PG8_STAGE(PG8_SB(1, 0), cB + kstep, voffB); PG8_STAGE_A(PG8_SA(1, 0), cA + kstep, 0, false); PG8_STAGE(PG8_SB(1, 1), cB + hstep + kstep, voffB);
        PG8_WAIT_V(6); PG8_BAR;
    }
    for (;;) {
        const bool has_next = S.next(ui + 1, nxt);
        const char* nA = cA; const char* nB = cB;
        if (has_next) PG8_UPTR(nxt, nA, nB);
#pragma unroll 1
        for (int t = 0; t < nt; t += 2) {
            const bool last = (t == nt - 2);
            const char* a1 = cA + (size_t)(t + 1) * kstep;
            const char* a2 = last ? nA : cA + (size_t)(t + 2) * kstep; const char* b2 = last ? nB : cB + (size_t)(t + 2) * kstep;
            const char* a3 = a2 + kstep; const char* b3 = b2 + kstep;
            if constexpr (SP2) {
            PG8_LDB(B0, 0, 0); PG8_LDB(B1, 0, 1); PG8_SCHED; PG8_LDA(At, 0, 0); PG8_STAGE_A(PG8_SA(1, 1), a1, 1, false);
            if constexpr (GATHER) { if (last && has_next) { PG8_GROWS(nxt, vC); } }
            PG8_WAIT_V(8); PG8_WAIT_L(0); PG8_BAR; PG8_MMA(0, 0, At, B0); PG8_MMA(0, 1, At, B1); PG8_BAR; PG8_SCHED;
            PG8_LDA(At, 0, 1); PG8_STAGE(PG8_SB(0, 0), b2, voffB); PG8_STAGE(PG8_SB(0, 1), b2 + hstep, voffB); PG8_STAGE_A(PG8_SA(0, 0), a2, 0, last);
            PG8_WAIT_V(8); PG8_WAIT_L(0); PG8_BAR; PG8_MMA(1, 0, At, B0); PG8_MMA(1, 1, At, B1); PG8_BAR; PG8_SCHED;
            PG8_LDB(B0, 1, 0); PG8_LDB(B1, 1, 1); PG8_SCHED; PG8_LDA(At, 1, 0); PG8_STAGE_A(PG8_SA(0, 1), a2, 1, last);
            PG8_WAIT_V(8); PG8_WAIT_L(0); PG8_BAR; PG8_MMA(0, 0, At, B0); PG8_MMA(0, 1, At, B1); PG8_BAR; PG8_SCHED;
            PG8_LDA(At, 1, 1); PG8_STAGE(PG8_SB(1, 0), b3, voffB); PG8_STAGE(PG8_SB(1, 1), b3 + hstep, voffB); PG8_STAGE_A(PG8_SA(1, 0), a3, 0, last);
            PG8_WAIT_V(8); PG8_WAIT_L(0); PG8_BAR; PG8_MMA(1, 0, At, B0); PG8_MMA(1, 1, At, B1); PG8_BAR; PG8_SCHED;
            } else {
            PG8_LDB(B0, 0, 0); PG8_SCHED; PG8_LDA(At, 0, 0); PG8_STAGE_A(PG8_SA(1, 1), a1, 1, false);
            if constexpr (GATHER) { if (last && has_next) { PG8_GROWS(nxt, vC); } }
            PG8_WAIT_L(8); PG8_BAR; PG8_WAIT_L(0); PG8_MMA(0, 0, At, B0); PG8_BAR; PG8_SCHED;
            PG8_LDB(B1, 0, 1); PG8_STAGE(PG8_SB(0, 0), b2, voffB);
            PG8_BAR; PG8_WAIT_L(0); PG8_MMA(0, 1, At, B1); PG8_BAR;
            PG8_LDA(At, 0, 1); PG8_STAGE_A(PG8_SA(0, 0), a2, 0, last);
            PG8_BAR; PG8_WAIT_L(0); PG8_MMA(1, 0, At, B0); PG8_BAR; PG8_SCHED;
            PG8_STAGE(PG8_SB(0, 1), b2 + hstep, voffB);
            PG8_WAIT_V(6); PG8_BAR; PG8_MMA(1, 1, At, B1); PG8_BAR;
            PG8_LDB(B0, 1, 0); PG8_SCHED; PG8_LDA(At, 1, 0); PG8_STAGE_A(PG8_SA(0, 1), a2, 1, last);
            PG8_WAIT_L(8); PG8_BAR; PG8_WAIT_L(0); PG8_MMA(0, 0, At, B0); PG8_BAR; PG8_SCHED;
            PG8_LDB(B1, 1, 1); PG8_STAGE(PG8_SB(1, 0), b3, voffB);
            PG8_BAR; PG8_WAIT_L(0); PG8_MMA(0, 1, At, B1); PG8_BAR;
            PG8_LDA(At, 1, 1); PG8_STAGE_A(PG8_SA(1, 0), a3, 0, last);
            PG8_BAR; PG8_WAIT_L(0); PG8_MMA(1, 0, At, B0); PG8_BAR; PG8_SCHED;
            PG8_STAGE(PG8_SB(1, 1), b3 + hstep, voffB);
            PG8_WAIT_V(6); PG8_BAR; PG8_MMA(1, 1, At, B1); PG8_BAR;
            }
        }
        if constexpr (ALIGN_EPI) { if (wr == 0) PG8_BAR; }
        if constexpr (FP8) { asm volatile("s_nop 15\n\ts_nop 15" ::: "memory"); PG8_SCHED; }
        E(acc, cur, wr, wc, fr, fq);
        if (!has_next) break;
#pragma unroll
        for (int a = 0; a < 2; ++a)
#pragma unroll
            for (int b = 0; b < 2; ++b)
#pragma unroll
                for (int m = 0; m < 4; ++m)
#pragma unroll
                    for (int n = 0; n < 2; ++n) acc[a][b][m][n] = (f32x4){0.f, 0.f, 0.f, 0.f};
        cur = nxt; cA = nA; cB = nB; ++ui;
        if constexpr (ALIGN_EPI) { if (wr == 1) PG8_BAR; }
    }
    PG8_WAIT_V(0);
    if constexpr (!ALIGN_EPI) { if (wr == 0) PG8_BAR; }
    PG8_BAR;
#undef PG8_SA
#undef PG8_SB
#undef PG8_STAGE
#undef PG8_LDA
#undef PG8_LDB
#undef PG8_MMA
#undef PG8_WAIT_V
#undef PG8_WAIT_L
#undef PG8_BAR
#undef PG8_SCHED
#undef PG8_UPTR
#undef PG8_STAGE_A
#undef PG8_GROWS
}

struct EpiProj {
    static constexpr bool PERM = true;
    bf16 *q, *k, *vT, *p;
    __device__ __forceinline__ void operator()(const f32x4 (&acc)[2][2][4][2], const Unit& u, int wr, int wc, int fr, int fq) const {
        const int row0 = u.pm * BM + wr * 64 + fr;
        const int pn = u.pn;
#pragma unroll
        for (int ai = 0; ai < 2; ++ai)
#pragma unroll
            for (int m = 0; m < 4; ++m) {
                const int row = row0 + ai * HALF + m * 16;
#pragma unroll
                for (int bj = 0; bj < 2; ++bj) {
                    f32x4 v0 = acc[ai][bj][m][0], v1 = acc[ai][bj][m][1];
                    const int col = pn * BM + bj * HALF + wc * 32 + 8 * fq;
                    if (pn >= 4 && pn < 6) {
                        const int cv = col - 1024, hh = cv >> 6, dim = cv & 63, b = row / T, t = row % T;
                        bf16* dst = vT + ((size_t)(((b * NH + hh) * GROWS + (t >> 6)) * HD + dim)) * 64 + (t & 63);
                        const unsigned w0 = cvt_pk_bf16(v0[0], v0[1]), w1 = cvt_pk_bf16(v0[2], v0[3]), w2 = cvt_pk_bf16(v1[0], v1[1]), w3 = cvt_pk_bf16(v1[2], v1[3]);
                        dst[0 * 64] = (bf16)(w0 & 0xffff); dst[1 * 64] = (bf16)(w0 >> 16); dst[2 * 64] = (bf16)(w1 & 0xffff); dst[3 * 64] = (bf16)(w1 >> 16);
                        dst[4 * 64] = (bf16)(w2 & 0xffff); dst[5 * 64] = (bf16)(w2 >> 16); dst[6 * 64] = (bf16)(w3 & 0xffff); dst[7 * 64] = (bf16)(w3 >> 16);
                        asm volatile("s_waitcnt vmcnt(40)" ::: "memory");
                    } else {
                        bf16* dst;
                        if (pn < 2) { v0 = v0 * 0.125f; v1 = v1 * 0.125f; dst = q + (size_t)row * CW + col; }
                        else if (pn < 4) dst = k + (size_t)row * CW + (col - 512);
                        else dst = p + (size_t)row * PW + (col - 1536);
                        u32x4 w; w.x = cvt_pk_bf16(v0[0], v0[1]); w.y = cvt_pk_bf16(v0[2], v0[3]); w.z = cvt_pk_bf16(v1[0], v1[1]); w.w = cvt_pk_bf16(v1[2], v1[3]);
                        *(u32x4*)dst = w;
                    }
                }
            }
    }
};
struct EpiWo {
    static constexpr bool PERM = true;
    const float* x; bf16* h;
    __device__ __forceinline__ void operator()(const f32x4 (&acc)[2][2][4][2], const Unit& u, int wr, int wc, int fr, int fq) const {
        const int row0 = u.pm * BM + wr * 64 + fr, col0 = u.pn * BM + wc * 32 + 8 * fq;
#pragma unroll
        for (int ai = 0; ai < 2; ++ai)
#pragma unroll
            for (int m = 0; m < 4; ++m) { const size_t off = (size_t)(row0 + ai * HALF + m * 16) * D + col0;
#pragma unroll
                for (int bj = 0; bj < 2; ++bj) { const f32x4 v0 = acc[ai][bj][m][0] + *(const f32x4*)(x + off + bj * HALF), v1 = acc[ai][bj][m][1] + *(const f32x4*)(x + off + bj * HALF + 4);
                    u32x4 w; w.x = cvt_pk_bf16(v0[0], v0[1]); w.y = cvt_pk_bf16(v0[2], v0[3]); w.z = cvt_pk_bf16(v1[0], v1[1]); w.w = cvt_pk_bf16(v1[2], v1[3]);
                    *(u32x4*)(h + off + bj * HALF) = w; } }
    }
};
struct EpiUp {
    static constexpr bool PERM = true;
    const float* b_up; unsigned char* act;
    __device__ __forceinline__ void operator()(const f32x4 (&acc)[2][2][4][2], const Unit& u, int wr, int wc, int fr, int fq) const {
        const int row0 = u.pm * BM + wr * 64 + fr, ch = u.pn * 128 + wc * 32 + 8 * fq;
        const float* bg = b_up + (size_t)u.e * 2048 + ch; const float* bl = bg + 1024;
        const f32x4 bg0 = *(const f32x4*)bg * F8_SACT, bg1 = *(const f32x4*)(bg + 4) * F8_SACT, bl0 = *(const f32x4*)bl, bl1 = *(const f32x4*)(bl + 4);
        constexpr float SG = F8_SACT / (F8_SX * F8_SW), SL = 1.0f / (F8_SX * F8_SW), KE = -1.702f * 1.44269504f / F8_SACT;
#pragma unroll
        for (int ai = 0; ai < 2; ++ai)
#pragma unroll
            for (int m = 0; m < 4; ++m) {
                float o[8];
#pragma unroll
                for (int n = 0; n < 2; ++n) { const f32x4 gv = acc[ai][0][m][n] * SG + (n ? bg1 : bg0), lv = acc[ai][1][m][n] * SL + (n ? bl1 : bl0);
#pragma unroll
                    for (int j = 0; j < 4; ++j) { const float gt = fminf(gv[j], 7.0f * F8_SACT), li = __builtin_amdgcn_fmed3f(lv[j], -7.0f, 7.0f);
                        const float t = gt * __builtin_amdgcn_rcpf(1.0f + __builtin_amdgcn_exp2f(gt * KE)); o[n * 4 + j] = __builtin_fmaf(li, t, t); } }
                int w0 = 0, w1 = 0;
                w0 = __builtin_amdgcn_cvt_pk_fp8_f32(o[0], o[1], w0, false); w0 = __builtin_amdgcn_cvt_pk_fp8_f32(o[2], o[3], w0, true);
                w1 = __builtin_amdgcn_cvt_pk_fp8_f32(o[4], o[5], w1, false); w1 = __builtin_amdgcn_cvt_pk_fp8_f32(o[6], o[7], w1, true);
                u32x2 w8; w8.x = (unsigned)w0; w8.y = (unsigned)w1;
                *(u32x2*)(act + (size_t)(row0 + ai * HALF + m * 16) * DE + ch) = w8;
            }
    }
};
struct EpiDown {
    static constexpr bool PERM = true;
    const float* b_dn; unsigned char* y;
    __device__ __forceinline__ void operator()(const f32x4 (&acc)[2][2][4][2], const Unit& u, int wr, int wc, int fr, int fq) const {
        const int row0 = u.pm * BM + wr * 64 + fr, col0 = u.pn * BM + wc * 32 + 8 * fq;
        const float* bb = b_dn + (size_t)u.e * D + col0;
        f32x4 bv[2][2];
#pragma unroll
        for (int bj = 0; bj < 2; ++bj)
#pragma unroll
            for (int n = 0; n < 2; ++n) bv[bj][n] = *(const f32x4*)(bb + bj * HALF + 4 * n) * F8_SY;
#pragma unroll
        for (int ai = 0; ai < 2; ++ai)
#pragma unroll
            for (int m = 0; m < 4; ++m) { unsigned char* rowp = y + (size_t)(row0 + ai * HALF + m * 16) * D + col0;
#pragma unroll
                for (int bj = 0; bj < 2; ++bj) { const f32x4 v0 = acc[ai][bj][m][0] * (F8_SY / (F8_SACT * F8_SW)) + bv[bj][0], v1 = acc[ai][bj][m][1] * (F8_SY / (F8_SACT * F8_SW)) + bv[bj][1];
                    u32x2 w; w.x = pk4_fp8(v0[0], v0[1], v0[2], v0[3]); w.y = pk4_fp8(v1[0], v1[1], v1[2], v1[3]);
                    *(u32x2*)(rowp + bj * HALF) = w; } }
    }
};
}


#define XB_TMO      128
#define XB_XCNT(j)  (256  + 64 * (j))
#define XB_XSUB(j)  (1280 + 64 * (j))
#define XB_XGEN(j)  (2304 + 64 * (j))
#define XB_TOP      3328
#define XB_TOPGEN   3392
#define XCD_BAR_WORDS 3456
#define XB_SPIN_CAP (1u << 20)
__device__ __forceinline__ unsigned xb_ld(unsigned* p)              { return __hip_atomic_load(p, __ATOMIC_RELAXED, __HIP_MEMORY_SCOPE_AGENT); }
__device__ __forceinline__ unsigned xb_add(unsigned* p, unsigned v) { return __hip_atomic_fetch_add(p, v, __ATOMIC_RELAXED, __HIP_MEMORY_SCOPE_AGENT); }
__device__ __forceinline__ unsigned xb_xcc_id() { return (unsigned)__builtin_amdgcn_s_getreg((3 << 11) | 20) & 0xFu; }
#define XB_SPIN(cond, bar) do { unsigned _sp = 0; while (cond) { __builtin_amdgcn_s_sleep(1); \
    if ((++_sp & 255u) == 0u) { if (xb_ld(&(bar)[XB_TMO])) break; if (_sp > XB_SPIN_CAP) { atomicAdd(&(bar)[XB_TMO], 1u); break; } } } } while (0)
struct XcdBarrier { unsigned* bar; unsigned x; volatile LAS unsigned* st; };
__device__ __forceinline__ XcdBarrier xcd_barrier_post(unsigned* bar, volatile LAS unsigned* st) {
    XcdBarrier b; b.bar = bar; b.x = xb_xcc_id(); b.st = st;
    if (threadIdx.x == 0) (void)xb_add(&bar[XB_XCNT(b.x)], 1u);
    return b;
}
__device__ __forceinline__ void xcd_barrier_complete(unsigned* bar, unsigned x, unsigned& nloc, unsigned& nx) {
    const unsigned G = gridDim.x * gridDim.y * gridDim.z;
    unsigned sum, cnt, mine, sp = 0u;
    for (;;) {
        sum = 0u; cnt = 0u; mine = 0u;
#pragma unroll
        for (unsigned j = 0; j < 16; ++j) { const unsigned c = xb_ld(&bar[XB_XCNT(j)]); sum += c; cnt += (c > 0u) ? 1u : 0u; mine = (j == x) ? c : mine; }
        if (sum == G) break;
        __builtin_amdgcn_s_sleep(1);
        if ((++sp & 255u) == 0u) { if (xb_ld(&bar[XB_TMO])) break; if (sp > XB_SPIN_CAP) { atomicAdd(&bar[XB_TMO], 1u); break; } }
    }
    nloc = mine > 0u ? mine : 1u; nx = cnt > 0u ? cnt : 1u;
}
__device__ __forceinline__ void xcd_barrier(const XcdBarrier& b) {
    asm volatile("s_waitcnt vmcnt(0)" ::: "memory");
    __syncthreads();
    if (threadIdx.x == 0) {
        unsigned* bar = b.bar;
        __builtin_amdgcn_s_waitcnt(0);
        unsigned nloc = b.st[0], nx = b.st[1];
        if (nloc == 0u) { xcd_barrier_complete(bar, b.x, nloc, nx); b.st[0] = nloc; b.st[1] = nx; }
        const unsigned old = xb_add(&bar[XB_XSUB(b.x)], 1u);
        const unsigned gen = old / nloc;
        if (old + 1u == (gen + 1u) * nloc) {
            __builtin_amdgcn_fence(__ATOMIC_RELEASE, "agent");
            asm volatile("s_waitcnt vmcnt(0)" ::: "memory");
            const unsigned og = xb_add(&bar[XB_TOP], 1u);
            const unsigned tg = og / nx;
            if (og + 1u == (tg + 1u) * nx) xb_add(&bar[XB_TOPGEN], 1u);
            else XB_SPIN(xb_ld(&bar[XB_TOPGEN]) == tg, bar);
            __builtin_amdgcn_fence(__ATOMIC_ACQUIRE, "agent");
            xb_add(&bar[XB_XGEN(b.x)], 1u);
            asm volatile("s_waitcnt vmcnt(0)" ::: "memory");
        } else {
            XB_SPIN(xb_ld(&bar[XB_XGEN(b.x)]) == gen, bar);
            __builtin_amdgcn_fence(__ATOMIC_ACQUIRE, "agent");
            asm volatile("s_waitcnt vmcnt(0)" ::: "memory");
        }
    }
    __syncthreads();
}

struct Args { const float* in[26]; float* out; unsigned char* ws; int ph_lo, ph_hi; };

struct Frame { LAS unsigned char* lds; int tid, lane, wave, G, vcu; };

__device__ __forceinline__ void transpose_item(const float* W, int K, int N, bf16* WT, int k0, int n0, int orow0, LAS float* scr, int lane) {
#pragma unroll 8
    for (int i = 0; i < 32; ++i) { const int kk = 2 * i + (lane >> 5); scr[kk * 33 + (lane & 31)] = W[(size_t)(k0 + kk) * N + n0 + (lane & 31)]; }
    asm volatile("s_waitcnt lgkmcnt(0)" ::: "memory");
    const int c = lane & 7;
#pragma unroll
    for (int j = 0; j < 4; ++j) { const int n = (lane >> 3) + 8 * j; const LAS float* s = scr + (8 * c) * 33 + n;
        u32x4 o; o.x = cvt_pk_bf16(s[0 * 33], s[1 * 33]); o.y = cvt_pk_bf16(s[2 * 33], s[3 * 33]); o.z = cvt_pk_bf16(s[4 * 33], s[5 * 33]); o.w = cvt_pk_bf16(s[6 * 33], s[7 * 33]);
        *(u32x4*)(WT + (size_t)(orow0 + n) * K + k0 + 8 * c) = o; }
    asm volatile("s_waitcnt lgkmcnt(0)" ::: "memory");
}

__device__ __forceinline__ void transpose_item8(const float* W, int K, int N, unsigned char* WT, int k0, int n0, int orow0, LAS float* scr, int lane) {
#pragma unroll 8
    for (int i = 0; i < 32; ++i) { const int kk = 2 * i + (lane >> 5); scr[kk * 33 + (lane & 31)] = W[(size_t)(k0 + kk) * N + n0 + (lane & 31)]; }
    asm volatile("s_waitcnt lgkmcnt(0)" ::: "memory");
    const int c = lane & 7;
#pragma unroll
    for (int j = 0; j < 4; ++j) { const int n = (lane >> 3) + 8 * j; const LAS float* s = scr + (8 * c) * 33 + n;
        u32x2 o; o.x = pk4_fp8(s[0 * 33] * F8_SW, s[1 * 33] * F8_SW, s[2 * 33] * F8_SW, s[3 * 33] * F8_SW); o.y = pk4_fp8(s[4 * 33] * F8_SW, s[5 * 33] * F8_SW, s[6 * 33] * F8_SW, s[7 * 33] * F8_SW);
        *(u32x2*)(WT + (size_t)(orow0 + n) * K + k0 + 8 * c) = o; }
    asm volatile("s_waitcnt lgkmcnt(0)" ::: "memory");
}

__device__ __forceinline__ void p0_prologue(const Frame& F, const Args& a) {
    unsigned char* ws = a.ws;
    LAS float* scr = (LAS float*)(F.lds + F.wave * 8448);
    const int gw = F.vcu * 8 + F.wave, NGW = F.G * 8;
    constexpr int I_IN = 16 * 108, I_O = 16 * 32, I_UP = 32 * 16 * 64, I_DN = 32 * 16 * 32, I_L = 16, I_G = 32;
    constexpr int NITEMS = I_IN + I_O + I_UP + I_DN + 2 * I_L + 2 * I_L + I_G;
    for (int it = gw; it < NITEMS; it += NGW) {
        int r = it;
        if (r < I_UP) {
            const int e = r / 1024, q = r % 1024, kb = q / 64, nb = q % 64, n0 = nb * 32;
            const int orow0 = n0 < 1024 ? 256 * (n0 >> 7) + (n0 & 127) : 256 * ((n0 - 1024) >> 7) + 128 + ((n0 - 1024) & 127);
            transpose_item8(a.in[21] + (size_t)e * 1024 * 2048, 1024, 2048, ws + WS_WUPT + (size_t)e * 2048 * 1024, kb * 64, n0, orow0, scr, F.lane); continue; }
        r -= I_UP;
        if (r < I_DN) { const int e = r / 512, q = r % 512, kb = q / 32, nb = q % 32;
            transpose_item8(a.in[23] + (size_t)e * 1024 * 1024, 1024, 1024, ws + WS_WDNT + (size_t)e * 1024 * 1024, kb * 64, nb * 32, nb * 32, scr, F.lane); continue; }
        r -= I_DN;
        if (r < I_IN) { const int kb = r / 108, nb = r % 108; transpose_item(a.in[2], 1024, NPROJ, (bf16*)(ws + WS_WINT), kb * 64, nb * 32, nb * 32, scr, F.lane); continue; }
        r -= I_IN;
        if (r < I_O) { const int kb = r / 32, nb = r % 32; transpose_item(a.in[17], 1024, 1024, (bf16*)(ws + WS_WOT), kb * 64, nb * 32, nb * 32, scr, F.lane); continue; }
        r -= I_O;
        if (r < 2 * I_L) { const int z = r / 16, nb = r % 16; transpose_item(a.in[8] + (size_t)z * 64 * 512, 64, 512, (bf16*)(ws + WS_W2T) + (size_t)z * 512 * 64, 0, nb * 32, nb * 32, scr, F.lane); continue; }
        r -= 2 * I_L;
        if (r < 2 * I_L) { const int z = r / 16, nb = r % 16; transpose_item(a.in[10] + (size_t)z * 64 * 512, 64, 512, (bf16*)(ws + WS_A2T) + (size_t)z * 512 * 64, 0, nb * 32, nb * 32, scr, F.lane); continue; }
        r -= 2 * I_L;
        { const int kb = r / 16, nb = r % 16; transpose_item(a.in[11], 128, 512, (bf16*)(ws + WS_G2T), kb * 64, nb * 32, nb * 32, scr, F.lane); }
    }
    { u32x4* z = (u32x4*)(ws + WS_WINT + (size_t)NPROJ * 1024 * 2); const u32x4 zero = {0u, 0u, 0u, 0u};
      for (int i = F.vcu * 512 + F.tid; i < 16384; i += F.G * 512) z[i] = zero; }
    const float* x = a.in[0]; const float* nw = a.in[1]; bf16* hn = (bf16*)(ws + WS_HN);
    f32x4 wv[4];
#pragma unroll
    for (int j = 0; j < 4; ++j) wv[j] = *((const f32x4*)nw + F.lane + 64 * j);
    for (int m = gw; m < M; m += 2 * NGW) {
        const int m1 = m + NGW; const bool has1 = m1 < M;
        const f32x4* xr0 = (const f32x4*)(x + (size_t)m * D) + F.lane; const f32x4* xr1 = (const f32x4*)(x + (size_t)(has1 ? m1 : m) * D) + F.lane;
        f32x4 v0[4], v1[4]; float s0 = 0.f, s1 = 0.f;
#pragma unroll
        for (int j = 0; j < 4; ++j) { v0[j] = xr0[64 * j]; v1[j] = xr1[64 * j]; }
#pragma unroll
        for (int j = 0; j < 4; ++j) { s0 += (v0[j].x * v0[j].x + v0[j].y * v0[j].y) + (v0[j].z * v0[j].z + v0[j].w * v0[j].w); s1 += (v1[j].x * v1[j].x + v1[j].y * v1[j].y) + (v1[j].z * v1[j].z + v1[j].w * v1[j].w); }
        const float rs0 = rsqrtf(wave_sum(s0) * (1.f / D) + RMS_EPS), rs1 = rsqrtf(wave_sum(s1) * (1.f / D) + RMS_EPS);
        u32x2* o0 = (u32x2*)(hn + (size_t)m * D) + F.lane; u32x2* o1 = (u32x2*)(hn + (size_t)m1 * D) + F.lane;
#pragma unroll
        for (int j = 0; j < 4; ++j) { u32x2 o; o.x = cvt_pk_bf16(v0[j].x * rs0 * wv[j].x, v0[j].y * rs0 * wv[j].y); o.y = cvt_pk_bf16(v0[j].z * rs0 * wv[j].z, v0[j].w * rs0 * wv[j].w); o0[64 * j] = o; }
        if (has1) {
#pragma unroll
            for (int j = 0; j < 4; ++j) { u32x2 o; o.x = cvt_pk_bf16(v1[j].x * rs1 * wv[j].x, v1[j].y * rs1 * wv[j].y); o.y = cvt_pk_bf16(v1[j].z * rs1 * wv[j].z, v1[j].w * rs1 * wv[j].w); o1[64 * j] = o; } }
    }
}

constexpr int PREP_KBUF = 0, PREP_INV = 65536, PREP_AW = 67584, PREP_AA = PREP_AW + 17408, PREP_AG = PREP_AA + 17408, PREP_LD = 136;
template <bool STORE>
__device__ __forceinline__ void prep_phase(const Frame& F, const Args& a) {
    unsigned char* ws = a.ws;
    const bf16* p = (const bf16*)(ws + WS_P);
    bf16* r_out = (bf16*)(ws + WS_R); bf16* v_out = (bf16*)(ws + WS_V); bf16* kk_out = (bf16*)(ws + WS_KK);
    bf16* decay_out = (bf16*)(ws + WS_DECAY); bf16* kdir_out = (bf16*)(ws + WS_KDIR); bf16* akk_out = (bf16*)(ws + WS_AKK); bf16* g_out = (bf16*)(ws + WS_G);
    const bf16* w2T = (const bf16*)(ws + WS_W2T); const bf16* a2T = (const bf16*)(ws + WS_A2T); const bf16* g2T = (const bf16*)(ws + WS_G2T);
    const float* mu_p = a.in[5]; const float* mu_n = a.in[6]; const float* w0 = a.in[7]; const float* a0 = a.in[9];
    const float* k_k = a.in[12]; const float* k_a = a.in[13];
    LAS bf16* kbuf = (LAS bf16*)(F.lds + PREP_KBUF); LAS float* invb = (LAS float*)(F.lds + PREP_INV);
    LAS bf16* Aw = (LAS bf16*)(F.lds + PREP_AW); LAS bf16* Aa = (LAS bf16*)(F.lds + PREP_AA); LAS bf16* Ag = (LAS bf16*)(F.lds + PREP_AG);
    const int lane = F.lane, wave = F.wave, fr = lane & 15, fg = lane >> 4;
    for (int tile = F.vcu; tile < M / 64; tile += F.G) {
        const int m0 = tile * 64;
#pragma unroll 1
        for (int jj = 0; jj < 4; ++jj) {
            const int q = lane + 64 * jj; const bool valid = q < 240; const int c0 = 8 * q;
            float mp[8], mn[8];
#pragma unroll
            for (int i = 0; i < 8; ++i) { mp[i] = valid ? mu_p[c0 + i] : 0.f; mn[i] = valid ? mu_n[c0 + i] : 0.f; }
            const int mfirst = m0 + wave * 8;
            const u32x4 zero = {0u, 0u, 0u, 0u};
            u32x4 rows[10];
#pragma unroll
            for (int rI = 0; rI < 10; ++rI) { const int mr = mfirst - 1 + rI;
                const bool ok = valid && !(rI == 0 && (mfirst % T) == 0) && !(rI == 9 && ((mfirst + 7) % T) == T - 1);
                rows[rI] = ok ? *(const u32x4*)(p + (size_t)mr * PW + c0) : zero; }
#pragma unroll
            for (int i = 0; i < 8; ++i) {
                const int m = mfirst + i, it = wave * 8 + i;
                const u32x4 prev = rows[i], cur = rows[i + 1], nxt = rows[i + 2];
                float fp[8], fc[8], fn[8], s[8];
                unpack8(prev, fp); unpack8(cur, fc); unpack8(nxt, fn);
#pragma unroll
                for (int e = 0; e < 8; ++e) s[e] = fc[e] + mp[e] * (fp[e] - fc[e]) + mn[e] * (fn[e] - fc[e]);
                if (jj == 0) { if (STORE) { *(u32x4*)(r_out + (size_t)m * CW + c0) = pack8(s); } }
                else if (jj == 1) {
                    const int c = c0 - 512;
                    *(LAS u32x4*)(kbuf + it * 512 + c) = pack8(s);
                    float kr[8]; float ss = 0.f;
#pragma unroll
                    for (int e = 0; e < 8; ++e) { kr[e] = s[e] * k_k[c + e]; ss += kr[e] * kr[e]; }
                    ss += __shfl_xor(ss, 1); ss += __shfl_xor(ss, 2); ss += __shfl_xor(ss, 4);
                    const float inv = fminf(__builtin_amdgcn_rsqf(ss), 1e12f);
#pragma unroll
                    for (int e = 0; e < 8; ++e) kr[e] *= inv;
                    if (STORE) { *(u32x4*)(kk_out + (size_t)m * CW + c) = pack8(kr); }
                    if ((lane & 7) == 0) invb[it * 8 + (lane >> 3)] = inv;
                }
                else if (jj == 2) { if (STORE) { *(u32x4*)(v_out + (size_t)m * CW + (c0 - 1024)) = pack8(s); } }
                else if (valid) {
                    const int seg = lane >> 4, cw = 8 * (lane & 15);
                    if (seg == 0) {
#pragma unroll
                        for (int e = 0; e < 8; ++e) s[e] = 1.0f - 2.0f * __builtin_amdgcn_rcpf(__expf(2.0f * s[e]) + 1.0f);
                        *(LAS u32x4*)(Aw + it * PREP_LD + cw) = pack8(s);
                    } else if (seg == 1) { *(LAS u32x4*)(Aa + it * PREP_LD + cw) = pack8(s); }
                    else {
#pragma unroll
                        for (int e = 0; e < 8; ++e) s[e] = sigmoidf_(s[e]);
                        *(LAS u32x4*)(Ag + it * PREP_LD + cw) = pack8(s);
                    }
                }
            }
        }
        __syncthreads();
        const int nb = 64 * wave;
#define PREP_PROW(nt_) (nb + 32 * ((nt_) >> 1) + 8 * (fr >> 2) + 4 * ((nt_) & 1) + (fr & 3))
#define PREP_COL(nt_)  (nb + 32 * ((nt_) >> 1) + 8 * fg + 4 * ((nt_) & 1))
#pragma unroll 1
        for (int job = 0; job < 4; ++job) {
            const int z = job & 1;
            const bf16* WT = job < 2 ? w2T + (size_t)z * 512 * 64 : a2T + (size_t)z * 512 * 64;
            const LAS bf16* Ax = job < 2 ? Aw + z * 64 : Aa + z * 64;
            bf16x8 wf[2][4];
#pragma unroll
            for (int ks = 0; ks < 2; ++ks)
#pragma unroll
                for (int nt = 0; nt < 4; ++nt) wf[ks][nt] = *(const bf16x8*)(WT + (size_t)PREP_PROW(nt) * 64 + 32 * ks + 8 * fg);
            f32x4 pb[4], pkk[4], pka[4];
#pragma unroll
            for (int nt = 0; nt < 4; ++nt) { const int n = PREP_COL(nt);
                pb[nt] = *(const f32x4*)((job < 2 ? w0 : a0) + z * 512 + n); pkk[nt] = *(const f32x4*)(k_k + n); pka[nt] = *(const f32x4*)(k_a + n); }
            f32x4 acc[4][4];
#pragma unroll
            for (int mt = 0; mt < 4; ++mt)
#pragma unroll
                for (int nt = 0; nt < 4; ++nt) acc[mt][nt] = (f32x4){0.f, 0.f, 0.f, 0.f};
#pragma unroll
            for (int ks = 0; ks < 2; ++ks) {
                bf16x8 af[4];
#pragma unroll
                for (int mt = 0; mt < 4; ++mt) af[mt] = *(const LAS bf16x8*)(Ax + (16 * mt + fr) * PREP_LD + 32 * ks + 8 * fg);
#pragma unroll
                for (int mt = 0; mt < 4; ++mt)
#pragma unroll
                    for (int nt = 0; nt < 4; ++nt) acc[mt][nt] = __builtin_amdgcn_mfma_f32_16x16x32_bf16(wf[ks][nt], af[mt], acc[mt][nt], 0, 0, 0);
            }
#pragma unroll
            for (int mt = 0; mt < 4; ++mt) {
                const int it = 16 * mt + fr; const size_t m = (size_t)(m0 + it);
#pragma unroll
                for (int np = 0; np < 2; ++np) {
                    const int c8 = nb + 32 * np + 8 * fg;
                    if (job < 2) {
                        float o[8];
#pragma unroll
                        for (int hh = 0; hh < 2; ++hh) { const f32x4 v = acc[mt][2 * np + hh], bq = pb[2 * np + hh];
#pragma unroll
                            for (int i = 0; i < 4; ++i) o[4 * hh + i] = __expf(-0.60653066f * sigmoidf_(v[i] + bq[i])); }
                        if (STORE) { *(u32x4*)(decay_out + ((size_t)z * M + m) * CW + c8) = pack8(o); }
                    } else {
                        const u32x4 kb = *(const LAS u32x4*)(kbuf + it * 512 + c8);
                        float kv[8]; unpack8(kb, kv);
                        const float inv = invb[it * 8 + wave];
                        float kd[8], ak[8];
#pragma unroll
                        for (int hh = 0; hh < 2; ++hh) { const f32x4 v = acc[mt][2 * np + hh], bq = pb[2 * np + hh], kkc = pkk[2 * np + hh], kac = pka[2 * np + hh];
#pragma unroll
                            for (int i = 0; i < 4; ++i) { const float av = sigmoidf_(v[i] + bq[i]), kx = kv[4 * hh + i]; kd[4 * hh + i] = kx * (1.0f + (av - 1.0f) * kac[i]); ak[4 * hh + i] = av * (kx * kkc[i] * inv); } }
                        if (STORE) { *(u32x4*)(kdir_out + ((size_t)z * M + m) * CW + c8) = pack8(kd); *(u32x4*)(akk_out + ((size_t)z * M + m) * CW + c8) = pack8(ak); }
                    }
                }
            }
        }
        {
            bf16x8 wf[4][4];
#pragma unroll
            for (int ks = 0; ks < 4; ++ks)
#pragma unroll
                for (int nt = 0; nt < 4; ++nt) wf[ks][nt] = *(const bf16x8*)(g2T + (size_t)PREP_PROW(nt) * 128 + 32 * ks + 8 * fg);
            f32x4 acc[4][4];
#pragma unroll
            for (int mt = 0; mt < 4; ++mt)
#pragma unroll
                for (int nt = 0; nt < 4; ++nt) acc[mt][nt] = (f32x4){0.f, 0.f, 0.f, 0.f};
#pragma unroll
            for (int ks = 0; ks < 4; ++ks) {
                bf16x8 af[4];
#pragma unroll
                for (int mt = 0; mt < 4; ++mt) af[mt] = *(const LAS bf16x8*)(Ag + (16 * mt + fr) * PREP_LD + 32 * ks + 8 * fg);
#pragma unroll
                for (int mt = 0; mt < 4; ++mt)
#pragma unroll
                    for (int nt = 0; nt < 4; ++nt) acc[mt][nt] = __builtin_amdgcn_mfma_f32_16x16x32_bf16(wf[ks][nt], af[mt], acc[mt][nt], 0, 0, 0);
            }
#pragma unroll
            for (int mt = 0; mt < 4; ++mt) { const size_t m = (size_t)(m0 + 16 * mt + fr);
#pragma unroll
                for (int np = 0; np < 2; ++np) { const f32x4 v0 = acc[mt][2 * np], v1 = acc[mt][2 * np + 1];
                    u32x4 w; w.x = cvt_pk_bf16(v0[0], v0[1]); w.y = cvt_pk_bf16(v0[2], v0[3]); w.z = cvt_pk_bf16(v1[0], v1[1]); w.w = cvt_pk_bf16(v1[2], v1[3]);
                    if (STORE) { *(u32x4*)(g_out + m * CW + nb + 32 * np + 8 * fg) = w; } } }
        }
#undef PREP_PROW
#undef PREP_COL
        __syncthreads();
    }
}

__device__ __forceinline__ void attn_phase(const Frame& F, const Args& a) {
    unsigned char* ws = a.ws;
    const bf16* q = (const bf16*)(ws + WS_Q); const bf16* k = (const bf16*)(ws + WS_K); const bf16* vT = (const bf16*)(ws + WS_VT);
    bf16* att = (bf16*)(ws + WS_ATT);
    LAS float* bias = (LAS float*)F.lds;
    for (int i = F.tid; i < 8 * 15 * 31; i += 512) bias[i] = a.in[3][i];
    __syncthreads();
    const int lane = F.lane, fr = lane & 15, fg = lane >> 4;
    const int NGW = F.G * 8, gw = F.vcu * 8 + F.wave;
    const int per = (16384 + NGW - 1) / NGW;
    for (int task = gw * per; task < (gw + 1) * per && task < 16384; ++task) {
        const int cgp = task & 3, r = (task >> 2) & 127, h = (task >> 9) & 7, b = task >> 12;
        const int c0 = 16 * cgp, wsc = min(max(c0 - 8, 0), 32), rs = min(max(r - 4, 0), GROWS - 8);
        const int c = c0 + fr, cs = min(max(c - 8, 0), 48);
        const size_t tq = (size_t)b * T + r * 64 + c;
        bf16x8 qf[2];
#pragma unroll
        for (int ks = 0; ks < 2; ++ks) qf[ks] = *(const bf16x8*)(q + tq * CW + h * 64 + 32 * ks + 8 * fg);
        f32x4 sc[16];
        const int kcol_a = wsc + 8 * (fr >> 2) + (fr & 3);
        { bf16x8 kf[16][2];
#pragma unroll
          for (int t = 0; t < 16; ++t) { const int u = t >> 1, par = t & 1;
              const size_t tk = (size_t)b * T + (rs + u) * 64 + kcol_a + 4 * par;
              kf[t][0] = *(const bf16x8*)(k + tk * CW + h * 64 + 8 * fg); kf[t][1] = *(const bf16x8*)(k + tk * CW + h * 64 + 32 + 8 * fg); }
#pragma unroll
          for (int t = 0; t < 16; ++t) { f32x4 s = {0.f, 0.f, 0.f, 0.f};
              s = __builtin_amdgcn_mfma_f32_16x16x32_bf16(kf[t][0], qf[0], s, 0, 0, 0);
              s = __builtin_amdgcn_mfma_f32_16x16x32_bf16(kf[t][1], qf[1], s, 0, 0, 0);
              sc[t] = s; } }
        float mx = -1e30f;
#pragma unroll
        for (int u = 0; u < 8; ++u) {
            const int dr = rs + u - r + 7;
#pragma unroll
            for (int par = 0; par < 2; ++par)
#pragma unroll
                for (int i = 0; i < 4; ++i) {
                    const int kc = wsc + 8 * fg + 4 * par + i; const bool ok = (kc >= cs) && (kc < cs + 16);
                    const int dc = min(max(kc - c + 15, 0), 30);
                    const float s = ok ? sc[2 * u + par][i] + bias[(h * 15 + dr) * 31 + dc] : -1e30f;
                    sc[2 * u + par][i] = s; mx = fmaxf(mx, s);
                }
        }
        mx = fmaxf(mx, __shfl_xor(mx, 16)); mx = fmaxf(mx, __shfl_xor(mx, 32));
        float sum = 0.f;
#pragma unroll
        for (int t = 0; t < 16; ++t)
#pragma unroll
            for (int i = 0; i < 4; ++i) { const float pv = sc[t][i] > -1e29f ? __expf(sc[t][i] - mx) : 0.f; sc[t][i] = pv; sum += pv; }
        sum += __shfl_xor(sum, 16); sum += __shfl_xor(sum, 32);
        const float inv = 1.0f / sum;
        f32x4 o[4];
#pragma unroll
        for (int nt = 0; nt < 4; ++nt) o[nt] = (f32x4){0.f, 0.f, 0.f, 0.f};
        { bf16x8 vf[8][4];
#pragma unroll
          for (int u = 0; u < 8; ++u) { const bf16* vblk = vT + ((size_t)((b * NH + h) * GROWS + rs + u)) * (HD * 64) + wsc + 8 * fg;
#pragma unroll
              for (int nt = 0; nt < 4; ++nt) vf[u][nt] = *(const bf16x8*)(vblk + (16 * nt + fr) * 64); }
#pragma unroll
          for (int u = 0; u < 8; ++u) {
              union { u32x4 w; bf16x8 h8; } pf;
              pf.w.x = cvt_pk_bf16(sc[2 * u][0], sc[2 * u][1]); pf.w.y = cvt_pk_bf16(sc[2 * u][2], sc[2 * u][3]);
              pf.w.z = cvt_pk_bf16(sc[2 * u + 1][0], sc[2 * u + 1][1]); pf.w.w = cvt_pk_bf16(sc[2 * u + 1][2], sc[2 * u + 1][3]);
#pragma unroll
              for (int nt = 0; nt < 4; ++nt) o[nt] = __builtin_amdgcn_mfma_f32_16x16x32_bf16(vf[u][nt], pf.h8, o[nt], 0, 0, 0); } }
#pragma unroll
        for (int nt = 0; nt < 4; ++nt) { u32x2 w; w.x = cvt_pk_bf16(o[nt][0] * inv, o[nt][1] * inv); w.y = cvt_pk_bf16(o[nt][2] * inv, o[nt][3] * inv);
            *(u32x2*)(att + tq * CW + h * 64 + 16 * nt + 4 * fg) = w; }
    }
    __syncthreads();
}

__device__ __forceinline__ float row16_sum(float v) {
    v += __builtin_bit_cast(float, __builtin_amdgcn_update_dpp(0, __builtin_bit_cast(int, v), 0xB1, 0xF, 0xF, true));
    v += __builtin_bit_cast(float, __builtin_amdgcn_update_dpp(0, __builtin_bit_cast(int, v), 0x4E, 0xF, 0xF, true));
    v += __builtin_bit_cast(float, __builtin_amdgcn_update_dpp(0, __builtin_bit_cast(int, v), 0x141, 0xF, 0xF, true));
    v += __builtin_bit_cast(float, __builtin_amdgcn_update_dpp(0, __builtin_bit_cast(int, v), 0x140, 0xF, 0xF, true));
    return v;
}
constexpr int CS_R = 8;
constexpr int CS_AT = 0, CS_RT = 2304, CS_KHT = 4608, CS_BHT = 6656, CS_VT = 8704, CS_TT = 9216, CS_AAK = 9728, CS_ARK = 10240, CS_ARB = 10752, CS_PL = 11264, CS_SLOT = 11520;
constexpr int CS_LD = 72;
constexpr int CS_SCR = CS_R * CS_SLOT  , CS_SCRW = 2304 * 2 + 1024  , CS_FLAG = CS_SCR + 7 * CS_SCRW  ;
__device__ __forceinline__ bf16 f2bf(float f) { return (bf16)cvt_pk_bf16(f, 0.f); }
struct ChainOps { u32x2 a4[4], r4[4], kh[4], bh[4], aak, ark, arb, tt, vb; f32x4 pl[4]; };
__device__ __forceinline__ void chain_load(const LAS unsigned char* sl, int fr, int fg, ChainOps& o) {
    const int o16 = fr * 32 + fg * 8;
    const LAS unsigned char* pa = sl + CS_AT + fr * (CS_LD * 2) + fg * 8; const LAS unsigned char* pr = sl + CS_RT + fr * (CS_LD * 2) + fg * 8;
#pragma unroll
    for (int kq = 0; kq < 4; ++kq) { o.a4[kq] = *(const LAS u32x2*)(pa + 32 * kq); o.r4[kq] = *(const LAS u32x2*)(pr + 32 * kq); }
    o.aak = *(const LAS u32x2*)(sl + CS_AAK + o16); o.ark = *(const LAS u32x2*)(sl + CS_ARK + o16); o.arb = *(const LAS u32x2*)(sl + CS_ARB + o16); o.tt = *(const LAS u32x2*)(sl + CS_TT + o16);
    o.vb = *(const LAS u32x2*)(sl + CS_VT + o16);
#pragma unroll
    for (int mt = 0; mt < 4; ++mt) { o.pl[mt] = *(const LAS f32x4*)(sl + CS_PL + (16 * mt + 4 * fg) * 4);
        o.kh[mt] = *(const LAS u32x2*)(sl + CS_KHT + 512 * mt + o16); o.bh[mt] = *(const LAS u32x2*)(sl + CS_BHT + 512 * mt + o16); }
}
__device__ __forceinline__ f32x4 chain_compute(const ChainOps& o, f32x4 (&zacc)[4]) {
#define CS_M32(A_, B_, C_) __builtin_amdgcn_mfma_f32_16x16x32_bf16(A_, B_, C_, 0, 0, 0)
#define CS_M16(A_, B_, C_) __builtin_amdgcn_mfma_f32_16x16x16bf16_1k(__builtin_bit_cast(s16x4, A_), __builtin_bit_cast(s16x4, B_), C_, 0, 0, 0)
    union { u32x4 w; bf16x8 h8; } zb0, zb1, ap0, ap1, rp0, rp1;
    zb0.w.x = cvt_pk_bf16(zacc[0][0], zacc[0][1]); zb0.w.y = cvt_pk_bf16(zacc[0][2], zacc[0][3]); zb0.w.z = cvt_pk_bf16(zacc[1][0], zacc[1][1]); zb0.w.w = cvt_pk_bf16(zacc[1][2], zacc[1][3]);
    zb1.w.x = cvt_pk_bf16(zacc[2][0], zacc[2][1]); zb1.w.y = cvt_pk_bf16(zacc[2][2], zacc[2][3]); zb1.w.z = cvt_pk_bf16(zacc[3][0], zacc[3][1]); zb1.w.w = cvt_pk_bf16(zacc[3][2], zacc[3][3]);
    ap0.w = (u32x4){o.a4[0].x, o.a4[0].y, o.a4[1].x, o.a4[1].y}; ap1.w = (u32x4){o.a4[2].x, o.a4[2].y, o.a4[3].x, o.a4[3].y};
    rp0.w = (u32x4){o.r4[0].x, o.r4[0].y, o.r4[1].x, o.r4[1].y}; rp1.w = (u32x4){o.r4[2].x, o.r4[2].y, o.r4[3].x, o.r4[3].y};
    const f32x4 zero4 = {0.f, 0.f, 0.f, 0.f};
    f32x4 Wc = CS_M16(o.aak, o.vb, zero4);
    Wc = CS_M32(ap0.h8, zb0.h8, Wc); Wc = CS_M32(ap1.h8, zb1.h8, Wc);
    f32x4 Yc = CS_M16(o.ark, o.vb, zero4);
    Yc = CS_M32(rp0.h8, zb0.h8, Yc); Yc = CS_M32(rp1.h8, zb1.h8, Yc);
    f32x4 zz[4];
#pragma unroll
    for (int mt = 0; mt < 4; ++mt) zz[mt] = CS_M16(o.kh[mt], o.vb, zacc[mt] * o.pl[mt]);
    u32x2 wb, ub;
    wb.x = cvt_pk_bf16(Wc[0], Wc[1]); wb.y = cvt_pk_bf16(Wc[2], Wc[3]);
    const f32x4 Uc = CS_M16(o.tt, wb, zero4);
    ub.x = cvt_pk_bf16(Uc[0], Uc[1]); ub.y = cvt_pk_bf16(Uc[2], Uc[3]);
    Yc = CS_M16(o.arb, ub, Yc);
#pragma unroll
    for (int mt = 0; mt < 4; ++mt) zacc[mt] = CS_M16(o.bh[mt], ub, zz[mt]);
#undef CS_M32
#undef CS_M16
    return Yc;
}
template <int z>
__device__ __forceinline__ void scan_phase_z(const Frame& F, const Args& a) {
    unsigned char* ws = a.ws;
    const int seq = F.vcu >> 2, ig = F.vcu & 3;
    const int b = (seq >> 3) & 3, h = seq & 7;
    const size_t mb = (size_t)b * T;
    const int lane = F.lane, wave = F.wave, fr = lane & 15, fg = lane >> 4;
    constexpr int NCK = T / 16;
    volatile LAS unsigned* flg = (volatile LAS unsigned*)(F.lds + CS_FLAG);
    if (F.tid < 16) flg[F.tid] = 0u;
    __syncthreads();
    const int o16 = fr * 32 + fg * 8;
#define CS_M32(A_, B_, C_) __builtin_amdgcn_mfma_f32_16x16x32_bf16(A_, B_, C_, 0, 0, 0)
#define CS_M16(A_, B_, C_) __builtin_amdgcn_mfma_f32_16x16x16bf16_1k(__builtin_bit_cast(s16x4, A_), __builtin_bit_cast(s16x4, B_), C_, 0, 0, 0)
    if (wave == 0) {
        __builtin_amdgcn_s_setprio(3);
        bf16* yout = (bf16*)(ws + WS_Y) + (size_t)z * M * CW + h * 64 + ig * 16 + fr;
        f32x4 zacc[4];
#pragma unroll
        for (int mt = 0; mt < 4; ++mt) zacc[mt] = (f32x4){0.f, 0.f, 0.f, 0.f};
        ChainOps opA, opB;
#define CS_READY(nn) do { unsigned sp_ = 0; while (flg[(nn) & (CS_R - 1)] != (unsigned)((nn) + 1)) { __builtin_amdgcn_s_sleep(1); if (++sp_ > (1u << 24)) break; } __builtin_amdgcn_fence(__ATOMIC_ACQUIRE, "workgroup"); } while (0)
#define CS_HANDBACK(nn) do { asm volatile("s_waitcnt lgkmcnt(0)" ::: "memory"); if (lane == 0) flg[8] = (unsigned)((nn) + 1); asm volatile("" ::: "memory"); } while (0)
#define CS_YSTORE(nn, Y_) do { asm volatile("s_waitcnt vmcnt(24)" ::: "memory"); _Pragma("unroll") for (int rr = 0; rr < 4; ++rr) { const int q_ = 16 * (nn) + 4 * fg + rr, t_ = z ? (T - 1 - q_) : q_; yout[(mb + t_) * CW] = f2bf((Y_)[rr]); } } while (0)
        CS_READY(0); chain_load(F.lds, fr, fg, opA);
#pragma unroll 1
        for (int n = 0; n < NCK; n += 2) {
            CS_READY(n + 1); CS_HANDBACK(n);
            chain_load(F.lds + ((n + 1) & (CS_R - 1)) * CS_SLOT, fr, fg, opB);
            { const f32x4 Yc = chain_compute(opA, zacc); CS_YSTORE(n, Yc); }
            if (n + 2 < NCK) CS_READY(n + 2);
            CS_HANDBACK(n + 1);
            if (n + 2 < NCK) chain_load(F.lds + ((n + 2) & (CS_R - 1)) * CS_SLOT, fr, fg, opA);
            { const f32x4 Yc = chain_compute(opB, zacc); CS_YSTORE(n + 1, Yc); }
        }
#undef CS_READY
#undef CS_HANDBACK
#undef CS_YSTORE
        __builtin_amdgcn_s_setprio(0);
    } else {
        const int pi = wave - 1;
        LAS unsigned char* scr = F.lds + CS_SCR + pi * CS_SCRW;
        LAS bf16* KT = (LAS bf16*)scr; LAS bf16* BT = (LAS bf16*)(scr + 2304);
        const bf16* gw_ = (const bf16*)(ws + WS_DECAY) + (size_t)z * M * CW + h * 64;
        const bf16* gkk = (const bf16*)(ws + WS_KK) + h * 64;
        const bf16* gak = (const bf16*)(ws + WS_AKK) + (size_t)z * M * CW + h * 64;
        const bf16* gk = (const bf16*)(ws + WS_KDIR) + (size_t)z * M * CW + h * 64;
        const bf16* gr = (const bf16*)(ws + WS_R) + h * 64;
        const bf16* gv = (const bf16*)(ws + WS_V) + h * 64 + ig * 16;
        unsigned nw[16], nkk[16], nak[16], nk[16], nr[16], nv[4];
        constexpr long RSTEP = z ? -(long)CW : (long)CW;
#define CS_FETCH_A(nn) do { if ((nn) < NCK) { const size_t m0_ = (mb + (z ? (T - 1 - 16 * (nn)) : 16 * (nn))) * CW + lane; const bf16* pw_ = gw_ + m0_; const bf16* pkk_ = gkk + m0_; \
            _Pragma("unroll") for (int tt = 0; tt < 16; ++tt) { nw[tt] = pw_[tt * RSTEP]; nkk[tt] = pkk_[tt * RSTEP]; } } } while (0)
#define CS_FETCH_B(nn) do { if ((nn) < NCK) { asm volatile("s_waitcnt vmcnt(30)" ::: "memory"); const size_t m0_ = (mb + (z ? (T - 1 - 16 * (nn)) : 16 * (nn))) * CW + lane; const bf16* pak_ = gak + m0_; const bf16* pk_ = gk + m0_; \
            _Pragma("unroll") for (int tt = 0; tt < 16; ++tt) { nak[tt] = pak_[tt * RSTEP]; nk[tt] = pk_[tt * RSTEP]; } } } while (0)
#define CS_FETCH_C(nn) do { if ((nn) < NCK) { asm volatile("s_waitcnt vmcnt(30)" ::: "memory"); const size_t m0_ = (mb + (z ? (T - 1 - 16 * (nn)) : 16 * (nn))) * CW + lane; const bf16* pr_ = gr + m0_; \
            _Pragma("unroll") for (int tt = 0; tt < 16; ++tt) nr[tt] = pr_[tt * RSTEP]; \
            const bf16* pv_ = gv + (mb + (z ? (T - 1 - 16 * (nn) - fg) : 16 * (nn) + fg)) * CW + fr; \
            _Pragma("unroll") for (int q4 = 0; q4 < 4; ++q4) nv[q4] = pv_[4 * q4 * RSTEP]; } } while (0)
        CS_FETCH_A(pi); CS_FETCH_B(pi); CS_FETCH_C(pi);
#pragma unroll 1
        for (int n = pi; n < NCK; n += 7) {
            const int slot = n & (CS_R - 1);
            float wv[16], kkv[16], akv[16], kv[16], rv[16], vq[4];
#pragma unroll
            for (int tt = 0; tt < 16; ++tt) { unsigned x0 = nw[tt], x1 = nkk[tt], x2 = nak[tt], x3 = nk[tt], x4 = nr[tt];
                asm volatile("" : "+v"(x0), "+v"(x1), "+v"(x2), "+v"(x3), "+v"(x4));
                wv[tt] = __uint_as_float(x0 << 16); kkv[tt] = __uint_as_float(x1 << 16); akv[tt] = __uint_as_float(x2 << 16); kv[tt] = __uint_as_float(x3 << 16); rv[tt] = __uint_as_float(x4 << 16); }
#pragma unroll
            for (int q4 = 0; q4 < 4; ++q4) { unsigned x0 = nv[q4]; asm volatile("" : "+v"(x0)); vq[q4] = __uint_as_float(x0 << 16); }
            CS_FETCH_A(n + 7);
            { unsigned sp = 0; while ((int)flg[8] < n - (CS_R - 3)) { __builtin_amdgcn_s_sleep(2); if (++sp > (1u << 24)) break; } }
            __builtin_amdgcn_fence(__ATOMIC_ACQUIRE, "workgroup");
            LAS unsigned char* sl = F.lds + slot * CS_SLOT;
            float P[16];
            P[0] = wv[0];
#pragma unroll
            for (int tt = 1; tt < 16; ++tt) P[tt] = P[tt - 1] * wv[tt];
            const float PL = P[15];
            float khat[16], bhat[16];
#pragma unroll
            for (int tt = 0; tt < 16; ++tt) {
                const float pm1 = tt ? P[tt - 1] : 1.0f, inv = __builtin_amdgcn_rcpf(P[tt]);
                const float at = kkv[tt] * pm1, rt = rv[tt] * P[tt], kt = kv[tt] * inv, bt = -akv[tt] * inv;
                khat[tt] = kt * PL; bhat[tt] = bt * PL;
                { const unsigned w_ = cvt_pk_bf16(at, rt); *(LAS bf16*)(sl + CS_AT + (tt * CS_LD + lane) * 2) = (bf16)w_; *(LAS bf16*)(sl + CS_RT + (tt * CS_LD + lane) * 2) = (bf16)(w_ >> 16); }
                { const unsigned w_ = cvt_pk_bf16(kt, bt); KT[tt * CS_LD + lane] = (bf16)w_; BT[tt * CS_LD + lane] = (bf16)(w_ >> 16); }
            }
            CS_FETCH_B(n + 7);
            { u32x4 o0, o1;
              o0.x = cvt_pk_bf16(khat[0], khat[1]); o0.y = cvt_pk_bf16(khat[2], khat[3]); o0.z = cvt_pk_bf16(khat[4], khat[5]); o0.w = cvt_pk_bf16(khat[6], khat[7]);
              o1.x = cvt_pk_bf16(khat[8], khat[9]); o1.y = cvt_pk_bf16(khat[10], khat[11]); o1.z = cvt_pk_bf16(khat[12], khat[13]); o1.w = cvt_pk_bf16(khat[14], khat[15]);
              *(LAS u32x4*)(sl + CS_KHT + lane * 32) = o0; *(LAS u32x4*)(sl + CS_KHT + lane * 32 + 16) = o1;
              o0.x = cvt_pk_bf16(bhat[0], bhat[1]); o0.y = cvt_pk_bf16(bhat[2], bhat[3]); o0.z = cvt_pk_bf16(bhat[4], bhat[5]); o0.w = cvt_pk_bf16(bhat[6], bhat[7]);
              o1.x = cvt_pk_bf16(bhat[8], bhat[9]); o1.y = cvt_pk_bf16(bhat[10], bhat[11]); o1.z = cvt_pk_bf16(bhat[12], bhat[13]); o1.w = cvt_pk_bf16(bhat[14], bhat[15]);
              *(LAS u32x4*)(sl + CS_BHT + lane * 32) = o0; *(LAS u32x4*)(sl + CS_BHT + lane * 32 + 16) = o1; }
            *(LAS float*)(sl + CS_PL + lane * 4) = PL;
#pragma unroll
            for (int q4 = 0; q4 < 4; ++q4) *(LAS bf16*)(sl + CS_VT + (fr * 16 + fg + 4 * q4) * 2) = f2bf(vq[q4]);
            asm volatile("s_waitcnt lgkmcnt(0)" ::: "memory");
            bf16x8 af[2], rf[2], kf[2], bf_[2];
#pragma unroll
            for (int ks = 0; ks < 2; ++ks) { af[ks] = *(const LAS bf16x8*)(sl + CS_AT + (fr * CS_LD + 32 * ks + 8 * fg) * 2); rf[ks] = *(const LAS bf16x8*)(sl + CS_RT + (fr * CS_LD + 32 * ks + 8 * fg) * 2);
                kf[ks] = *(const LAS bf16x8*)(KT + fr * CS_LD + 32 * ks + 8 * fg); bf_[ks] = *(const LAS bf16x8*)(BT + fr * CS_LD + 32 * ks + 8 * fg); }
            const f32x4 zero4 = {0.f, 0.f, 0.f, 0.f};
            f32x4 Xc = zero4, Xt = zero4, AakT = zero4, ArbT = zero4, ArkT = zero4;
#pragma unroll
            for (int ks = 0; ks < 2; ++ks) { Xc = CS_M32(af[ks], bf_[ks], Xc); Xt = CS_M32(bf_[ks], af[ks], Xt);
                AakT = CS_M32(kf[ks], af[ks], AakT); ArbT = CS_M32(bf_[ks], rf[ks], ArbT); ArkT = CS_M32(kf[ks], rf[ks], ArkT); }
            CS_FETCH_C(n + 7);
            f32x4 S1;
#pragma unroll
            for (int rr = 0; rr < 4; ++rr) { const int q = 4 * fg + rr;
                Xc[rr] = (fr < q) ? Xc[rr] : 0.f; Xt[rr] = (q < fr) ? Xt[rr] : 0.f; S1[rr] = Xt[rr] + ((q == fr) ? 1.0f : 0.f);
                AakT[rr] = (q < fr) ? AakT[rr] : 0.f; ArkT[rr] = (q <= fr) ? ArkT[rr] : 0.f; ArbT[rr] = (q <= fr) ? ArbT[rr] : 0.f; }
            { u32x2 w; w.x = cvt_pk_bf16(AakT[0], AakT[1]); w.y = cvt_pk_bf16(AakT[2], AakT[3]); *(LAS u32x2*)(sl + CS_AAK + o16) = w;
              w.x = cvt_pk_bf16(ArkT[0], ArkT[1]); w.y = cvt_pk_bf16(ArkT[2], ArkT[3]); *(LAS u32x2*)(sl + CS_ARK + o16) = w;
              w.x = cvt_pk_bf16(ArbT[0], ArbT[1]); w.y = cvt_pk_bf16(ArbT[2], ArbT[3]); *(LAS u32x2*)(sl + CS_ARB + o16) = w; }
#define CS_PK(v) ((u32x2){cvt_pk_bf16((v)[0], (v)[1]), cvt_pk_bf16((v)[2], (v)[3])})
            const u32x2 xc = CS_PK(Xc), xt = CS_PK(Xt), s1 = CS_PK(S1);
            const f32x4 X2c = CS_M16(xt, xc, zero4), X2t = CS_M16(xc, xt, zero4);
            const u32x2 x2c = CS_PK(X2c), x2t = CS_PK(X2t);
            const f32x4 S2 = CS_M16(x2c, s1, S1);
            const f32x4 X4c = CS_M16(x2t, x2c, zero4), X4t = CS_M16(x2c, x2t, zero4);
            const u32x2 x4c = CS_PK(X4c), x4t = CS_PK(X4t), s2 = CS_PK(S2);
            const f32x4 S4 = CS_M16(x4c, s2, S2);
            const f32x4 X8c = CS_M16(x4t, x4c, zero4);
            const u32x2 x8c = CS_PK(X8c), s4 = CS_PK(S4);
            const f32x4 S8 = CS_M16(x8c, s4, S4);
            *(LAS u32x2*)(sl + CS_TT + o16) = CS_PK(S8);
#undef CS_PK
            asm volatile("s_waitcnt lgkmcnt(0)" ::: "memory");
            __builtin_amdgcn_fence(__ATOMIC_RELEASE, "workgroup");
            if (lane == 0) flg[slot] = (unsigned)(n + 1);
        }
#undef CS_FETCH_A
#undef CS_FETCH_B
#undef CS_FETCH_C
    }
#undef CS_M32
#undef CS_M16
    __syncthreads();
}

__device__ __forceinline__ void scan_phase(const Frame& F, const Args& a) {
    const int seq = F.vcu >> 2;
    if (seq >= 64) return;
    if (seq >> 5) scan_phase_z<1>(F, a); else scan_phase_z<0>(F, a);
}

__device__ __forceinline__ void combine_phase(const Frame& F, const Args& a) {
    unsigned char* ws = a.ws;
    const bf16* att = (const bf16*)(ws + WS_ATT); const bf16* rr = (const bf16*)(ws + WS_R); const bf16* vv = (const bf16*)(ws + WS_V);
    const bf16* kd = (const bf16*)(ws + WS_KDIR); const bf16* gg = (const bf16*)(ws + WS_G); const bf16* y = (const bf16*)(ws + WS_Y);
    bf16* mix = (bf16*)(ws + WS_MIX);
    const float* anw = a.in[4]; const float* r_k = a.in[14]; const float* ln_w = a.in[15]; const float* ln_b = a.in[16];
    const int lane = F.lane, c0 = 8 * lane;
    float nw[8], rk[8], lw[8], lb[8];
#pragma unroll
    for (int i = 0; i < 8; ++i) { nw[i] = anw[c0 + i]; rk[i] = r_k[c0 + i]; lw[i] = ln_w[c0 + i]; lb[i] = ln_b[c0 + i]; }
    const int gw = F.vcu * 8 + F.wave, NGW = F.G * 8;
#pragma unroll 2
    for (int m = gw; m < M; m += NGW) {
        const size_t o = (size_t)m * CW + c0;
        float f[8];
        unpack8(*(const u32x4*)(att + o), f);
        float ss = 0.f;
#pragma unroll
        for (int i = 0; i < 8; ++i) ss += f[i] * f[i];
        const float rs = rsqrtf(wave_sum(ss) * (1.f / CW) + RMS_EPS);
#pragma unroll
        for (int i = 0; i < 8; ++i) f[i] = f[i] * rs * nw[i];
        *(u32x4*)(mix + (size_t)m * D + c0) = pack8(f);
        float yv[8], yw[8];
        unpack8(*(const u32x4*)(y + o), yv); unpack8(*(const u32x4*)(y + (size_t)M * CW + o), yw);
#pragma unroll
        for (int i = 0; i < 8; ++i) yv[i] += yw[i];
        float s1 = 0.f;
#pragma unroll
        for (int i = 0; i < 8; ++i) s1 += yv[i];
        s1 += __shfl_xor(s1, 1); s1 += __shfl_xor(s1, 2); s1 += __shfl_xor(s1, 4);
        const float mean = s1 * (1.f / 64.f);
        float s2 = 0.f;
#pragma unroll
        for (int i = 0; i < 8; ++i) { yv[i] -= mean; s2 += yv[i] * yv[i]; }
        s2 += __shfl_xor(s2, 1); s2 += __shfl_xor(s2, 2); s2 += __shfl_xor(s2, 4);
        const float rstd = rsqrtf(s2 * (1.f / 64.f) + GN_EPS);
        float rf[8], k0[8], k1[8], vf[8], gf[8];
        unpack8(*(const u32x4*)(rr + o), rf); unpack8(*(const u32x4*)(kd + o), k0); unpack8(*(const u32x4*)(kd + (size_t)M * CW + o), k1);
        unpack8(*(const u32x4*)(vv + o), vf); unpack8(*(const u32x4*)(gg + o), gf);
        float cf = 0.f;
#pragma unroll
        for (int i = 0; i < 8; ++i) cf += rf[i] * (k0[i] + k1[i]) * rk[i];
        cf += __shfl_xor(cf, 1); cf += __shfl_xor(cf, 2); cf += __shfl_xor(cf, 4);
#pragma unroll
        for (int i = 0; i < 8; ++i) f[i] = (yv[i] * rstd * lw[i] + lb[i] + cf * vf[i]) * gf[i];
        *(u32x4*)(mix + (size_t)m * D + CW + c0) = pack8(f);
    }
}

constexpr int RT_PITCH = 1032, RT_WH = 0, RT_WL = 32 * RT_PITCH * 2, RT_HIST = 2 * RT_WL, RT_EL = RT_HIST + 256;
__device__ __forceinline__ void router_phase(const Frame& F, const Args& a) {
    unsigned char* ws = a.ws;
    const bf16* hbuf = (const bf16*)(ws + WS_H); unsigned char* hn2 = ws + WS_HN2;
    int* eidx = (int*)(ws + WS_EIDX); float* gate = (float*)(ws + WS_GATE); int* rank = (int*)(ws + WS_RANK);
    unsigned* ctl = (unsigned*)(ws + WS_CTL);
    const float* n2w = a.in[18]; const float* rw = a.in[19]; const float* rb = a.in[20];
    LAS bf16* wh = (LAS bf16*)(F.lds + RT_WH); LAS bf16* wl = (LAS bf16*)(F.lds + RT_WL); LAS int* hist = (LAS int*)(F.lds + RT_HIST); LAS int* eL = (LAS int*)(F.lds + RT_EL);
    { f32x4 tmp[16];
#pragma unroll
      for (int j = 0; j < 16; ++j) tmp[j] = *((const f32x4*)rw + F.tid + 512 * j);
#pragma unroll
      for (int j = 0; j < 16; ++j) { const int q = F.tid + 512 * j, d = q >> 3, e0 = 4 * (q & 7);
#pragma unroll
          for (int i = 0; i < 4; ++i) { const float w = tmp[j][i]; const unsigned hb = cvt_pk_bf16(w, 0.f) & 0xffffu; const float lo = w - __uint_as_float(hb << 16);
              wh[(e0 + i) * RT_PITCH + d] = (bf16)hb; wl[(e0 + i) * RT_PITCH + d] = (bf16)cvt_pk_bf16(lo, 0.f); } } }
    if (F.tid < 32) hist[F.tid] = 0;
    __syncthreads();
    const int lane = F.lane, tk = lane & 15, g = lane >> 4;
    const int blk = F.vcu;
    const int m = blk * 128 + F.wave * 16 + tk;
    const bf16* hrow = hbuf + (size_t)m * D + 8 * g;
    float ss = 0.f;
#pragma unroll 8
    for (int ks = 0; ks < 32; ++ks) { float xf[8]; unpack8(*(const u32x4*)(hrow + 32 * ks), xf);
        ss += (xf[0] * xf[0] + xf[1] * xf[1]) + (xf[2] * xf[2] + xf[3] * xf[3]) + (xf[4] * xf[4] + xf[5] * xf[5]) + (xf[6] * xf[6] + xf[7] * xf[7]); }
    ss += __shfl_xor(ss, 16); ss += __shfl_xor(ss, 32);
    const float rs = rsqrtf(ss * (1.f / D) + RMS_EPS);
    f32x4 acc0 = {0.f, 0.f, 0.f, 0.f}, acc1 = acc0;
    unsigned char* hrow8 = hn2 + (size_t)m * D + 8 * g;
    const LAS bf16* wh0 = wh + tk * RT_PITCH + 8 * g; const LAS bf16* wl0 = wl + tk * RT_PITCH + 8 * g;
#pragma unroll 4
    for (int ks = 0; ks < 32; ++ks) {
        float xf[8]; unpack8(*(const u32x4*)(hrow + 32 * ks), xf);
        const f32x4 x0 = {xf[0], xf[1], xf[2], xf[3]}, x1 = {xf[4], xf[5], xf[6], xf[7]};
        const f32x4 n0 = *(const f32x4*)(n2w + 32 * ks + 8 * g), n1 = *(const f32x4*)(n2w + 32 * ks + 8 * g + 4);
        const f32x4 y0 = x0 * rs * n0, y1 = x1 * rs * n1;
        { u32x2 w8; w8.x = pk4_fp8(y0.x * F8_SX, y0.y * F8_SX, y0.z * F8_SX, y0.w * F8_SX); w8.y = pk4_fp8(y1.x * F8_SX, y1.y * F8_SX, y1.z * F8_SX, y1.w * F8_SX); *(u32x2*)(hrow8 + 32 * ks) = w8; }
        union { u32x4 w; bf16x8 h8; } xh, xl;
        xh.w.x = cvt_pk_bf16(y0.x, y0.y); xh.w.y = cvt_pk_bf16(y0.z, y0.w); xh.w.z = cvt_pk_bf16(y1.x, y1.y); xh.w.w = cvt_pk_bf16(y1.z, y1.w);
        xl.w.x = cvt_pk_bf16(y0.x - bflo(xh.w.x), y0.y - bfhi(xh.w.x)); xl.w.y = cvt_pk_bf16(y0.z - bflo(xh.w.y), y0.w - bfhi(xh.w.y));
        xl.w.z = cvt_pk_bf16(y1.x - bflo(xh.w.z), y1.y - bfhi(xh.w.z)); xl.w.w = cvt_pk_bf16(y1.z - bflo(xh.w.w), y1.w - bfhi(xh.w.w));
        const bf16x8 a0h = *(const LAS bf16x8*)(wh0 + 32 * ks), a1h = *(const LAS bf16x8*)(wh0 + 16 * RT_PITCH + 32 * ks);
        const bf16x8 a0l = *(const LAS bf16x8*)(wl0 + 32 * ks), a1l = *(const LAS bf16x8*)(wl0 + 16 * RT_PITCH + 32 * ks);
        acc0 = __builtin_amdgcn_mfma_f32_16x16x32_bf16(a0h, xh.h8, acc0, 0, 0, 0); acc1 = __builtin_amdgcn_mfma_f32_16x16x32_bf16(a1h, xh.h8, acc1, 0, 0, 0);
        acc0 = __builtin_amdgcn_mfma_f32_16x16x32_bf16(a0h, xl.h8, acc0, 0, 0, 0); acc1 = __builtin_amdgcn_mfma_f32_16x16x32_bf16(a1h, xl.h8, acc1, 0, 0, 0);
        acc0 = __builtin_amdgcn_mfma_f32_16x16x32_bf16(a0l, xh.h8, acc0, 0, 0, 0); acc1 = __builtin_amdgcn_mfma_f32_16x16x32_bf16(a1l, xh.h8, acc1, 0, 0, 0);
    }
    float lv[8]; int li[8];
    { const f32x4 b0 = *(const f32x4*)(rb + 4 * g), b1 = *(const f32x4*)(rb + 16 + 4 * g);
#pragma unroll
      for (int i = 0; i < 4; ++i) { lv[i] = acc0[i] + b0[i]; li[i] = 4 * g + i; lv[4 + i] = acc1[i] + b1[i]; li[4 + i] = 16 + 4 * g + i; } }
    float tv[4]; int ti[4];
#pragma unroll
    for (int kx = 0; kx < 4; ++kx) {
        float bv = lv[0]; int bi = li[0];
#pragma unroll
        for (int i = 1; i < 8; ++i) { const bool gt = lv[i] > bv; bv = gt ? lv[i] : bv; bi = gt ? li[i] : bi; }
#pragma unroll
        for (int o = 16; o < 64; o <<= 1) { const float ov = __shfl_xor(bv, o); const int oi = __shfl_xor(bi, o); const bool tko = (ov > bv) || (ov == bv && oi < bi); bv = tko ? ov : bv; bi = tko ? oi : bi; }
        tv[kx] = bv; ti[kx] = bi;
#pragma unroll
        for (int i = 0; i < 8; ++i) lv[i] = (li[i] == bi) ? -3.0e38f : lv[i];
    }
    if (g == 0) {
        const float e0 = 1.0f, e1 = __expf(tv[1] - tv[0]), e2 = __expf(tv[2] - tv[0]), e3 = __expf(tv[3] - tv[0]);
        const float is = 1.0f / (e0 + e1 + e2 + e3);
        const float gs[4] = {e0 * is, e1 * is, e2 * is, e3 * is};
#pragma unroll
        for (int kx = 0; kx < 4; ++kx) { eidx[m * 4 + kx] = ti[kx]; gate[m * 4 + kx] = gs[kx]; eL[(m - blk * 128) * 4 + kx] = ti[kx]; }
    }
    __syncthreads();
    { const int t = F.tid, e = eL[t]; int rk = 0;
      for (int u = 0; u < t; ++u) rk += (eL[u] == e) ? 1 : 0;
      rank[(blk * 128) * 4 + t] = rk;
      __hip_atomic_fetch_add(&hist[e], 1, __ATOMIC_RELAXED, __HIP_MEMORY_SCOPE_WORKGROUP); }
    __syncthreads();
    if (F.tid < 32) ctl[CW_CNT + blk * 32 + F.tid] = (unsigned)hist[F.tid];
}

__device__ __forceinline__ void dispatch_phase(const Frame& F, const Args& a) {
    unsigned char* ws = a.ws;
    unsigned* ctl = (unsigned*)(ws + WS_CTL);
    const int* eidx = (const int*)(ws + WS_EIDX); const int* rank = (const int*)(ws + WS_RANK); int* dest = (int*)(ws + WS_DEST);
    LAS int* part = (LAS int*)F.lds;
    LAS int* tot = part + 1024;
    const int blk = F.vcu, G = F.G;
    { const int e = F.tid & 31, pt = F.tid >> 5; int s = 0, sb = 0;
      if (G == 256) { int cv[16];
#pragma unroll
          for (int q = 0; q < 16; ++q) cv[q] = (int)ld_u32_agent(ctl + CW_CNT + (pt + 16 * q) * 32 + e);
#pragma unroll
          for (int q = 0; q < 16; ++q) { s += cv[q]; if (pt + 16 * q < blk) sb += cv[q]; } }
      else for (int bb = pt; bb < G; bb += 16) { const int cval = (int)ld_u32_agent(ctl + CW_CNT + bb * 32 + e); s += cval; if (bb < blk) sb += cval; }
      part[pt * 32 + e] = s; part[512 + pt * 32 + e] = sb; }
    __syncthreads();
    if (F.tid < 32) { int s = 0, sb = 0;
        for (int pt = 0; pt < 16; ++pt) { s += part[pt * 32 + F.tid]; sb += part[512 + pt * 32 + F.tid]; }
        tot[F.tid] = s; tot[32 + F.tid] = sb; tot[96 + F.tid] = (s + 255) & ~255; }
    __syncthreads();
    if (F.tid == 0) { int ps = 0; for (int e = 0; e < 32; ++e) { tot[64 + e] = ps; ps += tot[96 + e]; }
        tot[128] = ps >> 8; }
    __syncthreads();
    if (blk == 0) {
        if (F.tid == 0) ctl[CW_NT] = (unsigned)tot[128];
        for (int e = F.tid >> 4; e < 32; e += 32) { const int t0 = tot[64 + e] >> 8, nt = tot[96 + e] >> 8; for (int i = F.tid & 15; i < nt; i += 16) ctl[CW_TEXP + t0 + i] = (unsigned)e; }
    }
    const int lane = F.lane;
    const int mw = blk * 128 + F.wave * 16;
    int* rowtok = (int*)(ws + WS_ROWTOK);
    { const int e = eidx[mw * 4 + lane]; const int dl = tot[64 + e] + tot[32 + e] + rank[mw * 4 + lane]; dest[mw * 4 + lane] = dl; rowtok[dl] = mw + (lane >> 2); }
    { const int e = blk & 31, pt = blk >> 5, np = G >> 5; const int r0 = tot[64 + e] + tot[e], r1 = tot[64 + e] + tot[96 + e];
      if (np > 0) for (int r = r0 + pt * 512 + F.tid; r < r1; r += np * 512) rowtok[r] = 0; }
}

__device__ __forceinline__ void final_phase(const Frame& F, const Args& a) {
    unsigned char* ws = a.ws;
    const bf16* hbuf = (const bf16*)(ws + WS_H); const unsigned char* ybuf = ws + WS_YBUF;
    const int* dest = (const int*)(ws + WS_DEST); const float* gate = (const float*)(ws + WS_GATE);
    const float* fw = a.in[25]; float* out = a.out;
    const int lane = F.lane;
    f32x4 wn[4];
#pragma unroll
    for (int j = 0; j < 4; ++j) wn[j] = *((const f32x4*)fw + lane + 64 * j);
    const int gw = F.vcu * 8 + F.wave, NGW = F.G * 8;
    const int per = M / NGW;
    const int mw = gw * per;
    int dl = 0; float gl = 0.f;
    if (lane < 4 * per && per <= 16) { dl = dest[mw * 4 + lane]; gl = gate[mw * 4 + lane]; }
#pragma unroll 2
    for (int i = 0; i < per; ++i) {
        const int m = mw + i;
        const u32x2* hr = (const u32x2*)(hbuf + (size_t)m * D) + lane;
        f32x4 v[4];
#pragma unroll
        for (int j = 0; j < 4; ++j) { const u32x2 w = hr[64 * j]; v[j] = (f32x4){bflo(w.x), bfhi(w.x), bflo(w.y), bfhi(w.y)}; }
#pragma unroll
        for (int kx = 0; kx < 4; ++kx) {
            const int d = per <= 16 ? __shfl(dl, 4 * i + kx) : dest[m * 4 + kx]; const float gt = (per <= 16 ? __shfl(gl, 4 * i + kx) : gate[m * 4 + kx]) * (1.0f / F8_SY);
            const unsigned* yr = (const unsigned*)(ybuf + (size_t)d * D) + lane;
#pragma unroll
            for (int j = 0; j < 4; ++j) { const unsigned w = yr[64 * j]; const f32x2 lo = __builtin_amdgcn_cvt_pk_f32_fp8((int)w, false), hi = __builtin_amdgcn_cvt_pk_f32_fp8((int)w, true);
                v[j].x += gt * lo.x; v[j].y += gt * lo.y; v[j].z += gt * hi.x; v[j].w += gt * hi.y; }
        }
        float s = 0.f;
#pragma unroll
        for (int j = 0; j < 4; ++j) s += (v[j].x * v[j].x + v[j].y * v[j].y) + (v[j].z * v[j].z + v[j].w * v[j].w);
        const float rs = rsqrtf(wave_sum(s) * (1.f / D) + RMS_EPS);
        f32x4* orow = (f32x4*)(out + (size_t)m * D) + lane;
#pragma unroll
        for (int j = 0; j < 4; ++j) orow[64 * j] = v[j] * rs * wn[j];
    }
}

__global__ void __launch_bounds__(512, 2) fwd_megakernel(Args args) {
    extern __shared__ __attribute__((aligned(16))) unsigned char lds_raw[];
    Frame F;
    F.lds = (LAS unsigned char*)lds_raw;
    F.tid = threadIdx.x; F.lane = F.tid & 63; F.wave = __builtin_amdgcn_readfirstlane(F.tid >> 6);
    F.G = gridDim.x; { const int bx = blockIdx.x; F.vcu = (F.G % 8 == 0) ? (bx % 8) * (F.G / 8) + bx / 8 : bx; }
    unsigned char* ws = args.ws;
    const int lo = args.ph_lo, hi = args.ph_hi;
#define IN(k) (lo <= (k) && (k) < hi)
#if MK_SPLIT
#define SEAM(k) do { } while (0)
#else
    cg::grid_group grid = cg::this_grid();
    { volatile LAS unsigned* st = (volatile LAS unsigned*)(F.lds + LDS_MISC); if (F.tid < 2) st[F.tid] = 0u; __syncthreads(); }
    const XcdBarrier xbar = xcd_barrier_post((unsigned*)(ws + WS_CTL) + CW_BAR, (volatile LAS unsigned*)(F.lds + LDS_MISC));
    if (lo < 0) grid.sync();
#define SEAM(k) do { if (IN(k) && IN((k) + 1)) xcd_barrier(xbar); } while (0)
#endif
#define REP2(k) if constexpr (((MK_REPEAT >> (k)) & 1) != 0)
#define PH1 { pg8::Gemm g{(const bf16*)(ws + WS_HN), (const bf16*)(ws + WS_WINT), 1024, nullptr, 0, nullptr}; \
        pg8::StaticOrder S; S.init(M / 256, NPROJ_PAD / 256, F.G, (int)blockIdx.x); \
        pg8::EpiProj E{(bf16*)(ws + WS_Q), (bf16*)(ws + WS_K), (bf16*)(ws + WS_VT), (bf16*)(ws + WS_P)}; \
        pg8::gemm_phase<pg8::EpiProj, true, true>(F.lds, g, S, E); }
#define PH5 { pg8::Gemm g{(const bf16*)(ws + WS_MIX), (const bf16*)(ws + WS_WOT), 1024, nullptr, 0, nullptr}; \
        pg8::StaticOrder S; S.init(M / 256, D / 256, F.G, (int)blockIdx.x); \
        pg8::EpiWo E{args.in[0], (bf16*)(ws + WS_H)}; \
        pg8::gemm_phase<pg8::EpiWo, true, true>(F.lds, g, S, E); }
#define PH8 { const unsigned* ctl = (const unsigned*)(ws + WS_CTL); const int ntile = (int)ld_u32_agent(ctl + CW_NT); \
        pg8::Gemm g{(const bf16*)(ws + WS_HN2), (const bf16*)(ws + WS_WUPT), 512, ctl + CW_TEXP, (size_t)2048 * 1024, (const int*)(ws + WS_ROWTOK)}; \
        pg8::StaticOrder S; S.init(ntile, 8, F.G, (int)blockIdx.x); \
        pg8::EpiUp E{args.in[22], ws + WS_ACT}; \
        pg8::gemm_phase<pg8::EpiUp, true, true, true, true>(F.lds, g, S, E); }
#define PH9 { const unsigned* ctl = (const unsigned*)(ws + WS_CTL); const int ntile = (int)ld_u32_agent(ctl + CW_NT); \
        pg8::Gemm g{(const bf16*)(ws + WS_ACT), (const bf16*)(ws + WS_WDNT), 512, ctl + CW_TEXP, (size_t)1024 * 1024, nullptr}; \
        pg8::StaticOrder S; S.init(ntile, 4, F.G, (int)blockIdx.x); \
        pg8::EpiDown E{args.in[24], ws + WS_YBUF}; \
        pg8::gemm_phase<pg8::EpiDown, true, true, false, true>(F.lds, g, S, E); }
    if (IN(0)) { p0_prologue(F, args); REP2(0) p0_prologue(F, args); }
    SEAM(0);
    if (IN(1)) { PH1 REP2(1) PH1 }
    SEAM(1);
    if (IN(2)) { prep_phase<true>(F, args); REP2(2) prep_phase<true>(F, args); attn_phase(F, args); REP2(11) attn_phase(F, args); }
    SEAM(2);
    if (IN(3)) { scan_phase(F, args); REP2(3) scan_phase(F, args); }
    SEAM(3);
    if (IN(4)) { combine_phase(F, args); REP2(4) combine_phase(F, args); }
    SEAM(4);
    if (IN(5)) { PH5 REP2(5) PH5 }
    SEAM(5);
    if (IN(6)) { router_phase(F, args); REP2(6) { __syncthreads(); router_phase(F, args); } }
    SEAM(6);
    if (IN(7)) { dispatch_phase(F, args); REP2(7) { __syncthreads(); dispatch_phase(F, args); } }
    SEAM(7);
    if (IN(8)) { PH8 REP2(8) PH8 }
    SEAM(8);
    if (IN(9)) { PH9 REP2(9) PH9 }
    SEAM(9);
    if (IN(10)) { final_phase(F, args); REP2(10) final_phase(F, args); }
#undef IN
#undef SEAM
}

extern "C" void kernel_launch(void* const* d_in, const int* in_sizes, int n_in, void* d_out, int out_size, void* d_ws, size_t ws_size, hipStream_t stream) {
    static int grid = 0;
    if (grid == 0) {
        if (n_in != 26 || in_sizes[0] != M * D || out_size != M * D || ws_size < WS_END) { fprintf(stderr, "kernel_launch: unexpected problem (n_in %d, in0 %d, out %d, ws %zu)\n", n_in, n_in > 0 ? in_sizes[0] : -1, out_size, ws_size); grid = -1; return; }
        int dev = 0, cus = 0, per_cu = 0;
        if (hipGetDevice(&dev) != hipSuccess || hipDeviceGetAttribute(&cus, hipDeviceAttributeMultiprocessorCount, dev) != hipSuccess) { grid = -1; return; }
        if (hipFuncSetAttribute((const void*)fwd_megakernel, hipFuncAttributeMaxDynamicSharedMemorySize, LDS_BYTES) != hipSuccess) { fprintf(stderr, "kernel_launch: hipFuncSetAttribute failed\n"); grid = -1; return; }
        if (hipOccupancyMaxActiveBlocksPerMultiprocessor(&per_cu, (const void*)fwd_megakernel, 512, LDS_BYTES) != hipSuccess || per_cu < 1) { fprintf(stderr, "kernel_launch: occupancy query says %d\n", per_cu); per_cu = 1; }
        (void)hipGetLastError();
        grid = cus * 1;
        if (grid != 256) fprintf(stderr, "kernel_launch: note: %d CUs\n", cus);
    }
    if (grid < 0) return;
    if (hipMemsetAsync((char*)d_ws + WS_CTL + (size_t)CW_BAR * 4, 0, XCD_BAR_WORDS * 4, stream) != hipSuccess) { fprintf(stderr, "kernel_launch: memset failed\n"); return; }
    Args a{};
    for (int i = 0; i < 26; ++i) a.in[i] = (const float*)d_in[i];
    a.out = (float*)d_out; a.ws = (unsigned char*)d_ws;
#if MK_SPLIT
    for (int ph = 0; ph < NPHASE; ++ph) { a.ph_lo = ph; a.ph_hi = ph + 1; hipLaunchKernelGGL(fwd_megakernel, dim3(grid), dim3(512), LDS_BYTES, stream, a); }
#else
    a.ph_lo = 0; a.ph_hi = NPHASE;
    void* kargs[] = {&a};
    hipError_t e = hipLaunchCooperativeKernel((const void*)fwd_megakernel, dim3(grid), dim3(512), kargs, LDS_BYTES, stream);
    if (e != hipSuccess) fprintf(stderr, "kernel_launch: cooperative launch failed: %s (grid %d)\n", hipGetErrorString(e), grid);
#endif
}
```

```cpp
#include <hip/hip_runtime.h>
#include <hip/hip_cooperative_groups.h>
#include <cstdio>
#include <cstdint>
namespace cg = cooperative_groups;

#ifndef MK_SPLIT
#define MK_SPLIT 0
#endif

#ifndef MK_REPEAT
#define MK_REPEAT 0
#endif
#define LAS __attribute__((address_space(3)))
typedef unsigned short bf16;
typedef float f32x4 __attribute__((ext_vector_type(4)));
typedef float f32x2 __attribute__((ext_vector_type(2)));
typedef unsigned u32x4 __attribute__((ext_vector_type(4)));
typedef unsigned u32x2 __attribute__((ext_vector_type(2)));
typedef short bf16x8 __attribute__((ext_vector_type(8)));
typedef short s16x4 __attribute__((ext_vector_type(4)));

constexpr int BATCH = 4, T = 8192, D = 1024, M = BATCH * T;
constexpr int NH = 8, HD = 64, CW = 512;
constexpr int SHIFT_W = 1920, NPROJ = 3456, NPROJ_PAD = 3584, PW = 2048;
constexpr int NE = 32, TOPK = 4, DE = 1024;
constexpr int GRIDW = 64, GROWS = 128;
constexpr int P_TILES_MAX = 544, P_ROWS = P_TILES_MAX * 256;
constexpr float RMS_EPS = 1e-5f, GN_EPS = 64e-5f;
constexpr int NPHASE = 11;

constexpr size_t MiB = 1u << 20;
constexpr size_t WS_CTL = 0;
constexpr size_t WS_W2T = 1 * MiB, WS_A2T = WS_W2T + 131072, WS_G2T = WS_A2T + 131072;
constexpr size_t WS_WINT = 2 * MiB, WS_WOT = 9 * MiB, WS_WUPT = 12 * MiB, WS_WDNT = 140 * MiB;
constexpr size_t WS_EIDX = 204 * MiB, WS_GATE = WS_EIDX + 524288, WS_RANK = WS_GATE + 524288, WS_DEST = WS_RANK + 524288, WS_ROWTOK = WS_DEST + 524288;
constexpr size_t WS_R = 208 * MiB, WS_V = 240 * MiB, WS_KK = 272 * MiB, WS_DECAY = 304 * MiB, WS_KDIR = 368 * MiB, WS_AKK = 432 * MiB,
                 WS_G = 496 * MiB, WS_ATT = 528 * MiB;
constexpr size_t WS_Q = 560 * MiB, WS_K = 592 * MiB, WS_VT = 624 * MiB, WS_P = 656 * MiB, WS_HN = 784 * MiB, WS_Y = 848 * MiB;
constexpr size_t WS_MIX = 560 * MiB, WS_H = 752 * MiB, WS_HN2 = 880 * MiB, WS_XBUF = 208 * MiB, WS_ACT = 480 * MiB, WS_YBUF = 208 * MiB;
constexpr size_t WS_END = 976 * MiB;
constexpr int CW_NT = 0, CW_TEXP = 64, CW_CNT = 1024, CW_BAR = 16384;

constexpr int LDS_BYTES = 159744, LDS_MISC = LDS_BYTES - 256;

typedef __bf16 bf16x2_t __attribute__((ext_vector_type(2)));
__device__ __forceinline__ unsigned cvt_pk_bf16(float lo, float hi) { const f32x2 v = {lo, hi}; return __builtin_bit_cast(unsigned, __builtin_convertvector(v, bf16x2_t)); }
typedef int i32x8 __attribute__((ext_vector_type(8)));
typedef int i32x4 __attribute__((ext_vector_type(4)));
#ifndef F8_SCALE1
#define F8_SCALE1 0
#endif
constexpr float F8_SX = 32.0f, F8_SW = 128.0f, F8_SACT = 8.0f, F8_SY = 32.0f;
__device__ __forceinline__ float f8clamp(float v) { return __builtin_amdgcn_fmed3f(v, -448.0f, 448.0f); }
__device__ __forceinline__ unsigned pk4_fp8(float a, float b, float c, float d) { int w = 0; w = __builtin_amdgcn_cvt_pk_fp8_f32(f8clamp(a), f8clamp(b), w, false); w = __builtin_amdgcn_cvt_pk_fp8_f32(f8clamp(c), f8clamp(d), w, true); return (unsigned)w; }
__device__ __forceinline__ float bflo(unsigned u) { return __uint_as_float(u << 16); }
__device__ __forceinline__ float bfhi(unsigned u) { return __uint_as_float(u & 0xffff0000u); }
__device__ __forceinline__ float bf1(bf16 v) { return __uint_as_float(((unsigned)v) << 16); }
__device__ __forceinline__ void unpack8(const u32x4 u, float* f) { f[0] = bflo(u.x); f[1] = bfhi(u.x); f[2] = bflo(u.y); f[3] = bfhi(u.y); f[4] = bflo(u.z); f[5] = bfhi(u.z); f[6] = bflo(u.w); f[7] = bfhi(u.w); }
__device__ __forceinline__ u32x4 pack8(const float* f) { u32x4 o; o.x = cvt_pk_bf16(f[0], f[1]); o.y = cvt_pk_bf16(f[2], f[3]); o.z = cvt_pk_bf16(f[4], f[5]); o.w = cvt_pk_bf16(f[6], f[7]); return o; }
__device__ __forceinline__ float wave_sum(float v) {
#pragma unroll
    for (int o = 1; o < 64; o <<= 1) v += __shfl_xor(v, o);
    return v;
}
__device__ __forceinline__ float sigmoidf_(float x) { return __builtin_amdgcn_rcpf(1.0f + __expf(-x)); }
__device__ __forceinline__ unsigned ld_u32_agent(const unsigned* p) { return __hip_atomic_load(p, __ATOMIC_RELAXED, __HIP_MEMORY_SCOPE_AGENT); }

namespace pg8 {
constexpr int BM = 256, BK = 64, HALF = 128, HTB = HALF * BK * 2, STAGE_BYTES = 8 * HTB, NXCD = 8, WGM = 8;
__host__ __device__ __forceinline__ int lds_byte(int r, int c) { const int st = (r >> 4) * 2 + (c >> 5), rr = r & 15, cc = c & 31, ob = rr * 64 + cc * 2; return st * 1024 + (ob ^ (((ob >> 9) & 1) << 5)); }
__host__ __device__ __forceinline__ void stage_rc(int b, int& R, int& C) { const int st = b / 1024, sb = b % 1024, swz = sb ^ (((sb >> 9) & 1) << 5); R = (st >> 1) * 16 + swz / 64; C = (st & 1) * 32 + (swz % 64) / 2; }
__host__ __device__ __forceinline__ int perm32(int rho) { const int n = rho >> 4, i = rho & 15; return 8 * (i >> 2) + 4 * n + (i & 3); }

struct Unit { int pm, pn, e; };
struct Gemm { const bf16* A; const bf16* Bt; int K; const unsigned* texp; size_t bstride; const int* rowtok; };

struct StaticOrder {
    int nM, nN, nwg, G, c;
    __device__ void init(int nM_, int nN_, int G_, int c_) { nM = nM_; nN = nN_; nwg = nM * nN; G = G_; c = c_; }
    __device__ bool next(int i, Unit& u) const {
        const long L = (long)i * G + c; if (L >= nwg) return false;
        int wgid = (int)L; { const int q = nwg / NXCD, r = nwg % NXCD, xcd = wgid % NXCD, off = wgid / NXCD; wgid = (xcd < r ? xcd * (q + 1) : r * (q + 1) + (xcd - r) * q) + off; }
        const int nig = WGM * nN, gid = wgid / nig, fm = gid * WGM, gsz = (nM - fm) < WGM ? (nM - fm) : WGM;
        u.pm = fm + ((wgid % nig) % gsz); u.pn = (wgid % nig) / gsz; u.e = 0; return true;
    }
};

__device__ __forceinline__ i32x8 cat8(const bf16x8 lo, const bf16x8 hi) { return __builtin_shufflevector(__builtin_bit_cast(i32x4, lo), __builtin_bit_cast(i32x4, hi), 0, 1, 2, 3, 4, 5, 6, 7); }
template <class Epi, bool ALIGN_EPI, bool SP2, bool GATHER = false, bool FP8 = false>
__device__ __forceinline__ void gemm_phase(LAS unsigned char* lds, const Gemm g, const StaticOrder& S, const Epi& E) {
    const int tid = threadIdx.x, wid = __builtin_amdgcn_readfirstlane(tid >> 6), lane = tid & 63, wr = wid >> 2, wc = wid & 3, fr = lane & 15, fq = lane >> 4;
    const int K = g.K, nt = K / BK;
    unsigned voffA[2], voffB[2];
#pragma unroll
    for (int i = 0; i < 2; ++i) { int R, C; stage_rc(tid * 16 + i * 8192, R, C); const int Rb = Epi::PERM ? ((R & ~31) + perm32(R & 31)) : R;
        voffA[i] = (unsigned)(R * K + C) * 2u; voffB[i] = (unsigned)(Rb * K + C) * 2u; }
    unsigned vC[2][2];
#define PG8_GROWS(u, dst) do { _Pragma("unroll") for (int h_ = 0; h_ < 2; ++h_) _Pragma("unroll") for (int i_ = 0; i_ < 2; ++i_) { int R_, C_; stage_rc(tid * 16 + i_ * 8192, R_, C_); \
        dst[h_][i_] = (unsigned)g.rowtok[(u).pm * BM + h_ * HALF + R_] * (unsigned)(K * 2) + (unsigned)(C_ * 2); } } while (0)
    const size_t kstep = (size_t)(BK * 2);
    const size_t hstep = (size_t)HALF * K * 2;
    const size_t tstep = 2 * hstep;
    const unsigned ldsw = (unsigned)wid * 1024u;
    const int aoff = lds_byte(wr * 64 + fr, fq * 8), boff = lds_byte(wc * 32 + fr, fq * 8);
#define PG8_SA(b, h) (((b) * 2 + (h)) * HTB)
#define PG8_SB(b, h) ((4 + (b) * 2 + (h)) * HTB)
#define PG8_STAGE(bufoff, gbase, voff) do { _Pragma("unroll") for (int _i = 0; _i < 2; ++_i) \
        __builtin_amdgcn_global_load_lds((const unsigned*)((const char*)(gbase) + (voff)[_i]), (LAS unsigned*)(lds + (bufoff) + ldsw + _i * 8192), 16, 0, 0); } while (0)
#define PG8_STAGE_A(bufoff, p, h, nx) do { if constexpr (GATHER) { PG8_STAGE(bufoff, p, vC[h]); } else PG8_STAGE(bufoff, (p) + (h) * hstep, voffA); } while (0)
#define PG8_LDA(dst, b, h) do { _Pragma("unroll") for (int m = 0; m < 4; ++m) _Pragma("unroll") for (int k = 0; k < 2; ++k) dst[m][k] = *(const LAS bf16x8*)(lds + PG8_SA(b, h) + aoff + m * 2048 + k * 1024); } while (0)
#define PG8_LDB(dst, b, h) do { _Pragma("unroll") for (int n = 0; n < 2; ++n) _Pragma("unroll") for (int k = 0; k < 2; ++k) dst[n][k] = *(const LAS bf16x8*)(lds + PG8_SB(b, h) + boff + n * 2048 + k * 1024); } while (0)
#define PG8_MMA(ai, bj, At, Bt) do { __builtin_amdgcn_s_setprio(1); \
        if constexpr (FP8) { _Pragma("unroll") for (int m = 0; m < 4; ++m) _Pragma("unroll") for (int n = 0; n < 2; ++n) \
            { const i32x8 b8_ = cat8(Bt[n][0], Bt[n][1]), a8_ = cat8(At[m][0], At[m][1]); asm volatile("v_mfma_f32_16x16x128_f8f6f4 %0, %1, %2, %0" : "+v"(acc[ai][bj][m][n]) : "v"(b8_), "v"(a8_)); } } \
        else { _Pragma("unroll") for (int m = 0; m < 4; ++m) _Pragma("unroll") for (int n = 0; n < 2; ++n) _Pragma("unroll") for (int k = 0; k < 2; ++k) \
            acc[ai][bj][m][n] = __builtin_amdgcn_mfma_f32_16x16x32_bf16(Bt[n][k], At[m][k], acc[ai][bj][m][n], 0, 0, 0); } \
        __builtin_amdgcn_s_setprio(0); } while (0)
#define PG8_WAIT_V(n) asm volatile("s_waitcnt vmcnt(" #n ")" ::: "memory")
#define PG8_WAIT_L(n) asm volatile("s_waitcnt lgkmcnt(" #n ")" ::: "memory")
#define PG8_BAR __builtin_amdgcn_s_barrier()
#define PG8_SCHED __builtin_amdgcn_sched_barrier(0)
#define PG8_UPTR(u, pa, pb) do { unsigned _e = g.texp ? ld_u32_agent(g.texp + (u).pm) : 0u; _e = (unsigned)__builtin_amdgcn_readfirstlane((int)_e); (u).e = (int)_e; \
        pa = GATHER ? (const char*)g.A : (const char*)g.A + (size_t)(u).pm * tstep; pb = (const char*)g.Bt + (size_t)_e * g.bstride + (size_t)(u).pn * tstep; } while (0)
    Unit cur, nxt; int ui = 0;
    if (!S.next(0, cur)) return;
    f32x4 acc[2][2][4][2];
#pragma unroll
    for (int a = 0; a < 2; ++a)
#pragma unroll
        for (int b = 0; b < 2; ++b)
#pragma unroll
            for (int m = 0; m < 4; ++m)
#pragma unroll
                for (int n = 0; n < 2; ++n) acc[a][b][m][n] = (f32x4){0.f, 0.f, 0.f, 0.f};
    bf16x8 At[4][2], B0[2][2], B1[2][2];
    const char* cA; const char* cB;
    PG8_UPTR(cur, cA, cB);
    if constexpr (GATHER) { PG8_GROWS(cur, vC); }
    if constexpr (SP2) {
        PG8_STAGE(PG8_SB(0, 0), cB, voffB); PG8_STAGE(PG8_SB(0, 1), cB + hstep, voffB); PG8_STAGE_A(PG8_SA(0, 0), cA, 0, false); PG8_STAGE_A(PG8_SA(0, 1), cA, 1, false);
        if (wr == 1) PG8_BAR;
        PG8_WAIT_V(2); PG8_BAR;
        PG8_STAGE(PG8_SB(1, 0), cB + kstep, voffB); PG8_STAGE_A(PG8_SA(1, 0), cA + kstep, 0, false); PG8_STAGE(PG8_SB(1, 1), cB + hstep + kstep, voffB);
        PG8_WAIT_V(6); PG8_BAR;
    } else {
        PG8_STAGE(PG8_SB(0, 0), cB, voffB); PG8_STAGE_A(PG8_SA(0, 0), cA, 0, false); PG8_STAGE(PG8_SB(0, 1), cB + hstep, voffB); PG8_STAGE_A(PG8_SA(0, 1), cA, 1, false);
        if (wr == 1) PG8_BAR;
        PG8_WAIT_V(4); PG8_BAR;
        PG8_STAGE(PG8_SB(1, 0), cB + kstep, voffB); PG8_STAGE_A(PG8_SA(1, 0), cA + kstep, 0, false); PG8_STAGE(PG8_SB(1, 1), cB + hstep + kstep, voffB);
        PG8_WAIT_V(6); PG8_BAR;
    }
    for (;;) {
        const bool has_next = S.next(ui + 1, nxt);
        const char* nA = cA; const char* nB = cB;
        if (has_next) PG8_UPTR(nxt, nA, nB);
#pragma unroll 1
        for (int t = 0; t < nt; t += 2) {
            const bool last = (t == nt - 2);
            const char* a1 = cA + (size_t)(t + 1) * kstep;
            const char* a2 = last ? nA : cA + (size_t)(t + 2) * kstep; const char* b2 = last ? nB : cB + (size_t)(t + 2) * kstep;
            const char* a3 = a2 + kstep; const char* b3 = b2 + kstep;
            if constexpr (SP2) {
            PG8_LDB(B0, 0, 0); PG8_LDB(B1, 0, 1); PG8_SCHED; PG8_LDA(At, 0, 0); PG8_STAGE_A(PG8_SA(1, 1), a1, 1, false);
            if constexpr (GATHER) { if (last && has_next) { PG8_GROWS(nxt, vC); } }
            PG8_WAIT_V(8); PG8_WAIT_L(0); PG8_BAR; PG8_MMA(0, 0, At, B0); PG8_MMA(0, 1, At, B1); PG8_BAR; PG8_SCHED;
            PG8_LDA(At, 0, 1); PG8_STAGE(PG8_SB(0, 0), b2, voffB); PG8_STAGE(PG8_SB(0, 1), b2 + hstep, voffB); PG8_STAGE_A(PG8_SA(0, 0), a2, 0, last);
            PG8_WAIT_V(8); PG8_WAIT_L(0); PG8_BAR; PG8_MMA(1, 0, At, B0); PG8_MMA(1, 1, At, B1); PG8_BAR; PG8_SCHED;
            PG8_LDB(B0, 1, 0); PG8_LDB(B1, 1, 1); PG8_SCHED; PG8_LDA(At, 1, 0); PG8_STAGE_A(PG8_SA(0, 1), a2, 1, last);
            PG8_WAIT_V(8); PG8_WAIT_L(0); PG8_BAR; PG8_MMA(0, 0, At, B0); PG8_MMA(0, 1, At, B1); PG8_BAR; PG8_SCHED;
            PG8_LDA(At, 1, 1); PG8_STAGE(PG8_SB(1, 0), b3, voffB); PG8_STAGE(PG8_SB(1, 1), b3 + hstep, voffB); PG8_STAGE_A(PG8_SA(1, 0), a3, 0, last);
            PG8_WAIT_V(8); PG8_WAIT_L(0); PG8_BAR; PG8_MMA(1, 0, At, B0); PG8_MMA(1, 1, At, B1); PG8_BAR; PG8_SCHED;
            } else {
            PG8_LDB(B0, 0, 0); PG8_SCHED; PG8_LDA(At, 0, 0); PG8_STAGE_A(PG8_SA(1, 1), a1, 1, false);
            if constexpr (GATHER) { if (last && has_next) { PG8_GROWS(nxt, vC); } }
            PG8_WAIT_L(8); PG8_BAR; PG8_WAIT_L(0); PG8_MMA(0, 0, At, B0); PG8_BAR; PG8_SCHED;
            PG8_LDB(B1, 0, 1); PG8_STAGE(PG8_SB(0, 0), b2, voffB);
            PG8_BAR; PG8_WAIT_L(0); PG8_MMA(0, 1, At, B1); PG8_BAR;
            PG8_LDA(At, 0, 1); PG8_STAGE_A(PG8_SA(0, 0), a2, 0, last);
            PG8_BAR; PG8_WAIT_L(0); PG8_MMA(1, 0, At, B0); PG8_BAR; PG8_SCHED;
            PG8_STAGE(PG8_SB(0, 1), b2 + hstep, voffB);
            PG8_WAIT_V(6); PG8_BAR; PG8_MMA(1, 1, At, B1); PG8_BAR;
            PG8_LDB(B0, 1, 0); PG8_SCHED; PG8_LDA(At, 1, 0); PG8_STAGE_A(PG8_SA(0, 1), a2, 1, last);
            PG8_WAIT_L(8); PG8_BAR; PG8_WAIT_L(0); PG8_MMA(0, 0, At, B0); PG8_BAR; PG8_SCHED;
            PG8_LDB(B1, 1, 1); PG8_STAGE(PG8_SB(1, 0), b3, voffB);
            PG8_BAR; PG8_WAIT_L(0); PG8_MMA(0, 1, At, B1); PG8_BAR;
            PG8_LDA(At, 1, 1); PG8_STAGE_A(PG8_SA(1, 0), a3, 0, last);
            PG8_BAR; PG8_WAIT_L(0); PG8_MMA(1, 0, At, B0); PG8_BAR; PG8_SCHED;
            PG8_STAGE(PG8_SB(1, 1), b3 + hstep, voffB);
            PG8_WAIT_V(6); PG8_BAR; PG8_MMA(1, 1, At, B1); PG8_BAR;
            }
        }
        if constexpr (ALIGN_EPI) { if (wr == 0) PG8_BAR; }
        if constexpr (FP8) { asm volatile("s_nop 15\n\ts_nop 15" ::: "memory"); PG8_SCHED; }
        E(acc, cur, wr, wc, fr, fq);
        if (!has_next) break;
#pragma unroll
        for (int a = 0; a < 2; ++a)
#pragma unroll
            for (int b = 0; b < 2; ++b)
#pragma unroll
                for (int m = 0; m < 4; ++m)
#pragma unroll
                    for (int n = 0; n < 2; ++n) acc[a][b][m][n] = (f32x4){0.f, 0.f, 0.f, 0.f};
        cur = nxt; cA = nA; cB = nB; ++ui;
        if constexpr (ALIGN_EPI) { if (wr == 1) PG8_BAR; }
    }
    PG8_WAIT_V(0);
    if constexpr (!ALIGN_EPI) { if (wr == 0) PG8_BAR; }
    PG8_BAR;
#undef PG8_SA
#undef PG8_SB
#undef PG8_STAGE
#undef PG8_LDA
#undef PG8_LDB
#undef PG8_MMA
#undef PG8_WAIT_V
#undef PG8_WAIT_L
#undef PG8_BAR
#undef PG8_SCHED
#undef PG8_UPTR
#undef PG8_STAGE_A
#undef PG8_GROWS
}

struct EpiProj {
    static constexpr bool PERM = true;
    bf16 *q, *k, *vT, *p;
    __device__ __forceinline__ void operator()(const f32x4 (&acc)[2][2][4][2], const Unit& u, int wr, int wc, int fr, int fq) const {
        const int row0 = u.pm * BM + wr * 64 + fr;
        const int pn = u.pn;
#pragma unroll
        for (int ai = 0; ai < 2; ++ai)
#pragma unroll
            for (int m = 0; m < 4; ++m) {
                const int row = row0 + ai * HALF + m * 16;
#pragma unroll
                for (int bj = 0; bj < 2; ++bj) {
                    f32x4 v0 = acc[ai][bj][m][0], v1 = acc[ai][bj][m][1];
                    const int col = pn * BM + bj * HALF + wc * 32 + 8 * fq;
                    if (pn >= 4 && pn < 6) {
                        const int cv = col - 1024, hh = cv >> 6, dim = cv & 63, b = row / T, t = row % T;
                        bf16* dst = vT + ((size_t)(((b * NH + hh) * GROWS + (t >> 6)) * HD + dim)) * 64 + (t & 63);
                        const unsigned w0 = cvt_pk_bf16(v0[0], v0[1]), w1 = cvt_pk_bf16(v0[2], v0[3]), w2 = cvt_pk_bf16(v1[0], v1[1]), w3 = cvt_pk_bf16(v1[2], v1[3]);
                        dst[0 * 64] = (bf16)(w0 & 0xffff); dst[1 * 64] = (bf16)(w0 >> 16); dst[2 * 64] = (bf16)(w1 & 0xffff); dst[3 * 64] = (bf16)(w1 >> 16);
                        dst[4 * 64] = (bf16)(w2 & 0xffff); dst[5 * 64] = (bf16)(w2 >> 16); dst[6 * 64] = (bf16)(w3 & 0xffff); dst[7 * 64] = (bf16)(w3 >> 16);
                        asm volatile("s_waitcnt vmcnt(40)" ::: "memory");
                    } else {
                        bf16* dst;
                        if (pn < 2) { v0 = v0 * 0.125f; v1 = v1 * 0.125f; dst = q + (size_t)row * CW + col; }
                        else if (pn < 4) dst = k + (size_t)row * CW + (col - 512);
                        else dst = p + (size_t)row * PW + (col - 1536);
                        u32x4 w; w.x = cvt_pk_bf16(v0[0], v0[1]); w.y = cvt_pk_bf16(v0[2], v0[3]); w.z = cvt_pk_bf16(v1[0], v1[1]); w.w = cvt_pk_bf16(v1[2], v1[3]);
                        *(u32x4*)dst = w;
                    }
                }
            }
    }
};
struct EpiWo {
    static constexpr bool PERM = true;
    const float* x; bf16* h;
    __device__ __forceinline__ void operator()(const f32x4 (&acc)[2][2][4][2], const Unit& u, int wr, int wc, int fr, int fq) const {
        const int row0 = u.pm * BM + wr * 64 + fr, col0 = u.pn * BM + wc * 32 + 8 * fq;
#pragma unroll
        for (int ai = 0; ai < 2; ++ai)
#pragma unroll
            for (int m = 0; m < 4; ++m) { const size_t off = (size_t)(row0 + ai * HALF + m * 16) * D + col0;
#pragma unroll
                for (int bj = 0; bj < 2; ++bj) { const f32x4 v0 = acc[ai][bj][m][0] + *(const f32x4*)(x + off + bj * HALF), v1 = acc[ai][bj][m][1] + *(const f32x4*)(x + off + bj * HALF + 4);
                    u32x4 w; w.x = cvt_pk_bf16(v0[0], v0[1]); w.y = cvt_pk_bf16(v0[2], v0[3]); w.z = cvt_pk_bf16(v1[0], v1[1]); w.w = cvt_pk_bf16(v1[2], v1[3]);
                    *(u32x4*)(h + off + bj * HALF) = w; } }
    }
};
struct EpiUp {
    static constexpr bool PERM = true;
    const float* b_up; unsigned char* act;
    __device__ __forceinline__ void operator()(const f32x4 (&acc)[2][2][4][2], const Unit& u, int wr, int wc, int fr, int fq) const {
        const int row0 = u.pm * BM + wr * 64 + fr, ch = u.pn * 128 + wc * 32 + 8 * fq;
        const float* bg = b_up + (size_t)u.e * 2048 + ch; const float* bl = bg + 1024;
        const f32x4 bg0 = *(const f32x4*)bg * F8_SACT, bg1 = *(const f32x4*)(bg + 4) * F8_SACT, bl0 = *(const f32x4*)bl, bl1 = *(const f32x4*)(bl + 4);
        constexpr float SG = F8_SACT / (F8_SX * F8_SW), SL = 1.0f / (F8_SX * F8_SW), KE = -1.702f * 1.44269504f / F8_SACT;
#pragma unroll
        for (int ai = 0; ai < 2; ++ai)
#pragma unroll
            for (int m = 0; m < 4; ++m) {
                float o[8];
#pragma unroll
                for (int n = 0; n < 2; ++n) { const f32x4 gv = acc[ai][0][m][n] * SG + (n ? bg1 : bg0), lv = acc[ai][1][m][n] * SL + (n ? bl1 : bl0);
#pragma unroll
                    for (int j = 0; j < 4; ++j) { const float gt = fminf(gv[j], 7.0f * F8_SACT), li = __builtin_amdgcn_fmed3f(lv[j], -7.0f, 7.0f);
                        const float t = gt * __builtin_amdgcn_rcpf(1.0f + __builtin_amdgcn_exp2f(gt * KE)); o[n * 4 + j] = __builtin_fmaf(li, t, t); } }
                int w0 = 0, w1 = 0;
                w0 = __builtin_amdgcn_cvt_pk_fp8_f32(o[0], o[1], w0, false); w0 = __builtin_amdgcn_cvt_pk_fp8_f32(o[2], o[3], w0, true);
                w1 = __builtin_amdgcn_cvt_pk_fp8_f32(o[4], o[5], w1, false); w1 = __builtin_amdgcn_cvt_pk_fp8_f32(o[6], o[7], w1, true);
                u32x2 w8; w8.x = (unsigned)w0; w8.y = (unsigned)w1;
                *(u32x2*)(act + (size_t)(row0 + ai * HALF + m * 16) * DE + ch) = w8;
            }
    }
};
struct EpiDown {
    static constexpr bool PERM = true;
    const float* b_dn; unsigned char* y;
    __device__ __forceinline__ void operator()(const f32x4 (&acc)[2][2][4][2], const Unit& u, int wr, int wc, int fr, int fq) const {
        const int row0 = u.pm * BM + wr * 64 + fr, col0 = u.pn * BM + wc * 32 + 8 * fq;
        const float* bb = b_dn + (size_t)u.e * D + col0;
        f32x4 bv[2][2];
#pragma unroll
        for (int bj = 0; bj < 2; ++bj)
#pragma unroll
            for (int n = 0; n < 2; ++n) bv[bj][n] = *(const f32x4*)(bb + bj * HALF + 4 * n) * F8_SY;
#pragma unroll
        for (int ai = 0; ai < 2; ++ai)
#pragma unroll
            for (int m = 0; m < 4; ++m) { unsigned char* rowp = y + (size_t)(row0 + ai * HALF + m * 16) * D + col0;
#pragma unroll
                for (int bj = 0; bj < 2; ++bj) { const f32x4 v0 = acc[ai][bj][m][0] * (F8_SY / (F8_SACT * F8_SW)) + bv[bj][0], v1 = acc[ai][bj][m][1] * (F8_SY / (F8_SACT * F8_SW)) + bv[bj][1];
                    u32x2 w; w.x = pk4_fp8(v0[0], v0[1], v0[2], v0[3]); w.y = pk4_fp8(v1[0], v1[1], v1[2], v1[3]);
                    *(u32x2*)(rowp + bj * HALF) = w; } }
    }
};
}


#define XB_TMO      128
#define XB_XCNT(j)  (256  + 64 * (j))
#define XB_XSUB(j)  (1280 + 64 * (j))
#define XB_XGEN(j)  (2304 + 64 * (j))
#define XB_TOP      3328
#define XB_TOPGEN   3392
#define XCD_BAR_WORDS 3456
#define XB_SPIN_CAP (1u << 20)
__device__ __forceinline__ unsigned xb_ld(unsigned* p)              { return __hip_atomic_load(p, __ATOMIC_RELAXED, __HIP_MEMORY_SCOPE_AGENT); }
__device__ __forceinline__ unsigned xb_add(unsigned* p, unsigned v) { return __hip_atomic_fetch_add(p, v, __ATOMIC_RELAXED, __HIP_MEMORY_SCOPE_AGENT); }
__device__ __forceinline__ unsigned xb_xcc_id() { return (unsigned)__builtin_amdgcn_s_getreg((3 << 11) | 20) & 0xFu; }
#define XB_SPIN(cond, bar) do { unsigned _sp = 0; while (cond) { __builtin_amdgcn_s_sleep(1); \
    if ((++_sp & 255u) == 0u) { if (xb_ld(&(bar)[XB_TMO])) break; if (_sp > XB_SPIN_CAP) { atomicAdd(&(bar)[XB_TMO], 1u); break; } } } } while (0)
struct XcdBarrier { unsigned* bar; unsigned x; volatile LAS unsigned* st; };
__device__ __forceinline__ XcdBarrier xcd_barrier_post(unsigned* bar, volatile LAS unsigned* st) {
    XcdBarrier b; b.bar = bar; b.x = xb_xcc_id(); b.st = st;
    if (threadIdx.x == 0) (void)xb_add(&bar[XB_XCNT(b.x)], 1u);
    return b;
}
__device__ __forceinline__ void xcd_barrier_complete(unsigned* bar, unsigned x, unsigned& nloc, unsigned& nx) {
    const unsigned G = gridDim.x * gridDim.y * gridDim.z;
    unsigned sum, cnt, mine, sp = 0u;
    for (;;) {
        sum = 0u; cnt = 0u; mine = 0u;
#pragma unroll
        for (unsigned j = 0; j < 16; ++j) { const unsigned c = xb_ld(&bar[XB_XCNT(j)]); sum += c; cnt += (c > 0u) ? 1u : 0u; mine = (j == x) ? c : mine; }
        if (sum == G) break;
        __builtin_amdgcn_s_sleep(1);
        if ((++sp & 255u) == 0u) { if (xb_ld(&bar[XB_TMO])) break; if (sp > XB_SPIN_CAP) { atomicAdd(&bar[XB_TMO], 1u); break; } }
    }
    nloc = mine > 0u ? mine : 1u; nx = cnt > 0u ? cnt : 1u;
}
__device__ __forceinline__ void xcd_barrier(const XcdBarrier& b) {
    asm volatile("s_waitcnt vmcnt(0)" ::: "memory");
    __syncthreads();
    if (threadIdx.x == 0) {
        unsigned* bar = b.bar;
        __builtin_amdgcn_s_waitcnt(0);
        unsigned nloc = b.st[0], nx = b.st[1];
        if (nloc == 0u) { xcd_barrier_complete(bar, b.x, nloc, nx); b.st[0] = nloc; b.st[1] = nx; }
        const unsigned old = xb_add(&bar[XB_XSUB(b.x)], 1u);
        const unsigned gen = old / nloc;
        if (old + 1u == (gen + 1u) * nloc) {
            __builtin_amdgcn_fence(__ATOMIC_RELEASE, "agent");
            asm volatile("s_waitcnt vmcnt(0)" ::: "memory");
            const unsigned og = xb_add(&bar[XB_TOP], 1u);
            const unsigned tg = og / nx;
            if (og + 1u == (tg + 1u) * nx) xb_add(&bar[XB_TOPGEN], 1u);
            else XB_SPIN(xb_ld(&bar[XB_TOPGEN]) == tg, bar);
            __builtin_amdgcn_fence(__ATOMIC_ACQUIRE, "agent");
            xb_add(&bar[XB_XGEN(b.x)], 1u);
            asm volatile("s_waitcnt vmcnt(0)" ::: "memory");
        } else {
            XB_SPIN(xb_ld(&bar[XB_XGEN(b.x)]) == gen, bar);
            __builtin_amdgcn_fence(__ATOMIC_ACQUIRE, "agent");
            asm volatile("s_waitcnt vmcnt(0)" ::: "memory");
        }
    }
    __syncthreads();
}

struct Args { const float* in[26]; float* out; unsigned char* ws; int ph_lo, ph_hi; };

struct Frame { LAS unsigned char* lds; int tid, lane, wave, G, vcu; };

__device__ __forceinline__ void transpose_item(const float* W, int K, int N, bf16* WT, int k0, int n0, int orow0, LAS float* scr, int lane) {
#pragma unroll 8
    for (int i = 0; i < 32; ++i) { const int kk = 2 * i + (lane >> 5); scr[kk * 33 + (lane & 31)] = W[(size_t)(k0 + kk) * N + n0 + (lane & 31)]; }
    asm volatile("s_waitcnt lgkmcnt(0)" ::: "memory");
    const int c = lane & 7;
#pragma unroll
    for (int j = 0; j < 4; ++j) { const int n = (lane >> 3) + 8 * j; const LAS float* s = scr + (8 * c) * 33 + n;
        u32x4 o; o.x = cvt_pk_bf16(s[0 * 33], s[1 * 33]); o.y = cvt_pk_bf16(s[2 * 33], s[3 * 33]); o.z = cvt_pk_bf16(s[4 * 33], s[5 * 33]); o.w = cvt_pk_bf16(s[6 * 33], s[7 * 33]);
        *(u32x4*)(WT + (size_t)(orow0 + n) * K + k0 + 8 * c) = o; }
    asm volatile("s_waitcnt lgkmcnt(0)" ::: "memory");
}

__device__ __forceinline__ void transpose_item8(const float* W, int K, int N, unsigned char* WT, int k0, int n0, int orow0, LAS float* scr, int lane) {
#pragma unroll 8
    for (int i = 0; i < 32; ++i) { const int kk = 2 * i + (lane >> 5); scr[kk * 33 + (lane & 31)] = W[(size_t)(k0 + kk) * N + n0 + (lane & 31)]; }
    asm volatile("s_waitcnt lgkmcnt(0)" ::: "memory");
    const int c = lane & 7;
#pragma unroll
    for (int j = 0; j < 4; ++j) { const int n = (lane >> 3) + 8 * j; const LAS float* s = scr + (8 * c) * 33 + n;
        u32x2 o; o.x = pk4_fp8(s[0 * 33] * F8_SW, s[1 * 33] * F8_SW, s[2 * 33] * F8_SW, s[3 * 33] * F8_SW); o.y = pk4_fp8(s[4 * 33] * F8_SW, s[5 * 33] * F8_SW, s[6 * 33] * F8_SW, s[7 * 33] * F8_SW);
        *(u32x2*)(WT + (size_t)(orow0 + n) * K + k0 + 8 * c) = o; }
    asm volatile("s_waitcnt lgkmcnt(0)" ::: "memory");
}

__device__ __forceinline__ void p0_prologue(const Frame& F, const Args& a) {
    unsigned char* ws = a.ws;
    LAS float* scr = (LAS float*)(F.lds + F.wave * 8448);
    const int gw = F.vcu * 8 + F.wave, NGW = F.G * 8;
    constexpr int I_IN = 16 * 108, I_O = 16 * 32, I_L = 16, I_G = 32;
    constexpr int NITEMS = I_IN + I_O + 2 * I_L + 2 * I_L + I_G;
    for (int it = gw; it < NITEMS; it += NGW) {
        int r = it;
        if (r < I_IN) { const int kb = r / 108, nb = r % 108; transpose_item(a.in[2], 1024, NPROJ, (bf16*)(ws + WS_WINT), kb * 64, nb * 32, nb * 32, scr, F.lane); continue; }
        r -= I_IN;
        if (r < I_O) { const int kb = r / 32, nb = r % 32; transpose_item(a.in[17], 1024, 1024, (bf16*)(ws + WS_WOT), kb * 64, nb * 32, nb * 32, scr, F.lane); continue; }
        r -= I_O;
        if (r < 2 * I_L) { const int z = r / 16, nb = r % 16; transpose_item(a.in[8] + (size_t)z * 64 * 512, 64, 512, (bf16*)(ws + WS_W2T) + (size_t)z * 512 * 64, 0, nb * 32, nb * 32, scr, F.lane); continue; }
        r -= 2 * I_L;
        if (r < 2 * I_L) { const int z = r / 16, nb = r % 16; transpose_item(a.in[10] + (size_t)z * 64 * 512, 64, 512, (bf16*)(ws + WS_A2T) + (size_t)z * 512 * 64, 0, nb * 32, nb * 32, scr, F.lane); continue; }
        r -= 2 * I_L;
        { const int kb = r / 16, nb = r % 16; transpose_item(a.in[11], 128, 512, (bf16*)(ws + WS_G2T), kb * 64, nb * 32, nb * 32, scr, F.lane); }
    }
    { constexpr int I_UP = 32 * 16 * 64, I_DN = 32 * 16 * 32;
      for (int r = gw; r < I_UP + I_DN; r += NGW) {
        if (r < I_UP) {
            const int e = r / 1024, q = r % 1024, kb = q / 64, nb = q % 64, n0 = nb * 32;
            const int orow0 = n0 < 1024 ? 256 * (n0 >> 7) + (n0 & 127) : 256 * ((n0 - 1024) >> 7) + 128 + ((n0 - 1024) & 127);
            transpose_item8(a.in[21] + (size_t)e * 1024 * 2048, 1024, 2048, ws + WS_WUPT + (size_t)e * 2048 * 1024, kb * 64, n0, orow0, scr, F.lane); }
        else { const int r2 = r - I_UP, e = r2 / 512, q = r2 % 512, kb = q / 32, nb = q % 32;
            transpose_item8(a.in[23] + (size_t)e * 1024 * 1024, 1024, 1024, ws + WS_WDNT + (size_t)e * 1024 * 1024, kb * 64, nb * 32, nb * 32, scr, F.lane); } } }
    { u32x4* z = (u32x4*)(ws + WS_WINT + (size_t)NPROJ * 1024 * 2); const u32x4 zero = {0u, 0u, 0u, 0u};
      for (int i = F.vcu * 512 + F.tid; i < 16384; i += F.G * 512) z[i] = zero; }
    const float* x = a.in[0]; const float* nw = a.in[1]; bf16* hn = (bf16*)(ws + WS_HN);
    f32x4 wv[4];
#pragma unroll
    for (int j = 0; j < 4; ++j) wv[j] = *((const f32x4*)nw + F.lane + 64 * j);
    for (int m = gw; m < M; m += 2 * NGW) {
        const int m1 = m + NGW; const bool has1 = m1 < M;
        const f32x4* xr0 = (const f32x4*)(x + (size_t)m * D) + F.lane; const f32x4* xr1 = (const f32x4*)(x + (size_t)(has1 ? m1 : m) * D) + F.lane;
        f32x4 v0[4], v1[4]; float s0 = 0.f, s1 = 0.f;
#pragma unroll
        for (int j = 0; j < 4; ++j) { v0[j] = xr0[64 * j]; v1[j] = xr1[64 * j]; }
#pragma unroll
        for (int j = 0; j < 4; ++j) { s0 += (v0[j].x * v0[j].x + v0[j].y * v0[j].y) + (v0[j].z * v0[j].z + v0[j].w * v0[j].w); s1 += (v1[j].x * v1[j].x + v1[j].y * v1[j].y) + (v1[j].z * v1[j].z + v1[j].w * v1[j].w); }
        const float rs0 = rsqrtf(wave_sum(s0) * (1.f / D) + RMS_EPS), rs1 = rsqrtf(wave_sum(s1) * (1.f / D) + RMS_EPS);
        u32x2* o0 = (u32x2*)(hn + (size_t)m * D) + F.lane; u32x2* o1 = (u32x2*)(hn + (size_t)m1 * D) + F.lane;
#pragma unroll
        for (int j = 0; j < 4; ++j) { u32x2 o; o.x = cvt_pk_bf16(v0[j].x * rs0 * wv[j].x, v0[j].y * rs0 * wv[j].y); o.y = cvt_pk_bf16(v0[j].z * rs0 * wv[j].z, v0[j].w * rs0 * wv[j].w); o0[64 * j] = o; }
        if (has1) {
#pragma unroll
            for (int j = 0; j < 4; ++j) { u32x2 o; o.x = cvt_pk_bf16(v1[j].x * rs1 * wv[j].x, v1[j].y * rs1 * wv[j].y); o.y = cvt_pk_bf16(v1[j].z * rs1 * wv[j].z, v1[j].w * rs1 * wv[j].w); o1[64 * j] = o; } }
    }
}

constexpr int PREP_KBUF = 0, PREP_INV = 65536, PREP_AW = 67584, PREP_AA = PREP_AW + 17408, PREP_AG = PREP_AA + 17408, PREP_LD = 136;
template <bool STORE>
__device__ __forceinline__ void prep_phase(const Frame& F, const Args& a) {
    unsigned char* ws = a.ws;
    const bf16* p = (const bf16*)(ws + WS_P);
    bf16* r_out = (bf16*)(ws + WS_R); bf16* v_out = (bf16*)(ws + WS_V); bf16* kk_out = (bf16*)(ws + WS_KK);
    bf16* decay_out = (bf16*)(ws + WS_DECAY); bf16* kdir_out = (bf16*)(ws + WS_KDIR); bf16* akk_out = (bf16*)(ws + WS_AKK); bf16* g_out = (bf16*)(ws + WS_G);
    const bf16* w2T = (const bf16*)(ws + WS_W2T); const bf16* a2T = (const bf16*)(ws + WS_A2T); const bf16* g2T = (const bf16*)(ws + WS_G2T);
    const float* mu_p = a.in[5]; const float* mu_n = a.in[6]; const float* w0 = a.in[7]; const float* a0 = a.in[9];
    const float* k_k = a.in[12]; const float* k_a = a.in[13];
    LAS bf16* kbuf = (LAS bf16*)(F.lds + PREP_KBUF); LAS float* invb = (LAS float*)(F.lds + PREP_INV);
    LAS bf16* Aw = (LAS bf16*)(F.lds + PREP_AW); LAS bf16* Aa = (LAS bf16*)(F.lds + PREP_AA); LAS bf16* Ag = (LAS bf16*)(F.lds + PREP_AG);
    const int lane = F.lane, wave = F.wave, fr = lane & 15, fg = lane >> 4;
    for (int tile = F.vcu; tile < M / 64; tile += F.G) {
        const int m0 = tile * 64;
#pragma unroll 1
        for (int jj = 0; jj < 4; ++jj) {
            const int q = lane + 64 * jj; const bool valid = q < 240; const int c0 = 8 * q;
            float mp[8], mn[8];
#pragma unroll
            for (int i = 0; i < 8; ++i) { mp[i] = valid ? mu_p[c0 + i] : 0.f; mn[i] = valid ? mu_n[c0 + i] : 0.f; }
            const int mfirst = m0 + wave * 8;
            const u32x4 zero = {0u, 0u, 0u, 0u};
            u32x4 rows[10];
#pragma unroll
            for (int rI = 0; rI < 10; ++rI) { const int mr = mfirst - 1 + rI;
                const bool ok = valid && !(rI == 0 && (mfirst % T) == 0) && !(rI == 9 && ((mfirst + 7) % T) == T - 1);
                rows[rI] = ok ? *(const u32x4*)(p + (size_t)mr * PW + c0) : zero; }
#pragma unroll
            for (int i = 0; i < 8; ++i) {
                const int m = mfirst + i, it = wave * 8 + i;
                const u32x4 prev = rows[i], cur = rows[i + 1], nxt = rows[i + 2];
                float fp[8], fc[8], fn[8], s[8];
                unpack8(prev, fp); unpack8(cur, fc); unpack8(nxt, fn);
#pragma unroll
                for (int e = 0; e < 8; ++e) s[e] = fc[e] + mp[e] * (fp[e] - fc[e]) + mn[e] * (fn[e] - fc[e]);
                if (jj == 0) { if (STORE) { *(u32x4*)(r_out + (size_t)m * CW + c0) = pack8(s); } }
                else if (jj == 1) {
                    const int c = c0 - 512;
                    *(LAS u32x4*)(kbuf + it * 512 + c) = pack8(s);
                    float kr[8]; float ss = 0.f;
#pragma unroll
                    for (int e = 0; e < 8; ++e) { kr[e] = s[e] * k_k[c + e]; ss += kr[e] * kr[e]; }
                    ss += __shfl_xor(ss, 1); ss += __shfl_xor(ss, 2); ss += __shfl_xor(ss, 4);
                    const float inv = fminf(__builtin_amdgcn_rsqf(ss), 1e12f);
#pragma unroll
                    for (int e = 0; e < 8; ++e) kr[e] *= inv;
                    if (STORE) { *(u32x4*)(kk_out + (size_t)m * CW + c) = pack8(kr); }
                    if ((lane & 7) == 0) invb[it * 8 + (lane >> 3)] = inv;
                }
                else if (jj == 2) { if (STORE) { *(u32x4*)(v_out + (size_t)m * CW + (c0 - 1024)) = pack8(s); } }
                else if (valid) {
                    const int seg = lane >> 4, cw = 8 * (lane & 15);
                    if (seg == 0) {
#pragma unroll
                        for (int e = 0; e < 8; ++e) s[e] = 1.0f - 2.0f * __builtin_amdgcn_rcpf(__expf(2.0f * s[e]) + 1.0f);
                        *(LAS u32x4*)(Aw + it * PREP_LD + cw) = pack8(s);
                    } else if (seg == 1) { *(LAS u32x4*)(Aa + it * PREP_LD + cw) = pack8(s); }
                    else {
#pragma unroll
                        for (int e = 0; e < 8; ++e) s[e] = sigmoidf_(s[e]);
                        *(LAS u32x4*)(Ag + it * PREP_LD + cw) = pack8(s);
                    }
                }
            }
        }
        __syncthreads();
        const int nb = 64 * wave;
#define PREP_PROW(nt_) (nb + 32 * ((nt_) >> 1) + 8 * (fr >> 2) + 4 * ((nt_) & 1) + (fr & 3))
#define PREP_COL(nt_)  (nb + 32 * ((nt_) >> 1) + 8 * fg + 4 * ((nt_) & 1))
#pragma unroll 1
        for (int job = 0; job < 4; ++job) {
            const int z = job & 1;
            const bf16* WT = job < 2 ? w2T + (size_t)z * 512 * 64 : a2T + (size_t)z * 512 * 64;
            const LAS bf16* Ax = job < 2 ? Aw + z * 64 : Aa + z * 64;
            bf16x8 wf[2][4];
#pragma unroll
            for (int ks = 0; ks < 2; ++ks)
#pragma unroll
                for (int nt = 0; nt < 4; ++nt) wf[ks][nt] = *(const bf16x8*)(WT + (size_t)PREP_PROW(nt) * 64 + 32 * ks + 8 * fg);
            f32x4 pb[4], pkk[4], pka[4];
#pragma unroll
            for (int nt = 0; nt < 4; ++nt) { const int n = PREP_COL(nt);
                pb[nt] = *(const f32x4*)((job < 2 ? w0 : a0) + z * 512 + n); pkk[nt] = *(const f32x4*)(k_k + n); pka[nt] = *(const f32x4*)(k_a + n); }
            f32x4 acc[4][4];
#pragma unroll
            for (int mt = 0; mt < 4; ++mt)
#pragma unroll
                for (int nt = 0; nt < 4; ++nt) acc[mt][nt] = (f32x4){0.f, 0.f, 0.f, 0.f};
#pragma unroll
            for (int ks = 0; ks < 2; ++ks) {
                bf16x8 af[4];
#pragma unroll
                for (int mt = 0; mt < 4; ++mt) af[mt] = *(const LAS bf16x8*)(Ax + (16 * mt + fr) * PREP_LD + 32 * ks + 8 * fg);
#pragma unroll
                for (int mt = 0; mt < 4; ++mt)
#pragma unroll
                    for (int nt = 0; nt < 4; ++nt) acc[mt][nt] = __builtin_amdgcn_mfma_f32_16x16x32_bf16(wf[ks][nt], af[mt], acc[mt][nt], 0, 0, 0);
            }
#pragma unroll
            for (int mt = 0; mt < 4; ++mt) {
                const int it = 16 * mt + fr; const size_t m = (size_t)(m0 + it);
#pragma unroll
                for (int np = 0; np < 2; ++np) {
                    const int c8 = nb + 32 * np + 8 * fg;
                    if (job < 2) {
                        float o[8];
#pragma unroll
                        for (int hh = 0; hh < 2; ++hh) { const f32x4 v = acc[mt][2 * np + hh], bq = pb[2 * np + hh];
#pragma unroll
                            for (int i = 0; i < 4; ++i) o[4 * hh + i] = __expf(-0.60653066f * sigmoidf_(v[i] + bq[i])); }
                        if (STORE) { *(u32x4*)(decay_out + ((size_t)z * M + m) * CW + c8) = pack8(o); }
                    } else {
                        const u32x4 kb = *(const LAS u32x4*)(kbuf + it * 512 + c8);
                        float kv[8]; unpack8(kb, kv);
                        const float inv = invb[it * 8 + wave];
                        float kd[8], ak[8];
#pragma unroll
                        for (int hh = 0; hh < 2; ++hh) { const f32x4 v = acc[mt][2 * np + hh], bq = pb[2 * np + hh], kkc = pkk[2 * np + hh], kac = pka[2 * np + hh];
#pragma unroll
                            for (int i = 0; i < 4; ++i) { const float av = sigmoidf_(v[i] + bq[i]), kx = kv[4 * hh + i]; kd[4 * hh + i] = kx * (1.0f + (av - 1.0f) * kac[i]); ak[4 * hh + i] = av * (kx * kkc[i] * inv); } }
                        if (STORE) { *(u32x4*)(kdir_out + ((size_t)z * M + m) * CW + c8) = pack8(kd); *(u32x4*)(akk_out + ((size_t)z * M + m) * CW + c8) = pack8(ak); }
                    }
                }
            }
        }
        {
            bf16x8 wf[4][4];
#pragma unroll
            for (int ks = 0; ks < 4; ++ks)
#pragma unroll
                for (int nt = 0; nt < 4; ++nt) wf[ks][nt] = *(const bf16x8*)(g2T + (size_t)PREP_PROW(nt) * 128 + 32 * ks + 8 * fg);
            f32x4 acc[4][4];
#pragma unroll
            for (int mt = 0; mt < 4; ++mt)
#pragma unroll
                for (int nt = 0; nt < 4; ++nt) acc[mt][nt] = (f32x4){0.f, 0.f, 0.f, 0.f};
#pragma unroll
            for (int ks = 0; ks < 4; ++ks) {
                bf16x8 af[4];
#pragma unroll
                for (int mt = 0; mt < 4; ++mt) af[mt] = *(const LAS bf16x8*)(Ag + (16 * mt + fr) * PREP_LD + 32 * ks + 8 * fg);
#pragma unroll
                for (int mt = 0; mt < 4; ++mt)
#pragma unroll
                    for (int nt = 0; nt < 4; ++nt) acc[mt][nt] = __builtin_amdgcn_mfma_f32_16x16x32_bf16(wf[ks][nt], af[mt], acc[mt][nt], 0, 0, 0);
            }
#pragma unroll
            for (int mt = 0; mt < 4; ++mt) { const size_t m = (size_t)(m0 + 16 * mt + fr);
#pragma unroll
                for (int np = 0; np < 2; ++np) { const f32x4 v0 = acc[mt][2 * np], v1 = acc[mt][2 * np + 1];
                    u32x4 w; w.x = cvt_pk_bf16(v0[0], v0[1]); w.y = cvt_pk_bf16(v0[2], v0[3]); w.z = cvt_pk_bf16(v1[0], v1[1]); w.w = cvt_pk_bf16(v1[2], v1[3]);
                    if (STORE) { *(u32x4*)(g_out + m * CW + nb + 32 * np + 8 * fg) = w; } } }
        }
#undef PREP_PROW
#undef PREP_COL
        __syncthreads();
    }
}

__device__ __forceinline__ void attn_phase(const Frame& F, const Args& a, const int widx, const int nworkers) {
    unsigned char* ws = a.ws;
    const bf16* q = (const bf16*)(ws + WS_Q); const bf16* k = (const bf16*)(ws + WS_K); const bf16* vT = (const bf16*)(ws + WS_VT);
    bf16* att = (bf16*)(ws + WS_ATT);
    LAS float* bias = (LAS float*)F.lds;
    for (int i = F.tid; i < 8 * 15 * 31; i += 512) bias[i] = a.in[3][i];
    __syncthreads();
    const int lane = F.lane, fr = lane & 15, fg = lane >> 4;
    const int NGW = nworkers * 8, gw = widx * 8 + F.wave;
    const int per = (16384 + NGW - 1) / NGW;
    for (int task = gw * per; task < (gw + 1) * per && task < 16384; ++task) {
        const int cgp = task & 3, r = (task >> 2) & 127, h = (task >> 9) & 7, b = task >> 12;
        const int c0 = 16 * cgp, wsc = min(max(c0 - 8, 0), 32), rs = min(max(r - 4, 0), GROWS - 8);
        const int c = c0 + fr, cs = min(max(c - 8, 0), 48);
        const size_t tq = (size_t)b * T + r * 64 + c;
        bf16x8 qf[2];
#pragma unroll
        for (int ks = 0; ks < 2; ++ks) qf[ks] = *(const bf16x8*)(q + tq * CW + h * 64 + 32 * ks + 8 * fg);
        f32x4 sc[16];
        const int kcol_a = wsc + 8 * (fr >> 2) + (fr & 3);
        { bf16x8 kf[16][2];
#pragma unroll
          for (int t = 0; t < 16; ++t) { const int u = t >> 1, par = t & 1;
              const size_t tk = (size_t)b * T + (rs + u) * 64 + kcol_a + 4 * par;
              kf[t][0] = *(const bf16x8*)(k + tk * CW + h * 64 + 8 * fg); kf[t][1] = *(const bf16x8*)(k + tk * CW + h * 64 + 32 + 8 * fg); }
#pragma unroll
          for (int t = 0; t < 16; ++t) { f32x4 s = {0.f, 0.f, 0.f, 0.f};
              s = __builtin_amdgcn_mfma_f32_16x16x32_bf16(kf[t][0], qf[0], s, 0, 0, 0);
              s = __builtin_amdgcn_mfma_f32_16x16x32_bf16(kf[t][1], qf[1], s, 0, 0, 0);
              sc[t] = s; } }
        float mx = -1e30f;
#pragma unroll
        for (int u = 0; u < 8; ++u) {
            const int dr = rs + u - r + 7;
#pragma unroll
            for (int par = 0; par < 2; ++par)
#pragma unroll
                for (int i = 0; i < 4; ++i) {
                    const int kc = wsc + 8 * fg + 4 * par + i; const bool ok = (kc >= cs) && (kc < cs + 16);
                    const int dc = min(max(kc - c + 15, 0), 30);
                    const float s = ok ? sc[2 * u + par][i] + bias[(h * 15 + dr) * 31 + dc] : -1e30f;
                    sc[2 * u + par][i] = s; mx = fmaxf(mx, s);
                }
        }
        mx = fmaxf(mx, __shfl_xor(mx, 16)); mx = fmaxf(mx, __shfl_xor(mx, 32));
        float sum = 0.f;
#pragma unroll
        for (int t = 0; t < 16; ++t)
#pragma unroll
            for (int i = 0; i < 4; ++i) { const float pv = sc[t][i] > -1e29f ? __expf(sc[t][i] - mx) : 0.f; sc[t][i] = pv; sum += pv; }
        sum += __shfl_xor(sum, 16); sum += __shfl_xor(sum, 32);
        const float inv = 1.0f / sum;
        f32x4 o[4];
#pragma unroll
        for (int nt = 0; nt < 4; ++nt) o[nt] = (f32x4){0.f, 0.f, 0.f, 0.f};
        { bf16x8 vf[8][4];
#pragma unroll
          for (int u = 0; u < 8; ++u) { const bf16* vblk = vT + ((size_t)((b * NH + h) * GROWS + rs + u)) * (HD * 64) + wsc + 8 * fg;
#pragma unroll
              for (int nt = 0; nt < 4; ++nt) vf[u][nt] = *(const bf16x8*)(vblk + (16 * nt + fr) * 64); }
#pragma unroll
          for (int u = 0; u < 8; ++u) {
              union { u32x4 w; bf16x8 h8; } pf;
              pf.w.x = cvt_pk_bf16(sc[2 * u][0], sc[2 * u][1]); pf.w.y = cvt_pk_bf16(sc[2 * u][2], sc[2 * u][3]);
              pf.w.z = cvt_pk_bf16(sc[2 * u + 1][0], sc[2 * u + 1][1]); pf.w.w = cvt_pk_bf16(sc[2 * u + 1][2], sc[2 * u + 1][3]);
#pragma unroll
              for (int nt = 0; nt < 4; ++nt) o[nt] = __builtin_amdgcn_mfma_f32_16x16x32_bf16(vf[u][nt], pf.h8, o[nt], 0, 0, 0); } }
#pragma unroll
        for (int nt = 0; nt < 4; ++nt) { u32x2 w; w.x = cvt_pk_bf16(o[nt][0] * inv, o[nt][1] * inv); w.y = cvt_pk_bf16(o[nt][2] * inv, o[nt][3] * inv);
            *(u32x2*)(att + tq * CW + h * 64 + 16 * nt + 4 * fg) = w; }
    }
    __syncthreads();
}

__device__ __forceinline__ void side_phase(const Frame& F, const Args& a, const int widx, const int nworkers) {
    attn_phase(F, a, widx, nworkers);
}

__device__ __forceinline__ float row16_sum(float v) {
    v += __builtin_bit_cast(float, __builtin_amdgcn_update_dpp(0, __builtin_bit_cast(int, v), 0xB1, 0xF, 0xF, true));
    v += __builtin_bit_cast(float, __builtin_amdgcn_update_dpp(0, __builtin_bit_cast(int, v), 0x4E, 0xF, 0xF, true));
    v += __builtin_bit_cast(float, __builtin_amdgcn_update_dpp(0, __builtin_bit_cast(int, v), 0x141, 0xF, 0xF, true));
    v += __builtin_bit_cast(float, __builtin_amdgcn_update_dpp(0, __builtin_bit_cast(int, v), 0x140, 0xF, 0xF, true));
    return v;
}
constexpr int CS_R = 8;
constexpr int CS_NCH = 2, CS_NPR = 6;
constexpr int CS_AT = 0, CS_RT = 2304, CS_KHT = 4608, CS_BHT = 6656, CS_VT = 8704  , CS_TT = 10752, CS_AAK = 11264, CS_ARK = 11776, CS_ARB = 12288, CS_PL = 12800, CS_SLOT = 13056;
constexpr int CS_LD = 72;
constexpr int CS_SCR = CS_R * CS_SLOT  , CS_SCRW = 2304 * 2  , CS_FLAG = CS_SCR + CS_NPR * CS_SCRW  ;
__device__ __forceinline__ bf16 f2bf(float f) { return (bf16)cvt_pk_bf16(f, 0.f); }
struct ChainOps { u32x2 a4[4], r4[4], kh[4], bh[4], aak, ark, arb, tt, vb; f32x4 pl[4]; };
__device__ __forceinline__ void chain_load(const LAS unsigned char* sl, int fr, int fg, int c, ChainOps& o) {
    const int o16 = fr * 32 + fg * 8;
    const LAS unsigned char* pa = sl + CS_AT + fr * (CS_LD * 2) + fg * 8; const LAS unsigned char* pr = sl + CS_RT + fr * (CS_LD * 2) + fg * 8;
#pragma unroll
    for (int kq = 0; kq < 4; ++kq) { o.a4[kq] = *(const LAS u32x2*)(pa + 32 * kq); o.r4[kq] = *(const LAS u32x2*)(pr + 32 * kq); }
    o.aak = *(const LAS u32x2*)(sl + CS_AAK + o16); o.ark = *(const LAS u32x2*)(sl + CS_ARK + o16); o.arb = *(const LAS u32x2*)(sl + CS_ARB + o16); o.tt = *(const LAS u32x2*)(sl + CS_TT + o16);
    o.vb = *(const LAS u32x2*)(sl + CS_VT + c * 512 + o16);
#pragma unroll
    for (int mt = 0; mt < 4; ++mt) { o.pl[mt] = *(const LAS f32x4*)(sl + CS_PL + (16 * mt + 4 * fg) * 4);
        o.kh[mt] = *(const LAS u32x2*)(sl + CS_KHT + 512 * mt + o16); o.bh[mt] = *(const LAS u32x2*)(sl + CS_BHT + 512 * mt + o16); }
}
__device__ __forceinline__ f32x4 chain_compute(const ChainOps& o, f32x4 (&zacc)[4]) {
#define CS_M32(A_, B_, C_) __builtin_amdgcn_mfma_f32_16x16x32_bf16(A_, B_, C_, 0, 0, 0)
#define CS_M16(A_, B_, C_) __builtin_amdgcn_mfma_f32_16x16x16bf16_1k(__builtin_bit_cast(s16x4, A_), __builtin_bit_cast(s16x4, B_), C_, 0, 0, 0)
    union { u32x4 w; bf16x8 h8; } zb0, zb1, ap0, ap1, rp0, rp1;
    zb0.w.x = cvt_pk_bf16(zacc[0][0], zacc[0][1]); zb0.w.y = cvt_pk_bf16(zacc[0][2], zacc[0][3]); zb0.w.z = cvt_pk_bf16(zacc[1][0], zacc[1][1]); zb0.w.w = cvt_pk_bf16(zacc[1][2], zacc[1][3]);
    zb1.w.x = cvt_pk_bf16(zacc[2][0], zacc[2][1]); zb1.w.y = cvt_pk_bf16(zacc[2][2], zacc[2][3]); zb1.w.z = cvt_pk_bf16(zacc[3][0], zacc[3][1]); zb1.w.w = cvt_pk_bf16(zacc[3][2], zacc[3][3]);
    ap0.w = (u32x4){o.a4[0].x, o.a4[0].y, o.a4[1].x, o.a4[1].y}; ap1.w = (u32x4){o.a4[2].x, o.a4[2].y, o.a4[3].x, o.a4[3].y};
    rp0.w = (u32x4){o.r4[0].x, o.r4[0].y, o.r4[1].x, o.r4[1].y}; rp1.w = (u32x4){o.r4[2].x, o.r4[2].y, o.r4[3].x, o.r4[3].y};
    const f32x4 zero4 = {0.f, 0.f, 0.f, 0.f};
    f32x4 Wc = CS_M16(o.aak, o.vb, zero4);
    Wc = CS_M32(ap0.h8, zb0.h8, Wc); Wc = CS_M32(ap1.h8, zb1.h8, Wc);
    f32x4 Yc = CS_M16(o.ark, o.vb, zero4);
    Yc = CS_M32(rp0.h8, zb0.h8, Yc); Yc = CS_M32(rp1.h8, zb1.h8, Yc);
    f32x4 zz[4];
#pragma unroll
    for (int mt = 0; mt < 4; ++mt) zz[mt] = CS_M16(o.kh[mt], o.vb, zacc[mt] * o.pl[mt]);
    u32x2 wb, ub;
    wb.x = cvt_pk_bf16(Wc[0], Wc[1]); wb.y = cvt_pk_bf16(Wc[2], Wc[3]);
    const f32x4 Uc = CS_M16(o.tt, wb, zero4);
    ub.x = cvt_pk_bf16(Uc[0], Uc[1]); ub.y = cvt_pk_bf16(Uc[2], Uc[3]);
    Yc = CS_M16(o.arb, ub, Yc);
#pragma unroll
    for (int mt = 0; mt < 4; ++mt) zacc[mt] = CS_M16(o.bh[mt], ub, zz[mt]);
#undef CS_M32
#undef CS_M16
    return Yc;
}
template <int z>
__device__ __forceinline__ void scan_phase_z(const Frame& F, const Args& a, const int seq, const int half) {
    unsigned char* ws = a.ws;
    const int b = (seq >> 3) & 3, h = seq & 7;
    const size_t mb = (size_t)b * T;
    const int lane = F.lane, wave = F.wave, fr = lane & 15, fg = lane >> 4;
    constexpr int NCK = T / 16;
    volatile LAS unsigned* flg = (volatile LAS unsigned*)(F.lds + CS_FLAG);
    if (F.tid < 16) flg[F.tid] = 0u;
    __syncthreads();
    const int o16 = fr * 32 + fg * 8;
#define CS_M32(A_, B_, C_) __builtin_amdgcn_mfma_f32_16x16x32_bf16(A_, B_, C_, 0, 0, 0)
#define CS_M16(A_, B_, C_) __builtin_amdgcn_mfma_f32_16x16x16bf16_1k(__builtin_bit_cast(s16x4, A_), __builtin_bit_cast(s16x4, B_), C_, 0, 0, 0)
    if (wave < CS_NCH) {
        const int c = wave, rg = 2 * half + c;
        __builtin_amdgcn_s_setprio(3);
        bf16* yout = (bf16*)(ws + WS_Y) + (size_t)z * M * CW + h * 64 + rg * 16 + fr;
        f32x4 zacc[4];
#pragma unroll
        for (int mt = 0; mt < 4; ++mt) zacc[mt] = (f32x4){0.f, 0.f, 0.f, 0.f};
        ChainOps opA, opB;
#define CS_READY(nn) do { unsigned sp_ = 0; while (flg[(nn) & (CS_R - 1)] != (unsigned)((nn) + 1)) { __builtin_amdgcn_s_sleep(1); if (++sp_ > (1u << 24)) break; } __builtin_amdgcn_fence(__ATOMIC_ACQUIRE, "workgroup"); } while (0)
#define CS_HANDBACK(nn) do { asm volatile("s_waitcnt lgkmcnt(0)" ::: "memory"); if (lane == 0) flg[8 + c] = (unsigned)((nn) + 1); asm volatile("" ::: "memory"); } while (0)
#define CS_YSTORE(nn, Y_) do { asm volatile("s_waitcnt vmcnt(24)" ::: "memory");   _Pragma("unroll") for (int rr = 0; rr < 4; ++rr) { const int q_ = 16 * (nn) + 4 * fg + rr, t_ = z ? (T - 1 - q_) : q_; yout[(mb + t_) * CW] = f2bf((Y_)[rr]); } } while (0)
        CS_READY(0); chain_load(F.lds, fr, fg, rg, opA);
#pragma unroll 1
        for (int n = 0; n < NCK; n += 2) {
            CS_READY(n + 1); CS_HANDBACK(n);
            chain_load(F.lds + ((n + 1) & (CS_R - 1)) * CS_SLOT, fr, fg, rg, opB);
            { const f32x4 Yc = chain_compute(opA, zacc); CS_YSTORE(n, Yc); }
            if (n + 2 < NCK) CS_READY(n + 2);
            CS_HANDBACK(n + 1);
            if (n + 2 < NCK) chain_load(F.lds + ((n + 2) & (CS_R - 1)) * CS_SLOT, fr, fg, rg, opA);
            { const f32x4 Yc = chain_compute(opB, zacc); CS_YSTORE(n + 1, Yc); }
        }
#undef CS_READY
#undef CS_HANDBACK
#undef CS_YSTORE
        __builtin_amdgcn_s_setprio(0);
    } else {
        const int pi = wave - CS_NCH;
        LAS unsigned char* scr = F.lds + CS_SCR + pi * CS_SCRW;
        LAS bf16* KT = (LAS bf16*)scr; LAS bf16* BT = (LAS bf16*)(scr + 2304);
        const bf16* gw_ = (const bf16*)(ws + WS_DECAY) + (size_t)z * M * CW + h * 64;
        const bf16* gkk = (const bf16*)(ws + WS_KK) + h * 64;
        const bf16* gak = (const bf16*)(ws + WS_AKK) + (size_t)z * M * CW + h * 64;
        const bf16* gk = (const bf16*)(ws + WS_KDIR) + (size_t)z * M * CW + h * 64;
        const bf16* gr = (const bf16*)(ws + WS_R) + h * 64;
        const bf16* gv = (const bf16*)(ws + WS_V) + h * 64;
        unsigned nw[16], nkk[16], nak[16], nk[16], nr[16], nv[16];
        constexpr long RSTEP = z ? -(long)CW : (long)CW;
#define CS_FETCH_A(nn) do { if ((nn) < NCK) { const size_t m0_ = (mb + (z ? (T - 1 - 16 * (nn)) : 16 * (nn))) * CW + lane; const bf16* pw_ = gw_ + m0_; const bf16* pkk_ = gkk + m0_; \
            _Pragma("unroll") for (int tt = 0; tt < 16; ++tt) { nw[tt] = pw_[tt * RSTEP]; nkk[tt] = pkk_[tt * RSTEP]; } } } while (0)
#define CS_FETCH_B(nn) do { if ((nn) < NCK) { asm volatile("s_waitcnt vmcnt(30)" ::: "memory"); const size_t m0_ = (mb + (z ? (T - 1 - 16 * (nn)) : 16 * (nn))) * CW + lane; const bf16* pak_ = gak + m0_; const bf16* pk_ = gk + m0_; \
            _Pragma("unroll") for (int tt = 0; tt < 16; ++tt) { nak[tt] = pak_[tt * RSTEP]; nk[tt] = pk_[tt * RSTEP]; } } } while (0)
#define CS_FETCH_C(nn) do { if ((nn) < NCK) { asm volatile("s_waitcnt vmcnt(30)" ::: "memory"); const size_t m0_ = (mb + (z ? (T - 1 - 16 * (nn)) : 16 * (nn))) * CW + lane; const bf16* pr_ = gr + m0_; const bf16* pv_ = gv + m0_; \
            _Pragma("unroll") for (int tt = 0; tt < 16; ++tt) { nr[tt] = pr_[tt * RSTEP]; nv[tt] = pv_[tt * RSTEP]; } } } while (0)
        CS_FETCH_A(pi); CS_FETCH_B(pi); CS_FETCH_C(pi);
#pragma unroll 1
        for (int n = pi; n < NCK; n += CS_NPR) {
            const int slot = n & (CS_R - 1);
            float wv[16], kkv[16], akv[16], kv[16], rv[16]; unsigned vq[16];
#pragma unroll
            for (int tt = 0; tt < 16; ++tt) { unsigned x0 = nw[tt], x1 = nkk[tt], x2 = nak[tt], x3 = nk[tt], x4 = nr[tt];
                asm volatile("" : "+v"(x0), "+v"(x1), "+v"(x2), "+v"(x3), "+v"(x4));
                wv[tt] = __uint_as_float(x0 << 16); kkv[tt] = __uint_as_float(x1 << 16); akv[tt] = __uint_as_float(x2 << 16); kv[tt] = __uint_as_float(x3 << 16); rv[tt] = __uint_as_float(x4 << 16); }
#pragma unroll
            for (int tt = 0; tt < 16; ++tt) { unsigned x0 = nv[tt]; asm volatile("" : "+v"(x0)); vq[tt] = x0; }
            CS_FETCH_A(n + CS_NPR);
            { unsigned sp = 0; for (;;) { const u32x2 pg = *(const volatile LAS u32x2*)(flg + 8); const int mn = (int)min(pg.x, pg.y);
                  if (mn >= n - (CS_R - 3)) break; __builtin_amdgcn_s_sleep(2); if (++sp > (1u << 24)) break; } }
            __builtin_amdgcn_fence(__ATOMIC_ACQUIRE, "workgroup");
            LAS unsigned char* sl = F.lds + slot * CS_SLOT;
            float P[16];
            P[0] = wv[0];
#pragma unroll
            for (int tt = 1; tt < 16; ++tt) P[tt] = P[tt - 1] * wv[tt];
            const float PL = P[15];
            float khat[16], bhat[16];
#pragma unroll
            for (int tt = 0; tt < 16; ++tt) {
                const float pm1 = tt ? P[tt - 1] : 1.0f, inv = __builtin_amdgcn_rcpf(P[tt]);
                const float at = kkv[tt] * pm1, rt = rv[tt] * P[tt], kt = kv[tt] * inv, bt = -akv[tt] * inv;
                khat[tt] = kt * PL; bhat[tt] = bt * PL;
                { const unsigned w_ = cvt_pk_bf16(at, rt); *(LAS bf16*)(sl + CS_AT + (tt * CS_LD + lane) * 2) = (bf16)w_; *(LAS bf16*)(sl + CS_RT + (tt * CS_LD + lane) * 2) = (bf16)(w_ >> 16); }
                { const unsigned w_ = cvt_pk_bf16(kt, bt); KT[tt * CS_LD + lane] = (bf16)w_; BT[tt * CS_LD + lane] = (bf16)(w_ >> 16); }
            }
            CS_FETCH_B(n + CS_NPR);
            { u32x4 o0, o1;
              o0.x = cvt_pk_bf16(khat[0], khat[1]); o0.y = cvt_pk_bf16(khat[2], khat[3]); o0.z = cvt_pk_bf16(khat[4], khat[5]); o0.w = cvt_pk_bf16(khat[6], khat[7]);
              o1.x = cvt_pk_bf16(khat[8], khat[9]); o1.y = cvt_pk_bf16(khat[10], khat[11]); o1.z = cvt_pk_bf16(khat[12], khat[13]); o1.w = cvt_pk_bf16(khat[14], khat[15]);
              *(LAS u32x4*)(sl + CS_KHT + lane * 32) = o0; *(LAS u32x4*)(sl + CS_KHT + lane * 32 + 16) = o1;
              o0.x = cvt_pk_bf16(bhat[0], bhat[1]); o0.y = cvt_pk_bf16(bhat[2], bhat[3]); o0.z = cvt_pk_bf16(bhat[4], bhat[5]); o0.w = cvt_pk_bf16(bhat[6], bhat[7]);
              o1.x = cvt_pk_bf16(bhat[8], bhat[9]); o1.y = cvt_pk_bf16(bhat[10], bhat[11]); o1.z = cvt_pk_bf16(bhat[12], bhat[13]); o1.w = cvt_pk_bf16(bhat[14], bhat[15]);
              *(LAS u32x4*)(sl + CS_BHT + lane * 32) = o0; *(LAS u32x4*)(sl + CS_BHT + lane * 32 + 16) = o1; }
            *(LAS float*)(sl + CS_PL + lane * 4) = PL;
            { u32x4 o0, o1;
              o0.x = vq[0] | (vq[1] << 16); o0.y = vq[2] | (vq[3] << 16); o0.z = vq[4] | (vq[5] << 16); o0.w = vq[6] | (vq[7] << 16);
              o1.x = vq[8] | (vq[9] << 16); o1.y = vq[10] | (vq[11] << 16); o1.z = vq[12] | (vq[13] << 16); o1.w = vq[14] | (vq[15] << 16);
              *(LAS u32x4*)(sl + CS_VT + lane * 32) = o0; *(LAS u32x4*)(sl + CS_VT + lane * 32 + 16) = o1; }
            asm volatile("s_waitcnt lgkmcnt(0)" ::: "memory");
            bf16x8 af[2], rf[2], kf[2], bf_[2];
#pragma unroll
            for (int ks = 0; ks < 2; ++ks) { af[ks] = *(const LAS bf16x8*)(sl + CS_AT + (fr * CS_LD + 32 * ks + 8 * fg) * 2); rf[ks] = *(const LAS bf16x8*)(sl + CS_RT + (fr * CS_LD + 32 * ks + 8 * fg) * 2);
                kf[ks] = *(const LAS bf16x8*)(KT + fr * CS_LD + 32 * ks + 8 * fg); bf_[ks] = *(const LAS bf16x8*)(BT + fr * CS_LD + 32 * ks + 8 * fg); }
            const f32x4 zero4 = {0.f, 0.f, 0.f, 0.f};
            f32x4 Xc = zero4, Xt = zero4, AakT = zero4, ArbT = zero4, ArkT = zero4;
#pragma unroll
            for (int ks = 0; ks < 2; ++ks) { Xc = CS_M32(af[ks], bf_[ks], Xc); Xt = CS_M32(bf_[ks], af[ks], Xt);
                AakT = CS_M32(kf[ks], af[ks], AakT); ArbT = CS_M32(bf_[ks], rf[ks], ArbT); ArkT = CS_M32(kf[ks], rf[ks], ArkT); }
            CS_FETCH_C(n + CS_NPR);
            f32x4 S1;
#pragma unroll
            for (int rr = 0; rr < 4; ++rr) { const int q = 4 * fg + rr;
                Xc[rr] = (fr < q) ? Xc[rr] : 0.f; Xt[rr] = (q < fr) ? Xt[rr] : 0.f; S1[rr] = Xt[rr] + ((q == fr) ? 1.0f : 0.f);
                AakT[rr] = (q < fr) ? AakT[rr] : 0.f; ArkT[rr] = (q <= fr) ? ArkT[rr] : 0.f; ArbT[rr] = (q <= fr) ? ArbT[rr] : 0.f; }
            { u32x2 w; w.x = cvt_pk_bf16(AakT[0], AakT[1]); w.y = cvt_pk_bf16(AakT[2], AakT[3]); *(LAS u32x2*)(sl + CS_AAK + o16) = w;
              w.x = cvt_pk_bf16(ArkT[0], ArkT[1]); w.y = cvt_pk_bf16(ArkT[2], ArkT[3]); *(LAS u32x2*)(sl + CS_ARK + o16) = w;
              w.x = cvt_pk_bf16(ArbT[0], ArbT[1]); w.y = cvt_pk_bf16(ArbT[2], ArbT[3]); *(LAS u32x2*)(sl + CS_ARB + o16) = w; }
#define CS_PK(v) ((u32x2){cvt_pk_bf16((v)[0], (v)[1]), cvt_pk_bf16((v)[2], (v)[3])})
            const u32x2 xc = CS_PK(Xc), xt = CS_PK(Xt), s1 = CS_PK(S1);
            const f32x4 X2c = CS_M16(xt, xc, zero4), X2t = CS_M16(xc, xt, zero4);
            const u32x2 x2c = CS_PK(X2c), x2t = CS_PK(X2t);
            const f32x4 S2 = CS_M16(x2c, s1, S1);
            const f32x4 X4c = CS_M16(x2t, x2c, zero4), X4t = CS_M16(x2c, x2t, zero4);
            const u32x2 x4c = CS_PK(X4c), x4t = CS_PK(X4t), s2 = CS_PK(S2);
            const f32x4 S4 = CS_M16(x4c, s2, S2);
            const f32x4 X8c = CS_M16(x4t, x4c, zero4);
            const u32x2 x8c = CS_PK(X8c), s4 = CS_PK(S4);
            const f32x4 S8 = CS_M16(x8c, s4, S4);
            *(LAS u32x2*)(sl + CS_TT + o16) = CS_PK(S8);
#undef CS_PK
            asm volatile("s_waitcnt lgkmcnt(0)" ::: "memory");
            __builtin_amdgcn_fence(__ATOMIC_RELEASE, "workgroup");
            if (lane == 0) flg[slot] = (unsigned)(n + 1);
        }
#undef CS_FETCH_A
#undef CS_FETCH_B
#undef CS_FETCH_C
    }
#undef CS_M32
#undef CS_M16
    __syncthreads();
}

__device__ __forceinline__ void scan_phase(const Frame& F, const Args& a, const int idx) {
    const int seq = idx >> 1, half = idx & 1;
    if (seq >> 5) scan_phase_z<1>(F, a, seq, half); else scan_phase_z<0>(F, a, seq, half);
}

__device__ __forceinline__ void combine_phase(const Frame& F, const Args& a) {
    unsigned char* ws = a.ws;
    const bf16* att = (const bf16*)(ws + WS_ATT); const bf16* rr = (const bf16*)(ws + WS_R); const bf16* vv = (const bf16*)(ws + WS_V);
    const bf16* kd = (const bf16*)(ws + WS_KDIR); const bf16* gg = (const bf16*)(ws + WS_G); const bf16* y = (const bf16*)(ws + WS_Y);
    bf16* mix = (bf16*)(ws + WS_MIX);
    const float* anw = a.in[4]; const float* r_k = a.in[14]; const float* ln_w = a.in[15]; const float* ln_b = a.in[16];
    const int lane = F.lane, c0 = 8 * lane;
    float nw[8], rk[8], lw[8], lb[8];
#pragma unroll
    for (int i = 0; i < 8; ++i) { nw[i] = anw[c0 + i]; rk[i] = r_k[c0 + i]; lw[i] = ln_w[c0 + i]; lb[i] = ln_b[c0 + i]; }
    const int gw = F.vcu * 8 + F.wave, NGW = F.G * 8;
#pragma unroll 2
    for (int m = gw; m < M; m += NGW) {
        const size_t o = (size_t)m * CW + c0;
        float f[8];
        unpack8(*(const u32x4*)(att + o), f);
        float ss = 0.f;
#pragma unroll
        for (int i = 0; i < 8; ++i) ss += f[i] * f[i];
        const float rs = rsqrtf(wave_sum(ss) * (1.f / CW) + RMS_EPS);
#pragma unroll
        for (int i = 0; i < 8; ++i) f[i] = f[i] * rs * nw[i];
        *(u32x4*)(mix + (size_t)m * D + c0) = pack8(f);
        float yv[8], yw[8];
        unpack8(*(const u32x4*)(y + o), yv); unpack8(*(const u32x4*)(y + (size_t)M * CW + o), yw);
#pragma unroll
        for (int i = 0; i < 8; ++i) yv[i] += yw[i];
        float s1 = 0.f;
#pragma unroll
        for (int i = 0; i < 8; ++i) s1 += yv[i];
        s1 += __shfl_xor(s1, 1); s1 += __shfl_xor(s1, 2); s1 += __shfl_xor(s1, 4);
        const float mean = s1 * (1.f / 64.f);
        float s2 = 0.f;
#pragma unroll
        for (int i = 0; i < 8; ++i) { yv[i] -= mean; s2 += yv[i] * yv[i]; }
        s2 += __shfl_xor(s2, 1); s2 += __shfl_xor(s2, 2); s2 += __shfl_xor(s2, 4);
        const float rstd = rsqrtf(s2 * (1.f / 64.f) + GN_EPS);
        float rf[8], k0[8], k1[8], vf[8], gf[8];
        unpack8(*(const u32x4*)(rr + o), rf); unpack8(*(const u32x4*)(kd + o), k0); unpack8(*(const u32x4*)(kd + (size_t)M * CW + o), k1);
        unpack8(*(const u32x4*)(vv + o), vf); unpack8(*(const u32x4*)(gg + o), gf);
        float cf = 0.f;
#pragma unroll
        for (int i = 0; i < 8; ++i) cf += rf[i] * (k0[i] + k1[i]) * rk[i];
        cf += __shfl_xor(cf, 1); cf += __shfl_xor(cf, 2); cf += __shfl_xor(cf, 4);
#pragma unroll
        for (int i = 0; i < 8; ++i) f[i] = (yv[i] * rstd * lw[i] + lb[i] + cf * vf[i]) * gf[i];
        *(u32x4*)(mix + (size_t)m * D + CW + c0) = pack8(f);
    }
}

constexpr int RT_PITCH = 1032, RT_WH = 0, RT_WL = 32 * RT_PITCH * 2, RT_HIST = 2 * RT_WL, RT_EL = RT_HIST + 256;
__device__ __forceinline__ void router_phase(const Frame& F, const Args& a) {
    unsigned char* ws = a.ws;
    const bf16* hbuf = (const bf16*)(ws + WS_H); unsigned char* hn2 = ws + WS_HN2;
    int* eidx = (int*)(ws + WS_EIDX); float* gate = (float*)(ws + WS_GATE); int* rank = (int*)(ws + WS_RANK);
    unsigned* ctl = (unsigned*)(ws + WS_CTL);
    const float* n2w = a.in[18]; const float* rw = a.in[19]; const float* rb = a.in[20];
    LAS bf16* wh = (LAS bf16*)(F.lds + RT_WH); LAS bf16* wl = (LAS bf16*)(F.lds + RT_WL); LAS int* hist = (LAS int*)(F.lds + RT_HIST); LAS int* eL = (LAS int*)(F.lds + RT_EL);
    { f32x4 tmp[16];
#pragma unroll
      for (int j = 0; j < 16; ++j) tmp[j] = *((const f32x4*)rw + F.tid + 512 * j);
#pragma unroll
      for (int j = 0; j < 16; ++j) { const int q = F.tid + 512 * j, d = q >> 3, e0 = 4 * (q & 7);
#pragma unroll
          for (int i = 0; i < 4; ++i) { const float w = tmp[j][i]; const unsigned hb = cvt_pk_bf16(w, 0.f) & 0xffffu; const float lo = w - __uint_as_float(hb << 16);
              wh[(e0 + i) * RT_PITCH + d] = (bf16)hb; wl[(e0 + i) * RT_PITCH + d] = (bf16)cvt_pk_bf16(lo, 0.f); } } }
    if (F.tid < 32) hist[F.tid] = 0;
    __syncthreads();
    const int lane = F.lane, tk = lane & 15, g = lane >> 4;
    const int blk = F.vcu;
    const int m = blk * 128 + F.wave * 16 + tk;
    const bf16* hrow = hbuf + (size_t)m * D + 8 * g;
    float ss = 0.f;
#pragma unroll 8
    for (int ks = 0; ks < 32; ++ks) { float xf[8]; unpack8(*(const u32x4*)(hrow + 32 * ks), xf);
        ss += (xf[0] * xf[0] + xf[1] * xf[1]) + (xf[2] * xf[2] + xf[3] * xf[3]) + (xf[4] * xf[4] + xf[5] * xf[5]) + (xf[6] * xf[6] + xf[7] * xf[7]); }
    ss += __shfl_xor(ss, 16); ss += __shfl_xor(ss, 32);
    const float rs = rsqrtf(ss * (1.f / D) + RMS_EPS);
    f32x4 acc0 = {0.f, 0.f, 0.f, 0.f}, acc1 = acc0;
    unsigned char* hrow8 = hn2 + (size_t)m * D + 8 * g;
    const LAS bf16* wh0 = wh + tk * RT_PITCH + 8 * g; const LAS bf16* wl0 = wl + tk * RT_PITCH + 8 * g;
#pragma unroll 4
    for (int ks = 0; ks < 32; ++ks) {
        float xf[8]; unpack8(*(const u32x4*)(hrow + 32 * ks), xf);
        const f32x4 x0 = {xf[0], xf[1], xf[2], xf[3]}, x1 = {xf[4], xf[5], xf[6], xf[7]};
        const f32x4 n0 = *(const f32x4*)(n2w + 32 * ks + 8 * g), n1 = *(const f32x4*)(n2w + 32 * ks + 8 * g + 4);
        const f32x4 y0 = x0 * rs * n0, y1 = x1 * rs * n1;
        { u32x2 w8; w8.x = pk4_fp8(y0.x * F8_SX, y0.y * F8_SX, y0.z * F8_SX, y0.w * F8_SX); w8.y = pk4_fp8(y1.x * F8_SX, y1.y * F8_SX, y1.z * F8_SX, y1.w * F8_SX); *(u32x2*)(hrow8 + 32 * ks) = w8; }
        union { u32x4 w; bf16x8 h8; } xh, xl;
        xh.w.x = cvt_pk_bf16(y0.x, y0.y); xh.w.y = cvt_pk_bf16(y0.z, y0.w); xh.w.z = cvt_pk_bf16(y1.x, y1.y); xh.w.w = cvt_pk_bf16(y1.z, y1.w);
        xl.w.x = cvt_pk_bf16(y0.x - bflo(xh.w.x), y0.y - bfhi(xh.w.x)); xl.w.y = cvt_pk_bf16(y0.z - bflo(xh.w.y), y0.w - bfhi(xh.w.y));
        xl.w.z = cvt_pk_bf16(y1.x - bflo(xh.w.z), y1.y - bfhi(xh.w.z)); xl.w.w = cvt_pk_bf16(y1.z - bflo(xh.w.w), y1.w - bfhi(xh.w.w));
        const bf16x8 a0h = *(const LAS bf16x8*)(wh0 + 32 * ks), a1h = *(const LAS bf16x8*)(wh0 + 16 * RT_PITCH + 32 * ks);
        const bf16x8 a0l = *(const LAS bf16x8*)(wl0 + 32 * ks), a1l = *(const LAS bf16x8*)(wl0 + 16 * RT_PITCH + 32 * ks);
        acc0 = __builtin_amdgcn_mfma_f32_16x16x32_bf16(a0h, xh.h8, acc0, 0, 0, 0); acc1 = __builtin_amdgcn_mfma_f32_16x16x32_bf16(a1h, xh.h8, acc1, 0, 0, 0);
        acc0 = __builtin_amdgcn_mfma_f32_16x16x32_bf16(a0h, xl.h8, acc0, 0, 0, 0); acc1 = __builtin_amdgcn_mfma_f32_16x16x32_bf16(a1h, xl.h8, acc1, 0, 0, 0);
        acc0 = __builtin_amdgcn_mfma_f32_16x16x32_bf16(a0l, xh.h8, acc0, 0, 0, 0); acc1 = __builtin_amdgcn_mfma_f32_16x16x32_bf16(a1l, xh.h8, acc1, 0, 0, 0);
    }
    float lv[8]; int li[8];
    { const f32x4 b0 = *(const f32x4*)(rb + 4 * g), b1 = *(const f32x4*)(rb + 16 + 4 * g);
#pragma unroll
      for (int i = 0; i < 4; ++i) { lv[i] = acc0[i] + b0[i]; li[i] = 4 * g + i; lv[4 + i] = acc1[i] + b1[i]; li[4 + i] = 16 + 4 * g + i; } }
    float tv[4]; int ti[4];
#pragma unroll
    for (int kx = 0; kx < 4; ++kx) {
        float bv = lv[0]; int bi = li[0];
#pragma unroll
        for (int i = 1; i < 8; ++i) { const bool gt = lv[i] > bv; bv = gt ? lv[i] : bv; bi = gt ? li[i] : bi; }
#pragma unroll
        for (int o = 16; o < 64; o <<= 1) { const float ov = __shfl_xor(bv, o); const int oi = __shfl_xor(bi, o); const bool tko = (ov > bv) || (ov == bv && oi < bi); bv = tko ? ov : bv; bi = tko ? oi : bi; }
        tv[kx] = bv; ti[kx] = bi;
#pragma unroll
        for (int i = 0; i < 8; ++i) lv[i] = (li[i] == bi) ? -3.0e38f : lv[i];
    }
    if (g == 0) {
        const float e0 = 1.0f, e1 = __expf(tv[1] - tv[0]), e2 = __expf(tv[2] - tv[0]), e3 = __expf(tv[3] - tv[0]);
        const float is = 1.0f / (e0 + e1 + e2 + e3);
        const float gs[4] = {e0 * is, e1 * is, e2 * is, e3 * is};
#pragma unroll
        for (int kx = 0; kx < 4; ++kx) { eidx[m * 4 + kx] = ti[kx]; gate[m * 4 + kx] = gs[kx]; eL[(m - blk * 128) * 4 + kx] = ti[kx]; }
    }
    __syncthreads();
    { const int t = F.tid, e = eL[t]; int rk = 0;
      for (int u = 0; u < t; ++u) rk += (eL[u] == e) ? 1 : 0;
      rank[(blk * 128) * 4 + t] = rk;
      __hip_atomic_fetch_add(&hist[e], 1, __ATOMIC_RELAXED, __HIP_MEMORY_SCOPE_WORKGROUP); }
    __syncthreads();
    if (F.tid < 32) ctl[CW_CNT + blk * 32 + F.tid] = (unsigned)hist[F.tid];
}

__device__ __forceinline__ void dispatch_phase(const Frame& F, const Args& a) {
    unsigned char* ws = a.ws;
    unsigned* ctl = (unsigned*)(ws + WS_CTL);
    const int* eidx = (const int*)(ws + WS_EIDX); const int* rank = (const int*)(ws + WS_RANK); int* dest = (int*)(ws + WS_DEST);
    LAS int* part = (LAS int*)F.lds;
    LAS int* tot = part + 1024;
    const int blk = F.vcu, G = F.G;
    { const int e = F.tid & 31, pt = F.tid >> 5; int s = 0, sb = 0;
      if (G == 256) { int cv[16];
#pragma unroll
          for (int q = 0; q < 16; ++q) cv[q] = (int)ld_u32_agent(ctl + CW_CNT + (pt + 16 * q) * 32 + e);
#pragma unroll
          for (int q = 0; q < 16; ++q) { s += cv[q]; if (pt + 16 * q < blk) sb += cv[q]; } }
      else for (int bb = pt; bb < G; bb += 16) { const int cval = (int)ld_u32_agent(ctl + CW_CNT + bb * 32 + e); s += cval; if (bb < blk) sb += cval; }
      part[pt * 32 + e] = s; part[512 + pt * 32 + e] = sb; }
    __syncthreads();
    if (F.tid < 32) { int s = 0, sb = 0;
        for (int pt = 0; pt < 16; ++pt) { s += part[pt * 32 + F.tid]; sb += part[512 + pt * 32 + F.tid]; }
        tot[F.tid] = s; tot[32 + F.tid] = sb; tot[96 + F.tid] = (s + 255) & ~255; }
    __syncthreads();
    if (F.tid == 0) { int ps = 0; for (int e = 0; e < 32; ++e) { tot[64 + e] = ps; ps += tot[96 + e]; }
        tot[128] = ps >> 8; }
    __syncthreads();
    if (blk == 0) {
        if (F.tid == 0) ctl[CW_NT] = (unsigned)tot[128];
        for (int e = F.tid >> 4; e < 32; e += 32) { const int t0 = tot[64 + e] >> 8, nt = tot[96 + e] >> 8; for (int i = F.tid & 15; i < nt; i += 16) ctl[CW_TEXP + t0 + i] = (unsigned)e; }
    }
    const int lane = F.lane;
    const int mw = blk * 128 + F.wave * 16;
    int* rowtok = (int*)(ws + WS_ROWTOK);
    { const int e = eidx[mw * 4 + lane]; const int dl = tot[64 + e] + tot[32 + e] + rank[mw * 4 + lane]; dest[mw * 4 + lane] = dl; rowtok[dl] = mw + (lane >> 2); }
    { const int e = blk & 31, pt = blk >> 5, np = G >> 5; const int r0 = tot[64 + e] + tot[e], r1 = tot[64 + e] + tot[96 + e];
      if (np > 0) for (int r = r0 + pt * 512 + F.tid; r < r1; r += np * 512) rowtok[r] = 0; }
}

__device__ __forceinline__ void final_phase(const Frame& F, const Args& a) {
    unsigned char* ws = a.ws;
    const bf16* hbuf = (const bf16*)(ws + WS_H); const unsigned char* ybuf = ws + WS_YBUF;
    const int* dest = (const int*)(ws + WS_DEST); const float* gate = (const float*)(ws + WS_GATE);
    const float* fw = a.in[25]; float* out = a.out;
    const int lane = F.lane;
    f32x4 wn[4];
#pragma unroll
    for (int j = 0; j < 4; ++j) wn[j] = *((const f32x4*)fw + lane + 64 * j);
    const int gw = F.vcu * 8 + F.wave, NGW = F.G * 8;
    const int per = M / NGW;
    const int mw = gw * per;
    int dl = 0; float gl = 0.f;
    if (lane < 4 * per && per <= 16) { dl = dest[mw * 4 + lane]; gl = gate[mw * 4 + lane]; }
#pragma unroll 2
    for (int i = 0; i < per; ++i) {
        const int m = mw + i;
        const u32x2* hr = (const u32x2*)(hbuf + (size_t)m * D) + lane;
        f32x4 v[4];
#pragma unroll
        for (int j = 0; j < 4; ++j) { const u32x2 w = hr[64 * j]; v[j] = (f32x4){bflo(w.x), bfhi(w.x), bflo(w.y), bfhi(w.y)}; }
#pragma unroll
        for (int kx = 0; kx < 4; ++kx) {
            const int d = per <= 16 ? __shfl(dl, 4 * i + kx) : dest[m * 4 + kx]; const float gt = (per <= 16 ? __shfl(gl, 4 * i + kx) : gate[m * 4 + kx]) * (1.0f / F8_SY);
            const unsigned* yr = (const unsigned*)(ybuf + (size_t)d * D) + lane;
#pragma unroll
            for (int j = 0; j < 4; ++j) { const unsigned w = yr[64 * j]; const f32x2 lo = __builtin_amdgcn_cvt_pk_f32_fp8((int)w, false), hi = __builtin_amdgcn_cvt_pk_f32_fp8((int)w, true);
                v[j].x += gt * lo.x; v[j].y += gt * lo.y; v[j].z += gt * hi.x; v[j].w += gt * hi.y; }
        }
        float s = 0.f;
#pragma unroll
        for (int j = 0; j < 4; ++j) s += (v[j].x * v[j].x + v[j].y * v[j].y) + (v[j].z * v[j].z + v[j].w * v[j].w);
        const float rs = rsqrtf(wave_sum(s) * (1.f / D) + RMS_EPS);
        f32x4* orow = (f32x4*)(out + (size_t)m * D) + lane;
#pragma unroll
        for (int j = 0; j < 4; ++j) orow[64 * j] = v[j] * rs * wn[j];
    }
}

__global__ void __launch_bounds__(512, 2) fwd_megakernel(Args args) {
    extern __shared__ __attribute__((aligned(16))) unsigned char lds_raw[];
    Frame F;
    F.lds = (LAS unsigned char*)lds_raw;
    F.tid = threadIdx.x; F.lane = F.tid & 63; F.wave = __builtin_amdgcn_readfirstlane(F.tid >> 6);
    F.G = gridDim.x; { const int bx = blockIdx.x; F.vcu = (F.G % 8 == 0) ? (bx % 8) * (F.G / 8) + bx / 8 : bx; }
    unsigned char* ws = args.ws;
    const int lo = args.ph_lo, hi = args.ph_hi;
#define IN(k) (lo <= (k) && (k) < hi)
#if MK_SPLIT
#define SEAM(k) do { } while (0)
#else
    cg::grid_group grid = cg::this_grid();
    { volatile LAS unsigned* st = (volatile LAS unsigned*)(F.lds + LDS_MISC); if (F.tid < 2) st[F.tid] = 0u; __syncthreads(); }
    const XcdBarrier xbar = xcd_barrier_post((unsigned*)(ws + WS_CTL) + CW_BAR, (volatile LAS unsigned*)(F.lds + LDS_MISC));
    if (lo < 0) grid.sync();
#define SEAM(k) do { if (IN(k) && IN((k) + 1)) xcd_barrier(xbar); } while (0)
#endif
#define REP2(k) if constexpr (((MK_REPEAT >> (k)) & 1) != 0)
#define PH1 { pg8::Gemm g{(const bf16*)(ws + WS_HN), (const bf16*)(ws + WS_WINT), 1024, nullptr, 0, nullptr}; \
        pg8::StaticOrder S; S.init(M / 256, NPROJ_PAD / 256, F.G, (int)blockIdx.x); \
        pg8::EpiProj E{(bf16*)(ws + WS_Q), (bf16*)(ws + WS_K), (bf16*)(ws + WS_VT), (bf16*)(ws + WS_P)}; \
        pg8::gemm_phase<pg8::EpiProj, true, true>(F.lds, g, S, E); }
#define PH5 { pg8::Gemm g{(const bf16*)(ws + WS_MIX), (const bf16*)(ws + WS_WOT), 1024, nullptr, 0, nullptr}; \
        pg8::StaticOrder S; S.init(M / 256, D / 256, F.G, (int)blockIdx.x); \
        pg8::EpiWo E{args.in[0], (bf16*)(ws + WS_H)}; \
        pg8::gemm_phase<pg8::EpiWo, true, true>(F.lds, g, S, E); }
#define PH8 { const unsigned* ctl = (const unsigned*)(ws + WS_CTL); const int ntile = (int)ld_u32_agent(ctl + CW_NT); \
        pg8::Gemm g{(const bf16*)(ws + WS_HN2), (const bf16*)(ws + WS_WUPT), 512, ctl + CW_TEXP, (size_t)2048 * 1024, (const int*)(ws + WS_ROWTOK)}; \
        pg8::StaticOrder S; S.init(ntile, 8, F.G, (int)blockIdx.x); \
        pg8::EpiUp E{args.in[22], ws + WS_ACT}; \
        pg8::gemm_phase<pg8::EpiUp, true, true, true, true>(F.lds, g, S, E); }
#define PH9 { const unsigned* ctl = (const unsigned*)(ws + WS_CTL); const int ntile = (int)ld_u32_agent(ctl + CW_NT); \
        pg8::Gemm g{(const bf16*)(ws + WS_ACT), (const bf16*)(ws + WS_WDNT), 512, ctl + CW_TEXP, (size_t)1024 * 1024, nullptr}; \
        pg8::StaticOrder S; S.init(ntile, 4, F.G, (int)blockIdx.x); \
        pg8::EpiDown E{args.in[24], ws + WS_YBUF}; \
        pg8::gemm_phase<pg8::EpiDown, true, true, false, true>(F.lds, g, S, E); }
    if (IN(0)) { p0_prologue(F, args); REP2(0) p0_prologue(F, args); }
    SEAM(0);
    if (IN(1)) { PH1 REP2(1) PH1 }
    SEAM(1);
    if (IN(2)) { prep_phase<true>(F, args); REP2(2) prep_phase<true>(F, args); }
    SEAM(2);
    if (IN(3)) {
        if ((F.vcu & 1) == 0 && (F.vcu >> 1) < 128) { scan_phase(F, args, F.vcu >> 1); REP2(3) scan_phase(F, args, F.vcu >> 1); }
        else { const int nside = F.G - min((F.G + 1) / 2, 128); const int q_ = min((F.vcu + 1) >> 1, 128); side_phase(F, args, F.vcu - q_, nside); REP2(11) side_phase(F, args, F.vcu - q_, nside); }
    }
    SEAM(3);
    if (IN(4)) { combine_phase(F, args); REP2(4) combine_phase(F, args); }
    SEAM(4);
    if (IN(5)) { PH5 REP2(5) PH5 }
    SEAM(5);
    if (IN(6)) { router_phase(F, args); REP2(6) { __syncthreads(); router_phase(F, args); } }
    SEAM(6);
    if (IN(7)) { dispatch_phase(F, args); REP2(7) { __syncthreads(); dispatch_phase(F, args); } }
    SEAM(7);
    if (IN(8)) { PH8 REP2(8) PH8 }
    SEAM(8);
    if (IN(9)) { PH9 REP2(9) PH9 }
    SEAM(9);
    if (IN(10)) { final_phase(F, args); REP2(10) final_phase(F, args); }
#undef IN
#undef SEAM
}

extern "C" void kernel_launch(void* const* d_in, const int* in_sizes, int n_in, void* d_out, int out_size, void* d_ws, size_t ws_size, hipStream_t stream) {
    static int grid = 0;
    if (grid == 0) {
        if (n_in != 26 || in_sizes[0] != M * D || out_size != M * D || ws_size < WS_END) { fprintf(stderr, "kernel_launch: unexpected problem (n_in %d, in0 %d, out %d, ws %zu)\n", n_in, n_in > 0 ? in_sizes[0] : -1, out_size, ws_size); grid = -1; return; }
        int dev = 0, cus = 0, per_cu = 0;
        if (hipGetDevice(&dev) != hipSuccess || hipDeviceGetAttribute(&cus, hipDeviceAttributeMultiprocessorCount, dev) != hipSuccess) { grid = -1; return; }
        if (hipFuncSetAttribute((const void*)fwd_megakernel, hipFuncAttributeMaxDynamicSharedMemorySize, LDS_BYTES) != hipSuccess) { fprintf(stderr, "kernel_launch: hipFuncSetAttribute failed\n"); grid = -1; return; }
        if (hipOccupancyMaxActiveBlocksPerMultiprocessor(&per_cu, (const void*)fwd_megakernel, 512, LDS_BYTES) != hipSuccess || per_cu < 1) { fprintf(stderr, "kernel_launch: occupancy query says %d\n", per_cu); per_cu = 1; }
        (void)hipGetLastError();
        grid = cus * 1;
        if (grid != 256) fprintf(stderr, "kernel_launch: note: %d CUs\n", cus);
    }
    if (grid < 0) return;
    if (hipMemsetAsync((char*)d_ws + WS_CTL + (size_t)CW_BAR * 4, 0, XCD_BAR_WORDS * 4, stream) != hipSuccess) { fprintf(stderr, "kernel_launch: memset failed\n"); return; }
    Args a{};
    for (int i = 0; i < 26; ++i) a.in[i] = (const float*)d_in[i];
    a.out = (float*)d_out; a.ws = (unsigned char*)d_ws;
#if MK_SPLIT
    for (int ph = 0; ph < NPHASE; ++ph) { a.ph_lo = ph; a.ph_hi = ph + 1; hipLaunchKernelGGL(fwd_megakernel, dim3(grid), dim3(512), LDS_BYTES, stream, a); }
#else
    a.ph_lo = 0; a.ph_hi = NPHASE;
    void* kargs[] = {&a};
    hipError_t e = hipLaunchCooperativeKernel((const void*)fwd_megakernel, dim3(grid), dim3(512), kargs, LDS_BYTES, stream);
    if (e != hipSuccess) fprintf(stderr, "kernel_launch: cooperative launch failed: %s (grid %d)\n", hipGetErrorString(e), grid);
#endif
}
```

```cpp
#include <hip/hip_runtime.h>
#include <hip/hip_cooperative_groups.h>
#include <cstdio>
#include <cstdint>
namespace cg = cooperative_groups;

#ifndef MK_SPLIT
#define MK_SPLIT 0
#endif

#ifndef MK_REPEAT
#define MK_REPEAT 0
#endif
#define LAS __attribute__((address_space(3)))
typedef unsigned short bf16;
typedef float f32x4 __attribute__((ext_vector_type(4)));
typedef float f32x2 __attribute__((ext_vector_type(2)));
typedef unsigned u32x4 __attribute__((ext_vector_type(4)));
typedef unsigned u32x2 __attribute__((ext_vector_type(2)));
typedef short bf16x8 __attribute__((ext_vector_type(8)));
typedef short s16x4 __attribute__((ext_vector_type(4)));

constexpr int BATCH = 4, T = 8192, D = 1024, M = BATCH * T;
constexpr int NH = 8, HD = 64, CW = 512;
constexpr int SHIFT_W = 1920, NPROJ = 3456, NPROJ_PAD = 3584, PW = 2048;
constexpr int NE = 32, TOPK = 4, DE = 1024;
constexpr int GRIDW = 64, GROWS = 128;
constexpr int P_TILES_MAX = 544, P_ROWS = P_TILES_MAX * 256;
constexpr float RMS_EPS = 1e-5f, GN_EPS = 64e-5f;
constexpr int NPHASE = 11;

constexpr size_t MiB = 1u << 20;
constexpr size_t WS_CTL = 0;
constexpr size_t WS_W2T = 1 * MiB, WS_A2T = WS_W2T + 131072, WS_G2T = WS_A2T + 131072;
constexpr size_t WS_WINT = 2 * MiB, WS_WOT = 9 * MiB, WS_WUPT = 12 * MiB, WS_WDNT = 140 * MiB;
constexpr size_t WS_EIDX = 204 * MiB, WS_GATE = WS_EIDX + 524288, WS_RANK = WS_GATE + 524288, WS_DEST = WS_RANK + 524288, WS_ROWTOK = WS_DEST + 524288;
constexpr size_t WS_R = 208 * MiB, WS_V = 240 * MiB, WS_KK = 272 * MiB, WS_DECAY = 304 * MiB, WS_KDIR = 368 * MiB, WS_AKK = 432 * MiB,
                 WS_G = 496 * MiB, WS_ATT = 528 * MiB;
constexpr size_t WS_Q = 560 * MiB, WS_K = 592 * MiB, WS_VT = 624 * MiB, WS_P = 656 * MiB, WS_HN = 784 * MiB, WS_Y = 848 * MiB;
constexpr size_t WS_MIX = 560 * MiB, WS_H = 752 * MiB, WS_HN2 = 880 * MiB, WS_XBUF = 208 * MiB, WS_ACT = 480 * MiB, WS_YBUF = 208 * MiB;
constexpr size_t WS_END = 976 * MiB;
constexpr int CW_NT = 0, CW_TEXP = 64, CW_CNT = 1024, CW_BAR = 16384;

constexpr int LDS_BYTES = 159744, LDS_MISC = LDS_BYTES - 256;

typedef __bf16 bf16x2_t __attribute__((ext_vector_type(2)));
__device__ __forceinline__ unsigned cvt_pk_bf16(float lo, float hi) { const f32x2 v = {lo, hi}; return __builtin_bit_cast(unsigned, __builtin_convertvector(v, bf16x2_t)); }
typedef int i32x8 __attribute__((ext_vector_type(8)));
typedef int i32x4 __attribute__((ext_vector_type(4)));
#ifndef F8_SCALE1
#define F8_SCALE1 0
#endif
constexpr float F8_SX = 32.0f, F8_SW = 128.0f, F8_SACT = 8.0f, F8_SY = 32.0f;
__device__ __forceinline__ float f8clamp(float v) { return __builtin_amdgcn_fmed3f(v, -448.0f, 448.0f); }
__device__ __forceinline__ unsigned pk4_fp8(float a, float b, float c, float d) { int w = 0; w = __builtin_amdgcn_cvt_pk_fp8_f32(f8clamp(a), f8clamp(b), w, false); w = __builtin_amdgcn_cvt_pk_fp8_f32(f8clamp(c), f8clamp(d), w, true); return (unsigned)w; }
__device__ __forceinline__ float bflo(unsigned u) { return __uint_as_float(u << 16); }
__device__ __forceinline__ float bfhi(unsigned u) { return __uint_as_float(u & 0xffff0000u); }
__device__ __forceinline__ float bf1(bf16 v) { return __uint_as_float(((unsigned)v) << 16); }
__device__ __forceinline__ void unpack8(const u32x4 u, float* f) { f[0] = bflo(u.x); f[1] = bfhi(u.x); f[2] = bflo(u.y); f[3] = bfhi(u.y); f[4] = bflo(u.z); f[5] = bfhi(u.z); f[6] = bflo(u.w); f[7] = bfhi(u.w); }
__device__ __forceinline__ u32x4 pack8(const float* f) { u32x4 o; o.x = cvt_pk_bf16(f[0], f[1]); o.y = cvt_pk_bf16(f[2], f[3]); o.z = cvt_pk_bf16(f[4], f[5]); o.w = cvt_pk_bf16(f[6], f[7]); return o; }
__device__ __forceinline__ float wave_sum(float v) {
#pragma unroll
    for (int o = 1; o < 64; o <<= 1) v += __shfl_xor(v, o);
    return v;
}
__device__ __forceinline__ float sigmoidf_(float x) { return __builtin_amdgcn_rcpf(1.0f + __expf(-x)); }
__device__ __forceinline__ unsigned ld_u32_agent(const unsigned* p) { return __hip_atomic_load(p, __ATOMIC_RELAXED, __HIP_MEMORY_SCOPE_AGENT); }

namespace pg8 {
constexpr int BM = 256, BK = 64, HALF = 128, HTB = HALF * BK * 2, STAGE_BYTES = 8 * HTB, NXCD = 8, WGM = 8;
__host__ __device__ __forceinline__ int lds_byte(int r, int c) { const int st = (r >> 4) * 2 + (c >> 5), rr = r & 15, cc = c & 31, ob = rr * 64 + cc * 2; return st * 1024 + (ob ^ (((ob >> 9) & 1) << 5)); }
__host__ __device__ __forceinline__ void stage_rc(int b, int& R, int& C) { const int st = b / 1024, sb = b % 1024, swz = sb ^ (((sb >> 9) & 1) << 5); R = (st >> 1) * 16 + swz / 64; C = (st & 1) * 32 + (swz % 64) / 2; }
__host__ __device__ __forceinline__ int perm32(int rho) { const int n = rho >> 4, i = rho & 15; return 8 * (i >> 2) + 4 * n + (i & 3); }

struct Unit { int pm, pn, e; };
struct Gemm { const bf16* A; const bf16* Bt; int K; const unsigned* texp; size_t bstride; const int* rowtok; };

struct StaticOrder {
    int nM, nN, nwg, G, c;
    __device__ void init(int nM_, int nN_, int G_, int c_) { nM = nM_; nN = nN_; nwg = nM * nN; G = G_; c = c_; }
    __device__ bool next(int i, Unit& u) const {
        const long L = (long)i * G + c; if (L >= nwg) return false;
        int wgid = (int)L; { const int q = nwg / NXCD, r = nwg % NXCD, xcd = wgid % NXCD, off = wgid / NXCD; wgid = (xcd < r ? xcd * (q + 1) : r * (q + 1) + (xcd - r) * q) + off; }
        const int nig = WGM * nN, gid = wgid / nig, fm = gid * WGM, gsz = (nM - fm) < WGM ? (nM - fm) : WGM;
        u.pm = fm + ((wgid % nig) % gsz); u.pn = (wgid % nig) / gsz; u.e = 0; return true;
    }
};

__device__ __forceinline__ i32x8 cat8(const bf16x8 lo, const bf16x8 hi) { return __builtin_shufflevector(__builtin_bit_cast(i32x4, lo), __builtin_bit_cast(i32x4, hi), 0, 1, 2, 3, 4, 5, 6, 7); }
template <class Epi, bool ALIGN_EPI, bool SP2, bool GATHER = false, bool FP8 = false>
__device__ __forceinline__ void gemm_phase(LAS unsigned char* lds, const Gemm g, const StaticOrder& S, const Epi& E) {
    const int tid = threadIdx.x, wid = __builtin_amdgcn_readfirstlane(tid >> 6), lane = tid & 63, wr = wid >> 2, wc = wid & 3, fr = lane & 15, fq = lane >> 4;
    const int K = g.K, nt = K / BK;
    unsigned voffA[2], voffB[2];
#pragma unroll
    for (int i = 0; i < 2; ++i) { int R, C; stage_rc(tid * 16 + i * 8192, R, C); const int Rb = Epi::PERM ? ((R & ~31) + perm32(R & 31)) : R;
        voffA[i] = (unsigned)(R * K + C) * 2u; voffB[i] = (unsigned)(Rb * K + C) * 2u; }
    unsigned vC[2][2];
#define PG8_GROWS(u, dst) do { _Pragma("unroll") for (int h_ = 0; h_ < 2; ++h_) _Pragma("unroll") for (int i_ = 0; i_ < 2; ++i_) { int R_, C_; stage_rc(tid * 16 + i_ * 8192, R_, C_); \
        dst[h_][i_] = (unsigned)g.rowtok[(u).pm * BM + h_ * HALF + R_] * (unsigned)(K * 2) + (unsigned)(C_ * 2); } } while (0)
    const size_t kstep = (size_t)(BK * 2);
    const size_t hstep = (size_t)HALF * K * 2;
    const size_t tstep = 2 * hstep;
    const unsigned ldsw = (unsigned)wid * 1024u;
    const int aoff = lds_byte(wr * 64 + fr, fq * 8), boff = lds_byte(wc * 32 + fr, fq * 8);
#define PG8_SA(b, h) (((b) * 2 + (h)) * HTB)
#define PG8_SB(b, h) ((4 + (b) * 2 + (h)) * HTB)
#define PG8_STAGE(bufoff, gbase, voff) do { _Pragma("unroll") for (int _i = 0; _i < 2; ++_i) \
        __builtin_amdgcn_global_load_lds((const unsigned*)((const char*)(gbase) + (voff)[_i]), (LAS unsigned*)(lds + (bufoff) + ldsw + _i * 8192), 16, 0, 0); } while (0)
#define PG8_STAGE_A(bufoff, p, h, nx) do { if constexpr (GATHER) { PG8_STAGE(bufoff, p, vC[h]); } else PG8_STAGE(bufoff, (p) + (h) * hstep, voffA); } while (0)
#define PG8_LDA(dst, b, h) do { _Pragma("unroll") for (int m = 0; m < 4; ++m) _Pragma("unroll") for (int k = 0; k < 2; ++k) dst[m][k] = *(const LAS bf16x8*)(lds + PG8_SA(b, h) + aoff + m * 2048 + k * 1024); } while (0)
#define PG8_LDB(dst, b, h) do { _Pragma("unroll") for (int n = 0; n < 2; ++n) _Pragma("unroll") for (int k = 0; k < 2; ++k) dst[n][k] = *(const LAS bf16x8*)(lds + PG8_SB(b, h) + boff + n * 2048 + k * 1024); } while (0)
#define PG8_MMA(ai, bj, At, Bt) do { __builtin_amdgcn_s_setprio(1); \
        if constexpr (FP8) { _Pragma("unroll") for (int m = 0; m < 4; ++m) _Pragma("unroll") for (int n = 0; n < 2; ++n) \
            { const i32x8 b8_ = cat8(Bt[n][0], Bt[n][1]), a8_ = cat8(At[m][0], At[m][1]); asm volatile("v_mfma_f32_16x16x128_f8f6f4 %0, %1, %2, %0" : "+v"(acc[ai][bj][m][n]) : "v"(b8_), "v"(a8_)); } } \
        else { _Pragma("unroll") for (int m = 0; m < 4; ++m) _Pragma("unroll") for (int n = 0; n < 2; ++n) _Pragma("unroll") for (int k = 0; k < 2; ++k) \
            acc[ai][bj][m][n] = __builtin_amdgcn_mfma_f32_16x16x32_bf16(Bt[n][k], At[m][k], acc[ai][bj][m][n], 0, 0, 0); } \
        __builtin_amdgcn_s_setprio(0); } while (0)
#define PG8_WAIT_V(n) asm volatile("s_waitcnt vmcnt(" #n ")" ::: "memory")
#define PG8_WAIT_L(n) asm volatile("s_waitcnt lgkmcnt(" #n ")" ::: "memory")
#define PG8_BAR __builtin_amdgcn_s_barrier()
#define PG8_SCHED __builtin_amdgcn_sched_barrier(0)
#define PG8_UPTR(u, pa, pb) do { unsigned _e = g.texp ? ld_u32_agent(g.texp + (u).pm) : 0u; _e = (unsigned)__builtin_amdgcn_readfirstlane((int)_e); (u).e = (int)_e; \
        pa = GATHER ? (const char*)g.A : (const char*)g.A + (size_t)(u).pm * tstep; pb = (const char*)g.Bt + (size_t)_e * g.bstride + (size_t)(u).pn * tstep; } while (0)
    Unit cur, nxt; int ui = 0;
    if (!S.next(0, cur)) return;
    f32x4 acc[2][2][4][2];
#pragma unroll
    for (int a = 0; a < 2; ++a)
#pragma unroll
        for (int b = 0; b < 2; ++b)
#pragma unroll
            for (int m = 0; m < 4; ++m)
#pragma unroll
                for (int n = 0; n < 2; ++n) acc[a][b][m][n] = (f32x4){0.f, 0.f, 0.f, 0.f};
    bf16x8 At[4][2], B0[2][2], B1[2][2];
    const char* cA; const char* cB;
    PG8_UPTR(cur, cA, cB);
    if constexpr (GATHER) { PG8_GROWS(cur, vC); }
    if constexpr (SP2) {
        PG8_STAGE(PG8_SB(0, 0), cB, voffB); PG8_STAGE(PG8_SB(0, 1), cB + hstep, voffB); PG8_STAGE_A(PG8_SA(0, 0), cA, 0, false); PG8_STAGE_A(PG8_SA(0, 1), cA, 1, false);
        if (wr == 1) PG8_BAR;
        PG8_WAIT_V(2); PG8_BAR;
        PG8_STAGE(PG8_SB(1, 0), cB + kstep, voffB); PG8_STAGE_A(PG8_SA(1, 0), cA + kstep, 0, false); PG8_STAGE(PG8_SB(1, 1), cB + hstep + kstep, voffB);
        PG8_WAIT_V(6); PG8_BAR;
    } else {
        PG8_STAGE(PG8_SB(0, 0), cB, voffB); PG8_STAGE_A(PG8_SA(0, 0), cA, 0, false); PG8_STAGE(PG8_SB(0, 1), cB + hstep, voffB); PG8_STAGE_A(PG8_SA(0, 1), cA, 1, false);
        if (wr == 1) PG8_BAR;
        PG8_WAIT_V(4); PG8_BAR;
        PG8_STAGE(PG8_SB(1, 0), cB + kstep, voffB); PG8_STAGE_A(PG8_SA(1, 0), cA + kstep, 0, false); PG8_STAGE(PG8_SB(1, 1), cB + hstep + kstep, voffB);
        PG8_WAIT_V(6); PG8_BAR;
    }
    for (;;) {
        const bool has_next = S.next(ui + 1, nxt);
        const char* nA = cA; const char* nB = cB;
        if (has_next) PG8_UPTR(nxt, nA, nB);
#pragma unroll 1
        for (int t = 0; t < nt; t += 2) {
            const bool last = (t == nt - 2);
            const char* a1 = cA + (size_t)(t + 1) * kstep;
            const char* a2 = last ? nA : cA + (size_t)(t + 2) * kstep; const char* b2 = last ? nB : cB + (size_t)(t + 2) * kstep;
            const char* a3 = a2 + kstep; const char* b3 = b2 + kstep;
            if constexpr (SP2) {
            PG8_LDB(B0, 0, 0); PG8_LDB(B1, 0, 1); PG8_SCHED; PG8_LDA(At, 0, 0); PG8_STAGE_A(PG8_SA(1, 1), a1, 1, false);
            if constexpr (GATHER) { if (last && has_next) { PG8_GROWS(nxt, vC); } }
            PG8_WAIT_V(8); PG8_WAIT_L(0); PG8_BAR; PG8_MMA(0, 0, At, B0); PG8_MMA(0, 1, At, B1); PG8_BAR; PG8_SCHED;
            PG8_LDA(At, 0, 1); PG8_STAGE(PG8_SB(0, 0), b2, voffB); PG8_STAGE(PG8_SB(0, 1), b2 + hstep, voffB); PG8_STAGE_A(PG8_SA(0, 0), a2, 0, last);
            PG8_WAIT_V(8); PG8_WAIT_L(0); PG8_BAR; PG8_MMA(1, 0, At, B0); PG8_MMA(1, 1, At, B1); PG8_BAR; PG8_SCHED;
            PG8_LDB(B0, 1, 0); PG8_LDB(B1, 1, 1); PG8_SCHED; PG8_LDA(At, 1, 0); PG8_STAGE_A(PG8_SA(0, 1), a2, 1, last);
            PG8_WAIT_V(8); PG8_WAIT_L(0); PG8_BAR; PG8_MMA(0, 0, At, B0); PG8_MMA(0, 1, At, B1); PG8_BAR; PG8_SCHED;
            PG8_LDA(At, 1, 1); PG8_STAGE(PG8_SB(1, 0), b3, voffB); PG8_STAGE(PG8_SB(1, 1), b3 + hstep, voffB); PG8_STAGE_A(PG8_SA(1, 0), a3, 0, last);
            PG8_WAIT_V(8); PG8_WAIT_L(0); PG8_BAR; PG8_MMA(1, 0, At, B0); PG8_MMA(1, 1, At, B1); PG8_BAR; PG8_SCHED;
            } else {
            PG8_LDB(B0, 0, 0); PG8_SCHED; PG8_LDA(At, 0, 0); PG8_STAGE_A(PG8_SA(1, 1), a1, 1, false);
            if constexpr (GATHER) { if (last && has_next) { PG8_GROWS(nxt, vC); } }
            PG8_WAIT_L(8); PG8_BAR; PG8_WAIT_L(0); PG8_MMA(0, 0, At, B0); PG8_BAR; PG8_SCHED;
            PG8_LDB(B1, 0, 1); PG8_STAGE(PG8_SB(0, 0), b2, voffB);
            PG8_BAR; PG8_WAIT_L(0); PG8_MMA(0, 1, At, B1); PG8_BAR;
            PG8_LDA(At, 0, 1); PG8_STAGE_A(PG8_SA(0, 0), a2, 0, last);
            PG8_BAR; PG8_WAIT_L(0); PG8_MMA(1, 0, At, B0); PG8_BAR; PG8_SCHED;
            PG8_STAGE(PG8_SB(0, 1), b2 + hstep, voffB);
            PG8_WAIT_V(6); PG8_BAR; PG8_MMA(1, 1, At, B1); PG8_BAR;
            PG8_LDB(B0, 1, 0); PG8_SCHED; PG8_LDA(At, 1, 0); PG8_STAGE_A(PG8_SA(0, 1), a2, 1, last);
            PG8_WAIT_L(8); PG8_BAR; PG8_WAIT_L(0); PG8_MMA(0, 0, At, B0); PG8_BAR; PG8_SCHED;
            PG8_LDB(B1, 1, 1); PG8_STAGE(PG8_SB(1, 0), b3, voffB);
            PG8_BAR; PG8_WAIT_L(0); PG8_MMA(0, 1, At, B1); PG8_BAR;
            PG8_LDA(At, 1, 1); PG8_STAGE_A(PG8_SA(1, 0), a3, 0, last);
            PG8_BAR; PG8_WAIT_L(0); PG8_MMA(1, 0, At, B0); PG8_BAR; PG8_SCHED;
            PG8_STAGE(PG8_SB(1, 1), b3 + hstep, voffB);
            PG8_WAIT_V(6); PG8_BAR; PG8_MMA(1, 1, At, B1); PG8_BAR;
            }
        }
        if constexpr (ALIGN_EPI) { if (wr == 0) PG8_BAR; }
        if constexpr (FP8) { asm volatile("s_nop 15\n\ts_nop 15" ::: "memory"); PG8_SCHED; }
        E(acc, cur, wr, wc, fr, fq);
        if (!has_next) break;
#pragma unroll
        for (int a = 0; a < 2; ++a)
#pragma unroll
            for (int b = 0; b < 2; ++b)
#pragma unroll
                for (int m = 0; m < 4; ++m)
#pragma unroll
                    for (int n = 0; n < 2; ++n) acc[a][b][m][n] = (f32x4){0.f, 0.f, 0.f, 0.f};
        cur = nxt; cA = nA; cB = nB; ++ui;
        if constexpr (ALIGN_EPI) { if (wr == 1) PG8_BAR; }
    }
    PG8_WAIT_V(0);
    if constexpr (!ALIGN_EPI) { if (wr == 0) PG8_BAR; }
    PG8_BAR;
#undef PG8_SA
#undef PG8_SB
#undef PG8_STAGE
#undef PG8_LDA
#undef PG8_LDB
#undef PG8_MMA
#undef PG8_WAIT_V
#undef PG8_WAIT_L
#undef PG8_BAR
#undef PG8_SCHED
#undef PG8_UPTR
#undef PG8_STAGE_A
#undef PG8_GROWS
}

struct EpiProj {
    static constexpr bool PERM = true;
    bf16 *q, *k, *vT, *p;
    __device__ __forceinline__ void operator()(const f32x4 (&acc)[2][2][4][2], const Unit& u, int wr, int wc, int fr, int fq) const {
        const int row0 = u.pm * BM + wr * 64 + fr;
        const int pn = u.pn;
#pragma unroll
        for (int ai = 0; ai < 2; ++ai)
#pragma unroll
            for (int m = 0; m < 4; ++m) {
                const int row = row0 + ai * HALF + m * 16;
#pragma unroll
                for (int bj = 0; bj < 2; ++bj) {
                    f32x4 v0 = acc[ai][bj][m][0], v1 = acc[ai][bj][m][1];
                    const int col = pn * BM + bj * HALF + wc * 32 + 8 * fq;
                    if (pn >= 4 && pn < 6) {
                        const int cv = col - 1024, hh = cv >> 6, dim = cv & 63, b = row / T, t = row % T;
                        bf16* dst = vT + ((size_t)(((b * NH + hh) * GROWS + (t >> 6)) * HD + dim)) * 64 + (t & 63);
                        const unsigned w0 = cvt_pk_bf16(v0[0], v0[1]), w1 = cvt_pk_bf16(v0[2], v0[3]), w2 = cvt_pk_bf16(v1[0], v1[1]), w3 = cvt_pk_bf16(v1[2], v1[3]);
                        dst[0 * 64] = (bf16)(w0 & 0xffff); dst[1 * 64] = (bf16)(w0 >> 16); dst[2 * 64] = (bf16)(w1 & 0xffff); dst[3 * 64] = (bf16)(w1 >> 16);
                        dst[4 * 64] = (bf16)(w2 & 0xffff); dst[5 * 64] = (bf16)(w2 >> 16); dst[6 * 64] = (bf16)(w3 & 0xffff); dst[7 * 64] = (bf16)(w3 >> 16);
                        asm volatile("s_waitcnt vmcnt(40)" ::: "memory");
                    } else {
                        bf16* dst;
                        if (pn < 2) { v0 = v0 * 0.125f; v1 = v1 * 0.125f; dst = q + (size_t)row * CW + col; }
                        else if (pn < 4) dst = k + (size_t)row * CW + (col - 512);
                        else dst = p + (size_t)row * PW + (col - 1536);
                        u32x4 w; w.x = cvt_pk_bf16(v0[0], v0[1]); w.y = cvt_pk_bf16(v0[2], v0[3]); w.z = cvt_pk_bf16(v1[0], v1[1]); w.w = cvt_pk_bf16(v1[2], v1[3]);
                        *(u32x4*)dst = w;
                    }
                }
            }
    }
};
struct EpiWo {
    static constexpr bool PERM = true;
    const float* x; bf16* h;
    __device__ __forceinline__ void operator()(const f32x4 (&acc)[2][2][4][2], const Unit& u, int wr, int wc, int fr, int fq) const {
        const int row0 = u.pm * BM + wr * 64 + fr, col0 = u.pn * BM + wc * 32 + 8 * fq;
#pragma unroll
        for (int ai = 0; ai < 2; ++ai)
#pragma unroll
            for (int m = 0; m < 4; ++m) { const size_t off = (size_t)(row0 + ai * HALF + m * 16) * D + col0;
#pragma unroll
                for (int bj = 0; bj < 2; ++bj) { const f32x4 v0 = acc[ai][bj][m][0] + *(const f32x4*)(x + off + bj * HALF), v1 = acc[ai][bj][m][1] + *(const f32x4*)(x + off + bj * HALF + 4);
                    u32x4 w; w.x = cvt_pk_bf16(v0[0], v0[1]); w.y = cvt_pk_bf16(v0[2], v0[3]); w.z = cvt_pk_bf16(v1[0], v1[1]); w.w = cvt_pk_bf16(v1[2], v1[3]);
                    *(u32x4*)(h + off + bj * HALF) = w; } }
    }
};
struct EpiUp {
    static constexpr bool PERM = true;
    const float* b_up; unsigned char* act;
    __device__ __forceinline__ void operator()(const f32x4 (&acc)[2][2][4][2], const Unit& u, int wr, int wc, int fr, int fq) const {
        const int row0 = u.pm * BM + wr * 64 + fr, ch = u.pn * 128 + wc * 32 + 8 * fq;
        const float* bg = b_up + (size_t)u.e * 2048 + ch; const float* bl = bg + 1024;
        const f32x4 bg0 = *(const f32x4*)bg * F8_SACT, bg1 = *(const f32x4*)(bg + 4) * F8_SACT, bl0 = *(const f32x4*)bl, bl1 = *(const f32x4*)(bl + 4);
        constexpr float SG = F8_SACT / (F8_SX * F8_SW), SL = 1.0f / (F8_SX * F8_SW), KE = -1.702f * 1.44269504f / F8_SACT;
#pragma unroll
        for (int ai = 0; ai < 2; ++ai)
#pragma unroll
            for (int m = 0; m < 4; ++m) {
                float o[8];
#pragma unroll
                for (int n = 0; n < 2; ++n) { const f32x4 gv = acc[ai][0][m][n] * SG + (n ? bg1 : bg0), lv = acc[ai][1][m][n] * SL + (n ? bl1 : bl0);
#pragma unroll
                    for (int j = 0; j < 4; ++j) { const float gt = fminf(gv[j], 7.0f * F8_SACT), li = __builtin_amdgcn_fmed3f(lv[j], -7.0f, 7.0f);
                        const float t = gt * __builtin_amdgcn_rcpf(1.0f + __builtin_amdgcn_exp2f(gt * KE)); o[n * 4 + j] = __builtin_fmaf(li, t, t); } }
                int w0 = 0, w1 = 0;
                w0 = __builtin_amdgcn_cvt_pk_fp8_f32(o[0], o[1], w0, false); w0 = __builtin_amdgcn_cvt_pk_fp8_f32(o[2], o[3], w0, true);
                w1 = __builtin_amdgcn_cvt_pk_fp8_f32(o[4], o[5], w1, false); w1 = __builtin_amdgcn_cvt_pk_fp8_f32(o[6], o[7], w1, true);
                u32x2 w8; w8.x = (unsigned)w0; w8.y = (unsigned)w1;
                *(u32x2*)(act + (size_t)(row0 + ai * HALF + m * 16) * DE + ch) = w8;
            }
    }
};
struct EpiDown {
    static constexpr bool PERM = true;
    const float* b_dn; unsigned char* y;
    __device__ __forceinline__ void operator()(const f32x4 (&acc)[2][2][4][2], const Unit& u, int wr, int wc, int fr, int fq) const {
        const int row0 = u.pm * BM + wr * 64 + fr, col0 = u.pn * BM + wc * 32 + 8 * fq;
        const float* bb = b_dn + (size_t)u.e * D + col0;
        f32x4 bv[2][2];
#pragma unroll
        for (int bj = 0; bj < 2; ++bj)
#pragma unroll
            for (int n = 0; n < 2; ++n) bv[bj][n] = *(const f32x4*)(bb + bj * HALF + 4 * n) * F8_SY;
#pragma unroll
        for (int ai = 0; ai < 2; ++ai)
#pragma unroll
            for (int m = 0; m < 4; ++m) { unsigned char* rowp = y + (size_t)(row0 + ai * HALF + m * 16) * D + col0;
#pragma unroll
                for (int bj = 0; bj < 2; ++bj) { const f32x4 v0 = acc[ai][bj][m][0] * (F8_SY / (F8_SACT * F8_SW)) + bv[bj][0], v1 = acc[ai][bj][m][1] * (F8_SY / (F8_SACT * F8_SW)) + bv[bj][1];
                    u32x2 w; w.x = pk4_fp8(v0[0], v0[1], v0[2], v0[3]); w.y = pk4_fp8(v1[0], v1[1], v1[2], v1[3]);
                    *(u32x2*)(rowp + bj * HALF) = w; } }
    }
};
}


#define XB_TMO      128
#define XB_XCNT(j)  (256  + 64 * (j))
#define XB_XSUB(j)  (1280 + 64 * (j))
#define XB_XGEN(j)  (2304 + 64 * (j))
#define XB_TOP      3328
#define XB_TOPGEN   3392
#define XCD_BAR_WORDS 3456
#define XB_SPIN_CAP (1u << 20)
__device__ __forceinline__ unsigned xb_ld(unsigned* p)              { return __hip_atomic_load(p, __ATOMIC_RELAXED, __HIP_MEMORY_SCOPE_AGENT); }
__device__ __forceinline__ unsigned xb_add(unsigned* p, unsigned v) { return __hip_atomic_fetch_add(p, v, __ATOMIC_RELAXED, __HIP_MEMORY_SCOPE_AGENT); }
__device__ __forceinline__ unsigned xb_xcc_id() { return (unsigned)__builtin_amdgcn_s_getreg((3 << 11) | 20) & 0xFu; }
#define XB_SPIN(cond, bar) do { unsigned _sp = 0; while (cond) { __builtin_amdgcn_s_sleep(1); \
    if ((++_sp & 255u) == 0u) { if (xb_ld(&(bar)[XB_TMO])) break; if (_sp > XB_SPIN_CAP) { atomicAdd(&(bar)[XB_TMO], 1u); break; } } } } while (0)
struct XcdBarrier { unsigned* bar; unsigned x; volatile LAS unsigned* st; };
__device__ __forceinline__ XcdBarrier xcd_barrier_post(unsigned* bar, volatile LAS unsigned* st) {
    XcdBarrier b; b.bar = bar; b.x = xb_xcc_id(); b.st = st;
    if (threadIdx.x == 0) (void)xb_add(&bar[XB_XCNT(b.x)], 1u);
    return b;
}
__device__ __forceinline__ void xcd_barrier_complete(unsigned* bar, unsigned x, unsigned& nloc, unsigned& nx) {
    const unsigned G = gridDim.x * gridDim.y * gridDim.z;
    unsigned sum, cnt, mine, sp = 0u;
    for (;;) {
        sum = 0u; cnt = 0u; mine = 0u;
#pragma unroll
        for (unsigned j = 0; j < 16; ++j) { const unsigned c = xb_ld(&bar[XB_XCNT(j)]); sum += c; cnt += (c > 0u) ? 1u : 0u; mine = (j == x) ? c : mine; }
        if (sum == G) break;
        __builtin_amdgcn_s_sleep(1);
        if ((++sp & 255u) == 0u) { if (xb_ld(&bar[XB_TMO])) break; if (sp > XB_SPIN_CAP) { atomicAdd(&bar[XB_TMO], 1u); break; } }
    }
    nloc = mine > 0u ? mine : 1u; nx = cnt > 0u ? cnt : 1u;
}
__device__ __forceinline__ void xcd_barrier(const XcdBarrier& b) {
    asm volatile("s_waitcnt vmcnt(0)" ::: "memory");
    __syncthreads();
    if (threadIdx.x == 0) {
        unsigned* bar = b.bar;
        __builtin_amdgcn_s_waitcnt(0);
        unsigned nloc = b.st[0], nx = b.st[1];
        if (nloc == 0u) { xcd_barrier_complete(bar, b.x, nloc, nx); b.st[0] = nloc; b.st[1] = nx; }
        const unsigned old = xb_add(&bar[XB_XSUB(b.x)], 1u);
        const unsigned gen = old / nloc;
        if (old + 1u == (gen + 1u) * nloc) {
            __builtin_amdgcn_fence(__ATOMIC_RELEASE, "agent");
            asm volatile("s_waitcnt vmcnt(0)" ::: "memory");
            const unsigned og = xb_add(&bar[XB_TOP], 1u);
            const unsigned tg = og / nx;
            if (og + 1u == (tg + 1u) * nx) xb_add(&bar[XB_TOPGEN], 1u);
            else XB_SPIN(xb_ld(&bar[XB_TOPGEN]) == tg, bar);
            __builtin_amdgcn_fence(__ATOMIC_ACQUIRE, "agent");
            xb_add(&bar[XB_XGEN(b.x)], 1u);
            asm volatile("s_waitcnt vmcnt(0)" ::: "memory");
        } else {
            XB_SPIN(xb_ld(&bar[XB_XGEN(b.x)]) == gen, bar);
            __builtin_amdgcn_fence(__ATOMIC_ACQUIRE, "agent");
            asm volatile("s_waitcnt vmcnt(0)" ::: "memory");
        }
    }
    __syncthreads();
}

struct Args { const float* in[26]; float* out; unsigned char* ws; int ph_lo, ph_hi; };

struct Frame { LAS unsigned char* lds; int tid, lane, wave, G, vcu; };

__device__ __forceinline__ void transpose_item(const float* W, int K, int N, bf16* WT, int k0, int n0, int orow0, LAS float* scr, int lane) {
#pragma unroll 8
    for (int i = 0; i < 32; ++i) { const int kk = 2 * i + (lane >> 5); scr[kk * 33 + (lane & 31)] = W[(size_t)(k0 + kk) * N + n0 + (lane & 31)]; }
    asm volatile("s_waitcnt lgkmcnt(0)" ::: "memory");
    const int c = lane & 7;
#pragma unroll
    for (int j = 0; j < 4; ++j) { const int n = (lane >> 3) + 8 * j; const LAS float* s = scr + (8 * c) * 33 + n;
        u32x4 o; o.x = cvt_pk_bf16(s[0 * 33], s[1 * 33]); o.y = cvt_pk_bf16(s[2 * 33], s[3 * 33]); o.z = cvt_pk_bf16(s[4 * 33], s[5 * 33]); o.w = cvt_pk_bf16(s[6 * 33], s[7 * 33]);
        *(u32x4*)(WT + (size_t)(orow0 + n) * K + k0 + 8 * c) = o; }
    asm volatile("s_waitcnt lgkmcnt(0)" ::: "memory");
}

__device__ __forceinline__ void transpose_item8(const float* W, int K, int N, unsigned char* WT, int k0, int n0, int orow0, LAS float* scr, int lane) {
#pragma unroll 8
    for (int i = 0; i < 32; ++i) { const int kk = 2 * i + (lane >> 5); scr[kk * 33 + (lane & 31)] = W[(size_t)(k0 + kk) * N + n0 + (lane & 31)]; }
    asm volatile("s_waitcnt lgkmcnt(0)" ::: "memory");
    const int c = lane & 7;
#pragma unroll
    for (int j = 0; j < 4; ++j) { const int n = (lane >> 3) + 8 * j; const LAS float* s = scr + (8 * c) * 33 + n;
        u32x2 o; o.x = pk4_fp8(s[0 * 33] * F8_SW, s[1 * 33] * F8_SW, s[2 * 33] * F8_SW, s[3 * 33] * F8_SW); o.y = pk4_fp8(s[4 * 33] * F8_SW, s[5 * 33] * F8_SW, s[6 * 33] * F8_SW, s[7 * 33] * F8_SW);
        *(u32x2*)(WT + (size_t)(orow0 + n) * K + k0 + 8 * c) = o; }
    asm volatile("s_waitcnt lgkmcnt(0)" ::: "memory");
}

__device__ __forceinline__ void p0_prologue(const Frame& F, const Args& a) {
    unsigned char* ws = a.ws;
    LAS float* scr = (LAS float*)(F.lds + F.wave * 8448);
    const int gw = F.vcu * 8 + F.wave, NGW = F.G * 8;
    constexpr int I_IN = 16 * 108, I_O = 16 * 32, I_L = 16, I_G = 32;
    constexpr int NITEMS = I_IN + I_O + 2 * I_L + 2 * I_L + I_G;
    for (int it = gw; it < NITEMS; it += NGW) {
        int r = it;
        if (r < I_IN) { const int kb = r / 108, nb = r % 108; transpose_item(a.in[2], 1024, NPROJ, (bf16*)(ws + WS_WINT), kb * 64, nb * 32, nb * 32, scr, F.lane); continue; }
        r -= I_IN;
        if (r < I_O) { const int kb = r / 32, nb = r % 32; transpose_item(a.in[17], 1024, 1024, (bf16*)(ws + WS_WOT), kb * 64, nb * 32, nb * 32, scr, F.lane); continue; }
        r -= I_O;
        if (r < 2 * I_L) { const int z = r / 16, nb = r % 16; transpose_item(a.in[8] + (size_t)z * 64 * 512, 64, 512, (bf16*)(ws + WS_W2T) + (size_t)z * 512 * 64, 0, nb * 32, nb * 32, scr, F.lane); continue; }
        r -= 2 * I_L;
        if (r < 2 * I_L) { const int z = r / 16, nb = r % 16; transpose_item(a.in[10] + (size_t)z * 64 * 512, 64, 512, (bf16*)(ws + WS_A2T) + (size_t)z * 512 * 64, 0, nb * 32, nb * 32, scr, F.lane); continue; }
        r -= 2 * I_L;
        { const int kb = r / 16, nb = r % 16; transpose_item(a.in[11], 128, 512, (bf16*)(ws + WS_G2T), kb * 64, nb * 32, nb * 32, scr, F.lane); }
    }
    { constexpr int I_UP = 32 * 16 * 64, I_DN = 32 * 16 * 32;
      for (int r = gw; r < I_UP + I_DN; r += NGW) {
        if (r < I_UP) {
            const int e = r / 1024, q = r % 1024, kb = q / 64, nb = q % 64, n0 = nb * 32;
            const int orow0 = n0 < 1024 ? 256 * (n0 >> 7) + (n0 & 127) : 256 * ((n0 - 1024) >> 7) + 128 + ((n0 - 1024) & 127);
            transpose_item8(a.in[21] + (size_t)e * 1024 * 2048, 1024, 2048, ws + WS_WUPT + (size_t)e * 2048 * 1024, kb * 64, n0, orow0, scr, F.lane); }
        else { const int r2 = r - I_UP, e = r2 / 512, q = r2 % 512, kb = q / 32, nb = q % 32;
            transpose_item8(a.in[23] + (size_t)e * 1024 * 1024, 1024, 1024, ws + WS_WDNT + (size_t)e * 1024 * 1024, kb * 64, nb * 32, nb * 32, scr, F.lane); } } }
    { u32x4* z = (u32x4*)(ws + WS_WINT + (size_t)NPROJ * 1024 * 2); const u32x4 zero = {0u, 0u, 0u, 0u};
      for (int i = F.vcu * 512 + F.tid; i < 16384; i += F.G * 512) z[i] = zero; }
    const float* x = a.in[0]; const float* nw = a.in[1]; bf16* hn = (bf16*)(ws + WS_HN);
    f32x4 wv[4];
#pragma unroll
    for (int j = 0; j < 4; ++j) wv[j] = *((const f32x4*)nw + F.lane + 64 * j);
    for (int m = gw; m < M; m += 2 * NGW) {
        const int m1 = m + NGW; const bool has1 = m1 < M;
        const f32x4* xr0 = (const f32x4*)(x + (size_t)m * D) + F.lane; const f32x4* xr1 = (const f32x4*)(x + (size_t)(has1 ? m1 : m) * D) + F.lane;
        f32x4 v0[4], v1[4]; float s0 = 0.f, s1 = 0.f;
#pragma unroll
        for (int j = 0; j < 4; ++j) { v0[j] = xr0[64 * j]; v1[j] = xr1[64 * j]; }
#pragma unroll
        for (int j = 0; j < 4; ++j) { s0 += (v0[j].x * v0[j].x + v0[j].y * v0[j].y) + (v0[j].z * v0[j].z + v0[j].w * v0[j].w); s1 += (v1[j].x * v1[j].x + v1[j].y * v1[j].y) + (v1[j].z * v1[j].z + v1[j].w * v1[j].w); }
        const float rs0 = rsqrtf(wave_sum(s0) * (1.f / D) + RMS_EPS), rs1 = rsqrtf(wave_sum(s1) * (1.f / D) + RMS_EPS);
        u32x2* o0 = (u32x2*)(hn + (size_t)m * D) + F.lane; u32x2* o1 = (u32x2*)(hn + (size_t)m1 * D) + F.lane;
#pragma unroll
        for (int j = 0; j < 4; ++j) { u32x2 o; o.x = cvt_pk_bf16(v0[j].x * rs0 * wv[j].x, v0[j].y * rs0 * wv[j].y); o.y = cvt_pk_bf16(v0[j].z * rs0 * wv[j].z, v0[j].w * rs0 * wv[j].w); o0[64 * j] = o; }
        if (has1) {
#pragma unroll
            for (int j = 0; j < 4; ++j) { u32x2 o; o.x = cvt_pk_bf16(v1[j].x * rs1 * wv[j].x, v1[j].y * rs1 * wv[j].y); o.y = cvt_pk_bf16(v1[j].z * rs1 * wv[j].z, v1[j].w * rs1 * wv[j].w); o1[64 * j] = o; } }
    }
}

constexpr int PREP_KBUF = 0, PREP_INV = 65536, PREP_AW = 67584, PREP_AA = PREP_AW + 17408, PREP_AG = PREP_AA + 17408, PREP_LD = 136;
template <bool STORE>
__device__ __forceinline__ void prep_phase(const Frame& F, const Args& a) {
    unsigned char* ws = a.ws;
    const bf16* p = (const bf16*)(ws + WS_P);
    bf16* r_out = (bf16*)(ws + WS_R); bf16* v_out = (bf16*)(ws + WS_V); bf16* kk_out = (bf16*)(ws + WS_KK);
    bf16* decay_out = (bf16*)(ws + WS_DECAY); bf16* kdir_out = (bf16*)(ws + WS_KDIR); bf16* akk_out = (bf16*)(ws + WS_AKK); bf16* g_out = (bf16*)(ws + WS_G);
    const bf16* w2T = (const bf16*)(ws + WS_W2T); const bf16* a2T = (const bf16*)(ws + WS_A2T); const bf16* g2T = (const bf16*)(ws + WS_G2T);
    const float* mu_p = a.in[5]; const float* mu_n = a.in[6]; const float* w0 = a.in[7]; const float* a0 = a.in[9];
    const float* k_k = a.in[12]; const float* k_a = a.in[13];
    LAS bf16* kbuf = (LAS bf16*)(F.lds + PREP_KBUF); LAS float* invb = (LAS float*)(F.lds + PREP_INV);
    LAS bf16* Aw = (LAS bf16*)(F.lds + PREP_AW); LAS bf16* Aa = (LAS bf16*)(F.lds + PREP_AA); LAS bf16* Ag = (LAS bf16*)(F.lds + PREP_AG);
    const int lane = F.lane, wave = F.wave, fr = lane & 15, fg = lane >> 4;
    for (int tile = F.vcu; tile < M / 64; tile += F.G) {
        const int m0 = tile * 64;
#pragma unroll 1
        for (int jj = 0; jj < 4; ++jj) {
            const int q = lane + 64 * jj; const bool valid = q < 240; const int c0 = 8 * q;
            float mp[8], mn[8];
#pragma unroll
            for (int i = 0; i < 8; ++i) { mp[i] = valid ? mu_p[c0 + i] : 0.f; mn[i] = valid ? mu_n[c0 + i] : 0.f; }
            const int mfirst = m0 + wave * 8;
            const u32x4 zero = {0u, 0u, 0u, 0u};
            u32x4 rows[10];
#pragma unroll
            for (int rI = 0; rI < 10; ++rI) { const int mr = mfirst - 1 + rI;
                const bool ok = valid && !(rI == 0 && (mfirst % T) == 0) && !(rI == 9 && ((mfirst + 7) % T) == T - 1);
                rows[rI] = ok ? *(const u32x4*)(p + (size_t)mr * PW + c0) : zero; }
#pragma unroll
            for (int i = 0; i < 8; ++i) {
                const int m = mfirst + i, it = wave * 8 + i;
                const u32x4 prev = rows[i], cur = rows[i + 1], nxt = rows[i + 2];
                float fp[8], fc[8], fn[8], s[8];
                unpack8(prev, fp); unpack8(cur, fc); unpack8(nxt, fn);
#pragma unroll
                for (int e = 0; e < 8; ++e) s[e] = fc[e] + mp[e] * (fp[e] - fc[e]) + mn[e] * (fn[e] - fc[e]);
                if (jj == 0) { if (STORE) { *(u32x4*)(r_out + (size_t)m * CW + c0) = pack8(s); } }
                else if (jj == 1) {
                    const int c = c0 - 512;
                    *(LAS u32x4*)(kbuf + it * 512 + c) = pack8(s);
                    float kr[8]; float ss = 0.f;
#pragma unroll
                    for (int e = 0; e < 8; ++e) { kr[e] = s[e] * k_k[c + e]; ss += kr[e] * kr[e]; }
                    ss += __shfl_xor(ss, 1); ss += __shfl_xor(ss, 2); ss += __shfl_xor(ss, 4);
                    const float inv = fminf(__builtin_amdgcn_rsqf(ss), 1e12f);
#pragma unroll
                    for (int e = 0; e < 8; ++e) kr[e] *= inv;
                    if (STORE) { *(u32x4*)(kk_out + (size_t)m * CW + c) = pack8(kr); }
                    if ((lane & 7) == 0) invb[it * 8 + (lane >> 3)] = inv;
                }
                else if (jj == 2) { if (STORE) { *(u32x4*)(v_out + (size_t)m * CW + (c0 - 1024)) = pack8(s); } }
                else if (valid) {
                    const int seg = lane >> 4, cw = 8 * (lane & 15);
                    if (seg == 0) {
#pragma unroll
                        for (int e = 0; e < 8; ++e) s[e] = 1.0f - 2.0f * __builtin_amdgcn_rcpf(__expf(2.0f * s[e]) + 1.0f);
                        *(LAS u32x4*)(Aw + it * PREP_LD + cw) = pack8(s);
                    } else if (seg == 1) { *(LAS u32x4*)(Aa + it * PREP_LD + cw) = pack8(s); }
                    else {
#pragma unroll
                        for (int e = 0; e < 8; ++e) s[e] = sigmoidf_(s[e]);
                        *(LAS u32x4*)(Ag + it * PREP_LD + cw) = pack8(s);
                    }
                }
            }
        }
        __syncthreads();
        const int nb = 64 * wave;
#define PREP_PROW(nt_) (nb + 32 * ((nt_) >> 1) + 8 * (fr >> 2) + 4 * ((nt_) & 1) + (fr & 3))
#define PREP_COL(nt_)  (nb + 32 * ((nt_) >> 1) + 8 * fg + 4 * ((nt_) & 1))
#pragma unroll 1
        for (int job = 0; job < 4; ++job) {
            const int z = job & 1;
            const bf16* WT = job < 2 ? w2T + (size_t)z * 512 * 64 : a2T + (size_t)z * 512 * 64;
            const LAS bf16* Ax = job < 2 ? Aw + z * 64 : Aa + z * 64;
            bf16x8 wf[2][4];
#pragma unroll
            for (int ks = 0; ks < 2; ++ks)
#pragma unroll
                for (int nt = 0; nt < 4; ++nt) wf[ks][nt] = *(const bf16x8*)(WT + (size_t)PREP_PROW(nt) * 64 + 32 * ks + 8 * fg);
            f32x4 pb[4], pkk[4], pka[4];
#pragma unroll
            for (int nt = 0; nt < 4; ++nt) { const int n = PREP_COL(nt);
                pb[nt] = *(const f32x4*)((job < 2 ? w0 : a0) + z * 512 + n); pkk[nt] = *(const f32x4*)(k_k + n); pka[nt] = *(const f32x4*)(k_a + n); }
            f32x4 acc[4][4];
#pragma unroll
            for (int mt = 0; mt < 4; ++mt)
#pragma unroll
                for (int nt = 0; nt < 4; ++nt) acc[mt][nt] = (f32x4){0.f, 0.f, 0.f, 0.f};
#pragma unroll
            for (int ks = 0; ks < 2; ++ks) {
                bf16x8 af[4];
#pragma unroll
                for (int mt = 0; mt < 4; ++mt) af[mt] = *(const LAS bf16x8*)(Ax + (16 * mt + fr) * PREP_LD + 32 * ks + 8 * fg);
#pragma unroll
                for (int mt = 0; mt < 4; ++mt)
#pragma unroll
                    for (int nt = 0; nt < 4; ++nt) acc[mt][nt] = __builtin_amdgcn_mfma_f32_16x16x32_bf16(wf[ks][nt], af[mt], acc[mt][nt], 0, 0, 0);
            }
#pragma unroll
            for (int mt = 0; mt < 4; ++mt) {
                const int it = 16 * mt + fr; const size_t m = (size_t)(m0 + it);
#pragma unroll
                for (int np = 0; np < 2; ++np) {
                    const int c8 = nb + 32 * np + 8 * fg;
                    if (job < 2) {
                        float o[8];
#pragma unroll
                        for (int hh = 0; hh < 2; ++hh) { const f32x4 v = acc[mt][2 * np + hh], bq = pb[2 * np + hh];
#pragma unroll
                            for (int i = 0; i < 4; ++i) o[4 * hh + i] = __expf(-0.60653066f * sigmoidf_(v[i] + bq[i])); }
                        if (STORE) { *(u32x4*)(decay_out + ((size_t)z * M + m) * CW + c8) = pack8(o); }
                    } else {
                        const u32x4 kb = *(const LAS u32x4*)(kbuf + it * 512 + c8);
                        float kv[8]; unpack8(kb, kv);
                        const float inv = invb[it * 8 + wave];
                        float kd[8], ak[8];
#pragma unroll
                        for (int hh = 0; hh < 2; ++hh) { const f32x4 v = acc[mt][2 * np + hh], bq = pb[2 * np + hh], kkc = pkk[2 * np + hh], kac = pka[2 * np + hh];
#pragma unroll
                            for (int i = 0; i < 4; ++i) { const float av = sigmoidf_(v[i] + bq[i]), kx = kv[4 * hh + i]; kd[4 * hh + i] = kx * (1.0f + (av - 1.0f) * kac[i]); ak[4 * hh + i] = av * (kx * kkc[i] * inv); } }
                        if (STORE) { *(u32x4*)(kdir_out + ((size_t)z * M + m) * CW + c8) = pack8(kd); *(u32x4*)(akk_out + ((size_t)z * M + m) * CW + c8) = pack8(ak); }
                    }
                }
            }
        }
        {
            bf16x8 wf[4][4];
#pragma unroll
            for (int ks = 0; ks < 4; ++ks)
#pragma unroll
                for (int nt = 0; nt < 4; ++nt) wf[ks][nt] = *(const bf16x8*)(g2T + (size_t)PREP_PROW(nt) * 128 + 32 * ks + 8 * fg);
            f32x4 acc[4][4];
#pragma unroll
            for (int mt = 0; mt < 4; ++mt)
#pragma unroll
                for (int nt = 0; nt < 4; ++nt) acc[mt][nt] = (f32x4){0.f, 0.f, 0.f, 0.f};
#pragma unroll
            for (int ks = 0; ks < 4; ++ks) {
                bf16x8 af[4];
#pragma unroll
                for (int mt = 0; mt < 4; ++mt) af[mt] = *(const LAS bf16x8*)(Ag + (16 * mt + fr) * PREP_LD + 32 * ks + 8 * fg);
#pragma unroll
                for (int mt = 0; mt < 4; ++mt)
#pragma unroll
                    for (int nt = 0; nt < 4; ++nt) acc[mt][nt] = __builtin_amdgcn_mfma_f32_16x16x32_bf16(wf[ks][nt], af[mt], acc[mt][nt], 0, 0, 0);
            }
#pragma unroll
            for (int mt = 0; mt < 4; ++mt) { const size_t m = (size_t)(m0 + 16 * mt + fr);
#pragma unroll
                for (int np = 0; np < 2; ++np) { const f32x4 v0 = acc[mt][2 * np], v1 = acc[mt][2 * np + 1];
                    u32x4 w; w.x = cvt_pk_bf16(v0[0], v0[1]); w.y = cvt_pk_bf16(v0[2], v0[3]); w.z = cvt_pk_bf16(v1[0], v1[1]); w.w = cvt_pk_bf16(v1[2], v1[3]);
                    if (STORE) { *(u32x4*)(g_out + m * CW + nb + 32 * np + 8 * fg) = w; } } }
        }
#undef PREP_PROW
#undef PREP_COL
        __syncthreads();
    }
}

__device__ __forceinline__ void attn_phase(const Frame& F, const Args& a, const int widx, const int nworkers) {
    unsigned char* ws = a.ws;
    const bf16* q = (const bf16*)(ws + WS_Q); const bf16* k = (const bf16*)(ws + WS_K); const bf16* vT = (const bf16*)(ws + WS_VT);
    bf16* att = (bf16*)(ws + WS_ATT);
    LAS float* bias = (LAS float*)F.lds;
    for (int i = F.tid; i < 8 * 15 * 31; i += 512) bias[i] = a.in[3][i];
    __syncthreads();
    const int lane = F.lane, fr = lane & 15, fg = lane >> 4;
    const int per = (16384 + nworkers * 8 - 1) / (nworkers * 8);
    for (int it = 0; it < per; ++it) {
        const int task = widx * (8 * per) + it * 8 + F.wave; if (task >= 16384) break;
        const int cgp = task & 3, r = (task >> 2) & 127, h = (task >> 9) & 7, b = task >> 12;
        const int c0 = 16 * cgp, wsc = min(max(c0 - 8, 0), 32), rs = min(max(r - 4, 0), GROWS - 8);
        const int c = c0 + fr, cs = min(max(c - 8, 0), 48);
        const size_t tq = (size_t)b * T + r * 64 + c;
        bf16x8 qf[2];
#pragma unroll
        for (int ks = 0; ks < 2; ++ks) qf[ks] = *(const bf16x8*)(q + tq * CW + h * 64 + 32 * ks + 8 * fg);
        f32x4 sc[16];
        const int kcol_a = wsc + 8 * (fr >> 2) + (fr & 3);
        { bf16x8 kf[16][2];
#pragma unroll
          for (int t = 0; t < 16; ++t) { const int u = t >> 1, par = t & 1;
              const size_t tk = (size_t)b * T + (rs + u) * 64 + kcol_a + 4 * par;
              kf[t][0] = *(const bf16x8*)(k + tk * CW + h * 64 + 8 * fg); kf[t][1] = *(const bf16x8*)(k + tk * CW + h * 64 + 32 + 8 * fg); }
#pragma unroll
          for (int t = 0; t < 16; ++t) { f32x4 s = {0.f, 0.f, 0.f, 0.f};
              s = __builtin_amdgcn_mfma_f32_16x16x32_bf16(kf[t][0], qf[0], s, 0, 0, 0);
              s = __builtin_amdgcn_mfma_f32_16x16x32_bf16(kf[t][1], qf[1], s, 0, 0, 0);
              sc[t] = s; } }
        float mx = -1e30f;
#pragma unroll
        for (int u = 0; u < 8; ++u) {
            const int dr = rs + u - r + 7;
#pragma unroll
            for (int par = 0; par < 2; ++par)
#pragma unroll
                for (int i = 0; i < 4; ++i) {
                    const int kc = wsc + 8 * fg + 4 * par + i; const bool ok = (kc >= cs) && (kc < cs + 16);
                    const int dc = min(max(kc - c + 15, 0), 30);
                    const float s = ok ? sc[2 * u + par][i] + bias[(h * 15 + dr) * 31 + dc] : -1e30f;
                    sc[2 * u + par][i] = s; mx = fmaxf(mx, s);
                }
        }
        mx = fmaxf(mx, __shfl_xor(mx, 16)); mx = fmaxf(mx, __shfl_xor(mx, 32));
        float sum = 0.f;
#pragma unroll
        for (int t = 0; t < 16; ++t)
#pragma unroll
            for (int i = 0; i < 4; ++i) { const float pv = sc[t][i] > -1e29f ? __expf(sc[t][i] - mx) : 0.f; sc[t][i] = pv; sum += pv; }
        sum += __shfl_xor(sum, 16); sum += __shfl_xor(sum, 32);
        const float inv = 1.0f / sum;
        f32x4 o[4];
#pragma unroll
        for (int nt = 0; nt < 4; ++nt) o[nt] = (f32x4){0.f, 0.f, 0.f, 0.f};
        { bf16x8 vf[8][4];
#pragma unroll
          for (int u = 0; u < 8; ++u) { const bf16* vblk = vT + ((size_t)((b * NH + h) * GROWS + rs + u)) * (HD * 64) + wsc + 8 * fg;
#pragma unroll
              for (int nt = 0; nt < 4; ++nt) vf[u][nt] = *(const bf16x8*)(vblk + (16 * nt + fr) * 64); }
#pragma unroll
          for (int u = 0; u < 8; ++u) {
              union { u32x4 w; bf16x8 h8; } pf;
              pf.w.x = cvt_pk_bf16(sc[2 * u][0], sc[2 * u][1]); pf.w.y = cvt_pk_bf16(sc[2 * u][2], sc[2 * u][3]);
              pf.w.z = cvt_pk_bf16(sc[2 * u + 1][0], sc[2 * u + 1][1]); pf.w.w = cvt_pk_bf16(sc[2 * u + 1][2], sc[2 * u + 1][3]);
#pragma unroll
              for (int nt = 0; nt < 4; ++nt) o[nt] = __builtin_amdgcn_mfma_f32_16x16x32_bf16(vf[u][nt], pf.h8, o[nt], 0, 0, 0); } }
#pragma unroll
        for (int nt = 0; nt < 4; ++nt) { u32x2 w; w.x = cvt_pk_bf16(o[nt][0] * inv, o[nt][1] * inv); w.y = cvt_pk_bf16(o[nt][2] * inv, o[nt][3] * inv);
            *(u32x2*)(att + tq * CW + h * 64 + 16 * nt + 4 * fg) = w; }
    }
    __syncthreads();
}

__device__ __forceinline__ void side_phase(const Frame& F, const Args& a, const int widx, const int nworkers) {
    attn_phase(F, a, widx, nworkers);
}

__device__ __forceinline__ float row16_sum(float v) {
    v += __builtin_bit_cast(float, __builtin_amdgcn_update_dpp(0, __builtin_bit_cast(int, v), 0xB1, 0xF, 0xF, true));
    v += __builtin_bit_cast(float, __builtin_amdgcn_update_dpp(0, __builtin_bit_cast(int, v), 0x4E, 0xF, 0xF, true));
    v += __builtin_bit_cast(float, __builtin_amdgcn_update_dpp(0, __builtin_bit_cast(int, v), 0x141, 0xF, 0xF, true));
    v += __builtin_bit_cast(float, __builtin_amdgcn_update_dpp(0, __builtin_bit_cast(int, v), 0x140, 0xF, 0xF, true));
    return v;
}
constexpr int CS_R = 8;
constexpr int CS_NCH = 2, CS_NPR = 6;
constexpr int CS_AT = 0, CS_RT = 2304, CS_KHT = 4608, CS_BHT = 6656, CS_VT = 8704  , CS_TT = 10752, CS_AAK = 11264, CS_ARK = 11776, CS_ARB = 12288, CS_PL = 12800, CS_SLOT = 13056;
constexpr int CS_LD = 72;
constexpr int CS_SCR = CS_R * CS_SLOT  , CS_SCRW = 2304 * 2  , CS_FLAG = CS_SCR + CS_NPR * CS_SCRW  ;
__device__ __forceinline__ bf16 f2bf(float f) { return (bf16)cvt_pk_bf16(f, 0.f); }
struct ChainOps { u32x2 a4[4], r4[4], kh[4], bh[4], aak, ark, arb, tt, vb; f32x4 pl[4]; };
__device__ __forceinline__ void chain_load(const LAS unsigned char* sl, int fr, int fg, int c, ChainOps& o) {
    const int o16 = fr * 32 + fg * 8;
    const LAS unsigned char* pa = sl + CS_AT + fr * (CS_LD * 2) + fg * 8; const LAS unsigned char* pr = sl + CS_RT + fr * (CS_LD * 2) + fg * 8;
#pragma unroll
    for (int kq = 0; kq < 4; ++kq) { o.a4[kq] = *(const LAS u32x2*)(pa + 32 * kq); o.r4[kq] = *(const LAS u32x2*)(pr + 32 * kq); }
    o.aak = *(const LAS u32x2*)(sl + CS_AAK + o16); o.ark = *(const LAS u32x2*)(sl + CS_ARK + o16); o.arb = *(const LAS u32x2*)(sl + CS_ARB + o16); o.tt = *(const LAS u32x2*)(sl + CS_TT + o16);
    o.vb = *(const LAS u32x2*)(sl + CS_VT + c * 512 + o16);
#pragma unroll
    for (int mt = 0; mt < 4; ++mt) { o.pl[mt] = *(const LAS f32x4*)(sl + CS_PL + (16 * mt + 4 * fg) * 4);
        o.kh[mt] = *(const LAS u32x2*)(sl + CS_KHT + 512 * mt + o16); o.bh[mt] = *(const LAS u32x2*)(sl + CS_BHT + 512 * mt + o16); }
}
__device__ __forceinline__ f32x4 chain_compute(const ChainOps& o, f32x4 (&zacc)[4]) {
#define CS_M32(A_, B_, C_) __builtin_amdgcn_mfma_f32_16x16x32_bf16(A_, B_, C_, 0, 0, 0)
#define CS_M16(A_, B_, C_) __builtin_amdgcn_mfma_f32_16x16x16bf16_1k(__builtin_bit_cast(s16x4, A_), __builtin_bit_cast(s16x4, B_), C_, 0, 0, 0)
    union { u32x4 w; bf16x8 h8; } zb0, zb1, ap0, ap1, rp0, rp1;
    zb0.w.x = cvt_pk_bf16(zacc[0][0], zacc[0][1]); zb0.w.y = cvt_pk_bf16(zacc[0][2], zacc[0][3]); zb0.w.z = cvt_pk_bf16(zacc[1][0], zacc[1][1]); zb0.w.w = cvt_pk_bf16(zacc[1][2], zacc[1][3]);
    zb1.w.x = cvt_pk_bf16(zacc[2][0], zacc[2][1]); zb1.w.y = cvt_pk_bf16(zacc[2][2], zacc[2][3]); zb1.w.z = cvt_pk_bf16(zacc[3][0], zacc[3][1]); zb1.w.w = cvt_pk_bf16(zacc[3][2], zacc[3][3]);
    ap0.w = (u32x4){o.a4[0].x, o.a4[0].y, o.a4[1].x, o.a4[1].y}; ap1.w = (u32x4){o.a4[2].x, o.a4[2].y, o.a4[3].x, o.a4[3].y};
    rp0.w = (u32x4){o.r4[0].x, o.r4[0].y, o.r4[1].x, o.r4[1].y}; rp1.w = (u32x4){o.r4[2].x, o.r4[2].y, o.r4[3].x, o.r4[3].y};
    const f32x4 zero4 = {0.f, 0.f, 0.f, 0.f};
    f32x4 Wc = CS_M16(o.aak, o.vb, zero4);
    Wc = CS_M32(ap0.h8, zb0.h8, Wc); Wc = CS_M32(ap1.h8, zb1.h8, Wc);
    f32x4 Yc = CS_M16(o.ark, o.vb, zero4);
    Yc = CS_M32(rp0.h8, zb0.h8, Yc); Yc = CS_M32(rp1.h8, zb1.h8, Yc);
    f32x4 zz[4];
#pragma unroll
    for (int mt = 0; mt < 4; ++mt) zz[mt] = CS_M16(o.kh[mt], o.vb, zacc[mt] * o.pl[mt]);
    u32x2 wb, ub;
    wb.x = cvt_pk_bf16(Wc[0], Wc[1]); wb.y = cvt_pk_bf16(Wc[2], Wc[3]);
    const f32x4 Uc = CS_M16(o.tt, wb, zero4);
    ub.x = cvt_pk_bf16(Uc[0], Uc[1]); ub.y = cvt_pk_bf16(Uc[2], Uc[3]);
    Yc = CS_M16(o.arb, ub, Yc);
#pragma unroll
    for (int mt = 0; mt < 4; ++mt) zacc[mt] = CS_M16(o.bh[mt], ub, zz[mt]);
#undef CS_M32
#undef CS_M16
    return Yc;
}
template <int z>
__device__ __forceinline__ void scan_phase_z(const Frame& F, const Args& a, const int seq, const int half) {
    unsigned char* ws = a.ws;
    const int b = (seq >> 3) & 3, h = seq & 7;
    const size_t mb = (size_t)b * T;
    const int lane = F.lane, wave = F.wave, fr = lane & 15, fg = lane >> 4;
    constexpr int NCK = T / 16;
    volatile LAS unsigned* flg = (volatile LAS unsigned*)(F.lds + CS_FLAG);
    if (F.tid < 16) flg[F.tid] = 0u;
    __syncthreads();
    const int o16 = fr * 32 + fg * 8;
#define CS_M32(A_, B_, C_) __builtin_amdgcn_mfma_f32_16x16x32_bf16(A_, B_, C_, 0, 0, 0)
#define CS_M16(A_, B_, C_) __builtin_amdgcn_mfma_f32_16x16x16bf16_1k(__builtin_bit_cast(s16x4, A_), __builtin_bit_cast(s16x4, B_), C_, 0, 0, 0)
    if (wave < CS_NCH) {
        const int c = wave, rg = 2 * half + c;
        __builtin_amdgcn_s_setprio(3);
        bf16* yout = (bf16*)(ws + WS_Y) + (size_t)z * M * CW + h * 64 + rg * 16 + fr;
        f32x4 zacc[4];
#pragma unroll
        for (int mt = 0; mt < 4; ++mt) zacc[mt] = (f32x4){0.f, 0.f, 0.f, 0.f};
        ChainOps opA, opB;
#define CS_READY(nn) do { unsigned sp_ = 0; while (flg[(nn) & (CS_R - 1)] != (unsigned)((nn) + 1)) { __builtin_amdgcn_s_sleep(1); if (++sp_ > (1u << 24)) break; } __builtin_amdgcn_fence(__ATOMIC_ACQUIRE, "workgroup"); } while (0)
#define CS_HANDBACK(nn) do { asm volatile("s_waitcnt lgkmcnt(0)" ::: "memory"); if (lane == 0) flg[8 + c] = (unsigned)((nn) + 1); asm volatile("" ::: "memory"); } while (0)
#define CS_YSTORE(nn, Y_) do { asm volatile("s_waitcnt vmcnt(24)" ::: "memory");   _Pragma("unroll") for (int rr = 0; rr < 4; ++rr) { const int q_ = 16 * (nn) + 4 * fg + rr, t_ = z ? (T - 1 - q_) : q_; yout[(mb + t_) * CW] = f2bf((Y_)[rr]); } } while (0)
        CS_READY(0); chain_load(F.lds, fr, fg, rg, opA);
#pragma unroll 1
        for (int n = 0; n < NCK; n += 2) {
            CS_READY(n + 1); CS_HANDBACK(n);
            chain_load(F.lds + ((n + 1) & (CS_R - 1)) * CS_SLOT, fr, fg, rg, opB);
            { const f32x4 Yc = chain_compute(opA, zacc); CS_YSTORE(n, Yc); }
            if (n + 2 < NCK) CS_READY(n + 2);
            CS_HANDBACK(n + 1);
            if (n + 2 < NCK) chain_load(F.lds + ((n + 2) & (CS_R - 1)) * CS_SLOT, fr, fg, rg, opA);
            { const f32x4 Yc = chain_compute(opB, zacc); CS_YSTORE(n + 1, Yc); }
        }
#undef CS_READY
#undef CS_HANDBACK
#undef CS_YSTORE
        __builtin_amdgcn_s_setprio(0);
    } else {
        const int pi = wave - CS_NCH;
        LAS unsigned char* scr = F.lds + CS_SCR + pi * CS_SCRW;
        LAS bf16* KT = (LAS bf16*)scr; LAS bf16* BT = (LAS bf16*)(scr + 2304);
        const bf16* gw_ = (const bf16*)(ws + WS_DECAY) + (size_t)z * M * CW + h * 64;
        const bf16* gkk = (const bf16*)(ws + WS_KK) + h * 64;
        const bf16* gak = (const bf16*)(ws + WS_AKK) + (size_t)z * M * CW + h * 64;
        const bf16* gk = (const bf16*)(ws + WS_KDIR) + (size_t)z * M * CW + h * 64;
        const bf16* gr = (const bf16*)(ws + WS_R) + h * 64;
        const bf16* gv = (const bf16*)(ws + WS_V) + h * 64;
        unsigned nw[16], nkk[16], nak[16], nk[16], nr[16], nv[16];
        constexpr long RSTEP = z ? -(long)CW : (long)CW;
#define CS_FETCH_A(nn) do { if ((nn) < NCK) { const size_t m0_ = (mb + (z ? (T - 1 - 16 * (nn)) : 16 * (nn))) * CW + lane; const bf16* pw_ = gw_ + m0_; const bf16* pkk_ = gkk + m0_; \
            _Pragma("unroll") for (int tt = 0; tt < 16; ++tt) { nw[tt] = pw_[tt * RSTEP]; nkk[tt] = pkk_[tt * RSTEP]; } } } while (0)
#define CS_FETCH_B(nn) do { if ((nn) < NCK) { asm volatile("s_waitcnt vmcnt(30)" ::: "memory"); const size_t m0_ = (mb + (z ? (T - 1 - 16 * (nn)) : 16 * (nn))) * CW + lane; const bf16* pak_ = gak + m0_; const bf16* pk_ = gk + m0_; \
            _Pragma("unroll") for (int tt = 0; tt < 16; ++tt) { nak[tt] = pak_[tt * RSTEP]; nk[tt] = pk_[tt * RSTEP]; } } } while (0)
#define CS_FETCH_C(nn) do { if ((nn) < NCK) { asm volatile("s_waitcnt vmcnt(30)" ::: "memory"); const size_t m0_ = (mb + (z ? (T - 1 - 16 * (nn)) : 16 * (nn))) * CW + lane; const bf16* pr_ = gr + m0_; const bf16* pv_ = gv + m0_; \
            _Pragma("unroll") for (int tt = 0; tt < 16; ++tt) { nr[tt] = pr_[tt * RSTEP]; nv[tt] = pv_[tt * RSTEP]; } } } while (0)
        CS_FETCH_A(pi); CS_FETCH_B(pi); CS_FETCH_C(pi);
#pragma unroll 1
        for (int n = pi; n < NCK; n += CS_NPR) {
            const int slot = n & (CS_R - 1);
            float wv[16], kkv[16], akv[16], kv[16], rv[16]; unsigned vq[16];
#pragma unroll
            for (int tt = 0; tt < 16; ++tt) { unsigned x0 = nw[tt], x1 = nkk[tt], x2 = nak[tt], x3 = nk[tt], x4 = nr[tt];
                asm volatile("" : "+v"(x0), "+v"(x1), "+v"(x2), "+v"(x3), "+v"(x4));
                wv[tt] = __uint_as_float(x0 << 16); kkv[tt] = __uint_as_float(x1 << 16); akv[tt] = __uint_as_float(x2 << 16); kv[tt] = __uint_as_float(x3 << 16); rv[tt] = __uint_as_float(x4 << 16); }
#pragma unroll
            for (int tt = 0; tt < 16; ++tt) { unsigned x0 = nv[tt]; asm volatile("" : "+v"(x0)); vq[tt] = x0; }
            CS_FETCH_A(n + CS_NPR);
            { unsigned sp = 0; for (;;) { const u32x2 pg = *(const volatile LAS u32x2*)(flg + 8); const int mn = (int)min(pg.x, pg.y);
                  if (mn >= n - (CS_R - 3)) break; __builtin_amdgcn_s_sleep(2); if (++sp > (1u << 24)) break; } }
            __builtin_amdgcn_fence(__ATOMIC_ACQUIRE, "workgroup");
            LAS unsigned char* sl = F.lds + slot * CS_SLOT;
            float P[16];
            P[0] = wv[0];
#pragma unroll
            for (int tt = 1; tt < 16; ++tt) P[tt] = P[tt - 1] * wv[tt];
            const float PL = P[15];
            float khat[16], bhat[16];
#pragma unroll
            for (int tt = 0; tt < 16; ++tt) {
                const float pm1 = tt ? P[tt - 1] : 1.0f, inv = __builtin_amdgcn_rcpf(P[tt]);
                const float at = kkv[tt] * pm1, rt = rv[tt] * P[tt], kt = kv[tt] * inv, bt = -akv[tt] * inv;
                khat[tt] = kt * PL; bhat[tt] = bt * PL;
                { const unsigned w_ = cvt_pk_bf16(at, rt); *(LAS bf16*)(sl + CS_AT + (tt * CS_LD + lane) * 2) = (bf16)w_; *(LAS bf16*)(sl + CS_RT + (tt * CS_LD + lane) * 2) = (bf16)(w_ >> 16); }
                { const unsigned w_ = cvt_pk_bf16(kt, bt); KT[tt * CS_LD + lane] = (bf16)w_; BT[tt * CS_LD + lane] = (bf16)(w_ >> 16); }
            }
            CS_FETCH_B(n + CS_NPR);
            { u32x4 o0, o1;
              o0.x = cvt_pk_bf16(khat[0], khat[1]); o0.y = cvt_pk_bf16(khat[2], khat[3]); o0.z = cvt_pk_bf16(khat[4], khat[5]); o0.w = cvt_pk_bf16(khat[6], khat[7]);
              o1.x = cvt_pk_bf16(khat[8], khat[9]); o1.y = cvt_pk_bf16(khat[10], khat[11]); o1.z = cvt_pk_bf16(khat[12], khat[13]); o1.w = cvt_pk_bf16(khat[14], khat[15]);
              *(LAS u32x4*)(sl + CS_KHT + lane * 32) = o0; *(LAS u32x4*)(sl + CS_KHT + lane * 32 + 16) = o1;
              o0.x = cvt_pk_bf16(bhat[0], bhat[1]); o0.y = cvt_pk_bf16(bhat[2], bhat[3]); o0.z = cvt_pk_bf16(bhat[4], bhat[5]); o0.w = cvt_pk_bf16(bhat[6], bhat[7]);
              o1.x = cvt_pk_bf16(bhat[8], bhat[9]); o1.y = cvt_pk_bf16(bhat[10], bhat[11]); o1.z = cvt_pk_bf16(bhat[12], bhat[13]); o1.w = cvt_pk_bf16(bhat[14], bhat[15]);
              *(LAS u32x4*)(sl + CS_BHT + lane * 32) = o0; *(LAS u32x4*)(sl + CS_BHT + lane * 32 + 16) = o1; }
            *(LAS float*)(sl + CS_PL + lane * 4) = PL;
            { u32x4 o0, o1;
              o0.x = vq[0] | (vq[1] << 16); o0.y = vq[2] | (vq[3] << 16); o0.z = vq[4] | (vq[5] << 16); o0.w = vq[6] | (vq[7] << 16);
              o1.x = vq[8] | (vq[9] << 16); o1.y = vq[10] | (vq[11] << 16); o1.z = vq[12] | (vq[13] << 16); o1.w = vq[14] | (vq[15] << 16);
              *(LAS u32x4*)(sl + CS_VT + lane * 32) = o0; *(LAS u32x4*)(sl + CS_VT + lane * 32 + 16) = o1; }
            asm volatile("s_waitcnt lgkmcnt(0)" ::: "memory");
            bf16x8 af[2], rf[2], kf[2], bf_[2];
#pragma unroll
            for (int ks = 0; ks < 2; ++ks) { af[ks] = *(const LAS bf16x8*)(sl + CS_AT + (fr * CS_LD + 32 * ks + 8 * fg) * 2); rf[ks] = *(const LAS bf16x8*)(sl + CS_RT + (fr * CS_LD + 32 * ks + 8 * fg) * 2);
                kf[ks] = *(const LAS bf16x8*)(KT + fr * CS_LD + 32 * ks + 8 * fg); bf_[ks] = *(const LAS bf16x8*)(BT + fr * CS_LD + 32 * ks + 8 * fg); }
            const f32x4 zero4 = {0.f, 0.f, 0.f, 0.f};
            f32x4 Xc = zero4, Xt = zero4, AakT = zero4, ArbT = zero4, ArkT = zero4;
#pragma unroll
            for (int ks = 0; ks < 2; ++ks) { Xc = CS_M32(af[ks], bf_[ks], Xc); Xt = CS_M32(bf_[ks], af[ks], Xt);
                AakT = CS_M32(kf[ks], af[ks], AakT); ArbT = CS_M32(bf_[ks], rf[ks], ArbT); ArkT = CS_M32(kf[ks], rf[ks], ArkT); }
            CS_FETCH_C(n + CS_NPR);
            f32x4 S1;
#pragma unroll
            for (int rr = 0; rr < 4; ++rr) { const int q = 4 * fg + rr;
                Xc[rr] = (fr < q) ? Xc[rr] : 0.f; Xt[rr] = (q < fr) ? Xt[rr] : 0.f; S1[rr] = Xt[rr] + ((q == fr) ? 1.0f : 0.f);
                AakT[rr] = (q < fr) ? AakT[rr] : 0.f; ArkT[rr] = (q <= fr) ? ArkT[rr] : 0.f; ArbT[rr] = (q <= fr) ? ArbT[rr] : 0.f; }
            { u32x2 w; w.x = cvt_pk_bf16(AakT[0], AakT[1]); w.y = cvt_pk_bf16(AakT[2], AakT[3]); *(LAS u32x2*)(sl + CS_AAK + o16) = w;
              w.x = cvt_pk_bf16(ArkT[0], ArkT[1]); w.y = cvt_pk_bf16(ArkT[2], ArkT[3]); *(LAS u32x2*)(sl + CS_ARK + o16) = w;
              w.x = cvt_pk_bf16(ArbT[0], ArbT[1]); w.y = cvt_pk_bf16(ArbT[2], ArbT[3]); *(LAS u32x2*)(sl + CS_ARB + o16) = w; }
#define CS_PK(v) ((u32x2){cvt_pk_bf16((v)[0], (v)[1]), cvt_pk_bf16((v)[2], (v)[3])})
            const u32x2 xc = CS_PK(Xc), xt = CS_PK(Xt), s1 = CS_PK(S1);
            const f32x4 X2c = CS_M16(xt, xc, zero4), X2t = CS_M16(xc, xt, zero4);
            const u32x2 x2c = CS_PK(X2c), x2t = CS_PK(X2t);
            const f32x4 S2 = CS_M16(x2c, s1, S1);
            const f32x4 X4c = CS_M16(x2t, x2c, zero4), X4t = CS_M16(x2c, x2t, zero4);
            const u32x2 x4c = CS_PK(X4c), x4t = CS_PK(X4t), s2 = CS_PK(S2);
            const f32x4 S4 = CS_M16(x4c, s2, S2);
            const f32x4 X8c = CS_M16(x4t, x4c, zero4);
            const u32x2 x8c = CS_PK(X8c), s4 = CS_PK(S4);
            const f32x4 S8 = CS_M16(x8c, s4, S4);
            *(LAS u32x2*)(sl + CS_TT + o16) = CS_PK(S8);
#undef CS_PK
            asm volatile("s_waitcnt lgkmcnt(0)" ::: "memory");
            __builtin_amdgcn_fence(__ATOMIC_RELEASE, "workgroup");
            if (lane == 0) flg[slot] = (unsigned)(n + 1);
        }
#undef CS_FETCH_A
#undef CS_FETCH_B
#undef CS_FETCH_C
    }
#undef CS_M32
#undef CS_M16
    __syncthreads();
}

__device__ __forceinline__ void scan_phase(const Frame& F, const Args& a, const int idx) {
    const int seq = idx >> 1, half = idx & 1;
    if (seq >> 5) scan_phase_z<1>(F, a, seq, half); else scan_phase_z<0>(F, a, seq, half);
}

__device__ __forceinline__ void combine_phase(const Frame& F, const Args& a) {
    unsigned char* ws = a.ws;
    const bf16* att = (const bf16*)(ws + WS_ATT); const bf16* rr = (const bf16*)(ws + WS_R); const bf16* vv = (const bf16*)(ws + WS_V);
    const bf16* kd = (const bf16*)(ws + WS_KDIR); const bf16* gg = (const bf16*)(ws + WS_G); const bf16* y = (const bf16*)(ws + WS_Y);
    bf16* mix = (bf16*)(ws + WS_MIX);
    const float* anw = a.in[4]; const float* r_k = a.in[14]; const float* ln_w = a.in[15]; const float* ln_b = a.in[16];
    const int lane = F.lane, c0 = 8 * lane;
    float nw[8], rk[8], lw[8], lb[8];
#pragma unroll
    for (int i = 0; i < 8; ++i) { nw[i] = anw[c0 + i]; rk[i] = r_k[c0 + i]; lw[i] = ln_w[c0 + i]; lb[i] = ln_b[c0 + i]; }
    const int gw = F.vcu * 8 + F.wave, NGW = F.G * 8;
#pragma unroll 2
    for (int m = gw; m < M; m += NGW) {
        const size_t o = (size_t)m * CW + c0;
        float f[8];
        unpack8(*(const u32x4*)(att + o), f);
        float ss = 0.f;
#pragma unroll
        for (int i = 0; i < 8; ++i) ss += f[i] * f[i];
        const float rs = rsqrtf(wave_sum(ss) * (1.f / CW) + RMS_EPS);
#pragma unroll
        for (int i = 0; i < 8; ++i) f[i] = f[i] * rs * nw[i];
        *(u32x4*)(mix + (size_t)m * D + c0) = pack8(f);
        float yv[8], yw[8];
        unpack8(*(const u32x4*)(y + o), yv); unpack8(*(const u32x4*)(y + (size_t)M * CW + o), yw);
#pragma unroll
        for (int i = 0; i < 8; ++i) yv[i] += yw[i];
        float s1 = 0.f;
#pragma unroll
        for (int i = 0; i < 8; ++i) s1 += yv[i];
        s1 += __shfl_xor(s1, 1); s1 += __shfl_xor(s1, 2); s1 += __shfl_xor(s1, 4);
        const float mean = s1 * (1.f / 64.f);
        float s2 = 0.f;
#pragma unroll
        for (int i = 0; i < 8; ++i) { yv[i] -= mean; s2 += yv[i] * yv[i]; }
        s2 += __shfl_xor(s2, 1); s2 += __shfl_xor(s2, 2); s2 += __shfl_xor(s2, 4);
        const float rstd = rsqrtf(s2 * (1.f / 64.f) + GN_EPS);
        float rf[8], k0[8], k1[8], vf[8], gf[8];
        unpack8(*(const u32x4*)(rr + o), rf); unpack8(*(const u32x4*)(kd + o), k0); unpack8(*(const u32x4*)(kd + (size_t)M * CW + o), k1);
        unpack8(*(const u32x4*)(vv + o), vf); unpack8(*(const u32x4*)(gg + o), gf);
        float cf = 0.f;
#pragma unroll
        for (int i = 0; i < 8; ++i) cf += rf[i] * (k0[i] + k1[i]) * rk[i];
        cf += __shfl_xor(cf, 1); cf += __shfl_xor(cf, 2); cf += __shfl_xor(cf, 4);
#pragma unroll
        for (int i = 0; i < 8; ++i) f[i] = (yv[i] * rstd * lw[i] + lb[i] + cf * vf[i]) * gf[i];
        *(u32x4*)(mix + (size_t)m * D + CW + c0) = pack8(f);
    }
}

constexpr int RT_PITCH = 1032, RT_WH = 0, RT_WL = 32 * RT_PITCH * 2, RT_HIST = 2 * RT_WL, RT_EL = RT_HIST + 256;
__device__ __forceinline__ void router_phase(const Frame& F, const Args& a) {
    unsigned char* ws = a.ws;
    const bf16* hbuf = (const bf16*)(ws + WS_H); unsigned char* hn2 = ws + WS_HN2;
    int* eidx = (int*)(ws + WS_EIDX); float* gate = (float*)(ws + WS_GATE); int* rank = (int*)(ws + WS_RANK);
    unsigned* ctl = (unsigned*)(ws + WS_CTL);
    const float* n2w = a.in[18]; const float* rw = a.in[19]; const float* rb = a.in[20];
    LAS bf16* wh = (LAS bf16*)(F.lds + RT_WH); LAS bf16* wl = (LAS bf16*)(F.lds + RT_WL); LAS int* hist = (LAS int*)(F.lds + RT_HIST); LAS int* eL = (LAS int*)(F.lds + RT_EL);
    { f32x4 tmp[16];
#pragma unroll
      for (int j = 0; j < 16; ++j) tmp[j] = *((const f32x4*)rw + F.tid + 512 * j);
#pragma unroll
      for (int j = 0; j < 16; ++j) { const int q = F.tid + 512 * j, d = q >> 3, e0 = 4 * (q & 7);
#pragma unroll
          for (int i = 0; i < 4; ++i) { const float w = tmp[j][i]; const unsigned hb = cvt_pk_bf16(w, 0.f) & 0xffffu; const float lo = w - __uint_as_float(hb << 16);
              wh[(e0 + i) * RT_PITCH + d] = (bf16)hb; wl[(e0 + i) * RT_PITCH + d] = (bf16)cvt_pk_bf16(lo, 0.f); } } }
    if (F.tid < 32) hist[F.tid] = 0;
    __syncthreads();
    const int lane = F.lane, tk = lane & 15, g = lane >> 4;
    const int blk = F.vcu;
    const int m = blk * 128 + F.wave * 16 + tk;
    const bf16* hrow = hbuf + (size_t)m * D + 8 * g;
    float ss = 0.f;
#pragma unroll 8
    for (int ks = 0; ks < 32; ++ks) { float xf[8]; unpack8(*(const u32x4*)(hrow + 32 * ks), xf);
        ss += (xf[0] * xf[0] + xf[1] * xf[1]) + (xf[2] * xf[2] + xf[3] * xf[3]) + (xf[4] * xf[4] + xf[5] * xf[5]) + (xf[6] * xf[6] + xf[7] * xf[7]); }
    ss += __shfl_xor(ss, 16); ss += __shfl_xor(ss, 32);
    const float rs = rsqrtf(ss * (1.f / D) + RMS_EPS);
    f32x4 acc0 = {0.f, 0.f, 0.f, 0.f}, acc1 = acc0;
    unsigned char* hrow8 = hn2 + (size_t)m * D + 8 * g;
    const LAS bf16* wh0 = wh + tk * RT_PITCH + 8 * g; const LAS bf16* wl0 = wl + tk * RT_PITCH + 8 * g;
#pragma unroll 4
    for (int ks = 0; ks < 32; ++ks) {
        float xf[8]; unpack8(*(const u32x4*)(hrow + 32 * ks), xf);
        const f32x4 x0 = {xf[0], xf[1], xf[2], xf[3]}, x1 = {xf[4], xf[5], xf[6], xf[7]};
        const f32x4 n0 = *(const f32x4*)(n2w + 32 * ks + 8 * g), n1 = *(const f32x4*)(n2w + 32 * ks + 8 * g + 4);
        const f32x4 y0 = x0 * rs * n0, y1 = x1 * rs * n1;
        { u32x2 w8; w8.x = pk4_fp8(y0.x * F8_SX, y0.y * F8_SX, y0.z * F8_SX, y0.w * F8_SX); w8.y = pk4_fp8(y1.x * F8_SX, y1.y * F8_SX, y1.z * F8_SX, y1.w * F8_SX); *(u32x2*)(hrow8 + 32 * ks) = w8; }
        union { u32x4 w; bf16x8 h8; } xh, xl;
        xh.w.x = cvt_pk_bf16(y0.x, y0.y); xh.w.y = cvt_pk_bf16(y0.z, y0.w); xh.w.z = cvt_pk_bf16(y1.x, y1.y); xh.w.w = cvt_pk_bf16(y1.z, y1.w);
        xl.w.x = cvt_pk_bf16(y0.x - bflo(xh.w.x), y0.y - bfhi(xh.w.x)); xl.w.y = cvt_pk_bf16(y0.z - bflo(xh.w.y), y0.w - bfhi(xh.w.y));
        xl.w.z = cvt_pk_bf16(y1.x - bflo(xh.w.z), y1.y - bfhi(xh.w.z)); xl.w.w = cvt_pk_bf16(y1.z - bflo(xh.w.w), y1.w - bfhi(xh.w.w));
        const bf16x8 a0h = *(const LAS bf16x8*)(wh0 + 32 * ks), a1h = *(const LAS bf16x8*)(wh0 + 16 * RT_PITCH + 32 * ks);
        const bf16x8 a0l = *(const LAS bf16x8*)(wl0 + 32 * ks), a1l = *(const LAS bf16x8*)(wl0 + 16 * RT_PITCH + 32 * ks);
        acc0 = __builtin_amdgcn_mfma_f32_16x16x32_bf16(a0h, xh.h8, acc0, 0, 0, 0); acc1 = __builtin_amdgcn_mfma_f32_16x16x32_bf16(a1h, xh.h8, acc1, 0, 0, 0);
        acc0 = __builtin_amdgcn_mfma_f32_16x16x32_bf16(a0h, xl.h8, acc0, 0, 0, 0); acc1 = __builtin_amdgcn_mfma_f32_16x16x32_bf16(a1h, xl.h8, acc1, 0, 0, 0);
        acc0 = __builtin_amdgcn_mfma_f32_16x16x32_bf16(a0l, xh.h8, acc0, 0, 0, 0); acc1 = __builtin_amdgcn_mfma_f32_16x16x32_bf16(a1l, xh.h8, acc1, 0, 0, 0);
    }
    float lv[8]; int li[8];
    { const f32x4 b0 = *(const f32x4*)(rb + 4 * g), b1 = *(const f32x4*)(rb + 16 + 4 * g);
#pragma unroll
      for (int i = 0; i < 4; ++i) { lv[i] = acc0[i] + b0[i]; li[i] = 4 * g + i; lv[4 + i] = acc1[i] + b1[i]; li[4 + i] = 16 + 4 * g + i; } }
    float tv[4]; int ti[4];
#pragma unroll
    for (int kx = 0; kx < 4; ++kx) {
        float bv = lv[0]; int bi = li[0];
#pragma unroll
        for (int i = 1; i < 8; ++i) { const bool gt = lv[i] > bv; bv = gt ? lv[i] : bv; bi = gt ? li[i] : bi; }
#pragma unroll
        for (int o = 16; o < 64; o <<= 1) { const float ov = __shfl_xor(bv, o); const int oi = __shfl_xor(bi, o); const bool tko = (ov > bv) || (ov == bv && oi < bi); bv = tko ? ov : bv; bi = tko ? oi : bi; }
        tv[kx] = bv; ti[kx] = bi;
#pragma unroll
        for (int i = 0; i < 8; ++i) lv[i] = (li[i] == bi) ? -3.0e38f : lv[i];
    }
    if (g == 0) {
        const float e0 = 1.0f, e1 = __expf(tv[1] - tv[0]), e2 = __expf(tv[2] - tv[0]), e3 = __expf(tv[3] - tv[0]);
        const float is = 1.0f / (e0 + e1 + e2 + e3);
        const float gs[4] = {e0 * is, e1 * is, e2 * is, e3 * is};
#pragma unroll
        for (int kx = 0; kx < 4; ++kx) { eidx[m * 4 + kx] = ti[kx]; gate[m * 4 + kx] = gs[kx]; eL[(m - blk * 128) * 4 + kx] = ti[kx]; }
    }
    __syncthreads();
    { const int t = F.tid, e = eL[t]; int rk = 0;
      for (int u = 0; u < t; ++u) rk += (eL[u] == e) ? 1 : 0;
      rank[(blk * 128) * 4 + t] = rk;
      __hip_atomic_fetch_add(&hist[e], 1, __ATOMIC_RELAXED, __HIP_MEMORY_SCOPE_WORKGROUP); }
    __syncthreads();
    if (F.tid < 32) ctl[CW_CNT + blk * 32 + F.tid] = (unsigned)hist[F.tid];
}

__device__ __forceinline__ void dispatch_phase(const Frame& F, const Args& a) {
    unsigned char* ws = a.ws;
    unsigned* ctl = (unsigned*)(ws + WS_CTL);
    const int* eidx = (const int*)(ws + WS_EIDX); const int* rank = (const int*)(ws + WS_RANK); int* dest = (int*)(ws + WS_DEST);
    LAS int* part = (LAS int*)F.lds;
    LAS int* tot = part + 1024;
    const int blk = F.vcu, G = F.G;
    { const int e = F.tid & 31, pt = F.tid >> 5; int s = 0, sb = 0;
      if (G == 256) { int cv[16];
#pragma unroll
          for (int q = 0; q < 16; ++q) cv[q] = (int)ld_u32_agent(ctl + CW_CNT + (pt + 16 * q) * 32 + e);
#pragma unroll
          for (int q = 0; q < 16; ++q) { s += cv[q]; if (pt + 16 * q < blk) sb += cv[q]; } }
      else for (int bb = pt; bb < G; bb += 16) { const int cval = (int)ld_u32_agent(ctl + CW_CNT + bb * 32 + e); s += cval; if (bb < blk) sb += cval; }
      part[pt * 32 + e] = s; part[512 + pt * 32 + e] = sb; }
    __syncthreads();
    if (F.tid < 32) { int s = 0, sb = 0;
        for (int pt = 0; pt < 16; ++pt) { s += part[pt * 32 + F.tid]; sb += part[512 + pt * 32 + F.tid]; }
        tot[F.tid] = s; tot[32 + F.tid] = sb; tot[96 + F.tid] = (s + 255) & ~255; }
    __syncthreads();
    if (F.tid == 0) { int ps = 0; for (int e = 0; e < 32; ++e) { tot[64 + e] = ps; ps += tot[96 + e]; }
        tot[128] = ps >> 8; }
    __syncthreads();
    if (blk == 0) {
        if (F.tid == 0) ctl[CW_NT] = (unsigned)tot[128];
        for (int e = F.tid >> 4; e < 32; e += 32) { const int t0 = tot[64 + e] >> 8, nt = tot[96 + e] >> 8; for (int i = F.tid & 15; i < nt; i += 16) ctl[CW_TEXP + t0 + i] = (unsigned)e; }
    }
    const int lane = F.lane;
    const int mw = blk * 128 + F.wave * 16;
    int* rowtok = (int*)(ws + WS_ROWTOK);
    { const int e = eidx[mw * 4 + lane]; const int dl = tot[64 + e] + tot[32 + e] + rank[mw * 4 + lane]; dest[mw * 4 + lane] = dl; rowtok[dl] = mw + (lane >> 2); }
    { const int e = blk & 31, pt = blk >> 5, np = G >> 5; const int r0 = tot[64 + e] + tot[e], r1 = tot[64 + e] + tot[96 + e];
      if (np > 0) for (int r = r0 + pt * 512 + F.tid; r < r1; r += np * 512) rowtok[r] = 0; }
}

__device__ __forceinline__ void final_phase(const Frame& F, const Args& a) {
    unsigned char* ws = a.ws;
    const bf16* hbuf = (const bf16*)(ws + WS_H); const unsigned char* ybuf = ws + WS_YBUF;
    const int* dest = (const int*)(ws + WS_DEST); const float* gate = (const float*)(ws + WS_GATE);
    const float* fw = a.in[25]; float* out = a.out;
    const int lane = F.lane;
    f32x4 wn[4];
#pragma unroll
    for (int j = 0; j < 4; ++j) wn[j] = *((const f32x4*)fw + lane + 64 * j);
    const int gw = F.vcu * 8 + F.wave, NGW = F.G * 8;
    const int per = M / NGW;
    const int mw = gw * per;
    int dl = 0; float gl = 0.f;
    if (lane < 4 * per && per <= 16) { dl = dest[mw * 4 + lane]; gl = gate[mw * 4 + lane]; }
#pragma unroll 2
    for (int i = 0; i < per; ++i) {
        const int m = mw + i;
        const u32x2* hr = (const u32x2*)(hbuf + (size_t)m * D) + lane;
        f32x4 v[4];
#pragma unroll
        for (int j = 0; j < 4; ++j) { const u32x2 w = hr[64 * j]; v[j] = (f32x4){bflo(w.x), bfhi(w.x), bflo(w.y), bfhi(w.y)}; }
#pragma unroll
        for (int kx = 0; kx < 4; ++kx) {
            const int d = per <= 16 ? __shfl(dl, 4 * i + kx) : dest[m * 4 + kx]; const float gt = (per <= 16 ? __shfl(gl, 4 * i + kx) : gate[m * 4 + kx]) * (1.0f / F8_SY);
            const unsigned* yr = (const unsigned*)(ybuf + (size_t)d * D) + lane;
#pragma unroll
            for (int j = 0; j < 4; ++j) { const unsigned w = yr[64 * j]; const f32x2 lo = __builtin_amdgcn_cvt_pk_f32_fp8((int)w, false), hi = __builtin_amdgcn_cvt_pk_f32_fp8((int)w, true);
                v[j].x += gt * lo.x; v[j].y += gt * lo.y; v[j].z += gt * hi.x; v[j].w += gt * hi.y; }
        }
        float s = 0.f;
#pragma unroll
        for (int j = 0; j < 4; ++j) s += (v[j].x * v[j].x + v[j].y * v[j].y) + (v[j].z * v[j].z + v[j].w * v[j].w);
        const float rs = rsqrtf(wave_sum(s) * (1.f / D) + RMS_EPS);
        f32x4* orow = (f32x4*)(out + (size_t)m * D) + lane;
#pragma unroll
        for (int j = 0; j < 4; ++j) orow[64 * j] = v[j] * rs * wn[j];
    }
}

__global__ void __launch_bounds__(512, 2) fwd_megakernel(Args args) {
    extern __shared__ __attribute__((aligned(16))) unsigned char lds_raw[];
    Frame F;
    F.lds = (LAS unsigned char*)lds_raw;
    F.tid = threadIdx.x; F.lane = F.tid & 63; F.wave = __builtin_amdgcn_readfirstlane(F.tid >> 6);
    F.G = gridDim.x; { const int bx = blockIdx.x; F.vcu = (F.G % 8 == 0) ? (bx % 8) * (F.G / 8) + bx / 8 : bx; }
    unsigned char* ws = args.ws;
    const int lo = args.ph_lo, hi = args.ph_hi;
#define IN(k) (lo <= (k) && (k) < hi)
#if MK_SPLIT
#define SEAM(k) do { } while (0)
#else
    cg::grid_group grid = cg::this_grid();
    { volatile LAS unsigned* st = (volatile LAS unsigned*)(F.lds + LDS_MISC); if (F.tid < 2) st[F.tid] = 0u; __syncthreads(); }
    const XcdBarrier xbar = xcd_barrier_post((unsigned*)(ws + WS_CTL) + CW_BAR, (volatile LAS unsigned*)(F.lds + LDS_MISC));
    if (lo < 0) grid.sync();
#define SEAM(k) do { if (IN(k) && IN((k) + 1)) xcd_barrier(xbar); } while (0)
#endif
#define REP2(k) if constexpr (((MK_REPEAT >> (k)) & 1) != 0)
#define PH1 { pg8::Gemm g{(const bf16*)(ws + WS_HN), (const bf16*)(ws + WS_WINT), 1024, nullptr, 0, nullptr}; \
        pg8::StaticOrder S; S.init(M / 256, NPROJ_PAD / 256, F.G, (int)blockIdx.x); \
        pg8::EpiProj E{(bf16*)(ws + WS_Q), (bf16*)(ws + WS_K), (bf16*)(ws + WS_VT), (bf16*)(ws + WS_P)}; \
        pg8::gemm_phase<pg8::EpiProj, true, true>(F.lds, g, S, E); }
#define PH5 { pg8::Gemm g{(const bf16*)(ws + WS_MIX), (const bf16*)(ws + WS_WOT), 1024, nullptr, 0, nullptr}; \
        pg8::StaticOrder S; S.init(M / 256, D / 256, F.G, (int)blockIdx.x); \
        pg8::EpiWo E{args.in[0], (bf16*)(ws + WS_H)}; \
        pg8::gemm_phase<pg8::EpiWo, true, true>(F.lds, g, S, E); }
#define PH8 { const unsigned* ctl = (const unsigned*)(ws + WS_CTL); const int ntile = (int)ld_u32_agent(ctl + CW_NT); \
        pg8::Gemm g{(const bf16*)(ws + WS_HN2), (const bf16*)(ws + WS_WUPT), 512, ctl + CW_TEXP, (size_t)2048 * 1024, (const int*)(ws + WS_ROWTOK)}; \
        pg8::StaticOrder S; S.init(ntile, 8, F.G, (int)blockIdx.x); \
        pg8::EpiUp E{args.in[22], ws + WS_ACT}; \
        pg8::gemm_phase<pg8::EpiUp, true, true, true, true>(F.lds, g, S, E); }
#define PH9 { const unsigned* ctl = (const unsigned*)(ws + WS_CTL); const int ntile = (int)ld_u32_agent(ctl + CW_NT); \
        pg8::Gemm g{(const bf16*)(ws + WS_ACT), (const bf16*)(ws + WS_WDNT), 512, ctl + CW_TEXP, (size_t)1024 * 1024, nullptr}; \
        pg8::StaticOrder S; S.init(ntile, 4, F.G, (int)blockIdx.x); \
        pg8::EpiDown E{args.in[24], ws + WS_YBUF}; \
        pg8::gemm_phase<pg8::EpiDown, true, true, false, true>(F.lds, g, S, E); }
    if (IN(0)) { p0_prologue(F, args); REP2(0) p0_prologue(F, args); }
    SEAM(0);
    if (IN(1)) { PH1 REP2(1) PH1 }
    SEAM(1);
    if (IN(2)) { prep_phase<true>(F, args); REP2(2) prep_phase<true>(F, args); }
    SEAM(2);
    if (IN(3)) {
        if ((F.vcu & 1) == 0 && (F.vcu >> 1) < 128) { scan_phase(F, args, F.vcu >> 1); REP2(3) scan_phase(F, args, F.vcu >> 1); }
        else { const int nside = F.G - min((F.G + 1) / 2, 128); const int q_ = min((F.vcu + 1) >> 1, 128); side_phase(F, args, F.vcu - q_, nside); REP2(11) side_phase(F, args, F.vcu - q_, nside); }
    }
    SEAM(3);
    if (IN(4)) { combine_phase(F, args); REP2(4) combine_phase(F, args); }
    SEAM(4);
    if (IN(5)) { PH5 REP2(5) PH5 }
    SEAM(5);
    if (IN(6)) { router_phase(F, args); REP2(6) { __syncthreads(); router_phase(F, args); } }
    SEAM(6);
    if (IN(7)) { dispatch_phase(F, args); REP2(7) { __syncthreads(); dispatch_phase(F, args); } }
    SEAM(7);
    if (IN(8)) { PH8 REP2(8) PH8 }
    SEAM(8);
    if (IN(9)) { PH9 REP2(9) PH9 }
    SEAM(9);
    if (IN(10)) { final_phase(F, args); REP2(10) final_phase(F, args); }
#undef IN
#undef SEAM
}

extern "C" void kernel_launch(void* const* d_in, const int* in_sizes, int n_in, void* d_out, int out_size, void* d_ws, size_t ws_size, hipStream_t stream) {
    static int grid = 0;
    if (grid == 0) {
        if (n_in != 26 || in_sizes[0] != M * D || out_size != M * D || ws_size < WS_END) { fprintf(stderr, "kernel_launch: unexpected problem (n_in %d, in0 %d, out %d, ws %zu)\n", n_in, n_in > 0 ? in_sizes[0] : -1, out_size, ws_size); grid = -1; return; }
        int dev = 0, cus = 0, per_cu = 0;
        if (hipGetDevice(&dev) != hipSuccess || hipDeviceGetAttribute(&cus, hipDeviceAttributeMultiprocessorCount, dev) != hipSuccess) { grid = -1; return; }
        if (hipFuncSetAttribute((const void*)fwd_megakernel, hipFuncAttributeMaxDynamicSharedMemorySize, LDS_BYTES) != hipSuccess) { fprintf(stderr, "kernel_launch: hipFuncSetAttribute failed\n"); grid = -1; return; }
        if (hipOccupancyMaxActiveBlocksPerMultiprocessor(&per_cu, (const void*)fwd_megakernel, 512, LDS_BYTES) != hipSuccess || per_cu < 1) { fprintf(stderr, "kernel_launch: occupancy query says %d\n", per_cu); per_cu = 1; }
        (void)hipGetLastError();
        grid = cus * 1;
        if (grid != 256) fprintf(stderr, "kernel_launch: note: %d CUs\n", cus);
    }
    if (grid < 0) return;
    if (hipMemsetAsync((char*)d_ws + WS_CTL + (size_t)CW_BAR * 4, 0, XCD_BAR_WORDS * 4, stream) != hipSuccess) { fprintf(stderr, "kernel_launch: memset failed\n"); return; }
    Args a{};
    for (int i = 0; i < 26; ++i) a.in[i] = (const float*)d_in[i];
    a.out = (float*)d_out; a.ws = (unsigned char*)d_ws;
#if MK_SPLIT
    for (int ph = 0; ph < NPHASE; ++ph) { a.ph_lo = ph; a.ph_hi = ph + 1; hipLaunchKernelGGL(fwd_megakernel, dim3(grid), dim3(512), LDS_BYTES, stream, a); }
#else
    a.ph_lo = 0; a.ph_hi = NPHASE;
    void* kargs[] = {&a};
    hipError_t e = hipLaunchCooperativeKernel((const void*)fwd_megakernel, dim3(grid), dim3(512), kargs, LDS_BYTES, stream);
    if (e != hipSuccess) fprintf(stderr, "kernel_launch: cooperative launch failed: %s (grid %d)\n", hipGetErrorString(e), grid);
#endif
}
```

```cpp
#include <hip/hip_runtime.h>
#include <hip/hip_cooperative_groups.h>
#include <cstdio>
#include <cstdint>
namespace cg = cooperative_groups;

#ifndef MK_SPLIT
#define MK_SPLIT 0
#endif

#ifndef MK_REPEAT
#define MK_REPEAT 0
#endif
#define LAS __attribute__((address_space(3)))
typedef unsigned short bf16;
typedef float f32x4 __attribute__((ext_vector_type(4)));
typedef float f32x2 __attribute__((ext_vector_type(2)));
typedef unsigned u32x4 __attribute__((ext_vector_type(4)));
typedef unsigned u32x2 __attribute__((ext_vector_type(2)));
typedef short bf16x8 __attribute__((ext_vector_type(8)));
typedef short s16x4 __attribute__((ext_vector_type(4)));

constexpr int BATCH = 4, T = 8192, D = 1024, M = BATCH * T;
constexpr int NH = 8, HD = 64, CW = 512;
constexpr int SHIFT_W = 1920, NPROJ = 3456, NPROJ_PAD = 3584, PW = 2048;
constexpr int NE = 32, TOPK = 4, DE = 1024;
constexpr int GRIDW = 64, GROWS = 128;
constexpr int P_TILES_MAX = 544, P_ROWS = P_TILES_MAX * 256;
constexpr float RMS_EPS = 1e-5f, GN_EPS = 64e-5f;
constexpr int NPHASE = 11;

constexpr size_t MiB = 1u << 20;
constexpr size_t WS_CTL = 0;
constexpr size_t WS_W2T = 1 * MiB, WS_A2T = WS_W2T + 131072, WS_G2T = WS_A2T + 131072;
constexpr size_t WS_WINT = 2 * MiB, WS_WOT = 9 * MiB, WS_WUPT = 12 * MiB, WS_WDNT = 140 * MiB;
constexpr size_t WS_EIDX = 204 * MiB, WS_GATE = WS_EIDX + 524288, WS_RANK = WS_GATE + 524288, WS_DEST = WS_RANK + 524288, WS_ROWTOK = WS_DEST + 524288;
constexpr size_t WS_R = 208 * MiB, WS_V = 240 * MiB, WS_KK = 272 * MiB, WS_DECAY = 304 * MiB, WS_KDIR = 368 * MiB, WS_AKK = 432 * MiB,
                 WS_G = 496 * MiB, WS_ATT = 528 * MiB;
constexpr size_t WS_Q = 560 * MiB, WS_K = 592 * MiB, WS_VT = 624 * MiB, WS_P = 656 * MiB, WS_HN = 784 * MiB, WS_Y = 848 * MiB;
constexpr size_t WS_MIX = 560 * MiB, WS_H = 752 * MiB, WS_HN2 = 880 * MiB, WS_XBUF = 208 * MiB, WS_ACT = 480 * MiB, WS_YBUF = 208 * MiB;
constexpr size_t WS_END = 976 * MiB;
constexpr int CW_NT = 0, CW_TEXP = 64, CW_CNT = 1024, CW_BAR = 16384;

constexpr int LDS_BYTES = 159744, LDS_MISC = LDS_BYTES - 256;

typedef __bf16 bf16x2_t __attribute__((ext_vector_type(2)));
__device__ __forceinline__ unsigned cvt_pk_bf16(float lo, float hi) { const f32x2 v = {lo, hi}; return __builtin_bit_cast(unsigned, __builtin_convertvector(v, bf16x2_t)); }
typedef int i32x8 __attribute__((ext_vector_type(8)));
typedef int i32x4 __attribute__((ext_vector_type(4)));
#ifndef F8_SCALE1
#define F8_SCALE1 0
#endif
constexpr float F8_SX = 32.0f, F8_SW = 128.0f, F8_SACT = 8.0f, F8_SY = 32.0f;
__device__ __forceinline__ float f8clamp(float v) { return __builtin_amdgcn_fmed3f(v, -448.0f, 448.0f); }
__device__ __forceinline__ unsigned pk4_fp8(float a, float b, float c, float d) { int w = 0; w = __builtin_amdgcn_cvt_pk_fp8_f32(f8clamp(a), f8clamp(b), w, false); w = __builtin_amdgcn_cvt_pk_fp8_f32(f8clamp(c), f8clamp(d), w, true); return (unsigned)w; }
__device__ __forceinline__ float bflo(unsigned u) { return __uint_as_float(u << 16); }
__device__ __forceinline__ float bfhi(unsigned u) { return __uint_as_float(u & 0xffff0000u); }
__device__ __forceinline__ float bf1(bf16 v) { return __uint_as_float(((unsigned)v) << 16); }
__device__ __forceinline__ void unpack8(const u32x4 u, float* f) { f[0] = bflo(u.x); f[1] = bfhi(u.x); f[2] = bflo(u.y); f[3] = bfhi(u.y); f[4] = bflo(u.z); f[5] = bfhi(u.z); f[6] = bflo(u.w); f[7] = bfhi(u.w); }
__device__ __forceinline__ u32x4 pack8(const float* f) { u32x4 o; o.x = cvt_pk_bf16(f[0], f[1]); o.y = cvt_pk_bf16(f[2], f[3]); o.z = cvt_pk_bf16(f[4], f[5]); o.w = cvt_pk_bf16(f[6], f[7]); return o; }
__device__ __forceinline__ float wave_sum(float v) {
#pragma unroll
    for (int o = 1; o < 64; o <<= 1) v += __shfl_xor(v, o);
    return v;
}
__device__ __forceinline__ float sigmoidf_(float x) { return __builtin_amdgcn_rcpf(1.0f + __expf(-x)); }
__device__ __forceinline__ unsigned ld_u32_agent(const unsigned* p) { return __hip_atomic_load(p, __ATOMIC_RELAXED, __HIP_MEMORY_SCOPE_AGENT); }

namespace pg8 {
constexpr int BM = 256, BK = 64, HALF = 128, HTB = HALF * BK * 2, STAGE_BYTES = 8 * HTB, NXCD = 8, WGM = 8;
__host__ __device__ __forceinline__ int lds_byte(int r, int c) { const int st = (r >> 4) * 2 + (c >> 5), rr = r & 15, cc = c & 31, ob = rr * 64 + cc * 2; return st * 1024 + (ob ^ (((ob >> 9) & 1) << 5)); }
__host__ __device__ __forceinline__ void stage_rc(int b, int& R, int& C) { const int st = b / 1024, sb = b % 1024, swz = sb ^ (((sb >> 9) & 1) << 5); R = (st >> 1) * 16 + swz / 64; C = (st & 1) * 32 + (swz % 64) / 2; }
__host__ __device__ __forceinline__ int perm32(int rho) { const int n = rho >> 4, i = rho & 15; return 8 * (i >> 2) + 4 * n + (i & 3); }

struct Unit { int pm, pn, e; };
struct Gemm { const bf16* A; const bf16* Bt; int K; const unsigned* texp; size_t bstride; const int* rowtok; };

struct StaticOrder {
    int nM, nN, nwg, G, c;
    __device__ void init(int nM_, int nN_, int G_, int c_) { nM = nM_; nN = nN_; nwg = nM * nN; G = G_; c = c_; }
    __device__ bool next(int i, Unit& u) const {
        const long L = (long)i * G + c; if (L >= nwg) return false;
        int wgid = (int)L; { const int q = nwg / NXCD, r = nwg % NXCD, xcd = wgid % NXCD, off = wgid / NXCD; wgid = (xcd < r ? xcd * (q + 1) : r * (q + 1) + (xcd - r) * q) + off; }
        const int nig = WGM * nN, gid = wgid / nig, fm = gid * WGM, gsz = (nM - fm) < WGM ? (nM - fm) : WGM;
        u.pm = fm + ((wgid % nig) % gsz); u.pn = (wgid % nig) / gsz; u.e = 0; return true;
    }
};

__device__ __forceinline__ i32x8 cat8(const bf16x8 lo, const bf16x8 hi) { return __builtin_shufflevector(__builtin_bit_cast(i32x4, lo), __builtin_bit_cast(i32x4, hi), 0, 1, 2, 3, 4, 5, 6, 7); }
template <class Epi, bool ALIGN_EPI, bool SP2, bool GATHER = false, bool FP8 = false>
__device__ __forceinline__ void gemm_phase(LAS unsigned char* lds, const Gemm g, const StaticOrder& S, const Epi& E) {
    const int tid = threadIdx.x, wid = __builtin_amdgcn_readfirstlane(tid >> 6), lane = tid & 63, wr = wid >> 2, wc = wid & 3, fr = lane & 15, fq = lane >> 4;
    const int K = g.K, nt = K / BK;
    unsigned voffA[2], voffB[2];
#pragma unroll
    for (int i = 0; i < 2; ++i) { int R, C; stage_rc(tid * 16 + i * 8192, R, C); const int Rb = Epi::PERM ? ((R & ~31) + perm32(R & 31)) : R;
        voffA[i] = (unsigned)(R * K + C) * 2u; voffB[i] = (unsigned)(Rb * K + C) * 2u; }
    unsigned vC[2][2];
#define PG8_GROWS(u, dst) do { _Pragma("unroll") for (int h_ = 0; h_ < 2; ++h_) _Pragma("unroll") for (int i_ = 0; i_ < 2; ++i_) { int R_, C_; stage_rc(tid * 16 + i_ * 8192, R_, C_); \
        dst[h_][i_] = (unsigned)g.rowtok[(u).pm * BM + h_ * HALF + R_] * (unsigned)(K * 2) + (unsigned)(C_ * 2); } } while (0)
    const size_t kstep = (size_t)(BK * 2);
    const size_t hstep = (size_t)HALF * K * 2;
    const size_t tstep = 2 * hstep;
    const unsigned ldsw = (unsigned)wid * 1024u;
    const int aoff = lds_byte(wr * 64 + fr, fq * 8), boff = lds_byte(wc * 32 + fr, fq * 8);
#define PG8_SA(b, h) (((b) * 2 + (h)) * HTB)
#define PG8_SB(b, h) ((4 + (b) * 2 + (h)) * HTB)
#define PG8_STAGE(bufoff, gbase, voff) do { _Pragma("unroll") for (int _i = 0; _i < 2; ++_i) \
        __builtin_amdgcn_global_load_lds((const unsigned*)((const char*)(gbase) + (voff)[_i]), (LAS unsigned*)(lds + (bufoff) + ldsw + _i * 8192), 16, 0, 0); } while (0)
#define PG8_STAGE_A(bufoff, p, h, nx) do { if constexpr (GATHER) { PG8_STAGE(bufoff, p, vC[h]); } else PG8_STAGE(bufoff, (p) + (h) * hstep, voffA); } while (0)
#define PG8_LDA(dst, b, h) do { _Pragma("unroll") for (int m = 0; m < 4; ++m) _Pragma("unroll") for (int k = 0; k < 2; ++k) dst[m][k] = *(const LAS bf16x8*)(lds + PG8_SA(b, h) + aoff + m * 2048 + k * 1024); } while (0)
#define PG8_LDB(dst, b, h) do { _Pragma("unroll") for (int n = 0; n < 2; ++n) _Pragma("unroll") for (int k = 0; k < 2; ++k) dst[n][k] = *(const LAS bf16x8*)(lds + PG8_SB(b, h) + boff + n * 2048 + k * 1024); } while (0)
#define PG8_MMA(ai, bj, At, Bt) do { __builtin_amdgcn_s_setprio(1); \
        if constexpr (FP8) { _Pragma("unroll") for (int m = 0; m < 4; ++m) _Pragma("unroll") for (int n = 0; n < 2; ++n) \
            { const i32x8 b8_ = cat8(Bt[n][0], Bt[n][1]), a8_ = cat8(At[m][0], At[m][1]); asm volatile("v_mfma_f32_16x16x128_f8f6f4 %0, %1, %2, %0" : "+v"(acc[ai][bj][m][n]) : "v"(b8_), "v"(a8_)); } } \
        else { _Pragma("unroll") for (int m = 0; m < 4; ++m) _Pragma("unroll") for (int n = 0; n < 2; ++n) _Pragma("unroll") for (int k = 0; k < 2; ++k) \
            acc[ai][bj][m][n] = __builtin_amdgcn_mfma_f32_16x16x32_bf16(Bt[n][k], At[m][k], acc[ai][bj][m][n], 0, 0, 0); } \
        __builtin_amdgcn_s_setprio(0); } while (0)
#define PG8_WAIT_V(n) asm volatile("s_waitcnt vmcnt(" #n ")" ::: "memory")
#define PG8_WAIT_L(n) asm volatile("s_waitcnt lgkmcnt(" #n ")" ::: "memory")
#define PG8_BAR __builtin_amdgcn_s_barrier()
#define PG8_SCHED __builtin_amdgcn_sched_barrier(0)
#define PG8_UPTR(u, pa, pb) do { unsigned _e = g.texp ? ld_u32_agent(g.texp + (u).pm) : 0u; _e = (unsigned)__builtin_amdgcn_readfirstlane((int)_e); (u).e = (int)_e; \
        pa = GATHER ? (const char*)g.A : (const char*)g.A + (size_t)(u).pm * tstep; pb = (const char*)g.Bt + (size_t)_e * g.bstride + (size_t)(u).pn * tstep; } while (0)
    Unit cur, nxt; int ui = 0;
    if (!S.next(0, cur)) return;
    f32x4 acc[2][2][4][2];
#pragma unroll
    for (int a = 0; a < 2; ++a)
#pragma unroll
        for (int b = 0; b < 2; ++b)
#pragma unroll
            for (int m = 0; m < 4; ++m)
#pragma unroll
                for (int n = 0; n < 2; ++n) acc[a][b][m][n] = (f32x4){0.f, 0.f, 0.f, 0.f};
    bf16x8 At[4][2], B0[2][2], B1[2][2];
    const char* cA; const char* cB;
    PG8_UPTR(cur, cA, cB);
    if constexpr (GATHER) { PG8_GROWS(cur, vC); }
    if constexpr (SP2) {
        PG8_STAGE(PG8_SB(0, 0), cB, voffB); PG8_STAGE(PG8_SB(0, 1), cB + hstep, voffB); PG8_STAGE_A(PG8_SA(0, 0), cA, 0, false); PG8_STAGE_A(PG8_SA(0, 1), cA, 1, false);
        if (wr == 1) PG8_BAR;
        PG8_WAIT_V(2); PG8_BAR;
        PG8_STAGE(PG8_SB(1, 0), cB + kstep, voffB); PG8_STAGE_A(PG8_SA(1, 0), cA + kstep, 0, false); PG8_STAGE(PG8_SB(1, 1), cB + hstep + kstep, voffB);
        PG8_WAIT_V(6); PG8_BAR;
    } else {
        PG8_STAGE(PG8_SB(0, 0), cB, voffB); PG8_STAGE_A(PG8_SA(0, 0), cA, 0, false); PG8_STAGE(PG8_SB(0, 1), cB + hstep, voffB); PG8_STAGE_A(PG8_SA(0, 1), cA, 1, false);
        if (wr == 1) PG8_BAR;
        PG8_WAIT_V(4); PG8_BAR;
        PG8_STAGE(PG8_SB(1, 0), cB + kstep, voffB); PG8_STAGE_A(PG8_SA(1, 0), cA + kstep, 0, false); PG8_STAGE(PG8_SB(1, 1), cB + hstep + kstep, voffB);
        PG8_WAIT_V(6); PG8_BAR;
    }
    for (;;) {
        const bool has_next = S.next(ui + 1, nxt);
        const char* nA = cA; const char* nB = cB;
        if (has_next) PG8_UPTR(nxt, nA, nB);
#pragma unroll 1
        for (int t = 0; t < nt; t += 2) {
            const bool last = (t == nt - 2);
            const char* a1 = cA + (size_t)(t + 1) * kstep;
            const char* a2 = last ? nA : cA + (size_t)(t + 2) * kstep; const char* b2 = last ? nB : cB + (size_t)(t + 2) * kstep;
            const char* a3 = a2 + kstep; const char* b3 = b2 + kstep;
            if constexpr (SP2) {
            PG8_LDB(B0, 0, 0); PG8_LDB(B1, 0, 1); PG8_SCHED; PG8_LDA(At, 0, 0); PG8_STAGE_A(PG8_SA(1, 1), a1, 1, false);
            if constexpr (GATHER) { if (last && has_next) { PG8_GROWS(nxt, vC); } }
            PG8_WAIT_V(8); PG8_WAIT_L(0); PG8_BAR; PG8_MMA(0, 0, At, B0); PG8_MMA(0, 1, At, B1); PG8_BAR; PG8_SCHED;
            PG8_LDA(At, 0, 1); PG8_STAGE(PG8_SB(0, 0), b2, voffB); PG8_STAGE(PG8_SB(0, 1), b2 + hstep, voffB); PG8_STAGE_A(PG8_SA(0, 0), a2, 0, last);
            PG8_WAIT_V(8); PG8_WAIT_L(0); PG8_BAR; PG8_MMA(1, 0, At, B0); PG8_MMA(1, 1, At, B1); PG8_BAR; PG8_SCHED;
            PG8_LDB(B0, 1, 0); PG8_LDB(B1, 1, 1); PG8_SCHED; PG8_LDA(At, 1, 0); PG8_STAGE_A(PG8_SA(0, 1), a2, 1, last);
            PG8_WAIT_V(8); PG8_WAIT_L(0); PG8_BAR; PG8_MMA(0, 0, At, B0); PG8_MMA(0, 1, At, B1); PG8_BAR; PG8_SCHED;
            PG8_LDA(At, 1, 1); PG8_STAGE(PG8_SB(1, 0), b3, voffB); PG8_STAGE(PG8_SB(1, 1), b3 + hstep, voffB); PG8_STAGE_A(PG8_SA(1, 0), a3, 0, last);
            PG8_WAIT_V(8); PG8_WAIT_L(0); PG8_BAR; PG8_MMA(1, 0, At, B0); PG8_MMA(1, 1, At, B1); PG8_BAR; PG8_SCHED;
            } else {
            PG8_LDB(B0, 0, 0); PG8_SCHED; PG8_LDA(At, 0, 0); PG8_STAGE_A(PG8_SA(1, 1), a1, 1, false);
            if constexpr (GATHER) { if (last && has_next) { PG8_GROWS(nxt, vC); } }
            PG8_WAIT_L(8); PG8_BAR; PG8_WAIT_L(0); PG8_MMA(0, 0, At, B0); PG8_BAR; PG8_SCHED;
            PG8_LDB(B1, 0, 1); PG8_STAGE(PG8_SB(0, 0), b2, voffB);
            PG8_BAR; PG8_WAIT_L(0); PG8_MMA(0, 1, At, B1); PG8_BAR;
            PG8_LDA(At, 0, 1); PG8_STAGE_A(PG8_SA(0, 0), a2, 0, last);
            PG8_BAR; PG8_WAIT_L(0); PG8_MMA(1, 0, At, B0); PG8_BAR; PG8_SCHED;
            PG8_STAGE(PG8_SB(0, 1), b2 + hstep, voffB);
            PG8_WAIT_V(6); PG8_BAR; PG8_MMA(1, 1, At, B1); PG8_BAR;
            PG8_LDB(B0, 1, 0); PG8_SCHED; PG8_LDA(At, 1, 0); PG8_STAGE_A(PG8_SA(0, 1), a2, 1, last);
            PG8_WAIT_L(8); PG8_BAR; PG8_WAIT_L(0); PG8_MMA(0, 0, At, B0); PG8_BAR; PG8_SCHED;
            PG8_LDB(B1, 1, 1); PG8_STAGE(PG8_SB(1, 0), b3, voffB);
            PG8_BAR; PG8_WAIT_L(0); PG8_MMA(0, 1, At, B1); PG8_BAR;
            PG8_LDA(At, 1, 1); PG8_STAGE_A(PG8_SA(1, 0), a3, 0, last);
            PG8_BAR; PG8_WAIT_L(0); PG8_MMA(1, 0, At, B0); PG8_BAR; PG8_SCHED;
            PG8_STAGE(PG8_SB(1, 1), b3 + hstep, voffB);
            PG8_WAIT_V(6); PG8_BAR; PG8_MMA(1, 1, At, B1); PG8_BAR;
            }
        }
        if constexpr (ALIGN_EPI) { if (wr == 0) PG8_BAR; }
        if constexpr (FP8) { asm volatile("s_nop 15\n\ts_nop 15" ::: "memory"); PG8_SCHED; }
        E(acc, cur, wr, wc, fr, fq);
        if (!has_next) break;
#pragma unroll
        for (int a = 0; a < 2; ++a)
#pragma unroll
            for (int b = 0; b < 2; ++b)
#pragma unroll
                for (int m = 0; m < 4; ++m)
#pragma unroll
                    for (int n = 0; n < 2; ++n) acc[a][b][m][n] = (f32x4){0.f, 0.f, 0.f, 0.f};
        cur = nxt; cA = nA; cB = nB; ++ui;
        if constexpr (ALIGN_EPI) { if (wr == 1) PG8_BAR; }
    }
    PG8_WAIT_V(0);
    if constexpr (!ALIGN_EPI) { if (wr == 0) PG8_BAR; }
    PG8_BAR;
#undef PG8_SA
#undef PG8_SB
#undef PG8_STAGE
#undef PG8_LDA
#undef PG8_LDB
#undef PG8_MMA
#undef PG8_WAIT_V
#undef PG8_WAIT_L
#undef PG8_BAR
#undef PG8_SCHED
#undef PG8_UPTR
#undef PG8_STAGE_A
#undef PG8_GROWS
}

struct EpiProj {
    static constexpr bool PERM = true;
    bf16 *q, *k, *vT, *p;
    __device__ __forceinline__ void operator()(const f32x4 (&acc)[2][2][4][2], const Unit& u, int wr, int wc, int fr, int fq) const {
        const int row0 = u.pm * BM + wr * 64 + fr;
        const int pn = u.pn;
#pragma unroll
        for (int ai = 0; ai < 2; ++ai)
#pragma unroll
            for (int m = 0; m < 4; ++m) {
                const int row = row0 + ai * HALF + m * 16;
#pragma unroll
                for (int bj = 0; bj < 2; ++bj) {
                    f32x4 v0 = acc[ai][bj][m][0], v1 = acc[ai][bj][m][1];
                    const int col = pn * BM + bj * HALF + wc * 32 + 8 * fq;
                    if (pn >= 4 && pn < 6) {
                        const int cv = col - 1024, hh = cv >> 6, dim = cv & 63, b = row / T, t = row % T;
                        bf16* dst = vT + ((size_t)(((b * NH + hh) * GROWS + (t >> 6)) * HD + dim)) * 64 + (t & 63);
                        const unsigned w0 = cvt_pk_bf16(v0[0], v0[1]), w1 = cvt_pk_bf16(v0[2], v0[3]), w2 = cvt_pk_bf16(v1[0], v1[1]), w3 = cvt_pk_bf16(v1[2], v1[3]);
                        dst[0 * 64] = (bf16)(w0 & 0xffff); dst[1 * 64] = (bf16)(w0 >> 16); dst[2 * 64] = (bf16)(w1 & 0xffff); dst[3 * 64] = (bf16)(w1 >> 16);
                        dst[4 * 64] = (bf16)(w2 & 0xffff); dst[5 * 64] = (bf16)(w2 >> 16); dst[6 * 64] = (bf16)(w3 & 0xffff); dst[7 * 64] = (bf16)(w3 >> 16);
                        asm volatile("s_waitcnt vmcnt(40)" ::: "memory");
                    } else {
                        bf16* dst;
                        if (pn < 2) { v0 = v0 * 0.125f; v1 = v1 * 0.125f; dst = q + (size_t)row * CW + col; }
                        else if (pn < 4) dst = k + (size_t)row * CW + (col - 512);
                        else dst = p + (size_t)row * PW + (col - 1536);
                        u32x4 w; w.x = cvt_pk_bf16(v0[0], v0[1]); w.y = cvt_pk_bf16(v0[2], v0[3]); w.z = cvt_pk_bf16(v1[0], v1[1]); w.w = cvt_pk_bf16(v1[2], v1[3]);
                        *(u32x4*)dst = w;
                    }
                }
            }
    }
};
struct EpiWo {
    static constexpr bool PERM = true;
    const float* x; bf16* h;
    __device__ __forceinline__ void operator()(const f32x4 (&acc)[2][2][4][2], const Unit& u, int wr, int wc, int fr, int fq) const {
        const int row0 = u.pm * BM + wr * 64 + fr, col0 = u.pn * BM + wc * 32 + 8 * fq;
#pragma unroll
        for (int ai = 0; ai < 2; ++ai)
#pragma unroll
            for (int m = 0; m < 4; ++m) { const size_t off = (size_t)(row0 + ai * HALF + m * 16) * D + col0;
#pragma unroll
                for (int bj = 0; bj < 2; ++bj) { const f32x4 v0 = acc[ai][bj][m][0] + *(const f32x4*)(x + off + bj * HALF), v1 = acc[ai][bj][m][1] + *(const f32x4*)(x + off + bj * HALF + 4);
                    u32x4 w; w.x = cvt_pk_bf16(v0[0], v0[1]); w.y = cvt_pk_bf16(v0[2], v0[3]); w.z = cvt_pk_bf16(v1[0], v1[1]); w.w = cvt_pk_bf16(v1[2], v1[3]);
                    *(u32x4*)(h + off + bj * HALF) = w; } }
    }
};
struct EpiUp {
    static constexpr bool PERM = true;
    const float* b_up; unsigned char* act;
    __device__ __forceinline__ void operator()(const f32x4 (&acc)[2][2][4][2], const Unit& u, int wr, int wc, int fr, int fq) const {
        const int row0 = u.pm * BM + wr * 64 + fr, ch = u.pn * 128 + wc * 32 + 8 * fq;
        const float* bg = b_up + (size_t)u.e * 2048 + ch; const float* bl = bg + 1024;
        const f32x4 bg0 = *(const f32x4*)bg * F8_SACT, bg1 = *(const f32x4*)(bg + 4) * F8_SACT, bl0 = *(const f32x4*)bl, bl1 = *(const f32x4*)(bl + 4);
        constexpr float SG = F8_SACT / (F8_SX * F8_SW), SL = 1.0f / (F8_SX * F8_SW), KE = -1.702f * 1.44269504f / F8_SACT;
#pragma unroll
        for (int ai = 0; ai < 2; ++ai)
#pragma unroll
            for (int m = 0; m < 4; ++m) {
                float o[8];
#pragma unroll
                for (int n = 0; n < 2; ++n) { const f32x4 gv = acc[ai][0][m][n] * SG + (n ? bg1 : bg0), lv = acc[ai][1][m][n] * SL + (n ? bl1 : bl0);
#pragma unroll
                    for (int j = 0; j < 4; ++j) { const float gt = fminf(gv[j], 7.0f * F8_SACT), li = __builtin_amdgcn_fmed3f(lv[j], -7.0f, 7.0f);
                        const float t = gt * __builtin_amdgcn_rcpf(1.0f + __builtin_amdgcn_exp2f(gt * KE)); o[n * 4 + j] = __builtin_fmaf(li, t, t); } }
                int w0 = 0, w1 = 0;
                w0 = __builtin_amdgcn_cvt_pk_fp8_f32(o[0], o[1], w0, false); w0 = __builtin_amdgcn_cvt_pk_fp8_f32(o[2], o[3], w0, true);
                w1 = __builtin_amdgcn_cvt_pk_fp8_f32(o[4], o[5], w1, false); w1 = __builtin_amdgcn_cvt_pk_fp8_f32(o[6], o[7], w1, true);
                u32x2 w8; w8.x = (unsigned)w0; w8.y = (unsigned)w1;
                *(u32x2*)(act + (size_t)(row0 + ai * HALF + m * 16) * DE + ch) = w8;
            }
    }
};
struct EpiDown {
    static constexpr bool PERM = true;
    const float* b_dn; unsigned char* y;
    __device__ __forceinline__ void operator()(const f32x4 (&acc)[2][2][4][2], const Unit& u, int wr, int wc, int fr, int fq) const {
        const int row0 = u.pm * BM + wr * 64 + fr, col0 = u.pn * BM + wc * 32 + 8 * fq;
        const float* bb = b_dn + (size_t)u.e * D + col0;
        f32x4 bv[2][2];
#pragma unroll
        for (int bj = 0; bj < 2; ++bj)
#pragma unroll
            for (int n = 0; n < 2; ++n) bv[bj][n] = *(const f32x4*)(bb + bj * HALF + 4 * n) * F8_SY;
#pragma unroll
        for (int ai = 0; ai < 2; ++ai)
#pragma unroll
            for (int m = 0; m < 4; ++m) { unsigned char* rowp = y + (size_t)(row0 + ai * HALF + m * 16) * D + col0;
#pragma unroll
                for (int bj = 0; bj < 2; ++bj) { const f32x4 v0 = acc[ai][bj][m][0] * (F8_SY / (F8_SACT * F8_SW)) + bv[bj][0], v1 = acc[ai][bj][m][1] * (F8_SY / (F8_SACT * F8_SW)) + bv[bj][1];
                    u32x2 w; w.x = pk4_fp8(v0[0], v0[1], v0[2], v0[3]); w.y = pk4_fp8(v1[0], v1[1], v1[2], v1[3]);
                    *(u32x2*)(rowp + bj * HALF) = w; } }
    }
};
}


#define XB_TMO      128
#define XB_XCNT(j)  (256  + 64 * (j))
#define XB_XSUB(j)  (1280 + 64 * (j))
#define XB_XGEN(j)  (2304 + 64 * (j))
#define XB_TOP      3328
#define XB_TOPGEN   3392
#define XCD_BAR_WORDS 3456
#define XB_SPIN_CAP (1u << 20)
__device__ __forceinline__ unsigned xb_ld(unsigned* p)              { return __hip_atomic_load(p, __ATOMIC_RELAXED, __HIP_MEMORY_SCOPE_AGENT); }
__device__ __forceinline__ unsigned xb_add(unsigned* p, unsigned v) { return __hip_atomic_fetch_add(p, v, __ATOMIC_RELAXED, __HIP_MEMORY_SCOPE_AGENT); }
__device__ __forceinline__ unsigned xb_xcc_id() { return (unsigned)__builtin_amdgcn_s_getreg((3 << 11) | 20) & 0xFu; }
#define XB_SPIN(cond, bar) do { unsigned _sp = 0; while (cond) { __builtin_amdgcn_s_sleep(1); \
    if ((++_sp & 255u) == 0u) { if (xb_ld(&(bar)[XB_TMO])) break; if (_sp > XB_SPIN_CAP) { atomicAdd(&(bar)[XB_TMO], 1u); break; } } } } while (0)
struct XcdBarrier { unsigned* bar; unsigned x; volatile LAS unsigned* st; };
__device__ __forceinline__ XcdBarrier xcd_barrier_post(unsigned* bar, volatile LAS unsigned* st) {
    XcdBarrier b; b.bar = bar; b.x = xb_xcc_id(); b.st = st;
    if (threadIdx.x == 0) (void)xb_add(&bar[XB_XCNT(b.x)], 1u);
    return b;
}
__device__ __forceinline__ void xcd_barrier_complete(unsigned* bar, unsigned x, unsigned& nloc, unsigned& nx) {
    const unsigned G = gridDim.x * gridDim.y * gridDim.z;
    unsigned sum, cnt, mine, sp = 0u;
    for (;;) {
        sum = 0u; cnt = 0u; mine = 0u;
#pragma unroll
        for (unsigned j = 0; j < 16; ++j) { const unsigned c = xb_ld(&bar[XB_XCNT(j)]); sum += c; cnt += (c > 0u) ? 1u : 0u; mine = (j == x) ? c : mine; }
        if (sum == G) break;
        __builtin_amdgcn_s_sleep(1);
        if ((++sp & 255u) == 0u) { if (xb_ld(&bar[XB_TMO])) break; if (sp > XB_SPIN_CAP) { atomicAdd(&bar[XB_TMO], 1u); break; } }
    }
    nloc = mine > 0u ? mine : 1u; nx = cnt > 0u ? cnt : 1u;
}
__device__ __forceinline__ void xcd_barrier(const XcdBarrier& b) {
    asm volatile("s_waitcnt vmcnt(0)" ::: "memory");
    __syncthreads();
    if (threadIdx.x == 0) {
        unsigned* bar = b.bar;
        __builtin_amdgcn_s_waitcnt(0);
        unsigned nloc = b.st[0], nx = b.st[1];
        if (nloc == 0u) { xcd_barrier_complete(bar, b.x, nloc, nx); b.st[0] = nloc; b.st[1] = nx; }
        const unsigned old = xb_add(&bar[XB_XSUB(b.x)], 1u);
        const unsigned gen = old / nloc;
        if (old + 1u == (gen + 1u) * nloc) {
            __builtin_amdgcn_fence(__ATOMIC_RELEASE, "agent");
            asm volatile("s_waitcnt vmcnt(0)" ::: "memory");
            const unsigned og = xb_add(&bar[XB_TOP], 1u);
            const unsigned tg = og / nx;
            if (og + 1u == (tg + 1u) * nx) xb_add(&bar[XB_TOPGEN], 1u);
            else XB_SPIN(xb_ld(&bar[XB_TOPGEN]) == tg, bar);
            __builtin_amdgcn_fence(__ATOMIC_ACQUIRE, "agent");
            xb_add(&bar[XB_XGEN(b.x)], 1u);
            asm volatile("s_waitcnt vmcnt(0)" ::: "memory");
        } else {
            XB_SPIN(xb_ld(&bar[XB_XGEN(b.x)]) == gen, bar);
            __builtin_amdgcn_fence(__ATOMIC_ACQUIRE, "agent");
            asm volatile("s_waitcnt vmcnt(0)" ::: "memory");
        }
    }
    __syncthreads();
}

struct Args { const float* in[26]; float* out; unsigned char* ws; int ph_lo, ph_hi; };

struct Frame { LAS unsigned char* lds; int tid, lane, wave, G, vcu; };

__device__ __forceinline__ void transpose_item(const float* W, int K, int N, bf16* WT, int k0, int n0, int orow0, LAS float* scr, int lane) {
#pragma unroll 8
    for (int i = 0; i < 32; ++i) { const int kk = 2 * i + (lane >> 5); scr[kk * 33 + (lane & 31)] = W[(size_t)(k0 + kk) * N + n0 + (lane & 31)]; }
    asm volatile("s_waitcnt lgkmcnt(0)" ::: "memory");
    const int c = lane & 7;
#pragma unroll
    for (int j = 0; j < 4; ++j) { const int n = (lane >> 3) + 8 * j; const LAS float* s = scr + (8 * c) * 33 + n;
        u32x4 o; o.x = cvt_pk_bf16(s[0 * 33], s[1 * 33]); o.y = cvt_pk_bf16(s[2 * 33], s[3 * 33]); o.z = cvt_pk_bf16(s[4 * 33], s[5 * 33]); o.w = cvt_pk_bf16(s[6 * 33], s[7 * 33]);
        *(u32x4*)(WT + (size_t)(orow0 + n) * K + k0 + 8 * c) = o; }
    asm volatile("s_waitcnt lgkmcnt(0)" ::: "memory");
}

__device__ __forceinline__ void transpose_item8w(const float* W, int K, int N, unsigned char* WT, int k0, int n0, int orow0, LAS float* scr, int lane) {
#pragma unroll 8
    for (int i = 0; i < 64; ++i) { const int kk = 2 * i + (lane >> 5); scr[kk * 33 + (lane & 31)] = W[(size_t)(k0 + kk) * N + n0 + (lane & 31)]; }
    asm volatile("s_waitcnt lgkmcnt(0)" ::: "memory");
    const int c = lane & 7;
#pragma unroll
    for (int j = 0; j < 4; ++j) { const int n = (lane >> 3) + 8 * j; const LAS float* s = scr + (16 * c) * 33 + n;
        u32x4 o; o.x = pk4_fp8(s[0 * 33] * F8_SW, s[1 * 33] * F8_SW, s[2 * 33] * F8_SW, s[3 * 33] * F8_SW); o.y = pk4_fp8(s[4 * 33] * F8_SW, s[5 * 33] * F8_SW, s[6 * 33] * F8_SW, s[7 * 33] * F8_SW);
        o.z = pk4_fp8(s[8 * 33] * F8_SW, s[9 * 33] * F8_SW, s[10 * 33] * F8_SW, s[11 * 33] * F8_SW); o.w = pk4_fp8(s[12 * 33] * F8_SW, s[13 * 33] * F8_SW, s[14 * 33] * F8_SW, s[15 * 33] * F8_SW);
        *(u32x4*)(WT + (size_t)(orow0 + n) * K + k0 + 16 * c) = o; }
    asm volatile("s_waitcnt lgkmcnt(0)" ::: "memory");
}
__device__ __forceinline__ void transpose_item8(const float* W, int K, int N, unsigned char* WT, int k0, int n0, int orow0, LAS float* scr, int lane) {
#pragma unroll 8
    for (int i = 0; i < 32; ++i) { const int kk = 2 * i + (lane >> 5); scr[kk * 33 + (lane & 31)] = W[(size_t)(k0 + kk) * N + n0 + (lane & 31)]; }
    asm volatile("s_waitcnt lgkmcnt(0)" ::: "memory");
    const int c = lane & 7;
#pragma unroll
    for (int j = 0; j < 4; ++j) { const int n = (lane >> 3) + 8 * j; const LAS float* s = scr + (8 * c) * 33 + n;
        u32x2 o; o.x = pk4_fp8(s[0 * 33] * F8_SW, s[1 * 33] * F8_SW, s[2 * 33] * F8_SW, s[3 * 33] * F8_SW); o.y = pk4_fp8(s[4 * 33] * F8_SW, s[5 * 33] * F8_SW, s[6 * 33] * F8_SW, s[7 * 33] * F8_SW);
        *(u32x2*)(WT + (size_t)(orow0 + n) * K + k0 + 8 * c) = o; }
    asm volatile("s_waitcnt lgkmcnt(0)" ::: "memory");
}

__device__ __forceinline__ void p0_prologue(const Frame& F, const Args& a) {
    unsigned char* ws = a.ws;
    LAS float* scr = (LAS float*)(F.lds + F.wave * 8448);
    const int gw = F.vcu * 8 + F.wave, NGW = F.G * 8;
    constexpr int I_IN = 16 * 108, I_O = 16 * 32, I_L = 16, I_G = 32;
    constexpr int NITEMS = I_IN + I_O + 2 * I_L + 2 * I_L + I_G;
    for (int it = gw; it < NITEMS; it += NGW) {
        int r = it;
        if (r < I_IN) { const int kb = r / 108, nb = r % 108; transpose_item(a.in[2], 1024, NPROJ, (bf16*)(ws + WS_WINT), kb * 64, nb * 32, nb * 32, scr, F.lane); continue; }
        r -= I_IN;
        if (r < I_O) { const int kb = r / 32, nb = r % 32; transpose_item(a.in[17], 1024, 1024, (bf16*)(ws + WS_WOT), kb * 64, nb * 32, nb * 32, scr, F.lane); continue; }
        r -= I_O;
        if (r < 2 * I_L) { const int z = r / 16, nb = r % 16; transpose_item(a.in[8] + (size_t)z * 64 * 512, 64, 512, (bf16*)(ws + WS_W2T) + (size_t)z * 512 * 64, 0, nb * 32, nb * 32, scr, F.lane); continue; }
        r -= 2 * I_L;
        if (r < 2 * I_L) { const int z = r / 16, nb = r % 16; transpose_item(a.in[10] + (size_t)z * 64 * 512, 64, 512, (bf16*)(ws + WS_A2T) + (size_t)z * 512 * 64, 0, nb * 32, nb * 32, scr, F.lane); continue; }
        r -= 2 * I_L;
        { const int kb = r / 16, nb = r % 16; transpose_item(a.in[11], 128, 512, (bf16*)(ws + WS_G2T), kb * 64, nb * 32, nb * 32, scr, F.lane); }
    }
    { constexpr int I_UP = 32 * 8 * 64, I_DN = 32 * 8 * 32;
      LAS float* scrw = (LAS float*)(F.lds + F.wave * 16896);
      __syncthreads();
      for (int r = gw; r < I_UP + I_DN; r += NGW) {
        if (r < I_UP) {
            const int e = r / 512, q = r % 512, kb = q / 64, nb = q % 64, n0 = nb * 32;
            const int orow0 = n0 < 1024 ? 256 * (n0 >> 7) + (n0 & 127) : 256 * ((n0 - 1024) >> 7) + 128 + ((n0 - 1024) & 127);
            transpose_item8w(a.in[21] + (size_t)e * 1024 * 2048, 1024, 2048, ws + WS_WUPT + (size_t)e * 2048 * 1024, kb * 128, n0, orow0, scrw, F.lane); }
        else { const int r2 = r - I_UP, e = r2 / 256, q = r2 % 256, kb = q / 32, nb = q % 32;
            transpose_item8w(a.in[23] + (size_t)e * 1024 * 1024, 1024, 1024, ws + WS_WDNT + (size_t)e * 1024 * 1024, kb * 128, nb * 32, nb * 32, scrw, F.lane); } }
      __syncthreads(); }
    { u32x4* z = (u32x4*)(ws + WS_WINT + (size_t)NPROJ * 1024 * 2); const u32x4 zero = {0u, 0u, 0u, 0u};
      for (int i = F.vcu * 512 + F.tid; i < 16384; i += F.G * 512) z[i] = zero; }
    const float* x = a.in[0]; const float* nw = a.in[1]; bf16* hn = (bf16*)(ws + WS_HN);
    f32x4 wv[4];
#pragma unroll
    for (int j = 0; j < 4; ++j) wv[j] = *((const f32x4*)nw + F.lane + 64 * j);
    for (int m = gw; m < M; m += 2 * NGW) {
        const int m1 = m + NGW; const bool has1 = m1 < M;
        const f32x4* xr0 = (const f32x4*)(x + (size_t)m * D) + F.lane; const f32x4* xr1 = (const f32x4*)(x + (size_t)(has1 ? m1 : m) * D) + F.lane;
        f32x4 v0[4], v1[4]; float s0 = 0.f, s1 = 0.f;
#pragma unroll
        for (int j = 0; j < 4; ++j) { v0[j] = xr0[64 * j]; v1[j] = xr1[64 * j]; }
#pragma unroll
        for (int j = 0; j < 4; ++j) { s0 += (v0[j].x * v0[j].x + v0[j].y * v0[j].y) + (v0[j].z * v0[j].z + v0[j].w * v0[j].w); s1 += (v1[j].x * v1[j].x + v1[j].y * v1[j].y) + (v1[j].z * v1[j].z + v1[j].w * v1[j].w); }
        const float rs0 = rsqrtf(wave_sum(s0) * (1.f / D) + RMS_EPS), rs1 = rsqrtf(wave_sum(s1) * (1.f / D) + RMS_EPS);
        u32x2* o0 = (u32x2*)(hn + (size_t)m * D) + F.lane; u32x2* o1 = (u32x2*)(hn + (size_t)m1 * D) + F.lane;
#pragma unroll
        for (int j = 0; j < 4; ++j) { u32x2 o; o.x = cvt_pk_bf16(v0[j].x * rs0 * wv[j].x, v0[j].y * rs0 * wv[j].y); o.y = cvt_pk_bf16(v0[j].z * rs0 * wv[j].z, v0[j].w * rs0 * wv[j].w); o0[64 * j] = o; }
        if (has1) {
#pragma unroll
            for (int j = 0; j < 4; ++j) { u32x2 o; o.x = cvt_pk_bf16(v1[j].x * rs1 * wv[j].x, v1[j].y * rs1 * wv[j].y); o.y = cvt_pk_bf16(v1[j].z * rs1 * wv[j].z, v1[j].w * rs1 * wv[j].w); o1[64 * j] = o; } }
    }
}

constexpr int PREP_KBUF = 0, PREP_INV = 65536, PREP_AW = 67584, PREP_AA = PREP_AW + 17408, PREP_AG = PREP_AA + 17408, PREP_LD = 136;
template <bool STORE>
__device__ __forceinline__ void prep_phase(const Frame& F, const Args& a) {
    unsigned char* ws = a.ws;
    const bf16* p = (const bf16*)(ws + WS_P);
    bf16* r_out = (bf16*)(ws + WS_R); bf16* v_out = (bf16*)(ws + WS_V); bf16* kk_out = (bf16*)(ws + WS_KK);
    bf16* decay_out = (bf16*)(ws + WS_DECAY); bf16* kdir_out = (bf16*)(ws + WS_KDIR); bf16* akk_out = (bf16*)(ws + WS_AKK); bf16* g_out = (bf16*)(ws + WS_G);
    const bf16* w2T = (const bf16*)(ws + WS_W2T); const bf16* a2T = (const bf16*)(ws + WS_A2T); const bf16* g2T = (const bf16*)(ws + WS_G2T);
    const float* mu_p = a.in[5]; const float* mu_n = a.in[6]; const float* w0 = a.in[7]; const float* a0 = a.in[9];
    const float* k_k = a.in[12]; const float* k_a = a.in[13];
    LAS bf16* kbuf = (LAS bf16*)(F.lds + PREP_KBUF); LAS float* invb = (LAS float*)(F.lds + PREP_INV);
    LAS bf16* Aw = (LAS bf16*)(F.lds + PREP_AW); LAS bf16* Aa = (LAS bf16*)(F.lds + PREP_AA); LAS bf16* Ag = (LAS bf16*)(F.lds + PREP_AG);
    const int lane = F.lane, wave = F.wave, fr = lane & 15, fg = lane >> 4;
    for (int tile = F.vcu; tile < M / 64; tile += F.G) {
        const int m0 = tile * 64;
#pragma unroll 1
        for (int jj = 0; jj < 4; ++jj) {
            const int q = lane + 64 * jj; const bool valid = q < 240; const int c0 = 8 * q;
            float mp[8], mn[8];
#pragma unroll
            for (int i = 0; i < 8; ++i) { mp[i] = valid ? mu_p[c0 + i] : 0.f; mn[i] = valid ? mu_n[c0 + i] : 0.f; }
            const int mfirst = m0 + wave * 8;
            const u32x4 zero = {0u, 0u, 0u, 0u};
            u32x4 rows[10];
#pragma unroll
            for (int rI = 0; rI < 10; ++rI) { const int mr = mfirst - 1 + rI;
                const bool ok = valid && !(rI == 0 && (mfirst % T) == 0) && !(rI == 9 && ((mfirst + 7) % T) == T - 1);
                rows[rI] = ok ? *(const u32x4*)(p + (size_t)mr * PW + c0) : zero; }
#pragma unroll
            for (int i = 0; i < 8; ++i) {
                const int m = mfirst + i, it = wave * 8 + i;
                const u32x4 prev = rows[i], cur = rows[i + 1], nxt = rows[i + 2];
                float fp[8], fc[8], fn[8], s[8];
                unpack8(prev, fp); unpack8(cur, fc); unpack8(nxt, fn);
#pragma unroll
                for (int e = 0; e < 8; ++e) s[e] = fc[e] + mp[e] * (fp[e] - fc[e]) + mn[e] * (fn[e] - fc[e]);
                if (jj == 0) { if (STORE) { *(u32x4*)(r_out + (size_t)m * CW + c0) = pack8(s); } }
                else if (jj == 1) {
                    const int c = c0 - 512;
                    *(LAS u32x4*)(kbuf + it * 512 + c) = pack8(s);
                    float kr[8]; float ss = 0.f;
#pragma unroll
                    for (int e = 0; e < 8; ++e) { kr[e] = s[e] * k_k[c + e]; ss += kr[e] * kr[e]; }
                    ss += __shfl_xor(ss, 1); ss += __shfl_xor(ss, 2); ss += __shfl_xor(ss, 4);
                    const float inv = fminf(__builtin_amdgcn_rsqf(ss), 1e12f);
#pragma unroll
                    for (int e = 0; e < 8; ++e) kr[e] *= inv;
                    if (STORE) { *(u32x4*)(kk_out + (size_t)m * CW + c) = pack8(kr); }
                    if ((lane & 7) == 0) invb[it * 8 + (lane >> 3)] = inv;
                }
                else if (jj == 2) { if (STORE) { *(u32x4*)(v_out + (size_t)m * CW + (c0 - 1024)) = pack8(s); } }
                else if (valid) {
                    const int seg = lane >> 4, cw = 8 * (lane & 15);
                    if (seg == 0) {
#pragma unroll
                        for (int e = 0; e < 8; ++e) s[e] = 1.0f - 2.0f * __builtin_amdgcn_rcpf(__expf(2.0f * s[e]) + 1.0f);
                        *(LAS u32x4*)(Aw + it * PREP_LD + cw) = pack8(s);
                    } else if (seg == 1) { *(LAS u32x4*)(Aa + it * PREP_LD + cw) = pack8(s); }
                    else {
#pragma unroll
                        for (int e = 0; e < 8; ++e) s[e] = sigmoidf_(s[e]);
                        *(LAS u32x4*)(Ag + it * PREP_LD + cw) = pack8(s);
                    }
                }
            }
        }
        __syncthreads();
        const int nb = 64 * wave;
#define PREP_PROW(nt_) (nb + 32 * ((nt_) >> 1) + 8 * (fr >> 2) + 4 * ((nt_) & 1) + (fr & 3))
#define PREP_COL(nt_)  (nb + 32 * ((nt_) >> 1) + 8 * fg + 4 * ((nt_) & 1))
#pragma unroll 1
        for (int job = 0; job < 4; ++job) {
            const int z = job & 1;
            const bf16* WT = job < 2 ? w2T + (size_t)z * 512 * 64 : a2T + (size_t)z * 512 * 64;
            const LAS bf16* Ax = job < 2 ? Aw + z * 64 : Aa + z * 64;
            bf16x8 wf[2][4];
#pragma unroll
            for (int ks = 0; ks < 2; ++ks)
#pragma unroll
                for (int nt = 0; nt < 4; ++nt) wf[ks][nt] = *(const bf16x8*)(WT + (size_t)PREP_PROW(nt) * 64 + 32 * ks + 8 * fg);
            f32x4 pb[4], pkk[4], pka[4];
#pragma unroll
            for (int nt = 0; nt < 4; ++nt) { const int n = PREP_COL(nt);
                pb[nt] = *(const f32x4*)((job < 2 ? w0 : a0) + z * 512 + n); pkk[nt] = *(const f32x4*)(k_k + n); pka[nt] = *(const f32x4*)(k_a + n); }
            f32x4 acc[4][4];
#pragma unroll
            for (int mt = 0; mt < 4; ++mt)
#pragma unroll
                for (int nt = 0; nt < 4; ++nt) acc[mt][nt] = (f32x4){0.f, 0.f, 0.f, 0.f};
#pragma unroll
            for (int ks = 0; ks < 2; ++ks) {
                bf16x8 af[4];
#pragma unroll
                for (int mt = 0; mt < 4; ++mt) af[mt] = *(const LAS bf16x8*)(Ax + (16 * mt + fr) * PREP_LD + 32 * ks + 8 * fg);
#pragma unroll
                for (int mt = 0; mt < 4; ++mt)
#pragma unroll
                    for (int nt = 0; nt < 4; ++nt) acc[mt][nt] = __builtin_amdgcn_mfma_f32_16x16x32_bf16(wf[ks][nt], af[mt], acc[mt][nt], 0, 0, 0);
            }
#pragma unroll
            for (int mt = 0; mt < 4; ++mt) {
                const int it = 16 * mt + fr; const size_t m = (size_t)(m0 + it);
#pragma unroll
                for (int np = 0; np < 2; ++np) {
                    const int c8 = nb + 32 * np + 8 * fg;
                    if (job < 2) {
                        float o[8];
#pragma unroll
                        for (int hh = 0; hh < 2; ++hh) { const f32x4 v = acc[mt][2 * np + hh], bq = pb[2 * np + hh];
#pragma unroll
                            for (int i = 0; i < 4; ++i) o[4 * hh + i] = __expf(-0.60653066f * sigmoidf_(v[i] + bq[i])); }
                        if (STORE) { *(u32x4*)(decay_out + ((size_t)z * M + m) * CW + c8) = pack8(o); }
                    } else {
                        const u32x4 kb = *(const LAS u32x4*)(kbuf + it * 512 + c8);
                        float kv[8]; unpack8(kb, kv);
                        const float inv = invb[it * 8 + wave];
                        float kd[8], ak[8];
#pragma unroll
                        for (int hh = 0; hh < 2; ++hh) { const f32x4 v = acc[mt][2 * np + hh], bq = pb[2 * np + hh], kkc = pkk[2 * np + hh], kac = pka[2 * np + hh];
#pragma unroll
                            for (int i = 0; i < 4; ++i) { const float av = sigmoidf_(v[i] + bq[i]), kx = kv[4 * hh + i]; kd[4 * hh + i] = kx * (1.0f + (av - 1.0f) * kac[i]); ak[4 * hh + i] = av * (kx * kkc[i] * inv); } }
                        if (STORE) { *(u32x4*)(kdir_out + ((size_t)z * M + m) * CW + c8) = pack8(kd); *(u32x4*)(akk_out + ((size_t)z * M + m) * CW + c8) = pack8(ak); }
                    }
                }
            }
        }
        {
            bf16x8 wf[4][4];
#pragma unroll
            for (int ks = 0; ks < 4; ++ks)
#pragma unroll
                for (int nt = 0; nt < 4; ++nt) wf[ks][nt] = *(const bf16x8*)(g2T + (size_t)PREP_PROW(nt) * 128 + 32 * ks + 8 * fg);
            f32x4 acc[4][4];
#pragma unroll
            for (int mt = 0; mt < 4; ++mt)
#pragma unroll
                for (int nt = 0; nt < 4; ++nt) acc[mt][nt] = (f32x4){0.f, 0.f, 0.f, 0.f};
#pragma unroll
            for (int ks = 0; ks < 4; ++ks) {
                bf16x8 af[4];
#pragma unroll
                for (int mt = 0; mt < 4; ++mt) af[mt] = *(const LAS bf16x8*)(Ag + (16 * mt + fr) * PREP_LD + 32 * ks + 8 * fg);
#pragma unroll
                for (int mt = 0; mt < 4; ++mt)
#pragma unroll
                    for (int nt = 0; nt < 4; ++nt) acc[mt][nt] = __builtin_amdgcn_mfma_f32_16x16x32_bf16(wf[ks][nt], af[mt], acc[mt][nt], 0, 0, 0);
            }
#pragma unroll
            for (int mt = 0; mt < 4; ++mt) { const size_t m = (size_t)(m0 + 16 * mt + fr);
#pragma unroll
                for (int np = 0; np < 2; ++np) { const f32x4 v0 = acc[mt][2 * np], v1 = acc[mt][2 * np + 1];
                    u32x4 w; w.x = cvt_pk_bf16(v0[0], v0[1]); w.y = cvt_pk_bf16(v0[2], v0[3]); w.z = cvt_pk_bf16(v1[0], v1[1]); w.w = cvt_pk_bf16(v1[2], v1[3]);
                    if (STORE) { *(u32x4*)(g_out + m * CW + nb + 32 * np + 8 * fg) = w; } } }
        }
#undef PREP_PROW
#undef PREP_COL
        __syncthreads();
    }
}

__device__ __forceinline__ void attn_phase(const Frame& F, const Args& a, const int widx, const int nworkers) {
    unsigned char* ws = a.ws;
    const bf16* q = (const bf16*)(ws + WS_Q); const bf16* k = (const bf16*)(ws + WS_K); const bf16* vT = (const bf16*)(ws + WS_VT);
    bf16* att = (bf16*)(ws + WS_ATT);
    LAS float* bias = (LAS float*)F.lds + 16;
    for (int i = F.tid; i < 8 * 15 * 31; i += 512) bias[i] = a.in[3][i];
    __syncthreads();
    const int lane = F.lane, fr = lane & 15, fg = lane >> 4;
    const int per = (16384 + nworkers * 8 - 1) / (nworkers * 8);
    for (int it = 0; it < per; ++it) {
        const int task = widx * (8 * per) + it * 8 + F.wave; if (task >= 16384) break;
        const int cgp = task & 3, r = (task >> 2) & 127, h = (task >> 9) & 7, b = task >> 12;
        const int c0 = 16 * cgp, wsc = min(max(c0 - 8, 0), 32), rs = min(max(r - 4, 0), GROWS - 8);
        const int c = c0 + fr, cs = min(max(c - 8, 0), 48);
        const size_t tq = (size_t)b * T + r * 64 + c;
        bf16x8 qf[2];
#pragma unroll
        for (int ks = 0; ks < 2; ++ks) qf[ks] = *(const bf16x8*)(q + tq * CW + h * 64 + 32 * ks + 8 * fg);
        f32x4 sc[16];
        const int kcol_a = wsc + 8 * (fr >> 2) + (fr & 3);
        { bf16x8 kf[16][2];
#pragma unroll
          for (int t = 0; t < 16; ++t) { const int u = t >> 1, par = t & 1;
              const size_t tk = (size_t)b * T + (rs + u) * 64 + kcol_a + 4 * par;
              kf[t][0] = *(const bf16x8*)(k + tk * CW + h * 64 + 8 * fg); kf[t][1] = *(const bf16x8*)(k + tk * CW + h * 64 + 32 + 8 * fg); }
#pragma unroll
          for (int t = 0; t < 16; ++t) { f32x4 s = {0.f, 0.f, 0.f, 0.f};
              s = __builtin_amdgcn_mfma_f32_16x16x32_bf16(kf[t][0], qf[0], s, 0, 0, 0);
              s = __builtin_amdgcn_mfma_f32_16x16x32_bf16(kf[t][1], qf[1], s, 0, 0, 0);
              sc[t] = s; } }
        bool okm[8];
#pragma unroll
        for (int pi = 0; pi < 8; ++pi) { const int kc = wsc + 8 * fg + pi; okm[pi] = (kc >= cs) && (kc < cs + 16); }
        const LAS float* brow = bias + (h * 15 + (rs - r + 7)) * 31 + (wsc + 8 * fg - c + 15);
        float mx = -1e30f;
#pragma unroll
        for (int u = 0; u < 8; ++u)
#pragma unroll
            for (int pi = 0; pi < 8; ++pi) { const float s = okm[pi] ? sc[2 * u + (pi >> 2)][pi & 3] + brow[31 * u + pi] : -1e30f; sc[2 * u + (pi >> 2)][pi & 3] = s; mx = fmaxf(mx, s); }
        mx = fmaxf(mx, __shfl_xor(mx, 16)); mx = fmaxf(mx, __shfl_xor(mx, 32));
        float sum = 0.f;
        const float mxl = -mx * 1.44269504f;
#pragma unroll
        for (int t = 0; t < 16; ++t)
#pragma unroll
            for (int i = 0; i < 4; ++i) { const float pv = __builtin_amdgcn_exp2f(__builtin_fmaf(sc[t][i], 1.44269504f, mxl)); sc[t][i] = pv; sum += pv; }
        sum += __shfl_xor(sum, 16); sum += __shfl_xor(sum, 32);
        const float inv = 1.0f / sum;
        f32x4 o[4];
#pragma unroll
        for (int nt = 0; nt < 4; ++nt) o[nt] = (f32x4){0.f, 0.f, 0.f, 0.f};
        { bf16x8 vf[8][4];
#pragma unroll
          for (int u = 0; u < 8; ++u) { const bf16* vblk = vT + ((size_t)((b * NH + h) * GROWS + rs + u)) * (HD * 64) + wsc + 8 * fg;
#pragma unroll
              for (int nt = 0; nt < 4; ++nt) vf[u][nt] = *(const bf16x8*)(vblk + (16 * nt + fr) * 64); }
#pragma unroll
          for (int u = 0; u < 8; ++u) {
              union { u32x4 w; bf16x8 h8; } pf;
              pf.w.x = cvt_pk_bf16(sc[2 * u][0], sc[2 * u][1]); pf.w.y = cvt_pk_bf16(sc[2 * u][2], sc[2 * u][3]);
              pf.w.z = cvt_pk_bf16(sc[2 * u + 1][0], sc[2 * u + 1][1]); pf.w.w = cvt_pk_bf16(sc[2 * u + 1][2], sc[2 * u + 1][3]);
#pragma unroll
              for (int nt = 0; nt < 4; ++nt) o[nt] = __builtin_amdgcn_mfma_f32_16x16x32_bf16(vf[u][nt], pf.h8, o[nt], 0, 0, 0); } }
#pragma unroll
        for (int nt = 0; nt < 4; ++nt) { u32x2 w; w.x = cvt_pk_bf16(o[nt][0] * inv, o[nt][1] * inv); w.y = cvt_pk_bf16(o[nt][2] * inv, o[nt][3] * inv);
            *(u32x2*)(att + tq * CW + h * 64 + 16 * nt + 4 * fg) = w; }
    }
    __syncthreads();
}

__device__ __forceinline__ void side_phase(const Frame& F, const Args& a, const int widx, const int nworkers) {
    attn_phase(F, a, widx, nworkers);
}

__device__ __forceinline__ float row16_sum(float v) {
    v += __builtin_bit_cast(float, __builtin_amdgcn_update_dpp(0, __builtin_bit_cast(int, v), 0xB1, 0xF, 0xF, true));
    v += __builtin_bit_cast(float, __builtin_amdgcn_update_dpp(0, __builtin_bit_cast(int, v), 0x4E, 0xF, 0xF, true));
    v += __builtin_bit_cast(float, __builtin_amdgcn_update_dpp(0, __builtin_bit_cast(int, v), 0x141, 0xF, 0xF, true));
    v += __builtin_bit_cast(float, __builtin_amdgcn_update_dpp(0, __builtin_bit_cast(int, v), 0x140, 0xF, 0xF, true));
    return v;
}
constexpr int CS_R = 8;
constexpr int CS_NCH = 2, CS_NPR = 6;
constexpr int CS_AT = 0, CS_RT = 2304, CS_KHT = 4608, CS_BHT = 6656, CS_VT = 8704  , CS_TT = 10752, CS_AAK = 11264, CS_ARK = 11776, CS_ARB = 12288, CS_PL = 12800, CS_SLOT = 13056;
constexpr int CS_LD = 72;
constexpr int CS_SCR = CS_R * CS_SLOT  , CS_SCRW = 2304 * 2  , CS_FLAG = CS_SCR + CS_NPR * CS_SCRW  ;
__device__ __forceinline__ bf16 f2bf(float f) { return (bf16)cvt_pk_bf16(f, 0.f); }
struct ChainOps { u32x2 a4[4], r4[4], kh[4], bh[4], aak, ark, arb, tt, vb; f32x4 pl[4]; };
__device__ __forceinline__ void chain_load(const LAS unsigned char* sl, int fr, int fg, int c, ChainOps& o) {
    const int o16 = fr * 32 + fg * 8;
    const LAS unsigned char* pa = sl + CS_AT + fr * (CS_LD * 2) + fg * 8; const LAS unsigned char* pr = sl + CS_RT + fr * (CS_LD * 2) + fg * 8;
#pragma unroll
    for (int kq = 0; kq < 4; ++kq) { o.a4[kq] = *(const LAS u32x2*)(pa + 32 * kq); o.r4[kq] = *(const LAS u32x2*)(pr + 32 * kq); }
    o.aak = *(const LAS u32x2*)(sl + CS_AAK + o16); o.ark = *(const LAS u32x2*)(sl + CS_ARK + o16); o.arb = *(const LAS u32x2*)(sl + CS_ARB + o16); o.tt = *(const LAS u32x2*)(sl + CS_TT + o16);
    o.vb = *(const LAS u32x2*)(sl + CS_VT + c * 512 + o16);
#pragma unroll
    for (int mt = 0; mt < 4; ++mt) { o.pl[mt] = *(const LAS f32x4*)(sl + CS_PL + (16 * mt + 4 * fg) * 4);
        o.kh[mt] = *(const LAS u32x2*)(sl + CS_KHT + 512 * mt + o16); o.bh[mt] = *(const LAS u32x2*)(sl + CS_BHT + 512 * mt + o16); }
}
__device__ __forceinline__ f32x4 chain_compute(const ChainOps& o, f32x4 (&zacc)[4]) {
#define CS_M32(A_, B_, C_) __builtin_amdgcn_mfma_f32_16x16x32_bf16(A_, B_, C_, 0, 0, 0)
#define CS_M16(A_, B_, C_) __builtin_amdgcn_mfma_f32_16x16x16bf16_1k(__builtin_bit_cast(s16x4, A_), __builtin_bit_cast(s16x4, B_), C_, 0, 0, 0)
    union { u32x4 w; bf16x8 h8; } zb0, zb1, ap0, ap1, rp0, rp1;
    zb0.w.x = cvt_pk_bf16(zacc[0][0], zacc[0][1]); zb0.w.y = cvt_pk_bf16(zacc[0][2], zacc[0][3]); zb0.w.z = cvt_pk_bf16(zacc[1][0], zacc[1][1]); zb0.w.w = cvt_pk_bf16(zacc[1][2], zacc[1][3]);
    zb1.w.x = cvt_pk_bf16(zacc[2][0], zacc[2][1]); zb1.w.y = cvt_pk_bf16(zacc[2][2], zacc[2][3]); zb1.w.z = cvt_pk_bf16(zacc[3][0], zacc[3][1]); zb1.w.w = cvt_pk_bf16(zacc[3][2], zacc[3][3]);
    ap0.w = (u32x4){o.a4[0].x, o.a4[0].y, o.a4[1].x, o.a4[1].y}; ap1.w = (u32x4){o.a4[2].x, o.a4[2].y, o.a4[3].x, o.a4[3].y};
    rp0.w = (u32x4){o.r4[0].x, o.r4[0].y, o.r4[1].x, o.r4[1].y}; rp1.w = (u32x4){o.r4[2].x, o.r4[2].y, o.r4[3].x, o.r4[3].y};
    const f32x4 zero4 = {0.f, 0.f, 0.f, 0.f};
    f32x4 Wc = CS_M16(o.aak, o.vb, zero4);
    Wc = CS_M32(ap0.h8, zb0.h8, Wc); Wc = CS_M32(ap1.h8, zb1.h8, Wc);
    f32x4 Yc = CS_M16(o.ark, o.vb, zero4);
    Yc = CS_M32(rp0.h8, zb0.h8, Yc); Yc = CS_M32(rp1.h8, zb1.h8, Yc);
    f32x4 zz[4];
#pragma unroll
    for (int mt = 0; mt < 4; ++mt) zz[mt] = CS_M16(o.kh[mt], o.vb, zacc[mt] * o.pl[mt]);
    u32x2 wb, ub;
    wb.x = cvt_pk_bf16(Wc[0], Wc[1]); wb.y = cvt_pk_bf16(Wc[2], Wc[3]);
    const f32x4 Uc = CS_M16(o.tt, wb, zero4);
    ub.x = cvt_pk_bf16(Uc[0], Uc[1]); ub.y = cvt_pk_bf16(Uc[2], Uc[3]);
    Yc = CS_M16(o.arb, ub, Yc);
#pragma unroll
    for (int mt = 0; mt < 4; ++mt) zacc[mt] = CS_M16(o.bh[mt], ub, zz[mt]);
#undef CS_M32
#undef CS_M16
    return Yc;
}
template <int z>
__device__ __forceinline__ void scan_phase_z(const Frame& F, const Args& a, const int seq, const int half) {
    unsigned char* ws = a.ws;
    const int b = (seq >> 3) & 3, h = seq & 7;
    const size_t mb = (size_t)b * T;
    const int lane = F.lane, wave = F.wave, fr = lane & 15, fg = lane >> 4;
    constexpr int NCK = T / 16;
    volatile LAS unsigned* flg = (volatile LAS unsigned*)(F.lds + CS_FLAG);
    if (F.tid < 16) flg[F.tid] = 0u;
    __syncthreads();
    const int o16 = fr * 32 + fg * 8;
#define CS_M32(A_, B_, C_) __builtin_amdgcn_mfma_f32_16x16x32_bf16(A_, B_, C_, 0, 0, 0)
#define CS_M16(A_, B_, C_) __builtin_amdgcn_mfma_f32_16x16x16bf16_1k(__builtin_bit_cast(s16x4, A_), __builtin_bit_cast(s16x4, B_), C_, 0, 0, 0)
    if (wave < CS_NCH) {
        const int c = wave, rg = 2 * half + c;
        __builtin_amdgcn_s_setprio(3);
        bf16* yout = (bf16*)(ws + WS_Y) + (size_t)z * M * CW + h * 64 + rg * 16 + fr;
        f32x4 zacc[4];
#pragma unroll
        for (int mt = 0; mt < 4; ++mt) zacc[mt] = (f32x4){0.f, 0.f, 0.f, 0.f};
        ChainOps opA, opB;
#define CS_READY(nn) do { unsigned sp_ = 0; while (flg[(nn) & (CS_R - 1)] != (unsigned)((nn) + 1)) { __builtin_amdgcn_s_sleep(1); if (++sp_ > (1u << 24)) break; } __builtin_amdgcn_fence(__ATOMIC_ACQUIRE, "workgroup"); } while (0)
#define CS_HANDBACK(nn) do { asm volatile("s_waitcnt lgkmcnt(0)" ::: "memory"); if (lane == 0) flg[8 + c] = (unsigned)((nn) + 1); asm volatile("" ::: "memory"); } while (0)
#define CS_YSTORE(nn, Y_) do { asm volatile("s_waitcnt vmcnt(24)" ::: "memory");   _Pragma("unroll") for (int rr = 0; rr < 4; ++rr) { const int q_ = 16 * (nn) + 4 * fg + rr, t_ = z ? (T - 1 - q_) : q_; yout[(mb + t_) * CW] = f2bf((Y_)[rr]); } } while (0)
        CS_READY(0); chain_load(F.lds, fr, fg, rg, opA);
#pragma unroll 1
        for (int n = 0; n < NCK; n += 2) {
            CS_READY(n + 1); CS_HANDBACK(n);
            chain_load(F.lds + ((n + 1) & (CS_R - 1)) * CS_SLOT, fr, fg, rg, opB);
            { const f32x4 Yc = chain_compute(opA, zacc); CS_YSTORE(n, Yc); }
            if (n + 2 < NCK) CS_READY(n + 2);
            CS_HANDBACK(n + 1);
            if (n + 2 < NCK) chain_load(F.lds + ((n + 2) & (CS_R - 1)) * CS_SLOT, fr, fg, rg, opA);
            { const f32x4 Yc = chain_compute(opB, zacc); CS_YSTORE(n + 1, Yc); }
        }
#undef CS_READY
#undef CS_HANDBACK
#undef CS_YSTORE
        __builtin_amdgcn_s_setprio(0);
    } else {
        const int pi = wave - CS_NCH;
        LAS unsigned char* scr = F.lds + CS_SCR + pi * CS_SCRW;
        LAS bf16* KT = (LAS bf16*)scr; LAS bf16* BT = (LAS bf16*)(scr + 2304);
        const bf16* gw_ = (const bf16*)(ws + WS_DECAY) + (size_t)z * M * CW + h * 64;
        const bf16* gkk = (const bf16*)(ws + WS_KK) + h * 64;
        const bf16* gak = (const bf16*)(ws + WS_AKK) + (size_t)z * M * CW + h * 64;
        const bf16* gk = (const bf16*)(ws + WS_KDIR) + (size_t)z * M * CW + h * 64;
        const bf16* gr = (const bf16*)(ws + WS_R) + h * 64;
        const bf16* gv = (const bf16*)(ws + WS_V) + h * 64;
        unsigned nw[16], nkk[16], nak[16], nk[16], nr[16], nv[16];
        constexpr long RSTEP = z ? -(long)CW : (long)CW;
#define CS_FETCH_A(nn) do { if ((nn) < NCK) { const size_t m0_ = (mb + (z ? (T - 1 - 16 * (nn)) : 16 * (nn))) * CW + lane; const bf16* pw_ = gw_ + m0_; const bf16* pkk_ = gkk + m0_; \
            _Pragma("unroll") for (int tt = 0; tt < 16; ++tt) { nw[tt] = pw_[tt * RSTEP]; nkk[tt] = pkk_[tt * RSTEP]; } } } while (0)
#define CS_FETCH_B(nn) do { if ((nn) < NCK) { asm volatile("s_waitcnt vmcnt(30)" ::: "memory"); const size_t m0_ = (mb + (z ? (T - 1 - 16 * (nn)) : 16 * (nn))) * CW + lane; const bf16* pak_ = gak + m0_; const bf16* pk_ = gk + m0_; \
            _Pragma("unroll") for (int tt = 0; tt < 16; ++tt) { nak[tt] = pak_[tt * RSTEP]; nk[tt] = pk_[tt * RSTEP]; } } } while (0)
#define CS_FETCH_C(nn) do { if ((nn) < NCK) { asm volatile("s_waitcnt vmcnt(30)" ::: "memory"); const size_t m0_ = (mb + (z ? (T - 1 - 16 * (nn)) : 16 * (nn))) * CW + lane; const bf16* pr_ = gr + m0_; const bf16* pv_ = gv + m0_; \
            _Pragma("unroll") for (int tt = 0; tt < 16; ++tt) { nr[tt] = pr_[tt * RSTEP]; nv[tt] = pv_[tt * RSTEP]; } } } while (0)
        CS_FETCH_A(pi); CS_FETCH_B(pi); CS_FETCH_C(pi);
#pragma unroll 1
        for (int n = pi; n < NCK; n += CS_NPR) {
            const int slot = n & (CS_R - 1);
            float wv[16], kkv[16], akv[16], kv[16], rv[16]; unsigned vq[16];
#pragma unroll
            for (int tt = 0; tt < 16; ++tt) { unsigned x0 = nw[tt], x1 = nkk[tt], x2 = nak[tt], x3 = nk[tt], x4 = nr[tt];
                asm volatile("" : "+v"(x0), "+v"(x1), "+v"(x2), "+v"(x3), "+v"(x4));
                wv[tt] = __uint_as_float(x0 << 16); kkv[tt] = __uint_as_float(x1 << 16); akv[tt] = __uint_as_float(x2 << 16); kv[tt] = __uint_as_float(x3 << 16); rv[tt] = __uint_as_float(x4 << 16); }
#pragma unroll
            for (int tt = 0; tt < 16; ++tt) { unsigned x0 = nv[tt]; asm volatile("" : "+v"(x0)); vq[tt] = x0; }
            CS_FETCH_A(n + CS_NPR);
            { unsigned sp = 0; for (;;) { const u32x2 pg = *(const volatile LAS u32x2*)(flg + 8); const int mn = (int)min(pg.x, pg.y);
                  if (mn >= n - (CS_R - 3)) break; __builtin_amdgcn_s_sleep(2); if (++sp > (1u << 24)) break; } }
            __builtin_amdgcn_fence(__ATOMIC_ACQUIRE, "workgroup");
            LAS unsigned char* sl = F.lds + slot * CS_SLOT;
            float P[16];
            P[0] = wv[0];
#pragma unroll
            for (int tt = 1; tt < 16; ++tt) P[tt] = P[tt - 1] * wv[tt];
            const float PL = P[15];
            float khat[16], bhat[16];
#pragma unroll
            for (int tt = 0; tt < 16; ++tt) {
                const float pm1 = tt ? P[tt - 1] : 1.0f, inv = __builtin_amdgcn_rcpf(P[tt]);
                const float at = kkv[tt] * pm1, rt = rv[tt] * P[tt], kt = kv[tt] * inv, bt = -akv[tt] * inv;
                khat[tt] = kt * PL; bhat[tt] = bt * PL;
                { const unsigned w_ = cvt_pk_bf16(at, rt); *(LAS bf16*)(sl + CS_AT + (tt * CS_LD + lane) * 2) = (bf16)w_; *(LAS bf16*)(sl + CS_RT + (tt * CS_LD + lane) * 2) = (bf16)(w_ >> 16); }
                { const unsigned w_ = cvt_pk_bf16(kt, bt); KT[tt * CS_LD + lane] = (bf16)w_; BT[tt * CS_LD + lane] = (bf16)(w_ >> 16); }
            }
            CS_FETCH_B(n + CS_NPR);
            { u32x4 o0, o1;
              o0.x = cvt_pk_bf16(khat[0], khat[1]); o0.y = cvt_pk_bf16(khat[2], khat[3]); o0.z = cvt_pk_bf16(khat[4], khat[5]); o0.w = cvt_pk_bf16(khat[6], khat[7]);
              o1.x = cvt_pk_bf16(khat[8], khat[9]); o1.y = cvt_pk_bf16(khat[10], khat[11]); o1.z = cvt_pk_bf16(khat[12], khat[13]); o1.w = cvt_pk_bf16(khat[14], khat[15]);
              *(LAS u32x4*)(sl + CS_KHT + lane * 32) = o0; *(LAS u32x4*)(sl + CS_KHT + lane * 32 + 16) = o1;
              o0.x = cvt_pk_bf16(bhat[0], bhat[1]); o0.y = cvt_pk_bf16(bhat[2], bhat[3]); o0.z = cvt_pk_bf16(bhat[4], bhat[5]); o0.w = cvt_pk_bf16(bhat[6], bhat[7]);
              o1.x = cvt_pk_bf16(bhat[8], bhat[9]); o1.y = cvt_pk_bf16(bhat[10], bhat[11]); o1.z = cvt_pk_bf16(bhat[12], bhat[13]); o1.w = cvt_pk_bf16(bhat[14], bhat[15]);
              *(LAS u32x4*)(sl + CS_BHT + lane * 32) = o0; *(LAS u32x4*)(sl + CS_BHT + lane * 32 + 16) = o1; }
            *(LAS float*)(sl + CS_PL + lane * 4) = PL;
            { u32x4 o0, o1;
              o0.x = vq[0] | (vq[1] << 16); o0.y = vq[2] | (vq[3] << 16); o0.z = vq[4] | (vq[5] << 16); o0.w = vq[6] | (vq[7] << 16);
              o1.x = vq[8] | (vq[9] << 16); o1.y = vq[10] | (vq[11] << 16); o1.z = vq[12] | (vq[13] << 16); o1.w = vq[14] | (vq[15] << 16);
              *(LAS u32x4*)(sl + CS_VT + lane * 32) = o0; *(LAS u32x4*)(sl + CS_VT + lane * 32 + 16) = o1; }
            asm volatile("s_waitcnt lgkmcnt(0)" ::: "memory");
            bf16x8 af[2], rf[2], kf[2], bf_[2];
#pragma unroll
            for (int ks = 0; ks < 2; ++ks) { af[ks] = *(const LAS bf16x8*)(sl + CS_AT + (fr * CS_LD + 32 * ks + 8 * fg) * 2); rf[ks] = *(const LAS bf16x8*)(sl + CS_RT + (fr * CS_LD + 32 * ks + 8 * fg) * 2);
                kf[ks] = *(const LAS bf16x8*)(KT + fr * CS_LD + 32 * ks + 8 * fg); bf_[ks] = *(const LAS bf16x8*)(BT + fr * CS_LD + 32 * ks + 8 * fg); }
            const f32x4 zero4 = {0.f, 0.f, 0.f, 0.f};
            f32x4 Xc = zero4, Xt = zero4, AakT = zero4, ArbT = zero4, ArkT = zero4;
#pragma unroll
            for (int ks = 0; ks < 2; ++ks) { Xc = CS_M32(af[ks], bf_[ks], Xc); Xt = CS_M32(bf_[ks], af[ks], Xt);
                AakT = CS_M32(kf[ks], af[ks], AakT); ArbT = CS_M32(bf_[ks], rf[ks], ArbT); ArkT = CS_M32(kf[ks], rf[ks], ArkT); }
            CS_FETCH_C(n + CS_NPR);
            f32x4 S1;
#pragma unroll
            for (int rr = 0; rr < 4; ++rr) { const int q = 4 * fg + rr;
                Xc[rr] = (fr < q) ? Xc[rr] : 0.f; Xt[rr] = (q < fr) ? Xt[rr] : 0.f; S1[rr] = Xt[rr] + ((q == fr) ? 1.0f : 0.f);
                AakT[rr] = (q < fr) ? AakT[rr] : 0.f; ArkT[rr] = (q <= fr) ? ArkT[rr] : 0.f; ArbT[rr] = (q <= fr) ? ArbT[rr] : 0.f; }
            { u32x2 w; w.x = cvt_pk_bf16(AakT[0], AakT[1]); w.y = cvt_pk_bf16(AakT[2], AakT[3]); *(LAS u32x2*)(sl + CS_AAK + o16) = w;
              w.x = cvt_pk_bf16(ArkT[0], ArkT[1]); w.y = cvt_pk_bf16(ArkT[2], ArkT[3]); *(LAS u32x2*)(sl + CS_ARK + o16) = w;
              w.x = cvt_pk_bf16(ArbT[0], ArbT[1]); w.y = cvt_pk_bf16(ArbT[2], ArbT[3]); *(LAS u32x2*)(sl + CS_ARB + o16) = w; }
#define CS_PK(v) ((u32x2){cvt_pk_bf16((v)[0], (v)[1]), cvt_pk_bf16((v)[2], (v)[3])})
            const u32x2 xc = CS_PK(Xc), xt = CS_PK(Xt), s1 = CS_PK(S1);
            const f32x4 X2c = CS_M16(xt, xc, zero4), X2t = CS_M16(xc, xt, zero4);
            const u32x2 x2c = CS_PK(X2c), x2t = CS_PK(X2t);
            const f32x4 S2 = CS_M16(x2c, s1, S1);
            const f32x4 X4c = CS_M16(x2t, x2c, zero4), X4t = CS_M16(x2c, x2t, zero4);
            const u32x2 x4c = CS_PK(X4c), x4t = CS_PK(X4t), s2 = CS_PK(S2);
            const f32x4 S4 = CS_M16(x4c, s2, S2);
            const f32x4 X8c = CS_M16(x4t, x4c, zero4);
            const u32x2 x8c = CS_PK(X8c), s4 = CS_PK(S4);
            const f32x4 S8 = CS_M16(x8c, s4, S4);
            *(LAS u32x2*)(sl + CS_TT + o16) = CS_PK(S8);
#undef CS_PK
            asm volatile("s_waitcnt lgkmcnt(0)" ::: "memory");
            __builtin_amdgcn_fence(__ATOMIC_RELEASE, "workgroup");
            if (lane == 0) flg[slot] = (unsigned)(n + 1);
        }
#undef CS_FETCH_A
#undef CS_FETCH_B
#undef CS_FETCH_C
    }
#undef CS_M32
#undef CS_M16
    __syncthreads();
}

__device__ __forceinline__ void scan_phase(const Frame& F, const Args& a, const int idx) {
    const int seq = idx >> 1, half = idx & 1;
    if (seq >> 5) scan_phase_z<1>(F, a, seq, half); else scan_phase_z<0>(F, a, seq, half);
}

__device__ __forceinline__ void combine_phase(const Frame& F, const Args& a) {
    unsigned char* ws = a.ws;
    const bf16* att = (const bf16*)(ws + WS_ATT); const bf16* rr = (const bf16*)(ws + WS_R); const bf16* vv = (const bf16*)(ws + WS_V);
    const bf16* kd = (const bf16*)(ws + WS_KDIR); const bf16* gg = (const bf16*)(ws + WS_G); const bf16* y = (const bf16*)(ws + WS_Y);
    bf16* mix = (bf16*)(ws + WS_MIX);
    const float* anw = a.in[4]; const float* r_k = a.in[14]; const float* ln_w = a.in[15]; const float* ln_b = a.in[16];
    const int lane = F.lane, c0 = 8 * lane;
    float nw[8], rk[8], lw[8], lb[8];
#pragma unroll
    for (int i = 0; i < 8; ++i) { nw[i] = anw[c0 + i]; rk[i] = r_k[c0 + i]; lw[i] = ln_w[c0 + i]; lb[i] = ln_b[c0 + i]; }
    const int gw = F.vcu * 8 + F.wave, NGW = F.G * 8;
#pragma unroll 2
    for (int m = gw; m < M; m += NGW) {
        const size_t o = (size_t)m * CW + c0;
        float f[8];
        unpack8(*(const u32x4*)(att + o), f);
        float ss = 0.f;
#pragma unroll
        for (int i = 0; i < 8; ++i) ss += f[i] * f[i];
        const float rs = rsqrtf(wave_sum(ss) * (1.f / CW) + RMS_EPS);
#pragma unroll
        for (int i = 0; i < 8; ++i) f[i] = f[i] * rs * nw[i];
        *(u32x4*)(mix + (size_t)m * D + c0) = pack8(f);
        float yv[8], yw[8];
        unpack8(*(const u32x4*)(y + o), yv); unpack8(*(const u32x4*)(y + (size_t)M * CW + o), yw);
#pragma unroll
        for (int i = 0; i < 8; ++i) yv[i] += yw[i];
        float s1 = 0.f;
#pragma unroll
        for (int i = 0; i < 8; ++i) s1 += yv[i];
        s1 += __shfl_xor(s1, 1); s1 += __shfl_xor(s1, 2); s1 += __shfl_xor(s1, 4);
        const float mean = s1 * (1.f / 64.f);
        float s2 = 0.f;
#pragma unroll
        for (int i = 0; i < 8; ++i) { yv[i] -= mean; s2 += yv[i] * yv[i]; }
        s2 += __shfl_xor(s2, 1); s2 += __shfl_xor(s2, 2); s2 += __shfl_xor(s2, 4);
        const float rstd = rsqrtf(s2 * (1.f / 64.f) + GN_EPS);
        float rf[8], k0[8], k1[8], vf[8], gf[8];
        unpack8(*(const u32x4*)(rr + o), rf); unpack8(*(const u32x4*)(kd + o), k0); unpack8(*(const u32x4*)(kd + (size_t)M * CW + o), k1);
        unpack8(*(const u32x4*)(vv + o), vf); unpack8(*(const u32x4*)(gg + o), gf);
        float cf = 0.f;
#pragma unroll
        for (int i = 0; i < 8; ++i) cf += rf[i] * (k0[i] + k1[i]) * rk[i];
        cf += __shfl_xor(cf, 1); cf += __shfl_xor(cf, 2); cf += __shfl_xor(cf, 4);
#pragma unroll
        for (int i = 0; i < 8; ++i) f[i] = (yv[i] * rstd * lw[i] + lb[i] + cf * vf[i]) * gf[i];
        *(u32x4*)(mix + (size_t)m * D + CW + c0) = pack8(f);
    }
}

constexpr int RT_PITCH = 1032, RT_WH = 0, RT_WL = 32 * RT_PITCH * 2, RT_HIST = 2 * RT_WL, RT_EL = RT_HIST + 256;
__device__ __forceinline__ void router_phase(const Frame& F, const Args& a) {
    unsigned char* ws = a.ws;
    const bf16* hbuf = (const bf16*)(ws + WS_H); unsigned char* hn2 = ws + WS_HN2;
    int* eidx = (int*)(ws + WS_EIDX); float* gate = (float*)(ws + WS_GATE); int* rank = (int*)(ws + WS_RANK);
    unsigned* ctl = (unsigned*)(ws + WS_CTL);
    const float* n2w = a.in[18]; const float* rw = a.in[19]; const float* rb = a.in[20];
    LAS bf16* wh = (LAS bf16*)(F.lds + RT_WH); LAS bf16* wl = (LAS bf16*)(F.lds + RT_WL); LAS int* hist = (LAS int*)(F.lds + RT_HIST); LAS int* eL = (LAS int*)(F.lds + RT_EL);
    { f32x4 tmp[16];
#pragma unroll
      for (int j = 0; j < 16; ++j) tmp[j] = *((const f32x4*)rw + F.tid + 512 * j);
#pragma unroll
      for (int j = 0; j < 16; ++j) { const int q = F.tid + 512 * j, d = q >> 3, e0 = 4 * (q & 7);
#pragma unroll
          for (int i = 0; i < 4; ++i) { const float w = tmp[j][i]; const unsigned hb = cvt_pk_bf16(w, 0.f) & 0xffffu; const float lo = w - __uint_as_float(hb << 16);
              wh[(e0 + i) * RT_PITCH + d] = (bf16)hb; wl[(e0 + i) * RT_PITCH + d] = (bf16)cvt_pk_bf16(lo, 0.f); } } }
    if (F.tid < 32) hist[F.tid] = 0;
    __syncthreads();
    const int lane = F.lane, tk = lane & 15, g = lane >> 4;
    const int blk = F.vcu;
    const int m = blk * 128 + F.wave * 16 + tk;
    const bf16* hrow = hbuf + (size_t)m * D + 8 * g;
    float ss = 0.f;
#pragma unroll 8
    for (int ks = 0; ks < 32; ++ks) { float xf[8]; unpack8(*(const u32x4*)(hrow + 32 * ks), xf);
        ss += (xf[0] * xf[0] + xf[1] * xf[1]) + (xf[2] * xf[2] + xf[3] * xf[3]) + (xf[4] * xf[4] + xf[5] * xf[5]) + (xf[6] * xf[6] + xf[7] * xf[7]); }
    ss += __shfl_xor(ss, 16); ss += __shfl_xor(ss, 32);
    const float rs = rsqrtf(ss * (1.f / D) + RMS_EPS);
    f32x4 acc0 = {0.f, 0.f, 0.f, 0.f}, acc1 = acc0;
    unsigned char* hrow8 = hn2 + (size_t)m * D + 8 * g;
    const LAS bf16* wh0 = wh + tk * RT_PITCH + 8 * g; const LAS bf16* wl0 = wl + tk * RT_PITCH + 8 * g;
#pragma unroll 4
    for (int ks = 0; ks < 32; ++ks) {
        float xf[8]; unpack8(*(const u32x4*)(hrow + 32 * ks), xf);
        const f32x4 x0 = {xf[0], xf[1], xf[2], xf[3]}, x1 = {xf[4], xf[5], xf[6], xf[7]};
        const f32x4 n0 = *(const f32x4*)(n2w + 32 * ks + 8 * g), n1 = *(const f32x4*)(n2w + 32 * ks + 8 * g + 4);
        const f32x4 y0 = x0 * rs * n0, y1 = x1 * rs * n1;
        { u32x2 w8; w8.x = pk4_fp8(y0.x * F8_SX, y0.y * F8_SX, y0.z * F8_SX, y0.w * F8_SX); w8.y = pk4_fp8(y1.x * F8_SX, y1.y * F8_SX, y1.z * F8_SX, y1.w * F8_SX); *(u32x2*)(hrow8 + 32 * ks) = w8; }
        union { u32x4 w; bf16x8 h8; } xh, xl;
        xh.w.x = cvt_pk_bf16(y0.x, y0.y); xh.w.y = cvt_pk_bf16(y0.z, y0.w); xh.w.z = cvt_pk_bf16(y1.x, y1.y); xh.w.w = cvt_pk_bf16(y1.z, y1.w);
        xl.w.x = cvt_pk_bf16(y0.x - bflo(xh.w.x), y0.y - bfhi(xh.w.x)); xl.w.y = cvt_pk_bf16(y0.z - bflo(xh.w.y), y0.w - bfhi(xh.w.y));
        xl.w.z = cvt_pk_bf16(y1.x - bflo(xh.w.z), y1.y - bfhi(xh.w.z)); xl.w.w = cvt_pk_bf16(y1.z - bflo(xh.w.w), y1.w - bfhi(xh.w.w));
        const bf16x8 a0h = *(const LAS bf16x8*)(wh0 + 32 * ks), a1h = *(const LAS bf16x8*)(wh0 + 16 * RT_PITCH + 32 * ks);
        const bf16x8 a0l = *(const LAS bf16x8*)(wl0 + 32 * ks), a1l = *(const LAS bf16x8*)(wl0 + 16 * RT_PITCH + 32 * ks);
        acc0 = __builtin_amdgcn_mfma_f32_16x16x32_bf16(a0h, xh.h8, acc0, 0, 0, 0); acc1 = __builtin_amdgcn_mfma_f32_16x16x32_bf16(a1h, xh.h8, acc1, 0, 0, 0);
        acc0 = __builtin_amdgcn_mfma_f32_16x16x32_bf16(a0h, xl.h8, acc0, 0, 0, 0); acc1 = __builtin_amdgcn_mfma_f32_16x16x32_bf16(a1h, xl.h8, acc1, 0, 0, 0);
        acc0 = __builtin_amdgcn_mfma_f32_16x16x32_bf16(a0l, xh.h8, acc0, 0, 0, 0); acc1 = __builtin_amdgcn_mfma_f32_16x16x32_bf16(a1l, xh.h8, acc1, 0, 0, 0);
    }
    float lv[8]; int li[8];
    { const f32x4 b0 = *(const f32x4*)(rb + 4 * g), b1 = *(const f32x4*)(rb + 16 + 4 * g);
#pragma unroll
      for (int i = 0; i < 4; ++i) { lv[i] = acc0[i] + b0[i]; li[i] = 4 * g + i; lv[4 + i] = acc1[i] + b1[i]; li[4 + i] = 16 + 4 * g + i; } }
    float tv[4]; int ti[4];
#pragma unroll
    for (int kx = 0; kx < 4; ++kx) {
        float bv = lv[0]; int bi = li[0];
#pragma unroll
        for (int i = 1; i < 8; ++i) { const bool gt = lv[i] > bv; bv = gt ? lv[i] : bv; bi = gt ? li[i] : bi; }
#pragma unroll
        for (int o = 16; o < 64; o <<= 1) { const float ov = __shfl_xor(bv, o); const int oi = __shfl_xor(bi, o); const bool tko = (ov > bv) || (ov == bv && oi < bi); bv = tko ? ov : bv; bi = tko ? oi : bi; }
        tv[kx] = bv; ti[kx] = bi;
#pragma unroll
        for (int i = 0; i < 8; ++i) lv[i] = (li[i] == bi) ? -3.0e38f : lv[i];
    }
    if (g == 0) {
        const float e0 = 1.0f, e1 = __expf(tv[1] - tv[0]), e2 = __expf(tv[2] - tv[0]), e3 = __expf(tv[3] - tv[0]);
        const float is = 1.0f / (e0 + e1 + e2 + e3);
        const float gs[4] = {e0 * is, e1 * is, e2 * is, e3 * is};
#pragma unroll
        for (int kx = 0; kx < 4; ++kx) { eidx[m * 4 + kx] = ti[kx]; gate[m * 4 + kx] = gs[kx]; eL[(m - blk * 128) * 4 + kx] = ti[kx]; }
    }
    __syncthreads();
    { const int t = F.tid, e = eL[t]; int rk = 0;
      for (int u = 0; u < t; ++u) rk += (eL[u] == e) ? 1 : 0;
      rank[(blk * 128) * 4 + t] = rk;
      __hip_atomic_fetch_add(&hist[e], 1, __ATOMIC_RELAXED, __HIP_MEMORY_SCOPE_WORKGROUP); }
    __syncthreads();
    if (F.tid < 32) ctl[CW_CNT + blk * 32 + F.tid] = (unsigned)hist[F.tid];
}

__device__ __forceinline__ void dispatch_phase(const Frame& F, const Args& a) {
    unsigned char* ws = a.ws;
    unsigned* ctl = (unsigned*)(ws + WS_CTL);
    const int* eidx = (const int*)(ws + WS_EIDX); const int* rank = (const int*)(ws + WS_RANK); int* dest = (int*)(ws + WS_DEST);
    LAS int* part = (LAS int*)F.lds;
    LAS int* tot = part + 1024;
    const int blk = F.vcu, G = F.G;
    { const int e = F.tid & 31, pt = F.tid >> 5; int s = 0, sb = 0;
      if (G == 256) { int cv[16];
#pragma unroll
          for (int q = 0; q < 16; ++q) cv[q] = (int)ld_u32_agent(ctl + CW_CNT + (pt + 16 * q) * 32 + e);
#pragma unroll
          for (int q = 0; q < 16; ++q) { s += cv[q]; if (pt + 16 * q < blk) sb += cv[q]; } }
      else for (int bb = pt; bb < G; bb += 16) { const int cval = (int)ld_u32_agent(ctl + CW_CNT + bb * 32 + e); s += cval; if (bb < blk) sb += cval; }
      part[pt * 32 + e] = s; part[512 + pt * 32 + e] = sb; }
    __syncthreads();
    if (F.tid < 32) { int s = 0, sb = 0;
        for (int pt = 0; pt < 16; ++pt) { s += part[pt * 32 + F.tid]; sb += part[512 + pt * 32 + F.tid]; }
        tot[F.tid] = s; tot[32 + F.tid] = sb; tot[96 + F.tid] = (s + 255) & ~255; }
    __syncthreads();
    if (F.tid == 0) { int ps = 0; for (int e = 0; e < 32; ++e) { tot[64 + e] = ps; ps += tot[96 + e]; }
        tot[128] = ps >> 8; }
    __syncthreads();
    if (blk == 0) {
        if (F.tid == 0) ctl[CW_NT] = (unsigned)tot[128];
        for (int e = F.tid >> 4; e < 32; e += 32) { const int t0 = tot[64 + e] >> 8, nt = tot[96 + e] >> 8; for (int i = F.tid & 15; i < nt; i += 16) ctl[CW_TEXP + t0 + i] = (unsigned)e; }
    }
    const int lane = F.lane;
    const int mw = blk * 128 + F.wave * 16;
    int* rowtok = (int*)(ws + WS_ROWTOK);
    { const int e = eidx[mw * 4 + lane]; const int dl = tot[64 + e] + tot[32 + e] + rank[mw * 4 + lane]; dest[mw * 4 + lane] = dl; rowtok[dl] = mw + (lane >> 2); }
    { const int e = blk & 31, pt = blk >> 5, np = G >> 5; const int r0 = tot[64 + e] + tot[e], r1 = tot[64 + e] + tot[96 + e];
      if (np > 0) for (int r = r0 + pt * 512 + F.tid; r < r1; r += np * 512) rowtok[r] = 0; }
}

__device__ __forceinline__ void final_phase(const Frame& F, const Args& a) {
    unsigned char* ws = a.ws;
    const bf16* hbuf = (const bf16*)(ws + WS_H); const unsigned char* ybuf = ws + WS_YBUF;
    const int* dest = (const int*)(ws + WS_DEST); const float* gate = (const float*)(ws + WS_GATE);
    const float* fw = a.in[25]; float* out = a.out;
    const int lane = F.lane;
    f32x4 wn[4];
#pragma unroll
    for (int j = 0; j < 4; ++j) wn[j] = *((const f32x4*)fw + lane + 64 * j);
    const int gw = F.vcu * 8 + F.wave, NGW = F.G * 8;
    const int per = M / NGW;
    const int mw = gw * per;
    int dl = 0; float gl = 0.f;
    if (lane < 4 * per && per <= 16) { dl = dest[mw * 4 + lane]; gl = gate[mw * 4 + lane]; }
#pragma unroll 2
    for (int i = 0; i < per; ++i) {
        const int m = mw + i;
        const u32x2* hr = (const u32x2*)(hbuf + (size_t)m * D) + lane;
        f32x4 v[4];
#pragma unroll
        for (int j = 0; j < 4; ++j) { const u32x2 w = hr[64 * j]; v[j] = (f32x4){bflo(w.x), bfhi(w.x), bflo(w.y), bfhi(w.y)}; }
#pragma unroll
        for (int kx = 0; kx < 4; ++kx) {
            const int d = per <= 16 ? __shfl(dl, 4 * i + kx) : dest[m * 4 + kx]; const float gt = (per <= 16 ? __shfl(gl, 4 * i + kx) : gate[m * 4 + kx]) * (1.0f / F8_SY);
            const unsigned* yr = (const unsigned*)(ybuf + (size_t)d * D) + lane;
#pragma unroll
            for (int j = 0; j < 4; ++j) { const unsigned w = yr[64 * j]; const f32x2 lo = __builtin_amdgcn_cvt_pk_f32_fp8((int)w, false), hi = __builtin_amdgcn_cvt_pk_f32_fp8((int)w, true);
                v[j].x += gt * lo.x; v[j].y += gt * lo.y; v[j].z += gt * hi.x; v[j].w += gt * hi.y; }
        }
        float s = 0.f;
#pragma unroll
        for (int j = 0; j < 4; ++j) s += (v[j].x * v[j].x + v[j].y * v[j].y) + (v[j].z * v[j].z + v[j].w * v[j].w);
        const float rs = rsqrtf(wave_sum(s) * (1.f / D) + RMS_EPS);
        f32x4* orow = (f32x4*)(out + (size_t)m * D) + lane;
#pragma unroll
        for (int j = 0; j < 4; ++j) orow[64 * j] = v[j] * rs * wn[j];
    }
}

__global__ void __launch_bounds__(512, 2) fwd_megakernel(Args args) {
    extern __shared__ __attribute__((aligned(16))) unsigned char lds_raw[];
    Frame F;
    F.lds = (LAS unsigned char*)lds_raw;
    F.tid = threadIdx.x; F.lane = F.tid & 63; F.wave = __builtin_amdgcn_readfirstlane(F.tid >> 6);
    F.G = gridDim.x; { const int bx = blockIdx.x; F.vcu = (F.G % 8 == 0) ? (bx % 8) * (F.G / 8) + bx / 8 : bx; }
    unsigned char* ws = args.ws;
    const int lo = args.ph_lo, hi = args.ph_hi;
#define IN(k) (lo <= (k) && (k) < hi)
#if MK_SPLIT
#define SEAM(k) do { } while (0)
#else
    cg::grid_group grid = cg::this_grid();
    { volatile LAS unsigned* st = (volatile LAS unsigned*)(F.lds + LDS_MISC); if (F.tid < 2) st[F.tid] = 0u; __syncthreads(); }
    const XcdBarrier xbar = xcd_barrier_post((unsigned*)(ws + WS_CTL) + CW_BAR, (volatile LAS unsigned*)(F.lds + LDS_MISC));
    if (lo < 0) grid.sync();
#define SEAM(k) do { if (IN(k) && IN((k) + 1)) xcd_barrier(xbar); } while (0)
#endif
#define REP2(k) if constexpr (((MK_REPEAT >> (k)) & 1) != 0)
#define PH1 { pg8::Gemm g{(const bf16*)(ws + WS_HN), (const bf16*)(ws + WS_WINT), 1024, nullptr, 0, nullptr}; \
        pg8::StaticOrder S; S.init(M / 256, NPROJ_PAD / 256, F.G, (int)blockIdx.x); \
        pg8::EpiProj E{(bf16*)(ws + WS_Q), (bf16*)(ws + WS_K), (bf16*)(ws + WS_VT), (bf16*)(ws + WS_P)}; \
        pg8::gemm_phase<pg8::EpiProj, true, true>(F.lds, g, S, E); }
#define PH5 { pg8::Gemm g{(const bf16*)(ws + WS_MIX), (const bf16*)(ws + WS_WOT), 1024, nullptr, 0, nullptr}; \
        pg8::StaticOrder S; S.init(M / 256, D / 256, F.G, (int)blockIdx.x); \
        pg8::EpiWo E{args.in[0], (bf16*)(ws + WS_H)}; \
        pg8::gemm_phase<pg8::EpiWo, true, true>(F.lds, g, S, E); }
#define PH8 { const unsigned* ctl = (const unsigned*)(ws + WS_CTL); const int ntile = (int)ld_u32_agent(ctl + CW_NT); \
        pg8::Gemm g{(const bf16*)(ws + WS_HN2), (const bf16*)(ws + WS_WUPT), 512, ctl + CW_TEXP, (size_t)2048 * 1024, (const int*)(ws + WS_ROWTOK)}; \
        pg8::StaticOrder S; S.init(ntile, 8, F.G, (int)blockIdx.x); \
        pg8::EpiUp E{args.in[22], ws + WS_ACT}; \
        pg8::gemm_phase<pg8::EpiUp, true, true, true, true>(F.lds, g, S, E); }
#define PH9 { const unsigned* ctl = (const unsigned*)(ws + WS_CTL); const int ntile = (int)ld_u32_agent(ctl + CW_NT); \
        pg8::Gemm g{(const bf16*)(ws + WS_ACT), (const bf16*)(ws + WS_WDNT), 512, ctl + CW_TEXP, (size_t)1024 * 1024, nullptr}; \
        pg8::StaticOrder S; S.init(ntile, 4, F.G, (int)blockIdx.x); \
        pg8::EpiDown E{args.in[24], ws + WS_YBUF}; \
        pg8::gemm_phase<pg8::EpiDown, true, true, false, true>(F.lds, g, S, E); }
    if (IN(0)) { p0_prologue(F, args); REP2(0) p0_prologue(F, args); }
    SEAM(0);
    if (IN(1)) { PH1 REP2(1) PH1 }
    SEAM(1);
    if (IN(2)) { prep_phase<true>(F, args); REP2(2) prep_phase<true>(F, args); }
    SEAM(2);
    if (IN(3)) {
        if ((F.vcu & 1) == 0 && (F.vcu >> 1) < 128) { scan_phase(F, args, F.vcu >> 1); REP2(3) scan_phase(F, args, F.vcu >> 1); }
        else { const int nside = F.G - min((F.G + 1) / 2, 128); const int q_ = min((F.vcu + 1) >> 1, 128); side_phase(F, args, F.vcu - q_, nside); REP2(11) side_phase(F, args, F.vcu - q_, nside); }
    }
    SEAM(3);
    if (IN(4)) { combine_phase(F, args); REP2(4) combine_phase(F, args); }
    SEAM(4);
    if (IN(5)) { PH5 REP2(5) PH5 }
    SEAM(5);
    if (IN(6)) { router_phase(F, args); REP2(6) { __syncthreads(); router_phase(F, args); } }
    SEAM(6);
    if (IN(7)) { dispatch_phase(F, args); REP2(7) { __syncthreads(); dispatch_phase(F, args); } }
    SEAM(7);
    if (IN(8)) { PH8 REP2(8) PH8 }
    SEAM(8);
    if (IN(9)) { PH9 REP2(9) PH9 }
    SEAM(9);
    if (IN(10)) { final_phase(F, args); REP2(10) final_phase(F, args); }
#undef IN
#undef SEAM
}

extern "C" void kernel_launch(void* const* d_in, const int* in_sizes, int n_in, void* d_out, int out_size, void* d_ws, size_t ws_size, hipStream_t stream) {
    static int grid = 0;
    if (grid == 0) {
        if (n_in != 26 || in_sizes[0] != M * D || out_size != M * D || ws_size < WS_END) { fprintf(stderr, "kernel_launch: unexpected problem (n_in %d, in0 %d, out %d, ws %zu)\n", n_in, n_in > 0 ? in_sizes[0] : -1, out_size, ws_size); grid = -1; return; }
        int dev = 0, cus = 0, per_cu = 0;
        if (hipGetDevice(&dev) != hipSuccess || hipDeviceGetAttribute(&cus, hipDeviceAttributeMultiprocessorCount, dev) != hipSuccess) { grid = -1; return; }
        if (hipFuncSetAttribute((const void*)fwd_megakernel, hipFuncAttributeMaxDynamicSharedMemorySize, LDS_BYTES) != hipSuccess) { fprintf(stderr, "kernel_launch: hipFuncSetAttribute failed\n"); grid = -1; return; }
        if (hipOccupancyMaxActiveBlocksPerMultiprocessor(&per_cu, (const void*)fwd_megakernel, 512, LDS_BYTES) != hipSuccess || per_cu < 1) { fprintf(stderr, "kernel_launch: occupancy query says %d\n", per_cu); per_cu = 1; }
        (void)hipGetLastError();
        grid = cus * 1;
        if (grid != 256) fprintf(stderr, "kernel_launch: note: %d CUs\n", cus);
    }
    if (grid < 0) return;
    if (hipMemsetAsync((char*)d_ws + WS_CTL + (size_t)CW_BAR * 4, 0, XCD_BAR_WORDS * 4, stream) != hipSuccess) { fprintf(stderr, "kernel_launch: memset failed\n"); return; }
    Args a{};
    for (int i = 0; i < 26; ++i) a.in[i] = (const float*)d_in[i];
    a.out = (float*)d_out; a.ws = (unsigned char*)d_ws;
#if MK_SPLIT
    for (int ph = 0; ph < NPHASE; ++ph) { a.ph_lo = ph; a.ph_hi = ph + 1; hipLaunchKernelGGL(fwd_megakernel, dim3(grid), dim3(512), LDS_BYTES, stream, a); }
#else
    a.ph_lo = 0; a.ph_hi = NPHASE;
    void* kargs[] = {&a};
    hipError_t e = hipLaunchCooperativeKernel((const void*)fwd_megakernel, dim3(grid), dim3(512), kargs, LDS_BYTES, stream);
    if (e != hipSuccess) fprintf(stderr, "kernel_launch: cooperative launch failed: %s (grid %d)\n", hipGetErrorString(e), grid);
#endif
}
```

```cpp
#include <hip/hip_runtime.h>
#include <hip/hip_cooperative_groups.h>
#include <cstdio>
#include <cstdint>
namespace cg = cooperative_groups;

#ifndef MK_SPLIT
#define MK_SPLIT 0
#endif

#ifndef MK_REPEAT
#define MK_REPEAT 0
#endif
#define LAS __attribute__((address_space(3)))
typedef unsigned short bf16;
typedef float f32x4 __attribute__((ext_vector_type(4)));
typedef float f32x2 __attribute__((ext_vector_type(2)));
typedef unsigned u32x4 __attribute__((ext_vector_type(4)));
typedef unsigned u32x2 __attribute__((ext_vector_type(2)));
typedef short bf16x8 __attribute__((ext_vector_type(8)));
typedef short s16x4 __attribute__((ext_vector_type(4)));

constexpr int BATCH = 4, T = 8192, D = 1024, M = BATCH * T;
constexpr int NH = 8, HD = 64, CW = 512;
constexpr int SHIFT_W = 1920, NPROJ = 3456, NPROJ_PAD = 3584, PW = 2048;
constexpr int NE = 32, TOPK = 4, DE = 1024;
constexpr int GRIDW = 64, GROWS = 128;
constexpr int P_TILES_MAX = 544, P_ROWS = P_TILES_MAX * 256;
constexpr float RMS_EPS = 1e-5f, GN_EPS = 64e-5f;
constexpr int NPHASE = 11;

constexpr size_t MiB = 1u << 20;
constexpr size_t WS_CTL = 0;
constexpr size_t WS_W2T = 1 * MiB, WS_A2T = WS_W2T + 131072, WS_G2T = WS_A2T + 131072;
constexpr size_t WS_WINT = 2 * MiB, WS_WOT = 9 * MiB, WS_WUPT = 12 * MiB, WS_WDNT = 140 * MiB;
constexpr size_t WS_EIDX = 204 * MiB, WS_GATE = WS_EIDX + 524288, WS_RANK = WS_GATE + 524288, WS_DEST = WS_RANK + 524288, WS_ROWTOK = WS_DEST + 524288;
constexpr size_t WS_R = 208 * MiB, WS_V = 240 * MiB, WS_KK = 272 * MiB, WS_DECAY = 304 * MiB, WS_KDIR = 368 * MiB, WS_AKK = 432 * MiB,
                 WS_G = 496 * MiB, WS_ATT = 528 * MiB;
constexpr size_t WS_Q = 560 * MiB, WS_K = 592 * MiB, WS_VT = 624 * MiB, WS_P = 656 * MiB, WS_HN = 784 * MiB, WS_Y = 848 * MiB;
constexpr size_t WS_MIX = 560 * MiB, WS_H = 752 * MiB, WS_HN2 = 880 * MiB, WS_XBUF = 208 * MiB, WS_ACT = 480 * MiB, WS_YBUF = 208 * MiB;
constexpr size_t WS_END = 976 * MiB;
constexpr int CW_NT = 0, CW_TEXP = 64, CW_CNT = 1024, CW_BAR = 16384;

constexpr int LDS_BYTES = 159744, LDS_MISC = LDS_BYTES - 256;

typedef __bf16 bf16x2_t __attribute__((ext_vector_type(2)));
__device__ __forceinline__ unsigned cvt_pk_bf16(float lo, float hi) { const f32x2 v = {lo, hi}; return __builtin_bit_cast(unsigned, __builtin_convertvector(v, bf16x2_t)); }
typedef int i32x8 __attribute__((ext_vector_type(8)));
typedef int i32x4 __attribute__((ext_vector_type(4)));
#ifndef F8_SCALE1
#define F8_SCALE1 0
#endif
constexpr float F8_SX = 32.0f, F8_SW = 128.0f, F8_SACT = 8.0f, F8_SY = 32.0f;
__device__ __forceinline__ float f8clamp(float v) { return __builtin_amdgcn_fmed3f(v, -448.0f, 448.0f); }
__device__ __forceinline__ unsigned pk4_fp8(float a, float b, float c, float d) { int w = 0; w = __builtin_amdgcn_cvt_pk_fp8_f32(f8clamp(a), f8clamp(b), w, false); w = __builtin_amdgcn_cvt_pk_fp8_f32(f8clamp(c), f8clamp(d), w, true); return (unsigned)w; }
__device__ __forceinline__ float bflo(unsigned u) { return __uint_as_float(u << 16); }
__device__ __forceinline__ float bfhi(unsigned u) { return __uint_as_float(u & 0xffff0000u); }
__device__ __forceinline__ float bf1(bf16 v) { return __uint_as_float(((unsigned)v) << 16); }
__device__ __forceinline__ void unpack8(const u32x4 u, float* f) { f[0] = bflo(u.x); f[1] = bfhi(u.x); f[2] = bflo(u.y); f[3] = bfhi(u.y); f[4] = bflo(u.z); f[5] = bfhi(u.z); f[6] = bflo(u.w); f[7] = bfhi(u.w); }
__device__ __forceinline__ u32x4 pack8(const float* f) { u32x4 o; o.x = cvt_pk_bf16(f[0], f[1]); o.y = cvt_pk_bf16(f[2], f[3]); o.z = cvt_pk_bf16(f[4], f[5]); o.w = cvt_pk_bf16(f[6], f[7]); return o; }
__device__ __forceinline__ float wave_sum(float v) {
#pragma unroll
    for (int o = 1; o < 64; o <<= 1) v += __shfl_xor(v, o);
    return v;
}
__device__ __forceinline__ float sigmoidf_(float x) { return __builtin_amdgcn_rcpf(1.0f + __expf(-x)); }
__device__ __forceinline__ unsigned ld_u32_agent(const unsigned* p) { return __hip_atomic_load(p, __ATOMIC_RELAXED, __HIP_MEMORY_SCOPE_AGENT); }

namespace pg8 {
constexpr int BM = 256, BK = 64, HALF = 128, HTB = HALF * BK * 2, STAGE_BYTES = 8 * HTB, NXCD = 8, WGM = 8;
__host__ __device__ __forceinline__ int lds_byte(int r, int c) { const int st = (r >> 4) * 2 + (c >> 5), rr = r & 15, cc = c & 31, ob = rr * 64 + cc * 2; return st * 1024 + (ob ^ (((ob >> 9) & 1) << 5)); }
__host__ __device__ __forceinline__ void stage_rc(int b, int& R, int& C) { const int st = b / 1024, sb = b % 1024, swz = sb ^ (((sb >> 9) & 1) << 5); R = (st >> 1) * 16 + swz / 64; C = (st & 1) * 32 + (swz % 64) / 2; }
__host__ __device__ __forceinline__ int perm32(int rho) { const int n = rho >> 4, i = rho & 15; return 8 * (i >> 2) + 4 * n + (i & 3); }

struct Unit { int pm, pn, e; };
struct Gemm { const bf16* A; const bf16* Bt; int K; const unsigned* texp; size_t bstride; const int* rowtok; };

struct StaticOrder {
    int nM, nN, nwg, G, c;
    __device__ void init(int nM_, int nN_, int G_, int c_) { nM = nM_; nN = nN_; nwg = nM * nN; G = G_; c = c_; }
    __device__ bool next(int i, Unit& u) const {
        const long L = (long)i * G + c; if (L >= nwg) return false;
        int wgid = (int)L; { const int q = nwg / NXCD, r = nwg % NXCD, xcd = wgid % NXCD, off = wgid / NXCD; wgid = (xcd < r ? xcd * (q + 1) : r * (q + 1) + (xcd - r) * q) + off; }
        const int nig = WGM * nN, gid = wgid / nig, fm = gid * WGM, gsz = (nM - fm) < WGM ? (nM - fm) : WGM;
        u.pm = fm + ((wgid % nig) % gsz); u.pn = (wgid % nig) / gsz; u.e = 0; return true;
    }
};

__device__ __forceinline__ i32x8 cat8(const bf16x8 lo, const bf16x8 hi) { return __builtin_shufflevector(__builtin_bit_cast(i32x4, lo), __builtin_bit_cast(i32x4, hi), 0, 1, 2, 3, 4, 5, 6, 7); }
template <class Epi, bool ALIGN_EPI, bool SP2, bool GATHER = false, bool FP8 = false>
__device__ __forceinline__ void gemm_phase(LAS unsigned char* lds, const Gemm g, const StaticOrder& S, const Epi& E) {
    const int tid = threadIdx.x, wid = __builtin_amdgcn_readfirstlane(tid >> 6), lane = tid & 63, wr = wid >> 2, wc = wid & 3, fr = lane & 15, fq = lane >> 4;
    const int K = g.K, nt = K / BK;
    unsigned voffA[2], voffB[2];
#pragma unroll
    for (int i = 0; i < 2; ++i) { int R, C; stage_rc(tid * 16 + i * 8192, R, C); const int Rb = Epi::PERM ? ((R & ~31) + perm32(R & 31)) : R;
        voffA[i] = (unsigned)(R * K + C) * 2u; voffB[i] = (unsigned)(Rb * K + C) * 2u; }
    unsigned vC[2][2];
#define PG8_GROWS(u, dst) do { _Pragma("unroll") for (int h_ = 0; h_ < 2; ++h_) _Pragma("unroll") for (int i_ = 0; i_ < 2; ++i_) { int R_, C_; stage_rc(tid * 16 + i_ * 8192, R_, C_); \
        dst[h_][i_] = (unsigned)g.rowtok[(u).pm * BM + h_ * HALF + R_] * (unsigned)(K * 2) + (unsigned)(C_ * 2); } } while (0)
    const size_t kstep = (size_t)(BK * 2);
    const size_t hstep = (size_t)HALF * K * 2;
    const size_t tstep = 2 * hstep;
    const unsigned ldsw = (unsigned)wid * 1024u;
    const int aoff = lds_byte(wr * 64 + fr, fq * 8), boff = lds_byte(wc * 32 + fr, fq * 8);
#define PG8_SA(b, h) (((b) * 2 + (h)) * HTB)
#define PG8_SB(b, h) ((4 + (b) * 2 + (h)) * HTB)
#define PG8_STAGE(bufoff, gbase, voff) do { _Pragma("unroll") for (int _i = 0; _i < 2; ++_i) \
        __builtin_amdgcn_global_load_lds((const unsigned*)((const char*)(gbase) + (voff)[_i]), (LAS unsigned*)(lds + (bufoff) + ldsw + _i * 8192), 16, 0, 0); } while (0)
#define PG8_STAGE_A(bufoff, p, h, nx) do { if constexpr (GATHER) { PG8_STAGE(bufoff, p, vC[h]); } else PG8_STAGE(bufoff, (p) + (h) * hstep, voffA); } while (0)
#define PG8_LDA(dst, b, h) do { _Pragma("unroll") for (int m = 0; m < 4; ++m) _Pragma("unroll") for (int k = 0; k < 2; ++k) dst[m][k] = *(const LAS bf16x8*)(lds + PG8_SA(b, h) + aoff + m * 2048 + k * 1024); } while (0)
#define PG8_LDB(dst, b, h) do { _Pragma("unroll") for (int n = 0; n < 2; ++n) _Pragma("unroll") for (int k = 0; k < 2; ++k) dst[n][k] = *(const LAS bf16x8*)(lds + PG8_SB(b, h) + boff + n * 2048 + k * 1024); } while (0)
#define PG8_MMA(ai, bj, At, Bt) do { __builtin_amdgcn_s_setprio(1); \
        if constexpr (FP8) { _Pragma("unroll") for (int m = 0; m < 4; ++m) _Pragma("unroll") for (int n = 0; n < 2; ++n) \
            { const i32x8 b8_ = cat8(Bt[n][0], Bt[n][1]), a8_ = cat8(At[m][0], At[m][1]); asm volatile("v_mfma_f32_16x16x128_f8f6f4 %0, %1, %2, %0" : "+v"(acc[ai][bj][m][n]) : "v"(b8_), "v"(a8_)); } } \
        else { _Pragma("unroll") for (int m = 0; m < 4; ++m) _Pragma("unroll") for (int n = 0; n < 2; ++n) _Pragma("unroll") for (int k = 0; k < 2; ++k) \
            acc[ai][bj][m][n] = __builtin_amdgcn_mfma_f32_16x16x32_bf16(Bt[n][k], At[m][k], acc[ai][bj][m][n], 0, 0, 0); } \
        __builtin_amdgcn_s_setprio(0); } while (0)
#define PG8_WAIT_V(n) asm volatile("s_waitcnt vmcnt(" #n ")" ::: "memory")
#define PG8_WAIT_L(n) asm volatile("s_waitcnt lgkmcnt(" #n ")" ::: "memory")
#define PG8_BAR __builtin_amdgcn_s_barrier()
#define PG8_SCHED __builtin_amdgcn_sched_barrier(0)
#define PG8_UPTR(u, pa, pb) do { unsigned _e = g.texp ? ld_u32_agent(g.texp + (u).pm) : 0u; _e = (unsigned)__builtin_amdgcn_readfirstlane((int)_e); (u).e = (int)_e; \
        pa = GATHER ? (const char*)g.A : (const char*)g.A + (size_t)(u).pm * tstep; pb = (const char*)g.Bt + (size_t)_e * g.bstride + (size_t)(u).pn * tstep; } while (0)
    Unit cur, nxt; int ui = 0;
    if (!S.next(0, cur)) return;
    f32x4 acc[2][2][4][2];
#pragma unroll
    for (int a = 0; a < 2; ++a)
#pragma unroll
        for (int b = 0; b < 2; ++b)
#pragma unroll
            for (int m = 0; m < 4; ++m)
#pragma unroll
                for (int n = 0; n < 2; ++n) acc[a][b][m][n] = (f32x4){0.f, 0.f, 0.f, 0.f};
    bf16x8 At[4][2], B0[2][2], B1[2][2];
    const char* cA; const char* cB;
    PG8_UPTR(cur, cA, cB);
    if constexpr (GATHER) { PG8_GROWS(cur, vC); }
    if constexpr (SP2) {
        PG8_STAGE(PG8_SB(0, 0), cB, voffB); PG8_STAGE(PG8_SB(0, 1), cB + hstep, voffB); PG8_STAGE_A(PG8_SA(0, 0), cA, 0, false); PG8_STAGE_A(PG8_SA(0, 1), cA, 1, false);
        if (wr == 1) PG8_BAR;
        PG8_WAIT_V(2); PG8_BAR;
        PG8_STAGE(PG8_SB(1, 0), cB + kstep, voffB); PG8_STAGE_A(PG8_SA(1, 0), cA + kstep, 0, false); PG8_STAGE(PG8_SB(1, 1), cB + hstep + kstep, voffB);
        PG8_WAIT_V(6); PG8_BAR;
    } else {
        PG8_STAGE(PG8_SB(0, 0), cB, voffB); PG8_STAGE_A(PG8_SA(0, 0), cA, 0, false); PG8_STAGE(PG8_SB(0, 1), cB + hstep, voffB); PG8_STAGE_A(PG8_SA(0, 1), cA, 1, false);
        if (wr == 1) PG8_BAR;
        PG8_WAIT_V(4); PG8_BAR;
        PG8_STAGE(PG8_SB(1, 0), cB + kstep, voffB); PG8_STAGE_A(PG8_SA(1, 0), cA + kstep, 0, false); PG8_STAGE(PG8_SB(1, 1), cB + hstep + kstep, voffB);
        PG8_WAIT_V(6); PG8_BAR;
    }
    for (;;) {
        const bool has_next = S.next(ui + 1, nxt);
        const char* nA = cA; const char* nB = cB;
        if (has_next) PG8_UPTR(nxt, nA, nB);
#pragma unroll 1
        for (int t = 0; t < nt; t += 2) {
            const bool last = (t == nt - 2);
            const char* a1 = cA + (size_t)(t + 1) * kstep;
            const char* a2 = last ? nA : cA + (size_t)(t + 2) * kstep; const char* b2 = last ? nB : cB + (size_t)(t + 2) * kstep;
            const char* a3 = a2 + kstep; const char* b3 = b2 + kstep;
            if constexpr (SP2) {
            PG8_LDB(B0, 0, 0); PG8_LDB(B1, 0, 1); PG8_SCHED; PG8_LDA(At, 0, 0); PG8_STAGE_A(PG8_SA(1, 1), a1, 1, false);
            if constexpr (GATHER) { if (last && has_next) { PG8_GROWS(nxt, vC); } }
            PG8_WAIT_V(8); PG8_WAIT_L(0); PG8_BAR; PG8_MMA(0, 0, At, B0); PG8_MMA(0, 1, At, B1); PG8_BAR; PG8_SCHED;
            PG8_LDA(At, 0, 1); PG8_STAGE(PG8_SB(0, 0), b2, voffB); PG8_STAGE(PG8_SB(0, 1), b2 + hstep, voffB); PG8_STAGE_A(PG8_SA(0, 0), a2, 0, last);
            PG8_WAIT_V(8); PG8_WAIT_L(0); PG8_BAR; PG8_MMA(1, 0, At, B0); PG8_MMA(1, 1, At, B1); PG8_BAR; PG8_SCHED;
            PG8_LDB(B0, 1, 0); PG8_LDB(B1, 1, 1); PG8_SCHED; PG8_LDA(At, 1, 0); PG8_STAGE_A(PG8_SA(0, 1), a2, 1, last);
            PG8_WAIT_V(8); PG8_WAIT_L(0); PG8_BAR; PG8_MMA(0, 0, At, B0); PG8_MMA(0, 1, At, B1); PG8_BAR; PG8_SCHED;
            PG8_LDA(At, 1, 1); PG8_STAGE(PG8_SB(1, 0), b3, voffB); PG8_STAGE(PG8_SB(1, 1), b3 + hstep, voffB); PG8_STAGE_A(PG8_SA(1, 0), a3, 0, last);
            PG8_WAIT_V(8); PG8_WAIT_L(0); PG8_BAR; PG8_MMA(1, 0, At, B0); PG8_MMA(1, 1, At, B1); PG8_BAR; PG8_SCHED;
            } else {
            PG8_LDB(B0, 0, 0); PG8_SCHED; PG8_LDA(At, 0, 0); PG8_STAGE_A(PG8_SA(1, 1), a1, 1, false);
            if constexpr (GATHER) { if (last && has_next) { PG8_GROWS(nxt, vC); } }
            PG8_WAIT_L(8); PG8_BAR; PG8_WAIT_L(0); PG8_MMA(0, 0, At, B0); PG8_BAR; PG8_SCHED;
            PG8_LDB(B1, 0, 1); PG8_STAGE(PG8_SB(0, 0), b2, voffB);
            PG8_BAR; PG8_WAIT_L(0); PG8_MMA(0, 1, At, B1); PG8_BAR;
            PG8_LDA(At, 0, 1); PG8_STAGE_A(PG8_SA(0, 0), a2, 0, last);
            PG8_BAR; PG8_WAIT_L(0); PG8_MMA(1, 0, At, B0); PG8_BAR; PG8_SCHED;
            PG8_STAGE(PG8_SB(0, 1), b2 + hstep, voffB);
            PG8_WAIT_V(6); PG8_BAR; PG8_MMA(1, 1, At, B1); PG8_BAR;
            PG8_LDB(B0, 1, 0); PG8_SCHED; PG8_LDA(At, 1, 0); PG8_STAGE_A(PG8_SA(0, 1), a2, 1, last);
            PG8_WAIT_L(8); PG8_BAR; PG8_WAIT_L(0); PG8_MMA(0, 0, At, B0); PG8_BAR; PG8_SCHED;
            PG8_LDB(B1, 1, 1); PG8_STAGE(PG8_SB(1, 0), b3, voffB);
            PG8_BAR; PG8_WAIT_L(0); PG8_MMA(0, 1, At, B1); PG8_BAR;
            PG8_LDA(At, 1, 1); PG8_STAGE_A(PG8_SA(1, 0), a3, 0, last);
            PG8_BAR; PG8_WAIT_L(0); PG8_MMA(1, 0, At, B0); PG8_BAR; PG8_SCHED;
            PG8_STAGE(PG8_SB(1, 1), b3 + hstep, voffB);
            PG8_WAIT_V(6); PG8_BAR; PG8_MMA(1, 1, At, B1); PG8_BAR;
            }
        }
        if constexpr (ALIGN_EPI) { if (wr == 0) PG8_BAR; }
        if constexpr (FP8) { asm volatile("s_nop 15\n\ts_nop 15" ::: "memory"); PG8_SCHED; }
        E(acc, cur, wr, wc, fr, fq);
        if (!has_next) break;
#pragma unroll
        for (int a = 0; a < 2; ++a)
#pragma unroll
            for (int b = 0; b < 2; ++b)
#pragma unroll
                for (int m = 0; m < 4; ++m)
#pragma unroll
                    for (int n = 0; n < 2; ++n) acc[a][b][m][n] = (f32x4){0.f, 0.f, 0.f, 0.f};
        cur = nxt; cA = nA; cB = nB; ++ui;
        if constexpr (ALIGN_EPI) { if (wr == 1) PG8_BAR; }
    }
    PG8_WAIT_V(0);
    if constexpr (!ALIGN_EPI) { if (wr == 0) PG8_BAR; }
    PG8_BAR;
#undef PG8_SA
#undef PG8_SB
#undef PG8_STAGE
#undef PG8_LDA
#undef PG8_LDB
#undef PG8_MMA
#undef PG8_WAIT_V
#undef PG8_WAIT_L
#undef PG8_BAR
#undef PG8_SCHED
#undef PG8_UPTR
#undef PG8_STAGE_A
#undef PG8_GROWS
}

struct EpiProj {
    static constexpr bool PERM = true;
    bf16 *q, *k, *vT, *p;
    __device__ __forceinline__ void operator()(const f32x4 (&acc)[2][2][4][2], const Unit& u, int wr, int wc, int fr, int fq) const {
        const int row0 = u.pm * BM + wr * 64 + fr;
        const int pn = u.pn;
#pragma unroll
        for (int ai = 0; ai < 2; ++ai)
#pragma unroll
            for (int m = 0; m < 4; ++m) {
                const int row = row0 + ai * HALF + m * 16;
#pragma unroll
                for (int bj = 0; bj < 2; ++bj) {
                    f32x4 v0 = acc[ai][bj][m][0], v1 = acc[ai][bj][m][1];
                    const int col = pn * BM + bj * HALF + wc * 32 + 8 * fq;
                    if (pn >= 4 && pn < 6) {
                        const int cv = col - 1024, hh = cv >> 6, dim = cv & 63, b = row / T, t = row % T;
                        bf16* dst = vT + ((size_t)(((b * NH + hh) * GROWS + (t >> 6)) * HD + dim)) * 64 + (t & 63);
                        const unsigned w0 = cvt_pk_bf16(v0[0], v0[1]), w1 = cvt_pk_bf16(v0[2], v0[3]), w2 = cvt_pk_bf16(v1[0], v1[1]), w3 = cvt_pk_bf16(v1[2], v1[3]);
                        dst[0 * 64] = (bf16)(w0 & 0xffff); dst[1 * 64] = (bf16)(w0 >> 16); dst[2 * 64] = (bf16)(w1 & 0xffff); dst[3 * 64] = (bf16)(w1 >> 16);
                        dst[4 * 64] = (bf16)(w2 & 0xffff); dst[5 * 64] = (bf16)(w2 >> 16); dst[6 * 64] = (bf16)(w3 & 0xffff); dst[7 * 64] = (bf16)(w3 >> 16);
                        asm volatile("s_waitcnt vmcnt(40)" ::: "memory");
                    } else {
                        bf16* dst;
                        if (pn < 2) { v0 = v0 * 0.125f; v1 = v1 * 0.125f; dst = q + (size_t)row * CW + col; }
                        else if (pn < 4) dst = k + (size_t)row * CW + (col - 512);
                        else dst = p + (size_t)row * PW + (col - 1536);
                        u32x4 w; w.x = cvt_pk_bf16(v0[0], v0[1]); w.y = cvt_pk_bf16(v0[2], v0[3]); w.z = cvt_pk_bf16(v1[0], v1[1]); w.w = cvt_pk_bf16(v1[2], v1[3]);
                        *(u32x4*)dst = w;
                    }
                }
            }
    }
};
struct EpiWo {
    static constexpr bool PERM = true;
    const float* x; bf16* h;
    __device__ __forceinline__ void operator()(const f32x4 (&acc)[2][2][4][2], const Unit& u, int wr, int wc, int fr, int fq) const {
        const int row0 = u.pm * BM + wr * 64 + fr, col0 = u.pn * BM + wc * 32 + 8 * fq;
#pragma unroll
        for (int ai = 0; ai < 2; ++ai)
#pragma unroll
            for (int m = 0; m < 4; ++m) { const size_t off = (size_t)(row0 + ai * HALF + m * 16) * D + col0;
#pragma unroll
                for (int bj = 0; bj < 2; ++bj) { const f32x4 v0 = acc[ai][bj][m][0] + *(const f32x4*)(x + off + bj * HALF), v1 = acc[ai][bj][m][1] + *(const f32x4*)(x + off + bj * HALF + 4);
                    u32x4 w; w.x = cvt_pk_bf16(v0[0], v0[1]); w.y = cvt_pk_bf16(v0[2], v0[3]); w.z = cvt_pk_bf16(v1[0], v1[1]); w.w = cvt_pk_bf16(v1[2], v1[3]);
                    *(u32x4*)(h + off + bj * HALF) = w; } }
    }
};
struct EpiUp {
    static constexpr bool PERM = true;
    const float* b_up; unsigned char* act;
    __device__ __forceinline__ void operator()(const f32x4 (&acc)[2][2][4][2], const Unit& u, int wr, int wc, int fr, int fq) const {
        const int row0 = u.pm * BM + wr * 64 + fr, ch = u.pn * 128 + wc * 32 + 8 * fq;
        const float* bg = b_up + (size_t)u.e * 2048 + ch; const float* bl = bg + 1024;
        const f32x4 bg0 = *(const f32x4*)bg * F8_SACT, bg1 = *(const f32x4*)(bg + 4) * F8_SACT, bl0 = *(const f32x4*)bl, bl1 = *(const f32x4*)(bl + 4);
        constexpr float SG = F8_SACT / (F8_SX * F8_SW), SL = 1.0f / (F8_SX * F8_SW), KE = -1.702f * 1.44269504f / F8_SACT;
#pragma unroll
        for (int ai = 0; ai < 2; ++ai)
#pragma unroll
            for (int m = 0; m < 4; ++m) {
                float o[8];
#pragma unroll
                for (int n = 0; n < 2; ++n) { const f32x4 gv = acc[ai][0][m][n] * SG + (n ? bg1 : bg0), lv = acc[ai][1][m][n] * SL + (n ? bl1 : bl0);
#pragma unroll
                    for (int j = 0; j < 4; ++j) { const float gt = fminf(gv[j], 7.0f * F8_SACT), li = __builtin_amdgcn_fmed3f(lv[j], -7.0f, 7.0f);
                        const float t = gt * __builtin_amdgcn_rcpf(1.0f + __builtin_amdgcn_exp2f(gt * KE)); o[n * 4 + j] = __builtin_fmaf(li, t, t); } }
                int w0 = 0, w1 = 0;
                w0 = __builtin_amdgcn_cvt_pk_fp8_f32(o[0], o[1], w0, false); w0 = __builtin_amdgcn_cvt_pk_fp8_f32(o[2], o[3], w0, true);
                w1 = __builtin_amdgcn_cvt_pk_fp8_f32(o[4], o[5], w1, false); w1 = __builtin_amdgcn_cvt_pk_fp8_f32(o[6], o[7], w1, true);
                u32x2 w8; w8.x = (unsigned)w0; w8.y = (unsigned)w1;
                *(u32x2*)(act + (size_t)(row0 + ai * HALF + m * 16) * DE + ch) = w8;
            }
    }
};
struct EpiDown {
    static constexpr bool PERM = true;
    const float* b_dn; unsigned char* y;
    __device__ __forceinline__ void operator()(const f32x4 (&acc)[2][2][4][2], const Unit& u, int wr, int wc, int fr, int fq) const {
        const int row0 = u.pm * BM + wr * 64 + fr, col0 = u.pn * BM + wc * 32 + 8 * fq;
        const float* bb = b_dn + (size_t)u.e * D + col0;
        f32x4 bv[2][2];
#pragma unroll
        for (int bj = 0; bj < 2; ++bj)
#pragma unroll
            for (int n = 0; n < 2; ++n) bv[bj][n] = *(const f32x4*)(bb + bj * HALF + 4 * n) * F8_SY;
#pragma unroll
        for (int ai = 0; ai < 2; ++ai)
#pragma unroll
            for (int m = 0; m < 4; ++m) { unsigned char* rowp = y + (size_t)(row0 + ai * HALF + m * 16) * D + col0;
#pragma unroll
                for (int bj = 0; bj < 2; ++bj) { const f32x4 v0 = acc[ai][bj][m][0] * (F8_SY / (F8_SACT * F8_SW)) + bv[bj][0], v1 = acc[ai][bj][m][1] * (F8_SY / (F8_SACT * F8_SW)) + bv[bj][1];
                    u32x2 w; w.x = pk4_fp8(v0[0], v0[1], v0[2], v0[3]); w.y = pk4_fp8(v1[0], v1[1], v1[2], v1[3]);
                    *(u32x2*)(rowp + bj * HALF) = w; } }
    }
};
}


#define XB_TMO      128
#define XB_XCNT(j)  (256  + 64 * (j))
#define XB_XSUB(j)  (1280 + 64 * (j))
#define XB_XGEN(j)  (2304 + 64 * (j))
#define XB_TOP      3328
#define XB_TOPGEN   3392
#define XCD_BAR_WORDS 3456
#define XB_SPIN_CAP (1u << 20)
__device__ __forceinline__ unsigned xb_ld(unsigned* p)              { return __hip_atomic_load(p, __ATOMIC_RELAXED, __HIP_MEMORY_SCOPE_AGENT); }
__device__ __forceinline__ unsigned xb_add(unsigned* p, unsigned v) { return __hip_atomic_fetch_add(p, v, __ATOMIC_RELAXED, __HIP_MEMORY_SCOPE_AGENT); }
__device__ __forceinline__ unsigned xb_xcc_id() { return (unsigned)__builtin_amdgcn_s_getreg((3 << 11) | 20) & 0xFu; }
#define XB_SPIN(cond, bar) do { unsigned _sp = 0; while (cond) { __builtin_amdgcn_s_sleep(1); \
    if ((++_sp & 255u) == 0u) { if (xb_ld(&(bar)[XB_TMO])) break; if (_sp > XB_SPIN_CAP) { atomicAdd(&(bar)[XB_TMO], 1u); break; } } } } while (0)
struct XcdBarrier { unsigned* bar; unsigned x; volatile LAS unsigned* st; };
__device__ __forceinline__ XcdBarrier xcd_barrier_post(unsigned* bar, volatile LAS unsigned* st) {
    XcdBarrier b; b.bar = bar; b.x = xb_xcc_id(); b.st = st;
    if (threadIdx.x == 0) (void)xb_add(&bar[XB_XCNT(b.x)], 1u);
    return b;
}
__device__ __forceinline__ void xcd_barrier_complete(unsigned* bar, unsigned x, unsigned& nloc, unsigned& nx) {
    const unsigned G = gridDim.x * gridDim.y * gridDim.z;
    unsigned sum, cnt, mine, sp = 0u;
    for (;;) {
        sum = 0u; cnt = 0u; mine = 0u;
#pragma unroll
        for (unsigned j = 0; j < 16; ++j) { const unsigned c = xb_ld(&bar[XB_XCNT(j)]); sum += c; cnt += (c > 0u) ? 1u : 0u; mine = (j == x) ? c : mine; }
        if (sum == G) break;
        __builtin_amdgcn_s_sleep(1);
        if ((++sp & 255u) == 0u) { if (xb_ld(&bar[XB_TMO])) break; if (sp > XB_SPIN_CAP) { atomicAdd(&bar[XB_TMO], 1u); break; } }
    }
    nloc = mine > 0u ? mine : 1u; nx = cnt > 0u ? cnt : 1u;
}
__device__ __forceinline__ void xcd_barrier(const XcdBarrier& b) {
    asm volatile("s_waitcnt vmcnt(0)" ::: "memory");
    __syncthreads();
    if (threadIdx.x == 0) {
        unsigned* bar = b.bar;
        __builtin_amdgcn_s_waitcnt(0);
        unsigned nloc = b.st[0], nx = b.st[1];
        if (nloc == 0u) { xcd_barrier_complete(bar, b.x, nloc, nx); b.st[0] = nloc; b.st[1] = nx; }
        const unsigned old = xb_add(&bar[XB_XSUB(b.x)], 1u);
        const unsigned gen = old / nloc;
        if (old + 1u == (gen + 1u) * nloc) {
            __builtin_amdgcn_fence(__ATOMIC_RELEASE, "agent");
            asm volatile("s_waitcnt vmcnt(0)" ::: "memory");
            const unsigned og = xb_add(&bar[XB_TOP], 1u);
            const unsigned tg = og / nx;
            if (og + 1u == (tg + 1u) * nx) xb_add(&bar[XB_TOPGEN], 1u);
            else XB_SPIN(xb_ld(&bar[XB_TOPGEN]) == tg, bar);
            __builtin_amdgcn_fence(__ATOMIC_ACQUIRE, "agent");
            xb_add(&bar[XB_XGEN(b.x)], 1u);
            asm volatile("s_waitcnt vmcnt(0)" ::: "memory");
        } else {
            XB_SPIN(xb_ld(&bar[XB_XGEN(b.x)]) == gen, bar);
            __builtin_amdgcn_fence(__ATOMIC_ACQUIRE, "agent");
            asm volatile("s_waitcnt vmcnt(0)" ::: "memory");
        }
    }
    __syncthreads();
}

struct Args { const float* in[26]; float* out; unsigned char* ws; int ph_lo, ph_hi; };

struct Frame { LAS unsigned char* lds; int tid, lane, wave, G, vcu; };

__device__ __forceinline__ void transpose_item(const float* W, int K, int N, bf16* WT, int k0, int n0, int orow0, LAS float* scr, int lane) {
#pragma unroll 8
    for (int i = 0; i < 32; ++i) { const int kk = 2 * i + (lane >> 5); scr[kk * 33 + (lane & 31)] = W[(size_t)(k0 + kk) * N + n0 + (lane & 31)]; }
    asm volatile("s_waitcnt lgkmcnt(0)" ::: "memory");
    const int c = lane & 7;
#pragma unroll
    for (int j = 0; j < 4; ++j) { const int n = (lane >> 3) + 8 * j; const LAS float* s = scr + (8 * c) * 33 + n;
        u32x4 o; o.x = cvt_pk_bf16(s[0 * 33], s[1 * 33]); o.y = cvt_pk_bf16(s[2 * 33], s[3 * 33]); o.z = cvt_pk_bf16(s[4 * 33], s[5 * 33]); o.w = cvt_pk_bf16(s[6 * 33], s[7 * 33]);
        *(u32x4*)(WT + (size_t)(orow0 + n) * K + k0 + 8 * c) = o; }
    asm volatile("s_waitcnt lgkmcnt(0)" ::: "memory");
}

__device__ __forceinline__ void transpose_item8w(const float* W, int K, int N, unsigned char* WT, int k0, int n0, int orow0, LAS float* scr, int lane) {
#pragma unroll 8
    for (int i = 0; i < 64; ++i) { const int kk = 2 * i + (lane >> 5); scr[kk * 33 + (lane & 31)] = W[(size_t)(k0 + kk) * N + n0 + (lane & 31)]; }
    asm volatile("s_waitcnt lgkmcnt(0)" ::: "memory");
    const int c = lane & 7;
#pragma unroll
    for (int j = 0; j < 4; ++j) { const int n = (lane >> 3) + 8 * j; const LAS float* s = scr + (16 * c) * 33 + n;
        u32x4 o; o.x = pk4_fp8(s[0 * 33] * F8_SW, s[1 * 33] * F8_SW, s[2 * 33] * F8_SW, s[3 * 33] * F8_SW); o.y = pk4_fp8(s[4 * 33] * F8_SW, s[5 * 33] * F8_SW, s[6 * 33] * F8_SW, s[7 * 33] * F8_SW);
        o.z = pk4_fp8(s[8 * 33] * F8_SW, s[9 * 33] * F8_SW, s[10 * 33] * F8_SW, s[11 * 33] * F8_SW); o.w = pk4_fp8(s[12 * 33] * F8_SW, s[13 * 33] * F8_SW, s[14 * 33] * F8_SW, s[15 * 33] * F8_SW);
        *(u32x4*)(WT + (size_t)(orow0 + n) * K + k0 + 16 * c) = o; }
    asm volatile("s_waitcnt lgkmcnt(0)" ::: "memory");
}
__device__ __forceinline__ void transpose_item8(const float* W, int K, int N, unsigned char* WT, int k0, int n0, int orow0, LAS float* scr, int lane) {
#pragma unroll 8
    for (int i = 0; i < 32; ++i) { const int kk = 2 * i + (lane >> 5); scr[kk * 33 + (lane & 31)] = W[(size_t)(k0 + kk) * N + n0 + (lane & 31)]; }
    asm volatile("s_waitcnt lgkmcnt(0)" ::: "memory");
    const int c = lane & 7;
#pragma unroll
    for (int j = 0; j < 4; ++j) { const int n = (lane >> 3) + 8 * j; const LAS float* s = scr + (8 * c) * 33 + n;
        u32x2 o; o.x = pk4_fp8(s[0 * 33] * F8_SW, s[1 * 33] * F8_SW, s[2 * 33] * F8_SW, s[3 * 33] * F8_SW); o.y = pk4_fp8(s[4 * 33] * F8_SW, s[5 * 33] * F8_SW, s[6 * 33] * F8_SW, s[7 * 33] * F8_SW);
        *(u32x2*)(WT + (size_t)(orow0 + n) * K + k0 + 8 * c) = o; }
    asm volatile("s_waitcnt lgkmcnt(0)" ::: "memory");
}

__device__ __forceinline__ void p0_prologue(const Frame& F, const Args& a) {
    unsigned char* ws = a.ws;
    LAS float* scr = (LAS float*)(F.lds + F.wave * 8448);
    const int gw = F.vcu * 8 + F.wave, NGW = F.G * 8;
    constexpr int I_IN = 16 * 108, I_O = 16 * 32, I_L = 16, I_G = 32;
    constexpr int NITEMS = I_IN + I_O + 2 * I_L + 2 * I_L + I_G;
    for (int it = gw; it < NITEMS; it += NGW) {
        int r = it;
        if (r < I_IN) { const int kb = r / 108, nb = r % 108; transpose_item(a.in[2], 1024, NPROJ, (bf16*)(ws + WS_WINT), kb * 64, nb * 32, nb * 32, scr, F.lane); continue; }
        r -= I_IN;
        if (r < I_O) { const int kb = r / 32, nb = r % 32; transpose_item(a.in[17], 1024, 1024, (bf16*)(ws + WS_WOT), kb * 64, nb * 32, nb * 32, scr, F.lane); continue; }
        r -= I_O;
        if (r < 2 * I_L) { const int z = r / 16, nb = r % 16; transpose_item(a.in[8] + (size_t)z * 64 * 512, 64, 512, (bf16*)(ws + WS_W2T) + (size_t)z * 512 * 64, 0, nb * 32, nb * 32, scr, F.lane); continue; }
        r -= 2 * I_L;
        if (r < 2 * I_L) { const int z = r / 16, nb = r % 16; transpose_item(a.in[10] + (size_t)z * 64 * 512, 64, 512, (bf16*)(ws + WS_A2T) + (size_t)z * 512 * 64, 0, nb * 32, nb * 32, scr, F.lane); continue; }
        r -= 2 * I_L;
        { const int kb = r / 16, nb = r % 16; transpose_item(a.in[11], 128, 512, (bf16*)(ws + WS_G2T), kb * 64, nb * 32, nb * 32, scr, F.lane); }
    }
    { constexpr int I_UP = 32 * 8 * 64, I_DN = 32 * 8 * 32;
      LAS float* scrw = (LAS float*)(F.lds + F.wave * 16896);
      __syncthreads();
      for (int r = gw; r < I_UP + I_DN; r += NGW) {
        if (r < I_UP) {
            const int e = r / 512, q = r % 512, kb = q / 64, nb = q % 64, n0 = nb * 32;
            const int orow0 = n0 < 1024 ? 256 * (n0 >> 7) + (n0 & 127) : 256 * ((n0 - 1024) >> 7) + 128 + ((n0 - 1024) & 127);
            transpose_item8w(a.in[21] + (size_t)e * 1024 * 2048, 1024, 2048, ws + WS_WUPT + (size_t)e * 2048 * 1024, kb * 128, n0, orow0, scrw, F.lane); }
        else { const int r2 = r - I_UP, e = r2 / 256, q = r2 % 256, kb = q / 32, nb = q % 32;
            transpose_item8w(a.in[23] + (size_t)e * 1024 * 1024, 1024, 1024, ws + WS_WDNT + (size_t)e * 1024 * 1024, kb * 128, nb * 32, nb * 32, scrw, F.lane); } }
      __syncthreads(); }
    { u32x4* z = (u32x4*)(ws + WS_WINT + (size_t)NPROJ * 1024 * 2); const u32x4 zero = {0u, 0u, 0u, 0u};
      for (int i = F.vcu * 512 + F.tid; i < 16384; i += F.G * 512) z[i] = zero; }
    const float* x = a.in[0]; const float* nw = a.in[1]; bf16* hn = (bf16*)(ws + WS_HN);
    f32x4 wv[4];
#pragma unroll
    for (int j = 0; j < 4; ++j) wv[j] = *((const f32x4*)nw + F.lane + 64 * j);
    for (int m = gw; m < M; m += 2 * NGW) {
        const int m1 = m + NGW; const bool has1 = m1 < M;
        const f32x4* xr0 = (const f32x4*)(x + (size_t)m * D) + F.lane; const f32x4* xr1 = (const f32x4*)(x + (size_t)(has1 ? m1 : m) * D) + F.lane;
        f32x4 v0[4], v1[4]; float s0 = 0.f, s1 = 0.f;
#pragma unroll
        for (int j = 0; j < 4; ++j) { v0[j] = xr0[64 * j]; v1[j] = xr1[64 * j]; }
#pragma unroll
        for (int j = 0; j < 4; ++j) { s0 += (v0[j].x * v0[j].x + v0[j].y * v0[j].y) + (v0[j].z * v0[j].z + v0[j].w * v0[j].w); s1 += (v1[j].x * v1[j].x + v1[j].y * v1[j].y) + (v1[j].z * v1[j].z + v1[j].w * v1[j].w); }
        const float rs0 = rsqrtf(wave_sum(s0) * (1.f / D) + RMS_EPS), rs1 = rsqrtf(wave_sum(s1) * (1.f / D) + RMS_EPS);
        u32x2* o0 = (u32x2*)(hn + (size_t)m * D) + F.lane; u32x2* o1 = (u32x2*)(hn + (size_t)m1 * D) + F.lane;
#pragma unroll
        for (int j = 0; j < 4; ++j) { u32x2 o; o.x = cvt_pk_bf16(v0[j].x * rs0 * wv[j].x, v0[j].y * rs0 * wv[j].y); o.y = cvt_pk_bf16(v0[j].z * rs0 * wv[j].z, v0[j].w * rs0 * wv[j].w); o0[64 * j] = o; }
        if (has1) {
#pragma unroll
            for (int j = 0; j < 4; ++j) { u32x2 o; o.x = cvt_pk_bf16(v1[j].x * rs1 * wv[j].x, v1[j].y * rs1 * wv[j].y); o.y = cvt_pk_bf16(v1[j].z * rs1 * wv[j].z, v1[j].w * rs1 * wv[j].w); o1[64 * j] = o; } }
    }
}

constexpr int PREP_KBUF = 0, PREP_INV = 65536, PREP_AW = 67584, PREP_AA = PREP_AW + 17408, PREP_AG = PREP_AA + 17408, PREP_LD = 136;
template <bool STORE>
__device__ __forceinline__ void prep_phase(const Frame& F, const Args& a) {
    unsigned char* ws = a.ws;
    const bf16* p = (const bf16*)(ws + WS_P);
    bf16* r_out = (bf16*)(ws + WS_R); bf16* v_out = (bf16*)(ws + WS_V); bf16* kk_out = (bf16*)(ws + WS_KK);
    bf16* decay_out = (bf16*)(ws + WS_DECAY); bf16* kdir_out = (bf16*)(ws + WS_KDIR); bf16* akk_out = (bf16*)(ws + WS_AKK); bf16* g_out = (bf16*)(ws + WS_G);
    const bf16* w2T = (const bf16*)(ws + WS_W2T); const bf16* a2T = (const bf16*)(ws + WS_A2T); const bf16* g2T = (const bf16*)(ws + WS_G2T);
    const float* mu_p = a.in[5]; const float* mu_n = a.in[6]; const float* w0 = a.in[7]; const float* a0 = a.in[9];
    const float* k_k = a.in[12]; const float* k_a = a.in[13];
    LAS bf16* kbuf = (LAS bf16*)(F.lds + PREP_KBUF); LAS float* invb = (LAS float*)(F.lds + PREP_INV);
    LAS bf16* Aw = (LAS bf16*)(F.lds + PREP_AW); LAS bf16* Aa = (LAS bf16*)(F.lds + PREP_AA); LAS bf16* Ag = (LAS bf16*)(F.lds + PREP_AG);
    const int lane = F.lane, wave = F.wave, fr = lane & 15, fg = lane >> 4;
    for (int tile = F.vcu; tile < M / 64; tile += F.G) {
        const int m0 = tile * 64;
#pragma unroll 1
        for (int jj = 0; jj < 4; ++jj) {
            const int q = lane + 64 * jj; const bool valid = q < 240; const int c0 = 8 * q;
            float mp[8], mn[8];
#pragma unroll
            for (int i = 0; i < 8; ++i) { mp[i] = valid ? mu_p[c0 + i] : 0.f; mn[i] = valid ? mu_n[c0 + i] : 0.f; }
            const int mfirst = m0 + wave * 8;
            const u32x4 zero = {0u, 0u, 0u, 0u};
            u32x4 rows[10];
#pragma unroll
            for (int rI = 0; rI < 10; ++rI) { const int mr = mfirst - 1 + rI;
                const bool ok = valid && !(rI == 0 && (mfirst % T) == 0) && !(rI == 9 && ((mfirst + 7) % T) == T - 1);
                rows[rI] = ok ? *(const u32x4*)(p + (size_t)mr * PW + c0) : zero; }
#pragma unroll
            for (int i = 0; i < 8; ++i) {
                const int m = mfirst + i, it = wave * 8 + i;
                const u32x4 prev = rows[i], cur = rows[i + 1], nxt = rows[i + 2];
                float fp[8], fc[8], fn[8], s[8];
                unpack8(prev, fp); unpack8(cur, fc); unpack8(nxt, fn);
#pragma unroll
                for (int e = 0; e < 8; ++e) s[e] = fc[e] + mp[e] * (fp[e] - fc[e]) + mn[e] * (fn[e] - fc[e]);
                if (jj == 0) { if (STORE) { *(u32x4*)(r_out + (size_t)m * CW + c0) = pack8(s); } }
                else if (jj == 1) {
                    const int c = c0 - 512;
                    *(LAS u32x4*)(kbuf + it * 512 + c) = pack8(s);
                    float kr[8]; float ss = 0.f;
#pragma unroll
                    for (int e = 0; e < 8; ++e) { kr[e] = s[e] * k_k[c + e]; ss += kr[e] * kr[e]; }
                    ss += __shfl_xor(ss, 1); ss += __shfl_xor(ss, 2); ss += __shfl_xor(ss, 4);
                    const float inv = fminf(__builtin_amdgcn_rsqf(ss), 1e12f);
#pragma unroll
                    for (int e = 0; e < 8; ++e) kr[e] *= inv;
                    if (STORE) { *(u32x4*)(kk_out + (size_t)m * CW + c) = pack8(kr); }
                    if ((lane & 7) == 0) invb[it * 8 + (lane >> 3)] = inv;
                }
                else if (jj == 2) { if (STORE) { *(u32x4*)(v_out + (size_t)m * CW + (c0 - 1024)) = pack8(s); } }
                else if (valid) {
                    const int seg = lane >> 4, cw = 8 * (lane & 15);
                    if (seg == 0) {
#pragma unroll
                        for (int e = 0; e < 8; ++e) s[e] = 1.0f - 2.0f * __builtin_amdgcn_rcpf(__expf(2.0f * s[e]) + 1.0f);
                        *(LAS u32x4*)(Aw + it * PREP_LD + cw) = pack8(s);
                    } else if (seg == 1) { *(LAS u32x4*)(Aa + it * PREP_LD + cw) = pack8(s); }
                    else {
#pragma unroll
                        for (int e = 0; e < 8; ++e) s[e] = sigmoidf_(s[e]);
                        *(LAS u32x4*)(Ag + it * PREP_LD + cw) = pack8(s);
                    }
                }
            }
        }
        __syncthreads();
        const int nb = 64 * wave;
#define PREP_PROW(nt_) (nb + 32 * ((nt_) >> 1) + 8 * (fr >> 2) + 4 * ((nt_) & 1) + (fr & 3))
#define PREP_COL(nt_)  (nb + 32 * ((nt_) >> 1) + 8 * fg + 4 * ((nt_) & 1))
#pragma unroll 1
        for (int job = 0; job < 4; ++job) {
            const int z = job & 1;
            const bf16* WT = job < 2 ? w2T + (size_t)z * 512 * 64 : a2T + (size_t)z * 512 * 64;
            const LAS bf16* Ax = job < 2 ? Aw + z * 64 : Aa + z * 64;
            bf16x8 wf[2][4];
#pragma unroll
            for (int ks = 0; ks < 2; ++ks)
#pragma unroll
                for (int nt = 0; nt < 4; ++nt) wf[ks][nt] = *(const bf16x8*)(WT + (size_t)PREP_PROW(nt) * 64 + 32 * ks + 8 * fg);
            f32x4 pb[4], pkk[4], pka[4];
#pragma unroll
            for (int nt = 0; nt < 4; ++nt) { const int n = PREP_COL(nt);
                pb[nt] = *(const f32x4*)((job < 2 ? w0 : a0) + z * 512 + n); pkk[nt] = *(const f32x4*)(k_k + n); pka[nt] = *(const f32x4*)(k_a + n); }
            f32x4 acc[4][4];
#pragma unroll
            for (int mt = 0; mt < 4; ++mt)
#pragma unroll
                for (int nt = 0; nt < 4; ++nt) acc[mt][nt] = (f32x4){0.f, 0.f, 0.f, 0.f};
#pragma unroll
            for (int ks = 0; ks < 2; ++ks) {
                bf16x8 af[4];
#pragma unroll
                for (int mt = 0; mt < 4; ++mt) af[mt] = *(const LAS bf16x8*)(Ax + (16 * mt + fr) * PREP_LD + 32 * ks + 8 * fg);
#pragma unroll
                for (int mt = 0; mt < 4; ++mt)
#pragma unroll
                    for (int nt = 0; nt < 4; ++nt) acc[mt][nt] = __builtin_amdgcn_mfma_f32_16x16x32_bf16(wf[ks][nt], af[mt], acc[mt][nt], 0, 0, 0);
            }
#pragma unroll
            for (int mt = 0; mt < 4; ++mt) {
                const int it = 16 * mt + fr; const size_t m = (size_t)(m0 + it);
#pragma unroll
                for (int np = 0; np < 2; ++np) {
                    const int c8 = nb + 32 * np + 8 * fg;
                    if (job < 2) {
                        float o[8];
#pragma unroll
                        for (int hh = 0; hh < 2; ++hh) { const f32x4 v = acc[mt][2 * np + hh], bq = pb[2 * np + hh];
#pragma unroll
                            for (int i = 0; i < 4; ++i) o[4 * hh + i] = __expf(-0.60653066f * sigmoidf_(v[i] + bq[i])); }
                        if (STORE) { *(u32x4*)(decay_out + ((size_t)z * M + m) * CW + c8) = pack8(o); }
                    } else {
                        const u32x4 kb = *(const LAS u32x4*)(kbuf + it * 512 + c8);
                        float kv[8]; unpack8(kb, kv);
                        const float inv = invb[it * 8 + wave];
                        float kd[8], ak[8];
#pragma unroll
                        for (int hh = 0; hh < 2; ++hh) { const f32x4 v = acc[mt][2 * np + hh], bq = pb[2 * np + hh], kkc = pkk[2 * np + hh], kac = pka[2 * np + hh];
#pragma unroll
                            for (int i = 0; i < 4; ++i) { const float av = sigmoidf_(v[i] + bq[i]), kx = kv[4 * hh + i]; kd[4 * hh + i] = kx * (1.0f + (av - 1.0f) * kac[i]); ak[4 * hh + i] = av * (kx * kkc[i] * inv); } }
                        if (STORE) { *(u32x4*)(kdir_out + ((size_t)z * M + m) * CW + c8) = pack8(kd); *(u32x4*)(akk_out + ((size_t)z * M + m) * CW + c8) = pack8(ak); }
                    }
                }
            }
        }
        {
            bf16x8 wf[4][4];
#pragma unroll
            for (int ks = 0; ks < 4; ++ks)
#pragma unroll
                for (int nt = 0; nt < 4; ++nt) wf[ks][nt] = *(const bf16x8*)(g2T + (size_t)PREP_PROW(nt) * 128 + 32 * ks + 8 * fg);
            f32x4 acc[4][4];
#pragma unroll
            for (int mt = 0; mt < 4; ++mt)
#pragma unroll
                for (int nt = 0; nt < 4; ++nt) acc[mt][nt] = (f32x4){0.f, 0.f, 0.f, 0.f};
#pragma unroll
            for (int ks = 0; ks < 4; ++ks) {
                bf16x8 af[4];
#pragma unroll
                for (int mt = 0; mt < 4; ++mt) af[mt] = *(const LAS bf16x8*)(Ag + (16 * mt + fr) * PREP_LD + 32 * ks + 8 * fg);
#pragma unroll
                for (int mt = 0; mt < 4; ++mt)
#pragma unroll
                    for (int nt = 0; nt < 4; ++nt) acc[mt][nt] = __builtin_amdgcn_mfma_f32_16x16x32_bf16(wf[ks][nt], af[mt], acc[mt][nt], 0, 0, 0);
            }
#pragma unroll
            for (int mt = 0; mt < 4; ++mt) { const size_t m = (size_t)(m0 + 16 * mt + fr);
#pragma unroll
                for (int np = 0; np < 2; ++np) { const f32x4 v0 = acc[mt][2 * np], v1 = acc[mt][2 * np + 1];
                    u32x4 w; w.x = cvt_pk_bf16(v0[0], v0[1]); w.y = cvt_pk_bf16(v0[2], v0[3]); w.z = cvt_pk_bf16(v1[0], v1[1]); w.w = cvt_pk_bf16(v1[2], v1[3]);
                    if (STORE) { *(u32x4*)(g_out + m * CW + nb + 32 * np + 8 * fg) = w; } } }
        }
#undef PREP_PROW
#undef PREP_COL
        __syncthreads();
    }
}

__device__ __forceinline__ void attn_phase(const Frame& F, const Args& a, const int widx, const int nworkers) {
    unsigned char* ws = a.ws;
    const bf16* q = (const bf16*)(ws + WS_Q); const bf16* k = (const bf16*)(ws + WS_K); const bf16* vT = (const bf16*)(ws + WS_VT);
    bf16* att = (bf16*)(ws + WS_ATT);
    LAS float* bias = (LAS float*)F.lds + 16;
    for (int i = F.tid; i < 8 * 15 * 31; i += 512) bias[i] = a.in[3][i];
    __syncthreads();
    const int lane = F.lane, fr = lane & 15, fg = lane >> 4;
    const int per = (16384 + nworkers * 8 - 1) / (nworkers * 8);
    for (int it = 0; it < per; ++it) {
        const int task = widx * (8 * per) + it * 8 + F.wave; if (task >= 16384) break;
        const int cgp = task & 3, r = (task >> 2) & 127, h = (task >> 9) & 7, b = task >> 12;
        const int c0 = 16 * cgp, wsc = min(max(c0 - 8, 0), 32), rs = min(max(r - 4, 0), GROWS - 8);
        const int c = c0 + fr, cs = min(max(c - 8, 0), 48);
        const size_t tq = (size_t)b * T + r * 64 + c;
        bf16x8 qf[2];
#pragma unroll
        for (int ks = 0; ks < 2; ++ks) qf[ks] = *(const bf16x8*)(q + tq * CW + h * 64 + 32 * ks + 8 * fg);
        f32x4 sc[16];
        const int kcol_a = wsc + 8 * (fr >> 2) + (fr & 3);
        { bf16x8 kf[16][2];
#pragma unroll
          for (int t = 0; t < 16; ++t) { const int u = t >> 1, par = t & 1;
              const size_t tk = (size_t)b * T + (rs + u) * 64 + kcol_a + 4 * par;
              kf[t][0] = *(const bf16x8*)(k + tk * CW + h * 64 + 8 * fg); kf[t][1] = *(const bf16x8*)(k + tk * CW + h * 64 + 32 + 8 * fg); }
#pragma unroll
          for (int t = 0; t < 16; ++t) { f32x4 s = {0.f, 0.f, 0.f, 0.f};
              s = __builtin_amdgcn_mfma_f32_16x16x32_bf16(kf[t][0], qf[0], s, 0, 0, 0);
              s = __builtin_amdgcn_mfma_f32_16x16x32_bf16(kf[t][1], qf[1], s, 0, 0, 0);
              sc[t] = s; } }
        bool okm[8];
#pragma unroll
        for (int pi = 0; pi < 8; ++pi) { const int kc = wsc + 8 * fg + pi; okm[pi] = (kc >= cs) && (kc < cs + 16); }
        const LAS float* brow = bias + (h * 15 + (rs - r + 7)) * 31 + (wsc + 8 * fg - c + 15);
        float mx = -1e30f;
#pragma unroll
        for (int u = 0; u < 8; ++u)
#pragma unroll
            for (int pi = 0; pi < 8; ++pi) { const float s = okm[pi] ? sc[2 * u + (pi >> 2)][pi & 3] + brow[31 * u + pi] : -1e30f; sc[2 * u + (pi >> 2)][pi & 3] = s; mx = fmaxf(mx, s); }
        mx = fmaxf(mx, __shfl_xor(mx, 16)); mx = fmaxf(mx, __shfl_xor(mx, 32));
        float sum = 0.f;
        const float mxl = -mx * 1.44269504f;
#pragma unroll
        for (int t = 0; t < 16; ++t)
#pragma unroll
            for (int i = 0; i < 4; ++i) { const float pv = __builtin_amdgcn_exp2f(__builtin_fmaf(sc[t][i], 1.44269504f, mxl)); sc[t][i] = pv; sum += pv; }
        sum += __shfl_xor(sum, 16); sum += __shfl_xor(sum, 32);
        const float inv = 1.0f / sum;
        f32x4 o[4];
#pragma unroll
        for (int nt = 0; nt < 4; ++nt) o[nt] = (f32x4){0.f, 0.f, 0.f, 0.f};
        { bf16x8 vf[8][4];
#pragma unroll
          for (int u = 0; u < 8; ++u) { const bf16* vblk = vT + ((size_t)((b * NH + h) * GROWS + rs + u)) * (HD * 64) + wsc + 8 * fg;
#pragma unroll
              for (int nt = 0; nt < 4; ++nt) vf[u][nt] = *(const bf16x8*)(vblk + (16 * nt + fr) * 64); }
#pragma unroll
          for (int u = 0; u < 8; ++u) {
              union { u32x4 w; bf16x8 h8; } pf;
              pf.w.x = cvt_pk_bf16(sc[2 * u][0], sc[2 * u][1]); pf.w.y = cvt_pk_bf16(sc[2 * u][2], sc[2 * u][3]);
              pf.w.z = cvt_pk_bf16(sc[2 * u + 1][0], sc[2 * u + 1][1]); pf.w.w = cvt_pk_bf16(sc[2 * u + 1][2], sc[2 * u + 1][3]);
#pragma unroll
              for (int nt = 0; nt < 4; ++nt) o[nt] = __builtin_amdgcn_mfma_f32_16x16x32_bf16(vf[u][nt], pf.h8, o[nt], 0, 0, 0); } }
#pragma unroll
        for (int nt = 0; nt < 4; ++nt) { u32x2 w; w.x = cvt_pk_bf16(o[nt][0] * inv, o[nt][1] * inv); w.y = cvt_pk_bf16(o[nt][2] * inv, o[nt][3] * inv);
            *(u32x2*)(att + tq * CW + h * 64 + 16 * nt + 4 * fg) = w; }
    }
    __syncthreads();
}

__device__ __forceinline__ void side_phase(const Frame& F, const Args& a, const int widx, const int nworkers) {
    attn_phase(F, a, widx, nworkers);
}

__device__ __forceinline__ float row16_sum(float v) {
    v += __builtin_bit_cast(float, __builtin_amdgcn_update_dpp(0, __builtin_bit_cast(int, v), 0xB1, 0xF, 0xF, true));
    v += __builtin_bit_cast(float, __builtin_amdgcn_update_dpp(0, __builtin_bit_cast(int, v), 0x4E, 0xF, 0xF, true));
    v += __builtin_bit_cast(float, __builtin_amdgcn_update_dpp(0, __builtin_bit_cast(int, v), 0x141, 0xF, 0xF, true));
    v += __builtin_bit_cast(float, __builtin_amdgcn_update_dpp(0, __builtin_bit_cast(int, v), 0x140, 0xF, 0xF, true));
    return v;
}
constexpr int CS_R = 8;
constexpr int CS_NCH = 2, CS_NPR = 6;
constexpr int CS_AT = 0, CS_RT = 2304, CS_KHT = 4608, CS_BHT = 6656, CS_VT = 8704  , CS_TT = 10752, CS_AAK = 11264, CS_ARK = 11776, CS_ARB = 12288, CS_PL = 12800, CS_SLOT = 13056;
constexpr int CS_LD = 72;
constexpr int CS_SCR = CS_R * CS_SLOT  , CS_SCRW = 2304 * 2  , CS_FLAG = CS_SCR + CS_NPR * CS_SCRW  ;
__device__ __forceinline__ bf16 f2bf(float f) { return (bf16)cvt_pk_bf16(f, 0.f); }
struct ChainOps { u32x2 a4[4], r4[4], kh[4], bh[4], aak, ark, arb, tt, vb; f32x4 pl[4]; };
__device__ __forceinline__ void chain_load(const LAS unsigned char* sl, int fr, int fg, int c, ChainOps& o) {
    const int o16 = fr * 32 + fg * 8;
    const LAS unsigned char* pa = sl + CS_AT + fr * (CS_LD * 2) + fg * 8; const LAS unsigned char* pr = sl + CS_RT + fr * (CS_LD * 2) + fg * 8;
#pragma unroll
    for (int kq = 0; kq < 4; ++kq) { o.a4[kq] = *(const LAS u32x2*)(pa + 32 * kq); o.r4[kq] = *(const LAS u32x2*)(pr + 32 * kq); }
    o.aak = *(const LAS u32x2*)(sl + CS_AAK + o16); o.ark = *(const LAS u32x2*)(sl + CS_ARK + o16); o.arb = *(const LAS u32x2*)(sl + CS_ARB + o16); o.tt = *(const LAS u32x2*)(sl + CS_TT + o16);
    o.vb = *(const LAS u32x2*)(sl + CS_VT + c * 512 + o16);
#pragma unroll
    for (int mt = 0; mt < 4; ++mt) { o.pl[mt] = *(const LAS f32x4*)(sl + CS_PL + (16 * mt + 4 * fg) * 4);
        o.kh[mt] = *(const LAS u32x2*)(sl + CS_KHT + 512 * mt + o16); o.bh[mt] = *(const LAS u32x2*)(sl + CS_BHT + 512 * mt + o16); }
}
__device__ __forceinline__ f32x4 chain_compute(const ChainOps& o, f32x4 (&zacc)[4]) {
#define CS_M32(A_, B_, C_) __builtin_amdgcn_mfma_f32_16x16x32_bf16(A_, B_, C_, 0, 0, 0)
#define CS_M16(A_, B_, C_) __builtin_amdgcn_mfma_f32_16x16x16bf16_1k(__builtin_bit_cast(s16x4, A_), __builtin_bit_cast(s16x4, B_), C_, 0, 0, 0)
    union { u32x4 w; bf16x8 h8; } zb0, zb1, ap0, ap1, rp0, rp1;
    zb0.w.x = cvt_pk_bf16(zacc[0][0], zacc[0][1]); zb0.w.y = cvt_pk_bf16(zacc[0][2], zacc[0][3]); zb0.w.z = cvt_pk_bf16(zacc[1][0], zacc[1][1]); zb0.w.w = cvt_pk_bf16(zacc[1][2], zacc[1][3]);
    zb1.w.x = cvt_pk_bf16(zacc[2][0], zacc[2][1]); zb1.w.y = cvt_pk_bf16(zacc[2][2], zacc[2][3]); zb1.w.z = cvt_pk_bf16(zacc[3][0], zacc[3][1]); zb1.w.w = cvt_pk_bf16(zacc[3][2], zacc[3][3]);
    ap0.w = (u32x4){o.a4[0].x, o.a4[0].y, o.a4[1].x, o.a4[1].y}; ap1.w = (u32x4){o.a4[2].x, o.a4[2].y, o.a4[3].x, o.a4[3].y};
    rp0.w = (u32x4){o.r4[0].x, o.r4[0].y, o.r4[1].x, o.r4[1].y}; rp1.w = (u32x4){o.r4[2].x, o.r4[2].y, o.r4[3].x, o.r4[3].y};
    const f32x4 zero4 = {0.f, 0.f, 0.f, 0.f};
    f32x4 Wc = CS_M16(o.aak, o.vb, zero4);
    Wc = CS_M32(ap0.h8, zb0.h8, Wc); Wc = CS_M32(ap1.h8, zb1.h8, Wc);
    f32x4 Yc = CS_M16(o.ark, o.vb, zero4);
    Yc = CS_M32(rp0.h8, zb0.h8, Yc); Yc = CS_M32(rp1.h8, zb1.h8, Yc);
    f32x4 zz[4];
#pragma unroll
    for (int mt = 0; mt < 4; ++mt) zz[mt] = CS_M16(o.kh[mt], o.vb, zacc[mt] * o.pl[mt]);
    u32x2 wb, ub;
    wb.x = cvt_pk_bf16(Wc[0], Wc[1]); wb.y = cvt_pk_bf16(Wc[2], Wc[3]);
    const f32x4 Uc = CS_M16(o.tt, wb, zero4);
    ub.x = cvt_pk_bf16(Uc[0], Uc[1]); ub.y = cvt_pk_bf16(Uc[2], Uc[3]);
    Yc = CS_M16(o.arb, ub, Yc);
#pragma unroll
    for (int mt = 0; mt < 4; ++mt) zacc[mt] = CS_M16(o.bh[mt], ub, zz[mt]);
#undef CS_M32
#undef CS_M16
    return Yc;
}
template <int z>
__device__ __forceinline__ void scan_phase_z(const Frame& F, const Args& a, const int seq, const int half) {
    unsigned char* ws = a.ws;
    const int b = (seq >> 3) & 3, h = seq & 7;
    const size_t mb = (size_t)b * T;
    const int lane = F.lane, wave = F.wave, fr = lane & 15, fg = lane >> 4;
    constexpr int NCK = T / 16;
    volatile LAS unsigned* flg = (volatile LAS unsigned*)(F.lds + CS_FLAG);
    if (F.tid < 16) flg[F.tid] = 0u;
    __syncthreads();
    const int o16 = fr * 32 + fg * 8;
#define CS_M32(A_, B_, C_) __builtin_amdgcn_mfma_f32_16x16x32_bf16(A_, B_, C_, 0, 0, 0)
#define CS_M16(A_, B_, C_) __builtin_amdgcn_mfma_f32_16x16x16bf16_1k(__builtin_bit_cast(s16x4, A_), __builtin_bit_cast(s16x4, B_), C_, 0, 0, 0)
    if (wave < CS_NCH) {
        const int c = wave, rg = 2 * half + c;
        __builtin_amdgcn_s_setprio(3);
        bf16* yout = (bf16*)(ws + WS_Y) + (size_t)z * M * CW + h * 64 + rg * 16 + fr;
        f32x4 zacc[4];
#pragma unroll
        for (int mt = 0; mt < 4; ++mt) zacc[mt] = (f32x4){0.f, 0.f, 0.f, 0.f};
        ChainOps opA, opB;
#define CS_READY(nn) do { unsigned sp_ = 0; while (flg[(nn) & (CS_R - 1)] != (unsigned)((nn) + 1)) { __builtin_amdgcn_s_sleep(1); if (++sp_ > (1u << 24)) break; } __builtin_amdgcn_fence(__ATOMIC_ACQUIRE, "workgroup"); } while (0)
#define CS_HANDBACK(nn) do { asm volatile("s_waitcnt lgkmcnt(0)" ::: "memory"); if (lane == 0) flg[8 + c] = (unsigned)((nn) + 1); asm volatile("" ::: "memory"); } while (0)
#define CS_YSTORE(nn, Y_) do { asm volatile("s_waitcnt vmcnt(24)" ::: "memory");   _Pragma("unroll") for (int rr = 0; rr < 4; ++rr) { const int q_ = 16 * (nn) + 4 * fg + rr, t_ = z ? (T - 1 - q_) : q_; yout[(mb + t_) * CW] = f2bf((Y_)[rr]); } } while (0)
        CS_READY(0); chain_load(F.lds, fr, fg, c, opA);
#pragma unroll 1
        for (int n = 0; n < NCK; n += 2) {
            CS_READY(n + 1); CS_HANDBACK(n);
            chain_load(F.lds + ((n + 1) & (CS_R - 1)) * CS_SLOT, fr, fg, c, opB);
            { const f32x4 Yc = chain_compute(opA, zacc); CS_YSTORE(n, Yc); }
            if (n + 2 < NCK) CS_READY(n + 2);
            CS_HANDBACK(n + 1);
            if (n + 2 < NCK) chain_load(F.lds + ((n + 2) & (CS_R - 1)) * CS_SLOT, fr, fg, c, opA);
            { const f32x4 Yc = chain_compute(opB, zacc); CS_YSTORE(n + 1, Yc); }
        }
#undef CS_READY
#undef CS_HANDBACK
#undef CS_YSTORE
        __builtin_amdgcn_s_setprio(0);
    } else {
        const int pi = wave - CS_NCH;
        LAS unsigned char* scr = F.lds + CS_SCR + pi * CS_SCRW;
        LAS bf16* KT = (LAS bf16*)scr; LAS bf16* BT = (LAS bf16*)(scr + 2304);
        const bf16* gw_ = (const bf16*)(ws + WS_DECAY) + (size_t)z * M * CW + h * 64;
        const bf16* gkk = (const bf16*)(ws + WS_KK) + h * 64;
        const bf16* gak = (const bf16*)(ws + WS_AKK) + (size_t)z * M * CW + h * 64;
        const bf16* gk = (const bf16*)(ws + WS_KDIR) + (size_t)z * M * CW + h * 64;
        const bf16* gr = (const bf16*)(ws + WS_R) + h * 64;
        const bf16* gv = (const bf16*)(ws + WS_V) + h * 64 + half * 32 + (lane & 31);
        unsigned nw[16], nkk[16], nak[16], nk[16], nr[16], nv[8];
        constexpr long RSTEP = z ? -(long)CW : (long)CW;
#define CS_FETCH_A(nn) do { if ((nn) < NCK) { const size_t m0_ = (mb + (z ? (T - 1 - 16 * (nn)) : 16 * (nn))) * CW + lane; const bf16* pw_ = gw_ + m0_; const bf16* pkk_ = gkk + m0_; \
            _Pragma("unroll") for (int tt = 0; tt < 16; ++tt) { nw[tt] = pw_[tt * RSTEP]; nkk[tt] = pkk_[tt * RSTEP]; } } } while (0)
#define CS_FETCH_B(nn) do { if ((nn) < NCK) { asm volatile("s_waitcnt vmcnt(30)" ::: "memory"); const size_t m0_ = (mb + (z ? (T - 1 - 16 * (nn)) : 16 * (nn))) * CW + lane; const bf16* pak_ = gak + m0_; const bf16* pk_ = gk + m0_; \
            _Pragma("unroll") for (int tt = 0; tt < 16; ++tt) { nak[tt] = pak_[tt * RSTEP]; nk[tt] = pk_[tt * RSTEP]; } } } while (0)
#define CS_FETCH_C(nn) do { if ((nn) < NCK) { asm volatile("s_waitcnt vmcnt(30)" ::: "memory"); const size_t m0_ = (mb + (z ? (T - 1 - 16 * (nn)) : 16 * (nn))) * CW + lane; const bf16* pr_ = gr + m0_; \
            const bf16* pv_ = gv + (mb + (z ? (T - 1 - 16 * (nn) - 8 * (lane >> 5)) : 16 * (nn) + 8 * (lane >> 5))) * CW; \
            _Pragma("unroll") for (int tt = 0; tt < 16; ++tt) nr[tt] = pr_[tt * RSTEP]; \
            _Pragma("unroll") for (int i_ = 0; i_ < 8; ++i_) nv[i_] = pv_[i_ * RSTEP]; } } while (0)
        CS_FETCH_A(pi); CS_FETCH_B(pi); CS_FETCH_C(pi);
#pragma unroll 1
        for (int n = pi; n < NCK; n += CS_NPR) {
            const int slot = n & (CS_R - 1);
            float wv[16], kkv[16], akv[16], kv[16], rv[16]; unsigned vq[8];
#pragma unroll
            for (int tt = 0; tt < 16; ++tt) { unsigned x0 = nw[tt], x1 = nkk[tt], x2 = nak[tt], x3 = nk[tt], x4 = nr[tt];
                asm volatile("" : "+v"(x0), "+v"(x1), "+v"(x2), "+v"(x3), "+v"(x4));
                wv[tt] = __uint_as_float(x0 << 16); kkv[tt] = __uint_as_float(x1 << 16); akv[tt] = __uint_as_float(x2 << 16); kv[tt] = __uint_as_float(x3 << 16); rv[tt] = __uint_as_float(x4 << 16); }
#pragma unroll
            for (int tt = 0; tt < 8; ++tt) { unsigned x0 = nv[tt]; asm volatile("" : "+v"(x0)); vq[tt] = x0; }
            CS_FETCH_A(n + CS_NPR);
            { unsigned sp = 0; for (;;) { const u32x2 pg = *(const volatile LAS u32x2*)(flg + 8); const int mn = (int)min(pg.x, pg.y);
                  if (mn >= n - (CS_R - 3)) break; __builtin_amdgcn_s_sleep(2); if (++sp > (1u << 24)) break; } }
            __builtin_amdgcn_fence(__ATOMIC_ACQUIRE, "workgroup");
            LAS unsigned char* sl = F.lds + slot * CS_SLOT;
            float P[16];
            P[0] = wv[0];
#pragma unroll
            for (int tt = 1; tt < 16; ++tt) P[tt] = P[tt - 1] * wv[tt];
            const float PL = P[15];
            float khat[16], bhat[16];
#pragma unroll
            for (int tt = 0; tt < 16; ++tt) {
                const float pm1 = tt ? P[tt - 1] : 1.0f, inv = __builtin_amdgcn_rcpf(P[tt]);
                const float at = kkv[tt] * pm1, rt = rv[tt] * P[tt], kt = kv[tt] * inv, bt = -akv[tt] * inv;
                khat[tt] = kt * PL; bhat[tt] = bt * PL;
                { const unsigned w_ = cvt_pk_bf16(at, rt); *(LAS bf16*)(sl + CS_AT + (tt * CS_LD + lane) * 2) = (bf16)w_; *(LAS bf16*)(sl + CS_RT + (tt * CS_LD + lane) * 2) = (bf16)(w_ >> 16); }
                { const unsigned w_ = cvt_pk_bf16(kt, bt); KT[tt * CS_LD + lane] = (bf16)w_; BT[tt * CS_LD + lane] = (bf16)(w_ >> 16); }
            }
            CS_FETCH_B(n + CS_NPR);
            { u32x4 o0, o1;
              o0.x = cvt_pk_bf16(khat[0], khat[1]); o0.y = cvt_pk_bf16(khat[2], khat[3]); o0.z = cvt_pk_bf16(khat[4], khat[5]); o0.w = cvt_pk_bf16(khat[6], khat[7]);
              o1.x = cvt_pk_bf16(khat[8], khat[9]); o1.y = cvt_pk_bf16(khat[10], khat[11]); o1.z = cvt_pk_bf16(khat[12], khat[13]); o1.w = cvt_pk_bf16(khat[14], khat[15]);
              *(LAS u32x4*)(sl + CS_KHT + lane * 32) = o0; *(LAS u32x4*)(sl + CS_KHT + lane * 32 + 16) = o1;
              o0.x = cvt_pk_bf16(bhat[0], bhat[1]); o0.y = cvt_pk_bf16(bhat[2], bhat[3]); o0.z = cvt_pk_bf16(bhat[4], bhat[5]); o0.w = cvt_pk_bf16(bhat[6], bhat[7]);
              o1.x = cvt_pk_bf16(bhat[8], bhat[9]); o1.y = cvt_pk_bf16(bhat[10], bhat[11]); o1.z = cvt_pk_bf16(bhat[12], bhat[13]); o1.w = cvt_pk_bf16(bhat[14], bhat[15]);
              *(LAS u32x4*)(sl + CS_BHT + lane * 32) = o0; *(LAS u32x4*)(sl + CS_BHT + lane * 32 + 16) = o1; }
            *(LAS float*)(sl + CS_PL + lane * 4) = PL;
            { u32x4 o0;
              o0.x = vq[0] | (vq[1] << 16); o0.y = vq[2] | (vq[3] << 16); o0.z = vq[4] | (vq[5] << 16); o0.w = vq[6] | (vq[7] << 16);
              *(LAS u32x4*)(sl + CS_VT + (lane & 31) * 32 + (lane >> 5) * 16) = o0; }
            asm volatile("s_waitcnt lgkmcnt(0)" ::: "memory");
            bf16x8 af[2], rf[2], kf[2], bf_[2];
#pragma unroll
            for (int ks = 0; ks < 2; ++ks) { af[ks] = *(const LAS bf16x8*)(sl + CS_AT + (fr * CS_LD + 32 * ks + 8 * fg) * 2); rf[ks] = *(const LAS bf16x8*)(sl + CS_RT + (fr * CS_LD + 32 * ks + 8 * fg) * 2);
                kf[ks] = *(const LAS bf16x8*)(KT + fr * CS_LD + 32 * ks + 8 * fg); bf_[ks] = *(const LAS bf16x8*)(BT + fr * CS_LD + 32 * ks + 8 * fg); }
            const f32x4 zero4 = {0.f, 0.f, 0.f, 0.f};
            f32x4 Xc = zero4, Xt = zero4, AakT = zero4, ArbT = zero4, ArkT = zero4;
#pragma unroll
            for (int ks = 0; ks < 2; ++ks) { Xc = CS_M32(af[ks], bf_[ks], Xc); Xt = CS_M32(bf_[ks], af[ks], Xt);
                AakT = CS_M32(kf[ks], af[ks], AakT); ArbT = CS_M32(bf_[ks], rf[ks], ArbT); ArkT = CS_M32(kf[ks], rf[ks], ArkT); }
            CS_FETCH_C(n + CS_NPR);
            f32x4 S1;
#pragma unroll
            for (int rr = 0; rr < 4; ++rr) { const int q = 4 * fg + rr;
                Xc[rr] = (fr < q) ? Xc[rr] : 0.f; Xt[rr] = (q < fr) ? Xt[rr] : 0.f; S1[rr] = Xt[rr] + ((q == fr) ? 1.0f : 0.f);
                AakT[rr] = (q < fr) ? AakT[rr] : 0.f; ArkT[rr] = (q <= fr) ? ArkT[rr] : 0.f; ArbT[rr] = (q <= fr) ? ArbT[rr] : 0.f; }
            { u32x2 w; w.x = cvt_pk_bf16(AakT[0], AakT[1]); w.y = cvt_pk_bf16(AakT[2], AakT[3]); *(LAS u32x2*)(sl + CS_AAK + o16) = w;
              w.x = cvt_pk_bf16(ArkT[0], ArkT[1]); w.y = cvt_pk_bf16(ArkT[2], ArkT[3]); *(LAS u32x2*)(sl + CS_ARK + o16) = w;
              w.x = cvt_pk_bf16(ArbT[0], ArbT[1]); w.y = cvt_pk_bf16(ArbT[2], ArbT[3]); *(LAS u32x2*)(sl + CS_ARB + o16) = w; }
#define CS_PK(v) ((u32x2){cvt_pk_bf16((v)[0], (v)[1]), cvt_pk_bf16((v)[2], (v)[3])})
            const u32x2 xc = CS_PK(Xc), xt = CS_PK(Xt), s1 = CS_PK(S1);
            const f32x4 X2c = CS_M16(xt, xc, zero4), X2t = CS_M16(xc, xt, zero4);
            const u32x2 x2c = CS_PK(X2c), x2t = CS_PK(X2t);
            const f32x4 S2 = CS_M16(x2c, s1, S1);
            const f32x4 X4c = CS_M16(x2t, x2c, zero4), X4t = CS_M16(x2c, x2t, zero4);
            const u32x2 x4c = CS_PK(X4c), x4t = CS_PK(X4t), s2 = CS_PK(S2);
            const f32x4 S4 = CS_M16(x4c, s2, S2);
            const f32x4 X8c = CS_M16(x4t, x4c, zero4);
            const u32x2 x8c = CS_PK(X8c), s4 = CS_PK(S4);
            const f32x4 S8 = CS_M16(x8c, s4, S4);
            *(LAS u32x2*)(sl + CS_TT + o16) = CS_PK(S8);
#undef CS_PK
            asm volatile("s_waitcnt lgkmcnt(0)" ::: "memory");
            __builtin_amdgcn_fence(__ATOMIC_RELEASE, "workgroup");
            if (lane == 0) flg[slot] = (unsigned)(n + 1);
        }
#undef CS_FETCH_A
#undef CS_FETCH_B
#undef CS_FETCH_C
    }
#undef CS_M32
#undef CS_M16
    __syncthreads();
}

__device__ __forceinline__ void scan_phase(const Frame& F, const Args& a, const int idx) {
    const int seq = idx >> 1, half = idx & 1;
    if (seq >> 5) scan_phase_z<1>(F, a, seq, half); else scan_phase_z<0>(F, a, seq, half);
}

__device__ __forceinline__ void combine_phase(const Frame& F, const Args& a) {
    unsigned char* ws = a.ws;
    const bf16* att = (const bf16*)(ws + WS_ATT); const bf16* rr = (const bf16*)(ws + WS_R); const bf16* vv = (const bf16*)(ws + WS_V);
    const bf16* kd = (const bf16*)(ws + WS_KDIR); const bf16* gg = (const bf16*)(ws + WS_G); const bf16* y = (const bf16*)(ws + WS_Y);
    bf16* mix = (bf16*)(ws + WS_MIX);
    const float* anw = a.in[4]; const float* r_k = a.in[14]; const float* ln_w = a.in[15]; const float* ln_b = a.in[16];
    const int lane = F.lane, c0 = 8 * lane;
    float nw[8], rk[8], lw[8], lb[8];
#pragma unroll
    for (int i = 0; i < 8; ++i) { nw[i] = anw[c0 + i]; rk[i] = r_k[c0 + i]; lw[i] = ln_w[c0 + i]; lb[i] = ln_b[c0 + i]; }
    const int gw = F.vcu * 8 + F.wave, NGW = F.G * 8;
#pragma unroll 2
    for (int m = gw; m < M; m += NGW) {
        const size_t o = (size_t)m * CW + c0;
        float f[8];
        unpack8(*(const u32x4*)(att + o), f);
        float ss = 0.f;
#pragma unroll
        for (int i = 0; i < 8; ++i) ss += f[i] * f[i];
        const float rs = rsqrtf(wave_sum(ss) * (1.f / CW) + RMS_EPS);
#pragma unroll
        for (int i = 0; i < 8; ++i) f[i] = f[i] * rs * nw[i];
        *(u32x4*)(mix + (size_t)m * D + c0) = pack8(f);
        float yv[8], yw[8];
        unpack8(*(const u32x4*)(y + o), yv); unpack8(*(const u32x4*)(y + (size_t)M * CW + o), yw);
#pragma unroll
        for (int i = 0; i < 8; ++i) yv[i] += yw[i];
        float s1 = 0.f;
#pragma unroll
        for (int i = 0; i < 8; ++i) s1 += yv[i];
        s1 += __shfl_xor(s1, 1); s1 += __shfl_xor(s1, 2); s1 += __shfl_xor(s1, 4);
        const float mean = s1 * (1.f / 64.f);
        float s2 = 0.f;
#pragma unroll
        for (int i = 0; i < 8; ++i) { yv[i] -= mean; s2 += yv[i] * yv[i]; }
        s2 += __shfl_xor(s2, 1); s2 += __shfl_xor(s2, 2); s2 += __shfl_xor(s2, 4);
        const float rstd = rsqrtf(s2 * (1.f / 64.f) + GN_EPS);
        float rf[8], k0[8], k1[8], vf[8], gf[8];
        unpack8(*(const u32x4*)(rr + o), rf); unpack8(*(const u32x4*)(kd + o), k0); unpack8(*(const u32x4*)(kd + (size_t)M * CW + o), k1);
        unpack8(*(const u32x4*)(vv + o), vf); unpack8(*(const u32x4*)(gg + o), gf);
        float cf = 0.f;
#pragma unroll
        for (int i = 0; i < 8; ++i) cf += rf[i] * (k0[i] + k1[i]) * rk[i];
        cf += __shfl_xor(cf, 1); cf += __shfl_xor(cf, 2); cf += __shfl_xor(cf, 4);
#pragma unroll
        for (int i = 0; i < 8; ++i) f[i] = (yv[i] * rstd * lw[i] + lb[i] + cf * vf[i]) * gf[i];
        *(u32x4*)(mix + (size_t)m * D + CW + c0) = pack8(f);
    }
}

constexpr int RT_PITCH = 1032, RT_WH = 0, RT_WL = 32 * RT_PITCH * 2, RT_HIST = 2 * RT_WL, RT_EL = RT_HIST + 256;
__device__ __forceinline__ void router_phase(const Frame& F, const Args& a) {
    unsigned char* ws = a.ws;
    const bf16* hbuf = (const bf16*)(ws + WS_H); unsigned char* hn2 = ws + WS_HN2;
    int* eidx = (int*)(ws + WS_EIDX); float* gate = (float*)(ws + WS_GATE); int* rank = (int*)(ws + WS_RANK);
    unsigned* ctl = (unsigned*)(ws + WS_CTL);
    const float* n2w = a.in[18]; const float* rw = a.in[19]; const float* rb = a.in[20];
    LAS bf16* wh = (LAS bf16*)(F.lds + RT_WH); LAS bf16* wl = (LAS bf16*)(F.lds + RT_WL); LAS int* hist = (LAS int*)(F.lds + RT_HIST); LAS int* eL = (LAS int*)(F.lds + RT_EL);
    { f32x4 tmp[16];
#pragma unroll
      for (int j = 0; j < 16; ++j) tmp[j] = *((const f32x4*)rw + F.tid + 512 * j);
#pragma unroll
      for (int j = 0; j < 16; ++j) { const int q = F.tid + 512 * j, d = q >> 3, e0 = 4 * (q & 7);
#pragma unroll
          for (int i = 0; i < 4; ++i) { const float w = tmp[j][i]; const unsigned hb = cvt_pk_bf16(w, 0.f) & 0xffffu; const float lo = w - __uint_as_float(hb << 16);
              wh[(e0 + i) * RT_PITCH + d] = (bf16)hb; wl[(e0 + i) * RT_PITCH + d] = (bf16)cvt_pk_bf16(lo, 0.f); } } }
    if (F.tid < 32) hist[F.tid] = 0;
    __syncthreads();
    const int lane = F.lane, tk = lane & 15, g = lane >> 4;
    const int blk = F.vcu;
    const int m = blk * 128 + F.wave * 16 + tk;
    const bf16* hrow = hbuf + (size_t)m * D + 8 * g;
    float ss = 0.f;
#pragma unroll 8
    for (int ks = 0; ks < 32; ++ks) { float xf[8]; unpack8(*(const u32x4*)(hrow + 32 * ks), xf);
        ss += (xf[0] * xf[0] + xf[1] * xf[1]) + (xf[2] * xf[2] + xf[3] * xf[3]) + (xf[4] * xf[4] + xf[5] * xf[5]) + (xf[6] * xf[6] + xf[7] * xf[7]); }
    ss += __shfl_xor(ss, 16); ss += __shfl_xor(ss, 32);
    const float rs = rsqrtf(ss * (1.f / D) + RMS_EPS);
    f32x4 acc0 = {0.f, 0.f, 0.f, 0.f}, acc1 = acc0;
    unsigned char* hrow8 = hn2 + (size_t)m * D + 8 * g;
    const LAS bf16* wh0 = wh + tk * RT_PITCH + 8 * g; const LAS bf16* wl0 = wl + tk * RT_PITCH + 8 * g;
#pragma unroll 4
    for (int ks = 0; ks < 32; ++ks) {
        float xf[8]; unpack8(*(const u32x4*)(hrow + 32 * ks), xf);
        const f32x4 x0 = {xf[0], xf[1], xf[2], xf[3]}, x1 = {xf[4], xf[5], xf[6], xf[7]};
        const f32x4 n0 = *(const f32x4*)(n2w + 32 * ks + 8 * g), n1 = *(const f32x4*)(n2w + 32 * ks + 8 * g + 4);
        const f32x4 y0 = x0 * rs * n0, y1 = x1 * rs * n1;
        { u32x2 w8; w8.x = pk4_fp8(y0.x * F8_SX, y0.y * F8_SX, y0.z * F8_SX, y0.w * F8_SX); w8.y = pk4_fp8(y1.x * F8_SX, y1.y * F8_SX, y1.z * F8_SX, y1.w * F8_SX); *(u32x2*)(hrow8 + 32 * ks) = w8; }
        union { u32x4 w; bf16x8 h8; } xh, xl;
        xh.w.x = cvt_pk_bf16(y0.x, y0.y); xh.w.y = cvt_pk_bf16(y0.z, y0.w); xh.w.z = cvt_pk_bf16(y1.x, y1.y); xh.w.w = cvt_pk_bf16(y1.z, y1.w);
        xl.w.x = cvt_pk_bf16(y0.x - bflo(xh.w.x), y0.y - bfhi(xh.w.x)); xl.w.y = cvt_pk_bf16(y0.z - bflo(xh.w.y), y0.w - bfhi(xh.w.y));
        xl.w.z = cvt_pk_bf16(y1.x - bflo(xh.w.z), y1.y - bfhi(xh.w.z)); xl.w.w = cvt_pk_bf16(y1.z - bflo(xh.w.w), y1.w - bfhi(xh.w.w));
        const bf16x8 a0h = *(const LAS bf16x8*)(wh0 + 32 * ks), a1h = *(const LAS bf16x8*)(wh0 + 16 * RT_PITCH + 32 * ks);
        const bf16x8 a0l = *(const LAS bf16x8*)(wl0 + 32 * ks), a1l = *(const LAS bf16x8*)(wl0 + 16 * RT_PITCH + 32 * ks);
        acc0 = __builtin_amdgcn_mfma_f32_16x16x32_bf16(a0h, xh.h8, acc0, 0, 0, 0); acc1 = __builtin_amdgcn_mfma_f32_16x16x32_bf16(a1h, xh.h8, acc1, 0, 0, 0);
        acc0 = __builtin_amdgcn_mfma_f32_16x16x32_bf16(a0h, xl.h8, acc0, 0, 0, 0); acc1 = __builtin_amdgcn_mfma_f32_16x16x32_bf16(a1h, xl.h8, acc1, 0, 0, 0);
        acc0 = __builtin_amdgcn_mfma_f32_16x16x32_bf16(a0l, xh.h8, acc0, 0, 0, 0); acc1 = __builtin_amdgcn_mfma_f32_16x16x32_bf16(a1l, xh.h8, acc1, 0, 0, 0);
    }
    float lv[8]; int li[8];
    { const f32x4 b0 = *(const f32x4*)(rb + 4 * g), b1 = *(const f32x4*)(rb + 16 + 4 * g);
#pragma unroll
      for (int i = 0; i < 4; ++i) { lv[i] = acc0[i] + b0[i]; li[i] = 4 * g + i; lv[4 + i] = acc1[i] + b1[i]; li[4 + i] = 16 + 4 * g + i; } }
    float tv[4]; int ti[4];
#pragma unroll
    for (int kx = 0; kx < 4; ++kx) {
        float bv = lv[0]; int bi = li[0];
#pragma unroll
        for (int i = 1; i < 8; ++i) { const bool gt = lv[i] > bv; bv = gt ? lv[i] : bv; bi = gt ? li[i] : bi; }
#pragma unroll
        for (int o = 16; o < 64; o <<= 1) { const float ov = __shfl_xor(bv, o); const int oi = __shfl_xor(bi, o); const bool tko = (ov > bv) || (ov == bv && oi < bi); bv = tko ? ov : bv; bi = tko ? oi : bi; }
        tv[kx] = bv; ti[kx] = bi;
#pragma unroll
        for (int i = 0; i < 8; ++i) lv[i] = (li[i] == bi) ? -3.0e38f : lv[i];
    }
    if (g == 0) {
        const float e0 = 1.0f, e1 = __expf(tv[1] - tv[0]), e2 = __expf(tv[2] - tv[0]), e3 = __expf(tv[3] - tv[0]);
        const float is = 1.0f / (e0 + e1 + e2 + e3);
        const float gs[4] = {e0 * is, e1 * is, e2 * is, e3 * is};
#pragma unroll
        for (int kx = 0; kx < 4; ++kx) { eidx[m * 4 + kx] = ti[kx]; gate[m * 4 + kx] = gs[kx]; eL[(m - blk * 128) * 4 + kx] = ti[kx]; }
    }
    __syncthreads();
    { const int t = F.tid, e = eL[t]; int rk = 0;
      for (int u = 0; u < t; ++u) rk += (eL[u] == e) ? 1 : 0;
      rank[(blk * 128) * 4 + t] = rk;
      __hip_atomic_fetch_add(&hist[e], 1, __ATOMIC_RELAXED, __HIP_MEMORY_SCOPE_WORKGROUP); }
    __syncthreads();
    if (F.tid < 32) ctl[CW_CNT + blk * 32 + F.tid] = (unsigned)hist[F.tid];
}

__device__ __forceinline__ void dispatch_phase(const Frame& F, const Args& a) {
    unsigned char* ws = a.ws;
    unsigned* ctl = (unsigned*)(ws + WS_CTL);
    const int* eidx = (const int*)(ws + WS_EIDX); const int* rank = (const int*)(ws + WS_RANK); int* dest = (int*)(ws + WS_DEST);
    LAS int* part = (LAS int*)F.lds;
    LAS int* tot = part + 1024;
    const int blk = F.vcu, G = F.G;
    { const int e = F.tid & 31, pt = F.tid >> 5; int s = 0, sb = 0;
      if (G == 256) { int cv[16];
#pragma unroll
          for (int q = 0; q < 16; ++q) cv[q] = (int)ld_u32_agent(ctl + CW_CNT + (pt + 16 * q) * 32 + e);
#pragma unroll
          for (int q = 0; q < 16; ++q) { s += cv[q]; if (pt + 16 * q < blk) sb += cv[q]; } }
      else for (int bb = pt; bb < G; bb += 16) { const int cval = (int)ld_u32_agent(ctl + CW_CNT + bb * 32 + e); s += cval; if (bb < blk) sb += cval; }
      part[pt * 32 + e] = s; part[512 + pt * 32 + e] = sb; }
    __syncthreads();
    if (F.tid < 32) { int s = 0, sb = 0;
        for (int pt = 0; pt < 16; ++pt) { s += part[pt * 32 + F.tid]; sb += part[512 + pt * 32 + F.tid]; }
        tot[F.tid] = s; tot[32 + F.tid] = sb; tot[96 + F.tid] = (s + 255) & ~255; }
    __syncthreads();
    if (F.tid == 0) { int ps = 0; for (int e = 0; e < 32; ++e) { tot[64 + e] = ps; ps += tot[96 + e]; }
        tot[128] = ps >> 8; }
    __syncthreads();
    if (blk == 0) {
        if (F.tid == 0) ctl[CW_NT] = (unsigned)tot[128];
        for (int e = F.tid >> 4; e < 32; e += 32) { const int t0 = tot[64 + e] >> 8, nt = tot[96 + e] >> 8; for (int i = F.tid & 15; i < nt; i += 16) ctl[CW_TEXP + t0 + i] = (unsigned)e; }
    }
    const int lane = F.lane;
    const int mw = blk * 128 + F.wave * 16;
    int* rowtok = (int*)(ws + WS_ROWTOK);
    { const int e = eidx[mw * 4 + lane]; const int dl = tot[64 + e] + tot[32 + e] + rank[mw * 4 + lane]; dest[mw * 4 + lane] = dl; rowtok[dl] = mw + (lane >> 2); }
    { const int e = blk & 31, pt = blk >> 5, np = G >> 5; const int r0 = tot[64 + e] + tot[e], r1 = tot[64 + e] + tot[96 + e];
      if (np > 0) for (int r = r0 + pt * 512 + F.tid; r < r1; r += np * 512) rowtok[r] = 0; }
}

__device__ __forceinline__ void final_phase(const Frame& F, const Args& a) {
    unsigned char* ws = a.ws;
    const bf16* hbuf = (const bf16*)(ws + WS_H); const unsigned char* ybuf = ws + WS_YBUF;
    const int* dest = (const int*)(ws + WS_DEST); const float* gate = (const float*)(ws + WS_GATE);
    const float* fw = a.in[25]; float* out = a.out;
    const int lane = F.lane;
    f32x4 wn[4];
#pragma unroll
    for (int j = 0; j < 4; ++j) wn[j] = *((const f32x4*)fw + lane + 64 * j);
    const int gw = F.vcu * 8 + F.wave, NGW = F.G * 8;
    const int per = M / NGW;
    const int mw = gw * per;
    int dl = 0; float gl = 0.f;
    if (lane < 4 * per && per <= 16) { dl = dest[mw * 4 + lane]; gl = gate[mw * 4 + lane]; }
#pragma unroll 2
    for (int i = 0; i < per; ++i) {
        const int m = mw + i;
        const u32x2* hr = (const u32x2*)(hbuf + (size_t)m * D) + lane;
        f32x4 v[4];
#pragma unroll
        for (int j = 0; j < 4; ++j) { const u32x2 w = hr[64 * j]; v[j] = (f32x4){bflo(w.x), bfhi(w.x), bflo(w.y), bfhi(w.y)}; }
#pragma unroll
        for (int kx = 0; kx < 4; ++kx) {
            const int d = per <= 16 ? __shfl(dl, 4 * i + kx) : dest[m * 4 + kx]; const float gt = (per <= 16 ? __shfl(gl, 4 * i + kx) : gate[m * 4 + kx]) * (1.0f / F8_SY);
            const unsigned* yr = (const unsigned*)(ybuf + (size_t)d * D) + lane;
#pragma unroll
            for (int j = 0; j < 4; ++j) { const unsigned w = yr[64 * j]; const f32x2 lo = __builtin_amdgcn_cvt_pk_f32_fp8((int)w, false), hi = __builtin_amdgcn_cvt_pk_f32_fp8((int)w, true);
                v[j].x += gt * lo.x; v[j].y += gt * lo.y; v[j].z += gt * hi.x; v[j].w += gt * hi.y; }
        }
        float s = 0.f;
#pragma unroll
        for (int j = 0; j < 4; ++j) s += (v[j].x * v[j].x + v[j].y * v[j].y) + (v[j].z * v[j].z + v[j].w * v[j].w);
        const float rs = rsqrtf(wave_sum(s) * (1.f / D) + RMS_EPS);
        f32x4* orow = (f32x4*)(out + (size_t)m * D) + lane;
#pragma unroll
        for (int j = 0; j < 4; ++j) orow[64 * j] = v[j] * rs * wn[j];
    }
}

__global__ void __launch_bounds__(512, 2) fwd_megakernel(Args args) {
    extern __shared__ __attribute__((aligned(16))) unsigned char lds_raw[];
    Frame F;
    F.lds = (LAS unsigned char*)lds_raw;
    F.tid = threadIdx.x; F.lane = F.tid & 63; F.wave = __builtin_amdgcn_readfirstlane(F.tid >> 6);
    F.G = gridDim.x; { const int bx = blockIdx.x; F.vcu = (F.G % 8 == 0) ? (bx % 8) * (F.G / 8) + bx / 8 : bx; }
    unsigned char* ws = args.ws;
    const int lo = args.ph_lo, hi = args.ph_hi;
#define IN(k) (lo <= (k) && (k) < hi)
#if MK_SPLIT
#define SEAM(k) do { } while (0)
#else
    cg::grid_group grid = cg::this_grid();
    { volatile LAS unsigned* st = (volatile LAS unsigned*)(F.lds + LDS_MISC); if (F.tid < 2) st[F.tid] = 0u; __syncthreads(); }
    const XcdBarrier xbar = xcd_barrier_post((unsigned*)(ws + WS_CTL) + CW_BAR, (volatile LAS unsigned*)(F.lds + LDS_MISC));
    if (lo < 0) grid.sync();
#define SEAM(k) do { if (IN(k) && IN((k) + 1)) xcd_barrier(xbar); } while (0)
#endif
#define REP2(k) if constexpr (((MK_REPEAT >> (k)) & 1) != 0)
#define PH1 { pg8::Gemm g{(const bf16*)(ws + WS_HN), (const bf16*)(ws + WS_WINT), 1024, nullptr, 0, nullptr}; \
        pg8::StaticOrder S; S.init(M / 256, NPROJ_PAD / 256, F.G, (int)blockIdx.x); \
        pg8::EpiProj E{(bf16*)(ws + WS_Q), (bf16*)(ws + WS_K), (bf16*)(ws + WS_VT), (bf16*)(ws + WS_P)}; \
        pg8::gemm_phase<pg8::EpiProj, true, true>(F.lds, g, S, E); }
#define PH5 { pg8::Gemm g{(const bf16*)(ws + WS_MIX), (const bf16*)(ws + WS_WOT), 1024, nullptr, 0, nullptr}; \
        pg8::StaticOrder S; S.init(M / 256, D / 256, F.G, (int)blockIdx.x); \
        pg8::EpiWo E{args.in[0], (bf16*)(ws + WS_H)}; \
        pg8::gemm_phase<pg8::EpiWo, true, true>(F.lds, g, S, E); }
#define PH8 { const unsigned* ctl = (const unsigned*)(ws + WS_CTL); const int ntile = (int)ld_u32_agent(ctl + CW_NT); \
        pg8::Gemm g{(const bf16*)(ws + WS_HN2), (const bf16*)(ws + WS_WUPT), 512, ctl + CW_TEXP, (size_t)2048 * 1024, (const int*)(ws + WS_ROWTOK)}; \
        pg8::StaticOrder S; S.init(ntile, 8, F.G, (int)blockIdx.x); \
        pg8::EpiUp E{args.in[22], ws + WS_ACT}; \
        pg8::gemm_phase<pg8::EpiUp, true, true, true, true>(F.lds, g, S, E); }
#define PH9 { const unsigned* ctl = (const unsigned*)(ws + WS_CTL); const int ntile = (int)ld_u32_agent(ctl + CW_NT); \
        pg8::Gemm g{(const bf16*)(ws + WS_ACT), (const bf16*)(ws + WS_WDNT), 512, ctl + CW_TEXP, (size_t)1024 * 1024, nullptr}; \
        pg8::StaticOrder S; S.init(ntile, 4, F.G, (int)blockIdx.x); \
        pg8::EpiDown E{args.in[24], ws + WS_YBUF}; \
        pg8::gemm_phase<pg8::EpiDown, true, true, false, true>(F.lds, g, S, E); }
    if (IN(0)) { p0_prologue(F, args); REP2(0) p0_prologue(F, args); }
    SEAM(0);
    if (IN(1)) { PH1 REP2(1) PH1 }
    SEAM(1);
    if (IN(2)) { prep_phase<true>(F, args); REP2(2) prep_phase<true>(F, args); }
    SEAM(2);
    if (IN(3)) {
        if ((F.vcu & 1) == 0 && (F.vcu >> 1) < 128) { scan_phase(F, args, F.vcu >> 1); REP2(3) scan_phase(F, args, F.vcu >> 1); }
        else { const int nside = F.G - min((F.G + 1) / 2, 128); const int q_ = min((F.vcu + 1) >> 1, 128); side_phase(F, args, F.vcu - q_, nside); REP2(11) side_phase(F, args, F.vcu - q_, nside); }
    }
    SEAM(3);
    if (IN(4)) { combine_phase(F, args); REP2(4) combine_phase(F, args); }
    SEAM(4);
    if (IN(5)) { PH5 REP2(5) PH5 }
    SEAM(5);
    if (IN(6)) { router_phase(F, args); REP2(6) { __syncthreads(); router_phase(F, args); } }
    SEAM(6);
    if (IN(7)) { dispatch_phase(F, args); REP2(7) { __syncthreads(); dispatch_phase(F, args); } }
    SEAM(7);
    if (IN(8)) { PH8 REP2(8) PH8 }
    SEAM(8);
    if (IN(9)) { PH9 REP2(9) PH9 }
    SEAM(9);
    if (IN(10)) { final_phase(F, args); REP2(10) final_phase(F, args); }
#undef IN
#undef SEAM
}

extern "C" void kernel_launch(void* const* d_in, const int* in_sizes, int n_in, void* d_out, int out_size, void* d_ws, size_t ws_size, hipStream_t stream) {
    static int grid = 0;
    if (grid == 0) {
        if (n_in != 26 || in_sizes[0] != M * D || out_size != M * D || ws_size < WS_END) { fprintf(stderr, "kernel_launch: unexpected problem (n_in %d, in0 %d, out %d, ws %zu)\n", n_in, n_in > 0 ? in_sizes[0] : -1, out_size, ws_size); grid = -1; return; }
        int dev = 0, cus = 0, per_cu = 0;
        if (hipGetDevice(&dev) != hipSuccess || hipDeviceGetAttribute(&cus, hipDeviceAttributeMultiprocessorCount, dev) != hipSuccess) { grid = -1; return; }
        if (hipFuncSetAttribute((const void*)fwd_megakernel, hipFuncAttributeMaxDynamicSharedMemorySize, LDS_BYTES) != hipSuccess) { fprintf(stderr, "kernel_launch: hipFuncSetAttribute failed\n"); grid = -1; return; }
        if (hipOccupancyMaxActiveBlocksPerMultiprocessor(&per_cu, (const void*)fwd_megakernel, 512, LDS_BYTES) != hipSuccess || per_cu < 1) { fprintf(stderr, "kernel_launch: occupancy query says %d\n", per_cu); per_cu = 1; }
        (void)hipGetLastError();
        grid = cus * 1;
        if (grid != 256) fprintf(stderr, "kernel_launch: note: %d CUs\n", cus);
    }
    if (grid < 0) return;
    if (hipMemsetAsync((char*)d_ws + WS_CTL + (size_t)CW_BAR * 4, 0, XCD_BAR_WORDS * 4, stream) != hipSuccess) { fprintf(stderr, "kernel_launch: memset failed\n"); return; }
    Args a{};
    for (int i = 0; i < 26; ++i) a.in[i] = (const float*)d_in[i];
    a.out = (float*)d_out; a.ws = (unsigned char*)d_ws;
#if MK_SPLIT
    for (int ph = 0; ph < NPHASE; ++ph) { a.ph_lo = ph; a.ph_hi = ph + 1; hipLaunchKernelGGL(fwd_megakernel, dim3(grid), dim3(512), LDS_BYTES, stream, a); }
#else
    a.ph_lo = 0; a.ph_hi = NPHASE;
    void* kargs[] = {&a};
    hipError_t e = hipLaunchCooperativeKernel((const void*)fwd_megakernel, dim3(grid), dim3(512), kargs, LDS_BYTES, stream);
    if (e != hipSuccess) fprintf(stderr, "kernel_launch: cooperative launch failed: %s (grid %d)\n", hipGetErrorString(e), grid);
#endif
}
```

```cpp
#include <hip/hip_runtime.h>
#include <hip/hip_cooperative_groups.h>
#include <cstdio>
#include <cstdint>
namespace cg = cooperative_groups;

#ifndef MK_SPLIT
#define MK_SPLIT 0
#endif

#ifndef MK_REPEAT
#define MK_REPEAT 0
#endif
#define LAS __attribute__((address_space(3)))
typedef unsigned short bf16;
typedef float f32x4 __attribute__((ext_vector_type(4)));
typedef float f32x2 __attribute__((ext_vector_type(2)));
typedef unsigned u32x4 __attribute__((ext_vector_type(4)));
typedef unsigned u32x2 __attribute__((ext_vector_type(2)));
typedef short bf16x8 __attribute__((ext_vector_type(8)));
typedef short s16x4 __attribute__((ext_vector_type(4)));

constexpr int BATCH = 4, T = 8192, D = 1024, M = BATCH * T;
constexpr int NH = 8, HD = 64, CW = 512;
constexpr int SHIFT_W = 1920, NPROJ = 3456, NPROJ_PAD = 3584, PW = 2048;
constexpr int NE = 32, TOPK = 4, DE = 1024;
constexpr int GRIDW = 64, GROWS = 128;
constexpr int P_TILES_MAX = 544, P_ROWS = P_TILES_MAX * 256;
constexpr float RMS_EPS = 1e-5f, GN_EPS = 64e-5f;
constexpr int NPHASE = 11;

constexpr size_t MiB = 1u << 20;
constexpr size_t WS_CTL = 0;
constexpr size_t WS_W2T = 1 * MiB, WS_A2T = WS_W2T + 131072, WS_G2T = WS_A2T + 131072;
constexpr size_t WS_WINT = 2 * MiB, WS_WOT = 9 * MiB, WS_WUPT = 12 * MiB, WS_WDNT = 140 * MiB;
constexpr size_t WS_EIDX = 204 * MiB, WS_GATE = WS_EIDX + 524288, WS_RANK = WS_GATE + 524288, WS_DEST = WS_RANK + 524288, WS_ROWTOK = WS_DEST + 524288;
constexpr size_t WS_R = 208 * MiB, WS_V = 240 * MiB, WS_KK = 272 * MiB, WS_DECAY = 304 * MiB, WS_KDIR = 368 * MiB, WS_AKK = 432 * MiB,
                 WS_G = 496 * MiB, WS_ATT = 528 * MiB;
constexpr size_t WS_Q = 560 * MiB, WS_K = 592 * MiB, WS_VT = 624 * MiB, WS_P = 656 * MiB, WS_HN = 784 * MiB, WS_Y = 848 * MiB;
constexpr size_t WS_MIX = 560 * MiB, WS_H = 752 * MiB, WS_HN2 = 880 * MiB, WS_XBUF = 208 * MiB, WS_ACT = 480 * MiB, WS_YBUF = 208 * MiB;
constexpr size_t WS_END = 976 * MiB;
constexpr int CW_NT = 0, CW_TEXP = 64, CW_CNT = 1024, CW_BAR = 16384;

constexpr int LDS_BYTES = 159744, LDS_MISC = LDS_BYTES - 256;

typedef __bf16 bf16x2_t __attribute__((ext_vector_type(2)));
__device__ __forceinline__ unsigned cvt_pk_bf16(float lo, float hi) { const f32x2 v = {lo, hi}; return __builtin_bit_cast(unsigned, __builtin_convertvector(v, bf16x2_t)); }
typedef int i32x8 __attribute__((ext_vector_type(8)));
typedef int i32x4 __attribute__((ext_vector_type(4)));
#ifndef F8_SCALE1
#define F8_SCALE1 0
#endif
constexpr float F8_SX = 32.0f, F8_SW = 128.0f, F8_SACT = 8.0f, F8_SY = 32.0f;
__device__ __forceinline__ float f8clamp(float v) { return __builtin_amdgcn_fmed3f(v, -448.0f, 448.0f); }
__device__ __forceinline__ unsigned pk4_fp8(float a, float b, float c, float d) { int w = 0; w = __builtin_amdgcn_cvt_pk_fp8_f32(f8clamp(a), f8clamp(b), w, false); w = __builtin_amdgcn_cvt_pk_fp8_f32(f8clamp(c), f8clamp(d), w, true); return (unsigned)w; }
__device__ __forceinline__ float bflo(unsigned u) { return __uint_as_float(u << 16); }
__device__ __forceinline__ float bfhi(unsigned u) { return __uint_as_float(u & 0xffff0000u); }
__device__ __forceinline__ float bf1(bf16 v) { return __uint_as_float(((unsigned)v) << 16); }
__device__ __forceinline__ void unpack8(const u32x4 u, float* f) { f[0] = bflo(u.x); f[1] = bfhi(u.x); f[2] = bflo(u.y); f[3] = bfhi(u.y); f[4] = bflo(u.z); f[5] = bfhi(u.z); f[6] = bflo(u.w); f[7] = bfhi(u.w); }
__device__ __forceinline__ u32x4 pack8(const float* f) { u32x4 o; o.x = cvt_pk_bf16(f[0], f[1]); o.y = cvt_pk_bf16(f[2], f[3]); o.z = cvt_pk_bf16(f[4], f[5]); o.w = cvt_pk_bf16(f[6], f[7]); return o; }
__device__ __forceinline__ float wave_sum(float v) {
#pragma unroll
    for (int o = 1; o < 64; o <<= 1) v += __shfl_xor(v, o);
    return v;
}
__device__ __forceinline__ float sigmoidf_(float x) { return __builtin_amdgcn_rcpf(1.0f + __expf(-x)); }
__device__ __forceinline__ unsigned ld_u32_agent(const unsigned* p) { return __hip_atomic_load(p, __ATOMIC_RELAXED, __HIP_MEMORY_SCOPE_AGENT); }

namespace pg8 {
constexpr int BM = 256, BK = 64, HALF = 128, HTB = HALF * BK * 2, STAGE_BYTES = 8 * HTB, NXCD = 8, WGM = 8;
__host__ __device__ __forceinline__ int lds_byte(int r, int c) { const int st = (r >> 4) * 2 + (c >> 5), rr = r & 15, cc = c & 31, ob = rr * 64 + cc * 2; return st * 1024 + (ob ^ (((ob >> 9) & 1) << 5)); }
__host__ __device__ __forceinline__ void stage_rc(int b, int& R, int& C) { const int st = b / 1024, sb = b % 1024, swz = sb ^ (((sb >> 9) & 1) << 5); R = (st >> 1) * 16 + swz / 64; C = (st & 1) * 32 + (swz % 64) / 2; }
__host__ __device__ __forceinline__ int perm32(int rho) { const int n = rho >> 4, i = rho & 15; return 8 * (i >> 2) + 4 * n + (i & 3); }

struct Unit { int pm, pn, e; };
struct Gemm { const bf16* A; const bf16* Bt; int K; const unsigned* texp; size_t bstride; const int* rowtok; };

struct StaticOrder {
    int nM, nN, nwg, G, c;
    __device__ void init(int nM_, int nN_, int G_, int c_) { nM = nM_; nN = nN_; nwg = nM * nN; G = G_; c = c_; }
    __device__ bool next(int i, Unit& u) const {
        const long L = (long)i * G + c; if (L >= nwg) return false;
        int wgid = (int)L; { const int q = nwg / NXCD, r = nwg % NXCD, xcd = wgid % NXCD, off = wgid / NXCD; wgid = (xcd < r ? xcd * (q + 1) : r * (q + 1) + (xcd - r) * q) + off; }
        const int nig = WGM * nN, gid = wgid / nig, fm = gid * WGM, gsz = (nM - fm) < WGM ? (nM - fm) : WGM;
        u.pm = fm + ((wgid % nig) % gsz); u.pn = (wgid % nig) / gsz; u.e = 0; return true;
    }
};

__device__ __forceinline__ i32x8 cat8(const bf16x8 lo, const bf16x8 hi) { return __builtin_shufflevector(__builtin_bit_cast(i32x4, lo), __builtin_bit_cast(i32x4, hi), 0, 1, 2, 3, 4, 5, 6, 7); }
template <class Epi, bool ALIGN_EPI, bool SP2, bool GATHER = false, bool FP8 = false>
__device__ __forceinline__ void gemm_phase(LAS unsigned char* lds, const Gemm g, const StaticOrder& S, const Epi& E) {
    const int tid = threadIdx.x, wid = __builtin_amdgcn_readfirstlane(tid >> 6), lane = tid & 63, wr = wid >> 2, wc = wid & 3, fr = lane & 15, fq = lane >> 4;
    const int K = g.K, nt = K / BK;
    unsigned voffA[2], voffB[2];
#pragma unroll
    for (int i = 0; i < 2; ++i) { int R, C; stage_rc(tid * 16 + i * 8192, R, C); const int Rb = Epi::PERM ? ((R & ~31) + perm32(R & 31)) : R;
        voffA[i] = (unsigned)(R * K + C) * 2u; voffB[i] = (unsigned)(Rb * K + C) * 2u; }
    unsigned vC[2][2];
#define PG8_GROWS(u, dst) do { _Pragma("unroll") for (int h_ = 0; h_ < 2; ++h_) _Pragma("unroll") for (int i_ = 0; i_ < 2; ++i_) { int R_, C_; stage_rc(tid * 16 + i_ * 8192, R_, C_); \
        dst[h_][i_] = (unsigned)g.rowtok[(u).pm * BM + h_ * HALF + R_] * (unsigned)(K * 2) + (unsigned)(C_ * 2); } } while (0)
    const size_t kstep = (size_t)(BK * 2);
    const size_t hstep = (size_t)HALF * K * 2;
    const size_t tstep = 2 * hstep;
    const unsigned ldsw = (unsigned)wid * 1024u;
    const int aoff = lds_byte(wr * 64 + fr, fq * 8), boff = lds_byte(wc * 32 + fr, fq * 8);
#define PG8_SA(b, h) (((b) * 2 + (h)) * HTB)
#define PG8_SB(b, h) ((4 + (b) * 2 + (h)) * HTB)
#define PG8_STAGE(bufoff, gbase, voff) do { _Pragma("unroll") for (int _i = 0; _i < 2; ++_i) \
        __builtin_amdgcn_global_load_lds((const unsigned*)((const char*)(gbase) + (voff)[_i]), (LAS unsigned*)(lds + (bufoff) + ldsw + _i * 8192), 16, 0, 0); } while (0)
#define PG8_STAGE_A(bufoff, p, h, nx) do { if constexpr (GATHER) { PG8_STAGE(bufoff, p, vC[h]); } else PG8_STAGE(bufoff, (p) + (h) * hstep, voffA); } while (0)
#define PG8_LDA(dst, b, h) do { _Pragma("unroll") for (int m = 0; m < 4; ++m) _Pragma("unroll") for (int k = 0; k < 2; ++k) dst[m][k] = *(const LAS bf16x8*)(lds + PG8_SA(b, h) + aoff + m * 2048 + k * 1024); } while (0)
#define PG8_LDB(dst, b, h) do { _Pragma("unroll") for (int n = 0; n < 2; ++n) _Pragma("unroll") for (int k = 0; k < 2; ++k) dst[n][k] = *(const LAS bf16x8*)(lds + PG8_SB(b, h) + boff + n * 2048 + k * 1024); } while (0)
#define PG8_MMA(ai, bj, At, Bt) do { __builtin_amdgcn_s_setprio(1); \
        if constexpr (FP8) { _Pragma("unroll") for (int m = 0; m < 4; ++m) _Pragma("unroll") for (int n = 0; n < 2; ++n) \
            { const i32x8 b8_ = cat8(Bt[n][0], Bt[n][1]), a8_ = cat8(At[m][0], At[m][1]); asm volatile("v_mfma_f32_16x16x128_f8f6f4 %0, %1, %2, %0" : "+v"(acc[ai][bj][m][n]) : "v"(b8_), "v"(a8_)); } } \
        else { _Pragma("unroll") for (int m = 0; m < 4; ++m) _Pragma("unroll") for (int n = 0; n < 2; ++n) _Pragma("unroll") for (int k = 0; k < 2; ++k) \
            acc[ai][bj][m][n] = __builtin_amdgcn_mfma_f32_16x16x32_bf16(Bt[n][k], At[m][k], acc[ai][bj][m][n], 0, 0, 0); } \
        __builtin_amdgcn_s_setprio(0); } while (0)
#define PG8_WAIT_V(n) asm volatile("s_waitcnt vmcnt(" #n ")" ::: "memory")
#define PG8_WAIT_L(n) asm volatile("s_waitcnt lgkmcnt(" #n ")" ::: "memory")
#define PG8_BAR __builtin_amdgcn_s_barrier()
#define PG8_SCHED __builtin_amdgcn_sched_barrier(0)
#define PG8_UPTR(u, pa, pb) do { unsigned _e = g.texp ? ld_u32_agent(g.texp + (u).pm) : 0u; _e = (unsigned)__builtin_amdgcn_readfirstlane((int)_e); (u).e = (int)_e; \
        pa = GATHER ? (const char*)g.A : (const char*)g.A + (size_t)(u).pm * tstep; pb = (const char*)g.Bt + (size_t)_e * g.bstride + (size_t)(u).pn * tstep; } while (0)
    Unit cur, nxt; int ui = 0;
    if (!S.next(0, cur)) return;
    f32x4 acc[2][2][4][2];
#pragma unroll
    for (int a = 0; a < 2; ++a)
#pragma unroll
        for (int b = 0; b < 2; ++b)
#pragma unroll
            for (int m = 0; m < 4; ++m)
#pragma unroll
                for (int n = 0; n < 2; ++n) acc[a][b][m][n] = (f32x4){0.f, 0.f, 0.f, 0.f};
    bf16x8 At[4][2], B0[2][2], B1[2][2];
    const char* cA; const char* cB;
    PG8_UPTR(cur, cA, cB);
    if constexpr (GATHER) { PG8_GROWS(cur, vC); }
    if constexpr (SP2) {
        PG8_STAGE(PG8_SB(0, 0), cB, voffB); PG8_STAGE(PG8_SB(0, 1), cB + hstep, voffB); PG8_STAGE_A(PG8_SA(0, 0), cA, 0, false); PG8_STAGE_A(PG8_SA(0, 1), cA, 1, false);
        if (wr == 1) PG8_BAR;
        PG8_WAIT_V(2); PG8_BAR;
        PG8_STAGE(PG8_SB(1, 0), cB + kstep, voffB); PG8_STAGE_A(PG8_SA(1, 0), cA + kstep, 0, false); PG8_STAGE(PG8_SB(1, 1), cB + hstep + kstep, voffB);
        PG8_WAIT_V(6); PG8_BAR;
    } else {
        PG8_STAGE(PG8_SB(0, 0), cB, voffB); PG8_STAGE_A(PG8_SA(0, 0), cA, 0, false); PG8_STAGE(PG8_SB(0, 1), cB + hstep, voffB); PG8_STAGE_A(PG8_SA(0, 1), cA, 1, false);
        if (wr == 1) PG8_BAR;
        PG8_WAIT_V(4); PG8_BAR;
        PG8_STAGE(PG8_SB(1, 0), cB + kstep, voffB); PG8_STAGE_A(PG8_SA(1, 0), cA + kstep, 0, false); PG8_STAGE(PG8_SB(1, 1), cB + hstep + kstep, voffB);
        PG8_WAIT_V(6); PG8_BAR;
    }
    for (;;) {
        const bool has_next = S.next(ui + 1, nxt);
        const char* nA = cA; const char* nB = cB;
        if (has_next) PG8_UPTR(nxt, nA, nB);
#pragma unroll 1
        for (int t = 0; t < nt; t += 2) {
            const bool last = (t == nt - 2);
            const char* a1 = cA + (size_t)(t + 1) * kstep;
            const char* a2 = last ? nA : cA + (size_t)(t + 2) * kstep; const char* b2 = last ? nB : cB + (size_t)(t + 2) * kstep;
            const char* a3 = a2 + kstep; const char* b3 = b2 + kstep;
            if constexpr (SP2) {
            PG8_LDB(B0, 0, 0); PG8_LDB(B1, 0, 1); PG8_SCHED; PG8_LDA(At, 0, 0); PG8_STAGE_A(PG8_SA(1, 1), a1, 1, false);
            if constexpr (GATHER) { if (last && has_next) { PG8_GROWS(nxt, vC); } }
            PG8_WAIT_V(8); PG8_WAIT_L(0); PG8_BAR; PG8_MMA(0, 0, At, B0); PG8_MMA(0, 1, At, B1); PG8_BAR; PG8_SCHED;
            PG8_LDA(At, 0, 1); PG8_STAGE(PG8_SB(0, 0), b2, voffB); PG8_STAGE(PG8_SB(0, 1), b2 + hstep, voffB); PG8_STAGE_A(PG8_SA(0, 0), a2, 0, last);
            PG8_WAIT_V(8); PG8_WAIT_L(0); PG8_BAR; PG8_MMA(1, 0, At, B0); PG8_MMA(1, 1, At, B1); PG8_BAR; PG8_SCHED;
            PG8_LDB(B0, 1, 0); PG8_LDB(B1, 1, 1); PG8_SCHED; PG8_LDA(At, 1, 0); PG8_STAGE_A(PG8_SA(0, 1), a2, 1, last);
            PG8_WAIT_V(8); PG8_WAIT_L(0); PG8_BAR; PG8_MMA(0, 0, At, B0); PG8_MMA(0, 1, At, B1); PG8_BAR; PG8_SCHED;
            PG8_LDA(At, 1, 1); PG8_STAGE(PG8_SB(1, 0), b3, voffB); PG8_STAGE(PG8_SB(1, 1), b3 + hstep, voffB); PG8_STAGE_A(PG8_SA(1, 0), a3, 0, last);
            PG8_WAIT_V(8); PG8_WAIT_L(0); PG8_BAR; PG8_MMA(1, 0, At, B0); PG8_MMA(1, 1, At, B1); PG8_BAR; PG8_SCHED;
            } else {
            PG8_LDB(B0, 0, 0); PG8_SCHED; PG8_LDA(At, 0, 0); PG8_STAGE_A(PG8_SA(1, 1), a1, 1, false);
            if constexpr (GATHER) { if (last && has_next) { PG8_GROWS(nxt, vC); } }
            PG8_WAIT_L(8); PG8_BAR; PG8_WAIT_L(0); PG8_MMA(0, 0, At, B0); PG8_BAR; PG8_SCHED;
            PG8_LDB(B1, 0, 1); PG8_STAGE(PG8_SB(0, 0), b2, voffB);
            PG8_BAR; PG8_WAIT_L(0); PG8_MMA(0, 1, At, B1); PG8_BAR;
            PG8_LDA(At, 0, 1); PG8_STAGE_A(PG8_SA(0, 0), a2, 0, last);
            PG8_BAR; PG8_WAIT_L(0); PG8_MMA(1, 0, At, B0); PG8_BAR; PG8_SCHED;
            PG8_STAGE(PG8_SB(0, 1), b2 + hstep, voffB);
            PG8_WAIT_V(6); PG8_BAR; PG8_MMA(1, 1, At, B1); PG8_BAR;
            PG8_LDB(B0, 1, 0); PG8_SCHED; PG8_LDA(At, 1, 0); PG8_STAGE_A(PG8_SA(0, 1), a2, 1, last);
            PG8_WAIT_L(8); PG8_BAR; PG8_WAIT_L(0); PG8_MMA(0, 0, At, B0); PG8_BAR; PG8_SCHED;
            PG8_LDB(B1, 1, 1); PG8_STAGE(PG8_SB(1, 0), b3, voffB);
            PG8_BAR; PG8_WAIT_L(0); PG8_MMA(0, 1, At, B1); PG8_BAR;
            PG8_LDA(At, 1, 1); PG8_STAGE_A(PG8_SA(1, 0), a3, 0, last);
            PG8_BAR; PG8_WAIT_L(0); PG8_MMA(1, 0, At, B0); PG8_BAR; PG8_SCHED;
            PG8_STAGE(PG8_SB(1, 1), b3 + hstep, voffB);
            PG8_WAIT_V(6); PG8_BAR; PG8_MMA(1, 1, At, B1); PG8_BAR;
            }
        }
        if constexpr (ALIGN_EPI) { if (wr == 0) PG8_BAR; }
        if constexpr (FP8) { asm volatile("s_nop 15\n\ts_nop 15" ::: "memory"); PG8_SCHED; }
        E(acc, cur, wr, wc, fr, fq);
        if (!has_next) break;
#pragma unroll
        for (int a = 0; a < 2; ++a)
#pragma unroll
            for (int b = 0; b < 2; ++b)
#pragma unroll
                for (int m = 0; m < 4; ++m)
#pragma unroll
                    for (int n = 0; n < 2; ++n) acc[a][b][m][n] = (f32x4){0.f, 0.f, 0.f, 0.f};
        cur = nxt; cA = nA; cB = nB; ++ui;
        if constexpr (ALIGN_EPI) { if (wr == 1) PG8_BAR; }
    }
    PG8_WAIT_V(0);
    if constexpr (!ALIGN_EPI) { if (wr == 0) PG8_BAR; }
    PG8_BAR;
#undef PG8_SA
#undef PG8_SB
#undef PG8_STAGE
#undef PG8_LDA
#undef PG8_LDB
#undef PG8_MMA
#undef PG8_WAIT_V
#undef PG8_WAIT_L
#undef PG8_BAR
#undef PG8_SCHED
#undef PG8_UPTR
#undef PG8_STAGE_A
#undef PG8_GROWS
}

struct EpiProj {
    static constexpr bool PERM = true;
    bf16 *q, *k, *vT, *p;
    __device__ __forceinline__ void operator()(const f32x4 (&acc)[2][2][4][2], const Unit& u, int wr, int wc, int fr, int fq) const {
        const int row0 = u.pm * BM + wr * 64 + fr;
        const int pn = u.pn;
#pragma unroll
        for (int ai = 0; ai < 2; ++ai)
#pragma unroll
            for (int m = 0; m < 4; ++m) {
                const int row = row0 + ai * HALF + m * 16;
#pragma unroll
                for (int bj = 0; bj < 2; ++bj) {
                    f32x4 v0 = acc[ai][bj][m][0], v1 = acc[ai][bj][m][1];
                    const int col = pn * BM + bj * HALF + wc * 32 + 8 * fq;
                    if (pn >= 4 && pn < 6) {
                        const int cv = col - 1024, hh = cv >> 6, dim = cv & 63, b = row / T, t = row % T;
                        bf16* dst = vT + ((size_t)(((b * NH + hh) * GROWS + (t >> 6)) * HD + dim)) * 64 + (t & 63);
                        const unsigned w0 = cvt_pk_bf16(v0[0], v0[1]), w1 = cvt_pk_bf16(v0[2], v0[3]), w2 = cvt_pk_bf16(v1[0], v1[1]), w3 = cvt_pk_bf16(v1[2], v1[3]);
                        dst[0 * 64] = (bf16)(w0 & 0xffff); dst[1 * 64] = (bf16)(w0 >> 16); dst[2 * 64] = (bf16)(w1 & 0xffff); dst[3 * 64] = (bf16)(w1 >> 16);
                        dst[4 * 64] = (bf16)(w2 & 0xffff); dst[5 * 64] = (bf16)(w2 >> 16); dst[6 * 64] = (bf16)(w3 & 0xffff); dst[7 * 64] = (bf16)(w3 >> 16);
                        asm volatile("s_waitcnt vmcnt(40)" ::: "memory");
                    } else {
                        bf16* dst;
                        if (pn < 2) { v0 = v0 * 0.125f; v1 = v1 * 0.125f; dst = q + (size_t)row * CW + col; }
                        else if (pn < 4) dst = k + (size_t)row * CW + (col - 512);
                        else dst = p + (size_t)row * PW + (col - 1536);
                        u32x4 w; w.x = cvt_pk_bf16(v0[0], v0[1]); w.y = cvt_pk_bf16(v0[2], v0[3]); w.z = cvt_pk_bf16(v1[0], v1[1]); w.w = cvt_pk_bf16(v1[2], v1[3]);
                        *(u32x4*)dst = w;
                    }
                }
            }
    }
};
struct EpiWo {
    static constexpr bool PERM = true;
    const float* x; bf16* h;
    __device__ __forceinline__ void operator()(const f32x4 (&acc)[2][2][4][2], const Unit& u, int wr, int wc, int fr, int fq) const {
        const int row0 = u.pm * BM + wr * 64 + fr, col0 = u.pn * BM + wc * 32 + 8 * fq;
#pragma unroll
        for (int ai = 0; ai < 2; ++ai)
#pragma unroll
            for (int m = 0; m < 4; ++m) { const size_t off = (size_t)(row0 + ai * HALF + m * 16) * D + col0;
#pragma unroll
                for (int bj = 0; bj < 2; ++bj) { const f32x4 v0 = acc[ai][bj][m][0] + *(const f32x4*)(x + off + bj * HALF), v1 = acc[ai][bj][m][1] + *(const f32x4*)(x + off + bj * HALF + 4);
                    u32x4 w; w.x = cvt_pk_bf16(v0[0], v0[1]); w.y = cvt_pk_bf16(v0[2], v0[3]); w.z = cvt_pk_bf16(v1[0], v1[1]); w.w = cvt_pk_bf16(v1[2], v1[3]);
                    *(u32x4*)(h + off + bj * HALF) = w; } }
    }
};
struct EpiUp {
    static constexpr bool PERM = true;
    const float* b_up; unsigned char* act;
    __device__ __forceinline__ void operator()(const f32x4 (&acc)[2][2][4][2], const Unit& u, int wr, int wc, int fr, int fq) const {
        const int row0 = u.pm * BM + wr * 64 + fr, ch = u.pn * 128 + wc * 32 + 8 * fq;
        const float* bg = b_up + (size_t)u.e * 2048 + ch; const float* bl = bg + 1024;
        const f32x4 bg0 = *(const f32x4*)bg * F8_SACT, bg1 = *(const f32x4*)(bg + 4) * F8_SACT, bl0 = *(const f32x4*)bl, bl1 = *(const f32x4*)(bl + 4);
        constexpr float SG = F8_SACT / (F8_SX * F8_SW), SL = 1.0f / (F8_SX * F8_SW), KE = -1.702f * 1.44269504f / F8_SACT;
#pragma unroll
        for (int ai = 0; ai < 2; ++ai)
#pragma unroll
            for (int m = 0; m < 4; ++m) {
                float o[8];
#pragma unroll
                for (int n = 0; n < 2; ++n) { const f32x4 gv = acc[ai][0][m][n] * SG + (n ? bg1 : bg0), lv = acc[ai][1][m][n] * SL + (n ? bl1 : bl0);
#pragma unroll
                    for (int j = 0; j < 4; ++j) { const float gt = fminf(gv[j], 7.0f * F8_SACT), li = __builtin_amdgcn_fmed3f(lv[j], -7.0f, 7.0f);
                        const float t = gt * __builtin_amdgcn_rcpf(1.0f + __builtin_amdgcn_exp2f(gt * KE)); o[n * 4 + j] = __builtin_fmaf(li, t, t); } }
                int w0 = 0, w1 = 0;
                w0 = __builtin_amdgcn_cvt_pk_fp8_f32(o[0], o[1], w0, false); w0 = __builtin_amdgcn_cvt_pk_fp8_f32(o[2], o[3], w0, true);
                w1 = __builtin_amdgcn_cvt_pk_fp8_f32(o[4], o[5], w1, false); w1 = __builtin_amdgcn_cvt_pk_fp8_f32(o[6], o[7], w1, true);
                u32x2 w8; w8.x = (unsigned)w0; w8.y = (unsigned)w1;
                *(u32x2*)(act + (size_t)(row0 + ai * HALF + m * 16) * DE + ch) = w8;
            }
    }
};
struct EpiDown {
    static constexpr bool PERM = true;
    const float* b_dn; unsigned char* y;
    __device__ __forceinline__ void operator()(const f32x4 (&acc)[2][2][4][2], const Unit& u, int wr, int wc, int fr, int fq) const {
        const int row0 = u.pm * BM + wr * 64 + fr, col0 = u.pn * BM + wc * 32 + 8 * fq;
        const float* bb = b_dn + (size_t)u.e * D + col0;
        f32x4 bv[2][2];
#pragma unroll
        for (int bj = 0; bj < 2; ++bj)
#pragma unroll
            for (int n = 0; n < 2; ++n) bv[bj][n] = *(const f32x4*)(bb + bj * HALF + 4 * n) * F8_SY;
#pragma unroll
        for (int ai = 0; ai < 2; ++ai)
#pragma unroll
            for (int m = 0; m < 4; ++m) { unsigned char* rowp = y + (size_t)(row0 + ai * HALF + m * 16) * D + col0;
#pragma unroll
                for (int bj = 0; bj < 2; ++bj) { const f32x4 v0 = acc[ai][bj][m][0] * (F8_SY / (F8_SACT * F8_SW)) + bv[bj][0], v1 = acc[ai][bj][m][1] * (F8_SY / (F8_SACT * F8_SW)) + bv[bj][1];
                    u32x2 w; w.x = pk4_fp8(v0[0], v0[1], v0[2], v0[3]); w.y = pk4_fp8(v1[0], v1[1], v1[2], v1[3]);
                    *(u32x2*)(rowp + bj * HALF) = w; } }
    }
};
}


#define XB_TMO      128
#define XB_XCNT(j)  (256  + 64 * (j))
#define XB_XSUB(j)  (1280 + 64 * (j))
#define XB_XGEN(j)  (2304 + 64 * (j))
#define XB_TOP      3328
#define XB_TOPGEN   3392
#define XCD_BAR_WORDS 3456
#define XB_SPIN_CAP (1u << 20)
__device__ __forceinline__ unsigned xb_ld(unsigned* p)              { return __hip_atomic_load(p, __ATOMIC_RELAXED, __HIP_MEMORY_SCOPE_AGENT); }
__device__ __forceinline__ unsigned xb_add(unsigned* p, unsigned v) { return __hip_atomic_fetch_add(p, v, __ATOMIC_RELAXED, __HIP_MEMORY_SCOPE_AGENT); }
__device__ __forceinline__ unsigned xb_xcc_id() { return (unsigned)__builtin_amdgcn_s_getreg((3 << 11) | 20) & 0xFu; }
#define XB_SPIN(cond, bar) do { unsigned _sp = 0; while (cond) { __builtin_amdgcn_s_sleep(1); \
    if ((++_sp & 255u) == 0u) { if (xb_ld(&(bar)[XB_TMO])) break; if (_sp > XB_SPIN_CAP) { atomicAdd(&(bar)[XB_TMO], 1u); break; } } } } while (0)
struct XcdBarrier { unsigned* bar; unsigned x; volatile LAS unsigned* st; };
__device__ __forceinline__ XcdBarrier xcd_barrier_post(unsigned* bar, volatile LAS unsigned* st) {
    XcdBarrier b; b.bar = bar; b.x = xb_xcc_id(); b.st = st;
    if (threadIdx.x == 0) (void)xb_add(&bar[XB_XCNT(b.x)], 1u);
    return b;
}
__device__ __forceinline__ void xcd_barrier_complete(unsigned* bar, unsigned x, unsigned& nloc, unsigned& nx) {
    const unsigned G = gridDim.x * gridDim.y * gridDim.z;
    unsigned sum, cnt, mine, sp = 0u;
    for (;;) {
        sum = 0u; cnt = 0u; mine = 0u;
#pragma unroll
        for (unsigned j = 0; j < 16; ++j) { const unsigned c = xb_ld(&bar[XB_XCNT(j)]); sum += c; cnt += (c > 0u) ? 1u : 0u; mine = (j == x) ? c : mine; }
        if (sum == G) break;
        __builtin_amdgcn_s_sleep(1);
        if ((++sp & 255u) == 0u) { if (xb_ld(&bar[XB_TMO])) break; if (sp > XB_SPIN_CAP) { atomicAdd(&bar[XB_TMO], 1u); break; } }
    }
    nloc = mine > 0u ? mine : 1u; nx = cnt > 0u ? cnt : 1u;
}
__device__ __forceinline__ void xcd_barrier(const XcdBarrier& b) {
    asm volatile("s_waitcnt vmcnt(0)" ::: "memory");
    __syncthreads();
    if (threadIdx.x == 0) {
        unsigned* bar = b.bar;
        __builtin_amdgcn_s_waitcnt(0);
        unsigned nloc = b.st[0], nx = b.st[1];
        if (nloc == 0u) { xcd_barrier_complete(bar, b.x, nloc, nx); b.st[0] = nloc; b.st[1] = nx; }
        const unsigned old = xb_add(&bar[XB_XSUB(b.x)], 1u);
        const unsigned gen = old / nloc;
        if (old + 1u == (gen + 1u) * nloc) {
            __builtin_amdgcn_fence(__ATOMIC_RELEASE, "agent");
            asm volatile("s_waitcnt vmcnt(0)" ::: "memory");
            const unsigned og = xb_add(&bar[XB_TOP], 1u);
            const unsigned tg = og / nx;
            if (og + 1u == (tg + 1u) * nx) xb_add(&bar[XB_TOPGEN], 1u);
            else XB_SPIN(xb_ld(&bar[XB_TOPGEN]) == tg, bar);
            __builtin_amdgcn_fence(__ATOMIC_ACQUIRE, "agent");
            xb_add(&bar[XB_XGEN(b.x)], 1u);
            asm volatile("s_waitcnt vmcnt(0)" ::: "memory");
        } else {
            XB_SPIN(xb_ld(&bar[XB_XGEN(b.x)]) == gen, bar);
            __builtin_amdgcn_fence(__ATOMIC_ACQUIRE, "agent");
            asm volatile("s_waitcnt vmcnt(0)" ::: "memory");
        }
    }
    __syncthreads();
}

struct Args { const float* in[26]; float* out; unsigned char* ws; int ph_lo, ph_hi; };

struct Frame { LAS unsigned char* lds; int tid, lane, wave, G, vcu; };

__device__ __forceinline__ void transpose_item(const float* W, int K, int N, bf16* WT, int k0, int n0, int orow0, LAS float* scr, int lane) {
#pragma unroll 8
    for (int i = 0; i < 32; ++i) { const int kk = 2 * i + (lane >> 5); scr[kk * 33 + (lane & 31)] = W[(size_t)(k0 + kk) * N + n0 + (lane & 31)]; }
    asm volatile("s_waitcnt lgkmcnt(0)" ::: "memory");
    const int c = lane & 7;
#pragma unroll
    for (int j = 0; j < 4; ++j) { const int n = (lane >> 3) + 8 * j; const LAS float* s = scr + (8 * c) * 33 + n;
        u32x4 o; o.x = cvt_pk_bf16(s[0 * 33], s[1 * 33]); o.y = cvt_pk_bf16(s[2 * 33], s[3 * 33]); o.z = cvt_pk_bf16(s[4 * 33], s[5 * 33]); o.w = cvt_pk_bf16(s[6 * 33], s[7 * 33]);
        *(u32x4*)(WT + (size_t)(orow0 + n) * K + k0 + 8 * c) = o; }
    asm volatile("s_waitcnt lgkmcnt(0)" ::: "memory");
}

__device__ __forceinline__ void transpose_item8w(const float* W, int K, int N, unsigned char* WT, int k0, int n0, int orow0, LAS float* scr, int lane) {
#pragma unroll 8
    for (int i = 0; i < 64; ++i) { const int kk = 2 * i + (lane >> 5); scr[kk * 33 + (lane & 31)] = W[(size_t)(k0 + kk) * N + n0 + (lane & 31)]; }
    asm volatile("s_waitcnt lgkmcnt(0)" ::: "memory");
    const int c = lane & 7;
#pragma unroll
    for (int j = 0; j < 4; ++j) { const int n = (lane >> 3) + 8 * j; const LAS float* s = scr + (16 * c) * 33 + n;
        u32x4 o; o.x = pk4_fp8(s[0 * 33] * F8_SW, s[1 * 33] * F8_SW, s[2 * 33] * F8_SW, s[3 * 33] * F8_SW); o.y = pk4_fp8(s[4 * 33] * F8_SW, s[5 * 33] * F8_SW, s[6 * 33] * F8_SW, s[7 * 33] * F8_SW);
        o.z = pk4_fp8(s[8 * 33] * F8_SW, s[9 * 33] * F8_SW, s[10 * 33] * F8_SW, s[11 * 33] * F8_SW); o.w = pk4_fp8(s[12 * 33] * F8_SW, s[13 * 33] * F8_SW, s[14 * 33] * F8_SW, s[15 * 33] * F8_SW);
        *(u32x4*)(WT + (size_t)(orow0 + n) * K + k0 + 16 * c) = o; }
    asm volatile("s_waitcnt lgkmcnt(0)" ::: "memory");
}
__device__ __forceinline__ void transpose_item8(const float* W, int K, int N, unsigned char* WT, int k0, int n0, int orow0, LAS float* scr, int lane) {
#pragma unroll 8
    for (int i = 0; i < 32; ++i) { const int kk = 2 * i + (lane >> 5); scr[kk * 33 + (lane & 31)] = W[(size_t)(k0 + kk) * N + n0 + (lane & 31)]; }
    asm volatile("s_waitcnt lgkmcnt(0)" ::: "memory");
    const int c = lane & 7;
#pragma unroll
    for (int j = 0; j < 4; ++j) { const int n = (lane >> 3) + 8 * j; const LAS float* s = scr + (8 * c) * 33 + n;
        u32x2 o; o.x = pk4_fp8(s[0 * 33] * F8_SW, s[1 * 33] * F8_SW, s[2 * 33] * F8_SW, s[3 * 33] * F8_SW); o.y = pk4_fp8(s[4 * 33] * F8_SW, s[5 * 33] * F8_SW, s[6 * 33] * F8_SW, s[7 * 33] * F8_SW);
        *(u32x2*)(WT + (size_t)(orow0 + n) * K + k0 + 8 * c) = o; }
    asm volatile("s_waitcnt lgkmcnt(0)" ::: "memory");
}

__device__ __forceinline__ void p0_prologue(const Frame& F, const Args& a) {
    unsigned char* ws = a.ws;
    LAS float* scr = (LAS float*)(F.lds + F.wave * 8448);
    const int gw = F.vcu * 8 + F.wave, NGW = F.G * 8;
    constexpr int I_IN = 16 * 108, I_O = 16 * 32, I_L = 16, I_G = 32;
    constexpr int NITEMS = I_IN + I_O + 2 * I_L + 2 * I_L + I_G;
    for (int it = gw; it < NITEMS; it += NGW) {
        int r = it;
        if (r < I_IN) { const int kb = r / 108, nb = r % 108; transpose_item(a.in[2], 1024, NPROJ, (bf16*)(ws + WS_WINT), kb * 64, nb * 32, nb * 32, scr, F.lane); continue; }
        r -= I_IN;
        if (r < I_O) { const int kb = r / 32, nb = r % 32; transpose_item(a.in[17], 1024, 1024, (bf16*)(ws + WS_WOT), kb * 64, nb * 32, nb * 32, scr, F.lane); continue; }
        r -= I_O;
        if (r < 2 * I_L) { const int z = r / 16, nb = r % 16; transpose_item(a.in[8] + (size_t)z * 64 * 512, 64, 512, (bf16*)(ws + WS_W2T) + (size_t)z * 512 * 64, 0, nb * 32, nb * 32, scr, F.lane); continue; }
        r -= 2 * I_L;
        if (r < 2 * I_L) { const int z = r / 16, nb = r % 16; transpose_item(a.in[10] + (size_t)z * 64 * 512, 64, 512, (bf16*)(ws + WS_A2T) + (size_t)z * 512 * 64, 0, nb * 32, nb * 32, scr, F.lane); continue; }
        r -= 2 * I_L;
        { const int kb = r / 16, nb = r % 16; transpose_item(a.in[11], 128, 512, (bf16*)(ws + WS_G2T), kb * 64, nb * 32, nb * 32, scr, F.lane); }
    }
    {
        constexpr int BI_UP = 32 * 8 * 8, BI_DN = 32 * 8 * 4, WP = 257;
        LAS float* tile = (LAS float*)F.lds;
        const int lane = F.lane, w = F.wave, c = lane & 7;
        for (int bi = F.vcu; bi < BI_UP + BI_DN; bi += F.G) {
            const bool up = bi < BI_UP; const int r2 = up ? bi : bi - BI_UP;
            const int e = up ? r2 >> 6 : r2 >> 5, q = up ? r2 & 63 : r2 & 31, kb = up ? q >> 3 : q >> 2, nb = up ? q & 7 : q & 3;
            const int N = up ? 2048 : 1024, k0 = kb * 128, n0 = nb * 256;
            const float* W = (up ? a.in[21] + (size_t)e * 1024 * 2048 : a.in[23] + (size_t)e * 1024 * 1024) + (size_t)k0 * N + n0 + 4 * lane;
            unsigned char* WT = (up ? ws + WS_WUPT + (size_t)e * 2048 * 1024 : ws + WS_WDNT + (size_t)e * 1024 * 1024) + k0 + 16 * c;
            __syncthreads();
            f32x4 v[16];
#pragma unroll
            for (int i = 0; i < 16; ++i) v[i] = *(const f32x4*)(W + (size_t)(16 * w + i) * N);
#pragma unroll
            for (int i = 0; i < 16; ++i) { LAS float* t = tile + (16 * w + i) * WP + 4 * lane; t[0] = v[i].x; t[1] = v[i].y; t[2] = v[i].z; t[3] = v[i].w; }
            __syncthreads();
#pragma unroll
            for (int j = 0; j < 4; ++j) { const int nl = 32 * w + (lane >> 3) + 8 * j, n = n0 + nl;
                const int orow = up ? (n < 1024 ? 256 * (n >> 7) + (n & 127) : 256 * ((n - 1024) >> 7) + 128 + ((n - 1024) & 127)) : n;
                const LAS float* sp = tile + (16 * c) * WP + nl;
                u32x4 o; o.x = pk4_fp8(sp[0 * WP] * F8_SW, sp[1 * WP] * F8_SW, sp[2 * WP] * F8_SW, sp[3 * WP] * F8_SW); o.y = pk4_fp8(sp[4 * WP] * F8_SW, sp[5 * WP] * F8_SW, sp[6 * WP] * F8_SW, sp[7 * WP] * F8_SW);
                o.z = pk4_fp8(sp[8 * WP] * F8_SW, sp[9 * WP] * F8_SW, sp[10 * WP] * F8_SW, sp[11 * WP] * F8_SW); o.w = pk4_fp8(sp[12 * WP] * F8_SW, sp[13 * WP] * F8_SW, sp[14 * WP] * F8_SW, sp[15 * WP] * F8_SW);
                *(u32x4*)(WT + (size_t)orow * 1024) = o; }
        }
        __syncthreads(); }
    { u32x4* z = (u32x4*)(ws + WS_WINT + (size_t)NPROJ * 1024 * 2); const u32x4 zero = {0u, 0u, 0u, 0u};
      for (int i = F.vcu * 512 + F.tid; i < 16384; i += F.G * 512) z[i] = zero; }
    const float* x = a.in[0]; const float* nw = a.in[1]; bf16* hn = (bf16*)(ws + WS_HN);
    f32x4 wv[4];
#pragma unroll
    for (int j = 0; j < 4; ++j) wv[j] = *((const f32x4*)nw + F.lane + 64 * j);
    for (int m = gw; m < M; m += 2 * NGW) {
        const int m1 = m + NGW; const bool has1 = m1 < M;
        const f32x4* xr0 = (const f32x4*)(x + (size_t)m * D) + F.lane; const f32x4* xr1 = (const f32x4*)(x + (size_t)(has1 ? m1 : m) * D) + F.lane;
        f32x4 v0[4], v1[4]; float s0 = 0.f, s1 = 0.f;
#pragma unroll
        for (int j = 0; j < 4; ++j) { v0[j] = xr0[64 * j]; v1[j] = xr1[64 * j]; }
#pragma unroll
        for (int j = 0; j < 4; ++j) { s0 += (v0[j].x * v0[j].x + v0[j].y * v0[j].y) + (v0[j].z * v0[j].z + v0[j].w * v0[j].w); s1 += (v1[j].x * v1[j].x + v1[j].y * v1[j].y) + (v1[j].z * v1[j].z + v1[j].w * v1[j].w); }
        const float rs0 = rsqrtf(wave_sum(s0) * (1.f / D) + RMS_EPS), rs1 = rsqrtf(wave_sum(s1) * (1.f / D) + RMS_EPS);
        u32x2* o0 = (u32x2*)(hn + (size_t)m * D) + F.lane; u32x2* o1 = (u32x2*)(hn + (size_t)m1 * D) + F.lane;
#pragma unroll
        for (int j = 0; j < 4; ++j) { u32x2 o; o.x = cvt_pk_bf16(v0[j].x * rs0 * wv[j].x, v0[j].y * rs0 * wv[j].y); o.y = cvt_pk_bf16(v0[j].z * rs0 * wv[j].z, v0[j].w * rs0 * wv[j].w); o0[64 * j] = o; }
        if (has1) {
#pragma unroll
            for (int j = 0; j < 4; ++j) { u32x2 o; o.x = cvt_pk_bf16(v1[j].x * rs1 * wv[j].x, v1[j].y * rs1 * wv[j].y); o.y = cvt_pk_bf16(v1[j].z * rs1 * wv[j].z, v1[j].w * rs1 * wv[j].w); o1[64 * j] = o; } }
    }
}

constexpr int PREP_KBUF = 0, PREP_INV = 65536, PREP_AW = 67584, PREP_AA = PREP_AW + 17408, PREP_AG = PREP_AA + 17408, PREP_LD = 136;
template <bool STORE>
__device__ __forceinline__ void prep_phase(const Frame& F, const Args& a) {
    unsigned char* ws = a.ws;
    const bf16* p = (const bf16*)(ws + WS_P);
    bf16* r_out = (bf16*)(ws + WS_R); bf16* v_out = (bf16*)(ws + WS_V); bf16* kk_out = (bf16*)(ws + WS_KK);
    bf16* decay_out = (bf16*)(ws + WS_DECAY); bf16* kdir_out = (bf16*)(ws + WS_KDIR); bf16* akk_out = (bf16*)(ws + WS_AKK); bf16* g_out = (bf16*)(ws + WS_G);
    const bf16* w2T = (const bf16*)(ws + WS_W2T); const bf16* a2T = (const bf16*)(ws + WS_A2T); const bf16* g2T = (const bf16*)(ws + WS_G2T);
    const float* mu_p = a.in[5]; const float* mu_n = a.in[6]; const float* w0 = a.in[7]; const float* a0 = a.in[9];
    const float* k_k = a.in[12]; const float* k_a = a.in[13];
    LAS bf16* kbuf = (LAS bf16*)(F.lds + PREP_KBUF); LAS float* invb = (LAS float*)(F.lds + PREP_INV);
    LAS bf16* Aw = (LAS bf16*)(F.lds + PREP_AW); LAS bf16* Aa = (LAS bf16*)(F.lds + PREP_AA); LAS bf16* Ag = (LAS bf16*)(F.lds + PREP_AG);
    const int lane = F.lane, wave = F.wave, fr = lane & 15, fg = lane >> 4;
    for (int tile = F.vcu; tile < M / 64; tile += F.G) {
        const int m0 = tile * 64;
#pragma unroll 1
        for (int jj = 0; jj < 4; ++jj) {
            const int q = lane + 64 * jj; const bool valid = q < 240; const int c0 = 8 * q;
            float mp[8], mn[8];
#pragma unroll
            for (int i = 0; i < 8; ++i) { mp[i] = valid ? mu_p[c0 + i] : 0.f; mn[i] = valid ? mu_n[c0 + i] : 0.f; }
            const int mfirst = m0 + wave * 8;
            const u32x4 zero = {0u, 0u, 0u, 0u};
            u32x4 rows[10];
#pragma unroll
            for (int rI = 0; rI < 10; ++rI) { const int mr = mfirst - 1 + rI;
                const bool ok = valid && !(rI == 0 && (mfirst % T) == 0) && !(rI == 9 && ((mfirst + 7) % T) == T - 1);
                rows[rI] = ok ? *(const u32x4*)(p + (size_t)mr * PW + c0) : zero; }
#pragma unroll
            for (int i = 0; i < 8; ++i) {
                const int m = mfirst + i, it = wave * 8 + i;
                const u32x4 prev = rows[i], cur = rows[i + 1], nxt = rows[i + 2];
                float fp[8], fc[8], fn[8], s[8];
                unpack8(prev, fp); unpack8(cur, fc); unpack8(nxt, fn);
#pragma unroll
                for (int e = 0; e < 8; ++e) s[e] = fc[e] + mp[e] * (fp[e] - fc[e]) + mn[e] * (fn[e] - fc[e]);
                if (jj == 0) { if (STORE) { *(u32x4*)(r_out + (size_t)m * CW + c0) = pack8(s); } }
                else if (jj == 1) {
                    const int c = c0 - 512;
                    *(LAS u32x4*)(kbuf + it * 512 + c) = pack8(s);
                    float kr[8]; float ss = 0.f;
#pragma unroll
                    for (int e = 0; e < 8; ++e) { kr[e] = s[e] * k_k[c + e]; ss += kr[e] * kr[e]; }
                    ss += __shfl_xor(ss, 1); ss += __shfl_xor(ss, 2); ss += __shfl_xor(ss, 4);
                    const float inv = fminf(__builtin_amdgcn_rsqf(ss), 1e12f);
#pragma unroll
                    for (int e = 0; e < 8; ++e) kr[e] *= inv;
                    if (STORE) { *(u32x4*)(kk_out + (size_t)m * CW + c) = pack8(kr); }
                    if ((lane & 7) == 0) invb[it * 8 + (lane >> 3)] = inv;
                }
                else if (jj == 2) { if (STORE) { *(u32x4*)(v_out + (size_t)m * CW + (c0 - 1024)) = pack8(s); } }
                else if (valid) {
                    const int seg = lane >> 4, cw = 8 * (lane & 15);
                    if (seg == 0) {
#pragma unroll
                        for (int e = 0; e < 8; ++e) s[e] = 1.0f - 2.0f * __builtin_amdgcn_rcpf(__expf(2.0f * s[e]) + 1.0f);
                        *(LAS u32x4*)(Aw + it * PREP_LD + cw) = pack8(s);
                    } else if (seg == 1) { *(LAS u32x4*)(Aa + it * PREP_LD + cw) = pack8(s); }
                    else {
#pragma unroll
                        for (int e = 0; e < 8; ++e) s[e] = sigmoidf_(s[e]);
                        *(LAS u32x4*)(Ag + it * PREP_LD + cw) = pack8(s);
                    }
                }
            }
        }
        __syncthreads();
        const int nb = 64 * wave;
#define PREP_PROW(nt_) (nb + 32 * ((nt_) >> 1) + 8 * (fr >> 2) + 4 * ((nt_) & 1) + (fr & 3))
#define PREP_COL(nt_)  (nb + 32 * ((nt_) >> 1) + 8 * fg + 4 * ((nt_) & 1))
#pragma unroll 1
        for (int job = 0; job < 4; ++job) {
            const int z = job & 1;
            const bf16* WT = job < 2 ? w2T + (size_t)z * 512 * 64 : a2T + (size_t)z * 512 * 64;
            const LAS bf16* Ax = job < 2 ? Aw + z * 64 : Aa + z * 64;
            bf16x8 wf[2][4];
#pragma unroll
            for (int ks = 0; ks < 2; ++ks)
#pragma unroll
                for (int nt = 0; nt < 4; ++nt) wf[ks][nt] = *(const bf16x8*)(WT + (size_t)PREP_PROW(nt) * 64 + 32 * ks + 8 * fg);
            f32x4 pb[4], pkk[4], pka[4];
#pragma unroll
            for (int nt = 0; nt < 4; ++nt) { const int n = PREP_COL(nt);
                pb[nt] = *(const f32x4*)((job < 2 ? w0 : a0) + z * 512 + n); pkk[nt] = *(const f32x4*)(k_k + n); pka[nt] = *(const f32x4*)(k_a + n); }
            f32x4 acc[4][4];
#pragma unroll
            for (int mt = 0; mt < 4; ++mt)
#pragma unroll
                for (int nt = 0; nt < 4; ++nt) acc[mt][nt] = (f32x4){0.f, 0.f, 0.f, 0.f};
#pragma unroll
            for (int ks = 0; ks < 2; ++ks) {
                bf16x8 af[4];
#pragma unroll
                for (int mt = 0; mt < 4; ++mt) af[mt] = *(const LAS bf16x8*)(Ax + (16 * mt + fr) * PREP_LD + 32 * ks + 8 * fg);
#pragma unroll
                for (int mt = 0; mt < 4; ++mt)
#pragma unroll
                    for (int nt = 0; nt < 4; ++nt) acc[mt][nt] = __builtin_amdgcn_mfma_f32_16x16x32_bf16(wf[ks][nt], af[mt], acc[mt][nt], 0, 0, 0);
            }
#pragma unroll
            for (int mt = 0; mt < 4; ++mt) {
                const int it = 16 * mt + fr; const size_t m = (size_t)(m0 + it);
#pragma unroll
                for (int np = 0; np < 2; ++np) {
                    const int c8 = nb + 32 * np + 8 * fg;
                    if (job < 2) {
                        float o[8];
#pragma unroll
                        for (int hh = 0; hh < 2; ++hh) { const f32x4 v = acc[mt][2 * np + hh], bq = pb[2 * np + hh];
#pragma unroll
                            for (int i = 0; i < 4; ++i) o[4 * hh + i] = __expf(-0.60653066f * sigmoidf_(v[i] + bq[i])); }
                        if (STORE) { *(u32x4*)(decay_out + ((size_t)z * M + m) * CW + c8) = pack8(o); }
                    } else {
                        const u32x4 kb = *(const LAS u32x4*)(kbuf + it * 512 + c8);
                        float kv[8]; unpack8(kb, kv);
                        const float inv = invb[it * 8 + wave];
                        float kd[8], ak[8];
#pragma unroll
                        for (int hh = 0; hh < 2; ++hh) { const f32x4 v = acc[mt][2 * np + hh], bq = pb[2 * np + hh], kkc = pkk[2 * np + hh], kac = pka[2 * np + hh];
#pragma unroll
                            for (int i = 0; i < 4; ++i) { const float av = sigmoidf_(v[i] + bq[i]), kx = kv[4 * hh + i]; kd[4 * hh + i] = kx * (1.0f + (av - 1.0f) * kac[i]); ak[4 * hh + i] = av * (kx * kkc[i] * inv); } }
                        if (STORE) { *(u32x4*)(kdir_out + ((size_t)z * M + m) * CW + c8) = pack8(kd); *(u32x4*)(akk_out + ((size_t)z * M + m) * CW + c8) = pack8(ak); }
                    }
                }
            }
        }
        {
            bf16x8 wf[4][4];
#pragma unroll
            for (int ks = 0; ks < 4; ++ks)
#pragma unroll
                for (int nt = 0; nt < 4; ++nt) wf[ks][nt] = *(const bf16x8*)(g2T + (size_t)PREP_PROW(nt) * 128 + 32 * ks + 8 * fg);
            f32x4 acc[4][4];
#pragma unroll
            for (int mt = 0; mt < 4; ++mt)
#pragma unroll
                for (int nt = 0; nt < 4; ++nt) acc[mt][nt] = (f32x4){0.f, 0.f, 0.f, 0.f};
#pragma unroll
            for (int ks = 0; ks < 4; ++ks) {
                bf16x8 af[4];
#pragma unroll
                for (int mt = 0; mt < 4; ++mt) af[mt] = *(const LAS bf16x8*)(Ag + (16 * mt + fr) * PREP_LD + 32 * ks + 8 * fg);
#pragma unroll
                for (int mt = 0; mt < 4; ++mt)
#pragma unroll
                    for (int nt = 0; nt < 4; ++nt) acc[mt][nt] = __builtin_amdgcn_mfma_f32_16x16x32_bf16(wf[ks][nt], af[mt], acc[mt][nt], 0, 0, 0);
            }
#pragma unroll
            for (int mt = 0; mt < 4; ++mt) { const size_t m = (size_t)(m0 + 16 * mt + fr);
#pragma unroll
                for (int np = 0; np < 2; ++np) { const f32x4 v0 = acc[mt][2 * np], v1 = acc[mt][2 * np + 1];
                    u32x4 w; w.x = cvt_pk_bf16(v0[0], v0[1]); w.y = cvt_pk_bf16(v0[2], v0[3]); w.z = cvt_pk_bf16(v1[0], v1[1]); w.w = cvt_pk_bf16(v1[2], v1[3]);
                    if (STORE) { *(u32x4*)(g_out + m * CW + nb + 32 * np + 8 * fg) = w; } } }
        }
#undef PREP_PROW
#undef PREP_COL
        __syncthreads();
    }
}

__device__ __forceinline__ void attn_phase(const Frame& F, const Args& a, const int widx, const int nworkers) {
    unsigned char* ws = a.ws;
    const bf16* q = (const bf16*)(ws + WS_Q); const bf16* k = (const bf16*)(ws + WS_K); const bf16* vT = (const bf16*)(ws + WS_VT);
    bf16* att = (bf16*)(ws + WS_ATT);
    LAS float* bias = (LAS float*)F.lds + 16;
    for (int i = F.tid; i < 8 * 15 * 31; i += 512) bias[i] = a.in[3][i];
    __syncthreads();
    const int lane = F.lane, fr = lane & 15, fg = lane >> 4;
    const int per = (16384 + nworkers * 8 - 1) / (nworkers * 8);
    for (int it = 0; it < per; ++it) {
        const int task = widx * (8 * per) + it * 8 + F.wave; if (task >= 16384) break;
        const int cgp = task & 3, r = (task >> 2) & 127, h = (task >> 9) & 7, b = task >> 12;
        const int c0 = 16 * cgp, wsc = min(max(c0 - 8, 0), 32), rs = min(max(r - 4, 0), GROWS - 8);
        const int c = c0 + fr, cs = min(max(c - 8, 0), 48);
        const size_t tq = (size_t)b * T + r * 64 + c;
        bf16x8 qf[2];
#pragma unroll
        for (int ks = 0; ks < 2; ++ks) qf[ks] = *(const bf16x8*)(q + tq * CW + h * 64 + 32 * ks + 8 * fg);
        f32x4 sc[16];
        const int kcol_a = wsc + 8 * (fr >> 2) + (fr & 3);
        { bf16x8 kf[16][2];
#pragma unroll
          for (int t = 0; t < 16; ++t) { const int u = t >> 1, par = t & 1;
              const size_t tk = (size_t)b * T + (rs + u) * 64 + kcol_a + 4 * par;
              kf[t][0] = *(const bf16x8*)(k + tk * CW + h * 64 + 8 * fg); kf[t][1] = *(const bf16x8*)(k + tk * CW + h * 64 + 32 + 8 * fg); }
#pragma unroll
          for (int t = 0; t < 16; ++t) { f32x4 s = {0.f, 0.f, 0.f, 0.f};
              s = __builtin_amdgcn_mfma_f32_16x16x32_bf16(kf[t][0], qf[0], s, 0, 0, 0);
              s = __builtin_amdgcn_mfma_f32_16x16x32_bf16(kf[t][1], qf[1], s, 0, 0, 0);
              sc[t] = s; } }
        bool okm[8];
#pragma unroll
        for (int pi = 0; pi < 8; ++pi) { const int kc = wsc + 8 * fg + pi; okm[pi] = (kc >= cs) && (kc < cs + 16); }
        const LAS float* brow = bias + (h * 15 + (rs - r + 7)) * 31 + (wsc + 8 * fg - c + 15);
        float mx = -1e30f;
#pragma unroll
        for (int u = 0; u < 8; ++u)
#pragma unroll
            for (int pi = 0; pi < 8; ++pi) { const float s = okm[pi] ? sc[2 * u + (pi >> 2)][pi & 3] + brow[31 * u + pi] : -1e30f; sc[2 * u + (pi >> 2)][pi & 3] = s; mx = fmaxf(mx, s); }
        mx = fmaxf(mx, __shfl_xor(mx, 16)); mx = fmaxf(mx, __shfl_xor(mx, 32));
        float sum = 0.f;
        const float mxl = -mx * 1.44269504f;
#pragma unroll
        for (int t = 0; t < 16; ++t)
#pragma unroll
            for (int i = 0; i < 4; ++i) { const float pv = __builtin_amdgcn_exp2f(__builtin_fmaf(sc[t][i], 1.44269504f, mxl)); sc[t][i] = pv; sum += pv; }
        sum += __shfl_xor(sum, 16); sum += __shfl_xor(sum, 32);
        const float inv = 1.0f / sum;
        f32x4 o[4];
#pragma unroll
        for (int nt = 0; nt < 4; ++nt) o[nt] = (f32x4){0.f, 0.f, 0.f, 0.f};
        { bf16x8 vf[8][4];
#pragma unroll
          for (int u = 0; u < 8; ++u) { const bf16* vblk = vT + ((size_t)((b * NH + h) * GROWS + rs + u)) * (HD * 64) + wsc + 8 * fg;
#pragma unroll
              for (int nt = 0; nt < 4; ++nt) vf[u][nt] = *(const bf16x8*)(vblk + (16 * nt + fr) * 64); }
#pragma unroll
          for (int u = 0; u < 8; ++u) {
              union { u32x4 w; bf16x8 h8; } pf;
              pf.w.x = cvt_pk_bf16(sc[2 * u][0], sc[2 * u][1]); pf.w.y = cvt_pk_bf16(sc[2 * u][2], sc[2 * u][3]);
              pf.w.z = cvt_pk_bf16(sc[2 * u + 1][0], sc[2 * u + 1][1]); pf.w.w = cvt_pk_bf16(sc[2 * u + 1][2], sc[2 * u + 1][3]);
#pragma unroll
              for (int nt = 0; nt < 4; ++nt) o[nt] = __builtin_amdgcn_mfma_f32_16x16x32_bf16(vf[u][nt], pf.h8, o[nt], 0, 0, 0); } }
#pragma unroll
        for (int nt = 0; nt < 4; ++nt) { u32x2 w; w.x = cvt_pk_bf16(o[nt][0] * inv, o[nt][1] * inv); w.y = cvt_pk_bf16(o[nt][2] * inv, o[nt][3] * inv);
            *(u32x2*)(att + tq * CW + h * 64 + 16 * nt + 4 * fg) = w; }
    }
    __syncthreads();
}

__device__ __forceinline__ void side_phase(const Frame& F, const Args& a, const int widx, const int nworkers) {
    attn_phase(F, a, widx, nworkers);
}

__device__ __forceinline__ float row16_sum(float v) {
    v += __builtin_bit_cast(float, __builtin_amdgcn_update_dpp(0, __builtin_bit_cast(int, v), 0xB1, 0xF, 0xF, true));
    v += __builtin_bit_cast(float, __builtin_amdgcn_update_dpp(0, __builtin_bit_cast(int, v), 0x4E, 0xF, 0xF, true));
    v += __builtin_bit_cast(float, __builtin_amdgcn_update_dpp(0, __builtin_bit_cast(int, v), 0x141, 0xF, 0xF, true));
    v += __builtin_bit_cast(float, __builtin_amdgcn_update_dpp(0, __builtin_bit_cast(int, v), 0x140, 0xF, 0xF, true));
    return v;
}
constexpr int CS_R = 8;
constexpr int CS_NCH = 2, CS_NPR = 6;
constexpr int CS_AT = 0, CS_RT = 2304, CS_KHT = 4608, CS_BHT = 6656, CS_VT = 8704  , CS_TT = 10752, CS_AAK = 11264, CS_ARK = 11776, CS_ARB = 12288, CS_PL = 12800, CS_SLOT = 13056;
constexpr int CS_LD = 72;
constexpr int CS_SCR = CS_R * CS_SLOT  , CS_SCRW = 2304 * 2  , CS_FLAG = CS_SCR + CS_NPR * CS_SCRW  ;
__device__ __forceinline__ bf16 f2bf(float f) { return (bf16)cvt_pk_bf16(f, 0.f); }
struct ChainOps { u32x2 a4[4], r4[4], kh[4], bh[4], aak, ark, arb, tt, vb; f32x4 pl[4]; };
__device__ __forceinline__ void chain_load(const LAS unsigned char* sl, int fr, int fg, int c, ChainOps& o) {
    const int o16 = fr * 32 + fg * 8;
    const LAS unsigned char* pa = sl + CS_AT + fr * (CS_LD * 2) + fg * 8; const LAS unsigned char* pr = sl + CS_RT + fr * (CS_LD * 2) + fg * 8;
#pragma unroll
    for (int kq = 0; kq < 4; ++kq) { o.a4[kq] = *(const LAS u32x2*)(pa + 32 * kq); o.r4[kq] = *(const LAS u32x2*)(pr + 32 * kq); }
    o.aak = *(const LAS u32x2*)(sl + CS_AAK + o16); o.ark = *(const LAS u32x2*)(sl + CS_ARK + o16); o.arb = *(const LAS u32x2*)(sl + CS_ARB + o16); o.tt = *(const LAS u32x2*)(sl + CS_TT + o16);
    o.vb = *(const LAS u32x2*)(sl + CS_VT + c * 512 + o16);
#pragma unroll
    for (int mt = 0; mt < 4; ++mt) { o.pl[mt] = *(const LAS f32x4*)(sl + CS_PL + (16 * mt + 4 * fg) * 4);
        o.kh[mt] = *(const LAS u32x2*)(sl + CS_KHT + 512 * mt + o16); o.bh[mt] = *(const LAS u32x2*)(sl + CS_BHT + 512 * mt + o16); }
}
__device__ __forceinline__ f32x4 chain_compute(const ChainOps& o, f32x4 (&zacc)[4]) {
#define CS_M32(A_, B_, C_) __builtin_amdgcn_mfma_f32_16x16x32_bf16(A_, B_, C_, 0, 0, 0)
#define CS_M16(A_, B_, C_) __builtin_amdgcn_mfma_f32_16x16x16bf16_1k(__builtin_bit_cast(s16x4, A_), __builtin_bit_cast(s16x4, B_), C_, 0, 0, 0)
    union { u32x4 w; bf16x8 h8; } zb0, zb1, ap0, ap1, rp0, rp1;
    zb0.w.x = cvt_pk_bf16(zacc[0][0], zacc[0][1]); zb0.w.y = cvt_pk_bf16(zacc[0][2], zacc[0][3]); zb0.w.z = cvt_pk_bf16(zacc[1][0], zacc[1][1]); zb0.w.w = cvt_pk_bf16(zacc[1][2], zacc[1][3]);
    zb1.w.x = cvt_pk_bf16(zacc[2][0], zacc[2][1]); zb1.w.y = cvt_pk_bf16(zacc[2][2], zacc[2][3]); zb1.w.z = cvt_pk_bf16(zacc[3][0], zacc[3][1]); zb1.w.w = cvt_pk_bf16(zacc[3][2], zacc[3][3]);
    ap0.w = (u32x4){o.a4[0].x, o.a4[0].y, o.a4[1].x, o.a4[1].y}; ap1.w = (u32x4){o.a4[2].x, o.a4[2].y, o.a4[3].x, o.a4[3].y};
    rp0.w = (u32x4){o.r4[0].x, o.r4[0].y, o.r4[1].x, o.r4[1].y}; rp1.w = (u32x4){o.r4[2].x, o.r4[2].y, o.r4[3].x, o.r4[3].y};
    const f32x4 zero4 = {0.f, 0.f, 0.f, 0.f};
    f32x4 Wc = CS_M16(o.aak, o.vb, zero4);
    Wc = CS_M32(ap0.h8, zb0.h8, Wc); Wc = CS_M32(ap1.h8, zb1.h8, Wc);
    f32x4 Yc = CS_M16(o.ark, o.vb, zero4);
    Yc = CS_M32(rp0.h8, zb0.h8, Yc); Yc = CS_M32(rp1.h8, zb1.h8, Yc);
    f32x4 zz[4];
#pragma unroll
    for (int mt = 0; mt < 4; ++mt) zz[mt] = CS_M16(o.kh[mt], o.vb, zacc[mt] * o.pl[mt]);
    u32x2 wb, ub;
    wb.x = cvt_pk_bf16(Wc[0], Wc[1]); wb.y = cvt_pk_bf16(Wc[2], Wc[3]);
    const f32x4 Uc = CS_M16(o.tt, wb, zero4);
    ub.x = cvt_pk_bf16(Uc[0], Uc[1]); ub.y = cvt_pk_bf16(Uc[2], Uc[3]);
    Yc = CS_M16(o.arb, ub, Yc);
#pragma unroll
    for (int mt = 0; mt < 4; ++mt) zacc[mt] = CS_M16(o.bh[mt], ub, zz[mt]);
#undef CS_M32
#undef CS_M16
    return Yc;
}
template <int z>
__device__ __forceinline__ void scan_phase_z(const Frame& F, const Args& a, const int seq, const int half) {
    unsigned char* ws = a.ws;
    const int b = (seq >> 3) & 3, h = seq & 7;
    const size_t mb = (size_t)b * T;
    const int lane = F.lane, wave = F.wave, fr = lane & 15, fg = lane >> 4;
    constexpr int NCK = T / 16;
    volatile LAS unsigned* flg = (volatile LAS unsigned*)(F.lds + CS_FLAG);
    if (F.tid < 16) flg[F.tid] = 0u;
    __syncthreads();
    const int o16 = fr * 32 + fg * 8;
#define CS_M32(A_, B_, C_) __builtin_amdgcn_mfma_f32_16x16x32_bf16(A_, B_, C_, 0, 0, 0)
#define CS_M16(A_, B_, C_) __builtin_amdgcn_mfma_f32_16x16x16bf16_1k(__builtin_bit_cast(s16x4, A_), __builtin_bit_cast(s16x4, B_), C_, 0, 0, 0)
    if (wave < CS_NCH) {
        const int c = wave, rg = 2 * half + c;
        __builtin_amdgcn_s_setprio(3);
        bf16* yout = (bf16*)(ws + WS_Y) + (size_t)z * M * CW + h * 64 + rg * 16 + fr;
        f32x4 zacc[4];
#pragma unroll
        for (int mt = 0; mt < 4; ++mt) zacc[mt] = (f32x4){0.f, 0.f, 0.f, 0.f};
        ChainOps opA, opB;
#define CS_READY(nn) do { unsigned sp_ = 0; while (flg[(nn) & (CS_R - 1)] != (unsigned)((nn) + 1)) { __builtin_amdgcn_s_sleep(1); if (++sp_ > (1u << 24)) break; } __builtin_amdgcn_fence(__ATOMIC_ACQUIRE, "workgroup"); } while (0)
#define CS_HANDBACK(nn) do { asm volatile("s_waitcnt lgkmcnt(0)" ::: "memory"); if (lane == 0) flg[8 + c] = (unsigned)((nn) + 1); asm volatile("" ::: "memory"); } while (0)
#define CS_YSTORE(nn, Y_) do { asm volatile("s_waitcnt vmcnt(24)" ::: "memory");   _Pragma("unroll") for (int rr = 0; rr < 4; ++rr) { const int q_ = 16 * (nn) + 4 * fg + rr, t_ = z ? (T - 1 - q_) : q_; yout[(mb + t_) * CW] = f2bf((Y_)[rr]); } } while (0)
        CS_READY(0); chain_load(F.lds, fr, fg, c, opA);
#pragma unroll 1
        for (int n = 0; n < NCK; n += 2) {
            CS_READY(n + 1); CS_HANDBACK(n);
            chain_load(F.lds + ((n + 1) & (CS_R - 1)) * CS_SLOT, fr, fg, c, opB);
            { const f32x4 Yc = chain_compute(opA, zacc); CS_YSTORE(n, Yc); }
            if (n + 2 < NCK) CS_READY(n + 2);
            CS_HANDBACK(n + 1);
            if (n + 2 < NCK) chain_load(F.lds + ((n + 2) & (CS_R - 1)) * CS_SLOT, fr, fg, c, opA);
            { const f32x4 Yc = chain_compute(opB, zacc); CS_YSTORE(n + 1, Yc); }
        }
#undef CS_READY
#undef CS_HANDBACK
#undef CS_YSTORE
        __builtin_amdgcn_s_setprio(0);
    } else {
        const int pi = wave - CS_NCH;
        LAS unsigned char* scr = F.lds + CS_SCR + pi * CS_SCRW;
        LAS bf16* KT = (LAS bf16*)scr; LAS bf16* BT = (LAS bf16*)(scr + 2304);
        const bf16* gw_ = (const bf16*)(ws + WS_DECAY) + (size_t)z * M * CW + h * 64;
        const bf16* gkk = (const bf16*)(ws + WS_KK) + h * 64;
        const bf16* gak = (const bf16*)(ws + WS_AKK) + (size_t)z * M * CW + h * 64;
        const bf16* gk = (const bf16*)(ws + WS_KDIR) + (size_t)z * M * CW + h * 64;
        const bf16* gr = (const bf16*)(ws + WS_R) + h * 64;
        const bf16* gv = (const bf16*)(ws + WS_V) + h * 64 + half * 32 + (lane & 31);
        unsigned nw[16], nkk[16], nak[16], nk[16], nr[16], nv[8];
        constexpr long RSTEP = z ? -(long)CW : (long)CW;
#define CS_FETCH_A(nn) do { if ((nn) < NCK) { const size_t m0_ = (mb + (z ? (T - 1 - 16 * (nn)) : 16 * (nn))) * CW + lane; const bf16* pw_ = gw_ + m0_; const bf16* pkk_ = gkk + m0_; \
            _Pragma("unroll") for (int tt = 0; tt < 16; ++tt) { nw[tt] = pw_[tt * RSTEP]; nkk[tt] = pkk_[tt * RSTEP]; } } } while (0)
#define CS_FETCH_B(nn) do { if ((nn) < NCK) { asm volatile("s_waitcnt vmcnt(30)" ::: "memory"); const size_t m0_ = (mb + (z ? (T - 1 - 16 * (nn)) : 16 * (nn))) * CW + lane; const bf16* pak_ = gak + m0_; const bf16* pk_ = gk + m0_; \
            _Pragma("unroll") for (int tt = 0; tt < 16; ++tt) { nak[tt] = pak_[tt * RSTEP]; nk[tt] = pk_[tt * RSTEP]; } } } while (0)
#define CS_FETCH_C(nn) do { if ((nn) < NCK) { asm volatile("s_waitcnt vmcnt(30)" ::: "memory"); const size_t m0_ = (mb + (z ? (T - 1 - 16 * (nn)) : 16 * (nn))) * CW + lane; const bf16* pr_ = gr + m0_; \
            const bf16* pv_ = gv + (mb + (z ? (T - 1 - 16 * (nn) - 8 * (lane >> 5)) : 16 * (nn) + 8 * (lane >> 5))) * CW; \
            _Pragma("unroll") for (int tt = 0; tt < 16; ++tt) nr[tt] = pr_[tt * RSTEP]; \
            _Pragma("unroll") for (int i_ = 0; i_ < 8; ++i_) nv[i_] = pv_[i_ * RSTEP]; } } while (0)
        CS_FETCH_A(pi); CS_FETCH_B(pi); CS_FETCH_C(pi);
#pragma unroll 1
        for (int n = pi; n < NCK; n += CS_NPR) {
            const int slot = n & (CS_R - 1);
            float wv[16], kkv[16], akv[16], kv[16], rv[16]; unsigned vq[8];
#pragma unroll
            for (int tt = 0; tt < 16; ++tt) { unsigned x0 = nw[tt], x1 = nkk[tt], x2 = nak[tt], x3 = nk[tt], x4 = nr[tt];
                asm volatile("" : "+v"(x0), "+v"(x1), "+v"(x2), "+v"(x3), "+v"(x4));
                wv[tt] = __uint_as_float(x0 << 16); kkv[tt] = __uint_as_float(x1 << 16); akv[tt] = __uint_as_float(x2 << 16); kv[tt] = __uint_as_float(x3 << 16); rv[tt] = __uint_as_float(x4 << 16); }
#pragma unroll
            for (int tt = 0; tt < 8; ++tt) { unsigned x0 = nv[tt]; asm volatile("" : "+v"(x0)); vq[tt] = x0; }
            CS_FETCH_A(n + CS_NPR);
            { unsigned sp = 0; for (;;) { const u32x2 pg = *(const volatile LAS u32x2*)(flg + 8); const int mn = (int)min(pg.x, pg.y);
                  if (mn >= n - (CS_R - 3)) break; __builtin_amdgcn_s_sleep(2); if (++sp > (1u << 24)) break; } }
            __builtin_amdgcn_fence(__ATOMIC_ACQUIRE, "workgroup");
            LAS unsigned char* sl = F.lds + slot * CS_SLOT;
            float P[16];
            P[0] = wv[0];
#pragma unroll
            for (int tt = 1; tt < 16; ++tt) P[tt] = P[tt - 1] * wv[tt];
            const float PL = P[15];
            float khat[16], bhat[16];
#pragma unroll
            for (int tt = 0; tt < 16; ++tt) {
                const float pm1 = tt ? P[tt - 1] : 1.0f, inv = __builtin_amdgcn_rcpf(P[tt]);
                const float at = kkv[tt] * pm1, rt = rv[tt] * P[tt], kt = kv[tt] * inv, bt = -akv[tt] * inv;
                khat[tt] = kt * PL; bhat[tt] = bt * PL;
                { const unsigned w_ = cvt_pk_bf16(at, rt); *(LAS bf16*)(sl + CS_AT + (tt * CS_LD + lane) * 2) = (bf16)w_; *(LAS bf16*)(sl + CS_RT + (tt * CS_LD + lane) * 2) = (bf16)(w_ >> 16); }
                { const unsigned w_ = cvt_pk_bf16(kt, bt); KT[tt * CS_LD + lane] = (bf16)w_; BT[tt * CS_LD + lane] = (bf16)(w_ >> 16); }
            }
            CS_FETCH_B(n + CS_NPR);
            { u32x4 o0, o1;
              o0.x = cvt_pk_bf16(khat[0], khat[1]); o0.y = cvt_pk_bf16(khat[2], khat[3]); o0.z = cvt_pk_bf16(khat[4], khat[5]); o0.w = cvt_pk_bf16(khat[6], khat[7]);
              o1.x = cvt_pk_bf16(khat[8], khat[9]); o1.y = cvt_pk_bf16(khat[10], khat[11]); o1.z = cvt_pk_bf16(khat[12], khat[13]); o1.w = cvt_pk_bf16(khat[14], khat[15]);
              *(LAS u32x4*)(sl + CS_KHT + lane * 32) = o0; *(LAS u32x4*)(sl + CS_KHT + lane * 32 + 16) = o1;
              o0.x = cvt_pk_bf16(bhat[0], bhat[1]); o0.y = cvt_pk_bf16(bhat[2], bhat[3]); o0.z = cvt_pk_bf16(bhat[4], bhat[5]); o0.w = cvt_pk_bf16(bhat[6], bhat[7]);
              o1.x = cvt_pk_bf16(bhat[8], bhat[9]); o1.y = cvt_pk_bf16(bhat[10], bhat[11]); o1.z = cvt_pk_bf16(bhat[12], bhat[13]); o1.w = cvt_pk_bf16(bhat[14], bhat[15]);
              *(LAS u32x4*)(sl + CS_BHT + lane * 32) = o0; *(LAS u32x4*)(sl + CS_BHT + lane * 32 + 16) = o1; }
            *(LAS float*)(sl + CS_PL + lane * 4) = PL;
            { u32x4 o0;
              o0.x = vq[0] | (vq[1] << 16); o0.y = vq[2] | (vq[3] << 16); o0.z = vq[4] | (vq[5] << 16); o0.w = vq[6] | (vq[7] << 16);
              *(LAS u32x4*)(sl + CS_VT + (lane & 31) * 32 + (lane >> 5) * 16) = o0; }
            asm volatile("s_waitcnt lgkmcnt(0)" ::: "memory");
            bf16x8 af[2], rf[2], kf[2], bf_[2];
#pragma unroll
            for (int ks = 0; ks < 2; ++ks) { af[ks] = *(const LAS bf16x8*)(sl + CS_AT + (fr * CS_LD + 32 * ks + 8 * fg) * 2); rf[ks] = *(const LAS bf16x8*)(sl + CS_RT + (fr * CS_LD + 32 * ks + 8 * fg) * 2);
                kf[ks] = *(const LAS bf16x8*)(KT + fr * CS_LD + 32 * ks + 8 * fg); bf_[ks] = *(const LAS bf16x8*)(BT + fr * CS_LD + 32 * ks + 8 * fg); }
            const f32x4 zero4 = {0.f, 0.f, 0.f, 0.f};
            f32x4 Xc = zero4, Xt = zero4, AakT = zero4, ArbT = zero4, ArkT = zero4;
#pragma unroll
            for (int ks = 0; ks < 2; ++ks) { Xc = CS_M32(af[ks], bf_[ks], Xc); Xt = CS_M32(bf_[ks], af[ks], Xt);
                AakT = CS_M32(kf[ks], af[ks], AakT); ArbT = CS_M32(bf_[ks], rf[ks], ArbT); ArkT = CS_M32(kf[ks], rf[ks], ArkT); }
            CS_FETCH_C(n + CS_NPR);
            f32x4 S1;
#pragma unroll
            for (int rr = 0; rr < 4; ++rr) { const int q = 4 * fg + rr;
                Xc[rr] = (fr < q) ? Xc[rr] : 0.f; Xt[rr] = (q < fr) ? Xt[rr] : 0.f; S1[rr] = Xt[rr] + ((q == fr) ? 1.0f : 0.f);
                AakT[rr] = (q < fr) ? AakT[rr] : 0.f; ArkT[rr] = (q <= fr) ? ArkT[rr] : 0.f; ArbT[rr] = (q <= fr) ? ArbT[rr] : 0.f; }
            { u32x2 w; w.x = cvt_pk_bf16(AakT[0], AakT[1]); w.y = cvt_pk_bf16(AakT[2], AakT[3]); *(LAS u32x2*)(sl + CS_AAK + o16) = w;
              w.x = cvt_pk_bf16(ArkT[0], ArkT[1]); w.y = cvt_pk_bf16(ArkT[2], ArkT[3]); *(LAS u32x2*)(sl + CS_ARK + o16) = w;
              w.x = cvt_pk_bf16(ArbT[0], ArbT[1]); w.y = cvt_pk_bf16(ArbT[2], ArbT[3]); *(LAS u32x2*)(sl + CS_ARB + o16) = w; }
#define CS_PK(v) ((u32x2){cvt_pk_bf16((v)[0], (v)[1]), cvt_pk_bf16((v)[2], (v)[3])})
            const u32x2 xc = CS_PK(Xc), xt = CS_PK(Xt), s1 = CS_PK(S1);
            const f32x4 X2c = CS_M16(xt, xc, zero4), X2t = CS_M16(xc, xt, zero4);
            const u32x2 x2c = CS_PK(X2c), x2t = CS_PK(X2t);
            const f32x4 S2 = CS_M16(x2c, s1, S1);
            const f32x4 X4c = CS_M16(x2t, x2c, zero4), X4t = CS_M16(x2c, x2t, zero4);
            const u32x2 x4c = CS_PK(X4c), x4t = CS_PK(X4t), s2 = CS_PK(S2);
            const f32x4 S4 = CS_M16(x4c, s2, S2);
            const f32x4 X8c = CS_M16(x4t, x4c, zero4);
            const u32x2 x8c = CS_PK(X8c), s4 = CS_PK(S4);
            const f32x4 S8 = CS_M16(x8c, s4, S4);
            *(LAS u32x2*)(sl + CS_TT + o16) = CS_PK(S8);
#undef CS_PK
            asm volatile("s_waitcnt lgkmcnt(0)" ::: "memory");
            __builtin_amdgcn_fence(__ATOMIC_RELEASE, "workgroup");
            if (lane == 0) flg[slot] = (unsigned)(n + 1);
        }
#undef CS_FETCH_A
#undef CS_FETCH_B
#undef CS_FETCH_C
    }
#undef CS_M32
#undef CS_M16
    __syncthreads();
}

__device__ __forceinline__ void scan_phase(const Frame& F, const Args& a, const int idx) {
    const int seq = idx >> 1, half = idx & 1;
    if (seq >> 5) scan_phase_z<1>(F, a, seq, half); else scan_phase_z<0>(F, a, seq, half);
}

__device__ __forceinline__ void combine_phase(const Frame& F, const Args& a) {
    unsigned char* ws = a.ws;
    const bf16* att = (const bf16*)(ws + WS_ATT); const bf16* rr = (const bf16*)(ws + WS_R); const bf16* vv = (const bf16*)(ws + WS_V);
    const bf16* kd = (const bf16*)(ws + WS_KDIR); const bf16* gg = (const bf16*)(ws + WS_G); const bf16* y = (const bf16*)(ws + WS_Y);
    bf16* mix = (bf16*)(ws + WS_MIX);
    const float* anw = a.in[4]; const float* r_k = a.in[14]; const float* ln_w = a.in[15]; const float* ln_b = a.in[16];
    const int lane = F.lane, c0 = 8 * lane;
    float nw[8], rk[8], lw[8], lb[8];
#pragma unroll
    for (int i = 0; i < 8; ++i) { nw[i] = anw[c0 + i]; rk[i] = r_k[c0 + i]; lw[i] = ln_w[c0 + i]; lb[i] = ln_b[c0 + i]; }
    const int gw = F.vcu * 8 + F.wave, NGW = F.G * 8;
#pragma unroll 2
    for (int m = gw; m < M; m += NGW) {
        const size_t o = (size_t)m * CW + c0;
        float f[8];
        unpack8(*(const u32x4*)(att + o), f);
        float ss = 0.f;
#pragma unroll
        for (int i = 0; i < 8; ++i) ss += f[i] * f[i];
        const float rs = rsqrtf(wave_sum(ss) * (1.f / CW) + RMS_EPS);
#pragma unroll
        for (int i = 0; i < 8; ++i) f[i] = f[i] * rs * nw[i];
        *(u32x4*)(mix + (size_t)m * D + c0) = pack8(f);
        float yv[8], yw[8];
        unpack8(*(const u32x4*)(y + o), yv); unpack8(*(const u32x4*)(y + (size_t)M * CW + o), yw);
#pragma unroll
        for (int i = 0; i < 8; ++i) yv[i] += yw[i];
        float s1 = 0.f;
#pragma unroll
        for (int i = 0; i < 8; ++i) s1 += yv[i];
        s1 += __shfl_xor(s1, 1); s1 += __shfl_xor(s1, 2); s1 += __shfl_xor(s1, 4);
        const float mean = s1 * (1.f / 64.f);
        float s2 = 0.f;
#pragma unroll
        for (int i = 0; i < 8; ++i) { yv[i] -= mean; s2 += yv[i] * yv[i]; }
        s2 += __shfl_xor(s2, 1); s2 += __shfl_xor(s2, 2); s2 += __shfl_xor(s2, 4);
        const float rstd = rsqrtf(s2 * (1.f / 64.f) + GN_EPS);
        float rf[8], k0[8], k1[8], vf[8], gf[8];
        unpack8(*(const u32x4*)(rr + o), rf); unpack8(*(const u32x4*)(kd + o), k0); unpack8(*(const u32x4*)(kd + (size_t)M * CW + o), k1);
        unpack8(*(const u32x4*)(vv + o), vf); unpack8(*(const u32x4*)(gg + o), gf);
        float cf = 0.f;
#pragma unroll
        for (int i = 0; i < 8; ++i) cf += rf[i] * (k0[i] + k1[i]) * rk[i];
        cf += __shfl_xor(cf, 1); cf += __shfl_xor(cf, 2); cf += __shfl_xor(cf, 4);
#pragma unroll
        for (int i = 0; i < 8; ++i) f[i] = (yv[i] * rstd * lw[i] + lb[i] + cf * vf[i]) * gf[i];
        *(u32x4*)(mix + (size_t)m * D + CW + c0) = pack8(f);
    }
}

constexpr int RT_PITCH = 1032, RT_WH = 0, RT_WL = 32 * RT_PITCH * 2, RT_HIST = 2 * RT_WL, RT_EL = RT_HIST + 256;
__device__ __forceinline__ void router_phase(const Frame& F, const Args& a) {
    unsigned char* ws = a.ws;
    const bf16* hbuf = (const bf16*)(ws + WS_H); unsigned char* hn2 = ws + WS_HN2;
    int* eidx = (int*)(ws + WS_EIDX); float* gate = (float*)(ws + WS_GATE); int* rank = (int*)(ws + WS_RANK);
    unsigned* ctl = (unsigned*)(ws + WS_CTL);
    const float* n2w = a.in[18]; const float* rw = a.in[19]; const float* rb = a.in[20];
    LAS bf16* wh = (LAS bf16*)(F.lds + RT_WH); LAS bf16* wl = (LAS bf16*)(F.lds + RT_WL); LAS int* hist = (LAS int*)(F.lds + RT_HIST); LAS int* eL = (LAS int*)(F.lds + RT_EL);
    { f32x4 tmp[16];
#pragma unroll
      for (int j = 0; j < 16; ++j) tmp[j] = *((const f32x4*)rw + F.tid + 512 * j);
#pragma unroll
      for (int j = 0; j < 16; ++j) { const int q = F.tid + 512 * j, d = q >> 3, e0 = 4 * (q & 7);
#pragma unroll
          for (int i = 0; i < 4; ++i) { const float w = tmp[j][i]; const unsigned hb = cvt_pk_bf16(w, 0.f) & 0xffffu; const float lo = w - __uint_as_float(hb << 16);
              wh[(e0 + i) * RT_PITCH + d] = (bf16)hb; wl[(e0 + i) * RT_PITCH + d] = (bf16)cvt_pk_bf16(lo, 0.f); } } }
    if (F.tid < 32) hist[F.tid] = 0;
    __syncthreads();
    const int lane = F.lane, tk = lane & 15, g = lane >> 4;
    const int blk = F.vcu;
    const int m = blk * 128 + F.wave * 16 + tk;
    const bf16* hrow = hbuf + (size_t)m * D + 8 * g;
    float ss = 0.f;
#pragma unroll 8
    for (int ks = 0; ks < 32; ++ks) { float xf[8]; unpack8(*(const u32x4*)(hrow + 32 * ks), xf);
        ss += (xf[0] * xf[0] + xf[1] * xf[1]) + (xf[2] * xf[2] + xf[3] * xf[3]) + (xf[4] * xf[4] + xf[5] * xf[5]) + (xf[6] * xf[6] + xf[7] * xf[7]); }
    ss += __shfl_xor(ss, 16); ss += __shfl_xor(ss, 32);
    const float rs = rsqrtf(ss * (1.f / D) + RMS_EPS);
    f32x4 acc0 = {0.f, 0.f, 0.f, 0.f}, acc1 = acc0;
    unsigned char* hrow8 = hn2 + (size_t)m * D + 8 * g;
    const LAS bf16* wh0 = wh + tk * RT_PITCH + 8 * g; const LAS bf16* wl0 = wl + tk * RT_PITCH + 8 * g;
#pragma unroll 4
    for (int ks = 0; ks < 32; ++ks) {
        float xf[8]; unpack8(*(const u32x4*)(hrow + 32 * ks), xf);
        const f32x4 x0 = {xf[0], xf[1], xf[2], xf[3]}, x1 = {xf[4], xf[5], xf[6], xf[7]};
        const f32x4 n0 = *(const f32x4*)(n2w + 32 * ks + 8 * g), n1 = *(const f32x4*)(n2w + 32 * ks + 8 * g + 4);
        const f32x4 y0 = x0 * rs * n0, y1 = x1 * rs * n1;
        { u32x2 w8; w8.x = pk4_fp8(y0.x * F8_SX, y0.y * F8_SX, y0.z * F8_SX, y0.w * F8_SX); w8.y = pk4_fp8(y1.x * F8_SX, y1.y * F8_SX, y1.z * F8_SX, y1.w * F8_SX); *(u32x2*)(hrow8 + 32 * ks) = w8; }
        union { u32x4 w; bf16x8 h8; } xh, xl;
        xh.w.x = cvt_pk_bf16(y0.x, y0.y); xh.w.y = cvt_pk_bf16(y0.z, y0.w); xh.w.z = cvt_pk_bf16(y1.x, y1.y); xh.w.w = cvt_pk_bf16(y1.z, y1.w);
        xl.w.x = cvt_pk_bf16(y0.x - bflo(xh.w.x), y0.y - bfhi(xh.w.x)); xl.w.y = cvt_pk_bf16(y0.z - bflo(xh.w.y), y0.w - bfhi(xh.w.y));
        xl.w.z = cvt_pk_bf16(y1.x - bflo(xh.w.z), y1.y - bfhi(xh.w.z)); xl.w.w = cvt_pk_bf16(y1.z - bflo(xh.w.w), y1.w - bfhi(xh.w.w));
        const bf16x8 a0h = *(const LAS bf16x8*)(wh0 + 32 * ks), a1h = *(const LAS bf16x8*)(wh0 + 16 * RT_PITCH + 32 * ks);
        const bf16x8 a0l = *(const LAS bf16x8*)(wl0 + 32 * ks), a1l = *(const LAS bf16x8*)(wl0 + 16 * RT_PITCH + 32 * ks);
        acc0 = __builtin_amdgcn_mfma_f32_16x16x32_bf16(a0h, xh.h8, acc0, 0, 0, 0); acc1 = __builtin_amdgcn_mfma_f32_16x16x32_bf16(a1h, xh.h8, acc1, 0, 0, 0);
        acc0 = __builtin_amdgcn_mfma_f32_16x16x32_bf16(a0h, xl.h8, acc0, 0, 0, 0); acc1 = __builtin_amdgcn_mfma_f32_16x16x32_bf16(a1h, xl.h8, acc1, 0, 0, 0);
        acc0 = __builtin_amdgcn_mfma_f32_16x16x32_bf16(a0l, xh.h8, acc0, 0, 0, 0); acc1 = __builtin_amdgcn_mfma_f32_16x16x32_bf16(a1l, xh.h8, acc1, 0, 0, 0);
    }
    float lv[8]; int li[8];
    { const f32x4 b0 = *(const f32x4*)(rb + 4 * g), b1 = *(const f32x4*)(rb + 16 + 4 * g);
#pragma unroll
      for (int i = 0; i < 4; ++i) { lv[i] = acc0[i] + b0[i]; li[i] = 4 * g + i; lv[4 + i] = acc1[i] + b1[i]; li[4 + i] = 16 + 4 * g + i; } }
    float tv[4]; int ti[4];
#pragma unroll
    for (int kx = 0; kx < 4; ++kx) {
        float bv = lv[0]; int bi = li[0];
#pragma unroll
        for (int i = 1; i < 8; ++i) { const bool gt = lv[i] > bv; bv = gt ? lv[i] : bv; bi = gt ? li[i] : bi; }
#pragma unroll
        for (int o = 16; o < 64; o <<= 1) { const float ov = __shfl_xor(bv, o); const int oi = __shfl_xor(bi, o); const bool tko = (ov > bv) || (ov == bv && oi < bi); bv = tko ? ov : bv; bi = tko ? oi : bi; }
        tv[kx] = bv; ti[kx] = bi;
#pragma unroll
        for (int i = 0; i < 8; ++i) lv[i] = (li[i] == bi) ? -3.0e38f : lv[i];
    }
    if (g == 0) {
        const float e0 = 1.0f, e1 = __expf(tv[1] - tv[0]), e2 = __expf(tv[2] - tv[0]), e3 = __expf(tv[3] - tv[0]);
        const float is = 1.0f / (e0 + e1 + e2 + e3);
        const float gs[4] = {e0 * is, e1 * is, e2 * is, e3 * is};
#pragma unroll
        for (int kx = 0; kx < 4; ++kx) { eidx[m * 4 + kx] = ti[kx]; gate[m * 4 + kx] = gs[kx]; eL[(m - blk * 128) * 4 + kx] = ti[kx]; }
    }
    __syncthreads();
    { const int t = F.tid, e = eL[t]; int rk = 0;
      for (int u = 0; u < t; ++u) rk += (eL[u] == e) ? 1 : 0;
      rank[(blk * 128) * 4 + t] = rk;
      __hip_atomic_fetch_add(&hist[e], 1, __ATOMIC_RELAXED, __HIP_MEMORY_SCOPE_WORKGROUP); }
    __syncthreads();
    if (F.tid < 32) ctl[CW_CNT + blk * 32 + F.tid] = (unsigned)hist[F.tid];
}

__device__ __forceinline__ void dispatch_phase(const Frame& F, const Args& a) {
    unsigned char* ws = a.ws;
    unsigned* ctl = (unsigned*)(ws + WS_CTL);
    const int* eidx = (const int*)(ws + WS_EIDX); const int* rank = (const int*)(ws + WS_RANK); int* dest = (int*)(ws + WS_DEST);
    LAS int* part = (LAS int*)F.lds;
    LAS int* tot = part + 1024;
    const int blk = F.vcu, G = F.G;
    { const int e = F.tid & 31, pt = F.tid >> 5; int s = 0, sb = 0;
      if (G == 256) { int cv[16];
#pragma unroll
          for (int q = 0; q < 16; ++q) cv[q] = (int)ld_u32_agent(ctl + CW_CNT + (pt + 16 * q) * 32 + e);
#pragma unroll
          for (int q = 0; q < 16; ++q) { s += cv[q]; if (pt + 16 * q < blk) sb += cv[q]; } }
      else for (int bb = pt; bb < G; bb += 16) { const int cval = (int)ld_u32_agent(ctl + CW_CNT + bb * 32 + e); s += cval; if (bb < blk) sb += cval; }
      part[pt * 32 + e] = s; part[512 + pt * 32 + e] = sb; }
    __syncthreads();
    if (F.tid < 32) { int s = 0, sb = 0;
        for (int pt = 0; pt < 16; ++pt) { s += part[pt * 32 + F.tid]; sb += part[512 + pt * 32 + F.tid]; }
        tot[F.tid] = s; tot[32 + F.tid] = sb; tot[96 + F.tid] = (s + 255) & ~255; }
    __syncthreads();
    if (F.tid == 0) { int ps = 0; for (int e = 0; e < 32; ++e) { tot[64 + e] = ps; ps += tot[96 + e]; }
        tot[128] = ps >> 8; }
    __syncthreads();
    if (blk == 0) {
        if (F.tid == 0) ctl[CW_NT] = (unsigned)tot[128];
        for (int e = F.tid >> 4; e < 32; e += 32) { const int t0 = tot[64 + e] >> 8, nt = tot[96 + e] >> 8; for (int i = F.tid & 15; i < nt; i += 16) ctl[CW_TEXP + t0 + i] = (unsigned)e; }
    }
    const int lane = F.lane;
    const int mw = blk * 128 + F.wave * 16;
    int* rowtok = (int*)(ws + WS_ROWTOK);
    { const int e = eidx[mw * 4 + lane]; const int dl = tot[64 + e] + tot[32 + e] + rank[mw * 4 + lane]; dest[mw * 4 + lane] = dl; rowtok[dl] = mw + (lane >> 2); }
    { const int e = blk & 31, pt = blk >> 5, np = G >> 5; const int r0 = tot[64 + e] + tot[e], r1 = tot[64 + e] + tot[96 + e];
      if (np > 0) for (int r = r0 + pt * 512 + F.tid; r < r1; r += np * 512) rowtok[r] = 0; }
}

__device__ __forceinline__ void final_phase(const Frame& F, const Args& a) {
    unsigned char* ws = a.ws;
    const bf16* hbuf = (const bf16*)(ws + WS_H); const unsigned char* ybuf = ws + WS_YBUF;
    const int* dest = (const int*)(ws + WS_DEST); const float* gate = (const float*)(ws + WS_GATE);
    const float* fw = a.in[25]; float* out = a.out;
    const int lane = F.lane;
    f32x4 wn[4];
#pragma unroll
    for (int j = 0; j < 4; ++j) wn[j] = *((const f32x4*)fw + lane + 64 * j);
    const int gw = F.vcu * 8 + F.wave, NGW = F.G * 8;
    const int per = M / NGW;
    const int mw = gw * per;
    int dl = 0; float gl = 0.f;
    if (lane < 4 * per && per <= 16) { dl = dest[mw * 4 + lane]; gl = gate[mw * 4 + lane]; }
#pragma unroll 2
    for (int i = 0; i < per; ++i) {
        const int m = mw + i;
        const u32x2* hr = (const u32x2*)(hbuf + (size_t)m * D) + lane;
        f32x4 v[4];
#pragma unroll
        for (int j = 0; j < 4; ++j) { const u32x2 w = hr[64 * j]; v[j] = (f32x4){bflo(w.x), bfhi(w.x), bflo(w.y), bfhi(w.y)}; }
#pragma unroll
        for (int kx = 0; kx < 4; ++kx) {
            const int d = per <= 16 ? __shfl(dl, 4 * i + kx) : dest[m * 4 + kx]; const float gt = (per <= 16 ? __shfl(gl, 4 * i + kx) : gate[m * 4 + kx]) * (1.0f / F8_SY);
            const unsigned* yr = (const unsigned*)(ybuf + (size_t)d * D) + lane;
#pragma unroll
            for (int j = 0; j < 4; ++j) { const unsigned w = yr[64 * j]; const f32x2 lo = __builtin_amdgcn_cvt_pk_f32_fp8((int)w, false), hi = __builtin_amdgcn_cvt_pk_f32_fp8((int)w, true);
                v[j].x += gt * lo.x; v[j].y += gt * lo.y; v[j].z += gt * hi.x; v[j].w += gt * hi.y; }
        }
        float s = 0.f;
#pragma unroll
        for (int j = 0; j < 4; ++j) s += (v[j].x * v[j].x + v[j].y * v[j].y) + (v[j].z * v[j].z + v[j].w * v[j].w);
        const float rs = rsqrtf(wave_sum(s) * (1.f / D) + RMS_EPS);
        f32x4* orow = (f32x4*)(out + (size_t)m * D) + lane;
#pragma unroll
        for (int j = 0; j < 4; ++j) orow[64 * j] = v[j] * rs * wn[j];
    }
}

__global__ void __launch_bounds__(512, 2) fwd_megakernel(Args args) {
    extern __shared__ __attribute__((aligned(16))) unsigned char lds_raw[];
    Frame F;
    F.lds = (LAS unsigned char*)lds_raw;
    F.tid = threadIdx.x; F.lane = F.tid & 63; F.wave = __builtin_amdgcn_readfirstlane(F.tid >> 6);
    F.G = gridDim.x; { const int bx = blockIdx.x; F.vcu = (F.G % 8 == 0) ? (bx % 8) * (F.G / 8) + bx / 8 : bx; }
    unsigned char* ws = args.ws;
    const int lo = args.ph_lo, hi = args.ph_hi;
#define IN(k) (lo <= (k) && (k) < hi)
#if MK_SPLIT
#define SEAM(k) do { } while (0)
#else
    cg::grid_group grid = cg::this_grid();
    { volatile LAS unsigned* st = (volatile LAS unsigned*)(F.lds + LDS_MISC); if (F.tid < 2) st[F.tid] = 0u; __syncthreads(); }
    const XcdBarrier xbar = xcd_barrier_post((unsigned*)(ws + WS_CTL) + CW_BAR, (volatile LAS unsigned*)(F.lds + LDS_MISC));
    if (lo < 0) grid.sync();
#define SEAM(k) do { if (IN(k) && IN((k) + 1)) xcd_barrier(xbar); } while (0)
#endif
#define REP2(k) if constexpr (((MK_REPEAT >> (k)) & 1) != 0)
#define PH1 { pg8::Gemm g{(const bf16*)(ws + WS_HN), (const bf16*)(ws + WS_WINT), 1024, nullptr, 0, nullptr}; \
        pg8::StaticOrder S; S.init(M / 256, NPROJ_PAD / 256, F.G, (int)blockIdx.x); \
        pg8::EpiProj E{(bf16*)(ws + WS_Q), (bf16*)(ws + WS_K), (bf16*)(ws + WS_VT), (bf16*)(ws + WS_P)}; \
        pg8::gemm_phase<pg8::EpiProj, true, true>(F.lds, g, S, E); }
#define PH5 { pg8::Gemm g{(const bf16*)(ws + WS_MIX), (const bf16*)(ws + WS_WOT), 1024, nullptr, 0, nullptr}; \
        pg8::StaticOrder S; S.init(M / 256, D / 256, F.G, (int)blockIdx.x); \
        pg8::EpiWo E{args.in[0], (bf16*)(ws + WS_H)}; \
        pg8::gemm_phase<pg8::EpiWo, true, true>(F.lds, g, S, E); }
#define PH8 { const unsigned* ctl = (const unsigned*)(ws + WS_CTL); const int ntile = (int)ld_u32_agent(ctl + CW_NT); \
        pg8::Gemm g{(const bf16*)(ws + WS_HN2), (const bf16*)(ws + WS_WUPT), 512, ctl + CW_TEXP, (size_t)2048 * 1024, (const int*)(ws + WS_ROWTOK)}; \
        pg8::StaticOrder S; S.init(ntile, 8, F.G, (int)blockIdx.x); \
        pg8::EpiUp E{args.in[22], ws + WS_ACT}; \
        pg8::gemm_phase<pg8::EpiUp, true, true, true, true>(F.lds, g, S, E); }
#define PH9 { const unsigned* ctl = (const unsigned*)(ws + WS_CTL); const int ntile = (int)ld_u32_agent(ctl + CW_NT); \
        pg8::Gemm g{(const bf16*)(ws + WS_ACT), (const bf16*)(ws + WS_WDNT), 512, ctl + CW_TEXP, (size_t)1024 * 1024, nullptr}; \
        pg8::StaticOrder S; S.init(ntile, 4, F.G, (int)blockIdx.x); \
        pg8::EpiDown E{args.in[24], ws + WS_YBUF}; \
        pg8::gemm_phase<pg8::EpiDown, true, true, false, true>(F.lds, g, S, E); }
    if (IN(0)) { p0_prologue(F, args); REP2(0) p0_prologue(F, args); }
    SEAM(0);
    if (IN(1)) { PH1 REP2(1) PH1 }
    SEAM(1);
    if (IN(2)) { prep_phase<true>(F, args); REP2(2) prep_phase<true>(F, args); }
    SEAM(2);
    if (IN(3)) {
        if ((F.vcu & 1) == 0 && (F.vcu >> 1) < 128) { scan_phase(F, args, F.vcu >> 1); REP2(3) scan_phase(F, args, F.vcu >> 1); }
        else { const int nside = F.G - min((F.G + 1) / 2, 128); const int q_ = min((F.vcu + 1) >> 1, 128); side_phase(F, args, F.vcu - q_, nside); REP2(11) side_phase(F, args, F.vcu - q_, nside); }
    }
    SEAM(3);
    if (IN(4)) { combine_phase(F, args); REP2(4) combine_phase(F, args); }
    SEAM(4);
    if (IN(5)) { PH5 REP2(5) PH5 }
    SEAM(5);
    if (IN(6)) { router_phase(F, args); REP2(6) { __syncthreads(); router_phase(F, args); } }
    SEAM(6);
    if (IN(7)) { dispatch_phase(F, args); REP2(7) { __syncthreads(); dispatch_phase(F, args); } }
    SEAM(7);
    if (IN(8)) { PH8 REP2(8) PH8 }
    SEAM(8);
    if (IN(9)) { PH9 REP2(9) PH9 }
    SEAM(9);
    if (IN(10)) { final_phase(F, args); REP2(10) final_phase(F, args); }
#undef IN
#undef SEAM
}

extern "C" void kernel_launch(void* const* d_in, const int* in_sizes, int n_in, void* d_out, int out_size, void* d_ws, size_t ws_size, hipStream_t stream) {
    static int grid = 0;
    if (grid == 0) {
        if (n_in != 26 || in_sizes[0] != M * D || out_size != M * D || ws_size < WS_END) { fprintf(stderr, "kernel_launch: unexpected problem (n_in %d, in0 %d, out %d, ws %zu)\n", n_in, n_in > 0 ? in_sizes[0] : -1, out_size, ws_size); grid = -1; return; }
        int dev = 0, cus = 0, per_cu = 0;
        if (hipGetDevice(&dev) != hipSuccess || hipDeviceGetAttribute(&cus, hipDeviceAttributeMultiprocessorCount, dev) != hipSuccess) { grid = -1; return; }
        if (hipFuncSetAttribute((const void*)fwd_megakernel, hipFuncAttributeMaxDynamicSharedMemorySize, LDS_BYTES) != hipSuccess) { fprintf(stderr, "kernel_launch: hipFuncSetAttribute failed\n"); grid = -1; return; }
        if (hipOccupancyMaxActiveBlocksPerMultiprocessor(&per_cu, (const void*)fwd_megakernel, 512, LDS_BYTES) != hipSuccess || per_cu < 1) { fprintf(stderr, "kernel_launch: occupancy query says %d\n", per_cu); per_cu = 1; }
        (void)hipGetLastError();
        grid = cus * 1;
        if (grid != 256) fprintf(stderr, "kernel_launch: note: %d CUs\n", cus);
    }
    if (grid < 0) return;
    if (hipMemsetAsync((char*)d_ws + WS_CTL + (size_t)CW_BAR * 4, 0, XCD_BAR_WORDS * 4, stream) != hipSuccess) { fprintf(stderr, "kernel_launch: memset failed\n"); return; }
    Args a{};
    for (int i = 0; i < 26; ++i) a.in[i] = (const float*)d_in[i];
    a.out = (float*)d_out; a.ws = (unsigned char*)d_ws;
#if MK_SPLIT
    for (int ph = 0; ph < NPHASE; ++ph) { a.ph_lo = ph; a.ph_hi = ph + 1; hipLaunchKernelGGL(fwd_megakernel, dim3(grid), dim3(512), LDS_BYTES, stream, a); }
#else
    a.ph_lo = 0; a.ph_hi = NPHASE;
    void* kargs[] = {&a};
    hipError_t e = hipLaunchCooperativeKernel((const void*)fwd_megakernel, dim3(grid), dim3(512), kargs, LDS_BYTES, stream);
    if (e != hipSuccess) fprintf(stderr, "kernel_launch: cooperative launch failed: %s (grid %d)\n", hipGetErrorString(e), grid);
#endif
}
```

```cpp
#include <hip/hip_runtime.h>
#include <hip/hip_cooperative_groups.h>
#include <cstdio>
#include <cstdint>
namespace cg = cooperative_groups;

#ifndef MK_SPLIT
#define MK_SPLIT 0
#endif

#ifndef MK_REPEAT
#define MK_REPEAT 0
#endif
#define LAS __attribute__((address_space(3)))
typedef unsigned short bf16;
typedef float f32x4 __attribute__((ext_vector_type(4)));
typedef float f32x2 __attribute__((ext_vector_type(2)));
typedef unsigned u32x4 __attribute__((ext_vector_type(4)));
typedef unsigned u32x2 __attribute__((ext_vector_type(2)));
typedef short bf16x8 __attribute__((ext_vector_type(8)));
typedef short s16x4 __attribute__((ext_vector_type(4)));

constexpr int BATCH = 4, T = 8192, D = 1024, M = BATCH * T;
constexpr int NH = 8, HD = 64, CW = 512;
constexpr int SHIFT_W = 1920, NPROJ = 3456, NPROJ_PAD = 3584, PW = 2048;
constexpr int NE = 32, TOPK = 4, DE = 1024;
constexpr int GRIDW = 64, GROWS = 128;
constexpr int P_TILES_MAX = 544, P_ROWS = P_TILES_MAX * 256;
constexpr float RMS_EPS = 1e-5f, GN_EPS = 64e-5f;
constexpr int NPHASE = 11;

constexpr size_t MiB = 1u << 20;
constexpr size_t WS_CTL = 0;
constexpr size_t WS_W2T = 1 * MiB, WS_A2T = WS_W2T + 131072, WS_G2T = WS_A2T + 131072;
constexpr size_t WS_WINT = 2 * MiB, WS_WOT = 9 * MiB, WS_WUPT = 12 * MiB, WS_WDNT = 140 * MiB;
constexpr size_t WS_EIDX = 204 * MiB, WS_GATE = WS_EIDX + 524288, WS_RANK = WS_GATE + 524288, WS_DEST = WS_RANK + 524288, WS_ROWTOK = WS_DEST + 524288;
constexpr size_t WS_R = 208 * MiB, WS_V = 240 * MiB, WS_KK = 272 * MiB, WS_DECAY = 304 * MiB, WS_KDIR = 368 * MiB, WS_AKK = 432 * MiB,
                 WS_G = 496 * MiB, WS_ATT = 528 * MiB;
constexpr size_t WS_Q = 560 * MiB, WS_K = 592 * MiB, WS_VT = 624 * MiB, WS_P = 656 * MiB, WS_HN = 784 * MiB, WS_Y = 848 * MiB;
constexpr size_t WS_MIX = 560 * MiB, WS_H = 752 * MiB, WS_HN2 = 880 * MiB, WS_XBUF = 208 * MiB, WS_ACT = 480 * MiB, WS_YBUF = 208 * MiB;
constexpr size_t WS_END = 976 * MiB;
constexpr int CW_NT = 0, CW_TEXP = 64, CW_CNT = 1024, CW_BAR = 16384;

constexpr int LDS_BYTES = 159744, LDS_MISC = LDS_BYTES - 256;

typedef __bf16 bf16x2_t __attribute__((ext_vector_type(2)));
__device__ __forceinline__ unsigned cvt_pk_bf16(float lo, float hi) { const f32x2 v = {lo, hi}; return __builtin_bit_cast(unsigned, __builtin_convertvector(v, bf16x2_t)); }
typedef int i32x8 __attribute__((ext_vector_type(8)));
typedef int i32x4 __attribute__((ext_vector_type(4)));
#ifndef F8_SCALE1
#define F8_SCALE1 0
#endif
constexpr float F8_SX = 32.0f, F8_SW = 128.0f, F8_SACT = 8.0f, F8_SY = 32.0f;
__device__ __forceinline__ float f8clamp(float v) { return __builtin_amdgcn_fmed3f(v, -448.0f, 448.0f); }
__device__ __forceinline__ unsigned pk4_fp8(float a, float b, float c, float d) { int w = 0; w = __builtin_amdgcn_cvt_pk_fp8_f32(f8clamp(a), f8clamp(b), w, false); w = __builtin_amdgcn_cvt_pk_fp8_f32(f8clamp(c), f8clamp(d), w, true); return (unsigned)w; }
__device__ __forceinline__ float bflo(unsigned u) { return __uint_as_float(u << 16); }
__device__ __forceinline__ float bfhi(unsigned u) { return __uint_as_float(u & 0xffff0000u); }
__device__ __forceinline__ float bf1(bf16 v) { return __uint_as_float(((unsigned)v) << 16); }
__device__ __forceinline__ void unpack8(const u32x4 u, float* f) { f[0] = bflo(u.x); f[1] = bfhi(u.x); f[2] = bflo(u.y); f[3] = bfhi(u.y); f[4] = bflo(u.z); f[5] = bfhi(u.z); f[6] = bflo(u.w); f[7] = bfhi(u.w); }
__device__ __forceinline__ u32x4 pack8(const float* f) { u32x4 o; o.x = cvt_pk_bf16(f[0], f[1]); o.y = cvt_pk_bf16(f[2], f[3]); o.z = cvt_pk_bf16(f[4], f[5]); o.w = cvt_pk_bf16(f[6], f[7]); return o; }
__device__ __forceinline__ float wave_sum(float v) {
#pragma unroll
    for (int o = 1; o < 64; o <<= 1) v += __shfl_xor(v, o);
    return v;
}
__device__ __forceinline__ float sigmoidf_(float x) { return __builtin_amdgcn_rcpf(1.0f + __expf(-x)); }
__device__ __forceinline__ unsigned ld_u32_agent(const unsigned* p) { return __hip_atomic_load(p, __ATOMIC_RELAXED, __HIP_MEMORY_SCOPE_AGENT); }

namespace pg8 {
constexpr int BM = 256, BK = 64, HALF = 128, HTB = HALF * BK * 2, STAGE_BYTES = 8 * HTB, NXCD = 8, WGM = 8;
__host__ __device__ __forceinline__ int lds_byte(int r, int c) { const int st = (r >> 4) * 2 + (c >> 5), rr = r & 15, cc = c & 31, ob = rr * 64 + cc * 2; return st * 1024 + (ob ^ (((ob >> 9) & 1) << 5)); }
__host__ __device__ __forceinline__ void stage_rc(int b, int& R, int& C) { const int st = b / 1024, sb = b % 1024, swz = sb ^ (((sb >> 9) & 1) << 5); R = (st >> 1) * 16 + swz / 64; C = (st & 1) * 32 + (swz % 64) / 2; }
__host__ __device__ __forceinline__ int perm32(int rho) { const int n = rho >> 4, i = rho & 15; return 8 * (i >> 2) + 4 * n + (i & 3); }

struct Unit { int pm, pn, e; };
struct Gemm { const bf16* A; const bf16* Bt; int K; const unsigned* texp; size_t bstride; const int* rowtok; };

struct StaticOrder {
    int nM, nN, nwg, G, c;
    __device__ void init(int nM_, int nN_, int G_, int c_) { nM = nM_; nN = nN_; nwg = nM * nN; G = G_; c = c_; }
    __device__ bool next(int i, Unit& u) const {
        const long L = (long)i * G + c; if (L >= nwg) return false;
        int wgid = (int)L; { const int q = nwg / NXCD, r = nwg % NXCD, xcd = wgid % NXCD, off = wgid / NXCD; wgid = (xcd < r ? xcd * (q + 1) : r * (q + 1) + (xcd - r) * q) + off; }
        const int nig = WGM * nN, gid = wgid / nig, fm = gid * WGM, gsz = (nM - fm) < WGM ? (nM - fm) : WGM;
        u.pm = fm + ((wgid % nig) % gsz); u.pn = (wgid % nig) / gsz; u.e = 0; return true;
    }
};

__device__ __forceinline__ i32x8 cat8(const bf16x8 lo, const bf16x8 hi) { return __builtin_shufflevector(__builtin_bit_cast(i32x4, lo), __builtin_bit_cast(i32x4, hi), 0, 1, 2, 3, 4, 5, 6, 7); }
template <class Epi, bool ALIGN_EPI, bool SP2, bool GATHER = false, bool FP8 = false>
__device__ __forceinline__ void gemm_phase(LAS unsigned char* lds, const Gemm g, const StaticOrder& S, const Epi& E) {
    const int tid = threadIdx.x, wid = __builtin_amdgcn_readfirstlane(tid >> 6), lane = tid & 63, wr = wid >> 2, wc = wid & 3, fr = lane & 15, fq = lane >> 4;
    const int K = g.K, nt = K / BK;
    unsigned voffA[2], voffB[2];
#pragma unroll
    for (int i = 0; i < 2; ++i) { int R, C; stage_rc(tid * 16 + i * 8192, R, C); const int Rb = Epi::PERM ? ((R & ~31) + perm32(R & 31)) : R;
        voffA[i] = (unsigned)(R * K + C) * 2u; voffB[i] = (unsigned)(Rb * K + C) * 2u; }
    unsigned vC[2][2];
#define PG8_GROWS(u, dst) do { _Pragma("unroll") for (int h_ = 0; h_ < 2; ++h_) _Pragma("unroll") for (int i_ = 0; i_ < 2; ++i_) { int R_, C_; stage_rc(tid * 16 + i_ * 8192, R_, C_); \
        dst[h_][i_] = (unsigned)g.rowtok[(u).pm * BM + h_ * HALF + R_] * (unsigned)(K * 2) + (unsigned)(C_ * 2); } } while (0)
    const size_t kstep = (size_t)(BK * 2);
    const size_t hstep = (size_t)HALF * K * 2;
    const size_t tstep = 2 * hstep;
    const unsigned ldsw = (unsigned)wid * 1024u;
    const int aoff = lds_byte(wr * 64 + fr, fq * 8), boff = lds_byte(wc * 32 + fr, fq * 8);
#define PG8_SA(b, h) (((b) * 2 + (h)) * HTB)
#define PG8_SB(b, h) ((4 + (b) * 2 + (h)) * HTB)
#define PG8_STAGE(bufoff, gbase, voff) do { _Pragma("unroll") for (int _i = 0; _i < 2; ++_i) \
        __builtin_amdgcn_global_load_lds((const unsigned*)((const char*)(gbase) + (voff)[_i]), (LAS unsigned*)(lds + (bufoff) + ldsw + _i * 8192), 16, 0, 0); } while (0)
#define PG8_STAGE_A(bufoff, p, h, nx) do { if constexpr (GATHER) { PG8_STAGE(bufoff, p, vC[h]); } else PG8_STAGE(bufoff, (p) + (h) * hstep, voffA); } while (0)
#define PG8_LDA(dst, b, h) do { _Pragma("unroll") for (int m = 0; m < 4; ++m) _Pragma("unroll") for (int k = 0; k < 2; ++k) dst[m][k] = *(const LAS bf16x8*)(lds + PG8_SA(b, h) + aoff + m * 2048 + k * 1024); } while (0)
#define PG8_LDB(dst, b, h) do { _Pragma("unroll") for (int n = 0; n < 2; ++n) _Pragma("unroll") for (int k = 0; k < 2; ++k) dst[n][k] = *(const LAS bf16x8*)(lds + PG8_SB(b, h) + boff + n * 2048 + k * 1024); } while (0)
#define PG8_MMA(ai, bj, At, Bt) do { __builtin_amdgcn_s_setprio(1); \
        if constexpr (FP8) { _Pragma("unroll") for (int m = 0; m < 4; ++m) _Pragma("unroll") for (int n = 0; n < 2; ++n) \
            { const i32x8 b8_ = cat8(Bt[n][0], Bt[n][1]), a8_ = cat8(At[m][0], At[m][1]); asm volatile("v_mfma_f32_16x16x128_f8f6f4 %0, %1, %2, %0" : "+v"(acc[ai][bj][m][n]) : "v"(b8_), "v"(a8_)); } } \
        else { _Pragma("unroll") for (int m = 0; m < 4; ++m) _Pragma("unroll") for (int n = 0; n < 2; ++n) _Pragma("unroll") for (int k = 0; k < 2; ++k) \
            acc[ai][bj][m][n] = __builtin_amdgcn_mfma_f32_16x16x32_bf16(Bt[n][k], At[m][k], acc[ai][bj][m][n], 0, 0, 0); } \
        __builtin_amdgcn_s_setprio(0); } while (0)
#define PG8_WAIT_V(n) asm volatile("s_waitcnt vmcnt(" #n ")" ::: "memory")
#define PG8_WAIT_L(n) asm volatile("s_waitcnt lgkmcnt(" #n ")" ::: "memory")
#define PG8_BAR __builtin_amdgcn_s_barrier()
#define PG8_SCHED __builtin_amdgcn_sched_barrier(0)
#define PG8_UPTR(u, pa, pb) do { unsigned _e = g.texp ? ld_u32_agent(g.texp + (u).pm) : 0u; _e = (unsigned)__builtin_amdgcn_readfirstlane((int)_e); (u).e = (int)_e; \
        pa = GATHER ? (const char*)g.A : (const char*)g.A + (size_t)(u).pm * tstep; pb = (const char*)g.Bt + (size_t)_e * g.bstride + (size_t)(u).pn * tstep; } while (0)
    Unit cur, nxt; int ui = 0;
    if (!S.next(0, cur)) return;
    f32x4 acc[2][2][4][2];
#pragma unroll
    for (int a = 0; a < 2; ++a)
#pragma unroll
        for (int b = 0; b < 2; ++b)
#pragma unroll
            for (int m = 0; m < 4; ++m)
#pragma unroll
                for (int n = 0; n < 2; ++n) acc[a][b][m][n] = (f32x4){0.f, 0.f, 0.f, 0.f};
    bf16x8 At[4][2], B0[2][2], B1[2][2];
    const char* cA; const char* cB;
    PG8_UPTR(cur, cA, cB);
    if constexpr (GATHER) { PG8_GROWS(cur, vC); }
    if constexpr (SP2) {
        PG8_STAGE(PG8_SB(0, 0), cB, voffB); PG8_STAGE(PG8_SB(0, 1), cB + hstep, voffB); PG8_STAGE_A(PG8_SA(0, 0), cA, 0, false); PG8_STAGE_A(PG8_SA(0, 1), cA, 1, false);
        if (wr == 1) PG8_BAR;
        PG8_WAIT_V(2); PG8_BAR;
        PG8_STAGE(PG8_SB(1, 0), cB + kstep, voffB); PG8_STAGE_A(PG8_SA(1, 0), cA + kstep, 0, false); PG8_STAGE(PG8_SB(1, 1), cB + hstep + kstep, voffB);
        PG8_WAIT_V(6); PG8_BAR;
    } else {
        PG8_STAGE(PG8_SB(0, 0), cB, voffB); PG8_STAGE_A(PG8_SA(0, 0), cA, 0, false); PG8_STAGE(PG8_SB(0, 1), cB + hstep, voffB); PG8_STAGE_A(PG8_SA(0, 1), cA, 1, false);
        if (wr == 1) PG8_BAR;
        PG8_WAIT_V(4); PG8_BAR;
        PG8_STAGE(PG8_SB(1, 0), cB + kstep, voffB); PG8_STAGE_A(PG8_SA(1, 0), cA + kstep, 0, false); PG8_STAGE(PG8_SB(1, 1), cB + hstep + kstep, voffB);
        PG8_WAIT_V(6); PG8_BAR;
    }
    for (;;) {
        const bool has_next = S.next(ui + 1, nxt);
        const char* nA = cA; const char* nB = cB;
        if (has_next) PG8_UPTR(nxt, nA, nB);
#pragma unroll 1
        for (int t = 0; t < nt; t += 2) {
            const bool last = (t == nt - 2);
            const char* a1 = cA + (size_t)(t + 1) * kstep;
            const char* a2 = last ? nA : cA + (size_t)(t + 2) * kstep; const char* b2 = last ? nB : cB + (size_t)(t + 2) * kstep;
            const char* a3 = a2 + kstep; const char* b3 = b2 + kstep;
            if constexpr (SP2) {
            PG8_LDB(B0, 0, 0); PG8_LDB(B1, 0, 1); PG8_SCHED; PG8_LDA(At, 0, 0); PG8_STAGE_A(PG8_SA(1, 1), a1, 1, false);
            if constexpr (GATHER) { if (last && has_next) { PG8_GROWS(nxt, vC); } }
            PG8_WAIT_V(8); PG8_WAIT_L(0); PG8_BAR; PG8_MMA(0, 0, At, B0); PG8_MMA(0, 1, At, B1); PG8_BAR; PG8_SCHED;
            PG8_LDA(At, 0, 1); PG8_STAGE(PG8_SB(0, 0), b2, voffB); PG8_STAGE(PG8_SB(0, 1), b2 + hstep, voffB); PG8_STAGE_A(PG8_SA(0, 0), a2, 0, last);
            PG8_WAIT_V(8); PG8_WAIT_L(0); PG8_BAR; PG8_MMA(1, 0, At, B0); PG8_MMA(1, 1, At, B1); PG8_BAR; PG8_SCHED;
            PG8_LDB(B0, 1, 0); PG8_LDB(B1, 1, 1); PG8_SCHED; PG8_LDA(At, 1, 0); PG8_STAGE_A(PG8_SA(0, 1), a2, 1, last);
            PG8_WAIT_V(8); PG8_WAIT_L(0); PG8_BAR; PG8_MMA(0, 0, At, B0); PG8_MMA(0, 1, At, B1); PG8_BAR; PG8_SCHED;
            PG8_LDA(At, 1, 1); PG8_STAGE(PG8_SB(1, 0), b3, voffB); PG8_STAGE(PG8_SB(1, 1), b3 + hstep, voffB); PG8_STAGE_A(PG8_SA(1, 0), a3, 0, last);
            PG8_WAIT_V(8); PG8_WAIT_L(0); PG8_BAR; PG8_MMA(1, 0, At, B0); PG8_MMA(1, 1, At, B1); PG8_BAR; PG8_SCHED;
            } else {
            PG8_LDB(B0, 0, 0); PG8_SCHED; PG8_LDA(At, 0, 0); PG8_STAGE_A(PG8_SA(1, 1), a1, 1, false);
            if constexpr (GATHER) { if (last && has_next) { PG8_GROWS(nxt, vC); } }
            PG8_WAIT_L(8); PG8_BAR; PG8_WAIT_L(0); PG8_MMA(0, 0, At, B0); PG8_BAR; PG8_SCHED;
            PG8_LDB(B1, 0, 1); PG8_STAGE(PG8_SB(0, 0), b2, voffB);
            PG8_BAR; PG8_WAIT_L(0); PG8_MMA(0, 1, At, B1); PG8_BAR;
            PG8_LDA(At, 0, 1); PG8_STAGE_A(PG8_SA(0, 0), a2, 0, last);
            PG8_BAR; PG8_WAIT_L(0); PG8_MMA(1, 0, At, B0); PG8_BAR; PG8_SCHED;
            PG8_STAGE(PG8_SB(0, 1), b2 + hstep, voffB);
            PG8_WAIT_V(6); PG8_BAR; PG8_MMA(1, 1, At, B1); PG8_BAR;
            PG8_LDB(B0, 1, 0); PG8_SCHED; PG8_LDA(At, 1, 0); PG8_STAGE_A(PG8_SA(0, 1), a2, 1, last);
            PG8_WAIT_L(8); PG8_BAR; PG8_WAIT_L(0); PG8_MMA(0, 0, At, B0); PG8_BAR; PG8_SCHED;
            PG8_LDB(B1, 1, 1); PG8_STAGE(PG8_SB(1, 0), b3, voffB);
            PG8_BAR; PG8_WAIT_L(0); PG8_MMA(0, 1, At, B1); PG8_BAR;
            PG8_LDA(At, 1, 1); PG8_STAGE_A(PG8_SA(1, 0), a3, 0, last);
            PG8_BAR; PG8_WAIT_L(0); PG8_MMA(1, 0, At, B0); PG8_BAR; PG8_SCHED;
            PG8_STAGE(PG8_SB(1, 1), b3 + hstep, voffB);
            PG8_WAIT_V(6); PG8_BAR; PG8_MMA(1, 1, At, B1); PG8_BAR;
            }
        }
        if constexpr (ALIGN_EPI) { if (wr == 0) PG8_BAR; }
        if constexpr (FP8) { asm volatile("s_nop 15\n\ts_nop 15" ::: "memory"); PG8_SCHED; }
        E(acc, cur, wr, wc, fr, fq);
        if (!has_next) break;
#pragma unroll
        for (int a = 0; a < 2; ++a)
#pragma unroll
            for (int b = 0; b < 2; ++b)
#pragma unroll
                for (int m = 0; m < 4; ++m)
#pragma unroll
                    for (int n = 0; n < 2; ++n) acc[a][b][m][n] = (f32x4){0.f, 0.f, 0.f, 0.f};
        cur = nxt; cA = nA; cB = nB; ++ui;
        if constexpr (ALIGN_EPI) { if (wr == 1) PG8_BAR; }
    }
    PG8_WAIT_V(0);
    if constexpr (!ALIGN_EPI) { if (wr == 0) PG8_BAR; }
    PG8_BAR;
#undef PG8_SA
#undef PG8_SB
#undef PG8_STAGE
#undef PG8_LDA
#undef PG8_LDB
#undef PG8_MMA
#undef PG8_WAIT_V
#undef PG8_WAIT_L
#undef PG8_BAR
#undef PG8_SCHED
#undef PG8_UPTR
#undef PG8_STAGE_A
#undef PG8_GROWS
}

struct EpiProj {
    static constexpr bool PERM = true;
    bf16 *q, *k, *vT, *p;
    __device__ __forceinline__ void operator()(const f32x4 (&acc)[2][2][4][2], const Unit& u, int wr, int wc, int fr, int fq) const {
        const int row0 = u.pm * BM + wr * 64 + fr;
        const int pn = u.pn;
#pragma unroll
        for (int ai = 0; ai < 2; ++ai)
#pragma unroll
            for (int m = 0; m < 4; ++m) {
                const int row = row0 + ai * HALF + m * 16;
#pragma unroll
                for (int bj = 0; bj < 2; ++bj) {
                    f32x4 v0 = acc[ai][bj][m][0], v1 = acc[ai][bj][m][1];
                    const int col = pn * BM + bj * HALF + wc * 32 + 8 * fq;
                    if (pn >= 4 && pn < 6) {
                        const int cv = col - 1024, hh = cv >> 6, dim = cv & 63, b = row / T, t = row % T;
                        bf16* dst = vT + ((size_t)(((b * NH + hh) * GROWS + (t >> 6)) * HD + dim)) * 64 + (t & 63);
                        const unsigned w0 = cvt_pk_bf16(v0[0], v0[1]), w1 = cvt_pk_bf16(v0[2], v0[3]), w2 = cvt_pk_bf16(v1[0], v1[1]), w3 = cvt_pk_bf16(v1[2], v1[3]);
                        dst[0 * 64] = (bf16)(w0 & 0xffff); dst[1 * 64] = (bf16)(w0 >> 16); dst[2 * 64] = (bf16)(w1 & 0xffff); dst[3 * 64] = (bf16)(w1 >> 16);
                        dst[4 * 64] = (bf16)(w2 & 0xffff); dst[5 * 64] = (bf16)(w2 >> 16); dst[6 * 64] = (bf16)(w3 & 0xffff); dst[7 * 64] = (bf16)(w3 >> 16);
                        asm volatile("s_waitcnt vmcnt(40)" ::: "memory");
                    } else {
                        bf16* dst;
                        if (pn < 2) { v0 = v0 * 0.125f; v1 = v1 * 0.125f; dst = q + (size_t)row * CW + col; }
                        else if (pn < 4) dst = k + (size_t)row * CW + (col - 512);
                        else dst = p + (size_t)row * PW + (col - 1536);
                        u32x4 w; w.x = cvt_pk_bf16(v0[0], v0[1]); w.y = cvt_pk_bf16(v0[2], v0[3]); w.z = cvt_pk_bf16(v1[0], v1[1]); w.w = cvt_pk_bf16(v1[2], v1[3]);
                        *(u32x4*)dst = w;
                    }
                }
            }
    }
};
struct EpiWo {
    static constexpr bool PERM = true;
    const float* x; bf16* h;
    __device__ __forceinline__ void operator()(const f32x4 (&acc)[2][2][4][2], const Unit& u, int wr, int wc, int fr, int fq) const {
        const int row0 = u.pm * BM + wr * 64 + fr, col0 = u.pn * BM + wc * 32 + 8 * fq;
#pragma unroll
        for (int ai = 0; ai < 2; ++ai)
#pragma unroll
            for (int m = 0; m < 4; ++m) { const size_t off = (size_t)(row0 + ai * HALF + m * 16) * D + col0;
#pragma unroll
                for (int bj = 0; bj < 2; ++bj) { const f32x4 v0 = acc[ai][bj][m][0] + *(const f32x4*)(x + off + bj * HALF), v1 = acc[ai][bj][m][1] + *(const f32x4*)(x + off + bj * HALF + 4);
                    u32x4 w; w.x = cvt_pk_bf16(v0[0], v0[1]); w.y = cvt_pk_bf16(v0[2], v0[3]); w.z = cvt_pk_bf16(v1[0], v1[1]); w.w = cvt_pk_bf16(v1[2], v1[3]);
                    *(u32x4*)(h + off + bj * HALF) = w; } }
    }
};
struct EpiUp {
    static constexpr bool PERM = true;
    const float* b_up; unsigned char* act;
    __device__ __forceinline__ void operator()(const f32x4 (&acc)[2][2][4][2], const Unit& u, int wr, int wc, int fr, int fq) const {
        const int row0 = u.pm * BM + wr * 64 + fr, ch = u.pn * 128 + wc * 32 + 8 * fq;
        const float* bg = b_up + (size_t)u.e * 2048 + ch; const float* bl = bg + 1024;
        const f32x4 bg0 = *(const f32x4*)bg * F8_SACT, bg1 = *(const f32x4*)(bg + 4) * F8_SACT, bl0 = *(const f32x4*)bl, bl1 = *(const f32x4*)(bl + 4);
        constexpr float SG = F8_SACT / (F8_SX * F8_SW), SL = 1.0f / (F8_SX * F8_SW), KE = -1.702f * 1.44269504f / F8_SACT;
#pragma unroll
        for (int ai = 0; ai < 2; ++ai)
#pragma unroll
            for (int m = 0; m < 4; ++m) {
                float o[8];
#pragma unroll
                for (int n = 0; n < 2; ++n) { const f32x4 ga = acc[ai][0][m][n], la = acc[ai][1][m][n]; const f32x4 bgn = n ? bg1 : bg0, bln = n ? bl1 : bl0;
#pragma unroll
                    for (int hj = 0; hj < 2; ++hj) {
                        const f32x2 gv = __builtin_elementwise_fma((f32x2){ga[2 * hj], ga[2 * hj + 1]}, (f32x2){SG, SG}, (f32x2){bgn[2 * hj], bgn[2 * hj + 1]});
                        const f32x2 lv = __builtin_elementwise_fma((f32x2){la[2 * hj], la[2 * hj + 1]}, (f32x2){SL, SL}, (f32x2){bln[2 * hj], bln[2 * hj + 1]});
                        const f32x2 gt = {fminf(gv.x, 7.0f * F8_SACT), fminf(gv.y, 7.0f * F8_SACT)};
                        const f32x2 li = {__builtin_amdgcn_fmed3f(lv.x, -7.0f, 7.0f), __builtin_amdgcn_fmed3f(lv.y, -7.0f, 7.0f)};
                        const f32x2 zk = __builtin_elementwise_fma(gt, (f32x2){KE, KE}, (f32x2){-0.0f, -0.0f});
                        const f32x2 ez = {__builtin_amdgcn_exp2f(zk.x), __builtin_amdgcn_exp2f(zk.y)};
                        const f32x2 den = __builtin_elementwise_fma(ez, (f32x2){1.0f, 1.0f}, (f32x2){1.0f, 1.0f});
                        const f32x2 rc = {__builtin_amdgcn_rcpf(den.x), __builtin_amdgcn_rcpf(den.y)};
                        const f32x2 t = __builtin_elementwise_fma(gt, rc, (f32x2){-0.0f, -0.0f});
                        const f32x2 ov = __builtin_elementwise_fma(li, t, t);
                        o[n * 4 + 2 * hj] = ov.x; o[n * 4 + 2 * hj + 1] = ov.y; } }
                int w0 = 0, w1 = 0;
                w0 = __builtin_amdgcn_cvt_pk_fp8_f32(o[0], o[1], w0, false); w0 = __builtin_amdgcn_cvt_pk_fp8_f32(o[2], o[3], w0, true);
                w1 = __builtin_amdgcn_cvt_pk_fp8_f32(o[4], o[5], w1, false); w1 = __builtin_amdgcn_cvt_pk_fp8_f32(o[6], o[7], w1, true);
                u32x2 w8; w8.x = (unsigned)w0; w8.y = (unsigned)w1;
                *(u32x2*)(act + (size_t)(row0 + ai * HALF + m * 16) * DE + ch) = w8;
            }
    }
};
struct EpiDown {
    static constexpr bool PERM = true;
    const float* b_dn; unsigned char* y;
    __device__ __forceinline__ void operator()(const f32x4 (&acc)[2][2][4][2], const Unit& u, int wr, int wc, int fr, int fq) const {
        const int row0 = u.pm * BM + wr * 64 + fr, col0 = u.pn * BM + wc * 32 + 8 * fq;
        const float* bb = b_dn + (size_t)u.e * D + col0;
        f32x4 bv[2][2];
#pragma unroll
        for (int bj = 0; bj < 2; ++bj)
#pragma unroll
            for (int n = 0; n < 2; ++n) bv[bj][n] = *(const f32x4*)(bb + bj * HALF + 4 * n) * F8_SY;
#pragma unroll
        for (int ai = 0; ai < 2; ++ai)
#pragma unroll
            for (int m = 0; m < 4; ++m) { unsigned char* rowp = y + (size_t)(row0 + ai * HALF + m * 16) * D + col0;
#pragma unroll
                for (int bj = 0; bj < 2; ++bj) { const f32x4 v0 = acc[ai][bj][m][0] * (F8_SY / (F8_SACT * F8_SW)) + bv[bj][0], v1 = acc[ai][bj][m][1] * (F8_SY / (F8_SACT * F8_SW)) + bv[bj][1];
                    u32x2 w; w.x = pk4_fp8(v0[0], v0[1], v0[2], v0[3]); w.y = pk4_fp8(v1[0], v1[1], v1[2], v1[3]);
                    *(u32x2*)(rowp + bj * HALF) = w; } }
    }
};
}


#define XB_TMO      128
#define XB_XCNT(j)  (256  + 64 * (j))
#define XB_XSUB(j)  (1280 + 64 * (j))
#define XB_XGEN(j)  (2304 + 64 * (j))
#define XB_TOP      3328
#define XB_TOPGEN   3392
#define XCD_BAR_WORDS 3456
#define XB_SPIN_CAP (1u << 20)
__device__ __forceinline__ unsigned xb_ld(unsigned* p)              { return __hip_atomic_load(p, __ATOMIC_RELAXED, __HIP_MEMORY_SCOPE_AGENT); }
__device__ __forceinline__ unsigned xb_add(unsigned* p, unsigned v) { return __hip_atomic_fetch_add(p, v, __ATOMIC_RELAXED, __HIP_MEMORY_SCOPE_AGENT); }
__device__ __forceinline__ unsigned xb_xcc_id() { return (unsigned)__builtin_amdgcn_s_getreg((3 << 11) | 20) & 0xFu; }
#define XB_SPIN(cond, bar) do { unsigned _sp = 0; while (cond) { __builtin_amdgcn_s_sleep(1); \
    if ((++_sp & 255u) == 0u) { if (xb_ld(&(bar)[XB_TMO])) break; if (_sp > XB_SPIN_CAP) { atomicAdd(&(bar)[XB_TMO], 1u); break; } } } } while (0)
struct XcdBarrier { unsigned* bar; unsigned x; volatile LAS unsigned* st; };
__device__ __forceinline__ XcdBarrier xcd_barrier_post(unsigned* bar, volatile LAS unsigned* st) {
    XcdBarrier b; b.bar = bar; b.x = xb_xcc_id(); b.st = st;
    if (threadIdx.x == 0) (void)xb_add(&bar[XB_XCNT(b.x)], 1u);
    return b;
}
__device__ __forceinline__ void xcd_barrier_complete(unsigned* bar, unsigned x, unsigned& nloc, unsigned& nx) {
    const unsigned G = gridDim.x * gridDim.y * gridDim.z;
    unsigned sum, cnt, mine, sp = 0u;
    for (;;) {
        sum = 0u; cnt = 0u; mine = 0u;
#pragma unroll
        for (unsigned j = 0; j < 16; ++j) { const unsigned c = xb_ld(&bar[XB_XCNT(j)]); sum += c; cnt += (c > 0u) ? 1u : 0u; mine = (j == x) ? c : mine; }
        if (sum == G) break;
        __builtin_amdgcn_s_sleep(1);
        if ((++sp & 255u) == 0u) { if (xb_ld(&bar[XB_TMO])) break; if (sp > XB_SPIN_CAP) { atomicAdd(&bar[XB_TMO], 1u); break; } }
    }
    nloc = mine > 0u ? mine : 1u; nx = cnt > 0u ? cnt : 1u;
}
__device__ __forceinline__ void xcd_barrier(const XcdBarrier& b) {
    asm volatile("s_waitcnt vmcnt(0)" ::: "memory");
    __syncthreads();
    if (threadIdx.x == 0) {
        unsigned* bar = b.bar;
        __builtin_amdgcn_s_waitcnt(0);
        unsigned nloc = b.st[0], nx = b.st[1];
        if (nloc == 0u) { xcd_barrier_complete(bar, b.x, nloc, nx); b.st[0] = nloc; b.st[1] = nx; }
        const unsigned old = xb_add(&bar[XB_XSUB(b.x)], 1u);
        const unsigned gen = old / nloc;
        if (old + 1u == (gen + 1u) * nloc) {
            __builtin_amdgcn_fence(__ATOMIC_RELEASE, "agent");
            asm volatile("s_waitcnt vmcnt(0)" ::: "memory");
            const unsigned og = xb_add(&bar[XB_TOP], 1u);
            const unsigned tg = og / nx;
            if (og + 1u == (tg + 1u) * nx) xb_add(&bar[XB_TOPGEN], 1u);
            else XB_SPIN(xb_ld(&bar[XB_TOPGEN]) == tg, bar);
            __builtin_amdgcn_fence(__ATOMIC_ACQUIRE, "agent");
            xb_add(&bar[XB_XGEN(b.x)], 1u);
            asm volatile("s_waitcnt vmcnt(0)" ::: "memory");
        } else {
            XB_SPIN(xb_ld(&bar[XB_XGEN(b.x)]) == gen, bar);
            __builtin_amdgcn_fence(__ATOMIC_ACQUIRE, "agent");
            asm volatile("s_waitcnt vmcnt(0)" ::: "memory");
        }
    }
    __syncthreads();
}

struct Args { const float* in[26]; float* out; unsigned char* ws; int ph_lo, ph_hi; };

struct Frame { LAS unsigned char* lds; int tid, lane, wave, G, vcu; };

__device__ __forceinline__ void transpose_item(const float* W, int K, int N, bf16* WT, int k0, int n0, int orow0, LAS float* scr, int lane) {
#pragma unroll 8
    for (int i = 0; i < 32; ++i) { const int kk = 2 * i + (lane >> 5); scr[kk * 33 + (lane & 31)] = W[(size_t)(k0 + kk) * N + n0 + (lane & 31)]; }
    asm volatile("s_waitcnt lgkmcnt(0)" ::: "memory");
    const int c = lane & 7;
#pragma unroll
    for (int j = 0; j < 4; ++j) { const int n = (lane >> 3) + 8 * j; const LAS float* s = scr + (8 * c) * 33 + n;
        u32x4 o; o.x = cvt_pk_bf16(s[0 * 33], s[1 * 33]); o.y = cvt_pk_bf16(s[2 * 33], s[3 * 33]); o.z = cvt_pk_bf16(s[4 * 33], s[5 * 33]); o.w = cvt_pk_bf16(s[6 * 33], s[7 * 33]);
        *(u32x4*)(WT + (size_t)(orow0 + n) * K + k0 + 8 * c) = o; }
    asm volatile("s_waitcnt lgkmcnt(0)" ::: "memory");
}

__device__ __forceinline__ void transpose_item8w(const float* W, int K, int N, unsigned char* WT, int k0, int n0, int orow0, LAS float* scr, int lane) {
#pragma unroll 8
    for (int i = 0; i < 64; ++i) { const int kk = 2 * i + (lane >> 5); scr[kk * 33 + (lane & 31)] = W[(size_t)(k0 + kk) * N + n0 + (lane & 31)]; }
    asm volatile("s_waitcnt lgkmcnt(0)" ::: "memory");
    const int c = lane & 7;
#pragma unroll
    for (int j = 0; j < 4; ++j) { const int n = (lane >> 3) + 8 * j; const LAS float* s = scr + (16 * c) * 33 + n;
        u32x4 o; o.x = pk4_fp8(s[0 * 33] * F8_SW, s[1 * 33] * F8_SW, s[2 * 33] * F8_SW, s[3 * 33] * F8_SW); o.y = pk4_fp8(s[4 * 33] * F8_SW, s[5 * 33] * F8_SW, s[6 * 33] * F8_SW, s[7 * 33] * F8_SW);
        o.z = pk4_fp8(s[8 * 33] * F8_SW, s[9 * 33] * F8_SW, s[10 * 33] * F8_SW, s[11 * 33] * F8_SW); o.w = pk4_fp8(s[12 * 33] * F8_SW, s[13 * 33] * F8_SW, s[14 * 33] * F8_SW, s[15 * 33] * F8_SW);
        *(u32x4*)(WT + (size_t)(orow0 + n) * K + k0 + 16 * c) = o; }
    asm volatile("s_waitcnt lgkmcnt(0)" ::: "memory");
}
__device__ __forceinline__ void transpose_item8(const float* W, int K, int N, unsigned char* WT, int k0, int n0, int orow0, LAS float* scr, int lane) {
#pragma unroll 8
    for (int i = 0; i < 32; ++i) { const int kk = 2 * i + (lane >> 5); scr[kk * 33 + (lane & 31)] = W[(size_t)(k0 + kk) * N + n0 + (lane & 31)]; }
    asm volatile("s_waitcnt lgkmcnt(0)" ::: "memory");
    const int c = lane & 7;
#pragma unroll
    for (int j = 0; j < 4; ++j) { const int n = (lane >> 3) + 8 * j; const LAS float* s = scr + (8 * c) * 33 + n;
        u32x2 o; o.x = pk4_fp8(s[0 * 33] * F8_SW, s[1 * 33] * F8_SW, s[2 * 33] * F8_SW, s[3 * 33] * F8_SW); o.y = pk4_fp8(s[4 * 33] * F8_SW, s[5 * 33] * F8_SW, s[6 * 33] * F8_SW, s[7 * 33] * F8_SW);
        *(u32x2*)(WT + (size_t)(orow0 + n) * K + k0 + 8 * c) = o; }
    asm volatile("s_waitcnt lgkmcnt(0)" ::: "memory");
}

__device__ __forceinline__ void p0_prologue(const Frame& F, const Args& a) {
    unsigned char* ws = a.ws;
    LAS float* scr = (LAS float*)(F.lds + F.wave * 8448);
    const int gw = F.vcu * 8 + F.wave, NGW = F.G * 8;
    constexpr int I_IN = 16 * 108, I_O = 16 * 32, I_L = 16, I_G = 32;
    constexpr int NITEMS = I_IN + I_O + 2 * I_L + 2 * I_L + I_G;
    for (int it = gw; it < NITEMS; it += NGW) {
        int r = it;
        if (r < I_IN) { const int kb = r / 108, nb = r % 108; transpose_item(a.in[2], 1024, NPROJ, (bf16*)(ws + WS_WINT), kb * 64, nb * 32, nb * 32, scr, F.lane); continue; }
        r -= I_IN;
        if (r < I_O) { const int kb = r / 32, nb = r % 32; transpose_item(a.in[17], 1024, 1024, (bf16*)(ws + WS_WOT), kb * 64, nb * 32, nb * 32, scr, F.lane); continue; }
        r -= I_O;
        if (r < 2 * I_L) { const int z = r / 16, nb = r % 16; transpose_item(a.in[8] + (size_t)z * 64 * 512, 64, 512, (bf16*)(ws + WS_W2T) + (size_t)z * 512 * 64, 0, nb * 32, nb * 32, scr, F.lane); continue; }
        r -= 2 * I_L;
        if (r < 2 * I_L) { const int z = r / 16, nb = r % 16; transpose_item(a.in[10] + (size_t)z * 64 * 512, 64, 512, (bf16*)(ws + WS_A2T) + (size_t)z * 512 * 64, 0, nb * 32, nb * 32, scr, F.lane); continue; }
        r -= 2 * I_L;
        { const int kb = r / 16, nb = r % 16; transpose_item(a.in[11], 128, 512, (bf16*)(ws + WS_G2T), kb * 64, nb * 32, nb * 32, scr, F.lane); }
    }
    {
        constexpr int BI_UP = 32 * 8 * 8, BI_DN = 32 * 8 * 4, WP = 257;
        LAS float* tile = (LAS float*)F.lds;
        const int lane = F.lane, w = F.wave, c = lane & 7;
        for (int bi = F.vcu; bi < BI_UP + BI_DN; bi += F.G) {
            const bool up = bi < BI_UP; const int r2 = up ? bi : bi - BI_UP;
            const int e = up ? r2 >> 6 : r2 >> 5, q = up ? r2 & 63 : r2 & 31, kb = up ? q >> 3 : q >> 2, nb = up ? q & 7 : q & 3;
            const int N = up ? 2048 : 1024, k0 = kb * 128, n0 = nb * 256;
            const float* W = (up ? a.in[21] + (size_t)e * 1024 * 2048 : a.in[23] + (size_t)e * 1024 * 1024) + (size_t)k0 * N + n0 + 4 * lane;
            unsigned char* WT = (up ? ws + WS_WUPT + (size_t)e * 2048 * 1024 : ws + WS_WDNT + (size_t)e * 1024 * 1024) + k0 + 16 * c;
            __syncthreads();
            f32x4 v[16];
#pragma unroll
            for (int i = 0; i < 16; ++i) v[i] = *(const f32x4*)(W + (size_t)(16 * w + i) * N);
#pragma unroll
            for (int i = 0; i < 16; ++i) { LAS float* t = tile + (16 * w + i) * WP + 4 * lane; t[0] = v[i].x; t[1] = v[i].y; t[2] = v[i].z; t[3] = v[i].w; }
            __syncthreads();
#pragma unroll
            for (int j = 0; j < 4; ++j) { const int nl = 32 * w + (lane >> 3) + 8 * j, n = n0 + nl;
                const int orow = up ? (n < 1024 ? 256 * (n >> 7) + (n & 127) : 256 * ((n - 1024) >> 7) + 128 + ((n - 1024) & 127)) : n;
                const LAS float* sp = tile + (16 * c) * WP + nl;
                u32x4 o; o.x = pk4_fp8(sp[0 * WP] * F8_SW, sp[1 * WP] * F8_SW, sp[2 * WP] * F8_SW, sp[3 * WP] * F8_SW); o.y = pk4_fp8(sp[4 * WP] * F8_SW, sp[5 * WP] * F8_SW, sp[6 * WP] * F8_SW, sp[7 * WP] * F8_SW);
                o.z = pk4_fp8(sp[8 * WP] * F8_SW, sp[9 * WP] * F8_SW, sp[10 * WP] * F8_SW, sp[11 * WP] * F8_SW); o.w = pk4_fp8(sp[12 * WP] * F8_SW, sp[13 * WP] * F8_SW, sp[14 * WP] * F8_SW, sp[15 * WP] * F8_SW);
                *(u32x4*)(WT + (size_t)orow * 1024) = o; }
        }
        __syncthreads(); }
    { u32x4* z = (u32x4*)(ws + WS_WINT + (size_t)NPROJ * 1024 * 2); const u32x4 zero = {0u, 0u, 0u, 0u};
      for (int i = F.vcu * 512 + F.tid; i < 16384; i += F.G * 512) z[i] = zero; }
    const float* x = a.in[0]; const float* nw = a.in[1]; bf16* hn = (bf16*)(ws + WS_HN);
    f32x4 wv[4];
#pragma unroll
    for (int j = 0; j < 4; ++j) wv[j] = *((const f32x4*)nw + F.lane + 64 * j);
    for (int m = gw; m < M; m += 2 * NGW) {
        const int m1 = m + NGW; const bool has1 = m1 < M;
        const f32x4* xr0 = (const f32x4*)(x + (size_t)m * D) + F.lane; const f32x4* xr1 = (const f32x4*)(x + (size_t)(has1 ? m1 : m) * D) + F.lane;
        f32x4 v0[4], v1[4]; float s0 = 0.f, s1 = 0.f;
#pragma unroll
        for (int j = 0; j < 4; ++j) { v0[j] = xr0[64 * j]; v1[j] = xr1[64 * j]; }
#pragma unroll
        for (int j = 0; j < 4; ++j) { s0 += (v0[j].x * v0[j].x + v0[j].y * v0[j].y) + (v0[j].z * v0[j].z + v0[j].w * v0[j].w); s1 += (v1[j].x * v1[j].x + v1[j].y * v1[j].y) + (v1[j].z * v1[j].z + v1[j].w * v1[j].w); }
        const float rs0 = rsqrtf(wave_sum(s0) * (1.f / D) + RMS_EPS), rs1 = rsqrtf(wave_sum(s1) * (1.f / D) + RMS_EPS);
        u32x2* o0 = (u32x2*)(hn + (size_t)m * D) + F.lane; u32x2* o1 = (u32x2*)(hn + (size_t)m1 * D) + F.lane;
#pragma unroll
        for (int j = 0; j < 4; ++j) { u32x2 o; o.x = cvt_pk_bf16(v0[j].x * rs0 * wv[j].x, v0[j].y * rs0 * wv[j].y); o.y = cvt_pk_bf16(v0[j].z * rs0 * wv[j].z, v0[j].w * rs0 * wv[j].w); o0[64 * j] = o; }
        if (has1) {
#pragma unroll
            for (int j = 0; j < 4; ++j) { u32x2 o; o.x = cvt_pk_bf16(v1[j].x * rs1 * wv[j].x, v1[j].y * rs1 * wv[j].y); o.y = cvt_pk_bf16(v1[j].z * rs1 * wv[j].z, v1[j].w * rs1 * wv[j].w); o1[64 * j] = o; } }
    }
}

constexpr int PREP_KBUF = 0, PREP_INV = 65536, PREP_AW = 67584, PREP_AA = PREP_AW + 17408, PREP_AG = PREP_AA + 17408, PREP_LD = 136;
template <bool STORE>
__device__ __forceinline__ void prep_phase(const Frame& F, const Args& a) {
    unsigned char* ws = a.ws;
    const bf16* p = (const bf16*)(ws + WS_P);
    bf16* r_out = (bf16*)(ws + WS_R); bf16* v_out = (bf16*)(ws + WS_V); bf16* kk_out = (bf16*)(ws + WS_KK);
    bf16* decay_out = (bf16*)(ws + WS_DECAY); bf16* kdir_out = (bf16*)(ws + WS_KDIR); bf16* akk_out = (bf16*)(ws + WS_AKK); bf16* g_out = (bf16*)(ws + WS_G);
    const bf16* w2T = (const bf16*)(ws + WS_W2T); const bf16* a2T = (const bf16*)(ws + WS_A2T); const bf16* g2T = (const bf16*)(ws + WS_G2T);
    const float* mu_p = a.in[5]; const float* mu_n = a.in[6]; const float* w0 = a.in[7]; const float* a0 = a.in[9];
    const float* k_k = a.in[12]; const float* k_a = a.in[13];
    LAS bf16* kbuf = (LAS bf16*)(F.lds + PREP_KBUF); LAS float* invb = (LAS float*)(F.lds + PREP_INV);
    LAS bf16* Aw = (LAS bf16*)(F.lds + PREP_AW); LAS bf16* Aa = (LAS bf16*)(F.lds + PREP_AA); LAS bf16* Ag = (LAS bf16*)(F.lds + PREP_AG);
    const int lane = F.lane, wave = F.wave, fr = lane & 15, fg = lane >> 4;
    for (int tile = F.vcu; tile < M / 64; tile += F.G) {
        const int m0 = tile * 64;
#pragma unroll 1
        for (int jj = 0; jj < 4; ++jj) {
            const int q = lane + 64 * jj; const bool valid = q < 240; const int c0 = 8 * q;
            float mp[8], mn[8];
#pragma unroll
            for (int i = 0; i < 8; ++i) { mp[i] = valid ? mu_p[c0 + i] : 0.f; mn[i] = valid ? mu_n[c0 + i] : 0.f; }
            const int mfirst = m0 + wave * 8;
            const u32x4 zero = {0u, 0u, 0u, 0u};
            u32x4 rows[10];
#pragma unroll
            for (int rI = 0; rI < 10; ++rI) { const int mr = mfirst - 1 + rI;
                const bool ok = valid && !(rI == 0 && (mfirst % T) == 0) && !(rI == 9 && ((mfirst + 7) % T) == T - 1);
                rows[rI] = ok ? *(const u32x4*)(p + (size_t)mr * PW + c0) : zero; }
#pragma unroll
            for (int i = 0; i < 8; ++i) {
                const int m = mfirst + i, it = wave * 8 + i;
                const u32x4 prev = rows[i], cur = rows[i + 1], nxt = rows[i + 2];
                float fp[8], fc[8], fn[8], s[8];
                unpack8(prev, fp); unpack8(cur, fc); unpack8(nxt, fn);
#pragma unroll
                for (int e = 0; e < 8; ++e) s[e] = fc[e] + mp[e] * (fp[e] - fc[e]) + mn[e] * (fn[e] - fc[e]);
                if (jj == 0) { if (STORE) { *(u32x4*)(r_out + (size_t)m * CW + c0) = pack8(s); } }
                else if (jj == 1) {
                    const int c = c0 - 512;
                    *(LAS u32x4*)(kbuf + it * 512 + c) = pack8(s);
                    float kr[8]; float ss = 0.f;
#pragma unroll
                    for (int e = 0; e < 8; ++e) { kr[e] = s[e] * k_k[c + e]; ss += kr[e] * kr[e]; }
                    ss += __shfl_xor(ss, 1); ss += __shfl_xor(ss, 2); ss += __shfl_xor(ss, 4);
                    const float inv = fminf(__builtin_amdgcn_rsqf(ss), 1e12f);
#pragma unroll
                    for (int e = 0; e < 8; ++e) kr[e] *= inv;
                    if (STORE) { *(u32x4*)(kk_out + (size_t)m * CW + c) = pack8(kr); }
                    if ((lane & 7) == 0) invb[it * 8 + (lane >> 3)] = inv;
                }
                else if (jj == 2) { if (STORE) { *(u32x4*)(v_out + (size_t)m * CW + (c0 - 1024)) = pack8(s); } }
                else if (valid) {
                    const int seg = lane >> 4, cw = 8 * (lane & 15);
                    if (seg == 0) {
#pragma unroll
                        for (int e = 0; e < 8; ++e) s[e] = 1.0f - 2.0f * __builtin_amdgcn_rcpf(__expf(2.0f * s[e]) + 1.0f);
                        *(LAS u32x4*)(Aw + it * PREP_LD + cw) = pack8(s);
                    } else if (seg == 1) { *(LAS u32x4*)(Aa + it * PREP_LD + cw) = pack8(s); }
                    else {
#pragma unroll
                        for (int e = 0; e < 8; ++e) s[e] = sigmoidf_(s[e]);
                        *(LAS u32x4*)(Ag + it * PREP_LD + cw) = pack8(s);
                    }
                }
            }
        }
        __syncthreads();
        const int nb = 64 * wave;
#define PREP_PROW(nt_) (nb + 32 * ((nt_) >> 1) + 8 * (fr >> 2) + 4 * ((nt_) & 1) + (fr & 3))
#define PREP_COL(nt_)  (nb + 32 * ((nt_) >> 1) + 8 * fg + 4 * ((nt_) & 1))
#pragma unroll 1
        for (int job = 0; job < 4; ++job) {
            const int z = job & 1;
            const bf16* WT = job < 2 ? w2T + (size_t)z * 512 * 64 : a2T + (size_t)z * 512 * 64;
            const LAS bf16* Ax = job < 2 ? Aw + z * 64 : Aa + z * 64;
            bf16x8 wf[2][4];
#pragma unroll
            for (int ks = 0; ks < 2; ++ks)
#pragma unroll
                for (int nt = 0; nt < 4; ++nt) wf[ks][nt] = *(const bf16x8*)(WT + (size_t)PREP_PROW(nt) * 64 + 32 * ks + 8 * fg);
            f32x4 pb[4], pkk[4], pka[4];
#pragma unroll
            for (int nt = 0; nt < 4; ++nt) { const int n = PREP_COL(nt);
                pb[nt] = *(const f32x4*)((job < 2 ? w0 : a0) + z * 512 + n); pkk[nt] = *(const f32x4*)(k_k + n); pka[nt] = *(const f32x4*)(k_a + n); }
            f32x4 acc[4][4];
#pragma unroll
            for (int mt = 0; mt < 4; ++mt)
#pragma unroll
                for (int nt = 0; nt < 4; ++nt) acc[mt][nt] = (f32x4){0.f, 0.f, 0.f, 0.f};
#pragma unroll
            for (int ks = 0; ks < 2; ++ks) {
                bf16x8 af[4];
#pragma unroll
                for (int mt = 0; mt < 4; ++mt) af[mt] = *(const LAS bf16x8*)(Ax + (16 * mt + fr) * PREP_LD + 32 * ks + 8 * fg);
#pragma unroll
                for (int mt = 0; mt < 4; ++mt)
#pragma unroll
                    for (int nt = 0; nt < 4; ++nt) acc[mt][nt] = __builtin_amdgcn_mfma_f32_16x16x32_bf16(wf[ks][nt], af[mt], acc[mt][nt], 0, 0, 0);
            }
#pragma unroll
            for (int mt = 0; mt < 4; ++mt) {
                const int it = 16 * mt + fr; const size_t m = (size_t)(m0 + it);
#pragma unroll
                for (int np = 0; np < 2; ++np) {
                    const int c8 = nb + 32 * np + 8 * fg;
                    if (job < 2) {
                        float o[8];
#pragma unroll
                        for (int hh = 0; hh < 2; ++hh) { const f32x4 v = acc[mt][2 * np + hh], bq = pb[2 * np + hh];
#pragma unroll
                            for (int i = 0; i < 4; ++i) o[4 * hh + i] = __expf(-0.60653066f * sigmoidf_(v[i] + bq[i])); }
                        if (STORE) { *(u32x4*)(decay_out + ((size_t)z * M + m) * CW + c8) = pack8(o); }
                    } else {
                        const u32x4 kb = *(const LAS u32x4*)(kbuf + it * 512 + c8);
                        float kv[8]; unpack8(kb, kv);
                        const float inv = invb[it * 8 + wave];
                        float kd[8], ak[8];
#pragma unroll
                        for (int hh = 0; hh < 2; ++hh) { const f32x4 v = acc[mt][2 * np + hh], bq = pb[2 * np + hh], kkc = pkk[2 * np + hh], kac = pka[2 * np + hh];
#pragma unroll
                            for (int i = 0; i < 4; ++i) { const float av = sigmoidf_(v[i] + bq[i]), kx = kv[4 * hh + i]; kd[4 * hh + i] = kx * (1.0f + (av - 1.0f) * kac[i]); ak[4 * hh + i] = av * (kx * kkc[i] * inv); } }
                        if (STORE) { *(u32x4*)(kdir_out + ((size_t)z * M + m) * CW + c8) = pack8(kd); *(u32x4*)(akk_out + ((size_t)z * M + m) * CW + c8) = pack8(ak); }
                    }
                }
            }
        }
        {
            bf16x8 wf[4][4];
#pragma unroll
            for (int ks = 0; ks < 4; ++ks)
#pragma unroll
                for (int nt = 0; nt < 4; ++nt) wf[ks][nt] = *(const bf16x8*)(g2T + (size_t)PREP_PROW(nt) * 128 + 32 * ks + 8 * fg);
            f32x4 acc[4][4];
#pragma unroll
            for (int mt = 0; mt < 4; ++mt)
#pragma unroll
                for (int nt = 0; nt < 4; ++nt) acc[mt][nt] = (f32x4){0.f, 0.f, 0.f, 0.f};
#pragma unroll
            for (int ks = 0; ks < 4; ++ks) {
                bf16x8 af[4];
#pragma unroll
                for (int mt = 0; mt < 4; ++mt) af[mt] = *(const LAS bf16x8*)(Ag + (16 * mt + fr) * PREP_LD + 32 * ks + 8 * fg);
#pragma unroll
                for (int mt = 0; mt < 4; ++mt)
#pragma unroll
                    for (int nt = 0; nt < 4; ++nt) acc[mt][nt] = __builtin_amdgcn_mfma_f32_16x16x32_bf16(wf[ks][nt], af[mt], acc[mt][nt], 0, 0, 0);
            }
#pragma unroll
            for (int mt = 0; mt < 4; ++mt) { const size_t m = (size_t)(m0 + 16 * mt + fr);
#pragma unroll
                for (int np = 0; np < 2; ++np) { const f32x4 v0 = acc[mt][2 * np], v1 = acc[mt][2 * np + 1];
                    u32x4 w; w.x = cvt_pk_bf16(v0[0], v0[1]); w.y = cvt_pk_bf16(v0[2], v0[3]); w.z = cvt_pk_bf16(v1[0], v1[1]); w.w = cvt_pk_bf16(v1[2], v1[3]);
                    if (STORE) { *(u32x4*)(g_out + m * CW + nb + 32 * np + 8 * fg) = w; } } }
        }
#undef PREP_PROW
#undef PREP_COL
        __syncthreads();
    }
}

__device__ __forceinline__ void attn_phase(const Frame& F, const Args& a, const int widx, const int nworkers) {
    unsigned char* ws = a.ws;
    const bf16* q = (const bf16*)(ws + WS_Q); const bf16* k = (const bf16*)(ws + WS_K); const bf16* vT = (const bf16*)(ws + WS_VT);
    bf16* att = (bf16*)(ws + WS_ATT);
    LAS float* bias = (LAS float*)F.lds + 16;
    for (int i = F.tid; i < 8 * 15 * 31; i += 512) bias[i] = a.in[3][i];
    __syncthreads();
    const int lane = F.lane, fr = lane & 15, fg = lane >> 4;
    const int per = (16384 + nworkers * 8 - 1) / (nworkers * 8);
    for (int it = 0; it < per; ++it) {
        const int task = widx * (8 * per) + it * 8 + F.wave; if (task >= 16384) break;
        const int cgp = task & 3, r = (task >> 2) & 127, h = (task >> 9) & 7, b = task >> 12;
        const int c0 = 16 * cgp, wsc = min(max(c0 - 8, 0), 32), rs = min(max(r - 4, 0), GROWS - 8);
        const int c = c0 + fr, cs = min(max(c - 8, 0), 48);
        const size_t tq = (size_t)b * T + r * 64 + c;
        bf16x8 qf[2];
#pragma unroll
        for (int ks = 0; ks < 2; ++ks) qf[ks] = *(const bf16x8*)(q + tq * CW + h * 64 + 32 * ks + 8 * fg);
        f32x4 sc[16];
        const int kcol_a = wsc + 8 * (fr >> 2) + (fr & 3);
        { bf16x8 kf[16][2];
#pragma unroll
          for (int t = 0; t < 16; ++t) { const int u = t >> 1, par = t & 1;
              const size_t tk = (size_t)b * T + (rs + u) * 64 + kcol_a + 4 * par;
              kf[t][0] = *(const bf16x8*)(k + tk * CW + h * 64 + 8 * fg); kf[t][1] = *(const bf16x8*)(k + tk * CW + h * 64 + 32 + 8 * fg); }
#pragma unroll
          for (int t = 0; t < 16; ++t) { f32x4 s = {0.f, 0.f, 0.f, 0.f};
              s = __builtin_amdgcn_mfma_f32_16x16x32_bf16(kf[t][0], qf[0], s, 0, 0, 0);
              s = __builtin_amdgcn_mfma_f32_16x16x32_bf16(kf[t][1], qf[1], s, 0, 0, 0);
              sc[t] = s; } }
        bool okm[8];
#pragma unroll
        for (int pi = 0; pi < 8; ++pi) { const int kc = wsc + 8 * fg + pi; okm[pi] = (kc >= cs) && (kc < cs + 16); }
        const LAS float* brow = bias + (h * 15 + (rs - r + 7)) * 31 + (wsc + 8 * fg - c + 15);
        float mx = -1e30f;
#pragma unroll
        for (int u = 0; u < 8; ++u)
#pragma unroll
            for (int pi = 0; pi < 8; ++pi) { const float s = okm[pi] ? sc[2 * u + (pi >> 2)][pi & 3] + brow[31 * u + pi] : -1e30f; sc[2 * u + (pi >> 2)][pi & 3] = s; mx = fmaxf(mx, s); }
        mx = fmaxf(mx, __shfl_xor(mx, 16)); mx = fmaxf(mx, __shfl_xor(mx, 32));
        float sum = 0.f;
        const float mxl = -mx * 1.44269504f;
#pragma unroll
        for (int t = 0; t < 16; ++t)
#pragma unroll
            for (int i = 0; i < 4; ++i) { const float pv = __builtin_amdgcn_exp2f(__builtin_fmaf(sc[t][i], 1.44269504f, mxl)); sc[t][i] = pv; sum += pv; }
        sum += __shfl_xor(sum, 16); sum += __shfl_xor(sum, 32);
        const float inv = 1.0f / sum;
        f32x4 o[4];
#pragma unroll
        for (int nt = 0; nt < 4; ++nt) o[nt] = (f32x4){0.f, 0.f, 0.f, 0.f};
        { bf16x8 vf[8][4];
#pragma unroll
          for (int u = 0; u < 8; ++u) { const bf16* vblk = vT + ((size_t)((b * NH + h) * GROWS + rs + u)) * (HD * 64) + wsc + 8 * fg;
#pragma unroll
              for (int nt = 0; nt < 4; ++nt) vf[u][nt] = *(const bf16x8*)(vblk + (16 * nt + fr) * 64); }
#pragma unroll
          for (int u = 0; u < 8; ++u) {
              union { u32x4 w; bf16x8 h8; } pf;
              pf.w.x = cvt_pk_bf16(sc[2 * u][0], sc[2 * u][1]); pf.w.y = cvt_pk_bf16(sc[2 * u][2], sc[2 * u][3]);
              pf.w.z = cvt_pk_bf16(sc[2 * u + 1][0], sc[2 * u + 1][1]); pf.w.w = cvt_pk_bf16(sc[2 * u + 1][2], sc[2 * u + 1][3]);
#pragma unroll
              for (int nt = 0; nt < 4; ++nt) o[nt] = __builtin_amdgcn_mfma_f32_16x16x32_bf16(vf[u][nt], pf.h8, o[nt], 0, 0, 0); } }
#pragma unroll
        for (int nt = 0; nt < 4; ++nt) { u32x2 w; w.x = cvt_pk_bf16(o[nt][0] * inv, o[nt][1] * inv); w.y = cvt_pk_bf16(o[nt][2] * inv, o[nt][3] * inv);
            *(u32x2*)(att + tq * CW + h * 64 + 16 * nt + 4 * fg) = w; }
    }
    __syncthreads();
}

__device__ __forceinline__ void side_phase(const Frame& F, const Args& a, const int widx, const int nworkers) {
    attn_phase(F, a, widx, nworkers);
}

__device__ __forceinline__ float row16_sum(float v) {
    v += __builtin_bit_cast(float, __builtin_amdgcn_update_dpp(0, __builtin_bit_cast(int, v), 0xB1, 0xF, 0xF, true));
    v += __builtin_bit_cast(float, __builtin_amdgcn_update_dpp(0, __builtin_bit_cast(int, v), 0x4E, 0xF, 0xF, true));
    v += __builtin_bit_cast(float, __builtin_amdgcn_update_dpp(0, __builtin_bit_cast(int, v), 0x141, 0xF, 0xF, true));
    v += __builtin_bit_cast(float, __builtin_amdgcn_update_dpp(0, __builtin_bit_cast(int, v), 0x140, 0xF, 0xF, true));
    return v;
}
constexpr int CS_R = 8;
constexpr int CS_NCH = 2, CS_NPR = 6;
constexpr int CS_AT = 0, CS_RT = 2304, CS_KHT = 4608, CS_BHT = 6656, CS_VT = 8704  , CS_TT = 10752, CS_AAK = 11264, CS_ARK = 11776, CS_ARB = 12288, CS_PL = 12800, CS_SLOT = 13056;
constexpr int CS_LD = 72;
constexpr int CS_SCR = CS_R * CS_SLOT  , CS_SCRW = 2304 * 2  , CS_FLAG = CS_SCR + CS_NPR * CS_SCRW  ;
__device__ __forceinline__ bf16 f2bf(float f) { return (bf16)cvt_pk_bf16(f, 0.f); }
struct ChainOps { u32x2 a4[4], r4[4], kh[4], bh[4], aak, ark, arb, tt, vb; f32x4 pl[4]; };
__device__ __forceinline__ void chain_load(const LAS unsigned char* sl, int fr, int fg, int c, ChainOps& o) {
    const int o16 = fr * 32 + fg * 8;
    const LAS unsigned char* pa = sl + CS_AT + fr * (CS_LD * 2) + fg * 8; const LAS unsigned char* pr = sl + CS_RT + fr * (CS_LD * 2) + fg * 8;
#pragma unroll
    for (int kq = 0; kq < 4; ++kq) { o.a4[kq] = *(const LAS u32x2*)(pa + 32 * kq); o.r4[kq] = *(const LAS u32x2*)(pr + 32 * kq); }
    o.aak = *(const LAS u32x2*)(sl + CS_AAK + o16); o.ark = *(const LAS u32x2*)(sl + CS_ARK + o16); o.arb = *(const LAS u32x2*)(sl + CS_ARB + o16); o.tt = *(const LAS u32x2*)(sl + CS_TT + o16);
    o.vb = *(const LAS u32x2*)(sl + CS_VT + c * 512 + o16);
#pragma unroll
    for (int mt = 0; mt < 4; ++mt) { o.pl[mt] = *(const LAS f32x4*)(sl + CS_PL + (16 * mt + 4 * fg) * 4);
        o.kh[mt] = *(const LAS u32x2*)(sl + CS_KHT + 512 * mt + o16); o.bh[mt] = *(const LAS u32x2*)(sl + CS_BHT + 512 * mt + o16); }
}
__device__ __forceinline__ f32x4 chain_compute(const ChainOps& o, f32x4 (&zacc)[4]) {
#define CS_M32(A_, B_, C_) __builtin_amdgcn_mfma_f32_16x16x32_bf16(A_, B_, C_, 0, 0, 0)
#define CS_M16(A_, B_, C_) __builtin_amdgcn_mfma_f32_16x16x16bf16_1k(__builtin_bit_cast(s16x4, A_), __builtin_bit_cast(s16x4, B_), C_, 0, 0, 0)
    union { u32x4 w; bf16x8 h8; } zb0, zb1, ap0, ap1, rp0, rp1;
    zb0.w.x = cvt_pk_bf16(zacc[0][0], zacc[0][1]); zb0.w.y = cvt_pk_bf16(zacc[0][2], zacc[0][3]); zb0.w.z = cvt_pk_bf16(zacc[1][0], zacc[1][1]); zb0.w.w = cvt_pk_bf16(zacc[1][2], zacc[1][3]);
    zb1.w.x = cvt_pk_bf16(zacc[2][0], zacc[2][1]); zb1.w.y = cvt_pk_bf16(zacc[2][2], zacc[2][3]); zb1.w.z = cvt_pk_bf16(zacc[3][0], zacc[3][1]); zb1.w.w = cvt_pk_bf16(zacc[3][2], zacc[3][3]);
    ap0.w = (u32x4){o.a4[0].x, o.a4[0].y, o.a4[1].x, o.a4[1].y}; ap1.w = (u32x4){o.a4[2].x, o.a4[2].y, o.a4[3].x, o.a4[3].y};
    rp0.w = (u32x4){o.r4[0].x, o.r4[0].y, o.r4[1].x, o.r4[1].y}; rp1.w = (u32x4){o.r4[2].x, o.r4[2].y, o.r4[3].x, o.r4[3].y};
    const f32x4 zero4 = {0.f, 0.f, 0.f, 0.f};
    f32x4 Wc = CS_M16(o.aak, o.vb, zero4);
    Wc = CS_M32(ap0.h8, zb0.h8, Wc); Wc = CS_M32(ap1.h8, zb1.h8, Wc);
    f32x4 Yc = CS_M16(o.ark, o.vb, zero4);
    Yc = CS_M32(rp0.h8, zb0.h8, Yc); Yc = CS_M32(rp1.h8, zb1.h8, Yc);
    f32x4 zz[4];
#pragma unroll
    for (int mt = 0; mt < 4; ++mt) zz[mt] = CS_M16(o.kh[mt], o.vb, zacc[mt] * o.pl[mt]);
    u32x2 wb, ub;
    wb.x = cvt_pk_bf16(Wc[0], Wc[1]); wb.y = cvt_pk_bf16(Wc[2], Wc[3]);
    const f32x4 Uc = CS_M16(o.tt, wb, zero4);
    ub.x = cvt_pk_bf16(Uc[0], Uc[1]); ub.y = cvt_pk_bf16(Uc[2], Uc[3]);
    Yc = CS_M16(o.arb, ub, Yc);
#pragma unroll
    for (int mt = 0; mt < 4; ++mt) zacc[mt] = CS_M16(o.bh[mt], ub, zz[mt]);
#undef CS_M32
#undef CS_M16
    return Yc;
}
template <int z>
__device__ __forceinline__ void scan_phase_z(const Frame& F, const Args& a, const int seq, const int half) {
    unsigned char* ws = a.ws;
    const int b = (seq >> 3) & 3, h = seq & 7;
    const size_t mb = (size_t)b * T;
    const int lane = F.lane, wave = F.wave, fr = lane & 15, fg = lane >> 4;
    constexpr int NCK = T / 16;
    volatile LAS unsigned* flg = (volatile LAS unsigned*)(F.lds + CS_FLAG);
    if (F.tid < 16) flg[F.tid] = 0u;
    __syncthreads();
    const int o16 = fr * 32 + fg * 8;
#define CS_M32(A_, B_, C_) __builtin_amdgcn_mfma_f32_16x16x32_bf16(A_, B_, C_, 0, 0, 0)
#define CS_M16(A_, B_, C_) __builtin_amdgcn_mfma_f32_16x16x16bf16_1k(__builtin_bit_cast(s16x4, A_), __builtin_bit_cast(s16x4, B_), C_, 0, 0, 0)
    if (wave < CS_NCH) {
        const int c = wave, rg = 2 * half + c;
        __builtin_amdgcn_s_setprio(3);
        bf16* yout = (bf16*)(ws + WS_Y) + (size_t)z * M * CW + h * 64 + rg * 16 + fr;
        f32x4 zacc[4];
#pragma unroll
        for (int mt = 0; mt < 4; ++mt) zacc[mt] = (f32x4){0.f, 0.f, 0.f, 0.f};
        ChainOps opA, opB;
#define CS_READY(nn) do { unsigned sp_ = 0; while (flg[(nn) & (CS_R - 1)] != (unsigned)((nn) + 1)) { __builtin_amdgcn_s_sleep(1); if (++sp_ > (1u << 24)) break; } __builtin_amdgcn_fence(__ATOMIC_ACQUIRE, "workgroup"); } while (0)
#define CS_HANDBACK(nn) do { asm volatile("s_waitcnt lgkmcnt(0)" ::: "memory"); if (lane == 0) flg[8 + c] = (unsigned)((nn) + 1); asm volatile("" ::: "memory"); } while (0)
#define CS_YSTORE(nn, Y_) do { asm volatile("s_waitcnt vmcnt(24)" ::: "memory");   _Pragma("unroll") for (int rr = 0; rr < 4; ++rr) { const int q_ = 16 * (nn) + 4 * fg + rr, t_ = z ? (T - 1 - q_) : q_; yout[(mb + t_) * CW] = f2bf((Y_)[rr]); } } while (0)
        CS_READY(0); chain_load(F.lds, fr, fg, c, opA);
#pragma unroll 1
        for (int n = 0; n < NCK; n += 2) {
            CS_READY(n + 1); CS_HANDBACK(n);
            chain_load(F.lds + ((n + 1) & (CS_R - 1)) * CS_SLOT, fr, fg, c, opB);
            { const f32x4 Yc = chain_compute(opA, zacc); CS_YSTORE(n, Yc); }
            if (n + 2 < NCK) CS_READY(n + 2);
            CS_HANDBACK(n + 1);
            if (n + 2 < NCK) chain_load(F.lds + ((n + 2) & (CS_R - 1)) * CS_SLOT, fr, fg, c, opA);
            { const f32x4 Yc = chain_compute(opB, zacc); CS_YSTORE(n + 1, Yc); }
        }
#undef CS_READY
#undef CS_HANDBACK
#undef CS_YSTORE
        __builtin_amdgcn_s_setprio(0);
    } else {
        const int pi = wave - CS_NCH;
        LAS unsigned char* scr = F.lds + CS_SCR + pi * CS_SCRW;
        LAS bf16* KT = (LAS bf16*)scr; LAS bf16* BT = (LAS bf16*)(scr + 2304);
        const bf16* gw_ = (const bf16*)(ws + WS_DECAY) + (size_t)z * M * CW + h * 64;
        const bf16* gkk = (const bf16*)(ws + WS_KK) + h * 64;
        const bf16* gak = (const bf16*)(ws + WS_AKK) + (size_t)z * M * CW + h * 64;
        const bf16* gk = (const bf16*)(ws + WS_KDIR) + (size_t)z * M * CW + h * 64;
        const bf16* gr = (const bf16*)(ws + WS_R) + h * 64;
        const bf16* gv = (const bf16*)(ws + WS_V) + h * 64 + half * 32 + (lane & 31);
        unsigned nw[16], nkk[16], nak[16], nk[16], nr[16], nv[8];
        constexpr long RSTEP = z ? -(long)CW : (long)CW;
#define CS_FETCH_A(nn) do { if ((nn) < NCK) { const size_t m0_ = (mb + (z ? (T - 1 - 16 * (nn)) : 16 * (nn))) * CW + lane; const bf16* pw_ = gw_ + m0_; const bf16* pkk_ = gkk + m0_; \
            _Pragma("unroll") for (int tt = 0; tt < 16; ++tt) { nw[tt] = pw_[tt * RSTEP]; nkk[tt] = pkk_[tt * RSTEP]; } } } while (0)
#define CS_FETCH_B(nn) do { if ((nn) < NCK) { asm volatile("s_waitcnt vmcnt(30)" ::: "memory"); const size_t m0_ = (mb + (z ? (T - 1 - 16 * (nn)) : 16 * (nn))) * CW + lane; const bf16* pak_ = gak + m0_; const bf16* pk_ = gk + m0_; \
            _Pragma("unroll") for (int tt = 0; tt < 16; ++tt) { nak[tt] = pak_[tt * RSTEP]; nk[tt] = pk_[tt * RSTEP]; } } } while (0)
#define CS_FETCH_C(nn) do { if ((nn) < NCK) { asm volatile("s_waitcnt vmcnt(30)" ::: "memory"); const size_t m0_ = (mb + (z ? (T - 1 - 16 * (nn)) : 16 * (nn))) * CW + lane; const bf16* pr_ = gr + m0_; \
            const bf16* pv_ = gv + (mb + (z ? (T - 1 - 16 * (nn) - 8 * (lane >> 5)) : 16 * (nn) + 8 * (lane >> 5))) * CW; \
            _Pragma("unroll") for (int tt = 0; tt < 16; ++tt) nr[tt] = pr_[tt * RSTEP]; \
            _Pragma("unroll") for (int i_ = 0; i_ < 8; ++i_) nv[i_] = pv_[i_ * RSTEP]; } } while (0)
        CS_FETCH_A(pi); CS_FETCH_B(pi); CS_FETCH_C(pi);
#pragma unroll 1
        for (int n = pi; n < NCK; n += CS_NPR) {
            const int slot = n & (CS_R - 1);
            float wv[16], kkv[16], akv[16], kv[16], rv[16]; unsigned vq[8];
#pragma unroll
            for (int tt = 0; tt < 16; ++tt) { unsigned x0 = nw[tt], x1 = nkk[tt], x2 = nak[tt], x3 = nk[tt], x4 = nr[tt];
                asm volatile("" : "+v"(x0), "+v"(x1), "+v"(x2), "+v"(x3), "+v"(x4));
                wv[tt] = __uint_as_float(x0 << 16); kkv[tt] = __uint_as_float(x1 << 16); akv[tt] = __uint_as_float(x2 << 16); kv[tt] = __uint_as_float(x3 << 16); rv[tt] = __uint_as_float(x4 << 16); }
#pragma unroll
            for (int tt = 0; tt < 8; ++tt) { unsigned x0 = nv[tt]; asm volatile("" : "+v"(x0)); vq[tt] = x0; }
            CS_FETCH_A(n + CS_NPR);
            { unsigned sp = 0; for (;;) { const u32x2 pg = *(const volatile LAS u32x2*)(flg + 8); const int mn = (int)min(pg.x, pg.y);
                  if (mn >= n - (CS_R - 3)) break; __builtin_amdgcn_s_sleep(2); if (++sp > (1u << 24)) break; } }
            __builtin_amdgcn_fence(__ATOMIC_ACQUIRE, "workgroup");
            LAS unsigned char* sl = F.lds + slot * CS_SLOT;
            float P[16];
            P[0] = wv[0];
#pragma unroll
            for (int tt = 1; tt < 16; ++tt) P[tt] = P[tt - 1] * wv[tt];
            const float PL = P[15];
            float khat[16], bhat[16];
#pragma unroll
            for (int tt = 0; tt < 16; ++tt) {
                const float pm1 = tt ? P[tt - 1] : 1.0f, inv = __builtin_amdgcn_rcpf(P[tt]);
                const float at = kkv[tt] * pm1, rt = rv[tt] * P[tt], kt = kv[tt] * inv, bt = -akv[tt] * inv;
                khat[tt] = kt * PL; bhat[tt] = bt * PL;
                { const unsigned w_ = cvt_pk_bf16(at, rt); *(LAS bf16*)(sl + CS_AT + (tt * CS_LD + lane) * 2) = (bf16)w_; *(LAS bf16*)(sl + CS_RT + (tt * CS_LD + lane) * 2) = (bf16)(w_ >> 16); }
                { const unsigned w_ = cvt_pk_bf16(kt, bt); KT[tt * CS_LD + lane] = (bf16)w_; BT[tt * CS_LD + lane] = (bf16)(w_ >> 16); }
            }
            CS_FETCH_B(n + CS_NPR);
            { u32x4 o0, o1;
              o0.x = cvt_pk_bf16(khat[0], khat[1]); o0.y = cvt_pk_bf16(khat[2], khat[3]); o0.z = cvt_pk_bf16(khat[4], khat[5]); o0.w = cvt_pk_bf16(khat[6], khat[7]);
              o1.x = cvt_pk_bf16(khat[8], khat[9]); o1.y = cvt_pk_bf16(khat[10], khat[11]); o1.z = cvt_pk_bf16(khat[12], khat[13]); o1.w = cvt_pk_bf16(khat[14], khat[15]);
              *(LAS u32x4*)(sl + CS_KHT + lane * 32) = o0; *(LAS u32x4*)(sl + CS_KHT + lane * 32 + 16) = o1;
              o0.x = cvt_pk_bf16(bhat[0], bhat[1]); o0.y = cvt_pk_bf16(bhat[2], bhat[3]); o0.z = cvt_pk_bf16(bhat[4], bhat[5]); o0.w = cvt_pk_bf16(bhat[6], bhat[7]);
              o1.x = cvt_pk_bf16(bhat[8], bhat[9]); o1.y = cvt_pk_bf16(bhat[10], bhat[11]); o1.z = cvt_pk_bf16(bhat[12], bhat[13]); o1.w = cvt_pk_bf16(bhat[14], bhat[15]);
              *(LAS u32x4*)(sl + CS_BHT + lane * 32) = o0; *(LAS u32x4*)(sl + CS_BHT + lane * 32 + 16) = o1; }
            *(LAS float*)(sl + CS_PL + lane * 4) = PL;
            { u32x4 o0;
              o0.x = vq[0] | (vq[1] << 16); o0.y = vq[2] | (vq[3] << 16); o0.z = vq[4] | (vq[5] << 16); o0.w = vq[6] | (vq[7] << 16);
              *(LAS u32x4*)(sl + CS_VT + (lane & 31) * 32 + (lane >> 5) * 16) = o0; }
            asm volatile("s_waitcnt lgkmcnt(0)" ::: "memory");
            bf16x8 af[2], rf[2], kf[2], bf_[2];
#pragma unroll
            for (int ks = 0; ks < 2; ++ks) { af[ks] = *(const LAS bf16x8*)(sl + CS_AT + (fr * CS_LD + 32 * ks + 8 * fg) * 2); rf[ks] = *(const LAS bf16x8*)(sl + CS_RT + (fr * CS_LD + 32 * ks + 8 * fg) * 2);
                kf[ks] = *(const LAS bf16x8*)(KT + fr * CS_LD + 32 * ks + 8 * fg); bf_[ks] = *(const LAS bf16x8*)(BT + fr * CS_LD + 32 * ks + 8 * fg); }
            const f32x4 zero4 = {0.f, 0.f, 0.f, 0.f};
            f32x4 Xc = zero4, Xt = zero4, AakT = zero4, ArbT = zero4, ArkT = zero4;
#pragma unroll
            for (int ks = 0; ks < 2; ++ks) { Xc = CS_M32(af[ks], bf_[ks], Xc); Xt = CS_M32(bf_[ks], af[ks], Xt);
                AakT = CS_M32(kf[ks], af[ks], AakT); ArbT = CS_M32(bf_[ks], rf[ks], ArbT); ArkT = CS_M32(kf[ks], rf[ks], ArkT); }
            CS_FETCH_C(n + CS_NPR);
            f32x4 S1;
#pragma unroll
            for (int rr = 0; rr < 4; ++rr) { const int q = 4 * fg + rr;
                Xc[rr] = (fr < q) ? Xc[rr] : 0.f; Xt[rr] = (q < fr) ? Xt[rr] : 0.f; S1[rr] = Xt[rr] + ((q == fr) ? 1.0f : 0.f);
                AakT[rr] = (q < fr) ? AakT[rr] : 0.f; ArkT[rr] = (q <= fr) ? ArkT[rr] : 0.f; ArbT[rr] = (q <= fr) ? ArbT[rr] : 0.f; }
            { u32x2 w; w.x = cvt_pk_bf16(AakT[0], AakT[1]); w.y = cvt_pk_bf16(AakT[2], AakT[3]); *(LAS u32x2*)(sl + CS_AAK + o16) = w;
              w.x = cvt_pk_bf16(ArkT[0], ArkT[1]); w.y = cvt_pk_bf16(ArkT[2], ArkT[3]); *(LAS u32x2*)(sl + CS_ARK + o16) = w;
              w.x = cvt_pk_bf16(ArbT[0], ArbT[1]); w.y = cvt_pk_bf16(ArbT[2], ArbT[3]); *(LAS u32x2*)(sl + CS_ARB + o16) = w; }
#define CS_PK(v) ((u32x2){cvt_pk_bf16((v)[0], (v)[1]), cvt_pk_bf16((v)[2], (v)[3])})
            const u32x2 xc = CS_PK(Xc), xt = CS_PK(Xt), s1 = CS_PK(S1);
            const f32x4 X2c = CS_M16(xt, xc, zero4), X2t = CS_M16(xc, xt, zero4);
            const u32x2 x2c = CS_PK(X2c), x2t = CS_PK(X2t);
            const f32x4 S2 = CS_M16(x2c, s1, S1);
            const f32x4 X4c = CS_M16(x2t, x2c, zero4), X4t = CS_M16(x2c, x2t, zero4);
            const u32x2 x4c = CS_PK(X4c), x4t = CS_PK(X4t), s2 = CS_PK(S2);
            const f32x4 S4 = CS_M16(x4c, s2, S2);
            const f32x4 X8c = CS_M16(x4t, x4c, zero4);
            const u32x2 x8c = CS_PK(X8c), s4 = CS_PK(S4);
            const f32x4 S8 = CS_M16(x8c, s4, S4);
            *(LAS u32x2*)(sl + CS_TT + o16) = CS_PK(S8);
#undef CS_PK
            asm volatile("s_waitcnt lgkmcnt(0)" ::: "memory");
            __builtin_amdgcn_fence(__ATOMIC_RELEASE, "workgroup");
            if (lane == 0) flg[slot] = (unsigned)(n + 1);
        }
#undef CS_FETCH_A
#undef CS_FETCH_B
#undef CS_FETCH_C
    }
#undef CS_M32
#undef CS_M16
    __syncthreads();
}

__device__ __forceinline__ void scan_phase(const Frame& F, const Args& a, const int idx) {
    const int seq = idx >> 1, half = idx & 1;
    if (seq >> 5) scan_phase_z<1>(F, a, seq, half); else scan_phase_z<0>(F, a, seq, half);
}

__device__ __forceinline__ void combine_phase(const Frame& F, const Args& a) {
    unsigned char* ws = a.ws;
    const bf16* att = (const bf16*)(ws + WS_ATT); const bf16* rr = (const bf16*)(ws + WS_R); const bf16* vv = (const bf16*)(ws + WS_V);
    const bf16* kd = (const bf16*)(ws + WS_KDIR); const bf16* gg = (const bf16*)(ws + WS_G); const bf16* y = (const bf16*)(ws + WS_Y);
    bf16* mix = (bf16*)(ws + WS_MIX);
    const float* anw = a.in[4]; const float* r_k = a.in[14]; const float* ln_w = a.in[15]; const float* ln_b = a.in[16];
    const int lane = F.lane, c0 = 8 * lane;
    float nw[8], rk[8], lw[8], lb[8];
#pragma unroll
    for (int i = 0; i < 8; ++i) { nw[i] = anw[c0 + i]; rk[i] = r_k[c0 + i]; lw[i] = ln_w[c0 + i]; lb[i] = ln_b[c0 + i]; }
    const int gw = F.vcu * 8 + F.wave, NGW = F.G * 8;
#pragma unroll 2
    for (int m = gw; m < M; m += NGW) {
        const size_t o = (size_t)m * CW + c0;
        float f[8];
        unpack8(*(const u32x4*)(att + o), f);
        float ss = 0.f;
#pragma unroll
        for (int i = 0; i < 8; ++i) ss += f[i] * f[i];
        const float rs = rsqrtf(wave_sum(ss) * (1.f / CW) + RMS_EPS);
#pragma unroll
        for (int i = 0; i < 8; ++i) f[i] = f[i] * rs * nw[i];
        *(u32x4*)(mix + (size_t)m * D + c0) = pack8(f);
        float yv[8], yw[8];
        unpack8(*(const u32x4*)(y + o), yv); unpack8(*(const u32x4*)(y + (size_t)M * CW + o), yw);
#pragma unroll
        for (int i = 0; i < 8; ++i) yv[i] += yw[i];
        float s1 = 0.f;
#pragma unroll
        for (int i = 0; i < 8; ++i) s1 += yv[i];
        s1 += __shfl_xor(s1, 1); s1 += __shfl_xor(s1, 2); s1 += __shfl_xor(s1, 4);
        const float mean = s1 * (1.f / 64.f);
        float s2 = 0.f;
#pragma unroll
        for (int i = 0; i < 8; ++i) { yv[i] -= mean; s2 += yv[i] * yv[i]; }
        s2 += __shfl_xor(s2, 1); s2 += __shfl_xor(s2, 2); s2 += __shfl_xor(s2, 4);
        const float rstd = rsqrtf(s2 * (1.f / 64.f) + GN_EPS);
        float rf[8], k0[8], k1[8], vf[8], gf[8];
        unpack8(*(const u32x4*)(rr + o), rf); unpack8(*(const u32x4*)(kd + o), k0); unpack8(*(const u32x4*)(kd + (size_t)M * CW + o), k1);
        unpack8(*(const u32x4*)(vv + o), vf); unpack8(*(const u32x4*)(gg + o), gf);
        float cf = 0.f;
#pragma unroll
        for (int i = 0; i < 8; ++i) cf += rf[i] * (k0[i] + k1[i]) * rk[i];
        cf += __shfl_xor(cf, 1); cf += __shfl_xor(cf, 2); cf += __shfl_xor(cf, 4);
#pragma unroll
        for (int i = 0; i < 8; ++i) f[i] = (yv[i] * rstd * lw[i] + lb[i] + cf * vf[i]) * gf[i];
        *(u32x4*)(mix + (size_t)m * D + CW + c0) = pack8(f);
    }
}

constexpr int RT_PITCH = 1032, RT_WH = 0, RT_WL = 32 * RT_PITCH * 2, RT_HIST = 2 * RT_WL, RT_EL = RT_HIST + 256;
__device__ __forceinline__ void router_phase(const Frame& F, const Args& a) {
    unsigned char* ws = a.ws;
    const bf16* hbuf = (const bf16*)(ws + WS_H); unsigned char* hn2 = ws + WS_HN2;
    int* eidx = (int*)(ws + WS_EIDX); float* gate = (float*)(ws + WS_GATE); int* rank = (int*)(ws + WS_RANK);
    unsigned* ctl = (unsigned*)(ws + WS_CTL);
    const float* n2w = a.in[18]; const float* rw = a.in[19]; const float* rb = a.in[20];
    LAS bf16* wh = (LAS bf16*)(F.lds + RT_WH); LAS bf16* wl = (LAS bf16*)(F.lds + RT_WL); LAS int* hist = (LAS int*)(F.lds + RT_HIST); LAS int* eL = (LAS int*)(F.lds + RT_EL);
    { f32x4 tmp[16];
#pragma unroll
      for (int j = 0; j < 16; ++j) tmp[j] = *((const f32x4*)rw + F.tid + 512 * j);
#pragma unroll
      for (int j = 0; j < 16; ++j) { const int q = F.tid + 512 * j, d = q >> 3, e0 = 4 * (q & 7);
#pragma unroll
          for (int i = 0; i < 4; ++i) { const float w = tmp[j][i]; const unsigned hb = cvt_pk_bf16(w, 0.f) & 0xffffu; const float lo = w - __uint_as_float(hb << 16);
              wh[(e0 + i) * RT_PITCH + d] = (bf16)hb; wl[(e0 + i) * RT_PITCH + d] = (bf16)cvt_pk_bf16(lo, 0.f); } } }
    if (F.tid < 32) hist[F.tid] = 0;
    __syncthreads();
    const int lane = F.lane, tk = lane & 15, g = lane >> 4;
    const int blk = F.vcu;
    const int m = blk * 128 + F.wave * 16 + tk;
    const bf16* hrow = hbuf + (size_t)m * D + 8 * g;
    float ss = 0.f;
#pragma unroll 8
    for (int ks = 0; ks < 32; ++ks) { float xf[8]; unpack8(*(const u32x4*)(hrow + 32 * ks), xf);
        ss += (xf[0] * xf[0] + xf[1] * xf[1]) + (xf[2] * xf[2] + xf[3] * xf[3]) + (xf[4] * xf[4] + xf[5] * xf[5]) + (xf[6] * xf[6] + xf[7] * xf[7]); }
    ss += __shfl_xor(ss, 16); ss += __shfl_xor(ss, 32);
    const float rs = rsqrtf(ss * (1.f / D) + RMS_EPS);
    f32x4 acc0 = {0.f, 0.f, 0.f, 0.f}, acc1 = acc0;
    unsigned char* hrow8 = hn2 + (size_t)m * D + 8 * g;
    const LAS bf16* wh0 = wh + tk * RT_PITCH + 8 * g; const LAS bf16* wl0 = wl + tk * RT_PITCH + 8 * g;
#pragma unroll 4
    for (int ks = 0; ks < 32; ++ks) {
        float xf[8]; unpack8(*(const u32x4*)(hrow + 32 * ks), xf);
        const f32x4 x0 = {xf[0], xf[1], xf[2], xf[3]}, x1 = {xf[4], xf[5], xf[6], xf[7]};
        const f32x4 n0 = *(const f32x4*)(n2w + 32 * ks + 8 * g), n1 = *(const f32x4*)(n2w + 32 * ks + 8 * g + 4);
        const f32x4 y0 = x0 * rs * n0, y1 = x1 * rs * n1;
        { u32x2 w8; w8.x = pk4_fp8(y0.x * F8_SX, y0.y * F8_SX, y0.z * F8_SX, y0.w * F8_SX); w8.y = pk4_fp8(y1.x * F8_SX, y1.y * F8_SX, y1.z * F8_SX, y1.w * F8_SX); *(u32x2*)(hrow8 + 32 * ks) = w8; }
        union { u32x4 w; bf16x8 h8; } xh, xl;
        xh.w.x = cvt_pk_bf16(y0.x, y0.y); xh.w.y = cvt_pk_bf16(y0.z, y0.w); xh.w.z = cvt_pk_bf16(y1.x, y1.y); xh.w.w = cvt_pk_bf16(y1.z, y1.w);
        xl.w.x = cvt_pk_bf16(y0.x - bflo(xh.w.x), y0.y - bfhi(xh.w.x)); xl.w.y = cvt_pk_bf16(y0.z - bflo(xh.w.y), y0.w - bfhi(xh.w.y));
        xl.w.z = cvt_pk_bf16(y1.x - bflo(xh.w.z), y1.y - bfhi(xh.w.z)); xl.w.w = cvt_pk_bf16(y1.z - bflo(xh.w.w), y1.w - bfhi(xh.w.w));
        const bf16x8 a0h = *(const LAS bf16x8*)(wh0 + 32 * ks), a1h = *(const LAS bf16x8*)(wh0 + 16 * RT_PITCH + 32 * ks);
        const bf16x8 a0l = *(const LAS bf16x8*)(wl0 + 32 * ks), a1l = *(const LAS bf16x8*)(wl0 + 16 * RT_PITCH + 32 * ks);
        acc0 = __builtin_amdgcn_mfma_f32_16x16x32_bf16(a0h, xh.h8, acc0, 0, 0, 0); acc1 = __builtin_amdgcn_mfma_f32_16x16x32_bf16(a1h, xh.h8, acc1, 0, 0, 0);
        acc0 = __builtin_amdgcn_mfma_f32_16x16x32_bf16(a0h, xl.h8, acc0, 0, 0, 0); acc1 = __builtin_amdgcn_mfma_f32_16x16x32_bf16(a1h, xl.h8, acc1, 0, 0, 0);
        acc0 = __builtin_amdgcn_mfma_f32_16x16x32_bf16(a0l, xh.h8, acc0, 0, 0, 0); acc1 = __builtin_amdgcn_mfma_f32_16x16x32_bf16(a1l, xh.h8, acc1, 0, 0, 0);
    }
    float lv[8]; int li[8];
    { const f32x4 b0 = *(const f32x4*)(rb + 4 * g), b1 = *(const f32x4*)(rb + 16 + 4 * g);
#pragma unroll
      for (int i = 0; i < 4; ++i) { lv[i] = acc0[i] + b0[i]; li[i] = 4 * g + i; lv[4 + i] = acc1[i] + b1[i]; li[4 + i] = 16 + 4 * g + i; } }
    float tv[4]; int ti[4];
#pragma unroll
    for (int kx = 0; kx < 4; ++kx) {
        float bv = lv[0]; int bi = li[0];
#pragma unroll
        for (int i = 1; i < 8; ++i) { const bool gt = lv[i] > bv; bv = gt ? lv[i] : bv; bi = gt ? li[i] : bi; }
#pragma unroll
        for (int o = 16; o < 64; o <<= 1) { const float ov = __shfl_xor(bv, o); const int oi = __shfl_xor(bi, o); const bool tko = (ov > bv) || (ov == bv && oi < bi); bv = tko ? ov : bv; bi = tko ? oi : bi; }
        tv[kx] = bv; ti[kx] = bi;
#pragma unroll
        for (int i = 0; i < 8; ++i) lv[i] = (li[i] == bi) ? -3.0e38f : lv[i];
    }
    if (g == 0) {
        const float e0 = 1.0f, e1 = __expf(tv[1] - tv[0]), e2 = __expf(tv[2] - tv[0]), e3 = __expf(tv[3] - tv[0]);
        const float is = 1.0f / (e0 + e1 + e2 + e3);
        const float gs[4] = {e0 * is, e1 * is, e2 * is, e3 * is};
#pragma unroll
        for (int kx = 0; kx < 4; ++kx) { eidx[m * 4 + kx] = ti[kx]; gate[m * 4 + kx] = gs[kx]; eL[(m - blk * 128) * 4 + kx] = ti[kx]; }
    }
    __syncthreads();
    { const int t = F.tid, e = eL[t]; int rk = 0;
      for (int u = 0; u < t; ++u) rk += (eL[u] == e) ? 1 : 0;
      rank[(blk * 128) * 4 + t] = rk;
      __hip_atomic_fetch_add(&hist[e], 1, __ATOMIC_RELAXED, __HIP_MEMORY_SCOPE_WORKGROUP); }
    __syncthreads();
    if (F.tid < 32) ctl[CW_CNT + blk * 32 + F.tid] = (unsigned)hist[F.tid];
}

__device__ __forceinline__ void dispatch_phase(const Frame& F, const Args& a) {
    unsigned char* ws = a.ws;
    unsigned* ctl = (unsigned*)(ws + WS_CTL);
    const int* eidx = (const int*)(ws + WS_EIDX); const int* rank = (const int*)(ws + WS_RANK); int* dest = (int*)(ws + WS_DEST);
    LAS int* part = (LAS int*)F.lds;
    LAS int* tot = part + 1024;
    const int blk = F.vcu, G = F.G;
    { const int e = F.tid & 31, pt = F.tid >> 5; int s = 0, sb = 0;
      if (G == 256) { int cv[16];
#pragma unroll
          for (int q = 0; q < 16; ++q) cv[q] = (int)ld_u32_agent(ctl + CW_CNT + (pt + 16 * q) * 32 + e);
#pragma unroll
          for (int q = 0; q < 16; ++q) { s += cv[q]; if (pt + 16 * q < blk) sb += cv[q]; } }
      else for (int bb = pt; bb < G; bb += 16) { const int cval = (int)ld_u32_agent(ctl + CW_CNT + bb * 32 + e); s += cval; if (bb < blk) sb += cval; }
      part[pt * 32 + e] = s; part[512 + pt * 32 + e] = sb; }
    __syncthreads();
    if (F.tid < 32) { int s = 0, sb = 0;
        for (int pt = 0; pt < 16; ++pt) { s += part[pt * 32 + F.tid]; sb += part[512 + pt * 32 + F.tid]; }
        tot[F.tid] = s; tot[32 + F.tid] = sb; tot[96 + F.tid] = (s + 255) & ~255; }
    __syncthreads();
    if (F.tid == 0) { int ps = 0; for (int e = 0; e < 32; ++e) { tot[64 + e] = ps; ps += tot[96 + e]; }
        tot[128] = ps >> 8; }
    __syncthreads();
    if (blk == 0) {
        if (F.tid == 0) ctl[CW_NT] = (unsigned)tot[128];
        for (int e = F.tid >> 4; e < 32; e += 32) { const int t0 = tot[64 + e] >> 8, nt = tot[96 + e] >> 8; for (int i = F.tid & 15; i < nt; i += 16) ctl[CW_TEXP + t0 + i] = (unsigned)e; }
    }
    const int lane = F.lane;
    const int mw = blk * 128 + F.wave * 16;
    int* rowtok = (int*)(ws + WS_ROWTOK);
    { const int e = eidx[mw * 4 + lane]; const int dl = tot[64 + e] + tot[32 + e] + rank[mw * 4 + lane]; dest[mw * 4 + lane] = dl; rowtok[dl] = mw + (lane >> 2); }
    { const int e = blk & 31, pt = blk >> 5, np = G >> 5; const int r0 = tot[64 + e] + tot[e], r1 = tot[64 + e] + tot[96 + e];
      if (np > 0) for (int r = r0 + pt * 512 + F.tid; r < r1; r += np * 512) rowtok[r] = 0; }
}

__device__ __forceinline__ void final_phase(const Frame& F, const Args& a) {
    unsigned char* ws = a.ws;
    const bf16* hbuf = (const bf16*)(ws + WS_H); const unsigned char* ybuf = ws + WS_YBUF;
    const int* dest = (const int*)(ws + WS_DEST); const float* gate = (const float*)(ws + WS_GATE);
    const float* fw = a.in[25]; float* out = a.out;
    const int lane = F.lane;
    f32x4 wn[4];
#pragma unroll
    for (int j = 0; j < 4; ++j) wn[j] = *((const f32x4*)fw + lane + 64 * j);
    const int gw = F.vcu * 8 + F.wave, NGW = F.G * 8;
    const int per = M / NGW;
    const int mw = gw * per;
    int dl = 0; float gl = 0.f;
    if (lane < 4 * per && per <= 16) { dl = dest[mw * 4 + lane]; gl = gate[mw * 4 + lane]; }
#pragma unroll 2
    for (int i = 0; i < per; ++i) {
        const int m = mw + i;
        const u32x2* hr = (const u32x2*)(hbuf + (size_t)m * D) + lane;
        f32x4 v[4];
#pragma unroll
        for (int j = 0; j < 4; ++j) { const u32x2 w = hr[64 * j]; v[j] = (f32x4){bflo(w.x), bfhi(w.x), bflo(w.y), bfhi(w.y)}; }
#pragma unroll
        for (int kx = 0; kx < 4; ++kx) {
            const int d = per <= 16 ? __shfl(dl, 4 * i + kx) : dest[m * 4 + kx]; const float gt = (per <= 16 ? __shfl(gl, 4 * i + kx) : gate[m * 4 + kx]) * (1.0f / F8_SY);
            const unsigned* yr = (const unsigned*)(ybuf + (size_t)d * D) + lane;
#pragma unroll
            for (int j = 0; j < 4; ++j) { const unsigned w = yr[64 * j]; const f32x2 lo = __builtin_amdgcn_cvt_pk_f32_fp8((int)w, false), hi = __builtin_amdgcn_cvt_pk_f32_fp8((int)w, true);
                v[j].x += gt * lo.x; v[j].y += gt * lo.y; v[j].z += gt * hi.x; v[j].w += gt * hi.y; }
        }
        float s = 0.f;
#pragma unroll
        for (int j = 0; j < 4; ++j) s += (v[j].x * v[j].x + v[j].y * v[j].y) + (v[j].z * v[j].z + v[j].w * v[j].w);
        const float rs = rsqrtf(wave_sum(s) * (1.f / D) + RMS_EPS);
        f32x4* orow = (f32x4*)(out + (size_t)m * D) + lane;
#pragma unroll
        for (int j = 0; j < 4; ++j) orow[64 * j] = v[j] * rs * wn[j];
    }
}

__global__ void __launch_bounds__(512, 2) fwd_megakernel(Args args) {
    extern __shared__ __attribute__((aligned(16))) unsigned char lds_raw[];
    Frame F;
    F.lds = (LAS unsigned char*)lds_raw;
    F.tid = threadIdx.x; F.lane = F.tid & 63; F.wave = __builtin_amdgcn_readfirstlane(F.tid >> 6);
    F.G = gridDim.x; { const int bx = blockIdx.x; F.vcu = (F.G % 8 == 0) ? (bx % 8) * (F.G / 8) + bx / 8 : bx; }
    unsigned char* ws = args.ws;
    const int lo = args.ph_lo, hi = args.ph_hi;
#define IN(k) (lo <= (k) && (k) < hi)
#if MK_SPLIT
#define SEAM(k) do { } while (0)
#else
    cg::grid_group grid = cg::this_grid();
    { volatile LAS unsigned* st = (volatile LAS unsigned*)(F.lds + LDS_MISC); if (F.tid < 2) st[F.tid] = 0u; __syncthreads(); }
    const XcdBarrier xbar = xcd_barrier_post((unsigned*)(ws + WS_CTL) + CW_BAR, (volatile LAS unsigned*)(F.lds + LDS_MISC));
    if (lo < 0) grid.sync();
#define SEAM(k) do { if (IN(k) && IN((k) + 1)) xcd_barrier(xbar); } while (0)
#endif
#define REP2(k) if constexpr (((MK_REPEAT >> (k)) & 1) != 0)
#define PH1 { pg8::Gemm g{(const bf16*)(ws + WS_HN), (const bf16*)(ws + WS_WINT), 1024, nullptr, 0, nullptr}; \
        pg8::StaticOrder S; S.init(M / 256, NPROJ_PAD / 256, F.G, (int)blockIdx.x); \
        pg8::EpiProj E{(bf16*)(ws + WS_Q), (bf16*)(ws + WS_K), (bf16*)(ws + WS_VT), (bf16*)(ws + WS_P)}; \
        pg8::gemm_phase<pg8::EpiProj, true, true>(F.lds, g, S, E); }
#define PH5 { pg8::Gemm g{(const bf16*)(ws + WS_MIX), (const bf16*)(ws + WS_WOT), 1024, nullptr, 0, nullptr}; \
        pg8::StaticOrder S; S.init(M / 256, D / 256, F.G, (int)blockIdx.x); \
        pg8::EpiWo E{args.in[0], (bf16*)(ws + WS_H)}; \
        pg8::gemm_phase<pg8::EpiWo, true, true>(F.lds, g, S, E); }
#define PH8 { const unsigned* ctl = (const unsigned*)(ws + WS_CTL); const int ntile = (int)ld_u32_agent(ctl + CW_NT); \
        pg8::Gemm g{(const bf16*)(ws + WS_HN2), (const bf16*)(ws + WS_WUPT), 512, ctl + CW_TEXP, (size_t)2048 * 1024, (const int*)(ws + WS_ROWTOK)}; \
        pg8::StaticOrder S; S.init(ntile, 8, F.G, (int)blockIdx.x); \
        pg8::EpiUp E{args.in[22], ws + WS_ACT}; \
        pg8::gemm_phase<pg8::EpiUp, true, true, true, true>(F.lds, g, S, E); }
#define PH9 { const unsigned* ctl = (const unsigned*)(ws + WS_CTL); const int ntile = (int)ld_u32_agent(ctl + CW_NT); \
        pg8::Gemm g{(const bf16*)(ws + WS_ACT), (const bf16*)(ws + WS_WDNT), 512, ctl + CW_TEXP, (size_t)1024 * 1024, nullptr}; \
        pg8::StaticOrder S; S.init(ntile, 4, F.G, (int)blockIdx.x); \
        pg8::EpiDown E{args.in[24], ws + WS_YBUF}; \
        pg8::gemm_phase<pg8::EpiDown, true, true, false, true>(F.lds, g, S, E); }
    if (IN(0)) { p0_prologue(F, args); REP2(0) p0_prologue(F, args); }
    SEAM(0);
    if (IN(1)) { PH1 REP2(1) PH1 }
    SEAM(1);
    if (IN(2)) { prep_phase<true>(F, args); REP2(2) prep_phase<true>(F, args); }
    SEAM(2);
    if (IN(3)) {
        if ((F.vcu & 1) == 0 && (F.vcu >> 1) < 128) { scan_phase(F, args, F.vcu >> 1); REP2(3) scan_phase(F, args, F.vcu >> 1); }
        else { const int nside = F.G - min((F.G + 1) / 2, 128); const int q_ = min((F.vcu + 1) >> 1, 128); side_phase(F, args, F.vcu - q_, nside); REP2(11) side_phase(F, args, F.vcu - q_, nside); }
    }
    SEAM(3);
    if (IN(4)) { combine_phase(F, args); REP2(4) combine_phase(F, args); }
    SEAM(4);
    if (IN(5)) { PH5 REP2(5) PH5 }
    SEAM(5);
    if (IN(6)) { router_phase(F, args); REP2(6) { __syncthreads(); router_phase(F, args); } }
    SEAM(6);
    if (IN(7)) { dispatch_phase(F, args); REP2(7) { __syncthreads(); dispatch_phase(F, args); } }
    SEAM(7);
    if (IN(8)) { PH8 REP2(8) PH8 }
    SEAM(8);
    if (IN(9)) { PH9 REP2(9) PH9 }
    SEAM(9);
    if (IN(10)) { final_phase(F, args); REP2(10) final_phase(F, args); }
#undef IN
#undef SEAM
}

extern "C" void kernel_launch(void* const* d_in, const int* in_sizes, int n_in, void* d_out, int out_size, void* d_ws, size_t ws_size, hipStream_t stream) {
    static int grid = 0;
    if (grid == 0) {
        if (n_in != 26 || in_sizes[0] != M * D || out_size != M * D || ws_size < WS_END) { fprintf(stderr, "kernel_launch: unexpected problem (n_in %d, in0 %d, out %d, ws %zu)\n", n_in, n_in > 0 ? in_sizes[0] : -1, out_size, ws_size); grid = -1; return; }
        int dev = 0, cus = 0, per_cu = 0;
        if (hipGetDevice(&dev) != hipSuccess || hipDeviceGetAttribute(&cus, hipDeviceAttributeMultiprocessorCount, dev) != hipSuccess) { grid = -1; return; }
        if (hipFuncSetAttribute((const void*)fwd_megakernel, hipFuncAttributeMaxDynamicSharedMemorySize, LDS_BYTES) != hipSuccess) { fprintf(stderr, "kernel_launch: hipFuncSetAttribute failed\n"); grid = -1; return; }
        if (hipOccupancyMaxActiveBlocksPerMultiprocessor(&per_cu, (const void*)fwd_megakernel, 512, LDS_BYTES) != hipSuccess || per_cu < 1) { fprintf(stderr, "kernel_launch: occupancy query says %d\n", per_cu); per_cu = 1; }
        (void)hipGetLastError();
        grid = cus * 1;
        if (grid != 256) fprintf(stderr, "kernel_launch: note: %d CUs\n", cus);
    }
    if (grid < 0) return;
    if (hipMemsetAsync((char*)d_ws + WS_CTL + (size_t)CW_BAR * 4, 0, XCD_BAR_WORDS * 4, stream) != hipSuccess) { fprintf(stderr, "kernel_launch: memset failed\n"); return; }
    Args a{};
    for (int i = 0; i < 26; ++i) a.in[i] = (const float*)d_in[i];
    a.out = (float*)d_out; a.ws = (unsigned char*)d_ws;
#if MK_SPLIT
    for (int ph = 0; ph < NPHASE; ++ph) { a.ph_lo = ph; a.ph_hi = ph + 1; hipLaunchKernelGGL(fwd_megakernel, dim3(grid), dim3(512), LDS_BYTES, stream, a); }
#else
    a.ph_lo = 0; a.ph_hi = NPHASE;
    void* kargs[] = {&a};
    hipError_t e = hipLaunchCooperativeKernel((const void*)fwd_megakernel, dim3(grid), dim3(512), kargs, LDS_BYTES, stream);
    if (e != hipSuccess) fprintf(stderr, "kernel_launch: cooperative launch failed: %s (grid %d)\n", hipGetErrorString(e), grid);
#endif
}
```

```cpp
#include <hip/hip_runtime.h>
#include <hip/hip_cooperative_groups.h>
#include <cstdio>
#include <cstdint>
namespace cg = cooperative_groups;

#ifndef MK_SPLIT
#define MK_SPLIT 0
#endif

#ifndef MK_REPEAT
#define MK_REPEAT 0
#endif
#define LAS __attribute__((address_space(3)))
typedef unsigned short bf16;
typedef float f32x4 __attribute__((ext_vector_type(4)));
typedef float f32x2 __attribute__((ext_vector_type(2)));
typedef unsigned u32x4 __attribute__((ext_vector_type(4)));
typedef unsigned u32x2 __attribute__((ext_vector_type(2)));
typedef short bf16x8 __attribute__((ext_vector_type(8)));
typedef short s16x4 __attribute__((ext_vector_type(4)));

constexpr int BATCH = 4, T = 8192, D = 1024, M = BATCH * T;
constexpr int NH = 8, HD = 64, CW = 512;
constexpr int SHIFT_W = 1920, NPROJ = 3456, NPROJ_PAD = 3584, PW = 2048;
constexpr int NE = 32, TOPK = 4, DE = 1024;
constexpr int GRIDW = 64, GROWS = 128;
constexpr int P_TILES_MAX = 544, P_ROWS = P_TILES_MAX * 256;
constexpr float RMS_EPS = 1e-5f, GN_EPS = 64e-5f;
constexpr int NPHASE = 11;

constexpr size_t MiB = 1u << 20;
constexpr size_t WS_CTL = 0;
constexpr size_t WS_W2T = 1 * MiB, WS_A2T = WS_W2T + 131072, WS_G2T = WS_A2T + 131072;
constexpr size_t WS_WINT = 2 * MiB, WS_WOT = 9 * MiB, WS_WUPT = 12 * MiB, WS_WDNT = 140 * MiB;
constexpr size_t WS_EIDX = 204 * MiB, WS_GATE = WS_EIDX + 524288, WS_RANK = WS_GATE + 524288, WS_DEST = WS_RANK + 524288, WS_ROWTOK = WS_DEST + 524288;
constexpr size_t WS_R = 208 * MiB, WS_V = 240 * MiB, WS_KK = 272 * MiB, WS_DECAY = 304 * MiB, WS_KDIR = 368 * MiB, WS_AKK = 432 * MiB,
                 WS_G = 496 * MiB, WS_ATT = 528 * MiB;
constexpr size_t WS_Q = 560 * MiB, WS_K = 592 * MiB, WS_VT = 624 * MiB, WS_P = 656 * MiB, WS_HN = 784 * MiB, WS_Y = 848 * MiB;
constexpr size_t WS_MIX = 560 * MiB, WS_H = 752 * MiB, WS_HN2 = 880 * MiB, WS_XBUF = 208 * MiB, WS_ACT = 480 * MiB, WS_YBUF = 208 * MiB;
constexpr size_t WS_END = 976 * MiB;
constexpr int CW_NT = 0, CW_TEXP = 64, CW_CNT = 1024, CW_BAR = 16384;

constexpr int LDS_BYTES = 159744, LDS_MISC = LDS_BYTES - 256;

typedef __bf16 bf16x2_t __attribute__((ext_vector_type(2)));
__device__ __forceinline__ unsigned cvt_pk_bf16(float lo, float hi) { const f32x2 v = {lo, hi}; return __builtin_bit_cast(unsigned, __builtin_convertvector(v, bf16x2_t)); }
typedef int i32x8 __attribute__((ext_vector_type(8)));
typedef int i32x4 __attribute__((ext_vector_type(4)));
#ifndef F8_SCALE1
#define F8_SCALE1 0
#endif
constexpr float F8_SX = 32.0f, F8_SW = 128.0f, F8_SACT = 8.0f, F8_SY = 32.0f;
__device__ __forceinline__ float f8clamp(float v) { return __builtin_amdgcn_fmed3f(v, -448.0f, 448.0f); }
__device__ __forceinline__ unsigned pk4_fp8(float a, float b, float c, float d) { int w = 0; w = __builtin_amdgcn_cvt_pk_fp8_f32(f8clamp(a), f8clamp(b), w, false); w = __builtin_amdgcn_cvt_pk_fp8_f32(f8clamp(c), f8clamp(d), w, true); return (unsigned)w; }
__device__ __forceinline__ float bflo(unsigned u) { return __uint_as_float(u << 16); }
__device__ __forceinline__ float bfhi(unsigned u) { return __uint_as_float(u & 0xffff0000u); }
__device__ __forceinline__ float bf1(bf16 v) { return __uint_as_float(((unsigned)v) << 16); }
__device__ __forceinline__ void unpack8(const u32x4 u, float* f) { f[0] = bflo(u.x); f[1] = bfhi(u.x); f[2] = bflo(u.y); f[3] = bfhi(u.y); f[4] = bflo(u.z); f[5] = bfhi(u.z); f[6] = bflo(u.w); f[7] = bfhi(u.w); }
__device__ __forceinline__ u32x4 pack8(const float* f) { u32x4 o; o.x = cvt_pk_bf16(f[0], f[1]); o.y = cvt_pk_bf16(f[2], f[3]); o.z = cvt_pk_bf16(f[4], f[5]); o.w = cvt_pk_bf16(f[6], f[7]); return o; }
__device__ __forceinline__ float wave_sum(float v) {
#pragma unroll
    for (int o = 1; o < 64; o <<= 1) v += __shfl_xor(v, o);
    return v;
}
__device__ __forceinline__ float sigmoidf_(float x) { return __builtin_amdgcn_rcpf(1.0f + __expf(-x)); }
__device__ __forceinline__ unsigned ld_u32_agent(const unsigned* p) { return __hip_atomic_load(p, __ATOMIC_RELAXED, __HIP_MEMORY_SCOPE_AGENT); }

namespace pg8 {
constexpr int BM = 256, BK = 64, HALF = 128, HTB = HALF * BK * 2, STAGE_BYTES = 8 * HTB, NXCD = 8, WGM = 8;
__host__ __device__ __forceinline__ int lds_byte(int r, int c) { const int st = (r >> 4) * 2 + (c >> 5), rr = r & 15, cc = c & 31, ob = rr * 64 + cc * 2; return st * 1024 + (ob ^ (((ob >> 9) & 1) << 5)); }
__host__ __device__ __forceinline__ void stage_rc(int b, int& R, int& C) { const int st = b / 1024, sb = b % 1024, swz = sb ^ (((sb >> 9) & 1) << 5); R = (st >> 1) * 16 + swz / 64; C = (st & 1) * 32 + (swz % 64) / 2; }
__host__ __device__ __forceinline__ int perm32(int rho) { const int n = rho >> 4, i = rho & 15; return 8 * (i >> 2) + 4 * n + (i & 3); }

struct Unit { int pm, pn, e; };
struct Gemm { const bf16* A; const bf16* Bt; int K; const unsigned* texp; size_t bstride; const int* rowtok; };

struct StaticOrder {
    int nM, nN, nwg, G, c;
    __device__ void init(int nM_, int nN_, int G_, int c_) { nM = nM_; nN = nN_; nwg = nM * nN; G = G_; c = c_; }
    __device__ bool next(int i, Unit& u) const {
        const long L = (long)i * G + c; if (L >= nwg) return false;
        int wgid = (int)L; { const int q = nwg / NXCD, r = nwg % NXCD, xcd = wgid % NXCD, off = wgid / NXCD; wgid = (xcd < r ? xcd * (q + 1) : r * (q + 1) + (xcd - r) * q) + off; }
        const int nig = WGM * nN, gid = wgid / nig, fm = gid * WGM, gsz = (nM - fm) < WGM ? (nM - fm) : WGM;
        u.pm = fm + ((wgid % nig) % gsz); u.pn = (wgid % nig) / gsz; u.e = 0; return true;
    }
};

__device__ __forceinline__ i32x8 cat8(const bf16x8 lo, const bf16x8 hi) { return __builtin_shufflevector(__builtin_bit_cast(i32x4, lo), __builtin_bit_cast(i32x4, hi), 0, 1, 2, 3, 4, 5, 6, 7); }
template <class Epi, bool ALIGN_EPI, bool SP2, bool GATHER = false, bool FP8 = false>
__device__ __forceinline__ void gemm_phase(LAS unsigned char* lds, const Gemm g, const StaticOrder& S, const Epi& E) {
    const int tid = threadIdx.x, wid = __builtin_amdgcn_readfirstlane(tid >> 6), lane = tid & 63, wr = wid >> 2, wc = wid & 3, fr = lane & 15, fq = lane >> 4;
    const int K = g.K, nt = K / BK;
    unsigned voffA[2], voffB[2];
#pragma unroll
    for (int i = 0; i < 2; ++i) { int R, C; stage_rc(tid * 16 + i * 8192, R, C); const int Rb = Epi::PERM ? ((R & ~31) + perm32(R & 31)) : R;
        voffA[i] = (unsigned)(R * K + C) * 2u; voffB[i] = (unsigned)(Rb * K + C) * 2u; }
    unsigned vC[2][2];
#define PG8_GROWS(u, dst) do { _Pragma("unroll") for (int h_ = 0; h_ < 2; ++h_) _Pragma("unroll") for (int i_ = 0; i_ < 2; ++i_) { int R_, C_; stage_rc(tid * 16 + i_ * 8192, R_, C_); \
        dst[h_][i_] = (unsigned)g.rowtok[(u).pm * BM + h_ * HALF + R_] * (unsigned)(K * 2) + (unsigned)(C_ * 2); } } while (0)
    const size_t kstep = (size_t)(BK * 2);
    const size_t hstep = (size_t)HALF * K * 2;
    const size_t tstep = 2 * hstep;
    const unsigned ldsw = (unsigned)wid * 1024u;
    const int aoff = lds_byte(wr * 64 + fr, fq * 8), boff = lds_byte(wc * 32 + fr, fq * 8);
#define PG8_SA(b, h) (((b) * 2 + (h)) * HTB)
#define PG8_SB(b, h) ((4 + (b) * 2 + (h)) * HTB)
#define PG8_STAGE(bufoff, gbase, voff) do { _Pragma("unroll") for (int _i = 0; _i < 2; ++_i) \
        __builtin_amdgcn_global_load_lds((const unsigned*)((const char*)(gbase) + (voff)[_i]), (LAS unsigned*)(lds + (bufoff) + ldsw + _i * 8192), 16, 0, 0); } while (0)
#define PG8_STAGE_A(bufoff, p, h, nx) do { if constexpr (GATHER) { PG8_STAGE(bufoff, p, vC[h]); } else PG8_STAGE(bufoff, (p) + (h) * hstep, voffA); } while (0)
#define PG8_LDA(dst, b, h) do { _Pragma("unroll") for (int m = 0; m < 4; ++m) _Pragma("unroll") for (int k = 0; k < 2; ++k) dst[m][k] = *(const LAS bf16x8*)(lds + PG8_SA(b, h) + aoff + m * 2048 + k * 1024); } while (0)
#define PG8_LDB(dst, b, h) do { _Pragma("unroll") for (int n = 0; n < 2; ++n) _Pragma("unroll") for (int k = 0; k < 2; ++k) dst[n][k] = *(const LAS bf16x8*)(lds + PG8_SB(b, h) + boff + n * 2048 + k * 1024); } while (0)
#define PG8_MMA(ai, bj, At, Bt) do { __builtin_amdgcn_s_setprio(1); \
        if constexpr (FP8) { _Pragma("unroll") for (int m = 0; m < 4; ++m) _Pragma("unroll") for (int n = 0; n < 2; ++n) \
            { const i32x8 b8_ = cat8(Bt[n][0], Bt[n][1]), a8_ = cat8(At[m][0], At[m][1]); asm volatile("v_mfma_f32_16x16x128_f8f6f4 %0, %1, %2, %0" : "+v"(acc[ai][bj][m][n]) : "v"(b8_), "v"(a8_)); } } \
        else { _Pragma("unroll") for (int m = 0; m < 4; ++m) _Pragma("unroll") for (int n = 0; n < 2; ++n) _Pragma("unroll") for (int k = 0; k < 2; ++k) \
            acc[ai][bj][m][n] = __builtin_amdgcn_mfma_f32_16x16x32_bf16(Bt[n][k], At[m][k], acc[ai][bj][m][n], 0, 0, 0); } \
        __builtin_amdgcn_s_setprio(0); } while (0)
#define PG8_WAIT_V(n) asm volatile("s_waitcnt vmcnt(" #n ")" ::: "memory")
#define PG8_WAIT_L(n) asm volatile("s_waitcnt lgkmcnt(" #n ")" ::: "memory")
#define PG8_BAR __builtin_amdgcn_s_barrier()
#define PG8_SCHED __builtin_amdgcn_sched_barrier(0)
#define PG8_UPTR(u, pa, pb) do { unsigned _e = g.texp ? ld_u32_agent(g.texp + (u).pm) : 0u; _e = (unsigned)__builtin_amdgcn_readfirstlane((int)_e); (u).e = (int)_e; \
        pa = GATHER ? (const char*)g.A : (const char*)g.A + (size_t)(u).pm * tstep; pb = (const char*)g.Bt + (size_t)_e * g.bstride + (size_t)(u).pn * tstep; } while (0)
    Unit cur, nxt; int ui = 0;
    if (!S.next(0, cur)) return;
    f32x4 acc[2][2][4][2];
#pragma unroll
    for (int a = 0; a < 2; ++a)
#pragma unroll
        for (int b = 0; b < 2; ++b)
#pragma unroll
            for (int m = 0; m < 4; ++m)
#pragma unroll
                for (int n = 0; n < 2; ++n) acc[a][b][m][n] = (f32x4){0.f, 0.f, 0.f, 0.f};
    bf16x8 At[4][2], B0[2][2], B1[2][2];
    const char* cA; const char* cB;
    PG8_UPTR(cur, cA, cB);
    if constexpr (GATHER) { PG8_GROWS(cur, vC); }
    if constexpr (SP2) {
        PG8_STAGE(PG8_SB(0, 0), cB, voffB); PG8_STAGE(PG8_SB(0, 1), cB + hstep, voffB); PG8_STAGE_A(PG8_SA(0, 0), cA, 0, false); PG8_STAGE_A(PG8_SA(0, 1), cA, 1, false);
        if (wr == 1) PG8_BAR;
        PG8_WAIT_V(2); PG8_BAR;
        PG8_STAGE(PG8_SB(1, 0), cB + kstep, voffB); PG8_STAGE_A(PG8_SA(1, 0), cA + kstep, 0, false); PG8_STAGE(PG8_SB(1, 1), cB + hstep + kstep, voffB);
        PG8_WAIT_V(6); PG8_BAR;
    } else {
        PG8_STAGE(PG8_SB(0, 0), cB, voffB); PG8_STAGE_A(PG8_SA(0, 0), cA, 0, false); PG8_STAGE(PG8_SB(0, 1), cB + hstep, voffB); PG8_STAGE_A(PG8_SA(0, 1), cA, 1, false);
        if (wr == 1) PG8_BAR;
        PG8_WAIT_V(4); PG8_BAR;
        PG8_STAGE(PG8_SB(1, 0), cB + kstep, voffB); PG8_STAGE_A(PG8_SA(1, 0), cA + kstep, 0, false); PG8_STAGE(PG8_SB(1, 1), cB + hstep + kstep, voffB);
        PG8_WAIT_V(6); PG8_BAR;
    }
    for (;;) {
        const bool has_next = S.next(ui + 1, nxt);
        const char* nA = cA; const char* nB = cB;
        if (has_next) PG8_UPTR(nxt, nA, nB);
#pragma unroll 1
        for (int t = 0; t < nt; t += 2) {
            const bool last = (t == nt - 2);
            const char* a1 = cA + (size_t)(t + 1) * kstep;
            const char* a2 = last ? nA : cA + (size_t)(t + 2) * kstep; const char* b2 = last ? nB : cB + (size_t)(t + 2) * kstep;
            const char* a3 = a2 + kstep; const char* b3 = b2 + kstep;
            if constexpr (SP2) {
            PG8_LDB(B0, 0, 0); PG8_LDB(B1, 0, 1); PG8_SCHED; PG8_LDA(At, 0, 0); PG8_STAGE_A(PG8_SA(1, 1), a1, 1, false);
            if constexpr (GATHER) { if (last && has_next) { PG8_GROWS(nxt, vC); } }
            PG8_WAIT_V(8); PG8_WAIT_L(0); PG8_BAR; PG8_MMA(0, 0, At, B0); PG8_MMA(0, 1, At, B1); PG8_BAR; PG8_SCHED;
            PG8_LDA(At, 0, 1); PG8_STAGE(PG8_SB(0, 0), b2, voffB); PG8_STAGE(PG8_SB(0, 1), b2 + hstep, voffB); PG8_STAGE_A(PG8_SA(0, 0), a2, 0, last);
            PG8_WAIT_V(8); PG8_WAIT_L(0); PG8_BAR; PG8_MMA(1, 0, At, B0); PG8_MMA(1, 1, At, B1); PG8_BAR; PG8_SCHED;
            PG8_LDB(B0, 1, 0); PG8_LDB(B1, 1, 1); PG8_SCHED; PG8_LDA(At, 1, 0); PG8_STAGE_A(PG8_SA(0, 1), a2, 1, last);
            PG8_WAIT_V(8); PG8_WAIT_L(0); PG8_BAR; PG8_MMA(0, 0, At, B0); PG8_MMA(0, 1, At, B1); PG8_BAR; PG8_SCHED;
            PG8_LDA(At, 1, 1); PG8_STAGE(PG8_SB(1, 0), b3, voffB); PG8_STAGE(PG8_SB(1, 1), b3 + hstep, voffB); PG8_STAGE_A(PG8_SA(1, 0), a3, 0, last);
            PG8_WAIT_V(8); PG8_WAIT_L(0); PG8_BAR; PG8_MMA(1, 0, At, B0); PG8_MMA(1, 1, At, B1); PG8_BAR; PG8_SCHED;
            } else {
            PG8_LDB(B0, 0, 0); PG8_SCHED; PG8_LDA(At, 0, 0); PG8_STAGE_A(PG8_SA(1, 1), a1, 1, false);
            if constexpr (GATHER) { if (last && has_next) { PG8_GROWS(nxt, vC); } }
            PG8_WAIT_L(8); PG8_BAR; PG8_WAIT_L(0); PG8_MMA(0, 0, At, B0); PG8_BAR; PG8_SCHED;
            PG8_LDB(B1, 0, 1); PG8_STAGE(PG8_SB(0, 0), b2, voffB);
            PG8_BAR; PG8_WAIT_L(0); PG8_MMA(0, 1, At, B1); PG8_BAR;
            PG8_LDA(At, 0, 1); PG8_STAGE_A(PG8_SA(0, 0), a2, 0, last);
            PG8_BAR; PG8_WAIT_L(0); PG8_MMA(1, 0, At, B0); PG8_BAR; PG8_SCHED;
            PG8_STAGE(PG8_SB(0, 1), b2 + hstep, voffB);
            PG8_WAIT_V(6); PG8_BAR; PG8_MMA(1, 1, At, B1); PG8_BAR;
            PG8_LDB(B0, 1, 0); PG8_SCHED; PG8_LDA(At, 1, 0); PG8_STAGE_A(PG8_SA(0, 1), a2, 1, last);
            PG8_WAIT_L(8); PG8_BAR; PG8_WAIT_L(0); PG8_MMA(0, 0, At, B0); PG8_BAR; PG8_SCHED;
            PG8_LDB(B1, 1, 1); PG8_STAGE(PG8_SB(1, 0), b3, voffB);
            PG8_BAR; PG8_WAIT_L(0); PG8_MMA(0, 1, At, B1); PG8_BAR;
            PG8_LDA(At, 1, 1); PG8_STAGE_A(PG8_SA(1, 0), a3, 0, last);
            PG8_BAR; PG8_WAIT_L(0); PG8_MMA(1, 0, At, B0); PG8_BAR; PG8_SCHED;
            PG8_STAGE(PG8_SB(1, 1), b3 + hstep, voffB);
            PG8_WAIT_V(6); PG8_BAR; PG8_MMA(1, 1, At, B1); PG8_BAR;
            }
        }
        if constexpr (ALIGN_EPI) { if (wr == 0) PG8_BAR; }
        if constexpr (FP8) { asm volatile("s_nop 15\n\ts_nop 15" ::: "memory"); PG8_SCHED; }
        E(acc, cur, wr, wc, fr, fq);
        if (!has_next) break;
#pragma unroll
        for (int a = 0; a < 2; ++a)
#pragma unroll
            for (int b = 0; b < 2; ++b)
#pragma unroll
                for (int m = 0; m < 4; ++m)
#pragma unroll
                    for (int n = 0; n < 2; ++n) acc[a][b][m][n] = (f32x4){0.f, 0.f, 0.f, 0.f};
        cur = nxt; cA = nA; cB = nB; ++ui;
        if constexpr (ALIGN_EPI) { if (wr == 1) PG8_BAR; }
    }
    PG8_WAIT_V(0);
    if constexpr (!ALIGN_EPI) { if (wr == 0) PG8_BAR; }
    PG8_BAR;
#undef PG8_SA
#undef PG8_SB
#undef PG8_STAGE
#undef PG8_LDA
#undef PG8_LDB
#undef PG8_MMA
#undef PG8_WAIT_V
#undef PG8_WAIT_L
#undef PG8_BAR
#undef PG8_SCHED
#undef PG8_UPTR
#undef PG8_STAGE_A
#undef PG8_GROWS
}

struct EpiProj {
    static constexpr bool PERM = true;
    bf16 *q, *k, *vT, *p;
    __device__ __forceinline__ void operator()(const f32x4 (&acc)[2][2][4][2], const Unit& u, int wr, int wc, int fr, int fq) const {
        const int row0 = u.pm * BM + wr * 64 + fr;
        const int pn = u.pn;
#pragma unroll
        for (int ai = 0; ai < 2; ++ai)
#pragma unroll
            for (int m = 0; m < 4; ++m) {
                const int row = row0 + ai * HALF + m * 16;
#pragma unroll
                for (int bj = 0; bj < 2; ++bj) {
                    f32x4 v0 = acc[ai][bj][m][0], v1 = acc[ai][bj][m][1];
                    const int col = pn * BM + bj * HALF + wc * 32 + 8 * fq;
                    if (pn >= 4 && pn < 6) {
                        const int cv = col - 1024, hh = cv >> 6, dim = cv & 63, b = row / T, t = row % T;
                        bf16* dst = vT + ((size_t)(((b * NH + hh) * GROWS + (t >> 6)) * HD + dim)) * 64 + (t & 63);
                        const unsigned w0 = cvt_pk_bf16(v0[0], v0[1]), w1 = cvt_pk_bf16(v0[2], v0[3]), w2 = cvt_pk_bf16(v1[0], v1[1]), w3 = cvt_pk_bf16(v1[2], v1[3]);
                        dst[0 * 64] = (bf16)(w0 & 0xffff); dst[1 * 64] = (bf16)(w0 >> 16); dst[2 * 64] = (bf16)(w1 & 0xffff); dst[3 * 64] = (bf16)(w1 >> 16);
                        dst[4 * 64] = (bf16)(w2 & 0xffff); dst[5 * 64] = (bf16)(w2 >> 16); dst[6 * 64] = (bf16)(w3 & 0xffff); dst[7 * 64] = (bf16)(w3 >> 16);
                        asm volatile("s_waitcnt vmcnt(40)" ::: "memory");
                    } else {
                        bf16* dst;
                        if (pn < 2) { v0 = v0 * 0.125f; v1 = v1 * 0.125f; dst = q + (size_t)row * CW + col; }
                        else if (pn < 4) dst = k + (size_t)row * CW + (col - 512);
                        else dst = p + (size_t)row * PW + (col - 1536);
                        u32x4 w; w.x = cvt_pk_bf16(v0[0], v0[1]); w.y = cvt_pk_bf16(v0[2], v0[3]); w.z = cvt_pk_bf16(v1[0], v1[1]); w.w = cvt_pk_bf16(v1[2], v1[3]);
                        *(u32x4*)dst = w;
                    }
                }
            }
    }
};
struct EpiWo {
    static constexpr bool PERM = true;
    const float* x; bf16* h;
    __device__ __forceinline__ void operator()(const f32x4 (&acc)[2][2][4][2], const Unit& u, int wr, int wc, int fr, int fq) const {
        const int row0 = u.pm * BM + wr * 64 + fr, col0 = u.pn * BM + wc * 32 + 8 * fq;
#pragma unroll
        for (int ai = 0; ai < 2; ++ai)
#pragma unroll
            for (int m = 0; m < 4; ++m) { const size_t off = (size_t)(row0 + ai * HALF + m * 16) * D + col0;
#pragma unroll
                for (int bj = 0; bj < 2; ++bj) { const f32x4 v0 = acc[ai][bj][m][0] + *(const f32x4*)(x + off + bj * HALF), v1 = acc[ai][bj][m][1] + *(const f32x4*)(x + off + bj * HALF + 4);
                    u32x4 w; w.x = cvt_pk_bf16(v0[0], v0[1]); w.y = cvt_pk_bf16(v0[2], v0[3]); w.z = cvt_pk_bf16(v1[0], v1[1]); w.w = cvt_pk_bf16(v1[2], v1[3]);
                    *(u32x4*)(h + off + bj * HALF) = w; } }
    }
};
struct EpiUp {
    static constexpr bool PERM = true;
    const float* b_up; unsigned char* act;
    __device__ __forceinline__ void operator()(const f32x4 (&acc)[2][2][4][2], const Unit& u, int wr, int wc, int fr, int fq) const {
        const int row0 = u.pm * BM + wr * 64 + fr, ch = u.pn * 128 + wc * 32 + 8 * fq;
        const float* bg = b_up + (size_t)u.e * 2048 + ch; const float* bl = bg + 1024;
        const f32x4 bg0 = *(const f32x4*)bg * F8_SACT, bg1 = *(const f32x4*)(bg + 4) * F8_SACT, bl0 = *(const f32x4*)bl, bl1 = *(const f32x4*)(bl + 4);
        constexpr float SG = F8_SACT / (F8_SX * F8_SW), SL = 1.0f / (F8_SX * F8_SW), KE = -1.702f * 1.44269504f / F8_SACT;
#pragma unroll
        for (int ai = 0; ai < 2; ++ai)
#pragma unroll
            for (int m = 0; m < 4; ++m) {
                float o[8];
#pragma unroll
                for (int n = 0; n < 2; ++n) { const f32x4 ga = acc[ai][0][m][n], la = acc[ai][1][m][n]; const f32x4 bgn = n ? bg1 : bg0, bln = n ? bl1 : bl0;
#pragma unroll
                    for (int hj = 0; hj < 2; ++hj) {
                        const f32x2 gv = __builtin_elementwise_fma((f32x2){ga[2 * hj], ga[2 * hj + 1]}, (f32x2){SG, SG}, (f32x2){bgn[2 * hj], bgn[2 * hj + 1]});
                        const f32x2 lv = __builtin_elementwise_fma((f32x2){la[2 * hj], la[2 * hj + 1]}, (f32x2){SL, SL}, (f32x2){bln[2 * hj], bln[2 * hj + 1]});
                        const f32x2 gt = {fminf(gv.x, 7.0f * F8_SACT), fminf(gv.y, 7.0f * F8_SACT)};
                        const f32x2 li = {__builtin_amdgcn_fmed3f(lv.x, -7.0f, 7.0f), __builtin_amdgcn_fmed3f(lv.y, -7.0f, 7.0f)};
                        const f32x2 zk = __builtin_elementwise_fma(gt, (f32x2){KE, KE}, (f32x2){-0.0f, -0.0f});
                        const f32x2 ez = {__builtin_amdgcn_exp2f(zk.x), __builtin_amdgcn_exp2f(zk.y)};
                        const f32x2 den = __builtin_elementwise_fma(ez, (f32x2){1.0f, 1.0f}, (f32x2){1.0f, 1.0f});
                        const f32x2 rc = {__builtin_amdgcn_rcpf(den.x), __builtin_amdgcn_rcpf(den.y)};
                        const f32x2 t = __builtin_elementwise_fma(gt, rc, (f32x2){-0.0f, -0.0f});
                        const f32x2 ov = __builtin_elementwise_fma(li, t, t);
                        o[n * 4 + 2 * hj] = ov.x; o[n * 4 + 2 * hj + 1] = ov.y; } }
                int w0 = 0, w1 = 0;
                w0 = __builtin_amdgcn_cvt_pk_fp8_f32(o[0], o[1], w0, false); w0 = __builtin_amdgcn_cvt_pk_fp8_f32(o[2], o[3], w0, true);
                w1 = __builtin_amdgcn_cvt_pk_fp8_f32(o[4], o[5], w1, false); w1 = __builtin_amdgcn_cvt_pk_fp8_f32(o[6], o[7], w1, true);
                u32x2 w8; w8.x = (unsigned)w0; w8.y = (unsigned)w1;
                *(u32x2*)(act + (size_t)(row0 + ai * HALF + m * 16) * DE + ch) = w8;
            }
    }
};
struct EpiDown {
    static constexpr bool PERM = true;
    const float* b_dn; unsigned char* y;
    __device__ __forceinline__ void operator()(const f32x4 (&acc)[2][2][4][2], const Unit& u, int wr, int wc, int fr, int fq) const {
        const int row0 = u.pm * BM + wr * 64 + fr, col0 = u.pn * BM + wc * 32 + 8 * fq;
        const float* bb = b_dn + (size_t)u.e * D + col0;
        f32x4 bv[2][2];
#pragma unroll
        for (int bj = 0; bj < 2; ++bj)
#pragma unroll
            for (int n = 0; n < 2; ++n) bv[bj][n] = *(const f32x4*)(bb + bj * HALF + 4 * n) * F8_SY;
#pragma unroll
        for (int ai = 0; ai < 2; ++ai)
#pragma unroll
            for (int m = 0; m < 4; ++m) { unsigned char* rowp = y + (size_t)(row0 + ai * HALF + m * 16) * D + col0;
#pragma unroll
                for (int bj = 0; bj < 2; ++bj) { const f32x4 v0 = acc[ai][bj][m][0] * (F8_SY / (F8_SACT * F8_SW)) + bv[bj][0], v1 = acc[ai][bj][m][1] * (F8_SY / (F8_SACT * F8_SW)) + bv[bj][1];
                    u32x2 w; w.x = pk4_fp8(v0[0], v0[1], v0[2], v0[3]); w.y = pk4_fp8(v1[0], v1[1], v1[2], v1[3]);
                    *(u32x2*)(rowp + bj * HALF) = w; } }
    }
};
}


#define XB_TMO      128
#define XB_XCNT(j)  (256  + 64 * (j))
#define XB_XSUB(j)  (1280 + 64 * (j))
#define XB_XGEN(j)  (2304 + 64 * (j))
#define XB_TOP      3328
#define XB_TOPGEN   3392
#define XCD_BAR_WORDS 3456
#define XB_SPIN_CAP (1u << 20)
__device__ __forceinline__ unsigned xb_ld(unsigned* p)              { return __hip_atomic_load(p, __ATOMIC_RELAXED, __HIP_MEMORY_SCOPE_AGENT); }
__device__ __forceinline__ unsigned xb_add(unsigned* p, unsigned v) { return __hip_atomic_fetch_add(p, v, __ATOMIC_RELAXED, __HIP_MEMORY_SCOPE_AGENT); }
__device__ __forceinline__ unsigned xb_xcc_id() { return (unsigned)__builtin_amdgcn_s_getreg((3 << 11) | 20) & 0xFu; }
#define XB_SPIN(cond, bar) do { unsigned _sp = 0; while (cond) { __builtin_amdgcn_s_sleep(1); \
    if ((++_sp & 255u) == 0u) { if (xb_ld(&(bar)[XB_TMO])) break; if (_sp > XB_SPIN_CAP) { atomicAdd(&(bar)[XB_TMO], 1u); break; } } } } while (0)
struct XcdBarrier { unsigned* bar; unsigned x; volatile LAS unsigned* st; };
__device__ __forceinline__ XcdBarrier xcd_barrier_post(unsigned* bar, volatile LAS unsigned* st) {
    XcdBarrier b; b.bar = bar; b.x = xb_xcc_id(); b.st = st;
    if (threadIdx.x == 0) (void)xb_add(&bar[XB_XCNT(b.x)], 1u);
    return b;
}
__device__ __forceinline__ void xcd_barrier_complete(unsigned* bar, unsigned x, unsigned& nloc, unsigned& nx) {
    const unsigned G = gridDim.x * gridDim.y * gridDim.z;
    unsigned sum, cnt, mine, sp = 0u;
    for (;;) {
        sum = 0u; cnt = 0u; mine = 0u;
#pragma unroll
        for (unsigned j = 0; j < 16; ++j) { const unsigned c = xb_ld(&bar[XB_XCNT(j)]); sum += c; cnt += (c > 0u) ? 1u : 0u; mine = (j == x) ? c : mine; }
        if (sum == G) break;
        __builtin_amdgcn_s_sleep(1);
        if ((++sp & 255u) == 0u) { if (xb_ld(&bar[XB_TMO])) break; if (sp > XB_SPIN_CAP) { atomicAdd(&bar[XB_TMO], 1u); break; } }
    }
    nloc = mine > 0u ? mine : 1u; nx = cnt > 0u ? cnt : 1u;
}
__device__ __forceinline__ void xcd_barrier(const XcdBarrier& b) {
    asm volatile("s_waitcnt vmcnt(0)" ::: "memory");
    __syncthreads();
    if (threadIdx.x == 0) {
        unsigned* bar = b.bar;
        __builtin_amdgcn_s_waitcnt(0);
        unsigned nloc = b.st[0], nx = b.st[1];
        if (nloc == 0u) { xcd_barrier_complete(bar, b.x, nloc, nx); b.st[0] = nloc; b.st[1] = nx; }
        const unsigned old = xb_add(&bar[XB_XSUB(b.x)], 1u);
        const unsigned gen = old / nloc;
        if (old + 1u == (gen + 1u) * nloc) {
            __builtin_amdgcn_fence(__ATOMIC_RELEASE, "agent");
            asm volatile("s_waitcnt vmcnt(0)" ::: "memory");
            const unsigned og = xb_add(&bar[XB_TOP], 1u);
            const unsigned tg = og / nx;
            if (og + 1u == (tg + 1u) * nx) xb_add(&bar[XB_TOPGEN], 1u);
            else XB_SPIN(xb_ld(&bar[XB_TOPGEN]) == tg, bar);
            __builtin_amdgcn_fence(__ATOMIC_ACQUIRE, "agent");
            xb_add(&bar[XB_XGEN(b.x)], 1u);
            asm volatile("s_waitcnt vmcnt(0)" ::: "memory");
        } else {
            XB_SPIN(xb_ld(&bar[XB_XGEN(b.x)]) == gen, bar);
            __builtin_amdgcn_fence(__ATOMIC_ACQUIRE, "agent");
            asm volatile("s_waitcnt vmcnt(0)" ::: "memory");
        }
    }
    __syncthreads();
}

struct Args { const float* in[26]; float* out; unsigned char* ws; int ph_lo, ph_hi; };

struct Frame { LAS unsigned char* lds; int tid, lane, wave, G, vcu; };

__device__ __forceinline__ void transpose_item(const float* W, int K, int N, bf16* WT, int k0, int n0, int orow0, LAS float* scr, int lane) {
#pragma unroll 8
    for (int i = 0; i < 32; ++i) { const int kk = 2 * i + (lane >> 5); scr[kk * 33 + (lane & 31)] = W[(size_t)(k0 + kk) * N + n0 + (lane & 31)]; }
    asm volatile("s_waitcnt lgkmcnt(0)" ::: "memory");
    const int c = lane & 7;
#pragma unroll
    for (int j = 0; j < 4; ++j) { const int n = (lane >> 3) + 8 * j; const LAS float* s = scr + (8 * c) * 33 + n;
        u32x4 o; o.x = cvt_pk_bf16(s[0 * 33], s[1 * 33]); o.y = cvt_pk_bf16(s[2 * 33], s[3 * 33]); o.z = cvt_pk_bf16(s[4 * 33], s[5 * 33]); o.w = cvt_pk_bf16(s[6 * 33], s[7 * 33]);
        *(u32x4*)(WT + (size_t)(orow0 + n) * K + k0 + 8 * c) = o; }
    asm volatile("s_waitcnt lgkmcnt(0)" ::: "memory");
}

__device__ __forceinline__ void transpose_item8w(const float* W, int K, int N, unsigned char* WT, int k0, int n0, int orow0, LAS float* scr, int lane) {
#pragma unroll 8
    for (int i = 0; i < 64; ++i) { const int kk = 2 * i + (lane >> 5); scr[kk * 33 + (lane & 31)] = W[(size_t)(k0 + kk) * N + n0 + (lane & 31)]; }
    asm volatile("s_waitcnt lgkmcnt(0)" ::: "memory");
    const int c = lane & 7;
#pragma unroll
    for (int j = 0; j < 4; ++j) { const int n = (lane >> 3) + 8 * j; const LAS float* s = scr + (16 * c) * 33 + n;
        u32x4 o; o.x = pk4_fp8(s[0 * 33] * F8_SW, s[1 * 33] * F8_SW, s[2 * 33] * F8_SW, s[3 * 33] * F8_SW); o.y = pk4_fp8(s[4 * 33] * F8_SW, s[5 * 33] * F8_SW, s[6 * 33] * F8_SW, s[7 * 33] * F8_SW);
        o.z = pk4_fp8(s[8 * 33] * F8_SW, s[9 * 33] * F8_SW, s[10 * 33] * F8_SW, s[11 * 33] * F8_SW); o.w = pk4_fp8(s[12 * 33] * F8_SW, s[13 * 33] * F8_SW, s[14 * 33] * F8_SW, s[15 * 33] * F8_SW);
        *(u32x4*)(WT + (size_t)(orow0 + n) * K + k0 + 16 * c) = o; }
    asm volatile("s_waitcnt lgkmcnt(0)" ::: "memory");
}
__device__ __forceinline__ void transpose_item8(const float* W, int K, int N, unsigned char* WT, int k0, int n0, int orow0, LAS float* scr, int lane) {
#pragma unroll 8
    for (int i = 0; i < 32; ++i) { const int kk = 2 * i + (lane >> 5); scr[kk * 33 + (lane & 31)] = W[(size_t)(k0 + kk) * N + n0 + (lane & 31)]; }
    asm volatile("s_waitcnt lgkmcnt(0)" ::: "memory");
    const int c = lane & 7;
#pragma unroll
    for (int j = 0; j < 4; ++j) { const int n = (lane >> 3) + 8 * j; const LAS float* s = scr + (8 * c) * 33 + n;
        u32x2 o; o.x = pk4_fp8(s[0 * 33] * F8_SW, s[1 * 33] * F8_SW, s[2 * 33] * F8_SW, s[3 * 33] * F8_SW); o.y = pk4_fp8(s[4 * 33] * F8_SW, s[5 * 33] * F8_SW, s[6 * 33] * F8_SW, s[7 * 33] * F8_SW);
        *(u32x2*)(WT + (size_t)(orow0 + n) * K + k0 + 8 * c) = o; }
    asm volatile("s_waitcnt lgkmcnt(0)" ::: "memory");
}

constexpr int WC_BLOCKS = 32 * 8 * 8 + 32 * 8 * 4;
#ifndef WC_P0
#define WC_P0 0
#endif
__device__ __forceinline__ void wconv_blocks(const Frame& F, const Args& a, const int lo, const int hi, const int first, const int stride) {
    unsigned char* ws = a.ws;
    {
        constexpr int BI_UP = 32 * 8 * 8, BI_DN = 32 * 8 * 4, WP = 257;
        LAS float* tile = (LAS float*)F.lds;
        const int lane = F.lane, w = F.wave, c = lane & 7;
        for (int bi = lo + first; bi < hi; bi += stride) {
            const bool up = bi < BI_UP; const int r2 = up ? bi : bi - BI_UP;
            const int e = up ? r2 >> 6 : r2 >> 5, q = up ? r2 & 63 : r2 & 31, kb = up ? q >> 3 : q >> 2, nb = up ? q & 7 : q & 3;
            const int N = up ? 2048 : 1024, k0 = kb * 128, n0 = nb * 256;
            const float* W = (up ? a.in[21] + (size_t)e * 1024 * 2048 : a.in[23] + (size_t)e * 1024 * 1024) + (size_t)k0 * N + n0 + 4 * lane;
            unsigned char* WT = (up ? ws + WS_WUPT + (size_t)e * 2048 * 1024 : ws + WS_WDNT + (size_t)e * 1024 * 1024) + k0 + 16 * c;
            __syncthreads();
            f32x4 v[16];
#pragma unroll
            for (int i = 0; i < 16; ++i) v[i] = *(const f32x4*)(W + (size_t)(16 * w + i) * N);
#pragma unroll
            for (int i = 0; i < 16; ++i) { LAS float* t = tile + (16 * w + i) * WP + 4 * lane; t[0] = v[i].x; t[1] = v[i].y; t[2] = v[i].z; t[3] = v[i].w; }
            __syncthreads();
#pragma unroll
            for (int j = 0; j < 4; ++j) { const int nl = 32 * w + (lane >> 3) + 8 * j, n = n0 + nl;
                const int orow = up ? (n < 1024 ? 256 * (n >> 7) + (n & 127) : 256 * ((n - 1024) >> 7) + 128 + ((n - 1024) & 127)) : n;
                const LAS float* sp = tile + (16 * c) * WP + nl;
                u32x4 o; o.x = pk4_fp8(sp[0 * WP] * F8_SW, sp[1 * WP] * F8_SW, sp[2 * WP] * F8_SW, sp[3 * WP] * F8_SW); o.y = pk4_fp8(sp[4 * WP] * F8_SW, sp[5 * WP] * F8_SW, sp[6 * WP] * F8_SW, sp[7 * WP] * F8_SW);
                o.z = pk4_fp8(sp[8 * WP] * F8_SW, sp[9 * WP] * F8_SW, sp[10 * WP] * F8_SW, sp[11 * WP] * F8_SW); o.w = pk4_fp8(sp[12 * WP] * F8_SW, sp[13 * WP] * F8_SW, sp[14 * WP] * F8_SW, sp[15 * WP] * F8_SW);
                *(u32x4*)(WT + (size_t)orow * 1024) = o; }
        }
        __syncthreads(); }
}

__device__ __forceinline__ void p0_prologue(const Frame& F, const Args& a) {
    unsigned char* ws = a.ws;
    LAS float* scr = (LAS float*)(F.lds + F.wave * 8448);
    const int gw = F.vcu * 8 + F.wave, NGW = F.G * 8;
    constexpr int I_IN = 16 * 108, I_O = 16 * 32, I_L = 16, I_G = 32;
    constexpr int NITEMS = I_IN + I_O + 2 * I_L + 2 * I_L + I_G;
    for (int it = gw; it < NITEMS; it += NGW) {
        int r = it;
        if (r < I_IN) { const int kb = r / 108, nb = r % 108; transpose_item(a.in[2], 1024, NPROJ, (bf16*)(ws + WS_WINT), kb * 64, nb * 32, nb * 32, scr, F.lane); continue; }
        r -= I_IN;
        if (r < I_O) { const int kb = r / 32, nb = r % 32; transpose_item(a.in[17], 1024, 1024, (bf16*)(ws + WS_WOT), kb * 64, nb * 32, nb * 32, scr, F.lane); continue; }
        r -= I_O;
        if (r < 2 * I_L) { const int z = r / 16, nb = r % 16; transpose_item(a.in[8] + (size_t)z * 64 * 512, 64, 512, (bf16*)(ws + WS_W2T) + (size_t)z * 512 * 64, 0, nb * 32, nb * 32, scr, F.lane); continue; }
        r -= 2 * I_L;
        if (r < 2 * I_L) { const int z = r / 16, nb = r % 16; transpose_item(a.in[10] + (size_t)z * 64 * 512, 64, 512, (bf16*)(ws + WS_A2T) + (size_t)z * 512 * 64, 0, nb * 32, nb * 32, scr, F.lane); continue; }
        r -= 2 * I_L;
        { const int kb = r / 16, nb = r % 16; transpose_item(a.in[11], 128, 512, (bf16*)(ws + WS_G2T), kb * 64, nb * 32, nb * 32, scr, F.lane); }
    }
    wconv_blocks(F, a, 0, WC_P0, F.vcu, F.G);
    { u32x4* z = (u32x4*)(ws + WS_WINT + (size_t)NPROJ * 1024 * 2); const u32x4 zero = {0u, 0u, 0u, 0u};
      for (int i = F.vcu * 512 + F.tid; i < 16384; i += F.G * 512) z[i] = zero; }
    const float* x = a.in[0]; const float* nw = a.in[1]; bf16* hn = (bf16*)(ws + WS_HN);
    f32x4 wv[4];
#pragma unroll
    for (int j = 0; j < 4; ++j) wv[j] = *((const f32x4*)nw + F.lane + 64 * j);
    for (int m = gw; m < M; m += 2 * NGW) {
        const int m1 = m + NGW; const bool has1 = m1 < M;
        const f32x4* xr0 = (const f32x4*)(x + (size_t)m * D) + F.lane; const f32x4* xr1 = (const f32x4*)(x + (size_t)(has1 ? m1 : m) * D) + F.lane;
        f32x4 v0[4], v1[4]; float s0 = 0.f, s1 = 0.f;
#pragma unroll
        for (int j = 0; j < 4; ++j) { v0[j] = xr0[64 * j]; v1[j] = xr1[64 * j]; }
#pragma unroll
        for (int j = 0; j < 4; ++j) { s0 += (v0[j].x * v0[j].x + v0[j].y * v0[j].y) + (v0[j].z * v0[j].z + v0[j].w * v0[j].w); s1 += (v1[j].x * v1[j].x + v1[j].y * v1[j].y) + (v1[j].z * v1[j].z + v1[j].w * v1[j].w); }
        const float rs0 = rsqrtf(wave_sum(s0) * (1.f / D) + RMS_EPS), rs1 = rsqrtf(wave_sum(s1) * (1.f / D) + RMS_EPS);
        u32x2* o0 = (u32x2*)(hn + (size_t)m * D) + F.lane; u32x2* o1 = (u32x2*)(hn + (size_t)m1 * D) + F.lane;
#pragma unroll
        for (int j = 0; j < 4; ++j) { u32x2 o; o.x = cvt_pk_bf16(v0[j].x * rs0 * wv[j].x, v0[j].y * rs0 * wv[j].y); o.y = cvt_pk_bf16(v0[j].z * rs0 * wv[j].z, v0[j].w * rs0 * wv[j].w); o0[64 * j] = o; }
        if (has1) {
#pragma unroll
            for (int j = 0; j < 4; ++j) { u32x2 o; o.x = cvt_pk_bf16(v1[j].x * rs1 * wv[j].x, v1[j].y * rs1 * wv[j].y); o.y = cvt_pk_bf16(v1[j].z * rs1 * wv[j].z, v1[j].w * rs1 * wv[j].w); o1[64 * j] = o; } }
    }
}

constexpr int PREP_KBUF = 0, PREP_INV = 65536, PREP_AW = 67584, PREP_AA = PREP_AW + 17408, PREP_AG = PREP_AA + 17408, PREP_LD = 136;
template <bool STORE>
__device__ __forceinline__ void prep_phase(const Frame& F, const Args& a) {
    unsigned char* ws = a.ws;
    const bf16* p = (const bf16*)(ws + WS_P);
    bf16* r_out = (bf16*)(ws + WS_R); bf16* v_out = (bf16*)(ws + WS_V); bf16* kk_out = (bf16*)(ws + WS_KK);
    bf16* decay_out = (bf16*)(ws + WS_DECAY); bf16* kdir_out = (bf16*)(ws + WS_KDIR); bf16* akk_out = (bf16*)(ws + WS_AKK); bf16* g_out = (bf16*)(ws + WS_G);
    const bf16* w2T = (const bf16*)(ws + WS_W2T); const bf16* a2T = (const bf16*)(ws + WS_A2T); const bf16* g2T = (const bf16*)(ws + WS_G2T);
    const float* mu_p = a.in[5]; const float* mu_n = a.in[6]; const float* w0 = a.in[7]; const float* a0 = a.in[9];
    const float* k_k = a.in[12]; const float* k_a = a.in[13];
    LAS bf16* kbuf = (LAS bf16*)(F.lds + PREP_KBUF); LAS float* invb = (LAS float*)(F.lds + PREP_INV);
    LAS bf16* Aw = (LAS bf16*)(F.lds + PREP_AW); LAS bf16* Aa = (LAS bf16*)(F.lds + PREP_AA); LAS bf16* Ag = (LAS bf16*)(F.lds + PREP_AG);
    const int lane = F.lane, wave = F.wave, fr = lane & 15, fg = lane >> 4;
    for (int tile = F.vcu; tile < M / 64; tile += F.G) {
        const int m0 = tile * 64;
#pragma unroll 1
        for (int jj = 0; jj < 4; ++jj) {
            const int q = lane + 64 * jj; const bool valid = q < 240; const int c0 = 8 * q;
            float mp[8], mn[8];
#pragma unroll
            for (int i = 0; i < 8; ++i) { mp[i] = valid ? mu_p[c0 + i] : 0.f; mn[i] = valid ? mu_n[c0 + i] : 0.f; }
            const int mfirst = m0 + wave * 8;
            const u32x4 zero = {0u, 0u, 0u, 0u};
            u32x4 rows[10];
#pragma unroll
            for (int rI = 0; rI < 10; ++rI) { const int mr = mfirst - 1 + rI;
                const bool ok = valid && !(rI == 0 && (mfirst % T) == 0) && !(rI == 9 && ((mfirst + 7) % T) == T - 1);
                rows[rI] = ok ? *(const u32x4*)(p + (size_t)mr * PW + c0) : zero; }
#pragma unroll
            for (int i = 0; i < 8; ++i) {
                const int m = mfirst + i, it = wave * 8 + i;
                const u32x4 prev = rows[i], cur = rows[i + 1], nxt = rows[i + 2];
                float fp[8], fc[8], fn[8], s[8];
                unpack8(prev, fp); unpack8(cur, fc); unpack8(nxt, fn);
#pragma unroll
                for (int e = 0; e < 8; ++e) s[e] = fc[e] + mp[e] * (fp[e] - fc[e]) + mn[e] * (fn[e] - fc[e]);
                if (jj == 0) { if (STORE) { *(u32x4*)(r_out + (size_t)m * CW + c0) = pack8(s); } }
                else if (jj == 1) {
                    const int c = c0 - 512;
                    *(LAS u32x4*)(kbuf + it * 512 + c) = pack8(s);
                    float kr[8]; float ss = 0.f;
#pragma unroll
                    for (int e = 0; e < 8; ++e) { kr[e] = s[e] * k_k[c + e]; ss += kr[e] * kr[e]; }
                    ss += __shfl_xor(ss, 1); ss += __shfl_xor(ss, 2); ss += __shfl_xor(ss, 4);
                    const float inv = fminf(__builtin_amdgcn_rsqf(ss), 1e12f);
#pragma unroll
                    for (int e = 0; e < 8; ++e) kr[e] *= inv;
                    if (STORE) { *(u32x4*)(kk_out + (size_t)m * CW + c) = pack8(kr); }
                    if ((lane & 7) == 0) invb[it * 8 + (lane >> 3)] = inv;
                }
                else if (jj == 2) { if (STORE) { *(u32x4*)(v_out + (size_t)m * CW + (c0 - 1024)) = pack8(s); } }
                else if (valid) {
                    const int seg = lane >> 4, cw = 8 * (lane & 15);
                    if (seg == 0) {
#pragma unroll
                        for (int e = 0; e < 8; ++e) s[e] = 1.0f - 2.0f * __builtin_amdgcn_rcpf(__expf(2.0f * s[e]) + 1.0f);
                        *(LAS u32x4*)(Aw + it * PREP_LD + cw) = pack8(s);
                    } else if (seg == 1) { *(LAS u32x4*)(Aa + it * PREP_LD + cw) = pack8(s); }
                    else {
#pragma unroll
                        for (int e = 0; e < 8; ++e) s[e] = sigmoidf_(s[e]);
                        *(LAS u32x4*)(Ag + it * PREP_LD + cw) = pack8(s);
                    }
                }
            }
        }
        __syncthreads();
        const int nb = 64 * wave;
#define PREP_PROW(nt_) (nb + 32 * ((nt_) >> 1) + 8 * (fr >> 2) + 4 * ((nt_) & 1) + (fr & 3))
#define PREP_COL(nt_)  (nb + 32 * ((nt_) >> 1) + 8 * fg + 4 * ((nt_) & 1))
#pragma unroll 1
        for (int job = 0; job < 4; ++job) {
            const int z = job & 1;
            const bf16* WT = job < 2 ? w2T + (size_t)z * 512 * 64 : a2T + (size_t)z * 512 * 64;
            const LAS bf16* Ax = job < 2 ? Aw + z * 64 : Aa + z * 64;
            bf16x8 wf[2][4];
#pragma unroll
            for (int ks = 0; ks < 2; ++ks)
#pragma unroll
                for (int nt = 0; nt < 4; ++nt) wf[ks][nt] = *(const bf16x8*)(WT + (size_t)PREP_PROW(nt) * 64 + 32 * ks + 8 * fg);
            f32x4 pb[4], pkk[4], pka[4];
#pragma unroll
            for (int nt = 0; nt < 4; ++nt) { const int n = PREP_COL(nt);
                pb[nt] = *(const f32x4*)((job < 2 ? w0 : a0) + z * 512 + n); pkk[nt] = *(const f32x4*)(k_k + n); pka[nt] = *(const f32x4*)(k_a + n); }
            f32x4 acc[4][4];
#pragma unroll
            for (int mt = 0; mt < 4; ++mt)
#pragma unroll
                for (int nt = 0; nt < 4; ++nt) acc[mt][nt] = (f32x4){0.f, 0.f, 0.f, 0.f};
#pragma unroll
            for (int ks = 0; ks < 2; ++ks) {
                bf16x8 af[4];
#pragma unroll
                for (int mt = 0; mt < 4; ++mt) af[mt] = *(const LAS bf16x8*)(Ax + (16 * mt + fr) * PREP_LD + 32 * ks + 8 * fg);
#pragma unroll
                for (int mt = 0; mt < 4; ++mt)
#pragma unroll
                    for (int nt = 0; nt < 4; ++nt) acc[mt][nt] = __builtin_amdgcn_mfma_f32_16x16x32_bf16(wf[ks][nt], af[mt], acc[mt][nt], 0, 0, 0);
            }
#pragma unroll
            for (int mt = 0; mt < 4; ++mt) {
                const int it = 16 * mt + fr; const size_t m = (size_t)(m0 + it);
#pragma unroll
                for (int np = 0; np < 2; ++np) {
                    const int c8 = nb + 32 * np + 8 * fg;
                    if (job < 2) {
                        float o[8];
#pragma unroll
                        for (int hh = 0; hh < 2; ++hh) { const f32x4 v = acc[mt][2 * np + hh], bq = pb[2 * np + hh];
#pragma unroll
                            for (int i = 0; i < 4; ++i) o[4 * hh + i] = __expf(-0.60653066f * sigmoidf_(v[i] + bq[i])); }
                        if (STORE) { *(u32x4*)(decay_out + ((size_t)z * M + m) * CW + c8) = pack8(o); }
                    } else {
                        const u32x4 kb = *(const LAS u32x4*)(kbuf + it * 512 + c8);
                        float kv[8]; unpack8(kb, kv);
                        const float inv = invb[it * 8 + wave];
                        float kd[8], ak[8];
#pragma unroll
                        for (int hh = 0; hh < 2; ++hh) { const f32x4 v = acc[mt][2 * np + hh], bq = pb[2 * np + hh], kkc = pkk[2 * np + hh], kac = pka[2 * np + hh];
#pragma unroll
                            for (int i = 0; i < 4; ++i) { const float av = sigmoidf_(v[i] + bq[i]), kx = kv[4 * hh + i]; kd[4 * hh + i] = kx * (1.0f + (av - 1.0f) * kac[i]); ak[4 * hh + i] = av * (kx * kkc[i] * inv); } }
                        if (STORE) { *(u32x4*)(kdir_out + ((size_t)z * M + m) * CW + c8) = pack8(kd); *(u32x4*)(akk_out + ((size_t)z * M + m) * CW + c8) = pack8(ak); }
                    }
                }
            }
        }
        {
            bf16x8 wf[4][4];
#pragma unroll
            for (int ks = 0; ks < 4; ++ks)
#pragma unroll
                for (int nt = 0; nt < 4; ++nt) wf[ks][nt] = *(const bf16x8*)(g2T + (size_t)PREP_PROW(nt) * 128 + 32 * ks + 8 * fg);
            f32x4 acc[4][4];
#pragma unroll
            for (int mt = 0; mt < 4; ++mt)
#pragma unroll
                for (int nt = 0; nt < 4; ++nt) acc[mt][nt] = (f32x4){0.f, 0.f, 0.f, 0.f};
#pragma unroll
            for (int ks = 0; ks < 4; ++ks) {
                bf16x8 af[4];
#pragma unroll
                for (int mt = 0; mt < 4; ++mt) af[mt] = *(const LAS bf16x8*)(Ag + (16 * mt + fr) * PREP_LD + 32 * ks + 8 * fg);
#pragma unroll
                for (int mt = 0; mt < 4; ++mt)
#pragma unroll
                    for (int nt = 0; nt < 4; ++nt) acc[mt][nt] = __builtin_amdgcn_mfma_f32_16x16x32_bf16(wf[ks][nt], af[mt], acc[mt][nt], 0, 0, 0);
            }
#pragma unroll
            for (int mt = 0; mt < 4; ++mt) { const size_t m = (size_t)(m0 + 16 * mt + fr);
#pragma unroll
                for (int np = 0; np < 2; ++np) { const f32x4 v0 = acc[mt][2 * np], v1 = acc[mt][2 * np + 1];
                    u32x4 w; w.x = cvt_pk_bf16(v0[0], v0[1]); w.y = cvt_pk_bf16(v0[2], v0[3]); w.z = cvt_pk_bf16(v1[0], v1[1]); w.w = cvt_pk_bf16(v1[2], v1[3]);
                    if (STORE) { *(u32x4*)(g_out + m * CW + nb + 32 * np + 8 * fg) = w; } } }
        }
#undef PREP_PROW
#undef PREP_COL
        __syncthreads();
    }
}

constexpr int AT_K = 0, AT_V = 73728, AT_B = 147456;
__device__ __forceinline__ void attn_phase(const Frame& F, const Args& a, const int widx, const int nworkers) {
    unsigned char* ws = a.ws;
    const bf16* q = (const bf16*)(ws + WS_Q); const bf16* k = (const bf16*)(ws + WS_K); const bf16* vT = (const bf16*)(ws + WS_VT);
    bf16* att = (bf16*)(ws + WS_ATT);
    LAS unsigned char* L = F.lds;
    LAS float* bias = (LAS float*)(L + AT_B) + 16;
    const int tid = F.tid, lane = F.lane, fr = lane & 15, fg = lane >> 4, wave = F.wave;
    const int per = (16384 + nworkers * 8 - 1) / (nworkers * 8);
    const int base = widx * (8 * per);
    const int ltok = tid >> 3, lc = tid & 7;
    const int wK = AT_K + ltok * 128 + ((lc ^ ((((ltok >> 3) & 3) << 1) | ((ltok >> 1) & 1))) << 4), wV = AT_V + ltok * 128 + ((lc ^ ((ltok >> 1) & 7)) << 4);
    u32x4 kreg[9], vreg[9]; bf16x8 qn[2]; float breg = 0.f;
#define AT_ISSUE(it_) do { const int t0_ = base + (it_) * 8; if ((it_) < per && t0_ < 16384) { \
        const int r0_ = (t0_ >> 2) & 127, h_ = (t0_ >> 9) & 7, b_ = t0_ >> 12, R0_ = min(max(r0_ - 4, 0), GROWS - 8); \
        const bf16* kp_ = k + ((size_t)b_ * T + R0_ * 64 + ltok) * CW + h_ * 64 + lc * 8; \
        const bf16* vp_ = vT + ((size_t)((b_ * NH + h_) * GROWS + R0_)) * (HD * 64) + tid * 8; \
        _Pragma("unroll") for (int j = 0; j < 9; ++j) { const int jj = min(j, GROWS - 1 - R0_); kreg[j] = *(const u32x4*)(kp_ + (size_t)jj * 64 * CW); vreg[j] = *(const u32x4*)(vp_ + (size_t)jj * (HD * 64)); } \
        if (tid < 465) breg = a.in[3][h_ * 465 + tid]; \
        const size_t tq_ = (size_t)b_ * T + (r0_ + (wave >> 2)) * 64 + 16 * (wave & 3) + fr; \
        _Pragma("unroll") for (int ks = 0; ks < 2; ++ks) qn[ks] = *(const bf16x8*)(q + tq_ * CW + h_ * 64 + 32 * ks + 8 * fg); } } while (0)
    AT_ISSUE(0);
    for (int it = 0; it < per; ++it) {
        const int task0 = base + it * 8; if (task0 >= 16384) break;
        const int cgp = wave & 3, r0 = (task0 >> 2) & 127, r = r0 + (wave >> 2), h = (task0 >> 9) & 7, b = task0 >> 12, R0 = min(max(r0 - 4, 0), GROWS - 8);
        const int c0 = 16 * cgp, wsc = min(max(c0 - 8, 0), 32), rs = min(max(r - 4, 0), GROWS - 8);
        const int c = c0 + fr, cs = min(max(c - 8, 0), 48);
        const size_t tq = (size_t)b * T + r * 64 + c;
        __syncthreads();
#pragma unroll
        for (int j = 0; j < 9; ++j) { *(LAS u32x4*)(L + wK + j * 8192) = kreg[j]; *(LAS u32x4*)(L + wV + j * 8192) = vreg[j]; }
        if (tid < 465) bias[tid] = breg;
        const bf16x8 qf0 = qn[0], qf1 = qn[1];
        __syncthreads();
        f32x4 sc[16];
        const int kcol_a = wsc + 8 * (fr >> 2) + (fr & 3);
        const int jr0 = rs - R0;
        int offK[2];
#pragma unroll
        for (int par = 0; par < 2; ++par) { const int tok = kcol_a + 4 * par; offK[par] = AT_K + jr0 * 8192 + tok * 128 + ((fg ^ ((((tok >> 3) & 3) << 1) | ((tok >> 1) & 1))) << 4); }
#pragma unroll
        for (int t = 0; t < 16; ++t) { const int u = t >> 1, par = t & 1;
            const bf16x8 kf0 = *(const LAS bf16x8*)(L + offK[par] + u * 8192), kf1 = *(const LAS bf16x8*)(L + (offK[par] ^ 64) + u * 8192);
            f32x4 s = {0.f, 0.f, 0.f, 0.f};
            s = __builtin_amdgcn_mfma_f32_16x16x32_bf16(kf0, qf0, s, 0, 0, 0);
            s = __builtin_amdgcn_mfma_f32_16x16x32_bf16(kf1, qf1, s, 0, 0, 0);
            sc[t] = s; }
        AT_ISSUE(it + 1);
        bool okm[8];
#pragma unroll
        for (int pi = 0; pi < 8; ++pi) { const int kc = wsc + 8 * fg + pi; okm[pi] = (kc >= cs) && (kc < cs + 16); }
        const LAS float* brow = bias + (rs - r + 7) * 31 + (wsc + 8 * fg - c + 15);
        float mx = -1e30f;
#pragma unroll
        for (int u = 0; u < 8; ++u)
#pragma unroll
            for (int pi = 0; pi < 8; ++pi) { const float s = okm[pi] ? sc[2 * u + (pi >> 2)][pi & 3] + brow[31 * u + pi] : -1e30f; sc[2 * u + (pi >> 2)][pi & 3] = s; mx = fmaxf(mx, s); }
        mx = fmaxf(mx, __shfl_xor(mx, 16)); mx = fmaxf(mx, __shfl_xor(mx, 32));
        float sum = 0.f;
        const float mxl = -mx * 1.44269504f;
#pragma unroll
        for (int t = 0; t < 16; ++t)
#pragma unroll
            for (int i = 0; i < 4; ++i) { const float pv = __builtin_amdgcn_exp2f(__builtin_fmaf(sc[t][i], 1.44269504f, mxl)); sc[t][i] = pv; sum += pv; }
        sum += __shfl_xor(sum, 16); sum += __shfl_xor(sum, 32);
        const float inv = 1.0f / sum;
        f32x4 o[4];
#pragma unroll
        for (int nt = 0; nt < 4; ++nt) o[nt] = (f32x4){0.f, 0.f, 0.f, 0.f};
        const int offV = AT_V + jr0 * 8192 + fr * 128 + ((((wsc >> 3) + fg) ^ ((fr >> 1) & 7)) << 4);
#pragma unroll
        for (int u = 0; u < 8; ++u) {
            union { u32x4 w; bf16x8 h8; } pf;
            pf.w.x = cvt_pk_bf16(sc[2 * u][0], sc[2 * u][1]); pf.w.y = cvt_pk_bf16(sc[2 * u][2], sc[2 * u][3]);
            pf.w.z = cvt_pk_bf16(sc[2 * u + 1][0], sc[2 * u + 1][1]); pf.w.w = cvt_pk_bf16(sc[2 * u + 1][2], sc[2 * u + 1][3]);
#pragma unroll
            for (int nt = 0; nt < 4; ++nt) { const bf16x8 vf = *(const LAS bf16x8*)(L + offV + u * 8192 + nt * 2048); o[nt] = __builtin_amdgcn_mfma_f32_16x16x32_bf16(vf, pf.h8, o[nt], 0, 0, 0); } }
#pragma unroll
        for (int nt = 0; nt < 4; ++nt) { u32x2 w; w.x = cvt_pk_bf16(o[nt][0] * inv, o[nt][1] * inv); w.y = cvt_pk_bf16(o[nt][2] * inv, o[nt][3] * inv);
            *(u32x2*)(att + tq * CW + h * 64 + 16 * nt + 4 * fg) = w; }
    }
#undef AT_ISSUE
    __syncthreads();
}

__device__ __forceinline__ void side_phase(const Frame& F, const Args& a, const int widx, const int nworkers) {
    attn_phase(F, a, widx, nworkers);
    wconv_blocks(F, a, WC_P0, WC_BLOCKS, widx, nworkers);
}

__device__ __forceinline__ float row16_sum(float v) {
    v += __builtin_bit_cast(float, __builtin_amdgcn_update_dpp(0, __builtin_bit_cast(int, v), 0xB1, 0xF, 0xF, true));
    v += __builtin_bit_cast(float, __builtin_amdgcn_update_dpp(0, __builtin_bit_cast(int, v), 0x4E, 0xF, 0xF, true));
    v += __builtin_bit_cast(float, __builtin_amdgcn_update_dpp(0, __builtin_bit_cast(int, v), 0x141, 0xF, 0xF, true));
    v += __builtin_bit_cast(float, __builtin_amdgcn_update_dpp(0, __builtin_bit_cast(int, v), 0x140, 0xF, 0xF, true));
    return v;
}
constexpr int CS_R = 8;
constexpr int CS_NCH = 2, CS_NPR = 6;
constexpr int CS_AT = 0, CS_RT = 2304, CS_KHT = 4608, CS_BHT = 6656, CS_VT = 8704  , CS_TT = 10752, CS_AAK = 11264, CS_ARK = 11776, CS_ARB = 12288, CS_PL = 12800, CS_SLOT = 13056;
constexpr int CS_LD = 72;
constexpr int CS_SCR = CS_R * CS_SLOT  , CS_SCRW = 2304 * 2  , CS_FLAG = CS_SCR + CS_NPR * CS_SCRW  ;
__device__ __forceinline__ bf16 f2bf(float f) { return (bf16)cvt_pk_bf16(f, 0.f); }
struct ChainOps { u32x2 a4[4], r4[4], kh[4], bh[4], aak, ark, arb, tt, vb; f32x4 pl[4]; };
__device__ __forceinline__ void chain_load(const LAS unsigned char* sl, int fr, int fg, int c, ChainOps& o) {
    const int o16 = fr * 32 + fg * 8;
    const LAS unsigned char* pa = sl + CS_AT + fr * (CS_LD * 2) + fg * 8; const LAS unsigned char* pr = sl + CS_RT + fr * (CS_LD * 2) + fg * 8;
#pragma unroll
    for (int kq = 0; kq < 4; ++kq) { o.a4[kq] = *(const LAS u32x2*)(pa + 32 * kq); o.r4[kq] = *(const LAS u32x2*)(pr + 32 * kq); }
    o.aak = *(const LAS u32x2*)(sl + CS_AAK + o16); o.ark = *(const LAS u32x2*)(sl + CS_ARK + o16); o.arb = *(const LAS u32x2*)(sl + CS_ARB + o16); o.tt = *(const LAS u32x2*)(sl + CS_TT + o16);
    o.vb = *(const LAS u32x2*)(sl + CS_VT + c * 512 + o16);
#pragma unroll
    for (int mt = 0; mt < 4; ++mt) { o.pl[mt] = *(const LAS f32x4*)(sl + CS_PL + (16 * mt + 4 * fg) * 4);
        o.kh[mt] = *(const LAS u32x2*)(sl + CS_KHT + 512 * mt + o16); o.bh[mt] = *(const LAS u32x2*)(sl + CS_BHT + 512 * mt + o16); }
}
__device__ __forceinline__ f32x4 chain_compute(const ChainOps& o, f32x4 (&zacc)[4]) {
#define CS_M32(A_, B_, C_) __builtin_amdgcn_mfma_f32_16x16x32_bf16(A_, B_, C_, 0, 0, 0)
#define CS_M16(A_, B_, C_) __builtin_amdgcn_mfma_f32_16x16x16bf16_1k(__builtin_bit_cast(s16x4, A_), __builtin_bit_cast(s16x4, B_), C_, 0, 0, 0)
    union { u32x4 w; bf16x8 h8; } zb0, zb1, ap0, ap1, rp0, rp1;
    zb0.w.x = cvt_pk_bf16(zacc[0][0], zacc[0][1]); zb0.w.y = cvt_pk_bf16(zacc[0][2], zacc[0][3]); zb0.w.z = cvt_pk_bf16(zacc[1][0], zacc[1][1]); zb0.w.w = cvt_pk_bf16(zacc[1][2], zacc[1][3]);
    zb1.w.x = cvt_pk_bf16(zacc[2][0], zacc[2][1]); zb1.w.y = cvt_pk_bf16(zacc[2][2], zacc[2][3]); zb1.w.z = cvt_pk_bf16(zacc[3][0], zacc[3][1]); zb1.w.w = cvt_pk_bf16(zacc[3][2], zacc[3][3]);
    ap0.w = (u32x4){o.a4[0].x, o.a4[0].y, o.a4[1].x, o.a4[1].y}; ap1.w = (u32x4){o.a4[2].x, o.a4[2].y, o.a4[3].x, o.a4[3].y};
    rp0.w = (u32x4){o.r4[0].x, o.r4[0].y, o.r4[1].x, o.r4[1].y}; rp1.w = (u32x4){o.r4[2].x, o.r4[2].y, o.r4[3].x, o.r4[3].y};
    const f32x4 zero4 = {0.f, 0.f, 0.f, 0.f};
    f32x4 Wc = CS_M16(o.aak, o.vb, zero4);
    Wc = CS_M32(ap0.h8, zb0.h8, Wc); Wc = CS_M32(ap1.h8, zb1.h8, Wc);
    f32x4 Yc = CS_M16(o.ark, o.vb, zero4);
    Yc = CS_M32(rp0.h8, zb0.h8, Yc); Yc = CS_M32(rp1.h8, zb1.h8, Yc);
    f32x4 zz[4];
#pragma unroll
    for (int mt = 0; mt < 4; ++mt) zz[mt] = CS_M16(o.kh[mt], o.vb, zacc[mt] * o.pl[mt]);
    u32x2 wb, ub;
    wb.x = cvt_pk_bf16(Wc[0], Wc[1]); wb.y = cvt_pk_bf16(Wc[2], Wc[3]);
    const f32x4 Uc = CS_M16(o.tt, wb, zero4);
    ub.x = cvt_pk_bf16(Uc[0], Uc[1]); ub.y = cvt_pk_bf16(Uc[2], Uc[3]);
    Yc = CS_M16(o.arb, ub, Yc);
#pragma unroll
    for (int mt = 0; mt < 4; ++mt) zacc[mt] = CS_M16(o.bh[mt], ub, zz[mt]);
#undef CS_M32
#undef CS_M16
    return Yc;
}
template <int z>
__device__ __forceinline__ void scan_phase_z(const Frame& F, const Args& a, const int seq, const int half) {
    unsigned char* ws = a.ws;
    const int b = (seq >> 3) & 3, h = seq & 7;
    const size_t mb = (size_t)b * T;
    const int lane = F.lane, wave = F.wave, fr = lane & 15, fg = lane >> 4;
    constexpr int NCK = T / 16;
    volatile LAS unsigned* flg = (volatile LAS unsigned*)(F.lds + CS_FLAG);
    if (F.tid < 16) flg[F.tid] = 0u;
    __syncthreads();
    const int o16 = fr * 32 + fg * 8;
#define CS_M32(A_, B_, C_) __builtin_amdgcn_mfma_f32_16x16x32_bf16(A_, B_, C_, 0, 0, 0)
#define CS_M16(A_, B_, C_) __builtin_amdgcn_mfma_f32_16x16x16bf16_1k(__builtin_bit_cast(s16x4, A_), __builtin_bit_cast(s16x4, B_), C_, 0, 0, 0)
    if (wave < CS_NCH) {
        const int c = wave, rg = 2 * half + c;
        __builtin_amdgcn_s_setprio(3);
        bf16* yout = (bf16*)(ws + WS_Y) + (size_t)z * M * CW + h * 64 + rg * 16 + fr;
        f32x4 zacc[4];
#pragma unroll
        for (int mt = 0; mt < 4; ++mt) zacc[mt] = (f32x4){0.f, 0.f, 0.f, 0.f};
        ChainOps opA, opB;
#define CS_READY(nn) do { unsigned sp_ = 0; while (flg[(nn) & (CS_R - 1)] != (unsigned)((nn) + 1)) { __builtin_amdgcn_s_sleep(1); if (++sp_ > (1u << 24)) break; } __builtin_amdgcn_fence(__ATOMIC_ACQUIRE, "workgroup"); } while (0)
#define CS_HANDBACK(nn) do { asm volatile("s_waitcnt lgkmcnt(0)" ::: "memory"); if (lane == 0) flg[8 + c] = (unsigned)((nn) + 1); asm volatile("" ::: "memory"); } while (0)
#define CS_YSTORE(nn, Y_) do { asm volatile("s_waitcnt vmcnt(24)" ::: "memory");   _Pragma("unroll") for (int rr = 0; rr < 4; ++rr) { const int q_ = 16 * (nn) + 4 * fg + rr, t_ = z ? (T - 1 - q_) : q_; yout[(mb + t_) * CW] = f2bf((Y_)[rr]); } } while (0)
        CS_READY(0); chain_load(F.lds, fr, fg, c, opA);
#pragma unroll 1
        for (int n = 0; n < NCK; n += 2) {
            CS_READY(n + 1); CS_HANDBACK(n);
            chain_load(F.lds + ((n + 1) & (CS_R - 1)) * CS_SLOT, fr, fg, c, opB);
            { const f32x4 Yc = chain_compute(opA, zacc); CS_YSTORE(n, Yc); }
            if (n + 2 < NCK) CS_READY(n + 2);
            CS_HANDBACK(n + 1);
            if (n + 2 < NCK) chain_load(F.lds + ((n + 2) & (CS_R - 1)) * CS_SLOT, fr, fg, c, opA);
            { const f32x4 Yc = chain_compute(opB, zacc); CS_YSTORE(n + 1, Yc); }
        }
#undef CS_READY
#undef CS_HANDBACK
#undef CS_YSTORE
        __builtin_amdgcn_s_setprio(0);
    } else {
        const int pi = wave - CS_NCH;
        LAS unsigned char* scr = F.lds + CS_SCR + pi * CS_SCRW;
        LAS bf16* KT = (LAS bf16*)scr; LAS bf16* BT = (LAS bf16*)(scr + 2304);
        const bf16* gw_ = (const bf16*)(ws + WS_DECAY) + (size_t)z * M * CW + h * 64;
        const bf16* gkk = (const bf16*)(ws + WS_KK) + h * 64;
        const bf16* gak = (const bf16*)(ws + WS_AKK) + (size_t)z * M * CW + h * 64;
        const bf16* gk = (const bf16*)(ws + WS_KDIR) + (size_t)z * M * CW + h * 64;
        const bf16* gr = (const bf16*)(ws + WS_R) + h * 64;
        const bf16* gv = (const bf16*)(ws + WS_V) + h * 64 + half * 32 + (lane & 31);
        unsigned nw[16], nkk[16], nak[16], nk[16], nr[16], nv[8];
        constexpr long RSTEP = z ? -(long)CW : (long)CW;
#define CS_FETCH_A(nn) do { if ((nn) < NCK) { const size_t m0_ = (mb + (z ? (T - 1 - 16 * (nn)) : 16 * (nn))) * CW + lane; const bf16* pw_ = gw_ + m0_; const bf16* pkk_ = gkk + m0_; \
            _Pragma("unroll") for (int tt = 0; tt < 16; ++tt) { nw[tt] = pw_[tt * RSTEP]; nkk[tt] = pkk_[tt * RSTEP]; } } } while (0)
#define CS_FETCH_B(nn) do { if ((nn) < NCK) { asm volatile("s_waitcnt vmcnt(30)" ::: "memory"); const size_t m0_ = (mb + (z ? (T - 1 - 16 * (nn)) : 16 * (nn))) * CW + lane; const bf16* pak_ = gak + m0_; const bf16* pk_ = gk + m0_; \
            _Pragma("unroll") for (int tt = 0; tt < 16; ++tt) { nak[tt] = pak_[tt * RSTEP]; nk[tt] = pk_[tt * RSTEP]; } } } while (0)
#define CS_FETCH_C(nn) do { if ((nn) < NCK) { asm volatile("s_waitcnt vmcnt(30)" ::: "memory"); const size_t m0_ = (mb + (z ? (T - 1 - 16 * (nn)) : 16 * (nn))) * CW + lane; const bf16* pr_ = gr + m0_; \
            const bf16* pv_ = gv + (mb + (z ? (T - 1 - 16 * (nn) - 8 * (lane >> 5)) : 16 * (nn) + 8 * (lane >> 5))) * CW; \
            _Pragma("unroll") for (int tt = 0; tt < 16; ++tt) nr[tt] = pr_[tt * RSTEP]; \
            _Pragma("unroll") for (int i_ = 0; i_ < 8; ++i_) nv[i_] = pv_[i_ * RSTEP]; } } while (0)
        CS_FETCH_A(pi); CS_FETCH_B(pi); CS_FETCH_C(pi);
#pragma unroll 1
        for (int n = pi; n < NCK; n += CS_NPR) {
            const int slot = n & (CS_R - 1);
            float wv[16], kkv[16], akv[16], kv[16], rv[16]; unsigned vq[8];
#pragma unroll
            for (int tt = 0; tt < 16; ++tt) { unsigned x0 = nw[tt], x1 = nkk[tt], x2 = nak[tt], x3 = nk[tt], x4 = nr[tt];
                asm volatile("" : "+v"(x0), "+v"(x1), "+v"(x2), "+v"(x3), "+v"(x4));
                wv[tt] = __uint_as_float(x0 << 16); kkv[tt] = __uint_as_float(x1 << 16); akv[tt] = __uint_as_float(x2 << 16); kv[tt] = __uint_as_float(x3 << 16); rv[tt] = __uint_as_float(x4 << 16); }
#pragma unroll
            for (int tt = 0; tt < 8; ++tt) { unsigned x0 = nv[tt]; asm volatile("" : "+v"(x0)); vq[tt] = x0; }
            CS_FETCH_A(n + CS_NPR);
            { unsigned sp = 0; for (;;) { const u32x2 pg = *(const volatile LAS u32x2*)(flg + 8); const int mn = (int)min(pg.x, pg.y);
                  if (mn >= n - (CS_R - 3)) break; __builtin_amdgcn_s_sleep(2); if (++sp > (1u << 24)) break; } }
            __builtin_amdgcn_fence(__ATOMIC_ACQUIRE, "workgroup");
            LAS unsigned char* sl = F.lds + slot * CS_SLOT;
            float P[16];
            P[0] = wv[0];
#pragma unroll
            for (int tt = 1; tt < 16; ++tt) P[tt] = P[tt - 1] * wv[tt];
            const float PL = P[15];
            float khat[16], bhat[16];
#pragma unroll
            for (int tt = 0; tt < 16; ++tt) {
                const float pm1 = tt ? P[tt - 1] : 1.0f, inv = __builtin_amdgcn_rcpf(P[tt]);
                const float at = kkv[tt] * pm1, rt = rv[tt] * P[tt], kt = kv[tt] * inv, bt = -akv[tt] * inv;
                khat[tt] = kt * PL; bhat[tt] = bt * PL;
                { const unsigned w_ = cvt_pk_bf16(at, rt); *(LAS bf16*)(sl + CS_AT + (tt * CS_LD + lane) * 2) = (bf16)w_; *(LAS bf16*)(sl + CS_RT + (tt * CS_LD + lane) * 2) = (bf16)(w_ >> 16); }
                { const unsigned w_ = cvt_pk_bf16(kt, bt); KT[tt * CS_LD + lane] = (bf16)w_; BT[tt * CS_LD + lane] = (bf16)(w_ >> 16); }
            }
            CS_FETCH_B(n + CS_NPR);
            { u32x4 o0, o1;
              o0.x = cvt_pk_bf16(khat[0], khat[1]); o0.y = cvt_pk_bf16(khat[2], khat[3]); o0.z = cvt_pk_bf16(khat[4], khat[5]); o0.w = cvt_pk_bf16(khat[6], khat[7]);
              o1.x = cvt_pk_bf16(khat[8], khat[9]); o1.y = cvt_pk_bf16(khat[10], khat[11]); o1.z = cvt_pk_bf16(khat[12], khat[13]); o1.w = cvt_pk_bf16(khat[14], khat[15]);
              *(LAS u32x4*)(sl + CS_KHT + lane * 32) = o0; *(LAS u32x4*)(sl + CS_KHT + lane * 32 + 16) = o1;
              o0.x = cvt_pk_bf16(bhat[0], bhat[1]); o0.y = cvt_pk_bf16(bhat[2], bhat[3]); o0.z = cvt_pk_bf16(bhat[4], bhat[5]); o0.w = cvt_pk_bf16(bhat[6], bhat[7]);
              o1.x = cvt_pk_bf16(bhat[8], bhat[9]); o1.y = cvt_pk_bf16(bhat[10], bhat[11]); o1.z = cvt_pk_bf16(bhat[12], bhat[13]); o1.w = cvt_pk_bf16(bhat[14], bhat[15]);
              *(LAS u32x4*)(sl + CS_BHT + lane * 32) = o0; *(LAS u32x4*)(sl + CS_BHT + lane * 32 + 16) = o1; }
            *(LAS float*)(sl + CS_PL + lane * 4) = PL;
            { u32x4 o0;
              o0.x = vq[0] | (vq[1] << 16); o0.y = vq[2] | (vq[3] << 16); o0.z = vq[4] | (vq[5] << 16); o0.w = vq[6] | (vq[7] << 16);
              *(LAS u32x4*)(sl + CS_VT + (lane & 31) * 32 + (lane >> 5) * 16) = o0; }
            asm volatile("s_waitcnt lgkmcnt(0)" ::: "memory");
            bf16x8 af[2], rf[2], kf[2], bf_[2];
#pragma unroll
            for (int ks = 0; ks < 2; ++ks) { af[ks] = *(const LAS bf16x8*)(sl + CS_AT + (fr * CS_LD + 32 * ks + 8 * fg) * 2); rf[ks] = *(const LAS bf16x8*)(sl + CS_RT + (fr * CS_LD + 32 * ks + 8 * fg) * 2);
                kf[ks] = *(const LAS bf16x8*)(KT + fr * CS_LD + 32 * ks + 8 * fg); bf_[ks] = *(const LAS bf16x8*)(BT + fr * CS_LD + 32 * ks + 8 * fg); }
            const f32x4 zero4 = {0.f, 0.f, 0.f, 0.f};
            f32x4 Xc = zero4, Xt = zero4, AakT = zero4, ArbT = zero4, ArkT = zero4;
#pragma unroll
            for (int ks = 0; ks < 2; ++ks) { Xc = CS_M32(af[ks], bf_[ks], Xc); Xt = CS_M32(bf_[ks], af[ks], Xt);
                AakT = CS_M32(kf[ks], af[ks], AakT); ArbT = CS_M32(bf_[ks], rf[ks], ArbT); ArkT = CS_M32(kf[ks], rf[ks], ArkT); }
            CS_FETCH_C(n + CS_NPR);
            f32x4 S1;
#pragma unroll
            for (int rr = 0; rr < 4; ++rr) { const int q = 4 * fg + rr;
                Xc[rr] = (fr < q) ? Xc[rr] : 0.f; Xt[rr] = (q < fr) ? Xt[rr] : 0.f; S1[rr] = Xt[rr] + ((q == fr) ? 1.0f : 0.f);
                AakT[rr] = (q < fr) ? AakT[rr] : 0.f; ArkT[rr] = (q <= fr) ? ArkT[rr] : 0.f; ArbT[rr] = (q <= fr) ? ArbT[rr] : 0.f; }
            { u32x2 w; w.x = cvt_pk_bf16(AakT[0], AakT[1]); w.y = cvt_pk_bf16(AakT[2], AakT[3]); *(LAS u32x2*)(sl + CS_AAK + o16) = w;
              w.x = cvt_pk_bf16(ArkT[0], ArkT[1]); w.y = cvt_pk_bf16(ArkT[2], ArkT[3]); *(LAS u32x2*)(sl + CS_ARK + o16) = w;
              w.x = cvt_pk_bf16(ArbT[0], ArbT[1]); w.y = cvt_pk_bf16(ArbT[2], ArbT[3]); *(LAS u32x2*)(sl + CS_ARB + o16) = w; }
#define CS_PK(v) ((u32x2){cvt_pk_bf16((v)[0], (v)[1]), cvt_pk_bf16((v)[2], (v)[3])})
            const u32x2 xc = CS_PK(Xc), xt = CS_PK(Xt), s1 = CS_PK(S1);
            const f32x4 X2c = CS_M16(xt, xc, zero4), X2t = CS_M16(xc, xt, zero4);
            const u32x2 x2c = CS_PK(X2c), x2t = CS_PK(X2t);
            const f32x4 S2 = CS_M16(x2c, s1, S1);
            const f32x4 X4c = CS_M16(x2t, x2c, zero4), X4t = CS_M16(x2c, x2t, zero4);
            const u32x2 x4c = CS_PK(X4c), x4t = CS_PK(X4t), s2 = CS_PK(S2);
            const f32x4 S4 = CS_M16(x4c, s2, S2);
            const f32x4 X8c = CS_M16(x4t, x4c, zero4);
            const u32x2 x8c = CS_PK(X8c), s4 = CS_PK(S4);
            const f32x4 S8 = CS_M16(x8c, s4, S4);
            *(LAS u32x2*)(sl + CS_TT + o16) = CS_PK(S8);
#undef CS_PK
            asm volatile("s_waitcnt lgkmcnt(0)" ::: "memory");
            __builtin_amdgcn_fence(__ATOMIC_RELEASE, "workgroup");
            if (lane == 0) flg[slot] = (unsigned)(n + 1);
        }
#undef CS_FETCH_A
#undef CS_FETCH_B
#undef CS_FETCH_C
    }
#undef CS_M32
#undef CS_M16
    __syncthreads();
}

__device__ __forceinline__ void scan_phase(const Frame& F, const Args& a, const int idx) {
    const int seq = idx >> 1, half = idx & 1;
    if (seq >> 5) scan_phase_z<1>(F, a, seq, half); else scan_phase_z<0>(F, a, seq, half);
}

__device__ __forceinline__ void combine_phase(const Frame& F, const Args& a) {
    unsigned char* ws = a.ws;
    const bf16* att = (const bf16*)(ws + WS_ATT); const bf16* rr = (const bf16*)(ws + WS_R); const bf16* vv = (const bf16*)(ws + WS_V);
    const bf16* kd = (const bf16*)(ws + WS_KDIR); const bf16* gg = (const bf16*)(ws + WS_G); const bf16* y = (const bf16*)(ws + WS_Y);
    bf16* mix = (bf16*)(ws + WS_MIX);
    const float* anw = a.in[4]; const float* r_k = a.in[14]; const float* ln_w = a.in[15]; const float* ln_b = a.in[16];
    const int lane = F.lane, c0 = 8 * lane;
    float nw[8], rk[8], lw[8], lb[8];
#pragma unroll
    for (int i = 0; i < 8; ++i) { nw[i] = anw[c0 + i]; rk[i] = r_k[c0 + i]; lw[i] = ln_w[c0 + i]; lb[i] = ln_b[c0 + i]; }
    const int gw = F.vcu * 8 + F.wave, NGW = F.G * 8;
#pragma unroll 2
    for (int m = gw; m < M; m += NGW) {
        const size_t o = (size_t)m * CW + c0;
        float f[8];
        unpack8(*(const u32x4*)(att + o), f);
        float ss = 0.f;
#pragma unroll
        for (int i = 0; i < 8; ++i) ss += f[i] * f[i];
        const float rs = rsqrtf(wave_sum(ss) * (1.f / CW) + RMS_EPS);
#pragma unroll
        for (int i = 0; i < 8; ++i) f[i] = f[i] * rs * nw[i];
        *(u32x4*)(mix + (size_t)m * D + c0) = pack8(f);
        float yv[8], yw[8];
        unpack8(*(const u32x4*)(y + o), yv); unpack8(*(const u32x4*)(y + (size_t)M * CW + o), yw);
#pragma unroll
        for (int i = 0; i < 8; ++i) yv[i] += yw[i];
        float s1 = 0.f;
#pragma unroll
        for (int i = 0; i < 8; ++i) s1 += yv[i];
        s1 += __shfl_xor(s1, 1); s1 += __shfl_xor(s1, 2); s1 += __shfl_xor(s1, 4);
        const float mean = s1 * (1.f / 64.f);
        float s2 = 0.f;
#pragma unroll
        for (int i = 0; i < 8; ++i) { yv[i] -= mean; s2 += yv[i] * yv[i]; }
        s2 += __shfl_xor(s2, 1); s2 += __shfl_xor(s2, 2); s2 += __shfl_xor(s2, 4);
        const float rstd = rsqrtf(s2 * (1.f / 64.f) + GN_EPS);
        float rf[8], k0[8], k1[8], vf[8], gf[8];
        unpack8(*(const u32x4*)(rr + o), rf); unpack8(*(const u32x4*)(kd + o), k0); unpack8(*(const u32x4*)(kd + (size_t)M * CW + o), k1);
        unpack8(*(const u32x4*)(vv + o), vf); unpack8(*(const u32x4*)(gg + o), gf);
        float cf = 0.f;
#pragma unroll
        for (int i = 0; i < 8; ++i) cf += rf[i] * (k0[i] + k1[i]) * rk[i];
        cf += __shfl_xor(cf, 1); cf += __shfl_xor(cf, 2); cf += __shfl_xor(cf, 4);
#pragma unroll
        for (int i = 0; i < 8; ++i) f[i] = (yv[i] * rstd * lw[i] + lb[i] + cf * vf[i]) * gf[i];
        *(u32x4*)(mix + (size_t)m * D + CW + c0) = pack8(f);
    }
}

constexpr int RT_PITCH = 1032, RT_WH = 0, RT_WL = 32 * RT_PITCH * 2, RT_HIST = 2 * RT_WL, RT_EL = RT_HIST + 256;
__device__ __forceinline__ void router_phase(const Frame& F, const Args& a) {
    unsigned char* ws = a.ws;
    const bf16* hbuf = (const bf16*)(ws + WS_H); unsigned char* hn2 = ws + WS_HN2;
    int* eidx = (int*)(ws + WS_EIDX); float* gate = (float*)(ws + WS_GATE); int* rank = (int*)(ws + WS_RANK);
    unsigned* ctl = (unsigned*)(ws + WS_CTL);
    const float* n2w = a.in[18]; const float* rw = a.in[19]; const float* rb = a.in[20];
    LAS bf16* wh = (LAS bf16*)(F.lds + RT_WH); LAS bf16* wl = (LAS bf16*)(F.lds + RT_WL); LAS int* hist = (LAS int*)(F.lds + RT_HIST); LAS int* eL = (LAS int*)(F.lds + RT_EL);
    { f32x4 tmp[16];
#pragma unroll
      for (int j = 0; j < 16; ++j) tmp[j] = *((const f32x4*)rw + F.tid + 512 * j);
#pragma unroll
      for (int j = 0; j < 16; ++j) { const int q = F.tid + 512 * j, d = q >> 3, e0 = 4 * (q & 7);
#pragma unroll
          for (int i = 0; i < 4; ++i) { const float w = tmp[j][i]; const unsigned hb = cvt_pk_bf16(w, 0.f) & 0xffffu; const float lo = w - __uint_as_float(hb << 16);
              wh[(e0 + i) * RT_PITCH + d] = (bf16)hb; wl[(e0 + i) * RT_PITCH + d] = (bf16)cvt_pk_bf16(lo, 0.f); } } }
    if (F.tid < 32) hist[F.tid] = 0;
    __syncthreads();
    const int lane = F.lane, tk = lane & 15, g = lane >> 4;
    const int blk = F.vcu;
    const int m = blk * 128 + F.wave * 16 + tk;
    const bf16* hrow = hbuf + (size_t)m * D + 8 * g;
    float ss = 0.f;
#pragma unroll 8
    for (int ks = 0; ks < 32; ++ks) { float xf[8]; unpack8(*(const u32x4*)(hrow + 32 * ks), xf);
        ss += (xf[0] * xf[0] + xf[1] * xf[1]) + (xf[2] * xf[2] + xf[3] * xf[3]) + (xf[4] * xf[4] + xf[5] * xf[5]) + (xf[6] * xf[6] + xf[7] * xf[7]); }
    ss += __shfl_xor(ss, 16); ss += __shfl_xor(ss, 32);
    const float rs = rsqrtf(ss * (1.f / D) + RMS_EPS);
    f32x4 acc0 = {0.f, 0.f, 0.f, 0.f}, acc1 = acc0;
    unsigned char* hrow8 = hn2 + (size_t)m * D + 8 * g;
    const LAS bf16* wh0 = wh + tk * RT_PITCH + 8 * g; const LAS bf16* wl0 = wl + tk * RT_PITCH + 8 * g;
#pragma unroll 4
    for (int ks = 0; ks < 32; ++ks) {
        float xf[8]; unpack8(*(const u32x4*)(hrow + 32 * ks), xf);
        const f32x4 x0 = {xf[0], xf[1], xf[2], xf[3]}, x1 = {xf[4], xf[5], xf[6], xf[7]};
        const f32x4 n0 = *(const f32x4*)(n2w + 32 * ks + 8 * g), n1 = *(const f32x4*)(n2w + 32 * ks + 8 * g + 4);
        const f32x4 y0 = x0 * rs * n0, y1 = x1 * rs * n1;
        { u32x2 w8; w8.x = pk4_fp8(y0.x * F8_SX, y0.y * F8_SX, y0.z * F8_SX, y0.w * F8_SX); w8.y = pk4_fp8(y1.x * F8_SX, y1.y * F8_SX, y1.z * F8_SX, y1.w * F8_SX); *(u32x2*)(hrow8 + 32 * ks) = w8; }
        union { u32x4 w; bf16x8 h8; } xh, xl;
        xh.w.x = cvt_pk_bf16(y0.x, y0.y); xh.w.y = cvt_pk_bf16(y0.z, y0.w); xh.w.z = cvt_pk_bf16(y1.x, y1.y); xh.w.w = cvt_pk_bf16(y1.z, y1.w);
        xl.w.x = cvt_pk_bf16(y0.x - bflo(xh.w.x), y0.y - bfhi(xh.w.x)); xl.w.y = cvt_pk_bf16(y0.z - bflo(xh.w.y), y0.w - bfhi(xh.w.y));
        xl.w.z = cvt_pk_bf16(y1.x - bflo(xh.w.z), y1.y - bfhi(xh.w.z)); xl.w.w = cvt_pk_bf16(y1.z - bflo(xh.w.w), y1.w - bfhi(xh.w.w));
        const bf16x8 a0h = *(const LAS bf16x8*)(wh0 + 32 * ks), a1h = *(const LAS bf16x8*)(wh0 + 16 * RT_PITCH + 32 * ks);
        const bf16x8 a0l = *(const LAS bf16x8*)(wl0 + 32 * ks), a1l = *(const LAS bf16x8*)(wl0 + 16 * RT_PITCH + 32 * ks);
        acc0 = __builtin_amdgcn_mfma_f32_16x16x32_bf16(a0h, xh.h8, acc0, 0, 0, 0); acc1 = __builtin_amdgcn_mfma_f32_16x16x32_bf16(a1h, xh.h8, acc1, 0, 0, 0);
        acc0 = __builtin_amdgcn_mfma_f32_16x16x32_bf16(a0h, xl.h8, acc0, 0, 0, 0); acc1 = __builtin_amdgcn_mfma_f32_16x16x32_bf16(a1h, xl.h8, acc1, 0, 0, 0);
        acc0 = __builtin_amdgcn_mfma_f32_16x16x32_bf16(a0l, xh.h8, acc0, 0, 0, 0); acc1 = __builtin_amdgcn_mfma_f32_16x16x32_bf16(a1l, xh.h8, acc1, 0, 0, 0);
    }
    float lv[8]; int li[8];
    { const f32x4 b0 = *(const f32x4*)(rb + 4 * g), b1 = *(const f32x4*)(rb + 16 + 4 * g);
#pragma unroll
      for (int i = 0; i < 4; ++i) { lv[i] = acc0[i] + b0[i]; li[i] = 4 * g + i; lv[4 + i] = acc1[i] + b1[i]; li[4 + i] = 16 + 4 * g + i; } }
    float tv[4]; int ti[4];
#pragma unroll
    for (int kx = 0; kx < 4; ++kx) {
        float bv = lv[0]; int bi = li[0];
#pragma unroll
        for (int i = 1; i < 8; ++i) { const bool gt = lv[i] > bv; bv = gt ? lv[i] : bv; bi = gt ? li[i] : bi; }
#pragma unroll
        for (int o = 16; o < 64; o <<= 1) { const float ov = __shfl_xor(bv, o); const int oi = __shfl_xor(bi, o); const bool tko = (ov > bv) || (ov == bv && oi < bi); bv = tko ? ov : bv; bi = tko ? oi : bi; }
        tv[kx] = bv; ti[kx] = bi;
#pragma unroll
        for (int i = 0; i < 8; ++i) lv[i] = (li[i] == bi) ? -3.0e38f : lv[i];
    }
    if (g == 0) {
        const float e0 = 1.0f, e1 = __expf(tv[1] - tv[0]), e2 = __expf(tv[2] - tv[0]), e3 = __expf(tv[3] - tv[0]);
        const float is = 1.0f / (e0 + e1 + e2 + e3);
        const float gs[4] = {e0 * is, e1 * is, e2 * is, e3 * is};
#pragma unroll
        for (int kx = 0; kx < 4; ++kx) { eidx[m * 4 + kx] = ti[kx]; gate[m * 4 + kx] = gs[kx]; eL[(m - blk * 128) * 4 + kx] = ti[kx]; }
    }
    __syncthreads();
    { const int t = F.tid, e = eL[t]; int rk = 0;
      for (int u = 0; u < t; ++u) rk += (eL[u] == e) ? 1 : 0;
      rank[(blk * 128) * 4 + t] = rk;
      __hip_atomic_fetch_add(&hist[e], 1, __ATOMIC_RELAXED, __HIP_MEMORY_SCOPE_WORKGROUP); }
    __syncthreads();
    if (F.tid < 32) ctl[CW_CNT + blk * 32 + F.tid] = (unsigned)hist[F.tid];
}

__device__ __forceinline__ void dispatch_phase(const Frame& F, const Args& a) {
    unsigned char* ws = a.ws;
    unsigned* ctl = (unsigned*)(ws + WS_CTL);
    const int* eidx = (const int*)(ws + WS_EIDX); const int* rank = (const int*)(ws + WS_RANK); int* dest = (int*)(ws + WS_DEST);
    LAS int* part = (LAS int*)F.lds;
    LAS int* tot = part + 1024;
    const int blk = F.vcu, G = F.G;
    { const int e = F.tid & 31, pt = F.tid >> 5; int s = 0, sb = 0;
      if (G == 256) { int cv[16];
#pragma unroll
          for (int q = 0; q < 16; ++q) cv[q] = (int)ld_u32_agent(ctl + CW_CNT + (pt + 16 * q) * 32 + e);
#pragma unroll
          for (int q = 0; q < 16; ++q) { s += cv[q]; if (pt + 16 * q < blk) sb += cv[q]; } }
      else for (int bb = pt; bb < G; bb += 16) { const int cval = (int)ld_u32_agent(ctl + CW_CNT + bb * 32 + e); s += cval; if (bb < blk) sb += cval; }
      part[pt * 32 + e] = s; part[512 + pt * 32 + e] = sb; }
    __syncthreads();
    if (F.tid < 32) { int s = 0, sb = 0;
        for (int pt = 0; pt < 16; ++pt) { s += part[pt * 32 + F.tid]; sb += part[512 + pt * 32 + F.tid]; }
        tot[F.tid] = s; tot[32 + F.tid] = sb; tot[96 + F.tid] = (s + 255) & ~255; }
    __syncthreads();
    if (F.tid == 0) { int ps = 0; for (int e = 0; e < 32; ++e) { tot[64 + e] = ps; ps += tot[96 + e]; }
        tot[128] = ps >> 8; }
    __syncthreads();
    if (blk == 0) {
        if (F.tid == 0) ctl[CW_NT] = (unsigned)tot[128];
        for (int e = F.tid >> 4; e < 32; e += 32) { const int t0 = tot[64 + e] >> 8, nt = tot[96 + e] >> 8; for (int i = F.tid & 15; i < nt; i += 16) ctl[CW_TEXP + t0 + i] = (unsigned)e; }
    }
    const int lane = F.lane;
    const int mw = blk * 128 + F.wave * 16;
    int* rowtok = (int*)(ws + WS_ROWTOK);
    { const int e = eidx[mw * 4 + lane]; const int dl = tot[64 + e] + tot[32 + e] + rank[mw * 4 + lane]; dest[mw * 4 + lane] = dl; rowtok[dl] = mw + (lane >> 2); }
    { const int e = blk & 31, pt = blk >> 5, np = G >> 5; const int r0 = tot[64 + e] + tot[e], r1 = tot[64 + e] + tot[96 + e];
      if (np > 0) for (int r = r0 + pt * 512 + F.tid; r < r1; r += np * 512) rowtok[r] = 0; }
}

__device__ __forceinline__ void final_phase(const Frame& F, const Args& a) {
    unsigned char* ws = a.ws;
    const bf16* hbuf = (const bf16*)(ws + WS_H); const unsigned char* ybuf = ws + WS_YBUF;
    const int* dest = (const int*)(ws + WS_DEST); const float* gate = (const float*)(ws + WS_GATE);
    const float* fw = a.in[25]; float* out = a.out;
    const int lane = F.lane;
    f32x4 wn[4];
#pragma unroll
    for (int j = 0; j < 4; ++j) wn[j] = *((const f32x4*)fw + lane + 64 * j);
    const int gw = F.vcu * 8 + F.wave, NGW = F.G * 8;
    const int per = M / NGW;
    const int mw = gw * per;
    int dl = 0; float gl = 0.f;
    if (lane < 4 * per && per <= 16) { dl = dest[mw * 4 + lane]; gl = gate[mw * 4 + lane]; }
#pragma unroll 2
    for (int i = 0; i < per; ++i) {
        const int m = mw + i;
        const u32x2* hr = (const u32x2*)(hbuf + (size_t)m * D) + lane;
        f32x4 v[4];
#pragma unroll
        for (int j = 0; j < 4; ++j) { const u32x2 w = hr[64 * j]; v[j] = (f32x4){bflo(w.x), bfhi(w.x), bflo(w.y), bfhi(w.y)}; }
#pragma unroll
        for (int kx = 0; kx < 4; ++kx) {
            const int d = per <= 16 ? __shfl(dl, 4 * i + kx) : dest[m * 4 + kx]; const float gt = (per <= 16 ? __shfl(gl, 4 * i + kx) : gate[m * 4 + kx]) * (1.0f / F8_SY);
            const unsigned* yr = (const unsigned*)(ybuf + (size_t)d * D) + lane;
#pragma unroll
            for (int j = 0; j < 4; ++j) { const unsigned w = yr[64 * j]; const f32x2 lo = __builtin_amdgcn_cvt_pk_f32_fp8((int)w, false), hi = __builtin_amdgcn_cvt_pk_f32_fp8((int)w, true);
                v[j].x += gt * lo.x; v[j].y += gt * lo.y; v[j].z += gt * hi.x; v[j].w += gt * hi.y; }
        }
        float s = 0.f;
#pragma unroll
        for (int j = 0; j < 4; ++j) s += (v[j].x * v[j].x + v[j].y * v[j].y) + (v[j].z * v[j].z + v[j].w * v[j].w);
        const float rs = rsqrtf(wave_sum(s) * (1.f / D) + RMS_EPS);
        f32x4* orow = (f32x4*)(out + (size_t)m * D) + lane;
#pragma unroll
        for (int j = 0; j < 4; ++j) orow[64 * j] = v[j] * rs * wn[j];
    }
}

__global__ void __launch_bounds__(512, 2) fwd_megakernel(Args args) {
    extern __shared__ __attribute__((aligned(16))) unsigned char lds_raw[];
    Frame F;
    F.lds = (LAS unsigned char*)lds_raw;
    F.tid = threadIdx.x; F.lane = F.tid & 63; F.wave = __builtin_amdgcn_readfirstlane(F.tid >> 6);
    F.G = gridDim.x; { const int bx = blockIdx.x; F.vcu = (F.G % 8 == 0) ? (bx % 8) * (F.G / 8) + bx / 8 : bx; }
    unsigned char* ws = args.ws;
    const int lo = args.ph_lo, hi = args.ph_hi;
#define IN(k) (lo <= (k) && (k) < hi)
#if MK_SPLIT
#define SEAM(k) do { } while (0)
#else
    cg::grid_group grid = cg::this_grid();
    { volatile LAS unsigned* st = (volatile LAS unsigned*)(F.lds + LDS_MISC); if (F.tid < 2) st[F.tid] = 0u; __syncthreads(); }
    const XcdBarrier xbar = xcd_barrier_post((unsigned*)(ws + WS_CTL) + CW_BAR, (volatile LAS unsigned*)(F.lds + LDS_MISC));
    if (lo < 0) grid.sync();
#define SEAM(k) do { if (IN(k) && IN((k) + 1)) xcd_barrier(xbar); } while (0)
#endif
#define REP2(k) if constexpr (((MK_REPEAT >> (k)) & 1) != 0)
#define PH1 { pg8::Gemm g{(const bf16*)(ws + WS_HN), (const bf16*)(ws + WS_WINT), 1024, nullptr, 0, nullptr}; \
        pg8::StaticOrder S; S.init(M / 256, NPROJ_PAD / 256, F.G, (int)blockIdx.x); \
        pg8::EpiProj E{(bf16*)(ws + WS_Q), (bf16*)(ws + WS_K), (bf16*)(ws + WS_VT), (bf16*)(ws + WS_P)}; \
        pg8::gemm_phase<pg8::EpiProj, true, true>(F.lds, g, S, E); }
#define PH5 { pg8::Gemm g{(const bf16*)(ws + WS_MIX), (const bf16*)(ws + WS_WOT), 1024, nullptr, 0, nullptr}; \
        pg8::StaticOrder S; S.init(M / 256, D / 256, F.G, (int)blockIdx.x); \
        pg8::EpiWo E{args.in[0], (bf16*)(ws + WS_H)}; \
        pg8::gemm_phase<pg8::EpiWo, true, true>(F.lds, g, S, E); }
#define PH8 { const unsigned* ctl = (const unsigned*)(ws + WS_CTL); const int ntile = (int)ld_u32_agent(ctl + CW_NT); \
        pg8::Gemm g{(const bf16*)(ws + WS_HN2), (const bf16*)(ws + WS_WUPT), 512, ctl + CW_TEXP, (size_t)2048 * 1024, (const int*)(ws + WS_ROWTOK)}; \
        pg8::StaticOrder S; S.init(ntile, 8, F.G, (int)blockIdx.x); \
        pg8::EpiUp E{args.in[22], ws + WS_ACT}; \
        pg8::gemm_phase<pg8::EpiUp, true, true, true, true>(F.lds, g, S, E); }
#define PH9 { const unsigned* ctl = (const unsigned*)(ws + WS_CTL); const int ntile = (int)ld_u32_agent(ctl + CW_NT); \
        pg8::Gemm g{(const bf16*)(ws + WS_ACT), (const bf16*)(ws + WS_WDNT), 512, ctl + CW_TEXP, (size_t)1024 * 1024, nullptr}; \
        pg8::StaticOrder S; S.init(ntile, 4, F.G, (int)blockIdx.x); \
        pg8::EpiDown E{args.in[24], ws + WS_YBUF}; \
        pg8::gemm_phase<pg8::EpiDown, true, true, false, true>(F.lds, g, S, E); }
    if (IN(0)) { p0_prologue(F, args); REP2(0) p0_prologue(F, args); }
    SEAM(0);
    if (IN(1)) { PH1 REP2(1) PH1 }
    SEAM(1);
    if (IN(2)) { prep_phase<true>(F, args); REP2(2) prep_phase<true>(F, args); }
    SEAM(2);
    if (IN(3)) {
        if ((F.vcu & 1) == 0 && (F.vcu >> 1) < 128) { scan_phase(F, args, F.vcu >> 1); REP2(3) scan_phase(F, args, F.vcu >> 1); }
        else { const int nside = F.G - min((F.G + 1) / 2, 128); const int q_ = min((F.vcu + 1) >> 1, 128); side_phase(F, args, F.vcu - q_, nside); REP2(11) side_phase(F, args, F.vcu - q_, nside); }
    }
    SEAM(3);
    if (IN(4)) { combine_phase(F, args); REP2(4) combine_phase(F, args); }
    SEAM(4);
    if (IN(5)) { PH5 REP2(5) PH5 }
    SEAM(5);
    if (IN(6)) { router_phase(F, args); REP2(6) { __syncthreads(); router_phase(F, args); } }
    SEAM(6);
    if (IN(7)) { dispatch_phase(F, args); REP2(7) { __syncthreads(); dispatch_phase(F, args); } }
    SEAM(7);
    if (IN(8)) { PH8 REP2(8) PH8 }
    SEAM(8);
    if (IN(9)) { PH9 REP2(9) PH9 }
    SEAM(9);
    if (IN(10)) { final_phase(F, args); REP2(10) final_phase(F, args); }
#undef IN
#undef SEAM
}

extern "C" void kernel_launch(void* const* d_in, const int* in_sizes, int n_in, void* d_out, int out_size, void* d_ws, size_t ws_size, hipStream_t stream) {
    static int grid = 0;
    if (grid == 0) {
        if (n_in != 26 || in_sizes[0] != M * D || out_size != M * D || ws_size < WS_END) { fprintf(stderr, "kernel_launch: unexpected problem (n_in %d, in0 %d, out %d, ws %zu)\n", n_in, n_in > 0 ? in_sizes[0] : -1, out_size, ws_size); grid = -1; return; }
        int dev = 0, cus = 0, per_cu = 0;
        if (hipGetDevice(&dev) != hipSuccess || hipDeviceGetAttribute(&cus, hipDeviceAttributeMultiprocessorCount, dev) != hipSuccess) { grid = -1; return; }
        if (hipFuncSetAttribute((const void*)fwd_megakernel, hipFuncAttributeMaxDynamicSharedMemorySize, LDS_BYTES) != hipSuccess) { fprintf(stderr, "kernel_launch: hipFuncSetAttribute failed\n"); grid = -1; return; }
        if (hipOccupancyMaxActiveBlocksPerMultiprocessor(&per_cu, (const void*)fwd_megakernel, 512, LDS_BYTES) != hipSuccess || per_cu < 1) { fprintf(stderr, "kernel_launch: occupancy query says %d\n", per_cu); per_cu = 1; }
        (void)hipGetLastError();
        grid = cus * 1;
        if (grid != 256) fprintf(stderr, "kernel_launch: note: %d CUs\n", cus);
    }
    if (grid < 0) return;
    if (hipMemsetAsync((char*)d_ws + WS_CTL + (size_t)CW_BAR * 4, 0, XCD_BAR_WORDS * 4, stream) != hipSuccess) { fprintf(stderr, "kernel_launch: memset failed\n"); return; }
    Args a{};
    for (int i = 0; i < 26; ++i) a.in[i] = (const float*)d_in[i];
    a.out = (float*)d_out; a.ws = (unsigned char*)d_ws;
#if MK_SPLIT
    for (int ph = 0; ph < NPHASE; ++ph) { a.ph_lo = ph; a.ph_hi = ph + 1; hipLaunchKernelGGL(fwd_megakernel, dim3(grid), dim3(512), LDS_BYTES, stream, a); }
#else
    a.ph_lo = 0; a.ph_hi = NPHASE;
    void* kargs[] = {&a};
    hipError_t e = hipLaunchCooperativeKernel((const void*)fwd_megakernel, dim3(grid), dim3(512), kargs, LDS_BYTES, stream);
    if (e != hipSuccess) fprintf(stderr, "kernel_launch: cooperative launch failed: %s (grid %d)\n", hipGetErrorString(e), grid);
#endif
}
```

```cpp
#include <hip/hip_runtime.h>
#include <hip/hip_cooperative_groups.h>
#include <cstdio>
#include <cstdint>
namespace cg = cooperative_groups;

#ifndef MK_SPLIT
#define MK_SPLIT 0
#endif

#ifndef MK_REPEAT
#define MK_REPEAT 0
#endif
#define LAS __attribute__((address_space(3)))
typedef unsigned short bf16;
typedef float f32x4 __attribute__((ext_vector_type(4)));
typedef float f32x2 __attribute__((ext_vector_type(2)));
typedef unsigned u32x4 __attribute__((ext_vector_type(4)));
typedef unsigned u32x2 __attribute__((ext_vector_type(2)));
typedef short bf16x8 __attribute__((ext_vector_type(8)));
typedef short s16x4 __attribute__((ext_vector_type(4)));

constexpr int BATCH = 4, T = 8192, D = 1024, M = BATCH * T;
constexpr int NH = 8, HD = 64, CW = 512;
constexpr int SHIFT_W = 1920, NPROJ = 3456, NPROJ_PAD = 3584, PW = 2048;
constexpr int NE = 32, TOPK = 4, DE = 1024;
constexpr int GRIDW = 64, GROWS = 128;
constexpr int P_TILES_MAX = 544, P_ROWS = P_TILES_MAX * 256;
constexpr float RMS_EPS = 1e-5f, GN_EPS = 64e-5f;
constexpr int NPHASE = 11;

constexpr size_t MiB = 1u << 20;
constexpr size_t WS_CTL = 0;
constexpr size_t WS_W2T = 1 * MiB, WS_A2T = WS_W2T + 131072, WS_G2T = WS_A2T + 131072;
constexpr size_t WS_WINT = 2 * MiB, WS_WOT = 9 * MiB, WS_WUPT = 12 * MiB, WS_WDNT = 140 * MiB;
constexpr size_t WS_EIDX = 204 * MiB, WS_GATE = WS_EIDX + 524288, WS_RANK = WS_GATE + 524288, WS_DEST = WS_RANK + 524288, WS_ROWTOK = WS_DEST + 524288;
constexpr size_t WS_R = 208 * MiB, WS_V = 240 * MiB, WS_KK = 272 * MiB, WS_DECAY = 304 * MiB, WS_KDIR = 368 * MiB, WS_AKK = 432 * MiB,
                 WS_G = 496 * MiB, WS_ATT = 528 * MiB;
constexpr size_t WS_Q = 560 * MiB, WS_K = 592 * MiB, WS_VT = 624 * MiB, WS_P = 656 * MiB, WS_HN = 784 * MiB, WS_Y = 848 * MiB;
constexpr size_t WS_MIX = 560 * MiB, WS_H = 752 * MiB, WS_HN2 = 880 * MiB, WS_XBUF = 208 * MiB, WS_ACT = 480 * MiB, WS_YBUF = 208 * MiB;
constexpr size_t WS_END = 976 * MiB;
constexpr int RT_PITCH = 1032, RT_WH = 0, RT_WL = 32 * RT_PITCH * 2, RT_HIST = 2 * RT_WL, RT_EL = RT_HIST + 256;
constexpr size_t WS_RTIMG = 262144;

constexpr int CW_NT = 0, CW_TEXP = 64, CW_CNT = 1024, CW_BAR = 16384;

constexpr int LDS_BYTES = 159744, LDS_MISC = LDS_BYTES - 256;

typedef __bf16 bf16x2_t __attribute__((ext_vector_type(2)));
__device__ __forceinline__ unsigned cvt_pk_bf16(float lo, float hi) { const f32x2 v = {lo, hi}; return __builtin_bit_cast(unsigned, __builtin_convertvector(v, bf16x2_t)); }
typedef int i32x8 __attribute__((ext_vector_type(8)));
typedef int i32x4 __attribute__((ext_vector_type(4)));
#ifndef F8_SCALE1
#define F8_SCALE1 0
#endif
constexpr float F8_SX = 32.0f, F8_SW = 128.0f, F8_SACT = 8.0f, F8_SY = 32.0f;
__device__ __forceinline__ float f8clamp(float v) { return __builtin_amdgcn_fmed3f(v, -448.0f, 448.0f); }
__device__ __forceinline__ unsigned pk4_fp8(float a, float b, float c, float d) { int w = 0; w = __builtin_amdgcn_cvt_pk_fp8_f32(f8clamp(a), f8clamp(b), w, false); w = __builtin_amdgcn_cvt_pk_fp8_f32(f8clamp(c), f8clamp(d), w, true); return (unsigned)w; }
__device__ __forceinline__ float bflo(unsigned u) { return __uint_as_float(u << 16); }
__device__ __forceinline__ float bfhi(unsigned u) { return __uint_as_float(u & 0xffff0000u); }
__device__ __forceinline__ float bf1(bf16 v) { return __uint_as_float(((unsigned)v) << 16); }
__device__ __forceinline__ void unpack8(const u32x4 u, float* f) { f[0] = bflo(u.x); f[1] = bfhi(u.x); f[2] = bflo(u.y); f[3] = bfhi(u.y); f[4] = bflo(u.z); f[5] = bfhi(u.z); f[6] = bflo(u.w); f[7] = bfhi(u.w); }
__device__ __forceinline__ u32x4 pack8(const float* f) { u32x4 o; o.x = cvt_pk_bf16(f[0], f[1]); o.y = cvt_pk_bf16(f[2], f[3]); o.z = cvt_pk_bf16(f[4], f[5]); o.w = cvt_pk_bf16(f[6], f[7]); return o; }
__device__ __forceinline__ float wave_sum(float v) {
#pragma unroll
    for (int o = 1; o < 64; o <<= 1) v += __shfl_xor(v, o);
    return v;
}
__device__ __forceinline__ float sigmoidf_(float x) { return __builtin_amdgcn_rcpf(1.0f + __expf(-x)); }
__device__ __forceinline__ unsigned ld_u32_agent(const unsigned* p) { return __hip_atomic_load(p, __ATOMIC_RELAXED, __HIP_MEMORY_SCOPE_AGENT); }

namespace pg8 {
constexpr int BM = 256, BK = 64, HALF = 128, HTB = HALF * BK * 2, STAGE_BYTES = 8 * HTB, NXCD = 8, WGM = 8;
__host__ __device__ __forceinline__ int lds_byte(int r, int c) { const int st = (r >> 4) * 2 + (c >> 5), rr = r & 15, cc = c & 31, ob = rr * 64 + cc * 2; return st * 1024 + (ob ^ (((ob >> 9) & 1) << 5)); }
__host__ __device__ __forceinline__ void stage_rc(int b, int& R, int& C) { const int st = b / 1024, sb = b % 1024, swz = sb ^ (((sb >> 9) & 1) << 5); R = (st >> 1) * 16 + swz / 64; C = (st & 1) * 32 + (swz % 64) / 2; }
__host__ __device__ __forceinline__ int perm32(int rho) { const int n = rho >> 4, i = rho & 15; return 8 * (i >> 2) + 4 * n + (i & 3); }

struct Unit { int pm, pn, e; };
struct Gemm { const bf16* A; const bf16* Bt; int K; const unsigned* texp; size_t bstride; const int* rowtok; };

struct StaticOrder {
    int nM, nN, nwg, G, c;
    __device__ void init(int nM_, int nN_, int G_, int c_) { nM = nM_; nN = nN_; nwg = nM * nN; G = G_; c = c_; }
    __device__ bool next(int i, Unit& u) const {
        const long L = (long)i * G + c; if (L >= nwg) return false;
        int wgid = (int)L; { const int q = nwg / NXCD, r = nwg % NXCD, xcd = wgid % NXCD, off = wgid / NXCD; wgid = (xcd < r ? xcd * (q + 1) : r * (q + 1) + (xcd - r) * q) + off; }
        const int nig = WGM * nN, gid = wgid / nig, fm = gid * WGM, gsz = (nM - fm) < WGM ? (nM - fm) : WGM;
        u.pm = fm + ((wgid % nig) % gsz); u.pn = (wgid % nig) / gsz; u.e = 0; return true;
    }
};

__device__ __forceinline__ i32x8 cat8(const bf16x8 lo, const bf16x8 hi) { return __builtin_shufflevector(__builtin_bit_cast(i32x4, lo), __builtin_bit_cast(i32x4, hi), 0, 1, 2, 3, 4, 5, 6, 7); }
template <class Epi, bool ALIGN_EPI, bool SP2, bool GATHER = false, bool FP8 = false>
__device__ __forceinline__ void gemm_phase(LAS unsigned char* lds, const Gemm g, const StaticOrder& S, const Epi& E) {
    const int tid = threadIdx.x, wid = __builtin_amdgcn_readfirstlane(tid >> 6), lane = tid & 63, wr = wid >> 2, wc = wid & 3, fr = lane & 15, fq = lane >> 4;
    const int K = g.K, nt = K / BK;
    unsigned voffA[2], voffB[2];
#pragma unroll
    for (int i = 0; i < 2; ++i) { int R, C; stage_rc(tid * 16 + i * 8192, R, C); const int Rb = Epi::PERM ? ((R & ~31) + perm32(R & 31)) : R;
        voffA[i] = (unsigned)(R * K + C) * 2u; voffB[i] = (unsigned)(Rb * K + C) * 2u; }
    unsigned vC[2][2];
#define PG8_GROWS(u, dst) do { _Pragma("unroll") for (int h_ = 0; h_ < 2; ++h_) _Pragma("unroll") for (int i_ = 0; i_ < 2; ++i_) { int R_, C_; stage_rc(tid * 16 + i_ * 8192, R_, C_); \
        dst[h_][i_] = (unsigned)g.rowtok[(u).pm * BM + h_ * HALF + R_] * (unsigned)(K * 2) + (unsigned)(C_ * 2); } } while (0)
    const size_t kstep = (size_t)(BK * 2);
    const size_t hstep = (size_t)HALF * K * 2;
    const size_t tstep = 2 * hstep;
    const unsigned ldsw = (unsigned)wid * 1024u;
    const int aoff = lds_byte(wr * 64 + fr, fq * 8), boff = lds_byte(wc * 32 + fr, fq * 8);
#define PG8_SA(b, h) (((b) * 2 + (h)) * HTB)
#define PG8_SB(b, h) ((4 + (b) * 2 + (h)) * HTB)
#define PG8_STAGE(bufoff, gbase, voff) do { _Pragma("unroll") for (int _i = 0; _i < 2; ++_i) \
        __builtin_amdgcn_global_load_lds((const unsigned*)((const char*)(gbase) + (voff)[_i]), (LAS unsigned*)(lds + (bufoff) + ldsw + _i * 8192), 16, 0, 0); } while (0)
#define PG8_STAGE_A(bufoff, p, h, nx) do { if constexpr (GATHER) { PG8_STAGE(bufoff, p, vC[h]); } else PG8_STAGE(bufoff, (p) + (h) * hstep, voffA); } while (0)
#define PG8_LDA(dst, b, h) do { _Pragma("unroll") for (int m = 0; m < 4; ++m) _Pragma("unroll") for (int k = 0; k < 2; ++k) dst[m][k] = *(const LAS bf16x8*)(lds + PG8_SA(b, h) + aoff + m * 2048 + k * 1024); } while (0)
#define PG8_LDB(dst, b, h) do { _Pragma("unroll") for (int n = 0; n < 2; ++n) _Pragma("unroll") for (int k = 0; k < 2; ++k) dst[n][k] = *(const LAS bf16x8*)(lds + PG8_SB(b, h) + boff + n * 2048 + k * 1024); } while (0)
#define PG8_MMA(ai, bj, At, Bt) do { __builtin_amdgcn_s_setprio(1); \
        if constexpr (FP8) { _Pragma("unroll") for (int m = 0; m < 4; ++m) _Pragma("unroll") for (int n = 0; n < 2; ++n) \
            { const i32x8 b8_ = cat8(Bt[n][0], Bt[n][1]), a8_ = cat8(At[m][0], At[m][1]); asm volatile("v_mfma_f32_16x16x128_f8f6f4 %0, %1, %2, %0" : "+v"(acc[ai][bj][m][n]) : "v"(b8_), "v"(a8_)); } } \
        else { _Pragma("unroll") for (int m = 0; m < 4; ++m) _Pragma("unroll") for (int n = 0; n < 2; ++n) _Pragma("unroll") for (int k = 0; k < 2; ++k) \
            acc[ai][bj][m][n] = __builtin_amdgcn_mfma_f32_16x16x32_bf16(Bt[n][k], At[m][k], acc[ai][bj][m][n], 0, 0, 0); } \
        __builtin_amdgcn_s_setprio(0); } while (0)
#define PG8_WAIT_V(n) asm volatile("s_waitcnt vmcnt(" #n ")" ::: "memory")
#define PG8_WAIT_L(n) asm volatile("s_waitcnt lgkmcnt(" #n ")" ::: "memory")
#define PG8_BAR __builtin_amdgcn_s_barrier()
#define PG8_SCHED __builtin_amdgcn_sched_barrier(0)
#define PG8_UPTR(u, pa, pb) do { unsigned _e = g.texp ? ld_u32_agent(g.texp + (u).pm) : 0u; _e = (unsigned)__builtin_amdgcn_readfirstlane((int)_e); (u).e = (int)_e; \
        pa = GATHER ? (const char*)g.A : (const char*)g.A + (size_t)(u).pm * tstep; pb = (const char*)g.Bt + (size_t)_e * g.bstride + (size_t)(u).pn * tstep; } while (0)
    Unit cur, nxt; int ui = 0;
    if (!S.next(0, cur)) return;
    f32x4 acc[2][2][4][2];
#pragma unroll
    for (int a = 0; a < 2; ++a)
#pragma unroll
        for (int b = 0; b < 2; ++b)
#pragma unroll
            for (int m = 0; m < 4; ++m)
#pragma unroll
                for (int n = 0; n < 2; ++n) acc[a][b][m][n] = (f32x4){0.f, 0.f, 0.f, 0.f};
    bf16x8 At[4][2], B0[2][2], B1[2][2];
    const char* cA; const char* cB;
    PG8_UPTR(cur, cA, cB);
    if constexpr (GATHER) { PG8_GROWS(cur, vC); }
    if constexpr (SP2) {
        PG8_STAGE(PG8_SB(0, 0), cB, voffB); PG8_STAGE(PG8_SB(0, 1), cB + hstep, voffB); PG8_STAGE_A(PG8_SA(0, 0), cA, 0, false); PG8_STAGE_A(PG8_SA(0, 1), cA, 1, false);
        if (wr == 1) PG8_BAR;
        PG8_WAIT_V(2); PG8_BAR;
        PG8_STAGE(PG8_SB(1, 0), cB + kstep, voffB); PG8_STAGE_A(PG8_SA(1, 0), cA + kstep, 0, false); PG8_STAGE(PG8_SB(1, 1), cB + hstep + kstep, voffB);
        PG8_WAIT_V(6); PG8_BAR;
    } else {
        PG8_STAGE(PG8_SB(0, 0), cB, voffB); PG8_STAGE_A(PG8_SA(0, 0), cA, 0, false); PG8_STAGE(PG8_SB(0, 1), cB + hstep, voffB); PG8_STAGE_A(PG8_SA(0, 1), cA, 1, false);
        if (wr == 1) PG8_BAR;
        PG8_WAIT_V(4); PG8_BAR;
        PG8_STAGE(PG8_SB(1, 0), cB + kstep, voffB); PG8_STAGE_A(PG8_SA(1, 0), cA + kstep, 0, false); PG8_STAGE(PG8_SB(1, 1), cB + hstep + kstep, voffB);
        PG8_WAIT_V(6); PG8_BAR;
    }
    for (;;) {
        const bool has_next = S.next(ui + 1, nxt);
        const char* nA = cA; const char* nB = cB;
        if (has_next) PG8_UPTR(nxt, nA, nB);
#pragma unroll 1
        for (int t = 0; t < nt; t += 2) {
            const bool last = (t == nt - 2);
            const char* a1 = cA + (size_t)(t + 1) * kstep;
            const char* a2 = last ? nA : cA + (size_t)(t + 2) * kstep; const char* b2 = last ? nB : cB + (size_t)(t + 2) * kstep;
            const char* a3 = a2 + kstep; const char* b3 = b2 + kstep;
            if constexpr (SP2) {
            PG8_LDB(B0, 0, 0); PG8_LDB(B1, 0, 1); PG8_SCHED; PG8_LDA(At, 0, 0); PG8_STAGE_A(PG8_SA(1, 1), a1, 1, false);
            if constexpr (GATHER) { if (last && has_next) { PG8_GROWS(nxt, vC); } }
            PG8_WAIT_V(8); PG8_WAIT_L(0); PG8_BAR; PG8_MMA(0, 0, At, B0); PG8_MMA(0, 1, At, B1); PG8_BAR; PG8_SCHED;
            PG8_LDA(At, 0, 1); PG8_STAGE(PG8_SB(0, 0), b2, voffB); PG8_STAGE(PG8_SB(0, 1), b2 + hstep, voffB); PG8_STAGE_A(PG8_SA(0, 0), a2, 0, last);
            PG8_WAIT_V(8); PG8_WAIT_L(0); PG8_BAR; PG8_MMA(1, 0, At, B0); PG8_MMA(1, 1, At, B1); PG8_BAR; PG8_SCHED;
            PG8_LDB(B0, 1, 0); PG8_LDB(B1, 1, 1); PG8_SCHED; PG8_LDA(At, 1, 0); PG8_STAGE_A(PG8_SA(0, 1), a2, 1, last);
            PG8_WAIT_V(8); PG8_WAIT_L(0); PG8_BAR; PG8_MMA(0, 0, At, B0); PG8_MMA(0, 1, At, B1); PG8_BAR; PG8_SCHED;
            PG8_LDA(At, 1, 1); PG8_STAGE(PG8_SB(1, 0), b3, voffB); PG8_STAGE(PG8_SB(1, 1), b3 + hstep, voffB); PG8_STAGE_A(PG8_SA(1, 0), a3, 0, last);
            PG8_WAIT_V(8); PG8_WAIT_L(0); PG8_BAR; PG8_MMA(1, 0, At, B0); PG8_MMA(1, 1, At, B1); PG8_BAR; PG8_SCHED;
            } else {
            PG8_LDB(B0, 0, 0); PG8_SCHED; PG8_LDA(At, 0, 0); PG8_STAGE_A(PG8_SA(1, 1), a1, 1, false);
            if constexpr (GATHER) { if (last && has_next) { PG8_GROWS(nxt, vC); } }
            PG8_WAIT_L(8); PG8_BAR; PG8_WAIT_L(0); PG8_MMA(0, 0, At, B0); PG8_BAR; PG8_SCHED;
            PG8_LDB(B1, 0, 1); PG8_STAGE(PG8_SB(0, 0), b2, voffB);
            PG8_BAR; PG8_WAIT_L(0); PG8_MMA(0, 1, At, B1); PG8_BAR;
            PG8_LDA(At, 0, 1); PG8_STAGE_A(PG8_SA(0, 0), a2, 0, last);
            PG8_BAR; PG8_WAIT_L(0); PG8_MMA(1, 0, At, B0); PG8_BAR; PG8_SCHED;
            PG8_STAGE(PG8_SB(0, 1), b2 + hstep, voffB);
            PG8_WAIT_V(6); PG8_BAR; PG8_MMA(1, 1, At, B1); PG8_BAR;
            PG8_LDB(B0, 1, 0); PG8_SCHED; PG8_LDA(At, 1, 0); PG8_STAGE_A(PG8_SA(0, 1), a2, 1, last);
            PG8_WAIT_L(8); PG8_BAR; PG8_WAIT_L(0); PG8_MMA(0, 0, At, B0); PG8_BAR; PG8_SCHED;
            PG8_LDB(B1, 1, 1); PG8_STAGE(PG8_SB(1, 0), b3, voffB);
            PG8_BAR; PG8_WAIT_L(0); PG8_MMA(0, 1, At, B1); PG8_BAR;
            PG8_LDA(At, 1, 1); PG8_STAGE_A(PG8_SA(1, 0), a3, 0, last);
            PG8_BAR; PG8_WAIT_L(0); PG8_MMA(1, 0, At, B0); PG8_BAR; PG8_SCHED;
            PG8_STAGE(PG8_SB(1, 1), b3 + hstep, voffB);
            PG8_WAIT_V(6); PG8_BAR; PG8_MMA(1, 1, At, B1); PG8_BAR;
            }
        }
        if constexpr (ALIGN_EPI) { if (wr == 0) PG8_BAR; }
        if constexpr (FP8) { asm volatile("s_nop 15\n\ts_nop 15" ::: "memory"); PG8_SCHED; }
        E(acc, cur, wr, wc, fr, fq);
        if (!has_next) break;
#pragma unroll
        for (int a = 0; a < 2; ++a)
#pragma unroll
            for (int b = 0; b < 2; ++b)
#pragma unroll
                for (int m = 0; m < 4; ++m)
#pragma unroll
                    for (int n = 0; n < 2; ++n) acc[a][b][m][n] = (f32x4){0.f, 0.f, 0.f, 0.f};
        cur = nxt; cA = nA; cB = nB; ++ui;
        if constexpr (ALIGN_EPI) { if (wr == 1) PG8_BAR; }
    }
    PG8_WAIT_V(0);
    if constexpr (!ALIGN_EPI) { if (wr == 0) PG8_BAR; }
    PG8_BAR;
#undef PG8_SA
#undef PG8_SB
#undef PG8_STAGE
#undef PG8_LDA
#undef PG8_LDB
#undef PG8_MMA
#undef PG8_WAIT_V
#undef PG8_WAIT_L
#undef PG8_BAR
#undef PG8_SCHED
#undef PG8_UPTR
#undef PG8_STAGE_A
#undef PG8_GROWS
}

struct EpiProj {
    static constexpr bool PERM = true;
    bf16 *q, *k, *vT, *p;
    __device__ __forceinline__ void operator()(const f32x4 (&acc)[2][2][4][2], const Unit& u, int wr, int wc, int fr, int fq) const {
        const int row0 = u.pm * BM + wr * 64 + fr;
        const int pn = u.pn;
#pragma unroll
        for (int ai = 0; ai < 2; ++ai)
#pragma unroll
            for (int m = 0; m < 4; ++m) {
                const int row = row0 + ai * HALF + m * 16;
#pragma unroll
                for (int bj = 0; bj < 2; ++bj) {
                    f32x4 v0 = acc[ai][bj][m][0], v1 = acc[ai][bj][m][1];
                    const int col = pn * BM + bj * HALF + wc * 32 + 8 * fq;
                    if (pn >= 4 && pn < 6) {
                        const int cv = col - 1024, hh = cv >> 6, dim = cv & 63, b = row / T, t = row % T;
                        bf16* dst = vT + ((size_t)(((b * NH + hh) * GROWS + (t >> 6)) * HD + dim)) * 64 + (t & 63);
                        const unsigned w0 = cvt_pk_bf16(v0[0], v0[1]), w1 = cvt_pk_bf16(v0[2], v0[3]), w2 = cvt_pk_bf16(v1[0], v1[1]), w3 = cvt_pk_bf16(v1[2], v1[3]);
                        dst[0 * 64] = (bf16)(w0 & 0xffff); dst[1 * 64] = (bf16)(w0 >> 16); dst[2 * 64] = (bf16)(w1 & 0xffff); dst[3 * 64] = (bf16)(w1 >> 16);
                        dst[4 * 64] = (bf16)(w2 & 0xffff); dst[5 * 64] = (bf16)(w2 >> 16); dst[6 * 64] = (bf16)(w3 & 0xffff); dst[7 * 64] = (bf16)(w3 >> 16);
                        asm volatile("s_waitcnt vmcnt(40)" ::: "memory");
                    } else {
                        bf16* dst;
                        if (pn < 2) { v0 = v0 * 0.125f; v1 = v1 * 0.125f; dst = q + (size_t)row * CW + col; }
                        else if (pn < 4) dst = k + (size_t)row * CW + (col - 512);
                        else dst = p + (size_t)row * PW + (col - 1536);
                        u32x4 w; w.x = cvt_pk_bf16(v0[0], v0[1]); w.y = cvt_pk_bf16(v0[2], v0[3]); w.z = cvt_pk_bf16(v1[0], v1[1]); w.w = cvt_pk_bf16(v1[2], v1[3]);
                        *(u32x4*)dst = w;
                    }
                }
            }
    }
};
struct EpiWo {
    static constexpr bool PERM = true;
    const float* x; bf16* h;
    __device__ __forceinline__ void operator()(const f32x4 (&acc)[2][2][4][2], const Unit& u, int wr, int wc, int fr, int fq) const {
        const int row0 = u.pm * BM + wr * 64 + fr, col0 = u.pn * BM + wc * 32 + 8 * fq;
#pragma unroll
        for (int ai = 0; ai < 2; ++ai)
#pragma unroll
            for (int m = 0; m < 4; ++m) { const size_t off = (size_t)(row0 + ai * HALF + m * 16) * D + col0;
#pragma unroll
                for (int bj = 0; bj < 2; ++bj) { const f32x4 v0 = acc[ai][bj][m][0] + *(const f32x4*)(x + off + bj * HALF), v1 = acc[ai][bj][m][1] + *(const f32x4*)(x + off + bj * HALF + 4);
                    u32x4 w; w.x = cvt_pk_bf16(v0[0], v0[1]); w.y = cvt_pk_bf16(v0[2], v0[3]); w.z = cvt_pk_bf16(v1[0], v1[1]); w.w = cvt_pk_bf16(v1[2], v1[3]);
                    *(u32x4*)(h + off + bj * HALF) = w; } }
    }
};
struct EpiUp {
    static constexpr bool PERM = true;
    const float* b_up; unsigned char* act;
    __device__ __forceinline__ void operator()(const f32x4 (&acc)[2][2][4][2], const Unit& u, int wr, int wc, int fr, int fq) const {
        const int row0 = u.pm * BM + wr * 64 + fr, ch = u.pn * 128 + wc * 32 + 8 * fq;
        const float* bg = b_up + (size_t)u.e * 2048 + ch; const float* bl = bg + 1024;
        const f32x4 bg0 = *(const f32x4*)bg * F8_SACT, bg1 = *(const f32x4*)(bg + 4) * F8_SACT, bl0 = *(const f32x4*)bl, bl1 = *(const f32x4*)(bl + 4);
        constexpr float SG = F8_SACT / (F8_SX * F8_SW), SL = 1.0f / (F8_SX * F8_SW), KE = -1.702f * 1.44269504f / F8_SACT;
#pragma unroll
        for (int ai = 0; ai < 2; ++ai)
#pragma unroll
            for (int m = 0; m < 4; ++m) {
                float o[8];
#pragma unroll
                for (int n = 0; n < 2; ++n) { const f32x4 ga = acc[ai][0][m][n], la = acc[ai][1][m][n]; const f32x4 bgn = n ? bg1 : bg0, bln = n ? bl1 : bl0;
#pragma unroll
                    for (int hj = 0; hj < 2; ++hj) {
                        const f32x2 gv = __builtin_elementwise_fma((f32x2){ga[2 * hj], ga[2 * hj + 1]}, (f32x2){SG, SG}, (f32x2){bgn[2 * hj], bgn[2 * hj + 1]});
                        const f32x2 lv = __builtin_elementwise_fma((f32x2){la[2 * hj], la[2 * hj + 1]}, (f32x2){SL, SL}, (f32x2){bln[2 * hj], bln[2 * hj + 1]});
                        const f32x2 gt = {fminf(gv.x, 7.0f * F8_SACT), fminf(gv.y, 7.0f * F8_SACT)};
                        const f32x2 li = {__builtin_amdgcn_fmed3f(lv.x, -7.0f, 7.0f), __builtin_amdgcn_fmed3f(lv.y, -7.0f, 7.0f)};
                        const f32x2 zk = __builtin_elementwise_fma(gt, (f32x2){KE, KE}, (f32x2){-0.0f, -0.0f});
                        const f32x2 ez = {__builtin_amdgcn_exp2f(zk.x), __builtin_amdgcn_exp2f(zk.y)};
                        const f32x2 den = __builtin_elementwise_fma(ez, (f32x2){1.0f, 1.0f}, (f32x2){1.0f, 1.0f});
                        const f32x2 rc = {__builtin_amdgcn_rcpf(den.x), __builtin_amdgcn_rcpf(den.y)};
                        const f32x2 t = __builtin_elementwise_fma(gt, rc, (f32x2){-0.0f, -0.0f});
                        const f32x2 ov = __builtin_elementwise_fma(li, t, t);
                        o[n * 4 + 2 * hj] = ov.x; o[n * 4 + 2 * hj + 1] = ov.y; } }
                int w0 = 0, w1 = 0;
                w0 = __builtin_amdgcn_cvt_pk_fp8_f32(o[0], o[1], w0, false); w0 = __builtin_amdgcn_cvt_pk_fp8_f32(o[2], o[3], w0, true);
                w1 = __builtin_amdgcn_cvt_pk_fp8_f32(o[4], o[5], w1, false); w1 = __builtin_amdgcn_cvt_pk_fp8_f32(o[6], o[7], w1, true);
                u32x2 w8; w8.x = (unsigned)w0; w8.y = (unsigned)w1;
                *(u32x2*)(act + (size_t)(row0 + ai * HALF + m * 16) * DE + ch) = w8;
            }
    }
};
struct EpiDown {
    static constexpr bool PERM = true;
    const float* b_dn; unsigned char* y;
    __device__ __forceinline__ void operator()(const f32x4 (&acc)[2][2][4][2], const Unit& u, int wr, int wc, int fr, int fq) const {
        const int row0 = u.pm * BM + wr * 64 + fr, col0 = u.pn * BM + wc * 32 + 8 * fq;
        const float* bb = b_dn + (size_t)u.e * D + col0;
        f32x4 bv[2][2];
#pragma unroll
        for (int bj = 0; bj < 2; ++bj)
#pragma unroll
            for (int n = 0; n < 2; ++n) bv[bj][n] = *(const f32x4*)(bb + bj * HALF + 4 * n) * F8_SY;
#pragma unroll
        for (int ai = 0; ai < 2; ++ai)
#pragma unroll
            for (int m = 0; m < 4; ++m) { unsigned char* rowp = y + (size_t)(row0 + ai * HALF + m * 16) * D + col0;
#pragma unroll
                for (int bj = 0; bj < 2; ++bj) { const f32x4 v0 = acc[ai][bj][m][0] * (F8_SY / (F8_SACT * F8_SW)) + bv[bj][0], v1 = acc[ai][bj][m][1] * (F8_SY / (F8_SACT * F8_SW)) + bv[bj][1];
                    u32x2 w; w.x = pk4_fp8(v0[0], v0[1], v0[2], v0[3]); w.y = pk4_fp8(v1[0], v1[1], v1[2], v1[3]);
                    *(u32x2*)(rowp + bj * HALF) = w; } }
    }
};
}


#define XB_TMO      128
#define XB_XCNT(j)  (256  + 64 * (j))
#define XB_XSUB(j)  (1280 + 64 * (j))
#define XB_XGEN(j)  (2304 + 64 * (j))
#define XB_TOP      3328
#define XB_TOPGEN   3392
#define XCD_BAR_WORDS 3456
#define XB_SPIN_CAP (1u << 20)
__device__ __forceinline__ unsigned xb_ld(unsigned* p)              { return __hip_atomic_load(p, __ATOMIC_RELAXED, __HIP_MEMORY_SCOPE_AGENT); }
__device__ __forceinline__ unsigned xb_add(unsigned* p, unsigned v) { return __hip_atomic_fetch_add(p, v, __ATOMIC_RELAXED, __HIP_MEMORY_SCOPE_AGENT); }
__device__ __forceinline__ unsigned xb_xcc_id() { return (unsigned)__builtin_amdgcn_s_getreg((3 << 11) | 20) & 0xFu; }
#define XB_SPIN(cond, bar) do { unsigned _sp = 0; while (cond) { __builtin_amdgcn_s_sleep(1); \
    if ((++_sp & 255u) == 0u) { if (xb_ld(&(bar)[XB_TMO])) break; if (_sp > XB_SPIN_CAP) { atomicAdd(&(bar)[XB_TMO], 1u); break; } } } } while (0)
struct XcdBarrier { unsigned* bar; unsigned x; volatile LAS unsigned* st; };
__device__ __forceinline__ XcdBarrier xcd_barrier_post(unsigned* bar, volatile LAS unsigned* st) {
    XcdBarrier b; b.bar = bar; b.x = xb_xcc_id(); b.st = st;
    if (threadIdx.x == 0) (void)xb_add(&bar[XB_XCNT(b.x)], 1u);
    return b;
}
__device__ __forceinline__ void xcd_barrier_complete(unsigned* bar, unsigned x, unsigned& nloc, unsigned& nx) {
    const unsigned G = gridDim.x * gridDim.y * gridDim.z;
    unsigned sum, cnt, mine, sp = 0u;
    for (;;) {
        sum = 0u; cnt = 0u; mine = 0u;
#pragma unroll
        for (unsigned j = 0; j < 16; ++j) { const unsigned c = xb_ld(&bar[XB_XCNT(j)]); sum += c; cnt += (c > 0u) ? 1u : 0u; mine = (j == x) ? c : mine; }
        if (sum == G) break;
        __builtin_amdgcn_s_sleep(1);
        if ((++sp & 255u) == 0u) { if (xb_ld(&bar[XB_TMO])) break; if (sp > XB_SPIN_CAP) { atomicAdd(&bar[XB_TMO], 1u); break; } }
    }
    nloc = mine > 0u ? mine : 1u; nx = cnt > 0u ? cnt : 1u;
}
__device__ __forceinline__ void xcd_barrier(const XcdBarrier& b) {
    asm volatile("s_waitcnt vmcnt(0)" ::: "memory");
    __syncthreads();
    if (threadIdx.x == 0) {
        unsigned* bar = b.bar;
        __builtin_amdgcn_s_waitcnt(0);
        unsigned nloc = b.st[0], nx = b.st[1];
        if (nloc == 0u) { xcd_barrier_complete(bar, b.x, nloc, nx); b.st[0] = nloc; b.st[1] = nx; }
        const unsigned old = xb_add(&bar[XB_XSUB(b.x)], 1u);
        const unsigned gen = old / nloc;
        if (old + 1u == (gen + 1u) * nloc) {
            __builtin_amdgcn_fence(__ATOMIC_RELEASE, "agent");
            asm volatile("s_waitcnt vmcnt(0)" ::: "memory");
            const unsigned og = xb_add(&bar[XB_TOP], 1u);
            const unsigned tg = og / nx;
            if (og + 1u == (tg + 1u) * nx) xb_add(&bar[XB_TOPGEN], 1u);
            else XB_SPIN(xb_ld(&bar[XB_TOPGEN]) == tg, bar);
            __builtin_amdgcn_fence(__ATOMIC_ACQUIRE, "agent");
            xb_add(&bar[XB_XGEN(b.x)], 1u);
            asm volatile("s_waitcnt vmcnt(0)" ::: "memory");
        } else {
            XB_SPIN(xb_ld(&bar[XB_XGEN(b.x)]) == gen, bar);
            __builtin_amdgcn_fence(__ATOMIC_ACQUIRE, "agent");
            asm volatile("s_waitcnt vmcnt(0)" ::: "memory");
        }
    }
    __syncthreads();
}

struct Args { const float* in[26]; float* out; unsigned char* ws; int ph_lo, ph_hi; };

struct Frame { LAS unsigned char* lds; int tid, lane, wave, G, vcu; };

__device__ __forceinline__ void transpose_item(const float* W, int K, int N, bf16* WT, int k0, int n0, int orow0, LAS float* scr, int lane) {
#pragma unroll 8
    for (int i = 0; i < 32; ++i) { const int kk = 2 * i + (lane >> 5); scr[kk * 33 + (lane & 31)] = W[(size_t)(k0 + kk) * N + n0 + (lane & 31)]; }
    asm volatile("s_waitcnt lgkmcnt(0)" ::: "memory");
    const int c = lane & 7;
#pragma unroll
    for (int j = 0; j < 4; ++j) { const int n = (lane >> 3) + 8 * j; const LAS float* s = scr + (8 * c) * 33 + n;
        u32x4 o; o.x = cvt_pk_bf16(s[0 * 33], s[1 * 33]); o.y = cvt_pk_bf16(s[2 * 33], s[3 * 33]); o.z = cvt_pk_bf16(s[4 * 33], s[5 * 33]); o.w = cvt_pk_bf16(s[6 * 33], s[7 * 33]);
        *(u32x4*)(WT + (size_t)(orow0 + n) * K + k0 + 8 * c) = o; }
    asm volatile("s_waitcnt lgkmcnt(0)" ::: "memory");
}

__device__ __forceinline__ void transpose_item8w(const float* W, int K, int N, unsigned char* WT, int k0, int n0, int orow0, LAS float* scr, int lane) {
#pragma unroll 8
    for (int i = 0; i < 64; ++i) { const int kk = 2 * i + (lane >> 5); scr[kk * 33 + (lane & 31)] = W[(size_t)(k0 + kk) * N + n0 + (lane & 31)]; }
    asm volatile("s_waitcnt lgkmcnt(0)" ::: "memory");
    const int c = lane & 7;
#pragma unroll
    for (int j = 0; j < 4; ++j) { const int n = (lane >> 3) + 8 * j; const LAS float* s = scr + (16 * c) * 33 + n;
        u32x4 o; o.x = pk4_fp8(s[0 * 33] * F8_SW, s[1 * 33] * F8_SW, s[2 * 33] * F8_SW, s[3 * 33] * F8_SW); o.y = pk4_fp8(s[4 * 33] * F8_SW, s[5 * 33] * F8_SW, s[6 * 33] * F8_SW, s[7 * 33] * F8_SW);
        o.z = pk4_fp8(s[8 * 33] * F8_SW, s[9 * 33] * F8_SW, s[10 * 33] * F8_SW, s[11 * 33] * F8_SW); o.w = pk4_fp8(s[12 * 33] * F8_SW, s[13 * 33] * F8_SW, s[14 * 33] * F8_SW, s[15 * 33] * F8_SW);
        *(u32x4*)(WT + (size_t)(orow0 + n) * K + k0 + 16 * c) = o; }
    asm volatile("s_waitcnt lgkmcnt(0)" ::: "memory");
}
__device__ __forceinline__ void transpose_item8(const float* W, int K, int N, unsigned char* WT, int k0, int n0, int orow0, LAS float* scr, int lane) {
#pragma unroll 8
    for (int i = 0; i < 32; ++i) { const int kk = 2 * i + (lane >> 5); scr[kk * 33 + (lane & 31)] = W[(size_t)(k0 + kk) * N + n0 + (lane & 31)]; }
    asm volatile("s_waitcnt lgkmcnt(0)" ::: "memory");
    const int c = lane & 7;
#pragma unroll
    for (int j = 0; j < 4; ++j) { const int n = (lane >> 3) + 8 * j; const LAS float* s = scr + (8 * c) * 33 + n;
        u32x2 o; o.x = pk4_fp8(s[0 * 33] * F8_SW, s[1 * 33] * F8_SW, s[2 * 33] * F8_SW, s[3 * 33] * F8_SW); o.y = pk4_fp8(s[4 * 33] * F8_SW, s[5 * 33] * F8_SW, s[6 * 33] * F8_SW, s[7 * 33] * F8_SW);
        *(u32x2*)(WT + (size_t)(orow0 + n) * K + k0 + 8 * c) = o; }
    asm volatile("s_waitcnt lgkmcnt(0)" ::: "memory");
}

constexpr int WC_BLOCKS = 32 * 8 * 8 + 32 * 8 * 4;
#ifndef WC_P0
#define WC_P0 0
#endif
__device__ __forceinline__ void wconv_blocks(const Frame& F, const Args& a, const int lo, const int hi, const int first, const int stride) {
    unsigned char* ws = a.ws;
    {
        constexpr int BI_UP = 32 * 8 * 8, BI_DN = 32 * 8 * 4, WP = 257;
        LAS float* tile = (LAS float*)F.lds;
        const int lane = F.lane, w = F.wave, c = lane & 7;
        for (int bi = lo + first; bi < hi; bi += stride) {
            const bool up = bi < BI_UP; const int r2 = up ? bi : bi - BI_UP;
            const int e = up ? r2 >> 6 : r2 >> 5, q = up ? r2 & 63 : r2 & 31, kb = up ? q >> 3 : q >> 2, nb = up ? q & 7 : q & 3;
            const int N = up ? 2048 : 1024, k0 = kb * 128, n0 = nb * 256;
            const float* W = (up ? a.in[21] + (size_t)e * 1024 * 2048 : a.in[23] + (size_t)e * 1024 * 1024) + (size_t)k0 * N + n0 + 4 * lane;
            unsigned char* WT = (up ? ws + WS_WUPT + (size_t)e * 2048 * 1024 : ws + WS_WDNT + (size_t)e * 1024 * 1024) + k0 + 16 * c;
            __syncthreads();
            f32x4 v[16];
#pragma unroll
            for (int i = 0; i < 16; ++i) v[i] = *(const f32x4*)(W + (size_t)(16 * w + i) * N);
#pragma unroll
            for (int i = 0; i < 16; ++i) { LAS float* t = tile + (16 * w + i) * WP + 4 * lane; t[0] = v[i].x; t[1] = v[i].y; t[2] = v[i].z; t[3] = v[i].w; }
            __syncthreads();
#pragma unroll
            for (int j = 0; j < 4; ++j) { const int nl = 32 * w + (lane >> 3) + 8 * j, n = n0 + nl;
                const int orow = up ? (n < 1024 ? 256 * (n >> 7) + (n & 127) : 256 * ((n - 1024) >> 7) + 128 + ((n - 1024) & 127)) : n;
                const LAS float* sp = tile + (16 * c) * WP + nl;
                u32x4 o; o.x = pk4_fp8(sp[0 * WP] * F8_SW, sp[1 * WP] * F8_SW, sp[2 * WP] * F8_SW, sp[3 * WP] * F8_SW); o.y = pk4_fp8(sp[4 * WP] * F8_SW, sp[5 * WP] * F8_SW, sp[6 * WP] * F8_SW, sp[7 * WP] * F8_SW);
                o.z = pk4_fp8(sp[8 * WP] * F8_SW, sp[9 * WP] * F8_SW, sp[10 * WP] * F8_SW, sp[11 * WP] * F8_SW); o.w = pk4_fp8(sp[12 * WP] * F8_SW, sp[13 * WP] * F8_SW, sp[14 * WP] * F8_SW, sp[15 * WP] * F8_SW);
                *(u32x4*)(WT + (size_t)orow * 1024) = o; }
        }
        __syncthreads(); }
}

__device__ __forceinline__ void p0_prologue(const Frame& F, const Args& a) {
    unsigned char* ws = a.ws;
    LAS float* scr = (LAS float*)(F.lds + F.wave * 8448);
    const int gw = F.vcu * 8 + F.wave, NGW = F.G * 8;
    constexpr int I_IN = 16 * 108, I_L = 16, I_G = 32;
    constexpr int NITEMS = I_IN + 2 * I_L + 2 * I_L + I_G;
    for (int it = gw; it < NITEMS; it += NGW) {
        int r = it;
        if (r < I_IN) { const int kb = r / 108, nb = r % 108; transpose_item(a.in[2], 1024, NPROJ, (bf16*)(ws + WS_WINT), kb * 64, nb * 32, nb * 32, scr, F.lane); continue; }
        r -= I_IN;
        if (r < 2 * I_L) { const int z = r / 16, nb = r % 16; transpose_item(a.in[8] + (size_t)z * 64 * 512, 64, 512, (bf16*)(ws + WS_W2T) + (size_t)z * 512 * 64, 0, nb * 32, nb * 32, scr, F.lane); continue; }
        r -= 2 * I_L;
        if (r < 2 * I_L) { const int z = r / 16, nb = r % 16; transpose_item(a.in[10] + (size_t)z * 64 * 512, 64, 512, (bf16*)(ws + WS_A2T) + (size_t)z * 512 * 64, 0, nb * 32, nb * 32, scr, F.lane); continue; }
        r -= 2 * I_L;
        { const int kb = r / 16, nb = r % 16; transpose_item(a.in[11], 128, 512, (bf16*)(ws + WS_G2T), kb * 64, nb * 32, nb * 32, scr, F.lane); }
    }
    wconv_blocks(F, a, 0, WC_P0, F.vcu, F.G);
    { u32x4* z = (u32x4*)(ws + WS_WINT + (size_t)NPROJ * 1024 * 2); const u32x4 zero = {0u, 0u, 0u, 0u};
      for (int i = F.vcu * 512 + F.tid; i < 16384; i += F.G * 512) z[i] = zero; }
    const float* x = a.in[0]; const float* nw = a.in[1]; bf16* hn = (bf16*)(ws + WS_HN);
    f32x4 wv[4];
#pragma unroll
    for (int j = 0; j < 4; ++j) wv[j] = *((const f32x4*)nw + F.lane + 64 * j);
    for (int m = gw; m < M; m += 2 * NGW) {
        const int m1 = m + NGW; const bool has1 = m1 < M;
        const f32x4* xr0 = (const f32x4*)(x + (size_t)m * D) + F.lane; const f32x4* xr1 = (const f32x4*)(x + (size_t)(has1 ? m1 : m) * D) + F.lane;
        f32x4 v0[4], v1[4]; float s0 = 0.f, s1 = 0.f;
#pragma unroll
        for (int j = 0; j < 4; ++j) { v0[j] = xr0[64 * j]; v1[j] = xr1[64 * j]; }
#pragma unroll
        for (int j = 0; j < 4; ++j) { s0 += (v0[j].x * v0[j].x + v0[j].y * v0[j].y) + (v0[j].z * v0[j].z + v0[j].w * v0[j].w); s1 += (v1[j].x * v1[j].x + v1[j].y * v1[j].y) + (v1[j].z * v1[j].z + v1[j].w * v1[j].w); }
        const float rs0 = rsqrtf(wave_sum(s0) * (1.f / D) + RMS_EPS), rs1 = rsqrtf(wave_sum(s1) * (1.f / D) + RMS_EPS);
        u32x2* o0 = (u32x2*)(hn + (size_t)m * D) + F.lane; u32x2* o1 = (u32x2*)(hn + (size_t)m1 * D) + F.lane;
#pragma unroll
        for (int j = 0; j < 4; ++j) { u32x2 o; o.x = cvt_pk_bf16(v0[j].x * rs0 * wv[j].x, v0[j].y * rs0 * wv[j].y); o.y = cvt_pk_bf16(v0[j].z * rs0 * wv[j].z, v0[j].w * rs0 * wv[j].w); o0[64 * j] = o; }
        if (has1) {
#pragma unroll
            for (int j = 0; j < 4; ++j) { u32x2 o; o.x = cvt_pk_bf16(v1[j].x * rs1 * wv[j].x, v1[j].y * rs1 * wv[j].y); o.y = cvt_pk_bf16(v1[j].z * rs1 * wv[j].z, v1[j].w * rs1 * wv[j].w); o1[64 * j] = o; } }
    }
}

constexpr int PREP_KBUF = 0, PREP_INV = 65536, PREP_AW = 67584, PREP_AA = PREP_AW + 17408, PREP_AG = PREP_AA + 17408, PREP_LD = 136;
template <bool STORE>
__device__ __forceinline__ void prep_phase(const Frame& F, const Args& a) {
    unsigned char* ws = a.ws;
    const bf16* p = (const bf16*)(ws + WS_P);
    bf16* r_out = (bf16*)(ws + WS_R); bf16* v_out = (bf16*)(ws + WS_V); bf16* kk_out = (bf16*)(ws + WS_KK);
    bf16* decay_out = (bf16*)(ws + WS_DECAY); bf16* kdir_out = (bf16*)(ws + WS_KDIR); bf16* akk_out = (bf16*)(ws + WS_AKK); bf16* g_out = (bf16*)(ws + WS_G);
    const bf16* w2T = (const bf16*)(ws + WS_W2T); const bf16* a2T = (const bf16*)(ws + WS_A2T); const bf16* g2T = (const bf16*)(ws + WS_G2T);
    const float* mu_p = a.in[5]; const float* mu_n = a.in[6]; const float* w0 = a.in[7]; const float* a0 = a.in[9];
    const float* k_k = a.in[12]; const float* k_a = a.in[13];
    LAS bf16* kbuf = (LAS bf16*)(F.lds + PREP_KBUF); LAS float* invb = (LAS float*)(F.lds + PREP_INV);
    LAS bf16* Aw = (LAS bf16*)(F.lds + PREP_AW); LAS bf16* Aa = (LAS bf16*)(F.lds + PREP_AA); LAS bf16* Ag = (LAS bf16*)(F.lds + PREP_AG);
    const int lane = F.lane, wave = F.wave, fr = lane & 15, fg = lane >> 4;
    for (int tile = F.vcu; tile < M / 64; tile += F.G) {
        const int m0 = tile * 64;
#pragma unroll 1
        for (int jj = 0; jj < 4; ++jj) {
            const int q = lane + 64 * jj; const bool valid = q < 240; const int c0 = 8 * q;
            float mp[8], mn[8];
#pragma unroll
            for (int i = 0; i < 8; ++i) { mp[i] = valid ? mu_p[c0 + i] : 0.f; mn[i] = valid ? mu_n[c0 + i] : 0.f; }
            const int mfirst = m0 + wave * 8;
            const u32x4 zero = {0u, 0u, 0u, 0u};
            u32x4 rows[10];
#pragma unroll
            for (int rI = 0; rI < 10; ++rI) { const int mr = mfirst - 1 + rI;
                const bool ok = valid && !(rI == 0 && (mfirst % T) == 0) && !(rI == 9 && ((mfirst + 7) % T) == T - 1);
                rows[rI] = ok ? *(const u32x4*)(p + (size_t)mr * PW + c0) : zero; }
#pragma unroll
            for (int i = 0; i < 8; ++i) {
                const int m = mfirst + i, it = wave * 8 + i;
                const u32x4 prev = rows[i], cur = rows[i + 1], nxt = rows[i + 2];
                float fp[8], fc[8], fn[8], s[8];
                unpack8(prev, fp); unpack8(cur, fc); unpack8(nxt, fn);
#pragma unroll
                for (int e = 0; e < 8; ++e) s[e] = fc[e] + mp[e] * (fp[e] - fc[e]) + mn[e] * (fn[e] - fc[e]);
                if (jj == 0) { if (STORE) { *(u32x4*)(r_out + (size_t)m * CW + c0) = pack8(s); } }
                else if (jj == 1) {
                    const int c = c0 - 512;
                    *(LAS u32x4*)(kbuf + it * 512 + c) = pack8(s);
                    float kr[8]; float ss = 0.f;
#pragma unroll
                    for (int e = 0; e < 8; ++e) { kr[e] = s[e] * k_k[c + e]; ss += kr[e] * kr[e]; }
                    ss += __shfl_xor(ss, 1); ss += __shfl_xor(ss, 2); ss += __shfl_xor(ss, 4);
                    const float inv = fminf(__builtin_amdgcn_rsqf(ss), 1e12f);
#pragma unroll
                    for (int e = 0; e < 8; ++e) kr[e] *= inv;
                    if (STORE) { *(u32x4*)(kk_out + (size_t)m * CW + c) = pack8(kr); }
                    if ((lane & 7) == 0) invb[it * 8 + (lane >> 3)] = inv;
                }
                else if (jj == 2) { if (STORE) { *(u32x4*)(v_out + (size_t)m * CW + (c0 - 1024)) = pack8(s); } }
                else if (valid) {
                    const int seg = lane >> 4, cw = 8 * (lane & 15);
                    if (seg == 0) {
#pragma unroll
                        for (int e = 0; e < 8; ++e) s[e] = 1.0f - 2.0f * __builtin_amdgcn_rcpf(__expf(2.0f * s[e]) + 1.0f);
                        *(LAS u32x4*)(Aw + it * PREP_LD + cw) = pack8(s);
                    } else if (seg == 1) { *(LAS u32x4*)(Aa + it * PREP_LD + cw) = pack8(s); }
                    else {
#pragma unroll
                        for (int e = 0; e < 8; ++e) s[e] = sigmoidf_(s[e]);
                        *(LAS u32x4*)(Ag + it * PREP_LD + cw) = pack8(s);
                    }
                }
            }
        }
        __syncthreads();
        const int nb = 64 * wave;
#define PREP_PROW(nt_) (nb + 32 * ((nt_) >> 1) + 8 * (fr >> 2) + 4 * ((nt_) & 1) + (fr & 3))
#define PREP_COL(nt_)  (nb + 32 * ((nt_) >> 1) + 8 * fg + 4 * ((nt_) & 1))
#pragma unroll 1
        for (int job = 0; job < 4; ++job) {
            const int z = job & 1;
            const bf16* WT = job < 2 ? w2T + (size_t)z * 512 * 64 : a2T + (size_t)z * 512 * 64;
            const LAS bf16* Ax = job < 2 ? Aw + z * 64 : Aa + z * 64;
            bf16x8 wf[2][4];
#pragma unroll
            for (int ks = 0; ks < 2; ++ks)
#pragma unroll
                for (int nt = 0; nt < 4; ++nt) wf[ks][nt] = *(const bf16x8*)(WT + (size_t)PREP_PROW(nt) * 64 + 32 * ks + 8 * fg);
            f32x4 pb[4], pkk[4], pka[4];
#pragma unroll
            for (int nt = 0; nt < 4; ++nt) { const int n = PREP_COL(nt);
                pb[nt] = *(const f32x4*)((job < 2 ? w0 : a0) + z * 512 + n); pkk[nt] = *(const f32x4*)(k_k + n); pka[nt] = *(const f32x4*)(k_a + n); }
            f32x4 acc[4][4];
#pragma unroll
            for (int mt = 0; mt < 4; ++mt)
#pragma unroll
                for (int nt = 0; nt < 4; ++nt) acc[mt][nt] = (f32x4){0.f, 0.f, 0.f, 0.f};
#pragma unroll
            for (int ks = 0; ks < 2; ++ks) {
                bf16x8 af[4];
#pragma unroll
                for (int mt = 0; mt < 4; ++mt) af[mt] = *(const LAS bf16x8*)(Ax + (16 * mt + fr) * PREP_LD + 32 * ks + 8 * fg);
#pragma unroll
                for (int mt = 0; mt < 4; ++mt)
#pragma unroll
                    for (int nt = 0; nt < 4; ++nt) acc[mt][nt] = __builtin_amdgcn_mfma_f32_16x16x32_bf16(wf[ks][nt], af[mt], acc[mt][nt], 0, 0, 0);
            }
#pragma unroll
            for (int mt = 0; mt < 4; ++mt) {
                const int it = 16 * mt + fr; const size_t m = (size_t)(m0 + it);
#pragma unroll
                for (int np = 0; np < 2; ++np) {
                    const int c8 = nb + 32 * np + 8 * fg;
                    if (job < 2) {
                        float o[8];
#pragma unroll
                        for (int hh = 0; hh < 2; ++hh) { const f32x4 v = acc[mt][2 * np + hh], bq = pb[2 * np + hh];
#pragma unroll
                            for (int i = 0; i < 4; ++i) o[4 * hh + i] = __expf(-0.60653066f * sigmoidf_(v[i] + bq[i])); }
                        if (STORE) { *(u32x4*)(decay_out + ((size_t)z * M + m) * CW + c8) = pack8(o); }
                    } else {
                        const u32x4 kb = *(const LAS u32x4*)(kbuf + it * 512 + c8);
                        float kv[8]; unpack8(kb, kv);
                        const float inv = invb[it * 8 + wave];
                        float kd[8], ak[8];
#pragma unroll
                        for (int hh = 0; hh < 2; ++hh) { const f32x4 v = acc[mt][2 * np + hh], bq = pb[2 * np + hh], kkc = pkk[2 * np + hh], kac = pka[2 * np + hh];
#pragma unroll
                            for (int i = 0; i < 4; ++i) { const float av = sigmoidf_(v[i] + bq[i]), kx = kv[4 * hh + i]; kd[4 * hh + i] = kx * (1.0f + (av - 1.0f) * kac[i]); ak[4 * hh + i] = av * (kx * kkc[i] * inv); } }
                        if (STORE) { *(u32x4*)(kdir_out + ((size_t)z * M + m) * CW + c8) = pack8(kd); *(u32x4*)(akk_out + ((size_t)z * M + m) * CW + c8) = pack8(ak); }
                    }
                }
            }
        }
        {
            bf16x8 wf[4][4];
#pragma unroll
            for (int ks = 0; ks < 4; ++ks)
#pragma unroll
                for (int nt = 0; nt < 4; ++nt) wf[ks][nt] = *(const bf16x8*)(g2T + (size_t)PREP_PROW(nt) * 128 + 32 * ks + 8 * fg);
            f32x4 acc[4][4];
#pragma unroll
            for (int mt = 0; mt < 4; ++mt)
#pragma unroll
                for (int nt = 0; nt < 4; ++nt) acc[mt][nt] = (f32x4){0.f, 0.f, 0.f, 0.f};
#pragma unroll
            for (int ks = 0; ks < 4; ++ks) {
                bf16x8 af[4];
#pragma unroll
                for (int mt = 0; mt < 4; ++mt) af[mt] = *(const LAS bf16x8*)(Ag + (16 * mt + fr) * PREP_LD + 32 * ks + 8 * fg);
#pragma unroll
                for (int mt = 0; mt < 4; ++mt)
#pragma unroll
                    for (int nt = 0; nt < 4; ++nt) acc[mt][nt] = __builtin_amdgcn_mfma_f32_16x16x32_bf16(wf[ks][nt], af[mt], acc[mt][nt], 0, 0, 0);
            }
#pragma unroll
            for (int mt = 0; mt < 4; ++mt) { const size_t m = (size_t)(m0 + 16 * mt + fr);
#pragma unroll
                for (int np = 0; np < 2; ++np) { const f32x4 v0 = acc[mt][2 * np], v1 = acc[mt][2 * np + 1];
                    u32x4 w; w.x = cvt_pk_bf16(v0[0], v0[1]); w.y = cvt_pk_bf16(v0[2], v0[3]); w.z = cvt_pk_bf16(v1[0], v1[1]); w.w = cvt_pk_bf16(v1[2], v1[3]);
                    if (STORE) { *(u32x4*)(g_out + m * CW + nb + 32 * np + 8 * fg) = w; } } }
        }
#undef PREP_PROW
#undef PREP_COL
        __syncthreads();
    }
}

constexpr int AT_K = 0, AT_V = 73728, AT_B = 147456;
__device__ __forceinline__ void attn_phase(const Frame& F, const Args& a, const int widx, const int nworkers) {
    unsigned char* ws = a.ws;
    const bf16* q = (const bf16*)(ws + WS_Q); const bf16* k = (const bf16*)(ws + WS_K); const bf16* vT = (const bf16*)(ws + WS_VT);
    bf16* att = (bf16*)(ws + WS_ATT);
    LAS unsigned char* L = F.lds;
    LAS float* bias = (LAS float*)(L + AT_B) + 16;
    const int tid = F.tid, lane = F.lane, fr = lane & 15, fg = lane >> 4, wave = F.wave;
    const int per = (16384 + nworkers * 8 - 1) / (nworkers * 8);
    const int base = widx * (8 * per);
    const int ltok = tid >> 3, lc = tid & 7;
    const int wK = AT_K + ltok * 128 + ((lc ^ ((((ltok >> 3) & 3) << 1) | ((ltok >> 1) & 1))) << 4), wV = AT_V + ltok * 128 + ((lc ^ ((ltok >> 1) & 7)) << 4);
    u32x4 kreg[9], vreg[9]; bf16x8 qn[2]; float breg = 0.f;
#define AT_ISSUE(it_) do { const int t0_ = base + (it_) * 8; if ((it_) < per && t0_ < 16384) { \
        const int r0_ = (t0_ >> 2) & 127, h_ = (t0_ >> 9) & 7, b_ = t0_ >> 12, R0_ = min(max(r0_ - 4, 0), GROWS - 8); \
        const bf16* kp_ = k + ((size_t)b_ * T + R0_ * 64 + ltok) * CW + h_ * 64 + lc * 8; \
        const bf16* vp_ = vT + ((size_t)((b_ * NH + h_) * GROWS + R0_)) * (HD * 64) + tid * 8; \
        _Pragma("unroll") for (int j = 0; j < 9; ++j) { const int jj = min(j, GROWS - 1 - R0_); kreg[j] = *(const u32x4*)(kp_ + (size_t)jj * 64 * CW); vreg[j] = *(const u32x4*)(vp_ + (size_t)jj * (HD * 64)); } \
        if (tid < 465) breg = a.in[3][h_ * 465 + tid]; \
        const size_t tq_ = (size_t)b_ * T + (r0_ + (wave >> 2)) * 64 + 16 * (wave & 3) + fr; \
        _Pragma("unroll") for (int ks = 0; ks < 2; ++ks) qn[ks] = *(const bf16x8*)(q + tq_ * CW + h_ * 64 + 32 * ks + 8 * fg); } } while (0)
    AT_ISSUE(0);
    for (int it = 0; it < per; ++it) {
        const int task0 = base + it * 8; if (task0 >= 16384) break;
        const int cgp = wave & 3, r0 = (task0 >> 2) & 127, r = r0 + (wave >> 2), h = (task0 >> 9) & 7, b = task0 >> 12, R0 = min(max(r0 - 4, 0), GROWS - 8);
        const int c0 = 16 * cgp, wsc = min(max(c0 - 8, 0), 32), rs = min(max(r - 4, 0), GROWS - 8);
        const int c = c0 + fr, cs = min(max(c - 8, 0), 48);
        const size_t tq = (size_t)b * T + r * 64 + c;
        __syncthreads();
#pragma unroll
        for (int j = 0; j < 9; ++j) { *(LAS u32x4*)(L + wK + j * 8192) = kreg[j]; *(LAS u32x4*)(L + wV + j * 8192) = vreg[j]; }
        if (tid < 465) bias[tid] = breg;
        const bf16x8 qf0 = qn[0], qf1 = qn[1];
        __syncthreads();
        f32x4 sc[16];
        const int kcol_a = wsc + 8 * (fr >> 2) + (fr & 3);
        const int jr0 = rs - R0;
        int offK[2];
#pragma unroll
        for (int par = 0; par < 2; ++par) { const int tok = kcol_a + 4 * par; offK[par] = AT_K + jr0 * 8192 + tok * 128 + ((fg ^ ((((tok >> 3) & 3) << 1) | ((tok >> 1) & 1))) << 4); }
#pragma unroll
        for (int t = 0; t < 16; ++t) { const int u = t >> 1, par = t & 1;
            const bf16x8 kf0 = *(const LAS bf16x8*)(L + offK[par] + u * 8192), kf1 = *(const LAS bf16x8*)(L + (offK[par] ^ 64) + u * 8192);
            f32x4 s = {0.f, 0.f, 0.f, 0.f};
            s = __builtin_amdgcn_mfma_f32_16x16x32_bf16(kf0, qf0, s, 0, 0, 0);
            s = __builtin_amdgcn_mfma_f32_16x16x32_bf16(kf1, qf1, s, 0, 0, 0);
            sc[t] = s; }
        AT_ISSUE(it + 1);
        bool okm[8];
#pragma unroll
        for (int pi = 0; pi < 8; ++pi) { const int kc = wsc + 8 * fg + pi; okm[pi] = (kc >= cs) && (kc < cs + 16); }
        const LAS float* brow = bias + (rs - r + 7) * 31 + (wsc + 8 * fg - c + 15);
        float mx = -1e30f;
#pragma unroll
        for (int u = 0; u < 8; ++u)
#pragma unroll
            for (int pi = 0; pi < 8; ++pi) { const float s = okm[pi] ? sc[2 * u + (pi >> 2)][pi & 3] + brow[31 * u + pi] : -1e30f; sc[2 * u + (pi >> 2)][pi & 3] = s; mx = fmaxf(mx, s); }
        mx = fmaxf(mx, __shfl_xor(mx, 16)); mx = fmaxf(mx, __shfl_xor(mx, 32));
        float sum = 0.f;
        const float mxl = -mx * 1.44269504f;
#pragma unroll
        for (int t = 0; t < 16; ++t)
#pragma unroll
            for (int i = 0; i < 4; ++i) { const float pv = __builtin_amdgcn_exp2f(__builtin_fmaf(sc[t][i], 1.44269504f, mxl)); sc[t][i] = pv; sum += pv; }
        sum += __shfl_xor(sum, 16); sum += __shfl_xor(sum, 32);
        const float inv = 1.0f / sum;
        f32x4 o[4];
#pragma unroll
        for (int nt = 0; nt < 4; ++nt) o[nt] = (f32x4){0.f, 0.f, 0.f, 0.f};
        const int offV = AT_V + jr0 * 8192 + fr * 128 + ((((wsc >> 3) + fg) ^ ((fr >> 1) & 7)) << 4);
#pragma unroll
        for (int u = 0; u < 8; ++u) {
            union { u32x4 w; bf16x8 h8; } pf;
            pf.w.x = cvt_pk_bf16(sc[2 * u][0], sc[2 * u][1]); pf.w.y = cvt_pk_bf16(sc[2 * u][2], sc[2 * u][3]);
            pf.w.z = cvt_pk_bf16(sc[2 * u + 1][0], sc[2 * u + 1][1]); pf.w.w = cvt_pk_bf16(sc[2 * u + 1][2], sc[2 * u + 1][3]);
#pragma unroll
            for (int nt = 0; nt < 4; ++nt) { const bf16x8 vf = *(const LAS bf16x8*)(L + offV + u * 8192 + nt * 2048); o[nt] = __builtin_amdgcn_mfma_f32_16x16x32_bf16(vf, pf.h8, o[nt], 0, 0, 0); } }
#pragma unroll
        for (int nt = 0; nt < 4; ++nt) { u32x2 w; w.x = cvt_pk_bf16(o[nt][0] * inv, o[nt][1] * inv); w.y = cvt_pk_bf16(o[nt][2] * inv, o[nt][3] * inv);
            *(u32x2*)(att + tq * CW + h * 64 + 16 * nt + 4 * fg) = w; }
    }
#undef AT_ISSUE
    __syncthreads();
}

__device__ __forceinline__ void side_phase(const Frame& F, const Args& a, const int widx, const int nworkers) {
    {
        LAS float* scr = (LAS float*)(F.lds + F.wave * 8448);
        for (int it = widx * 8 + F.wave; it < 16 * 32; it += nworkers * 8) { const int kb = it / 32, nb = it % 32; transpose_item(a.in[17], 1024, 1024, (bf16*)(a.ws + WS_WOT), kb * 64, nb * 32, nb * 32, scr, F.lane); } }
    {
        const float* rw = a.in[19]; bf16* ih = (bf16*)(a.ws + WS_RTIMG); bf16* il = ih + 32 * RT_PITCH;
        for (int idx = widx * 512 + F.tid; idx < 32768; idx += nworkers * 512) { const int e = idx & 31, d = idx >> 5; const float w = rw[idx];
            const unsigned hb = cvt_pk_bf16(w, 0.f) & 0xffffu; const float lo = w - __uint_as_float(hb << 16);
            ih[e * RT_PITCH + d] = (bf16)hb; il[e * RT_PITCH + d] = (bf16)cvt_pk_bf16(lo, 0.f); } }
    attn_phase(F, a, widx, nworkers);
    wconv_blocks(F, a, WC_P0, WC_BLOCKS, widx, nworkers);
}

__device__ __forceinline__ float row16_sum(float v) {
    v += __builtin_bit_cast(float, __builtin_amdgcn_update_dpp(0, __builtin_bit_cast(int, v), 0xB1, 0xF, 0xF, true));
    v += __builtin_bit_cast(float, __builtin_amdgcn_update_dpp(0, __builtin_bit_cast(int, v), 0x4E, 0xF, 0xF, true));
    v += __builtin_bit_cast(float, __builtin_amdgcn_update_dpp(0, __builtin_bit_cast(int, v), 0x141, 0xF, 0xF, true));
    v += __builtin_bit_cast(float, __builtin_amdgcn_update_dpp(0, __builtin_bit_cast(int, v), 0x140, 0xF, 0xF, true));
    return v;
}
constexpr int CS_R = 8;
constexpr int CS_NCH = 2, CS_NPR = 6;
constexpr int CS_AT = 0, CS_RT = 2304, CS_KHT = 4608, CS_BHT = 6656, CS_VT = 8704  , CS_TT = 10752, CS_AAK = 11264, CS_ARK = 11776, CS_ARB = 12288, CS_PL = 12800, CS_SLOT = 13056;
constexpr int CS_LD = 72;
constexpr int CS_SCR = CS_R * CS_SLOT  , CS_SCRW = 2304 * 2  , CS_FLAG = CS_SCR + CS_NPR * CS_SCRW  ;
__device__ __forceinline__ bf16 f2bf(float f) { return (bf16)cvt_pk_bf16(f, 0.f); }
struct ChainOps { u32x2 a4[4], r4[4], kh[4], bh[4], aak, ark, arb, tt, vb; f32x4 pl[4]; };
__device__ __forceinline__ void chain_load(const LAS unsigned char* sl, int fr, int fg, int c, ChainOps& o) {
    const int o16 = fr * 32 + fg * 8;
    const LAS unsigned char* pa = sl + CS_AT + fr * (CS_LD * 2) + fg * 8; const LAS unsigned char* pr = sl + CS_RT + fr * (CS_LD * 2) + fg * 8;
#pragma unroll
    for (int kq = 0; kq < 4; ++kq) { o.a4[kq] = *(const LAS u32x2*)(pa + 32 * kq); o.r4[kq] = *(const LAS u32x2*)(pr + 32 * kq); }
    o.aak = *(const LAS u32x2*)(sl + CS_AAK + o16); o.ark = *(const LAS u32x2*)(sl + CS_ARK + o16); o.arb = *(const LAS u32x2*)(sl + CS_ARB + o16); o.tt = *(const LAS u32x2*)(sl + CS_TT + o16);
    o.vb = *(const LAS u32x2*)(sl + CS_VT + c * 512 + o16);
#pragma unroll
    for (int mt = 0; mt < 4; ++mt) { o.pl[mt] = *(const LAS f32x4*)(sl + CS_PL + (16 * mt + 4 * fg) * 4);
        o.kh[mt] = *(const LAS u32x2*)(sl + CS_KHT + 512 * mt + o16); o.bh[mt] = *(const LAS u32x2*)(sl + CS_BHT + 512 * mt + o16); }
}
__device__ __forceinline__ f32x4 chain_compute(const ChainOps& o, f32x4 (&zacc)[4]) {
#define CS_M32(A_, B_, C_) __builtin_amdgcn_mfma_f32_16x16x32_bf16(A_, B_, C_, 0, 0, 0)
#define CS_M16(A_, B_, C_) __builtin_amdgcn_mfma_f32_16x16x16bf16_1k(__builtin_bit_cast(s16x4, A_), __builtin_bit_cast(s16x4, B_), C_, 0, 0, 0)
    union { u32x4 w; bf16x8 h8; } zb0, zb1, ap0, ap1, rp0, rp1;
    zb0.w.x = cvt_pk_bf16(zacc[0][0], zacc[0][1]); zb0.w.y = cvt_pk_bf16(zacc[0][2], zacc[0][3]); zb0.w.z = cvt_pk_bf16(zacc[1][0], zacc[1][1]); zb0.w.w = cvt_pk_bf16(zacc[1][2], zacc[1][3]);
    zb1.w.x = cvt_pk_bf16(zacc[2][0], zacc[2][1]); zb1.w.y = cvt_pk_bf16(zacc[2][2], zacc[2][3]); zb1.w.z = cvt_pk_bf16(zacc[3][0], zacc[3][1]); zb1.w.w = cvt_pk_bf16(zacc[3][2], zacc[3][3]);
    ap0.w = (u32x4){o.a4[0].x, o.a4[0].y, o.a4[1].x, o.a4[1].y}; ap1.w = (u32x4){o.a4[2].x, o.a4[2].y, o.a4[3].x, o.a4[3].y};
    rp0.w = (u32x4){o.r4[0].x, o.r4[0].y, o.r4[1].x, o.r4[1].y}; rp1.w = (u32x4){o.r4[2].x, o.r4[2].y, o.r4[3].x, o.r4[3].y};
    const f32x4 zero4 = {0.f, 0.f, 0.f, 0.f};
    f32x4 Wc = CS_M16(o.aak, o.vb, zero4);
    Wc = CS_M32(ap0.h8, zb0.h8, Wc); Wc = CS_M32(ap1.h8, zb1.h8, Wc);
    f32x4 Yc = CS_M16(o.ark, o.vb, zero4);
    Yc = CS_M32(rp0.h8, zb0.h8, Yc); Yc = CS_M32(rp1.h8, zb1.h8, Yc);
    f32x4 zz[4];
#pragma unroll
    for (int mt = 0; mt < 4; ++mt) zz[mt] = CS_M16(o.kh[mt], o.vb, zacc[mt] * o.pl[mt]);
    u32x2 wb, ub;
    wb.x = cvt_pk_bf16(Wc[0], Wc[1]); wb.y = cvt_pk_bf16(Wc[2], Wc[3]);
    const f32x4 Uc = CS_M16(o.tt, wb, zero4);
    ub.x = cvt_pk_bf16(Uc[0], Uc[1]); ub.y = cvt_pk_bf16(Uc[2], Uc[3]);
    Yc = CS_M16(o.arb, ub, Yc);
#pragma unroll
    for (int mt = 0; mt < 4; ++mt) zacc[mt] = CS_M16(o.bh[mt], ub, zz[mt]);
#undef CS_M32
#undef CS_M16
    return Yc;
}
template <int z>
__device__ __forceinline__ void scan_phase_z(const Frame& F, const Args& a, const int seq, const int half) {
    unsigned char* ws = a.ws;
    const int b = (seq >> 3) & 3, h = seq & 7;
    const size_t mb = (size_t)b * T;
    const int lane = F.lane, wave = F.wave, fr = lane & 15, fg = lane >> 4;
    constexpr int NCK = T / 16;
    volatile LAS unsigned* flg = (volatile LAS unsigned*)(F.lds + CS_FLAG);
    if (F.tid < 16) flg[F.tid] = 0u;
    __syncthreads();
    const int o16 = fr * 32 + fg * 8;
#define CS_M32(A_, B_, C_) __builtin_amdgcn_mfma_f32_16x16x32_bf16(A_, B_, C_, 0, 0, 0)
#define CS_M16(A_, B_, C_) __builtin_amdgcn_mfma_f32_16x16x16bf16_1k(__builtin_bit_cast(s16x4, A_), __builtin_bit_cast(s16x4, B_), C_, 0, 0, 0)
    if (wave < CS_NCH) {
        const int c = wave, rg = 2 * half + c;
        __builtin_amdgcn_s_setprio(3);
        bf16* yout = (bf16*)(ws + WS_Y) + (size_t)z * M * CW + h * 64 + rg * 16 + fr;
        f32x4 zacc[4];
#pragma unroll
        for (int mt = 0; mt < 4; ++mt) zacc[mt] = (f32x4){0.f, 0.f, 0.f, 0.f};
        ChainOps opA, opB;
#define CS_READY(nn) do { unsigned sp_ = 0; while (flg[(nn) & (CS_R - 1)] != (unsigned)((nn) + 1)) { __builtin_amdgcn_s_sleep(1); if (++sp_ > (1u << 24)) break; } __builtin_amdgcn_fence(__ATOMIC_ACQUIRE, "workgroup"); } while (0)
#define CS_HANDBACK(nn) do { asm volatile("s_waitcnt lgkmcnt(0)" ::: "memory"); if (lane == 0) flg[8 + c] = (unsigned)((nn) + 1); asm volatile("" ::: "memory"); } while (0)
#define CS_YSTORE(nn, Y_) do { asm volatile("s_waitcnt vmcnt(24)" ::: "memory");   _Pragma("unroll") for (int rr = 0; rr < 4; ++rr) { const int q_ = 16 * (nn) + 4 * fg + rr, t_ = z ? (T - 1 - q_) : q_; yout[(mb + t_) * CW] = f2bf((Y_)[rr]); } } while (0)
        CS_READY(0); chain_load(F.lds, fr, fg, c, opA);
#pragma unroll 1
        for (int n = 0; n < NCK; n += 2) {
            CS_READY(n + 1); CS_HANDBACK(n);
            chain_load(F.lds + ((n + 1) & (CS_R - 1)) * CS_SLOT, fr, fg, c, opB);
            { const f32x4 Yc = chain_compute(opA, zacc); CS_YSTORE(n, Yc); }
            if (n + 2 < NCK) CS_READY(n + 2);
            CS_HANDBACK(n + 1);
            if (n + 2 < NCK) chain_load(F.lds + ((n + 2) & (CS_R - 1)) * CS_SLOT, fr, fg, c, opA);
            { const f32x4 Yc = chain_compute(opB, zacc); CS_YSTORE(n + 1, Yc); }
        }
#undef CS_READY
#undef CS_HANDBACK
#undef CS_YSTORE
        __builtin_amdgcn_s_setprio(0);
    } else {
        const int pi = wave - CS_NCH;
        LAS unsigned char* scr = F.lds + CS_SCR + pi * CS_SCRW;
        LAS bf16* KT = (LAS bf16*)scr; LAS bf16* BT = (LAS bf16*)(scr + 2304);
        const bf16* gw_ = (const bf16*)(ws + WS_DECAY) + (size_t)z * M * CW + h * 64;
        const bf16* gkk = (const bf16*)(ws + WS_KK) + h * 64;
        const bf16* gak = (const bf16*)(ws + WS_AKK) + (size_t)z * M * CW + h * 64;
        const bf16* gk = (const bf16*)(ws + WS_KDIR) + (size_t)z * M * CW + h * 64;
        const bf16* gr = (const bf16*)(ws + WS_R) + h * 64;
        const bf16* gv = (const bf16*)(ws + WS_V) + h * 64 + half * 32 + (lane & 31);
        const int hf = lane >> 5, cp = lane & 31;
        unsigned xw[8], xkk[8], xak[8], xk[8], xr[8], nv[8];
        constexpr long RSTEP = z ? -(long)CW : (long)CW;
#define CS_FETCH(nn) do { if ((nn) < NCK) { const size_t m0_ = (mb + (z ? (T - 1 - 16 * (nn) - 8 * hf) : 16 * (nn) + 8 * hf)) * CW; \
            const unsigned* pw_ = (const unsigned*)(gw_ + m0_ + 2 * cp); const unsigned* pkk_ = (const unsigned*)(gkk + m0_ + 2 * cp); const unsigned* pak_ = (const unsigned*)(gak + m0_ + 2 * cp); \
            const unsigned* pk_ = (const unsigned*)(gk + m0_ + 2 * cp); const unsigned* pr_ = (const unsigned*)(gr + m0_ + 2 * cp); const bf16* pv_ = gv + m0_; \
            _Pragma("unroll") for (int i_ = 0; i_ < 8; ++i_) { xw[i_] = pw_[i_ * (RSTEP / 2)]; xkk[i_] = pkk_[i_ * (RSTEP / 2)]; xak[i_] = pak_[i_ * (RSTEP / 2)]; xk[i_] = pk_[i_ * (RSTEP / 2)]; xr[i_] = pr_[i_ * (RSTEP / 2)]; \
                nv[i_] = pv_[i_ * RSTEP]; } } } while (0)
        CS_FETCH(pi);
#pragma unroll 1
        for (int n = pi; n < NCK; n += CS_NPR) {
            const int slot = n & (CS_R - 1);
            f32x2 w2[8], kk2[8], ak2[8], k2[8], r2[8]; unsigned vq[8];
#pragma unroll
            for (int i = 0; i < 8; ++i) { unsigned x0 = xw[i], x1 = xkk[i], x2 = xak[i], x3 = xk[i], x4 = xr[i], x5 = nv[i];
                asm volatile("" : "+v"(x0), "+v"(x1), "+v"(x2), "+v"(x3), "+v"(x4), "+v"(x5));
                w2[i] = (f32x2){__uint_as_float(x0 << 16), __uint_as_float(x0 & 0xffff0000u)}; kk2[i] = (f32x2){__uint_as_float(x1 << 16), __uint_as_float(x1 & 0xffff0000u)};
                ak2[i] = (f32x2){__uint_as_float(x2 << 16), __uint_as_float(x2 & 0xffff0000u)}; k2[i] = (f32x2){__uint_as_float(x3 << 16), __uint_as_float(x3 & 0xffff0000u)};
                r2[i] = (f32x2){__uint_as_float(x4 << 16), __uint_as_float(x4 & 0xffff0000u)}; vq[i] = x5; }
            CS_FETCH(n + CS_NPR);
            { unsigned sp = 0; for (;;) { const u32x2 pg = *(const volatile LAS u32x2*)(flg + 8); const int mn = (int)min(pg.x, pg.y);
                  if (mn >= n - (CS_R - 3)) break; __builtin_amdgcn_s_sleep(2); if (++sp > (1u << 24)) break; } }
            __builtin_amdgcn_fence(__ATOMIC_ACQUIRE, "workgroup");
            LAS unsigned char* sl = F.lds + slot * CS_SLOT;
            f32x2 Pl[8];
            Pl[0] = w2[0];
#pragma unroll
            for (int i = 1; i < 8; ++i) Pl[i] = Pl[i - 1] * w2[i];
            const f32x2 tot = Pl[7];
            const f32x2 oth = {__shfl_xor(tot.x, 32), __shfl_xor(tot.y, 32)};
            const f32x2 carry = hf ? oth : (f32x2){1.0f, 1.0f};
            const f32x2 PL2 = tot * oth;
            f32x2 kh[8], bh[8], Pprev = carry;
            { LAS unsigned char* pat = sl + CS_AT + (8 * hf * CS_LD + 2 * cp) * 2; LAS unsigned char* prt = sl + CS_RT + (8 * hf * CS_LD + 2 * cp) * 2;
              LAS unsigned char* pkt = scr + (8 * hf * CS_LD + 2 * cp) * 2; LAS unsigned char* pbt = scr + 2304 + (8 * hf * CS_LD + 2 * cp) * 2;
#pragma unroll
              for (int i = 0; i < 8; ++i) {
                  const f32x2 P = Pl[i] * carry;
                  const f32x2 inv = {__builtin_amdgcn_rcpf(P.x), __builtin_amdgcn_rcpf(P.y)};
                  const f32x2 at = kk2[i] * Pprev, rt = r2[i] * P, kt = k2[i] * inv, bt = -(ak2[i] * inv);
                  kh[i] = kt * PL2; bh[i] = bt * PL2;
                  *(LAS unsigned*)(pat + i * (CS_LD * 2)) = cvt_pk_bf16(at.x, at.y); *(LAS unsigned*)(prt + i * (CS_LD * 2)) = cvt_pk_bf16(rt.x, rt.y);
                  *(LAS unsigned*)(pkt + i * (CS_LD * 2)) = cvt_pk_bf16(kt.x, kt.y); *(LAS unsigned*)(pbt + i * (CS_LD * 2)) = cvt_pk_bf16(bt.x, bt.y);
                  Pprev = P; } }
            { u32x4 o0, o1;
              o0.x = cvt_pk_bf16(kh[0].x, kh[1].x); o0.y = cvt_pk_bf16(kh[2].x, kh[3].x); o0.z = cvt_pk_bf16(kh[4].x, kh[5].x); o0.w = cvt_pk_bf16(kh[6].x, kh[7].x);
              o1.x = cvt_pk_bf16(kh[0].y, kh[1].y); o1.y = cvt_pk_bf16(kh[2].y, kh[3].y); o1.z = cvt_pk_bf16(kh[4].y, kh[5].y); o1.w = cvt_pk_bf16(kh[6].y, kh[7].y);
              *(LAS u32x4*)(sl + CS_KHT + cp * 64 + hf * 16) = o0; *(LAS u32x4*)(sl + CS_KHT + cp * 64 + 32 + hf * 16) = o1;
              o0.x = cvt_pk_bf16(bh[0].x, bh[1].x); o0.y = cvt_pk_bf16(bh[2].x, bh[3].x); o0.z = cvt_pk_bf16(bh[4].x, bh[5].x); o0.w = cvt_pk_bf16(bh[6].x, bh[7].x);
              o1.x = cvt_pk_bf16(bh[0].y, bh[1].y); o1.y = cvt_pk_bf16(bh[2].y, bh[3].y); o1.z = cvt_pk_bf16(bh[4].y, bh[5].y); o1.w = cvt_pk_bf16(bh[6].y, bh[7].y);
              *(LAS u32x4*)(sl + CS_BHT + cp * 64 + hf * 16) = o0; *(LAS u32x4*)(sl + CS_BHT + cp * 64 + 32 + hf * 16) = o1; }
            if (hf == 0) *(LAS f32x2*)(sl + CS_PL + cp * 8) = PL2;
            { u32x4 o0;
              o0.x = vq[0] | (vq[1] << 16); o0.y = vq[2] | (vq[3] << 16); o0.z = vq[4] | (vq[5] << 16); o0.w = vq[6] | (vq[7] << 16);
              *(LAS u32x4*)(sl + CS_VT + (lane & 31) * 32 + (lane >> 5) * 16) = o0; }
            asm volatile("s_waitcnt lgkmcnt(0)" ::: "memory");
            bf16x8 af[2], rf[2], kf[2], bf_[2];
#pragma unroll
            for (int ks = 0; ks < 2; ++ks) { af[ks] = *(const LAS bf16x8*)(sl + CS_AT + (fr * CS_LD + 32 * ks + 8 * fg) * 2); rf[ks] = *(const LAS bf16x8*)(sl + CS_RT + (fr * CS_LD + 32 * ks + 8 * fg) * 2);
                kf[ks] = *(const LAS bf16x8*)(KT + fr * CS_LD + 32 * ks + 8 * fg); bf_[ks] = *(const LAS bf16x8*)(BT + fr * CS_LD + 32 * ks + 8 * fg); }
            const f32x4 zero4 = {0.f, 0.f, 0.f, 0.f};
            f32x4 Xc = zero4, Xt = zero4, AakT = zero4, ArbT = zero4, ArkT = zero4;
#pragma unroll
            for (int ks = 0; ks < 2; ++ks) { Xc = CS_M32(af[ks], bf_[ks], Xc); Xt = CS_M32(bf_[ks], af[ks], Xt);
                AakT = CS_M32(kf[ks], af[ks], AakT); ArbT = CS_M32(bf_[ks], rf[ks], ArbT); ArkT = CS_M32(kf[ks], rf[ks], ArkT); }
            f32x4 S1;
#pragma unroll
            for (int rr = 0; rr < 4; ++rr) { const int q = 4 * fg + rr;
                Xc[rr] = (fr < q) ? Xc[rr] : 0.f; Xt[rr] = (q < fr) ? Xt[rr] : 0.f; S1[rr] = Xt[rr] + ((q == fr) ? 1.0f : 0.f);
                AakT[rr] = (q < fr) ? AakT[rr] : 0.f; ArkT[rr] = (q <= fr) ? ArkT[rr] : 0.f; ArbT[rr] = (q <= fr) ? ArbT[rr] : 0.f; }
            { u32x2 w; w.x = cvt_pk_bf16(AakT[0], AakT[1]); w.y = cvt_pk_bf16(AakT[2], AakT[3]); *(LAS u32x2*)(sl + CS_AAK + o16) = w;
              w.x = cvt_pk_bf16(ArkT[0], ArkT[1]); w.y = cvt_pk_bf16(ArkT[2], ArkT[3]); *(LAS u32x2*)(sl + CS_ARK + o16) = w;
              w.x = cvt_pk_bf16(ArbT[0], ArbT[1]); w.y = cvt_pk_bf16(ArbT[2], ArbT[3]); *(LAS u32x2*)(sl + CS_ARB + o16) = w; }
#define CS_PK(v) ((u32x2){cvt_pk_bf16((v)[0], (v)[1]), cvt_pk_bf16((v)[2], (v)[3])})
            const u32x2 xc = CS_PK(Xc), xt = CS_PK(Xt), s1 = CS_PK(S1);
            const f32x4 X2c = CS_M16(xt, xc, zero4), X2t = CS_M16(xc, xt, zero4);
            const u32x2 x2c = CS_PK(X2c), x2t = CS_PK(X2t);
            const f32x4 S2 = CS_M16(x2c, s1, S1);
            const f32x4 X4c = CS_M16(x2t, x2c, zero4), X4t = CS_M16(x2c, x2t, zero4);
            const u32x2 x4c = CS_PK(X4c), x4t = CS_PK(X4t), s2 = CS_PK(S2);
            const f32x4 S4 = CS_M16(x4c, s2, S2);
            const f32x4 X8c = CS_M16(x4t, x4c, zero4);
            const u32x2 x8c = CS_PK(X8c), s4 = CS_PK(S4);
            const f32x4 S8 = CS_M16(x8c, s4, S4);
            *(LAS u32x2*)(sl + CS_TT + o16) = CS_PK(S8);
#undef CS_PK
            asm volatile("s_waitcnt lgkmcnt(0)" ::: "memory");
            __builtin_amdgcn_fence(__ATOMIC_RELEASE, "workgroup");
            if (lane == 0) flg[slot] = (unsigned)(n + 1);
        }
#undef CS_FETCH
    }
#undef CS_M32
#undef CS_M16
    __syncthreads();
}

__device__ __forceinline__ void scan_phase(const Frame& F, const Args& a, const int idx) {
    const int seq = idx >> 1, half = idx & 1;
    if (seq >> 5) scan_phase_z<1>(F, a, seq, half); else scan_phase_z<0>(F, a, seq, half);
}

__device__ __forceinline__ void combine_phase(const Frame& F, const Args& a) {
    unsigned char* ws = a.ws;
    const bf16* att = (const bf16*)(ws + WS_ATT); const bf16* rr = (const bf16*)(ws + WS_R); const bf16* vv = (const bf16*)(ws + WS_V);
    const bf16* kd = (const bf16*)(ws + WS_KDIR); const bf16* gg = (const bf16*)(ws + WS_G); const bf16* y = (const bf16*)(ws + WS_Y);
    bf16* mix = (bf16*)(ws + WS_MIX);
    const float* anw = a.in[4]; const float* r_k = a.in[14]; const float* ln_w = a.in[15]; const float* ln_b = a.in[16];
    const int lane = F.lane, c0 = 8 * lane;
    float nw[8], rk[8], lw[8], lb[8];
#pragma unroll
    for (int i = 0; i < 8; ++i) { nw[i] = anw[c0 + i]; rk[i] = r_k[c0 + i]; lw[i] = ln_w[c0 + i]; lb[i] = ln_b[c0 + i]; }
    const int gw = F.vcu * 8 + F.wave, NGW = F.G * 8;
#pragma unroll 2
    for (int m = gw; m < M; m += NGW) {
        const size_t o = (size_t)m * CW + c0;
        float f[8];
        unpack8(*(const u32x4*)(att + o), f);
        float ss = 0.f;
#pragma unroll
        for (int i = 0; i < 8; ++i) ss += f[i] * f[i];
        const float rs = rsqrtf(wave_sum(ss) * (1.f / CW) + RMS_EPS);
#pragma unroll
        for (int i = 0; i < 8; ++i) f[i] = f[i] * rs * nw[i];
        *(u32x4*)(mix + (size_t)m * D + c0) = pack8(f);
        float yv[8], yw[8];
        unpack8(*(const u32x4*)(y + o), yv); unpack8(*(const u32x4*)(y + (size_t)M * CW + o), yw);
#pragma unroll
        for (int i = 0; i < 8; ++i) yv[i] += yw[i];
        float s1 = 0.f;
#pragma unroll
        for (int i = 0; i < 8; ++i) s1 += yv[i];
        s1 += __shfl_xor(s1, 1); s1 += __shfl_xor(s1, 2); s1 += __shfl_xor(s1, 4);
        const float mean = s1 * (1.f / 64.f);
        float s2 = 0.f;
#pragma unroll
        for (int i = 0; i < 8; ++i) { yv[i] -= mean; s2 += yv[i] * yv[i]; }
        s2 += __shfl_xor(s2, 1); s2 += __shfl_xor(s2, 2); s2 += __shfl_xor(s2, 4);
        const float rstd = rsqrtf(s2 * (1.f / 64.f) + GN_EPS);
        float rf[8], k0[8], k1[8], vf[8], gf[8];
        unpack8(*(const u32x4*)(rr + o), rf); unpack8(*(const u32x4*)(kd + o), k0); unpack8(*(const u32x4*)(kd + (size_t)M * CW + o), k1);
        unpack8(*(const u32x4*)(vv + o), vf); unpack8(*(const u32x4*)(gg + o), gf);
        float cf = 0.f;
#pragma unroll
        for (int i = 0; i < 8; ++i) cf += rf[i] * (k0[i] + k1[i]) * rk[i];
        cf += __shfl_xor(cf, 1); cf += __shfl_xor(cf, 2); cf += __shfl_xor(cf, 4);
#pragma unroll
        for (int i = 0; i < 8; ++i) f[i] = (yv[i] * rstd * lw[i] + lb[i] + cf * vf[i]) * gf[i];
        *(u32x4*)(mix + (size_t)m * D + CW + c0) = pack8(f);
    }
}

__device__ __forceinline__ void router_phase(const Frame& F, const Args& a) {
    unsigned char* ws = a.ws;
    const bf16* hbuf = (const bf16*)(ws + WS_H); unsigned char* hn2 = ws + WS_HN2;
    int* eidx = (int*)(ws + WS_EIDX); float* gate = (float*)(ws + WS_GATE); int* rank = (int*)(ws + WS_RANK);
    unsigned* ctl = (unsigned*)(ws + WS_CTL);
    const float* n2w = a.in[18]; const float* rw = a.in[19]; const float* rb = a.in[20];
    LAS bf16* wh = (LAS bf16*)(F.lds + RT_WH); LAS bf16* wl = (LAS bf16*)(F.lds + RT_WL); LAS int* hist = (LAS int*)(F.lds + RT_HIST); LAS int* eL = (LAS int*)(F.lds + RT_EL);
    {
        const u32x4* img = (const u32x4*)(ws + WS_RTIMG); LAS u32x4* dst = (LAS u32x4*)(F.lds + RT_WH);
        u32x4 t[17];
#pragma unroll
        for (int j = 0; j < 17; ++j) { const int i = F.tid + 512 * j; if (i < 8256) t[j] = img[i]; }
#pragma unroll
        for (int j = 0; j < 17; ++j) { const int i = F.tid + 512 * j; if (i < 8256) dst[i] = t[j]; } }
    if (F.tid < 32) hist[F.tid] = 0;
    __syncthreads();
    const int lane = F.lane, tk = lane & 15, g = lane >> 4;
    const int blk = F.vcu;
    const int m = blk * 128 + F.wave * 16 + tk;
    const bf16* hrow = hbuf + (size_t)m * D + 8 * g;
    float ss = 0.f;
#pragma unroll 8
    for (int ks = 0; ks < 32; ++ks) { float xf[8]; unpack8(*(const u32x4*)(hrow + 32 * ks), xf);
        ss += (xf[0] * xf[0] + xf[1] * xf[1]) + (xf[2] * xf[2] + xf[3] * xf[3]) + (xf[4] * xf[4] + xf[5] * xf[5]) + (xf[6] * xf[6] + xf[7] * xf[7]); }
    ss += __shfl_xor(ss, 16); ss += __shfl_xor(ss, 32);
    const float rs = rsqrtf(ss * (1.f / D) + RMS_EPS);
    f32x4 acc0 = {0.f, 0.f, 0.f, 0.f}, acc1 = acc0;
    unsigned char* hrow8 = hn2 + (size_t)m * D + 8 * g;
    const LAS bf16* wh0 = wh + tk * RT_PITCH + 8 * g; const LAS bf16* wl0 = wl + tk * RT_PITCH + 8 * g;
#pragma unroll 4
    for (int ks = 0; ks < 32; ++ks) {
        float xf[8]; unpack8(*(const u32x4*)(hrow + 32 * ks), xf);
        const f32x4 x0 = {xf[0], xf[1], xf[2], xf[3]}, x1 = {xf[4], xf[5], xf[6], xf[7]};
        const f32x4 n0 = *(const f32x4*)(n2w + 32 * ks + 8 * g), n1 = *(const f32x4*)(n2w + 32 * ks + 8 * g + 4);
        const f32x4 y0 = x0 * rs * n0, y1 = x1 * rs * n1;
        { u32x2 w8; w8.x = pk4_fp8(y0.x * F8_SX, y0.y * F8_SX, y0.z * F8_SX, y0.w * F8_SX); w8.y = pk4_fp8(y1.x * F8_SX, y1.y * F8_SX, y1.z * F8_SX, y1.w * F8_SX); *(u32x2*)(hrow8 + 32 * ks) = w8; }
        union { u32x4 w; bf16x8 h8; } xh, xl;
        xh.w.x = cvt_pk_bf16(y0.x, y0.y); xh.w.y = cvt_pk_bf16(y0.z, y0.w); xh.w.z = cvt_pk_bf16(y1.x, y1.y); xh.w.w = cvt_pk_bf16(y1.z, y1.w);
        xl.w.x = cvt_pk_bf16(y0.x - bflo(xh.w.x), y0.y - bfhi(xh.w.x)); xl.w.y = cvt_pk_bf16(y0.z - bflo(xh.w.y), y0.w - bfhi(xh.w.y));
        xl.w.z = cvt_pk_bf16(y1.x - bflo(xh.w.z), y1.y - bfhi(xh.w.z)); xl.w.w = cvt_pk_bf16(y1.z - bflo(xh.w.w), y1.w - bfhi(xh.w.w));
        const bf16x8 a0h = *(const LAS bf16x8*)(wh0 + 32 * ks), a1h = *(const LAS bf16x8*)(wh0 + 16 * RT_PITCH + 32 * ks);
        const bf16x8 a0l = *(const LAS bf16x8*)(wl0 + 32 * ks), a1l = *(const LAS bf16x8*)(wl0 + 16 * RT_PITCH + 32 * ks);
        acc0 = __builtin_amdgcn_mfma_f32_16x16x32_bf16(a0h, xh.h8, acc0, 0, 0, 0); acc1 = __builtin_amdgcn_mfma_f32_16x16x32_bf16(a1h, xh.h8, acc1, 0, 0, 0);
        acc0 = __builtin_amdgcn_mfma_f32_16x16x32_bf16(a0h, xl.h8, acc0, 0, 0, 0); acc1 = __builtin_amdgcn_mfma_f32_16x16x32_bf16(a1h, xl.h8, acc1, 0, 0, 0);
        acc0 = __builtin_amdgcn_mfma_f32_16x16x32_bf16(a0l, xh.h8, acc0, 0, 0, 0); acc1 = __builtin_amdgcn_mfma_f32_16x16x32_bf16(a1l, xh.h8, acc1, 0, 0, 0);
    }
    float lv[8]; int li[8];
    { const f32x4 b0 = *(const f32x4*)(rb + 4 * g), b1 = *(const f32x4*)(rb + 16 + 4 * g);
#pragma unroll
      for (int i = 0; i < 4; ++i) { lv[i] = acc0[i] + b0[i]; li[i] = 4 * g + i; lv[4 + i] = acc1[i] + b1[i]; li[4 + i] = 16 + 4 * g + i; } }
    float tv[4]; int ti[4];
#pragma unroll
    for (int kx = 0; kx < 4; ++kx) {
        float bv = lv[0]; int bi = li[0];
#pragma unroll
        for (int i = 1; i < 8; ++i) { const bool gt = lv[i] > bv; bv = gt ? lv[i] : bv; bi = gt ? li[i] : bi; }
#pragma unroll
        for (int o = 16; o < 64; o <<= 1) { const float ov = __shfl_xor(bv, o); const int oi = __shfl_xor(bi, o); const bool tko = (ov > bv) || (ov == bv && oi < bi); bv = tko ? ov : bv; bi = tko ? oi : bi; }
        tv[kx] = bv; ti[kx] = bi;
#pragma unroll
        for (int i = 0; i < 8; ++i) lv[i] = (li[i] == bi) ? -3.0e38f : lv[i];
    }
    if (g == 0) {
        const float e0 = 1.0f, e1 = __expf(tv[1] - tv[0]), e2 = __expf(tv[2] - tv[0]), e3 = __expf(tv[3] - tv[0]);
        const float is = 1.0f / (e0 + e1 + e2 + e3);
        const float gs[4] = {e0 * is, e1 * is, e2 * is, e3 * is};
#pragma unroll
        for (int kx = 0; kx < 4; ++kx) { eidx[m * 4 + kx] = ti[kx]; gate[m * 4 + kx] = gs[kx]; eL[(m - blk * 128) * 4 + kx] = ti[kx]; }
    }
    __syncthreads();
    { const int t = F.tid, e = eL[t]; int rk = 0;
      for (int u = 0; u < t; ++u) rk += (eL[u] == e) ? 1 : 0;
      rank[(blk * 128) * 4 + t] = rk;
      __hip_atomic_fetch_add(&hist[e], 1, __ATOMIC_RELAXED, __HIP_MEMORY_SCOPE_WORKGROUP); }
    __syncthreads();
    if (F.tid < 32) ctl[CW_CNT + blk * 32 + F.tid] = (unsigned)hist[F.tid];
}

__device__ __forceinline__ void dispatch_phase(const Frame& F, const Args& a) {
    unsigned char* ws = a.ws;
    unsigned* ctl = (unsigned*)(ws + WS_CTL);
    const int* eidx = (const int*)(ws + WS_EIDX); const int* rank = (const int*)(ws + WS_RANK); int* dest = (int*)(ws + WS_DEST);
    LAS int* part = (LAS int*)F.lds;
    LAS int* tot = part + 1024;
    const int blk = F.vcu, G = F.G;
    { const int e = F.tid & 31, pt = F.tid >> 5; int s = 0, sb = 0;
      if (G == 256) { int cv[16];
#pragma unroll
          for (int q = 0; q < 16; ++q) cv[q] = (int)ld_u32_agent(ctl + CW_CNT + (pt + 16 * q) * 32 + e);
#pragma unroll
          for (int q = 0; q < 16; ++q) { s += cv[q]; if (pt + 16 * q < blk) sb += cv[q]; } }
      else for (int bb = pt; bb < G; bb += 16) { const int cval = (int)ld_u32_agent(ctl + CW_CNT + bb * 32 + e); s += cval; if (bb < blk) sb += cval; }
      part[pt * 32 + e] = s; part[512 + pt * 32 + e] = sb; }
    __syncthreads();
    if (F.tid < 32) { int s = 0, sb = 0;
        for (int pt = 0; pt < 16; ++pt) { s += part[pt * 32 + F.tid]; sb += part[512 + pt * 32 + F.tid]; }
        tot[F.tid] = s; tot[32 + F.tid] = sb; tot[96 + F.tid] = (s + 255) & ~255; }
    __syncthreads();
    if (F.tid == 0) { int ps = 0; for (int e = 0; e < 32; ++e) { tot[64 + e] = ps; ps += tot[96 + e]; }
        tot[128] = ps >> 8; }
    __syncthreads();
    if (blk == 0) {
        if (F.tid == 0) ctl[CW_NT] = (unsigned)tot[128];
        for (int e = F.tid >> 4; e < 32; e += 32) { const int t0 = tot[64 + e] >> 8, nt = tot[96 + e] >> 8; for (int i = F.tid & 15; i < nt; i += 16) ctl[CW_TEXP + t0 + i] = (unsigned)e; }
    }
    const int lane = F.lane;
    const int mw = blk * 128 + F.wave * 16;
    int* rowtok = (int*)(ws + WS_ROWTOK);
    { const int e = eidx[mw * 4 + lane]; const int dl = tot[64 + e] + tot[32 + e] + rank[mw * 4 + lane]; dest[mw * 4 + lane] = dl; rowtok[dl] = mw + (lane >> 2); }
    { const int e = blk & 31, pt = blk >> 5, np = G >> 5; const int r0 = tot[64 + e] + tot[e], r1 = tot[64 + e] + tot[96 + e];
      if (np > 0) for (int r = r0 + pt * 512 + F.tid; r < r1; r += np * 512) rowtok[r] = 0; }
}

__device__ __forceinline__ void final_phase(const Frame& F, const Args& a) {
    unsigned char* ws = a.ws;
    const bf16* hbuf = (const bf16*)(ws + WS_H); const unsigned char* ybuf = ws + WS_YBUF;
    const int* dest = (const int*)(ws + WS_DEST); const float* gate = (const float*)(ws + WS_GATE);
    const float* fw = a.in[25]; float* out = a.out;
    const int lane = F.lane;
    f32x4 wn[4];
#pragma unroll
    for (int j = 0; j < 4; ++j) wn[j] = *((const f32x4*)fw + lane + 64 * j);
    const int gw = F.vcu * 8 + F.wave, NGW = F.G * 8;
    const int per = M / NGW;
    const int mw = gw * per;
    int dl = 0; float gl = 0.f;
    if (lane < 4 * per && per <= 16) { dl = dest[mw * 4 + lane]; gl = gate[mw * 4 + lane]; }
#pragma unroll 2
    for (int i = 0; i < per; ++i) {
        const int m = mw + i;
        const u32x2* hr = (const u32x2*)(hbuf + (size_t)m * D) + lane;
        f32x4 v[4];
#pragma unroll
        for (int j = 0; j < 4; ++j) { const u32x2 w = hr[64 * j]; v[j] = (f32x4){bflo(w.x), bfhi(w.x), bflo(w.y), bfhi(w.y)}; }
#pragma unroll
        for (int kx = 0; kx < 4; ++kx) {
            const int d = per <= 16 ? __shfl(dl, 4 * i + kx) : dest[m * 4 + kx]; const float gt = (per <= 16 ? __shfl(gl, 4 * i + kx) : gate[m * 4 + kx]) * (1.0f / F8_SY);
            const unsigned* yr = (const unsigned*)(ybuf + (size_t)d * D) + lane;
#pragma unroll
            for (int j = 0; j < 4; ++j) { const unsigned w = yr[64 * j]; const f32x2 lo = __builtin_amdgcn_cvt_pk_f32_fp8((int)w, false), hi = __builtin_amdgcn_cvt_pk_f32_fp8((int)w, true);
                v[j].x += gt * lo.x; v[j].y += gt * lo.y; v[j].z += gt * hi.x; v[j].w += gt * hi.y; }
        }
        float s = 0.f;
#pragma unroll
        for (int j = 0; j < 4; ++j) s += (v[j].x * v[j].x + v[j].y * v[j].y) + (v[j].z * v[j].z + v[j].w * v[j].w);
        const float rs = rsqrtf(wave_sum(s) * (1.f / D) + RMS_EPS);
        f32x4* orow = (f32x4*)(out + (size_t)m * D) + lane;
#pragma unroll
        for (int j = 0; j < 4; ++j) orow[64 * j] = v[j] * rs * wn[j];
    }
}

__global__ void __launch_bounds__(512, 2) fwd_megakernel(Args args) {
    extern __shared__ __attribute__((aligned(16))) unsigned char lds_raw[];
    Frame F;
    F.lds = (LAS unsigned char*)lds_raw;
    F.tid = threadIdx.x; F.lane = F.tid & 63; F.wave = __builtin_amdgcn_readfirstlane(F.tid >> 6);
    F.G = gridDim.x; { const int bx = blockIdx.x; F.vcu = (F.G % 8 == 0) ? (bx % 8) * (F.G / 8) + bx / 8 : bx; }
    unsigned char* ws = args.ws;
    const int lo = args.ph_lo, hi = args.ph_hi;
#define IN(k) (lo <= (k) && (k) < hi)
#if MK_SPLIT
#define SEAM(k) do { } while (0)
#else
    cg::grid_group grid = cg::this_grid();
    { volatile LAS unsigned* st = (volatile LAS unsigned*)(F.lds + LDS_MISC); if (F.tid < 2) st[F.tid] = 0u; __syncthreads(); }
    const XcdBarrier xbar = xcd_barrier_post((unsigned*)(ws + WS_CTL) + CW_BAR, (volatile LAS unsigned*)(F.lds + LDS_MISC));
    if (lo < 0) grid.sync();
#define SEAM(k) do { if (IN(k) && IN((k) + 1)) xcd_barrier(xbar); } while (0)
#endif
#define REP2(k) if constexpr (((MK_REPEAT >> (k)) & 1) != 0)
#define PH1 { pg8::Gemm g{(const bf16*)(ws + WS_HN), (const bf16*)(ws + WS_WINT), 1024, nullptr, 0, nullptr}; \
        pg8::StaticOrder S; S.init(M / 256, NPROJ_PAD / 256, F.G, (int)blockIdx.x); \
        pg8::EpiProj E{(bf16*)(ws + WS_Q), (bf16*)(ws + WS_K), (bf16*)(ws + WS_VT), (bf16*)(ws + WS_P)}; \
        pg8::gemm_phase<pg8::EpiProj, true, true>(F.lds, g, S, E); }
#define PH5 { pg8::Gemm g{(const bf16*)(ws + WS_MIX), (const bf16*)(ws + WS_WOT), 1024, nullptr, 0, nullptr}; \
        pg8::StaticOrder S; S.init(M / 256, D / 256, F.G, (int)blockIdx.x); \
        pg8::EpiWo E{args.in[0], (bf16*)(ws + WS_H)}; \
        pg8::gemm_phase<pg8::EpiWo, true, true>(F.lds, g, S, E); }
#define PH8 { const unsigned* ctl = (const unsigned*)(ws + WS_CTL); const int ntile = (int)ld_u32_agent(ctl + CW_NT); \
        pg8::Gemm g{(const bf16*)(ws + WS_HN2), (const bf16*)(ws + WS_WUPT), 512, ctl + CW_TEXP, (size_t)2048 * 1024, (const int*)(ws + WS_ROWTOK)}; \
        pg8::StaticOrder S; S.init(ntile, 8, F.G, (int)blockIdx.x); \
        pg8::EpiUp E{args.in[22], ws + WS_ACT}; \
        pg8::gemm_phase<pg8::EpiUp, true, true, true, true>(F.lds, g, S, E); }
#define PH9 { const unsigned* ctl = (const unsigned*)(ws + WS_CTL); const int ntile = (int)ld_u32_agent(ctl + CW_NT); \
        pg8::Gemm g{(const bf16*)(ws + WS_ACT), (const bf16*)(ws + WS_WDNT), 512, ctl + CW_TEXP, (size_t)1024 * 1024, nullptr}; \
        pg8::StaticOrder S; S.init(ntile, 4, F.G, (int)blockIdx.x); \
        pg8::EpiDown E{args.in[24], ws + WS_YBUF}; \
        pg8::gemm_phase<pg8::EpiDown, true, true, false, true>(F.lds, g, S, E); }
    if (IN(0)) { p0_prologue(F, args); REP2(0) p0_prologue(F, args); }
    SEAM(0);
    if (IN(1)) { PH1 REP2(1) PH1 }
    SEAM(1);
    if (IN(2)) { prep_phase<true>(F, args); REP2(2) prep_phase<true>(F, args); }
    SEAM(2);
    if (IN(3)) {
        if ((F.vcu & 1) == 0 && (F.vcu >> 1) < 128) { scan_phase(F, args, F.vcu >> 1); REP2(3) scan_phase(F, args, F.vcu >> 1); }
        else { const int nside = F.G - min((F.G + 1) / 2, 128); const int q_ = min((F.vcu + 1) >> 1, 128); side_phase(F, args, F.vcu - q_, nside); REP2(11) side_phase(F, args, F.vcu - q_, nside); }
    }
    SEAM(3);
    if (IN(4)) { combine_phase(F, args); REP2(4) combine_phase(F, args); }
    SEAM(4);
    if (IN(5)) { PH5 REP2(5) PH5 }
    SEAM(5);
    if (IN(6)) { router_phase(F, args); REP2(6) { __syncthreads(); router_phase(F, args); } }
    SEAM(6);
    if (IN(7)) { dispatch_phase(F, args); REP2(7) { __syncthreads(); dispatch_phase(F, args); } }
    SEAM(7);
    if (IN(8)) { PH8 REP2(8) PH8 }
    SEAM(8);
    if (IN(9)) { PH9 REP2(9) PH9 }
    SEAM(9);
    if (IN(10)) { final_phase(F, args); REP2(10) final_phase(F, args); }
#undef IN
#undef SEAM
}

extern "C" void kernel_launch(void* const* d_in, const int* in_sizes, int n_in, void* d_out, int out_size, void* d_ws, size_t ws_size, hipStream_t stream) {
    static int grid = 0;
    if (grid == 0) {
        if (n_in != 26 || in_sizes[0] != M * D || out_size != M * D || ws_size < WS_END) { fprintf(stderr, "kernel_launch: unexpected problem (n_in %d, in0 %d, out %d, ws %zu)\n", n_in, n_in > 0 ? in_sizes[0] : -1, out_size, ws_size); grid = -1; return; }
        int dev = 0, cus = 0, per_cu = 0;
        if (hipGetDevice(&dev) != hipSuccess || hipDeviceGetAttribute(&cus, hipDeviceAttributeMultiprocessorCount, dev) != hipSuccess) { grid = -1; return; }
        if (hipFuncSetAttribute((const void*)fwd_megakernel, hipFuncAttributeMaxDynamicSharedMemorySize, LDS_BYTES) != hipSuccess) { fprintf(stderr, "kernel_launch: hipFuncSetAttribute failed\n"); grid = -1; return; }
        if (hipOccupancyMaxActiveBlocksPerMultiprocessor(&per_cu, (const void*)fwd_megakernel, 512, LDS_BYTES) != hipSuccess || per_cu < 1) { fprintf(stderr, "kernel_launch: occupancy query says %d\n", per_cu); per_cu = 1; }
        (void)hipGetLastError();
        grid = cus * 1;
        if (grid != 256) fprintf(stderr, "kernel_launch: note: %d CUs\n", cus);
    }
    if (grid < 0) return;
    if (hipMemsetAsync((char*)d_ws + WS_CTL + (size_t)CW_BAR * 4, 0, XCD_BAR_WORDS * 4, stream) != hipSuccess) { fprintf(stderr, "kernel_launch: memset failed\n"); return; }
    Args a{};
    for (int i = 0; i < 26; ++i) a.in[i] = (const float*)d_in[i];
    a.out = (float*)d_out; a.ws = (unsigned char*)d_ws;
#if MK_SPLIT
    for (int ph = 0; ph < NPHASE; ++ph) { a.ph_lo = ph; a.ph_hi = ph + 1; hipLaunchKernelGGL(fwd_megakernel, dim3(grid), dim3(512), LDS_BYTES, stream, a); }
#else
    a.ph_lo = 0; a.ph_hi = NPHASE;
    void* kargs[] = {&a};
    hipError_t e = hipLaunchCooperativeKernel((const void*)fwd_megakernel, dim3(grid), dim3(512), kargs, LDS_BYTES, stream);
    if (e != hipSuccess) fprintf(stderr, "kernel_launch: cooperative launch failed: %s (grid %d)\n", hipGetErrorString(e), grid);
#endif
}
```

```cpp
#include <hip/hip_runtime.h>
#include <hip/hip_cooperative_groups.h>
#include <cstdio>
#include <cstdint>
namespace cg = cooperative_groups;

#ifndef MK_SPLIT
#define MK_SPLIT 0
#endif

#ifndef MK_REPEAT
#define MK_REPEAT 0
#endif
#define LAS __attribute__((address_space(3)))
typedef unsigned short bf16;
typedef float f32x4 __attribute__((ext_vector_type(4)));
typedef float f32x2 __attribute__((ext_vector_type(2)));
typedef unsigned u32x4 __attribute__((ext_vector_type(4)));
typedef unsigned u32x2 __attribute__((ext_vector_type(2)));
typedef short bf16x8 __attribute__((ext_vector_type(8)));
typedef short s16x4 __attribute__((ext_vector_type(4)));

constexpr int BATCH = 4, T = 8192, D = 1024, M = BATCH * T;
constexpr int NH = 8, HD = 64, CW = 512;
constexpr int SHIFT_W = 1920, NPROJ = 3456, NPROJ_PAD = 3584, PW = 2048;
constexpr int NE = 32, TOPK = 4, DE = 1024;
constexpr int GRIDW = 64, GROWS = 128;
constexpr int P_TILES_MAX = 544, P_ROWS = P_TILES_MAX * 256;
constexpr float RMS_EPS = 1e-5f, GN_EPS = 64e-5f;
constexpr int NPHASE = 11;

constexpr size_t MiB = 1u << 20;
constexpr size_t WS_CTL = 0;
constexpr size_t WS_W2T = 1 * MiB, WS_A2T = WS_W2T + 131072, WS_G2T = WS_A2T + 131072;
constexpr size_t WS_WINT = 2 * MiB, WS_WOT = 9 * MiB, WS_WUPT = 12 * MiB, WS_WDNT = 140 * MiB;
constexpr size_t WS_EIDX = 204 * MiB, WS_GATE = WS_EIDX + 524288, WS_RANK = WS_GATE + 524288, WS_DEST = WS_RANK + 524288, WS_ROWTOK = WS_DEST + 524288;
constexpr size_t WS_R = 208 * MiB, WS_V = 240 * MiB, WS_KK = 272 * MiB, WS_DECAY = 304 * MiB, WS_KDIR = 368 * MiB, WS_AKK = 432 * MiB,
                 WS_G = 496 * MiB, WS_ATT = 528 * MiB;
constexpr size_t WS_Q = 560 * MiB, WS_K = 592 * MiB, WS_VT = 624 * MiB, WS_P = 656 * MiB, WS_HN = 784 * MiB, WS_Y = 848 * MiB;
constexpr size_t WS_MIX = 560 * MiB, WS_H = 752 * MiB, WS_HN2 = 880 * MiB, WS_XBUF = 208 * MiB, WS_ACT = 480 * MiB, WS_YBUF = 208 * MiB;
constexpr size_t WS_END = 976 * MiB;
constexpr int RT_PITCH = 1032, RT_WH = 0, RT_WL = 32 * RT_PITCH * 2, RT_HIST = 2 * RT_WL, RT_EL = RT_HIST + 256;
constexpr size_t WS_RTIMG = 262144;

constexpr int CW_NT = 0, CW_TEXP = 64, CW_CNT = 1024, CW_BAR = 16384;

constexpr int LDS_BYTES = 159744, LDS_MISC = LDS_BYTES - 256;

typedef __bf16 bf16x2_t __attribute__((ext_vector_type(2)));
__device__ __forceinline__ unsigned cvt_pk_bf16(float lo, float hi) { const f32x2 v = {lo, hi}; return __builtin_bit_cast(unsigned, __builtin_convertvector(v, bf16x2_t)); }
typedef int i32x8 __attribute__((ext_vector_type(8)));
typedef int i32x4 __attribute__((ext_vector_type(4)));
#ifndef F8_SCALE1
#define F8_SCALE1 0
#endif
constexpr float F8_SX = 32.0f, F8_SW = 128.0f, F8_SACT = 8.0f, F8_SY = 32.0f;
__device__ __forceinline__ float f8clamp(float v) { return __builtin_amdgcn_fmed3f(v, -448.0f, 448.0f); }
__device__ __forceinline__ unsigned pk4_fp8(float a, float b, float c, float d) { int w = 0; w = __builtin_amdgcn_cvt_pk_fp8_f32(f8clamp(a), f8clamp(b), w, false); w = __builtin_amdgcn_cvt_pk_fp8_f32(f8clamp(c), f8clamp(d), w, true); return (unsigned)w; }
__device__ __forceinline__ float bflo(unsigned u) { return __uint_as_float(u << 16); }
__device__ __forceinline__ float bfhi(unsigned u) { return __uint_as_float(u & 0xffff0000u); }
__device__ __forceinline__ float bf1(bf16 v) { return __uint_as_float(((unsigned)v) << 16); }
__device__ __forceinline__ void unpack8(const u32x4 u, float* f) { f[0] = bflo(u.x); f[1] = bfhi(u.x); f[2] = bflo(u.y); f[3] = bfhi(u.y); f[4] = bflo(u.z); f[5] = bfhi(u.z); f[6] = bflo(u.w); f[7] = bfhi(u.w); }
__device__ __forceinline__ u32x4 pack8(const float* f) { u32x4 o; o.x = cvt_pk_bf16(f[0], f[1]); o.y = cvt_pk_bf16(f[2], f[3]); o.z = cvt_pk_bf16(f[4], f[5]); o.w = cvt_pk_bf16(f[6], f[7]); return o; }
__device__ __forceinline__ float wave_sum(float v) {
#pragma unroll
    for (int o = 1; o < 64; o <<= 1) v += __shfl_xor(v, o);
    return v;
}
__device__ __forceinline__ float sigmoidf_(float x) { return __builtin_amdgcn_rcpf(1.0f + __expf(-x)); }
__device__ __forceinline__ unsigned ld_u32_agent(const unsigned* p) { return __hip_atomic_load(p, __ATOMIC_RELAXED, __HIP_MEMORY_SCOPE_AGENT); }

namespace pg8 {
constexpr int BM = 256, BK = 64, HALF = 128, HTB = HALF * BK * 2, STAGE_BYTES = 8 * HTB, NXCD = 8, WGM = 8;
__host__ __device__ __forceinline__ int lds_byte(int r, int c) { const int st = (r >> 4) * 2 + (c >> 5), rr = r & 15, cc = c & 31, ob = rr * 64 + cc * 2; return st * 1024 + (ob ^ (((ob >> 9) & 1) << 5)); }
__host__ __device__ __forceinline__ void stage_rc(int b, int& R, int& C) { const int st = b / 1024, sb = b % 1024, swz = sb ^ (((sb >> 9) & 1) << 5); R = (st >> 1) * 16 + swz / 64; C = (st & 1) * 32 + (swz % 64) / 2; }
__host__ __device__ __forceinline__ int perm32(int rho) { const int n = rho >> 4, i = rho & 15; return 8 * (i >> 2) + 4 * n + (i & 3); }

struct Unit { int pm, pn, e; };
struct Gemm { const bf16* A; const bf16* Bt; int K; const unsigned* texp; size_t bstride; const int* rowtok; };

struct StaticOrder {
    int nM, nN, nwg, G, c;
    __device__ void init(int nM_, int nN_, int G_, int c_) { nM = nM_; nN = nN_; nwg = nM * nN; G = G_; c = c_; }
    __device__ bool next(int i, Unit& u) const {
        const long L = (long)i * G + c; if (L >= nwg) return false;
        int wgid = (int)L; { const int q = nwg / NXCD, r = nwg % NXCD, xcd = wgid % NXCD, off = wgid / NXCD; wgid = (xcd < r ? xcd * (q + 1) : r * (q + 1) + (xcd - r) * q) + off; }
        const int nig = WGM * nN, gid = wgid / nig, fm = gid * WGM, gsz = (nM - fm) < WGM ? (nM - fm) : WGM;
        u.pm = fm + ((wgid % nig) % gsz); u.pn = (wgid % nig) / gsz; u.e = 0; return true;
    }
};

__device__ __forceinline__ i32x8 cat8(const bf16x8 lo, const bf16x8 hi) { return __builtin_shufflevector(__builtin_bit_cast(i32x4, lo), __builtin_bit_cast(i32x4, hi), 0, 1, 2, 3, 4, 5, 6, 7); }
template <class Epi, bool ALIGN_EPI, bool SP2, bool GATHER = false, bool FP8 = false>
__device__ __forceinline__ void gemm_phase(LAS unsigned char* lds, const Gemm g, const StaticOrder& S, const Epi& E) {
    const int tid = threadIdx.x, wid = __builtin_amdgcn_readfirstlane(tid >> 6), lane = tid & 63, wr = wid >> 2, wc = wid & 3, fr = lane & 15, fq = lane >> 4;
    const int K = g.K, nt = K / BK;
    unsigned voffA[2], voffB[2];
#pragma unroll
    for (int i = 0; i < 2; ++i) { int R, C; stage_rc(tid * 16 + i * 8192, R, C); const int Rb = Epi::PERM ? ((R & ~31) + perm32(R & 31)) : R;
        voffA[i] = (unsigned)(R * K + C) * 2u; voffB[i] = (unsigned)(Rb * K + C) * 2u; }
    unsigned vC[2][2];
#define PG8_GROWS(u, dst) do { _Pragma("unroll") for (int h_ = 0; h_ < 2; ++h_) _Pragma("unroll") for (int i_ = 0; i_ < 2; ++i_) { int R_, C_; stage_rc(tid * 16 + i_ * 8192, R_, C_); \
        dst[h_][i_] = (unsigned)g.rowtok[(u).pm * BM + h_ * HALF + R_] * (unsigned)(K * 2) + (unsigned)(C_ * 2); } } while (0)
    const size_t kstep = (size_t)(BK * 2);
    const size_t hstep = (size_t)HALF * K * 2;
    const size_t tstep = 2 * hstep;
    const unsigned ldsw = (unsigned)wid * 1024u;
    const int aoff = lds_byte(wr * 64 + fr, fq * 8), boff = lds_byte(wc * 32 + fr, fq * 8);
#define PG8_SA(b, h) (((b) * 2 + (h)) * HTB)
#define PG8_SB(b, h) ((4 + (b) * 2 + (h)) * HTB)
#define PG8_STAGE(bufoff, gbase, voff) do { _Pragma("unroll") for (int _i = 0; _i < 2; ++_i) \
        __builtin_amdgcn_global_load_lds((const unsigned*)((const char*)(gbase) + (voff)[_i]), (LAS unsigned*)(lds + (bufoff) + ldsw + _i * 8192), 16, 0, 0); } while (0)
#define PG8_STAGE_A(bufoff, p, h, nx) do { if constexpr (GATHER) { PG8_STAGE(bufoff, p, vC[h]); } else PG8_STAGE(bufoff, (p) + (h) * hstep, voffA); } while (0)
#define PG8_LDA(dst, b, h) do { _Pragma("unroll") for (int m = 0; m < 4; ++m) _Pragma("unroll") for (int k = 0; k < 2; ++k) dst[m][k] = *(const LAS bf16x8*)(lds + PG8_SA(b, h) + aoff + m * 2048 + k * 1024); } while (0)
#define PG8_LDB(dst, b, h) do { _Pragma("unroll") for (int n = 0; n < 2; ++n) _Pragma("unroll") for (int k = 0; k < 2; ++k) dst[n][k] = *(const LAS bf16x8*)(lds + PG8_SB(b, h) + boff + n * 2048 + k * 1024); } while (0)
#define PG8_MMA(ai, bj, At, Bt) do { __builtin_amdgcn_s_setprio(1); \
        if constexpr (FP8) { _Pragma("unroll") for (int m = 0; m < 4; ++m) _Pragma("unroll") for (int n = 0; n < 2; ++n) \
            { const i32x8 b8_ = cat8(Bt[n][0], Bt[n][1]), a8_ = cat8(At[m][0], At[m][1]); asm volatile("v_mfma_f32_16x16x128_f8f6f4 %0, %1, %2, %0" : "+v"(acc[ai][bj][m][n]) : "v"(b8_), "v"(a8_)); } } \
        else { _Pragma("unroll") for (int m = 0; m < 4; ++m) _Pragma("unroll") for (int n = 0; n < 2; ++n) _Pragma("unroll") for (int k = 0; k < 2; ++k) \
            acc[ai][bj][m][n] = __builtin_amdgcn_mfma_f32_16x16x32_bf16(Bt[n][k], At[m][k], acc[ai][bj][m][n], 0, 0, 0); } \
        __builtin_amdgcn_s_setprio(0); } while (0)
#define PG8_WAIT_V(n) asm volatile("s_waitcnt vmcnt(" #n ")" ::: "memory")
#define PG8_WAIT_L(n) asm volatile("s_waitcnt lgkmcnt(" #n ")" ::: "memory")
#define PG8_BAR __builtin_amdgcn_s_barrier()
#define PG8_SCHED __builtin_amdgcn_sched_barrier(0)
#define PG8_UPTR(u, pa, pb) do { unsigned _e = g.texp ? ld_u32_agent(g.texp + (u).pm) : 0u; _e = (unsigned)__builtin_amdgcn_readfirstlane((int)_e); (u).e = (int)_e; \
        pa = GATHER ? (const char*)g.A : (const char*)g.A + (size_t)(u).pm * tstep; pb = (const char*)g.Bt + (size_t)_e * g.bstride + (size_t)(u).pn * tstep; } while (0)
    Unit cur, nxt; int ui = 0;
    if (!S.next(0, cur)) return;
    f32x4 acc[2][2][4][2];
#pragma unroll
    for (int a = 0; a < 2; ++a)
#pragma unroll
        for (int b = 0; b < 2; ++b)
#pragma unroll
            for (int m = 0; m < 4; ++m)
#pragma unroll
                for (int n = 0; n < 2; ++n) acc[a][b][m][n] = (f32x4){0.f, 0.f, 0.f, 0.f};
    bf16x8 At[4][2], B0[2][2], B1[2][2];
    const char* cA; const char* cB;
    PG8_UPTR(cur, cA, cB);
    if constexpr (GATHER) { PG8_GROWS(cur, vC); }
    if constexpr (SP2) {
        PG8_STAGE(PG8_SB(0, 0), cB, voffB); PG8_STAGE(PG8_SB(0, 1), cB + hstep, voffB); PG8_STAGE_A(PG8_SA(0, 0), cA, 0, false); PG8_STAGE_A(PG8_SA(0, 1), cA, 1, false);
        if (wr == 1) PG8_BAR;
        PG8_WAIT_V(2); PG8_BAR;
        PG8_STAGE(PG8_SB(1, 0), cB + kstep, voffB); PG8_STAGE_A(PG8_SA(1, 0), cA + kstep, 0, false); PG8_STAGE(PG8_SB(1, 1), cB + hstep + kstep, voffB);
        PG8_WAIT_V(6); PG8_BAR;
    } else {
        PG8_STAGE(PG8_SB(0, 0), cB, voffB); PG8_STAGE_A(PG8_SA(0, 0), cA, 0, false); PG8_STAGE(PG8_SB(0, 1), cB + hstep, voffB); PG8_STAGE_A(PG8_SA(0, 1), cA, 1, false);
        if (wr == 1) PG8_BAR;
        PG8_WAIT_V(4); PG8_BAR;
        PG8_STAGE(PG8_SB(1, 0), cB + kstep, voffB); PG8_STAGE_A(PG8_SA(1, 0), cA + kstep, 0, false); PG8_STAGE(PG8_SB(1, 1), cB + hstep + kstep, voffB);
        PG8_WAIT_V(6); PG8_BAR;
    }
    for (;;) {
        const bool has_next = S.next(ui + 1, nxt);
        const char* nA = cA; const char* nB = cB;
        if (has_next) PG8_UPTR(nxt, nA, nB);
#pragma unroll 1
        for (int t = 0; t < nt; t += 2) {
            const bool last = (t == nt - 2);
            const char* a1 = cA + (size_t)(t + 1) * kstep;
            const char* a2 = last ? nA : cA + (size_t)(t + 2) * kstep; const char* b2 = last ? nB : cB + (size_t)(t + 2) * kstep;
            const char* a3 = a2 + kstep; const char* b3 = b2 + kstep;
            if constexpr (SP2) {
            PG8_LDB(B0, 0, 0); PG8_LDB(B1, 0, 1); PG8_SCHED; PG8_LDA(At, 0, 0); PG8_STAGE_A(PG8_SA(1, 1), a1, 1, false);
            if constexpr (GATHER) { if (last && has_next) { PG8_GROWS(nxt, vC); } }
            PG8_WAIT_V(8); PG8_WAIT_L(0); PG8_BAR; PG8_MMA(0, 0, At, B0); PG8_MMA(0, 1, At, B1); PG8_BAR; PG8_SCHED;
            PG8_LDA(At, 0, 1); PG8_STAGE(PG8_SB(0, 0), b2, voffB); PG8_STAGE(PG8_SB(0, 1), b2 + hstep, voffB); PG8_STAGE_A(PG8_SA(0, 0), a2, 0, last);
            PG8_WAIT_V(8); PG8_WAIT_L(0); PG8_BAR; PG8_MMA(1, 0, At, B0); PG8_MMA(1, 1, At, B1); PG8_BAR; PG8_SCHED;
            PG8_LDB(B0, 1, 0); PG8_LDB(B1, 1, 1); PG8_SCHED; PG8_LDA(At, 1, 0); PG8_STAGE_A(PG8_SA(0, 1), a2, 1, last);
            PG8_WAIT_V(8); PG8_WAIT_L(0); PG8_BAR; PG8_MMA(0, 0, At, B0); PG8_MMA(0, 1, At, B1); PG8_BAR; PG8_SCHED;
            PG8_LDA(At, 1, 1); PG8_STAGE(PG8_SB(1, 0), b3, voffB); PG8_STAGE(PG8_SB(1, 1), b3 + hstep, voffB); PG8_STAGE_A(PG8_SA(1, 0), a3, 0, last);
            PG8_WAIT_V(8); PG8_WAIT_L(0); PG8_BAR; PG8_MMA(1, 0, At, B0); PG8_MMA(1, 1, At, B1); PG8_BAR; PG8_SCHED;
            } else {
            PG8_LDB(B0, 0, 0); PG8_SCHED; PG8_LDA(At, 0, 0); PG8_STAGE_A(PG8_SA(1, 1), a1, 1, false);
            if constexpr (GATHER) { if (last && has_next) { PG8_GROWS(nxt, vC); } }
            PG8_WAIT_L(8); PG8_BAR; PG8_WAIT_L(0); PG8_MMA(0, 0, At, B0); PG8_BAR; PG8_SCHED;
            PG8_LDB(B1, 0, 1); PG8_STAGE(PG8_SB(0, 0), b2, voffB);
            PG8_BAR; PG8_WAIT_L(0); PG8_MMA(0, 1, At, B1); PG8_BAR;
            PG8_LDA(At, 0, 1); PG8_STAGE_A(PG8_SA(0, 0), a2, 0, last);
            PG8_BAR; PG8_WAIT_L(0); PG8_MMA(1, 0, At, B0); PG8_BAR; PG8_SCHED;
            PG8_STAGE(PG8_SB(0, 1), b2 + hstep, voffB);
            PG8_WAIT_V(6); PG8_BAR; PG8_MMA(1, 1, At, B1); PG8_BAR;
            PG8_LDB(B0, 1, 0); PG8_SCHED; PG8_LDA(At, 1, 0); PG8_STAGE_A(PG8_SA(0, 1), a2, 1, last);
            PG8_WAIT_L(8); PG8_BAR; PG8_WAIT_L(0); PG8_MMA(0, 0, At, B0); PG8_BAR; PG8_SCHED;
            PG8_LDB(B1, 1, 1); PG8_STAGE(PG8_SB(1, 0), b3, voffB);
            PG8_BAR; PG8_WAIT_L(0); PG8_MMA(0, 1, At, B1); PG8_BAR;
            PG8_LDA(At, 1, 1); PG8_STAGE_A(PG8_SA(1, 0), a3, 0, last);
            PG8_BAR; PG8_WAIT_L(0); PG8_MMA(1, 0, At, B0); PG8_BAR; PG8_SCHED;
            PG8_STAGE(PG8_SB(1, 1), b3 + hstep, voffB);
            PG8_WAIT_V(6); PG8_BAR; PG8_MMA(1, 1, At, B1); PG8_BAR;
            }
        }
        if constexpr (ALIGN_EPI) { if (wr == 0) PG8_BAR; }
        if constexpr (FP8) { asm volatile("s_nop 15\n\ts_nop 15" ::: "memory"); PG8_SCHED; }
        E(acc, cur, wr, wc, fr, fq);
        if (!has_next) break;
#pragma unroll
        for (int a = 0; a < 2; ++a)
#pragma unroll
            for (int b = 0; b < 2; ++b)
#pragma unroll
                for (int m = 0; m < 4; ++m)
#pragma unroll
                    for (int n = 0; n < 2; ++n) acc[a][b][m][n] = (f32x4){0.f, 0.f, 0.f, 0.f};
        cur = nxt; cA = nA; cB = nB; ++ui;
        if constexpr (ALIGN_EPI) { if (wr == 1) PG8_BAR; }
    }
    PG8_WAIT_V(0);
    if constexpr (!ALIGN_EPI) { if (wr == 0) PG8_BAR; }
    PG8_BAR;
#undef PG8_SA
#undef PG8_SB
#undef PG8_STAGE
#undef PG8_LDA
#undef PG8_LDB
#undef PG8_MMA
#undef PG8_WAIT_V
#undef PG8_WAIT_L
#undef PG8_BAR
#undef PG8_SCHED
#undef PG8_UPTR
#undef PG8_STAGE_A
#undef PG8_GROWS
}

struct EpiProj {
    static constexpr bool PERM = true;
    bf16 *q, *k, *vT, *p;
    __device__ __forceinline__ void operator()(const f32x4 (&acc)[2][2][4][2], const Unit& u, int wr, int wc, int fr, int fq) const {
        const int row0 = u.pm * BM + wr * 64 + fr;
        const int pn = u.pn;
#pragma unroll
        for (int ai = 0; ai < 2; ++ai)
#pragma unroll
            for (int m = 0; m < 4; ++m) {
                const int row = row0 + ai * HALF + m * 16;
#pragma unroll
                for (int bj = 0; bj < 2; ++bj) {
                    f32x4 v0 = acc[ai][bj][m][0], v1 = acc[ai][bj][m][1];
                    const int col = pn * BM + bj * HALF + wc * 32 + 8 * fq;
                    if (pn >= 4 && pn < 6) {
                        const int cv = col - 1024, hh = cv >> 6, dim = cv & 63, b = row / T, t = row % T;
                        bf16* dst = vT + ((size_t)(((b * NH + hh) * GROWS + (t >> 6)) * HD + dim)) * 64 + (t & 63);
                        const unsigned w0 = cvt_pk_bf16(v0[0], v0[1]), w1 = cvt_pk_bf16(v0[2], v0[3]), w2 = cvt_pk_bf16(v1[0], v1[1]), w3 = cvt_pk_bf16(v1[2], v1[3]);
                        dst[0 * 64] = (bf16)(w0 & 0xffff); dst[1 * 64] = (bf16)(w0 >> 16); dst[2 * 64] = (bf16)(w1 & 0xffff); dst[3 * 64] = (bf16)(w1 >> 16);
                        dst[4 * 64] = (bf16)(w2 & 0xffff); dst[5 * 64] = (bf16)(w2 >> 16); dst[6 * 64] = (bf16)(w3 & 0xffff); dst[7 * 64] = (bf16)(w3 >> 16);
                        asm volatile("s_waitcnt vmcnt(40)" ::: "memory");
                    } else {
                        bf16* dst;
                        if (pn < 2) { v0 = v0 * 0.125f; v1 = v1 * 0.125f; dst = q + (size_t)row * CW + col; }
                        else if (pn < 4) dst = k + (size_t)row * CW + (col - 512);
                        else dst = p + (size_t)row * PW + (col - 1536);
                        u32x4 w; w.x = cvt_pk_bf16(v0[0], v0[1]); w.y = cvt_pk_bf16(v0[2], v0[3]); w.z = cvt_pk_bf16(v1[0], v1[1]); w.w = cvt_pk_bf16(v1[2], v1[3]);
                        *(u32x4*)dst = w;
                    }
                }
            }
    }
};
struct EpiWo {
    static constexpr bool PERM = true;
    const float* x; bf16* h;
    __device__ __forceinline__ void operator()(const f32x4 (&acc)[2][2][4][2], const Unit& u, int wr, int wc, int fr, int fq) const {
        const int row0 = u.pm * BM + wr * 64 + fr, col0 = u.pn * BM + wc * 32 + 8 * fq;
#pragma unroll
        for (int ai = 0; ai < 2; ++ai)
#pragma unroll
            for (int m = 0; m < 4; ++m) { const size_t off = (size_t)(row0 + ai * HALF + m * 16) * D + col0;
#pragma unroll
                for (int bj = 0; bj < 2; ++bj) { const f32x4 v0 = acc[ai][bj][m][0] + *(const f32x4*)(x + off + bj * HALF), v1 = acc[ai][bj][m][1] + *(const f32x4*)(x + off + bj * HALF + 4);
                    u32x4 w; w.x = cvt_pk_bf16(v0[0], v0[1]); w.y = cvt_pk_bf16(v0[2], v0[3]); w.z = cvt_pk_bf16(v1[0], v1[1]); w.w = cvt_pk_bf16(v1[2], v1[3]);
                    *(u32x4*)(h + off + bj * HALF) = w; } }
    }
};
struct EpiUp {
    static constexpr bool PERM = true;
    const float* b_up; unsigned char* act;
    __device__ __forceinline__ void operator()(const f32x4 (&acc)[2][2][4][2], const Unit& u, int wr, int wc, int fr, int fq) const {
        const int row0 = u.pm * BM + wr * 64 + fr, ch = u.pn * 128 + wc * 32 + 8 * fq;
        const float* bg = b_up + (size_t)u.e * 2048 + ch; const float* bl = bg + 1024;
        const f32x4 bg0 = *(const f32x4*)bg * F8_SACT, bg1 = *(const f32x4*)(bg + 4) * F8_SACT, bl0 = *(const f32x4*)bl, bl1 = *(const f32x4*)(bl + 4);
        constexpr float SG = F8_SACT / (F8_SX * F8_SW), SL = 1.0f / (F8_SX * F8_SW), KE = -1.702f * 1.44269504f / F8_SACT;
#pragma unroll
        for (int ai = 0; ai < 2; ++ai)
#pragma unroll
            for (int m = 0; m < 4; ++m) {
                float o[8];
#pragma unroll
                for (int n = 0; n < 2; ++n) { const f32x4 ga = acc[ai][0][m][n], la = acc[ai][1][m][n]; const f32x4 bgn = n ? bg1 : bg0, bln = n ? bl1 : bl0;
#pragma unroll
                    for (int hj = 0; hj < 2; ++hj) {
                        const f32x2 gv = __builtin_elementwise_fma((f32x2){ga[2 * hj], ga[2 * hj + 1]}, (f32x2){SG, SG}, (f32x2){bgn[2 * hj], bgn[2 * hj + 1]});
                        const f32x2 lv = __builtin_elementwise_fma((f32x2){la[2 * hj], la[2 * hj + 1]}, (f32x2){SL, SL}, (f32x2){bln[2 * hj], bln[2 * hj + 1]});
                        const f32x2 gt = {fminf(gv.x, 7.0f * F8_SACT), fminf(gv.y, 7.0f * F8_SACT)};
                        const f32x2 li = {__builtin_amdgcn_fmed3f(lv.x, -7.0f, 7.0f), __builtin_amdgcn_fmed3f(lv.y, -7.0f, 7.0f)};
                        const f32x2 zk = __builtin_elementwise_fma(gt, (f32x2){KE, KE}, (f32x2){-0.0f, -0.0f});
                        const f32x2 ez = {__builtin_amdgcn_exp2f(zk.x), __builtin_amdgcn_exp2f(zk.y)};
                        const f32x2 den = __builtin_elementwise_fma(ez, (f32x2){1.0f, 1.0f}, (f32x2){1.0f, 1.0f});
                        const f32x2 rc = {__builtin_amdgcn_rcpf(den.x), __builtin_amdgcn_rcpf(den.y)};
                        const f32x2 t = __builtin_elementwise_fma(gt, rc, (f32x2){-0.0f, -0.0f});
                        const f32x2 ov = __builtin_elementwise_fma(li, t, t);
                        o[n * 4 + 2 * hj] = ov.x; o[n * 4 + 2 * hj + 1] = ov.y; } }
                int w0 = 0, w1 = 0;
                w0 = __builtin_amdgcn_cvt_pk_fp8_f32(o[0], o[1], w0, false); w0 = __builtin_amdgcn_cvt_pk_fp8_f32(o[2], o[3], w0, true);
                w1 = __builtin_amdgcn_cvt_pk_fp8_f32(o[4], o[5], w1, false); w1 = __builtin_amdgcn_cvt_pk_fp8_f32(o[6], o[7], w1, true);
                u32x2 w8; w8.x = (unsigned)w0; w8.y = (unsigned)w1;
                *(u32x2*)(act + (size_t)(row0 + ai * HALF + m * 16) * DE + ch) = w8;
            }
    }
};
struct EpiDown {
    static constexpr bool PERM = true;
    const float* b_dn; unsigned char* y;
    __device__ __forceinline__ void operator()(const f32x4 (&acc)[2][2][4][2], const Unit& u, int wr, int wc, int fr, int fq) const {
        const int row0 = u.pm * BM + wr * 64 + fr, col0 = u.pn * BM + wc * 32 + 8 * fq;
        const float* bb = b_dn + (size_t)u.e * D + col0;
        f32x4 bv[2][2];
#pragma unroll
        for (int bj = 0; bj < 2; ++bj)
#pragma unroll
            for (int n = 0; n < 2; ++n) bv[bj][n] = *(const f32x4*)(bb + bj * HALF + 4 * n) * F8_SY;
#pragma unroll
        for (int ai = 0; ai < 2; ++ai)
#pragma unroll
            for (int m = 0; m < 4; ++m) { unsigned char* rowp = y + (size_t)(row0 + ai * HALF + m * 16) * D + col0;
#pragma unroll
                for (int bj = 0; bj < 2; ++bj) { const f32x4 v0 = acc[ai][bj][m][0] * (F8_SY / (F8_SACT * F8_SW)) + bv[bj][0], v1 = acc[ai][bj][m][1] * (F8_SY / (F8_SACT * F8_SW)) + bv[bj][1];
                    u32x2 w; w.x = pk4_fp8(v0[0], v0[1], v0[2], v0[3]); w.y = pk4_fp8(v1[0], v1[1], v1[2], v1[3]);
                    *(u32x2*)(rowp + bj * HALF) = w; } }
    }
};
}


#define XB_TMO      128
#define XB_XCNT(j)  (256  + 64 * (j))
#define XB_XSUB(j)  (1280 + 64 * (j))
#define XB_XGEN(j)  (2304 + 64 * (j))
#define XB_TOP      3328
#define XB_TOPGEN   3392
#define XCD_BAR_WORDS 3456
#define XB_SPIN_CAP (1u << 20)
__device__ __forceinline__ unsigned xb_ld(unsigned* p)              { return __hip_atomic_load(p, __ATOMIC_RELAXED, __HIP_MEMORY_SCOPE_AGENT); }
__device__ __forceinline__ unsigned xb_add(unsigned* p, unsigned v) { return __hip_atomic_fetch_add(p, v, __ATOMIC_RELAXED, __HIP_MEMORY_SCOPE_AGENT); }
__device__ __forceinline__ unsigned xb_xcc_id() { return (unsigned)__builtin_amdgcn_s_getreg((3 << 11) | 20) & 0xFu; }
#define XB_SPIN(cond, bar) do { unsigned _sp = 0; while (cond) { __builtin_amdgcn_s_sleep(1); \
    if ((++_sp & 255u) == 0u) { if (xb_ld(&(bar)[XB_TMO])) break; if (_sp > XB_SPIN_CAP) { atomicAdd(&(bar)[XB_TMO], 1u); break; } } } } while (0)
struct XcdBarrier { unsigned* bar; unsigned x; volatile LAS unsigned* st; };
__device__ __forceinline__ XcdBarrier xcd_barrier_post(unsigned* bar, volatile LAS unsigned* st) {
    XcdBarrier b; b.bar = bar; b.x = xb_xcc_id(); b.st = st;
    if (threadIdx.x == 0) (void)xb_add(&bar[XB_XCNT(b.x)], 1u);
    return b;
}
__device__ __forceinline__ void xcd_barrier_complete(unsigned* bar, unsigned x, unsigned& nloc, unsigned& nx) {
    const unsigned G = gridDim.x * gridDim.y * gridDim.z;
    unsigned sum, cnt, mine, sp = 0u;
    for (;;) {
        sum = 0u; cnt = 0u; mine = 0u;
#pragma unroll
        for (unsigned j = 0; j < 16; ++j) { const unsigned c = xb_ld(&bar[XB_XCNT(j)]); sum += c; cnt += (c > 0u) ? 1u : 0u; mine = (j == x) ? c : mine; }
        if (sum == G) break;
        __builtin_amdgcn_s_sleep(1);
        if ((++sp & 255u) == 0u) { if (xb_ld(&bar[XB_TMO])) break; if (sp > XB_SPIN_CAP) { atomicAdd(&bar[XB_TMO], 1u); break; } }
    }
    nloc = mine > 0u ? mine : 1u; nx = cnt > 0u ? cnt : 1u;
}
__device__ __forceinline__ void xcd_barrier(const XcdBarrier& b) {
    asm volatile("s_waitcnt vmcnt(0)" ::: "memory");
    __syncthreads();
    if (threadIdx.x == 0) {
        unsigned* bar = b.bar;
        __builtin_amdgcn_s_waitcnt(0);
        unsigned nloc = b.st[0], nx = b.st[1];
        if (nloc == 0u) { xcd_barrier_complete(bar, b.x, nloc, nx); b.st[0] = nloc; b.st[1] = nx; }
        const unsigned old = xb_add(&bar[XB_XSUB(b.x)], 1u);
        const unsigned gen = old / nloc;
        if (old + 1u == (gen + 1u) * nloc) {
            __builtin_amdgcn_fence(__ATOMIC_RELEASE, "agent");
            asm volatile("s_waitcnt vmcnt(0)" ::: "memory");
            const unsigned og = xb_add(&bar[XB_TOP], 1u);
            const unsigned tg = og / nx;
            if (og + 1u == (tg + 1u) * nx) xb_add(&bar[XB_TOPGEN], 1u);
            else XB_SPIN(xb_ld(&bar[XB_TOPGEN]) == tg, bar);
            __builtin_amdgcn_fence(__ATOMIC_ACQUIRE, "agent");
            xb_add(&bar[XB_XGEN(b.x)], 1u);
            asm volatile("s_waitcnt vmcnt(0)" ::: "memory");
        } else {
            XB_SPIN(xb_ld(&bar[XB_XGEN(b.x)]) == gen, bar);
            __builtin_amdgcn_fence(__ATOMIC_ACQUIRE, "agent");
            asm volatile("s_waitcnt vmcnt(0)" ::: "memory");
        }
    }
    __syncthreads();
}

struct Args { const float* in[26]; float* out; unsigned char* ws; int ph_lo, ph_hi; };

struct Frame { LAS unsigned char* lds; int tid, lane, wave, G, vcu; };

__device__ __forceinline__ void transpose_item(const float* W, int K, int N, bf16* WT, int k0, int n0, int orow0, LAS float* scr, int lane) {
#pragma unroll 8
    for (int i = 0; i < 32; ++i) { const int kk = 2 * i + (lane >> 5); scr[kk * 33 + (lane & 31)] = W[(size_t)(k0 + kk) * N + n0 + (lane & 31)]; }
    asm volatile("s_waitcnt lgkmcnt(0)" ::: "memory");
    const int c = lane & 7;
#pragma unroll
    for (int j = 0; j < 4; ++j) { const int n = (lane >> 3) + 8 * j; const LAS float* s = scr + (8 * c) * 33 + n;
        u32x4 o; o.x = cvt_pk_bf16(s[0 * 33], s[1 * 33]); o.y = cvt_pk_bf16(s[2 * 33], s[3 * 33]); o.z = cvt_pk_bf16(s[4 * 33], s[5 * 33]); o.w = cvt_pk_bf16(s[6 * 33], s[7 * 33]);
        *(u32x4*)(WT + (size_t)(orow0 + n) * K + k0 + 8 * c) = o; }
    asm volatile("s_waitcnt lgkmcnt(0)" ::: "memory");
}

__device__ __forceinline__ void transpose_item8w(const float* W, int K, int N, unsigned char* WT, int k0, int n0, int orow0, LAS float* scr, int lane) {
#pragma unroll 8
    for (int i = 0; i < 64; ++i) { const int kk = 2 * i + (lane >> 5); scr[kk * 33 + (lane & 31)] = W[(size_t)(k0 + kk) * N + n0 + (lane & 31)]; }
    asm volatile("s_waitcnt lgkmcnt(0)" ::: "memory");
    const int c = lane & 7;
#pragma unroll
    for (int j = 0; j < 4; ++j) { const int n = (lane >> 3) + 8 * j; const LAS float* s = scr + (16 * c) * 33 + n;
        u32x4 o; o.x = pk4_fp8(s[0 * 33] * F8_SW, s[1 * 33] * F8_SW, s[2 * 33] * F8_SW, s[3 * 33] * F8_SW); o.y = pk4_fp8(s[4 * 33] * F8_SW, s[5 * 33] * F8_SW, s[6 * 33] * F8_SW, s[7 * 33] * F8_SW);
        o.z = pk4_fp8(s[8 * 33] * F8_SW, s[9 * 33] * F8_SW, s[10 * 33] * F8_SW, s[11 * 33] * F8_SW); o.w = pk4_fp8(s[12 * 33] * F8_SW, s[13 * 33] * F8_SW, s[14 * 33] * F8_SW, s[15 * 33] * F8_SW);
        *(u32x4*)(WT + (size_t)(orow0 + n) * K + k0 + 16 * c) = o; }
    asm volatile("s_waitcnt lgkmcnt(0)" ::: "memory");
}
__device__ __forceinline__ void transpose_item8(const float* W, int K, int N, unsigned char* WT, int k0, int n0, int orow0, LAS float* scr, int lane) {
#pragma unroll 8
    for (int i = 0; i < 32; ++i) { const int kk = 2 * i + (lane >> 5); scr[kk * 33 + (lane & 31)] = W[(size_t)(k0 + kk) * N + n0 + (lane & 31)]; }
    asm volatile("s_waitcnt lgkmcnt(0)" ::: "memory");
    const int c = lane & 7;
#pragma unroll
    for (int j = 0; j < 4; ++j) { const int n = (lane >> 3) + 8 * j; const LAS float* s = scr + (8 * c) * 33 + n;
        u32x2 o; o.x = pk4_fp8(s[0 * 33] * F8_SW, s[1 * 33] * F8_SW, s[2 * 33] * F8_SW, s[3 * 33] * F8_SW); o.y = pk4_fp8(s[4 * 33] * F8_SW, s[5 * 33] * F8_SW, s[6 * 33] * F8_SW, s[7 * 33] * F8_SW);
        *(u32x2*)(WT + (size_t)(orow0 + n) * K + k0 + 8 * c) = o; }
    asm volatile("s_waitcnt lgkmcnt(0)" ::: "memory");
}

constexpr int WC_BLOCKS = 32 * 8 * 8 + 32 * 8 * 4;
#ifndef WC_P0
#define WC_P0 0
#endif
__device__ __forceinline__ void wconv_blocks(const Frame& F, const Args& a, const int lo, const int hi, const int first, const int stride) {
    unsigned char* ws = a.ws;
    {
        constexpr int BI_UP = 32 * 8 * 8, BI_DN = 32 * 8 * 4, WP = 257;
        LAS float* tile = (LAS float*)F.lds;
        const int lane = F.lane, w = F.wave, c = lane & 7;
        for (int bi = lo + first; bi < hi; bi += stride) {
            const bool up = bi < BI_UP; const int r2 = up ? bi : bi - BI_UP;
            const int e = up ? r2 >> 6 : r2 >> 5, q = up ? r2 & 63 : r2 & 31, kb = up ? q >> 3 : q >> 2, nb = up ? q & 7 : q & 3;
            const int N = up ? 2048 : 1024, k0 = kb * 128, n0 = nb * 256;
            const float* W = (up ? a.in[21] + (size_t)e * 1024 * 2048 : a.in[23] + (size_t)e * 1024 * 1024) + (size_t)k0 * N + n0 + 4 * lane;
            unsigned char* WT = (up ? ws + WS_WUPT + (size_t)e * 2048 * 1024 : ws + WS_WDNT + (size_t)e * 1024 * 1024) + k0 + 16 * c;
            __syncthreads();
            f32x4 v[16];
#pragma unroll
            for (int i = 0; i < 16; ++i) v[i] = *(const f32x4*)(W + (size_t)(16 * w + i) * N);
#pragma unroll
            for (int i = 0; i < 16; ++i) { LAS float* t = tile + (16 * w + i) * WP + 4 * lane; t[0] = v[i].x; t[1] = v[i].y; t[2] = v[i].z; t[3] = v[i].w; }
            __syncthreads();
#pragma unroll
            for (int j = 0; j < 4; ++j) { const int nl = 32 * w + (lane >> 3) + 8 * j, n = n0 + nl;
                const int orow = up ? (n < 1024 ? 256 * (n >> 7) + (n & 127) : 256 * ((n - 1024) >> 7) + 128 + ((n - 1024) & 127)) : n;
                const LAS float* sp = tile + (16 * c) * WP + nl;
                u32x4 o; o.x = pk4_fp8(sp[0 * WP] * F8_SW, sp[1 * WP] * F8_SW, sp[2 * WP] * F8_SW, sp[3 * WP] * F8_SW); o.y = pk4_fp8(sp[4 * WP] * F8_SW, sp[5 * WP] * F8_SW, sp[6 * WP] * F8_SW, sp[7 * WP] * F8_SW);
                o.z = pk4_fp8(sp[8 * WP] * F8_SW, sp[9 * WP] * F8_SW, sp[10 * WP] * F8_SW, sp[11 * WP] * F8_SW); o.w = pk4_fp8(sp[12 * WP] * F8_SW, sp[13 * WP] * F8_SW, sp[14 * WP] * F8_SW, sp[15 * WP] * F8_SW);
                *(u32x4*)(WT + (size_t)orow * 1024) = o; }
        }
        __syncthreads(); }
}

__device__ __forceinline__ void p0_prologue(const Frame& F, const Args& a) {
    unsigned char* ws = a.ws;
    LAS float* scr = (LAS float*)(F.lds + F.wave * 8448);
    const int gw = F.vcu * 8 + F.wave, NGW = F.G * 8;
    constexpr int I_IN = 16 * 108, I_L = 16, I_G = 32;
    constexpr int NITEMS = I_IN + 2 * I_L + 2 * I_L + I_G;
    for (int it = gw; it < NITEMS; it += NGW) {
        int r = it;
        if (r < I_IN) { const int kb = r / 108, nb = r % 108; transpose_item(a.in[2], 1024, NPROJ, (bf16*)(ws + WS_WINT), kb * 64, nb * 32, nb * 32, scr, F.lane); continue; }
        r -= I_IN;
        if (r < 2 * I_L) { const int z = r / 16, nb = r % 16; transpose_item(a.in[8] + (size_t)z * 64 * 512, 64, 512, (bf16*)(ws + WS_W2T) + (size_t)z * 512 * 64, 0, nb * 32, nb * 32, scr, F.lane); continue; }
        r -= 2 * I_L;
        if (r < 2 * I_L) { const int z = r / 16, nb = r % 16; transpose_item(a.in[10] + (size_t)z * 64 * 512, 64, 512, (bf16*)(ws + WS_A2T) + (size_t)z * 512 * 64, 0, nb * 32, nb * 32, scr, F.lane); continue; }
        r -= 2 * I_L;
        { const int kb = r / 16, nb = r % 16; transpose_item(a.in[11], 128, 512, (bf16*)(ws + WS_G2T), kb * 64, nb * 32, nb * 32, scr, F.lane); }
    }
    wconv_blocks(F, a, 0, WC_P0, F.vcu, F.G);
    { u32x4* z = (u32x4*)(ws + WS_WINT + (size_t)NPROJ * 1024 * 2); const u32x4 zero = {0u, 0u, 0u, 0u};
      for (int i = F.vcu * 512 + F.tid; i < 16384; i += F.G * 512) z[i] = zero; }
    const float* x = a.in[0]; const float* nw = a.in[1]; bf16* hn = (bf16*)(ws + WS_HN);
    f32x4 wv[4];
#pragma unroll
    for (int j = 0; j < 4; ++j) wv[j] = *((const f32x4*)nw + F.lane + 64 * j);
    for (int m = gw; m < M; m += 2 * NGW) {
        const int m1 = m + NGW; const bool has1 = m1 < M;
        const f32x4* xr0 = (const f32x4*)(x + (size_t)m * D) + F.lane; const f32x4* xr1 = (const f32x4*)(x + (size_t)(has1 ? m1 : m) * D) + F.lane;
        f32x4 v0[4], v1[4]; float s0 = 0.f, s1 = 0.f;
#pragma unroll
        for (int j = 0; j < 4; ++j) { v0[j] = xr0[64 * j]; v1[j] = xr1[64 * j]; }
#pragma unroll
        for (int j = 0; j < 4; ++j) { s0 += (v0[j].x * v0[j].x + v0[j].y * v0[j].y) + (v0[j].z * v0[j].z + v0[j].w * v0[j].w); s1 += (v1[j].x * v1[j].x + v1[j].y * v1[j].y) + (v1[j].z * v1[j].z + v1[j].w * v1[j].w); }
        const float rs0 = rsqrtf(wave_sum(s0) * (1.f / D) + RMS_EPS), rs1 = rsqrtf(wave_sum(s1) * (1.f / D) + RMS_EPS);
        u32x2* o0 = (u32x2*)(hn + (size_t)m * D) + F.lane; u32x2* o1 = (u32x2*)(hn + (size_t)m1 * D) + F.lane;
#pragma unroll
        for (int j = 0; j < 4; ++j) { u32x2 o; o.x = cvt_pk_bf16(v0[j].x * rs0 * wv[j].x, v0[j].y * rs0 * wv[j].y); o.y = cvt_pk_bf16(v0[j].z * rs0 * wv[j].z, v0[j].w * rs0 * wv[j].w); o0[64 * j] = o; }
        if (has1) {
#pragma unroll
            for (int j = 0; j < 4; ++j) { u32x2 o; o.x = cvt_pk_bf16(v1[j].x * rs1 * wv[j].x, v1[j].y * rs1 * wv[j].y); o.y = cvt_pk_bf16(v1[j].z * rs1 * wv[j].z, v1[j].w * rs1 * wv[j].w); o1[64 * j] = o; } }
    }
}

constexpr int PREP_KBUF = 0, PREP_INV = 65536, PREP_AW = 67584, PREP_AA = PREP_AW + 17408, PREP_AG = PREP_AA + 17408, PREP_LD = 136, PREP_MU = PREP_AG + 17408  , PREP_PAR = PREP_MU + 15360  ;
template <bool STORE>
__device__ __forceinline__ void prep_phase(const Frame& F, const Args& a) {
    unsigned char* ws = a.ws;
    const bf16* p = (const bf16*)(ws + WS_P);
    bf16* r_out = (bf16*)(ws + WS_R); bf16* v_out = (bf16*)(ws + WS_V); bf16* kk_out = (bf16*)(ws + WS_KK);
    bf16* decay_out = (bf16*)(ws + WS_DECAY); bf16* kdir_out = (bf16*)(ws + WS_KDIR); bf16* akk_out = (bf16*)(ws + WS_AKK); bf16* g_out = (bf16*)(ws + WS_G);
    const bf16* w2T = (const bf16*)(ws + WS_W2T); const bf16* a2T = (const bf16*)(ws + WS_A2T); const bf16* g2T = (const bf16*)(ws + WS_G2T);
    const float* mu_p = a.in[5]; const float* mu_n = a.in[6]; const float* w0 = a.in[7]; const float* a0 = a.in[9];
    const float* k_k = a.in[12]; const float* k_a = a.in[13];
    LAS bf16* kbuf = (LAS bf16*)(F.lds + PREP_KBUF); LAS float* invb = (LAS float*)(F.lds + PREP_INV);
    LAS bf16* Aw = (LAS bf16*)(F.lds + PREP_AW); LAS bf16* Aa = (LAS bf16*)(F.lds + PREP_AA); LAS bf16* Ag = (LAS bf16*)(F.lds + PREP_AG);
    const int lane = F.lane, wave = F.wave, fr = lane & 15, fg = lane >> 4;
    LAS float* mul = (LAS float*)(F.lds + PREP_MU);
    for (int i = F.tid; i < 1920; i += 512) { mul[i] = mu_p[i]; mul[1920 + i] = mu_n[i]; }
    LAS float* par = (LAS float*)(F.lds + PREP_PAR);
    { const int i = F.tid; par[i] = k_k[i]; par[512 + i] = k_a[i]; par[1024 + i] = w0[i]; par[1536 + i] = w0[512 + i]; par[2048 + i] = a0[i]; par[2560 + i] = a0[512 + i]; }
    __syncthreads();
    for (int tile = F.vcu; tile < M / 64; tile += F.G) {
        const int m0 = tile * 64;
        int lane_o = F.lane; asm volatile("" : "+v"(lane_o));
        const int lane = lane_o, fr = lane & 15, fg = lane >> 4;
        const int mfirst = m0 + wave * 8;
        const u32x4 zero = {0u, 0u, 0u, 0u};
        u32x4 rowsN[10];
#define PREP_LOAD(jj_) do { const int q_ = lane + 64 * (jj_); const bool v_ = q_ < 240; const int c_ = 8 * q_; \
            _Pragma("unroll") for (int rI = 0; rI < 10; ++rI) { const int mr = mfirst - 1 + rI; \
                const bool ok = v_ && !(rI == 0 && (mfirst % T) == 0) && !(rI == 9 && ((mfirst + 7) % T) == T - 1); \
                rowsN[rI] = ok ? *(const u32x4*)(p + (size_t)mr * PW + c_) : zero; } } while (0)
        PREP_LOAD(0);
#pragma unroll 1
        for (int jj = 0; jj < 4; ++jj) {
            const int q = lane + 64 * jj; const bool valid = q < 240; const int c0 = 8 * q;
            float mp[8], mn[8];
            u32x4 rows[10];
            { const int cl = valid ? c0 : 0; const f32x4 a0_ = *(const LAS f32x4*)(mul + cl), a1_ = *(const LAS f32x4*)(mul + cl + 4), b0_ = *(const LAS f32x4*)(mul + 1920 + cl), b1_ = *(const LAS f32x4*)(mul + 1920 + cl + 4);
#pragma unroll
              for (int i = 0; i < 4; ++i) { mp[i] = valid ? a0_[i] : 0.f; mp[4 + i] = valid ? a1_[i] : 0.f; mn[i] = valid ? b0_[i] : 0.f; mn[4 + i] = valid ? b1_[i] : 0.f; } }
#pragma unroll
            for (int rI = 0; rI < 10; ++rI) rows[rI] = rowsN[rI];
            if (jj < 3) PREP_LOAD(jj + 1);
#pragma unroll
            for (int i = 0; i < 8; ++i) {
                const int m = mfirst + i, it = wave * 8 + i;
                const u32x4 prev = rows[i], cur = rows[i + 1], nxt = rows[i + 2];
                float fp[8], fc[8], fn[8], s[8];
                unpack8(prev, fp); unpack8(cur, fc); unpack8(nxt, fn);
#pragma unroll
                for (int e = 0; e < 8; ++e) s[e] = fc[e] + mp[e] * (fp[e] - fc[e]) + mn[e] * (fn[e] - fc[e]);
                if (jj == 0) { if (STORE) { *(u32x4*)(r_out + (size_t)m * CW + c0) = pack8(s); } }
                else if (jj == 1) {
                    const int c = c0 - 512;
                    *(LAS u32x4*)(kbuf + it * 512 + c) = pack8(s);
                    float kr[8]; float ss = 0.f;
#pragma unroll
                    for (int e = 0; e < 8; ++e) { kr[e] = s[e] * k_k[c + e]; ss += kr[e] * kr[e]; }
                    ss += __shfl_xor(ss, 1); ss += __shfl_xor(ss, 2); ss += __shfl_xor(ss, 4);
                    const float inv = fminf(__builtin_amdgcn_rsqf(ss), 1e12f);
#pragma unroll
                    for (int e = 0; e < 8; ++e) kr[e] *= inv;
                    if (STORE) { *(u32x4*)(kk_out + (size_t)m * CW + c) = pack8(kr); }
                    if ((lane & 7) == 0) invb[it * 8 + (lane >> 3)] = inv;
                }
                else if (jj == 2) { if (STORE) { *(u32x4*)(v_out + (size_t)m * CW + (c0 - 1024)) = pack8(s); } }
                else if (valid) {
                    const int seg = lane >> 4, cw = 8 * (lane & 15);
                    if (seg == 0) {
#pragma unroll
                        for (int e = 0; e < 8; ++e) s[e] = 1.0f - 2.0f * __builtin_amdgcn_rcpf(__expf(2.0f * s[e]) + 1.0f);
                        *(LAS u32x4*)(Aw + it * PREP_LD + cw) = pack8(s);
                    } else if (seg == 1) { *(LAS u32x4*)(Aa + it * PREP_LD + cw) = pack8(s); }
                    else {
#pragma unroll
                        for (int e = 0; e < 8; ++e) s[e] = sigmoidf_(s[e]);
                        *(LAS u32x4*)(Ag + it * PREP_LD + cw) = pack8(s);
                    }
                }
            }
        }
        const int nb = 64 * wave;
#define PREP_PROW(nt_) (nb + 32 * ((nt_) >> 1) + 8 * (fr >> 2) + 4 * ((nt_) & 1) + (fr & 3))
#define PREP_COL(nt_)  (nb + 32 * ((nt_) >> 1) + 8 * fg + 4 * ((nt_) & 1))
        bf16x8 wf[2][4];
#define PREP_JLOAD(job_) do { const int z_ = (job_) & 1; const bf16* WT_ = (job_) < 2 ? w2T + (size_t)z_ * 512 * 64 : a2T + (size_t)z_ * 512 * 64; \
            _Pragma("unroll") for (int ks = 0; ks < 2; ++ks) _Pragma("unroll") for (int nt = 0; nt < 4; ++nt) wf[ks][nt] = *(const bf16x8*)(WT_ + (size_t)PREP_PROW(nt) * 64 + 32 * ks + 8 * fg); \
            } while (0)
        PREP_JLOAD(0);
        __syncthreads();
#pragma unroll 1
        for (int job = 0; job < 4; ++job) {
            const int z = job & 1;
            const LAS bf16* Ax = job < 2 ? Aw + z * 64 : Aa + z * 64;
            f32x4 pb[4];
            f32x4 acc[4][4];
#pragma unroll
            for (int mt = 0; mt < 4; ++mt)
#pragma unroll
                for (int nt = 0; nt < 4; ++nt) acc[mt][nt] = (f32x4){0.f, 0.f, 0.f, 0.f};
#pragma unroll
            for (int ks = 0; ks < 2; ++ks) {
                bf16x8 af[4];
#pragma unroll
                for (int mt = 0; mt < 4; ++mt) af[mt] = *(const LAS bf16x8*)(Ax + (16 * mt + fr) * PREP_LD + 32 * ks + 8 * fg);
#pragma unroll
                for (int mt = 0; mt < 4; ++mt)
#pragma unroll
                    for (int nt = 0; nt < 4; ++nt) acc[mt][nt] = __builtin_amdgcn_mfma_f32_16x16x32_bf16(wf[ks][nt], af[mt], acc[mt][nt], 0, 0, 0);
            }
            if (job < 3) PREP_JLOAD(job + 1);
            f32x4 pkk[4], pka[4];
#pragma unroll
            for (int nt = 0; nt < 4; ++nt) { const int n = PREP_COL(nt); pb[nt] = *(const LAS f32x4*)(par + 1024 + (job < 2 ? 0 : 1024) + z * 512 + n); pkk[nt] = *(const LAS f32x4*)(par + n); pka[nt] = *(const LAS f32x4*)(par + 512 + n); }
#pragma unroll
            for (int mt = 0; mt < 4; ++mt) {
                const int it = 16 * mt + fr; const size_t m = (size_t)(m0 + it);
#pragma unroll
                for (int np = 0; np < 2; ++np) {
                    const int c8 = nb + 32 * np + 8 * fg;
                    if (job < 2) {
                        float o[8];
#pragma unroll
                        for (int hh = 0; hh < 2; ++hh) { const f32x4 v = acc[mt][2 * np + hh], bq = pb[2 * np + hh];
#pragma unroll
                            for (int i = 0; i < 4; ++i) o[4 * hh + i] = __expf(-0.60653066f * sigmoidf_(v[i] + bq[i])); }
                        if (STORE) { *(u32x4*)(decay_out + ((size_t)z * M + m) * CW + c8) = pack8(o); }
                    } else {
                        const u32x4 kb = *(const LAS u32x4*)(kbuf + it * 512 + c8);
                        float kv[8]; unpack8(kb, kv);
                        const float inv = invb[it * 8 + wave];
                        float kd[8], ak[8];
#pragma unroll
                        for (int hh = 0; hh < 2; ++hh) { const f32x4 v = acc[mt][2 * np + hh], bq = pb[2 * np + hh], kkc = pkk[2 * np + hh], kac = pka[2 * np + hh];
#pragma unroll
                            for (int i = 0; i < 4; ++i) { const float av = sigmoidf_(v[i] + bq[i]), kx = kv[4 * hh + i]; kd[4 * hh + i] = kx * (1.0f + (av - 1.0f) * kac[i]); ak[4 * hh + i] = av * (kx * kkc[i] * inv); } }
                        if (STORE) { *(u32x4*)(kdir_out + ((size_t)z * M + m) * CW + c8) = pack8(kd); *(u32x4*)(akk_out + ((size_t)z * M + m) * CW + c8) = pack8(ak); }
                    }
                }
            }
        }
        {
            bf16x8 wf[4][4];
#pragma unroll
            for (int ks = 0; ks < 4; ++ks)
#pragma unroll
                for (int nt = 0; nt < 4; ++nt) wf[ks][nt] = *(const bf16x8*)(g2T + (size_t)PREP_PROW(nt) * 128 + 32 * ks + 8 * fg);
            f32x4 acc[4][4];
#pragma unroll
            for (int mt = 0; mt < 4; ++mt)
#pragma unroll
                for (int nt = 0; nt < 4; ++nt) acc[mt][nt] = (f32x4){0.f, 0.f, 0.f, 0.f};
#pragma unroll
            for (int ks = 0; ks < 4; ++ks) {
                bf16x8 af[4];
#pragma unroll
                for (int mt = 0; mt < 4; ++mt) af[mt] = *(const LAS bf16x8*)(Ag + (16 * mt + fr) * PREP_LD + 32 * ks + 8 * fg);
#pragma unroll
                for (int mt = 0; mt < 4; ++mt)
#pragma unroll
                    for (int nt = 0; nt < 4; ++nt) acc[mt][nt] = __builtin_amdgcn_mfma_f32_16x16x32_bf16(wf[ks][nt], af[mt], acc[mt][nt], 0, 0, 0);
            }
#pragma unroll
            for (int mt = 0; mt < 4; ++mt) { const size_t m = (size_t)(m0 + 16 * mt + fr);
#pragma unroll
                for (int np = 0; np < 2; ++np) { const f32x4 v0 = acc[mt][2 * np], v1 = acc[mt][2 * np + 1];
                    u32x4 w; w.x = cvt_pk_bf16(v0[0], v0[1]); w.y = cvt_pk_bf16(v0[2], v0[3]); w.z = cvt_pk_bf16(v1[0], v1[1]); w.w = cvt_pk_bf16(v1[2], v1[3]);
                    if (STORE) { *(u32x4*)(g_out + m * CW + nb + 32 * np + 8 * fg) = w; } } }
        }
#undef PREP_PROW
#undef PREP_COL
#undef PREP_LOAD
#undef PREP_JLOAD
        __syncthreads();
    }
}

constexpr int AT_K = 0, AT_V = 73728, AT_B = 147456;
__device__ __forceinline__ void attn_phase(const Frame& F, const Args& a, const int widx, const int nworkers) {
    unsigned char* ws = a.ws;
    const bf16* q = (const bf16*)(ws + WS_Q); const bf16* k = (const bf16*)(ws + WS_K); const bf16* vT = (const bf16*)(ws + WS_VT);
    bf16* att = (bf16*)(ws + WS_ATT);
    LAS unsigned char* L = F.lds;
    LAS float* bias = (LAS float*)(L + AT_B) + 16;
    const int tid = F.tid, lane = F.lane, fr = lane & 15, fg = lane >> 4, wave = F.wave;
    const int per = (16384 + nworkers * 8 - 1) / (nworkers * 8);
    const int base = widx * (8 * per);
    const int ltok = tid >> 3, lc = tid & 7;
    const int wK = AT_K + ltok * 128 + ((lc ^ ((((ltok >> 3) & 3) << 1) | ((ltok >> 1) & 1))) << 4), wV = AT_V + ltok * 128 + ((lc ^ ((ltok >> 1) & 7)) << 4);
    u32x4 kreg[9], vreg[9]; bf16x8 qn[2]; float breg = 0.f;
#define AT_ISSUE(it_) do { const int t0_ = base + (it_) * 8; if ((it_) < per && t0_ < 16384) { \
        const int r0_ = (t0_ >> 2) & 127, h_ = (t0_ >> 9) & 7, b_ = t0_ >> 12, R0_ = min(max(r0_ - 4, 0), GROWS - 8); \
        const bf16* kp_ = k + ((size_t)b_ * T + R0_ * 64 + ltok) * CW + h_ * 64 + lc * 8; \
        const bf16* vp_ = vT + ((size_t)((b_ * NH + h_) * GROWS + R0_)) * (HD * 64) + tid * 8; \
        _Pragma("unroll") for (int j = 0; j < 9; ++j) { const int jj = min(j, GROWS - 1 - R0_); kreg[j] = *(const u32x4*)(kp_ + (size_t)jj * 64 * CW); vreg[j] = *(const u32x4*)(vp_ + (size_t)jj * (HD * 64)); } \
        if (tid < 465) breg = a.in[3][h_ * 465 + tid]; \
        const size_t tq_ = (size_t)b_ * T + (r0_ + (wave >> 2)) * 64 + 16 * (wave & 3) + fr; \
        _Pragma("unroll") for (int ks = 0; ks < 2; ++ks) qn[ks] = *(const bf16x8*)(q + tq_ * CW + h_ * 64 + 32 * ks + 8 * fg); } } while (0)
    AT_ISSUE(0);
    for (int it = 0; it < per; ++it) {
        const int task0 = base + it * 8; if (task0 >= 16384) break;
        const int cgp = wave & 3, r0 = (task0 >> 2) & 127, r = r0 + (wave >> 2), h = (task0 >> 9) & 7, b = task0 >> 12, R0 = min(max(r0 - 4, 0), GROWS - 8);
        const int c0 = 16 * cgp, wsc = min(max(c0 - 8, 0), 32), rs = min(max(r - 4, 0), GROWS - 8);
        const int c = c0 + fr, cs = min(max(c - 8, 0), 48);
        const size_t tq = (size_t)b * T + r * 64 + c;
        __syncthreads();
#pragma unroll
        for (int j = 0; j < 9; ++j) { *(LAS u32x4*)(L + wK + j * 8192) = kreg[j]; *(LAS u32x4*)(L + wV + j * 8192) = vreg[j]; }
        if (tid < 465) bias[tid] = breg;
        const bf16x8 qf0 = qn[0], qf1 = qn[1];
        __syncthreads();
        f32x4 sc[16];
        const int kcol_a = wsc + 8 * (fr >> 2) + (fr & 3);
        const int jr0 = rs - R0;
        int offK[2];
#pragma unroll
        for (int par = 0; par < 2; ++par) { const int tok = kcol_a + 4 * par; offK[par] = AT_K + jr0 * 8192 + tok * 128 + ((fg ^ ((((tok >> 3) & 3) << 1) | ((tok >> 1) & 1))) << 4); }
#pragma unroll
        for (int t = 0; t < 16; ++t) { const int u = t >> 1, par = t & 1;
            const bf16x8 kf0 = *(const LAS bf16x8*)(L + offK[par] + u * 8192), kf1 = *(const LAS bf16x8*)(L + (offK[par] ^ 64) + u * 8192);
            f32x4 s = {0.f, 0.f, 0.f, 0.f};
            s = __builtin_amdgcn_mfma_f32_16x16x32_bf16(kf0, qf0, s, 0, 0, 0);
            s = __builtin_amdgcn_mfma_f32_16x16x32_bf16(kf1, qf1, s, 0, 0, 0);
            sc[t] = s; }
        AT_ISSUE(it + 1);
        bool okm[8];
#pragma unroll
        for (int pi = 0; pi < 8; ++pi) { const int kc = wsc + 8 * fg + pi; okm[pi] = (kc >= cs) && (kc < cs + 16); }
        const LAS float* brow = bias + (rs - r + 7) * 31 + (wsc + 8 * fg - c + 15);
        float mx = -1e30f;
#pragma unroll
        for (int u = 0; u < 8; ++u)
#pragma unroll
            for (int pi = 0; pi < 8; ++pi) { const float s = okm[pi] ? sc[2 * u + (pi >> 2)][pi & 3] + brow[31 * u + pi] : -1e30f; sc[2 * u + (pi >> 2)][pi & 3] = s; mx = fmaxf(mx, s); }
        mx = fmaxf(mx, __shfl_xor(mx, 16)); mx = fmaxf(mx, __shfl_xor(mx, 32));
        float sum = 0.f;
        const float mxl = -mx * 1.44269504f;
#pragma unroll
        for (int t = 0; t < 16; ++t)
#pragma unroll
            for (int i = 0; i < 4; ++i) { const float pv = __builtin_amdgcn_exp2f(__builtin_fmaf(sc[t][i], 1.44269504f, mxl)); sc[t][i] = pv; sum += pv; }
        sum += __shfl_xor(sum, 16); sum += __shfl_xor(sum, 32);
        const float inv = 1.0f / sum;
        f32x4 o[4];
#pragma unroll
        for (int nt = 0; nt < 4; ++nt) o[nt] = (f32x4){0.f, 0.f, 0.f, 0.f};
        const int offV = AT_V + jr0 * 8192 + fr * 128 + ((((wsc >> 3) + fg) ^ ((fr >> 1) & 7)) << 4);
#pragma unroll
        for (int u = 0; u < 8; ++u) {
            union { u32x4 w; bf16x8 h8; } pf;
            pf.w.x = cvt_pk_bf16(sc[2 * u][0], sc[2 * u][1]); pf.w.y = cvt_pk_bf16(sc[2 * u][2], sc[2 * u][3]);
            pf.w.z = cvt_pk_bf16(sc[2 * u + 1][0], sc[2 * u + 1][1]); pf.w.w = cvt_pk_bf16(sc[2 * u + 1][2], sc[2 * u + 1][3]);
#pragma unroll
            for (int nt = 0; nt < 4; ++nt) { const bf16x8 vf = *(const LAS bf16x8*)(L + offV + u * 8192 + nt * 2048); o[nt] = __builtin_amdgcn_mfma_f32_16x16x32_bf16(vf, pf.h8, o[nt], 0, 0, 0); } }
#pragma unroll
        for (int nt = 0; nt < 4; ++nt) { u32x2 w; w.x = cvt_pk_bf16(o[nt][0] * inv, o[nt][1] * inv); w.y = cvt_pk_bf16(o[nt][2] * inv, o[nt][3] * inv);
            *(u32x2*)(att + tq * CW + h * 64 + 16 * nt + 4 * fg) = w; }
    }
#undef AT_ISSUE
    __syncthreads();
}

__device__ __forceinline__ void side_phase(const Frame& F, const Args& a, const int widx, const int nworkers) {
    {
        LAS float* scr = (LAS float*)(F.lds + F.wave * 8448);
        for (int it = widx * 8 + F.wave; it < 16 * 32; it += nworkers * 8) { const int kb = it / 32, nb = it % 32; transpose_item(a.in[17], 1024, 1024, (bf16*)(a.ws + WS_WOT), kb * 64, nb * 32, nb * 32, scr, F.lane); } }
    {
        const float* rw = a.in[19]; bf16* ih = (bf16*)(a.ws + WS_RTIMG); bf16* il = ih + 32 * RT_PITCH;
        for (int idx = widx * 512 + F.tid; idx < 32768; idx += nworkers * 512) { const int e = idx & 31, d = idx >> 5; const float w = rw[idx];
            const unsigned hb = cvt_pk_bf16(w, 0.f) & 0xffffu; const float lo = w - __uint_as_float(hb << 16);
            ih[e * RT_PITCH + d] = (bf16)hb; il[e * RT_PITCH + d] = (bf16)cvt_pk_bf16(lo, 0.f); } }
    attn_phase(F, a, widx, nworkers);
    wconv_blocks(F, a, WC_P0, WC_BLOCKS, widx, nworkers);
}

__device__ __forceinline__ float row16_sum(float v) {
    v += __builtin_bit_cast(float, __builtin_amdgcn_update_dpp(0, __builtin_bit_cast(int, v), 0xB1, 0xF, 0xF, true));
    v += __builtin_bit_cast(float, __builtin_amdgcn_update_dpp(0, __builtin_bit_cast(int, v), 0x4E, 0xF, 0xF, true));
    v += __builtin_bit_cast(float, __builtin_amdgcn_update_dpp(0, __builtin_bit_cast(int, v), 0x141, 0xF, 0xF, true));
    v += __builtin_bit_cast(float, __builtin_amdgcn_update_dpp(0, __builtin_bit_cast(int, v), 0x140, 0xF, 0xF, true));
    return v;
}
constexpr int CS_R = 8;
constexpr int CS_NCH = 2, CS_NPR = 6;
constexpr int CS_AT = 0, CS_RT = 2304, CS_KHT = 4608, CS_BHT = 6656, CS_VT = 8704  , CS_TT = 10752, CS_AAK = 11264, CS_ARK = 11776, CS_ARB = 12288, CS_PL = 12800, CS_SLOT = 13056;
constexpr int CS_LD = 72;
constexpr int CS_SCR = CS_R * CS_SLOT  , CS_SCRW = 2304 * 2  , CS_FLAG = CS_SCR + CS_NPR * CS_SCRW  ;
__device__ __forceinline__ bf16 f2bf(float f) { return (bf16)cvt_pk_bf16(f, 0.f); }
struct ChainOps { u32x2 a4[4], r4[4], kh[4], bh[4], aak, ark, arb, tt, vb; f32x4 pl[4]; };
__device__ __forceinline__ void chain_load(const LAS unsigned char* sl, int fr, int fg, int c, ChainOps& o) {
    const int o16 = fr * 32 + fg * 8;
    const LAS unsigned char* pa = sl + CS_AT + fr * (CS_LD * 2) + fg * 8; const LAS unsigned char* pr = sl + CS_RT + fr * (CS_LD * 2) + fg * 8;
#pragma unroll
    for (int kq = 0; kq < 4; ++kq) { o.a4[kq] = *(const LAS u32x2*)(pa + 32 * kq); o.r4[kq] = *(const LAS u32x2*)(pr + 32 * kq); }
    o.aak = *(const LAS u32x2*)(sl + CS_AAK + o16); o.ark = *(const LAS u32x2*)(sl + CS_ARK + o16); o.arb = *(const LAS u32x2*)(sl + CS_ARB + o16); o.tt = *(const LAS u32x2*)(sl + CS_TT + o16);
    o.vb = *(const LAS u32x2*)(sl + CS_VT + c * 512 + o16);
#pragma unroll
    for (int mt = 0; mt < 4; ++mt) { o.pl[mt] = *(const LAS f32x4*)(sl + CS_PL + (16 * mt + 4 * fg) * 4);
        o.kh[mt] = *(const LAS u32x2*)(sl + CS_KHT + 512 * mt + o16); o.bh[mt] = *(const LAS u32x2*)(sl + CS_BHT + 512 * mt + o16); }
}
__device__ __forceinline__ f32x4 chain_compute(const ChainOps& o, f32x4 (&zacc)[4]) {
#define CS_M32(A_, B_, C_) __builtin_amdgcn_mfma_f32_16x16x32_bf16(A_, B_, C_, 0, 0, 0)
#define CS_M16(A_, B_, C_) __builtin_amdgcn_mfma_f32_16x16x16bf16_1k(__builtin_bit_cast(s16x4, A_), __builtin_bit_cast(s16x4, B_), C_, 0, 0, 0)
    union { u32x4 w; bf16x8 h8; } zb0, zb1, ap0, ap1, rp0, rp1;
    zb0.w.x = cvt_pk_bf16(zacc[0][0], zacc[0][1]); zb0.w.y = cvt_pk_bf16(zacc[0][2], zacc[0][3]); zb0.w.z = cvt_pk_bf16(zacc[1][0], zacc[1][1]); zb0.w.w = cvt_pk_bf16(zacc[1][2], zacc[1][3]);
    zb1.w.x = cvt_pk_bf16(zacc[2][0], zacc[2][1]); zb1.w.y = cvt_pk_bf16(zacc[2][2], zacc[2][3]); zb1.w.z = cvt_pk_bf16(zacc[3][0], zacc[3][1]); zb1.w.w = cvt_pk_bf16(zacc[3][2], zacc[3][3]);
    ap0.w = (u32x4){o.a4[0].x, o.a4[0].y, o.a4[1].x, o.a4[1].y}; ap1.w = (u32x4){o.a4[2].x, o.a4[2].y, o.a4[3].x, o.a4[3].y};
    rp0.w = (u32x4){o.r4[0].x, o.r4[0].y, o.r4[1].x, o.r4[1].y}; rp1.w = (u32x4){o.r4[2].x, o.r4[2].y, o.r4[3].x, o.r4[3].y};
    const f32x4 zero4 = {0.f, 0.f, 0.f, 0.f};
    f32x4 Wc = CS_M16(o.aak, o.vb, zero4);
    Wc = CS_M32(ap0.h8, zb0.h8, Wc); Wc = CS_M32(ap1.h8, zb1.h8, Wc);
    f32x4 Yc = CS_M16(o.ark, o.vb, zero4);
    Yc = CS_M32(rp0.h8, zb0.h8, Yc); Yc = CS_M32(rp1.h8, zb1.h8, Yc);
    f32x4 zz[4];
#pragma unroll
    for (int mt = 0; mt < 4; ++mt) zz[mt] = CS_M16(o.kh[mt], o.vb, zacc[mt] * o.pl[mt]);
    u32x2 wb, ub;
    wb.x = cvt_pk_bf16(Wc[0], Wc[1]); wb.y = cvt_pk_bf16(Wc[2], Wc[3]);
    const f32x4 Uc = CS_M16(o.tt, wb, zero4);
    ub.x = cvt_pk_bf16(Uc[0], Uc[1]); ub.y = cvt_pk_bf16(Uc[2], Uc[3]);
    Yc = CS_M16(o.arb, ub, Yc);
#pragma unroll
    for (int mt = 0; mt < 4; ++mt) zacc[mt] = CS_M16(o.bh[mt], ub, zz[mt]);
#undef CS_M32
#undef CS_M16
    return Yc;
}
template <int z>
__device__ __forceinline__ void scan_phase_z(const Frame& F, const Args& a, const int seq, const int half) {
    unsigned char* ws = a.ws;
    const int b = (seq >> 3) & 3, h = seq & 7;
    const size_t mb = (size_t)b * T;
    const int lane = F.lane, wave = F.wave, fr = lane & 15, fg = lane >> 4;
    constexpr int NCK = T / 16;
    volatile LAS unsigned* flg = (volatile LAS unsigned*)(F.lds + CS_FLAG);
    if (F.tid < 16) flg[F.tid] = 0u;
    __syncthreads();
    const int o16 = fr * 32 + fg * 8;
#define CS_M32(A_, B_, C_) __builtin_amdgcn_mfma_f32_16x16x32_bf16(A_, B_, C_, 0, 0, 0)
#define CS_M16(A_, B_, C_) __builtin_amdgcn_mfma_f32_16x16x16bf16_1k(__builtin_bit_cast(s16x4, A_), __builtin_bit_cast(s16x4, B_), C_, 0, 0, 0)
    if (wave < CS_NCH) {
        const int c = wave, rg = 2 * half + c;
        __builtin_amdgcn_s_setprio(3);
        bf16* yout = (bf16*)(ws + WS_Y) + (size_t)z * M * CW + h * 64 + rg * 16 + fr;
        f32x4 zacc[4];
#pragma unroll
        for (int mt = 0; mt < 4; ++mt) zacc[mt] = (f32x4){0.f, 0.f, 0.f, 0.f};
        ChainOps opA, opB;
#define CS_READY(nn) do { unsigned sp_ = 0; while (flg[(nn) & (CS_R - 1)] != (unsigned)((nn) + 1)) { __builtin_amdgcn_s_sleep(1); if (++sp_ > (1u << 24)) break; } __builtin_amdgcn_fence(__ATOMIC_ACQUIRE, "workgroup"); } while (0)
#define CS_HANDBACK(nn) do { asm volatile("s_waitcnt lgkmcnt(0)" ::: "memory"); if (lane == 0) flg[8 + c] = (unsigned)((nn) + 1); asm volatile("" ::: "memory"); } while (0)
#define CS_YSTORE(nn, Y_) do { asm volatile("s_waitcnt vmcnt(24)" ::: "memory");   _Pragma("unroll") for (int rr = 0; rr < 4; ++rr) { const int q_ = 16 * (nn) + 4 * fg + rr, t_ = z ? (T - 1 - q_) : q_; yout[(mb + t_) * CW] = f2bf((Y_)[rr]); } } while (0)
        CS_READY(0); chain_load(F.lds, fr, fg, c, opA);
#pragma unroll 1
        for (int n = 0; n < NCK; n += 2) {
            CS_READY(n + 1); CS_HANDBACK(n);
            chain_load(F.lds + ((n + 1) & (CS_R - 1)) * CS_SLOT, fr, fg, c, opB);
            { const f32x4 Yc = chain_compute(opA, zacc); CS_YSTORE(n, Yc); }
            if (n + 2 < NCK) CS_READY(n + 2);
            CS_HANDBACK(n + 1);
            if (n + 2 < NCK) chain_load(F.lds + ((n + 2) & (CS_R - 1)) * CS_SLOT, fr, fg, c, opA);
            { const f32x4 Yc = chain_compute(opB, zacc); CS_YSTORE(n + 1, Yc); }
        }
#undef CS_READY
#undef CS_HANDBACK
#undef CS_YSTORE
        __builtin_amdgcn_s_setprio(0);
    } else {
        const int pi = wave - CS_NCH;
        LAS unsigned char* scr = F.lds + CS_SCR + pi * CS_SCRW;
        LAS bf16* KT = (LAS bf16*)scr; LAS bf16* BT = (LAS bf16*)(scr + 2304);
        const bf16* gw_ = (const bf16*)(ws + WS_DECAY) + (size_t)z * M * CW + h * 64;
        const bf16* gkk = (const bf16*)(ws + WS_KK) + h * 64;
        const bf16* gak = (const bf16*)(ws + WS_AKK) + (size_t)z * M * CW + h * 64;
        const bf16* gk = (const bf16*)(ws + WS_KDIR) + (size_t)z * M * CW + h * 64;
        const bf16* gr = (const bf16*)(ws + WS_R) + h * 64;
        const bf16* gv = (const bf16*)(ws + WS_V) + h * 64 + half * 32 + (lane & 31);
        const int hf = lane >> 5, cp = lane & 31;
        unsigned xw[8], xkk[8], xak[8], xk[8], xr[8], nv[8];
        constexpr long RSTEP = z ? -(long)CW : (long)CW;
#define CS_FETCH(nn) do { if ((nn) < NCK) { const size_t m0_ = (mb + (z ? (T - 1 - 16 * (nn) - 8 * hf) : 16 * (nn) + 8 * hf)) * CW; \
            const unsigned* pw_ = (const unsigned*)(gw_ + m0_ + 2 * cp); const unsigned* pkk_ = (const unsigned*)(gkk + m0_ + 2 * cp); const unsigned* pak_ = (const unsigned*)(gak + m0_ + 2 * cp); \
            const unsigned* pk_ = (const unsigned*)(gk + m0_ + 2 * cp); const unsigned* pr_ = (const unsigned*)(gr + m0_ + 2 * cp); const bf16* pv_ = gv + m0_; \
            _Pragma("unroll") for (int i_ = 0; i_ < 8; ++i_) { xw[i_] = pw_[i_ * (RSTEP / 2)]; xkk[i_] = pkk_[i_ * (RSTEP / 2)]; xak[i_] = pak_[i_ * (RSTEP / 2)]; xk[i_] = pk_[i_ * (RSTEP / 2)]; xr[i_] = pr_[i_ * (RSTEP / 2)]; \
                nv[i_] = pv_[i_ * RSTEP]; } } } while (0)
        CS_FETCH(pi);
#pragma unroll 1
        for (int n = pi; n < NCK; n += CS_NPR) {
            const int slot = n & (CS_R - 1);
            f32x2 w2[8], kk2[8], ak2[8], k2[8], r2[8]; unsigned vq[8];
#pragma unroll
            for (int i = 0; i < 8; ++i) { unsigned x0 = xw[i], x1 = xkk[i], x2 = xak[i], x3 = xk[i], x4 = xr[i], x5 = nv[i];
                asm volatile("" : "+v"(x0), "+v"(x1), "+v"(x2), "+v"(x3), "+v"(x4), "+v"(x5));
                w2[i] = (f32x2){__uint_as_float(x0 << 16), __uint_as_float(x0 & 0xffff0000u)}; kk2[i] = (f32x2){__uint_as_float(x1 << 16), __uint_as_float(x1 & 0xffff0000u)};
                ak2[i] = (f32x2){__uint_as_float(x2 << 16), __uint_as_float(x2 & 0xffff0000u)}; k2[i] = (f32x2){__uint_as_float(x3 << 16), __uint_as_float(x3 & 0xffff0000u)};
                r2[i] = (f32x2){__uint_as_float(x4 << 16), __uint_as_float(x4 & 0xffff0000u)}; vq[i] = x5; }
            CS_FETCH(n + CS_NPR);
            { unsigned sp = 0; for (;;) { const u32x2 pg = *(const volatile LAS u32x2*)(flg + 8); const int mn = (int)min(pg.x, pg.y);
                  if (mn >= n - (CS_R - 3)) break; __builtin_amdgcn_s_sleep(2); if (++sp > (1u << 24)) break; } }
            __builtin_amdgcn_fence(__ATOMIC_ACQUIRE, "workgroup");
            LAS unsigned char* sl = F.lds + slot * CS_SLOT;
            f32x2 Pl[8];
            Pl[0] = w2[0];
#pragma unroll
            for (int i = 1; i < 8; ++i) Pl[i] = Pl[i - 1] * w2[i];
            const f32x2 tot = Pl[7];
            const f32x2 oth = {__shfl_xor(tot.x, 32), __shfl_xor(tot.y, 32)};
            const f32x2 carry = hf ? oth : (f32x2){1.0f, 1.0f};
            const f32x2 PL2 = tot * oth;
            f32x2 kh[8], bh[8], Pprev = carry;
            { LAS unsigned char* pat = sl + CS_AT + (8 * hf * CS_LD + 2 * cp) * 2; LAS unsigned char* prt = sl + CS_RT + (8 * hf * CS_LD + 2 * cp) * 2;
              LAS unsigned char* pkt = scr + (8 * hf * CS_LD + 2 * cp) * 2; LAS unsigned char* pbt = scr + 2304 + (8 * hf * CS_LD + 2 * cp) * 2;
#pragma unroll
              for (int i = 0; i < 8; ++i) {
                  const f32x2 P = Pl[i] * carry;
                  const f32x2 inv = {__builtin_amdgcn_rcpf(P.x), __builtin_amdgcn_rcpf(P.y)};
                  const f32x2 at = kk2[i] * Pprev, rt = r2[i] * P, kt = k2[i] * inv, bt = -(ak2[i] * inv);
                  kh[i] = kt * PL2; bh[i] = bt * PL2;
                  *(LAS unsigned*)(pat + i * (CS_LD * 2)) = cvt_pk_bf16(at.x, at.y); *(LAS unsigned*)(prt + i * (CS_LD * 2)) = cvt_pk_bf16(rt.x, rt.y);
                  *(LAS unsigned*)(pkt + i * (CS_LD * 2)) = cvt_pk_bf16(kt.x, kt.y); *(LAS unsigned*)(pbt + i * (CS_LD * 2)) = cvt_pk_bf16(bt.x, bt.y);
                  Pprev = P; } }
            { u32x4 o0, o1;
              o0.x = cvt_pk_bf16(kh[0].x, kh[1].x); o0.y = cvt_pk_bf16(kh[2].x, kh[3].x); o0.z = cvt_pk_bf16(kh[4].x, kh[5].x); o0.w = cvt_pk_bf16(kh[6].x, kh[7].x);
              o1.x = cvt_pk_bf16(kh[0].y, kh[1].y); o1.y = cvt_pk_bf16(kh[2].y, kh[3].y); o1.z = cvt_pk_bf16(kh[4].y, kh[5].y); o1.w = cvt_pk_bf16(kh[6].y, kh[7].y);
              *(LAS u32x4*)(sl + CS_KHT + cp * 64 + hf * 16) = o0; *(LAS u32x4*)(sl + CS_KHT + cp * 64 + 32 + hf * 16) = o1;
              o0.x = cvt_pk_bf16(bh[0].x, bh[1].x); o0.y = cvt_pk_bf16(bh[2].x, bh[3].x); o0.z = cvt_pk_bf16(bh[4].x, bh[5].x); o0.w = cvt_pk_bf16(bh[6].x, bh[7].x);
              o1.x = cvt_pk_bf16(bh[0].y, bh[1].y); o1.y = cvt_pk_bf16(bh[2].y, bh[3].y); o1.z = cvt_pk_bf16(bh[4].y, bh[5].y); o1.w = cvt_pk_bf16(bh[6].y, bh[7].y);
              *(LAS u32x4*)(sl + CS_BHT + cp * 64 + hf * 16) = o0; *(LAS u32x4*)(sl + CS_BHT + cp * 64 + 32 + hf * 16) = o1; }
            if (hf == 0) *(LAS f32x2*)(sl + CS_PL + cp * 8) = PL2;
            { u32x4 o0;
              o0.x = vq[0] | (vq[1] << 16); o0.y = vq[2] | (vq[3] << 16); o0.z = vq[4] | (vq[5] << 16); o0.w = vq[6] | (vq[7] << 16);
              *(LAS u32x4*)(sl + CS_VT + (lane & 31) * 32 + (lane >> 5) * 16) = o0; }
            asm volatile("s_waitcnt lgkmcnt(0)" ::: "memory");
            bf16x8 af[2], rf[2], kf[2], bf_[2];
#pragma unroll
            for (int ks = 0; ks < 2; ++ks) { af[ks] = *(const LAS bf16x8*)(sl + CS_AT + (fr * CS_LD + 32 * ks + 8 * fg) * 2); rf[ks] = *(const LAS bf16x8*)(sl + CS_RT + (fr * CS_LD + 32 * ks + 8 * fg) * 2);
                kf[ks] = *(const LAS bf16x8*)(KT + fr * CS_LD + 32 * ks + 8 * fg); bf_[ks] = *(const LAS bf16x8*)(BT + fr * CS_LD + 32 * ks + 8 * fg); }
            const f32x4 zero4 = {0.f, 0.f, 0.f, 0.f};
            f32x4 Xc = zero4, Xt = zero4, AakT = zero4, ArbT = zero4, ArkT = zero4;
#pragma unroll
            for (int ks = 0; ks < 2; ++ks) { Xc = CS_M32(af[ks], bf_[ks], Xc); Xt = CS_M32(bf_[ks], af[ks], Xt);
                AakT = CS_M32(kf[ks], af[ks], AakT); ArbT = CS_M32(bf_[ks], rf[ks], ArbT); ArkT = CS_M32(kf[ks], rf[ks], ArkT); }
            f32x4 S1;
#pragma unroll
            for (int rr = 0; rr < 4; ++rr) { const int q = 4 * fg + rr;
                Xc[rr] = (fr < q) ? Xc[rr] : 0.f; Xt[rr] = (q < fr) ? Xt[rr] : 0.f; S1[rr] = Xt[rr] + ((q == fr) ? 1.0f : 0.f);
                AakT[rr] = (q < fr) ? AakT[rr] : 0.f; ArkT[rr] = (q <= fr) ? ArkT[rr] : 0.f; ArbT[rr] = (q <= fr) ? ArbT[rr] : 0.f; }
            { u32x2 w; w.x = cvt_pk_bf16(AakT[0], AakT[1]); w.y = cvt_pk_bf16(AakT[2], AakT[3]); *(LAS u32x2*)(sl + CS_AAK + o16) = w;
              w.x = cvt_pk_bf16(ArkT[0], ArkT[1]); w.y = cvt_pk_bf16(ArkT[2], ArkT[3]); *(LAS u32x2*)(sl + CS_ARK + o16) = w;
              w.x = cvt_pk_bf16(ArbT[0], ArbT[1]); w.y = cvt_pk_bf16(ArbT[2], ArbT[3]); *(LAS u32x2*)(sl + CS_ARB + o16) = w; }
#define CS_PK(v) ((u32x2){cvt_pk_bf16((v)[0], (v)[1]), cvt_pk_bf16((v)[2], (v)[3])})
            const u32x2 xc = CS_PK(Xc), xt = CS_PK(Xt), s1 = CS_PK(S1);
            const f32x4 X2c = CS_M16(xt, xc, zero4), X2t = CS_M16(xc, xt, zero4);
            const u32x2 x2c = CS_PK(X2c), x2t = CS_PK(X2t);
            const f32x4 S2 = CS_M16(x2c, s1, S1);
            const f32x4 X4c = CS_M16(x2t, x2c, zero4), X4t = CS_M16(x2c, x2t, zero4);
            const u32x2 x4c = CS_PK(X4c), x4t = CS_PK(X4t), s2 = CS_PK(S2);
            const f32x4 S4 = CS_M16(x4c, s2, S2);
            const f32x4 X8c = CS_M16(x4t, x4c, zero4);
            const u32x2 x8c = CS_PK(X8c), s4 = CS_PK(S4);
            const f32x4 S8 = CS_M16(x8c, s4, S4);
            *(LAS u32x2*)(sl + CS_TT + o16) = CS_PK(S8);
#undef CS_PK
            asm volatile("s_waitcnt lgkmcnt(0)" ::: "memory");
            __builtin_amdgcn_fence(__ATOMIC_RELEASE, "workgroup");
            if (lane == 0) flg[slot] = (unsigned)(n + 1);
        }
#undef CS_FETCH
    }
#undef CS_M32
#undef CS_M16
    __syncthreads();
}

__device__ __forceinline__ void scan_phase(const Frame& F, const Args& a, const int idx) {
    const int seq = idx >> 1, half = idx & 1;
    if (seq >> 5) scan_phase_z<1>(F, a, seq, half); else scan_phase_z<0>(F, a, seq, half);
}

__device__ __forceinline__ void combine_phase(const Frame& F, const Args& a) {
    unsigned char* ws = a.ws;
    const bf16* att = (const bf16*)(ws + WS_ATT); const bf16* rr = (const bf16*)(ws + WS_R); const bf16* vv = (const bf16*)(ws + WS_V);
    const bf16* kd = (const bf16*)(ws + WS_KDIR); const bf16* gg = (const bf16*)(ws + WS_G); const bf16* y = (const bf16*)(ws + WS_Y);
    bf16* mix = (bf16*)(ws + WS_MIX);
    const float* anw = a.in[4]; const float* r_k = a.in[14]; const float* ln_w = a.in[15]; const float* ln_b = a.in[16];
    const int lane = F.lane, c0 = 8 * lane;
    float nw[8], rk[8], lw[8], lb[8];
#pragma unroll
    for (int i = 0; i < 8; ++i) { nw[i] = anw[c0 + i]; rk[i] = r_k[c0 + i]; lw[i] = ln_w[c0 + i]; lb[i] = ln_b[c0 + i]; }
    const int gw = F.vcu * 8 + F.wave, NGW = F.G * 8;
#pragma unroll 2
    for (int m = gw; m < M; m += NGW) {
        const size_t o = (size_t)m * CW + c0;
        float f[8];
        unpack8(*(const u32x4*)(att + o), f);
        float ss = 0.f;
#pragma unroll
        for (int i = 0; i < 8; ++i) ss += f[i] * f[i];
        const float rs = rsqrtf(wave_sum(ss) * (1.f / CW) + RMS_EPS);
#pragma unroll
        for (int i = 0; i < 8; ++i) f[i] = f[i] * rs * nw[i];
        *(u32x4*)(mix + (size_t)m * D + c0) = pack8(f);
        float yv[8], yw[8];
        unpack8(*(const u32x4*)(y + o), yv); unpack8(*(const u32x4*)(y + (size_t)M * CW + o), yw);
#pragma unroll
        for (int i = 0; i < 8; ++i) yv[i] += yw[i];
        float s1 = 0.f;
#pragma unroll
        for (int i = 0; i < 8; ++i) s1 += yv[i];
        s1 += __shfl_xor(s1, 1); s1 += __shfl_xor(s1, 2); s1 += __shfl_xor(s1, 4);
        const float mean = s1 * (1.f / 64.f);
        float s2 = 0.f;
#pragma unroll
        for (int i = 0; i < 8; ++i) { yv[i] -= mean; s2 += yv[i] * yv[i]; }
        s2 += __shfl_xor(s2, 1); s2 += __shfl_xor(s2, 2); s2 += __shfl_xor(s2, 4);
        const float rstd = rsqrtf(s2 * (1.f / 64.f) + GN_EPS);
        float rf[8], k0[8], k1[8], vf[8], gf[8];
        unpack8(*(const u32x4*)(rr + o), rf); unpack8(*(const u32x4*)(kd + o), k0); unpack8(*(const u32x4*)(kd + (size_t)M * CW + o), k1);
        unpack8(*(const u32x4*)(vv + o), vf); unpack8(*(const u32x4*)(gg + o), gf);
        float cf = 0.f;
#pragma unroll
        for (int i = 0; i < 8; ++i) cf += rf[i] * (k0[i] + k1[i]) * rk[i];
        cf += __shfl_xor(cf, 1); cf += __shfl_xor(cf, 2); cf += __shfl_xor(cf, 4);
#pragma unroll
        for (int i = 0; i < 8; ++i) f[i] = (yv[i] * rstd * lw[i] + lb[i] + cf * vf[i]) * gf[i];
        *(u32x4*)(mix + (size_t)m * D + CW + c0) = pack8(f);
    }
}

__device__ __forceinline__ void router_phase(const Frame& F, const Args& a) {
    unsigned char* ws = a.ws;
    const bf16* hbuf = (const bf16*)(ws + WS_H); unsigned char* hn2 = ws + WS_HN2;
    int* eidx = (int*)(ws + WS_EIDX); float* gate = (float*)(ws + WS_GATE); int* rank = (int*)(ws + WS_RANK);
    unsigned* ctl = (unsigned*)(ws + WS_CTL);
    const float* n2w = a.in[18]; const float* rw = a.in[19]; const float* rb = a.in[20];
    LAS bf16* wh = (LAS bf16*)(F.lds + RT_WH); LAS bf16* wl = (LAS bf16*)(F.lds + RT_WL); LAS int* hist = (LAS int*)(F.lds + RT_HIST); LAS int* eL = (LAS int*)(F.lds + RT_EL);
    {
        const u32x4* img = (const u32x4*)(ws + WS_RTIMG); LAS u32x4* dst = (LAS u32x4*)(F.lds + RT_WH);
        u32x4 t[17];
#pragma unroll
        for (int j = 0; j < 17; ++j) { const int i = F.tid + 512 * j; if (i < 8256) t[j] = img[i]; }
#pragma unroll
        for (int j = 0; j < 17; ++j) { const int i = F.tid + 512 * j; if (i < 8256) dst[i] = t[j]; } }
    if (F.tid < 32) hist[F.tid] = 0;
    __syncthreads();
    const int lane = F.lane, tk = lane & 15, g = lane >> 4;
    const int blk = F.vcu;
    const int m = blk * 128 + F.wave * 16 + tk;
    const bf16* hrow = hbuf + (size_t)m * D + 8 * g;
    float ss = 0.f;
#pragma unroll 8
    for (int ks = 0; ks < 32; ++ks) { float xf[8]; unpack8(*(const u32x4*)(hrow + 32 * ks), xf);
        ss += (xf[0] * xf[0] + xf[1] * xf[1]) + (xf[2] * xf[2] + xf[3] * xf[3]) + (xf[4] * xf[4] + xf[5] * xf[5]) + (xf[6] * xf[6] + xf[7] * xf[7]); }
    ss += __shfl_xor(ss, 16); ss += __shfl_xor(ss, 32);
    const float rs = rsqrtf(ss * (1.f / D) + RMS_EPS);
    f32x4 acc0 = {0.f, 0.f, 0.f, 0.f}, acc1 = acc0;
    unsigned char* hrow8 = hn2 + (size_t)m * D + 8 * g;
    const LAS bf16* wh0 = wh + tk * RT_PITCH + 8 * g; const LAS bf16* wl0 = wl + tk * RT_PITCH + 8 * g;
#pragma unroll 4
    for (int ks = 0; ks < 32; ++ks) {
        float xf[8]; unpack8(*(const u32x4*)(hrow + 32 * ks), xf);
        const f32x4 x0 = {xf[0], xf[1], xf[2], xf[3]}, x1 = {xf[4], xf[5], xf[6], xf[7]};
        const f32x4 n0 = *(const f32x4*)(n2w + 32 * ks + 8 * g), n1 = *(const f32x4*)(n2w + 32 * ks + 8 * g + 4);
        const f32x4 y0 = x0 * rs * n0, y1 = x1 * rs * n1;
        { u32x2 w8; w8.x = pk4_fp8(y0.x * F8_SX, y0.y * F8_SX, y0.z * F8_SX, y0.w * F8_SX); w8.y = pk4_fp8(y1.x * F8_SX, y1.y * F8_SX, y1.z * F8_SX, y1.w * F8_SX); *(u32x2*)(hrow8 + 32 * ks) = w8; }
        union { u32x4 w; bf16x8 h8; } xh, xl;
        xh.w.x = cvt_pk_bf16(y0.x, y0.y); xh.w.y = cvt_pk_bf16(y0.z, y0.w); xh.w.z = cvt_pk_bf16(y1.x, y1.y); xh.w.w = cvt_pk_bf16(y1.z, y1.w);
        xl.w.x = cvt_pk_bf16(y0.x - bflo(xh.w.x), y0.y - bfhi(xh.w.x)); xl.w.y = cvt_pk_bf16(y0.z - bflo(xh.w.y), y0.w - bfhi(xh.w.y));
        xl.w.z = cvt_pk_bf16(y1.x - bflo(xh.w.z), y1.y - bfhi(xh.w.z)); xl.w.w = cvt_pk_bf16(y1.z - bflo(xh.w.w), y1.w - bfhi(xh.w.w));
        const bf16x8 a0h = *(const LAS bf16x8*)(wh0 + 32 * ks), a1h = *(const LAS bf16x8*)(wh0 + 16 * RT_PITCH + 32 * ks);
        const bf16x8 a0l = *(const LAS bf16x8*)(wl0 + 32 * ks), a1l = *(const LAS bf16x8*)(wl0 + 16 * RT_PITCH + 32 * ks);
        acc0 = __builtin_amdgcn_mfma_f32_16x16x32_bf16(a0h, xh.h8, acc0, 0, 0, 0); acc1 = __builtin_amdgcn_mfma_f32_16x16x32_bf16(a1h, xh.h8, acc1, 0, 0, 0);
        acc0 = __builtin_amdgcn_mfma_f32_16x16x32_bf16(a0h, xl.h8, acc0, 0, 0, 0); acc1 = __builtin_amdgcn_mfma_f32_16x16x32_bf16(a1h, xl.h8, acc1, 0, 0, 0);
        acc0 = __builtin_amdgcn_mfma_f32_16x16x32_bf16(a0l, xh.h8, acc0, 0, 0, 0); acc1 = __builtin_amdgcn_mfma_f32_16x16x32_bf16(a1l, xh.h8, acc1, 0, 0, 0);
    }
    float lv[8]; int li[8];
    { const f32x4 b0 = *(const f32x4*)(rb + 4 * g), b1 = *(const f32x4*)(rb + 16 + 4 * g);
#pragma unroll
      for (int i = 0; i < 4; ++i) { lv[i] = acc0[i] + b0[i]; li[i] = 4 * g + i; lv[4 + i] = acc1[i] + b1[i]; li[4 + i] = 16 + 4 * g + i; } }
    float tv[4]; int ti[4];
#pragma unroll
    for (int kx = 0; kx < 4; ++kx) {
        float bv = lv[0]; int bi = li[0];
#pragma unroll
        for (int i = 1; i < 8; ++i) { const bool gt = lv[i] > bv; bv = gt ? lv[i] : bv; bi = gt ? li[i] : bi; }
#pragma unroll
        for (int o = 16; o < 64; o <<= 1) { const float ov = __shfl_xor(bv, o); const int oi = __shfl_xor(bi, o); const bool tko = (ov > bv) || (ov == bv && oi < bi); bv = tko ? ov : bv; bi = tko ? oi : bi; }
        tv[kx] = bv; ti[kx] = bi;
#pragma unroll
        for (int i = 0; i < 8; ++i) lv[i] = (li[i] == bi) ? -3.0e38f : lv[i];
    }
    if (g == 0) {
        const float e0 = 1.0f, e1 = __expf(tv[1] - tv[0]), e2 = __expf(tv[2] - tv[0]), e3 = __expf(tv[3] - tv[0]);
        const float is = 1.0f / (e0 + e1 + e2 + e3);
        const float gs[4] = {e0 * is, e1 * is, e2 * is, e3 * is};
#pragma unroll
        for (int kx = 0; kx < 4; ++kx) { eidx[m * 4 + kx] = ti[kx]; gate[m * 4 + kx] = gs[kx]; eL[(m - blk * 128) * 4 + kx] = ti[kx]; }
    }
    __syncthreads();
    { const int t = F.tid, e = eL[t]; int rk = 0;
      for (int u = 0; u < t; ++u) rk += (eL[u] == e) ? 1 : 0;
      rank[(blk * 128) * 4 + t] = rk;
      __hip_atomic_fetch_add(&hist[e], 1, __ATOMIC_RELAXED, __HIP_MEMORY_SCOPE_WORKGROUP); }
    __syncthreads();
    if (F.tid < 32) ctl[CW_CNT + blk * 32 + F.tid] = (unsigned)hist[F.tid];
}

__device__ __forceinline__ void dispatch_phase(const Frame& F, const Args& a) {
    unsigned char* ws = a.ws;
    unsigned* ctl = (unsigned*)(ws + WS_CTL);
    const int* eidx = (const int*)(ws + WS_EIDX); const int* rank = (const int*)(ws + WS_RANK); int* dest = (int*)(ws + WS_DEST);
    LAS int* part = (LAS int*)F.lds;
    LAS int* tot = part + 1024;
    const int blk = F.vcu, G = F.G;
    { const int e = F.tid & 31, pt = F.tid >> 5; int s = 0, sb = 0;
      if (G == 256) { int cv[16];
#pragma unroll
          for (int q = 0; q < 16; ++q) cv[q] = (int)ld_u32_agent(ctl + CW_CNT + (pt + 16 * q) * 32 + e);
#pragma unroll
          for (int q = 0; q < 16; ++q) { s += cv[q]; if (pt + 16 * q < blk) sb += cv[q]; } }
      else for (int bb = pt; bb < G; bb += 16) { const int cval = (int)ld_u32_agent(ctl + CW_CNT + bb * 32 + e); s += cval; if (bb < blk) sb += cval; }
      part[pt * 32 + e] = s; part[512 + pt * 32 + e] = sb; }
    __syncthreads();
    if (F.tid < 32) { int s = 0, sb = 0;
        for (int pt = 0; pt < 16; ++pt) { s += part[pt * 32 + F.tid]; sb += part[512 + pt * 32 + F.tid]; }
        tot[F.tid] = s; tot[32 + F.tid] = sb; tot[96 + F.tid] = (s + 255) & ~255; }
    __syncthreads();
    if (F.tid == 0) { int ps = 0; for (int e = 0; e < 32; ++e) { tot[64 + e] = ps; ps += tot[96 + e]; }
        tot[128] = ps >> 8; }
    __syncthreads();
    if (blk == 0) {
        if (F.tid == 0) ctl[CW_NT] = (unsigned)tot[128];
        for (int e = F.tid >> 4; e < 32; e += 32) { const int t0 = tot[64 + e] >> 8, nt = tot[96 + e] >> 8; for (int i = F.tid & 15; i < nt; i += 16) ctl[CW_TEXP + t0 + i] = (unsigned)e; }
    }
    const int lane = F.lane;
    const int mw = blk * 128 + F.wave * 16;
    int* rowtok = (int*)(ws + WS_ROWTOK);
    { const int e = eidx[mw * 4 + lane]; const int dl = tot[64 + e] + tot[32 + e] + rank[mw * 4 + lane]; dest[mw * 4 + lane] = dl; rowtok[dl] = mw + (lane >> 2); }
    { const int e = blk & 31, pt = blk >> 5, np = G >> 5; const int r0 = tot[64 + e] + tot[e], r1 = tot[64 + e] + tot[96 + e];
      if (np > 0) for (int r = r0 + pt * 512 + F.tid; r < r1; r += np * 512) rowtok[r] = 0; }
}

__device__ __forceinline__ void final_phase(const Frame& F, const Args& a) {
    unsigned char* ws = a.ws;
    const bf16* hbuf = (const bf16*)(ws + WS_H); const unsigned char* ybuf = ws + WS_YBUF;
    const int* dest = (const int*)(ws + WS_DEST); const float* gate = (const float*)(ws + WS_GATE);
    const float* fw = a.in[25]; float* out = a.out;
    const int lane = F.lane;
    f32x4 wn[4];
#pragma unroll
    for (int j = 0; j < 4; ++j) wn[j] = *((const f32x4*)fw + lane + 64 * j);
    const int gw = F.vcu * 8 + F.wave, NGW = F.G * 8;
    const int per = M / NGW;
    const int mw = gw * per;
    int dl = 0; float gl = 0.f;
    if (lane < 4 * per && per <= 16) { dl = dest[mw * 4 + lane]; gl = gate[mw * 4 + lane]; }
#pragma unroll 2
    for (int i = 0; i < per; ++i) {
        const int m = mw + i;
        const u32x2* hr = (const u32x2*)(hbuf + (size_t)m * D) + lane;
        f32x4 v[4];
#pragma unroll
        for (int j = 0; j < 4; ++j) { const u32x2 w = hr[64 * j]; v[j] = (f32x4){bflo(w.x), bfhi(w.x), bflo(w.y), bfhi(w.y)}; }
#pragma unroll
        for (int kx = 0; kx < 4; ++kx) {
            const int d = per <= 16 ? __shfl(dl, 4 * i + kx) : dest[m * 4 + kx]; const float gt = (per <= 16 ? __shfl(gl, 4 * i + kx) : gate[m * 4 + kx]) * (1.0f / F8_SY);
            const unsigned* yr = (const unsigned*)(ybuf + (size_t)d * D) + lane;
#pragma unroll
            for (int j = 0; j < 4; ++j) { const unsigned w = yr[64 * j]; const f32x2 lo = __builtin_amdgcn_cvt_pk_f32_fp8((int)w, false), hi = __builtin_amdgcn_cvt_pk_f32_fp8((int)w, true);
                v[j].x += gt * lo.x; v[j].y += gt * lo.y; v[j].z += gt * hi.x; v[j].w += gt * hi.y; }
        }
        float s = 0.f;
#pragma unroll
        for (int j = 0; j < 4; ++j) s += (v[j].x * v[j].x + v[j].y * v[j].y) + (v[j].z * v[j].z + v[j].w * v[j].w);
        const float rs = rsqrtf(wave_sum(s) * (1.f / D) + RMS_EPS);
        f32x4* orow = (f32x4*)(out + (size_t)m * D) + lane;
#pragma unroll
        for (int j = 0; j < 4; ++j) orow[64 * j] = v[j] * rs * wn[j];
    }
}

__global__ void __launch_bounds__(512, 2) fwd_megakernel(Args args) {
    extern __shared__ __attribute__((aligned(16))) unsigned char lds_raw[];
    Frame F;
    F.lds = (LAS unsigned char*)lds_raw;
    F.tid = threadIdx.x; F.lane = F.tid & 63; F.wave = __builtin_amdgcn_readfirstlane(F.tid >> 6);
    F.G = gridDim.x; { const int bx = blockIdx.x; F.vcu = (F.G % 8 == 0) ? (bx % 8) * (F.G / 8) + bx / 8 : bx; }
    unsigned char* ws = args.ws;
    const int lo = args.ph_lo, hi = args.ph_hi;
#define IN(k) (lo <= (k) && (k) < hi)
#if MK_SPLIT
#define SEAM(k) do { } while (0)
#else
    cg::grid_group grid = cg::this_grid();
    { volatile LAS unsigned* st = (volatile LAS unsigned*)(F.lds + LDS_MISC); if (F.tid < 2) st[F.tid] = 0u; __syncthreads(); }
    const XcdBarrier xbar = xcd_barrier_post((unsigned*)(ws + WS_CTL) + CW_BAR, (volatile LAS unsigned*)(F.lds + LDS_MISC));
    if (lo < 0) grid.sync();
#define SEAM(k) do { if (IN(k) && IN((k) + 1)) xcd_barrier(xbar); } while (0)
#endif
#define REP2(k) if constexpr (((MK_REPEAT >> (k)) & 1) != 0)
#define PH1 { pg8::Gemm g{(const bf16*)(ws + WS_HN), (const bf16*)(ws + WS_WINT), 1024, nullptr, 0, nullptr}; \
        pg8::StaticOrder S; S.init(M / 256, NPROJ_PAD / 256, F.G, (int)blockIdx.x); \
        pg8::EpiProj E{(bf16*)(ws + WS_Q), (bf16*)(ws + WS_K), (bf16*)(ws + WS_VT), (bf16*)(ws + WS_P)}; \
        pg8::gemm_phase<pg8::EpiProj, true, true>(F.lds, g, S, E); }
#define PH5 { pg8::Gemm g{(const bf16*)(ws + WS_MIX), (const bf16*)(ws + WS_WOT), 1024, nullptr, 0, nullptr}; \
        pg8::StaticOrder S; S.init(M / 256, D / 256, F.G, (int)blockIdx.x); \
        pg8::EpiWo E{args.in[0], (bf16*)(ws + WS_H)}; \
        pg8::gemm_phase<pg8::EpiWo, true, true>(F.lds, g, S, E); }
#define PH8 { const unsigned* ctl = (const unsigned*)(ws + WS_CTL); const int ntile = (int)ld_u32_agent(ctl + CW_NT); \
        pg8::Gemm g{(const bf16*)(ws + WS_HN2), (const bf16*)(ws + WS_WUPT), 512, ctl + CW_TEXP, (size_t)2048 * 1024, (const int*)(ws + WS_ROWTOK)}; \
        pg8::StaticOrder S; S.init(ntile, 8, F.G, (int)blockIdx.x); \
        pg8::EpiUp E{args.in[22], ws + WS_ACT}; \
        pg8::gemm_phase<pg8::EpiUp, true, true, true, true>(F.lds, g, S, E); }
#define PH9 { const unsigned* ctl = (const unsigned*)(ws + WS_CTL); const int ntile = (int)ld_u32_agent(ctl + CW_NT); \
        pg8::Gemm g{(const bf16*)(ws + WS_ACT), (const bf16*)(ws + WS_WDNT), 512, ctl + CW_TEXP, (size_t)1024 * 1024, nullptr}; \
        pg8::StaticOrder S; S.init(ntile, 4, F.G, (int)blockIdx.x); \
        pg8::EpiDown E{args.in[24], ws + WS_YBUF}; \
        pg8::gemm_phase<pg8::EpiDown, true, true, false, true>(F.lds, g, S, E); }
    if (IN(0)) { p0_prologue(F, args); REP2(0) p0_prologue(F, args); }
    SEAM(0);
    if (IN(1)) { PH1 REP2(1) PH1 }
    SEAM(1);
    if (IN(2)) { prep_phase<true>(F, args); REP2(2) prep_phase<true>(F, args); }
    SEAM(2);
    if (IN(3)) {
        if ((F.vcu & 1) == 0 && (F.vcu >> 1) < 128) { scan_phase(F, args, F.vcu >> 1); REP2(3) scan_phase(F, args, F.vcu >> 1); }
        else { const int nside = F.G - min((F.G + 1) / 2, 128); const int q_ = min((F.vcu + 1) >> 1, 128); side_phase(F, args, F.vcu - q_, nside); REP2(11) side_phase(F, args, F.vcu - q_, nside); }
    }
    SEAM(3);
    if (IN(4)) { combine_phase(F, args); REP2(4) combine_phase(F, args); }
    SEAM(4);
    if (IN(5)) { PH5 REP2(5) PH5 }
    SEAM(5);
    if (IN(6)) { router_phase(F, args); REP2(6) { __syncthreads(); router_phase(F, args); } }
    SEAM(6);
    if (IN(7)) { dispatch_phase(F, args); REP2(7) { __syncthreads(); dispatch_phase(F, args); } }
    SEAM(7);
    if (IN(8)) { PH8 REP2(8) PH8 }
    SEAM(8);
    if (IN(9)) { PH9 REP2(9) PH9 }
    SEAM(9);
    if (IN(10)) { final_phase(F, args); REP2(10) final_phase(F, args); }
#undef IN
#undef SEAM
}

extern "C" void kernel_launch(void* const* d_in, const int* in_sizes, int n_in, void* d_out, int out_size, void* d_ws, size_t ws_size, hipStream_t stream) {
    static int grid = 0;
    if (grid == 0) {
        if (n_in != 26 || in_sizes[0] != M * D || out_size != M * D || ws_size < WS_END) { fprintf(stderr, "kernel_launch: unexpected problem (n_in %d, in0 %d, out %d, ws %zu)\n", n_in, n_in > 0 ? in_sizes[0] : -1, out_size, ws_size); grid = -1; return; }
        int dev = 0, cus = 0, per_cu = 0;
        if (hipGetDevice(&dev) != hipSuccess || hipDeviceGetAttribute(&cus, hipDeviceAttributeMultiprocessorCount, dev) != hipSuccess) { grid = -1; return; }
        if (hipFuncSetAttribute((const void*)fwd_megakernel, hipFuncAttributeMaxDynamicSharedMemorySize, LDS_BYTES) != hipSuccess) { fprintf(stderr, "kernel_launch: hipFuncSetAttribute failed\n"); grid = -1; return; }
        if (hipOccupancyMaxActiveBlocksPerMultiprocessor(&per_cu, (const void*)fwd_megakernel, 512, LDS_BYTES) != hipSuccess || per_cu < 1) { fprintf(stderr, "kernel_launch: occupancy query says %d\n", per_cu); per_cu = 1; }
        (void)hipGetLastError();
        grid = cus * 1;
        if (grid != 256) fprintf(stderr, "kernel_launch: note: %d CUs\n", cus);
    }
    if (grid < 0) return;
    if (hipMemsetAsync((char*)d_ws + WS_CTL + (size_t)CW_BAR * 4, 0, XCD_BAR_WORDS * 4, stream) != hipSuccess) { fprintf(stderr, "kernel_launch: memset failed\n"); return; }
    Args a{};
    for (int i = 0; i < 26; ++i) a.in[i] = (const float*)d_in[i];
    a.out = (float*)d_out; a.ws = (unsigned char*)d_ws;
#if MK_SPLIT
    for (int ph = 0; ph < NPHASE; ++ph) { a.ph_lo = ph; a.ph_hi = ph + 1; hipLaunchKernelGGL(fwd_megakernel, dim3(grid), dim3(512), LDS_BYTES, stream, a); }
#else
    a.ph_lo = 0; a.ph_hi = NPHASE;
    void* kargs[] = {&a};
    hipError_t e = hipLaunchCooperativeKernel((const void*)fwd_megakernel, dim3(grid), dim3(512), kargs, LDS_BYTES, stream);
    if (e != hipSuccess) fprintf(stderr, "kernel_launch: cooperative launch failed: %s (grid %d)\n", hipGetErrorString(e), grid);
#endif
}
```

```cpp
#include <hip/hip_runtime.h>
#include <hip/hip_cooperative_groups.h>
#include <cstdio>
#include <cstdint>
namespace cg = cooperative_groups;

#ifndef MK_SPLIT
#define MK_SPLIT 0
#endif

#ifndef MK_REPEAT
#define MK_REPEAT 0
#endif
#define LAS __attribute__((address_space(3)))
typedef unsigned short bf16;
typedef float f32x4 __attribute__((ext_vector_type(4)));
typedef float f32x2 __attribute__((ext_vector_type(2)));
typedef unsigned u32x4 __attribute__((ext_vector_type(4)));
typedef unsigned u32x2 __attribute__((ext_vector_type(2)));
typedef short bf16x8 __attribute__((ext_vector_type(8)));
typedef short s16x4 __attribute__((ext_vector_type(4)));

constexpr int BATCH = 4, T = 8192, D = 1024, M = BATCH * T;
constexpr int NH = 8, HD = 64, CW = 512;
constexpr int SHIFT_W = 1920, NPROJ = 3456, NPROJ_PAD = 3584, PW = 2048;
constexpr int NE = 32, TOPK = 4, DE = 1024;
constexpr int GRIDW = 64, GROWS = 128;
constexpr int P_TILES_MAX = 544, P_ROWS = P_TILES_MAX * 256;
constexpr float RMS_EPS = 1e-5f, GN_EPS = 64e-5f;
constexpr int NPHASE = 11;

constexpr size_t MiB = 1u << 20;
constexpr size_t WS_CTL = 0;
constexpr size_t WS_W2T = 1 * MiB, WS_A2T = WS_W2T + 131072, WS_G2T = WS_A2T + 131072;
constexpr size_t WS_WINT = 2 * MiB, WS_WOT = 9 * MiB, WS_WUPT = 12 * MiB, WS_WDNT = 140 * MiB;
constexpr size_t WS_EIDX = 204 * MiB, WS_GATE = WS_EIDX + 524288, WS_RANK = WS_GATE + 524288, WS_DEST = WS_RANK + 524288, WS_ROWTOK = WS_DEST + 524288;
constexpr size_t WS_R = 208 * MiB, WS_V = 240 * MiB, WS_KK = 272 * MiB, WS_DECAY = 304 * MiB, WS_KDIR = 368 * MiB, WS_AKK = 432 * MiB,
                 WS_G = 496 * MiB, WS_ATT = 528 * MiB;
constexpr size_t WS_Q = 560 * MiB, WS_K = 592 * MiB, WS_VT = 624 * MiB, WS_P = 656 * MiB, WS_HN = 784 * MiB, WS_Y = 848 * MiB;
constexpr size_t WS_MIX = 656 * MiB  , WS_H = 752 * MiB, WS_HN2 = 880 * MiB, WS_XBUF = 208 * MiB, WS_ACT = 480 * MiB, WS_YBUF = 208 * MiB;
constexpr size_t WS_END = 976 * MiB;
constexpr int RT_PITCH = 1032, RT_WH = 0, RT_WL = 32 * RT_PITCH * 2, RT_HIST = 2 * RT_WL, RT_EL = RT_HIST + 256;
constexpr size_t WS_RTIMG = 262144;

constexpr int CW_NT = 0, CW_TEXP = 64, CW_CNT = 1024, CW_BAR = 16384;

constexpr int LDS_BYTES = 159744, LDS_MISC = LDS_BYTES - 256;

typedef __bf16 bf16x2_t __attribute__((ext_vector_type(2)));
__device__ __forceinline__ unsigned cvt_pk_bf16(float lo, float hi) { const f32x2 v = {lo, hi}; return __builtin_bit_cast(unsigned, __builtin_convertvector(v, bf16x2_t)); }
typedef int i32x8 __attribute__((ext_vector_type(8)));
typedef int i32x4 __attribute__((ext_vector_type(4)));
#ifndef F8_SCALE1
#define F8_SCALE1 0
#endif
constexpr float F8_SX = 32.0f, F8_SW = 128.0f, F8_SACT = 8.0f, F8_SY = 32.0f;
__device__ __forceinline__ float f8clamp(float v) { return __builtin_amdgcn_fmed3f(v, -448.0f, 448.0f); }
__device__ __forceinline__ unsigned pk4_fp8(float a, float b, float c, float d) { int w = 0; w = __builtin_amdgcn_cvt_pk_fp8_f32(f8clamp(a), f8clamp(b), w, false); w = __builtin_amdgcn_cvt_pk_fp8_f32(f8clamp(c), f8clamp(d), w, true); return (unsigned)w; }
__device__ __forceinline__ float bflo(unsigned u) { return __uint_as_float(u << 16); }
__device__ __forceinline__ float bfhi(unsigned u) { return __uint_as_float(u & 0xffff0000u); }
__device__ __forceinline__ float bf1(bf16 v) { return __uint_as_float(((unsigned)v) << 16); }
__device__ __forceinline__ void unpack8(const u32x4 u, float* f) { f[0] = bflo(u.x); f[1] = bfhi(u.x); f[2] = bflo(u.y); f[3] = bfhi(u.y); f[4] = bflo(u.z); f[5] = bfhi(u.z); f[6] = bflo(u.w); f[7] = bfhi(u.w); }
__device__ __forceinline__ u32x4 pack8(const float* f) { u32x4 o; o.x = cvt_pk_bf16(f[0], f[1]); o.y = cvt_pk_bf16(f[2], f[3]); o.z = cvt_pk_bf16(f[4], f[5]); o.w = cvt_pk_bf16(f[6], f[7]); return o; }
__device__ __forceinline__ float wave_sum(float v) {
#pragma unroll
    for (int o = 1; o < 64; o <<= 1) v += __shfl_xor(v, o);
    return v;
}
__device__ __forceinline__ float sigmoidf_(float x) { return __builtin_amdgcn_rcpf(1.0f + __expf(-x)); }
__device__ __forceinline__ unsigned ld_u32_agent(const unsigned* p) { return __hip_atomic_load(p, __ATOMIC_RELAXED, __HIP_MEMORY_SCOPE_AGENT); }

namespace pg8 {
constexpr int BM = 256, BK = 64, HALF = 128, HTB = HALF * BK * 2, STAGE_BYTES = 8 * HTB, NXCD = 8, WGM = 8;
__host__ __device__ __forceinline__ int lds_byte(int r, int c) { const int st = (r >> 4) * 2 + (c >> 5), rr = r & 15, cc = c & 31, ob = rr * 64 + cc * 2; return st * 1024 + (ob ^ (((ob >> 9) & 1) << 5)); }
__host__ __device__ __forceinline__ void stage_rc(int b, int& R, int& C) { const int st = b / 1024, sb = b % 1024, swz = sb ^ (((sb >> 9) & 1) << 5); R = (st >> 1) * 16 + swz / 64; C = (st & 1) * 32 + (swz % 64) / 2; }
__host__ __device__ __forceinline__ int perm32(int rho) { const int n = rho >> 4, i = rho & 15; return 8 * (i >> 2) + 4 * n + (i & 3); }

struct Unit { int pm, pn, e; };
struct Gemm { const bf16* A; const bf16* Bt; int K; const unsigned* texp; size_t bstride; const int* rowtok; };

struct StaticOrder {
    int nM, nN, nwg, G, c;
    __device__ void init(int nM_, int nN_, int G_, int c_) { nM = nM_; nN = nN_; nwg = nM * nN; G = G_; c = c_; }
    __device__ bool next(int i, Unit& u) const {
        const long L = (long)i * G + c; if (L >= nwg) return false;
        int wgid = (int)L; { const int q = nwg / NXCD, r = nwg % NXCD, xcd = wgid % NXCD, off = wgid / NXCD; wgid = (xcd < r ? xcd * (q + 1) : r * (q + 1) + (xcd - r) * q) + off; }
        const int nig = WGM * nN, gid = wgid / nig, fm = gid * WGM, gsz = (nM - fm) < WGM ? (nM - fm) : WGM;
        u.pm = fm + ((wgid % nig) % gsz); u.pn = (wgid % nig) / gsz; u.e = 0; return true;
    }
};

__device__ __forceinline__ i32x8 cat8(const bf16x8 lo, const bf16x8 hi) { return __builtin_shufflevector(__builtin_bit_cast(i32x4, lo), __builtin_bit_cast(i32x4, hi), 0, 1, 2, 3, 4, 5, 6, 7); }
template <class Epi, bool ALIGN_EPI, bool SP2, bool GATHER = false, bool FP8 = false>
__device__ __forceinline__ void gemm_phase(LAS unsigned char* lds, const Gemm g, const StaticOrder& S, const Epi& E) {
    const int tid = threadIdx.x, wid = __builtin_amdgcn_readfirstlane(tid >> 6), lane = tid & 63, wr = wid >> 2, wc = wid & 3, fr = lane & 15, fq = lane >> 4;
    const int K = g.K, nt = K / BK;
    unsigned voffA[2], voffB[2];
#pragma unroll
    for (int i = 0; i < 2; ++i) { int R, C; stage_rc(tid * 16 + i * 8192, R, C); const int Rb = Epi::PERM ? ((R & ~31) + perm32(R & 31)) : R;
        voffA[i] = (unsigned)(R * K + C) * 2u; voffB[i] = (unsigned)(Rb * K + C) * 2u; }
    unsigned vC[2][2];
#define PG8_GROWS(u, dst) do { _Pragma("unroll") for (int h_ = 0; h_ < 2; ++h_) _Pragma("unroll") for (int i_ = 0; i_ < 2; ++i_) { int R_, C_; stage_rc(tid * 16 + i_ * 8192, R_, C_); \
        dst[h_][i_] = (unsigned)g.rowtok[(u).pm * BM + h_ * HALF + R_] * (unsigned)(K * 2) + (unsigned)(C_ * 2); } } while (0)
    const size_t kstep = (size_t)(BK * 2);
    const size_t hstep = (size_t)HALF * K * 2;
    const size_t tstep = 2 * hstep;
    const unsigned ldsw = (unsigned)wid * 1024u;
    const int aoff = lds_byte(wr * 64 + fr, fq * 8), boff = lds_byte(wc * 32 + fr, fq * 8);
#define PG8_SA(b, h) (((b) * 2 + (h)) * HTB)
#define PG8_SB(b, h) ((4 + (b) * 2 + (h)) * HTB)
#define PG8_STAGE(bufoff, gbase, voff) do { _Pragma("unroll") for (int _i = 0; _i < 2; ++_i) \
        __builtin_amdgcn_global_load_lds((const unsigned*)((const char*)(gbase) + (voff)[_i]), (LAS unsigned*)(lds + (bufoff) + ldsw + _i * 8192), 16, 0, 0); } while (0)
#define PG8_STAGE_A(bufoff, p, h, nx) do { if constexpr (GATHER) { PG8_STAGE(bufoff, p, vC[h]); } else PG8_STAGE(bufoff, (p) + (h) * hstep, voffA); } while (0)
#define PG8_LDA(dst, b, h) do { _Pragma("unroll") for (int m = 0; m < 4; ++m) _Pragma("unroll") for (int k = 0; k < 2; ++k) dst[m][k] = *(const LAS bf16x8*)(lds + PG8_SA(b, h) + aoff + m * 2048 + k * 1024); } while (0)
#define PG8_LDB(dst, b, h) do { _Pragma("unroll") for (int n = 0; n < 2; ++n) _Pragma("unroll") for (int k = 0; k < 2; ++k) dst[n][k] = *(const LAS bf16x8*)(lds + PG8_SB(b, h) + boff + n * 2048 + k * 1024); } while (0)
#define PG8_MMA(ai, bj, At, Bt) do { __builtin_amdgcn_s_setprio(1); \
        if constexpr (FP8) { _Pragma("unroll") for (int m = 0; m < 4; ++m) _Pragma("unroll") for (int n = 0; n < 2; ++n) \
            { const i32x8 b8_ = cat8(Bt[n][0], Bt[n][1]), a8_ = cat8(At[m][0], At[m][1]); asm volatile("v_mfma_f32_16x16x128_f8f6f4 %0, %1, %2, %0" : "+v"(acc[ai][bj][m][n]) : "v"(b8_), "v"(a8_)); } } \
        else { _Pragma("unroll") for (int m = 0; m < 4; ++m) _Pragma("unroll") for (int n = 0; n < 2; ++n) _Pragma("unroll") for (int k = 0; k < 2; ++k) \
            acc[ai][bj][m][n] = __builtin_amdgcn_mfma_f32_16x16x32_bf16(Bt[n][k], At[m][k], acc[ai][bj][m][n], 0, 0, 0); } \
        __builtin_amdgcn_s_setprio(0); } while (0)
#define PG8_WAIT_V(n) asm volatile("s_waitcnt vmcnt(" #n ")" ::: "memory")
#define PG8_WAIT_L(n) asm volatile("s_waitcnt lgkmcnt(" #n ")" ::: "memory")
#define PG8_BAR __builtin_amdgcn_s_barrier()
#define PG8_SCHED __builtin_amdgcn_sched_barrier(0)
#define PG8_UPTR(u, pa, pb) do { unsigned _e = g.texp ? ld_u32_agent(g.texp + (u).pm) : 0u; _e = (unsigned)__builtin_amdgcn_readfirstlane((int)_e); (u).e = (int)_e; \
        pa = GATHER ? (const char*)g.A : (const char*)g.A + (size_t)(u).pm * tstep; pb = (const char*)g.Bt + (size_t)_e * g.bstride + (size_t)(u).pn * tstep; } while (0)
    Unit cur, nxt; int ui = 0;
    if (!S.next(0, cur)) return;
    f32x4 acc[2][2][4][2];
#pragma unroll
    for (int a = 0; a < 2; ++a)
#pragma unroll
        for (int b = 0; b < 2; ++b)
#pragma unroll
            for (int m = 0; m < 4; ++m)
#pragma unroll
                for (int n = 0; n < 2; ++n) acc[a][b][m][n] = (f32x4){0.f, 0.f, 0.f, 0.f};
    bf16x8 At[4][2], B0[2][2], B1[2][2];
    const char* cA; const char* cB;
    PG8_UPTR(cur, cA, cB);
    if constexpr (GATHER) { PG8_GROWS(cur, vC); }
    if constexpr (SP2) {
        PG8_STAGE(PG8_SB(0, 0), cB, voffB); PG8_STAGE(PG8_SB(0, 1), cB + hstep, voffB); PG8_STAGE_A(PG8_SA(0, 0), cA, 0, false); PG8_STAGE_A(PG8_SA(0, 1), cA, 1, false);
        if (wr == 1) PG8_BAR;
        PG8_WAIT_V(2); PG8_BAR;
        PG8_STAGE(PG8_SB(1, 0), cB + kstep, voffB); PG8_STAGE_A(PG8_SA(1, 0), cA + kstep, 0, false); PG8_STAGE(PG8_SB(1, 1), cB + hstep + kstep, voffB);
        PG8_WAIT_V(6); PG8_BAR;
    } else {
        PG8_STAGE(PG8_SB(0, 0), cB, voffB); PG8_STAGE_A(PG8_SA(0, 0), cA, 0, false); PG8_STAGE(PG8_SB(0, 1), cB + hstep, voffB); PG8_STAGE_A(PG8_SA(0, 1), cA, 1, false);
        if (wr == 1) PG8_BAR;
        PG8_WAIT_V(4); PG8_BAR;
        PG8_STAGE(PG8_SB(1, 0), cB + kstep, voffB); PG8_STAGE_A(PG8_SA(1, 0), cA + kstep, 0, false); PG8_STAGE(PG8_SB(1, 1), cB + hstep + kstep, voffB);
        PG8_WAIT_V(6); PG8_BAR;
    }
    for (;;) {
        const bool has_next = S.next(ui + 1, nxt);
        const char* nA = cA; const char* nB = cB;
        if (has_next) PG8_UPTR(nxt, nA, nB);
#pragma unroll 1
        for (int t = 0; t < nt; t += 2) {
            const bool last = (t == nt - 2);
            const char* a1 = cA + (size_t)(t + 1) * kstep;
            const char* a2 = last ? nA : cA + (size_t)(t + 2) * kstep; const char* b2 = last ? nB : cB + (size_t)(t + 2) * kstep;
            const char* a3 = a2 + kstep; const char* b3 = b2 + kstep;
            if constexpr (SP2) {
            PG8_LDB(B0, 0, 0); PG8_LDB(B1, 0, 1); PG8_SCHED; PG8_LDA(At, 0, 0); PG8_STAGE_A(PG8_SA(1, 1), a1, 1, false);
            if constexpr (GATHER) { if (last && has_next) { PG8_GROWS(nxt, vC); } }
            PG8_WAIT_V(8); PG8_WAIT_L(0); PG8_BAR; PG8_MMA(0, 0, At, B0); PG8_MMA(0, 1, At, B1); PG8_BAR; PG8_SCHED;
            PG8_LDA(At, 0, 1); PG8_STAGE(PG8_SB(0, 0), b2, voffB); PG8_STAGE(PG8_SB(0, 1), b2 + hstep, voffB); PG8_STAGE_A(PG8_SA(0, 0), a2, 0, last);
            PG8_WAIT_V(8); PG8_WAIT_L(0); PG8_BAR; PG8_MMA(1, 0, At, B0); PG8_MMA(1, 1, At, B1); PG8_BAR; PG8_SCHED;
            PG8_LDB(B0, 1, 0); PG8_LDB(B1, 1, 1); PG8_SCHED; PG8_LDA(At, 1, 0); PG8_STAGE_A(PG8_SA(0, 1), a2, 1, last);
            PG8_WAIT_V(8); PG8_WAIT_L(0); PG8_BAR; PG8_MMA(0, 0, At, B0); PG8_MMA(0, 1, At, B1); PG8_BAR; PG8_SCHED;
            PG8_LDA(At, 1, 1); PG8_STAGE(PG8_SB(1, 0), b3, voffB); PG8_STAGE(PG8_SB(1, 1), b3 + hstep, voffB); PG8_STAGE_A(PG8_SA(1, 0), a3, 0, last);
            PG8_WAIT_V(8); PG8_WAIT_L(0); PG8_BAR; PG8_MMA(1, 0, At, B0); PG8_MMA(1, 1, At, B1); PG8_BAR; PG8_SCHED;
            } else {
            PG8_LDB(B0, 0, 0); PG8_SCHED; PG8_LDA(At, 0, 0); PG8_STAGE_A(PG8_SA(1, 1), a1, 1, false);
            if constexpr (GATHER) { if (last && has_next) { PG8_GROWS(nxt, vC); } }
            PG8_WAIT_L(8); PG8_BAR; PG8_WAIT_L(0); PG8_MMA(0, 0, At, B0); PG8_BAR; PG8_SCHED;
            PG8_LDB(B1, 0, 1); PG8_STAGE(PG8_SB(0, 0), b2, voffB);
            PG8_BAR; PG8_WAIT_L(0); PG8_MMA(0, 1, At, B1); PG8_BAR;
            PG8_LDA(At, 0, 1); PG8_STAGE_A(PG8_SA(0, 0), a2, 0, last);
            PG8_BAR; PG8_WAIT_L(0); PG8_MMA(1, 0, At, B0); PG8_BAR; PG8_SCHED;
            PG8_STAGE(PG8_SB(0, 1), b2 + hstep, voffB);
            PG8_WAIT_V(6); PG8_BAR; PG8_MMA(1, 1, At, B1); PG8_BAR;
            PG8_LDB(B0, 1, 0); PG8_SCHED; PG8_LDA(At, 1, 0); PG8_STAGE_A(PG8_SA(0, 1), a2, 1, last);
            PG8_WAIT_L(8); PG8_BAR; PG8_WAIT_L(0); PG8_MMA(0, 0, At, B0); PG8_BAR; PG8_SCHED;
            PG8_LDB(B1, 1, 1); PG8_STAGE(PG8_SB(1, 0), b3, voffB);
            PG8_BAR; PG8_WAIT_L(0); PG8_MMA(0, 1, At, B1); PG8_BAR;
            PG8_LDA(At, 1, 1); PG8_STAGE_A(PG8_SA(1, 0), a3, 0, last);
            PG8_BAR; PG8_WAIT_L(0); PG8_MMA(1, 0, At, B0); PG8_BAR; PG8_SCHED;
            PG8_STAGE(PG8_SB(1, 1), b3 + hstep, voffB);
            PG8_WAIT_V(6); PG8_BAR; PG8_MMA(1, 1, At, B1); PG8_BAR;
            }
        }
        if constexpr (ALIGN_EPI) { if (wr == 0) PG8_BAR; }
        if constexpr (FP8) { asm volatile("s_nop 15\n\ts_nop 15" ::: "memory"); PG8_SCHED; }
        E(acc, cur, wr, wc, fr, fq);
        if (!has_next) break;
#pragma unroll
        for (int a = 0; a < 2; ++a)
#pragma unroll
            for (int b = 0; b < 2; ++b)
#pragma unroll
                for (int m = 0; m < 4; ++m)
#pragma unroll
                    for (int n = 0; n < 2; ++n) acc[a][b][m][n] = (f32x4){0.f, 0.f, 0.f, 0.f};
        cur = nxt; cA = nA; cB = nB; ++ui;
        if constexpr (ALIGN_EPI) { if (wr == 1) PG8_BAR; }
    }
    PG8_WAIT_V(0);
    if constexpr (!ALIGN_EPI) { if (wr == 0) PG8_BAR; }
    PG8_BAR;
#undef PG8_SA
#undef PG8_SB
#undef PG8_STAGE
#undef PG8_LDA
#undef PG8_LDB
#undef PG8_MMA
#undef PG8_WAIT_V
#undef PG8_WAIT_L
#undef PG8_BAR
#undef PG8_SCHED
#undef PG8_UPTR
#undef PG8_STAGE_A
#undef PG8_GROWS
}

struct EpiProj {
    static constexpr bool PERM = true;
    bf16 *q, *k, *vT, *p;
    __device__ __forceinline__ void operator()(const f32x4 (&acc)[2][2][4][2], const Unit& u, int wr, int wc, int fr, int fq) const {
        const int row0 = u.pm * BM + wr * 64 + fr;
        const int pn = u.pn;
#pragma unroll
        for (int ai = 0; ai < 2; ++ai)
#pragma unroll
            for (int m = 0; m < 4; ++m) {
                const int row = row0 + ai * HALF + m * 16;
#pragma unroll
                for (int bj = 0; bj < 2; ++bj) {
                    f32x4 v0 = acc[ai][bj][m][0], v1 = acc[ai][bj][m][1];
                    const int col = pn * BM + bj * HALF + wc * 32 + 8 * fq;
                    if (pn >= 4 && pn < 6) {
                        const int cv = col - 1024, hh = cv >> 6, dim = cv & 63, b = row / T, t = row % T;
                        bf16* dst = vT + ((size_t)(((b * NH + hh) * GROWS + (t >> 6)) * HD + dim)) * 64 + (t & 63);
                        const unsigned w0 = cvt_pk_bf16(v0[0], v0[1]), w1 = cvt_pk_bf16(v0[2], v0[3]), w2 = cvt_pk_bf16(v1[0], v1[1]), w3 = cvt_pk_bf16(v1[2], v1[3]);
                        dst[0 * 64] = (bf16)(w0 & 0xffff); dst[1 * 64] = (bf16)(w0 >> 16); dst[2 * 64] = (bf16)(w1 & 0xffff); dst[3 * 64] = (bf16)(w1 >> 16);
                        dst[4 * 64] = (bf16)(w2 & 0xffff); dst[5 * 64] = (bf16)(w2 >> 16); dst[6 * 64] = (bf16)(w3 & 0xffff); dst[7 * 64] = (bf16)(w3 >> 16);
                        asm volatile("s_waitcnt vmcnt(40)" ::: "memory");
                    } else {
                        bf16* dst;
                        if (pn < 2) { v0 = v0 * 0.125f; v1 = v1 * 0.125f; dst = q + (size_t)row * CW + col; }
                        else if (pn < 4) dst = k + (size_t)row * CW + (col - 512);
                        else dst = p + (size_t)row * PW + (col - 1536);
                        u32x4 w; w.x = cvt_pk_bf16(v0[0], v0[1]); w.y = cvt_pk_bf16(v0[2], v0[3]); w.z = cvt_pk_bf16(v1[0], v1[1]); w.w = cvt_pk_bf16(v1[2], v1[3]);
                        *(u32x4*)dst = w;
                    }
                }
            }
    }
};
struct EpiWo {
    static constexpr bool PERM = true;
    const float* x; bf16* h;
    __device__ __forceinline__ void operator()(const f32x4 (&acc)[2][2][4][2], const Unit& u, int wr, int wc, int fr, int fq) const {
        const int row0 = u.pm * BM + wr * 64 + fr, col0 = u.pn * BM + wc * 32 + 8 * fq;
#pragma unroll
        for (int ai = 0; ai < 2; ++ai)
#pragma unroll
            for (int m = 0; m < 4; ++m) { const size_t off = (size_t)(row0 + ai * HALF + m * 16) * D + col0;
#pragma unroll
                for (int bj = 0; bj < 2; ++bj) { const f32x4 v0 = acc[ai][bj][m][0] + *(const f32x4*)(x + off + bj * HALF), v1 = acc[ai][bj][m][1] + *(const f32x4*)(x + off + bj * HALF + 4);
                    u32x4 w; w.x = cvt_pk_bf16(v0[0], v0[1]); w.y = cvt_pk_bf16(v0[2], v0[3]); w.z = cvt_pk_bf16(v1[0], v1[1]); w.w = cvt_pk_bf16(v1[2], v1[3]);
                    *(u32x4*)(h + off + bj * HALF) = w; } }
    }
};
struct EpiUp {
    static constexpr bool PERM = true;
    const float* b_up; unsigned char* act;
    __device__ __forceinline__ void operator()(const f32x4 (&acc)[2][2][4][2], const Unit& u, int wr, int wc, int fr, int fq) const {
        const int row0 = u.pm * BM + wr * 64 + fr, ch = u.pn * 128 + wc * 32 + 8 * fq;
        const float* bg = b_up + (size_t)u.e * 2048 + ch; const float* bl = bg + 1024;
        const f32x4 bg0 = *(const f32x4*)bg * F8_SACT, bg1 = *(const f32x4*)(bg + 4) * F8_SACT, bl0 = *(const f32x4*)bl, bl1 = *(const f32x4*)(bl + 4);
        constexpr float SG = F8_SACT / (F8_SX * F8_SW), SL = 1.0f / (F8_SX * F8_SW), KE = -1.702f * 1.44269504f / F8_SACT;
#pragma unroll
        for (int ai = 0; ai < 2; ++ai)
#pragma unroll
            for (int m = 0; m < 4; ++m) {
                float o[8];
#pragma unroll
                for (int n = 0; n < 2; ++n) { const f32x4 ga = acc[ai][0][m][n], la = acc[ai][1][m][n]; const f32x4 bgn = n ? bg1 : bg0, bln = n ? bl1 : bl0;
#pragma unroll
                    for (int hj = 0; hj < 2; ++hj) {
                        const f32x2 gv = __builtin_elementwise_fma((f32x2){ga[2 * hj], ga[2 * hj + 1]}, (f32x2){SG, SG}, (f32x2){bgn[2 * hj], bgn[2 * hj + 1]});
                        const f32x2 lv = __builtin_elementwise_fma((f32x2){la[2 * hj], la[2 * hj + 1]}, (f32x2){SL, SL}, (f32x2){bln[2 * hj], bln[2 * hj + 1]});
                        const f32x2 gt = {fminf(gv.x, 7.0f * F8_SACT), fminf(gv.y, 7.0f * F8_SACT)};
                        const f32x2 li = {__builtin_amdgcn_fmed3f(lv.x, -7.0f, 7.0f), __builtin_amdgcn_fmed3f(lv.y, -7.0f, 7.0f)};
                        const f32x2 zk = __builtin_elementwise_fma(gt, (f32x2){KE, KE}, (f32x2){-0.0f, -0.0f});
                        const f32x2 ez = {__builtin_amdgcn_exp2f(zk.x), __builtin_amdgcn_exp2f(zk.y)};
                        const f32x2 den = __builtin_elementwise_fma(ez, (f32x2){1.0f, 1.0f}, (f32x2){1.0f, 1.0f});
                        const f32x2 rc = {__builtin_amdgcn_rcpf(den.x), __builtin_amdgcn_rcpf(den.y)};
                        const f32x2 t = __builtin_elementwise_fma(gt, rc, (f32x2){-0.0f, -0.0f});
                        const f32x2 ov = __builtin_elementwise_fma(li, t, t);
                        o[n * 4 + 2 * hj] = ov.x; o[n * 4 + 2 * hj + 1] = ov.y; } }
                int w0 = 0, w1 = 0;
                w0 = __builtin_amdgcn_cvt_pk_fp8_f32(o[0], o[1], w0, false); w0 = __builtin_amdgcn_cvt_pk_fp8_f32(o[2], o[3], w0, true);
                w1 = __builtin_amdgcn_cvt_pk_fp8_f32(o[4], o[5], w1, false); w1 = __builtin_amdgcn_cvt_pk_fp8_f32(o[6], o[7], w1, true);
                u32x2 w8; w8.x = (unsigned)w0; w8.y = (unsigned)w1;
                *(u32x2*)(act + (size_t)(row0 + ai * HALF + m * 16) * DE + ch) = w8;
            }
    }
};
struct EpiDown {
    static constexpr bool PERM = true;
    const float* b_dn; unsigned char* y;
    __device__ __forceinline__ void operator()(const f32x4 (&acc)[2][2][4][2], const Unit& u, int wr, int wc, int fr, int fq) const {
        const int row0 = u.pm * BM + wr * 64 + fr, col0 = u.pn * BM + wc * 32 + 8 * fq;
        const float* bb = b_dn + (size_t)u.e * D + col0;
        f32x4 bv[2][2];
#pragma unroll
        for (int bj = 0; bj < 2; ++bj)
#pragma unroll
            for (int n = 0; n < 2; ++n) bv[bj][n] = *(const f32x4*)(bb + bj * HALF + 4 * n) * F8_SY;
#pragma unroll
        for (int ai = 0; ai < 2; ++ai)
#pragma unroll
            for (int m = 0; m < 4; ++m) { unsigned char* rowp = y + (size_t)(row0 + ai * HALF + m * 16) * D + col0;
#pragma unroll
                for (int bj = 0; bj < 2; ++bj) { const f32x4 v0 = acc[ai][bj][m][0] * (F8_SY / (F8_SACT * F8_SW)) + bv[bj][0], v1 = acc[ai][bj][m][1] * (F8_SY / (F8_SACT * F8_SW)) + bv[bj][1];
                    u32x2 w; w.x = pk4_fp8(v0[0], v0[1], v0[2], v0[3]); w.y = pk4_fp8(v1[0], v1[1], v1[2], v1[3]);
                    *(u32x2*)(rowp + bj * HALF) = w; } }
    }
};
}


#define XB_TMO      128
#define XB_XCNT(j)  (256  + 64 * (j))
#define XB_XSUB(j)  (1280 + 64 * (j))
#define XB_XGEN(j)  (2304 + 64 * (j))
#define XB_TOP      3328
#define XB_TOPGEN   3392
#define XCD_BAR_WORDS 3456
#define XB_SPIN_CAP (1u << 20)
__device__ __forceinline__ unsigned xb_ld(unsigned* p)              { return __hip_atomic_load(p, __ATOMIC_RELAXED, __HIP_MEMORY_SCOPE_AGENT); }
__device__ __forceinline__ unsigned xb_add(unsigned* p, unsigned v) { return __hip_atomic_fetch_add(p, v, __ATOMIC_RELAXED, __HIP_MEMORY_SCOPE_AGENT); }
__device__ __forceinline__ unsigned xb_xcc_id() { return (unsigned)__builtin_amdgcn_s_getreg((3 << 11) | 20) & 0xFu; }
#define XB_SPIN(cond, bar) do { unsigned _sp = 0; while (cond) { __builtin_amdgcn_s_sleep(1); \
    if ((++_sp & 255u) == 0u) { if (xb_ld(&(bar)[XB_TMO])) break; if (_sp > XB_SPIN_CAP) { atomicAdd(&(bar)[XB_TMO], 1u); break; } } } } while (0)
struct XcdBarrier { unsigned* bar; unsigned x; volatile LAS unsigned* st; };
__device__ __forceinline__ XcdBarrier xcd_barrier_post(unsigned* bar, volatile LAS unsigned* st) {
    XcdBarrier b; b.bar = bar; b.x = xb_xcc_id(); b.st = st;
    if (threadIdx.x == 0) (void)xb_add(&bar[XB_XCNT(b.x)], 1u);
    return b;
}
__device__ __forceinline__ void xcd_barrier_complete(unsigned* bar, unsigned x, unsigned& nloc, unsigned& nx) {
    const unsigned G = gridDim.x * gridDim.y * gridDim.z;
    unsigned sum, cnt, mine, sp = 0u;
    for (;;) {
        sum = 0u; cnt = 0u; mine = 0u;
#pragma unroll
        for (unsigned j = 0; j < 16; ++j) { const unsigned c = xb_ld(&bar[XB_XCNT(j)]); sum += c; cnt += (c > 0u) ? 1u : 0u; mine = (j == x) ? c : mine; }
        if (sum == G) break;
        __builtin_amdgcn_s_sleep(1);
        if ((++sp & 255u) == 0u) { if (xb_ld(&bar[XB_TMO])) break; if (sp > XB_SPIN_CAP) { atomicAdd(&bar[XB_TMO], 1u); break; } }
    }
    nloc = mine > 0u ? mine : 1u; nx = cnt > 0u ? cnt : 1u;
}
__device__ __forceinline__ void xcd_barrier(const XcdBarrier& b) {
    asm volatile("s_waitcnt vmcnt(0)" ::: "memory");
    __syncthreads();
    if (threadIdx.x == 0) {
        unsigned* bar = b.bar;
        __builtin_amdgcn_s_waitcnt(0);
        unsigned nloc = b.st[0], nx = b.st[1];
        if (nloc == 0u) { xcd_barrier_complete(bar, b.x, nloc, nx); b.st[0] = nloc; b.st[1] = nx; }
        const unsigned old = xb_add(&bar[XB_XSUB(b.x)], 1u);
        const unsigned gen = old / nloc;
        if (old + 1u == (gen + 1u) * nloc) {
            __builtin_amdgcn_fence(__ATOMIC_RELEASE, "agent");
            asm volatile("s_waitcnt vmcnt(0)" ::: "memory");
            const unsigned og = xb_add(&bar[XB_TOP], 1u);
            const unsigned tg = og / nx;
            if (og + 1u == (tg + 1u) * nx) xb_add(&bar[XB_TOPGEN], 1u);
            else XB_SPIN(xb_ld(&bar[XB_TOPGEN]) == tg, bar);
            __builtin_amdgcn_fence(__ATOMIC_ACQUIRE, "agent");
            xb_add(&bar[XB_XGEN(b.x)], 1u);
            asm volatile("s_waitcnt vmcnt(0)" ::: "memory");
        } else {
            XB_SPIN(xb_ld(&bar[XB_XGEN(b.x)]) == gen, bar);
            __builtin_amdgcn_fence(__ATOMIC_ACQUIRE, "agent");
            asm volatile("s_waitcnt vmcnt(0)" ::: "memory");
        }
    }
    __syncthreads();
}

struct Args { const float* in[26]; float* out; unsigned char* ws; int ph_lo, ph_hi; };

struct Frame { LAS unsigned char* lds; int tid, lane, wave, G, vcu; };

__device__ __forceinline__ void transpose_item(const float* W, int K, int N, bf16* WT, int k0, int n0, int orow0, LAS float* scr, int lane) {
#pragma unroll 8
    for (int i = 0; i < 32; ++i) { const int kk = 2 * i + (lane >> 5); scr[kk * 33 + (lane & 31)] = W[(size_t)(k0 + kk) * N + n0 + (lane & 31)]; }
    asm volatile("s_waitcnt lgkmcnt(0)" ::: "memory");
    const int c = lane & 7;
#pragma unroll
    for (int j = 0; j < 4; ++j) { const int n = (lane >> 3) + 8 * j; const LAS float* s = scr + (8 * c) * 33 + n;
        u32x4 o; o.x = cvt_pk_bf16(s[0 * 33], s[1 * 33]); o.y = cvt_pk_bf16(s[2 * 33], s[3 * 33]); o.z = cvt_pk_bf16(s[4 * 33], s[5 * 33]); o.w = cvt_pk_bf16(s[6 * 33], s[7 * 33]);
        *(u32x4*)(WT + (size_t)(orow0 + n) * K + k0 + 8 * c) = o; }
    asm volatile("s_waitcnt lgkmcnt(0)" ::: "memory");
}

__device__ __forceinline__ void transpose_item8w(const float* W, int K, int N, unsigned char* WT, int k0, int n0, int orow0, LAS float* scr, int lane) {
#pragma unroll 8
    for (int i = 0; i < 64; ++i) { const int kk = 2 * i + (lane >> 5); scr[kk * 33 + (lane & 31)] = W[(size_t)(k0 + kk) * N + n0 + (lane & 31)]; }
    asm volatile("s_waitcnt lgkmcnt(0)" ::: "memory");
    const int c = lane & 7;
#pragma unroll
    for (int j = 0; j < 4; ++j) { const int n = (lane >> 3) + 8 * j; const LAS float* s = scr + (16 * c) * 33 + n;
        u32x4 o; o.x = pk4_fp8(s[0 * 33] * F8_SW, s[1 * 33] * F8_SW, s[2 * 33] * F8_SW, s[3 * 33] * F8_SW); o.y = pk4_fp8(s[4 * 33] * F8_SW, s[5 * 33] * F8_SW, s[6 * 33] * F8_SW, s[7 * 33] * F8_SW);
        o.z = pk4_fp8(s[8 * 33] * F8_SW, s[9 * 33] * F8_SW, s[10 * 33] * F8_SW, s[11 * 33] * F8_SW); o.w = pk4_fp8(s[12 * 33] * F8_SW, s[13 * 33] * F8_SW, s[14 * 33] * F8_SW, s[15 * 33] * F8_SW);
        *(u32x4*)(WT + (size_t)(orow0 + n) * K + k0 + 16 * c) = o; }
    asm volatile("s_waitcnt lgkmcnt(0)" ::: "memory");
}
__device__ __forceinline__ void transpose_item8(const float* W, int K, int N, unsigned char* WT, int k0, int n0, int orow0, LAS float* scr, int lane) {
#pragma unroll 8
    for (int i = 0; i < 32; ++i) { const int kk = 2 * i + (lane >> 5); scr[kk * 33 + (lane & 31)] = W[(size_t)(k0 + kk) * N + n0 + (lane & 31)]; }
    asm volatile("s_waitcnt lgkmcnt(0)" ::: "memory");
    const int c = lane & 7;
#pragma unroll
    for (int j = 0; j < 4; ++j) { const int n = (lane >> 3) + 8 * j; const LAS float* s = scr + (8 * c) * 33 + n;
        u32x2 o; o.x = pk4_fp8(s[0 * 33] * F8_SW, s[1 * 33] * F8_SW, s[2 * 33] * F8_SW, s[3 * 33] * F8_SW); o.y = pk4_fp8(s[4 * 33] * F8_SW, s[5 * 33] * F8_SW, s[6 * 33] * F8_SW, s[7 * 33] * F8_SW);
        *(u32x2*)(WT + (size_t)(orow0 + n) * K + k0 + 8 * c) = o; }
    asm volatile("s_waitcnt lgkmcnt(0)" ::: "memory");
}

constexpr int WC_BLOCKS = 32 * 8 * 8 + 32 * 8 * 4;
#ifndef WC_P0
#define WC_P0 0
#endif
__device__ __forceinline__ void wconv_blocks(const Frame& F, const Args& a, const int lo, const int hi, const int first, const int stride) {
    unsigned char* ws = a.ws;
    {
        constexpr int BI_UP = 32 * 8 * 8, BI_DN = 32 * 8 * 4, WP = 257;
        LAS float* tile = (LAS float*)F.lds;
        const int lane = F.lane, w = F.wave, c = lane & 7;
        for (int bi = lo + first; bi < hi; bi += stride) {
            const bool up = bi < BI_UP; const int r2 = up ? bi : bi - BI_UP;
            const int e = up ? r2 >> 6 : r2 >> 5, q = up ? r2 & 63 : r2 & 31, kb = up ? q >> 3 : q >> 2, nb = up ? q & 7 : q & 3;
            const int N = up ? 2048 : 1024, k0 = kb * 128, n0 = nb * 256;
            const float* W = (up ? a.in[21] + (size_t)e * 1024 * 2048 : a.in[23] + (size_t)e * 1024 * 1024) + (size_t)k0 * N + n0 + 4 * lane;
            unsigned char* WT = (up ? ws + WS_WUPT + (size_t)e * 2048 * 1024 : ws + WS_WDNT + (size_t)e * 1024 * 1024) + k0 + 16 * c;
            asm volatile("s_waitcnt vmcnt(40) lgkmcnt(0)" ::: "memory"); __builtin_amdgcn_s_barrier(); asm volatile("" ::: "memory");
            f32x4 v[16];
#pragma unroll
            for (int i = 0; i < 16; ++i) v[i] = *(const f32x4*)(W + (size_t)(16 * w + i) * N);
#pragma unroll
            for (int i = 0; i < 16; ++i) { LAS float* t = tile + (16 * w + i) * WP + 4 * lane; t[0] = v[i].x; t[1] = v[i].y; t[2] = v[i].z; t[3] = v[i].w; }
            __syncthreads();
#pragma unroll
            for (int j = 0; j < 4; ++j) { const int nl = 32 * w + (lane >> 3) + 8 * j, n = n0 + nl;
                const int orow = up ? (n < 1024 ? 256 * (n >> 7) + (n & 127) : 256 * ((n - 1024) >> 7) + 128 + ((n - 1024) & 127)) : n;
                const LAS float* sp = tile + (16 * c) * WP + nl;
                u32x4 o; o.x = pk4_fp8(sp[0 * WP] * F8_SW, sp[1 * WP] * F8_SW, sp[2 * WP] * F8_SW, sp[3 * WP] * F8_SW); o.y = pk4_fp8(sp[4 * WP] * F8_SW, sp[5 * WP] * F8_SW, sp[6 * WP] * F8_SW, sp[7 * WP] * F8_SW);
                o.z = pk4_fp8(sp[8 * WP] * F8_SW, sp[9 * WP] * F8_SW, sp[10 * WP] * F8_SW, sp[11 * WP] * F8_SW); o.w = pk4_fp8(sp[12 * WP] * F8_SW, sp[13 * WP] * F8_SW, sp[14 * WP] * F8_SW, sp[15 * WP] * F8_SW);
                *(u32x4*)(WT + (size_t)orow * 1024) = o; }
        }
        __syncthreads(); }
}

__device__ __forceinline__ void p0_prologue(const Frame& F, const Args& a) {
    unsigned char* ws = a.ws;
    LAS float* scr = (LAS float*)(F.lds + F.wave * 8448);
    const int gw = F.vcu * 8 + F.wave, NGW = F.G * 8;
    constexpr int I_IN = 16 * 108, I_L = 16, I_G = 32;
    constexpr int NITEMS = I_IN + 2 * I_L + 2 * I_L + I_G;
    for (int it = gw; it < NITEMS; it += NGW) {
        int r = it;
        if (r < I_IN) { const int kb = r / 108, nb = r % 108; transpose_item(a.in[2], 1024, NPROJ, (bf16*)(ws + WS_WINT), kb * 64, nb * 32, nb * 32, scr, F.lane); continue; }
        r -= I_IN;
        if (r < 2 * I_L) { const int z = r / 16, nb = r % 16; transpose_item(a.in[8] + (size_t)z * 64 * 512, 64, 512, (bf16*)(ws + WS_W2T) + (size_t)z * 512 * 64, 0, nb * 32, nb * 32, scr, F.lane); continue; }
        r -= 2 * I_L;
        if (r < 2 * I_L) { const int z = r / 16, nb = r % 16; transpose_item(a.in[10] + (size_t)z * 64 * 512, 64, 512, (bf16*)(ws + WS_A2T) + (size_t)z * 512 * 64, 0, nb * 32, nb * 32, scr, F.lane); continue; }
        r -= 2 * I_L;
        { const int kb = r / 16, nb = r % 16; transpose_item(a.in[11], 128, 512, (bf16*)(ws + WS_G2T), kb * 64, nb * 32, nb * 32, scr, F.lane); }
    }
    wconv_blocks(F, a, 0, WC_P0, F.vcu, F.G);
    { u32x4* z = (u32x4*)(ws + WS_WINT + (size_t)NPROJ * 1024 * 2); const u32x4 zero = {0u, 0u, 0u, 0u};
      for (int i = F.vcu * 512 + F.tid; i < 16384; i += F.G * 512) z[i] = zero; }
    const float* x = a.in[0]; const float* nw = a.in[1]; bf16* hn = (bf16*)(ws + WS_HN);
    f32x4 wv[4];
#pragma unroll
    for (int j = 0; j < 4; ++j) wv[j] = *((const f32x4*)nw + F.lane + 64 * j);
    for (int m = gw; m < M; m += 2 * NGW) {
        const int m1 = m + NGW; const bool has1 = m1 < M;
        const f32x4* xr0 = (const f32x4*)(x + (size_t)m * D) + F.lane; const f32x4* xr1 = (const f32x4*)(x + (size_t)(has1 ? m1 : m) * D) + F.lane;
        f32x4 v0[4], v1[4]; float s0 = 0.f, s1 = 0.f;
#pragma unroll
        for (int j = 0; j < 4; ++j) { v0[j] = xr0[64 * j]; v1[j] = xr1[64 * j]; }
#pragma unroll
        for (int j = 0; j < 4; ++j) { s0 += (v0[j].x * v0[j].x + v0[j].y * v0[j].y) + (v0[j].z * v0[j].z + v0[j].w * v0[j].w); s1 += (v1[j].x * v1[j].x + v1[j].y * v1[j].y) + (v1[j].z * v1[j].z + v1[j].w * v1[j].w); }
        const float rs0 = rsqrtf(wave_sum(s0) * (1.f / D) + RMS_EPS), rs1 = rsqrtf(wave_sum(s1) * (1.f / D) + RMS_EPS);
        u32x2* o0 = (u32x2*)(hn + (size_t)m * D) + F.lane; u32x2* o1 = (u32x2*)(hn + (size_t)m1 * D) + F.lane;
#pragma unroll
        for (int j = 0; j < 4; ++j) { u32x2 o; o.x = cvt_pk_bf16(v0[j].x * rs0 * wv[j].x, v0[j].y * rs0 * wv[j].y); o.y = cvt_pk_bf16(v0[j].z * rs0 * wv[j].z, v0[j].w * rs0 * wv[j].w); o0[64 * j] = o; }
        if (has1) {
#pragma unroll
            for (int j = 0; j < 4; ++j) { u32x2 o; o.x = cvt_pk_bf16(v1[j].x * rs1 * wv[j].x, v1[j].y * rs1 * wv[j].y); o.y = cvt_pk_bf16(v1[j].z * rs1 * wv[j].z, v1[j].w * rs1 * wv[j].w); o1[64 * j] = o; } }
    }
}

constexpr int PREP_KBUF = 0, PREP_INV = 65536, PREP_AW = 67584, PREP_AA = PREP_AW + 17408, PREP_AG = PREP_AA + 17408, PREP_LD = 136, PREP_MU = PREP_AG + 17408  , PREP_PAR = PREP_MU + 15360  ;
template <bool STORE>
__device__ __forceinline__ void prep_phase(const Frame& F, const Args& a) {
    unsigned char* ws = a.ws;
    const bf16* p = (const bf16*)(ws + WS_P);
    bf16* r_out = (bf16*)(ws + WS_R); bf16* v_out = (bf16*)(ws + WS_V); bf16* kk_out = (bf16*)(ws + WS_KK);
    bf16* decay_out = (bf16*)(ws + WS_DECAY); bf16* kdir_out = (bf16*)(ws + WS_KDIR); bf16* akk_out = (bf16*)(ws + WS_AKK); bf16* g_out = (bf16*)(ws + WS_G);
    const bf16* w2T = (const bf16*)(ws + WS_W2T); const bf16* a2T = (const bf16*)(ws + WS_A2T); const bf16* g2T = (const bf16*)(ws + WS_G2T);
    const float* mu_p = a.in[5]; const float* mu_n = a.in[6]; const float* w0 = a.in[7]; const float* a0 = a.in[9];
    const float* k_k = a.in[12]; const float* k_a = a.in[13];
    LAS bf16* kbuf = (LAS bf16*)(F.lds + PREP_KBUF); LAS float* invb = (LAS float*)(F.lds + PREP_INV);
    LAS bf16* Aw = (LAS bf16*)(F.lds + PREP_AW); LAS bf16* Aa = (LAS bf16*)(F.lds + PREP_AA); LAS bf16* Ag = (LAS bf16*)(F.lds + PREP_AG);
    const int lane = F.lane, wave = F.wave, fr = lane & 15, fg = lane >> 4;
    LAS float* mul = (LAS float*)(F.lds + PREP_MU);
    for (int i = F.tid; i < 1920; i += 512) { mul[i] = mu_p[i]; mul[1920 + i] = mu_n[i]; }
    LAS float* par = (LAS float*)(F.lds + PREP_PAR);
    { const int i = F.tid; par[i] = k_k[i]; par[512 + i] = k_a[i]; par[1024 + i] = w0[i]; par[1536 + i] = w0[512 + i]; par[2048 + i] = a0[i]; par[2560 + i] = a0[512 + i]; }
    __syncthreads();
    for (int tile = F.vcu; tile < M / 64; tile += F.G) {
        const int m0 = tile * 64;
        int lane_o = F.lane; asm volatile("" : "+v"(lane_o));
        const int lane = lane_o, fr = lane & 15, fg = lane >> 4;
        const int mfirst = m0 + wave * 8;
        const u32x4 zero = {0u, 0u, 0u, 0u};
        u32x4 rowsN[10];
#define PREP_LOAD(jj_) do { const int q_ = lane + 64 * (jj_); const bool v_ = q_ < 240; const int c_ = 8 * q_; \
            _Pragma("unroll") for (int rI = 0; rI < 10; ++rI) { const int mr = mfirst - 1 + rI; \
                const bool ok = v_ && !(rI == 0 && (mfirst % T) == 0) && !(rI == 9 && ((mfirst + 7) % T) == T - 1); \
                rowsN[rI] = ok ? *(const u32x4*)(p + (size_t)mr * PW + c_) : zero; } } while (0)
        PREP_LOAD(0);
#pragma unroll 1
        for (int jj = 0; jj < 4; ++jj) {
            const int q = lane + 64 * jj; const bool valid = q < 240; const int c0 = 8 * q;
            float mp[8], mn[8];
            u32x4 rows[10];
            { const int cl = valid ? c0 : 0; const f32x4 a0_ = *(const LAS f32x4*)(mul + cl), a1_ = *(const LAS f32x4*)(mul + cl + 4), b0_ = *(const LAS f32x4*)(mul + 1920 + cl), b1_ = *(const LAS f32x4*)(mul + 1920 + cl + 4);
#pragma unroll
              for (int i = 0; i < 4; ++i) { mp[i] = valid ? a0_[i] : 0.f; mp[4 + i] = valid ? a1_[i] : 0.f; mn[i] = valid ? b0_[i] : 0.f; mn[4 + i] = valid ? b1_[i] : 0.f; } }
#pragma unroll
            for (int rI = 0; rI < 10; ++rI) rows[rI] = rowsN[rI];
            if (jj < 3) PREP_LOAD(jj + 1);
#pragma unroll
            for (int i = 0; i < 8; ++i) {
                const int m = mfirst + i, it = wave * 8 + i;
                const u32x4 prev = rows[i], cur = rows[i + 1], nxt = rows[i + 2];
                float fp[8], fc[8], fn[8], s[8];
                unpack8(prev, fp); unpack8(cur, fc); unpack8(nxt, fn);
#pragma unroll
                for (int e = 0; e < 8; ++e) s[e] = fc[e] + mp[e] * (fp[e] - fc[e]) + mn[e] * (fn[e] - fc[e]);
                if (jj == 0) { if (STORE) { *(u32x4*)(r_out + (size_t)m * CW + c0) = pack8(s); } }
                else if (jj == 1) {
                    const int c = c0 - 512;
                    *(LAS u32x4*)(kbuf + it * 512 + c) = pack8(s);
                    float kr[8]; float ss = 0.f;
#pragma unroll
                    for (int e = 0; e < 8; ++e) { kr[e] = s[e] * k_k[c + e]; ss += kr[e] * kr[e]; }
                    ss += __shfl_xor(ss, 1); ss += __shfl_xor(ss, 2); ss += __shfl_xor(ss, 4);
                    const float inv = fminf(__builtin_amdgcn_rsqf(ss), 1e12f);
#pragma unroll
                    for (int e = 0; e < 8; ++e) kr[e] *= inv;
                    if (STORE) { *(u32x4*)(kk_out + (size_t)m * CW + c) = pack8(kr); }
                    if ((lane & 7) == 0) invb[it * 8 + (lane >> 3)] = inv;
                }
                else if (jj == 2) { if (STORE) { *(u32x4*)(v_out + (size_t)m * CW + (c0 - 1024)) = pack8(s); } }
                else if (valid) {
                    const int seg = lane >> 4, cw = 8 * (lane & 15);
                    if (seg == 0) {
#pragma unroll
                        for (int e = 0; e < 8; ++e) s[e] = 1.0f - 2.0f * __builtin_amdgcn_rcpf(__expf(2.0f * s[e]) + 1.0f);
                        *(LAS u32x4*)(Aw + it * PREP_LD + cw) = pack8(s);
                    } else if (seg == 1) { *(LAS u32x4*)(Aa + it * PREP_LD + cw) = pack8(s); }
                    else {
#pragma unroll
                        for (int e = 0; e < 8; ++e) s[e] = sigmoidf_(s[e]);
                        *(LAS u32x4*)(Ag + it * PREP_LD + cw) = pack8(s);
                    }
                }
            }
        }
        const int nb = 64 * wave;
#define PREP_PROW(nt_) (nb + 32 * ((nt_) >> 1) + 8 * (fr >> 2) + 4 * ((nt_) & 1) + (fr & 3))
#define PREP_COL(nt_)  (nb + 32 * ((nt_) >> 1) + 8 * fg + 4 * ((nt_) & 1))
        bf16x8 wf[2][4];
#define PREP_JLOAD(job_) do { const int z_ = (job_) & 1; const bf16* WT_ = (job_) < 2 ? w2T + (size_t)z_ * 512 * 64 : a2T + (size_t)z_ * 512 * 64; \
            _Pragma("unroll") for (int ks = 0; ks < 2; ++ks) _Pragma("unroll") for (int nt = 0; nt < 4; ++nt) wf[ks][nt] = *(const bf16x8*)(WT_ + (size_t)PREP_PROW(nt) * 64 + 32 * ks + 8 * fg); \
            } while (0)
        PREP_JLOAD(0);
        __syncthreads();
#pragma unroll 1
        for (int job = 0; job < 4; ++job) {
            const int z = job & 1;
            const LAS bf16* Ax = job < 2 ? Aw + z * 64 : Aa + z * 64;
            f32x4 pb[4];
            f32x4 acc[4][4];
#pragma unroll
            for (int mt = 0; mt < 4; ++mt)
#pragma unroll
                for (int nt = 0; nt < 4; ++nt) acc[mt][nt] = (f32x4){0.f, 0.f, 0.f, 0.f};
#pragma unroll
            for (int ks = 0; ks < 2; ++ks) {
                bf16x8 af[4];
#pragma unroll
                for (int mt = 0; mt < 4; ++mt) af[mt] = *(const LAS bf16x8*)(Ax + (16 * mt + fr) * PREP_LD + 32 * ks + 8 * fg);
#pragma unroll
                for (int mt = 0; mt < 4; ++mt)
#pragma unroll
                    for (int nt = 0; nt < 4; ++nt) acc[mt][nt] = __builtin_amdgcn_mfma_f32_16x16x32_bf16(wf[ks][nt], af[mt], acc[mt][nt], 0, 0, 0);
            }
            if (job < 3) PREP_JLOAD(job + 1);
            f32x4 pkk[4], pka[4];
#pragma unroll
            for (int nt = 0; nt < 4; ++nt) { const int n = PREP_COL(nt); pb[nt] = *(const LAS f32x4*)(par + 1024 + (job < 2 ? 0 : 1024) + z * 512 + n); pkk[nt] = *(const LAS f32x4*)(par + n); pka[nt] = *(const LAS f32x4*)(par + 512 + n); }
#pragma unroll
            for (int mt = 0; mt < 4; ++mt) {
                const int it = 16 * mt + fr; const size_t m = (size_t)(m0 + it);
#pragma unroll
                for (int np = 0; np < 2; ++np) {
                    const int c8 = nb + 32 * np + 8 * fg;
                    if (job < 2) {
                        float o[8];
#pragma unroll
                        for (int hh = 0; hh < 2; ++hh) { const f32x4 v = acc[mt][2 * np + hh], bq = pb[2 * np + hh];
#pragma unroll
                            for (int i = 0; i < 4; ++i) o[4 * hh + i] = __expf(-0.60653066f * sigmoidf_(v[i] + bq[i])); }
                        if (STORE) { *(u32x4*)(decay_out + ((size_t)z * M + m) * CW + c8) = pack8(o); }
                    } else {
                        const u32x4 kb = *(const LAS u32x4*)(kbuf + it * 512 + c8);
                        float kv[8]; unpack8(kb, kv);
                        const float inv = invb[it * 8 + wave];
                        float kd[8], ak[8];
#pragma unroll
                        for (int hh = 0; hh < 2; ++hh) { const f32x4 v = acc[mt][2 * np + hh], bq = pb[2 * np + hh], kkc = pkk[2 * np + hh], kac = pka[2 * np + hh];
#pragma unroll
                            for (int i = 0; i < 4; ++i) { const float av = sigmoidf_(v[i] + bq[i]), kx = kv[4 * hh + i]; kd[4 * hh + i] = kx * (1.0f + (av - 1.0f) * kac[i]); ak[4 * hh + i] = av * (kx * kkc[i] * inv); } }
                        if (STORE) { *(u32x4*)(kdir_out + ((size_t)z * M + m) * CW + c8) = pack8(kd); *(u32x4*)(akk_out + ((size_t)z * M + m) * CW + c8) = pack8(ak); }
                    }
                }
            }
        }
        {
            bf16x8 wf[4][4];
#pragma unroll
            for (int ks = 0; ks < 4; ++ks)
#pragma unroll
                for (int nt = 0; nt < 4; ++nt) wf[ks][nt] = *(const bf16x8*)(g2T + (size_t)PREP_PROW(nt) * 128 + 32 * ks + 8 * fg);
            f32x4 acc[4][4];
#pragma unroll
            for (int mt = 0; mt < 4; ++mt)
#pragma unroll
                for (int nt = 0; nt < 4; ++nt) acc[mt][nt] = (f32x4){0.f, 0.f, 0.f, 0.f};
#pragma unroll
            for (int ks = 0; ks < 4; ++ks) {
                bf16x8 af[4];
#pragma unroll
                for (int mt = 0; mt < 4; ++mt) af[mt] = *(const LAS bf16x8*)(Ag + (16 * mt + fr) * PREP_LD + 32 * ks + 8 * fg);
#pragma unroll
                for (int mt = 0; mt < 4; ++mt)
#pragma unroll
                    for (int nt = 0; nt < 4; ++nt) acc[mt][nt] = __builtin_amdgcn_mfma_f32_16x16x32_bf16(wf[ks][nt], af[mt], acc[mt][nt], 0, 0, 0);
            }
#pragma unroll
            for (int mt = 0; mt < 4; ++mt) { const size_t m = (size_t)(m0 + 16 * mt + fr);
#pragma unroll
                for (int np = 0; np < 2; ++np) { const f32x4 v0 = acc[mt][2 * np], v1 = acc[mt][2 * np + 1];
                    u32x4 w; w.x = cvt_pk_bf16(v0[0], v0[1]); w.y = cvt_pk_bf16(v0[2], v0[3]); w.z = cvt_pk_bf16(v1[0], v1[1]); w.w = cvt_pk_bf16(v1[2], v1[3]);
                    if (STORE) { *(u32x4*)(g_out + m * CW + nb + 32 * np + 8 * fg) = w; } } }
        }
#undef PREP_PROW
#undef PREP_COL
#undef PREP_LOAD
#undef PREP_JLOAD
        __syncthreads();
    }
}

constexpr int AT_K = 0, AT_V = 73728, AT_B = 147456;
__device__ __forceinline__ void attn_phase(const Frame& F, const Args& a, const int widx, const int nworkers) {
    unsigned char* ws = a.ws;
    const bf16* q = (const bf16*)(ws + WS_Q); const bf16* k = (const bf16*)(ws + WS_K); const bf16* vT = (const bf16*)(ws + WS_VT);
    bf16* att = (bf16*)(ws + WS_ATT);
    LAS unsigned char* L = F.lds;
    LAS float* bias = (LAS float*)(L + AT_B) + 16;
    const int tid = F.tid, lane = F.lane, fr = lane & 15, fg = lane >> 4, wave = F.wave;
    const int per = (16384 + nworkers * 8 - 1) / (nworkers * 8);
    const int base = widx * (8 * per);
    const bool blk = nworkers == 128;
    const int ltok = tid >> 3, lc = tid & 7;
    const int wK = AT_K + ltok * 128 + ((lc ^ ((((ltok >> 3) & 3) << 1) | ((ltok >> 1) & 1))) << 4), wV = AT_V + ltok * 128 + ((lc ^ ((ltok >> 1) & 7)) << 4);
    u32x4 kreg[9], vreg[9]; bf16x8 qn[2]; float breg = 0.f;
#define AT_ISSUE(it_) do { const int t0_ = base + (it_) * 8; if ((it_) < per && (blk || t0_ < 16384)) { \
        const int r0_ = blk ? (widx & 31) * 4 + 2 * ((it_) & 1) : (t0_ >> 2) & 127, h_ = blk ? (it_) >> 1 : (t0_ >> 9) & 7, b_ = blk ? widx >> 5 : t0_ >> 12, R0_ = min(max(r0_ - 4, 0), GROWS - 8); \
        const bf16* kp_ = k + ((size_t)b_ * T + R0_ * 64 + ltok) * CW + h_ * 64 + lc * 8; \
        const bf16* vp_ = vT + ((size_t)((b_ * NH + h_) * GROWS + R0_)) * (HD * 64) + tid * 8; \
        _Pragma("unroll") for (int j = 0; j < 9; ++j) { const int jj = min(j, GROWS - 1 - R0_); kreg[j] = *(const u32x4*)(kp_ + (size_t)jj * 64 * CW); vreg[j] = *(const u32x4*)(vp_ + (size_t)jj * (HD * 64)); } \
        if (tid < 465) breg = a.in[3][h_ * 465 + tid]; \
        const size_t tq_ = (size_t)b_ * T + (r0_ + (wave >> 2)) * 64 + 16 * (wave & 3) + fr; \
        _Pragma("unroll") for (int ks = 0; ks < 2; ++ks) qn[ks] = *(const bf16x8*)(q + tq_ * CW + h_ * 64 + 32 * ks + 8 * fg); } } while (0)
    AT_ISSUE(0);
    for (int it = 0; it < per; ++it) {
        const int task0 = base + it * 8; if (!blk && task0 >= 16384) break;
        const int cgp = wave & 3, r0 = blk ? (widx & 31) * 4 + 2 * (it & 1) : (task0 >> 2) & 127, r = r0 + (wave >> 2), h = blk ? it >> 1 : (task0 >> 9) & 7, b = blk ? widx >> 5 : task0 >> 12, R0 = min(max(r0 - 4, 0), GROWS - 8);
        const int c0 = 16 * cgp, wsc = min(max(c0 - 8, 0), 32), rs = min(max(r - 4, 0), GROWS - 8);
        const int c = c0 + fr, cs = min(max(c - 8, 0), 48);
        const size_t tq = (size_t)b * T + r * 64 + c;
        __syncthreads();
#pragma unroll
        for (int j = 0; j < 9; ++j) { *(LAS u32x4*)(L + wK + j * 8192) = kreg[j]; *(LAS u32x4*)(L + wV + j * 8192) = vreg[j]; }
        if (tid < 465) bias[tid] = breg;
        const bf16x8 qf0 = qn[0], qf1 = qn[1];
        __syncthreads();
        f32x4 sc[16];
        const int kcol_a = wsc + 8 * (fr >> 2) + (fr & 3);
        const int jr0 = rs - R0;
        int offK[2];
#pragma unroll
        for (int par = 0; par < 2; ++par) { const int tok = kcol_a + 4 * par; offK[par] = AT_K + jr0 * 8192 + tok * 128 + ((fg ^ ((((tok >> 3) & 3) << 1) | ((tok >> 1) & 1))) << 4); }
#pragma unroll
        for (int t = 0; t < 16; ++t) { const int u = t >> 1, par = t & 1;
            const bf16x8 kf0 = *(const LAS bf16x8*)(L + offK[par] + u * 8192), kf1 = *(const LAS bf16x8*)(L + (offK[par] ^ 64) + u * 8192);
            f32x4 s = {0.f, 0.f, 0.f, 0.f};
            s = __builtin_amdgcn_mfma_f32_16x16x32_bf16(kf0, qf0, s, 0, 0, 0);
            s = __builtin_amdgcn_mfma_f32_16x16x32_bf16(kf1, qf1, s, 0, 0, 0);
            sc[t] = s; }
        AT_ISSUE(it + 1);
        bool okm[8];
#pragma unroll
        for (int pi = 0; pi < 8; ++pi) { const int kc = wsc + 8 * fg + pi; okm[pi] = (kc >= cs) && (kc < cs + 16); }
        const LAS float* brow = bias + (rs - r + 7) * 31 + (wsc + 8 * fg - c + 15);
        float mx = -1e30f;
#pragma unroll
        for (int u = 0; u < 8; ++u)
#pragma unroll
            for (int pi = 0; pi < 8; ++pi) { const float s = okm[pi] ? sc[2 * u + (pi >> 2)][pi & 3] + brow[31 * u + pi] : -1e30f; sc[2 * u + (pi >> 2)][pi & 3] = s; mx = fmaxf(mx, s); }
        mx = fmaxf(mx, __shfl_xor(mx, 16)); mx = fmaxf(mx, __shfl_xor(mx, 32));
        float sum = 0.f;
        const float mxl = -mx * 1.44269504f;
#pragma unroll
        for (int t = 0; t < 16; ++t)
#pragma unroll
            for (int i = 0; i < 4; ++i) { const float pv = __builtin_amdgcn_exp2f(__builtin_fmaf(sc[t][i], 1.44269504f, mxl)); sc[t][i] = pv; sum += pv; }
        sum += __shfl_xor(sum, 16); sum += __shfl_xor(sum, 32);
        const float inv = 1.0f / sum;
        f32x4 o[4];
#pragma unroll
        for (int nt = 0; nt < 4; ++nt) o[nt] = (f32x4){0.f, 0.f, 0.f, 0.f};
        const int offV = AT_V + jr0 * 8192 + fr * 128 + ((((wsc >> 3) + fg) ^ ((fr >> 1) & 7)) << 4);
#pragma unroll
        for (int u = 0; u < 8; ++u) {
            union { u32x4 w; bf16x8 h8; } pf;
            pf.w.x = cvt_pk_bf16(sc[2 * u][0], sc[2 * u][1]); pf.w.y = cvt_pk_bf16(sc[2 * u][2], sc[2 * u][3]);
            pf.w.z = cvt_pk_bf16(sc[2 * u + 1][0], sc[2 * u + 1][1]); pf.w.w = cvt_pk_bf16(sc[2 * u + 1][2], sc[2 * u + 1][3]);
#pragma unroll
            for (int nt = 0; nt < 4; ++nt) { const bf16x8 vf = *(const LAS bf16x8*)(L + offV + u * 8192 + nt * 2048); o[nt] = __builtin_amdgcn_mfma_f32_16x16x32_bf16(vf, pf.h8, o[nt], 0, 0, 0); } }
#pragma unroll
        for (int nt = 0; nt < 4; ++nt) { u32x2 w; w.x = cvt_pk_bf16(o[nt][0] * inv, o[nt][1] * inv); w.y = cvt_pk_bf16(o[nt][2] * inv, o[nt][3] * inv);
            *(u32x2*)(att + tq * CW + h * 64 + 16 * nt + 4 * fg) = w; }
    }
#undef AT_ISSUE
    asm volatile("s_waitcnt vmcnt(0)" ::: "memory");
    __syncthreads();
    if (blk) {
        const float* anw = a.in[4]; bf16* mix = (bf16*)(ws + WS_MIX); const int c0 = 8 * lane;
        float nw[8];
#pragma unroll
        for (int i = 0; i < 8; ++i) nw[i] = anw[c0 + i];
        const size_t mbase = (size_t)(widx >> 5) * T + (size_t)((widx & 31) * 4) * 64;
#pragma unroll 4
        for (int i = wave; i < 256; i += 8) { const size_t m = mbase + i;
            float f[8]; unpack8(*(const u32x4*)(att + m * CW + c0), f);
            float ss = 0.f;
#pragma unroll
            for (int e = 0; e < 8; ++e) ss += f[e] * f[e];
            const float rs = rsqrtf(wave_sum(ss) * (1.f / CW) + RMS_EPS);
#pragma unroll
            for (int e = 0; e < 8; ++e) f[e] = f[e] * rs * nw[e];
            *(u32x4*)(mix + m * D + c0) = pack8(f); }
    }
}

__device__ __forceinline__ void side_phase(const Frame& F, const Args& a, const int widx, const int nworkers) {
    {
        LAS float* scr = (LAS float*)(F.lds + F.wave * 8448);
        for (int it = widx * 8 + F.wave; it < 16 * 32; it += nworkers * 8) { const int kb = it / 32, nb = it % 32; transpose_item(a.in[17], 1024, 1024, (bf16*)(a.ws + WS_WOT), kb * 64, nb * 32, nb * 32, scr, F.lane); } }
    {
        const float* rw = a.in[19]; bf16* ih = (bf16*)(a.ws + WS_RTIMG); bf16* il = ih + 32 * RT_PITCH;
        for (int idx = widx * 512 + F.tid; idx < 32768; idx += nworkers * 512) { const int e = idx & 31, d = idx >> 5; const float w = rw[idx];
            const unsigned hb = cvt_pk_bf16(w, 0.f) & 0xffffu; const float lo = w - __uint_as_float(hb << 16);
            ih[e * RT_PITCH + d] = (bf16)hb; il[e * RT_PITCH + d] = (bf16)cvt_pk_bf16(lo, 0.f); } }
    attn_phase(F, a, widx, nworkers);
    wconv_blocks(F, a, WC_P0, WC_BLOCKS, widx, nworkers);
}

__device__ __forceinline__ float row16_sum(float v) {
    v += __builtin_bit_cast(float, __builtin_amdgcn_update_dpp(0, __builtin_bit_cast(int, v), 0xB1, 0xF, 0xF, true));
    v += __builtin_bit_cast(float, __builtin_amdgcn_update_dpp(0, __builtin_bit_cast(int, v), 0x4E, 0xF, 0xF, true));
    v += __builtin_bit_cast(float, __builtin_amdgcn_update_dpp(0, __builtin_bit_cast(int, v), 0x141, 0xF, 0xF, true));
    v += __builtin_bit_cast(float, __builtin_amdgcn_update_dpp(0, __builtin_bit_cast(int, v), 0x140, 0xF, 0xF, true));
    return v;
}
constexpr int CS_R = 8;
constexpr int CS_NCH = 2, CS_NPR = 6;
constexpr int CS_AT = 0, CS_RT = 2304, CS_KHT = 4608, CS_BHT = 6656, CS_VT = 8704  , CS_TT = 10752, CS_AAK = 11264, CS_ARK = 11776, CS_ARB = 12288, CS_PL = 12800, CS_SLOT = 13056;
constexpr int CS_LD = 72;
constexpr int CS_SCR = CS_R * CS_SLOT  , CS_SCRW = 2304 * 2  , CS_FLAG = CS_SCR + CS_NPR * CS_SCRW  ;
__device__ __forceinline__ bf16 f2bf(float f) { return (bf16)cvt_pk_bf16(f, 0.f); }
struct ChainOps { u32x2 a4[4], r4[4], kh[4], bh[4], aak, ark, arb, tt, vb; f32x4 pl[4]; };
__device__ __forceinline__ void chain_load(const LAS unsigned char* sl, int fr, int fg, int c, ChainOps& o) {
    const int o16 = fr * 32 + fg * 8;
    const LAS unsigned char* pa = sl + CS_AT + fr * (CS_LD * 2) + fg * 8; const LAS unsigned char* pr = sl + CS_RT + fr * (CS_LD * 2) + fg * 8;
#pragma unroll
    for (int kq = 0; kq < 4; ++kq) { o.a4[kq] = *(const LAS u32x2*)(pa + 32 * kq); o.r4[kq] = *(const LAS u32x2*)(pr + 32 * kq); }
    o.aak = *(const LAS u32x2*)(sl + CS_AAK + o16); o.ark = *(const LAS u32x2*)(sl + CS_ARK + o16); o.arb = *(const LAS u32x2*)(sl + CS_ARB + o16); o.tt = *(const LAS u32x2*)(sl + CS_TT + o16);
    o.vb = *(const LAS u32x2*)(sl + CS_VT + c * 512 + o16);
#pragma unroll
    for (int mt = 0; mt < 4; ++mt) { o.pl[mt] = *(const LAS f32x4*)(sl + CS_PL + (16 * mt + 4 * fg) * 4);
        o.kh[mt] = *(const LAS u32x2*)(sl + CS_KHT + 512 * mt + o16); o.bh[mt] = *(const LAS u32x2*)(sl + CS_BHT + 512 * mt + o16); }
}
__device__ __forceinline__ f32x4 chain_compute(const ChainOps& o, f32x4 (&zacc)[4]) {
#define CS_M32(A_, B_, C_) __builtin_amdgcn_mfma_f32_16x16x32_bf16(A_, B_, C_, 0, 0, 0)
#define CS_M16(A_, B_, C_) __builtin_amdgcn_mfma_f32_16x16x16bf16_1k(__builtin_bit_cast(s16x4, A_), __builtin_bit_cast(s16x4, B_), C_, 0, 0, 0)
    union { u32x4 w; bf16x8 h8; } zb0, zb1, ap0, ap1, rp0, rp1;
    zb0.w.x = cvt_pk_bf16(zacc[0][0], zacc[0][1]); zb0.w.y = cvt_pk_bf16(zacc[0][2], zacc[0][3]); zb0.w.z = cvt_pk_bf16(zacc[1][0], zacc[1][1]); zb0.w.w = cvt_pk_bf16(zacc[1][2], zacc[1][3]);
    zb1.w.x = cvt_pk_bf16(zacc[2][0], zacc[2][1]); zb1.w.y = cvt_pk_bf16(zacc[2][2], zacc[2][3]); zb1.w.z = cvt_pk_bf16(zacc[3][0], zacc[3][1]); zb1.w.w = cvt_pk_bf16(zacc[3][2], zacc[3][3]);
    ap0.w = (u32x4){o.a4[0].x, o.a4[0].y, o.a4[1].x, o.a4[1].y}; ap1.w = (u32x4){o.a4[2].x, o.a4[2].y, o.a4[3].x, o.a4[3].y};
    rp0.w = (u32x4){o.r4[0].x, o.r4[0].y, o.r4[1].x, o.r4[1].y}; rp1.w = (u32x4){o.r4[2].x, o.r4[2].y, o.r4[3].x, o.r4[3].y};
    const f32x4 zero4 = {0.f, 0.f, 0.f, 0.f};
    f32x4 Wc = CS_M16(o.aak, o.vb, zero4);
    Wc = CS_M32(ap0.h8, zb0.h8, Wc); Wc = CS_M32(ap1.h8, zb1.h8, Wc);
    f32x4 Yc = CS_M16(o.ark, o.vb, zero4);
    Yc = CS_M32(rp0.h8, zb0.h8, Yc); Yc = CS_M32(rp1.h8, zb1.h8, Yc);
    f32x4 zz[4];
#pragma unroll
    for (int mt = 0; mt < 4; ++mt) zz[mt] = CS_M16(o.kh[mt], o.vb, zacc[mt] * o.pl[mt]);
    u32x2 wb, ub;
    wb.x = cvt_pk_bf16(Wc[0], Wc[1]); wb.y = cvt_pk_bf16(Wc[2], Wc[3]);
    const f32x4 Uc = CS_M16(o.tt, wb, zero4);
    ub.x = cvt_pk_bf16(Uc[0], Uc[1]); ub.y = cvt_pk_bf16(Uc[2], Uc[3]);
    Yc = CS_M16(o.arb, ub, Yc);
#pragma unroll
    for (int mt = 0; mt < 4; ++mt) zacc[mt] = CS_M16(o.bh[mt], ub, zz[mt]);
#undef CS_M32
#undef CS_M16
    return Yc;
}
template <int z>
__device__ __forceinline__ void scan_phase_z(const Frame& F, const Args& a, const int seq, const int half) {
    unsigned char* ws = a.ws;
    const int b = (seq >> 3) & 3, h = seq & 7;
    const size_t mb = (size_t)b * T;
    const int lane = F.lane, wave = F.wave, fr = lane & 15, fg = lane >> 4;
    constexpr int NCK = T / 16;
    volatile LAS unsigned* flg = (volatile LAS unsigned*)(F.lds + CS_FLAG);
    if (F.tid < 16) flg[F.tid] = 0u;
    __syncthreads();
    const int o16 = fr * 32 + fg * 8;
#define CS_M32(A_, B_, C_) __builtin_amdgcn_mfma_f32_16x16x32_bf16(A_, B_, C_, 0, 0, 0)
#define CS_M16(A_, B_, C_) __builtin_amdgcn_mfma_f32_16x16x16bf16_1k(__builtin_bit_cast(s16x4, A_), __builtin_bit_cast(s16x4, B_), C_, 0, 0, 0)
    if (wave < CS_NCH) {
        const int c = wave, rg = 2 * half + c;
        __builtin_amdgcn_s_setprio(3);
        bf16* yout = (bf16*)(ws + WS_Y) + (size_t)z * M * CW + h * 64 + rg * 16 + fr;
        f32x4 zacc[4];
#pragma unroll
        for (int mt = 0; mt < 4; ++mt) zacc[mt] = (f32x4){0.f, 0.f, 0.f, 0.f};
        ChainOps opA, opB;
#define CS_READY(nn) do { unsigned sp_ = 0; while (flg[(nn) & (CS_R - 1)] != (unsigned)((nn) + 1)) { __builtin_amdgcn_s_sleep(1); if (++sp_ > (1u << 24)) break; } __builtin_amdgcn_fence(__ATOMIC_ACQUIRE, "workgroup"); } while (0)
#define CS_HANDBACK(nn) do { asm volatile("s_waitcnt lgkmcnt(0)" ::: "memory"); if (lane == 0) flg[8 + c] = (unsigned)((nn) + 1); asm volatile("" ::: "memory"); } while (0)
#define CS_YSTORE(nn, Y_) do { asm volatile("s_waitcnt vmcnt(24)" ::: "memory");   _Pragma("unroll") for (int rr = 0; rr < 4; ++rr) { const int q_ = 16 * (nn) + 4 * fg + rr, t_ = z ? (T - 1 - q_) : q_; yout[(mb + t_) * CW] = f2bf((Y_)[rr]); } } while (0)
        CS_READY(0); chain_load(F.lds, fr, fg, c, opA);
#pragma unroll 1
        for (int n = 0; n < NCK; n += 2) {
            CS_READY(n + 1); CS_HANDBACK(n);
            chain_load(F.lds + ((n + 1) & (CS_R - 1)) * CS_SLOT, fr, fg, c, opB);
            { const f32x4 Yc = chain_compute(opA, zacc); CS_YSTORE(n, Yc); }
            if (n + 2 < NCK) CS_READY(n + 2);
            CS_HANDBACK(n + 1);
            if (n + 2 < NCK) chain_load(F.lds + ((n + 2) & (CS_R - 1)) * CS_SLOT, fr, fg, c, opA);
            { const f32x4 Yc = chain_compute(opB, zacc); CS_YSTORE(n + 1, Yc); }
        }
#undef CS_READY
#undef CS_HANDBACK
#undef CS_YSTORE
        __builtin_amdgcn_s_setprio(0);
    } else {
        const int pi = wave - CS_NCH;
        LAS unsigned char* scr = F.lds + CS_SCR + pi * CS_SCRW;
        LAS bf16* KT = (LAS bf16*)scr; LAS bf16* BT = (LAS bf16*)(scr + 2304);
        const bf16* gw_ = (const bf16*)(ws + WS_DECAY) + (size_t)z * M * CW + h * 64;
        const bf16* gkk = (const bf16*)(ws + WS_KK) + h * 64;
        const bf16* gak = (const bf16*)(ws + WS_AKK) + (size_t)z * M * CW + h * 64;
        const bf16* gk = (const bf16*)(ws + WS_KDIR) + (size_t)z * M * CW + h * 64;
        const bf16* gr = (const bf16*)(ws + WS_R) + h * 64;
        const bf16* gv = (const bf16*)(ws + WS_V) + h * 64 + half * 32 + (lane & 31);
        const int hf = lane >> 5, cp = lane & 31;
        unsigned xw[8], xkk[8], xak[8], xk[8], xr[8], nv[8];
        constexpr long RSTEP = z ? -(long)CW : (long)CW;
#define CS_FETCH(nn) do { if ((nn) < NCK) { const size_t m0_ = (mb + (z ? (T - 1 - 16 * (nn) - 8 * hf) : 16 * (nn) + 8 * hf)) * CW; \
            const unsigned* pw_ = (const unsigned*)(gw_ + m0_ + 2 * cp); const unsigned* pkk_ = (const unsigned*)(gkk + m0_ + 2 * cp); const unsigned* pak_ = (const unsigned*)(gak + m0_ + 2 * cp); \
            const unsigned* pk_ = (const unsigned*)(gk + m0_ + 2 * cp); const unsigned* pr_ = (const unsigned*)(gr + m0_ + 2 * cp); const bf16* pv_ = gv + m0_; \
            _Pragma("unroll") for (int i_ = 0; i_ < 8; ++i_) { xw[i_] = pw_[i_ * (RSTEP / 2)]; xkk[i_] = pkk_[i_ * (RSTEP / 2)]; xak[i_] = pak_[i_ * (RSTEP / 2)]; xk[i_] = pk_[i_ * (RSTEP / 2)]; xr[i_] = pr_[i_ * (RSTEP / 2)]; \
                nv[i_] = pv_[i_ * RSTEP]; } } } while (0)
        const int pstart = pi < 2 ? pi : (pi == 2 ? 4 : (pi == 3 ? 9 : pi - 2)), pstep = (pi == 2 || pi == 3) ? 10 : 5;
        CS_FETCH(pstart);
#pragma unroll 1
        for (int n = pstart; n < NCK; n += pstep) {
            const int slot = n & (CS_R - 1);
            f32x2 w2[8], kk2[8], ak2[8], k2[8], r2[8]; unsigned vq[8];
#pragma unroll
            for (int i = 0; i < 8; ++i) { unsigned x0 = xw[i], x1 = xkk[i], x2 = xak[i], x3 = xk[i], x4 = xr[i], x5 = nv[i];
                asm volatile("" : "+v"(x0), "+v"(x1), "+v"(x2), "+v"(x3), "+v"(x4), "+v"(x5));
                w2[i] = (f32x2){__uint_as_float(x0 << 16), __uint_as_float(x0 & 0xffff0000u)}; kk2[i] = (f32x2){__uint_as_float(x1 << 16), __uint_as_float(x1 & 0xffff0000u)};
                ak2[i] = (f32x2){__uint_as_float(x2 << 16), __uint_as_float(x2 & 0xffff0000u)}; k2[i] = (f32x2){__uint_as_float(x3 << 16), __uint_as_float(x3 & 0xffff0000u)};
                r2[i] = (f32x2){__uint_as_float(x4 << 16), __uint_as_float(x4 & 0xffff0000u)}; vq[i] = x5; }
            CS_FETCH(n + pstep);
            { unsigned sp = 0; for (;;) { const u32x2 pg = *(const volatile LAS u32x2*)(flg + 8); const int mn = (int)min(pg.x, pg.y);
                  if (mn >= n - (CS_R - 3)) break; __builtin_amdgcn_s_sleep(2); if (++sp > (1u << 24)) break; } }
            __builtin_amdgcn_fence(__ATOMIC_ACQUIRE, "workgroup");
            LAS unsigned char* sl = F.lds + slot * CS_SLOT;
            f32x2 Pl[8];
            Pl[0] = w2[0];
#pragma unroll
            for (int i = 1; i < 8; ++i) Pl[i] = Pl[i - 1] * w2[i];
            const f32x2 tot = Pl[7];
            const f32x2 oth = {__shfl_xor(tot.x, 32), __shfl_xor(tot.y, 32)};
            const f32x2 carry = hf ? oth : (f32x2){1.0f, 1.0f};
            const f32x2 PL2 = tot * oth;
            f32x2 Sf[8]; Sf[7] = (f32x2){1.0f, 1.0f};
#pragma unroll
            for (int i = 6; i >= 0; --i) Sf[i] = Sf[i + 1] * w2[i + 1];
            const f32x2 tc = tot * carry; const f32x2 Rr = {__builtin_amdgcn_rcpf(tc.x), __builtin_amdgcn_rcpf(tc.y)};
            f32x2 kh[8], bh[8], Pprev = carry;
            { LAS unsigned char* pat = sl + CS_AT + (8 * hf * CS_LD + 2 * cp) * 2; LAS unsigned char* prt = sl + CS_RT + (8 * hf * CS_LD + 2 * cp) * 2;
              LAS unsigned char* pkt = scr + (8 * hf * CS_LD + 2 * cp) * 2; LAS unsigned char* pbt = scr + 2304 + (8 * hf * CS_LD + 2 * cp) * 2;
#pragma unroll
              for (int i = 0; i < 8; ++i) {
                  const f32x2 P = Pl[i] * carry;
                  const f32x2 inv = Sf[i] * Rr;
                  const f32x2 at = kk2[i] * Pprev, rt = r2[i] * P, kt = k2[i] * inv, bt = -(ak2[i] * inv);
                  kh[i] = kt * PL2; bh[i] = bt * PL2;
                  *(LAS unsigned*)(pat + i * (CS_LD * 2)) = cvt_pk_bf16(at.x, at.y); *(LAS unsigned*)(prt + i * (CS_LD * 2)) = cvt_pk_bf16(rt.x, rt.y);
                  *(LAS unsigned*)(pkt + i * (CS_LD * 2)) = cvt_pk_bf16(kt.x, kt.y); *(LAS unsigned*)(pbt + i * (CS_LD * 2)) = cvt_pk_bf16(bt.x, bt.y);
                  Pprev = P; } }
            { u32x4 o0, o1;
              o0.x = cvt_pk_bf16(kh[0].x, kh[1].x); o0.y = cvt_pk_bf16(kh[2].x, kh[3].x); o0.z = cvt_pk_bf16(kh[4].x, kh[5].x); o0.w = cvt_pk_bf16(kh[6].x, kh[7].x);
              o1.x = cvt_pk_bf16(kh[0].y, kh[1].y); o1.y = cvt_pk_bf16(kh[2].y, kh[3].y); o1.z = cvt_pk_bf16(kh[4].y, kh[5].y); o1.w = cvt_pk_bf16(kh[6].y, kh[7].y);
              *(LAS u32x4*)(sl + CS_KHT + cp * 64 + hf * 16) = o0; *(LAS u32x4*)(sl + CS_KHT + cp * 64 + 32 + hf * 16) = o1;
              o0.x = cvt_pk_bf16(bh[0].x, bh[1].x); o0.y = cvt_pk_bf16(bh[2].x, bh[3].x); o0.z = cvt_pk_bf16(bh[4].x, bh[5].x); o0.w = cvt_pk_bf16(bh[6].x, bh[7].x);
              o1.x = cvt_pk_bf16(bh[0].y, bh[1].y); o1.y = cvt_pk_bf16(bh[2].y, bh[3].y); o1.z = cvt_pk_bf16(bh[4].y, bh[5].y); o1.w = cvt_pk_bf16(bh[6].y, bh[7].y);
              *(LAS u32x4*)(sl + CS_BHT + cp * 64 + hf * 16) = o0; *(LAS u32x4*)(sl + CS_BHT + cp * 64 + 32 + hf * 16) = o1; }
            if (hf == 0) *(LAS f32x2*)(sl + CS_PL + cp * 8) = PL2;
            { u32x4 o0;
              o0.x = vq[0] | (vq[1] << 16); o0.y = vq[2] | (vq[3] << 16); o0.z = vq[4] | (vq[5] << 16); o0.w = vq[6] | (vq[7] << 16);
              *(LAS u32x4*)(sl + CS_VT + (lane & 31) * 32 + (lane >> 5) * 16) = o0; }
            asm volatile("s_waitcnt lgkmcnt(0)" ::: "memory");
            bf16x8 af[2], rf[2], kf[2], bf_[2];
#pragma unroll
            for (int ks = 0; ks < 2; ++ks) { af[ks] = *(const LAS bf16x8*)(sl + CS_AT + (fr * CS_LD + 32 * ks + 8 * fg) * 2); rf[ks] = *(const LAS bf16x8*)(sl + CS_RT + (fr * CS_LD + 32 * ks + 8 * fg) * 2);
                kf[ks] = *(const LAS bf16x8*)(KT + fr * CS_LD + 32 * ks + 8 * fg); bf_[ks] = *(const LAS bf16x8*)(BT + fr * CS_LD + 32 * ks + 8 * fg); }
            const f32x4 zero4 = {0.f, 0.f, 0.f, 0.f};
            f32x4 Xc = zero4, Xt = zero4, AakT = zero4, ArbT = zero4, ArkT = zero4;
#pragma unroll
            for (int ks = 0; ks < 2; ++ks) { Xc = CS_M32(af[ks], bf_[ks], Xc); Xt = CS_M32(bf_[ks], af[ks], Xt);
                AakT = CS_M32(kf[ks], af[ks], AakT); ArbT = CS_M32(bf_[ks], rf[ks], ArbT); ArkT = CS_M32(kf[ks], rf[ks], ArkT); }
            f32x4 S1;
#pragma unroll
            for (int rr = 0; rr < 4; ++rr) { const int q = 4 * fg + rr;
                Xc[rr] = (fr < q) ? Xc[rr] : 0.f; Xt[rr] = (q < fr) ? Xt[rr] : 0.f; S1[rr] = Xt[rr] + ((q == fr) ? 1.0f : 0.f);
                AakT[rr] = (q < fr) ? AakT[rr] : 0.f; ArkT[rr] = (q <= fr) ? ArkT[rr] : 0.f; ArbT[rr] = (q <= fr) ? ArbT[rr] : 0.f; }
            { u32x2 w; w.x = cvt_pk_bf16(AakT[0], AakT[1]); w.y = cvt_pk_bf16(AakT[2], AakT[3]); *(LAS u32x2*)(sl + CS_AAK + o16) = w;
              w.x = cvt_pk_bf16(ArkT[0], ArkT[1]); w.y = cvt_pk_bf16(ArkT[2], ArkT[3]); *(LAS u32x2*)(sl + CS_ARK + o16) = w;
              w.x = cvt_pk_bf16(ArbT[0], ArbT[1]); w.y = cvt_pk_bf16(ArbT[2], ArbT[3]); *(LAS u32x2*)(sl + CS_ARB + o16) = w; }
#define CS_PK(v) ((u32x2){cvt_pk_bf16((v)[0], (v)[1]), cvt_pk_bf16((v)[2], (v)[3])})
            const u32x2 xc = CS_PK(Xc), xt = CS_PK(Xt), s1 = CS_PK(S1);
            const f32x4 X2c = CS_M16(xt, xc, zero4), X2t = CS_M16(xc, xt, zero4);
            const u32x2 x2c = CS_PK(X2c), x2t = CS_PK(X2t);
            const f32x4 S2 = CS_M16(x2c, s1, S1);
            const f32x4 X4c = CS_M16(x2t, x2c, zero4), X4t = CS_M16(x2c, x2t, zero4);
            const u32x2 x4c = CS_PK(X4c), x4t = CS_PK(X4t), s2 = CS_PK(S2);
            const f32x4 S4 = CS_M16(x4c, s2, S2);
            const f32x4 X8c = CS_M16(x4t, x4c, zero4);
            const u32x2 x8c = CS_PK(X8c), s4 = CS_PK(S4);
            const f32x4 S8 = CS_M16(x8c, s4, S4);
            *(LAS u32x2*)(sl + CS_TT + o16) = CS_PK(S8);
#undef CS_PK
            asm volatile("s_waitcnt lgkmcnt(0)" ::: "memory");
            __builtin_amdgcn_fence(__ATOMIC_RELEASE, "workgroup");
            if (lane == 0) flg[slot] = (unsigned)(n + 1);
        }
#undef CS_FETCH
    }
#undef CS_M32
#undef CS_M16
    __syncthreads();
}

__device__ __forceinline__ void scan_phase(const Frame& F, const Args& a, const int idx) {
    const int seq = idx >> 1, half = idx & 1;
    if (seq >> 5) scan_phase_z<1>(F, a, seq, half); else scan_phase_z<0>(F, a, seq, half);
}

__device__ __forceinline__ void combine_phase(const Frame& F, const Args& a) {
    unsigned char* ws = a.ws;
    const bf16* att = (const bf16*)(ws + WS_ATT); const bf16* rr = (const bf16*)(ws + WS_R); const bf16* vv = (const bf16*)(ws + WS_V);
    const bf16* kd = (const bf16*)(ws + WS_KDIR); const bf16* gg = (const bf16*)(ws + WS_G); const bf16* y = (const bf16*)(ws + WS_Y);
    bf16* mix = (bf16*)(ws + WS_MIX);
    const float* anw = a.in[4]; const float* r_k = a.in[14]; const float* ln_w = a.in[15]; const float* ln_b = a.in[16];
    const int lane = F.lane, c0 = 8 * lane;
    float nw[8], rk[8], lw[8], lb[8];
#pragma unroll
    for (int i = 0; i < 8; ++i) { nw[i] = anw[c0 + i]; rk[i] = r_k[c0 + i]; lw[i] = ln_w[c0 + i]; lb[i] = ln_b[c0 + i]; }
    const int gw = F.vcu * 8 + F.wave, NGW = F.G * 8;
#pragma unroll 2
    for (int m = gw; m < M; m += NGW) {
        const size_t o = (size_t)m * CW + c0;
        float f[8];
        if (F.G != 256) {
        unpack8(*(const u32x4*)(att + o), f);
        float ss = 0.f;
#pragma unroll
        for (int i = 0; i < 8; ++i) ss += f[i] * f[i];
        const float rs = rsqrtf(wave_sum(ss) * (1.f / CW) + RMS_EPS);
#pragma unroll
        for (int i = 0; i < 8; ++i) f[i] = f[i] * rs * nw[i];
        *(u32x4*)(mix + (size_t)m * D + c0) = pack8(f); }
        float yv[8], yw[8];
        unpack8(*(const u32x4*)(y + o), yv); unpack8(*(const u32x4*)(y + (size_t)M * CW + o), yw);
#pragma unroll
        for (int i = 0; i < 8; ++i) yv[i] += yw[i];
        float s1 = 0.f;
#pragma unroll
        for (int i = 0; i < 8; ++i) s1 += yv[i];
        s1 += __shfl_xor(s1, 1); s1 += __shfl_xor(s1, 2); s1 += __shfl_xor(s1, 4);
        const float mean = s1 * (1.f / 64.f);
        float s2 = 0.f;
#pragma unroll
        for (int i = 0; i < 8; ++i) { yv[i] -= mean; s2 += yv[i] * yv[i]; }
        s2 += __shfl_xor(s2, 1); s2 += __shfl_xor(s2, 2); s2 += __shfl_xor(s2, 4);
        const float rstd = rsqrtf(s2 * (1.f / 64.f) + GN_EPS);
        float rf[8], k0[8], k1[8], vf[8], gf[8];
        unpack8(*(const u32x4*)(rr + o), rf); unpack8(*(const u32x4*)(kd + o), k0); unpack8(*(const u32x4*)(kd + (size_t)M * CW + o), k1);
        unpack8(*(const u32x4*)(vv + o), vf); unpack8(*(const u32x4*)(gg + o), gf);
        float cf = 0.f;
#pragma unroll
        for (int i = 0; i < 8; ++i) cf += rf[i] * (k0[i] + k1[i]) * rk[i];
        cf += __shfl_xor(cf, 1); cf += __shfl_xor(cf, 2); cf += __shfl_xor(cf, 4);
#pragma unroll
        for (int i = 0; i < 8; ++i) f[i] = (yv[i] * rstd * lw[i] + lb[i] + cf * vf[i]) * gf[i];
        *(u32x4*)(mix + (size_t)m * D + CW + c0) = pack8(f);
    }
}

__device__ __forceinline__ void router_phase(const Frame& F, const Args& a) {
    unsigned char* ws = a.ws;
    const bf16* hbuf = (const bf16*)(ws + WS_H); unsigned char* hn2 = ws + WS_HN2;
    int* eidx = (int*)(ws + WS_EIDX); float* gate = (float*)(ws + WS_GATE); int* rank = (int*)(ws + WS_RANK);
    unsigned* ctl = (unsigned*)(ws + WS_CTL);
    const float* n2w = a.in[18]; const float* rw = a.in[19]; const float* rb = a.in[20];
    LAS bf16* wh = (LAS bf16*)(F.lds + RT_WH); LAS bf16* wl = (LAS bf16*)(F.lds + RT_WL); LAS int* hist = (LAS int*)(F.lds + RT_HIST); LAS int* eL = (LAS int*)(F.lds + RT_EL);
    {
        const u32x4* img = (const u32x4*)(ws + WS_RTIMG); LAS u32x4* dst = (LAS u32x4*)(F.lds + RT_WH);
        u32x4 t[17];
#pragma unroll
        for (int j = 0; j < 17; ++j) { const int i = F.tid + 512 * j; if (i < 8256) t[j] = img[i]; }
#pragma unroll
        for (int j = 0; j < 17; ++j) { const int i = F.tid + 512 * j; if (i < 8256) dst[i] = t[j]; } }
    if (F.tid < 32) hist[F.tid] = 0;
    __syncthreads();
    const int lane = F.lane, tk = lane & 15, g = lane >> 4;
    const int blk = F.vcu;
    const int m = blk * 128 + F.wave * 16 + tk;
    const bf16* hrow = hbuf + (size_t)m * D + 8 * g;
    float ss = 0.f;
#pragma unroll 8
    for (int ks = 0; ks < 32; ++ks) { float xf[8]; unpack8(*(const u32x4*)(hrow + 32 * ks), xf);
        ss += (xf[0] * xf[0] + xf[1] * xf[1]) + (xf[2] * xf[2] + xf[3] * xf[3]) + (xf[4] * xf[4] + xf[5] * xf[5]) + (xf[6] * xf[6] + xf[7] * xf[7]); }
    ss += __shfl_xor(ss, 16); ss += __shfl_xor(ss, 32);
    const float rs = rsqrtf(ss * (1.f / D) + RMS_EPS);
    f32x4 acc0 = {0.f, 0.f, 0.f, 0.f}, acc1 = acc0;
    unsigned char* hrow8 = hn2 + (size_t)m * D + 8 * g;
    const LAS bf16* wh0 = wh + tk * RT_PITCH + 8 * g; const LAS bf16* wl0 = wl + tk * RT_PITCH + 8 * g;
#pragma unroll 4
    for (int ks = 0; ks < 32; ++ks) {
        float xf[8]; unpack8(*(const u32x4*)(hrow + 32 * ks), xf);
        const f32x4 x0 = {xf[0], xf[1], xf[2], xf[3]}, x1 = {xf[4], xf[5], xf[6], xf[7]};
        const f32x4 n0 = *(const f32x4*)(n2w + 32 * ks + 8 * g), n1 = *(const f32x4*)(n2w + 32 * ks + 8 * g + 4);
        const f32x4 y0 = x0 * rs * n0, y1 = x1 * rs * n1;
        { u32x2 w8; w8.x = pk4_fp8(y0.x * F8_SX, y0.y * F8_SX, y0.z * F8_SX, y0.w * F8_SX); w8.y = pk4_fp8(y1.x * F8_SX, y1.y * F8_SX, y1.z * F8_SX, y1.w * F8_SX); *(u32x2*)(hrow8 + 32 * ks) = w8; }
        union { u32x4 w; bf16x8 h8; } xh, xl;
        xh.w.x = cvt_pk_bf16(y0.x, y0.y); xh.w.y = cvt_pk_bf16(y0.z, y0.w); xh.w.z = cvt_pk_bf16(y1.x, y1.y); xh.w.w = cvt_pk_bf16(y1.z, y1.w);
        xl.w.x = cvt_pk_bf16(y0.x - bflo(xh.w.x), y0.y - bfhi(xh.w.x)); xl.w.y = cvt_pk_bf16(y0.z - bflo(xh.w.y), y0.w - bfhi(xh.w.y));
        xl.w.z = cvt_pk_bf16(y1.x - bflo(xh.w.z), y1.y - bfhi(xh.w.z)); xl.w.w = cvt_pk_bf16(y1.z - bflo(xh.w.w), y1.w - bfhi(xh.w.w));
        const bf16x8 a0h = *(const LAS bf16x8*)(wh0 + 32 * ks), a1h = *(const LAS bf16x8*)(wh0 + 16 * RT_PITCH + 32 * ks);
        const bf16x8 a0l = *(const LAS bf16x8*)(wl0 + 32 * ks), a1l = *(const LAS bf16x8*)(wl0 + 16 * RT_PITCH + 32 * ks);
        acc0 = __builtin_amdgcn_mfma_f32_16x16x32_bf16(a0h, xh.h8, acc0, 0, 0, 0); acc1 = __builtin_amdgcn_mfma_f32_16x16x32_bf16(a1h, xh.h8, acc1, 0, 0, 0);
        acc0 = __builtin_amdgcn_mfma_f32_16x16x32_bf16(a0h, xl.h8, acc0, 0, 0, 0); acc1 = __builtin_amdgcn_mfma_f32_16x16x32_bf16(a1h, xl.h8, acc1, 0, 0, 0);
        acc0 = __builtin_amdgcn_mfma_f32_16x16x32_bf16(a0l, xh.h8, acc0, 0, 0, 0); acc1 = __builtin_amdgcn_mfma_f32_16x16x32_bf16(a1l, xh.h8, acc1, 0, 0, 0);
    }
    float lv[8]; int li[8];
    { const f32x4 b0 = *(const f32x4*)(rb + 4 * g), b1 = *(const f32x4*)(rb + 16 + 4 * g);
#pragma unroll
      for (int i = 0; i < 4; ++i) { lv[i] = acc0[i] + b0[i]; li[i] = 4 * g + i; lv[4 + i] = acc1[i] + b1[i]; li[4 + i] = 16 + 4 * g + i; } }
    float tv[4]; int ti[4];
#pragma unroll
    for (int kx = 0; kx < 4; ++kx) {
        float bv = lv[0]; int bi = li[0];
#pragma unroll
        for (int i = 1; i < 8; ++i) { const bool gt = lv[i] > bv; bv = gt ? lv[i] : bv; bi = gt ? li[i] : bi; }
#pragma unroll
        for (int o = 16; o < 64; o <<= 1) { const float ov = __shfl_xor(bv, o); const int oi = __shfl_xor(bi, o); const bool tko = (ov > bv) || (ov == bv && oi < bi); bv = tko ? ov : bv; bi = tko ? oi : bi; }
        tv[kx] = bv; ti[kx] = bi;
#pragma unroll
        for (int i = 0; i < 8; ++i) lv[i] = (li[i] == bi) ? -3.0e38f : lv[i];
    }
    if (g == 0) {
        const float e0 = 1.0f, e1 = __expf(tv[1] - tv[0]), e2 = __expf(tv[2] - tv[0]), e3 = __expf(tv[3] - tv[0]);
        const float is = 1.0f / (e0 + e1 + e2 + e3);
        const float gs[4] = {e0 * is, e1 * is, e2 * is, e3 * is};
#pragma unroll
        for (int kx = 0; kx < 4; ++kx) { eidx[m * 4 + kx] = ti[kx]; gate[m * 4 + kx] = gs[kx]; eL[(m - blk * 128) * 4 + kx] = ti[kx]; }
    }
    __syncthreads();
    { const int t = F.tid, e = eL[t]; int rk = 0;
      for (int u = 0; u < t; ++u) rk += (eL[u] == e) ? 1 : 0;
      rank[(blk * 128) * 4 + t] = rk;
      __hip_atomic_fetch_add(&hist[e], 1, __ATOMIC_RELAXED, __HIP_MEMORY_SCOPE_WORKGROUP); }
    __syncthreads();
    if (F.tid < 32) ctl[CW_CNT + blk * 32 + F.tid] = (unsigned)hist[F.tid];
}

__device__ __forceinline__ void dispatch_phase(const Frame& F, const Args& a) {
    unsigned char* ws = a.ws;
    unsigned* ctl = (unsigned*)(ws + WS_CTL);
    const int* eidx = (const int*)(ws + WS_EIDX); const int* rank = (const int*)(ws + WS_RANK); int* dest = (int*)(ws + WS_DEST);
    LAS int* part = (LAS int*)F.lds;
    LAS int* tot = part + 1024;
    const int blk = F.vcu, G = F.G;
    { const int e = F.tid & 31, pt = F.tid >> 5; int s = 0, sb = 0;
      if (G == 256) { int cv[16];
#pragma unroll
          for (int q = 0; q < 16; ++q) cv[q] = (int)ld_u32_agent(ctl + CW_CNT + (pt + 16 * q) * 32 + e);
#pragma unroll
          for (int q = 0; q < 16; ++q) { s += cv[q]; if (pt + 16 * q < blk) sb += cv[q]; } }
      else for (int bb = pt; bb < G; bb += 16) { const int cval = (int)ld_u32_agent(ctl + CW_CNT + bb * 32 + e); s += cval; if (bb < blk) sb += cval; }
      part[pt * 32 + e] = s; part[512 + pt * 32 + e] = sb; }
    __syncthreads();
    if (F.tid < 32) { int s = 0, sb = 0;
        for (int pt = 0; pt < 16; ++pt) { s += part[pt * 32 + F.tid]; sb += part[512 + pt * 32 + F.tid]; }
        tot[F.tid] = s; tot[32 + F.tid] = sb; tot[96 + F.tid] = (s + 255) & ~255; }
    __syncthreads();
    if (F.tid == 0) { int ps = 0; for (int e = 0; e < 32; ++e) { tot[64 + e] = ps; ps += tot[96 + e]; }
        tot[128] = ps >> 8; }
    __syncthreads();
    if (blk == 0) {
        if (F.tid == 0) ctl[CW_NT] = (unsigned)tot[128];
        for (int e = F.tid >> 4; e < 32; e += 32) { const int t0 = tot[64 + e] >> 8, nt = tot[96 + e] >> 8; for (int i = F.tid & 15; i < nt; i += 16) ctl[CW_TEXP + t0 + i] = (unsigned)e; }
    }
    const int lane = F.lane;
    const int mw = blk * 128 + F.wave * 16;
    int* rowtok = (int*)(ws + WS_ROWTOK);
    { const int e = eidx[mw * 4 + lane]; const int dl = tot[64 + e] + tot[32 + e] + rank[mw * 4 + lane]; dest[mw * 4 + lane] = dl; rowtok[dl] = mw + (lane >> 2); }
    { const int e = blk & 31, pt = blk >> 5, np = G >> 5; const int r0 = tot[64 + e] + tot[e], r1 = tot[64 + e] + tot[96 + e];
      if (np > 0) for (int r = r0 + pt * 512 + F.tid; r < r1; r += np * 512) rowtok[r] = 0; }
}

__device__ __forceinline__ void final_phase(const Frame& F, const Args& a) {
    unsigned char* ws = a.ws;
    const bf16* hbuf = (const bf16*)(ws + WS_H); const unsigned char* ybuf = ws + WS_YBUF;
    const int* dest = (const int*)(ws + WS_DEST); const float* gate = (const float*)(ws + WS_GATE);
    const float* fw = a.in[25]; float* out = a.out;
    const int lane = F.lane;
    f32x4 wn[4];
#pragma unroll
    for (int j = 0; j < 4; ++j) wn[j] = *((const f32x4*)fw + lane + 64 * j);
    const int gw = F.vcu * 8 + F.wave, NGW = F.G * 8;
    const int per = M / NGW;
    const int mw = gw * per;
    int dl = 0; float gl = 0.f;
    if (lane < 4 * per && per <= 16) { dl = dest[mw * 4 + lane]; gl = gate[mw * 4 + lane]; }
#pragma unroll 2
    for (int i = 0; i < per; ++i) {
        const int m = mw + i;
        const u32x2* hr = (const u32x2*)(hbuf + (size_t)m * D) + lane;
        f32x4 v[4];
#pragma unroll
        for (int j = 0; j < 4; ++j) { const u32x2 w = hr[64 * j]; v[j] = (f32x4){bflo(w.x), bfhi(w.x), bflo(w.y), bfhi(w.y)}; }
#pragma unroll
        for (int kx = 0; kx < 4; ++kx) {
            const int d = per <= 16 ? __shfl(dl, 4 * i + kx) : dest[m * 4 + kx]; const float gt = (per <= 16 ? __shfl(gl, 4 * i + kx) : gate[m * 4 + kx]) * (1.0f / F8_SY);
            const unsigned* yr = (const unsigned*)(ybuf + (size_t)d * D) + lane;
#pragma unroll
            for (int j = 0; j < 4; ++j) { const unsigned w = yr[64 * j]; const f32x2 lo = __builtin_amdgcn_cvt_pk_f32_fp8((int)w, false), hi = __builtin_amdgcn_cvt_pk_f32_fp8((int)w, true);
                v[j].x += gt * lo.x; v[j].y += gt * lo.y; v[j].z += gt * hi.x; v[j].w += gt * hi.y; }
        }
        float s = 0.f;
#pragma unroll
        for (int j = 0; j < 4; ++j) s += (v[j].x * v[j].x + v[j].y * v[j].y) + (v[j].z * v[j].z + v[j].w * v[j].w);
        const float rs = rsqrtf(wave_sum(s) * (1.f / D) + RMS_EPS);
        f32x4* orow = (f32x4*)(out + (size_t)m * D) + lane;
#pragma unroll
        for (int j = 0; j < 4; ++j) orow[64 * j] = v[j] * rs * wn[j];
    }
}

__global__ void __launch_bounds__(512, 2) fwd_megakernel(Args args) {
    extern __shared__ __attribute__((aligned(16))) unsigned char lds_raw[];
    Frame F;
    F.lds = (LAS unsigned char*)lds_raw;
    F.tid = threadIdx.x; F.lane = F.tid & 63; F.wave = __builtin_amdgcn_readfirstlane(F.tid >> 6);
    F.G = gridDim.x; { const int bx = blockIdx.x; F.vcu = (F.G % 8 == 0) ? (bx % 8) * (F.G / 8) + bx / 8 : bx; }
    unsigned char* ws = args.ws;
    const int lo = args.ph_lo, hi = args.ph_hi;
#define IN(k) (lo <= (k) && (k) < hi)
#if MK_SPLIT
#define SEAM(k) do { } while (0)
#else
    cg::grid_group grid = cg::this_grid();
    { volatile LAS unsigned* st = (volatile LAS unsigned*)(F.lds + LDS_MISC); if (F.tid < 2) st[F.tid] = 0u; __syncthreads(); }
    const XcdBarrier xbar = xcd_barrier_post((unsigned*)(ws + WS_CTL) + CW_BAR, (volatile LAS unsigned*)(F.lds + LDS_MISC));
    if (lo < 0) grid.sync();
#define SEAM(k) do { if (IN(k) && IN((k) + 1)) xcd_barrier(xbar); } while (0)
#endif
#define REP2(k) if constexpr (((MK_REPEAT >> (k)) & 1) != 0)
#define PH1 { pg8::Gemm g{(const bf16*)(ws + WS_HN), (const bf16*)(ws + WS_WINT), 1024, nullptr, 0, nullptr}; \
        pg8::StaticOrder S; S.init(M / 256, NPROJ_PAD / 256, F.G, (int)blockIdx.x); \
        pg8::EpiProj E{(bf16*)(ws + WS_Q), (bf16*)(ws + WS_K), (bf16*)(ws + WS_VT), (bf16*)(ws + WS_P)}; \
        pg8::gemm_phase<pg8::EpiProj, true, true>(F.lds, g, S, E); }
#define PH5 { pg8::Gemm g{(const bf16*)(ws + WS_MIX), (const bf16*)(ws + WS_WOT), 1024, nullptr, 0, nullptr}; \
        pg8::StaticOrder S; S.init(M / 256, D / 256, F.G, (int)blockIdx.x); \
        pg8::EpiWo E{args.in[0], (bf16*)(ws + WS_H)}; \
        pg8::gemm_phase<pg8::EpiWo, true, true>(F.lds, g, S, E); }
#define PH8 { const unsigned* ctl = (const unsigned*)(ws + WS_CTL); const int ntile = (int)ld_u32_agent(ctl + CW_NT); \
        pg8::Gemm g{(const bf16*)(ws + WS_HN2), (const bf16*)(ws + WS_WUPT), 512, ctl + CW_TEXP, (size_t)2048 * 1024, (const int*)(ws + WS_ROWTOK)}; \
        pg8::StaticOrder S; S.init(ntile, 8, F.G, (int)blockIdx.x); \
        pg8::EpiUp E{args.in[22], ws + WS_ACT}; \
        pg8::gemm_phase<pg8::EpiUp, true, true, true, true>(F.lds, g, S, E); }
#define PH9 { const unsigned* ctl = (const unsigned*)(ws + WS_CTL); const int ntile = (int)ld_u32_agent(ctl + CW_NT); \
        pg8::Gemm g{(const bf16*)(ws + WS_ACT), (const bf16*)(ws + WS_WDNT), 512, ctl + CW_TEXP, (size_t)1024 * 1024, nullptr}; \
        pg8::StaticOrder S; S.init(ntile, 4, F.G, (int)blockIdx.x); \
        pg8::EpiDown E{args.in[24], ws + WS_YBUF}; \
        pg8::gemm_phase<pg8::EpiDown, true, true, false, true>(F.lds, g, S, E); }
    if (IN(0)) { p0_prologue(F, args); REP2(0) p0_prologue(F, args); }
    SEAM(0);
    if (IN(1)) { PH1 REP2(1) PH1 }
    SEAM(1);
    if (IN(2)) { prep_phase<true>(F, args); REP2(2) prep_phase<true>(F, args); }
    SEAM(2);
    if (IN(3)) {
        if ((F.vcu & 1) == 0 && (F.vcu >> 1) < 128) { scan_phase(F, args, F.vcu >> 1); REP2(3) scan_phase(F, args, F.vcu >> 1); }
        else { const int nside = F.G - min((F.G + 1) / 2, 128); const int q_ = min((F.vcu + 1) >> 1, 128); side_phase(F, args, F.vcu - q_, nside); REP2(11) side_phase(F, args, F.vcu - q_, nside); }
    }
    SEAM(3);
    if (IN(4)) { combine_phase(F, args); REP2(4) combine_phase(F, args); }
    SEAM(4);
    if (IN(5)) { PH5 REP2(5) PH5 }
    SEAM(5);
    if (IN(6)) { router_phase(F, args); REP2(6) { __syncthreads(); router_phase(F, args); } }
    SEAM(6);
    if (IN(7)) { dispatch_phase(F, args); REP2(7) { __syncthreads(); dispatch_phase(F, args); } }
    SEAM(7);
    if (IN(8)) { PH8 REP2(8) PH8 }
    SEAM(8);
    if (IN(9)) { PH9 REP2(9) PH9 }
    SEAM(9);
    if (IN(10)) { final_phase(F, args); REP2(10) final_phase(F, args); }
#undef IN
#undef SEAM
}

extern "C" void kernel_launch(void* const* d_in, const int* in_sizes, int n_in, void* d_out, int out_size, void* d_ws, size_t ws_size, hipStream_t stream) {
    static int grid = 0;
    if (grid == 0) {
        if (n_in != 26 || in_sizes[0] != M * D || out_size != M * D || ws_size < WS_END) { fprintf(stderr, "kernel_launch: unexpected problem (n_in %d, in0 %d, out %d, ws %zu)\n", n_in, n_in > 0 ? in_sizes[0] : -1, out_size, ws_size); grid = -1; return; }
        int dev = 0, cus = 0, per_cu = 0;
        if (hipGetDevice(&dev) != hipSuccess || hipDeviceGetAttribute(&cus, hipDeviceAttributeMultiprocessorCount, dev) != hipSuccess) { grid = -1; return; }
        if (hipFuncSetAttribute((const void*)fwd_megakernel, hipFuncAttributeMaxDynamicSharedMemorySize, LDS_BYTES) != hipSuccess) { fprintf(stderr, "kernel_launch: hipFuncSetAttribute failed\n"); grid = -1; return; }
        if (hipOccupancyMaxActiveBlocksPerMultiprocessor(&per_cu, (const void*)fwd_megakernel, 512, LDS_BYTES) != hipSuccess || per_cu < 1) { fprintf(stderr, "kernel_launch: occupancy query says %d\n", per_cu); per_cu = 1; }
        (void)hipGetLastError();
        grid = cus * 1;
        if (grid != 256) fprintf(stderr, "kernel_launch: note: %d CUs\n", cus);
    }
    if (grid < 0) return;
    if (hipMemsetAsync((char*)d_ws + WS_CTL + (size_t)CW_BAR * 4, 0, XCD_BAR_WORDS * 4, stream) != hipSuccess) { fprintf(stderr, "kernel_launch: memset failed\n"); return; }
    Args a{};
    for (int i = 0; i < 26; ++i) a.in[i] = (const float*)d_in[i];
    a.out = (float*)d_out; a.ws = (unsigned char*)d_ws;
#if MK_SPLIT
    for (int ph = 0; ph < NPHASE; ++ph) { a.ph_lo = ph; a.ph_hi = ph + 1; hipLaunchKernelGGL(fwd_megakernel, dim3(grid), dim3(512), LDS_BYTES, stream, a); }
#else
    a.ph_lo = 0; a.ph_hi = NPHASE;
    void* kargs[] = {&a};
    hipError_t e = hipLaunchCooperativeKernel((const void*)fwd_megakernel, dim3(grid), dim3(512), kargs, LDS_BYTES, stream);
    if (e != hipSuccess) fprintf(stderr, "kernel_launch: cooperative launch failed: %s (grid %d)\n", hipGetErrorString(e), grid);
#endif
}
```
